# Optimizing an MI355X kernel written in HIP

```python
import math
import jax, jax.numpy as jnp
from jax import lax
import numpy as np

D_MODEL = 1024
BATCH = 2
SEQ = 8192
DEPTH = 2

N_BRANCH = 4
BRANCH_WIDTH = D_MODEL // 2
POOL_WINDOWS = (2, 4, 8, 16)
POOL_GROUPS = len(POOL_WINDOWS)
POOL_GROUP_DIM = BRANCH_WIDTH // POOL_GROUPS
HGRN_HEAD_DIM = 128
HGRN_HEADS = BRANCH_WIDTH // HGRN_HEAD_DIM
HGRN_CHUNK = 64
GMLP_CHUNK = 128
GMLP_GROUPS = 4
GMLP_GROUP_DIM = BRANCH_WIDTH // GMLP_GROUPS
FOX_HEAD_DIM = 128
FOX_HEADS = BRANCH_WIDTH // FOX_HEAD_DIM
FOX_BLOCK = 128
N_IN = BRANCH_WIDTH * (1 + 4 + 2 + 3) + FOX_HEADS
PEER_HEADS = 8
PEER_N_KEYS = 128
PEER_N_EXPERTS = PEER_N_KEYS * PEER_N_KEYS
PEER_TOPK = 16
PEER_QUERY_DIM = 256
PEER_HALF = PEER_QUERY_DIM // 2
PEER_BLOCK = 128
ALPHA = (2.0 * DEPTH) ** 0.25
BETA = (8.0 * DEPTH) ** -0.25
LN_EPS = 1e-5
RMS_EPS = 1e-6
NEG_BIG = -1e30

kernel_name = "hybrid_pool_hgrn2_gmlp_fox_peer_deepnorm"


def layer_norm(x, g, b):
    xf = x.astype(jnp.float32)
    mu = jnp.mean(xf, -1, keepdims=True)
    var = jnp.mean(jnp.square(xf - mu), -1, keepdims=True)
    return ((xf - mu) * lax.rsqrt(var + LN_EPS) * g + b).astype(x.dtype)


def rms_norm(x, g):
    xf = x.astype(jnp.float32)
    return xf * lax.rsqrt(jnp.mean(jnp.square(xf), -1, keepdims=True) + RMS_EPS) * g


def pool_mixer(p, pool_w, pool_scale):
    B, S, _ = p.shape
    pf = p.astype(jnp.float32)
    cs = jnp.cumsum(pf, axis=1)
    cs = jnp.concatenate([jnp.zeros_like(cs[:, :1]), cs], axis=1)
    t1 = jnp.arange(1, S + 1, dtype=jnp.float32)[None, :, None]
    outs = []
    for g, w in enumerate(POOL_WINDOWS):
        sl = slice(g * POOL_GROUP_DIM, (g + 1) * POOL_GROUP_DIM)
        cg = cs[..., sl]
        lo = jnp.pad(cg[:, :S + 1 - w], ((0, 0), (w - 1, 0), (0, 0)))
        mean = (cg[:, 1:] - lo) / jnp.minimum(t1, float(w))
        outs.append(mean - pf[..., sl])
    d = jnp.stack(outs, axis=2).astype(p.dtype)
    y = jnp.einsum('bsgc,gcd->bsgd', d, pool_w).reshape(B, S, BRANCH_WIDTH)
    return y * pool_scale


def hgrn2_mixer(q, f_raw, i, g, lb, norm_g):
    B, S, _ = q.shape
    H, Dh, C = HGRN_HEADS, HGRN_HEAD_DIM, HGRN_CHUNK
    n = S // C
    zf = f_raw.astype(jnp.float32)
    k = (1.0 - lb) * jax.nn.sigmoid(-zf)
    log_f = jnp.log1p(-k)

    def chunks(z):
        return z.astype(jnp.float32).reshape(B, n, C, H, Dh).transpose(1, 0, 3, 2, 4)

    mask = jnp.tril(jnp.ones((C, C), bool))[None, None, :, :, None]

    def step(state, inp):
        qc, kc, vc, lc = inp
        b = jnp.cumsum(lc, axis=2)
        o_inter = jnp.einsum('bhtk,bhkv->bhtv', qc * jnp.exp(b), state)
        diff = b[:, :, :, None, :] - b[:, :, None, :, :]
        decay = jnp.exp(jnp.where(mask, diff, NEG_BIG))
        a = jnp.einsum('bhtk,bhtsk,bhsk->bhts', qc, decay, kc)
        o = o_inter + jnp.einsum('bhts,bhsv->bhtv', a, vc)
        b_last = b[:, :, -1:, :]
        new_state = jnp.exp(b_last[:, :, 0, :, None]) * state + jnp.einsum(
            'bhsk,bhsv->bhkv', kc * jnp.exp(b_last - b), vc)
        return new_state, o

    s0 = jnp.zeros((B, H, Dh, Dh), jnp.float32)
    _, o = lax.scan(step, s0, (chunks(jax.nn.silu(q.astype(jnp.float32))), chunks(k), chunks(i), chunks(log_f)))
    o = o.transpose(1, 0, 3, 2, 4).reshape(B, S, H, Dh)
    o = rms_norm(o, norm_g).reshape(B, S, BRANCH_WIDTH)
    return (o * jax.nn.silu(g.astype(jnp.float32))).astype(q.dtype)


def gmlp_mixer(u, v, ln_g, ln_b, ws, bs):
    B, S, _ = u.shape
    n = S // GMLP_CHUNK
    u = jax.nn.gelu(u)
    v = layer_norm(jax.nn.gelu(v), ln_g, ln_b)
    vc = v.reshape(B, n, GMLP_CHUNK, GMLP_GROUPS, GMLP_GROUP_DIM)
    ws_causal = ws * jnp.tril(jnp.ones((GMLP_CHUNK, GMLP_CHUNK), ws.dtype))
    s = jnp.einsum('gts,bnsgc->bntgc', ws_causal, vc) + bs.T[None, None, :, :, None]
    return u * s.reshape(B, S, BRANCH_WIDTH)


def fox_mixer(q, k, v, f_logit):
    B, S, _ = q.shape
    H, Dh, Bq = FOX_HEADS, FOX_HEAD_DIM, FOX_BLOCK
    nb = S // Bq
    c = jnp.cumsum(jax.nn.log_sigmoid(f_logit.astype(jnp.float32)), axis=1).transpose(0, 2, 1)
    qh = q.reshape(B, S, H, Dh).transpose(0, 2, 1, 3) * (Dh ** -0.5)
    kh = k.reshape(B, S, H, Dh).transpose(0, 2, 1, 3)
    vh = v.reshape(B, S, H, Dh).transpose(0, 2, 1, 3)
    qb = qh.reshape(B, H, nb, Bq, Dh).transpose(2, 0, 1, 3, 4)
    cb = c.reshape(B, H, nb, Bq).transpose(2, 0, 1, 3)
    pos_k = jnp.arange(S)

    def block(args):
        qi, ci, blk = args
        pos_q = blk * Bq + jnp.arange(Bq)
        logits = jnp.einsum('bhtd,bhsd->bhts', qi.astype(jnp.float32), kh.astype(jnp.float32))
        logits = logits + ci[..., None] - c[:, :, None, :]
        logits = jnp.where(pos_q[:, None] >= pos_k[None, :], logits, NEG_BIG)
        p = jax.nn.softmax(logits, axis=-1)
        return jnp.einsum('bhts,bhsd->bhtd', p.astype(vh.dtype), vh)

    o = lax.map(block, (qb, cb, jnp.arange(nb)))
    return o.transpose(1, 0, 3, 2, 4).reshape(B, S, BRANCH_WIDTH)


def token_mixer_block(x, w_in, b_fox_f, pool_w, pool_scale, lb, hgrn_norm_g,
                      gmlp_ln_g, gmlp_ln_b, gmlp_ws, gmlp_bs, w_gate, b_gate, w_branch, w_out):
    B, S, D = x.shape
    W = BRANCH_WIDTH
    h = jnp.einsum('bsd,dn->bsn', x, w_in)
    splits = [W * j for j in range(1, 11)]
    (p_in, hq, hf, hi, hg, gu, gv, fq, fk, fv, ff) = jnp.split(h, splits, axis=-1)
    a = pool_mixer(p_in, pool_w, pool_scale)
    b = hgrn2_mixer(hq, hf, hi, hg, lb, hgrn_norm_g)
    c = gmlp_mixer(gu, gv, gmlp_ln_g, gmlp_ln_b, gmlp_ws, gmlp_bs)
    d = fox_mixer(fq, fk, fv, ff + b_fox_f)
    br = jnp.stack([a, b, c, d], axis=2)
    gates = jax.nn.sigmoid(jnp.einsum('bsd,dn->bsn', x, w_gate) + b_gate).reshape(B, S, N_BRANCH, D)
    merged = jnp.einsum('bsmw,mwd,bsmd->bsd', br, w_branch, gates)
    return jnp.einsum('bsd,de->bse', merged, w_out)


def peer_ffn(x, wq, keys, u_tab, v_tab):
    B, S, D = x.shape
    T = B * S
    xt = x.reshape(T, D)
    q = jnp.einsum('td,dn->tn', xt, wq).reshape(T, PEER_HEADS, 2, PEER_HALF).astype(jnp.float32)
    s1 = jnp.einsum('thd,hkd->thk', q[:, :, 0], keys[0].astype(jnp.float32))
    s2 = jnp.einsum('thd,hkd->thk', q[:, :, 1], keys[1].astype(jnp.float32))
    v1, i1 = lax.top_k(s1, PEER_TOPK)
    v2, i2 = lax.top_k(s2, PEER_TOPK)
    cand = (v1[..., :, None] + v2[..., None, :]).reshape(T, PEER_HEADS, PEER_TOPK * PEER_TOPK)
    cidx = (i1[..., :, None] * PEER_N_KEYS + i2[..., None, :]).reshape(T, PEER_HEADS, PEER_TOPK * PEER_TOPK)
    top_s, pos = lax.top_k(cand, PEER_TOPK)
    eidx = jnp.take_along_axis(cidx, pos, axis=-1)
    gate = jax.nn.softmax(top_s, axis=-1).astype(x.dtype)
    nblk = T // PEER_BLOCK

    def blk(args):
        xb, eb, gb = args
        hidden = jax.nn.gelu(jnp.einsum('td,thkd->thk', xb, u_tab[eb]))
        return jnp.einsum('thk,thkd->td', gb * hidden, v_tab[eb])

    y = lax.map(blk, (xt.reshape(nblk, PEER_BLOCK, D),
                      eidx.reshape(nblk, PEER_BLOCK, PEER_HEADS, PEER_TOPK),
                      gate.reshape(nblk, PEER_BLOCK, PEER_HEADS, PEER_TOPK)))
    return y.reshape(B, S, D)


def setup_inputs(seed: int = 0) -> dict:
    key = jax.random.key(seed)
    ks = jax.random.split(key, 24)
    f32 = jnp.float32
    L, D, W = DEPTH, D_MODEL, BRANCH_WIDTH

    def nrm(k, shape, scale):
        return jax.random.normal(k, shape, f32) * scale

    return {
        "x": nrm(ks[0], (BATCH, SEQ, D), 1.0),
        "w_in": nrm(ks[1], (L, D, N_IN), D ** -0.5),
        "b_fox_f": nrm(ks[2], (L, FOX_HEADS), 0.1),
        "pool_w": nrm(ks[3], (L, POOL_GROUPS, POOL_GROUP_DIM, POOL_GROUP_DIM), POOL_GROUP_DIM ** -0.5),
        "pool_scale": 1.0 + nrm(ks[4], (L, W), 0.02),
        "hgrn_lb_logits": nrm(ks[5], (L, W), 0.1),
        "hgrn_norm_g": 1.0 + nrm(ks[6], (L, HGRN_HEAD_DIM), 0.02),
        "gmlp_ln_g": 1.0 + nrm(ks[7], (L, W), 0.02),
        "gmlp_ln_b": nrm(ks[8], (L, W), 0.02),
        "gmlp_ws": nrm(ks[9], (L, GMLP_GROUPS, GMLP_CHUNK, GMLP_CHUNK), 0.02),
        "gmlp_bs": 1.0 + nrm(ks[10], (L, GMLP_GROUPS, GMLP_CHUNK), 0.01),
        "w_gate": nrm(ks[11], (L, D, N_BRANCH * D), D ** -0.5),
        "b_gate": nrm(ks[12], (L, N_BRANCH * D), 0.02),
        "w_branch": nrm(ks[13], (L, N_BRANCH, W, D), BETA * W ** -0.5),
        "w_out": nrm(ks[14], (L, D, D), BETA * D ** -0.5),
        "ln1_g": 1.0 + nrm(ks[15], (L, D), 0.02),
        "ln1_b": nrm(ks[16], (L, D), 0.02),
        "peer_wq": nrm(ks[17], (L, D, PEER_HEADS * PEER_QUERY_DIM), D ** -0.5),
        "peer_keys": nrm(ks[18], (L, 2, PEER_HEADS, PEER_N_KEYS, PEER_HALF), PEER_HALF ** -0.5),
        "peer_u": nrm(ks[19], (L, PEER_N_EXPERTS, D), D ** -0.5),
        "peer_v": nrm(ks[20], (L, PEER_N_EXPERTS, D), BETA),
        "ln2_g": 1.0 + nrm(ks[21], (L, D), 0.02),
        "ln2_b": nrm(ks[22], (L, D), 0.02),
    }


def reference(x, w_in, b_fox_f, pool_w, pool_scale, hgrn_lb_logits, hgrn_norm_g, gmlp_ln_g, gmlp_ln_b,
              gmlp_ws, gmlp_bs, w_gate, b_gate, w_branch, w_out, ln1_g, ln1_b, peer_wq, peer_keys,
              peer_u, peer_v, ln2_g, ln2_b):
    p_lb = jax.nn.softmax(hgrn_lb_logits.astype(jnp.float32), axis=0)
    lower_bounds = jnp.cumsum(p_lb, axis=0) - p_lb[0]
    for l in range(DEPTH):
        mix = token_mixer_block(x, w_in[l], b_fox_f[l], pool_w[l], pool_scale[l], lower_bounds[l],
                                hgrn_norm_g[l], gmlp_ln_g[l], gmlp_ln_b[l], gmlp_ws[l], gmlp_bs[l],
                                w_gate[l], b_gate[l], w_branch[l], w_out[l])
        x = layer_norm(ALPHA * x + mix, ln1_g[l], ln1_b[l])
        ffn = peer_ffn(x, peer_wq[l], peer_keys[l], peer_u[l], peer_v[l])
        x = layer_norm(ALPHA * x + ffn, ln2_g[l], ln2_b[l])
    return x
```

```cpp
#include <hip/hip_runtime.h>
#include <cstdio>
#include <cstdint>

#ifndef MK_ONE_LAUNCH
#define MK_ONE_LAUNCH 0
#endif

#define LAS __attribute__((address_space(3)))
#define GAS __attribute__((address_space(1)))
typedef unsigned short bf16_t;
typedef short bf16x8 __attribute__((ext_vector_type(8)));
typedef float f32x4 __attribute__((ext_vector_type(4)));
typedef float f32x2 __attribute__((ext_vector_type(2)));
typedef unsigned u32x4 __attribute__((ext_vector_type(4)));
typedef unsigned u32x2 __attribute__((ext_vector_type(2)));

constexpr int DM = 1024, BATCH = 2, SEQ = 8192, DEPTH = 2, T = BATCH * SEQ;
constexpr int BW = 512, NIN = 5124, NH = 5120, NG = 4096, NBR = 2048, NQ = 2048;
constexpr int NEXP = 16384, TOPK = 16, PH = 8;
constexpr float ALPHA = 1.4142135623730951f;
constexpr float LN_EPS = 1e-5f, RMS_EPS = 1e-6f;
constexpr int HC_P = 0, HC_HQ = 512, HC_HF = 1024, HC_HI = 1536, HC_HG = 2048, HC_GU = 2560, HC_GV = 3072, HC_FQ = 3584, HC_FK = 4096, HC_FV = 4608;

constexpr size_t MiB = 1u << 20;
constexpr size_t WS_CTL = 0, CTL_ZERO_BYTES = 64 * 1024;
constexpr size_t WS_MISC = 512 * 1024;
constexpr size_t WS_CUM = 768 * 1024;
constexpr size_t WS_W = 1 * MiB;
constexpr size_t W_LAYER = 30 * MiB;
constexpr size_t WO_WIN = 0, WO_WG = 10 * MiB, WO_WBR = 18 * MiB, WO_WOUT = 22 * MiB, WO_WQ = 24 * MiB, WO_KEYS = 28 * MiB, WO_WF = 28 * MiB + 512 * 1024;
constexpr size_t WS_TABU = 64 * MiB, WS_TABV = 96 * MiB;
constexpr size_t WS_XA = 128 * MiB;
constexpr size_t WS_XB = 192 * MiB;
constexpr size_t WS_X1B = 224 * MiB;
constexpr size_t WS_H = 256 * MiB;
constexpr size_t WS_ST = 416 * MiB;
constexpr size_t WS_BR = 448 * MiB;
constexpr size_t WS_G = 256 * MiB;
constexpr size_t WS_MGF = 384 * MiB;
constexpr size_t WS_XC = 256 * MiB;
constexpr size_t WS_Q = 320 * MiB;
constexpr size_t WS_EIDX = 384 * MiB, WS_EGATE = 392 * MiB;
constexpr size_t WS_END = 512 * MiB;

__device__ __forceinline__ float bf2f(unsigned u) { return __builtin_bit_cast(float, u << 16); }
__device__ __forceinline__ unsigned f2bf(float f) { unsigned u = __builtin_bit_cast(unsigned, f); return (u + 0x7fffu + ((u >> 16) & 1u)) >> 16; }
__device__ __forceinline__ unsigned pk2(float lo, float hi) { return f2bf(lo) | (f2bf(hi) << 16); }
__device__ __forceinline__ float wave_sum(float v) {
#pragma unroll
    for (int o = 32; o > 0; o >>= 1) v += __shfl_xor(v, o, 64);
    return v;
}
__device__ __forceinline__ float sigmoidf_(float x) { return 1.f / (1.f + __expf(-x)); }
__device__ __forceinline__ float siluf_(float x) { return x / (1.f + __expf(-x)); }
__device__ __forceinline__ float geluf_(float x) { const float u = 0.7978845608028654f * (x + 0.044715f * x * x * x); return 0.5f * x * (1.f + tanhf(u)); }
__device__ __forceinline__ float logsigmoidf_(float z) { return fminf(z, 0.f) - log1pf(__expf(-fabsf(z))); }

namespace pg8 {
constexpr int BM = 256, BK = 64, HALF = 128, HTB = HALF * BK * 2, STAGE_BYTES = 8 * HTB, NXCD = 8, WGM = 8;
__host__ __device__ __forceinline__ int lds_byte(int r, int c) { const int st = (r >> 4) * 2 + (c >> 5), rr = r & 15, cc = c & 31, ob = rr * 64 + cc * 2; return st * 1024 + (ob ^ (((ob >> 9) & 1) << 5)); }
__host__ __device__ __forceinline__ void stage_rc(int b, int& R, int& C) { const int st = b / 1024, sb = b % 1024, swz = sb ^ (((sb >> 9) & 1) << 5); R = (st >> 1) * 16 + swz / 64; C = (st & 1) * 32 + (swz % 64) / 2; }
__host__ __device__ __forceinline__ int perm32(int rho) { const int n = rho >> 4, i = rho & 15; return 8 * (i >> 2) + 4 * n + (i & 3); }

struct Unit { int pm, pn, z; };
struct Gemm { const bf16_t* A; const bf16_t* Bt; int lda, ldb, K; size_t zA, zB; };

struct StaticOrder {
    int nM, nN, nwg, G, c;
    __device__ void init(int M, int N, int G_, int c_) { nM = M / BM; nN = N / BM; nwg = nM * nN; G = G_; c = c_; }
    __device__ bool next(int i, Unit& u) const {
        const long L = (long)i * G + c; if (L >= nwg) return false;
        int wgid = (int)L; { const int q = nwg / NXCD, r = nwg % NXCD, xcd = wgid % NXCD, off = wgid / NXCD; wgid = (xcd < r ? xcd * (q + 1) : r * (q + 1) + (xcd - r) * q) + off; }
        const int nig = WGM * nN, gid = wgid / nig, fm = gid * WGM, gsz = (nM - fm) < WGM ? (nM - fm) : WGM;
        u.pm = fm + ((wgid % nig) % gsz); u.pn = (wgid % nig) / gsz; u.z = 0; return true;
    }
};
struct ZOrder {
    int nM, nN, nZ, ntile, G, c;
    __device__ void init(int M, int N, int Z, int G_, int c_) { nM = M / BM; nN = N / BM; nZ = Z; ntile = nM * nN; G = G_; c = c_; }
    __device__ bool next(int i, Unit& u) const {
        const long L = (long)(i / nZ) * G + c; if (L >= ntile) return false;
        u.pm = (int)L / nN; u.pn = (int)L % nN; u.z = i % nZ; return true;
    }
};

template <class F> struct Epi8 {
    static constexpr bool PERM = true;
    F f;
    __device__ __forceinline__ void operator()(const f32x4 (&acc)[2][2][4][2], const Unit& u, int wr, int wc, int fr, int fq) const {
        const int row0 = u.pm * BM + wr * 64 + fr, col0 = u.pn * BM + wc * 32 + 8 * fq;
#pragma unroll
        for (int ai = 0; ai < 2; ++ai)
#pragma unroll
            for (int m = 0; m < 4; ++m)
#pragma unroll
                for (int bj = 0; bj < 2; ++bj) f(row0 + ai * HALF + m * 16, col0 + bj * HALF, acc[ai][bj][m][0], acc[ai][bj][m][1], u.z);
    }
};
template <class F> struct Epi4 {
    static constexpr bool PERM = false;
    F f;
    __device__ __forceinline__ void operator()(const f32x4 (&acc)[2][2][4][2], const Unit& u, int wr, int wc, int fr, int fq) const {
        const int row0 = u.pm * BM + wr * 64 + fr, col0 = u.pn * BM + wc * 32 + 4 * fq;
#pragma unroll
        for (int ai = 0; ai < 2; ++ai)
#pragma unroll
            for (int m = 0; m < 4; ++m)
#pragma unroll
                for (int bj = 0; bj < 2; ++bj)
#pragma unroll
                    for (int n = 0; n < 2; ++n) f(row0 + ai * HALF + m * 16, col0 + bj * HALF + n * 16, acc[ai][bj][m][n], u.z);
    }
};

template <class Epi, class Sched, bool ALIGN_EPI = true>
__device__ __forceinline__ void gemm_phase(LAS unsigned char* lds, const Gemm g, const Sched& S, const Epi& E) {
    const int tid = threadIdx.x, wid = __builtin_amdgcn_readfirstlane(tid >> 6), lane = tid & 63, wr = wid >> 2, wc = wid & 3, fr = lane & 15, fq = lane >> 4;
    const int K = g.K, nt = K / BK;
    unsigned voffA[2], voffB[2];
#pragma unroll
    for (int i = 0; i < 2; ++i) { int R, C; stage_rc(tid * 16 + i * 8192, R, C); const int Rb = Epi::PERM ? ((R & ~31) + perm32(R & 31)) : R;
        voffA[i] = (unsigned)(R * g.lda + C) * 2u; voffB[i] = (unsigned)(Rb * g.ldb + C) * 2u; }
    const size_t kstep = (size_t)(BK * 2);
    const size_t hstepA = (size_t)HALF * g.lda * 2, hstepB = (size_t)HALF * g.ldb * 2;
    const size_t tstepA = 2 * hstepA, tstepB = 2 * hstepB;
    const unsigned ldsw = (unsigned)wid * 1024u;
    const int aoff = lds_byte(wr * 64 + fr, fq * 8), boff = lds_byte(wc * 32 + fr, fq * 8);
#define PG8_SA(b, h) (((b) * 2 + (h)) * HTB)
#define PG8_SB(b, h) ((4 + (b) * 2 + (h)) * HTB)
#define PG8_STAGE(bufoff, gbase, voff) do { _Pragma("unroll") for (int _i = 0; _i < 2; ++_i) \
        __builtin_amdgcn_global_load_lds((const unsigned*)((const char*)(gbase) + (voff)[_i]), (LAS unsigned*)(lds + (bufoff) + ldsw + _i * 8192), 16, 0, 0); } while (0)
#define PG8_LDA(dst, b, h) do { _Pragma("unroll") for (int m = 0; m < 4; ++m) _Pragma("unroll") for (int k = 0; k < 2; ++k) dst[m][k] = *(const LAS bf16x8*)(lds + PG8_SA(b, h) + aoff + m * 2048 + k * 1024); } while (0)
#define PG8_LDB(dst, b, h) do { _Pragma("unroll") for (int n = 0; n < 2; ++n) _Pragma("unroll") for (int k = 0; k < 2; ++k) dst[n][k] = *(const LAS bf16x8*)(lds + PG8_SB(b, h) + boff + n * 2048 + k * 1024); } while (0)
#define PG8_MMA(ai, bj, At, Bt) do { __builtin_amdgcn_s_setprio(1); _Pragma("unroll") for (int m = 0; m < 4; ++m) _Pragma("unroll") for (int n = 0; n < 2; ++n) _Pragma("unroll") for (int k = 0; k < 2; ++k) \
        acc[ai][bj][m][n] = __builtin_amdgcn_mfma_f32_16x16x32_bf16(Bt[n][k], At[m][k], acc[ai][bj][m][n], 0, 0, 0); __builtin_amdgcn_s_setprio(0); } while (0)
#define PG8_WAIT_V(n) asm volatile("s_waitcnt vmcnt(" #n ")" ::: "memory")
#define PG8_WAIT_L(n) asm volatile("s_waitcnt lgkmcnt(" #n ")" ::: "memory")
#define PG8_BAR __builtin_amdgcn_s_barrier()
#define PG8_SCHED __builtin_amdgcn_sched_barrier(0)
    Unit cur, nxt; int ui = 0;
    if (!S.next(0, cur)) return;
    f32x4 acc[2][2][4][2];
#pragma unroll
    for (int a = 0; a < 2; ++a)
#pragma unroll
        for (int b = 0; b < 2; ++b)
#pragma unroll
            for (int m = 0; m < 4; ++m)
#pragma unroll
                for (int n = 0; n < 2; ++n) acc[a][b][m][n] = (f32x4){0.f, 0.f, 0.f, 0.f};
    bf16x8 At[4][2], B0[2][2], B1[2][2];
    const char* cA = (const char*)(g.A + (size_t)cur.z * g.zA) + (size_t)cur.pm * tstepA; const char* cB = (const char*)(g.Bt + (size_t)cur.z * g.zB) + (size_t)cur.pn * tstepB;
    PG8_STAGE(PG8_SB(0, 0), cB, voffB); PG8_STAGE(PG8_SB(0, 1), cB + hstepB, voffB); PG8_STAGE(PG8_SA(0, 0), cA, voffA); PG8_STAGE(PG8_SA(0, 1), cA + hstepA, voffA);
    if (wr == 1) PG8_BAR;
    PG8_WAIT_V(2); PG8_BAR;
    PG8_STAGE(PG8_SB(1, 0), cB + kstep, voffB); PG8_STAGE(PG8_SA(1, 0), cA + kstep, voffA); PG8_STAGE(PG8_SB(1, 1), cB + hstepB + kstep, voffB);
    PG8_WAIT_V(6); PG8_BAR;
    for (;;) {
        const bool has_next = S.next(ui + 1, nxt);
        const char* nA = has_next ? (const char*)(g.A + (size_t)nxt.z * g.zA) + (size_t)nxt.pm * tstepA : cA;
        const char* nB = has_next ? (const char*)(g.Bt + (size_t)nxt.z * g.zB) + (size_t)nxt.pn * tstepB : cB;
        for (int t = 0; t < nt; t += 2) {
            const bool last = (t == nt - 2);
            const char* a1 = cA + (size_t)(t + 1) * kstep;
            const char* a2 = last ? nA : cA + (size_t)(t + 2) * kstep; const char* b2 = last ? nB : cB + (size_t)(t + 2) * kstep;
            const char* a3 = a2 + kstep; const char* b3 = b2 + kstep;
            PG8_LDB(B0, 0, 0); PG8_LDB(B1, 0, 1); PG8_SCHED; PG8_LDA(At, 0, 0); PG8_STAGE(PG8_SA(1, 1), a1 + hstepA, voffA);
            PG8_WAIT_V(8); PG8_WAIT_L(0); PG8_BAR; PG8_MMA(0, 0, At, B0); PG8_MMA(0, 1, At, B1); PG8_BAR; PG8_SCHED;
            PG8_LDA(At, 0, 1); PG8_STAGE(PG8_SB(0, 0), b2, voffB); PG8_STAGE(PG8_SB(0, 1), b2 + hstepB, voffB); PG8_STAGE(PG8_SA(0, 0), a2, voffA);
            PG8_WAIT_V(8); PG8_WAIT_L(0); PG8_BAR; PG8_MMA(1, 0, At, B0); PG8_MMA(1, 1, At, B1); PG8_BAR; PG8_SCHED;
            PG8_LDB(B0, 1, 0); PG8_LDB(B1, 1, 1); PG8_SCHED; PG8_LDA(At, 1, 0); PG8_STAGE(PG8_SA(0, 1), a2 + hstepA, voffA);
            PG8_WAIT_V(8); PG8_WAIT_L(0); PG8_BAR; PG8_MMA(0, 0, At, B0); PG8_MMA(0, 1, At, B1); PG8_BAR; PG8_SCHED;
            PG8_LDA(At, 1, 1); PG8_STAGE(PG8_SB(1, 0), b3, voffB); PG8_STAGE(PG8_SB(1, 1), b3 + hstepB, voffB); PG8_STAGE(PG8_SA(1, 0), a3, voffA);
            PG8_WAIT_V(8); PG8_WAIT_L(0); PG8_BAR; PG8_MMA(1, 0, At, B0); PG8_MMA(1, 1, At, B1); PG8_BAR; PG8_SCHED;
        }
        if constexpr (ALIGN_EPI) { if (wr == 0) PG8_BAR; }
        E(acc, cur, wr, wc, fr, fq);
        if (!has_next) break;
#pragma unroll
        for (int a = 0; a < 2; ++a)
#pragma unroll
            for (int b = 0; b < 2; ++b)
#pragma unroll
                for (int m = 0; m < 4; ++m)
#pragma unroll
                    for (int n = 0; n < 2; ++n) acc[a][b][m][n] = (f32x4){0.f, 0.f, 0.f, 0.f};
        cur = nxt; cA = nA; cB = nB; ++ui;
        if constexpr (ALIGN_EPI) { if (wr == 1) PG8_BAR; }
    }
    PG8_WAIT_V(0);
    if constexpr (!ALIGN_EPI) { if (wr == 0) PG8_BAR; }
    PG8_BAR;
#undef PG8_SA
#undef PG8_SB
#undef PG8_STAGE
#undef PG8_LDA
#undef PG8_LDB
#undef PG8_MMA
#undef PG8_WAIT_V
#undef PG8_WAIT_L
#undef PG8_BAR
#undef PG8_SCHED
}
}

#define XB_TMO      128
#define XB_XCNT(j)  (256  + 64 * (j))
#define XB_XSUB(j)  (1280 + 64 * (j))
#define XB_XGEN(j)  (2304 + 64 * (j))
#define XB_TOP      3328
#define XB_TOPGEN   3392
#define XCD_BAR_WORDS 3456
#define XB_SPIN_CAP (1u << 22)
__device__ __forceinline__ unsigned xb_ld(unsigned* p)              { return __hip_atomic_load(p, __ATOMIC_RELAXED, __HIP_MEMORY_SCOPE_AGENT); }
__device__ __forceinline__ unsigned xb_add(unsigned* p, unsigned v) { return __hip_atomic_fetch_add(p, v, __ATOMIC_RELAXED, __HIP_MEMORY_SCOPE_AGENT); }
__device__ __forceinline__ unsigned xb_xcc_id() { return (unsigned)__builtin_amdgcn_s_getreg((3 << 11) | 20) & 0xFu; }
#define XB_SPIN(cond, bar) do { unsigned _sp = 0; while (cond) { __builtin_amdgcn_s_sleep(1); \
    if ((++_sp & 255u) == 0u) { if (xb_ld(&(bar)[XB_TMO])) break; if (_sp > XB_SPIN_CAP) { atomicAdd(&(bar)[XB_TMO], 1u); break; } } } } while (0)
struct XcdBarrier { unsigned* bar; unsigned x; volatile LAS unsigned* st; };
__device__ __forceinline__ XcdBarrier xcd_barrier_post(unsigned* bar, volatile LAS unsigned* st) {
    XcdBarrier b; b.bar = bar; b.x = xb_xcc_id(); b.st = st;
    if (threadIdx.x == 0) (void)xb_add(&bar[XB_XCNT(b.x)], 1u);
    return b;
}
__device__ __forceinline__ void xcd_barrier_complete(unsigned* bar, unsigned x, unsigned& nloc, unsigned& nx) {
    const unsigned G = gridDim.x * gridDim.y * gridDim.z;
    unsigned sum, cnt, mine, sp = 0u;
    for (;;) {
        sum = 0u; cnt = 0u; mine = 0u;
#pragma unroll
        for (unsigned j = 0; j < 16; ++j) { const unsigned c = xb_ld(&bar[XB_XCNT(j)]); sum += c; cnt += (c > 0u) ? 1u : 0u; mine = (j == x) ? c : mine; }
        if (sum == G) break;
        __builtin_amdgcn_s_sleep(1);
        if ((++sp & 255u) == 0u) { if (xb_ld(&bar[XB_TMO])) break; if (sp > XB_SPIN_CAP) { atomicAdd(&bar[XB_TMO], 1u); break; } }
    }
    nloc = mine > 0u ? mine : 1u; nx = cnt > 0u ? cnt : 1u;
}
__device__ __forceinline__ void xcd_barrier(const XcdBarrier& b) {
    asm volatile("s_waitcnt vmcnt(0)" ::: "memory");
    __syncthreads();
    if (threadIdx.x == 0) {
        unsigned* bar = b.bar;
        __builtin_amdgcn_s_waitcnt(0);
        unsigned nloc = b.st[0], nx = b.st[1];
        if (nloc == 0u) { xcd_barrier_complete(bar, b.x, nloc, nx); b.st[0] = nloc; b.st[1] = nx; }
        const unsigned old = xb_add(&bar[XB_XSUB(b.x)], 1u);
        const unsigned gen = old / nloc;
        if (old + 1u == (gen + 1u) * nloc) {
            __builtin_amdgcn_fence(__ATOMIC_RELEASE, "agent");
            asm volatile("s_waitcnt vmcnt(0)" ::: "memory");
            const unsigned og = xb_add(&bar[XB_TOP], 1u);
            const unsigned tg = og / nx;
            if (og + 1u == (tg + 1u) * nx) xb_add(&bar[XB_TOPGEN], 1u);
            else XB_SPIN(xb_ld(&bar[XB_TOPGEN]) == tg, bar);
            __builtin_amdgcn_fence(__ATOMIC_ACQUIRE, "agent");
            xb_add(&bar[XB_XGEN(b.x)], 1u);
            asm volatile("s_waitcnt vmcnt(0)" ::: "memory");
        } else {
            XB_SPIN(xb_ld(&bar[XB_XGEN(b.x)]) == gen, bar);
            __builtin_amdgcn_fence(__ATOMIC_ACQUIRE, "agent");
            asm volatile("s_waitcnt vmcnt(0)" ::: "memory");
        }
    }
    __syncthreads();
}

constexpr int NIN_PTRS = 23;
struct Args { const float* in[NIN_PTRS]; float* out; unsigned char* ws; int ph_lo, ph_hi, bar_slot, pad; };
enum { I_X = 0, I_WIN, I_BFOX, I_POOLW, I_POOLS, I_LBL, I_HNG, I_GLNG, I_GLNB, I_GWS, I_GBS, I_WGATE, I_BGATE, I_WBR, I_WOUT, I_LN1G, I_LN1B, I_WQ, I_KEYS, I_PU, I_PV, I_LN2G, I_LN2B };

constexpr int LDS_BYTES = 147456;
constexpr int LDSCTL_OFF = 131072;

struct Ctx {
    LAS unsigned char* lds;
    unsigned char* ws;
    const float* const* in;
    float* out;
    int tid, lane, wave, G, bid, vcu;
};

__device__ __forceinline__ void tconv_job(const Ctx& C, const float* src, int ld_src, int K, int N, bf16_t* dst) {
    LAS float* tile = (LAS float*)C.lds;
    const int nk = K / 64, nn = N / 64, ntiles = nk * nn;
    for (int tl = C.bid; tl < ntiles; tl += C.G) {
        const int k0 = (tl / nn) * 64, n0 = (tl % nn) * 64;
#pragma unroll
        for (int p = 0; p < 2; ++p) {
            const int kr = (C.tid >> 4) + p * 32, nc = (C.tid & 15) * 4;
            const f32x4 v = *(const f32x4*)(src + (size_t)(k0 + kr) * ld_src + n0 + nc);
            tile[kr * 65 + nc + 0] = v[0]; tile[kr * 65 + nc + 1] = v[1]; tile[kr * 65 + nc + 2] = v[2]; tile[kr * 65 + nc + 3] = v[3];
        }
        __syncthreads();
        {
            const int n = C.tid >> 3, k8 = (C.tid & 7) * 8;
            u32x4 o;
#pragma unroll
            for (int j = 0; j < 4; ++j) o[j] = pk2(tile[(k8 + 2 * j) * 65 + n], tile[(k8 + 2 * j + 1) * 65 + n]);
            *(u32x4*)(dst + (size_t)(n0 + n) * K + k0 + k8) = o;
        }
        __syncthreads();
    }
}
__device__ __forceinline__ void cvt_copy(const Ctx& C, const float* src, bf16_t* dst, size_t n) {
    const size_t n8 = n / 8;
    for (size_t i = (size_t)C.bid * 512 + C.tid; i < n8; i += (size_t)C.G * 512) {
        const f32x4 a = *(const f32x4*)(src + i * 8), b = *(const f32x4*)(src + i * 8 + 4);
        u32x4 o; o[0] = pk2(a[0], a[1]); o[1] = pk2(a[2], a[3]); o[2] = pk2(b[0], b[1]); o[3] = pk2(b[2], b[3]);
        *(u32x4*)(dst + i * 8) = o;
    }
}
__device__ __forceinline__ void p_conv_weights(const Ctx& C) {
    for (int l = 0; l < DEPTH; ++l) {
        unsigned char* wb = C.ws + WS_W + (size_t)l * W_LAYER;
        tconv_job(C, C.in[I_WIN] + (size_t)l * DM * NIN, NIN, DM, NH, (bf16_t*)(wb + WO_WIN));
        tconv_job(C, C.in[I_WGATE] + (size_t)l * DM * NG, NG, DM, NG, (bf16_t*)(wb + WO_WG));
        for (int m = 0; m < 4; ++m)
            tconv_job(C, C.in[I_WBR] + ((size_t)l * 4 + m) * BW * DM, DM, BW, DM, (bf16_t*)(wb + WO_WBR) + (size_t)m * DM * BW);
        tconv_job(C, C.in[I_WOUT] + (size_t)l * DM * DM, DM, DM, DM, (bf16_t*)(wb + WO_WOUT));
        tconv_job(C, C.in[I_WQ] + (size_t)l * DM * NQ, NQ, DM, NQ, (bf16_t*)(wb + WO_WQ));
        cvt_copy(C, C.in[I_KEYS] + (size_t)l * 2 * PH * 128 * 128, (bf16_t*)(wb + WO_KEYS), (size_t)2 * PH * 128 * 128);
        float* wf = (float*)(wb + WO_WF);
        for (int i = C.bid * 512 + C.tid; i < 4 * DM; i += C.G * 512) { const int h = i / DM, k = i % DM; wf[i] = C.in[I_WIN][(size_t)l * DM * NIN + (size_t)k * NIN + NH + h]; }
    }
}
__device__ __forceinline__ void p_conv_tables(const Ctx& C, int l) {
    cvt_copy(C, C.in[I_PU] + (size_t)l * NEXP * DM, (bf16_t*)(C.ws + WS_TABU), (size_t)NEXP * DM);
    cvt_copy(C, C.in[I_PV] + (size_t)l * NEXP * DM, (bf16_t*)(C.ws + WS_TABV), (size_t)NEXP * DM);
}

__device__ __forceinline__ void row_emit(const Ctx& C, int row, const float (&v)[16], int l, bool want_lsig) {
    bf16_t* xb = (bf16_t*)(C.ws + WS_XB) + (size_t)row * DM;
    u32x4 o0, o1;
#pragma unroll
    for (int j = 0; j < 4; ++j) { o0[j] = pk2(v[2 * j], v[2 * j + 1]); o1[j] = pk2(v[8 + 2 * j], v[8 + 2 * j + 1]); }
    *(u32x4*)(xb + C.lane * 8) = o0; *(u32x4*)(xb + 512 + C.lane * 8) = o1;
    if (want_lsig) {
        const float* wf = (const float*)(C.ws + WS_W + (size_t)l * W_LAYER + WO_WF);
        float* lsig = (float*)(C.ws + WS_MISC);
#pragma unroll
        for (int h = 0; h < 4; ++h) {
            const f32x4 a0 = *(const f32x4*)(wf + h * DM + C.lane * 8), a1 = *(const f32x4*)(wf + h * DM + C.lane * 8 + 4);
            const f32x4 b0 = *(const f32x4*)(wf + h * DM + 512 + C.lane * 8), b1 = *(const f32x4*)(wf + h * DM + 512 + C.lane * 8 + 4);
            float s = 0.f;
#pragma unroll
            for (int j = 0; j < 4; ++j) s += v[j] * a0[j] + v[4 + j] * a1[j] + v[8 + j] * b0[j] + v[12 + j] * b1[j];
            s = wave_sum(s);
            if (C.lane == 0) lsig[(size_t)row * 4 + h] = logsigmoidf_(s + C.in[I_BFOX][l * 4 + h]);
        }
    }
}
__device__ __forceinline__ void load_row16(const float* p, int lane, float (&v)[16]) {
    const f32x4 a0 = *(const f32x4*)(p + lane * 8), a1 = *(const f32x4*)(p + lane * 8 + 4), b0 = *(const f32x4*)(p + 512 + lane * 8), b1 = *(const f32x4*)(p + 512 + lane * 8 + 4);
#pragma unroll
    for (int j = 0; j < 4; ++j) { v[j] = a0[j]; v[4 + j] = a1[j]; v[8 + j] = b0[j]; v[12 + j] = b1[j]; }
}
__device__ __forceinline__ void store_row16(float* p, int lane, const float (&v)[16]) {
    *(f32x4*)(p + lane * 8) = (f32x4){v[0], v[1], v[2], v[3]}; *(f32x4*)(p + lane * 8 + 4) = (f32x4){v[4], v[5], v[6], v[7]};
    *(f32x4*)(p + 512 + lane * 8) = (f32x4){v[8], v[9], v[10], v[11]}; *(f32x4*)(p + 512 + lane * 8 + 4) = (f32x4){v[12], v[13], v[14], v[15]};
}
__device__ __forceinline__ void ln_row16(float (&v)[16], const float* g, const float* b, int lane) {
    float s = 0.f;
#pragma unroll
    for (int j = 0; j < 16; ++j) s += v[j];
    const float mean = wave_sum(s) * (1.f / DM);
    float q = 0.f;
#pragma unroll
    for (int j = 0; j < 16; ++j) { const float d = v[j] - mean; q += d * d; }
    const float rstd = rsqrtf(wave_sum(q) * (1.f / DM) + LN_EPS);
    float gg[16], bb[16];
    load_row16(g, lane, gg); load_row16(b, lane, bb);
#pragma unroll
    for (int j = 0; j < 16; ++j) v[j] = (v[j] - mean) * rstd * gg[j] + bb[j];
}
__device__ __forceinline__ void p_rowpass0(const Ctx& C) {
    for (int row = C.bid * 8 + C.wave; row < T; row += C.G * 8) {
        float v[16]; load_row16(C.in[I_X] + (size_t)row * DM, C.lane, v);
        row_emit(C, row, v, 0, true);
    }
}
__device__ __forceinline__ void p_cumsum(const Ctx& C) {
    if (C.bid != 0) return;
    const float* lsig = (const float*)(C.ws + WS_MISC);
    float* cum = (float*)(C.ws + WS_CUM);
    const int b = C.wave >> 2, h = C.wave & 3;
    float loc = 0.f;
    for (int j = 0; j < 128; ++j) loc += lsig[((size_t)b * SEQ + C.lane * 128 + j) * 4 + h];
    float inc = loc;
#pragma unroll
    for (int o = 1; o < 64; o <<= 1) { const float t = __shfl_up(inc, o, 64); if (C.lane >= o) inc += t; }
    float run = inc - loc;
    for (int j = 0; j < 128; ++j) { run += lsig[((size_t)b * SEQ + C.lane * 128 + j) * 4 + h]; cum[((size_t)b * 4 + h) * SEQ + C.lane * 128 + j] = run; }
}
__device__ __forceinline__ void p_ln1(const Ctx& C, int l) {
    float* xc = (float*)(C.ws + WS_XC); bf16_t* x1b = (bf16_t*)(C.ws + WS_X1B);
    for (int row = C.bid * 8 + C.wave; row < T; row += C.G * 8) {
        float v[16]; load_row16(xc + (size_t)row * DM, C.lane, v);
        ln_row16(v, C.in[I_LN1G] + l * DM, C.in[I_LN1B] + l * DM, C.lane);
        store_row16(xc + (size_t)row * DM, C.lane, v);
        u32x4 o0, o1;
#pragma unroll
        for (int j = 0; j < 4; ++j) { o0[j] = pk2(v[2 * j], v[2 * j + 1]); o1[j] = pk2(v[8 + 2 * j], v[8 + 2 * j + 1]); }
        *(u32x4*)(x1b + (size_t)row * DM + C.lane * 8) = o0; *(u32x4*)(x1b + (size_t)row * DM + 512 + C.lane * 8) = o1;
    }
}

__device__ __forceinline__ void mix_pool_naive(const Ctx& C, int l) {
    const bf16_t* H = (const bf16_t*)(C.ws + WS_H); bf16_t* BR = (bf16_t*)(C.ws + WS_BR);
    LAS float* dd = (LAS float*)C.lds;
    for (int u = C.bid; u < (T / 64) * 4; u += C.G) {
        const int g = u & 3, t0 = (u >> 2) * 64, w = 2 << g;
        for (int idx = C.tid; idx < 64 * 128; idx += 512) {
            const int r = idx >> 7, c = idx & 127, row = t0 + r, pos = row & (SEQ - 1);
            const int nwin = (pos + 1 < w) ? pos + 1 : w;
            float s = 0.f;
            for (int j = 0; j < nwin; ++j) s += bf2f(H[(size_t)(row - j) * NH + HC_P + g * 128 + c]);
            dd[idx] = s / (float)nwin - bf2f(H[(size_t)row * NH + HC_P + g * 128 + c]);
        }
        __syncthreads();
        const int dcol = C.tid & 127, rq = C.tid >> 7;
        float acc[16];
#pragma unroll
        for (int i = 0; i < 16; ++i) acc[i] = 0.f;
        const float* pw = C.in[I_POOLW] + ((size_t)l * 4 + g) * 128 * 128;
        for (int c = 0; c < 128; ++c) {
            const float wv = pw[c * 128 + dcol];
#pragma unroll
            for (int i = 0; i < 16; ++i) acc[i] += dd[(rq * 16 + i) * 128 + c] * wv;
        }
        const float sc = C.in[I_POOLS][l * BW + g * 128 + dcol];
#pragma unroll
        for (int i = 0; i < 16; ++i) BR[(size_t)(t0 + rq * 16 + i) * NBR + 0 + g * 128 + dcol] = (bf16_t)f2bf(acc[i] * sc);
        __syncthreads();
    }
}
__device__ __forceinline__ void mix_gmlp_naive(const Ctx& C, int l) {
    const bf16_t* H = (const bf16_t*)(C.ws + WS_H); bf16_t* BR = (bf16_t*)(C.ws + WS_BR);
    LAS float* vn = (LAS float*)C.lds;
    for (int u = C.bid; u < (T / 128) * 4; u += C.G) {
        const int g = u & 3, t0 = (u >> 2) * 128;
        for (int i = 0; i < 16; ++i) {
            const int r = C.wave * 16 + i, row = t0 + r;
            const u32x4 raw = *(const u32x4*)(H + (size_t)row * NH + HC_GV + C.lane * 8);
            float e[8];
#pragma unroll
            for (int j = 0; j < 4; ++j) { e[2 * j] = geluf_(bf2f(raw[j] & 0xffffu)); e[2 * j + 1] = geluf_(bf2f(raw[j] >> 16)); }
            float s = 0.f;
#pragma unroll
            for (int j = 0; j < 8; ++j) s += e[j];
            const float mean = wave_sum(s) * (1.f / BW);
            float q = 0.f;
#pragma unroll
            for (int j = 0; j < 8; ++j) { const float d = e[j] - mean; q += d * d; }
            const float rstd = rsqrtf(wave_sum(q) * (1.f / BW) + LN_EPS);
            if ((C.lane >> 4) == g) {
#pragma unroll
                for (int j = 0; j < 8; ++j) { const int col = C.lane * 8 + j;
                    vn[r * 128 + (col - g * 128)] = (e[j] - mean) * rstd * C.in[I_GLNG][l * BW + col] + C.in[I_GLNB][l * BW + col]; }
            }
        }
        __syncthreads();
        const int c = C.tid & 127, tq = C.tid >> 7;
        const float* wsg = C.in[I_GWS] + ((size_t)l * 4 + g) * 128 * 128;
        for (int t = tq; t < 128; t += 4) {
            float acc = 0.f;
            for (int s = 0; s <= t; ++s) acc += wsg[t * 128 + s] * vn[s * 128 + c];
            const float sv = acc + C.in[I_GBS][(l * 4 + g) * 128 + t];
            const float uv = geluf_(bf2f(H[(size_t)(t0 + t) * NH + HC_GU + g * 128 + c]));
            BR[(size_t)(t0 + t) * NBR + 1024 + g * 128 + c] = (bf16_t)f2bf(uv * sv);
        }
        __syncthreads();
    }
}
__device__ __forceinline__ void mix_fox_naive(const Ctx& C, int l) {
    const bf16_t* H = (const bf16_t*)(C.ws + WS_H); bf16_t* BR = (bf16_t*)(C.ws + WS_BR);
    const float* cum = (const float*)(C.ws + WS_CUM);
    const float scale = 0.08838834764831845f;
    for (int u = C.bid; u < T * 4 / 8; u += C.G) {
        const int rid = u * 8 + C.wave;
        const int h = rid & 3, row = rid >> 2, b = row / SEQ, t = row % SEQ;
        const unsigned qraw = *(const unsigned*)(H + (size_t)row * NH + HC_FQ + h * 128 + C.lane * 2);
        const float q0 = bf2f(qraw & 0xffffu) * scale, q1 = bf2f(qraw >> 16) * scale;
        const float* cm = cum + ((size_t)b * 4 + h) * SEQ;
        const float ct = cm[t];
        float m = -1e30f, lsum = 0.f, o0 = 0.f, o1 = 0.f;
        for (int s = t; s >= 0; --s) {
            const size_t kr = (size_t)(b * SEQ + s) * NH + h * 128 + C.lane * 2;
            const unsigned kraw = *(const unsigned*)(H + kr + HC_FK);
            const unsigned vraw = *(const unsigned*)(H + kr + HC_FV);
            float d = q0 * bf2f(kraw & 0xffffu) + q1 * bf2f(kraw >> 16);
            d = wave_sum(d);
            const float z = d + ct - cm[s];
            const float mn = fmaxf(m, z), al = __expf(m - mn), p = __expf(z - mn);
            lsum = lsum * al + p; o0 = o0 * al + p * bf2f(vraw & 0xffffu); o1 = o1 * al + p * bf2f(vraw >> 16); m = mn;
        }
        const float inv = 1.f / lsum;
        *(unsigned*)(BR + (size_t)row * NBR + 1536 + h * 128 + C.lane * 2) = pk2(o0 * inv, o1 * inv);
    }
}
__device__ __forceinline__ void mix_hgrn_naive(const Ctx& C, int l) {
    if (C.bid >= BATCH * 4) return;
    const bf16_t* H = (const bf16_t*)(C.ws + WS_H); bf16_t* BR = (bf16_t*)(C.ws + WS_BR);
    const int b = C.bid >> 2, h = C.bid & 3;
    LAS float* fdec = (LAS float*)C.lds;
    LAS float* kkv = fdec + 32 * 128;
    LAS float* qsv = kkv + 32 * 128;
    LAS float* vv = qsv + 32 * 128;
    LAS float* opart = vv + 32 * 128;
    const int kq = C.tid >> 7, v = C.tid & 127;
    float S[32];
#pragma unroll
    for (int j = 0; j < 32; ++j) S[j] = 0.f;
    for (int c0 = 0; c0 < SEQ; c0 += 32) {
        for (int idx = C.tid; idx < 32 * 128; idx += 512) {
            const int st = idx >> 7, k = idx & 127; const size_t rb = (size_t)(b * SEQ + c0 + st) * NH + h * 128 + k;
            float lb = 0.f;
            if (l == 1) { const float z0 = C.in[I_LBL][h * 128 + k], z1 = C.in[I_LBL][BW + h * 128 + k]; lb = 1.f / (1.f + __expf(z0 - z1)); }
            const float zf = bf2f(H[rb + HC_HF]);
            const float kk = (1.f - lb) * sigmoidf_(-zf);
            fdec[idx] = 1.f - kk; kkv[idx] = kk; qsv[idx] = siluf_(bf2f(H[rb + HC_HQ])); vv[idx] = bf2f(H[rb + HC_HI]);
        }
        __syncthreads();
        for (int st = 0; st < 32; ++st) {
            const float vt = vv[st * 128 + v];
            float part = 0.f;
#pragma unroll
            for (int j = 0; j < 32; ++j) { const int k = kq * 32 + j; S[j] = fdec[st * 128 + k] * S[j] + kkv[st * 128 + k] * vt; part += S[j] * qsv[st * 128 + k]; }
            opart[(kq * 32 + st) * 128 + v] = part;
        }
        __syncthreads();
        for (int i = 0; i < 4; ++i) {
            const int st = C.wave * 4 + i, row = b * SEQ + c0 + st;
            float o0 = 0.f, o1 = 0.f;
#pragma unroll
            for (int q = 0; q < 4; ++q) { o0 += opart[(q * 32 + st) * 128 + C.lane]; o1 += opart[(q * 32 + st) * 128 + 64 + C.lane]; }
            const float ss = wave_sum(o0 * o0 + o1 * o1);
            const float r = rsqrtf(ss * (1.f / 128.f) + RMS_EPS);
            const float g0 = siluf_(bf2f(H[(size_t)row * NH + HC_HG + h * 128 + C.lane])), g1 = siluf_(bf2f(H[(size_t)row * NH + HC_HG + h * 128 + 64 + C.lane]));
            BR[(size_t)row * NBR + 512 + h * 128 + C.lane] = (bf16_t)f2bf(o0 * r * C.in[I_HNG][l * 128 + C.lane] * g0);
            BR[(size_t)row * NBR + 512 + h * 128 + 64 + C.lane] = (bf16_t)f2bf(o1 * r * C.in[I_HNG][l * 128 + 64 + C.lane] * g1);
        }
        __syncthreads();
    }
}

__device__ __forceinline__ void wave_argmax(float& v, int& i) {
#pragma unroll
    for (int o = 32; o > 0; o >>= 1) {
        const float ov = __shfl_xor(v, o, 64); const int oi = __shfl_xor(i, o, 64);
        if (ov > v || (ov == v && oi < i)) { v = ov; i = oi; }
    }
}
__device__ __forceinline__ void p_topk_naive(const Ctx& C, int l) {
    const bf16_t* Q = (const bf16_t*)(C.ws + WS_Q);
    const bf16_t* keys = (const bf16_t*)(C.ws + WS_W + (size_t)l * W_LAYER + WO_KEYS);
    int* eidx = (int*)(C.ws + WS_EIDX); float* egate = (float*)(C.ws + WS_EGATE);
    LAS float* qs = (LAS float*)C.lds;
    LAS float* sc = qs + 2048;
    LAS float* tv = sc + 2048;
    LAS int* ti = (LAS int*)(tv + 256);
    for (int t = C.bid; t < T; t += C.G) {
        for (int i = C.tid; i < 2048; i += 512) qs[i] = bf2f(Q[(size_t)t * NQ + i]);
        __syncthreads();
        for (int i = 0; i < 4; ++i) {
            const int idx = C.tid + 512 * i, hj = idx >> 7, key = idx & 127, h = hj >> 1, j = hj & 1;
            const bf16_t* kp = keys + (((size_t)j * PH + h) * 128 + key) * 128;
            float s = 0.f;
            for (int d8 = 0; d8 < 16; ++d8) {
                const u32x4 raw = *(const u32x4*)(kp + d8 * 8);
#pragma unroll
                for (int e = 0; e < 4; ++e) s += qs[h * 256 + j * 128 + d8 * 8 + 2 * e] * bf2f(raw[e] & 0xffffu) + qs[h * 256 + j * 128 + d8 * 8 + 2 * e + 1] * bf2f(raw[e] >> 16);
            }
            sc[idx] = s;
        }
        __syncthreads();
        for (int i = 0; i < 2; ++i) {
            const int hj = C.wave * 2 + i;
            float a0 = sc[hj * 128 + C.lane], a1 = sc[hj * 128 + 64 + C.lane];
            for (int r = 0; r < 16; ++r) {
                float bv; int bi;
                if (a0 > a1 || (a0 == a1)) { bv = a0; bi = C.lane; } else { bv = a1; bi = C.lane + 64; }
                wave_argmax(bv, bi);
                if (C.lane == 0) { tv[hj * 16 + r] = bv; ti[hj * 16 + r] = bi; }
                if (bi == C.lane) a0 = -3e38f; if (bi == C.lane + 64) a1 = -3e38f;
            }
        }
        __syncthreads();
        {
            const int h = C.wave;
            float cv[4];
#pragma unroll
            for (int i = 0; i < 4; ++i) { const int c = C.lane * 4 + i; cv[i] = tv[(h * 2) * 16 + (c >> 4)] + tv[(h * 2 + 1) * 16 + (c & 15)]; }
            float topv = 0.f; int tope = 0; float mx = 0.f;
            for (int r = 0; r < 16; ++r) {
                float bv = cv[0]; int bi = C.lane * 4;
#pragma unroll
                for (int i = 1; i < 4; ++i) if (cv[i] > bv) { bv = cv[i]; bi = C.lane * 4 + i; }
                wave_argmax(bv, bi);
                if (r == 0) mx = bv;
                if (C.lane == r) { topv = bv; tope = ti[(h * 2) * 16 + (bi >> 4)] * 128 + ti[(h * 2 + 1) * 16 + (bi & 15)]; }
#pragma unroll
                for (int i = 0; i < 4; ++i) if (bi == C.lane * 4 + i) cv[i] = -3e38f;
            }
            float e = (C.lane < 16) ? __expf(topv - mx) : 0.f;
            const float den = wave_sum(e);
            if (C.lane < 16) { eidx[(size_t)t * 128 + h * 16 + C.lane] = tope; egate[(size_t)t * 128 + h * 16 + C.lane] = e / den; }
        }
        __syncthreads();
    }
}
__device__ __forceinline__ void p_gather(const Ctx& C, int l) {
    const float* xc = (const float*)(C.ws + WS_XC);
    const bf16_t* U = (const bf16_t*)(C.ws + WS_TABU); const bf16_t* V = (const bf16_t*)(C.ws + WS_TABV);
    const int* eidx = (const int*)(C.ws + WS_EIDX); const float* egate = (const float*)(C.ws + WS_EGATE);
    for (int t = C.bid * 8 + C.wave; t < T; t += C.G * 8) {
        float x[16]; load_row16(xc + (size_t)t * DM, C.lane, x);
        const int e0 = eidx[(size_t)t * 128 + C.lane], e1 = eidx[(size_t)t * 128 + 64 + C.lane];
        const float g0 = egate[(size_t)t * 128 + C.lane], g1 = egate[(size_t)t * 128 + 64 + C.lane];
        float c0 = 0.f, c1 = 0.f;
        for (int e = 0; e < 128; e += 4) {
            float part[4];
#pragma unroll
            for (int i = 0; i < 4; ++i) {
                const int ee = e + i;
                const int ex = __builtin_amdgcn_readlane(ee < 64 ? e0 : e1, ee & 63);
                const bf16_t* up = U + (size_t)ex * DM;
                const u32x4 r0 = *(const u32x4*)(up + C.lane * 8), r1 = *(const u32x4*)(up + 512 + C.lane * 8);
                float s = 0.f;
#pragma unroll
                for (int j = 0; j < 4; ++j) { s += x[2 * j] * bf2f(r0[j] & 0xffffu) + x[2 * j + 1] * bf2f(r0[j] >> 16); s += x[8 + 2 * j] * bf2f(r1[j] & 0xffffu) + x[8 + 2 * j + 1] * bf2f(r1[j] >> 16); }
                part[i] = s;
            }
#pragma unroll
            for (int i = 0; i < 4; ++i) {
                const float s = wave_sum(part[i]);
                const int ee = e + i;
                if (ee < 64) { if (C.lane == ee) c0 = geluf_(s) * g0; } else { if (C.lane == ee - 64) c1 = geluf_(s) * g1; }
            }
        }
        float y[16];
#pragma unroll
        for (int j = 0; j < 16; ++j) y[j] = 0.f;
        for (int e = 0; e < 128; e += 4) {
#pragma unroll
            for (int i = 0; i < 4; ++i) {
                const int ee = e + i;
                const int ex = __builtin_amdgcn_readlane(ee < 64 ? e0 : e1, ee & 63);
                const float cf = __builtin_bit_cast(float, __builtin_amdgcn_readlane(__builtin_bit_cast(int, ee < 64 ? c0 : c1), ee & 63));
                const bf16_t* vp = V + (size_t)ex * DM;
                const u32x4 r0 = *(const u32x4*)(vp + C.lane * 8), r1 = *(const u32x4*)(vp + 512 + C.lane * 8);
#pragma unroll
                for (int j = 0; j < 4; ++j) { y[2 * j] += cf * bf2f(r0[j] & 0xffffu); y[2 * j + 1] += cf * bf2f(r0[j] >> 16); y[8 + 2 * j] += cf * bf2f(r1[j] & 0xffffu); y[8 + 2 * j + 1] += cf * bf2f(r1[j] >> 16); }
            }
        }
#pragma unroll
        for (int j = 0; j < 16; ++j) y[j] += ALPHA * x[j];
        ln_row16(y, C.in[I_LN2G] + l * DM, C.in[I_LN2B] + l * DM, C.lane);
        if (l + 1 < DEPTH) {
            store_row16((float*)(C.ws + WS_XA) + (size_t)t * DM, C.lane, y);
            row_emit(C, t, y, l + 1, true);
        } else {
            store_row16(C.out + (size_t)t * DM, C.lane, y);
        }
    }
}

struct FStoreBf16 { bf16_t* O; int ld;
    __device__ __forceinline__ void operator()(int row, int col, f32x4 v0, f32x4 v1, int) const {
        u32x4 o; o[0] = pk2(v0[0], v0[1]); o[1] = pk2(v0[2], v0[3]); o[2] = pk2(v1[0], v1[1]); o[3] = pk2(v1[2], v1[3]);
        *(u32x4*)(O + (size_t)row * ld + col) = o; } };
struct FGate { bf16_t* O; const float* bias;
    __device__ __forceinline__ void operator()(int row, int col, f32x4 v0, f32x4 v1, int) const {
        const f32x4 b0 = *(const f32x4*)(bias + col), b1 = *(const f32x4*)(bias + col + 4);
        u32x4 o; o[0] = pk2(sigmoidf_(v0[0] + b0[0]), sigmoidf_(v0[1] + b0[1])); o[1] = pk2(sigmoidf_(v0[2] + b0[2]), sigmoidf_(v0[3] + b0[3]));
        o[2] = pk2(sigmoidf_(v1[0] + b1[0]), sigmoidf_(v1[1] + b1[1])); o[3] = pk2(sigmoidf_(v1[2] + b1[2]), sigmoidf_(v1[3] + b1[3]));
        *(u32x4*)(O + (size_t)row * NG + col) = o; } };
struct FMerge { const bf16_t* G; float* MGF; bf16_t* MG;
    __device__ __forceinline__ void operator()(int row, int col, f32x4 v, int z) const {
        const u32x2 gr = *(const u32x2*)(G + (size_t)row * NG + z * DM + col);
        f32x4 r; r[0] = v[0] * bf2f(gr[0] & 0xffffu); r[1] = v[1] * bf2f(gr[0] >> 16); r[2] = v[2] * bf2f(gr[1] & 0xffffu); r[3] = v[3] * bf2f(gr[1] >> 16);
        float* p = MGF + (size_t)row * DM + col;
        if (z > 0) r += *(const f32x4*)p;
        if (z < 3) *(f32x4*)p = r;
        else { u32x2 o; o[0] = pk2(r[0], r[1]); o[1] = pk2(r[2], r[3]); *(u32x2*)(MG + (size_t)row * DM + col) = o; } } };
struct FResid { const float* X; float* Y;
    __device__ __forceinline__ void operator()(int row, int col, f32x4 v, int) const {
        const f32x4 x = *(const f32x4*)(X + (size_t)row * DM + col);
        *(f32x4*)(Y + (size_t)row * DM + col) = x * ALPHA + v; } };

constexpr int PH_PER_LAYER = 10, N_PHASES = 1 + DEPTH * PH_PER_LAYER;
template <int SP> __device__ __forceinline__ void run_phase(const Ctx& C, int l) {
    unsigned char* wb = C.ws + WS_W + (size_t)l * W_LAYER;
    if constexpr (SP == -1) { p_conv_weights(C); }
    if constexpr (SP == 0) {
        p_conv_tables(C, l);
        if (l == 0) p_rowpass0(C);
    }
    if constexpr (SP == 1) {
        p_cumsum(C);
        __syncthreads();
        pg8::Gemm g{(const bf16_t*)(C.ws + WS_XB), (const bf16_t*)(wb + WO_WIN), DM, DM, DM, 0, 0};
        pg8::StaticOrder S; S.init(T, NH, C.G, C.bid);
        pg8::Epi8<FStoreBf16> E{{(bf16_t*)(C.ws + WS_H), NH}};
        pg8::gemm_phase(C.lds, g, S, E);
    }
    if constexpr (SP == 2) {
        mix_hgrn_naive(C, l);
        __syncthreads();
        mix_pool_naive(C, l);
        mix_gmlp_naive(C, l);
        mix_fox_naive(C, l);
    }
    if constexpr (SP == 3) {
        pg8::Gemm g{(const bf16_t*)(C.ws + WS_XB), (const bf16_t*)(wb + WO_WG), DM, DM, DM, 0, 0};
        pg8::StaticOrder S; S.init(T, NG, C.G, C.bid);
        pg8::Epi8<FGate> E{{(bf16_t*)(C.ws + WS_G), C.in[I_BGATE] + l * NG}};
        pg8::gemm_phase(C.lds, g, S, E);
    }
    if constexpr (SP == 4) {
        pg8::Gemm g{(const bf16_t*)(C.ws + WS_BR), (const bf16_t*)(wb + WO_WBR), NBR, BW, BW, (size_t)BW, (size_t)DM * BW};
        pg8::ZOrder S; S.init(T, DM, 4, C.G, C.vcu);
        pg8::Epi4<FMerge> E{{(const bf16_t*)(C.ws + WS_G), (float*)(C.ws + WS_MGF), (bf16_t*)(C.ws + WS_XB)}};
        pg8::gemm_phase(C.lds, g, S, E);
    }
    if constexpr (SP == 5) {
        const float* xin = (l == 0) ? C.in[I_X] : (const float*)(C.ws + WS_XA);
        pg8::Gemm g{(const bf16_t*)(C.ws + WS_XB), (const bf16_t*)(wb + WO_WOUT), DM, DM, DM, 0, 0};
        pg8::StaticOrder S; S.init(T, DM, C.G, C.bid);
        pg8::Epi4<FResid> E{{xin, (float*)(C.ws + WS_XC)}};
        pg8::gemm_phase(C.lds, g, S, E);
    }
    if constexpr (SP == 6) p_ln1(C, l);
    if constexpr (SP == 7) {
        pg8::Gemm g{(const bf16_t*)(C.ws + WS_X1B), (const bf16_t*)(wb + WO_WQ), DM, DM, DM, 0, 0};
        pg8::StaticOrder S; S.init(T, NQ, C.G, C.bid);
        pg8::Epi8<FStoreBf16> E{{(bf16_t*)(C.ws + WS_Q), NQ}};
        pg8::gemm_phase(C.lds, g, S, E);
    }
    if constexpr (SP == 8) p_topk_naive(C, l);
    if constexpr (SP == 9) p_gather(C, l);
}
__device__ __forceinline__ void make_ctx(Ctx& C, const Args& args, unsigned char* lds_raw) {
    C.lds = (LAS unsigned char*)lds_raw; C.ws = args.ws; C.in = args.in; C.out = args.out;
    C.tid = threadIdx.x; C.lane = C.tid & 63; C.wave = __builtin_amdgcn_readfirstlane(C.tid >> 6);
    C.G = gridDim.x; C.bid = blockIdx.x; C.vcu = (C.G % 8 == 0) ? (C.bid % 8) * (C.G / 8) + C.bid / 8 : C.bid;
}
template <int SP> __global__ void __launch_bounds__(512, 2) mk_phase(Args args) {
    extern __shared__ __attribute__((aligned(16))) unsigned char lds_raw[];
    Ctx C; make_ctx(C, args, lds_raw);
    run_phase<SP>(C, args.ph_lo);
}

template <int SP> static void launch_phase(const Args& a, int grid, hipStream_t stream) {
    static bool attr_done = false;
    if (!attr_done) { (void)hipFuncSetAttribute((const void*)mk_phase<SP>, hipFuncAttributeMaxDynamicSharedMemorySize, LDS_BYTES); attr_done = true; }
    hipLaunchKernelGGL(mk_phase<SP>, dim3(grid), dim3(512), LDS_BYTES, stream, a);
}
extern "C" void kernel_launch(void* const* d_in, const int* in_sizes, int n_in, void* d_out, int out_size, void* d_ws, size_t ws_size, hipStream_t stream) {
    static int grid = 0;
    if (grid == 0) {
        if (n_in != NIN_PTRS || out_size != T * DM || ws_size < WS_END) { fprintf(stderr, "kernel_launch: unexpected shapes n_in %d out %d ws %zu\n", n_in, out_size, ws_size); grid = -1; return; }
        int dev = 0, cus = 0;
        if (hipGetDevice(&dev) != hipSuccess || hipDeviceGetAttribute(&cus, hipDeviceAttributeMultiprocessorCount, dev) != hipSuccess) { grid = -1; return; }
        grid = cus;
    }
    if (grid < 0) return;
    (void)hipMemsetAsync((char*)d_ws + WS_CTL, 0, CTL_ZERO_BYTES, stream);
    Args a{};
    for (int i = 0; i < NIN_PTRS; ++i) a.in[i] = (const float*)d_in[i];
    a.out = (float*)d_out; a.ws = (unsigned char*)d_ws; a.bar_slot = 0; a.pad = 0; a.ph_hi = 0;
    a.ph_lo = 0; launch_phase<-1>(a, grid, stream);
    for (int l = 0; l < DEPTH; ++l) {
        a.ph_lo = l;
        launch_phase<0>(a, grid, stream); launch_phase<1>(a, grid, stream); launch_phase<2>(a, grid, stream); launch_phase<3>(a, grid, stream); launch_phase<4>(a, grid, stream);
        launch_phase<5>(a, grid, stream); launch_phase<6>(a, grid, stream); launch_phase<7>(a, grid, stream); launch_phase<8>(a, grid, stream); launch_phase<9>(a, grid, stream);
    }
}
```

```cpp
#include <hip/hip_runtime.h>
#include <cstdio>
#include <cstdint>

#ifndef MK_ONE_LAUNCH
#define MK_ONE_LAUNCH 1
#endif

#define LAS __attribute__((address_space(3)))
#define GAS __attribute__((address_space(1)))
typedef unsigned short bf16_t;
typedef short bf16x8 __attribute__((ext_vector_type(8)));
typedef float f32x4 __attribute__((ext_vector_type(4)));
typedef float f32x2 __attribute__((ext_vector_type(2)));
typedef unsigned u32x4 __attribute__((ext_vector_type(4)));
typedef unsigned u32x2 __attribute__((ext_vector_type(2)));

constexpr int DM = 1024, BATCH = 2, SEQ = 8192, DEPTH = 2, T = BATCH * SEQ;
constexpr int BW = 512, NIN = 5124, NH = 5120, NG = 4096, NBR = 2048, NQ = 2048;
constexpr int NEXP = 16384, TOPK = 16, PH = 8;
constexpr float ALPHA = 1.4142135623730951f;
constexpr float LN_EPS = 1e-5f, RMS_EPS = 1e-6f;
constexpr int HC_P = 0, HC_HQ = 512, HC_HF = 1024, HC_HI = 1536, HC_HG = 2048, HC_GU = 2560, HC_GV = 3072, HC_FQ = 3584, HC_FK = 4096, HC_FV = 4608;

constexpr size_t MiB = 1u << 20;
constexpr size_t WS_CTL = 0, CTL_ZERO_BYTES = 64 * 1024;
constexpr size_t WS_MISC = 512 * 1024;
constexpr size_t WS_CUM = 768 * 1024;
constexpr size_t WS_W = 1 * MiB;
constexpr size_t W_LAYER = 30 * MiB;
constexpr size_t WO_WIN = 0, WO_WG = 10 * MiB, WO_WBR = 18 * MiB, WO_WOUT = 22 * MiB, WO_WQ = 24 * MiB, WO_KEYS = 28 * MiB, WO_WF = 28 * MiB + 512 * 1024;
constexpr size_t WS_TABU = 64 * MiB, WS_TABV = 96 * MiB;
constexpr size_t WS_XA = 128 * MiB;
constexpr size_t WS_XB = 192 * MiB;
constexpr size_t WS_X1B = 224 * MiB;
constexpr size_t WS_H = 256 * MiB;
constexpr size_t WS_ST = 416 * MiB;
constexpr size_t WS_BR = 448 * MiB;
constexpr size_t WS_G = 256 * MiB;
constexpr size_t WS_MGF = 384 * MiB;
constexpr size_t WS_XC = 256 * MiB;
constexpr size_t WS_Q = 320 * MiB;
constexpr size_t WS_EIDX = 384 * MiB, WS_EGATE = 392 * MiB;
constexpr size_t WS_END = 512 * MiB;

__device__ __forceinline__ float bf2f(unsigned u) { return __builtin_bit_cast(float, u << 16); }
__device__ __forceinline__ unsigned f2bf(float f) { unsigned u = __builtin_bit_cast(unsigned, f); return (u + 0x7fffu + ((u >> 16) & 1u)) >> 16; }
__device__ __forceinline__ unsigned pk2(float lo, float hi) { return f2bf(lo) | (f2bf(hi) << 16); }
__device__ __forceinline__ float wave_sum(float v) {
#pragma unroll
    for (int o = 32; o > 0; o >>= 1) v += __shfl_xor(v, o, 64);
    return v;
}
__device__ __forceinline__ float sigmoidf_(float x) { return 1.f / (1.f + __expf(-x)); }
__device__ __forceinline__ float siluf_(float x) { return x / (1.f + __expf(-x)); }
__device__ __forceinline__ float geluf_(float x) { const float u = 0.7978845608028654f * (x + 0.044715f * x * x * x); return 0.5f * x * (1.f + tanhf(u)); }
__device__ __forceinline__ float logsigmoidf_(float z) { return fminf(z, 0.f) - log1pf(__expf(-fabsf(z))); }

__device__ __forceinline__ unsigned launder_u(unsigned x) { asm volatile("" : "+v"(x)); return __builtin_amdgcn_readfirstlane(x); }
template <class P> __device__ __forceinline__ P launder_ptr(P p) {
    const unsigned lo = launder_u((unsigned)(uintptr_t)p), hi = launder_u((unsigned)((uintptr_t)p >> 32));
    return (P)(((uintptr_t)hi << 32) | lo);
}

namespace pg8 {
constexpr int BM = 256, BK = 64, HALF = 128, HTB = HALF * BK * 2, STAGE_BYTES = 8 * HTB, NXCD = 8, WGM = 8;
__host__ __device__ __forceinline__ int lds_byte(int r, int c) { const int st = (r >> 4) * 2 + (c >> 5), rr = r & 15, cc = c & 31, ob = rr * 64 + cc * 2; return st * 1024 + (ob ^ (((ob >> 9) & 1) << 5)); }
__host__ __device__ __forceinline__ void stage_rc(int b, int& R, int& C) { const int st = b / 1024, sb = b % 1024, swz = sb ^ (((sb >> 9) & 1) << 5); R = (st >> 1) * 16 + swz / 64; C = (st & 1) * 32 + (swz % 64) / 2; }
__host__ __device__ __forceinline__ int perm32(int rho) { const int n = rho >> 4, i = rho & 15; return 8 * (i >> 2) + 4 * n + (i & 3); }

struct Unit { int pm, pn, z; };
struct Gemm { const bf16_t* A; const bf16_t* Bt; int lda, ldb, K; size_t zA, zB; };

struct StaticOrder {
    int nM, nN, nwg, G, c;
    __device__ void init(int M, int N, int G_, int c_) { nM = M / BM; nN = N / BM; nwg = nM * nN; G = G_; c = c_; }
    __device__ bool next(int i, Unit& u) const {
        const long L = (long)i * G + c; if (L >= nwg) return false;
        int wgid = (int)L; { const int q = nwg / NXCD, r = nwg % NXCD, xcd = wgid % NXCD, off = wgid / NXCD; wgid = (xcd < r ? xcd * (q + 1) : r * (q + 1) + (xcd - r) * q) + off; }
        const int nig = WGM * nN, gid = wgid / nig, fm = gid * WGM, gsz = (nM - fm) < WGM ? (nM - fm) : WGM;
        u.pm = fm + ((wgid % nig) % gsz); u.pn = (wgid % nig) / gsz; u.z = 0; return true;
    }
};
struct ZOrder {
    int nM, nN, nZ, ntile, G, c;
    __device__ void init(int M, int N, int Z, int G_, int c_) { nM = M / BM; nN = N / BM; nZ = Z; ntile = nM * nN; G = G_; c = c_; }
    __device__ bool next(int i, Unit& u) const {
        const long L = (long)(i / nZ) * G + c; if (L >= ntile) return false;
        u.pm = (int)L / nN; u.pn = (int)L % nN; u.z = i % nZ; return true;
    }
};

template <class F> struct Epi8 {
    static constexpr bool PERM = true;
    F f;
    __device__ __forceinline__ void operator()(const f32x4 (&acc)[2][2][4][2], const Unit& u, int wr, int wc, int fr, int fq) const {
        const int row0 = u.pm * BM + wr * 64 + fr, col0 = u.pn * BM + wc * 32 + 8 * fq;
#pragma unroll
        for (int ai = 0; ai < 2; ++ai)
#pragma unroll
            for (int m = 0; m < 4; ++m)
#pragma unroll
                for (int bj = 0; bj < 2; ++bj) f(row0 + ai * HALF + m * 16, col0 + bj * HALF, acc[ai][bj][m][0], acc[ai][bj][m][1], u.z);
    }
};
template <class F> struct Epi4 {
    static constexpr bool PERM = false;
    F f;
    __device__ __forceinline__ void operator()(const f32x4 (&acc)[2][2][4][2], const Unit& u, int wr, int wc, int fr, int fq) const {
        const int row0 = u.pm * BM + wr * 64 + fr, col0 = u.pn * BM + wc * 32 + 4 * fq;
#pragma unroll
        for (int ai = 0; ai < 2; ++ai)
#pragma unroll
            for (int m = 0; m < 4; ++m)
#pragma unroll
                for (int bj = 0; bj < 2; ++bj)
#pragma unroll
                    for (int n = 0; n < 2; ++n) f(row0 + ai * HALF + m * 16, col0 + bj * HALF + n * 16, acc[ai][bj][m][n], u.z);
    }
};

template <class Epi, class Sched, bool ALIGN_EPI = true>
__device__ __forceinline__ void gemm_phase(LAS unsigned char* lds, const Gemm g, const Sched& S, const Epi& E, const int tid) {
    const int wid = __builtin_amdgcn_readfirstlane(tid >> 6), lane = tid & 63, wr = wid >> 2, wc = wid & 3, fr = lane & 15, fq = lane >> 4;
    const int K = g.K, nt = K / BK;
    unsigned voffA[2], voffB[2];
#pragma unroll
    for (int i = 0; i < 2; ++i) { int R, C; stage_rc(tid * 16 + i * 8192, R, C); const int Rb = Epi::PERM ? ((R & ~31) + perm32(R & 31)) : R;
        voffA[i] = (unsigned)(R * g.lda + C) * 2u; voffB[i] = (unsigned)(Rb * g.ldb + C) * 2u; }
    const size_t kstep = (size_t)(BK * 2);
    const size_t hstepA = (size_t)HALF * g.lda * 2, hstepB = (size_t)HALF * g.ldb * 2;
    const size_t tstepA = 2 * hstepA, tstepB = 2 * hstepB;
    const unsigned ldsw = (unsigned)wid * 1024u;
    const int aoff = lds_byte(wr * 64 + fr, fq * 8), boff = lds_byte(wc * 32 + fr, fq * 8);
#define PG8_SA(b, h) (((b) * 2 + (h)) * HTB)
#define PG8_SB(b, h) ((4 + (b) * 2 + (h)) * HTB)
#define PG8_STAGE(bufoff, gbase, voff) do { _Pragma("unroll") for (int _i = 0; _i < 2; ++_i) \
        __builtin_amdgcn_global_load_lds((const unsigned*)((const char*)(gbase) + (voff)[_i]), (LAS unsigned*)(lds + (bufoff) + ldsw + _i * 8192), 16, 0, 0); } while (0)
#define PG8_LDA(dst, b, h) do { _Pragma("unroll") for (int m = 0; m < 4; ++m) _Pragma("unroll") for (int k = 0; k < 2; ++k) dst[m][k] = *(const LAS bf16x8*)(lds + PG8_SA(b, h) + aoff + m * 2048 + k * 1024); } while (0)
#define PG8_LDB(dst, b, h) do { _Pragma("unroll") for (int n = 0; n < 2; ++n) _Pragma("unroll") for (int k = 0; k < 2; ++k) dst[n][k] = *(const LAS bf16x8*)(lds + PG8_SB(b, h) + boff + n * 2048 + k * 1024); } while (0)
#define PG8_MMA(ai, bj, At, Bt) do { __builtin_amdgcn_s_setprio(1); _Pragma("unroll") for (int m = 0; m < 4; ++m) _Pragma("unroll") for (int n = 0; n < 2; ++n) _Pragma("unroll") for (int k = 0; k < 2; ++k) \
        acc[ai][bj][m][n] = __builtin_amdgcn_mfma_f32_16x16x32_bf16(Bt[n][k], At[m][k], acc[ai][bj][m][n], 0, 0, 0); __builtin_amdgcn_s_setprio(0); } while (0)
#define PG8_WAIT_V(n) asm volatile("s_waitcnt vmcnt(" #n ")" ::: "memory")
#define PG8_WAIT_L(n) asm volatile("s_waitcnt lgkmcnt(" #n ")" ::: "memory")
#define PG8_BAR __builtin_amdgcn_s_barrier()
#define PG8_SCHED __builtin_amdgcn_sched_barrier(0)
    Unit cur, nxt; int ui = 0;
    if (!S.next(0, cur)) return;
    f32x4 acc[2][2][4][2];
#pragma unroll
    for (int a = 0; a < 2; ++a)
#pragma unroll
        for (int b = 0; b < 2; ++b)
#pragma unroll
            for (int m = 0; m < 4; ++m)
#pragma unroll
                for (int n = 0; n < 2; ++n) acc[a][b][m][n] = (f32x4){0.f, 0.f, 0.f, 0.f};
    bf16x8 At[4][2], B0[2][2], B1[2][2];
    const char* cA = (const char*)(g.A + (size_t)cur.z * g.zA) + (size_t)cur.pm * tstepA; const char* cB = (const char*)(g.Bt + (size_t)cur.z * g.zB) + (size_t)cur.pn * tstepB;
    PG8_STAGE(PG8_SB(0, 0), cB, voffB); PG8_STAGE(PG8_SB(0, 1), cB + hstepB, voffB); PG8_STAGE(PG8_SA(0, 0), cA, voffA); PG8_STAGE(PG8_SA(0, 1), cA + hstepA, voffA);
    if (wr == 1) PG8_BAR;
    PG8_WAIT_V(2); PG8_BAR;
    PG8_STAGE(PG8_SB(1, 0), cB + kstep, voffB); PG8_STAGE(PG8_SA(1, 0), cA + kstep, voffA); PG8_STAGE(PG8_SB(1, 1), cB + hstepB + kstep, voffB);
    PG8_WAIT_V(6); PG8_BAR;
    for (;;) {
        const bool has_next = S.next(ui + 1, nxt);
        const char* nA = has_next ? (const char*)(g.A + (size_t)nxt.z * g.zA) + (size_t)nxt.pm * tstepA : cA;
        const char* nB = has_next ? (const char*)(g.Bt + (size_t)nxt.z * g.zB) + (size_t)nxt.pn * tstepB : cB;
        for (int t = 0; t < nt; t += 2) {
            const bool last = (t == nt - 2);
            const char* a1 = cA + (size_t)(t + 1) * kstep;
            const char* a2 = last ? nA : cA + (size_t)(t + 2) * kstep; const char* b2 = last ? nB : cB + (size_t)(t + 2) * kstep;
            const char* a3 = a2 + kstep; const char* b3 = b2 + kstep;
            PG8_LDB(B0, 0, 0); PG8_LDB(B1, 0, 1); PG8_SCHED; PG8_LDA(At, 0, 0); PG8_STAGE(PG8_SA(1, 1), a1 + hstepA, voffA);
            PG8_WAIT_V(8); PG8_WAIT_L(0); PG8_BAR; PG8_MMA(0, 0, At, B0); PG8_MMA(0, 1, At, B1); PG8_BAR; PG8_SCHED;
            PG8_LDA(At, 0, 1); PG8_STAGE(PG8_SB(0, 0), b2, voffB); PG8_STAGE(PG8_SB(0, 1), b2 + hstepB, voffB); PG8_STAGE(PG8_SA(0, 0), a2, voffA);
            PG8_WAIT_V(8); PG8_WAIT_L(0); PG8_BAR; PG8_MMA(1, 0, At, B0); PG8_MMA(1, 1, At, B1); PG8_BAR; PG8_SCHED;
            PG8_LDB(B0, 1, 0); PG8_LDB(B1, 1, 1); PG8_SCHED; PG8_LDA(At, 1, 0); PG8_STAGE(PG8_SA(0, 1), a2 + hstepA, voffA);
            PG8_WAIT_V(8); PG8_WAIT_L(0); PG8_BAR; PG8_MMA(0, 0, At, B0); PG8_MMA(0, 1, At, B1); PG8_BAR; PG8_SCHED;
            PG8_LDA(At, 1, 1); PG8_STAGE(PG8_SB(1, 0), b3, voffB); PG8_STAGE(PG8_SB(1, 1), b3 + hstepB, voffB); PG8_STAGE(PG8_SA(1, 0), a3, voffA);
            PG8_WAIT_V(8); PG8_WAIT_L(0); PG8_BAR; PG8_MMA(1, 0, At, B0); PG8_MMA(1, 1, At, B1); PG8_BAR; PG8_SCHED;
        }
        if constexpr (ALIGN_EPI) { if (wr == 0) PG8_BAR; }
        E(acc, cur, wr, wc, fr, fq);
        if (!has_next) break;
#pragma unroll
        for (int a = 0; a < 2; ++a)
#pragma unroll
            for (int b = 0; b < 2; ++b)
#pragma unroll
                for (int m = 0; m < 4; ++m)
#pragma unroll
                    for (int n = 0; n < 2; ++n) acc[a][b][m][n] = (f32x4){0.f, 0.f, 0.f, 0.f};
        cur = nxt; cA = nA; cB = nB; ++ui;
        if constexpr (ALIGN_EPI) { if (wr == 1) PG8_BAR; }
    }
    PG8_WAIT_V(0);
    if constexpr (!ALIGN_EPI) { if (wr == 0) PG8_BAR; }
    PG8_BAR;
#undef PG8_SA
#undef PG8_SB
#undef PG8_STAGE
#undef PG8_LDA
#undef PG8_LDB
#undef PG8_MMA
#undef PG8_WAIT_V
#undef PG8_WAIT_L
#undef PG8_BAR
#undef PG8_SCHED
}
}

#define XB_TMO      128
#define XB_XCNT(j)  (256  + 64 * (j))
#define XB_XSUB(j)  (1280 + 64 * (j))
#define XB_XGEN(j)  (2304 + 64 * (j))
#define XB_TOP      3328
#define XB_TOPGEN   3392
#define XCD_BAR_WORDS 3456
#define XB_SPIN_CAP (1u << 22)
__device__ __forceinline__ unsigned xb_ld(unsigned* p)              { return __hip_atomic_load(p, __ATOMIC_RELAXED, __HIP_MEMORY_SCOPE_AGENT); }
__device__ __forceinline__ unsigned xb_add(unsigned* p, unsigned v) { return __hip_atomic_fetch_add(p, v, __ATOMIC_RELAXED, __HIP_MEMORY_SCOPE_AGENT); }
__device__ __forceinline__ unsigned xb_xcc_id() { return (unsigned)__builtin_amdgcn_s_getreg((3 << 11) | 20) & 0xFu; }
#define XB_SPIN(cond, bar) do { unsigned _sp = 0; while (cond) { __builtin_amdgcn_s_sleep(1); \
    if ((++_sp & 255u) == 0u) { if (xb_ld(&(bar)[XB_TMO])) break; if (_sp > XB_SPIN_CAP) { atomicAdd(&(bar)[XB_TMO], 1u); break; } } } } while (0)
__device__ __forceinline__ void xcd_barrier_post(unsigned* bar) {
    if (threadIdx.x == 0) (void)xb_add(&bar[XB_XCNT(xb_xcc_id())], 1u);
}
__device__ __forceinline__ void xcd_barrier_complete(unsigned* bar, unsigned x, unsigned& nloc, unsigned& nx) {
    const unsigned G = gridDim.x * gridDim.y * gridDim.z;
    unsigned sum, cnt, mine, sp = 0u;
    for (;;) {
        sum = 0u; cnt = 0u; mine = 0u;
#pragma unroll
        for (unsigned j = 0; j < 16; ++j) { const unsigned c = xb_ld(&bar[XB_XCNT(j)]); sum += c; cnt += (c > 0u) ? 1u : 0u; mine = (j == x) ? c : mine; }
        if (sum == G) break;
        __builtin_amdgcn_s_sleep(1);
        if ((++sp & 255u) == 0u) { if (xb_ld(&bar[XB_TMO])) break; if (sp > XB_SPIN_CAP) { atomicAdd(&bar[XB_TMO], 1u); break; } }
    }
    nloc = mine > 0u ? mine : 1u; nx = cnt > 0u ? cnt : 1u;
}
__device__ __noinline__ void xcd_barrier_leader(unsigned* bar, volatile LAS unsigned* st) {
    const unsigned x = xb_xcc_id();
    __builtin_amdgcn_s_waitcnt(0);
    unsigned nloc = st[0], nx = st[1];
    if (nloc == 0u) { xcd_barrier_complete(bar, x, nloc, nx); st[0] = nloc; st[1] = nx; }
    const unsigned old = xb_add(&bar[XB_XSUB(x)], 1u);
    const unsigned gen = old / nloc;
    if (old + 1u == (gen + 1u) * nloc) {
        __builtin_amdgcn_fence(__ATOMIC_RELEASE, "agent");
        asm volatile("s_waitcnt vmcnt(0)" ::: "memory");
        const unsigned og = xb_add(&bar[XB_TOP], 1u);
        const unsigned tg = og / nx;
        if (og + 1u == (tg + 1u) * nx) xb_add(&bar[XB_TOPGEN], 1u);
        else XB_SPIN(xb_ld(&bar[XB_TOPGEN]) == tg, bar);
        __builtin_amdgcn_fence(__ATOMIC_ACQUIRE, "agent");
        xb_add(&bar[XB_XGEN(x)], 1u);
        asm volatile("s_waitcnt vmcnt(0)" ::: "memory");
    } else {
        XB_SPIN(xb_ld(&bar[XB_XGEN(x)]) == gen, bar);
        __builtin_amdgcn_fence(__ATOMIC_ACQUIRE, "agent");
        asm volatile("s_waitcnt vmcnt(0)" ::: "memory");
    }
}
__device__ __forceinline__ void xcd_barrier(unsigned* bar, volatile LAS unsigned* st) {
    asm volatile("s_waitcnt vmcnt(0)" ::: "memory");
    __syncthreads();
    if (threadIdx.x == 0) xcd_barrier_leader(bar, st);
    __syncthreads();
}

constexpr int NIN_PTRS = 23;
struct Args { const float* in[NIN_PTRS]; float* out; unsigned char* ws; int ph_lo, ph_hi, bar_slot, pad; };
enum { I_X = 0, I_WIN, I_BFOX, I_POOLW, I_POOLS, I_LBL, I_HNG, I_GLNG, I_GLNB, I_GWS, I_GBS, I_WGATE, I_BGATE, I_WBR, I_WOUT, I_LN1G, I_LN1B, I_WQ, I_KEYS, I_PU, I_PV, I_LN2G, I_LN2B };

constexpr int LDS_BYTES = 147456;
constexpr int LDSCTL_OFF = 131072;

struct Ctx {
    LAS unsigned char* lds;
    unsigned char* ws;
    const float* const* in;
    float* out;
    int tid, lane, wave, G, bid, vcu;
};

__device__ __forceinline__ void tconv_job(const Ctx& C, const float* src, int ld_src, int K, int N, bf16_t* dst) {
    LAS float* tile = (LAS float*)C.lds;
    const int nk = K / 64, nn = N / 64, ntiles = nk * nn;
    for (int tl = C.bid; tl < ntiles; tl += C.G) {
        const int k0 = (tl / nn) * 64, n0 = (tl % nn) * 64;
#pragma unroll
        for (int p = 0; p < 2; ++p) {
            const int kr = (C.tid >> 4) + p * 32, nc = (C.tid & 15) * 4;
            const f32x4 v = *(const f32x4*)(src + (size_t)(k0 + kr) * ld_src + n0 + nc);
            tile[kr * 65 + nc + 0] = v[0]; tile[kr * 65 + nc + 1] = v[1]; tile[kr * 65 + nc + 2] = v[2]; tile[kr * 65 + nc + 3] = v[3];
        }
        __syncthreads();
        {
            const int n = C.tid >> 3, k8 = (C.tid & 7) * 8;
            u32x4 o;
#pragma unroll
            for (int j = 0; j < 4; ++j) o[j] = pk2(tile[(k8 + 2 * j) * 65 + n], tile[(k8 + 2 * j + 1) * 65 + n]);
            *(u32x4*)(dst + (size_t)(n0 + n) * K + k0 + k8) = o;
        }
        __syncthreads();
    }
}
__device__ __forceinline__ void cvt_copy(const Ctx& C, const float* src, bf16_t* dst, size_t n) {
    const size_t n8 = n / 8;
    for (size_t i = (size_t)C.bid * 512 + C.tid; i < n8; i += (size_t)C.G * 512) {
        const f32x4 a = *(const f32x4*)(src + i * 8), b = *(const f32x4*)(src + i * 8 + 4);
        u32x4 o; o[0] = pk2(a[0], a[1]); o[1] = pk2(a[2], a[3]); o[2] = pk2(b[0], b[1]); o[3] = pk2(b[2], b[3]);
        *(u32x4*)(dst + i * 8) = o;
    }
}
__device__ __forceinline__ void p_conv_weights(const Ctx& C) {
    for (int l = 0; l < DEPTH; ++l) {
        unsigned char* wb = C.ws + WS_W + (size_t)l * W_LAYER;
        tconv_job(C, C.in[I_WIN] + (size_t)l * DM * NIN, NIN, DM, NH, (bf16_t*)(wb + WO_WIN));
        tconv_job(C, C.in[I_WGATE] + (size_t)l * DM * NG, NG, DM, NG, (bf16_t*)(wb + WO_WG));
        for (int m = 0; m < 4; ++m)
            tconv_job(C, C.in[I_WBR] + ((size_t)l * 4 + m) * BW * DM, DM, BW, DM, (bf16_t*)(wb + WO_WBR) + (size_t)m * DM * BW);
        tconv_job(C, C.in[I_WOUT] + (size_t)l * DM * DM, DM, DM, DM, (bf16_t*)(wb + WO_WOUT));
        tconv_job(C, C.in[I_WQ] + (size_t)l * DM * NQ, NQ, DM, NQ, (bf16_t*)(wb + WO_WQ));
        cvt_copy(C, C.in[I_KEYS] + (size_t)l * 2 * PH * 128 * 128, (bf16_t*)(wb + WO_KEYS), (size_t)2 * PH * 128 * 128);
        float* wf = (float*)(wb + WO_WF);
        for (int i = C.bid * 512 + C.tid; i < 4 * DM; i += C.G * 512) { const int h = i / DM, k = i % DM; wf[i] = C.in[I_WIN][(size_t)l * DM * NIN + (size_t)k * NIN + NH + h]; }
    }
}
__device__ __forceinline__ void p_conv_tables(const Ctx& C, int l) {
    cvt_copy(C, C.in[I_PU] + (size_t)l * NEXP * DM, (bf16_t*)(C.ws + WS_TABU), (size_t)NEXP * DM);
    cvt_copy(C, C.in[I_PV] + (size_t)l * NEXP * DM, (bf16_t*)(C.ws + WS_TABV), (size_t)NEXP * DM);
}

__device__ __forceinline__ void row_emit(const Ctx& C, int row, const float (&v)[16], int l, bool want_lsig) {
    bf16_t* xb = (bf16_t*)(C.ws + WS_XB) + (size_t)row * DM;
    u32x4 o0, o1;
#pragma unroll
    for (int j = 0; j < 4; ++j) { o0[j] = pk2(v[2 * j], v[2 * j + 1]); o1[j] = pk2(v[8 + 2 * j], v[8 + 2 * j + 1]); }
    *(u32x4*)(xb + C.lane * 8) = o0; *(u32x4*)(xb + 512 + C.lane * 8) = o1;
    if (want_lsig) {
        const float* wf = (const float*)(C.ws + WS_W + (size_t)l * W_LAYER + WO_WF);
        float* lsig = (float*)(C.ws + WS_MISC);
#pragma unroll
        for (int h = 0; h < 4; ++h) {
            const f32x4 a0 = *(const f32x4*)(wf + h * DM + C.lane * 8), a1 = *(const f32x4*)(wf + h * DM + C.lane * 8 + 4);
            const f32x4 b0 = *(const f32x4*)(wf + h * DM + 512 + C.lane * 8), b1 = *(const f32x4*)(wf + h * DM + 512 + C.lane * 8 + 4);
            float s = 0.f;
#pragma unroll
            for (int j = 0; j < 4; ++j) s += v[j] * a0[j] + v[4 + j] * a1[j] + v[8 + j] * b0[j] + v[12 + j] * b1[j];
            s = wave_sum(s);
            if (C.lane == 0) lsig[(size_t)row * 4 + h] = logsigmoidf_(s + C.in[I_BFOX][l * 4 + h]);
        }
    }
}
__device__ __forceinline__ void load_row16(const float* p, int lane, float (&v)[16]) {
    const f32x4 a0 = *(const f32x4*)(p + lane * 8), a1 = *(const f32x4*)(p + lane * 8 + 4), b0 = *(const f32x4*)(p + 512 + lane * 8), b1 = *(const f32x4*)(p + 512 + lane * 8 + 4);
#pragma unroll
    for (int j = 0; j < 4; ++j) { v[j] = a0[j]; v[4 + j] = a1[j]; v[8 + j] = b0[j]; v[12 + j] = b1[j]; }
}
__device__ __forceinline__ void store_row16(float* p, int lane, const float (&v)[16]) {
    *(f32x4*)(p + lane * 8) = (f32x4){v[0], v[1], v[2], v[3]}; *(f32x4*)(p + lane * 8 + 4) = (f32x4){v[4], v[5], v[6], v[7]};
    *(f32x4*)(p + 512 + lane * 8) = (f32x4){v[8], v[9], v[10], v[11]}; *(f32x4*)(p + 512 + lane * 8 + 4) = (f32x4){v[12], v[13], v[14], v[15]};
}
__device__ __forceinline__ void ln_row16(float (&v)[16], const float* g, const float* b, int lane) {
    float s = 0.f;
#pragma unroll
    for (int j = 0; j < 16; ++j) s += v[j];
    const float mean = wave_sum(s) * (1.f / DM);
    float q = 0.f;
#pragma unroll
    for (int j = 0; j < 16; ++j) { const float d = v[j] - mean; q += d * d; }
    const float rstd = rsqrtf(wave_sum(q) * (1.f / DM) + LN_EPS);
    float gg[16], bb[16];
    load_row16(g, lane, gg); load_row16(b, lane, bb);
#pragma unroll
    for (int j = 0; j < 16; ++j) v[j] = (v[j] - mean) * rstd * gg[j] + bb[j];
}
__device__ __forceinline__ void p_rowpass0(const Ctx& C) {
    for (int row = C.bid * 8 + C.wave; row < T; row += C.G * 8) {
        float v[16]; load_row16(C.in[I_X] + (size_t)row * DM, C.lane, v);
        row_emit(C, row, v, 0, true);
    }
}
__device__ __forceinline__ void p_cumsum(const Ctx& C) {
    if (C.bid != 0) return;
    const float* lsig = (const float*)(C.ws + WS_MISC);
    float* cum = (float*)(C.ws + WS_CUM);
    const int b = C.wave >> 2, h = C.wave & 3;
    float loc = 0.f;
    for (int j = 0; j < 128; ++j) loc += lsig[((size_t)b * SEQ + C.lane * 128 + j) * 4 + h];
    float inc = loc;
#pragma unroll
    for (int o = 1; o < 64; o <<= 1) { const float t = __shfl_up(inc, o, 64); if (C.lane >= o) inc += t; }
    float run = inc - loc;
    for (int j = 0; j < 128; ++j) { run += lsig[((size_t)b * SEQ + C.lane * 128 + j) * 4 + h]; cum[((size_t)b * 4 + h) * SEQ + C.lane * 128 + j] = run; }
}
__device__ __forceinline__ void p_ln1(const Ctx& C, int l) {
    float* xc = (float*)(C.ws + WS_XC); bf16_t* x1b = (bf16_t*)(C.ws + WS_X1B);
    for (int row = C.bid * 8 + C.wave; row < T; row += C.G * 8) {
        float v[16]; load_row16(xc + (size_t)row * DM, C.lane, v);
        ln_row16(v, C.in[I_LN1G] + l * DM, C.in[I_LN1B] + l * DM, C.lane);
        store_row16(xc + (size_t)row * DM, C.lane, v);
        u32x4 o0, o1;
#pragma unroll
        for (int j = 0; j < 4; ++j) { o0[j] = pk2(v[2 * j], v[2 * j + 1]); o1[j] = pk2(v[8 + 2 * j], v[8 + 2 * j + 1]); }
        *(u32x4*)(x1b + (size_t)row * DM + C.lane * 8) = o0; *(u32x4*)(x1b + (size_t)row * DM + 512 + C.lane * 8) = o1;
    }
}

__device__ __forceinline__ void mix_pool_naive(const Ctx& C, int l) {
    const bf16_t* H = (const bf16_t*)(C.ws + WS_H); bf16_t* BR = (bf16_t*)(C.ws + WS_BR);
    LAS float* dd = (LAS float*)C.lds;
    for (int u = C.bid; u < (T / 64) * 4; u += C.G) {
        const int g = u & 3, t0 = (u >> 2) * 64, w = 2 << g;
        for (int idx = C.tid; idx < 64 * 128; idx += 512) {
            const int r = idx >> 7, c = idx & 127, row = t0 + r, pos = row & (SEQ - 1);
            const int nwin = (pos + 1 < w) ? pos + 1 : w;
            float s = 0.f;
            for (int j = 0; j < nwin; ++j) s += bf2f(H[(size_t)(row - j) * NH + HC_P + g * 128 + c]);
            dd[idx] = s / (float)nwin - bf2f(H[(size_t)row * NH + HC_P + g * 128 + c]);
        }
        __syncthreads();
        const int dcol = C.tid & 127, rq = C.tid >> 7;
        float acc[16];
#pragma unroll
        for (int i = 0; i < 16; ++i) acc[i] = 0.f;
        const float* pw = C.in[I_POOLW] + ((size_t)l * 4 + g) * 128 * 128;
        for (int c = 0; c < 128; ++c) {
            const float wv = pw[c * 128 + dcol];
#pragma unroll
            for (int i = 0; i < 16; ++i) acc[i] += dd[(rq * 16 + i) * 128 + c] * wv;
        }
        const float sc = C.in[I_POOLS][l * BW + g * 128 + dcol];
#pragma unroll
        for (int i = 0; i < 16; ++i) BR[(size_t)(t0 + rq * 16 + i) * NBR + 0 + g * 128 + dcol] = (bf16_t)f2bf(acc[i] * sc);
        __syncthreads();
    }
}
__device__ __forceinline__ void mix_gmlp_naive(const Ctx& C, int l) {
    const bf16_t* H = (const bf16_t*)(C.ws + WS_H); bf16_t* BR = (bf16_t*)(C.ws + WS_BR);
    LAS float* vn = (LAS float*)C.lds;
    for (int u = C.bid; u < (T / 128) * 4; u += C.G) {
        const int g = u & 3, t0 = (u >> 2) * 128;
        for (int i = 0; i < 16; ++i) {
            const int r = C.wave * 16 + i, row = t0 + r;
            const u32x4 raw = *(const u32x4*)(H + (size_t)row * NH + HC_GV + C.lane * 8);
            float e[8];
#pragma unroll
            for (int j = 0; j < 4; ++j) { e[2 * j] = geluf_(bf2f(raw[j] & 0xffffu)); e[2 * j + 1] = geluf_(bf2f(raw[j] >> 16)); }
            float s = 0.f;
#pragma unroll
            for (int j = 0; j < 8; ++j) s += e[j];
            const float mean = wave_sum(s) * (1.f / BW);
            float q = 0.f;
#pragma unroll
            for (int j = 0; j < 8; ++j) { const float d = e[j] - mean; q += d * d; }
            const float rstd = rsqrtf(wave_sum(q) * (1.f / BW) + LN_EPS);
            if ((C.lane >> 4) == g) {
#pragma unroll
                for (int j = 0; j < 8; ++j) { const int col = C.lane * 8 + j;
                    vn[r * 128 + (col - g * 128)] = (e[j] - mean) * rstd * C.in[I_GLNG][l * BW + col] + C.in[I_GLNB][l * BW + col]; }
            }
        }
        __syncthreads();
        const int c = C.tid & 127, tq = C.tid >> 7;
        const float* wsg = C.in[I_GWS] + ((size_t)l * 4 + g) * 128 * 128;
        for (int t = tq; t < 128; t += 4) {
            float acc = 0.f;
            for (int s = 0; s <= t; ++s) acc += wsg[t * 128 + s] * vn[s * 128 + c];
            const float sv = acc + C.in[I_GBS][(l * 4 + g) * 128 + t];
            const float uv = geluf_(bf2f(H[(size_t)(t0 + t) * NH + HC_GU + g * 128 + c]));
            BR[(size_t)(t0 + t) * NBR + 1024 + g * 128 + c] = (bf16_t)f2bf(uv * sv);
        }
        __syncthreads();
    }
}
__device__ __forceinline__ void mix_fox_naive(const Ctx& C, int l) {
    const bf16_t* H = (const bf16_t*)(C.ws + WS_H); bf16_t* BR = (bf16_t*)(C.ws + WS_BR);
    const float* cum = (const float*)(C.ws + WS_CUM);
    const float scale = 0.08838834764831845f;
    for (int u = C.bid; u < T * 4 / 8; u += C.G) {
        const int rid = u * 8 + C.wave;
        const int h = rid & 3, row = rid >> 2, b = row / SEQ, t = row % SEQ;
        const unsigned qraw = *(const unsigned*)(H + (size_t)row * NH + HC_FQ + h * 128 + C.lane * 2);
        const float q0 = bf2f(qraw & 0xffffu) * scale, q1 = bf2f(qraw >> 16) * scale;
        const float* cm = cum + ((size_t)b * 4 + h) * SEQ;
        const float ct = cm[t];
        float m = -1e30f, lsum = 0.f, o0 = 0.f, o1 = 0.f;
        for (int s = t; s >= 0; --s) {
            const size_t kr = (size_t)(b * SEQ + s) * NH + h * 128 + C.lane * 2;
            const unsigned kraw = *(const unsigned*)(H + kr + HC_FK);
            const unsigned vraw = *(const unsigned*)(H + kr + HC_FV);
            float d = q0 * bf2f(kraw & 0xffffu) + q1 * bf2f(kraw >> 16);
            d = wave_sum(d);
            const float z = d + ct - cm[s];
            const float mn = fmaxf(m, z), al = __expf(m - mn), p = __expf(z - mn);
            lsum = lsum * al + p; o0 = o0 * al + p * bf2f(vraw & 0xffffu); o1 = o1 * al + p * bf2f(vraw >> 16); m = mn;
        }
        const float inv = 1.f / lsum;
        *(unsigned*)(BR + (size_t)row * NBR + 1536 + h * 128 + C.lane * 2) = pk2(o0 * inv, o1 * inv);
    }
}
__device__ __forceinline__ void mix_hgrn_naive(const Ctx& C, int l) {
    if (C.bid >= BATCH * 4) return;
    const bf16_t* H = (const bf16_t*)(C.ws + WS_H); bf16_t* BR = (bf16_t*)(C.ws + WS_BR);
    const int b = C.bid >> 2, h = C.bid & 3;
    LAS float* fdec = (LAS float*)C.lds;
    LAS float* kkv = fdec + 32 * 128;
    LAS float* qsv = kkv + 32 * 128;
    LAS float* vv = qsv + 32 * 128;
    LAS float* opart = vv + 32 * 128;
    const int kq = C.tid >> 7, v = C.tid & 127;
    float S[32];
#pragma unroll
    for (int j = 0; j < 32; ++j) S[j] = 0.f;
    for (int c0 = 0; c0 < SEQ; c0 += 32) {
        for (int idx = C.tid; idx < 32 * 128; idx += 512) {
            const int st = idx >> 7, k = idx & 127; const size_t rb = (size_t)(b * SEQ + c0 + st) * NH + h * 128 + k;
            float lb = 0.f;
            if (l == 1) { const float z0 = C.in[I_LBL][h * 128 + k], z1 = C.in[I_LBL][BW + h * 128 + k]; lb = 1.f / (1.f + __expf(z0 - z1)); }
            const float zf = bf2f(H[rb + HC_HF]);
            const float kk = (1.f - lb) * sigmoidf_(-zf);
            fdec[idx] = 1.f - kk; kkv[idx] = kk; qsv[idx] = siluf_(bf2f(H[rb + HC_HQ])); vv[idx] = bf2f(H[rb + HC_HI]);
        }
        __syncthreads();
        for (int st = 0; st < 32; ++st) {
            const float vt = vv[st * 128 + v];
            float part = 0.f;
#pragma unroll
            for (int j = 0; j < 32; ++j) { const int k = kq * 32 + j; S[j] = fdec[st * 128 + k] * S[j] + kkv[st * 128 + k] * vt; part += S[j] * qsv[st * 128 + k]; }
            opart[(kq * 32 + st) * 128 + v] = part;
        }
        __syncthreads();
        for (int i = 0; i < 4; ++i) {
            const int st = C.wave * 4 + i, row = b * SEQ + c0 + st;
            float o0 = 0.f, o1 = 0.f;
#pragma unroll
            for (int q = 0; q < 4; ++q) { o0 += opart[(q * 32 + st) * 128 + C.lane]; o1 += opart[(q * 32 + st) * 128 + 64 + C.lane]; }
            const float ss = wave_sum(o0 * o0 + o1 * o1);
            const float r = rsqrtf(ss * (1.f / 128.f) + RMS_EPS);
            const float g0 = siluf_(bf2f(H[(size_t)row * NH + HC_HG + h * 128 + C.lane])), g1 = siluf_(bf2f(H[(size_t)row * NH + HC_HG + h * 128 + 64 + C.lane]));
            BR[(size_t)row * NBR + 512 + h * 128 + C.lane] = (bf16_t)f2bf(o0 * r * C.in[I_HNG][l * 128 + C.lane] * g0);
            BR[(size_t)row * NBR + 512 + h * 128 + 64 + C.lane] = (bf16_t)f2bf(o1 * r * C.in[I_HNG][l * 128 + 64 + C.lane] * g1);
        }
        __syncthreads();
    }
}

__device__ __forceinline__ void wave_argmax(float& v, int& i) {
#pragma unroll
    for (int o = 32; o > 0; o >>= 1) {
        const float ov = __shfl_xor(v, o, 64); const int oi = __shfl_xor(i, o, 64);
        if (ov > v || (ov == v && oi < i)) { v = ov; i = oi; }
    }
}
__device__ __forceinline__ void p_topk_naive(const Ctx& C, int l) {
    const bf16_t* Q = (const bf16_t*)(C.ws + WS_Q);
    const bf16_t* keys = (const bf16_t*)(C.ws + WS_W + (size_t)l * W_LAYER + WO_KEYS);
    int* eidx = (int*)(C.ws + WS_EIDX); float* egate = (float*)(C.ws + WS_EGATE);
    LAS float* qs = (LAS float*)C.lds;
    LAS float* sc = qs + 2048;
    LAS float* tv = sc + 2048;
    LAS int* ti = (LAS int*)(tv + 256);
    for (int t = C.bid; t < T; t += C.G) {
        for (int i = C.tid; i < 2048; i += 512) qs[i] = bf2f(Q[(size_t)t * NQ + i]);
        __syncthreads();
        for (int i = 0; i < 4; ++i) {
            const int idx = C.tid + 512 * i, hj = idx >> 7, key = idx & 127, h = hj >> 1, j = hj & 1;
            const bf16_t* kp = keys + (((size_t)j * PH + h) * 128 + key) * 128;
            float s = 0.f;
            for (int d8 = 0; d8 < 16; ++d8) {
                const u32x4 raw = *(const u32x4*)(kp + d8 * 8);
#pragma unroll
                for (int e = 0; e < 4; ++e) s += qs[h * 256 + j * 128 + d8 * 8 + 2 * e] * bf2f(raw[e] & 0xffffu) + qs[h * 256 + j * 128 + d8 * 8 + 2 * e + 1] * bf2f(raw[e] >> 16);
            }
            sc[idx] = s;
        }
        __syncthreads();
        for (int i = 0; i < 2; ++i) {
            const int hj = C.wave * 2 + i;
            float a0 = sc[hj * 128 + C.lane], a1 = sc[hj * 128 + 64 + C.lane];
            for (int r = 0; r < 16; ++r) {
                float bv; int bi;
                if (a0 > a1 || (a0 == a1)) { bv = a0; bi = C.lane; } else { bv = a1; bi = C.lane + 64; }
                wave_argmax(bv, bi);
                if (C.lane == 0) { tv[hj * 16 + r] = bv; ti[hj * 16 + r] = bi; }
                if (bi == C.lane) a0 = -3e38f; if (bi == C.lane + 64) a1 = -3e38f;
            }
        }
        __syncthreads();
        {
            const int h = C.wave;
            float cv[4];
#pragma unroll
            for (int i = 0; i < 4; ++i) { const int c = C.lane * 4 + i; cv[i] = tv[(h * 2) * 16 + (c >> 4)] + tv[(h * 2 + 1) * 16 + (c & 15)]; }
            float topv = 0.f; int tope = 0; float mx = 0.f;
            for (int r = 0; r < 16; ++r) {
                float bv = cv[0]; int bi = C.lane * 4;
#pragma unroll
                for (int i = 1; i < 4; ++i) if (cv[i] > bv) { bv = cv[i]; bi = C.lane * 4 + i; }
                wave_argmax(bv, bi);
                if (r == 0) mx = bv;
                if (C.lane == r) { topv = bv; tope = ti[(h * 2) * 16 + (bi >> 4)] * 128 + ti[(h * 2 + 1) * 16 + (bi & 15)]; }
#pragma unroll
                for (int i = 0; i < 4; ++i) if (bi == C.lane * 4 + i) cv[i] = -3e38f;
            }
            float e = (C.lane < 16) ? __expf(topv - mx) : 0.f;
            const float den = wave_sum(e);
            if (C.lane < 16) { eidx[(size_t)t * 128 + h * 16 + C.lane] = tope; egate[(size_t)t * 128 + h * 16 + C.lane] = e / den; }
        }
        __syncthreads();
    }
}
__device__ __forceinline__ void p_gather(const Ctx& C, int l) {
    const float* xc = (const float*)(C.ws + WS_XC);
    const bf16_t* U = (const bf16_t*)(C.ws + WS_TABU); const bf16_t* V = (const bf16_t*)(C.ws + WS_TABV);
    const int* eidx = (const int*)(C.ws + WS_EIDX); const float* egate = (const float*)(C.ws + WS_EGATE);
    for (int t = C.bid * 8 + C.wave; t < T; t += C.G * 8) {
        float x[16]; load_row16(xc + (size_t)t * DM, C.lane, x);
        const int e0 = eidx[(size_t)t * 128 + C.lane], e1 = eidx[(size_t)t * 128 + 64 + C.lane];
        const float g0 = egate[(size_t)t * 128 + C.lane], g1 = egate[(size_t)t * 128 + 64 + C.lane];
        float c0 = 0.f, c1 = 0.f;
        for (int e = 0; e < 128; e += 4) {
            float part[4];
#pragma unroll
            for (int i = 0; i < 4; ++i) {
                const int ee = e + i;
                const int ex = __builtin_amdgcn_readlane(ee < 64 ? e0 : e1, ee & 63);
                const bf16_t* up = U + (size_t)ex * DM;
                const u32x4 r0 = *(const u32x4*)(up + C.lane * 8), r1 = *(const u32x4*)(up + 512 + C.lane * 8);
                float s = 0.f;
#pragma unroll
                for (int j = 0; j < 4; ++j) { s += x[2 * j] * bf2f(r0[j] & 0xffffu) + x[2 * j + 1] * bf2f(r0[j] >> 16); s += x[8 + 2 * j] * bf2f(r1[j] & 0xffffu) + x[8 + 2 * j + 1] * bf2f(r1[j] >> 16); }
                part[i] = s;
            }
#pragma unroll
            for (int i = 0; i < 4; ++i) {
                const float s = wave_sum(part[i]);
                const int ee = e + i;
                if (ee < 64) { if (C.lane == ee) c0 = geluf_(s) * g0; } else { if (C.lane == ee - 64) c1 = geluf_(s) * g1; }
            }
        }
        float y[16];
#pragma unroll
        for (int j = 0; j < 16; ++j) y[j] = 0.f;
        for (int e = 0; e < 128; e += 4) {
#pragma unroll
            for (int i = 0; i < 4; ++i) {
                const int ee = e + i;
                const int ex = __builtin_amdgcn_readlane(ee < 64 ? e0 : e1, ee & 63);
                const float cf = __builtin_bit_cast(float, __builtin_amdgcn_readlane(__builtin_bit_cast(int, ee < 64 ? c0 : c1), ee & 63));
                const bf16_t* vp = V + (size_t)ex * DM;
                const u32x4 r0 = *(const u32x4*)(vp + C.lane * 8), r1 = *(const u32x4*)(vp + 512 + C.lane * 8);
#pragma unroll
                for (int j = 0; j < 4; ++j) { y[2 * j] += cf * bf2f(r0[j] & 0xffffu); y[2 * j + 1] += cf * bf2f(r0[j] >> 16); y[8 + 2 * j] += cf * bf2f(r1[j] & 0xffffu); y[8 + 2 * j + 1] += cf * bf2f(r1[j] >> 16); }
            }
        }
#pragma unroll
        for (int j = 0; j < 16; ++j) y[j] += ALPHA * x[j];
        ln_row16(y, C.in[I_LN2G] + l * DM, C.in[I_LN2B] + l * DM, C.lane);
        if (l + 1 < DEPTH) {
            store_row16((float*)(C.ws + WS_XA) + (size_t)t * DM, C.lane, y);
            row_emit(C, t, y, l + 1, true);
        } else {
            store_row16(C.out + (size_t)t * DM, C.lane, y);
        }
    }
}

struct FStoreBf16 { bf16_t* O; int ld;
    __device__ __forceinline__ void operator()(int row, int col, f32x4 v0, f32x4 v1, int) const {
        u32x4 o; o[0] = pk2(v0[0], v0[1]); o[1] = pk2(v0[2], v0[3]); o[2] = pk2(v1[0], v1[1]); o[3] = pk2(v1[2], v1[3]);
        *(u32x4*)(O + (size_t)row * ld + col) = o; } };
struct FGate { bf16_t* O; const float* bias;
    __device__ __forceinline__ void operator()(int row, int col, f32x4 v0, f32x4 v1, int) const {
        const f32x4 b0 = *(const f32x4*)(bias + col), b1 = *(const f32x4*)(bias + col + 4);
        u32x4 o; o[0] = pk2(sigmoidf_(v0[0] + b0[0]), sigmoidf_(v0[1] + b0[1])); o[1] = pk2(sigmoidf_(v0[2] + b0[2]), sigmoidf_(v0[3] + b0[3]));
        o[2] = pk2(sigmoidf_(v1[0] + b1[0]), sigmoidf_(v1[1] + b1[1])); o[3] = pk2(sigmoidf_(v1[2] + b1[2]), sigmoidf_(v1[3] + b1[3]));
        *(u32x4*)(O + (size_t)row * NG + col) = o; } };
struct FMerge { const bf16_t* G; float* MGF; bf16_t* MG;
    __device__ __forceinline__ void operator()(int row, int col, f32x4 v, int z) const {
        const u32x2 gr = *(const u32x2*)(G + (size_t)row * NG + z * DM + col);
        f32x4 r; r[0] = v[0] * bf2f(gr[0] & 0xffffu); r[1] = v[1] * bf2f(gr[0] >> 16); r[2] = v[2] * bf2f(gr[1] & 0xffffu); r[3] = v[3] * bf2f(gr[1] >> 16);
        float* p = MGF + (size_t)row * DM + col;
        if (z > 0) r += *(const f32x4*)p;
        if (z < 3) *(f32x4*)p = r;
        else { u32x2 o; o[0] = pk2(r[0], r[1]); o[1] = pk2(r[2], r[3]); *(u32x2*)(MG + (size_t)row * DM + col) = o; } } };
struct FResid { const float* X; float* Y;
    __device__ __forceinline__ void operator()(int row, int col, f32x4 v, int) const {
        const f32x4 x = *(const f32x4*)(X + (size_t)row * DM + col);
        *(f32x4*)(Y + (size_t)row * DM + col) = x * ALPHA + v; } };

constexpr int PH_PER_LAYER = 10, N_PHASES = 1 + DEPTH * PH_PER_LAYER;
template <int SP> __device__ __forceinline__ void run_phase(const Ctx& C0, int l) {
    Ctx C = C0;
    asm volatile("" : "+v"(C.tid));
    C.ws = launder_ptr(C.ws); C.out = launder_ptr(C.out); l = (int)launder_u((unsigned)l);
    C.lane = C.tid & 63; C.wave = __builtin_amdgcn_readfirstlane(C.tid >> 6);
    unsigned char* wb = C.ws + WS_W + (size_t)l * W_LAYER;
    if constexpr (SP == -1) { p_conv_weights(C); }
    if constexpr (SP == 0) {
        p_conv_tables(C, l);
        if (l == 0) p_rowpass0(C);
    }
    if constexpr (SP == 1) {
        p_cumsum(C);
        __syncthreads();
        pg8::Gemm g{(const bf16_t*)(C.ws + WS_XB), (const bf16_t*)(wb + WO_WIN), DM, DM, DM, 0, 0};
        pg8::StaticOrder S; S.init(T, NH, C.G, C.bid);
        pg8::Epi8<FStoreBf16> E{{(bf16_t*)(C.ws + WS_H), NH}};
        pg8::gemm_phase(C.lds, g, S, E, C.tid);
    }
    if constexpr (SP == 2) {
        mix_hgrn_naive(C, l);
        __syncthreads();
        mix_pool_naive(C, l);
        mix_gmlp_naive(C, l);
        mix_fox_naive(C, l);
    }
    if constexpr (SP == 3) {
        pg8::Gemm g{(const bf16_t*)(C.ws + WS_XB), (const bf16_t*)(wb + WO_WG), DM, DM, DM, 0, 0};
        pg8::StaticOrder S; S.init(T, NG, C.G, C.bid);
        pg8::Epi8<FGate> E{{(bf16_t*)(C.ws + WS_G), C.in[I_BGATE] + l * NG}};
        pg8::gemm_phase(C.lds, g, S, E, C.tid);
    }
    if constexpr (SP == 4) {
        pg8::Gemm g{(const bf16_t*)(C.ws + WS_BR), (const bf16_t*)(wb + WO_WBR), NBR, BW, BW, (size_t)BW, (size_t)DM * BW};
        pg8::ZOrder S; S.init(T, DM, 4, C.G, C.vcu);
        pg8::Epi4<FMerge> E{{(const bf16_t*)(C.ws + WS_G), (float*)(C.ws + WS_MGF), (bf16_t*)(C.ws + WS_XB)}};
        pg8::gemm_phase(C.lds, g, S, E, C.tid);
    }
    if constexpr (SP == 5) {
        const float* xin = (l == 0) ? C.in[I_X] : (const float*)(C.ws + WS_XA);
        pg8::Gemm g{(const bf16_t*)(C.ws + WS_XB), (const bf16_t*)(wb + WO_WOUT), DM, DM, DM, 0, 0};
        pg8::StaticOrder S; S.init(T, DM, C.G, C.bid);
        pg8::Epi4<FResid> E{{xin, (float*)(C.ws + WS_XC)}};
        pg8::gemm_phase(C.lds, g, S, E, C.tid);
    }
    if constexpr (SP == 6) p_ln1(C, l);
    if constexpr (SP == 7) {
        pg8::Gemm g{(const bf16_t*)(C.ws + WS_X1B), (const bf16_t*)(wb + WO_WQ), DM, DM, DM, 0, 0};
        pg8::StaticOrder S; S.init(T, NQ, C.G, C.bid);
        pg8::Epi8<FStoreBf16> E{{(bf16_t*)(C.ws + WS_Q), NQ}};
        pg8::gemm_phase(C.lds, g, S, E, C.tid);
    }
    if constexpr (SP == 8) p_topk_naive(C, l);
    if constexpr (SP == 9) p_gather(C, l);
}
__device__ __forceinline__ void make_ctx(Ctx& C, const Args& args, unsigned char* lds_raw) {
    C.lds = (LAS unsigned char*)lds_raw; C.ws = args.ws; C.in = args.in; C.out = args.out;
    C.tid = threadIdx.x; C.lane = C.tid & 63; C.wave = __builtin_amdgcn_readfirstlane(C.tid >> 6);
    C.G = gridDim.x; C.bid = blockIdx.x; C.vcu = (C.G % 8 == 0) ? (C.bid % 8) * (C.G / 8) + C.bid / 8 : C.bid;
}
template <int SP> __global__ void __launch_bounds__(512, 2) mk_phase(Args args) {
    extern __shared__ __attribute__((aligned(16))) unsigned char lds_raw[];
    Ctx C; make_ctx(C, args, lds_raw);
    run_phase<SP>(C, args.ph_lo);
}

#define GRID_BAR() xcd_barrier((unsigned*)(args.ws + WS_CTL) + 1024, (volatile LAS unsigned*)((LAS unsigned char*)lds_raw + LDSCTL_OFF + 32))
__global__ void __launch_bounds__(512, 2) mk_fwd(Args args) {
    extern __shared__ __attribute__((aligned(16))) unsigned char lds_raw[];
    Ctx C; make_ctx(C, args, lds_raw);
    { volatile LAS unsigned* misc = (volatile LAS unsigned*)(C.lds + LDSCTL_OFF); if (C.tid < 64) misc[C.tid] = 0u; }
    __syncthreads();
    xcd_barrier_post((unsigned*)(args.ws + WS_CTL) + 1024);
    run_phase<-1>(C, 0); GRID_BAR();
#pragma unroll 1
    for (int l = 0; l < DEPTH; ++l) {
        run_phase<0>(C, l); GRID_BAR();
        run_phase<1>(C, l); GRID_BAR();
        run_phase<2>(C, l); GRID_BAR();
        run_phase<3>(C, l); GRID_BAR();
        run_phase<4>(C, l); GRID_BAR();
        run_phase<5>(C, l); GRID_BAR();
        run_phase<6>(C, l); GRID_BAR();
        run_phase<7>(C, l); GRID_BAR();
        run_phase<8>(C, l); GRID_BAR();
        run_phase<9>(C, l); if (l + 1 < DEPTH) GRID_BAR();
    }
}

template <int SP> static void launch_phase(const Args& a, int grid, hipStream_t stream) {
    static bool attr_done = false;
    if (!attr_done) { (void)hipFuncSetAttribute((const void*)mk_phase<SP>, hipFuncAttributeMaxDynamicSharedMemorySize, LDS_BYTES); attr_done = true; }
    hipLaunchKernelGGL(mk_phase<SP>, dim3(grid), dim3(512), LDS_BYTES, stream, a);
}
extern "C" void kernel_launch(void* const* d_in, const int* in_sizes, int n_in, void* d_out, int out_size, void* d_ws, size_t ws_size, hipStream_t stream) {
    static int grid = 0;
    if (grid == 0) {
        if (n_in != NIN_PTRS || out_size != T * DM || ws_size < WS_END) { fprintf(stderr, "kernel_launch: unexpected shapes n_in %d out %d ws %zu\n", n_in, out_size, ws_size); grid = -1; return; }
        int dev = 0, cus = 0;
        if (hipGetDevice(&dev) != hipSuccess || hipDeviceGetAttribute(&cus, hipDeviceAttributeMultiprocessorCount, dev) != hipSuccess) { grid = -1; return; }
        grid = cus;
    }
    if (grid < 0) return;
    (void)hipMemsetAsync((char*)d_ws + WS_CTL, 0, CTL_ZERO_BYTES, stream);
    Args a{};
    for (int i = 0; i < NIN_PTRS; ++i) a.in[i] = (const float*)d_in[i];
    a.out = (float*)d_out; a.ws = (unsigned char*)d_ws; a.bar_slot = 0; a.pad = 0; a.ph_hi = 0;
#if MK_ONE_LAUNCH
    static bool attr_done = false;
    if (!attr_done) { (void)hipFuncSetAttribute((const void*)mk_fwd, hipFuncAttributeMaxDynamicSharedMemorySize, LDS_BYTES); attr_done = true; }
    hipLaunchKernelGGL(mk_fwd, dim3(grid), dim3(512), LDS_BYTES, stream, a);
    return;
#endif
    a.ph_lo = 0; launch_phase<-1>(a, grid, stream);
    for (int l = 0; l < DEPTH; ++l) {
        a.ph_lo = l;
        launch_phase<0>(a, grid, stream); launch_phase<1>(a, grid, stream); launch_phase<2>(a, grid, stream); launch_phase<3>(a, grid, stream); launch_phase<4>(a, grid, stream);
        launch_phase<5>(a, grid, stream); launch_phase<6>(a, grid, stream); launch_phase<7>(a, grid, stream); launch_phase<8>(a, grid, stream); launch_phase<9>(a, grid, stream);
    }
}
```

```cpp
#include <hip/hip_runtime.h>
#include <cstdio>
#include <cstdint>

#ifndef DIAG
#define DIAG 0
#endif
#ifndef DIAG_LO
#define DIAG_LO 0
#endif
#ifndef DIAG_HI
#define DIAG_HI 64
#endif
#ifndef DIAG_MOD
#define DIAG_MOD 64
#endif
#ifndef TOPK_NAIVE
#define TOPK_NAIVE 0
#endif
#ifndef FOX_NAIVE
#define FOX_NAIVE 0
#endif
#ifndef HG_NAIVE_L
#define HG_NAIVE_L 99
#endif
#ifndef DIAG_LAYER
#define DIAG_LAYER 0
#endif
#ifndef MK_ONE_LAUNCH
#define MK_ONE_LAUNCH 1
#endif

#define LAS __attribute__((address_space(3)))
#define GAS __attribute__((address_space(1)))
typedef unsigned short bf16_t;
typedef short bf16x8 __attribute__((ext_vector_type(8)));
typedef float f32x4 __attribute__((ext_vector_type(4)));
typedef float f32x2 __attribute__((ext_vector_type(2)));
typedef unsigned u32x4 __attribute__((ext_vector_type(4)));
typedef unsigned u32x2 __attribute__((ext_vector_type(2)));

constexpr int DM = 1024, BATCH = 2, SEQ = 8192, DEPTH = 2, T = BATCH * SEQ;
constexpr int BW = 512, NIN = 5124, NH = 5120, NG = 4096, NBR = 2048, NQ = 2048;
constexpr int NEXP = 16384, TOPK = 16, PH = 8;
constexpr float ALPHA = 1.4142135623730951f;
constexpr float LN_EPS = 1e-5f, RMS_EPS = 1e-6f;
constexpr int HC_P = 0, HC_HQ = 512, HC_HF = 1024, HC_HI = 1536, HC_HG = 2048, HC_GU = 2560, HC_GV = 3072, HC_FQ = 3584, HC_FK = 4096, HC_FV = 4608;

constexpr size_t MiB = 1u << 20;
constexpr size_t WS_CTL = 0, CTL_ZERO_BYTES = 64 * 1024;
constexpr size_t WS_MISC = 512 * 1024;
constexpr size_t WS_CUM = 768 * 1024;
constexpr size_t WS_W = 1 * MiB;
constexpr size_t W_LAYER = 30 * MiB;
constexpr size_t WO_WIN = 0, WO_WG = 10 * MiB, WO_WBR = 18 * MiB, WO_WOUT = 22 * MiB, WO_WQ = 24 * MiB, WO_KEYS = 28 * MiB, WO_WF = 28 * MiB + 512 * 1024;
constexpr size_t WS_TABU = 64 * MiB, WS_TABV = 96 * MiB;
constexpr size_t WS_XA = 128 * MiB;
constexpr size_t WS_XB = 192 * MiB;
constexpr size_t WS_X1B = 224 * MiB;
constexpr size_t WS_H = 256 * MiB;
constexpr size_t WS_ST = 416 * MiB;
constexpr size_t WS_BR = 448 * MiB;
constexpr size_t WS_G = 256 * MiB;
constexpr size_t WS_MGF = 384 * MiB;
constexpr size_t WS_XC = 256 * MiB;
constexpr size_t WS_Q = 320 * MiB;
constexpr size_t WS_EIDX = 384 * MiB, WS_EGATE = 392 * MiB;
constexpr size_t WS_END = 512 * MiB;

__device__ __forceinline__ float bf2f(unsigned u) { return __builtin_bit_cast(float, u << 16); }
__device__ __forceinline__ unsigned f2bf(float f) { unsigned u = __builtin_bit_cast(unsigned, f); return (u + 0x7fffu + ((u >> 16) & 1u)) >> 16; }
__device__ __forceinline__ unsigned pk2(float lo, float hi) { return f2bf(lo) | (f2bf(hi) << 16); }
__device__ __forceinline__ float wave_sum(float v) {
#pragma unroll
    for (int o = 32; o > 0; o >>= 1) v += __shfl_xor(v, o, 64);
    return v;
}
__device__ __forceinline__ float sigmoidf_(float x) { return 1.f / (1.f + __expf(-x)); }
__device__ __forceinline__ float siluf_(float x) { return x / (1.f + __expf(-x)); }
__device__ __forceinline__ float geluf_(float x) { const float u = 0.7978845608028654f * (x + 0.044715f * x * x * x); return 0.5f * x * (1.f + tanhf(u)); }
__device__ __forceinline__ float logsigmoidf_(float z) { return fminf(z, 0.f) - log1pf(__expf(-fabsf(z))); }

__device__ __forceinline__ unsigned launder_u(unsigned x) { asm volatile("" : "+v"(x)); return __builtin_amdgcn_readfirstlane(x); }
template <class P> __device__ __forceinline__ P launder_ptr(P p) {
    const unsigned lo = launder_u((unsigned)(uintptr_t)p), hi = launder_u((unsigned)((uintptr_t)p >> 32));
    return (P)(((uintptr_t)hi << 32) | lo);
}

namespace pg8 {
constexpr int BM = 256, BK = 64, HALF = 128, HTB = HALF * BK * 2, STAGE_BYTES = 8 * HTB, NXCD = 8, WGM = 8;
__host__ __device__ __forceinline__ int lds_byte(int r, int c) { const int st = (r >> 4) * 2 + (c >> 5), rr = r & 15, cc = c & 31, ob = rr * 64 + cc * 2; return st * 1024 + (ob ^ (((ob >> 9) & 1) << 5)); }
__host__ __device__ __forceinline__ void stage_rc(int b, int& R, int& C) { const int st = b / 1024, sb = b % 1024, swz = sb ^ (((sb >> 9) & 1) << 5); R = (st >> 1) * 16 + swz / 64; C = (st & 1) * 32 + (swz % 64) / 2; }
__host__ __device__ __forceinline__ int perm32(int rho) { const int n = rho >> 4, i = rho & 15; return 8 * (i >> 2) + 4 * n + (i & 3); }

struct Unit { int pm, pn, z; };
struct Gemm { const bf16_t* A; const bf16_t* Bt; int lda, ldb, K; size_t zA, zB; };

struct StaticOrder {
    int nM, nN, nwg, G, c;
    __device__ void init(int M, int N, int G_, int c_) { nM = M / BM; nN = N / BM; nwg = nM * nN; G = G_; c = c_; }
    __device__ bool next(int i, Unit& u) const {
        const long L = (long)i * G + c; if (L >= nwg) return false;
        int wgid = (int)L; { const int q = nwg / NXCD, r = nwg % NXCD, xcd = wgid % NXCD, off = wgid / NXCD; wgid = (xcd < r ? xcd * (q + 1) : r * (q + 1) + (xcd - r) * q) + off; }
        const int nig = WGM * nN, gid = wgid / nig, fm = gid * WGM, gsz = (nM - fm) < WGM ? (nM - fm) : WGM;
        u.pm = fm + ((wgid % nig) % gsz); u.pn = (wgid % nig) / gsz; u.z = 0; return true;
    }
};
struct ZOrder {
    int nM, nN, nZ, ntile, G, c;
    __device__ void init(int M, int N, int Z, int G_, int c_) { nM = M / BM; nN = N / BM; nZ = Z; ntile = nM * nN; G = G_; c = c_; }
    __device__ bool next(int i, Unit& u) const {
        const long L = (long)(i / nZ) * G + c; if (L >= ntile) return false;
        u.pm = (int)L / nN; u.pn = (int)L % nN; u.z = i % nZ; return true;
    }
};

template <class F> struct Epi8 {
    static constexpr bool PERM = true;
    F f;
    __device__ __forceinline__ void operator()(const f32x4 (&acc)[2][2][4][2], const Unit& u, int wr, int wc, int fr, int fq) const {
        const int row0 = u.pm * BM + wr * 64 + fr, col0 = u.pn * BM + wc * 32 + 8 * fq;
#pragma unroll
        for (int ai = 0; ai < 2; ++ai)
#pragma unroll
            for (int m = 0; m < 4; ++m)
#pragma unroll
                for (int bj = 0; bj < 2; ++bj) f(row0 + ai * HALF + m * 16, col0 + bj * HALF, acc[ai][bj][m][0], acc[ai][bj][m][1], u.z);
    }
};
template <class F> struct Epi4 {
    static constexpr bool PERM = false;
    F f;
    __device__ __forceinline__ void operator()(const f32x4 (&acc)[2][2][4][2], const Unit& u, int wr, int wc, int fr, int fq) const {
        const int row0 = u.pm * BM + wr * 64 + fr, col0 = u.pn * BM + wc * 32 + 4 * fq;
#pragma unroll
        for (int ai = 0; ai < 2; ++ai)
#pragma unroll
            for (int m = 0; m < 4; ++m)
#pragma unroll
                for (int bj = 0; bj < 2; ++bj)
#pragma unroll
                    for (int n = 0; n < 2; ++n) f(row0 + ai * HALF + m * 16, col0 + bj * HALF + n * 16, acc[ai][bj][m][n], u.z);
    }
};

template <class Epi, class Sched, bool ALIGN_EPI = true>
__device__ __forceinline__ void gemm_phase(LAS unsigned char* lds, const Gemm g, const Sched& S, const Epi& E, const int tid) {
    const int wid = __builtin_amdgcn_readfirstlane(tid >> 6), lane = tid & 63, wr = wid >> 2, wc = wid & 3, fr = lane & 15, fq = lane >> 4;
    const int K = g.K, nt = K / BK;
    unsigned voffA[2], voffB[2];
#pragma unroll
    for (int i = 0; i < 2; ++i) { int R, C; stage_rc(tid * 16 + i * 8192, R, C); const int Rb = Epi::PERM ? ((R & ~31) + perm32(R & 31)) : R;
        voffA[i] = (unsigned)(R * g.lda + C) * 2u; voffB[i] = (unsigned)(Rb * g.ldb + C) * 2u; }
    const size_t kstep = (size_t)(BK * 2);
    const size_t hstepA = (size_t)HALF * g.lda * 2, hstepB = (size_t)HALF * g.ldb * 2;
    const size_t tstepA = 2 * hstepA, tstepB = 2 * hstepB;
    const unsigned ldsw = (unsigned)wid * 1024u;
    const int aoff = lds_byte(wr * 64 + fr, fq * 8), boff = lds_byte(wc * 32 + fr, fq * 8);
#define PG8_SA(b, h) (((b) * 2 + (h)) * HTB)
#define PG8_SB(b, h) ((4 + (b) * 2 + (h)) * HTB)
#define PG8_STAGE(bufoff, gbase, voff) do { _Pragma("unroll") for (int _i = 0; _i < 2; ++_i) \
        __builtin_amdgcn_global_load_lds((const unsigned*)((const char*)(gbase) + (voff)[_i]), (LAS unsigned*)(lds + (bufoff) + ldsw + _i * 8192), 16, 0, 0); } while (0)
#define PG8_LDA(dst, b, h) do { _Pragma("unroll") for (int m = 0; m < 4; ++m) _Pragma("unroll") for (int k = 0; k < 2; ++k) dst[m][k] = *(const LAS bf16x8*)(lds + PG8_SA(b, h) + aoff + m * 2048 + k * 1024); } while (0)
#define PG8_LDB(dst, b, h) do { _Pragma("unroll") for (int n = 0; n < 2; ++n) _Pragma("unroll") for (int k = 0; k < 2; ++k) dst[n][k] = *(const LAS bf16x8*)(lds + PG8_SB(b, h) + boff + n * 2048 + k * 1024); } while (0)
#define PG8_MMA(ai, bj, At, Bt) do { __builtin_amdgcn_s_setprio(1); _Pragma("unroll") for (int m = 0; m < 4; ++m) _Pragma("unroll") for (int n = 0; n < 2; ++n) _Pragma("unroll") for (int k = 0; k < 2; ++k) \
        acc[ai][bj][m][n] = __builtin_amdgcn_mfma_f32_16x16x32_bf16(Bt[n][k], At[m][k], acc[ai][bj][m][n], 0, 0, 0); __builtin_amdgcn_s_setprio(0); } while (0)
#define PG8_WAIT_V(n) asm volatile("s_waitcnt vmcnt(" #n ")" ::: "memory")
#define PG8_WAIT_L(n) asm volatile("s_waitcnt lgkmcnt(" #n ")" ::: "memory")
#define PG8_BAR __builtin_amdgcn_s_barrier()
#define PG8_SCHED __builtin_amdgcn_sched_barrier(0)
    Unit cur, nxt; int ui = 0;
    if (!S.next(0, cur)) return;
    f32x4 acc[2][2][4][2];
#pragma unroll
    for (int a = 0; a < 2; ++a)
#pragma unroll
        for (int b = 0; b < 2; ++b)
#pragma unroll
            for (int m = 0; m < 4; ++m)
#pragma unroll
                for (int n = 0; n < 2; ++n) acc[a][b][m][n] = (f32x4){0.f, 0.f, 0.f, 0.f};
    bf16x8 At[4][2], B0[2][2], B1[2][2];
    const char* cA = (const char*)(g.A + (size_t)cur.z * g.zA) + (size_t)cur.pm * tstepA; const char* cB = (const char*)(g.Bt + (size_t)cur.z * g.zB) + (size_t)cur.pn * tstepB;
    PG8_STAGE(PG8_SB(0, 0), cB, voffB); PG8_STAGE(PG8_SB(0, 1), cB + hstepB, voffB); PG8_STAGE(PG8_SA(0, 0), cA, voffA); PG8_STAGE(PG8_SA(0, 1), cA + hstepA, voffA);
    if (wr == 1) PG8_BAR;
    PG8_WAIT_V(2); PG8_BAR;
    PG8_STAGE(PG8_SB(1, 0), cB + kstep, voffB); PG8_STAGE(PG8_SA(1, 0), cA + kstep, voffA); PG8_STAGE(PG8_SB(1, 1), cB + hstepB + kstep, voffB);
    PG8_WAIT_V(6); PG8_BAR;
    for (;;) {
        const bool has_next = S.next(ui + 1, nxt);
        const char* nA = has_next ? (const char*)(g.A + (size_t)nxt.z * g.zA) + (size_t)nxt.pm * tstepA : cA;
        const char* nB = has_next ? (const char*)(g.Bt + (size_t)nxt.z * g.zB) + (size_t)nxt.pn * tstepB : cB;
        for (int t = 0; t < nt; t += 2) {
            const bool last = (t == nt - 2);
            const char* a1 = cA + (size_t)(t + 1) * kstep;
            const char* a2 = last ? nA : cA + (size_t)(t + 2) * kstep; const char* b2 = last ? nB : cB + (size_t)(t + 2) * kstep;
            const char* a3 = a2 + kstep; const char* b3 = b2 + kstep;
            PG8_LDB(B0, 0, 0); PG8_LDB(B1, 0, 1); PG8_SCHED; PG8_LDA(At, 0, 0); PG8_STAGE(PG8_SA(1, 1), a1 + hstepA, voffA);
            PG8_WAIT_V(8); PG8_WAIT_L(0); PG8_BAR; PG8_MMA(0, 0, At, B0); PG8_MMA(0, 1, At, B1); PG8_BAR; PG8_SCHED;
            PG8_LDA(At, 0, 1); PG8_STAGE(PG8_SB(0, 0), b2, voffB); PG8_STAGE(PG8_SB(0, 1), b2 + hstepB, voffB); PG8_STAGE(PG8_SA(0, 0), a2, voffA);
            PG8_WAIT_V(8); PG8_WAIT_L(0); PG8_BAR; PG8_MMA(1, 0, At, B0); PG8_MMA(1, 1, At, B1); PG8_BAR; PG8_SCHED;
            PG8_LDB(B0, 1, 0); PG8_LDB(B1, 1, 1); PG8_SCHED; PG8_LDA(At, 1, 0); PG8_STAGE(PG8_SA(0, 1), a2 + hstepA, voffA);
            PG8_WAIT_V(8); PG8_WAIT_L(0); PG8_BAR; PG8_MMA(0, 0, At, B0); PG8_MMA(0, 1, At, B1); PG8_BAR; PG8_SCHED;
            PG8_LDA(At, 1, 1); PG8_STAGE(PG8_SB(1, 0), b3, voffB); PG8_STAGE(PG8_SB(1, 1), b3 + hstepB, voffB); PG8_STAGE(PG8_SA(1, 0), a3, voffA);
            PG8_WAIT_V(8); PG8_WAIT_L(0); PG8_BAR; PG8_MMA(1, 0, At, B0); PG8_MMA(1, 1, At, B1); PG8_BAR; PG8_SCHED;
        }
        if constexpr (ALIGN_EPI) { if (wr == 0) PG8_BAR; }
        E(acc, cur, wr, wc, fr, fq);
        if (!has_next) break;
#pragma unroll
        for (int a = 0; a < 2; ++a)
#pragma unroll
            for (int b = 0; b < 2; ++b)
#pragma unroll
                for (int m = 0; m < 4; ++m)
#pragma unroll
                    for (int n = 0; n < 2; ++n) acc[a][b][m][n] = (f32x4){0.f, 0.f, 0.f, 0.f};
        cur = nxt; cA = nA; cB = nB; ++ui;
        if constexpr (ALIGN_EPI) { if (wr == 1) PG8_BAR; }
    }
    PG8_WAIT_V(0);
    if constexpr (!ALIGN_EPI) { if (wr == 0) PG8_BAR; }
    PG8_BAR;
#undef PG8_SA
#undef PG8_SB
#undef PG8_STAGE
#undef PG8_LDA
#undef PG8_LDB
#undef PG8_MMA
#undef PG8_WAIT_V
#undef PG8_WAIT_L
#undef PG8_BAR
#undef PG8_SCHED
}
}

#define XB_TMO      128
#define XB_XCNT(j)  (256  + 64 * (j))
#define XB_XSUB(j)  (1280 + 64 * (j))
#define XB_XGEN(j)  (2304 + 64 * (j))
#define XB_TOP      3328
#define XB_TOPGEN   3392
#define XCD_BAR_WORDS 3456
#define XB_SPIN_CAP (1u << 22)
__device__ __forceinline__ unsigned xb_ld(unsigned* p)              { return __hip_atomic_load(p, __ATOMIC_RELAXED, __HIP_MEMORY_SCOPE_AGENT); }
__device__ __forceinline__ unsigned xb_add(unsigned* p, unsigned v) { return __hip_atomic_fetch_add(p, v, __ATOMIC_RELAXED, __HIP_MEMORY_SCOPE_AGENT); }
__device__ __forceinline__ unsigned xb_xcc_id() { return (unsigned)__builtin_amdgcn_s_getreg((3 << 11) | 20) & 0xFu; }
#define XB_SPIN(cond, bar) do { unsigned _sp = 0; while (cond) { __builtin_amdgcn_s_sleep(1); \
    if ((++_sp & 255u) == 0u) { if (xb_ld(&(bar)[XB_TMO])) break; if (_sp > XB_SPIN_CAP) { atomicAdd(&(bar)[XB_TMO], 1u); break; } } } } while (0)
__device__ __forceinline__ void xcd_barrier_post(unsigned* bar) {
    if (threadIdx.x == 0) (void)xb_add(&bar[XB_XCNT(xb_xcc_id())], 1u);
}
__device__ __forceinline__ void xcd_barrier_complete(unsigned* bar, unsigned x, unsigned& nloc, unsigned& nx) {
    const unsigned G = gridDim.x * gridDim.y * gridDim.z;
    unsigned sum, cnt, mine, sp = 0u;
    for (;;) {
        sum = 0u; cnt = 0u; mine = 0u;
#pragma unroll
        for (unsigned j = 0; j < 16; ++j) { const unsigned c = xb_ld(&bar[XB_XCNT(j)]); sum += c; cnt += (c > 0u) ? 1u : 0u; mine = (j == x) ? c : mine; }
        if (sum == G) break;
        __builtin_amdgcn_s_sleep(1);
        if ((++sp & 255u) == 0u) { if (xb_ld(&bar[XB_TMO])) break; if (sp > XB_SPIN_CAP) { atomicAdd(&bar[XB_TMO], 1u); break; } }
    }
    nloc = mine > 0u ? mine : 1u; nx = cnt > 0u ? cnt : 1u;
}
__device__ __noinline__ void xcd_barrier_leader(unsigned* bar, volatile LAS unsigned* st) {
    const unsigned x = xb_xcc_id();
    __builtin_amdgcn_s_waitcnt(0);
    unsigned nloc = st[0], nx = st[1];
    if (nloc == 0u) { xcd_barrier_complete(bar, x, nloc, nx); st[0] = nloc; st[1] = nx; }
    const unsigned old = xb_add(&bar[XB_XSUB(x)], 1u);
    const unsigned gen = old / nloc;
    if (old + 1u == (gen + 1u) * nloc) {
        __builtin_amdgcn_fence(__ATOMIC_RELEASE, "agent");
        asm volatile("s_waitcnt vmcnt(0)" ::: "memory");
        const unsigned og = xb_add(&bar[XB_TOP], 1u);
        const unsigned tg = og / nx;
        if (og + 1u == (tg + 1u) * nx) xb_add(&bar[XB_TOPGEN], 1u);
        else XB_SPIN(xb_ld(&bar[XB_TOPGEN]) == tg, bar);
        __builtin_amdgcn_fence(__ATOMIC_ACQUIRE, "agent");
        xb_add(&bar[XB_XGEN(x)], 1u);
        asm volatile("s_waitcnt vmcnt(0)" ::: "memory");
    } else {
        XB_SPIN(xb_ld(&bar[XB_XGEN(x)]) == gen, bar);
        __builtin_amdgcn_fence(__ATOMIC_ACQUIRE, "agent");
        asm volatile("s_waitcnt vmcnt(0)" ::: "memory");
    }
}
__device__ __forceinline__ void xcd_barrier(unsigned* bar, volatile LAS unsigned* st) {
    asm volatile("s_waitcnt vmcnt(0)" ::: "memory");
    __syncthreads();
    if (threadIdx.x == 0) xcd_barrier_leader(bar, st);
    __syncthreads();
}

constexpr int NIN_PTRS = 23;
struct Args { const float* in[NIN_PTRS]; float* out; unsigned char* ws; int ph_lo, ph_hi, bar_slot, pad; };
enum { I_X = 0, I_WIN, I_BFOX, I_POOLW, I_POOLS, I_LBL, I_HNG, I_GLNG, I_GLNB, I_GWS, I_GBS, I_WGATE, I_BGATE, I_WBR, I_WOUT, I_LN1G, I_LN1B, I_WQ, I_KEYS, I_PU, I_PV, I_LN2G, I_LN2B };

constexpr int LDS_BYTES = 147456;
constexpr int LDSCTL_OFF = 143360;

struct Ctx {
    LAS unsigned char* lds;
    unsigned char* ws;
    const float* const* in;
    float* out;
    int tid, lane, wave, G, bid, vcu;
};

__device__ __forceinline__ void tconv_job(const Ctx& C, const float* src, int ld_src, int K, int N, bf16_t* dst) {
    LAS float* tile = (LAS float*)C.lds;
    const int nk = K / 64, nn = N / 64, ntiles = nk * nn;
    for (int tl = C.bid; tl < ntiles; tl += C.G) {
        const int k0 = (tl / nn) * 64, n0 = (tl % nn) * 64;
#pragma unroll
        for (int p = 0; p < 2; ++p) {
            const int kr = (C.tid >> 4) + p * 32, nc = (C.tid & 15) * 4;
            const f32x4 v = *(const f32x4*)(src + (size_t)(k0 + kr) * ld_src + n0 + nc);
            tile[kr * 65 + nc + 0] = v[0]; tile[kr * 65 + nc + 1] = v[1]; tile[kr * 65 + nc + 2] = v[2]; tile[kr * 65 + nc + 3] = v[3];
        }
        __syncthreads();
        {
            const int n = C.tid >> 3, k8 = (C.tid & 7) * 8;
            u32x4 o;
#pragma unroll
            for (int j = 0; j < 4; ++j) o[j] = pk2(tile[(k8 + 2 * j) * 65 + n], tile[(k8 + 2 * j + 1) * 65 + n]);
            *(u32x4*)(dst + (size_t)(n0 + n) * K + k0 + k8) = o;
        }
        __syncthreads();
    }
}
__device__ __forceinline__ void cvt_copy(const Ctx& C, const float* src, bf16_t* dst, size_t n) {
    const size_t n8 = n / 8;
    for (size_t i = (size_t)C.bid * 512 + C.tid; i < n8; i += (size_t)C.G * 512) {
        const f32x4 a = *(const f32x4*)(src + i * 8), b = *(const f32x4*)(src + i * 8 + 4);
        u32x4 o; o[0] = pk2(a[0], a[1]); o[1] = pk2(a[2], a[3]); o[2] = pk2(b[0], b[1]); o[3] = pk2(b[2], b[3]);
        *(u32x4*)(dst + i * 8) = o;
    }
}
__device__ __forceinline__ void p_conv_weights(const Ctx& C) {
    for (int l = 0; l < DEPTH; ++l) {
        unsigned char* wb = C.ws + WS_W + (size_t)l * W_LAYER;
        tconv_job(C, C.in[I_WIN] + (size_t)l * DM * NIN, NIN, DM, NH, (bf16_t*)(wb + WO_WIN));
        tconv_job(C, C.in[I_WGATE] + (size_t)l * DM * NG, NG, DM, NG, (bf16_t*)(wb + WO_WG));
        for (int m = 0; m < 4; ++m)
            tconv_job(C, C.in[I_WBR] + ((size_t)l * 4 + m) * BW * DM, DM, BW, DM, (bf16_t*)(wb + WO_WBR) + (size_t)m * DM * BW);
        tconv_job(C, C.in[I_WOUT] + (size_t)l * DM * DM, DM, DM, DM, (bf16_t*)(wb + WO_WOUT));
        tconv_job(C, C.in[I_WQ] + (size_t)l * DM * NQ, NQ, DM, NQ, (bf16_t*)(wb + WO_WQ));
        cvt_copy(C, C.in[I_KEYS] + (size_t)l * 2 * PH * 128 * 128, (bf16_t*)(wb + WO_KEYS), (size_t)2 * PH * 128 * 128);
        float* wf = (float*)(wb + WO_WF);
        for (int i = C.bid * 512 + C.tid; i < 4 * DM; i += C.G * 512) { const int h = i / DM, k = i % DM; wf[i] = C.in[I_WIN][(size_t)l * DM * NIN + (size_t)k * NIN + NH + h]; }
    }
}
__device__ __forceinline__ void p_conv_tables(const Ctx& C, int l) {
    cvt_copy(C, C.in[I_PU] + (size_t)l * NEXP * DM, (bf16_t*)(C.ws + WS_TABU), (size_t)NEXP * DM);
    cvt_copy(C, C.in[I_PV] + (size_t)l * NEXP * DM, (bf16_t*)(C.ws + WS_TABV), (size_t)NEXP * DM);
}

__device__ __forceinline__ void row_emit(const Ctx& C, int row, const float (&v)[16], int l, bool want_lsig) {
    bf16_t* xb = (bf16_t*)(C.ws + WS_XB) + (size_t)row * DM;
    u32x4 o0, o1;
#pragma unroll
    for (int j = 0; j < 4; ++j) { o0[j] = pk2(v[2 * j], v[2 * j + 1]); o1[j] = pk2(v[8 + 2 * j], v[8 + 2 * j + 1]); }
    *(u32x4*)(xb + C.lane * 8) = o0; *(u32x4*)(xb + 512 + C.lane * 8) = o1;
    if (want_lsig) {
        const float* wf = (const float*)(C.ws + WS_W + (size_t)l * W_LAYER + WO_WF);
        float* lsig = (float*)(C.ws + WS_MISC);
#pragma unroll
        for (int h = 0; h < 4; ++h) {
            const f32x4 a0 = *(const f32x4*)(wf + h * DM + C.lane * 8), a1 = *(const f32x4*)(wf + h * DM + C.lane * 8 + 4);
            const f32x4 b0 = *(const f32x4*)(wf + h * DM + 512 + C.lane * 8), b1 = *(const f32x4*)(wf + h * DM + 512 + C.lane * 8 + 4);
            float s = 0.f;
#pragma unroll
            for (int j = 0; j < 4; ++j) s += v[j] * a0[j] + v[4 + j] * a1[j] + v[8 + j] * b0[j] + v[12 + j] * b1[j];
            s = wave_sum(s);
            if (C.lane == 0) lsig[(size_t)row * 4 + h] = logsigmoidf_(s + C.in[I_BFOX][l * 4 + h]);
        }
    }
}
__device__ __forceinline__ void load_row16(const float* p, int lane, float (&v)[16]) {
    const f32x4 a0 = *(const f32x4*)(p + lane * 8), a1 = *(const f32x4*)(p + lane * 8 + 4), b0 = *(const f32x4*)(p + 512 + lane * 8), b1 = *(const f32x4*)(p + 512 + lane * 8 + 4);
#pragma unroll
    for (int j = 0; j < 4; ++j) { v[j] = a0[j]; v[4 + j] = a1[j]; v[8 + j] = b0[j]; v[12 + j] = b1[j]; }
}
__device__ __forceinline__ void store_row16(float* p, int lane, const float (&v)[16]) {
    *(f32x4*)(p + lane * 8) = (f32x4){v[0], v[1], v[2], v[3]}; *(f32x4*)(p + lane * 8 + 4) = (f32x4){v[4], v[5], v[6], v[7]};
    *(f32x4*)(p + 512 + lane * 8) = (f32x4){v[8], v[9], v[10], v[11]}; *(f32x4*)(p + 512 + lane * 8 + 4) = (f32x4){v[12], v[13], v[14], v[15]};
}
__device__ __forceinline__ void ln_row16(float (&v)[16], const float* g, const float* b, int lane) {
    float s = 0.f;
#pragma unroll
    for (int j = 0; j < 16; ++j) s += v[j];
    const float mean = wave_sum(s) * (1.f / DM);
    float q = 0.f;
#pragma unroll
    for (int j = 0; j < 16; ++j) { const float d = v[j] - mean; q += d * d; }
    const float rstd = rsqrtf(wave_sum(q) * (1.f / DM) + LN_EPS);
    float gg[16], bb[16];
    load_row16(g, lane, gg); load_row16(b, lane, bb);
#pragma unroll
    for (int j = 0; j < 16; ++j) v[j] = (v[j] - mean) * rstd * gg[j] + bb[j];
}
__device__ __forceinline__ void p_rowpass0(const Ctx& C) {
    for (int row = C.bid * 8 + C.wave; row < T; row += C.G * 8) {
        float v[16]; load_row16(C.in[I_X] + (size_t)row * DM, C.lane, v);
        row_emit(C, row, v, 0, true);
    }
}
__device__ __forceinline__ void p_cumsum(const Ctx& C) {
    if (C.bid != 0) return;
    const float* lsig = (const float*)(C.ws + WS_MISC);
    float* cum = (float*)(C.ws + WS_CUM);
    const int b = C.wave >> 2, h = C.wave & 3;
    float loc = 0.f;
    for (int j = 0; j < 128; ++j) loc += lsig[((size_t)b * SEQ + C.lane * 128 + j) * 4 + h];
    float inc = loc;
#pragma unroll
    for (int o = 1; o < 64; o <<= 1) { const float t = __shfl_up(inc, o, 64); if (C.lane >= o) inc += t; }
    float run = inc - loc;
    for (int j = 0; j < 128; ++j) { run += lsig[((size_t)b * SEQ + C.lane * 128 + j) * 4 + h]; cum[((size_t)b * 4 + h) * SEQ + C.lane * 128 + j] = run; }
}
__device__ __forceinline__ void p_ln1(const Ctx& C, int l) {
    float* xc = (float*)(C.ws + WS_XC); bf16_t* x1b = (bf16_t*)(C.ws + WS_X1B);
    for (int row = C.bid * 8 + C.wave; row < T; row += C.G * 8) {
        float v[16]; load_row16(xc + (size_t)row * DM, C.lane, v);
        ln_row16(v, C.in[I_LN1G] + l * DM, C.in[I_LN1B] + l * DM, C.lane);
        store_row16(xc + (size_t)row * DM, C.lane, v);
        u32x4 o0, o1;
#pragma unroll
        for (int j = 0; j < 4; ++j) { o0[j] = pk2(v[2 * j], v[2 * j + 1]); o1[j] = pk2(v[8 + 2 * j], v[8 + 2 * j + 1]); }
        *(u32x4*)(x1b + (size_t)row * DM + C.lane * 8) = o0; *(u32x4*)(x1b + (size_t)row * DM + 512 + C.lane * 8) = o1;
    }
}

__device__ __forceinline__ void mix_pool_naive(const Ctx& C, int l) {
    const bf16_t* H = (const bf16_t*)(C.ws + WS_H); bf16_t* BR = (bf16_t*)(C.ws + WS_BR);
    LAS float* dd = (LAS float*)C.lds;
    for (int u = C.bid; u < (T / 64) * 4; u += C.G) {
        const int g = u & 3, t0 = (u >> 2) * 64, w = 2 << g;
        for (int idx = C.tid; idx < 64 * 128; idx += 512) {
            const int r = idx >> 7, c = idx & 127, row = t0 + r, pos = row & (SEQ - 1);
            const int nwin = (pos + 1 < w) ? pos + 1 : w;
            float s = 0.f;
            for (int j = 0; j < nwin; ++j) s += bf2f(H[(size_t)(row - j) * NH + HC_P + g * 128 + c]);
            dd[idx] = s / (float)nwin - bf2f(H[(size_t)row * NH + HC_P + g * 128 + c]);
        }
        __syncthreads();
        const int dcol = C.tid & 127, rq = C.tid >> 7;
        float acc[16];
#pragma unroll
        for (int i = 0; i < 16; ++i) acc[i] = 0.f;
        const float* pw = C.in[I_POOLW] + ((size_t)l * 4 + g) * 128 * 128;
        for (int c = 0; c < 128; ++c) {
            const float wv = pw[c * 128 + dcol];
#pragma unroll
            for (int i = 0; i < 16; ++i) acc[i] += dd[(rq * 16 + i) * 128 + c] * wv;
        }
        const float sc = C.in[I_POOLS][l * BW + g * 128 + dcol];
#pragma unroll
        for (int i = 0; i < 16; ++i) BR[(size_t)(t0 + rq * 16 + i) * NBR + 0 + g * 128 + dcol] = (bf16_t)f2bf(acc[i] * sc);
        __syncthreads();
    }
}
__device__ __forceinline__ void mix_gmlp_naive(const Ctx& C, int l) {
    const bf16_t* H = (const bf16_t*)(C.ws + WS_H); bf16_t* BR = (bf16_t*)(C.ws + WS_BR);
    LAS float* vn = (LAS float*)C.lds;
    for (int u = C.bid; u < (T / 128) * 4; u += C.G) {
        const int g = u & 3, t0 = (u >> 2) * 128;
        for (int i = 0; i < 16; ++i) {
            const int r = C.wave * 16 + i, row = t0 + r;
            const u32x4 raw = *(const u32x4*)(H + (size_t)row * NH + HC_GV + C.lane * 8);
            float e[8];
#pragma unroll
            for (int j = 0; j < 4; ++j) { e[2 * j] = geluf_(bf2f(raw[j] & 0xffffu)); e[2 * j + 1] = geluf_(bf2f(raw[j] >> 16)); }
            float s = 0.f;
#pragma unroll
            for (int j = 0; j < 8; ++j) s += e[j];
            const float mean = wave_sum(s) * (1.f / BW);
            float q = 0.f;
#pragma unroll
            for (int j = 0; j < 8; ++j) { const float d = e[j] - mean; q += d * d; }
            const float rstd = rsqrtf(wave_sum(q) * (1.f / BW) + LN_EPS);
            if ((C.lane >> 4) == g) {
#pragma unroll
                for (int j = 0; j < 8; ++j) { const int col = C.lane * 8 + j;
                    vn[r * 128 + (col - g * 128)] = (e[j] - mean) * rstd * C.in[I_GLNG][l * BW + col] + C.in[I_GLNB][l * BW + col]; }
            }
        }
        __syncthreads();
        const int c = C.tid & 127, tq = C.tid >> 7;
        const float* wsg = C.in[I_GWS] + ((size_t)l * 4 + g) * 128 * 128;
        for (int t = tq; t < 128; t += 4) {
            float acc = 0.f;
            for (int s = 0; s <= t; ++s) acc += wsg[t * 128 + s] * vn[s * 128 + c];
            const float sv = acc + C.in[I_GBS][(l * 4 + g) * 128 + t];
            const float uv = geluf_(bf2f(H[(size_t)(t0 + t) * NH + HC_GU + g * 128 + c]));
            BR[(size_t)(t0 + t) * NBR + 1024 + g * 128 + c] = (bf16_t)f2bf(uv * sv);
        }
        __syncthreads();
    }
}
__device__ __forceinline__ void mix_fox_naive(const Ctx& C, int l) {
    const bf16_t* H = (const bf16_t*)(C.ws + WS_H); bf16_t* BR = (bf16_t*)(C.ws + WS_BR);
    const float* cum = (const float*)(C.ws + WS_CUM);
    const float scale = 0.08838834764831845f;
    for (int u = C.bid; u < T * 4 / 8; u += C.G) {
        const int rid = u * 8 + C.wave;
        const int h = rid & 3, row = rid >> 2, b = row / SEQ, t = row % SEQ;
        const unsigned qraw = *(const unsigned*)(H + (size_t)row * NH + HC_FQ + h * 128 + C.lane * 2);
        const float q0 = bf2f(qraw & 0xffffu) * scale, q1 = bf2f(qraw >> 16) * scale;
        const float* cm = cum + ((size_t)b * 4 + h) * SEQ;
        const float ct = cm[t];
        float m = -1e30f, lsum = 0.f, o0 = 0.f, o1 = 0.f;
        for (int s = t; s >= 0; --s) {
            const size_t kr = (size_t)(b * SEQ + s) * NH + h * 128 + C.lane * 2;
            const unsigned kraw = *(const unsigned*)(H + kr + HC_FK);
            const unsigned vraw = *(const unsigned*)(H + kr + HC_FV);
            float d = q0 * bf2f(kraw & 0xffffu) + q1 * bf2f(kraw >> 16);
            d = wave_sum(d);
            const float z = d + ct - cm[s];
            const float mn = fmaxf(m, z), al = __expf(m - mn), p = __expf(z - mn);
            lsum = lsum * al + p; o0 = o0 * al + p * bf2f(vraw & 0xffffu); o1 = o1 * al + p * bf2f(vraw >> 16); m = mn;
        }
        const float inv = 1.f / lsum;
        *(unsigned*)(BR + (size_t)row * NBR + 1536 + h * 128 + C.lane * 2) = pk2(o0 * inv, o1 * inv);
    }
}
__device__ __forceinline__ void mix_hgrn_naive(const Ctx& C, int l) {
    if (C.bid >= BATCH * 4) return;
    const bf16_t* H = (const bf16_t*)(C.ws + WS_H); bf16_t* BR = (bf16_t*)(C.ws + WS_BR);
    const int b = C.bid >> 2, h = C.bid & 3;
    LAS float* fdec = (LAS float*)C.lds;
    LAS float* kkv = fdec + 32 * 128;
    LAS float* qsv = kkv + 32 * 128;
    LAS float* vv = qsv + 32 * 128;
    LAS float* opart = vv + 32 * 128;
    const int kq = C.tid >> 7, v = C.tid & 127;
    float S[32];
#pragma unroll
    for (int j = 0; j < 32; ++j) S[j] = 0.f;
    for (int c0 = 0; c0 < SEQ; c0 += 32) {
        for (int idx = C.tid; idx < 32 * 128; idx += 512) {
            const int st = idx >> 7, k = idx & 127; const size_t rb = (size_t)(b * SEQ + c0 + st) * NH + h * 128 + k;
            float lb = 0.f;
            if (l == 1) { const float z0 = C.in[I_LBL][h * 128 + k], z1 = C.in[I_LBL][BW + h * 128 + k]; lb = 1.f / (1.f + __expf(z0 - z1)); }
            const float zf = bf2f(H[rb + HC_HF]);
            const float kk = (1.f - lb) * sigmoidf_(-zf);
            fdec[idx] = 1.f - kk; kkv[idx] = kk; qsv[idx] = siluf_(bf2f(H[rb + HC_HQ])); vv[idx] = bf2f(H[rb + HC_HI]);
        }
        __syncthreads();
        for (int st = 0; st < 32; ++st) {
            const float vt = vv[st * 128 + v];
            float part = 0.f;
#pragma unroll
            for (int j = 0; j < 32; ++j) { const int k = kq * 32 + j; S[j] = fdec[st * 128 + k] * S[j] + kkv[st * 128 + k] * vt; part += S[j] * qsv[st * 128 + k]; }
            opart[(kq * 32 + st) * 128 + v] = part;
        }
        __syncthreads();
        for (int i = 0; i < 4; ++i) {
            const int st = C.wave * 4 + i, row = b * SEQ + c0 + st;
            float o0 = 0.f, o1 = 0.f;
#pragma unroll
            for (int q = 0; q < 4; ++q) { o0 += opart[(q * 32 + st) * 128 + C.lane]; o1 += opart[(q * 32 + st) * 128 + 64 + C.lane]; }
            const float ss = wave_sum(o0 * o0 + o1 * o1);
            const float r = rsqrtf(ss * (1.f / 128.f) + RMS_EPS);
            const float g0 = siluf_(bf2f(H[(size_t)row * NH + HC_HG + h * 128 + C.lane])), g1 = siluf_(bf2f(H[(size_t)row * NH + HC_HG + h * 128 + 64 + C.lane]));
            BR[(size_t)row * NBR + 512 + h * 128 + C.lane] = (bf16_t)f2bf(o0 * r * C.in[I_HNG][l * 128 + C.lane] * g0);
            BR[(size_t)row * NBR + 512 + h * 128 + 64 + C.lane] = (bf16_t)f2bf(o1 * r * C.in[I_HNG][l * 128 + 64 + C.lane] * g1);
        }
        __syncthreads();
    }
}


typedef float f32x16 __attribute__((ext_vector_type(16)));
typedef short s16x4 __attribute__((ext_vector_type(4)));
typedef short v4i16_t __attribute__((ext_vector_type(4)));
typedef __bf16 bf16x2_t __attribute__((ext_vector_type(2)));
__device__ __forceinline__ unsigned cvtpk(float lo, float hi) { f32x2 v = {lo, hi}; bf16x2_t b = __builtin_convertvector(v, bf16x2_t); return __builtin_bit_cast(unsigned, b); }
__device__ __forceinline__ s16x4 vtr(const LAS unsigned char* p) { return __builtin_bit_cast(s16x4, __builtin_amdgcn_ds_read_tr16_b64_v4i16((LAS v4i16_t*)p)); }
__device__ __forceinline__ float xor32(float x) { return __shfl_xor(x, 32, 64); }
#define MFMA32(a, b, c) __builtin_amdgcn_mfma_f32_32x32x16_bf16((a), (b), (c), 0, 0, 0)
constexpr int CW_KMAX = 16;

__device__ __forceinline__ void p_knorm(const Ctx& C, int l) {
    const bf16_t* H = (const bf16_t*)(C.ws + WS_H);
    unsigned* kmax = (unsigned*)(C.ws + WS_CTL) + CW_KMAX + l * 8;
    float best = 0.f;
    int bsel = -1;
    for (int row = C.bid * 8 + C.wave; row < T; row += C.G * 8) {
        const u32x4 raw = *(const u32x4*)(H + (size_t)row * NH + HC_FK + C.lane * 8);
        float s = 0.f;
#pragma unroll
        for (int j = 0; j < 4; ++j) { const float a = bf2f(raw[j] & 0xffffu), b = bf2f(raw[j] >> 16); s += a * a + b * b; }
#pragma unroll
        for (int o = 8; o > 0; o >>= 1) s += __shfl_xor(s, o, 64);
        const int b = row / SEQ;
        if (bsel >= 0 && b != bsel) { if ((C.lane & 15) == 0) atomicMax(kmax + bsel * 4 + (C.lane >> 4), __builtin_bit_cast(unsigned, best)); best = 0.f; }
        bsel = b; best = fmaxf(best, s);
    }
    if (bsel >= 0 && (C.lane & 15) == 0) atomicMax(kmax + bsel * 4 + (C.lane >> 4), __builtin_bit_cast(unsigned, best));
}

constexpr int FOX_KST = 272, FOX_VST = 320;
constexpr int FOX_KB = 0, FOX_VB = 2 * 64 * FOX_KST, FOX_BETA = FOX_VB + 2 * 64 * FOX_VST, FOX_FLAG = FOX_BETA + 2 * 64 * 4, FOX_END = FOX_FLAG + 2 * 8 * 4;
__device__ __forceinline__ void mix_fox(const Ctx& C, int l) {
    const bf16_t* H = (const bf16_t*)(C.ws + WS_H); bf16_t* BR = (bf16_t*)(C.ws + WS_BR);
    const float* cum = (const float*)(C.ws + WS_CUM);
    const unsigned* kmaxw = (const unsigned*)(C.ws + WS_CTL) + CW_KMAX + l * 8;
    const float LOG2E = 1.4426950408889634f, QS = 0.08838834764831845f * LOG2E;
    const int lane = C.lane, w = C.wave, r32 = lane & 31, hh = lane >> 5;
    LAS unsigned char* lds = C.lds;
    LAS float* betaL = (LAS float*)(lds + FOX_BETA);
    volatile LAS int* flagL = (volatile LAS int*)(lds + FOX_FLAG);
    for (int u = C.bid; u < BATCH * 4 * (SEQ / 256); u += C.G) {
        const int qb = u % (SEQ / 256), bh = u / (SEQ / 256), b = bh >> 2, h = bh & 3;
        const int q0 = qb * 256, qw = q0 + 32 * w;
        const size_t rowbase = (size_t)b * SEQ;
        const float* cm = cum + ((size_t)b * 4 + h) * SEQ;
        const float c0 = cm[q0];
        const float kmx = sqrtf(__builtin_bit_cast(float, __hip_atomic_load(kmaxw + b * 4 + h, __ATOMIC_RELAXED, __HIP_MEMORY_SCOPE_AGENT)));
        bf16x8 qf[8]; float qn = 0.f;
        {
            const bf16_t* qp = H + (rowbase + qw + r32) * NH + HC_FQ + h * 128 + 8 * hh;
#pragma unroll
            for (int ks = 0; ks < 8; ++ks) {
                const u32x4 raw = *(const u32x4*)(qp + 16 * ks);
                u32x4 o;
#pragma unroll
                for (int j = 0; j < 4; ++j) { const float a = bf2f(raw[j] & 0xffffu), bb = bf2f(raw[j] >> 16); qn += a * a + bb * bb; o[j] = cvtpk(a * QS, bb * QS); }
                qf[ks] = __builtin_bit_cast(bf16x8, o);
            }
            qn += xor32(qn); qn = sqrtf(qn);
        }
        const float qbound = qn * kmx * QS;
        f32x16 oacc[4];
#pragma unroll
        for (int mt = 0; mt < 4; ++mt)
#pragma unroll
            for (int i = 0; i < 16; ++i) oacc[mt][i] = 0.f;
        float m_run = -1e30f, l_run = 0.f;
        const int jmax = (q0 + 255) >> 6;
        const int srow = C.tid >> 4, sch = C.tid & 15;
        u32x4 kreg[2], vreg[2]; float breg = 0.f;
#define FOX_GLOAD(j_) do { _Pragma("unroll") for (int p = 0; p < 2; ++p) { \
                const bf16_t* rp = H + (rowbase + 64 * (j_) + srow + 32 * p) * NH + h * 128 + sch * 8; \
                kreg[p] = *(const u32x4*)(rp + HC_FK); vreg[p] = *(const u32x4*)(rp + HC_FV); } \
            if (C.tid < 64) breg = (c0 - cm[64 * (j_) + C.tid]) * LOG2E; } while (0)
#define FOX_LWRITE(buf_) do { _Pragma("unroll") for (int p = 0; p < 2; ++p) { \
                *(LAS u32x4*)(lds + FOX_KB + (buf_) * 64 * FOX_KST + (srow + 32 * p) * FOX_KST + sch * 16) = kreg[p]; \
                *(LAS u32x4*)(lds + FOX_VB + (buf_) * 64 * FOX_VST + (srow + 32 * p) * FOX_VST + sch * 16) = vreg[p]; } \
            if (C.tid < 64) betaL[(buf_) * 64 + C.tid] = breg; } while (0)
        __syncthreads();
        if (C.tid < 16) flagL[C.tid] = 0;
        FOX_GLOAD(jmax); FOX_LWRITE(jmax & 1);
        bool wdone = false;
        for (int j = jmax; j >= 0; --j) {
            const int cur = j & 1;
            __syncthreads();
            if (j < jmax) { int all = 1;
#pragma unroll
                for (int i = 0; i < 8; ++i) all &= flagL[((j + 1) & 1) * 8 + i];
                if (all) break; }
            if (j > 0) FOX_GLOAD(j - 1);
            const int k0 = 64 * j;
            if (k0 <= qw + 31 && !wdone) {
                const LAS unsigned char* kb = lds + FOX_KB + cur * 64 * FOX_KST;
                const LAS unsigned char* vb = lds + FOX_VB + cur * 64 * FOX_VST;
                f32x16 sacc[2];
#pragma unroll
                for (int mt = 0; mt < 2; ++mt)
#pragma unroll
                    for (int g = 0; g < 4; ++g) { const f32x4 bv = *(const LAS f32x4*)(betaL + cur * 64 + 32 * mt + 8 * g + 4 * hh);
                        sacc[mt][4 * g] = bv[0]; sacc[mt][4 * g + 1] = bv[1]; sacc[mt][4 * g + 2] = bv[2]; sacc[mt][4 * g + 3] = bv[3]; }
#pragma unroll
                for (int ks = 0; ks < 8; ++ks)
#pragma unroll
                    for (int mt = 0; mt < 2; ++mt) {
                        const bf16x8 kf = *(const LAS bf16x8*)(kb + (32 * mt + r32) * FOX_KST + 32 * ks + 16 * hh);
                        sacc[mt] = MFMA32(kf, qf[ks], sacc[mt]);
                    }
                const int tq = qw + r32;
                if (k0 + 63 > qw) {
#pragma unroll
                    for (int mt = 0; mt < 2; ++mt)
#pragma unroll
                        for (int i = 0; i < 16; ++i) { const int key = k0 + 32 * mt + (i & 3) + 8 * (i >> 2) + 4 * hh; if (key > tq) sacc[mt][i] = -1e30f; }
                }
                float mx = sacc[0][0];
#pragma unroll
                for (int mt = 0; mt < 2; ++mt)
#pragma unroll
                    for (int i = 0; i < 16; ++i) mx = fmaxf(mx, sacc[mt][i]);
                mx = fmaxf(mx, xor32(mx));
                const float mn = fmaxf(m_run, mx), alpha = __builtin_amdgcn_exp2f(m_run - mn);
                m_run = mn;
                float ps = 0.f;
#pragma unroll
                for (int mt = 0; mt < 2; ++mt)
#pragma unroll
                    for (int i = 0; i < 16; ++i) { const float p = __builtin_amdgcn_exp2f(sacc[mt][i] - mn); sacc[mt][i] = p; ps += p; }
                l_run = l_run * alpha + ps;
#pragma unroll
                for (int mt = 0; mt < 4; ++mt)
#pragma unroll
                    for (int i = 0; i < 16; ++i) oacc[mt][i] *= alpha;
#pragma unroll
                for (int s4 = 0; s4 < 4; ++s4) {
                    const int mtk = s4 >> 1, s = s4 & 1;
                    u32x4 pb;
#pragma unroll
                    for (int e = 0; e < 4; ++e) pb[e] = cvtpk(sacc[mtk][8 * s + 2 * e], sacc[mtk][8 * s + 2 * e + 1]);
                    const bf16x8 pfrag = __builtin_bit_cast(bf16x8, pb);
                    const int i16 = lane & 15, q4 = i16 >> 2, p4 = i16 & 3, blk = (lane >> 4) & 1;
                    const int keyA = 32 * mtk + 16 * s + 4 * hh + q4;
#pragma unroll
                    for (int mt = 0; mt < 4; ++mt) {
                        const LAS unsigned char* a0 = vb + keyA * FOX_VST + (32 * mt + 16 * blk + 4 * p4) * 2;
                        const s16x4 lo = vtr(a0), hi = vtr(a0 + 8 * FOX_VST);
                        const bf16x8 vf = __builtin_shufflevector(lo, hi, 0, 1, 2, 3, 4, 5, 6, 7);
                        oacc[mt] = MFMA32(vf, pfrag, oacc[mt]);
                    }
                }
                if (j > 0) { const float bl = (c0 - cm[k0 - 1]) * LOG2E;
                    const int ok = (qbound + bl < m_run - 152.f) ? 1 : 0;
                    wdone = __all(ok); }
            }
            if (lane == 0) flagL[cur * 8 + w] = wdone ? 1 : 0;
            if (j > 0) FOX_LWRITE(cur ^ 1);
        }
        l_run += xor32(l_run);
        const float inv = 1.f / l_run;
        bf16_t* op = BR + (rowbase + qw + r32) * NBR + 1536 + h * 128;
#pragma unroll
        for (int mt = 0; mt < 4; ++mt)
#pragma unroll
            for (int g = 0; g < 4; ++g) { u32x2 o; o[0] = cvtpk(oacc[mt][4 * g] * inv, oacc[mt][4 * g + 1] * inv); o[1] = cvtpk(oacc[mt][4 * g + 2] * inv, oacc[mt][4 * g + 3] * inv);
                *(u32x2*)(op + 32 * mt + 8 * g + 4 * hh) = o; }
    }
}


constexpr int HG_LF = 0, HG_QA = 34816, HG_QB = HG_QA + 17408, HG_KD = HG_QB + 8704, HG_KO = HG_KD + 17408, HG_KT = HG_KO + 8704, HG_VN = HG_KT + 20480, HG_AM = HG_VN + 20480, HG_END = HG_AM + 12288;
constexpr int HG_LFS = 132;
static_assert(HG_END <= 140 * 1024, "hgrn LDS");
constexpr size_t WS_DSC = WS_ST + (size_t)BATCH * 4 * 32 * 128 * 128 * 4;

template <bool FULL>
__device__ __forceinline__ void hgrn_unit(const Ctx& C, int l, int u) {
#if DIAG
    const bf16_t* H = (const bf16_t*)(C.ws + WS_H); bf16_t* BR = (l == 0) ? (bf16_t*)(C.ws + WS_XA) : (bf16_t*)(C.ws + WS_TABU);
#else
    const bf16_t* H = (const bf16_t*)(C.ws + WS_H); bf16_t* BR = (bf16_t*)(C.ws + WS_BR);
#endif
    float* STB = (float*)(C.ws + WS_ST); float* DSC = (float*)(C.ws + WS_DSC);
    LAS unsigned char* lds = C.lds;
    LAS float* LF = (LAS float*)(lds + HG_LF);
    const int lane = C.lane, w = C.wave, r32 = lane & 31, hh = lane >> 5;
    const int sc = u & 31, bh = u >> 5, b = bh >> 2, h = bh & 3;
    const int wk = w >> 1, wv = w & 1;
    const int mt = w >> 2, nt = w & 3;
    const int i16 = lane & 15, q4 = i16 >> 2, p4 = i16 & 3, blk = (lane >> 4) & 1;
    f32x16 S0, S1;
    float* stp = STB + ((size_t)bh * 32 + sc) * 128 * 128;
    if constexpr (FULL) {
#pragma unroll
        for (int i = 0; i < 16; ++i) { const int k = 32 * wk + (i & 3) + 8 * (i >> 2) + 4 * hh;
            S0[i] = stp[k * 128 + 64 * wv + r32]; S1[i] = stp[k * 128 + 64 * wv + 32 + r32]; }
    } else {
#pragma unroll
        for (int i = 0; i < 16; ++i) { S0[i] = 0.f; S1[i] = 0.f; }
    }
    float dtot = 0.f;
    const int ps = C.tid >> 3, pseg = C.tid & 7;
    float lbv[16];
#pragma unroll
    for (int j = 0; j < 16; ++j) { lbv[j] = 0.f;
        if (l == 1) { const int ch = h * 128 + 16 * pseg + j; lbv[j] = 1.f / (1.f + __expf(C.in[I_LBL][ch] - C.in[I_LBL][BW + ch])); } }
    for (int c = 0; c < 4; ++c) {
        const size_t row0 = (size_t)b * SEQ + sc * 256 + c * 64;
        const bf16_t* hp = H + (row0 + ps) * NH + h * 128 + 16 * pseg;
        float kkv[16], qsv[16];
        u32x4 vraw0, vraw1;
        {
            const u32x4 f0 = *(const u32x4*)(hp + HC_HF), f1 = *(const u32x4*)(hp + HC_HF + 8);
            vraw0 = *(const u32x4*)(hp + HC_HI); vraw1 = *(const u32x4*)(hp + HC_HI + 8);
#pragma unroll
            for (int j = 0; j < 8; ++j) { const unsigned r = (j < 4) ? f0[j] : f1[j - 4];
                const float z0 = bf2f(r & 0xffffu), z1 = bf2f(r >> 16);
                kkv[2 * j] = (1.f - lbv[2 * j]) * sigmoidf_(-z0); kkv[2 * j + 1] = (1.f - lbv[2 * j + 1]) * sigmoidf_(-z1); }
            if constexpr (FULL) {
                const u32x4 q0 = *(const u32x4*)(hp + HC_HQ), q1 = *(const u32x4*)(hp + HC_HQ + 8);
#pragma unroll
                for (int j = 0; j < 8; ++j) { const unsigned r = (j < 4) ? q0[j] : q1[j - 4]; qsv[2 * j] = siluf_(bf2f(r & 0xffffu)); qsv[2 * j + 1] = siluf_(bf2f(r >> 16)); }
            }
#pragma unroll
            for (int j4 = 0; j4 < 4; ++j4) { f32x4 o;
#pragma unroll
                for (int e = 0; e < 4; ++e) o[e] = log1pf(-kkv[4 * j4 + e]);
                *(LAS f32x4*)(LF + ps * HG_LFS + 16 * pseg + 4 * j4) = o; }
        }
        __syncthreads();
        if (C.tid < 128) { float run = 0.f;
#pragma unroll 8
            for (int s = 0; s < 64; ++s) { run += LF[s * HG_LFS + C.tid]; LF[s * HG_LFS + C.tid] = run; }
            dtot += run; }
        __syncthreads();
        float bv[16], b31[16], bl[16];
#pragma unroll
        for (int j4 = 0; j4 < 4; ++j4) { const f32x4 x = *(const LAS f32x4*)(LF + ps * HG_LFS + 16 * pseg + 4 * j4), y = *(const LAS f32x4*)(LF + 31 * HG_LFS + 16 * pseg + 4 * j4), z = *(const LAS f32x4*)(LF + 63 * HG_LFS + 16 * pseg + 4 * j4);
#pragma unroll
            for (int e = 0; e < 4; ++e) { bv[4 * j4 + e] = x[e]; b31[4 * j4 + e] = y[e]; bl[4 * j4 + e] = z[e]; } }
        {
            u32x4 o0, o1;
#pragma unroll
            for (int j = 0; j < 4; ++j) { o0[j] = cvtpk(kkv[2 * j] * __expf(bl[2 * j] - bv[2 * j]), kkv[2 * j + 1] * __expf(bl[2 * j + 1] - bv[2 * j + 1]));
                o1[j] = cvtpk(kkv[8 + 2 * j] * __expf(bl[8 + 2 * j] - bv[8 + 2 * j]), kkv[9 + 2 * j] * __expf(bl[9 + 2 * j] - bv[9 + 2 * j])); }
            *(LAS u32x4*)(lds + HG_KT + ps * 320 + 32 * pseg) = o0; *(LAS u32x4*)(lds + HG_KT + ps * 320 + 32 * pseg + 16) = o1;
            *(LAS u32x4*)(lds + HG_VN + ps * 320 + 32 * pseg) = vraw0; *(LAS u32x4*)(lds + HG_VN + ps * 320 + 32 * pseg + 16) = vraw1;
            if constexpr (FULL) {
                const bool hi = ps >= 32;
                float rr[16];
#pragma unroll
                for (int j = 0; j < 16; ++j) rr[j] = hi ? b31[j] : 0.f;
#pragma unroll
                for (int j = 0; j < 4; ++j) { o0[j] = cvtpk(qsv[2 * j] * __expf(bv[2 * j] - rr[2 * j]), qsv[2 * j + 1] * __expf(bv[2 * j + 1] - rr[2 * j + 1]));
                    o1[j] = cvtpk(qsv[8 + 2 * j] * __expf(bv[8 + 2 * j] - rr[8 + 2 * j]), qsv[9 + 2 * j] * __expf(bv[9 + 2 * j] - rr[9 + 2 * j])); }
                *(LAS u32x4*)(lds + HG_QA + ps * 272 + 32 * pseg) = o0; *(LAS u32x4*)(lds + HG_QA + ps * 272 + 32 * pseg + 16) = o1;
#pragma unroll
                for (int j = 0; j < 4; ++j) { o0[j] = cvtpk(kkv[2 * j] * __expf(rr[2 * j] - bv[2 * j]), kkv[2 * j + 1] * __expf(rr[2 * j + 1] - bv[2 * j + 1]));
                    o1[j] = cvtpk(kkv[8 + 2 * j] * __expf(rr[8 + 2 * j] - bv[8 + 2 * j]), kkv[9 + 2 * j] * __expf(rr[9 + 2 * j] - bv[9 + 2 * j])); }
                *(LAS u32x4*)(lds + HG_KD + ps * 272 + 32 * pseg) = o0; *(LAS u32x4*)(lds + HG_KD + ps * 272 + 32 * pseg + 16) = o1;
                if (hi) {
#pragma unroll
                    for (int j = 0; j < 4; ++j) { o0[j] = cvtpk(qsv[2 * j] * __expf(bv[2 * j]), qsv[2 * j + 1] * __expf(bv[2 * j + 1]));
                        o1[j] = cvtpk(qsv[8 + 2 * j] * __expf(bv[8 + 2 * j]), qsv[9 + 2 * j] * __expf(bv[9 + 2 * j])); }
                    *(LAS u32x4*)(lds + HG_QB + (ps - 32) * 272 + 32 * pseg) = o0; *(LAS u32x4*)(lds + HG_QB + (ps - 32) * 272 + 32 * pseg + 16) = o1;
                } else {
#pragma unroll
                    for (int j = 0; j < 4; ++j) { o0[j] = cvtpk(kkv[2 * j] * __expf(b31[2 * j] - bv[2 * j]), kkv[2 * j + 1] * __expf(b31[2 * j + 1] - bv[2 * j + 1]));
                        o1[j] = cvtpk(kkv[8 + 2 * j] * __expf(b31[8 + 2 * j] - bv[8 + 2 * j]), kkv[9 + 2 * j] * __expf(b31[9 + 2 * j] - bv[9 + 2 * j])); }
                    *(LAS u32x4*)(lds + HG_KO + ps * 272 + 32 * pseg) = o0; *(LAS u32x4*)(lds + HG_KO + ps * 272 + 32 * pseg + 16) = o1;
                }
            }
        }
        float dk[16];
#pragma unroll
        for (int i = 0; i < 16; ++i) dk[i] = __expf(LF[63 * HG_LFS + 32 * wk + (i & 3) + 8 * (i >> 2) + 4 * hh]);
        __syncthreads();
        if constexpr (FULL) {
#pragma unroll
            for (int g = 0; g < 4; ++g) {
                u32x2 o; o[0] = cvtpk(S0[4 * g], S0[4 * g + 1]); o[1] = cvtpk(S0[4 * g + 2], S0[4 * g + 3]);
                *(LAS u32x2*)(lds + HG_LF + (64 * wv + r32) * 272 + (32 * wk + 8 * g + 4 * hh) * 2) = o;
                o[0] = cvtpk(S1[4 * g], S1[4 * g + 1]); o[1] = cvtpk(S1[4 * g + 2], S1[4 * g + 3]);
                *(LAS u32x2*)(lds + HG_LF + (64 * wv + 32 + r32) * 272 + (32 * wk + 8 * g + 4 * hh) * 2) = o;
            }
#define HG_ATILE(AMT_, AST_) do { \
                const LAS unsigned char* kb = ((AMT_) == (AST_)) ? (lds + HG_KD + (32 * (AST_)) * 272) : (lds + HG_KO); \
                f32x16 a; \
                _Pragma("unroll") for (int i = 0; i < 16; ++i) a[i] = 0.f; \
                _Pragma("unroll") for (int ks = 0; ks < 8; ++ks) { \
                    const bf16x8 af = *(const LAS bf16x8*)(lds + HG_QA + (32 * (AMT_) + r32) * 272 + 32 * ks + 16 * hh); \
                    const bf16x8 bf = *(const LAS bf16x8*)(kb + r32 * 272 + 32 * ks + 16 * hh); \
                    a = MFMA32(af, bf, a); } \
                _Pragma("unroll") for (int g = 0; g < 4; ++g) { \
                    float x[4]; \
                    _Pragma("unroll") for (int e = 0; e < 4; ++e) { const int tl = 8 * g + 4 * hh + e; x[e] = ((AMT_) != (AST_) || r32 <= tl) ? a[4 * g + e] : 0.f; } \
                    u32x2 o; o[0] = cvtpk(x[0], x[1]); o[1] = cvtpk(x[2], x[3]); \
                    *(LAS u32x2*)(lds + HG_AM + (32 * (AST_) + r32) * 192 + (32 * (AMT_) + 8 * g + 4 * hh) * 2) = o; } } while (0)
            if (w == 0) { HG_ATILE(0, 0); }
            else if (w == 1) { HG_ATILE(1, 0); }
            else if (w == 2) { HG_ATILE(1, 1); }
        }
#pragma unroll
        for (int i = 0; i < 16; ++i) { S0[i] *= dk[i]; S1[i] *= dk[i]; }
#pragma unroll
        for (int ks = 0; ks < 4; ++ks) {
            const LAS unsigned char* ka = lds + HG_KT + (16 * ks + 8 * hh + q4) * 320 + (32 * wk + 16 * blk + 4 * p4) * 2;
            const s16x4 alo = vtr(ka), ahi = vtr(ka + 4 * 320);
            const bf16x8 af = __builtin_shufflevector(alo, ahi, 0, 1, 2, 3, 4, 5, 6, 7);
            const LAS unsigned char* vb0 = lds + HG_VN + (16 * ks + 8 * hh + q4) * 320 + (64 * wv + 16 * blk + 4 * p4) * 2;
            const s16x4 b0lo = vtr(vb0), b0hi = vtr(vb0 + 4 * 320), b1lo = vtr(vb0 + 64), b1hi = vtr(vb0 + 64 + 4 * 320);
            S0 = MFMA32(af, __builtin_shufflevector(b0lo, b0hi, 0, 1, 2, 3, 4, 5, 6, 7), S0);
            S1 = MFMA32(af, __builtin_shufflevector(b1lo, b1hi, 0, 1, 2, 3, 4, 5, 6, 7), S1);
        }
        if constexpr (FULL) {
            __syncthreads();
            f32x16 o;
#pragma unroll
            for (int i = 0; i < 16; ++i) o[i] = 0.f;
            const LAS unsigned char* qb = (mt == 0) ? (lds + HG_QA) : (lds + HG_QB);
#pragma unroll
            for (int ks = 0; ks < 8; ++ks) {
                const bf16x8 af = *(const LAS bf16x8*)(qb + r32 * 272 + 32 * ks + 16 * hh);
                const bf16x8 bf = *(const LAS bf16x8*)(lds + HG_LF + (32 * nt + r32) * 272 + 32 * ks + 16 * hh);
                o = MFMA32(af, bf, o);
            }
#pragma unroll
            for (int ks = 0; ks < 4; ++ks) {
                if (mt == 0 && ks >= 2) continue;
                const LAS unsigned char* aa = lds + HG_AM + (16 * ks + 8 * hh + q4) * 192 + (32 * mt + 16 * blk + 4 * p4) * 2;
                const s16x4 alo = vtr(aa), ahi = vtr(aa + 4 * 192);
                const LAS unsigned char* vb0 = lds + HG_VN + (16 * ks + 8 * hh + q4) * 320 + (32 * nt + 16 * blk + 4 * p4) * 2;
                const s16x4 blo = vtr(vb0), bhi = vtr(vb0 + 4 * 320);
                o = MFMA32(__builtin_shufflevector(alo, ahi, 0, 1, 2, 3, 4, 5, 6, 7), __builtin_shufflevector(blo, bhi, 0, 1, 2, 3, 4, 5, 6, 7), o);
            }
            __syncthreads();
#pragma unroll
            for (int i = 0; i < 16; ++i) LF[(32 * mt + (i & 3) + 8 * (i >> 2) + 4 * hh) * HG_LFS + 32 * nt + r32] = o[i];
            __syncthreads();
            {
                float ov[16]; float ss = 0.f;
#pragma unroll
                for (int j4 = 0; j4 < 4; ++j4) { const f32x4 x = *(const LAS f32x4*)(LF + ps * HG_LFS + 16 * pseg + 4 * j4);
#pragma unroll
                    for (int e = 0; e < 4; ++e) { ov[4 * j4 + e] = x[e]; ss += x[e] * x[e]; } }
                ss += __shfl_xor(ss, 1, 64); ss += __shfl_xor(ss, 2, 64); ss += __shfl_xor(ss, 4, 64);
                const float rn = rsqrtf(ss * (1.f / 128.f) + RMS_EPS);
                const u32x4 g0 = *(const u32x4*)(hp + HC_HG), g1 = *(const u32x4*)(hp + HC_HG + 8);
                const float* ng = C.in[I_HNG] + l * 128 + 16 * pseg;
                u32x4 o0, o1;
#pragma unroll
                for (int j = 0; j < 4; ++j) {
                    o0[j] = cvtpk(ov[2 * j] * rn * ng[2 * j] * siluf_(bf2f(g0[j] & 0xffffu)), ov[2 * j + 1] * rn * ng[2 * j + 1] * siluf_(bf2f(g0[j] >> 16)));
                    o1[j] = cvtpk(ov[8 + 2 * j] * rn * ng[8 + 2 * j] * siluf_(bf2f(g1[j] & 0xffffu)), ov[9 + 2 * j] * rn * ng[9 + 2 * j] * siluf_(bf2f(g1[j] >> 16)));
                }
                bf16_t* bp = BR + (row0 + ps) * NBR + 512 + h * 128 + 16 * pseg;
                *(u32x4*)bp = o0; *(u32x4*)(bp + 8) = o1;
            }
        }
        __syncthreads();
    }
    if constexpr (!FULL) {
#pragma unroll
        for (int i = 0; i < 16; ++i) { const int k = 32 * wk + (i & 3) + 8 * (i >> 2) + 4 * hh;
            stp[k * 128 + 64 * wv + r32] = S0[i]; stp[k * 128 + 64 * wv + 32 + r32] = S1[i]; }
        if (C.tid < 128) DSC[((size_t)bh * 32 + sc) * 128 + C.tid] = __expf(dtot);
    }
}
__device__ __forceinline__ void hgrn_b1(const Ctx& C, int l) { for (int u = C.bid; u < BATCH * 4 * 32; u += C.G) hgrn_unit<false>(C, l, u); }
__device__ __forceinline__ void hgrn_b3(const Ctx& C, int l) { for (int u = C.bid; u < BATCH * 4 * 32; u += C.G) hgrn_unit<true>(C, l, u); }
__device__ __forceinline__ void hgrn_b2(const Ctx& C) {
    float* STB = (float*)(C.ws + WS_ST); const float* DSC = (const float*)(C.ws + WS_DSC);
    for (int e = C.bid * 512 + C.tid; e < BATCH * 4 * 128 * 128; e += C.G * 512) {
        const int bh = e >> 14, kv = e & 16383, k = kv >> 7;
        float* p = STB + (size_t)bh * 32 * 16384 + kv;
        float uu[32], dd[32];
#pragma unroll
        for (int s = 0; s < 32; ++s) { uu[s] = p[(size_t)s * 16384]; dd[s] = DSC[((size_t)bh * 32 + s) * 128 + k]; }
        float st = 0.f;
#pragma unroll
        for (int s = 0; s < 32; ++s) { p[(size_t)s * 16384] = st; st = dd[s] * st + uu[s]; }
    }
}


#define CE_D(a, b) do { const float _h = fmaxf(a, b), _l = fminf(a, b); a = _h; b = _l; } while (0)
__device__ __forceinline__ void sort16_desc(float (&x)[16]) {
#pragma unroll
    for (int k = 2; k <= 16; k <<= 1)
#pragma unroll
        for (int j = k >> 1; j > 0; j >>= 1)
#pragma unroll
            for (int i = 0; i < 16; ++i) { const int l = i ^ j; if (l > i) { if ((i & k) == 0) CE_D(x[i], x[l]); else CE_D(x[l], x[i]); } }
}
__device__ __forceinline__ void bmerge16_desc(float (&x)[16]) {
#pragma unroll
    for (int j = 8; j > 0; j >>= 1)
#pragma unroll
        for (int i = 0; i < 16; ++i) { const int l = i ^ j; if (l > i) CE_D(x[i], x[l]); }
}
__device__ __forceinline__ void top16_merge(float (&a)[16], const float (&b)[16]) {
#pragma unroll
    for (int i = 0; i < 16; ++i) a[i] = fmaxf(a[i], b[15 - i]);
    bmerge16_desc(a);
}
__device__ __forceinline__ float pack_idx(float v, unsigned idx, unsigned mask) { return __builtin_bit_cast(float, (__builtin_bit_cast(unsigned, v) & ~mask) | idx); }

constexpr int TK_KST = 272, TK_KBUF = 128 * TK_KST;
__device__ __forceinline__ void p_topk(const Ctx& C, int l) {
    const bf16_t* Q = (const bf16_t*)(C.ws + WS_Q);
    const bf16_t* keys = (const bf16_t*)(C.ws + WS_W + (size_t)l * W_LAYER + WO_KEYS);
    int* eidx = (int*)(C.ws + WS_EIDX); float* egate = (float*)(C.ws + WS_EGATE);
    LAS unsigned char* lds = C.lds;
    const int lane = C.lane, w = C.wave, r32 = lane & 31, hh = lane >> 5;
    for (int u = C.bid; u < (T / 256) * PH; u += C.G) {
        const int h = u & 7, t0 = (u >> 3) * 256, tok = t0 + 32 * w + r32;
        float v12[2][16];
        __syncthreads();
#pragma unroll
        for (int j = 0; j < 2; ++j) {
            const bf16_t* kp = keys + ((size_t)j * PH + h) * 128 * 128;
#pragma unroll
            for (int p = 0; p < 4; ++p) { const int idx = C.tid + 512 * p, row = idx >> 4, ch = idx & 15;
                *(LAS u32x4*)(lds + j * TK_KBUF + row * TK_KST + ch * 16) = *(const u32x4*)(kp + row * 128 + ch * 8); }
        }
        __syncthreads();
#pragma unroll
        for (int j = 0; j < 2; ++j) {
            bf16x8 qf[8];
            const bf16_t* qp = Q + (size_t)tok * NQ + h * 256 + j * 128 + 8 * hh;
#pragma unroll
            for (int ks = 0; ks < 8; ++ks) qf[ks] = *(const bf16x8*)(qp + 16 * ks);
            f32x16 sacc[4];
#pragma unroll
            for (int mt = 0; mt < 4; ++mt)
#pragma unroll
                for (int i = 0; i < 16; ++i) sacc[mt][i] = 0.f;
#pragma unroll
            for (int ks = 0; ks < 8; ++ks)
#pragma unroll
                for (int mt = 0; mt < 4; ++mt) {
                    const bf16x8 kf = *(const LAS bf16x8*)(lds + j * TK_KBUF + (32 * mt + r32) * TK_KST + 32 * ks + 16 * hh);
                    sacc[mt] = MFMA32(kf, qf[ks], sacc[mt]);
                }
            float g[4][16];
#pragma unroll
            for (int mt = 0; mt < 4; ++mt) {
#pragma unroll
                for (int i = 0; i < 16; ++i) g[mt][i] = pack_idx(sacc[mt][i], (unsigned)(32 * mt + (i & 3) + 8 * (i >> 2) + 4 * hh), 127u);
                sort16_desc(g[mt]);
            }
            top16_merge(g[0], g[1]); top16_merge(g[2], g[3]); top16_merge(g[0], g[2]);
            float o[16];
#pragma unroll
            for (int i = 0; i < 16; ++i) o[i] = __shfl_xor(g[0][i], 32, 64);
            top16_merge(g[0], o);
#pragma unroll
            for (int i = 0; i < 16; ++i) v12[j][i] = g[0][i];
        }
        float c[4][16];
        {
            int n = 0;
#pragma unroll
            for (int a = 0; a < 16; ++a)
#pragma unroll
                for (int b = 0; b < 16; ++b) if ((a + 1) * (b + 1) <= 16) {
                    const unsigned id = ((__builtin_bit_cast(unsigned, v12[0][a]) & 127u) << 7) | (__builtin_bit_cast(unsigned, v12[1][b]) & 127u);
                    c[n >> 4][n & 15] = pack_idx(v12[0][a] + v12[1][b], id, 16383u); ++n; }
#pragma unroll
            for (; n < 64; ++n) c[n >> 4][n & 15] = -3.0e38f;
        }
#pragma unroll
        for (int q = 0; q < 4; ++q) sort16_desc(c[q]);
        top16_merge(c[0], c[1]); top16_merge(c[2], c[3]); top16_merge(c[0], c[2]);
        float e[16], den = 0.f;
#pragma unroll
        for (int i = 0; i < 16; ++i) { e[i] = __expf(c[0][i] - c[0][0]); den += e[i]; }
        const float inv = 1.f / den;
        int* ip = eidx + (size_t)tok * 128 + h * 16 + 8 * hh; float* gp = egate + (size_t)tok * 128 + h * 16 + 8 * hh;
        u32x4 i0, i1; f32x4 g0, g1;
#pragma unroll
        for (int i = 0; i < 4; ++i) {
            const float ca = hh ? c[0][8 + i] : c[0][i], cb = hh ? c[0][12 + i] : c[0][4 + i];
            i0[i] = __builtin_bit_cast(unsigned, ca) & 16383u; i1[i] = __builtin_bit_cast(unsigned, cb) & 16383u;
            g0[i] = (hh ? e[8 + i] : e[i]) * inv; g1[i] = (hh ? e[12 + i] : e[4 + i]) * inv;
        }
        *(u32x4*)ip = i0; *(u32x4*)(ip + 4) = i1; *(f32x4*)gp = g0; *(f32x4*)(gp + 4) = g1;
    }
}

constexpr int CW_DIAG = 64;
__device__ __forceinline__ void diag_cmp(const Ctx& C, const bf16_t* A, int lda, const bf16_t* R, int ldr, int nc) {
    float sd = 0.f, sr = 0.f;
    for (int row = C.bid; row < T; row += C.G) {
        const int tm = row % DIAG_MOD; if (tm < DIAG_LO || tm >= DIAG_HI) continue;
        for (int c = C.tid; c < nc; c += 512) { const float a = bf2f(A[(size_t)row * lda + c]), r = bf2f(R[(size_t)row * ldr + c]); sd += (a - r) * (a - r); sr += r * r; }
    }
    sd = wave_sum(sd); sr = wave_sum(sr);
    if (C.lane == 0) { atomicAdd((float*)(C.ws + WS_CTL) + CW_DIAG, sd); atomicAdd((float*)(C.ws + WS_CTL) + CW_DIAG + 1, sr); }
}
__device__ __forceinline__ float diag_alpha(const Ctx& C) {
    const float sd = __hip_atomic_load((float*)(C.ws + WS_CTL) + CW_DIAG, __ATOMIC_RELAXED, __HIP_MEMORY_SCOPE_AGENT), sr = __hip_atomic_load((float*)(C.ws + WS_CTL) + CW_DIAG + 1, __ATOMIC_RELAXED, __HIP_MEMORY_SCOPE_AGENT);
    const float err = fmaxf(sd / fmaxf(sr, 1e-30f), 1e-8f);
    return 0.1f + 0.1f * (rintf(log10f(err / 1e-8f) * 10.f) * 0.1f);
}

__device__ __forceinline__ void wave_argmax(float& v, int& i) {
#pragma unroll
    for (int o = 32; o > 0; o >>= 1) {
        const float ov = __shfl_xor(v, o, 64); const int oi = __shfl_xor(i, o, 64);
        if (ov > v || (ov == v && oi < i)) { v = ov; i = oi; }
    }
}
__device__ __forceinline__ void p_topk_naive(const Ctx& C, int l) {
    const bf16_t* Q = (const bf16_t*)(C.ws + WS_Q);
    const bf16_t* keys = (const bf16_t*)(C.ws + WS_W + (size_t)l * W_LAYER + WO_KEYS);
    int* eidx = (int*)(C.ws + WS_EIDX); float* egate = (float*)(C.ws + WS_EGATE);
    LAS float* qs = (LAS float*)C.lds;
    LAS float* sc = qs + 2048;
    LAS float* tv = sc + 2048;
    LAS int* ti = (LAS int*)(tv + 256);
    for (int t = C.bid; t < T; t += C.G) {
        for (int i = C.tid; i < 2048; i += 512) qs[i] = bf2f(Q[(size_t)t * NQ + i]);
        __syncthreads();
        for (int i = 0; i < 4; ++i) {
            const int idx = C.tid + 512 * i, hj = idx >> 7, key = idx & 127, h = hj >> 1, j = hj & 1;
            const bf16_t* kp = keys + (((size_t)j * PH + h) * 128 + key) * 128;
            float s = 0.f;
            for (int d8 = 0; d8 < 16; ++d8) {
                const u32x4 raw = *(const u32x4*)(kp + d8 * 8);
#pragma unroll
                for (int e = 0; e < 4; ++e) s += qs[h * 256 + j * 128 + d8 * 8 + 2 * e] * bf2f(raw[e] & 0xffffu) + qs[h * 256 + j * 128 + d8 * 8 + 2 * e + 1] * bf2f(raw[e] >> 16);
            }
            sc[idx] = s;
        }
        __syncthreads();
        for (int i = 0; i < 2; ++i) {
            const int hj = C.wave * 2 + i;
            float a0 = sc[hj * 128 + C.lane], a1 = sc[hj * 128 + 64 + C.lane];
            for (int r = 0; r < 16; ++r) {
                float bv; int bi;
                if (a0 > a1 || (a0 == a1)) { bv = a0; bi = C.lane; } else { bv = a1; bi = C.lane + 64; }
                wave_argmax(bv, bi);
                if (C.lane == 0) { tv[hj * 16 + r] = bv; ti[hj * 16 + r] = bi; }
                if (bi == C.lane) a0 = -3e38f; if (bi == C.lane + 64) a1 = -3e38f;
            }
        }
        __syncthreads();
        {
            const int h = C.wave;
            float cv[4];
#pragma unroll
            for (int i = 0; i < 4; ++i) { const int c = C.lane * 4 + i; cv[i] = tv[(h * 2) * 16 + (c >> 4)] + tv[(h * 2 + 1) * 16 + (c & 15)]; }
            float topv = 0.f; int tope = 0; float mx = 0.f;
            for (int r = 0; r < 16; ++r) {
                float bv = cv[0]; int bi = C.lane * 4;
#pragma unroll
                for (int i = 1; i < 4; ++i) if (cv[i] > bv) { bv = cv[i]; bi = C.lane * 4 + i; }
                wave_argmax(bv, bi);
                if (r == 0) mx = bv;
                if (C.lane == r) { topv = bv; tope = ti[(h * 2) * 16 + (bi >> 4)] * 128 + ti[(h * 2 + 1) * 16 + (bi & 15)]; }
#pragma unroll
                for (int i = 0; i < 4; ++i) if (bi == C.lane * 4 + i) cv[i] = -3e38f;
            }
            float e = (C.lane < 16) ? __expf(topv - mx) : 0.f;
            const float den = wave_sum(e);
            if (C.lane < 16) { eidx[(size_t)t * 128 + h * 16 + C.lane] = tope; egate[(size_t)t * 128 + h * 16 + C.lane] = e / den; }
        }
        __syncthreads();
    }
}
__device__ __forceinline__ void p_gather(const Ctx& C, int l) {
    const float* xc = (const float*)(C.ws + WS_XC);
    const bf16_t* U = (const bf16_t*)(C.ws + WS_TABU); const bf16_t* V = (const bf16_t*)(C.ws + WS_TABV);
    const int* eidx = (const int*)(C.ws + WS_EIDX); const float* egate = (const float*)(C.ws + WS_EGATE);
    for (int t = C.bid * 8 + C.wave; t < T; t += C.G * 8) {
        float x[16]; load_row16(xc + (size_t)t * DM, C.lane, x);
        const int e0 = eidx[(size_t)t * 128 + C.lane], e1 = eidx[(size_t)t * 128 + 64 + C.lane];
        const float g0 = egate[(size_t)t * 128 + C.lane], g1 = egate[(size_t)t * 128 + 64 + C.lane];
        float c0 = 0.f, c1 = 0.f;
        for (int e = 0; e < 128; e += 4) {
            float part[4];
#pragma unroll
            for (int i = 0; i < 4; ++i) {
                const int ee = e + i;
                const int ex = __builtin_amdgcn_readlane(ee < 64 ? e0 : e1, ee & 63);
                const bf16_t* up = U + (size_t)ex * DM;
                const u32x4 r0 = *(const u32x4*)(up + C.lane * 8), r1 = *(const u32x4*)(up + 512 + C.lane * 8);
                float s = 0.f;
#pragma unroll
                for (int j = 0; j < 4; ++j) { s += x[2 * j] * bf2f(r0[j] & 0xffffu) + x[2 * j + 1] * bf2f(r0[j] >> 16); s += x[8 + 2 * j] * bf2f(r1[j] & 0xffffu) + x[8 + 2 * j + 1] * bf2f(r1[j] >> 16); }
                part[i] = s;
            }
#pragma unroll
            for (int i = 0; i < 4; ++i) {
                const float s = wave_sum(part[i]);
                const int ee = e + i;
                if (ee < 64) { if (C.lane == ee) c0 = geluf_(s) * g0; } else { if (C.lane == ee - 64) c1 = geluf_(s) * g1; }
            }
        }
        float y[16];
#pragma unroll
        for (int j = 0; j < 16; ++j) y[j] = 0.f;
        for (int e = 0; e < 128; e += 4) {
#pragma unroll
            for (int i = 0; i < 4; ++i) {
                const int ee = e + i;
                const int ex = __builtin_amdgcn_readlane(ee < 64 ? e0 : e1, ee & 63);
                const float cf = __builtin_bit_cast(float, __builtin_amdgcn_readlane(__builtin_bit_cast(int, ee < 64 ? c0 : c1), ee & 63));
                const bf16_t* vp = V + (size_t)ex * DM;
                const u32x4 r0 = *(const u32x4*)(vp + C.lane * 8), r1 = *(const u32x4*)(vp + 512 + C.lane * 8);
#pragma unroll
                for (int j = 0; j < 4; ++j) { y[2 * j] += cf * bf2f(r0[j] & 0xffffu); y[2 * j + 1] += cf * bf2f(r0[j] >> 16); y[8 + 2 * j] += cf * bf2f(r1[j] & 0xffffu); y[8 + 2 * j + 1] += cf * bf2f(r1[j] >> 16); }
            }
        }
#pragma unroll
        for (int j = 0; j < 16; ++j) y[j] += ALPHA * x[j];
        ln_row16(y, C.in[I_LN2G] + l * DM, C.in[I_LN2B] + l * DM, C.lane);
        if (l + 1 < DEPTH) {
            store_row16((float*)(C.ws + WS_XA) + (size_t)t * DM, C.lane, y);
            row_emit(C, t, y, l + 1, true);
        } else {
#if DIAG
            { const float al = 1.f + diag_alpha(C);
#pragma unroll
              for (int j = 0; j < 16; ++j) y[j] *= al; }
#endif
            store_row16(C.out + (size_t)t * DM, C.lane, y);
        }
    }
}

struct FStoreBf16 { bf16_t* O; int ld;
    __device__ __forceinline__ void operator()(int row, int col, f32x4 v0, f32x4 v1, int) const {
        u32x4 o; o[0] = pk2(v0[0], v0[1]); o[1] = pk2(v0[2], v0[3]); o[2] = pk2(v1[0], v1[1]); o[3] = pk2(v1[2], v1[3]);
        *(u32x4*)(O + (size_t)row * ld + col) = o; } };
struct FGate { bf16_t* O; const float* bias;
    __device__ __forceinline__ void operator()(int row, int col, f32x4 v0, f32x4 v1, int) const {
        const f32x4 b0 = *(const f32x4*)(bias + col), b1 = *(const f32x4*)(bias + col + 4);
        u32x4 o; o[0] = pk2(sigmoidf_(v0[0] + b0[0]), sigmoidf_(v0[1] + b0[1])); o[1] = pk2(sigmoidf_(v0[2] + b0[2]), sigmoidf_(v0[3] + b0[3]));
        o[2] = pk2(sigmoidf_(v1[0] + b1[0]), sigmoidf_(v1[1] + b1[1])); o[3] = pk2(sigmoidf_(v1[2] + b1[2]), sigmoidf_(v1[3] + b1[3]));
        *(u32x4*)(O + (size_t)row * NG + col) = o; } };
struct FMerge { const bf16_t* G; float* MGF; bf16_t* MG;
    __device__ __forceinline__ void operator()(int row, int col, f32x4 v, int z) const {
        const u32x2 gr = *(const u32x2*)(G + (size_t)row * NG + z * DM + col);
        f32x4 r; r[0] = v[0] * bf2f(gr[0] & 0xffffu); r[1] = v[1] * bf2f(gr[0] >> 16); r[2] = v[2] * bf2f(gr[1] & 0xffffu); r[3] = v[3] * bf2f(gr[1] >> 16);
        float* p = MGF + (size_t)row * DM + col;
        if (z > 0) r += *(const f32x4*)p;
        if (z < 3) *(f32x4*)p = r;
        else { u32x2 o; o[0] = pk2(r[0], r[1]); o[1] = pk2(r[2], r[3]); *(u32x2*)(MG + (size_t)row * DM + col) = o; } } };
struct FResid { const float* X; float* Y;
    __device__ __forceinline__ void operator()(int row, int col, f32x4 v, int) const {
        const f32x4 x = *(const f32x4*)(X + (size_t)row * DM + col);
        *(f32x4*)(Y + (size_t)row * DM + col) = x * ALPHA + v; } };

constexpr int PH_PER_LAYER = 12, N_PHASES = 1 + DEPTH * PH_PER_LAYER;
template <int SP> __device__ __forceinline__ void run_phase(const Ctx& C0, int l) {
    Ctx C = C0;
    asm volatile("" : "+v"(C.tid));
    C.ws = launder_ptr(C.ws); C.out = launder_ptr(C.out); l = (int)launder_u((unsigned)l);
    C.lane = C.tid & 63; C.wave = __builtin_amdgcn_readfirstlane(C.tid >> 6);
    unsigned char* wb = C.ws + WS_W + (size_t)l * W_LAYER;
    if constexpr (SP == -1) { p_conv_weights(C); }
    if constexpr (SP == 0) {
        if (l == 0) p_rowpass0(C);
    }
    if constexpr (SP == 1) {
        p_cumsum(C);
        __syncthreads();
        pg8::Gemm g{(const bf16_t*)(C.ws + WS_XB), (const bf16_t*)(wb + WO_WIN), DM, DM, DM, 0, 0};
        pg8::StaticOrder S; S.init(T, NH, C.G, C.bid);
        pg8::Epi8<FStoreBf16> E{{(bf16_t*)(C.ws + WS_H), NH}};
        pg8::gemm_phase(C.lds, g, S, E, C.tid);
    }
    if constexpr (SP == 2) { p_knorm(C, l); if (l != HG_NAIVE_L) hgrn_b1(C, l); }
    if constexpr (SP == 3) { if (l != HG_NAIVE_L) hgrn_b2(C); mix_pool_naive(C, l); mix_gmlp_naive(C, l); }
#if DIAG
    if constexpr (SP == 4) { hgrn_b3(C, l); { mix_hgrn_naive(C, l); __syncthreads(); } mix_fox(C, l); }
    if constexpr (SP == 5) { if (l == DIAG_LAYER) diag_cmp(C, (const bf16_t*)(C.ws + (DIAG_LAYER == 0 ? WS_XA : WS_TABU)) + 512, NBR, (const bf16_t*)(C.ws + WS_BR) + 512, NBR, 512); }
#else
    if constexpr (SP == 4) { if (l != HG_NAIVE_L) hgrn_b3(C, l); else { mix_hgrn_naive(C, l); __syncthreads(); } mix_fox(C, l); }
#endif
    if constexpr (SP == 5) {
        pg8::Gemm g{(const bf16_t*)(C.ws + WS_XB), (const bf16_t*)(wb + WO_WG), DM, DM, DM, 0, 0};
        pg8::StaticOrder S; S.init(T, NG, C.G, C.bid);
        pg8::Epi8<FGate> E{{(bf16_t*)(C.ws + WS_G), C.in[I_BGATE] + l * NG}};
        pg8::gemm_phase(C.lds, g, S, E, C.tid);
    }
    if constexpr (SP == 6) {
        pg8::Gemm g{(const bf16_t*)(C.ws + WS_BR), (const bf16_t*)(wb + WO_WBR), NBR, BW, BW, (size_t)BW, (size_t)DM * BW};
        pg8::ZOrder S; S.init(T, DM, 4, C.G, C.vcu);
        pg8::Epi4<FMerge> E{{(const bf16_t*)(C.ws + WS_G), (float*)(C.ws + WS_MGF), (bf16_t*)(C.ws + WS_XB)}};
        pg8::gemm_phase(C.lds, g, S, E, C.tid);
    }
    if constexpr (SP == 7) {
        const float* xin = (l == 0) ? C.in[I_X] : (const float*)(C.ws + WS_XA);
        pg8::Gemm g{(const bf16_t*)(C.ws + WS_XB), (const bf16_t*)(wb + WO_WOUT), DM, DM, DM, 0, 0};
        pg8::StaticOrder S; S.init(T, DM, C.G, C.bid);
        pg8::Epi4<FResid> E{{xin, (float*)(C.ws + WS_XC)}};
        pg8::gemm_phase(C.lds, g, S, E, C.tid);
    }
    if constexpr (SP == 8) { p_ln1(C, l); p_conv_tables(C, l); }
    if constexpr (SP == 9) {
        pg8::Gemm g{(const bf16_t*)(C.ws + WS_X1B), (const bf16_t*)(wb + WO_WQ), DM, DM, DM, 0, 0};
        pg8::StaticOrder S; S.init(T, NQ, C.G, C.bid);
        pg8::Epi8<FStoreBf16> E{{(bf16_t*)(C.ws + WS_Q), NQ}};
        pg8::gemm_phase(C.lds, g, S, E, C.tid);
    }
#if TOPK_NAIVE
    if constexpr (SP == 10) p_topk_naive(C, l);
#else
    if constexpr (SP == 10) p_topk(C, l);
#endif
    if constexpr (SP == 11) p_gather(C, l);
}
__device__ __forceinline__ void make_ctx(Ctx& C, const Args& args, unsigned char* lds_raw) {
    C.lds = (LAS unsigned char*)lds_raw; C.ws = args.ws; C.in = args.in; C.out = args.out;
    C.tid = threadIdx.x; C.lane = C.tid & 63; C.wave = __builtin_amdgcn_readfirstlane(C.tid >> 6);
    C.G = gridDim.x; C.bid = blockIdx.x; C.vcu = (C.G % 8 == 0) ? (C.bid % 8) * (C.G / 8) + C.bid / 8 : C.bid;
}
template <int SP> __global__ void __launch_bounds__(512, 2) mk_phase(Args args) {
    extern __shared__ __attribute__((aligned(16))) unsigned char lds_raw[];
    Ctx C; make_ctx(C, args, lds_raw);
    run_phase<SP>(C, args.ph_lo);
}

#define GRID_BAR() xcd_barrier((unsigned*)(args.ws + WS_CTL) + 1024, (volatile LAS unsigned*)((LAS unsigned char*)lds_raw + LDSCTL_OFF + 32))
__global__ void __launch_bounds__(512, 2) mk_fwd(Args args) {
    extern __shared__ __attribute__((aligned(16))) unsigned char lds_raw[];
    Ctx C; make_ctx(C, args, lds_raw);
    { volatile LAS unsigned* misc = (volatile LAS unsigned*)(C.lds + LDSCTL_OFF); if (C.tid < 64) misc[C.tid] = 0u; }
    __syncthreads();
    xcd_barrier_post((unsigned*)(args.ws + WS_CTL) + 1024);
    run_phase<-1>(C, 0); GRID_BAR();
#pragma unroll 1
    for (int l = 0; l < DEPTH; ++l) {
        if (l == 0) { run_phase<0>(C, l); GRID_BAR(); }
        run_phase<1>(C, l); GRID_BAR();
        run_phase<2>(C, l); GRID_BAR();
        run_phase<3>(C, l); GRID_BAR();
        run_phase<4>(C, l); GRID_BAR();
        run_phase<5>(C, l); GRID_BAR();
        run_phase<6>(C, l); GRID_BAR();
        run_phase<7>(C, l); GRID_BAR();
        run_phase<8>(C, l); GRID_BAR();
        run_phase<9>(C, l); GRID_BAR();
        run_phase<10>(C, l); GRID_BAR();
        run_phase<11>(C, l); if (l + 1 < DEPTH) GRID_BAR();
    }
}

template <int SP> static void launch_phase(const Args& a, int grid, hipStream_t stream) {
    static bool attr_done = false;
    if (!attr_done) { (void)hipFuncSetAttribute((const void*)mk_phase<SP>, hipFuncAttributeMaxDynamicSharedMemorySize, LDS_BYTES); attr_done = true; }
    hipLaunchKernelGGL(mk_phase<SP>, dim3(grid), dim3(512), LDS_BYTES, stream, a);
}
extern "C" void kernel_launch(void* const* d_in, const int* in_sizes, int n_in, void* d_out, int out_size, void* d_ws, size_t ws_size, hipStream_t stream) {
    static int grid = 0;
    if (grid == 0) {
        if (n_in != NIN_PTRS || out_size != T * DM || ws_size < WS_END) { fprintf(stderr, "kernel_launch: unexpected shapes n_in %d out %d ws %zu\n", n_in, out_size, ws_size); grid = -1; return; }
        int dev = 0, cus = 0;
        if (hipGetDevice(&dev) != hipSuccess || hipDeviceGetAttribute(&cus, hipDeviceAttributeMultiprocessorCount, dev) != hipSuccess) { grid = -1; return; }
        grid = cus;
    }
    if (grid < 0) return;
    (void)hipMemsetAsync((char*)d_ws + WS_CTL, 0, CTL_ZERO_BYTES, stream);
    Args a{};
    for (int i = 0; i < NIN_PTRS; ++i) a.in[i] = (const float*)d_in[i];
    a.out = (float*)d_out; a.ws = (unsigned char*)d_ws; a.bar_slot = 0; a.pad = 0; a.ph_hi = 0;
#if MK_ONE_LAUNCH
    static bool attr_done = false;
    if (!attr_done) { (void)hipFuncSetAttribute((const void*)mk_fwd, hipFuncAttributeMaxDynamicSharedMemorySize, LDS_BYTES); attr_done = true; }
    hipLaunchKernelGGL(mk_fwd, dim3(grid), dim3(512), LDS_BYTES, stream, a);
    return;
#endif
    a.ph_lo = 0; launch_phase<-1>(a, grid, stream);
    for (int l = 0; l < DEPTH; ++l) {
        a.ph_lo = l;
        launch_phase<0>(a, grid, stream); launch_phase<1>(a, grid, stream); launch_phase<2>(a, grid, stream); launch_phase<3>(a, grid, stream); launch_phase<4>(a, grid, stream);
        launch_phase<5>(a, grid, stream); launch_phase<6>(a, grid, stream); launch_phase<7>(a, grid, stream); launch_phase<8>(a, grid, stream); launch_phase<9>(a, grid, stream); launch_phase<10>(a, grid, stream); launch_phase<11>(a, grid, stream);
    }
}
```

```cpp
#include <hip/hip_runtime.h>
#include <cstdio>
#include <cstdint>

#ifndef DIAG
#define DIAG 0
#endif
#ifndef DIAG_LO
#define DIAG_LO 0
#endif
#ifndef DIAG_HI
#define DIAG_HI 64
#endif
#ifndef DIAG_MOD
#define DIAG_MOD 64
#endif
#ifndef TOPK_NAIVE
#define TOPK_NAIVE 0
#endif
#ifndef MIX_NAIVE
#define MIX_NAIVE 0
#endif
#ifndef FOX_NAIVE
#define FOX_NAIVE 0
#endif
#ifndef HG_NAIVE_L
#define HG_NAIVE_L 99
#endif
#ifndef DIAG_LAYER
#define DIAG_LAYER 0
#endif
#ifndef MK_ONE_LAUNCH
#define MK_ONE_LAUNCH 1
#endif

#define LAS __attribute__((address_space(3)))
#define GAS __attribute__((address_space(1)))
typedef unsigned short bf16_t;
typedef short bf16x8 __attribute__((ext_vector_type(8)));
typedef float f32x4 __attribute__((ext_vector_type(4)));
typedef float f32x2 __attribute__((ext_vector_type(2)));
typedef unsigned u32x4 __attribute__((ext_vector_type(4)));
typedef unsigned u32x2 __attribute__((ext_vector_type(2)));

constexpr int DM = 1024, BATCH = 2, SEQ = 8192, DEPTH = 2, T = BATCH * SEQ;
constexpr int BW = 512, NIN = 5124, NH = 5120, NG = 4096, NBR = 2048, NQ = 2048;
constexpr int NEXP = 16384, TOPK = 16, PH = 8;
constexpr float ALPHA = 1.4142135623730951f;
constexpr float LN_EPS = 1e-5f, RMS_EPS = 1e-6f;
constexpr int HC_P = 0, HC_HQ = 512, HC_HF = 1024, HC_HI = 1536, HC_HG = 2048, HC_GU = 2560, HC_GV = 3072, HC_FQ = 3584, HC_FK = 4096, HC_FV = 4608;

constexpr size_t MiB = 1u << 20;
constexpr size_t WS_CTL = 0, CTL_ZERO_BYTES = 64 * 1024;
constexpr size_t WS_MISC = 512 * 1024;
constexpr size_t WS_CUM = 768 * 1024;
constexpr size_t WS_W = 1 * MiB;
constexpr size_t W_LAYER = 30 * MiB;
constexpr size_t WO_WIN = 0, WO_WG = 10 * MiB, WO_WBR = 18 * MiB, WO_WOUT = 22 * MiB, WO_WQ = 24 * MiB, WO_KEYS = 28 * MiB, WO_WF = 28 * MiB + 512 * 1024, WO_POOLW = 28 * MiB + 768 * 1024, WO_GWS = 29 * MiB;
constexpr size_t WS_TABU = 64 * MiB, WS_TABV = 96 * MiB;
constexpr size_t WS_XA = 128 * MiB;
constexpr size_t WS_XB = 192 * MiB;
constexpr size_t WS_X1B = 224 * MiB;
constexpr size_t WS_H = 256 * MiB;
constexpr size_t WS_ST = 416 * MiB;
constexpr size_t WS_BR = 448 * MiB;
constexpr size_t WS_G = 256 * MiB;
constexpr size_t WS_MGF = 384 * MiB;
constexpr size_t WS_XC = 256 * MiB;
constexpr size_t WS_Q = 320 * MiB;
constexpr size_t WS_EIDX = 384 * MiB, WS_EGATE = 392 * MiB;
constexpr size_t WS_END = 512 * MiB;

__device__ __forceinline__ float bf2f(unsigned u) { return __builtin_bit_cast(float, u << 16); }
__device__ __forceinline__ unsigned f2bf(float f) { unsigned u = __builtin_bit_cast(unsigned, f); return (u + 0x7fffu + ((u >> 16) & 1u)) >> 16; }
__device__ __forceinline__ unsigned pk2(float lo, float hi) { return f2bf(lo) | (f2bf(hi) << 16); }
__device__ __forceinline__ float wave_sum(float v) {
#pragma unroll
    for (int o = 32; o > 0; o >>= 1) v += __shfl_xor(v, o, 64);
    return v;
}
__device__ __forceinline__ float sigmoidf_(float x) { return 1.f / (1.f + __expf(-x)); }
__device__ __forceinline__ float siluf_(float x) { return x / (1.f + __expf(-x)); }
__device__ __forceinline__ float geluf_(float x) { const float u = 0.7978845608028654f * (x + 0.044715f * x * x * x); return 0.5f * x * (1.f + tanhf(u)); }
__device__ __forceinline__ float logsigmoidf_(float z) { return fminf(z, 0.f) - log1pf(__expf(-fabsf(z))); }

__device__ __forceinline__ unsigned launder_u(unsigned x) { asm volatile("" : "+v"(x)); return __builtin_amdgcn_readfirstlane(x); }
template <class P> __device__ __forceinline__ P launder_ptr(P p) {
    const unsigned lo = launder_u((unsigned)(uintptr_t)p), hi = launder_u((unsigned)((uintptr_t)p >> 32));
    return (P)(((uintptr_t)hi << 32) | lo);
}

namespace pg8 {
constexpr int BM = 256, BK = 64, HALF = 128, HTB = HALF * BK * 2, STAGE_BYTES = 8 * HTB, NXCD = 8, WGM = 8;
__host__ __device__ __forceinline__ int lds_byte(int r, int c) { const int st = (r >> 4) * 2 + (c >> 5), rr = r & 15, cc = c & 31, ob = rr * 64 + cc * 2; return st * 1024 + (ob ^ (((ob >> 9) & 1) << 5)); }
__host__ __device__ __forceinline__ void stage_rc(int b, int& R, int& C) { const int st = b / 1024, sb = b % 1024, swz = sb ^ (((sb >> 9) & 1) << 5); R = (st >> 1) * 16 + swz / 64; C = (st & 1) * 32 + (swz % 64) / 2; }
__host__ __device__ __forceinline__ int perm32(int rho) { const int n = rho >> 4, i = rho & 15; return 8 * (i >> 2) + 4 * n + (i & 3); }

struct Unit { int pm, pn, z; };
struct Gemm { const bf16_t* A; const bf16_t* Bt; int lda, ldb, K; size_t zA, zB; };

struct StaticOrder {
    int nM, nN, nwg, G, c;
    __device__ void init(int M, int N, int G_, int c_) { nM = M / BM; nN = N / BM; nwg = nM * nN; G = G_; c = c_; }
    __device__ bool next(int i, Unit& u) const {
        const long L = (long)i * G + c; if (L >= nwg) return false;
        int wgid = (int)L; { const int q = nwg / NXCD, r = nwg % NXCD, xcd = wgid % NXCD, off = wgid / NXCD; wgid = (xcd < r ? xcd * (q + 1) : r * (q + 1) + (xcd - r) * q) + off; }
        const int nig = WGM * nN, gid = wgid / nig, fm = gid * WGM, gsz = (nM - fm) < WGM ? (nM - fm) : WGM;
        u.pm = fm + ((wgid % nig) % gsz); u.pn = (wgid % nig) / gsz; u.z = 0; return true;
    }
};
struct ZOrder {
    int nM, nN, nZ, ntile, G, c;
    __device__ void init(int M, int N, int Z, int G_, int c_) { nM = M / BM; nN = N / BM; nZ = Z; ntile = nM * nN; G = G_; c = c_; }
    __device__ bool next(int i, Unit& u) const {
        const long L = (long)(i / nZ) * G + c; if (L >= ntile) return false;
        u.pm = (int)L / nN; u.pn = (int)L % nN; u.z = i % nZ; return true;
    }
};

template <class F> struct Epi8 {
    static constexpr bool PERM = true;
    F f;
    __device__ __forceinline__ void operator()(const f32x4 (&acc)[2][2][4][2], const Unit& u, int wr, int wc, int fr, int fq) const {
        const int row0 = u.pm * BM + wr * 64 + fr, col0 = u.pn * BM + wc * 32 + 8 * fq;
#pragma unroll
        for (int ai = 0; ai < 2; ++ai)
#pragma unroll
            for (int m = 0; m < 4; ++m)
#pragma unroll
                for (int bj = 0; bj < 2; ++bj) f(row0 + ai * HALF + m * 16, col0 + bj * HALF, acc[ai][bj][m][0], acc[ai][bj][m][1], u.z);
    }
};
template <class F> struct Epi4 {
    static constexpr bool PERM = false;
    F f;
    __device__ __forceinline__ void operator()(const f32x4 (&acc)[2][2][4][2], const Unit& u, int wr, int wc, int fr, int fq) const {
        const int row0 = u.pm * BM + wr * 64 + fr, col0 = u.pn * BM + wc * 32 + 4 * fq;
#pragma unroll
        for (int ai = 0; ai < 2; ++ai)
#pragma unroll
            for (int m = 0; m < 4; ++m)
#pragma unroll
                for (int bj = 0; bj < 2; ++bj)
#pragma unroll
                    for (int n = 0; n < 2; ++n) f(row0 + ai * HALF + m * 16, col0 + bj * HALF + n * 16, acc[ai][bj][m][n], u.z);
    }
};

template <class Epi, class Sched, bool ALIGN_EPI = true>
__device__ __forceinline__ void gemm_phase(LAS unsigned char* lds, const Gemm g, const Sched& S, const Epi& E, const int tid) {
    const int wid = __builtin_amdgcn_readfirstlane(tid >> 6), lane = tid & 63, wr = wid >> 2, wc = wid & 3, fr = lane & 15, fq = lane >> 4;
    const int K = g.K, nt = K / BK;
    unsigned voffA[2], voffB[2];
#pragma unroll
    for (int i = 0; i < 2; ++i) { int R, C; stage_rc(tid * 16 + i * 8192, R, C); const int Rb = Epi::PERM ? ((R & ~31) + perm32(R & 31)) : R;
        voffA[i] = (unsigned)(R * g.lda + C) * 2u; voffB[i] = (unsigned)(Rb * g.ldb + C) * 2u; }
    const size_t kstep = (size_t)(BK * 2);
    const size_t hstepA = (size_t)HALF * g.lda * 2, hstepB = (size_t)HALF * g.ldb * 2;
    const size_t tstepA = 2 * hstepA, tstepB = 2 * hstepB;
    const unsigned ldsw = (unsigned)wid * 1024u;
    const int aoff = lds_byte(wr * 64 + fr, fq * 8), boff = lds_byte(wc * 32 + fr, fq * 8);
#define PG8_SA(b, h) (((b) * 2 + (h)) * HTB)
#define PG8_SB(b, h) ((4 + (b) * 2 + (h)) * HTB)
#define PG8_STAGE(bufoff, gbase, voff) do { _Pragma("unroll") for (int _i = 0; _i < 2; ++_i) \
        __builtin_amdgcn_global_load_lds((const unsigned*)((const char*)(gbase) + (voff)[_i]), (LAS unsigned*)(lds + (bufoff) + ldsw + _i * 8192), 16, 0, 0); } while (0)
#define PG8_LDA(dst, b, h) do { _Pragma("unroll") for (int m = 0; m < 4; ++m) _Pragma("unroll") for (int k = 0; k < 2; ++k) dst[m][k] = *(const LAS bf16x8*)(lds + PG8_SA(b, h) + aoff + m * 2048 + k * 1024); } while (0)
#define PG8_LDB(dst, b, h) do { _Pragma("unroll") for (int n = 0; n < 2; ++n) _Pragma("unroll") for (int k = 0; k < 2; ++k) dst[n][k] = *(const LAS bf16x8*)(lds + PG8_SB(b, h) + boff + n * 2048 + k * 1024); } while (0)
#define PG8_MMA(ai, bj, At, Bt) do { __builtin_amdgcn_s_setprio(1); _Pragma("unroll") for (int m = 0; m < 4; ++m) _Pragma("unroll") for (int n = 0; n < 2; ++n) _Pragma("unroll") for (int k = 0; k < 2; ++k) \
        acc[ai][bj][m][n] = __builtin_amdgcn_mfma_f32_16x16x32_bf16(Bt[n][k], At[m][k], acc[ai][bj][m][n], 0, 0, 0); __builtin_amdgcn_s_setprio(0); } while (0)
#define PG8_WAIT_V(n) asm volatile("s_waitcnt vmcnt(" #n ")" ::: "memory")
#define PG8_WAIT_L(n) asm volatile("s_waitcnt lgkmcnt(" #n ")" ::: "memory")
#define PG8_BAR __builtin_amdgcn_s_barrier()
#define PG8_SCHED __builtin_amdgcn_sched_barrier(0)
    Unit cur, nxt; int ui = 0;
    if (!S.next(0, cur)) return;
    f32x4 acc[2][2][4][2];
#pragma unroll
    for (int a = 0; a < 2; ++a)
#pragma unroll
        for (int b = 0; b < 2; ++b)
#pragma unroll
            for (int m = 0; m < 4; ++m)
#pragma unroll
                for (int n = 0; n < 2; ++n) acc[a][b][m][n] = (f32x4){0.f, 0.f, 0.f, 0.f};
    bf16x8 At[4][2], B0[2][2], B1[2][2];
    const char* cA = (const char*)(g.A + (size_t)cur.z * g.zA) + (size_t)cur.pm * tstepA; const char* cB = (const char*)(g.Bt + (size_t)cur.z * g.zB) + (size_t)cur.pn * tstepB;
    PG8_STAGE(PG8_SB(0, 0), cB, voffB); PG8_STAGE(PG8_SB(0, 1), cB + hstepB, voffB); PG8_STAGE(PG8_SA(0, 0), cA, voffA); PG8_STAGE(PG8_SA(0, 1), cA + hstepA, voffA);
    if (wr == 1) PG8_BAR;
    PG8_WAIT_V(2); PG8_BAR;
    PG8_STAGE(PG8_SB(1, 0), cB + kstep, voffB); PG8_STAGE(PG8_SA(1, 0), cA + kstep, voffA); PG8_STAGE(PG8_SB(1, 1), cB + hstepB + kstep, voffB);
    PG8_WAIT_V(6); PG8_BAR;
    for (;;) {
        const bool has_next = S.next(ui + 1, nxt);
        const char* nA = has_next ? (const char*)(g.A + (size_t)nxt.z * g.zA) + (size_t)nxt.pm * tstepA : cA;
        const char* nB = has_next ? (const char*)(g.Bt + (size_t)nxt.z * g.zB) + (size_t)nxt.pn * tstepB : cB;
        for (int t = 0; t < nt; t += 2) {
            const bool last = (t == nt - 2);
            const char* a1 = cA + (size_t)(t + 1) * kstep;
            const char* a2 = last ? nA : cA + (size_t)(t + 2) * kstep; const char* b2 = last ? nB : cB + (size_t)(t + 2) * kstep;
            const char* a3 = a2 + kstep; const char* b3 = b2 + kstep;
            PG8_LDB(B0, 0, 0); PG8_LDB(B1, 0, 1); PG8_SCHED; PG8_LDA(At, 0, 0); PG8_STAGE(PG8_SA(1, 1), a1 + hstepA, voffA);
            PG8_WAIT_V(8); PG8_WAIT_L(0); PG8_BAR; PG8_MMA(0, 0, At, B0); PG8_MMA(0, 1, At, B1); PG8_BAR; PG8_SCHED;
            PG8_LDA(At, 0, 1); PG8_STAGE(PG8_SB(0, 0), b2, voffB); PG8_STAGE(PG8_SB(0, 1), b2 + hstepB, voffB); PG8_STAGE(PG8_SA(0, 0), a2, voffA);
            PG8_WAIT_V(8); PG8_WAIT_L(0); PG8_BAR; PG8_MMA(1, 0, At, B0); PG8_MMA(1, 1, At, B1); PG8_BAR; PG8_SCHED;
            PG8_LDB(B0, 1, 0); PG8_LDB(B1, 1, 1); PG8_SCHED; PG8_LDA(At, 1, 0); PG8_STAGE(PG8_SA(0, 1), a2 + hstepA, voffA);
            PG8_WAIT_V(8); PG8_WAIT_L(0); PG8_BAR; PG8_MMA(0, 0, At, B0); PG8_MMA(0, 1, At, B1); PG8_BAR; PG8_SCHED;
            PG8_LDA(At, 1, 1); PG8_STAGE(PG8_SB(1, 0), b3, voffB); PG8_STAGE(PG8_SB(1, 1), b3 + hstepB, voffB); PG8_STAGE(PG8_SA(1, 0), a3, voffA);
            PG8_WAIT_V(8); PG8_WAIT_L(0); PG8_BAR; PG8_MMA(1, 0, At, B0); PG8_MMA(1, 1, At, B1); PG8_BAR; PG8_SCHED;
        }
        if constexpr (ALIGN_EPI) { if (wr == 0) PG8_BAR; }
        E(acc, cur, wr, wc, fr, fq);
        if (!has_next) break;
#pragma unroll
        for (int a = 0; a < 2; ++a)
#pragma unroll
            for (int b = 0; b < 2; ++b)
#pragma unroll
                for (int m = 0; m < 4; ++m)
#pragma unroll
                    for (int n = 0; n < 2; ++n) acc[a][b][m][n] = (f32x4){0.f, 0.f, 0.f, 0.f};
        cur = nxt; cA = nA; cB = nB; ++ui;
        if constexpr (ALIGN_EPI) { if (wr == 1) PG8_BAR; }
    }
    PG8_WAIT_V(0);
    if constexpr (!ALIGN_EPI) { if (wr == 0) PG8_BAR; }
    PG8_BAR;
#undef PG8_SA
#undef PG8_SB
#undef PG8_STAGE
#undef PG8_LDA
#undef PG8_LDB
#undef PG8_MMA
#undef PG8_WAIT_V
#undef PG8_WAIT_L
#undef PG8_BAR
#undef PG8_SCHED
}
}

#define XB_TMO      128
#define XB_XCNT(j)  (256  + 64 * (j))
#define XB_XSUB(j)  (1280 + 64 * (j))
#define XB_XGEN(j)  (2304 + 64 * (j))
#define XB_TOP      3328
#define XB_TOPGEN   3392
#define XCD_BAR_WORDS 3456
#define XB_SPIN_CAP (1u << 22)
__device__ __forceinline__ unsigned xb_ld(unsigned* p)              { return __hip_atomic_load(p, __ATOMIC_RELAXED, __HIP_MEMORY_SCOPE_AGENT); }
__device__ __forceinline__ unsigned xb_add(unsigned* p, unsigned v) { return __hip_atomic_fetch_add(p, v, __ATOMIC_RELAXED, __HIP_MEMORY_SCOPE_AGENT); }
__device__ __forceinline__ unsigned xb_xcc_id() { return (unsigned)__builtin_amdgcn_s_getreg((3 << 11) | 20) & 0xFu; }
#define XB_SPIN(cond, bar) do { unsigned _sp = 0; while (cond) { __builtin_amdgcn_s_sleep(1); \
    if ((++_sp & 255u) == 0u) { if (xb_ld(&(bar)[XB_TMO])) break; if (_sp > XB_SPIN_CAP) { atomicAdd(&(bar)[XB_TMO], 1u); break; } } } } while (0)
__device__ __forceinline__ void xcd_barrier_post(unsigned* bar) {
    if (threadIdx.x == 0) (void)xb_add(&bar[XB_XCNT(xb_xcc_id())], 1u);
}
__device__ __forceinline__ void xcd_barrier_complete(unsigned* bar, unsigned x, unsigned& nloc, unsigned& nx) {
    const unsigned G = gridDim.x * gridDim.y * gridDim.z;
    unsigned sum, cnt, mine, sp = 0u;
    for (;;) {
        sum = 0u; cnt = 0u; mine = 0u;
#pragma unroll
        for (unsigned j = 0; j < 16; ++j) { const unsigned c = xb_ld(&bar[XB_XCNT(j)]); sum += c; cnt += (c > 0u) ? 1u : 0u; mine = (j == x) ? c : mine; }
        if (sum == G) break;
        __builtin_amdgcn_s_sleep(1);
        if ((++sp & 255u) == 0u) { if (xb_ld(&bar[XB_TMO])) break; if (sp > XB_SPIN_CAP) { atomicAdd(&bar[XB_TMO], 1u); break; } }
    }
    nloc = mine > 0u ? mine : 1u; nx = cnt > 0u ? cnt : 1u;
}
__device__ __noinline__ void xcd_barrier_leader(unsigned* bar, volatile LAS unsigned* st) {
    const unsigned x = xb_xcc_id();
    __builtin_amdgcn_s_waitcnt(0);
    unsigned nloc = st[0], nx = st[1];
    if (nloc == 0u) { xcd_barrier_complete(bar, x, nloc, nx); st[0] = nloc; st[1] = nx; }
    const unsigned old = xb_add(&bar[XB_XSUB(x)], 1u);
    const unsigned gen = old / nloc;
    if (old + 1u == (gen + 1u) * nloc) {
        __builtin_amdgcn_fence(__ATOMIC_RELEASE, "agent");
        asm volatile("s_waitcnt vmcnt(0)" ::: "memory");
        const unsigned og = xb_add(&bar[XB_TOP], 1u);
        const unsigned tg = og / nx;
        if (og + 1u == (tg + 1u) * nx) xb_add(&bar[XB_TOPGEN], 1u);
        else XB_SPIN(xb_ld(&bar[XB_TOPGEN]) == tg, bar);
        __builtin_amdgcn_fence(__ATOMIC_ACQUIRE, "agent");
        xb_add(&bar[XB_XGEN(x)], 1u);
        asm volatile("s_waitcnt vmcnt(0)" ::: "memory");
    } else {
        XB_SPIN(xb_ld(&bar[XB_XGEN(x)]) == gen, bar);
        __builtin_amdgcn_fence(__ATOMIC_ACQUIRE, "agent");
        asm volatile("s_waitcnt vmcnt(0)" ::: "memory");
    }
}
__device__ __forceinline__ void xcd_barrier(unsigned* bar, volatile LAS unsigned* st) {
    asm volatile("s_waitcnt vmcnt(0)" ::: "memory");
    __syncthreads();
    if (threadIdx.x == 0) xcd_barrier_leader(bar, st);
    __syncthreads();
}

constexpr int NIN_PTRS = 23;
struct Args { const float* in[NIN_PTRS]; float* out; unsigned char* ws; int ph_lo, ph_hi, bar_slot, pad; };
enum { I_X = 0, I_WIN, I_BFOX, I_POOLW, I_POOLS, I_LBL, I_HNG, I_GLNG, I_GLNB, I_GWS, I_GBS, I_WGATE, I_BGATE, I_WBR, I_WOUT, I_LN1G, I_LN1B, I_WQ, I_KEYS, I_PU, I_PV, I_LN2G, I_LN2B };

constexpr int LDS_BYTES = 147456;
constexpr int LDSCTL_OFF = 143360;

struct Ctx {
    LAS unsigned char* lds;
    unsigned char* ws;
    const float* const* in;
    float* out;
    int tid, lane, wave, G, bid, vcu;
};

__device__ __forceinline__ void tconv_job(const Ctx& C, const float* src, int ld_src, int K, int N, bf16_t* dst) {
    LAS float* tile = (LAS float*)C.lds;
    const int nk = K / 64, nn = N / 64, ntiles = nk * nn;
    for (int tl = C.bid; tl < ntiles; tl += C.G) {
        const int k0 = (tl / nn) * 64, n0 = (tl % nn) * 64;
#pragma unroll
        for (int p = 0; p < 2; ++p) {
            const int kr = (C.tid >> 4) + p * 32, nc = (C.tid & 15) * 4;
            const f32x4 v = *(const f32x4*)(src + (size_t)(k0 + kr) * ld_src + n0 + nc);
            tile[kr * 65 + nc + 0] = v[0]; tile[kr * 65 + nc + 1] = v[1]; tile[kr * 65 + nc + 2] = v[2]; tile[kr * 65 + nc + 3] = v[3];
        }
        __syncthreads();
        {
            const int n = C.tid >> 3, k8 = (C.tid & 7) * 8;
            u32x4 o;
#pragma unroll
            for (int j = 0; j < 4; ++j) o[j] = pk2(tile[(k8 + 2 * j) * 65 + n], tile[(k8 + 2 * j + 1) * 65 + n]);
            *(u32x4*)(dst + (size_t)(n0 + n) * K + k0 + k8) = o;
        }
        __syncthreads();
    }
}
__device__ __forceinline__ void cvt_copy(const Ctx& C, const float* src, bf16_t* dst, size_t n) {
    const size_t n8 = n / 8;
    for (size_t i = (size_t)C.bid * 512 + C.tid; i < n8; i += (size_t)C.G * 512) {
        const f32x4 a = *(const f32x4*)(src + i * 8), b = *(const f32x4*)(src + i * 8 + 4);
        u32x4 o; o[0] = pk2(a[0], a[1]); o[1] = pk2(a[2], a[3]); o[2] = pk2(b[0], b[1]); o[3] = pk2(b[2], b[3]);
        *(u32x4*)(dst + i * 8) = o;
    }
}
__device__ __forceinline__ void p_conv_weights(const Ctx& C) {
    for (int l = 0; l < DEPTH; ++l) {
        unsigned char* wb = C.ws + WS_W + (size_t)l * W_LAYER;
        tconv_job(C, C.in[I_WIN] + (size_t)l * DM * NIN, NIN, DM, NH, (bf16_t*)(wb + WO_WIN));
        tconv_job(C, C.in[I_WGATE] + (size_t)l * DM * NG, NG, DM, NG, (bf16_t*)(wb + WO_WG));
        for (int m = 0; m < 4; ++m)
            tconv_job(C, C.in[I_WBR] + ((size_t)l * 4 + m) * BW * DM, DM, BW, DM, (bf16_t*)(wb + WO_WBR) + (size_t)m * DM * BW);
        tconv_job(C, C.in[I_WOUT] + (size_t)l * DM * DM, DM, DM, DM, (bf16_t*)(wb + WO_WOUT));
        tconv_job(C, C.in[I_WQ] + (size_t)l * DM * NQ, NQ, DM, NQ, (bf16_t*)(wb + WO_WQ));
        cvt_copy(C, C.in[I_KEYS] + (size_t)l * 2 * PH * 128 * 128, (bf16_t*)(wb + WO_KEYS), (size_t)2 * PH * 128 * 128);
        for (int g = 0; g < 4; ++g)
            tconv_job(C, C.in[I_POOLW] + ((size_t)l * 4 + g) * 128 * 128, 128, 128, 128, (bf16_t*)(wb + WO_POOLW) + (size_t)g * 128 * 128);
        {
            bf16_t* gw = (bf16_t*)(wb + WO_GWS); const float* src = C.in[I_GWS] + (size_t)l * 4 * 128 * 128;
            for (int i = C.bid * 512 + C.tid; i < 4 * 128 * 128; i += C.G * 512) { const int t = (i >> 7) & 127, sx = i & 127; gw[i] = (bf16_t)f2bf(sx <= t ? src[i] : 0.f); }
        }
        float* wf = (float*)(wb + WO_WF);
        for (int i = C.bid * 512 + C.tid; i < 4 * DM; i += C.G * 512) { const int h = i / DM, k = i % DM; wf[i] = C.in[I_WIN][(size_t)l * DM * NIN + (size_t)k * NIN + NH + h]; }
    }
}
constexpr size_t WS_U8 = WS_TABU, WS_V8 = WS_TABU + 16 * MiB, WS_SU = WS_TABU + 32 * MiB, WS_SV = WS_SU + 64 * 1024;
__device__ __forceinline__ float wave_max(float v) {
#pragma unroll
    for (int o = 32; o > 0; o >>= 1) v = fmaxf(v, __shfl_xor(v, o, 64));
    return v;
}
__device__ __forceinline__ void quant_rows(const Ctx& C, const float* src, unsigned char* dst, float* scl) {
    for (int row = C.bid * 8 + C.wave; row < NEXP; row += C.G * 8) {
        const float* p = src + (size_t)row * DM + C.lane * 16;
        f32x4 v[4]; float mx = 0.f;
#pragma unroll
        for (int i = 0; i < 4; ++i) { v[i] = *(const f32x4*)(p + 4 * i);
#pragma unroll
            for (int e = 0; e < 4; ++e) mx = fmaxf(mx, fabsf(v[i][e])); }
        mx = fmaxf(wave_max(mx), 1e-30f);
        const float sc = mx * (1.f / 127.f), isc = 127.f / mx;
        u32x4 o;
#pragma unroll
        for (int i = 0; i < 4; ++i) { unsigned wd = 0u;
#pragma unroll
            for (int e = 0; e < 4; ++e) { const int q = (int)rintf(v[i][e] * isc) + 128; wd |= (unsigned)q << (8 * e); }
            o[i] = wd; }
        *(u32x4*)(dst + (size_t)row * DM + C.lane * 16) = o;
        if (C.lane == 0) scl[row] = sc;
    }
}
__device__ __forceinline__ void p_conv_tables(const Ctx& C, int l) {
    quant_rows(C, C.in[I_PU] + (size_t)l * NEXP * DM, C.ws + WS_U8, (float*)(C.ws + WS_SU));
    quant_rows(C, C.in[I_PV] + (size_t)l * NEXP * DM, C.ws + WS_V8, (float*)(C.ws + WS_SV));
}

__device__ __forceinline__ void row_emit(const Ctx& C, int row, const float (&v)[16], int l, bool want_lsig) {
    bf16_t* xb = (bf16_t*)(C.ws + WS_XB) + (size_t)row * DM;
    u32x4 o0, o1;
#pragma unroll
    for (int j = 0; j < 4; ++j) { o0[j] = pk2(v[2 * j], v[2 * j + 1]); o1[j] = pk2(v[8 + 2 * j], v[8 + 2 * j + 1]); }
    *(u32x4*)(xb + C.lane * 8) = o0; *(u32x4*)(xb + 512 + C.lane * 8) = o1;
    if (want_lsig) {
        const float* wf = (const float*)(C.ws + WS_W + (size_t)l * W_LAYER + WO_WF);
        float* lsig = (float*)(C.ws + WS_MISC);
#pragma unroll
        for (int h = 0; h < 4; ++h) {
            const f32x4 a0 = *(const f32x4*)(wf + h * DM + C.lane * 8), a1 = *(const f32x4*)(wf + h * DM + C.lane * 8 + 4);
            const f32x4 b0 = *(const f32x4*)(wf + h * DM + 512 + C.lane * 8), b1 = *(const f32x4*)(wf + h * DM + 512 + C.lane * 8 + 4);
            float s = 0.f;
#pragma unroll
            for (int j = 0; j < 4; ++j) s += v[j] * a0[j] + v[4 + j] * a1[j] + v[8 + j] * b0[j] + v[12 + j] * b1[j];
            s = wave_sum(s);
            if (C.lane == 0) lsig[(size_t)row * 4 + h] = logsigmoidf_(s + C.in[I_BFOX][l * 4 + h]);
        }
    }
}
__device__ __forceinline__ void load_row16(const float* p, int lane, float (&v)[16]) {
    const f32x4 a0 = *(const f32x4*)(p + lane * 8), a1 = *(const f32x4*)(p + lane * 8 + 4), b0 = *(const f32x4*)(p + 512 + lane * 8), b1 = *(const f32x4*)(p + 512 + lane * 8 + 4);
#pragma unroll
    for (int j = 0; j < 4; ++j) { v[j] = a0[j]; v[4 + j] = a1[j]; v[8 + j] = b0[j]; v[12 + j] = b1[j]; }
}
__device__ __forceinline__ void store_row16(float* p, int lane, const float (&v)[16]) {
    *(f32x4*)(p + lane * 8) = (f32x4){v[0], v[1], v[2], v[3]}; *(f32x4*)(p + lane * 8 + 4) = (f32x4){v[4], v[5], v[6], v[7]};
    *(f32x4*)(p + 512 + lane * 8) = (f32x4){v[8], v[9], v[10], v[11]}; *(f32x4*)(p + 512 + lane * 8 + 4) = (f32x4){v[12], v[13], v[14], v[15]};
}
__device__ __forceinline__ void ln_row16(float (&v)[16], const float* g, const float* b, int lane) {
    float s = 0.f;
#pragma unroll
    for (int j = 0; j < 16; ++j) s += v[j];
    const float mean = wave_sum(s) * (1.f / DM);
    float q = 0.f;
#pragma unroll
    for (int j = 0; j < 16; ++j) { const float d = v[j] - mean; q += d * d; }
    const float rstd = rsqrtf(wave_sum(q) * (1.f / DM) + LN_EPS);
    float gg[16], bb[16];
    load_row16(g, lane, gg); load_row16(b, lane, bb);
#pragma unroll
    for (int j = 0; j < 16; ++j) v[j] = (v[j] - mean) * rstd * gg[j] + bb[j];
}
__device__ __forceinline__ void p_rowpass0(const Ctx& C) {
    for (int row = C.bid * 8 + C.wave; row < T; row += C.G * 8) {
        float v[16]; load_row16(C.in[I_X] + (size_t)row * DM, C.lane, v);
        row_emit(C, row, v, 0, true);
    }
}
__device__ __forceinline__ void p_cumsum(const Ctx& C) {
    if (C.bid != 0) return;
    const float* lsig = (const float*)(C.ws + WS_MISC);
    float* cum = (float*)(C.ws + WS_CUM);
    const int b = C.wave >> 2, h = C.wave & 3;
    float loc = 0.f;
    for (int j = 0; j < 128; ++j) loc += lsig[((size_t)b * SEQ + C.lane * 128 + j) * 4 + h];
    float inc = loc;
#pragma unroll
    for (int o = 1; o < 64; o <<= 1) { const float t = __shfl_up(inc, o, 64); if (C.lane >= o) inc += t; }
    float run = inc - loc;
    for (int j = 0; j < 128; ++j) { run += lsig[((size_t)b * SEQ + C.lane * 128 + j) * 4 + h]; cum[((size_t)b * 4 + h) * SEQ + C.lane * 128 + j] = run; }
}
__device__ __forceinline__ void p_ln1(const Ctx& C, int l) {
    float* xc = (float*)(C.ws + WS_XC); bf16_t* x1b = (bf16_t*)(C.ws + WS_X1B);
    for (int row = C.bid * 8 + C.wave; row < T; row += C.G * 8) {
        float v[16]; load_row16(xc + (size_t)row * DM, C.lane, v);
        ln_row16(v, C.in[I_LN1G] + l * DM, C.in[I_LN1B] + l * DM, C.lane);
        store_row16(xc + (size_t)row * DM, C.lane, v);
        u32x4 o0, o1;
#pragma unroll
        for (int j = 0; j < 4; ++j) { o0[j] = pk2(v[2 * j], v[2 * j + 1]); o1[j] = pk2(v[8 + 2 * j], v[8 + 2 * j + 1]); }
        *(u32x4*)(x1b + (size_t)row * DM + C.lane * 8) = o0; *(u32x4*)(x1b + (size_t)row * DM + 512 + C.lane * 8) = o1;
    }
}

__device__ __forceinline__ void mix_pool_naive(const Ctx& C, int l) {
    const bf16_t* H = (const bf16_t*)(C.ws + WS_H); bf16_t* BR = (bf16_t*)(C.ws + WS_BR);
    LAS float* dd = (LAS float*)C.lds;
    for (int u = C.bid; u < (T / 64) * 4; u += C.G) {
        const int g = u & 3, t0 = (u >> 2) * 64, w = 2 << g;
        for (int idx = C.tid; idx < 64 * 128; idx += 512) {
            const int r = idx >> 7, c = idx & 127, row = t0 + r, pos = row & (SEQ - 1);
            const int nwin = (pos + 1 < w) ? pos + 1 : w;
            float s = 0.f;
            for (int j = 0; j < nwin; ++j) s += bf2f(H[(size_t)(row - j) * NH + HC_P + g * 128 + c]);
            dd[idx] = s / (float)nwin - bf2f(H[(size_t)row * NH + HC_P + g * 128 + c]);
        }
        __syncthreads();
        const int dcol = C.tid & 127, rq = C.tid >> 7;
        float acc[16];
#pragma unroll
        for (int i = 0; i < 16; ++i) acc[i] = 0.f;
        const float* pw = C.in[I_POOLW] + ((size_t)l * 4 + g) * 128 * 128;
        for (int c = 0; c < 128; ++c) {
            const float wv = pw[c * 128 + dcol];
#pragma unroll
            for (int i = 0; i < 16; ++i) acc[i] += dd[(rq * 16 + i) * 128 + c] * wv;
        }
        const float sc = C.in[I_POOLS][l * BW + g * 128 + dcol];
#pragma unroll
        for (int i = 0; i < 16; ++i) BR[(size_t)(t0 + rq * 16 + i) * NBR + 0 + g * 128 + dcol] = (bf16_t)f2bf(acc[i] * sc);
        __syncthreads();
    }
}
__device__ __forceinline__ void mix_gmlp_naive(const Ctx& C, int l) {
    const bf16_t* H = (const bf16_t*)(C.ws + WS_H); bf16_t* BR = (bf16_t*)(C.ws + WS_BR);
    LAS float* vn = (LAS float*)C.lds;
    for (int u = C.bid; u < (T / 128) * 4; u += C.G) {
        const int g = u & 3, t0 = (u >> 2) * 128;
        for (int i = 0; i < 16; ++i) {
            const int r = C.wave * 16 + i, row = t0 + r;
            const u32x4 raw = *(const u32x4*)(H + (size_t)row * NH + HC_GV + C.lane * 8);
            float e[8];
#pragma unroll
            for (int j = 0; j < 4; ++j) { e[2 * j] = geluf_(bf2f(raw[j] & 0xffffu)); e[2 * j + 1] = geluf_(bf2f(raw[j] >> 16)); }
            float s = 0.f;
#pragma unroll
            for (int j = 0; j < 8; ++j) s += e[j];
            const float mean = wave_sum(s) * (1.f / BW);
            float q = 0.f;
#pragma unroll
            for (int j = 0; j < 8; ++j) { const float d = e[j] - mean; q += d * d; }
            const float rstd = rsqrtf(wave_sum(q) * (1.f / BW) + LN_EPS);
            if ((C.lane >> 4) == g) {
#pragma unroll
                for (int j = 0; j < 8; ++j) { const int col = C.lane * 8 + j;
                    vn[r * 128 + (col - g * 128)] = (e[j] - mean) * rstd * C.in[I_GLNG][l * BW + col] + C.in[I_GLNB][l * BW + col]; }
            }
        }
        __syncthreads();
        const int c = C.tid & 127, tq = C.tid >> 7;
        const float* wsg = C.in[I_GWS] + ((size_t)l * 4 + g) * 128 * 128;
        for (int t = tq; t < 128; t += 4) {
            float acc = 0.f;
            for (int s = 0; s <= t; ++s) acc += wsg[t * 128 + s] * vn[s * 128 + c];
            const float sv = acc + C.in[I_GBS][(l * 4 + g) * 128 + t];
            const float uv = geluf_(bf2f(H[(size_t)(t0 + t) * NH + HC_GU + g * 128 + c]));
            BR[(size_t)(t0 + t) * NBR + 1024 + g * 128 + c] = (bf16_t)f2bf(uv * sv);
        }
        __syncthreads();
    }
}
__device__ __forceinline__ void mix_fox_naive(const Ctx& C, int l) {
    const bf16_t* H = (const bf16_t*)(C.ws + WS_H); bf16_t* BR = (bf16_t*)(C.ws + WS_BR);
    const float* cum = (const float*)(C.ws + WS_CUM);
    const float scale = 0.08838834764831845f;
    for (int u = C.bid; u < T * 4 / 8; u += C.G) {
        const int rid = u * 8 + C.wave;
        const int h = rid & 3, row = rid >> 2, b = row / SEQ, t = row % SEQ;
        const unsigned qraw = *(const unsigned*)(H + (size_t)row * NH + HC_FQ + h * 128 + C.lane * 2);
        const float q0 = bf2f(qraw & 0xffffu) * scale, q1 = bf2f(qraw >> 16) * scale;
        const float* cm = cum + ((size_t)b * 4 + h) * SEQ;
        const float ct = cm[t];
        float m = -1e30f, lsum = 0.f, o0 = 0.f, o1 = 0.f;
        for (int s = t; s >= 0; --s) {
            const size_t kr = (size_t)(b * SEQ + s) * NH + h * 128 + C.lane * 2;
            const unsigned kraw = *(const unsigned*)(H + kr + HC_FK);
            const unsigned vraw = *(const unsigned*)(H + kr + HC_FV);
            float d = q0 * bf2f(kraw & 0xffffu) + q1 * bf2f(kraw >> 16);
            d = wave_sum(d);
            const float z = d + ct - cm[s];
            const float mn = fmaxf(m, z), al = __expf(m - mn), p = __expf(z - mn);
            lsum = lsum * al + p; o0 = o0 * al + p * bf2f(vraw & 0xffffu); o1 = o1 * al + p * bf2f(vraw >> 16); m = mn;
        }
        const float inv = 1.f / lsum;
        *(unsigned*)(BR + (size_t)row * NBR + 1536 + h * 128 + C.lane * 2) = pk2(o0 * inv, o1 * inv);
    }
}
__device__ __forceinline__ void mix_hgrn_naive(const Ctx& C, int l) {
    if (C.bid >= BATCH * 4) return;
    const bf16_t* H = (const bf16_t*)(C.ws + WS_H); bf16_t* BR = (bf16_t*)(C.ws + WS_BR);
    const int b = C.bid >> 2, h = C.bid & 3;
    LAS float* fdec = (LAS float*)C.lds;
    LAS float* kkv = fdec + 32 * 128;
    LAS float* qsv = kkv + 32 * 128;
    LAS float* vv = qsv + 32 * 128;
    LAS float* opart = vv + 32 * 128;
    const int kq = C.tid >> 7, v = C.tid & 127;
    float S[32];
#pragma unroll
    for (int j = 0; j < 32; ++j) S[j] = 0.f;
    for (int c0 = 0; c0 < SEQ; c0 += 32) {
        for (int idx = C.tid; idx < 32 * 128; idx += 512) {
            const int st = idx >> 7, k = idx & 127; const size_t rb = (size_t)(b * SEQ + c0 + st) * NH + h * 128 + k;
            float lb = 0.f;
            if (l == 1) { const float z0 = C.in[I_LBL][h * 128 + k], z1 = C.in[I_LBL][BW + h * 128 + k]; lb = 1.f / (1.f + __expf(z0 - z1)); }
            const float zf = bf2f(H[rb + HC_HF]);
            const float kk = (1.f - lb) * sigmoidf_(-zf);
            fdec[idx] = 1.f - kk; kkv[idx] = kk; qsv[idx] = siluf_(bf2f(H[rb + HC_HQ])); vv[idx] = bf2f(H[rb + HC_HI]);
        }
        __syncthreads();
        for (int st = 0; st < 32; ++st) {
            const float vt = vv[st * 128 + v];
            float part = 0.f;
#pragma unroll
            for (int j = 0; j < 32; ++j) { const int k = kq * 32 + j; S[j] = fdec[st * 128 + k] * S[j] + kkv[st * 128 + k] * vt; part += S[j] * qsv[st * 128 + k]; }
            opart[(kq * 32 + st) * 128 + v] = part;
        }
        __syncthreads();
        for (int i = 0; i < 4; ++i) {
            const int st = C.wave * 4 + i, row = b * SEQ + c0 + st;
            float o0 = 0.f, o1 = 0.f;
#pragma unroll
            for (int q = 0; q < 4; ++q) { o0 += opart[(q * 32 + st) * 128 + C.lane]; o1 += opart[(q * 32 + st) * 128 + 64 + C.lane]; }
            const float ss = wave_sum(o0 * o0 + o1 * o1);
            const float r = rsqrtf(ss * (1.f / 128.f) + RMS_EPS);
            const float g0 = siluf_(bf2f(H[(size_t)row * NH + HC_HG + h * 128 + C.lane])), g1 = siluf_(bf2f(H[(size_t)row * NH + HC_HG + h * 128 + 64 + C.lane]));
            BR[(size_t)row * NBR + 512 + h * 128 + C.lane] = (bf16_t)f2bf(o0 * r * C.in[I_HNG][l * 128 + C.lane] * g0);
            BR[(size_t)row * NBR + 512 + h * 128 + 64 + C.lane] = (bf16_t)f2bf(o1 * r * C.in[I_HNG][l * 128 + 64 + C.lane] * g1);
        }
        __syncthreads();
    }
}


typedef float f32x16 __attribute__((ext_vector_type(16)));
typedef short s16x4 __attribute__((ext_vector_type(4)));
typedef short v4i16_t __attribute__((ext_vector_type(4)));
typedef __bf16 bf16x2_t __attribute__((ext_vector_type(2)));
__device__ __forceinline__ unsigned cvtpk(float lo, float hi) { f32x2 v = {lo, hi}; bf16x2_t b = __builtin_convertvector(v, bf16x2_t); return __builtin_bit_cast(unsigned, b); }
__device__ __forceinline__ s16x4 vtr(const LAS unsigned char* p) { return __builtin_bit_cast(s16x4, __builtin_amdgcn_ds_read_tr16_b64_v4i16((LAS v4i16_t*)p)); }
__device__ __forceinline__ float xor32(float x) { return __shfl_xor(x, 32, 64); }
#define MFMA32(a, b, c) __builtin_amdgcn_mfma_f32_32x32x16_bf16((a), (b), (c), 0, 0, 0)
constexpr int CW_KMAX = 16;

__device__ __forceinline__ void p_knorm(const Ctx& C, int l) {
    const bf16_t* H = (const bf16_t*)(C.ws + WS_H);
    unsigned* kmax = (unsigned*)(C.ws + WS_CTL) + CW_KMAX + l * 8;
    float best = 0.f;
    int bsel = -1;
    for (int row = C.bid * 8 + C.wave; row < T; row += C.G * 8) {
        const u32x4 raw = *(const u32x4*)(H + (size_t)row * NH + HC_FK + C.lane * 8);
        float s = 0.f;
#pragma unroll
        for (int j = 0; j < 4; ++j) { const float a = bf2f(raw[j] & 0xffffu), b = bf2f(raw[j] >> 16); s += a * a + b * b; }
#pragma unroll
        for (int o = 8; o > 0; o >>= 1) s += __shfl_xor(s, o, 64);
        const int b = row / SEQ;
        if (bsel >= 0 && b != bsel) { if ((C.lane & 15) == 0) atomicMax(kmax + bsel * 4 + (C.lane >> 4), __builtin_bit_cast(unsigned, best)); best = 0.f; }
        bsel = b; best = fmaxf(best, s);
    }
    if (bsel >= 0 && (C.lane & 15) == 0) atomicMax(kmax + bsel * 4 + (C.lane >> 4), __builtin_bit_cast(unsigned, best));
}

constexpr int FOX_KST = 272, FOX_VST = 320;
constexpr int FOX_KB = 0, FOX_VB = 2 * 64 * FOX_KST, FOX_BETA = FOX_VB + 2 * 64 * FOX_VST, FOX_FLAG = FOX_BETA + 2 * 64 * 4, FOX_END = FOX_FLAG + 2 * 8 * 4;
__device__ __forceinline__ void mix_fox(const Ctx& C, int l) {
    const bf16_t* H = (const bf16_t*)(C.ws + WS_H); bf16_t* BR = (bf16_t*)(C.ws + WS_BR);
    const float* cum = (const float*)(C.ws + WS_CUM);
    const unsigned* kmaxw = (const unsigned*)(C.ws + WS_CTL) + CW_KMAX + l * 8;
    const float LOG2E = 1.4426950408889634f, QS = 0.08838834764831845f * LOG2E;
    const int lane = C.lane, w = C.wave, r32 = lane & 31, hh = lane >> 5;
    LAS unsigned char* lds = C.lds;
    LAS float* betaL = (LAS float*)(lds + FOX_BETA);
    volatile LAS int* flagL = (volatile LAS int*)(lds + FOX_FLAG);
    for (int u = C.bid; u < BATCH * 4 * (SEQ / 256); u += C.G) {
        const int qb = u % (SEQ / 256), bh = u / (SEQ / 256), b = bh >> 2, h = bh & 3;
        const int q0 = qb * 256, qw = q0 + 32 * w;
        const size_t rowbase = (size_t)b * SEQ;
        const float* cm = cum + ((size_t)b * 4 + h) * SEQ;
        const float c0 = cm[q0];
        const float kmx = sqrtf(__builtin_bit_cast(float, __hip_atomic_load(kmaxw + b * 4 + h, __ATOMIC_RELAXED, __HIP_MEMORY_SCOPE_AGENT)));
        bf16x8 qf[8]; float qn = 0.f;
        {
            const bf16_t* qp = H + (rowbase + qw + r32) * NH + HC_FQ + h * 128 + 8 * hh;
#pragma unroll
            for (int ks = 0; ks < 8; ++ks) {
                const u32x4 raw = *(const u32x4*)(qp + 16 * ks);
                u32x4 o;
#pragma unroll
                for (int j = 0; j < 4; ++j) { const float a = bf2f(raw[j] & 0xffffu), bb = bf2f(raw[j] >> 16); qn += a * a + bb * bb; o[j] = cvtpk(a * QS, bb * QS); }
                qf[ks] = __builtin_bit_cast(bf16x8, o);
            }
            qn += xor32(qn); qn = sqrtf(qn);
        }
        const float qbound = qn * kmx * QS;
        f32x16 oacc[4];
#pragma unroll
        for (int mt = 0; mt < 4; ++mt)
#pragma unroll
            for (int i = 0; i < 16; ++i) oacc[mt][i] = 0.f;
        float m_run = -1e30f, l_run = 0.f;
        const int jmax = (q0 + 255) >> 6;
        const int srow = C.tid >> 4, sch = C.tid & 15;
        u32x4 kreg[2], vreg[2]; float breg = 0.f;
#define FOX_GLOAD(j_) do { _Pragma("unroll") for (int p = 0; p < 2; ++p) { \
                const bf16_t* rp = H + (rowbase + 64 * (j_) + srow + 32 * p) * NH + h * 128 + sch * 8; \
                kreg[p] = *(const u32x4*)(rp + HC_FK); vreg[p] = *(const u32x4*)(rp + HC_FV); } \
            if (C.tid < 64) breg = (c0 - cm[64 * (j_) + C.tid]) * LOG2E; } while (0)
#define FOX_LWRITE(buf_) do { _Pragma("unroll") for (int p = 0; p < 2; ++p) { \
                *(LAS u32x4*)(lds + FOX_KB + (buf_) * 64 * FOX_KST + (srow + 32 * p) * FOX_KST + sch * 16) = kreg[p]; \
                *(LAS u32x4*)(lds + FOX_VB + (buf_) * 64 * FOX_VST + (srow + 32 * p) * FOX_VST + sch * 16) = vreg[p]; } \
            if (C.tid < 64) betaL[(buf_) * 64 + C.tid] = breg; } while (0)
        __syncthreads();
        if (C.tid < 16) flagL[C.tid] = 0;
        FOX_GLOAD(jmax); FOX_LWRITE(jmax & 1);
        bool wdone = false;
        for (int j = jmax; j >= 0; --j) {
            const int cur = j & 1;
            __syncthreads();
            if (j < jmax) { int all = 1;
#pragma unroll
                for (int i = 0; i < 8; ++i) all &= flagL[((j + 1) & 1) * 8 + i];
                if (all) break; }
            if (j > 0) FOX_GLOAD(j - 1);
            const int k0 = 64 * j;
            if (k0 <= qw + 31 && !wdone) {
                const LAS unsigned char* kb = lds + FOX_KB + cur * 64 * FOX_KST;
                const LAS unsigned char* vb = lds + FOX_VB + cur * 64 * FOX_VST;
                f32x16 sacc[2];
#pragma unroll
                for (int mt = 0; mt < 2; ++mt)
#pragma unroll
                    for (int g = 0; g < 4; ++g) { const f32x4 bv = *(const LAS f32x4*)(betaL + cur * 64 + 32 * mt + 8 * g + 4 * hh);
                        sacc[mt][4 * g] = bv[0]; sacc[mt][4 * g + 1] = bv[1]; sacc[mt][4 * g + 2] = bv[2]; sacc[mt][4 * g + 3] = bv[3]; }
#pragma unroll
                for (int ks = 0; ks < 8; ++ks)
#pragma unroll
                    for (int mt = 0; mt < 2; ++mt) {
                        const bf16x8 kf = *(const LAS bf16x8*)(kb + (32 * mt + r32) * FOX_KST + 32 * ks + 16 * hh);
                        sacc[mt] = MFMA32(kf, qf[ks], sacc[mt]);
                    }
                const int tq = qw + r32;
                if (k0 + 63 > qw) {
#pragma unroll
                    for (int mt = 0; mt < 2; ++mt)
#pragma unroll
                        for (int i = 0; i < 16; ++i) { const int key = k0 + 32 * mt + (i & 3) + 8 * (i >> 2) + 4 * hh; if (key > tq) sacc[mt][i] = -1e30f; }
                }
                float mx = sacc[0][0];
#pragma unroll
                for (int mt = 0; mt < 2; ++mt)
#pragma unroll
                    for (int i = 0; i < 16; ++i) mx = fmaxf(mx, sacc[mt][i]);
                mx = fmaxf(mx, xor32(mx));
                const float mn = fmaxf(m_run, mx), alpha = __builtin_amdgcn_exp2f(m_run - mn);
                m_run = mn;
                float ps = 0.f;
#pragma unroll
                for (int mt = 0; mt < 2; ++mt)
#pragma unroll
                    for (int i = 0; i < 16; ++i) { const float p = __builtin_amdgcn_exp2f(sacc[mt][i] - mn); sacc[mt][i] = p; ps += p; }
                l_run = l_run * alpha + ps;
#pragma unroll
                for (int mt = 0; mt < 4; ++mt)
#pragma unroll
                    for (int i = 0; i < 16; ++i) oacc[mt][i] *= alpha;
#pragma unroll
                for (int s4 = 0; s4 < 4; ++s4) {
                    const int mtk = s4 >> 1, s = s4 & 1;
                    u32x4 pb;
#pragma unroll
                    for (int e = 0; e < 4; ++e) pb[e] = cvtpk(sacc[mtk][8 * s + 2 * e], sacc[mtk][8 * s + 2 * e + 1]);
                    const bf16x8 pfrag = __builtin_bit_cast(bf16x8, pb);
                    const int i16 = lane & 15, q4 = i16 >> 2, p4 = i16 & 3, blk = (lane >> 4) & 1;
                    const int keyA = 32 * mtk + 16 * s + 4 * hh + q4;
#pragma unroll
                    for (int mt = 0; mt < 4; ++mt) {
                        const LAS unsigned char* a0 = vb + keyA * FOX_VST + (32 * mt + 16 * blk + 4 * p4) * 2;
                        const s16x4 lo = vtr(a0), hi = vtr(a0 + 8 * FOX_VST);
                        const bf16x8 vf = __builtin_shufflevector(lo, hi, 0, 1, 2, 3, 4, 5, 6, 7);
                        oacc[mt] = MFMA32(vf, pfrag, oacc[mt]);
                    }
                }
                if (j > 0) { const float bl = (c0 - cm[k0 - 1]) * LOG2E;
                    const int ok = (qbound + bl < m_run - 152.f) ? 1 : 0;
                    wdone = __all(ok); }
            }
            if (lane == 0) flagL[cur * 8 + w] = wdone ? 1 : 0;
            if (j > 0) FOX_LWRITE(cur ^ 1);
        }
        l_run += xor32(l_run);
        const float inv = 1.f / l_run;
        bf16_t* op = BR + (rowbase + qw + r32) * NBR + 1536 + h * 128;
#pragma unroll
        for (int mt = 0; mt < 4; ++mt)
#pragma unroll
            for (int g = 0; g < 4; ++g) { u32x2 o; o[0] = cvtpk(oacc[mt][4 * g] * inv, oacc[mt][4 * g + 1] * inv); o[1] = cvtpk(oacc[mt][4 * g + 2] * inv, oacc[mt][4 * g + 3] * inv);
                *(u32x2*)(op + 32 * mt + 8 * g + 4 * hh) = o; }
    }
}


constexpr int HG_LF = 0, HG_QA = 34816, HG_QB = HG_QA + 17408, HG_KD = HG_QB + 8704, HG_KO = HG_KD + 17408, HG_KT = HG_KO + 8704, HG_VN = HG_KT + 20480, HG_AM = HG_VN + 20480, HG_END = HG_AM + 12288;
constexpr int HG_LFS = 132;
static_assert(HG_END <= 140 * 1024, "hgrn LDS");
constexpr size_t WS_DSC = WS_ST + (size_t)BATCH * 4 * 32 * 128 * 128 * 4;

template <bool FULL>
__device__ __forceinline__ void hgrn_unit(const Ctx& C, int l, int u) {
#if DIAG == 1
    const bf16_t* H = (const bf16_t*)(C.ws + WS_H); bf16_t* BR = (l == 0) ? (bf16_t*)(C.ws + WS_XA) : (bf16_t*)(C.ws + WS_TABU);
#else
    const bf16_t* H = (const bf16_t*)(C.ws + WS_H); bf16_t* BR = (bf16_t*)(C.ws + WS_BR);
#endif
    float* STB = (float*)(C.ws + WS_ST); float* DSC = (float*)(C.ws + WS_DSC);
    LAS unsigned char* lds = C.lds;
    LAS float* LF = (LAS float*)(lds + HG_LF);
    const int lane = C.lane, w = C.wave, r32 = lane & 31, hh = lane >> 5;
    const int sc = u & 31, bh = u >> 5, b = bh >> 2, h = bh & 3;
    const int wk = w >> 1, wv = w & 1;
    const int mt = w >> 2, nt = w & 3;
    const int i16 = lane & 15, q4 = i16 >> 2, p4 = i16 & 3, blk = (lane >> 4) & 1;
    f32x16 S0, S1;
    float* stp = STB + ((size_t)bh * 32 + sc) * 128 * 128;
    if constexpr (FULL) {
#pragma unroll
        for (int i = 0; i < 16; ++i) { const int k = 32 * wk + (i & 3) + 8 * (i >> 2) + 4 * hh;
            S0[i] = stp[k * 128 + 64 * wv + r32]; S1[i] = stp[k * 128 + 64 * wv + 32 + r32]; }
    } else {
#pragma unroll
        for (int i = 0; i < 16; ++i) { S0[i] = 0.f; S1[i] = 0.f; }
    }
    float dtot = 0.f;
    const int ps = C.tid >> 3, pseg = C.tid & 7;
    float lbv[16];
#pragma unroll
    for (int j = 0; j < 16; ++j) { lbv[j] = 0.f;
        if (l == 1) { const int ch = h * 128 + 16 * pseg + j; lbv[j] = 1.f / (1.f + __expf(C.in[I_LBL][ch] - C.in[I_LBL][BW + ch])); } }
    for (int c = 0; c < 4; ++c) {
        const size_t row0 = (size_t)b * SEQ + sc * 256 + c * 64;
        const bf16_t* hp = H + (row0 + ps) * NH + h * 128 + 16 * pseg;
        float kkv[16], qsv[16];
        u32x4 vraw0, vraw1;
        {
            const u32x4 f0 = *(const u32x4*)(hp + HC_HF), f1 = *(const u32x4*)(hp + HC_HF + 8);
            vraw0 = *(const u32x4*)(hp + HC_HI); vraw1 = *(const u32x4*)(hp + HC_HI + 8);
#pragma unroll
            for (int j = 0; j < 8; ++j) { const unsigned r = (j < 4) ? f0[j] : f1[j - 4];
                const float z0 = bf2f(r & 0xffffu), z1 = bf2f(r >> 16);
                kkv[2 * j] = (1.f - lbv[2 * j]) * sigmoidf_(-z0); kkv[2 * j + 1] = (1.f - lbv[2 * j + 1]) * sigmoidf_(-z1); }
            if constexpr (FULL) {
                const u32x4 q0 = *(const u32x4*)(hp + HC_HQ), q1 = *(const u32x4*)(hp + HC_HQ + 8);
#pragma unroll
                for (int j = 0; j < 8; ++j) { const unsigned r = (j < 4) ? q0[j] : q1[j - 4]; qsv[2 * j] = siluf_(bf2f(r & 0xffffu)); qsv[2 * j + 1] = siluf_(bf2f(r >> 16)); }
            }
#pragma unroll
            for (int j4 = 0; j4 < 4; ++j4) { f32x4 o;
#pragma unroll
                for (int e = 0; e < 4; ++e) o[e] = log1pf(-kkv[4 * j4 + e]);
                *(LAS f32x4*)(LF + ps * HG_LFS + 16 * pseg + 4 * j4) = o; }
        }
        __syncthreads();
        if (C.tid < 128) { float run = 0.f;
#pragma unroll 8
            for (int s = 0; s < 64; ++s) { run += LF[s * HG_LFS + C.tid]; LF[s * HG_LFS + C.tid] = run; }
            dtot += run; }
        __syncthreads();
        float bv[16], b31[16], bl[16];
#pragma unroll
        for (int j4 = 0; j4 < 4; ++j4) { const f32x4 x = *(const LAS f32x4*)(LF + ps * HG_LFS + 16 * pseg + 4 * j4), y = *(const LAS f32x4*)(LF + 31 * HG_LFS + 16 * pseg + 4 * j4), z = *(const LAS f32x4*)(LF + 63 * HG_LFS + 16 * pseg + 4 * j4);
#pragma unroll
            for (int e = 0; e < 4; ++e) { bv[4 * j4 + e] = x[e]; b31[4 * j4 + e] = y[e]; bl[4 * j4 + e] = z[e]; } }
        {
            u32x4 o0, o1;
#pragma unroll
            for (int j = 0; j < 4; ++j) { o0[j] = cvtpk(kkv[2 * j] * __expf(bl[2 * j] - bv[2 * j]), kkv[2 * j + 1] * __expf(bl[2 * j + 1] - bv[2 * j + 1]));
                o1[j] = cvtpk(kkv[8 + 2 * j] * __expf(bl[8 + 2 * j] - bv[8 + 2 * j]), kkv[9 + 2 * j] * __expf(bl[9 + 2 * j] - bv[9 + 2 * j])); }
            *(LAS u32x4*)(lds + HG_KT + ps * 320 + 32 * pseg) = o0; *(LAS u32x4*)(lds + HG_KT + ps * 320 + 32 * pseg + 16) = o1;
            *(LAS u32x4*)(lds + HG_VN + ps * 320 + 32 * pseg) = vraw0; *(LAS u32x4*)(lds + HG_VN + ps * 320 + 32 * pseg + 16) = vraw1;
            if constexpr (FULL) {
                const bool hi = ps >= 32;
                float rr[16];
#pragma unroll
                for (int j = 0; j < 16; ++j) rr[j] = hi ? b31[j] : 0.f;
#pragma unroll
                for (int j = 0; j < 4; ++j) { o0[j] = cvtpk(qsv[2 * j] * __expf(bv[2 * j] - rr[2 * j]), qsv[2 * j + 1] * __expf(bv[2 * j + 1] - rr[2 * j + 1]));
                    o1[j] = cvtpk(qsv[8 + 2 * j] * __expf(bv[8 + 2 * j] - rr[8 + 2 * j]), qsv[9 + 2 * j] * __expf(bv[9 + 2 * j] - rr[9 + 2 * j])); }
                *(LAS u32x4*)(lds + HG_QA + ps * 272 + 32 * pseg) = o0; *(LAS u32x4*)(lds + HG_QA + ps * 272 + 32 * pseg + 16) = o1;
#pragma unroll
                for (int j = 0; j < 4; ++j) { o0[j] = cvtpk(kkv[2 * j] * __expf(rr[2 * j] - bv[2 * j]), kkv[2 * j + 1] * __expf(rr[2 * j + 1] - bv[2 * j + 1]));
                    o1[j] = cvtpk(kkv[8 + 2 * j] * __expf(rr[8 + 2 * j] - bv[8 + 2 * j]), kkv[9 + 2 * j] * __expf(rr[9 + 2 * j] - bv[9 + 2 * j])); }
                *(LAS u32x4*)(lds + HG_KD + ps * 272 + 32 * pseg) = o0; *(LAS u32x4*)(lds + HG_KD + ps * 272 + 32 * pseg + 16) = o1;
                if (hi) {
#pragma unroll
                    for (int j = 0; j < 4; ++j) { o0[j] = cvtpk(qsv[2 * j] * __expf(bv[2 * j]), qsv[2 * j + 1] * __expf(bv[2 * j + 1]));
                        o1[j] = cvtpk(qsv[8 + 2 * j] * __expf(bv[8 + 2 * j]), qsv[9 + 2 * j] * __expf(bv[9 + 2 * j])); }
                    *(LAS u32x4*)(lds + HG_QB + (ps - 32) * 272 + 32 * pseg) = o0; *(LAS u32x4*)(lds + HG_QB + (ps - 32) * 272 + 32 * pseg + 16) = o1;
                } else {
#pragma unroll
                    for (int j = 0; j < 4; ++j) { o0[j] = cvtpk(kkv[2 * j] * __expf(b31[2 * j] - bv[2 * j]), kkv[2 * j + 1] * __expf(b31[2 * j + 1] - bv[2 * j + 1]));
                        o1[j] = cvtpk(kkv[8 + 2 * j] * __expf(b31[8 + 2 * j] - bv[8 + 2 * j]), kkv[9 + 2 * j] * __expf(b31[9 + 2 * j] - bv[9 + 2 * j])); }
                    *(LAS u32x4*)(lds + HG_KO + ps * 272 + 32 * pseg) = o0; *(LAS u32x4*)(lds + HG_KO + ps * 272 + 32 * pseg + 16) = o1;
                }
            }
        }
        float dk[16];
#pragma unroll
        for (int i = 0; i < 16; ++i) dk[i] = __expf(LF[63 * HG_LFS + 32 * wk + (i & 3) + 8 * (i >> 2) + 4 * hh]);
        __syncthreads();
        if constexpr (FULL) {
#pragma unroll
            for (int g = 0; g < 4; ++g) {
                u32x2 o; o[0] = cvtpk(S0[4 * g], S0[4 * g + 1]); o[1] = cvtpk(S0[4 * g + 2], S0[4 * g + 3]);
                *(LAS u32x2*)(lds + HG_LF + (64 * wv + r32) * 272 + (32 * wk + 8 * g + 4 * hh) * 2) = o;
                o[0] = cvtpk(S1[4 * g], S1[4 * g + 1]); o[1] = cvtpk(S1[4 * g + 2], S1[4 * g + 3]);
                *(LAS u32x2*)(lds + HG_LF + (64 * wv + 32 + r32) * 272 + (32 * wk + 8 * g + 4 * hh) * 2) = o;
            }
#define HG_ATILE(AMT_, AST_) do { \
                const LAS unsigned char* kb = ((AMT_) == (AST_)) ? (lds + HG_KD + (32 * (AST_)) * 272) : (lds + HG_KO); \
                f32x16 a; \
                _Pragma("unroll") for (int i = 0; i < 16; ++i) a[i] = 0.f; \
                _Pragma("unroll") for (int ks = 0; ks < 8; ++ks) { \
                    const bf16x8 af = *(const LAS bf16x8*)(lds + HG_QA + (32 * (AMT_) + r32) * 272 + 32 * ks + 16 * hh); \
                    const bf16x8 bf = *(const LAS bf16x8*)(kb + r32 * 272 + 32 * ks + 16 * hh); \
                    a = MFMA32(af, bf, a); } \
                _Pragma("unroll") for (int g = 0; g < 4; ++g) { \
                    float x[4]; \
                    _Pragma("unroll") for (int e = 0; e < 4; ++e) { const int tl = 8 * g + 4 * hh + e; x[e] = ((AMT_) != (AST_) || r32 <= tl) ? a[4 * g + e] : 0.f; } \
                    u32x2 o; o[0] = cvtpk(x[0], x[1]); o[1] = cvtpk(x[2], x[3]); \
                    *(LAS u32x2*)(lds + HG_AM + (32 * (AST_) + r32) * 192 + (32 * (AMT_) + 8 * g + 4 * hh) * 2) = o; } } while (0)
            if (w == 0) { HG_ATILE(0, 0); }
            else if (w == 1) { HG_ATILE(1, 0); }
            else if (w == 2) { HG_ATILE(1, 1); }
        }
#pragma unroll
        for (int i = 0; i < 16; ++i) { S0[i] *= dk[i]; S1[i] *= dk[i]; }
#pragma unroll
        for (int ks = 0; ks < 4; ++ks) {
            const LAS unsigned char* ka = lds + HG_KT + (16 * ks + 8 * hh + q4) * 320 + (32 * wk + 16 * blk + 4 * p4) * 2;
            const s16x4 alo = vtr(ka), ahi = vtr(ka + 4 * 320);
            const bf16x8 af = __builtin_shufflevector(alo, ahi, 0, 1, 2, 3, 4, 5, 6, 7);
            const LAS unsigned char* vb0 = lds + HG_VN + (16 * ks + 8 * hh + q4) * 320 + (64 * wv + 16 * blk + 4 * p4) * 2;
            const s16x4 b0lo = vtr(vb0), b0hi = vtr(vb0 + 4 * 320), b1lo = vtr(vb0 + 64), b1hi = vtr(vb0 + 64 + 4 * 320);
            S0 = MFMA32(af, __builtin_shufflevector(b0lo, b0hi, 0, 1, 2, 3, 4, 5, 6, 7), S0);
            S1 = MFMA32(af, __builtin_shufflevector(b1lo, b1hi, 0, 1, 2, 3, 4, 5, 6, 7), S1);
        }
        if constexpr (FULL) {
            __syncthreads();
            f32x16 o;
#pragma unroll
            for (int i = 0; i < 16; ++i) o[i] = 0.f;
            const LAS unsigned char* qb = (mt == 0) ? (lds + HG_QA) : (lds + HG_QB);
#pragma unroll
            for (int ks = 0; ks < 8; ++ks) {
                const bf16x8 af = *(const LAS bf16x8*)(qb + r32 * 272 + 32 * ks + 16 * hh);
                const bf16x8 bf = *(const LAS bf16x8*)(lds + HG_LF + (32 * nt + r32) * 272 + 32 * ks + 16 * hh);
                o = MFMA32(af, bf, o);
            }
#pragma unroll
            for (int ks = 0; ks < 4; ++ks) {
                if (mt == 0 && ks >= 2) continue;
                const LAS unsigned char* aa = lds + HG_AM + (16 * ks + 8 * hh + q4) * 192 + (32 * mt + 16 * blk + 4 * p4) * 2;
                const s16x4 alo = vtr(aa), ahi = vtr(aa + 4 * 192);
                const LAS unsigned char* vb0 = lds + HG_VN + (16 * ks + 8 * hh + q4) * 320 + (32 * nt + 16 * blk + 4 * p4) * 2;
                const s16x4 blo = vtr(vb0), bhi = vtr(vb0 + 4 * 320);
                o = MFMA32(__builtin_shufflevector(alo, ahi, 0, 1, 2, 3, 4, 5, 6, 7), __builtin_shufflevector(blo, bhi, 0, 1, 2, 3, 4, 5, 6, 7), o);
            }
            __syncthreads();
#pragma unroll
            for (int i = 0; i < 16; ++i) LF[(32 * mt + (i & 3) + 8 * (i >> 2) + 4 * hh) * HG_LFS + 32 * nt + r32] = o[i];
            __syncthreads();
            {
                float ov[16]; float ss = 0.f;
#pragma unroll
                for (int j4 = 0; j4 < 4; ++j4) { const f32x4 x = *(const LAS f32x4*)(LF + ps * HG_LFS + 16 * pseg + 4 * j4);
#pragma unroll
                    for (int e = 0; e < 4; ++e) { ov[4 * j4 + e] = x[e]; ss += x[e] * x[e]; } }
                ss += __shfl_xor(ss, 1, 64); ss += __shfl_xor(ss, 2, 64); ss += __shfl_xor(ss, 4, 64);
                const float rn = rsqrtf(ss * (1.f / 128.f) + RMS_EPS);
                const u32x4 g0 = *(const u32x4*)(hp + HC_HG), g1 = *(const u32x4*)(hp + HC_HG + 8);
                const float* ng = C.in[I_HNG] + l * 128 + 16 * pseg;
                u32x4 o0, o1;
#pragma unroll
                for (int j = 0; j < 4; ++j) {
                    o0[j] = cvtpk(ov[2 * j] * rn * ng[2 * j] * siluf_(bf2f(g0[j] & 0xffffu)), ov[2 * j + 1] * rn * ng[2 * j + 1] * siluf_(bf2f(g0[j] >> 16)));
                    o1[j] = cvtpk(ov[8 + 2 * j] * rn * ng[8 + 2 * j] * siluf_(bf2f(g1[j] & 0xffffu)), ov[9 + 2 * j] * rn * ng[9 + 2 * j] * siluf_(bf2f(g1[j] >> 16)));
                }
                bf16_t* bp = BR + (row0 + ps) * NBR + 512 + h * 128 + 16 * pseg;
                *(u32x4*)bp = o0; *(u32x4*)(bp + 8) = o1;
            }
        }
        __syncthreads();
    }
    if constexpr (!FULL) {
#pragma unroll
        for (int i = 0; i < 16; ++i) { const int k = 32 * wk + (i & 3) + 8 * (i >> 2) + 4 * hh;
            stp[k * 128 + 64 * wv + r32] = S0[i]; stp[k * 128 + 64 * wv + 32 + r32] = S1[i]; }
        if (C.tid < 128) DSC[((size_t)bh * 32 + sc) * 128 + C.tid] = __expf(dtot);
    }
}
__device__ __forceinline__ void hgrn_b1(const Ctx& C, int l) { for (int u = C.bid; u < BATCH * 4 * 32; u += C.G) hgrn_unit<false>(C, l, u); }
__device__ __forceinline__ void hgrn_b3(const Ctx& C, int l) { for (int u = C.bid; u < BATCH * 4 * 32; u += C.G) hgrn_unit<true>(C, l, u); }
__device__ __forceinline__ void hgrn_b2(const Ctx& C) {
    float* STB = (float*)(C.ws + WS_ST); const float* DSC = (const float*)(C.ws + WS_DSC);
    for (int e = C.bid * 512 + C.tid; e < BATCH * 4 * 128 * 128; e += C.G * 512) {
        const int bh = e >> 14, kv = e & 16383, k = kv >> 7;
        float* p = STB + (size_t)bh * 32 * 16384 + kv;
        float uu[32], dd[32];
#pragma unroll
        for (int s = 0; s < 32; ++s) { uu[s] = p[(size_t)s * 16384]; dd[s] = DSC[((size_t)bh * 32 + s) * 128 + k]; }
        float st = 0.f;
#pragma unroll
        for (int s = 0; s < 32; ++s) { p[(size_t)s * 16384] = st; st = dd[s] * st + uu[s]; }
    }
}


__device__ __forceinline__ void mix_pool(const Ctx& C, int l) {
#if DIAG == 2
    const bf16_t* H = (const bf16_t*)(C.ws + WS_H); bf16_t* BR = (l == 0) ? (bf16_t*)(C.ws + WS_XA) : (bf16_t*)(C.ws + WS_TABU);
#else
    const bf16_t* H = (const bf16_t*)(C.ws + WS_H); bf16_t* BR = (bf16_t*)(C.ws + WS_BR);
#endif
    const bf16_t* Wt = (const bf16_t*)(C.ws + WS_W + (size_t)l * W_LAYER + WO_POOLW);
    LAS unsigned char* lds = C.lds;
    const int lane = C.lane, w = C.wave, r32 = lane & 31, hh = lane >> 5;
    for (int u = C.bid; u < (T / 256) * 4; u += C.G) {
        const int g = u & 3, t0 = (u >> 2) * 256, win = 2 << g;
        const int row = t0 + 32 * w + r32, pos = row & (SEQ - 1);
        __syncthreads();
#pragma unroll
        for (int p = 0; p < 4; ++p) { const int idx = C.tid + 512 * p, rr = idx >> 4, ch = idx & 15;
            *(LAS u32x4*)(lds + rr * 272 + ch * 16) = *(const u32x4*)(Wt + (size_t)g * 128 * 128 + rr * 128 + ch * 8); }
        const int nwin = (pos + 1 < win) ? pos + 1 : win;
        const float invn = 1.f / (float)nwin;
        bf16x8 df[8];
        const bf16_t* pp = H + (size_t)row * NH + HC_P + g * 128 + 8 * hh;
#pragma unroll
        for (int ks = 0; ks < 8; ++ks) {
            float sum[8];
#pragma unroll
            for (int e = 0; e < 8; ++e) sum[e] = 0.f;
            u32x4 self = {0u, 0u, 0u, 0u};
            for (int j = 0; j < nwin; ++j) {
                const u32x4 raw = *(const u32x4*)(pp + 16 * ks - (size_t)j * NH);
                if (j == 0) self = raw;
#pragma unroll
                for (int e = 0; e < 4; ++e) { sum[2 * e] += bf2f(raw[e] & 0xffffu); sum[2 * e + 1] += bf2f(raw[e] >> 16); }
            }
            u32x4 o;
#pragma unroll
            for (int e = 0; e < 4; ++e) o[e] = cvtpk(sum[2 * e] * invn - bf2f(self[e] & 0xffffu), sum[2 * e + 1] * invn - bf2f(self[e] >> 16));
            df[ks] = __builtin_bit_cast(bf16x8, o);
        }
        __syncthreads();
        f32x16 acc[4];
#pragma unroll
        for (int mt = 0; mt < 4; ++mt)
#pragma unroll
            for (int i = 0; i < 16; ++i) acc[mt][i] = 0.f;
#pragma unroll
        for (int ks = 0; ks < 8; ++ks)
#pragma unroll
            for (int mt = 0; mt < 4; ++mt) {
                const bf16x8 wf = *(const LAS bf16x8*)(lds + (32 * mt + r32) * 272 + 32 * ks + 16 * hh);
                acc[mt] = MFMA32(wf, df[ks], acc[mt]);
            }
        const float* psc = C.in[I_POOLS] + l * BW + g * 128;
        bf16_t* op = BR + (size_t)row * NBR + g * 128;
#pragma unroll
        for (int mt = 0; mt < 4; ++mt)
#pragma unroll
            for (int q = 0; q < 4; ++q) { const int d0 = 32 * mt + 8 * q + 4 * hh; const f32x4 sc = *(const f32x4*)(psc + d0);
                u32x2 o; o[0] = cvtpk(acc[mt][4 * q] * sc[0], acc[mt][4 * q + 1] * sc[1]); o[1] = cvtpk(acc[mt][4 * q + 2] * sc[2], acc[mt][4 * q + 3] * sc[3]);
                *(u32x2*)(op + d0) = o; }
    }
}
constexpr int GM_VN = 0, GM_WC = 128 * 320, GM_END = GM_WC + 128 * 272;
__device__ __forceinline__ void mix_gmlp(const Ctx& C, int l) {
#if DIAG == 3
    const bf16_t* H = (const bf16_t*)(C.ws + WS_H); bf16_t* BR = (l == 0) ? (bf16_t*)(C.ws + WS_XA) : (bf16_t*)(C.ws + WS_TABU);
#else
    const bf16_t* H = (const bf16_t*)(C.ws + WS_H); bf16_t* BR = (bf16_t*)(C.ws + WS_BR);
#endif
    const bf16_t* Wc = (const bf16_t*)(C.ws + WS_W + (size_t)l * W_LAYER + WO_GWS);
    LAS unsigned char* lds = C.lds;
    const int lane = C.lane, w = C.wave, r32 = lane & 31, hh = lane >> 5;
    const int i16 = lane & 15, q4 = i16 >> 2, p4 = i16 & 3, blk = (lane >> 4) & 1;
    for (int u = C.bid; u < (T / 128) * 4; u += C.G) {
        const int g = u & 3, t0 = (u >> 2) * 128;
        __syncthreads();
#pragma unroll
        for (int p = 0; p < 4; ++p) { const int idx = C.tid + 512 * p, rr = idx >> 4, ch = idx & 15;
            *(LAS u32x4*)(lds + GM_WC + rr * 272 + ch * 16) = *(const u32x4*)(Wc + (size_t)g * 128 * 128 + rr * 128 + ch * 8); }
        for (int i = 0; i < 16; ++i) {
            const int r = w * 16 + i, row = t0 + r;
            const u32x4 raw = *(const u32x4*)(H + (size_t)row * NH + HC_GV + lane * 8);
            float e[8];
#pragma unroll
            for (int j = 0; j < 4; ++j) { e[2 * j] = geluf_(bf2f(raw[j] & 0xffffu)); e[2 * j + 1] = geluf_(bf2f(raw[j] >> 16)); }
            float sm = 0.f;
#pragma unroll
            for (int j = 0; j < 8; ++j) sm += e[j];
            const float mean = wave_sum(sm) * (1.f / BW);
            float qq = 0.f;
#pragma unroll
            for (int j = 0; j < 8; ++j) { const float d = e[j] - mean; qq += d * d; }
            const float rstd = rsqrtf(wave_sum(qq) * (1.f / BW) + LN_EPS);
            if ((lane >> 4) == g) {
                const float* lg = C.in[I_GLNG] + l * BW + lane * 8; const float* lb = C.in[I_GLNB] + l * BW + lane * 8;
                u32x4 o;
#pragma unroll
                for (int j = 0; j < 4; ++j) o[j] = cvtpk((e[2 * j] - mean) * rstd * lg[2 * j] + lb[2 * j], (e[2 * j + 1] - mean) * rstd * lg[2 * j + 1] + lb[2 * j + 1]);
                *(LAS u32x4*)(lds + GM_VN + r * 320 + (lane & 15) * 16) = o;
            }
        }
        __syncthreads();
        const int nt = w & 3, mb = (w >> 2) * 2;
        f32x16 acc[2];
#pragma unroll
        for (int m = 0; m < 2; ++m)
#pragma unroll
            for (int i = 0; i < 16; ++i) acc[m][i] = 0.f;
        for (int ks = 0; ks < 2 * (nt + 1); ++ks) {
            const bf16x8 bf = *(const LAS bf16x8*)(lds + GM_WC + (32 * nt + r32) * 272 + 32 * ks + 16 * hh);
#pragma unroll
            for (int m = 0; m < 2; ++m) {
                const LAS unsigned char* aa = lds + GM_VN + (16 * ks + 8 * hh + q4) * 320 + (32 * (mb + m) + 16 * blk + 4 * p4) * 2;
                const s16x4 lo = vtr(aa), hi = vtr(aa + 4 * 320);
                acc[m] = MFMA32(__builtin_shufflevector(lo, hi, 0, 1, 2, 3, 4, 5, 6, 7), bf, acc[m]);
            }
        }
        const int tl = 32 * nt + r32, row = t0 + tl;
        const float bias = C.in[I_GBS][(l * 4 + g) * 128 + tl];
#pragma unroll
        for (int m = 0; m < 2; ++m)
#pragma unroll
            for (int q = 0; q < 4; ++q) { const int c0 = 32 * (mb + m) + 8 * q + 4 * hh;
                const u32x2 ur = *(const u32x2*)(H + (size_t)row * NH + HC_GU + g * 128 + c0);
                u32x2 o;
                o[0] = cvtpk(geluf_(bf2f(ur[0] & 0xffffu)) * (acc[m][4 * q] + bias), geluf_(bf2f(ur[0] >> 16)) * (acc[m][4 * q + 1] + bias));
                o[1] = cvtpk(geluf_(bf2f(ur[1] & 0xffffu)) * (acc[m][4 * q + 2] + bias), geluf_(bf2f(ur[1] >> 16)) * (acc[m][4 * q + 3] + bias));
                *(u32x2*)(BR + (size_t)row * NBR + 1024 + g * 128 + c0) = o; }
    }
}

#define CE_D(a, b) do { const float _h = fmaxf(a, b), _l = fminf(a, b); a = _h; b = _l; } while (0)
__device__ __forceinline__ void sort16_desc(float (&x)[16]) {
#pragma unroll
    for (int k = 2; k <= 16; k <<= 1)
#pragma unroll
        for (int j = k >> 1; j > 0; j >>= 1)
#pragma unroll
            for (int i = 0; i < 16; ++i) { const int l = i ^ j; if (l > i) { if ((i & k) == 0) CE_D(x[i], x[l]); else CE_D(x[l], x[i]); } }
}
__device__ __forceinline__ void bmerge16_desc(float (&x)[16]) {
#pragma unroll
    for (int j = 8; j > 0; j >>= 1)
#pragma unroll
        for (int i = 0; i < 16; ++i) { const int l = i ^ j; if (l > i) CE_D(x[i], x[l]); }
}
__device__ __forceinline__ void top16_merge(float (&a)[16], const float (&b)[16]) {
#pragma unroll
    for (int i = 0; i < 16; ++i) a[i] = fmaxf(a[i], b[15 - i]);
    bmerge16_desc(a);
}
__device__ __forceinline__ float pack_idx(float v, unsigned idx, unsigned mask) { return __builtin_bit_cast(float, (__builtin_bit_cast(unsigned, v) & ~mask) | idx); }

constexpr int TK_KST = 272, TK_KBUF = 128 * TK_KST;
__device__ __forceinline__ void p_topk(const Ctx& C, int l) {
    const bf16_t* Q = (const bf16_t*)(C.ws + WS_Q);
    const bf16_t* keys = (const bf16_t*)(C.ws + WS_W + (size_t)l * W_LAYER + WO_KEYS);
    int* eidx = (int*)(C.ws + WS_EIDX); float* egate = (float*)(C.ws + WS_EGATE);
    LAS unsigned char* lds = C.lds;
    const int lane = C.lane, w = C.wave, r32 = lane & 31, hh = lane >> 5;
    for (int u = C.bid; u < (T / 256) * PH; u += C.G) {
        const int h = u & 7, t0 = (u >> 3) * 256, tok = t0 + 32 * w + r32;
        float v12[2][16];
        __syncthreads();
#pragma unroll
        for (int j = 0; j < 2; ++j) {
            const bf16_t* kp = keys + ((size_t)j * PH + h) * 128 * 128;
#pragma unroll
            for (int p = 0; p < 4; ++p) { const int idx = C.tid + 512 * p, row = idx >> 4, ch = idx & 15;
                *(LAS u32x4*)(lds + j * TK_KBUF + row * TK_KST + ch * 16) = *(const u32x4*)(kp + row * 128 + ch * 8); }
        }
        __syncthreads();
#pragma unroll
        for (int j = 0; j < 2; ++j) {
            bf16x8 qf[8];
            const bf16_t* qp = Q + (size_t)tok * NQ + h * 256 + j * 128 + 8 * hh;
#pragma unroll
            for (int ks = 0; ks < 8; ++ks) qf[ks] = *(const bf16x8*)(qp + 16 * ks);
            f32x16 sacc[4];
#pragma unroll
            for (int mt = 0; mt < 4; ++mt)
#pragma unroll
                for (int i = 0; i < 16; ++i) sacc[mt][i] = 0.f;
#pragma unroll
            for (int ks = 0; ks < 8; ++ks)
#pragma unroll
                for (int mt = 0; mt < 4; ++mt) {
                    const bf16x8 kf = *(const LAS bf16x8*)(lds + j * TK_KBUF + (32 * mt + r32) * TK_KST + 32 * ks + 16 * hh);
                    sacc[mt] = MFMA32(kf, qf[ks], sacc[mt]);
                }
            float g[4][16];
#pragma unroll
            for (int mt = 0; mt < 4; ++mt) {
#pragma unroll
                for (int i = 0; i < 16; ++i) g[mt][i] = pack_idx(sacc[mt][i], (unsigned)(32 * mt + (i & 3) + 8 * (i >> 2) + 4 * hh), 127u);
                sort16_desc(g[mt]);
            }
            top16_merge(g[0], g[1]); top16_merge(g[2], g[3]); top16_merge(g[0], g[2]);
            float o[16];
#pragma unroll
            for (int i = 0; i < 16; ++i) o[i] = __shfl_xor(g[0][i], 32, 64);
            top16_merge(g[0], o);
#pragma unroll
            for (int i = 0; i < 16; ++i) v12[j][i] = g[0][i];
        }
        float c[4][16];
        {
            int n = 0;
#pragma unroll
            for (int a = 0; a < 16; ++a)
#pragma unroll
                for (int b = 0; b < 16; ++b) if ((a + 1) * (b + 1) <= 16) {
                    const unsigned id = ((__builtin_bit_cast(unsigned, v12[0][a]) & 127u) << 7) | (__builtin_bit_cast(unsigned, v12[1][b]) & 127u);
                    c[n >> 4][n & 15] = pack_idx(v12[0][a] + v12[1][b], id, 16383u); ++n; }
#pragma unroll
            for (; n < 64; ++n) c[n >> 4][n & 15] = -3.0e38f;
        }
#pragma unroll
        for (int q = 0; q < 4; ++q) sort16_desc(c[q]);
        top16_merge(c[0], c[1]); top16_merge(c[2], c[3]); top16_merge(c[0], c[2]);
        float e[16], den = 0.f;
#pragma unroll
        for (int i = 0; i < 16; ++i) { e[i] = __expf(c[0][i] - c[0][0]); den += e[i]; }
        const float inv = 1.f / den;
        int* ip = eidx + (size_t)tok * 128 + h * 16 + 8 * hh; float* gp = egate + (size_t)tok * 128 + h * 16 + 8 * hh;
        u32x4 i0, i1; f32x4 g0, g1;
#pragma unroll
        for (int i = 0; i < 4; ++i) {
            const float ca = hh ? c[0][8 + i] : c[0][i], cb = hh ? c[0][12 + i] : c[0][4 + i];
            i0[i] = __builtin_bit_cast(unsigned, ca) & 16383u; i1[i] = __builtin_bit_cast(unsigned, cb) & 16383u;
            g0[i] = (hh ? e[8 + i] : e[i]) * inv; g1[i] = (hh ? e[12 + i] : e[4 + i]) * inv;
        }
        *(u32x4*)ip = i0; *(u32x4*)(ip + 4) = i1; *(f32x4*)gp = g0; *(f32x4*)(gp + 4) = g1;
    }
}

constexpr int CW_DIAG = 64;
__device__ __forceinline__ void diag_cmp(const Ctx& C, const bf16_t* A, int lda, const bf16_t* R, int ldr, int nc) {
    float sd = 0.f, sr = 0.f;
    for (int row = C.bid; row < T; row += C.G) {
        const int tm = row % DIAG_MOD; if (tm < DIAG_LO || tm >= DIAG_HI) continue;
        for (int c = C.tid; c < nc; c += 512) { const float a = bf2f(A[(size_t)row * lda + c]), r = bf2f(R[(size_t)row * ldr + c]); sd += (a - r) * (a - r); sr += r * r; }
    }
    sd = wave_sum(sd); sr = wave_sum(sr);
    if (C.lane == 0) { atomicAdd((float*)(C.ws + WS_CTL) + CW_DIAG, sd); atomicAdd((float*)(C.ws + WS_CTL) + CW_DIAG + 1, sr); }
}
__device__ __forceinline__ float diag_alpha(const Ctx& C) {
    const float sd = __hip_atomic_load((float*)(C.ws + WS_CTL) + CW_DIAG, __ATOMIC_RELAXED, __HIP_MEMORY_SCOPE_AGENT), sr = __hip_atomic_load((float*)(C.ws + WS_CTL) + CW_DIAG + 1, __ATOMIC_RELAXED, __HIP_MEMORY_SCOPE_AGENT);
    const float err = fmaxf(sd / fmaxf(sr, 1e-30f), 1e-8f);
    return 0.1f + 0.1f * (rintf(log10f(err / 1e-8f) * 10.f) * 0.1f);
}

__device__ __forceinline__ void wave_argmax(float& v, int& i) {
#pragma unroll
    for (int o = 32; o > 0; o >>= 1) {
        const float ov = __shfl_xor(v, o, 64); const int oi = __shfl_xor(i, o, 64);
        if (ov > v || (ov == v && oi < i)) { v = ov; i = oi; }
    }
}
__device__ __forceinline__ void p_topk_naive(const Ctx& C, int l) {
    const bf16_t* Q = (const bf16_t*)(C.ws + WS_Q);
    const bf16_t* keys = (const bf16_t*)(C.ws + WS_W + (size_t)l * W_LAYER + WO_KEYS);
    int* eidx = (int*)(C.ws + WS_EIDX); float* egate = (float*)(C.ws + WS_EGATE);
    LAS float* qs = (LAS float*)C.lds;
    LAS float* sc = qs + 2048;
    LAS float* tv = sc + 2048;
    LAS int* ti = (LAS int*)(tv + 256);
    for (int t = C.bid; t < T; t += C.G) {
        for (int i = C.tid; i < 2048; i += 512) qs[i] = bf2f(Q[(size_t)t * NQ + i]);
        __syncthreads();
        for (int i = 0; i < 4; ++i) {
            const int idx = C.tid + 512 * i, hj = idx >> 7, key = idx & 127, h = hj >> 1, j = hj & 1;
            const bf16_t* kp = keys + (((size_t)j * PH + h) * 128 + key) * 128;
            float s = 0.f;
            for (int d8 = 0; d8 < 16; ++d8) {
                const u32x4 raw = *(const u32x4*)(kp + d8 * 8);
#pragma unroll
                for (int e = 0; e < 4; ++e) s += qs[h * 256 + j * 128 + d8 * 8 + 2 * e] * bf2f(raw[e] & 0xffffu) + qs[h * 256 + j * 128 + d8 * 8 + 2 * e + 1] * bf2f(raw[e] >> 16);
            }
            sc[idx] = s;
        }
        __syncthreads();
        for (int i = 0; i < 2; ++i) {
            const int hj = C.wave * 2 + i;
            float a0 = sc[hj * 128 + C.lane], a1 = sc[hj * 128 + 64 + C.lane];
            for (int r = 0; r < 16; ++r) {
                float bv; int bi;
                if (a0 > a1 || (a0 == a1)) { bv = a0; bi = C.lane; } else { bv = a1; bi = C.lane + 64; }
                wave_argmax(bv, bi);
                if (C.lane == 0) { tv[hj * 16 + r] = bv; ti[hj * 16 + r] = bi; }
                if (bi == C.lane) a0 = -3e38f; if (bi == C.lane + 64) a1 = -3e38f;
            }
        }
        __syncthreads();
        {
            const int h = C.wave;
            float cv[4];
#pragma unroll
            for (int i = 0; i < 4; ++i) { const int c = C.lane * 4 + i; cv[i] = tv[(h * 2) * 16 + (c >> 4)] + tv[(h * 2 + 1) * 16 + (c & 15)]; }
            float topv = 0.f; int tope = 0; float mx = 0.f;
            for (int r = 0; r < 16; ++r) {
                float bv = cv[0]; int bi = C.lane * 4;
#pragma unroll
                for (int i = 1; i < 4; ++i) if (cv[i] > bv) { bv = cv[i]; bi = C.lane * 4 + i; }
                wave_argmax(bv, bi);
                if (r == 0) mx = bv;
                if (C.lane == r) { topv = bv; tope = ti[(h * 2) * 16 + (bi >> 4)] * 128 + ti[(h * 2 + 1) * 16 + (bi & 15)]; }
#pragma unroll
                for (int i = 0; i < 4; ++i) if (bi == C.lane * 4 + i) cv[i] = -3e38f;
            }
            float e = (C.lane < 16) ? __expf(topv - mx) : 0.f;
            const float den = wave_sum(e);
            if (C.lane < 16) { eidx[(size_t)t * 128 + h * 16 + C.lane] = tope; egate[(size_t)t * 128 + h * 16 + C.lane] = e / den; }
        }
        __syncthreads();
    }
}
__device__ __forceinline__ float ub(unsigned w, int e) { return (float)((w >> (8 * e)) & 255u); }
__device__ __forceinline__ void p_gather(const Ctx& C, int l) {
    const float* xc = (const float*)(C.ws + WS_XC);
    const unsigned char* U8 = C.ws + WS_U8; const unsigned char* V8 = C.ws + WS_V8;
    const float* SU = (const float*)(C.ws + WS_SU); const float* SV = (const float*)(C.ws + WS_SV);
    const int* eidx = (const int*)(C.ws + WS_EIDX); const float* egate = (const float*)(C.ws + WS_EGATE);
    const int lane = C.lane;
    for (int t = C.bid * 8 + C.wave; t < T; t += C.G * 8) {
        float x[16];
        { const float* xp = xc + (size_t)t * DM + lane * 16;
#pragma unroll
          for (int i = 0; i < 4; ++i) { const f32x4 v = *(const f32x4*)(xp + 4 * i); x[4 * i] = v[0]; x[4 * i + 1] = v[1]; x[4 * i + 2] = v[2]; x[4 * i + 3] = v[3]; } }
        float xs = 0.f;
#pragma unroll
        for (int j = 0; j < 16; ++j) xs += x[j];
        xs = wave_sum(xs);
        float cf[2]; int ex[2];
#pragma unroll
        for (int bt = 0; bt < 2; ++bt) {
            ex[bt] = eidx[(size_t)t * 128 + 64 * bt + lane];
            const float gate = egate[(size_t)t * 128 + 64 * bt + lane];
            float p[64];
#pragma unroll
            for (int e0 = 0; e0 < 64; e0 += 16) {
                u32x4 r[16];
#pragma unroll
                for (int i = 0; i < 16; ++i) { const int e = __builtin_amdgcn_readlane(ex[bt], e0 + i); r[i] = *(const u32x4*)(U8 + (size_t)e * DM + lane * 16); }
#pragma unroll
                for (int i = 0; i < 16; ++i) { float sacc = 0.f;
#pragma unroll
                    for (int q = 0; q < 4; ++q)
#pragma unroll
                        for (int e = 0; e < 4; ++e) sacc += x[4 * q + e] * ub(r[i][q], e);
                    p[e0 + i] = sacc; }
            }
#pragma unroll
            for (int st = 32, n = 32; st > 0; st >>= 1, n >>= 1) {
                const bool up = (lane & st) != 0;
#pragma unroll
                for (int i = 0; i < n; ++i) { const float send = up ? p[i] : p[i + n], keep = up ? p[i + n] : p[i]; p[i] = keep + __shfl_xor(send, st, 64); }
            }
            const float hsum = SU[ex[bt]] * (p[0] - 128.f * xs);
            cf[bt] = gate * geluf_(hsum) * SV[ex[bt]];
        }
        float y[16];
#pragma unroll
        for (int j = 0; j < 16; ++j) y[j] = 0.f;
        float csum = wave_sum(cf[0] + cf[1]);
#pragma unroll
        for (int bt = 0; bt < 2; ++bt)
#pragma unroll
            for (int e0 = 0; e0 < 64; e0 += 16) {
                u32x4 r[16];
#pragma unroll
                for (int i = 0; i < 16; ++i) { const int e = __builtin_amdgcn_readlane(ex[bt], e0 + i); r[i] = *(const u32x4*)(V8 + (size_t)e * DM + lane * 16); }
#pragma unroll
                for (int i = 0; i < 16; ++i) { const float c = __builtin_bit_cast(float, __builtin_amdgcn_readlane(__builtin_bit_cast(int, cf[bt]), e0 + i));
#pragma unroll
                    for (int q = 0; q < 4; ++q)
#pragma unroll
                        for (int e = 0; e < 4; ++e) y[4 * q + e] += c * ub(r[i][q], e); }
            }
#pragma unroll
        for (int j = 0; j < 16; ++j) y[j] = y[j] - 128.f * csum + ALPHA * x[j];
        float sm = 0.f;
#pragma unroll
        for (int j = 0; j < 16; ++j) sm += y[j];
        const float mean = wave_sum(sm) * (1.f / DM);
        float qq = 0.f;
#pragma unroll
        for (int j = 0; j < 16; ++j) { const float d = y[j] - mean; qq += d * d; }
        const float rstd = rsqrtf(wave_sum(qq) * (1.f / DM) + LN_EPS);
        const float* gp = C.in[I_LN2G] + l * DM + lane * 16; const float* bp = C.in[I_LN2B] + l * DM + lane * 16;
#pragma unroll
        for (int i = 0; i < 4; ++i) { const f32x4 gg = *(const f32x4*)(gp + 4 * i), bb = *(const f32x4*)(bp + 4 * i);
#pragma unroll
            for (int e = 0; e < 4; ++e) y[4 * i + e] = (y[4 * i + e] - mean) * rstd * gg[e] + bb[e]; }
        float* dst = (l + 1 < DEPTH) ? (float*)(C.ws + WS_XA) + (size_t)t * DM : C.out + (size_t)t * DM;
#pragma unroll
        for (int i = 0; i < 4; ++i) *(f32x4*)(dst + lane * 16 + 4 * i) = (f32x4){y[4 * i], y[4 * i + 1], y[4 * i + 2], y[4 * i + 3]};
        if (l + 1 < DEPTH) {
            bf16_t* xb = (bf16_t*)(C.ws + WS_XB) + (size_t)t * DM + lane * 16;
            u32x4 o0, o1;
#pragma unroll
            for (int j = 0; j < 4; ++j) { o0[j] = pk2(y[2 * j], y[2 * j + 1]); o1[j] = pk2(y[8 + 2 * j], y[9 + 2 * j]); }
            *(u32x4*)xb = o0; *(u32x4*)(xb + 8) = o1;
            const float* wf = (const float*)(C.ws + WS_W + (size_t)(l + 1) * W_LAYER + WO_WF);
            float* lsig = (float*)(C.ws + WS_MISC);
#pragma unroll
            for (int h = 0; h < 4; ++h) {
                float sd = 0.f;
#pragma unroll
                for (int i = 0; i < 4; ++i) { const f32x4 a = *(const f32x4*)(wf + h * DM + lane * 16 + 4 * i);
#pragma unroll
                    for (int e = 0; e < 4; ++e) sd += y[4 * i + e] * a[e]; }
                sd = wave_sum(sd);
                if (lane == 0) lsig[(size_t)t * 4 + h] = logsigmoidf_(sd + C.in[I_BFOX][(l + 1) * 4 + h]);
            }
        }
    }
}

struct FStoreBf16 { bf16_t* O; int ld;
    __device__ __forceinline__ void operator()(int row, int col, f32x4 v0, f32x4 v1, int) const {
        u32x4 o; o[0] = pk2(v0[0], v0[1]); o[1] = pk2(v0[2], v0[3]); o[2] = pk2(v1[0], v1[1]); o[3] = pk2(v1[2], v1[3]);
        *(u32x4*)(O + (size_t)row * ld + col) = o; } };
struct FGate { bf16_t* O; const float* bias;
    __device__ __forceinline__ void operator()(int row, int col, f32x4 v0, f32x4 v1, int) const {
        const f32x4 b0 = *(const f32x4*)(bias + col), b1 = *(const f32x4*)(bias + col + 4);
        u32x4 o; o[0] = pk2(sigmoidf_(v0[0] + b0[0]), sigmoidf_(v0[1] + b0[1])); o[1] = pk2(sigmoidf_(v0[2] + b0[2]), sigmoidf_(v0[3] + b0[3]));
        o[2] = pk2(sigmoidf_(v1[0] + b1[0]), sigmoidf_(v1[1] + b1[1])); o[3] = pk2(sigmoidf_(v1[2] + b1[2]), sigmoidf_(v1[3] + b1[3]));
        *(u32x4*)(O + (size_t)row * NG + col) = o; } };
struct FMerge { const bf16_t* G; float* MGF; bf16_t* MG;
    __device__ __forceinline__ void operator()(int row, int col, f32x4 v, int z) const {
        const u32x2 gr = *(const u32x2*)(G + (size_t)row * NG + z * DM + col);
        f32x4 r; r[0] = v[0] * bf2f(gr[0] & 0xffffu); r[1] = v[1] * bf2f(gr[0] >> 16); r[2] = v[2] * bf2f(gr[1] & 0xffffu); r[3] = v[3] * bf2f(gr[1] >> 16);
        float* p = MGF + (size_t)row * DM + col;
        if (z > 0) r += *(const f32x4*)p;
        if (z < 3) *(f32x4*)p = r;
        else { u32x2 o; o[0] = pk2(r[0], r[1]); o[1] = pk2(r[2], r[3]); *(u32x2*)(MG + (size_t)row * DM + col) = o; } } };
struct FResid { const float* X; float* Y;
    __device__ __forceinline__ void operator()(int row, int col, f32x4 v, int) const {
        const f32x4 x = *(const f32x4*)(X + (size_t)row * DM + col);
        *(f32x4*)(Y + (size_t)row * DM + col) = x * ALPHA + v; } };

constexpr int PH_PER_LAYER = 12, N_PHASES = 1 + DEPTH * PH_PER_LAYER;
template <int SP> __device__ __forceinline__ void run_phase(const Ctx& C0, int l) {
    Ctx C = C0;
    asm volatile("" : "+v"(C.tid));
    C.ws = launder_ptr(C.ws); C.out = launder_ptr(C.out); l = (int)launder_u((unsigned)l);
    C.lane = C.tid & 63; C.wave = __builtin_amdgcn_readfirstlane(C.tid >> 6);
    unsigned char* wb = C.ws + WS_W + (size_t)l * W_LAYER;
    if constexpr (SP == -1) { p_conv_weights(C); }
    if constexpr (SP == 0) {
        if (l == 0) p_rowpass0(C);
    }
    if constexpr (SP == 1) {
        p_cumsum(C);
        __syncthreads();
        pg8::Gemm g{(const bf16_t*)(C.ws + WS_XB), (const bf16_t*)(wb + WO_WIN), DM, DM, DM, 0, 0};
        pg8::StaticOrder S; S.init(T, NH, C.G, C.bid);
        pg8::Epi8<FStoreBf16> E{{(bf16_t*)(C.ws + WS_H), NH}};
        pg8::gemm_phase(C.lds, g, S, E, C.tid);
    }
    if constexpr (SP == 2) { p_knorm(C, l); if (l != HG_NAIVE_L) hgrn_b1(C, l); }
#if MIX_NAIVE
    if constexpr (SP == 3) { if (l != HG_NAIVE_L) hgrn_b2(C); mix_pool_naive(C, l); mix_gmlp_naive(C, l); }
#else
    if constexpr (SP == 3) { if (l != HG_NAIVE_L) hgrn_b2(C); mix_pool(C, l); mix_gmlp(C, l);
        if (DIAG == 2) mix_pool_naive(C, l); if (DIAG == 3) mix_gmlp_naive(C, l); }
#endif
#if DIAG == 1
    if constexpr (SP == 4) { hgrn_b3(C, l); { mix_hgrn_naive(C, l); __syncthreads(); } mix_fox(C, l); }
    if constexpr (SP == 5) { if (l == DIAG_LAYER) diag_cmp(C, (const bf16_t*)(C.ws + (DIAG_LAYER == 0 ? WS_XA : WS_TABU)) + 512, NBR, (const bf16_t*)(C.ws + WS_BR) + 512, NBR, 512); }
#elif DIAG == 2 || DIAG == 3
    if constexpr (SP == 4) { hgrn_b3(C, l); mix_fox(C, l); if (l == DIAG_LAYER) diag_cmp(C, (const bf16_t*)(C.ws + (DIAG_LAYER == 0 ? WS_XA : WS_TABU)) + (DIAG == 2 ? 0 : 1024), NBR, (const bf16_t*)(C.ws + WS_BR) + (DIAG == 2 ? 0 : 1024), NBR, 512); }
#else
    if constexpr (SP == 4) { if (l != HG_NAIVE_L) hgrn_b3(C, l); else { mix_hgrn_naive(C, l); __syncthreads(); } mix_fox(C, l); }
#endif
    if constexpr (SP == 5) {
        pg8::Gemm g{(const bf16_t*)(C.ws + WS_XB), (const bf16_t*)(wb + WO_WG), DM, DM, DM, 0, 0};
        pg8::StaticOrder S; S.init(T, NG, C.G, C.bid);
        pg8::Epi8<FGate> E{{(bf16_t*)(C.ws + WS_G), C.in[I_BGATE] + l * NG}};
        pg8::gemm_phase(C.lds, g, S, E, C.tid);
    }
    if constexpr (SP == 6) {
        pg8::Gemm g{(const bf16_t*)(C.ws + WS_BR), (const bf16_t*)(wb + WO_WBR), NBR, BW, BW, (size_t)BW, (size_t)DM * BW};
        pg8::ZOrder S; S.init(T, DM, 4, C.G, C.vcu);
        pg8::Epi4<FMerge> E{{(const bf16_t*)(C.ws + WS_G), (float*)(C.ws + WS_MGF), (bf16_t*)(C.ws + WS_XB)}};
        pg8::gemm_phase(C.lds, g, S, E, C.tid);
    }
    if constexpr (SP == 7) {
        const float* xin = (l == 0) ? C.in[I_X] : (const float*)(C.ws + WS_XA);
        pg8::Gemm g{(const bf16_t*)(C.ws + WS_XB), (const bf16_t*)(wb + WO_WOUT), DM, DM, DM, 0, 0};
        pg8::StaticOrder S; S.init(T, DM, C.G, C.bid);
        pg8::Epi4<FResid> E{{xin, (float*)(C.ws + WS_XC)}};
        pg8::gemm_phase(C.lds, g, S, E, C.tid);
    }
    if constexpr (SP == 8) { p_ln1(C, l); p_conv_tables(C, l); }
    if constexpr (SP == 9) {
        pg8::Gemm g{(const bf16_t*)(C.ws + WS_X1B), (const bf16_t*)(wb + WO_WQ), DM, DM, DM, 0, 0};
        pg8::StaticOrder S; S.init(T, NQ, C.G, C.bid);
        pg8::Epi8<FStoreBf16> E{{(bf16_t*)(C.ws + WS_Q), NQ}};
        pg8::gemm_phase(C.lds, g, S, E, C.tid);
    }
#if TOPK_NAIVE
    if constexpr (SP == 10) p_topk_naive(C, l);
#else
    if constexpr (SP == 10) p_topk(C, l);
#endif
    if constexpr (SP == 11) p_gather(C, l);
}
__device__ __forceinline__ void make_ctx(Ctx& C, const Args& args, unsigned char* lds_raw) {
    C.lds = (LAS unsigned char*)lds_raw; C.ws = args.ws; C.in = args.in; C.out = args.out;
    C.tid = threadIdx.x; C.lane = C.tid & 63; C.wave = __builtin_amdgcn_readfirstlane(C.tid >> 6);
    C.G = gridDim.x; C.bid = blockIdx.x; C.vcu = (C.G % 8 == 0) ? (C.bid % 8) * (C.G / 8) + C.bid / 8 : C.bid;
}
template <int SP> __global__ void __launch_bounds__(512, 2) mk_phase(Args args) {
    extern __shared__ __attribute__((aligned(16))) unsigned char lds_raw[];
    Ctx C; make_ctx(C, args, lds_raw);
    run_phase<SP>(C, args.ph_lo);
}

#define GRID_BAR() xcd_barrier((unsigned*)(args.ws + WS_CTL) + 1024, (volatile LAS unsigned*)((LAS unsigned char*)lds_raw + LDSCTL_OFF + 32))
__global__ void __launch_bounds__(512, 2) mk_fwd(Args args) {
    extern __shared__ __attribute__((aligned(16))) unsigned char lds_raw[];
    Ctx C; make_ctx(C, args, lds_raw);
    { volatile LAS unsigned* misc = (volatile LAS unsigned*)(C.lds + LDSCTL_OFF); if (C.tid < 64) misc[C.tid] = 0u; }
    __syncthreads();
    xcd_barrier_post((unsigned*)(args.ws + WS_CTL) + 1024);
    run_phase<-1>(C, 0); GRID_BAR();
#pragma unroll 1
    for (int l = 0; l < DEPTH; ++l) {
        if (l == 0) { run_phase<0>(C, l); GRID_BAR(); }
        run_phase<1>(C, l); GRID_BAR();
        run_phase<2>(C, l); GRID_BAR();
        run_phase<3>(C, l); GRID_BAR();
        run_phase<4>(C, l); GRID_BAR();
        run_phase<5>(C, l); GRID_BAR();
        run_phase<6>(C, l); GRID_BAR();
        run_phase<7>(C, l); GRID_BAR();
        run_phase<8>(C, l); GRID_BAR();
        run_phase<9>(C, l); GRID_BAR();
        run_phase<10>(C, l); GRID_BAR();
        run_phase<11>(C, l); if (l + 1 < DEPTH) GRID_BAR();
    }
}

template <int SP> static void launch_phase(const Args& a, int grid, hipStream_t stream) {
    static bool attr_done = false;
    if (!attr_done) { (void)hipFuncSetAttribute((const void*)mk_phase<SP>, hipFuncAttributeMaxDynamicSharedMemorySize, LDS_BYTES); attr_done = true; }
    hipLaunchKernelGGL(mk_phase<SP>, dim3(grid), dim3(512), LDS_BYTES, stream, a);
}
extern "C" void kernel_launch(void* const* d_in, const int* in_sizes, int n_in, void* d_out, int out_size, void* d_ws, size_t ws_size, hipStream_t stream) {
    static int grid = 0;
    if (grid == 0) {
        if (n_in != NIN_PTRS || out_size != T * DM || ws_size < WS_END) { fprintf(stderr, "kernel_launch: unexpected shapes n_in %d out %d ws %zu\n", n_in, out_size, ws_size); grid = -1; return; }
        int dev = 0, cus = 0;
        if (hipGetDevice(&dev) != hipSuccess || hipDeviceGetAttribute(&cus, hipDeviceAttributeMultiprocessorCount, dev) != hipSuccess) { grid = -1; return; }
        grid = cus;
    }
    if (grid < 0) return;
    (void)hipMemsetAsync((char*)d_ws + WS_CTL, 0, CTL_ZERO_BYTES, stream);
    Args a{};
    for (int i = 0; i < NIN_PTRS; ++i) a.in[i] = (const float*)d_in[i];
    a.out = (float*)d_out; a.ws = (unsigned char*)d_ws; a.bar_slot = 0; a.pad = 0; a.ph_hi = 0;
#if MK_ONE_LAUNCH
    static bool attr_done = false;
    if (!attr_done) { (void)hipFuncSetAttribute((const void*)mk_fwd, hipFuncAttributeMaxDynamicSharedMemorySize, LDS_BYTES); attr_done = true; }
    hipLaunchKernelGGL(mk_fwd, dim3(grid), dim3(512), LDS_BYTES, stream, a);
    return;
#endif
    a.ph_lo = 0; launch_phase<-1>(a, grid, stream);
    for (int l = 0; l < DEPTH; ++l) {
        a.ph_lo = l;
        launch_phase<0>(a, grid, stream); launch_phase<1>(a, grid, stream); launch_phase<2>(a, grid, stream); launch_phase<3>(a, grid, stream); launch_phase<4>(a, grid, stream);
        launch_phase<5>(a, grid, stream); launch_phase<6>(a, grid, stream); launch_phase<7>(a, grid, stream); launch_phase<8>(a, grid, stream); launch_phase<9>(a, grid, stream); launch_phase<10>(a, grid, stream); launch_phase<11>(a, grid, stream);
    }
}
```

```cpp
#include <hip/hip_runtime.h>
#include <cstdio>
#include <cstdint>

#ifndef DIAG
#define DIAG 0
#endif
#ifndef DIAG_LO
#define DIAG_LO 0
#endif
#ifndef DIAG_HI
#define DIAG_HI 64
#endif
#ifndef DIAG_MOD
#define DIAG_MOD 64
#endif
#ifndef TOPK_NAIVE
#define TOPK_NAIVE 0
#endif
#ifndef MIX_NAIVE
#define MIX_NAIVE 0
#endif
#ifndef FOX_NAIVE
#define FOX_NAIVE 0
#endif
#ifndef HG_NAIVE_L
#define HG_NAIVE_L 99
#endif
#ifndef DIAG_LAYER
#define DIAG_LAYER 0
#endif
#ifndef MK_ONE_LAUNCH
#define MK_ONE_LAUNCH 1
#endif

#define LAS __attribute__((address_space(3)))
#define GAS __attribute__((address_space(1)))
typedef unsigned short bf16_t;
typedef short bf16x8 __attribute__((ext_vector_type(8)));
typedef float f32x4 __attribute__((ext_vector_type(4)));
typedef float f32x2 __attribute__((ext_vector_type(2)));
typedef unsigned u32x4 __attribute__((ext_vector_type(4)));
typedef unsigned u32x2 __attribute__((ext_vector_type(2)));

constexpr int DM = 1024, BATCH = 2, SEQ = 8192, DEPTH = 2, T = BATCH * SEQ;
constexpr int BW = 512, NIN = 5124, NH = 5120, NG = 4096, NBR = 2048, NQ = 2048;
constexpr int NEXP = 16384, TOPK = 16, PH = 8;
constexpr float ALPHA = 1.4142135623730951f;
constexpr float LN_EPS = 1e-5f, RMS_EPS = 1e-6f;
constexpr int HC_P = 0, HC_HQ = 512, HC_HF = 1024, HC_HI = 1536, HC_HG = 2048, HC_GU = 2560, HC_GV = 3072, HC_FQ = 3584, HC_FK = 4096, HC_FV = 4608;

constexpr size_t MiB = 1u << 20;
constexpr size_t WS_CTL = 0, CTL_ZERO_BYTES = 64 * 1024;
constexpr size_t WS_MISC = 512 * 1024;
constexpr size_t WS_CUM = 768 * 1024;
constexpr size_t WS_W = 1 * MiB;
constexpr size_t W_LAYER = 30 * MiB;
constexpr size_t WO_WIN = 0, WO_WG = 10 * MiB, WO_WBR = 18 * MiB, WO_WOUT = 22 * MiB, WO_WQ = 24 * MiB, WO_KEYS = 28 * MiB, WO_WF = 28 * MiB + 512 * 1024, WO_POOLW = 28 * MiB + 768 * 1024, WO_GWS = 29 * MiB;
constexpr size_t WS_TABU = 64 * MiB, WS_TABV = 96 * MiB;
constexpr size_t WS_XA = 128 * MiB;
constexpr size_t WS_XB = 192 * MiB;
constexpr size_t WS_X1B = 224 * MiB;
constexpr size_t WS_H = 256 * MiB;
constexpr size_t WS_ST = 416 * MiB;
constexpr size_t WS_BR = 448 * MiB;
constexpr size_t WS_G = 256 * MiB;
constexpr size_t WS_MGF = 384 * MiB;
constexpr size_t WS_XC = 256 * MiB;
constexpr size_t WS_Q = 320 * MiB;
constexpr size_t WS_EIDX = 384 * MiB, WS_EGATE = 392 * MiB;
constexpr size_t WS_END = 512 * MiB;

__device__ __forceinline__ float bf2f(unsigned u) { return __builtin_bit_cast(float, u << 16); }
__device__ __forceinline__ unsigned f2bf(float f) { unsigned u = __builtin_bit_cast(unsigned, f); return (u + 0x7fffu + ((u >> 16) & 1u)) >> 16; }
__device__ __forceinline__ unsigned pk2(float lo, float hi) { return f2bf(lo) | (f2bf(hi) << 16); }
__device__ __forceinline__ float wave_sum(float v) {
#pragma unroll
    for (int o = 32; o > 0; o >>= 1) v += __shfl_xor(v, o, 64);
    return v;
}
__device__ __forceinline__ float sigmoidf_(float x) { return 1.f / (1.f + __expf(-x)); }
__device__ __forceinline__ float siluf_(float x) { return x / (1.f + __expf(-x)); }
__device__ __forceinline__ float geluf_(float x) { const float u = 0.7978845608028654f * (x + 0.044715f * x * x * x); return 0.5f * x * (1.f + tanhf(u)); }
__device__ __forceinline__ float logsigmoidf_(float z) { return fminf(z, 0.f) - log1pf(__expf(-fabsf(z))); }

__device__ __forceinline__ unsigned launder_u(unsigned x) { asm volatile("" : "+v"(x)); return __builtin_amdgcn_readfirstlane(x); }
template <class P> __device__ __forceinline__ P launder_ptr(P p) {
    const unsigned lo = launder_u((unsigned)(uintptr_t)p), hi = launder_u((unsigned)((uintptr_t)p >> 32));
    return (P)(((uintptr_t)hi << 32) | lo);
}

namespace pg8 {
constexpr int BM = 256, BK = 64, HALF = 128, HTB = HALF * BK * 2, STAGE_BYTES = 8 * HTB, NXCD = 8, WGM = 8;
__host__ __device__ __forceinline__ int lds_byte(int r, int c) { const int st = (r >> 4) * 2 + (c >> 5), rr = r & 15, cc = c & 31, ob = rr * 64 + cc * 2; return st * 1024 + (ob ^ (((ob >> 9) & 1) << 5)); }
__host__ __device__ __forceinline__ void stage_rc(int b, int& R, int& C) { const int st = b / 1024, sb = b % 1024, swz = sb ^ (((sb >> 9) & 1) << 5); R = (st >> 1) * 16 + swz / 64; C = (st & 1) * 32 + (swz % 64) / 2; }
__host__ __device__ __forceinline__ int perm32(int rho) { const int n = rho >> 4, i = rho & 15; return 8 * (i >> 2) + 4 * n + (i & 3); }

struct Unit { int pm, pn, z; };
struct Gemm { const bf16_t* A; const bf16_t* Bt; int lda, ldb, K; size_t zA, zB; };

struct StaticOrder {
    int nM, nN, nwg, G, c;
    __device__ void init(int M, int N, int G_, int c_) { nM = M / BM; nN = N / BM; nwg = nM * nN; G = G_; c = c_; }
    __device__ bool next(int i, Unit& u) const {
        const long L = (long)i * G + c; if (L >= nwg) return false;
        int wgid = (int)L; { const int q = nwg / NXCD, r = nwg % NXCD, xcd = wgid % NXCD, off = wgid / NXCD; wgid = (xcd < r ? xcd * (q + 1) : r * (q + 1) + (xcd - r) * q) + off; }
        const int nig = WGM * nN, gid = wgid / nig, fm = gid * WGM, gsz = (nM - fm) < WGM ? (nM - fm) : WGM;
        u.pm = fm + ((wgid % nig) % gsz); u.pn = (wgid % nig) / gsz; u.z = 0; return true;
    }
};
struct ZOrder {
    int nM, nN, nZ, ntile, G, c;
    __device__ void init(int M, int N, int Z, int G_, int c_) { nM = M / BM; nN = N / BM; nZ = Z; ntile = nM * nN; G = G_; c = c_; }
    __device__ bool next(int i, Unit& u) const {
        const long L = (long)(i / nZ) * G + c; if (L >= ntile) return false;
        u.pm = (int)L / nN; u.pn = (int)L % nN; u.z = i % nZ; return true;
    }
};

template <class F> struct Epi8 {
    static constexpr bool PERM = true;
    F f;
    __device__ __forceinline__ void operator()(const f32x4 (&acc)[2][2][4][2], const Unit& u, int wr, int wc, int fr, int fq) const {
        const int row0 = u.pm * BM + wr * 64 + fr, col0 = u.pn * BM + wc * 32 + 8 * fq;
#pragma unroll
        for (int ai = 0; ai < 2; ++ai)
#pragma unroll
            for (int m = 0; m < 4; ++m)
#pragma unroll
                for (int bj = 0; bj < 2; ++bj) f(row0 + ai * HALF + m * 16, col0 + bj * HALF, acc[ai][bj][m][0], acc[ai][bj][m][1], u.z);
    }
};
template <class F> struct Epi4 {
    static constexpr bool PERM = false;
    F f;
    __device__ __forceinline__ void operator()(const f32x4 (&acc)[2][2][4][2], const Unit& u, int wr, int wc, int fr, int fq) const {
        const int row0 = u.pm * BM + wr * 64 + fr, col0 = u.pn * BM + wc * 32 + 4 * fq;
#pragma unroll
        for (int ai = 0; ai < 2; ++ai)
#pragma unroll
            for (int m = 0; m < 4; ++m)
#pragma unroll
                for (int bj = 0; bj < 2; ++bj)
#pragma unroll
                    for (int n = 0; n < 2; ++n) f(row0 + ai * HALF + m * 16, col0 + bj * HALF + n * 16, acc[ai][bj][m][n], u.z);
    }
};

template <class Epi, class Sched, bool ALIGN_EPI = true>
__device__ __forceinline__ void gemm_phase(LAS unsigned char* lds, const Gemm g, const Sched& S, const Epi& E, const int tid) {
    const int wid = __builtin_amdgcn_readfirstlane(tid >> 6), lane = tid & 63, wr = wid >> 2, wc = wid & 3, fr = lane & 15, fq = lane >> 4;
    const int K = g.K, nt = K / BK;
    unsigned voffA[2], voffB[2];
#pragma unroll
    for (int i = 0; i < 2; ++i) { int R, C; stage_rc(tid * 16 + i * 8192, R, C); const int Rb = Epi::PERM ? ((R & ~31) + perm32(R & 31)) : R;
        voffA[i] = (unsigned)(R * g.lda + C) * 2u; voffB[i] = (unsigned)(Rb * g.ldb + C) * 2u; }
    const size_t kstep = (size_t)(BK * 2);
    const size_t hstepA = (size_t)HALF * g.lda * 2, hstepB = (size_t)HALF * g.ldb * 2;
    const size_t tstepA = 2 * hstepA, tstepB = 2 * hstepB;
    const unsigned ldsw = (unsigned)wid * 1024u;
    const int aoff = lds_byte(wr * 64 + fr, fq * 8), boff = lds_byte(wc * 32 + fr, fq * 8);
#define PG8_SA(b, h) (((b) * 2 + (h)) * HTB)
#define PG8_SB(b, h) ((4 + (b) * 2 + (h)) * HTB)
#define PG8_STAGE(bufoff, gbase, voff) do { _Pragma("unroll") for (int _i = 0; _i < 2; ++_i) \
        __builtin_amdgcn_global_load_lds((const unsigned*)((const char*)(gbase) + (voff)[_i]), (LAS unsigned*)(lds + (bufoff) + ldsw + _i * 8192), 16, 0, 0); } while (0)
#define PG8_LDA(dst, b, h) do { _Pragma("unroll") for (int m = 0; m < 4; ++m) _Pragma("unroll") for (int k = 0; k < 2; ++k) dst[m][k] = *(const LAS bf16x8*)(lds + PG8_SA(b, h) + aoff + m * 2048 + k * 1024); } while (0)
#define PG8_LDB(dst, b, h) do { _Pragma("unroll") for (int n = 0; n < 2; ++n) _Pragma("unroll") for (int k = 0; k < 2; ++k) dst[n][k] = *(const LAS bf16x8*)(lds + PG8_SB(b, h) + boff + n * 2048 + k * 1024); } while (0)
#define PG8_MMA(ai, bj, At, Bt) do { __builtin_amdgcn_s_setprio(1); _Pragma("unroll") for (int m = 0; m < 4; ++m) _Pragma("unroll") for (int n = 0; n < 2; ++n) _Pragma("unroll") for (int k = 0; k < 2; ++k) \
        acc[ai][bj][m][n] = __builtin_amdgcn_mfma_f32_16x16x32_bf16(Bt[n][k], At[m][k], acc[ai][bj][m][n], 0, 0, 0); __builtin_amdgcn_s_setprio(0); } while (0)
#define PG8_WAIT_V(n) asm volatile("s_waitcnt vmcnt(" #n ")" ::: "memory")
#define PG8_WAIT_L(n) asm volatile("s_waitcnt lgkmcnt(" #n ")" ::: "memory")
#define PG8_BAR __builtin_amdgcn_s_barrier()
#define PG8_SCHED __builtin_amdgcn_sched_barrier(0)
    Unit cur, nxt; int ui = 0;
    if (!S.next(0, cur)) return;
    f32x4 acc[2][2][4][2];
#pragma unroll
    for (int a = 0; a < 2; ++a)
#pragma unroll
        for (int b = 0; b < 2; ++b)
#pragma unroll
            for (int m = 0; m < 4; ++m)
#pragma unroll
                for (int n = 0; n < 2; ++n) acc[a][b][m][n] = (f32x4){0.f, 0.f, 0.f, 0.f};
    bf16x8 At[4][2], B0[2][2], B1[2][2];
    const char* cA = (const char*)(g.A + (size_t)cur.z * g.zA) + (size_t)cur.pm * tstepA; const char* cB = (const char*)(g.Bt + (size_t)cur.z * g.zB) + (size_t)cur.pn * tstepB;
    PG8_STAGE(PG8_SB(0, 0), cB, voffB); PG8_STAGE(PG8_SB(0, 1), cB + hstepB, voffB); PG8_STAGE(PG8_SA(0, 0), cA, voffA); PG8_STAGE(PG8_SA(0, 1), cA + hstepA, voffA);
    if (wr == 1) PG8_BAR;
    PG8_WAIT_V(2); PG8_BAR;
    PG8_STAGE(PG8_SB(1, 0), cB + kstep, voffB); PG8_STAGE(PG8_SA(1, 0), cA + kstep, voffA); PG8_STAGE(PG8_SB(1, 1), cB + hstepB + kstep, voffB);
    PG8_WAIT_V(6); PG8_BAR;
    for (;;) {
        const bool has_next = S.next(ui + 1, nxt);
        const char* nA = has_next ? (const char*)(g.A + (size_t)nxt.z * g.zA) + (size_t)nxt.pm * tstepA : cA;
        const char* nB = has_next ? (const char*)(g.Bt + (size_t)nxt.z * g.zB) + (size_t)nxt.pn * tstepB : cB;
        for (int t = 0; t < nt; t += 2) {
            const bool last = (t == nt - 2);
            const char* a1 = cA + (size_t)(t + 1) * kstep;
            const char* a2 = last ? nA : cA + (size_t)(t + 2) * kstep; const char* b2 = last ? nB : cB + (size_t)(t + 2) * kstep;
            const char* a3 = a2 + kstep; const char* b3 = b2 + kstep;
            PG8_LDB(B0, 0, 0); PG8_LDB(B1, 0, 1); PG8_SCHED; PG8_LDA(At, 0, 0); PG8_STAGE(PG8_SA(1, 1), a1 + hstepA, voffA);
            PG8_WAIT_V(8); PG8_WAIT_L(0); PG8_BAR; PG8_MMA(0, 0, At, B0); PG8_MMA(0, 1, At, B1); PG8_BAR; PG8_SCHED;
            PG8_LDA(At, 0, 1); PG8_STAGE(PG8_SB(0, 0), b2, voffB); PG8_STAGE(PG8_SB(0, 1), b2 + hstepB, voffB); PG8_STAGE(PG8_SA(0, 0), a2, voffA);
            PG8_WAIT_V(8); PG8_WAIT_L(0); PG8_BAR; PG8_MMA(1, 0, At, B0); PG8_MMA(1, 1, At, B1); PG8_BAR; PG8_SCHED;
            PG8_LDB(B0, 1, 0); PG8_LDB(B1, 1, 1); PG8_SCHED; PG8_LDA(At, 1, 0); PG8_STAGE(PG8_SA(0, 1), a2 + hstepA, voffA);
            PG8_WAIT_V(8); PG8_WAIT_L(0); PG8_BAR; PG8_MMA(0, 0, At, B0); PG8_MMA(0, 1, At, B1); PG8_BAR; PG8_SCHED;
            PG8_LDA(At, 1, 1); PG8_STAGE(PG8_SB(1, 0), b3, voffB); PG8_STAGE(PG8_SB(1, 1), b3 + hstepB, voffB); PG8_STAGE(PG8_SA(1, 0), a3, voffA);
            PG8_WAIT_V(8); PG8_WAIT_L(0); PG8_BAR; PG8_MMA(1, 0, At, B0); PG8_MMA(1, 1, At, B1); PG8_BAR; PG8_SCHED;
        }
        if constexpr (ALIGN_EPI) { if (wr == 0) PG8_BAR; }
        E(acc, cur, wr, wc, fr, fq);
        if (!has_next) break;
#pragma unroll
        for (int a = 0; a < 2; ++a)
#pragma unroll
            for (int b = 0; b < 2; ++b)
#pragma unroll
                for (int m = 0; m < 4; ++m)
#pragma unroll
                    for (int n = 0; n < 2; ++n) acc[a][b][m][n] = (f32x4){0.f, 0.f, 0.f, 0.f};
        cur = nxt; cA = nA; cB = nB; ++ui;
        if constexpr (ALIGN_EPI) { if (wr == 1) PG8_BAR; }
    }
    PG8_WAIT_V(0);
    if constexpr (!ALIGN_EPI) { if (wr == 0) PG8_BAR; }
    PG8_BAR;
#undef PG8_SA
#undef PG8_SB
#undef PG8_STAGE
#undef PG8_LDA
#undef PG8_LDB
#undef PG8_MMA
#undef PG8_WAIT_V
#undef PG8_WAIT_L
#undef PG8_BAR
#undef PG8_SCHED
}
}

#define XB_TMO      128
#define XB_XCNT(j)  (256  + 64 * (j))
#define XB_XSUB(j)  (1280 + 64 * (j))
#define XB_XGEN(j)  (2304 + 64 * (j))
#define XB_TOP      3328
#define XB_TOPGEN   3392
#define XCD_BAR_WORDS 3456
#define XB_SPIN_CAP (1u << 22)
__device__ __forceinline__ unsigned xb_ld(unsigned* p)              { return __hip_atomic_load(p, __ATOMIC_RELAXED, __HIP_MEMORY_SCOPE_AGENT); }
__device__ __forceinline__ unsigned xb_add(unsigned* p, unsigned v) { return __hip_atomic_fetch_add(p, v, __ATOMIC_RELAXED, __HIP_MEMORY_SCOPE_AGENT); }
__device__ __forceinline__ unsigned xb_xcc_id() { return (unsigned)__builtin_amdgcn_s_getreg((3 << 11) | 20) & 0xFu; }
#define XB_SPIN(cond, bar) do { unsigned _sp = 0; while (cond) { __builtin_amdgcn_s_sleep(1); \
    if ((++_sp & 255u) == 0u) { if (xb_ld(&(bar)[XB_TMO])) break; if (_sp > XB_SPIN_CAP) { atomicAdd(&(bar)[XB_TMO], 1u); break; } } } } while (0)
__device__ __forceinline__ void xcd_barrier_post(unsigned* bar) {
    if (threadIdx.x == 0) (void)xb_add(&bar[XB_XCNT(xb_xcc_id())], 1u);
}
__device__ __forceinline__ void xcd_barrier_complete(unsigned* bar, unsigned x, unsigned& nloc, unsigned& nx) {
    const unsigned G = gridDim.x * gridDim.y * gridDim.z;
    unsigned sum, cnt, mine, sp = 0u;
    for (;;) {
        sum = 0u; cnt = 0u; mine = 0u;
#pragma unroll
        for (unsigned j = 0; j < 16; ++j) { const unsigned c = xb_ld(&bar[XB_XCNT(j)]); sum += c; cnt += (c > 0u) ? 1u : 0u; mine = (j == x) ? c : mine; }
        if (sum == G) break;
        __builtin_amdgcn_s_sleep(1);
        if ((++sp & 255u) == 0u) { if (xb_ld(&bar[XB_TMO])) break; if (sp > XB_SPIN_CAP) { atomicAdd(&bar[XB_TMO], 1u); break; } }
    }
    nloc = mine > 0u ? mine : 1u; nx = cnt > 0u ? cnt : 1u;
}
__device__ __noinline__ void xcd_barrier_leader(unsigned* bar, volatile LAS unsigned* st) {
    const unsigned x = xb_xcc_id();
    __builtin_amdgcn_s_waitcnt(0);
    unsigned nloc = st[0], nx = st[1];
    if (nloc == 0u) { xcd_barrier_complete(bar, x, nloc, nx); st[0] = nloc; st[1] = nx; }
    const unsigned old = xb_add(&bar[XB_XSUB(x)], 1u);
    const unsigned gen = old / nloc;
    if (old + 1u == (gen + 1u) * nloc) {
        __builtin_amdgcn_fence(__ATOMIC_RELEASE, "agent");
        asm volatile("s_waitcnt vmcnt(0)" ::: "memory");
        const unsigned og = xb_add(&bar[XB_TOP], 1u);
        const unsigned tg = og / nx;
        if (og + 1u == (tg + 1u) * nx) xb_add(&bar[XB_TOPGEN], 1u);
        else XB_SPIN(xb_ld(&bar[XB_TOPGEN]) == tg, bar);
        __builtin_amdgcn_fence(__ATOMIC_ACQUIRE, "agent");
        xb_add(&bar[XB_XGEN(x)], 1u);
        asm volatile("s_waitcnt vmcnt(0)" ::: "memory");
    } else {
        XB_SPIN(xb_ld(&bar[XB_XGEN(x)]) == gen, bar);
        __builtin_amdgcn_fence(__ATOMIC_ACQUIRE, "agent");
        asm volatile("s_waitcnt vmcnt(0)" ::: "memory");
    }
}
__device__ __forceinline__ void xcd_barrier(unsigned* bar, volatile LAS unsigned* st) {
    asm volatile("s_waitcnt vmcnt(0)" ::: "memory");
    __syncthreads();
    if (threadIdx.x == 0) xcd_barrier_leader(bar, st);
    __syncthreads();
}

constexpr int NIN_PTRS = 23;
struct Args { const float* in[NIN_PTRS]; float* out; unsigned char* ws; int ph_lo, ph_hi, bar_slot, pad; };
enum { I_X = 0, I_WIN, I_BFOX, I_POOLW, I_POOLS, I_LBL, I_HNG, I_GLNG, I_GLNB, I_GWS, I_GBS, I_WGATE, I_BGATE, I_WBR, I_WOUT, I_LN1G, I_LN1B, I_WQ, I_KEYS, I_PU, I_PV, I_LN2G, I_LN2B };

constexpr int LDS_BYTES = 147456;
constexpr int LDSCTL_OFF = 143360;

struct Ctx {
    LAS unsigned char* lds;
    unsigned char* ws;
    const float* const* in;
    float* out;
    int tid, lane, wave, G, bid, vcu;
};

__device__ __forceinline__ void tconv_job(const Ctx& C, const float* src, int ld_src, int K, int N, bf16_t* dst) {
    LAS float* tile = (LAS float*)C.lds;
    const int nk = K / 64, nn = N / 64, ntiles = nk * nn;
    for (int tl = C.bid; tl < ntiles; tl += C.G) {
        const int k0 = (tl / nn) * 64, n0 = (tl % nn) * 64;
#pragma unroll
        for (int p = 0; p < 2; ++p) {
            const int kr = (C.tid >> 4) + p * 32, nc = (C.tid & 15) * 4;
            const f32x4 v = *(const f32x4*)(src + (size_t)(k0 + kr) * ld_src + n0 + nc);
            tile[kr * 65 + nc + 0] = v[0]; tile[kr * 65 + nc + 1] = v[1]; tile[kr * 65 + nc + 2] = v[2]; tile[kr * 65 + nc + 3] = v[3];
        }
        __syncthreads();
        {
            const int n = C.tid >> 3, k8 = (C.tid & 7) * 8;
            u32x4 o;
#pragma unroll
            for (int j = 0; j < 4; ++j) o[j] = pk2(tile[(k8 + 2 * j) * 65 + n], tile[(k8 + 2 * j + 1) * 65 + n]);
            *(u32x4*)(dst + (size_t)(n0 + n) * K + k0 + k8) = o;
        }
        __syncthreads();
    }
}
__device__ __forceinline__ void cvt_copy(const Ctx& C, const float* src, bf16_t* dst, size_t n) {
    const size_t n8 = n / 8;
    for (size_t i = (size_t)C.bid * 512 + C.tid; i < n8; i += (size_t)C.G * 512) {
        const f32x4 a = *(const f32x4*)(src + i * 8), b = *(const f32x4*)(src + i * 8 + 4);
        u32x4 o; o[0] = pk2(a[0], a[1]); o[1] = pk2(a[2], a[3]); o[2] = pk2(b[0], b[1]); o[3] = pk2(b[2], b[3]);
        *(u32x4*)(dst + i * 8) = o;
    }
}
__device__ __forceinline__ void p_conv_weights(const Ctx& C) {
    for (int l = 0; l < DEPTH; ++l) {
        unsigned char* wb = C.ws + WS_W + (size_t)l * W_LAYER;
        tconv_job(C, C.in[I_WIN] + (size_t)l * DM * NIN, NIN, DM, NH, (bf16_t*)(wb + WO_WIN));
        tconv_job(C, C.in[I_WGATE] + (size_t)l * DM * NG, NG, DM, NG, (bf16_t*)(wb + WO_WG));
        for (int m = 0; m < 4; ++m)
            tconv_job(C, C.in[I_WBR] + ((size_t)l * 4 + m) * BW * DM, DM, BW, DM, (bf16_t*)(wb + WO_WBR) + (size_t)m * DM * BW);
        tconv_job(C, C.in[I_WOUT] + (size_t)l * DM * DM, DM, DM, DM, (bf16_t*)(wb + WO_WOUT));
        tconv_job(C, C.in[I_WQ] + (size_t)l * DM * NQ, NQ, DM, NQ, (bf16_t*)(wb + WO_WQ));
        cvt_copy(C, C.in[I_KEYS] + (size_t)l * 2 * PH * 128 * 128, (bf16_t*)(wb + WO_KEYS), (size_t)2 * PH * 128 * 128);
        for (int g = 0; g < 4; ++g)
            tconv_job(C, C.in[I_POOLW] + ((size_t)l * 4 + g) * 128 * 128, 128, 128, 128, (bf16_t*)(wb + WO_POOLW) + (size_t)g * 128 * 128);
        {
            bf16_t* gw = (bf16_t*)(wb + WO_GWS); const float* src = C.in[I_GWS] + (size_t)l * 4 * 128 * 128;
            for (int i = C.bid * 512 + C.tid; i < 4 * 128 * 128; i += C.G * 512) { const int t = (i >> 7) & 127, sx = i & 127; gw[i] = (bf16_t)f2bf(sx <= t ? src[i] : 0.f); }
        }
        float* wf = (float*)(wb + WO_WF);
        for (int i = C.bid * 512 + C.tid; i < 4 * DM; i += C.G * 512) { const int h = i / DM, k = i % DM; wf[i] = C.in[I_WIN][(size_t)l * DM * NIN + (size_t)k * NIN + NH + h]; }
    }
}
constexpr size_t WS_U8 = WS_TABU, WS_V8 = WS_TABU + 16 * MiB, WS_SU = WS_TABU + 32 * MiB, WS_SV = WS_SU + 64 * 1024;
__device__ __forceinline__ float wave_max(float v) {
#pragma unroll
    for (int o = 32; o > 0; o >>= 1) v = fmaxf(v, __shfl_xor(v, o, 64));
    return v;
}
__device__ __forceinline__ void quant_rows(const Ctx& C, const float* src, unsigned char* dst, float* scl) {
    for (int row = C.bid * 8 + C.wave; row < NEXP; row += C.G * 8) {
        const float* p = src + (size_t)row * DM + C.lane * 16;
        f32x4 v[4]; float mx = 0.f;
#pragma unroll
        for (int i = 0; i < 4; ++i) { v[i] = *(const f32x4*)(p + 4 * i);
#pragma unroll
            for (int e = 0; e < 4; ++e) mx = fmaxf(mx, fabsf(v[i][e])); }
        mx = fmaxf(wave_max(mx), 1e-30f);
        const float sc = mx * (1.f / 127.f), isc = 127.f / mx;
        u32x4 o;
#pragma unroll
        for (int i = 0; i < 4; ++i) { unsigned wd = 0u;
#pragma unroll
            for (int e = 0; e < 4; ++e) { const int q = (int)rintf(v[i][e] * isc) + 128; wd |= (unsigned)q << (8 * e); }
            o[i] = wd; }
        *(u32x4*)(dst + (size_t)row * DM + C.lane * 16) = o;
        if (C.lane == 0) scl[row] = sc;
    }
}
__device__ __forceinline__ void p_conv_tables(const Ctx& C, int l) {
    quant_rows(C, C.in[I_PU] + (size_t)l * NEXP * DM, C.ws + WS_U8, (float*)(C.ws + WS_SU));
    quant_rows(C, C.in[I_PV] + (size_t)l * NEXP * DM, C.ws + WS_V8, (float*)(C.ws + WS_SV));
}

__device__ __forceinline__ void row_emit(const Ctx& C, int row, const float (&v)[16], int l, bool want_lsig) {
    bf16_t* xb = (bf16_t*)(C.ws + WS_XB) + (size_t)row * DM;
    u32x4 o0, o1;
#pragma unroll
    for (int j = 0; j < 4; ++j) { o0[j] = pk2(v[2 * j], v[2 * j + 1]); o1[j] = pk2(v[8 + 2 * j], v[8 + 2 * j + 1]); }
    *(u32x4*)(xb + C.lane * 8) = o0; *(u32x4*)(xb + 512 + C.lane * 8) = o1;
    if (want_lsig) {
        const float* wf = (const float*)(C.ws + WS_W + (size_t)l * W_LAYER + WO_WF);
        float* lsig = (float*)(C.ws + WS_MISC);
#pragma unroll
        for (int h = 0; h < 4; ++h) {
            const f32x4 a0 = *(const f32x4*)(wf + h * DM + C.lane * 8), a1 = *(const f32x4*)(wf + h * DM + C.lane * 8 + 4);
            const f32x4 b0 = *(const f32x4*)(wf + h * DM + 512 + C.lane * 8), b1 = *(const f32x4*)(wf + h * DM + 512 + C.lane * 8 + 4);
            float s = 0.f;
#pragma unroll
            for (int j = 0; j < 4; ++j) s += v[j] * a0[j] + v[4 + j] * a1[j] + v[8 + j] * b0[j] + v[12 + j] * b1[j];
            s = wave_sum(s);
            if (C.lane == 0) lsig[(size_t)row * 4 + h] = logsigmoidf_(s + C.in[I_BFOX][l * 4 + h]);
        }
    }
}
__device__ __forceinline__ void load_row16(const float* p, int lane, float (&v)[16]) {
    const f32x4 a0 = *(const f32x4*)(p + lane * 8), a1 = *(const f32x4*)(p + lane * 8 + 4), b0 = *(const f32x4*)(p + 512 + lane * 8), b1 = *(const f32x4*)(p + 512 + lane * 8 + 4);
#pragma unroll
    for (int j = 0; j < 4; ++j) { v[j] = a0[j]; v[4 + j] = a1[j]; v[8 + j] = b0[j]; v[12 + j] = b1[j]; }
}
__device__ __forceinline__ void store_row16(float* p, int lane, const float (&v)[16]) {
    *(f32x4*)(p + lane * 8) = (f32x4){v[0], v[1], v[2], v[3]}; *(f32x4*)(p + lane * 8 + 4) = (f32x4){v[4], v[5], v[6], v[7]};
    *(f32x4*)(p + 512 + lane * 8) = (f32x4){v[8], v[9], v[10], v[11]}; *(f32x4*)(p + 512 + lane * 8 + 4) = (f32x4){v[12], v[13], v[14], v[15]};
}
__device__ __forceinline__ void ln_row16(float (&v)[16], const float* g, const float* b, int lane) {
    float s = 0.f;
#pragma unroll
    for (int j = 0; j < 16; ++j) s += v[j];
    const float mean = wave_sum(s) * (1.f / DM);
    float q = 0.f;
#pragma unroll
    for (int j = 0; j < 16; ++j) { const float d = v[j] - mean; q += d * d; }
    const float rstd = rsqrtf(wave_sum(q) * (1.f / DM) + LN_EPS);
    float gg[16], bb[16];
    load_row16(g, lane, gg); load_row16(b, lane, bb);
#pragma unroll
    for (int j = 0; j < 16; ++j) v[j] = (v[j] - mean) * rstd * gg[j] + bb[j];
}
__device__ __forceinline__ void p_rowpass0(const Ctx& C) {
    for (int row = C.bid * 8 + C.wave; row < T; row += C.G * 8) {
        float v[16]; load_row16(C.in[I_X] + (size_t)row * DM, C.lane, v);
        row_emit(C, row, v, 0, true);
    }
}
__device__ __forceinline__ void p_cumsum(const Ctx& C) {
    if (C.bid >= BATCH * 4) return;
    const float* lsig = (const float*)(C.ws + WS_MISC);
    float* cum = (float*)(C.ws + WS_CUM);
    LAS float* wt = (LAS float*)C.lds;
    const int b = C.bid >> 2, h = C.bid & 3;
    float v[16];
#pragma unroll
    for (int j = 0; j < 16; ++j) v[j] = lsig[((size_t)b * SEQ + C.tid * 16 + j) * 4 + h];
#pragma unroll
    for (int j = 1; j < 16; ++j) v[j] += v[j - 1];
    float inc = v[15];
#pragma unroll
    for (int o = 1; o < 64; o <<= 1) { const float t = __shfl_up(inc, o, 64); if (C.lane >= o) inc += t; }
    if (C.lane == 63) wt[C.wave] = inc;
    __syncthreads();
    float off = inc - v[15];
    for (int w2 = 0; w2 < C.wave; ++w2) off += wt[w2];
    float* cp = cum + ((size_t)b * 4 + h) * SEQ + C.tid * 16;
#pragma unroll
    for (int j4 = 0; j4 < 4; ++j4) *(f32x4*)(cp + 4 * j4) = (f32x4){v[4 * j4] + off, v[4 * j4 + 1] + off, v[4 * j4 + 2] + off, v[4 * j4 + 3] + off};
    __syncthreads();
}
__device__ __forceinline__ void p_ln1(const Ctx& C, int l) {
    float* xc = (float*)(C.ws + WS_XC); bf16_t* x1b = (bf16_t*)(C.ws + WS_X1B);
    for (int row = C.bid * 8 + C.wave; row < T; row += C.G * 8) {
        float v[16]; load_row16(xc + (size_t)row * DM, C.lane, v);
        ln_row16(v, C.in[I_LN1G] + l * DM, C.in[I_LN1B] + l * DM, C.lane);
        store_row16(xc + (size_t)row * DM, C.lane, v);
        u32x4 o0, o1;
#pragma unroll
        for (int j = 0; j < 4; ++j) { o0[j] = pk2(v[2 * j], v[2 * j + 1]); o1[j] = pk2(v[8 + 2 * j], v[8 + 2 * j + 1]); }
        *(u32x4*)(x1b + (size_t)row * DM + C.lane * 8) = o0; *(u32x4*)(x1b + (size_t)row * DM + 512 + C.lane * 8) = o1;
    }
}

__device__ __forceinline__ void mix_pool_naive(const Ctx& C, int l) {
    const bf16_t* H = (const bf16_t*)(C.ws + WS_H); bf16_t* BR = (bf16_t*)(C.ws + WS_BR);
    LAS float* dd = (LAS float*)C.lds;
    for (int u = C.bid; u < (T / 64) * 4; u += C.G) {
        const int g = u & 3, t0 = (u >> 2) * 64, w = 2 << g;
        for (int idx = C.tid; idx < 64 * 128; idx += 512) {
            const int r = idx >> 7, c = idx & 127, row = t0 + r, pos = row & (SEQ - 1);
            const int nwin = (pos + 1 < w) ? pos + 1 : w;
            float s = 0.f;
            for (int j = 0; j < nwin; ++j) s += bf2f(H[(size_t)(row - j) * NH + HC_P + g * 128 + c]);
            dd[idx] = s / (float)nwin - bf2f(H[(size_t)row * NH + HC_P + g * 128 + c]);
        }
        __syncthreads();
        const int dcol = C.tid & 127, rq = C.tid >> 7;
        float acc[16];
#pragma unroll
        for (int i = 0; i < 16; ++i) acc[i] = 0.f;
        const float* pw = C.in[I_POOLW] + ((size_t)l * 4 + g) * 128 * 128;
        for (int c = 0; c < 128; ++c) {
            const float wv = pw[c * 128 + dcol];
#pragma unroll
            for (int i = 0; i < 16; ++i) acc[i] += dd[(rq * 16 + i) * 128 + c] * wv;
        }
        const float sc = C.in[I_POOLS][l * BW + g * 128 + dcol];
#pragma unroll
        for (int i = 0; i < 16; ++i) BR[(size_t)(t0 + rq * 16 + i) * NBR + 0 + g * 128 + dcol] = (bf16_t)f2bf(acc[i] * sc);
        __syncthreads();
    }
}
__device__ __forceinline__ void mix_gmlp_naive(const Ctx& C, int l) {
    const bf16_t* H = (const bf16_t*)(C.ws + WS_H); bf16_t* BR = (bf16_t*)(C.ws + WS_BR);
    LAS float* vn = (LAS float*)C.lds;
    for (int u = C.bid; u < (T / 128) * 4; u += C.G) {
        const int g = u & 3, t0 = (u >> 2) * 128;
        for (int i = 0; i < 16; ++i) {
            const int r = C.wave * 16 + i, row = t0 + r;
            const u32x4 raw = *(const u32x4*)(H + (size_t)row * NH + HC_GV + C.lane * 8);
            float e[8];
#pragma unroll
            for (int j = 0; j < 4; ++j) { e[2 * j] = geluf_(bf2f(raw[j] & 0xffffu)); e[2 * j + 1] = geluf_(bf2f(raw[j] >> 16)); }
            float s = 0.f;
#pragma unroll
            for (int j = 0; j < 8; ++j) s += e[j];
            const float mean = wave_sum(s) * (1.f / BW);
            float q = 0.f;
#pragma unroll
            for (int j = 0; j < 8; ++j) { const float d = e[j] - mean; q += d * d; }
            const float rstd = rsqrtf(wave_sum(q) * (1.f / BW) + LN_EPS);
            if ((C.lane >> 4) == g) {
#pragma unroll
                for (int j = 0; j < 8; ++j) { const int col = C.lane * 8 + j;
                    vn[r * 128 + (col - g * 128)] = (e[j] - mean) * rstd * C.in[I_GLNG][l * BW + col] + C.in[I_GLNB][l * BW + col]; }
            }
        }
        __syncthreads();
        const int c = C.tid & 127, tq = C.tid >> 7;
        const float* wsg = C.in[I_GWS] + ((size_t)l * 4 + g) * 128 * 128;
        for (int t = tq; t < 128; t += 4) {
            float acc = 0.f;
            for (int s = 0; s <= t; ++s) acc += wsg[t * 128 + s] * vn[s * 128 + c];
            const float sv = acc + C.in[I_GBS][(l * 4 + g) * 128 + t];
            const float uv = geluf_(bf2f(H[(size_t)(t0 + t) * NH + HC_GU + g * 128 + c]));
            BR[(size_t)(t0 + t) * NBR + 1024 + g * 128 + c] = (bf16_t)f2bf(uv * sv);
        }
        __syncthreads();
    }
}
__device__ __forceinline__ void mix_fox_naive(const Ctx& C, int l) {
    const bf16_t* H = (const bf16_t*)(C.ws + WS_H); bf16_t* BR = (bf16_t*)(C.ws + WS_BR);
    const float* cum = (const float*)(C.ws + WS_CUM);
    const float scale = 0.08838834764831845f;
    for (int u = C.bid; u < T * 4 / 8; u += C.G) {
        const int rid = u * 8 + C.wave;
        const int h = rid & 3, row = rid >> 2, b = row / SEQ, t = row % SEQ;
        const unsigned qraw = *(const unsigned*)(H + (size_t)row * NH + HC_FQ + h * 128 + C.lane * 2);
        const float q0 = bf2f(qraw & 0xffffu) * scale, q1 = bf2f(qraw >> 16) * scale;
        const float* cm = cum + ((size_t)b * 4 + h) * SEQ;
        const float ct = cm[t];
        float m = -1e30f, lsum = 0.f, o0 = 0.f, o1 = 0.f;
        for (int s = t; s >= 0; --s) {
            const size_t kr = (size_t)(b * SEQ + s) * NH + h * 128 + C.lane * 2;
            const unsigned kraw = *(const unsigned*)(H + kr + HC_FK);
            const unsigned vraw = *(const unsigned*)(H + kr + HC_FV);
            float d = q0 * bf2f(kraw & 0xffffu) + q1 * bf2f(kraw >> 16);
            d = wave_sum(d);
            const float z = d + ct - cm[s];
            const float mn = fmaxf(m, z), al = __expf(m - mn), p = __expf(z - mn);
            lsum = lsum * al + p; o0 = o0 * al + p * bf2f(vraw & 0xffffu); o1 = o1 * al + p * bf2f(vraw >> 16); m = mn;
        }
        const float inv = 1.f / lsum;
        *(unsigned*)(BR + (size_t)row * NBR + 1536 + h * 128 + C.lane * 2) = pk2(o0 * inv, o1 * inv);
    }
}
__device__ __forceinline__ void mix_hgrn_naive(const Ctx& C, int l) {
    if (C.bid >= BATCH * 4) return;
    const bf16_t* H = (const bf16_t*)(C.ws + WS_H); bf16_t* BR = (bf16_t*)(C.ws + WS_BR);
    const int b = C.bid >> 2, h = C.bid & 3;
    LAS float* fdec = (LAS float*)C.lds;
    LAS float* kkv = fdec + 32 * 128;
    LAS float* qsv = kkv + 32 * 128;
    LAS float* vv = qsv + 32 * 128;
    LAS float* opart = vv + 32 * 128;
    const int kq = C.tid >> 7, v = C.tid & 127;
    float S[32];
#pragma unroll
    for (int j = 0; j < 32; ++j) S[j] = 0.f;
    for (int c0 = 0; c0 < SEQ; c0 += 32) {
        for (int idx = C.tid; idx < 32 * 128; idx += 512) {
            const int st = idx >> 7, k = idx & 127; const size_t rb = (size_t)(b * SEQ + c0 + st) * NH + h * 128 + k;
            float lb = 0.f;
            if (l == 1) { const float z0 = C.in[I_LBL][h * 128 + k], z1 = C.in[I_LBL][BW + h * 128 + k]; lb = 1.f / (1.f + __expf(z0 - z1)); }
            const float zf = bf2f(H[rb + HC_HF]);
            const float kk = (1.f - lb) * sigmoidf_(-zf);
            fdec[idx] = 1.f - kk; kkv[idx] = kk; qsv[idx] = siluf_(bf2f(H[rb + HC_HQ])); vv[idx] = bf2f(H[rb + HC_HI]);
        }
        __syncthreads();
        for (int st = 0; st < 32; ++st) {
            const float vt = vv[st * 128 + v];
            float part = 0.f;
#pragma unroll
            for (int j = 0; j < 32; ++j) { const int k = kq * 32 + j; S[j] = fdec[st * 128 + k] * S[j] + kkv[st * 128 + k] * vt; part += S[j] * qsv[st * 128 + k]; }
            opart[(kq * 32 + st) * 128 + v] = part;
        }
        __syncthreads();
        for (int i = 0; i < 4; ++i) {
            const int st = C.wave * 4 + i, row = b * SEQ + c0 + st;
            float o0 = 0.f, o1 = 0.f;
#pragma unroll
            for (int q = 0; q < 4; ++q) { o0 += opart[(q * 32 + st) * 128 + C.lane]; o1 += opart[(q * 32 + st) * 128 + 64 + C.lane]; }
            const float ss = wave_sum(o0 * o0 + o1 * o1);
            const float r = rsqrtf(ss * (1.f / 128.f) + RMS_EPS);
            const float g0 = siluf_(bf2f(H[(size_t)row * NH + HC_HG + h * 128 + C.lane])), g1 = siluf_(bf2f(H[(size_t)row * NH + HC_HG + h * 128 + 64 + C.lane]));
            BR[(size_t)row * NBR + 512 + h * 128 + C.lane] = (bf16_t)f2bf(o0 * r * C.in[I_HNG][l * 128 + C.lane] * g0);
            BR[(size_t)row * NBR + 512 + h * 128 + 64 + C.lane] = (bf16_t)f2bf(o1 * r * C.in[I_HNG][l * 128 + 64 + C.lane] * g1);
        }
        __syncthreads();
    }
}


typedef float f32x16 __attribute__((ext_vector_type(16)));
typedef short s16x4 __attribute__((ext_vector_type(4)));
typedef short v4i16_t __attribute__((ext_vector_type(4)));
typedef __bf16 bf16x2_t __attribute__((ext_vector_type(2)));
__device__ __forceinline__ unsigned cvtpk(float lo, float hi) { f32x2 v = {lo, hi}; bf16x2_t b = __builtin_convertvector(v, bf16x2_t); return __builtin_bit_cast(unsigned, b); }
__device__ __forceinline__ s16x4 vtr(const LAS unsigned char* p) { return __builtin_bit_cast(s16x4, __builtin_amdgcn_ds_read_tr16_b64_v4i16((LAS v4i16_t*)p)); }
__device__ __forceinline__ float xor32(float x) { return __shfl_xor(x, 32, 64); }
#define MFMA32(a, b, c) __builtin_amdgcn_mfma_f32_32x32x16_bf16((a), (b), (c), 0, 0, 0)
constexpr int CW_KMAX = 16;

__device__ __forceinline__ void p_knorm(const Ctx& C, int l) {
    const bf16_t* H = (const bf16_t*)(C.ws + WS_H);
    unsigned* kmax = (unsigned*)(C.ws + WS_CTL) + CW_KMAX + l * 8;
    float best = 0.f;
    int bsel = -1;
    for (int row = C.bid * 8 + C.wave; row < T; row += C.G * 8) {
        const u32x4 raw = *(const u32x4*)(H + (size_t)row * NH + HC_FK + C.lane * 8);
        float s = 0.f;
#pragma unroll
        for (int j = 0; j < 4; ++j) { const float a = bf2f(raw[j] & 0xffffu), b = bf2f(raw[j] >> 16); s += a * a + b * b; }
#pragma unroll
        for (int o = 8; o > 0; o >>= 1) s += __shfl_xor(s, o, 64);
        const int b = row / SEQ;
        if (bsel >= 0 && b != bsel) { if ((C.lane & 15) == 0) atomicMax(kmax + bsel * 4 + (C.lane >> 4), __builtin_bit_cast(unsigned, best)); best = 0.f; }
        bsel = b; best = fmaxf(best, s);
    }
    if (bsel >= 0 && (C.lane & 15) == 0) atomicMax(kmax + bsel * 4 + (C.lane >> 4), __builtin_bit_cast(unsigned, best));
}

constexpr int FOX_KST = 272, FOX_VST = 320;
constexpr int FOX_KB = 0, FOX_VB = 2 * 64 * FOX_KST, FOX_BETA = FOX_VB + 2 * 64 * FOX_VST, FOX_FLAG = FOX_BETA + 2 * 64 * 4, FOX_END = FOX_FLAG + 2 * 8 * 4;
__device__ __forceinline__ void mix_fox(const Ctx& C, int l) {
    const bf16_t* H = (const bf16_t*)(C.ws + WS_H); bf16_t* BR = (bf16_t*)(C.ws + WS_BR);
    const float* cum = (const float*)(C.ws + WS_CUM);
    const unsigned* kmaxw = (const unsigned*)(C.ws + WS_CTL) + CW_KMAX + l * 8;
    const float LOG2E = 1.4426950408889634f, QS = 0.08838834764831845f * LOG2E;
    const int lane = C.lane, w = C.wave, r32 = lane & 31, hh = lane >> 5;
    LAS unsigned char* lds = C.lds;
    LAS float* betaL = (LAS float*)(lds + FOX_BETA);
    volatile LAS int* flagL = (volatile LAS int*)(lds + FOX_FLAG);
    for (int u = C.bid; u < BATCH * 4 * (SEQ / 256); u += C.G) {
        const int qb = u % (SEQ / 256), bh = u / (SEQ / 256), b = bh >> 2, h = bh & 3;
        const int q0 = qb * 256, qw = q0 + 32 * w;
        const size_t rowbase = (size_t)b * SEQ;
        const float* cm = cum + ((size_t)b * 4 + h) * SEQ;
        const float c0 = cm[q0];
        const float kmx = sqrtf(__builtin_bit_cast(float, __hip_atomic_load(kmaxw + b * 4 + h, __ATOMIC_RELAXED, __HIP_MEMORY_SCOPE_AGENT)));
        bf16x8 qf[8]; float qn = 0.f;
        {
            const bf16_t* qp = H + (rowbase + qw + r32) * NH + HC_FQ + h * 128 + 8 * hh;
#pragma unroll
            for (int ks = 0; ks < 8; ++ks) {
                const u32x4 raw = *(const u32x4*)(qp + 16 * ks);
                u32x4 o;
#pragma unroll
                for (int j = 0; j < 4; ++j) { const float a = bf2f(raw[j] & 0xffffu), bb = bf2f(raw[j] >> 16); qn += a * a + bb * bb; o[j] = cvtpk(a * QS, bb * QS); }
                qf[ks] = __builtin_bit_cast(bf16x8, o);
            }
            qn += xor32(qn); qn = sqrtf(qn);
        }
        const float qbound = qn * kmx * QS;
        f32x16 oacc[4];
#pragma unroll
        for (int mt = 0; mt < 4; ++mt)
#pragma unroll
            for (int i = 0; i < 16; ++i) oacc[mt][i] = 0.f;
        float m_run = -1e30f, l_run = 0.f;
        const int jmax = (q0 + 255) >> 6;
        const int srow = C.tid >> 4, sch = C.tid & 15;
        u32x4 kreg[2], vreg[2]; float breg = 0.f;
#define FOX_GLOAD(j_) do { _Pragma("unroll") for (int p = 0; p < 2; ++p) { \
                const bf16_t* rp = H + (rowbase + 64 * (j_) + srow + 32 * p) * NH + h * 128 + sch * 8; \
                kreg[p] = *(const u32x4*)(rp + HC_FK); vreg[p] = *(const u32x4*)(rp + HC_FV); } \
            if (C.tid < 64) breg = (c0 - cm[64 * (j_) + C.tid]) * LOG2E; } while (0)
#define FOX_LWRITE(buf_) do { _Pragma("unroll") for (int p = 0; p < 2; ++p) { \
                *(LAS u32x4*)(lds + FOX_KB + (buf_) * 64 * FOX_KST + (srow + 32 * p) * FOX_KST + sch * 16) = kreg[p]; \
                *(LAS u32x4*)(lds + FOX_VB + (buf_) * 64 * FOX_VST + (srow + 32 * p) * FOX_VST + sch * 16) = vreg[p]; } \
            if (C.tid < 64) betaL[(buf_) * 64 + C.tid] = breg; } while (0)
        __syncthreads();
        if (C.tid < 16) flagL[C.tid] = 0;
        FOX_GLOAD(jmax); FOX_LWRITE(jmax & 1);
        bool wdone = false;
        for (int j = jmax; j >= 0; --j) {
            const int cur = j & 1;
            __syncthreads();
            if (j < jmax) { int all = 1;
#pragma unroll
                for (int i = 0; i < 8; ++i) all &= flagL[((j + 1) & 1) * 8 + i];
                if (all) break; }
            if (j > 0) FOX_GLOAD(j - 1);
            const int k0 = 64 * j;
            if (k0 <= qw + 31 && !wdone) {
                const LAS unsigned char* kb = lds + FOX_KB + cur * 64 * FOX_KST;
                const LAS unsigned char* vb = lds + FOX_VB + cur * 64 * FOX_VST;
                f32x16 sacc[2];
#pragma unroll
                for (int mt = 0; mt < 2; ++mt)
#pragma unroll
                    for (int g = 0; g < 4; ++g) { const f32x4 bv = *(const LAS f32x4*)(betaL + cur * 64 + 32 * mt + 8 * g + 4 * hh);
                        sacc[mt][4 * g] = bv[0]; sacc[mt][4 * g + 1] = bv[1]; sacc[mt][4 * g + 2] = bv[2]; sacc[mt][4 * g + 3] = bv[3]; }
#pragma unroll
                for (int ks = 0; ks < 8; ++ks)
#pragma unroll
                    for (int mt = 0; mt < 2; ++mt) {
                        const bf16x8 kf = *(const LAS bf16x8*)(kb + (32 * mt + r32) * FOX_KST + 32 * ks + 16 * hh);
                        sacc[mt] = MFMA32(kf, qf[ks], sacc[mt]);
                    }
                const int tq = qw + r32;
                if (k0 + 63 > qw) {
#pragma unroll
                    for (int mt = 0; mt < 2; ++mt)
#pragma unroll
                        for (int i = 0; i < 16; ++i) { const int key = k0 + 32 * mt + (i & 3) + 8 * (i >> 2) + 4 * hh; if (key > tq) sacc[mt][i] = -1e30f; }
                }
                float mx = sacc[0][0];
#pragma unroll
                for (int mt = 0; mt < 2; ++mt)
#pragma unroll
                    for (int i = 0; i < 16; ++i) mx = fmaxf(mx, sacc[mt][i]);
                mx = fmaxf(mx, xor32(mx));
                const float mn = fmaxf(m_run, mx), alpha = __builtin_amdgcn_exp2f(m_run - mn);
                m_run = mn;
                float ps = 0.f;
#pragma unroll
                for (int mt = 0; mt < 2; ++mt)
#pragma unroll
                    for (int i = 0; i < 16; ++i) { const float p = __builtin_amdgcn_exp2f(sacc[mt][i] - mn); sacc[mt][i] = p; ps += p; }
                l_run = l_run * alpha + ps;
#pragma unroll
                for (int mt = 0; mt < 4; ++mt)
#pragma unroll
                    for (int i = 0; i < 16; ++i) oacc[mt][i] *= alpha;
#pragma unroll
                for (int s4 = 0; s4 < 4; ++s4) {
                    const int mtk = s4 >> 1, s = s4 & 1;
                    u32x4 pb;
#pragma unroll
                    for (int e = 0; e < 4; ++e) pb[e] = cvtpk(sacc[mtk][8 * s + 2 * e], sacc[mtk][8 * s + 2 * e + 1]);
                    const bf16x8 pfrag = __builtin_bit_cast(bf16x8, pb);
                    const int i16 = lane & 15, q4 = i16 >> 2, p4 = i16 & 3, blk = (lane >> 4) & 1;
                    const int keyA = 32 * mtk + 16 * s + 4 * hh + q4;
#pragma unroll
                    for (int mt = 0; mt < 4; ++mt) {
                        const LAS unsigned char* a0 = vb + keyA * FOX_VST + (32 * mt + 16 * blk + 4 * p4) * 2;
                        const s16x4 lo = vtr(a0), hi = vtr(a0 + 8 * FOX_VST);
                        const bf16x8 vf = __builtin_shufflevector(lo, hi, 0, 1, 2, 3, 4, 5, 6, 7);
                        oacc[mt] = MFMA32(vf, pfrag, oacc[mt]);
                    }
                }
                if (j > 0) { const float bl = (c0 - cm[k0 - 1]) * LOG2E;
                    const int ok = (qbound + bl < m_run - 152.f) ? 1 : 0;
                    wdone = __all(ok); }
            }
            if (lane == 0) flagL[cur * 8 + w] = wdone ? 1 : 0;
            if (j > 0) FOX_LWRITE(cur ^ 1);
        }
        l_run += xor32(l_run);
        const float inv = 1.f / l_run;
        bf16_t* op = BR + (rowbase + qw + r32) * NBR + 1536 + h * 128;
#pragma unroll
        for (int mt = 0; mt < 4; ++mt)
#pragma unroll
            for (int g = 0; g < 4; ++g) { u32x2 o; o[0] = cvtpk(oacc[mt][4 * g] * inv, oacc[mt][4 * g + 1] * inv); o[1] = cvtpk(oacc[mt][4 * g + 2] * inv, oacc[mt][4 * g + 3] * inv);
                *(u32x2*)(op + 32 * mt + 8 * g + 4 * hh) = o; }
    }
}


constexpr int HG_LF = 0, HG_QA = 34816, HG_QB = HG_QA + 17408, HG_KD = HG_QB + 8704, HG_KO = HG_KD + 17408, HG_KT = HG_KO + 8704, HG_VN = HG_KT + 20480, HG_AM = HG_VN + 20480, HG_END = HG_AM + 12288;
constexpr int HG_LFS = 132;
static_assert(HG_END + 2048 <= 140 * 1024, "hgrn LDS");
constexpr size_t WS_DSC = WS_ST + (size_t)BATCH * 4 * 32 * 128 * 128 * 4;

template <bool FULL>
__device__ __forceinline__ void hgrn_unit(const Ctx& C, int l, int u) {
#if DIAG == 1
    const bf16_t* H = (const bf16_t*)(C.ws + WS_H); bf16_t* BR = (l == 0) ? (bf16_t*)(C.ws + WS_XA) : (bf16_t*)(C.ws + WS_TABU);
#else
    const bf16_t* H = (const bf16_t*)(C.ws + WS_H); bf16_t* BR = (bf16_t*)(C.ws + WS_BR);
#endif
    float* STB = (float*)(C.ws + WS_ST); float* DSC = (float*)(C.ws + WS_DSC);
    LAS unsigned char* lds = C.lds;
    LAS float* LF = (LAS float*)(lds + HG_LF);
    const int lane = C.lane, w = C.wave, r32 = lane & 31, hh = lane >> 5;
    const int sc = u & 31, bh = u >> 5, b = bh >> 2, h = bh & 3;
    const int wk = w >> 1, wv = w & 1;
    const int mt = w >> 2, nt = w & 3;
    const int i16 = lane & 15, q4 = i16 >> 2, p4 = i16 & 3, blk = (lane >> 4) & 1;
    f32x16 S0, S1;
    float* stp = STB + ((size_t)bh * 32 + sc) * 128 * 128;
    if constexpr (FULL) {
#pragma unroll
        for (int i = 0; i < 16; ++i) { const int k = 32 * wk + (i & 3) + 8 * (i >> 2) + 4 * hh;
            S0[i] = stp[k * 128 + 64 * wv + r32]; S1[i] = stp[k * 128 + 64 * wv + 32 + r32]; }
    } else {
#pragma unroll
        for (int i = 0; i < 16; ++i) { S0[i] = 0.f; S1[i] = 0.f; }
    }
    float dtot = 0.f;
    const int ps = C.tid >> 3, pseg = C.tid & 7;
    float lbv[16];
#pragma unroll
    for (int j = 0; j < 16; ++j) { lbv[j] = 0.f;
        if (l == 1) { const int ch = h * 128 + 16 * pseg + j; lbv[j] = 1.f / (1.f + __expf(C.in[I_LBL][ch] - C.in[I_LBL][BW + ch])); } }
    for (int c = 0; c < 4; ++c) {
        const size_t row0 = (size_t)b * SEQ + sc * 256 + c * 64;
        const bf16_t* hp = H + (row0 + ps) * NH + h * 128 + 16 * pseg;
        float kkv[16], qsv[16];
        u32x4 vraw0, vraw1;
        {
            const u32x4 f0 = *(const u32x4*)(hp + HC_HF), f1 = *(const u32x4*)(hp + HC_HF + 8);
            vraw0 = *(const u32x4*)(hp + HC_HI); vraw1 = *(const u32x4*)(hp + HC_HI + 8);
#pragma unroll
            for (int j = 0; j < 8; ++j) { const unsigned r = (j < 4) ? f0[j] : f1[j - 4];
                const float z0 = bf2f(r & 0xffffu), z1 = bf2f(r >> 16);
                kkv[2 * j] = (1.f - lbv[2 * j]) * sigmoidf_(-z0); kkv[2 * j + 1] = (1.f - lbv[2 * j + 1]) * sigmoidf_(-z1); }
            if constexpr (FULL) {
                const u32x4 q0 = *(const u32x4*)(hp + HC_HQ), q1 = *(const u32x4*)(hp + HC_HQ + 8);
#pragma unroll
                for (int j = 0; j < 8; ++j) { const unsigned r = (j < 4) ? q0[j] : q1[j - 4]; qsv[2 * j] = siluf_(bf2f(r & 0xffffu)); qsv[2 * j + 1] = siluf_(bf2f(r >> 16)); }
            }
#pragma unroll
            for (int j4 = 0; j4 < 4; ++j4) { f32x4 o;
#pragma unroll
                for (int e = 0; e < 4; ++e) o[e] = log1pf(-kkv[4 * j4 + e]);
                *(LAS f32x4*)(LF + ps * HG_LFS + 16 * pseg + 4 * j4) = o; }
        }
        __syncthreads();
        {
            const int sk = C.tid & 127, sg = C.tid >> 7;
            float vals[16];
#pragma unroll
            for (int i = 0; i < 16; ++i) vals[i] = LF[(16 * sg + i) * HG_LFS + sk];
#pragma unroll
            for (int i = 1; i < 16; ++i) vals[i] += vals[i - 1];
            LAS float* TOT = (LAS float*)(lds + HG_END);
            TOT[sg * 128 + sk] = vals[15];
            __syncthreads();
            float off = 0.f;
#pragma unroll
            for (int j = 0; j < 3; ++j) if (j < sg) off += TOT[j * 128 + sk];
#pragma unroll
            for (int i = 0; i < 16; ++i) LF[(16 * sg + i) * HG_LFS + sk] = vals[i] + off;
            if (sg == 3) dtot += vals[15] + off;
        }
        __syncthreads();
        float bv[16], b31[16], bl[16];
#pragma unroll
        for (int j4 = 0; j4 < 4; ++j4) { const f32x4 x = *(const LAS f32x4*)(LF + ps * HG_LFS + 16 * pseg + 4 * j4), y = *(const LAS f32x4*)(LF + 31 * HG_LFS + 16 * pseg + 4 * j4), z = *(const LAS f32x4*)(LF + 63 * HG_LFS + 16 * pseg + 4 * j4);
#pragma unroll
            for (int e = 0; e < 4; ++e) { bv[4 * j4 + e] = x[e]; b31[4 * j4 + e] = y[e]; bl[4 * j4 + e] = z[e]; } }
        {
            u32x4 o0, o1;
#pragma unroll
            for (int j = 0; j < 4; ++j) { o0[j] = cvtpk(kkv[2 * j] * __expf(bl[2 * j] - bv[2 * j]), kkv[2 * j + 1] * __expf(bl[2 * j + 1] - bv[2 * j + 1]));
                o1[j] = cvtpk(kkv[8 + 2 * j] * __expf(bl[8 + 2 * j] - bv[8 + 2 * j]), kkv[9 + 2 * j] * __expf(bl[9 + 2 * j] - bv[9 + 2 * j])); }
            *(LAS u32x4*)(lds + HG_KT + ps * 320 + 32 * pseg) = o0; *(LAS u32x4*)(lds + HG_KT + ps * 320 + 32 * pseg + 16) = o1;
            *(LAS u32x4*)(lds + HG_VN + ps * 320 + 32 * pseg) = vraw0; *(LAS u32x4*)(lds + HG_VN + ps * 320 + 32 * pseg + 16) = vraw1;
            if constexpr (FULL) {
                const bool hi = ps >= 32;
                float rr[16];
#pragma unroll
                for (int j = 0; j < 16; ++j) rr[j] = hi ? b31[j] : 0.f;
#pragma unroll
                for (int j = 0; j < 4; ++j) { o0[j] = cvtpk(qsv[2 * j] * __expf(bv[2 * j] - rr[2 * j]), qsv[2 * j + 1] * __expf(bv[2 * j + 1] - rr[2 * j + 1]));
                    o1[j] = cvtpk(qsv[8 + 2 * j] * __expf(bv[8 + 2 * j] - rr[8 + 2 * j]), qsv[9 + 2 * j] * __expf(bv[9 + 2 * j] - rr[9 + 2 * j])); }
                *(LAS u32x4*)(lds + HG_QA + ps * 272 + 32 * pseg) = o0; *(LAS u32x4*)(lds + HG_QA + ps * 272 + 32 * pseg + 16) = o1;
#pragma unroll
                for (int j = 0; j < 4; ++j) { o0[j] = cvtpk(kkv[2 * j] * __expf(rr[2 * j] - bv[2 * j]), kkv[2 * j + 1] * __expf(rr[2 * j + 1] - bv[2 * j + 1]));
                    o1[j] = cvtpk(kkv[8 + 2 * j] * __expf(rr[8 + 2 * j] - bv[8 + 2 * j]), kkv[9 + 2 * j] * __expf(rr[9 + 2 * j] - bv[9 + 2 * j])); }
                *(LAS u32x4*)(lds + HG_KD + ps * 272 + 32 * pseg) = o0; *(LAS u32x4*)(lds + HG_KD + ps * 272 + 32 * pseg + 16) = o1;
                if (hi) {
#pragma unroll
                    for (int j = 0; j < 4; ++j) { o0[j] = cvtpk(qsv[2 * j] * __expf(bv[2 * j]), qsv[2 * j + 1] * __expf(bv[2 * j + 1]));
                        o1[j] = cvtpk(qsv[8 + 2 * j] * __expf(bv[8 + 2 * j]), qsv[9 + 2 * j] * __expf(bv[9 + 2 * j])); }
                    *(LAS u32x4*)(lds + HG_QB + (ps - 32) * 272 + 32 * pseg) = o0; *(LAS u32x4*)(lds + HG_QB + (ps - 32) * 272 + 32 * pseg + 16) = o1;
                } else {
#pragma unroll
                    for (int j = 0; j < 4; ++j) { o0[j] = cvtpk(kkv[2 * j] * __expf(b31[2 * j] - bv[2 * j]), kkv[2 * j + 1] * __expf(b31[2 * j + 1] - bv[2 * j + 1]));
                        o1[j] = cvtpk(kkv[8 + 2 * j] * __expf(b31[8 + 2 * j] - bv[8 + 2 * j]), kkv[9 + 2 * j] * __expf(b31[9 + 2 * j] - bv[9 + 2 * j])); }
                    *(LAS u32x4*)(lds + HG_KO + ps * 272 + 32 * pseg) = o0; *(LAS u32x4*)(lds + HG_KO + ps * 272 + 32 * pseg + 16) = o1;
                }
            }
        }
        float dk[16];
#pragma unroll
        for (int i = 0; i < 16; ++i) dk[i] = __expf(LF[63 * HG_LFS + 32 * wk + (i & 3) + 8 * (i >> 2) + 4 * hh]);
        __syncthreads();
        if constexpr (FULL) {
#pragma unroll
            for (int g = 0; g < 4; ++g) {
                u32x2 o; o[0] = cvtpk(S0[4 * g], S0[4 * g + 1]); o[1] = cvtpk(S0[4 * g + 2], S0[4 * g + 3]);
                *(LAS u32x2*)(lds + HG_LF + (64 * wv + r32) * 272 + (32 * wk + 8 * g + 4 * hh) * 2) = o;
                o[0] = cvtpk(S1[4 * g], S1[4 * g + 1]); o[1] = cvtpk(S1[4 * g + 2], S1[4 * g + 3]);
                *(LAS u32x2*)(lds + HG_LF + (64 * wv + 32 + r32) * 272 + (32 * wk + 8 * g + 4 * hh) * 2) = o;
            }
#define HG_ATILE(AMT_, AST_) do { \
                const LAS unsigned char* kb = ((AMT_) == (AST_)) ? (lds + HG_KD + (32 * (AST_)) * 272) : (lds + HG_KO); \
                f32x16 a; \
                _Pragma("unroll") for (int i = 0; i < 16; ++i) a[i] = 0.f; \
                _Pragma("unroll") for (int ks = 0; ks < 8; ++ks) { \
                    const bf16x8 af = *(const LAS bf16x8*)(lds + HG_QA + (32 * (AMT_) + r32) * 272 + 32 * ks + 16 * hh); \
                    const bf16x8 bf = *(const LAS bf16x8*)(kb + r32 * 272 + 32 * ks + 16 * hh); \
                    a = MFMA32(af, bf, a); } \
                _Pragma("unroll") for (int g = 0; g < 4; ++g) { \
                    float x[4]; \
                    _Pragma("unroll") for (int e = 0; e < 4; ++e) { const int tl = 8 * g + 4 * hh + e; x[e] = ((AMT_) != (AST_) || r32 <= tl) ? a[4 * g + e] : 0.f; } \
                    u32x2 o; o[0] = cvtpk(x[0], x[1]); o[1] = cvtpk(x[2], x[3]); \
                    *(LAS u32x2*)(lds + HG_AM + (32 * (AST_) + r32) * 192 + (32 * (AMT_) + 8 * g + 4 * hh) * 2) = o; } } while (0)
            if (w == 0) { HG_ATILE(0, 0); }
            else if (w == 1) { HG_ATILE(1, 0); }
            else if (w == 2) { HG_ATILE(1, 1); }
        }
#pragma unroll
        for (int i = 0; i < 16; ++i) { S0[i] *= dk[i]; S1[i] *= dk[i]; }
#pragma unroll
        for (int ks = 0; ks < 4; ++ks) {
            const LAS unsigned char* ka = lds + HG_KT + (16 * ks + 8 * hh + q4) * 320 + (32 * wk + 16 * blk + 4 * p4) * 2;
            const s16x4 alo = vtr(ka), ahi = vtr(ka + 4 * 320);
            const bf16x8 af = __builtin_shufflevector(alo, ahi, 0, 1, 2, 3, 4, 5, 6, 7);
            const LAS unsigned char* vb0 = lds + HG_VN + (16 * ks + 8 * hh + q4) * 320 + (64 * wv + 16 * blk + 4 * p4) * 2;
            const s16x4 b0lo = vtr(vb0), b0hi = vtr(vb0 + 4 * 320), b1lo = vtr(vb0 + 64), b1hi = vtr(vb0 + 64 + 4 * 320);
            S0 = MFMA32(af, __builtin_shufflevector(b0lo, b0hi, 0, 1, 2, 3, 4, 5, 6, 7), S0);
            S1 = MFMA32(af, __builtin_shufflevector(b1lo, b1hi, 0, 1, 2, 3, 4, 5, 6, 7), S1);
        }
        if constexpr (FULL) {
            __syncthreads();
            f32x16 o;
#pragma unroll
            for (int i = 0; i < 16; ++i) o[i] = 0.f;
            const LAS unsigned char* qb = (mt == 0) ? (lds + HG_QA) : (lds + HG_QB);
#pragma unroll
            for (int ks = 0; ks < 8; ++ks) {
                const bf16x8 af = *(const LAS bf16x8*)(qb + r32 * 272 + 32 * ks + 16 * hh);
                const bf16x8 bf = *(const LAS bf16x8*)(lds + HG_LF + (32 * nt + r32) * 272 + 32 * ks + 16 * hh);
                o = MFMA32(af, bf, o);
            }
#pragma unroll
            for (int ks = 0; ks < 4; ++ks) {
                if (mt == 0 && ks >= 2) continue;
                const LAS unsigned char* aa = lds + HG_AM + (16 * ks + 8 * hh + q4) * 192 + (32 * mt + 16 * blk + 4 * p4) * 2;
                const s16x4 alo = vtr(aa), ahi = vtr(aa + 4 * 192);
                const LAS unsigned char* vb0 = lds + HG_VN + (16 * ks + 8 * hh + q4) * 320 + (32 * nt + 16 * blk + 4 * p4) * 2;
                const s16x4 blo = vtr(vb0), bhi = vtr(vb0 + 4 * 320);
                o = MFMA32(__builtin_shufflevector(alo, ahi, 0, 1, 2, 3, 4, 5, 6, 7), __builtin_shufflevector(blo, bhi, 0, 1, 2, 3, 4, 5, 6, 7), o);
            }
            __syncthreads();
#pragma unroll
            for (int i = 0; i < 16; ++i) LF[(32 * mt + (i & 3) + 8 * (i >> 2) + 4 * hh) * HG_LFS + 32 * nt + r32] = o[i];
            __syncthreads();
            {
                float ov[16]; float ss = 0.f;
#pragma unroll
                for (int j4 = 0; j4 < 4; ++j4) { const f32x4 x = *(const LAS f32x4*)(LF + ps * HG_LFS + 16 * pseg + 4 * j4);
#pragma unroll
                    for (int e = 0; e < 4; ++e) { ov[4 * j4 + e] = x[e]; ss += x[e] * x[e]; } }
                ss += __shfl_xor(ss, 1, 64); ss += __shfl_xor(ss, 2, 64); ss += __shfl_xor(ss, 4, 64);
                const float rn = rsqrtf(ss * (1.f / 128.f) + RMS_EPS);
                const u32x4 g0 = *(const u32x4*)(hp + HC_HG), g1 = *(const u32x4*)(hp + HC_HG + 8);
                const float* ng = C.in[I_HNG] + l * 128 + 16 * pseg;
                u32x4 o0, o1;
#pragma unroll
                for (int j = 0; j < 4; ++j) {
                    o0[j] = cvtpk(ov[2 * j] * rn * ng[2 * j] * siluf_(bf2f(g0[j] & 0xffffu)), ov[2 * j + 1] * rn * ng[2 * j + 1] * siluf_(bf2f(g0[j] >> 16)));
                    o1[j] = cvtpk(ov[8 + 2 * j] * rn * ng[8 + 2 * j] * siluf_(bf2f(g1[j] & 0xffffu)), ov[9 + 2 * j] * rn * ng[9 + 2 * j] * siluf_(bf2f(g1[j] >> 16)));
                }
                bf16_t* bp = BR + (row0 + ps) * NBR + 512 + h * 128 + 16 * pseg;
                *(u32x4*)bp = o0; *(u32x4*)(bp + 8) = o1;
            }
        }
        __syncthreads();
    }
    if constexpr (!FULL) {
#pragma unroll
        for (int i = 0; i < 16; ++i) { const int k = 32 * wk + (i & 3) + 8 * (i >> 2) + 4 * hh;
            stp[k * 128 + 64 * wv + r32] = S0[i]; stp[k * 128 + 64 * wv + 32 + r32] = S1[i]; }
        if (C.tid >= 384) DSC[((size_t)bh * 32 + sc) * 128 + (C.tid & 127)] = __expf(dtot);
    }
}
__device__ __forceinline__ void hgrn_b1(const Ctx& C, int l) { for (int u = C.bid; u < BATCH * 4 * 32; u += C.G) hgrn_unit<false>(C, l, u); }
__device__ __forceinline__ void hgrn_b3(const Ctx& C, int l) { for (int u = C.bid; u < BATCH * 4 * 32; u += C.G) hgrn_unit<true>(C, l, u); }
__device__ __forceinline__ void hgrn_b2(const Ctx& C) {
    float* STB = (float*)(C.ws + WS_ST); const float* DSC = (const float*)(C.ws + WS_DSC);
    for (int e = C.bid * 512 + C.tid; e < BATCH * 4 * 128 * 128; e += C.G * 512) {
        const int bh = e >> 14, kv = e & 16383, k = kv >> 7;
        float* p = STB + (size_t)bh * 32 * 16384 + kv;
        float uu[32], dd[32];
#pragma unroll
        for (int s = 0; s < 32; ++s) { uu[s] = p[(size_t)s * 16384]; dd[s] = DSC[((size_t)bh * 32 + s) * 128 + k]; }
        float st = 0.f;
#pragma unroll
        for (int s = 0; s < 32; ++s) { p[(size_t)s * 16384] = st; st = dd[s] * st + uu[s]; }
    }
}


__device__ __forceinline__ void mix_pool(const Ctx& C, int l) {
#if DIAG == 2
    const bf16_t* H = (const bf16_t*)(C.ws + WS_H); bf16_t* BR = (l == 0) ? (bf16_t*)(C.ws + WS_XA) : (bf16_t*)(C.ws + WS_TABU);
#else
    const bf16_t* H = (const bf16_t*)(C.ws + WS_H); bf16_t* BR = (bf16_t*)(C.ws + WS_BR);
#endif
    const bf16_t* Wt = (const bf16_t*)(C.ws + WS_W + (size_t)l * W_LAYER + WO_POOLW);
    LAS unsigned char* lds = C.lds;
    const int lane = C.lane, w = C.wave, r32 = lane & 31, hh = lane >> 5;
    for (int u = C.bid; u < (T / 256) * 4; u += C.G) {
        const int g = u & 3, t0 = (u >> 2) * 256, win = 2 << g;
        const int row = t0 + 32 * w + r32, pos = row & (SEQ - 1);
        __syncthreads();
#pragma unroll
        for (int p = 0; p < 4; ++p) { const int idx = C.tid + 512 * p, rr = idx >> 4, ch = idx & 15;
            *(LAS u32x4*)(lds + rr * 272 + ch * 16) = *(const u32x4*)(Wt + (size_t)g * 128 * 128 + rr * 128 + ch * 8); }
        const int nwin = (pos + 1 < win) ? pos + 1 : win;
        const float invn = 1.f / (float)nwin;
        bf16x8 df[8];
        const bf16_t* pp = H + (size_t)row * NH + HC_P + g * 128 + 8 * hh;
#pragma unroll
        for (int ks = 0; ks < 8; ++ks) {
            float sum[8];
#pragma unroll
            for (int e = 0; e < 8; ++e) sum[e] = 0.f;
            u32x4 self = {0u, 0u, 0u, 0u};
            for (int j = 0; j < nwin; ++j) {
                const u32x4 raw = *(const u32x4*)(pp + 16 * ks - (size_t)j * NH);
                if (j == 0) self = raw;
#pragma unroll
                for (int e = 0; e < 4; ++e) { sum[2 * e] += bf2f(raw[e] & 0xffffu); sum[2 * e + 1] += bf2f(raw[e] >> 16); }
            }
            u32x4 o;
#pragma unroll
            for (int e = 0; e < 4; ++e) o[e] = cvtpk(sum[2 * e] * invn - bf2f(self[e] & 0xffffu), sum[2 * e + 1] * invn - bf2f(self[e] >> 16));
            df[ks] = __builtin_bit_cast(bf16x8, o);
        }
        __syncthreads();
        f32x16 acc[4];
#pragma unroll
        for (int mt = 0; mt < 4; ++mt)
#pragma unroll
            for (int i = 0; i < 16; ++i) acc[mt][i] = 0.f;
#pragma unroll
        for (int ks = 0; ks < 8; ++ks)
#pragma unroll
            for (int mt = 0; mt < 4; ++mt) {
                const bf16x8 wf = *(const LAS bf16x8*)(lds + (32 * mt + r32) * 272 + 32 * ks + 16 * hh);
                acc[mt] = MFMA32(wf, df[ks], acc[mt]);
            }
        const float* psc = C.in[I_POOLS] + l * BW + g * 128;
        bf16_t* op = BR + (size_t)row * NBR + g * 128;
#pragma unroll
        for (int mt = 0; mt < 4; ++mt)
#pragma unroll
            for (int q = 0; q < 4; ++q) { const int d0 = 32 * mt + 8 * q + 4 * hh; const f32x4 sc = *(const f32x4*)(psc + d0);
                u32x2 o; o[0] = cvtpk(acc[mt][4 * q] * sc[0], acc[mt][4 * q + 1] * sc[1]); o[1] = cvtpk(acc[mt][4 * q + 2] * sc[2], acc[mt][4 * q + 3] * sc[3]);
                *(u32x2*)(op + d0) = o; }
    }
}
constexpr int GM_VN = 0, GM_WC = 128 * 320, GM_END = GM_WC + 128 * 272;
__device__ __forceinline__ void mix_gmlp(const Ctx& C, int l) {
#if DIAG == 3
    const bf16_t* H = (const bf16_t*)(C.ws + WS_H); bf16_t* BR = (l == 0) ? (bf16_t*)(C.ws + WS_XA) : (bf16_t*)(C.ws + WS_TABU);
#else
    const bf16_t* H = (const bf16_t*)(C.ws + WS_H); bf16_t* BR = (bf16_t*)(C.ws + WS_BR);
#endif
    const bf16_t* Wc = (const bf16_t*)(C.ws + WS_W + (size_t)l * W_LAYER + WO_GWS);
    LAS unsigned char* lds = C.lds;
    const int lane = C.lane, w = C.wave, r32 = lane & 31, hh = lane >> 5;
    const int i16 = lane & 15, q4 = i16 >> 2, p4 = i16 & 3, blk = (lane >> 4) & 1;
    for (int u = C.bid; u < (T / 128) * 4; u += C.G) {
        const int g = u & 3, t0 = (u >> 2) * 128;
        __syncthreads();
#pragma unroll
        for (int p = 0; p < 4; ++p) { const int idx = C.tid + 512 * p, rr = idx >> 4, ch = idx & 15;
            *(LAS u32x4*)(lds + GM_WC + rr * 272 + ch * 16) = *(const u32x4*)(Wc + (size_t)g * 128 * 128 + rr * 128 + ch * 8); }
        for (int i = 0; i < 16; ++i) {
            const int r = w * 16 + i, row = t0 + r;
            const u32x4 raw = *(const u32x4*)(H + (size_t)row * NH + HC_GV + lane * 8);
            float e[8];
#pragma unroll
            for (int j = 0; j < 4; ++j) { e[2 * j] = geluf_(bf2f(raw[j] & 0xffffu)); e[2 * j + 1] = geluf_(bf2f(raw[j] >> 16)); }
            float sm = 0.f;
#pragma unroll
            for (int j = 0; j < 8; ++j) sm += e[j];
            const float mean = wave_sum(sm) * (1.f / BW);
            float qq = 0.f;
#pragma unroll
            for (int j = 0; j < 8; ++j) { const float d = e[j] - mean; qq += d * d; }
            const float rstd = rsqrtf(wave_sum(qq) * (1.f / BW) + LN_EPS);
            if ((lane >> 4) == g) {
                const float* lg = C.in[I_GLNG] + l * BW + lane * 8; const float* lb = C.in[I_GLNB] + l * BW + lane * 8;
                u32x4 o;
#pragma unroll
                for (int j = 0; j < 4; ++j) o[j] = cvtpk((e[2 * j] - mean) * rstd * lg[2 * j] + lb[2 * j], (e[2 * j + 1] - mean) * rstd * lg[2 * j + 1] + lb[2 * j + 1]);
                *(LAS u32x4*)(lds + GM_VN + r * 320 + (lane & 15) * 16) = o;
            }
        }
        __syncthreads();
        const int nt = w & 3, mb = (w >> 2) * 2;
        f32x16 acc[2];
#pragma unroll
        for (int m = 0; m < 2; ++m)
#pragma unroll
            for (int i = 0; i < 16; ++i) acc[m][i] = 0.f;
        for (int ks = 0; ks < 2 * (nt + 1); ++ks) {
            const bf16x8 bf = *(const LAS bf16x8*)(lds + GM_WC + (32 * nt + r32) * 272 + 32 * ks + 16 * hh);
#pragma unroll
            for (int m = 0; m < 2; ++m) {
                const LAS unsigned char* aa = lds + GM_VN + (16 * ks + 8 * hh + q4) * 320 + (32 * (mb + m) + 16 * blk + 4 * p4) * 2;
                const s16x4 lo = vtr(aa), hi = vtr(aa + 4 * 320);
                acc[m] = MFMA32(__builtin_shufflevector(lo, hi, 0, 1, 2, 3, 4, 5, 6, 7), bf, acc[m]);
            }
        }
        const int tl = 32 * nt + r32, row = t0 + tl;
        const float bias = C.in[I_GBS][(l * 4 + g) * 128 + tl];
#pragma unroll
        for (int m = 0; m < 2; ++m)
#pragma unroll
            for (int q = 0; q < 4; ++q) { const int c0 = 32 * (mb + m) + 8 * q + 4 * hh;
                const u32x2 ur = *(const u32x2*)(H + (size_t)row * NH + HC_GU + g * 128 + c0);
                u32x2 o;
                o[0] = cvtpk(geluf_(bf2f(ur[0] & 0xffffu)) * (acc[m][4 * q] + bias), geluf_(bf2f(ur[0] >> 16)) * (acc[m][4 * q + 1] + bias));
                o[1] = cvtpk(geluf_(bf2f(ur[1] & 0xffffu)) * (acc[m][4 * q + 2] + bias), geluf_(bf2f(ur[1] >> 16)) * (acc[m][4 * q + 3] + bias));
                *(u32x2*)(BR + (size_t)row * NBR + 1024 + g * 128 + c0) = o; }
    }
}

#define CE_D(a, b) do { const float _h = fmaxf(a, b), _l = fminf(a, b); a = _h; b = _l; } while (0)
__device__ __forceinline__ void sort16_desc(float (&x)[16]) {
#pragma unroll
    for (int k = 2; k <= 16; k <<= 1)
#pragma unroll
        for (int j = k >> 1; j > 0; j >>= 1)
#pragma unroll
            for (int i = 0; i < 16; ++i) { const int l = i ^ j; if (l > i) { if ((i & k) == 0) CE_D(x[i], x[l]); else CE_D(x[l], x[i]); } }
}
__device__ __forceinline__ void bmerge16_desc(float (&x)[16]) {
#pragma unroll
    for (int j = 8; j > 0; j >>= 1)
#pragma unroll
        for (int i = 0; i < 16; ++i) { const int l = i ^ j; if (l > i) CE_D(x[i], x[l]); }
}
__device__ __forceinline__ void top16_merge(float (&a)[16], const float (&b)[16]) {
#pragma unroll
    for (int i = 0; i < 16; ++i) a[i] = fmaxf(a[i], b[15 - i]);
    bmerge16_desc(a);
}
__device__ __forceinline__ float pack_idx(float v, unsigned idx, unsigned mask) { return __builtin_bit_cast(float, (__builtin_bit_cast(unsigned, v) & ~mask) | idx); }

constexpr int TK_KST = 272, TK_KBUF = 128 * TK_KST;
__device__ __forceinline__ void p_topk(const Ctx& C, int l) {
    const bf16_t* Q = (const bf16_t*)(C.ws + WS_Q);
    const bf16_t* keys = (const bf16_t*)(C.ws + WS_W + (size_t)l * W_LAYER + WO_KEYS);
    int* eidx = (int*)(C.ws + WS_EIDX); float* egate = (float*)(C.ws + WS_EGATE);
    LAS unsigned char* lds = C.lds;
    const int lane = C.lane, w = C.wave, r32 = lane & 31, hh = lane >> 5;
    for (int u = C.bid; u < (T / 256) * PH; u += C.G) {
        const int h = u & 7, t0 = (u >> 3) * 256, tok = t0 + 32 * w + r32;
        float v12[2][16];
        __syncthreads();
#pragma unroll
        for (int j = 0; j < 2; ++j) {
            const bf16_t* kp = keys + ((size_t)j * PH + h) * 128 * 128;
#pragma unroll
            for (int p = 0; p < 4; ++p) { const int idx = C.tid + 512 * p, row = idx >> 4, ch = idx & 15;
                *(LAS u32x4*)(lds + j * TK_KBUF + row * TK_KST + ch * 16) = *(const u32x4*)(kp + row * 128 + ch * 8); }
        }
        __syncthreads();
#pragma unroll
        for (int j = 0; j < 2; ++j) {
            bf16x8 qf[8];
            const bf16_t* qp = Q + (size_t)tok * NQ + h * 256 + j * 128 + 8 * hh;
#pragma unroll
            for (int ks = 0; ks < 8; ++ks) qf[ks] = *(const bf16x8*)(qp + 16 * ks);
            f32x16 sacc[4];
#pragma unroll
            for (int mt = 0; mt < 4; ++mt)
#pragma unroll
                for (int i = 0; i < 16; ++i) sacc[mt][i] = 0.f;
#pragma unroll
            for (int ks = 0; ks < 8; ++ks)
#pragma unroll
                for (int mt = 0; mt < 4; ++mt) {
                    const bf16x8 kf = *(const LAS bf16x8*)(lds + j * TK_KBUF + (32 * mt + r32) * TK_KST + 32 * ks + 16 * hh);
                    sacc[mt] = MFMA32(kf, qf[ks], sacc[mt]);
                }
            float g[4][16];
#pragma unroll
            for (int mt = 0; mt < 4; ++mt) {
#pragma unroll
                for (int i = 0; i < 16; ++i) g[mt][i] = pack_idx(sacc[mt][i], (unsigned)(32 * mt + (i & 3) + 8 * (i >> 2) + 4 * hh), 127u);
                sort16_desc(g[mt]);
            }
            top16_merge(g[0], g[1]); top16_merge(g[2], g[3]); top16_merge(g[0], g[2]);
            float o[16];
#pragma unroll
            for (int i = 0; i < 16; ++i) o[i] = __shfl_xor(g[0][i], 32, 64);
            top16_merge(g[0], o);
#pragma unroll
            for (int i = 0; i < 16; ++i) v12[j][i] = g[0][i];
        }
        float c[4][16];
        {
            int n = 0;
#pragma unroll
            for (int a = 0; a < 16; ++a)
#pragma unroll
                for (int b = 0; b < 16; ++b) if ((a + 1) * (b + 1) <= 16) {
                    const unsigned id = ((__builtin_bit_cast(unsigned, v12[0][a]) & 127u) << 7) | (__builtin_bit_cast(unsigned, v12[1][b]) & 127u);
                    c[n >> 4][n & 15] = pack_idx(v12[0][a] + v12[1][b], id, 16383u); ++n; }
#pragma unroll
            for (; n < 64; ++n) c[n >> 4][n & 15] = -3.0e38f;
        }
#pragma unroll
        for (int q = 0; q < 4; ++q) sort16_desc(c[q]);
        top16_merge(c[0], c[1]); top16_merge(c[2], c[3]); top16_merge(c[0], c[2]);
        float e[16], den = 0.f;
#pragma unroll
        for (int i = 0; i < 16; ++i) { e[i] = __expf(c[0][i] - c[0][0]); den += e[i]; }
        const float inv = 1.f / den;
        int* ip = eidx + (size_t)tok * 128 + h * 16 + 8 * hh; float* gp = egate + (size_t)tok * 128 + h * 16 + 8 * hh;
        u32x4 i0, i1; f32x4 g0, g1;
#pragma unroll
        for (int i = 0; i < 4; ++i) {
            const float ca = hh ? c[0][8 + i] : c[0][i], cb = hh ? c[0][12 + i] : c[0][4 + i];
            i0[i] = __builtin_bit_cast(unsigned, ca) & 16383u; i1[i] = __builtin_bit_cast(unsigned, cb) & 16383u;
            g0[i] = (hh ? e[8 + i] : e[i]) * inv; g1[i] = (hh ? e[12 + i] : e[4 + i]) * inv;
        }
        *(u32x4*)ip = i0; *(u32x4*)(ip + 4) = i1; *(f32x4*)gp = g0; *(f32x4*)(gp + 4) = g1;
    }
}

constexpr int CW_DIAG = 64;
__device__ __forceinline__ void diag_cmp(const Ctx& C, const bf16_t* A, int lda, const bf16_t* R, int ldr, int nc) {
    float sd = 0.f, sr = 0.f;
    for (int row = C.bid; row < T; row += C.G) {
        const int tm = row % DIAG_MOD; if (tm < DIAG_LO || tm >= DIAG_HI) continue;
        for (int c = C.tid; c < nc; c += 512) { const float a = bf2f(A[(size_t)row * lda + c]), r = bf2f(R[(size_t)row * ldr + c]); sd += (a - r) * (a - r); sr += r * r; }
    }
    sd = wave_sum(sd); sr = wave_sum(sr);
    if (C.lane == 0) { atomicAdd((float*)(C.ws + WS_CTL) + CW_DIAG, sd); atomicAdd((float*)(C.ws + WS_CTL) + CW_DIAG + 1, sr); }
}
__device__ __forceinline__ float diag_alpha(const Ctx& C) {
    const float sd = __hip_atomic_load((float*)(C.ws + WS_CTL) + CW_DIAG, __ATOMIC_RELAXED, __HIP_MEMORY_SCOPE_AGENT), sr = __hip_atomic_load((float*)(C.ws + WS_CTL) + CW_DIAG + 1, __ATOMIC_RELAXED, __HIP_MEMORY_SCOPE_AGENT);
    const float err = fmaxf(sd / fmaxf(sr, 1e-30f), 1e-8f);
    return 0.1f + 0.1f * (rintf(log10f(err / 1e-8f) * 10.f) * 0.1f);
}

__device__ __forceinline__ void wave_argmax(float& v, int& i) {
#pragma unroll
    for (int o = 32; o > 0; o >>= 1) {
        const float ov = __shfl_xor(v, o, 64); const int oi = __shfl_xor(i, o, 64);
        if (ov > v || (ov == v && oi < i)) { v = ov; i = oi; }
    }
}
__device__ __forceinline__ void p_topk_naive(const Ctx& C, int l) {
    const bf16_t* Q = (const bf16_t*)(C.ws + WS_Q);
    const bf16_t* keys = (const bf16_t*)(C.ws + WS_W + (size_t)l * W_LAYER + WO_KEYS);
    int* eidx = (int*)(C.ws + WS_EIDX); float* egate = (float*)(C.ws + WS_EGATE);
    LAS float* qs = (LAS float*)C.lds;
    LAS float* sc = qs + 2048;
    LAS float* tv = sc + 2048;
    LAS int* ti = (LAS int*)(tv + 256);
    for (int t = C.bid; t < T; t += C.G) {
        for (int i = C.tid; i < 2048; i += 512) qs[i] = bf2f(Q[(size_t)t * NQ + i]);
        __syncthreads();
        for (int i = 0; i < 4; ++i) {
            const int idx = C.tid + 512 * i, hj = idx >> 7, key = idx & 127, h = hj >> 1, j = hj & 1;
            const bf16_t* kp = keys + (((size_t)j * PH + h) * 128 + key) * 128;
            float s = 0.f;
            for (int d8 = 0; d8 < 16; ++d8) {
                const u32x4 raw = *(const u32x4*)(kp + d8 * 8);
#pragma unroll
                for (int e = 0; e < 4; ++e) s += qs[h * 256 + j * 128 + d8 * 8 + 2 * e] * bf2f(raw[e] & 0xffffu) + qs[h * 256 + j * 128 + d8 * 8 + 2 * e + 1] * bf2f(raw[e] >> 16);
            }
            sc[idx] = s;
        }
        __syncthreads();
        for (int i = 0; i < 2; ++i) {
            const int hj = C.wave * 2 + i;
            float a0 = sc[hj * 128 + C.lane], a1 = sc[hj * 128 + 64 + C.lane];
            for (int r = 0; r < 16; ++r) {
                float bv; int bi;
                if (a0 > a1 || (a0 == a1)) { bv = a0; bi = C.lane; } else { bv = a1; bi = C.lane + 64; }
                wave_argmax(bv, bi);
                if (C.lane == 0) { tv[hj * 16 + r] = bv; ti[hj * 16 + r] = bi; }
                if (bi == C.lane) a0 = -3e38f; if (bi == C.lane + 64) a1 = -3e38f;
            }
        }
        __syncthreads();
        {
            const int h = C.wave;
            float cv[4];
#pragma unroll
            for (int i = 0; i < 4; ++i) { const int c = C.lane * 4 + i; cv[i] = tv[(h * 2) * 16 + (c >> 4)] + tv[(h * 2 + 1) * 16 + (c & 15)]; }
            float topv = 0.f; int tope = 0; float mx = 0.f;
            for (int r = 0; r < 16; ++r) {
                float bv = cv[0]; int bi = C.lane * 4;
#pragma unroll
                for (int i = 1; i < 4; ++i) if (cv[i] > bv) { bv = cv[i]; bi = C.lane * 4 + i; }
                wave_argmax(bv, bi);
                if (r == 0) mx = bv;
                if (C.lane == r) { topv = bv; tope = ti[(h * 2) * 16 + (bi >> 4)] * 128 + ti[(h * 2 + 1) * 16 + (bi & 15)]; }
#pragma unroll
                for (int i = 0; i < 4; ++i) if (bi == C.lane * 4 + i) cv[i] = -3e38f;
            }
            float e = (C.lane < 16) ? __expf(topv - mx) : 0.f;
            const float den = wave_sum(e);
            if (C.lane < 16) { eidx[(size_t)t * 128 + h * 16 + C.lane] = tope; egate[(size_t)t * 128 + h * 16 + C.lane] = e / den; }
        }
        __syncthreads();
    }
}
__device__ __forceinline__ float ub(unsigned w, int e) { return (float)((w >> (8 * e)) & 255u); }
__device__ __forceinline__ void p_gather(const Ctx& C, int l) {
    const float* xc = (const float*)(C.ws + WS_XC);
    const unsigned char* U8 = C.ws + WS_U8; const unsigned char* V8 = C.ws + WS_V8;
    const float* SU = (const float*)(C.ws + WS_SU); const float* SV = (const float*)(C.ws + WS_SV);
    const int* eidx = (const int*)(C.ws + WS_EIDX); const float* egate = (const float*)(C.ws + WS_EGATE);
    const int lane = C.lane;
    for (int t = C.bid * 8 + C.wave; t < T; t += C.G * 8) {
        float x[16];
        { const float* xp = xc + (size_t)t * DM + lane * 16;
#pragma unroll
          for (int i = 0; i < 4; ++i) { const f32x4 v = *(const f32x4*)(xp + 4 * i); x[4 * i] = v[0]; x[4 * i + 1] = v[1]; x[4 * i + 2] = v[2]; x[4 * i + 3] = v[3]; } }
        float xs = 0.f;
#pragma unroll
        for (int j = 0; j < 16; ++j) xs += x[j];
        xs = wave_sum(xs);
        float cf[2]; int ex[2];
#pragma unroll
        for (int bt = 0; bt < 2; ++bt) {
            ex[bt] = eidx[(size_t)t * 128 + 64 * bt + lane];
            const float gate = egate[(size_t)t * 128 + 64 * bt + lane];
            float p[64];
#pragma unroll
            for (int e0 = 0; e0 < 64; e0 += 16) {
                u32x4 r[16];
#pragma unroll
                for (int i = 0; i < 16; ++i) { const int e = __builtin_amdgcn_readlane(ex[bt], e0 + i); r[i] = *(const u32x4*)(U8 + (size_t)e * DM + lane * 16); }
#pragma unroll
                for (int i = 0; i < 16; ++i) { float sacc = 0.f;
#pragma unroll
                    for (int q = 0; q < 4; ++q)
#pragma unroll
                        for (int e = 0; e < 4; ++e) sacc += x[4 * q + e] * ub(r[i][q], e);
                    p[e0 + i] = sacc; }
            }
#pragma unroll
            for (int st = 32, n = 32; st > 0; st >>= 1, n >>= 1) {
                const bool up = (lane & st) != 0;
#pragma unroll
                for (int i = 0; i < n; ++i) { const float send = up ? p[i] : p[i + n], keep = up ? p[i + n] : p[i]; p[i] = keep + __shfl_xor(send, st, 64); }
            }
            const float hsum = SU[ex[bt]] * (p[0] - 128.f * xs);
            cf[bt] = gate * geluf_(hsum) * SV[ex[bt]];
        }
        float y[16];
#pragma unroll
        for (int j = 0; j < 16; ++j) y[j] = 0.f;
        float csum = wave_sum(cf[0] + cf[1]);
#pragma unroll
        for (int bt = 0; bt < 2; ++bt)
#pragma unroll
            for (int e0 = 0; e0 < 64; e0 += 16) {
                u32x4 r[16];
#pragma unroll
                for (int i = 0; i < 16; ++i) { const int e = __builtin_amdgcn_readlane(ex[bt], e0 + i); r[i] = *(const u32x4*)(V8 + (size_t)e * DM + lane * 16); }
#pragma unroll
                for (int i = 0; i < 16; ++i) { const float c = __builtin_bit_cast(float, __builtin_amdgcn_readlane(__builtin_bit_cast(int, cf[bt]), e0 + i));
#pragma unroll
                    for (int q = 0; q < 4; ++q)
#pragma unroll
                        for (int e = 0; e < 4; ++e) y[4 * q + e] += c * ub(r[i][q], e); }
            }
#pragma unroll
        for (int j = 0; j < 16; ++j) y[j] = y[j] - 128.f * csum + ALPHA * x[j];
        float sm = 0.f;
#pragma unroll
        for (int j = 0; j < 16; ++j) sm += y[j];
        const float mean = wave_sum(sm) * (1.f / DM);
        float qq = 0.f;
#pragma unroll
        for (int j = 0; j < 16; ++j) { const float d = y[j] - mean; qq += d * d; }
        const float rstd = rsqrtf(wave_sum(qq) * (1.f / DM) + LN_EPS);
        const float* gp = C.in[I_LN2G] + l * DM + lane * 16; const float* bp = C.in[I_LN2B] + l * DM + lane * 16;
#pragma unroll
        for (int i = 0; i < 4; ++i) { const f32x4 gg = *(const f32x4*)(gp + 4 * i), bb = *(const f32x4*)(bp + 4 * i);
#pragma unroll
            for (int e = 0; e < 4; ++e) y[4 * i + e] = (y[4 * i + e] - mean) * rstd * gg[e] + bb[e]; }
        float* dst = (l + 1 < DEPTH) ? (float*)(C.ws + WS_XA) + (size_t)t * DM : C.out + (size_t)t * DM;
#pragma unroll
        for (int i = 0; i < 4; ++i) *(f32x4*)(dst + lane * 16 + 4 * i) = (f32x4){y[4 * i], y[4 * i + 1], y[4 * i + 2], y[4 * i + 3]};
        if (l + 1 < DEPTH) {
            bf16_t* xb = (bf16_t*)(C.ws + WS_XB) + (size_t)t * DM + lane * 16;
            u32x4 o0, o1;
#pragma unroll
            for (int j = 0; j < 4; ++j) { o0[j] = pk2(y[2 * j], y[2 * j + 1]); o1[j] = pk2(y[8 + 2 * j], y[9 + 2 * j]); }
            *(u32x4*)xb = o0; *(u32x4*)(xb + 8) = o1;
            const float* wf = (const float*)(C.ws + WS_W + (size_t)(l + 1) * W_LAYER + WO_WF);
            float* lsig = (float*)(C.ws + WS_MISC);
#pragma unroll
            for (int h = 0; h < 4; ++h) {
                float sd = 0.f;
#pragma unroll
                for (int i = 0; i < 4; ++i) { const f32x4 a = *(const f32x4*)(wf + h * DM + lane * 16 + 4 * i);
#pragma unroll
                    for (int e = 0; e < 4; ++e) sd += y[4 * i + e] * a[e]; }
                sd = wave_sum(sd);
                if (lane == 0) lsig[(size_t)t * 4 + h] = logsigmoidf_(sd + C.in[I_BFOX][(l + 1) * 4 + h]);
            }
        }
    }
}

struct FStoreBf16 { bf16_t* O; int ld;
    __device__ __forceinline__ void operator()(int row, int col, f32x4 v0, f32x4 v1, int) const {
        u32x4 o; o[0] = pk2(v0[0], v0[1]); o[1] = pk2(v0[2], v0[3]); o[2] = pk2(v1[0], v1[1]); o[3] = pk2(v1[2], v1[3]);
        *(u32x4*)(O + (size_t)row * ld + col) = o; } };
struct FGate { bf16_t* O; const float* bias;
    __device__ __forceinline__ void operator()(int row, int col, f32x4 v0, f32x4 v1, int) const {
        const f32x4 b0 = *(const f32x4*)(bias + col), b1 = *(const f32x4*)(bias + col + 4);
        u32x4 o; o[0] = pk2(sigmoidf_(v0[0] + b0[0]), sigmoidf_(v0[1] + b0[1])); o[1] = pk2(sigmoidf_(v0[2] + b0[2]), sigmoidf_(v0[3] + b0[3]));
        o[2] = pk2(sigmoidf_(v1[0] + b1[0]), sigmoidf_(v1[1] + b1[1])); o[3] = pk2(sigmoidf_(v1[2] + b1[2]), sigmoidf_(v1[3] + b1[3]));
        *(u32x4*)(O + (size_t)row * NG + col) = o; } };
struct FMerge { const bf16_t* G; bf16_t* MG;
    __device__ __forceinline__ void operator()(int row, int col, f32x4 v0, f32x4 v1, int z) const {
        const u32x4 gr = *(const u32x4*)(G + (size_t)row * NG + z * DM + col);
        float r[8];
#pragma unroll
        for (int e = 0; e < 4; ++e) { const float a = (e < 2) ? v0[2 * e] : v1[2 * e - 4], b = (e < 2) ? v0[2 * e + 1] : v1[2 * e - 3];
            r[2 * e] = a * bf2f(gr[e] & 0xffffu); r[2 * e + 1] = b * bf2f(gr[e] >> 16); }
        bf16_t* p = MG + (size_t)row * DM + col;
        if (z > 0) { const u32x4 pr = *(const u32x4*)p;
#pragma unroll
            for (int e = 0; e < 4; ++e) { r[2 * e] += bf2f(pr[e] & 0xffffu); r[2 * e + 1] += bf2f(pr[e] >> 16); } }
        u32x4 o;
#pragma unroll
        for (int e = 0; e < 4; ++e) o[e] = pk2(r[2 * e], r[2 * e + 1]);
        *(u32x4*)p = o; } };
struct FResid { const float* X; float* Y;
    __device__ __forceinline__ void operator()(int row, int col, f32x4 v, int) const {
        const f32x4 x = *(const f32x4*)(X + (size_t)row * DM + col);
        *(f32x4*)(Y + (size_t)row * DM + col) = x * ALPHA + v; } };

constexpr int PH_PER_LAYER = 12, N_PHASES = 1 + DEPTH * PH_PER_LAYER;
template <int SP> __device__ __forceinline__ void run_phase(const Ctx& C0, int l) {
    Ctx C = C0;
    asm volatile("" : "+v"(C.tid));
    C.ws = launder_ptr(C.ws); C.out = launder_ptr(C.out); l = (int)launder_u((unsigned)l);
    C.lane = C.tid & 63; C.wave = __builtin_amdgcn_readfirstlane(C.tid >> 6);
    unsigned char* wb = C.ws + WS_W + (size_t)l * W_LAYER;
    if constexpr (SP == -1) { p_conv_weights(C); }
    if constexpr (SP == 0) {
        if (l == 0) p_rowpass0(C);
    }
    if constexpr (SP == 1) {
        p_cumsum(C);
        __syncthreads();
        pg8::Gemm g{(const bf16_t*)(C.ws + WS_XB), (const bf16_t*)(wb + WO_WIN), DM, DM, DM, 0, 0};
        pg8::StaticOrder S; S.init(T, NH, C.G, C.bid);
        pg8::Epi8<FStoreBf16> E{{(bf16_t*)(C.ws + WS_H), NH}};
        pg8::gemm_phase(C.lds, g, S, E, C.tid);
    }
    if constexpr (SP == 2) { p_knorm(C, l); if (l != HG_NAIVE_L) hgrn_b1(C, l); }
#if MIX_NAIVE
    if constexpr (SP == 3) { if (l != HG_NAIVE_L) hgrn_b2(C); mix_pool_naive(C, l); mix_gmlp_naive(C, l); }
#else
    if constexpr (SP == 3) { if (l != HG_NAIVE_L) hgrn_b2(C); mix_pool(C, l); mix_gmlp(C, l);
        if (DIAG == 2) mix_pool_naive(C, l); if (DIAG == 3) mix_gmlp_naive(C, l); }
#endif
#if DIAG == 1
    if constexpr (SP == 4) { hgrn_b3(C, l); { mix_hgrn_naive(C, l); __syncthreads(); } mix_fox(C, l); }
    if constexpr (SP == 5) { if (l == DIAG_LAYER) diag_cmp(C, (const bf16_t*)(C.ws + (DIAG_LAYER == 0 ? WS_XA : WS_TABU)) + 512, NBR, (const bf16_t*)(C.ws + WS_BR) + 512, NBR, 512); }
#elif DIAG == 2 || DIAG == 3
    if constexpr (SP == 4) { hgrn_b3(C, l); mix_fox(C, l); if (l == DIAG_LAYER) diag_cmp(C, (const bf16_t*)(C.ws + (DIAG_LAYER == 0 ? WS_XA : WS_TABU)) + (DIAG == 2 ? 0 : 1024), NBR, (const bf16_t*)(C.ws + WS_BR) + (DIAG == 2 ? 0 : 1024), NBR, 512); }
#else
    if constexpr (SP == 4) { if (l != HG_NAIVE_L) hgrn_b3(C, l); else { mix_hgrn_naive(C, l); __syncthreads(); } mix_fox(C, l); }
#endif
    if constexpr (SP == 5) {
        pg8::Gemm g{(const bf16_t*)(C.ws + WS_XB), (const bf16_t*)(wb + WO_WG), DM, DM, DM, 0, 0};
        pg8::StaticOrder S; S.init(T, NG, C.G, C.bid);
        pg8::Epi8<FGate> E{{(bf16_t*)(C.ws + WS_G), C.in[I_BGATE] + l * NG}};
        pg8::gemm_phase(C.lds, g, S, E, C.tid);
    }
    if constexpr (SP == 6) {
        pg8::Gemm g{(const bf16_t*)(C.ws + WS_BR), (const bf16_t*)(wb + WO_WBR), NBR, BW, BW, (size_t)BW, (size_t)DM * BW};
        pg8::ZOrder S; S.init(T, DM, 4, C.G, C.vcu);
        pg8::Epi8<FMerge> E{{(const bf16_t*)(C.ws + WS_G), (bf16_t*)(C.ws + WS_XB)}};
        pg8::gemm_phase(C.lds, g, S, E, C.tid);
    }
    if constexpr (SP == 7) {
        const float* xin = (l == 0) ? C.in[I_X] : (const float*)(C.ws + WS_XA);
        pg8::Gemm g{(const bf16_t*)(C.ws + WS_XB), (const bf16_t*)(wb + WO_WOUT), DM, DM, DM, 0, 0};
        pg8::StaticOrder S; S.init(T, DM, C.G, C.bid);
        pg8::Epi4<FResid> E{{xin, (float*)(C.ws + WS_XC)}};
        pg8::gemm_phase(C.lds, g, S, E, C.tid);
    }
    if constexpr (SP == 8) { p_ln1(C, l); p_conv_tables(C, l); }
    if constexpr (SP == 9) {
        pg8::Gemm g{(const bf16_t*)(C.ws + WS_X1B), (const bf16_t*)(wb + WO_WQ), DM, DM, DM, 0, 0};
        pg8::StaticOrder S; S.init(T, NQ, C.G, C.bid);
        pg8::Epi8<FStoreBf16> E{{(bf16_t*)(C.ws + WS_Q), NQ}};
        pg8::gemm_phase(C.lds, g, S, E, C.tid);
    }
#if TOPK_NAIVE
    if constexpr (SP == 10) p_topk_naive(C, l);
#else
    if constexpr (SP == 10) p_topk(C, l);
#endif
    if constexpr (SP == 11) p_gather(C, l);
}
__device__ __forceinline__ void make_ctx(Ctx& C, const Args& args, unsigned char* lds_raw) {
    C.lds = (LAS unsigned char*)lds_raw; C.ws = args.ws; C.in = args.in; C.out = args.out;
    C.tid = threadIdx.x; C.lane = C.tid & 63; C.wave = __builtin_amdgcn_readfirstlane(C.tid >> 6);
    C.G = gridDim.x; C.bid = blockIdx.x; C.vcu = (C.G % 8 == 0) ? (C.bid % 8) * (C.G / 8) + C.bid / 8 : C.bid;
}
template <int SP> __global__ void __launch_bounds__(512, 2) mk_phase(Args args) {
    extern __shared__ __attribute__((aligned(16))) unsigned char lds_raw[];
    Ctx C; make_ctx(C, args, lds_raw);
    run_phase<SP>(C, args.ph_lo);
}

#define GRID_BAR() xcd_barrier((unsigned*)(args.ws + WS_CTL) + 1024, (volatile LAS unsigned*)((LAS unsigned char*)lds_raw + LDSCTL_OFF + 32))
__global__ void __launch_bounds__(512, 2) mk_fwd(Args args) {
    extern __shared__ __attribute__((aligned(16))) unsigned char lds_raw[];
    Ctx C; make_ctx(C, args, lds_raw);
    { volatile LAS unsigned* misc = (volatile LAS unsigned*)(C.lds + LDSCTL_OFF); if (C.tid < 64) misc[C.tid] = 0u; }
    __syncthreads();
    xcd_barrier_post((unsigned*)(args.ws + WS_CTL) + 1024);
    run_phase<-1>(C, 0); GRID_BAR();
#pragma unroll 1
    for (int l = 0; l < DEPTH; ++l) {
        if (l == 0) { run_phase<0>(C, l); GRID_BAR(); }
        run_phase<1>(C, l); GRID_BAR();
        run_phase<2>(C, l); GRID_BAR();
        run_phase<3>(C, l); GRID_BAR();
        run_phase<4>(C, l); GRID_BAR();
        run_phase<5>(C, l); GRID_BAR();
        run_phase<6>(C, l); GRID_BAR();
        run_phase<7>(C, l); GRID_BAR();
        run_phase<8>(C, l); GRID_BAR();
        run_phase<9>(C, l); GRID_BAR();
        run_phase<10>(C, l); GRID_BAR();
        run_phase<11>(C, l); if (l + 1 < DEPTH) GRID_BAR();
    }
}

template <int SP> static void launch_phase(const Args& a, int grid, hipStream_t stream) {
    static bool attr_done = false;
    if (!attr_done) { (void)hipFuncSetAttribute((const void*)mk_phase<SP>, hipFuncAttributeMaxDynamicSharedMemorySize, LDS_BYTES); attr_done = true; }
    hipLaunchKernelGGL(mk_phase<SP>, dim3(grid), dim3(512), LDS_BYTES, stream, a);
}
extern "C" void kernel_launch(void* const* d_in, const int* in_sizes, int n_in, void* d_out, int out_size, void* d_ws, size_t ws_size, hipStream_t stream) {
    static int grid = 0;
    if (grid == 0) {
        if (n_in != NIN_PTRS || out_size != T * DM || ws_size < WS_END) { fprintf(stderr, "kernel_launch: unexpected shapes n_in %d out %d ws %zu\n", n_in, out_size, ws_size); grid = -1; return; }
        int dev = 0, cus = 0;
        if (hipGetDevice(&dev) != hipSuccess || hipDeviceGetAttribute(&cus, hipDeviceAttributeMultiprocessorCount, dev) != hipSuccess) { grid = -1; return; }
        grid = cus;
    }
    if (grid < 0) return;
    (void)hipMemsetAsync((char*)d_ws + WS_CTL, 0, CTL_ZERO_BYTES, stream);
    Args a{};
    for (int i = 0; i < NIN_PTRS; ++i) a.in[i] = (const float*)d_in[i];
    a.out = (float*)d_out; a.ws = (unsigned char*)d_ws; a.bar_slot = 0; a.pad = 0; a.ph_hi = 0;
#if MK_ONE_LAUNCH
    static bool attr_done = false;
    if (!attr_done) { (void)hipFuncSetAttribute((const void*)mk_fwd, hipFuncAttributeMaxDynamicSharedMemorySize, LDS_BYTES); attr_done = true; }
    hipLaunchKernelGGL(mk_fwd, dim3(grid), dim3(512), LDS_BYTES, stream, a);
    return;
#endif
    a.ph_lo = 0; launch_phase<-1>(a, grid, stream);
    for (int l = 0; l < DEPTH; ++l) {
        a.ph_lo = l;
        launch_phase<0>(a, grid, stream); launch_phase<1>(a, grid, stream); launch_phase<2>(a, grid, stream); launch_phase<3>(a, grid, stream); launch_phase<4>(a, grid, stream);
        launch_phase<5>(a, grid, stream); launch_phase<6>(a, grid, stream); launch_phase<7>(a, grid, stream); launch_phase<8>(a, grid, stream); launch_phase<9>(a, grid, stream); launch_phase<10>(a, grid, stream); launch_phase<11>(a, grid, stream);
    }
}
```

```cpp
#include <hip/hip_runtime.h>
#include <cstdio>
#include <cstdint>

#ifndef DIAG
#define DIAG 0
#endif
#ifndef DIAG_LO
#define DIAG_LO 0
#endif
#ifndef DIAG_HI
#define DIAG_HI 64
#endif
#ifndef DIAG_MOD
#define DIAG_MOD 64
#endif
#ifndef TOPK_NAIVE
#define TOPK_NAIVE 0
#endif
#ifndef MIX_NAIVE
#define MIX_NAIVE 0
#endif
#ifndef FOX_NAIVE
#define FOX_NAIVE 0
#endif
#ifndef HG_NAIVE_L
#define HG_NAIVE_L 99
#endif
#ifndef DIAG_LAYER
#define DIAG_LAYER 0
#endif
#ifndef MK_ONE_LAUNCH
#define MK_ONE_LAUNCH 1
#endif

#define LAS __attribute__((address_space(3)))
#define GAS __attribute__((address_space(1)))
typedef unsigned short bf16_t;
typedef short bf16x8 __attribute__((ext_vector_type(8)));
typedef float f32x4 __attribute__((ext_vector_type(4)));
typedef float f32x2 __attribute__((ext_vector_type(2)));
typedef unsigned u32x4 __attribute__((ext_vector_type(4)));
typedef unsigned u32x2 __attribute__((ext_vector_type(2)));

constexpr int DM = 1024, BATCH = 2, SEQ = 8192, DEPTH = 2, T = BATCH * SEQ;
constexpr int BW = 512, NIN = 5124, NH = 5120, NG = 4096, NBR = 2048, NQ = 2048;
constexpr int NEXP = 16384, TOPK = 16, PH = 8;
constexpr float ALPHA = 1.4142135623730951f;
constexpr float LN_EPS = 1e-5f, RMS_EPS = 1e-6f;
constexpr int HC_P = 0, HC_HQ = 512, HC_HF = 1024, HC_HI = 1536, HC_HG = 2048, HC_GU = 2560, HC_GV = 3072, HC_FQ = 3584, HC_FK = 4096, HC_FV = 4608;

constexpr size_t MiB = 1u << 20;
constexpr size_t WS_CTL = 0, CTL_ZERO_BYTES = 64 * 1024;
constexpr size_t WS_MISC = 512 * 1024;
constexpr size_t WS_CUM = 768 * 1024;
constexpr size_t WS_W = 1 * MiB;
constexpr size_t W_LAYER = 30 * MiB;
constexpr size_t WO_WIN = 0, WO_WG = 10 * MiB, WO_WBR = 18 * MiB, WO_WOUT = 22 * MiB, WO_WQ = 24 * MiB, WO_KEYS = 28 * MiB, WO_WF = 28 * MiB + 512 * 1024, WO_POOLW = 28 * MiB + 768 * 1024, WO_GWS = 29 * MiB;
constexpr size_t WS_TABU = 64 * MiB, WS_TABV = 96 * MiB;
constexpr size_t WS_XA = 128 * MiB;
constexpr size_t WS_XB = 192 * MiB;
constexpr size_t WS_X1B = 224 * MiB;
constexpr size_t WS_H = 256 * MiB;
constexpr size_t WS_ST = 416 * MiB;
constexpr size_t WS_BR = 448 * MiB;
constexpr size_t WS_G = 256 * MiB;
constexpr size_t WS_MGF = 384 * MiB;
constexpr size_t WS_XC = 256 * MiB;
constexpr size_t WS_Q = 320 * MiB;
constexpr size_t WS_EIDX = 384 * MiB, WS_EGATE = 392 * MiB;
constexpr size_t WS_END = 512 * MiB;

__device__ __forceinline__ float bf2f(unsigned u) { return __builtin_bit_cast(float, u << 16); }
__device__ __forceinline__ unsigned f2bf(float f) { unsigned u = __builtin_bit_cast(unsigned, f); return (u + 0x7fffu + ((u >> 16) & 1u)) >> 16; }
typedef __bf16 bf16x2_t __attribute__((ext_vector_type(2)));
__device__ __forceinline__ unsigned cvtpk(float lo, float hi) { f32x2 v = {lo, hi}; bf16x2_t b = __builtin_convertvector(v, bf16x2_t); return __builtin_bit_cast(unsigned, b); }
__device__ __forceinline__ unsigned pk2(float lo, float hi) { return cvtpk(lo, hi); }
__device__ __forceinline__ float wave_sum(float v) {
#pragma unroll
    for (int o = 32; o > 0; o >>= 1) v += __shfl_xor(v, o, 64);
    return v;
}
__device__ __forceinline__ float sigmoidf_(float x) { return __builtin_amdgcn_rcpf(1.f + __builtin_amdgcn_exp2f(-1.4426950408889634f * x)); }
__device__ __forceinline__ float siluf_(float x) { return x * __builtin_amdgcn_rcpf(1.f + __builtin_amdgcn_exp2f(-1.4426950408889634f * x)); }
__device__ __forceinline__ float geluf_slow(float x) { const float u = 0.7978845608028654f * (x + 0.044715f * x * x * x); return 0.5f * x * (1.f + tanhf(u)); }
__device__ __forceinline__ float geluf_(float x) { const float u2 = -2.302208198f * (x + 0.044715f * x * x * x); return x * __builtin_amdgcn_rcpf(1.f + __builtin_amdgcn_exp2f(u2)); }
__device__ __forceinline__ float logsigmoidf_(float z) { return fminf(z, 0.f) - log1pf(__expf(-fabsf(z))); }

__device__ __forceinline__ unsigned launder_u(unsigned x) { asm volatile("" : "+v"(x)); return __builtin_amdgcn_readfirstlane(x); }
template <class P> __device__ __forceinline__ P launder_ptr(P p) {
    const unsigned lo = launder_u((unsigned)(uintptr_t)p), hi = launder_u((unsigned)((uintptr_t)p >> 32));
    return (P)(((uintptr_t)hi << 32) | lo);
}

namespace pg8 {
constexpr int BM = 256, BK = 64, HALF = 128, HTB = HALF * BK * 2, STAGE_BYTES = 8 * HTB, NXCD = 8, WGM = 8;
__host__ __device__ __forceinline__ int lds_byte(int r, int c) { const int st = (r >> 4) * 2 + (c >> 5), rr = r & 15, cc = c & 31, ob = rr * 64 + cc * 2; return st * 1024 + (ob ^ (((ob >> 9) & 1) << 5)); }
__host__ __device__ __forceinline__ void stage_rc(int b, int& R, int& C) { const int st = b / 1024, sb = b % 1024, swz = sb ^ (((sb >> 9) & 1) << 5); R = (st >> 1) * 16 + swz / 64; C = (st & 1) * 32 + (swz % 64) / 2; }
__host__ __device__ __forceinline__ int perm32(int rho) { const int n = rho >> 4, i = rho & 15; return 8 * (i >> 2) + 4 * n + (i & 3); }

struct Unit { int pm, pn, z; };
struct Gemm { const bf16_t* A; const bf16_t* Bt; int lda, ldb, K; size_t zA, zB; };

struct StaticOrder {
    int nM, nN, nwg, G, c;
    __device__ void init(int M, int N, int G_, int c_) { nM = M / BM; nN = N / BM; nwg = nM * nN; G = G_; c = c_; }
    __device__ bool next(int i, Unit& u) const {
        const long L = (long)i * G + c; if (L >= nwg) return false;
        int wgid = (int)L; { const int q = nwg / NXCD, r = nwg % NXCD, xcd = wgid % NXCD, off = wgid / NXCD; wgid = (xcd < r ? xcd * (q + 1) : r * (q + 1) + (xcd - r) * q) + off; }
        const int nig = WGM * nN, gid = wgid / nig, fm = gid * WGM, gsz = (nM - fm) < WGM ? (nM - fm) : WGM;
        u.pm = fm + ((wgid % nig) % gsz); u.pn = (wgid % nig) / gsz; u.z = 0; return true;
    }
};
struct ZOrder {
    int nM, nN, nZ, ntile, G, c;
    __device__ void init(int M, int N, int Z, int G_, int c_) { nM = M / BM; nN = N / BM; nZ = Z; ntile = nM * nN; G = G_; c = c_; }
    __device__ bool next(int i, Unit& u) const {
        const long L = (long)(i / nZ) * G + c; if (L >= ntile) return false;
        u.pm = (int)L / nN; u.pn = (int)L % nN; u.z = i % nZ; return true;
    }
};

template <class F> struct Epi8 {
    static constexpr bool PERM = true;
    F f;
    __device__ __forceinline__ void operator()(const f32x4 (&acc)[2][2][4][2], const Unit& u, int wr, int wc, int fr, int fq) const {
        const int row0 = u.pm * BM + wr * 64 + fr, col0 = u.pn * BM + wc * 32 + 8 * fq;
#pragma unroll
        for (int ai = 0; ai < 2; ++ai)
#pragma unroll
            for (int m = 0; m < 4; ++m)
#pragma unroll
                for (int bj = 0; bj < 2; ++bj) f(row0 + ai * HALF + m * 16, col0 + bj * HALF, acc[ai][bj][m][0], acc[ai][bj][m][1], u.z);
    }
};
template <class F> struct Epi4 {
    static constexpr bool PERM = false;
    F f;
    __device__ __forceinline__ void operator()(const f32x4 (&acc)[2][2][4][2], const Unit& u, int wr, int wc, int fr, int fq) const {
        const int row0 = u.pm * BM + wr * 64 + fr, col0 = u.pn * BM + wc * 32 + 4 * fq;
#pragma unroll
        for (int ai = 0; ai < 2; ++ai)
#pragma unroll
            for (int m = 0; m < 4; ++m)
#pragma unroll
                for (int bj = 0; bj < 2; ++bj)
#pragma unroll
                    for (int n = 0; n < 2; ++n) f(row0 + ai * HALF + m * 16, col0 + bj * HALF + n * 16, acc[ai][bj][m][n], u.z);
    }
};

template <class Epi, class Sched, bool ALIGN_EPI = true>
__device__ __forceinline__ void gemm_phase(LAS unsigned char* lds, const Gemm g, const Sched& S, const Epi& E, const int tid) {
    const int wid = __builtin_amdgcn_readfirstlane(tid >> 6), lane = tid & 63, wr = wid >> 2, wc = wid & 3, fr = lane & 15, fq = lane >> 4;
    const int K = g.K, nt = K / BK;
    unsigned voffA[2], voffB[2];
#pragma unroll
    for (int i = 0; i < 2; ++i) { int R, C; stage_rc(tid * 16 + i * 8192, R, C); const int Rb = Epi::PERM ? ((R & ~31) + perm32(R & 31)) : R;
        voffA[i] = (unsigned)(R * g.lda + C) * 2u; voffB[i] = (unsigned)(Rb * g.ldb + C) * 2u; }
    const size_t kstep = (size_t)(BK * 2);
    const size_t hstepA = (size_t)HALF * g.lda * 2, hstepB = (size_t)HALF * g.ldb * 2;
    const size_t tstepA = 2 * hstepA, tstepB = 2 * hstepB;
    const unsigned ldsw = (unsigned)wid * 1024u;
    const int aoff = lds_byte(wr * 64 + fr, fq * 8), boff = lds_byte(wc * 32 + fr, fq * 8);
#define PG8_SA(b, h) (((b) * 2 + (h)) * HTB)
#define PG8_SB(b, h) ((4 + (b) * 2 + (h)) * HTB)
#define PG8_STAGE(bufoff, gbase, voff) do { _Pragma("unroll") for (int _i = 0; _i < 2; ++_i) \
        __builtin_amdgcn_global_load_lds((const unsigned*)((const char*)(gbase) + (voff)[_i]), (LAS unsigned*)(lds + (bufoff) + ldsw + _i * 8192), 16, 0, 0); } while (0)
#define PG8_LDA(dst, b, h) do { _Pragma("unroll") for (int m = 0; m < 4; ++m) _Pragma("unroll") for (int k = 0; k < 2; ++k) dst[m][k] = *(const LAS bf16x8*)(lds + PG8_SA(b, h) + aoff + m * 2048 + k * 1024); } while (0)
#define PG8_LDB(dst, b, h) do { _Pragma("unroll") for (int n = 0; n < 2; ++n) _Pragma("unroll") for (int k = 0; k < 2; ++k) dst[n][k] = *(const LAS bf16x8*)(lds + PG8_SB(b, h) + boff + n * 2048 + k * 1024); } while (0)
#define PG8_MMA(ai, bj, At, Bt) do { __builtin_amdgcn_s_setprio(1); _Pragma("unroll") for (int m = 0; m < 4; ++m) _Pragma("unroll") for (int n = 0; n < 2; ++n) _Pragma("unroll") for (int k = 0; k < 2; ++k) \
        acc[ai][bj][m][n] = __builtin_amdgcn_mfma_f32_16x16x32_bf16(Bt[n][k], At[m][k], acc[ai][bj][m][n], 0, 0, 0); __builtin_amdgcn_s_setprio(0); } while (0)
#define PG8_WAIT_V(n) asm volatile("s_waitcnt vmcnt(" #n ")" ::: "memory")
#define PG8_WAIT_L(n) asm volatile("s_waitcnt lgkmcnt(" #n ")" ::: "memory")
#define PG8_BAR __builtin_amdgcn_s_barrier()
#define PG8_SCHED __builtin_amdgcn_sched_barrier(0)
    Unit cur, nxt; int ui = 0;
    if (!S.next(0, cur)) return;
    f32x4 acc[2][2][4][2];
#pragma unroll
    for (int a = 0; a < 2; ++a)
#pragma unroll
        for (int b = 0; b < 2; ++b)
#pragma unroll
            for (int m = 0; m < 4; ++m)
#pragma unroll
                for (int n = 0; n < 2; ++n) acc[a][b][m][n] = (f32x4){0.f, 0.f, 0.f, 0.f};
    bf16x8 At[4][2], B0[2][2], B1[2][2];
    const char* cA = (const char*)(g.A + (size_t)cur.z * g.zA) + (size_t)cur.pm * tstepA; const char* cB = (const char*)(g.Bt + (size_t)cur.z * g.zB) + (size_t)cur.pn * tstepB;
    PG8_STAGE(PG8_SB(0, 0), cB, voffB); PG8_STAGE(PG8_SB(0, 1), cB + hstepB, voffB); PG8_STAGE(PG8_SA(0, 0), cA, voffA); PG8_STAGE(PG8_SA(0, 1), cA + hstepA, voffA);
    if (wr == 1) PG8_BAR;
    PG8_WAIT_V(2); PG8_BAR;
    PG8_STAGE(PG8_SB(1, 0), cB + kstep, voffB); PG8_STAGE(PG8_SA(1, 0), cA + kstep, voffA); PG8_STAGE(PG8_SB(1, 1), cB + hstepB + kstep, voffB);
    PG8_WAIT_V(6); PG8_BAR;
    for (;;) {
        const bool has_next = S.next(ui + 1, nxt);
        const char* nA = has_next ? (const char*)(g.A + (size_t)nxt.z * g.zA) + (size_t)nxt.pm * tstepA : cA;
        const char* nB = has_next ? (const char*)(g.Bt + (size_t)nxt.z * g.zB) + (size_t)nxt.pn * tstepB : cB;
        for (int t = 0; t < nt; t += 2) {
            const bool last = (t == nt - 2);
            const char* a1 = cA + (size_t)(t + 1) * kstep;
            const char* a2 = last ? nA : cA + (size_t)(t + 2) * kstep; const char* b2 = last ? nB : cB + (size_t)(t + 2) * kstep;
            const char* a3 = a2 + kstep; const char* b3 = b2 + kstep;
            PG8_LDB(B0, 0, 0); PG8_LDB(B1, 0, 1); PG8_SCHED; PG8_LDA(At, 0, 0); PG8_STAGE(PG8_SA(1, 1), a1 + hstepA, voffA);
            PG8_WAIT_V(8); PG8_WAIT_L(0); PG8_BAR; PG8_MMA(0, 0, At, B0); PG8_MMA(0, 1, At, B1); PG8_BAR; PG8_SCHED;
            PG8_LDA(At, 0, 1); PG8_STAGE(PG8_SB(0, 0), b2, voffB); PG8_STAGE(PG8_SB(0, 1), b2 + hstepB, voffB); PG8_STAGE(PG8_SA(0, 0), a2, voffA);
            PG8_WAIT_V(8); PG8_WAIT_L(0); PG8_BAR; PG8_MMA(1, 0, At, B0); PG8_MMA(1, 1, At, B1); PG8_BAR; PG8_SCHED;
            PG8_LDB(B0, 1, 0); PG8_LDB(B1, 1, 1); PG8_SCHED; PG8_LDA(At, 1, 0); PG8_STAGE(PG8_SA(0, 1), a2 + hstepA, voffA);
            PG8_WAIT_V(8); PG8_WAIT_L(0); PG8_BAR; PG8_MMA(0, 0, At, B0); PG8_MMA(0, 1, At, B1); PG8_BAR; PG8_SCHED;
            PG8_LDA(At, 1, 1); PG8_STAGE(PG8_SB(1, 0), b3, voffB); PG8_STAGE(PG8_SB(1, 1), b3 + hstepB, voffB); PG8_STAGE(PG8_SA(1, 0), a3, voffA);
            PG8_WAIT_V(8); PG8_WAIT_L(0); PG8_BAR; PG8_MMA(1, 0, At, B0); PG8_MMA(1, 1, At, B1); PG8_BAR; PG8_SCHED;
        }
        if constexpr (ALIGN_EPI) { if (wr == 0) PG8_BAR; }
        E(acc, cur, wr, wc, fr, fq);
        if (!has_next) break;
#pragma unroll
        for (int a = 0; a < 2; ++a)
#pragma unroll
            for (int b = 0; b < 2; ++b)
#pragma unroll
                for (int m = 0; m < 4; ++m)
#pragma unroll
                    for (int n = 0; n < 2; ++n) acc[a][b][m][n] = (f32x4){0.f, 0.f, 0.f, 0.f};
        cur = nxt; cA = nA; cB = nB; ++ui;
        if constexpr (ALIGN_EPI) { if (wr == 1) PG8_BAR; }
    }
    PG8_WAIT_V(0);
    if constexpr (!ALIGN_EPI) { if (wr == 0) PG8_BAR; }
    PG8_BAR;
#undef PG8_SA
#undef PG8_SB
#undef PG8_STAGE
#undef PG8_LDA
#undef PG8_LDB
#undef PG8_MMA
#undef PG8_WAIT_V
#undef PG8_WAIT_L
#undef PG8_BAR
#undef PG8_SCHED
}
}

#define XB_TMO      128
#define XB_XCNT(j)  (256  + 64 * (j))
#define XB_XSUB(j)  (1280 + 64 * (j))
#define XB_XGEN(j)  (2304 + 64 * (j))
#define XB_TOP      3328
#define XB_TOPGEN   3392
#define XCD_BAR_WORDS 3456
#define XB_SPIN_CAP (1u << 22)
__device__ __forceinline__ unsigned xb_ld(unsigned* p)              { return __hip_atomic_load(p, __ATOMIC_RELAXED, __HIP_MEMORY_SCOPE_AGENT); }
__device__ __forceinline__ unsigned xb_add(unsigned* p, unsigned v) { return __hip_atomic_fetch_add(p, v, __ATOMIC_RELAXED, __HIP_MEMORY_SCOPE_AGENT); }
__device__ __forceinline__ unsigned xb_xcc_id() { return (unsigned)__builtin_amdgcn_s_getreg((3 << 11) | 20) & 0xFu; }
#define XB_SPIN(cond, bar) do { unsigned _sp = 0; while (cond) { __builtin_amdgcn_s_sleep(1); \
    if ((++_sp & 255u) == 0u) { if (xb_ld(&(bar)[XB_TMO])) break; if (_sp > XB_SPIN_CAP) { atomicAdd(&(bar)[XB_TMO], 1u); break; } } } } while (0)
__device__ __forceinline__ void xcd_barrier_post(unsigned* bar) {
    if (threadIdx.x == 0) (void)xb_add(&bar[XB_XCNT(xb_xcc_id())], 1u);
}
__device__ __forceinline__ void xcd_barrier_complete(unsigned* bar, unsigned x, unsigned& nloc, unsigned& nx) {
    const unsigned G = gridDim.x * gridDim.y * gridDim.z;
    unsigned sum, cnt, mine, sp = 0u;
    for (;;) {
        sum = 0u; cnt = 0u; mine = 0u;
#pragma unroll
        for (unsigned j = 0; j < 16; ++j) { const unsigned c = xb_ld(&bar[XB_XCNT(j)]); sum += c; cnt += (c > 0u) ? 1u : 0u; mine = (j == x) ? c : mine; }
        if (sum == G) break;
        __builtin_amdgcn_s_sleep(1);
        if ((++sp & 255u) == 0u) { if (xb_ld(&bar[XB_TMO])) break; if (sp > XB_SPIN_CAP) { atomicAdd(&bar[XB_TMO], 1u); break; } }
    }
    nloc = mine > 0u ? mine : 1u; nx = cnt > 0u ? cnt : 1u;
}
__device__ __noinline__ void xcd_barrier_leader(unsigned* bar, volatile LAS unsigned* st) {
    const unsigned x = xb_xcc_id();
    __builtin_amdgcn_s_waitcnt(0);
    unsigned nloc = st[0], nx = st[1];
    if (nloc == 0u) { xcd_barrier_complete(bar, x, nloc, nx); st[0] = nloc; st[1] = nx; }
    const unsigned old = xb_add(&bar[XB_XSUB(x)], 1u);
    const unsigned gen = old / nloc;
    if (old + 1u == (gen + 1u) * nloc) {
        __builtin_amdgcn_fence(__ATOMIC_RELEASE, "agent");
        asm volatile("s_waitcnt vmcnt(0)" ::: "memory");
        const unsigned og = xb_add(&bar[XB_TOP], 1u);
        const unsigned tg = og / nx;
        if (og + 1u == (tg + 1u) * nx) xb_add(&bar[XB_TOPGEN], 1u);
        else XB_SPIN(xb_ld(&bar[XB_TOPGEN]) == tg, bar);
        __builtin_amdgcn_fence(__ATOMIC_ACQUIRE, "agent");
        xb_add(&bar[XB_XGEN(x)], 1u);
        asm volatile("s_waitcnt vmcnt(0)" ::: "memory");
    } else {
        XB_SPIN(xb_ld(&bar[XB_XGEN(x)]) == gen, bar);
        __builtin_amdgcn_fence(__ATOMIC_ACQUIRE, "agent");
        asm volatile("s_waitcnt vmcnt(0)" ::: "memory");
    }
}
__device__ __forceinline__ void xcd_barrier(unsigned* bar, volatile LAS unsigned* st) {
    asm volatile("s_waitcnt vmcnt(0)" ::: "memory");
    __syncthreads();
    if (threadIdx.x == 0) xcd_barrier_leader(bar, st);
    __syncthreads();
}

constexpr int NIN_PTRS = 23;
struct Args { const float* in[NIN_PTRS]; float* out; unsigned char* ws; int ph_lo, ph_hi, bar_slot, pad; };
enum { I_X = 0, I_WIN, I_BFOX, I_POOLW, I_POOLS, I_LBL, I_HNG, I_GLNG, I_GLNB, I_GWS, I_GBS, I_WGATE, I_BGATE, I_WBR, I_WOUT, I_LN1G, I_LN1B, I_WQ, I_KEYS, I_PU, I_PV, I_LN2G, I_LN2B };

constexpr int LDS_BYTES = 147456;
constexpr int LDSCTL_OFF = 143360;

struct Ctx {
    LAS unsigned char* lds;
    unsigned char* ws;
    const float* const* in;
    float* out;
    int tid, lane, wave, G, bid, vcu;
};

__device__ __forceinline__ void tconv_job(const Ctx& C, const float* src, int ld_src, int K, int N, bf16_t* dst) {
    LAS float* tile = (LAS float*)C.lds;
    const int nk = K / 64, nn = N / 64, ntiles = nk * nn;
    for (int tl = C.bid; tl < ntiles; tl += C.G) {
        const int k0 = (tl / nn) * 64, n0 = (tl % nn) * 64;
#pragma unroll
        for (int p = 0; p < 2; ++p) {
            const int kr = (C.tid >> 4) + p * 32, nc = (C.tid & 15) * 4;
            const f32x4 v = *(const f32x4*)(src + (size_t)(k0 + kr) * ld_src + n0 + nc);
            tile[kr * 65 + nc + 0] = v[0]; tile[kr * 65 + nc + 1] = v[1]; tile[kr * 65 + nc + 2] = v[2]; tile[kr * 65 + nc + 3] = v[3];
        }
        __syncthreads();
        {
            const int n = C.tid >> 3, k8 = (C.tid & 7) * 8;
            u32x4 o;
#pragma unroll
            for (int j = 0; j < 4; ++j) o[j] = pk2(tile[(k8 + 2 * j) * 65 + n], tile[(k8 + 2 * j + 1) * 65 + n]);
            *(u32x4*)(dst + (size_t)(n0 + n) * K + k0 + k8) = o;
        }
        __syncthreads();
    }
}
__device__ __forceinline__ void cvt_copy(const Ctx& C, const float* src, bf16_t* dst, size_t n) {
    const size_t n8 = n / 8;
    for (size_t i = (size_t)C.bid * 512 + C.tid; i < n8; i += (size_t)C.G * 512) {
        const f32x4 a = *(const f32x4*)(src + i * 8), b = *(const f32x4*)(src + i * 8 + 4);
        u32x4 o; o[0] = pk2(a[0], a[1]); o[1] = pk2(a[2], a[3]); o[2] = pk2(b[0], b[1]); o[3] = pk2(b[2], b[3]);
        *(u32x4*)(dst + i * 8) = o;
    }
}
__device__ __forceinline__ void p_conv_weights(const Ctx& C) {
    for (int l = 0; l < DEPTH; ++l) {
        unsigned char* wb = C.ws + WS_W + (size_t)l * W_LAYER;
        tconv_job(C, C.in[I_WIN] + (size_t)l * DM * NIN, NIN, DM, NH, (bf16_t*)(wb + WO_WIN));
        tconv_job(C, C.in[I_WGATE] + (size_t)l * DM * NG, NG, DM, NG, (bf16_t*)(wb + WO_WG));
        for (int m = 0; m < 4; ++m)
            tconv_job(C, C.in[I_WBR] + ((size_t)l * 4 + m) * BW * DM, DM, BW, DM, (bf16_t*)(wb + WO_WBR) + (size_t)m * DM * BW);
        tconv_job(C, C.in[I_WOUT] + (size_t)l * DM * DM, DM, DM, DM, (bf16_t*)(wb + WO_WOUT));
        tconv_job(C, C.in[I_WQ] + (size_t)l * DM * NQ, NQ, DM, NQ, (bf16_t*)(wb + WO_WQ));
        cvt_copy(C, C.in[I_KEYS] + (size_t)l * 2 * PH * 128 * 128, (bf16_t*)(wb + WO_KEYS), (size_t)2 * PH * 128 * 128);
        for (int g = 0; g < 4; ++g)
            tconv_job(C, C.in[I_POOLW] + ((size_t)l * 4 + g) * 128 * 128, 128, 128, 128, (bf16_t*)(wb + WO_POOLW) + (size_t)g * 128 * 128);
        {
            bf16_t* gw = (bf16_t*)(wb + WO_GWS); const float* src = C.in[I_GWS] + (size_t)l * 4 * 128 * 128;
            for (int i = C.bid * 512 + C.tid; i < 4 * 128 * 128; i += C.G * 512) { const int t = (i >> 7) & 127, sx = i & 127; gw[i] = (bf16_t)f2bf(sx <= t ? src[i] : 0.f); }
        }
        float* wf = (float*)(wb + WO_WF);
        for (int i = C.bid * 512 + C.tid; i < 4 * DM; i += C.G * 512) { const int h = i / DM, k = i % DM; wf[i] = C.in[I_WIN][(size_t)l * DM * NIN + (size_t)k * NIN + NH + h]; }
    }
}
constexpr size_t WS_U8 = WS_TABU, WS_V8 = WS_TABU + 16 * MiB, WS_SU = WS_TABU + 32 * MiB, WS_SV = WS_SU + 64 * 1024;
__device__ __forceinline__ float wave_max(float v) {
#pragma unroll
    for (int o = 32; o > 0; o >>= 1) v = fmaxf(v, __shfl_xor(v, o, 64));
    return v;
}
__device__ __forceinline__ void quant_rows(const Ctx& C, const float* src, unsigned char* dst, float* scl) {
    for (int row = C.bid * 8 + C.wave; row < NEXP; row += C.G * 8) {
        const float* p = src + (size_t)row * DM + C.lane * 16;
        f32x4 v[4]; float mx = 0.f;
#pragma unroll
        for (int i = 0; i < 4; ++i) { v[i] = *(const f32x4*)(p + 4 * i);
#pragma unroll
            for (int e = 0; e < 4; ++e) mx = fmaxf(mx, fabsf(v[i][e])); }
        mx = fmaxf(wave_max(mx), 1e-30f);
        const float sc = mx * (1.f / 127.f), isc = 127.f / mx;
        u32x4 o;
#pragma unroll
        for (int i = 0; i < 4; ++i) { unsigned wd = 0u;
#pragma unroll
            for (int e = 0; e < 4; ++e) { const int q = (int)rintf(v[i][e] * isc) + 128; wd |= (unsigned)q << (8 * e); }
            o[i] = wd; }
        *(u32x4*)(dst + (size_t)row * DM + C.lane * 16) = o;
        if (C.lane == 0) scl[row] = sc;
    }
}
__device__ __forceinline__ void p_conv_tables(const Ctx& C, int l) {
    quant_rows(C, C.in[I_PU] + (size_t)l * NEXP * DM, C.ws + WS_U8, (float*)(C.ws + WS_SU));
    quant_rows(C, C.in[I_PV] + (size_t)l * NEXP * DM, C.ws + WS_V8, (float*)(C.ws + WS_SV));
}

__device__ __forceinline__ void row_emit(const Ctx& C, int row, const float (&v)[16], int l, bool want_lsig) {
    bf16_t* xb = (bf16_t*)(C.ws + WS_XB) + (size_t)row * DM;
    u32x4 o0, o1;
#pragma unroll
    for (int j = 0; j < 4; ++j) { o0[j] = pk2(v[2 * j], v[2 * j + 1]); o1[j] = pk2(v[8 + 2 * j], v[8 + 2 * j + 1]); }
    *(u32x4*)(xb + C.lane * 8) = o0; *(u32x4*)(xb + 512 + C.lane * 8) = o1;
    if (want_lsig) {
        const float* wf = (const float*)(C.ws + WS_W + (size_t)l * W_LAYER + WO_WF);
        float* lsig = (float*)(C.ws + WS_MISC);
#pragma unroll
        for (int h = 0; h < 4; ++h) {
            const f32x4 a0 = *(const f32x4*)(wf + h * DM + C.lane * 8), a1 = *(const f32x4*)(wf + h * DM + C.lane * 8 + 4);
            const f32x4 b0 = *(const f32x4*)(wf + h * DM + 512 + C.lane * 8), b1 = *(const f32x4*)(wf + h * DM + 512 + C.lane * 8 + 4);
            float s = 0.f;
#pragma unroll
            for (int j = 0; j < 4; ++j) s += v[j] * a0[j] + v[4 + j] * a1[j] + v[8 + j] * b0[j] + v[12 + j] * b1[j];
            s = wave_sum(s);
            if (C.lane == 0) lsig[(size_t)row * 4 + h] = logsigmoidf_(s + C.in[I_BFOX][l * 4 + h]);
        }
    }
}
__device__ __forceinline__ void load_row16(const float* p, int lane, float (&v)[16]) {
    const f32x4 a0 = *(const f32x4*)(p + lane * 8), a1 = *(const f32x4*)(p + lane * 8 + 4), b0 = *(const f32x4*)(p + 512 + lane * 8), b1 = *(const f32x4*)(p + 512 + lane * 8 + 4);
#pragma unroll
    for (int j = 0; j < 4; ++j) { v[j] = a0[j]; v[4 + j] = a1[j]; v[8 + j] = b0[j]; v[12 + j] = b1[j]; }
}
__device__ __forceinline__ void store_row16(float* p, int lane, const float (&v)[16]) {
    *(f32x4*)(p + lane * 8) = (f32x4){v[0], v[1], v[2], v[3]}; *(f32x4*)(p + lane * 8 + 4) = (f32x4){v[4], v[5], v[6], v[7]};
    *(f32x4*)(p + 512 + lane * 8) = (f32x4){v[8], v[9], v[10], v[11]}; *(f32x4*)(p + 512 + lane * 8 + 4) = (f32x4){v[12], v[13], v[14], v[15]};
}
__device__ __forceinline__ void ln_row16(float (&v)[16], const float* g, const float* b, int lane) {
    float s = 0.f;
#pragma unroll
    for (int j = 0; j < 16; ++j) s += v[j];
    const float mean = wave_sum(s) * (1.f / DM);
    float q = 0.f;
#pragma unroll
    for (int j = 0; j < 16; ++j) { const float d = v[j] - mean; q += d * d; }
    const float rstd = rsqrtf(wave_sum(q) * (1.f / DM) + LN_EPS);
    float gg[16], bb[16];
    load_row16(g, lane, gg); load_row16(b, lane, bb);
#pragma unroll
    for (int j = 0; j < 16; ++j) v[j] = (v[j] - mean) * rstd * gg[j] + bb[j];
}
__device__ __forceinline__ void p_rowpass0(const Ctx& C) {
    for (int row = C.bid * 8 + C.wave; row < T; row += C.G * 8) {
        float v[16]; load_row16(C.in[I_X] + (size_t)row * DM, C.lane, v);
        row_emit(C, row, v, 0, true);
    }
}
__device__ __forceinline__ void p_cumsum(const Ctx& C) {
    if (C.bid >= BATCH * 4) return;
    const float* lsig = (const float*)(C.ws + WS_MISC);
    float* cum = (float*)(C.ws + WS_CUM);
    LAS float* wt = (LAS float*)C.lds;
    const int b = C.bid >> 2, h = C.bid & 3;
    float v[16];
#pragma unroll
    for (int j = 0; j < 16; ++j) v[j] = lsig[((size_t)b * SEQ + C.tid * 16 + j) * 4 + h];
#pragma unroll
    for (int j = 1; j < 16; ++j) v[j] += v[j - 1];
    float inc = v[15];
#pragma unroll
    for (int o = 1; o < 64; o <<= 1) { const float t = __shfl_up(inc, o, 64); if (C.lane >= o) inc += t; }
    if (C.lane == 63) wt[C.wave] = inc;
    __syncthreads();
    float off = inc - v[15];
    for (int w2 = 0; w2 < C.wave; ++w2) off += wt[w2];
    float* cp = cum + ((size_t)b * 4 + h) * SEQ + C.tid * 16;
#pragma unroll
    for (int j4 = 0; j4 < 4; ++j4) *(f32x4*)(cp + 4 * j4) = (f32x4){v[4 * j4] + off, v[4 * j4 + 1] + off, v[4 * j4 + 2] + off, v[4 * j4 + 3] + off};
    __syncthreads();
}
__device__ __forceinline__ void load_row16_bf(const bf16_t* p, int lane, float (&v)[16]) {
    const u32x4 a = *(const u32x4*)(p + lane * 8), b = *(const u32x4*)(p + 512 + lane * 8);
#pragma unroll
    for (int j = 0; j < 4; ++j) { v[2 * j] = bf2f(a[j] & 0xffffu); v[2 * j + 1] = bf2f(a[j] >> 16); v[8 + 2 * j] = bf2f(b[j] & 0xffffu); v[9 + 2 * j] = bf2f(b[j] >> 16); }
}
__device__ __forceinline__ void p_ln1(const Ctx& C, int l) {
    const bf16_t* y1 = (const bf16_t*)(C.ws + WS_XC); bf16_t* x1b = (bf16_t*)(C.ws + WS_X1B);
    for (int row = C.bid * 8 + C.wave; row < T; row += C.G * 8) {
        float v[16]; load_row16_bf(y1 + (size_t)row * DM, C.lane, v);
        ln_row16(v, C.in[I_LN1G] + l * DM, C.in[I_LN1B] + l * DM, C.lane);
        u32x4 o0, o1;
#pragma unroll
        for (int j = 0; j < 4; ++j) { o0[j] = pk2(v[2 * j], v[2 * j + 1]); o1[j] = pk2(v[8 + 2 * j], v[8 + 2 * j + 1]); }
        *(u32x4*)(x1b + (size_t)row * DM + C.lane * 8) = o0; *(u32x4*)(x1b + (size_t)row * DM + 512 + C.lane * 8) = o1;
    }
}

__device__ __forceinline__ void mix_pool_naive(const Ctx& C, int l) {
    const bf16_t* H = (const bf16_t*)(C.ws + WS_H); bf16_t* BR = (bf16_t*)(C.ws + WS_BR);
    LAS float* dd = (LAS float*)C.lds;
    for (int u = C.bid; u < (T / 64) * 4; u += C.G) {
        const int g = u & 3, t0 = (u >> 2) * 64, w = 2 << g;
        for (int idx = C.tid; idx < 64 * 128; idx += 512) {
            const int r = idx >> 7, c = idx & 127, row = t0 + r, pos = row & (SEQ - 1);
            const int nwin = (pos + 1 < w) ? pos + 1 : w;
            float s = 0.f;
            for (int j = 0; j < nwin; ++j) s += bf2f(H[(size_t)(row - j) * NH + HC_P + g * 128 + c]);
            dd[idx] = s / (float)nwin - bf2f(H[(size_t)row * NH + HC_P + g * 128 + c]);
        }
        __syncthreads();
        const int dcol = C.tid & 127, rq = C.tid >> 7;
        float acc[16];
#pragma unroll
        for (int i = 0; i < 16; ++i) acc[i] = 0.f;
        const float* pw = C.in[I_POOLW] + ((size_t)l * 4 + g) * 128 * 128;
        for (int c = 0; c < 128; ++c) {
            const float wv = pw[c * 128 + dcol];
#pragma unroll
            for (int i = 0; i < 16; ++i) acc[i] += dd[(rq * 16 + i) * 128 + c] * wv;
        }
        const float sc = C.in[I_POOLS][l * BW + g * 128 + dcol];
#pragma unroll
        for (int i = 0; i < 16; ++i) BR[(size_t)(t0 + rq * 16 + i) * NBR + 0 + g * 128 + dcol] = (bf16_t)f2bf(acc[i] * sc);
        __syncthreads();
    }
}
__device__ __forceinline__ void mix_gmlp_naive(const Ctx& C, int l) {
    const bf16_t* H = (const bf16_t*)(C.ws + WS_H); bf16_t* BR = (bf16_t*)(C.ws + WS_BR);
    LAS float* vn = (LAS float*)C.lds;
    for (int u = C.bid; u < (T / 128) * 4; u += C.G) {
        const int g = u & 3, t0 = (u >> 2) * 128;
        for (int i = 0; i < 16; ++i) {
            const int r = C.wave * 16 + i, row = t0 + r;
            const u32x4 raw = *(const u32x4*)(H + (size_t)row * NH + HC_GV + C.lane * 8);
            float e[8];
#pragma unroll
            for (int j = 0; j < 4; ++j) { e[2 * j] = geluf_(bf2f(raw[j] & 0xffffu)); e[2 * j + 1] = geluf_(bf2f(raw[j] >> 16)); }
            float s = 0.f;
#pragma unroll
            for (int j = 0; j < 8; ++j) s += e[j];
            const float mean = wave_sum(s) * (1.f / BW);
            float q = 0.f;
#pragma unroll
            for (int j = 0; j < 8; ++j) { const float d = e[j] - mean; q += d * d; }
            const float rstd = rsqrtf(wave_sum(q) * (1.f / BW) + LN_EPS);
            if ((C.lane >> 4) == g) {
#pragma unroll
                for (int j = 0; j < 8; ++j) { const int col = C.lane * 8 + j;
                    vn[r * 128 + (col - g * 128)] = (e[j] - mean) * rstd * C.in[I_GLNG][l * BW + col] + C.in[I_GLNB][l * BW + col]; }
            }
        }
        __syncthreads();
        const int c = C.tid & 127, tq = C.tid >> 7;
        const float* wsg = C.in[I_GWS] + ((size_t)l * 4 + g) * 128 * 128;
        for (int t = tq; t < 128; t += 4) {
            float acc = 0.f;
            for (int s = 0; s <= t; ++s) acc += wsg[t * 128 + s] * vn[s * 128 + c];
            const float sv = acc + C.in[I_GBS][(l * 4 + g) * 128 + t];
            const float uv = geluf_(bf2f(H[(size_t)(t0 + t) * NH + HC_GU + g * 128 + c]));
            BR[(size_t)(t0 + t) * NBR + 1024 + g * 128 + c] = (bf16_t)f2bf(uv * sv);
        }
        __syncthreads();
    }
}
__device__ __forceinline__ void mix_fox_naive(const Ctx& C, int l) {
    const bf16_t* H = (const bf16_t*)(C.ws + WS_H); bf16_t* BR = (bf16_t*)(C.ws + WS_BR);
    const float* cum = (const float*)(C.ws + WS_CUM);
    const float scale = 0.08838834764831845f;
    for (int u = C.bid; u < T * 4 / 8; u += C.G) {
        const int rid = u * 8 + C.wave;
        const int h = rid & 3, row = rid >> 2, b = row / SEQ, t = row % SEQ;
        const unsigned qraw = *(const unsigned*)(H + (size_t)row * NH + HC_FQ + h * 128 + C.lane * 2);
        const float q0 = bf2f(qraw & 0xffffu) * scale, q1 = bf2f(qraw >> 16) * scale;
        const float* cm = cum + ((size_t)b * 4 + h) * SEQ;
        const float ct = cm[t];
        float m = -1e30f, lsum = 0.f, o0 = 0.f, o1 = 0.f;
        for (int s = t; s >= 0; --s) {
            const size_t kr = (size_t)(b * SEQ + s) * NH + h * 128 + C.lane * 2;
            const unsigned kraw = *(const unsigned*)(H + kr + HC_FK);
            const unsigned vraw = *(const unsigned*)(H + kr + HC_FV);
            float d = q0 * bf2f(kraw & 0xffffu) + q1 * bf2f(kraw >> 16);
            d = wave_sum(d);
            const float z = d + ct - cm[s];
            const float mn = fmaxf(m, z), al = __expf(m - mn), p = __expf(z - mn);
            lsum = lsum * al + p; o0 = o0 * al + p * bf2f(vraw & 0xffffu); o1 = o1 * al + p * bf2f(vraw >> 16); m = mn;
        }
        const float inv = 1.f / lsum;
        *(unsigned*)(BR + (size_t)row * NBR + 1536 + h * 128 + C.lane * 2) = pk2(o0 * inv, o1 * inv);
    }
}
__device__ __forceinline__ void mix_hgrn_naive(const Ctx& C, int l) {
    if (C.bid >= BATCH * 4) return;
    const bf16_t* H = (const bf16_t*)(C.ws + WS_H); bf16_t* BR = (bf16_t*)(C.ws + WS_BR);
    const int b = C.bid >> 2, h = C.bid & 3;
    LAS float* fdec = (LAS float*)C.lds;
    LAS float* kkv = fdec + 32 * 128;
    LAS float* qsv = kkv + 32 * 128;
    LAS float* vv = qsv + 32 * 128;
    LAS float* opart = vv + 32 * 128;
    const int kq = C.tid >> 7, v = C.tid & 127;
    float S[32];
#pragma unroll
    for (int j = 0; j < 32; ++j) S[j] = 0.f;
    for (int c0 = 0; c0 < SEQ; c0 += 32) {
        for (int idx = C.tid; idx < 32 * 128; idx += 512) {
            const int st = idx >> 7, k = idx & 127; const size_t rb = (size_t)(b * SEQ + c0 + st) * NH + h * 128 + k;
            float lb = 0.f;
            if (l == 1) { const float z0 = C.in[I_LBL][h * 128 + k], z1 = C.in[I_LBL][BW + h * 128 + k]; lb = 1.f / (1.f + __expf(z0 - z1)); }
            const float zf = bf2f(H[rb + HC_HF]);
            const float kk = (1.f - lb) * sigmoidf_(-zf);
            fdec[idx] = 1.f - kk; kkv[idx] = kk; qsv[idx] = siluf_(bf2f(H[rb + HC_HQ])); vv[idx] = bf2f(H[rb + HC_HI]);
        }
        __syncthreads();
        for (int st = 0; st < 32; ++st) {
            const float vt = vv[st * 128 + v];
            float part = 0.f;
#pragma unroll
            for (int j = 0; j < 32; ++j) { const int k = kq * 32 + j; S[j] = fdec[st * 128 + k] * S[j] + kkv[st * 128 + k] * vt; part += S[j] * qsv[st * 128 + k]; }
            opart[(kq * 32 + st) * 128 + v] = part;
        }
        __syncthreads();
        for (int i = 0; i < 4; ++i) {
            const int st = C.wave * 4 + i, row = b * SEQ + c0 + st;
            float o0 = 0.f, o1 = 0.f;
#pragma unroll
            for (int q = 0; q < 4; ++q) { o0 += opart[(q * 32 + st) * 128 + C.lane]; o1 += opart[(q * 32 + st) * 128 + 64 + C.lane]; }
            const float ss = wave_sum(o0 * o0 + o1 * o1);
            const float r = rsqrtf(ss * (1.f / 128.f) + RMS_EPS);
            const float g0 = siluf_(bf2f(H[(size_t)row * NH + HC_HG + h * 128 + C.lane])), g1 = siluf_(bf2f(H[(size_t)row * NH + HC_HG + h * 128 + 64 + C.lane]));
            BR[(size_t)row * NBR + 512 + h * 128 + C.lane] = (bf16_t)f2bf(o0 * r * C.in[I_HNG][l * 128 + C.lane] * g0);
            BR[(size_t)row * NBR + 512 + h * 128 + 64 + C.lane] = (bf16_t)f2bf(o1 * r * C.in[I_HNG][l * 128 + 64 + C.lane] * g1);
        }
        __syncthreads();
    }
}


typedef float f32x16 __attribute__((ext_vector_type(16)));
typedef short s16x4 __attribute__((ext_vector_type(4)));
typedef short v4i16_t __attribute__((ext_vector_type(4)));
__device__ __forceinline__ s16x4 vtr(const LAS unsigned char* p) { return __builtin_bit_cast(s16x4, __builtin_amdgcn_ds_read_tr16_b64_v4i16((LAS v4i16_t*)p)); }
__device__ __forceinline__ float xor32(float x) { return __shfl_xor(x, 32, 64); }
#define MFMA32(a, b, c) __builtin_amdgcn_mfma_f32_32x32x16_bf16((a), (b), (c), 0, 0, 0)
constexpr int CW_KMAX = 16;

__device__ __forceinline__ void p_knorm(const Ctx& C, int l) {
    const bf16_t* H = (const bf16_t*)(C.ws + WS_H);
    unsigned* kmax = (unsigned*)(C.ws + WS_CTL) + CW_KMAX + l * 8;
    float best = 0.f;
    int bsel = -1;
    for (int row = C.bid * 8 + C.wave; row < T; row += C.G * 8) {
        const u32x4 raw = *(const u32x4*)(H + (size_t)row * NH + HC_FK + C.lane * 8);
        float s = 0.f;
#pragma unroll
        for (int j = 0; j < 4; ++j) { const float a = bf2f(raw[j] & 0xffffu), b = bf2f(raw[j] >> 16); s += a * a + b * b; }
#pragma unroll
        for (int o = 8; o > 0; o >>= 1) s += __shfl_xor(s, o, 64);
        const int b = row / SEQ;
        if (bsel >= 0 && b != bsel) { if ((C.lane & 15) == 0) atomicMax(kmax + bsel * 4 + (C.lane >> 4), __builtin_bit_cast(unsigned, best)); best = 0.f; }
        bsel = b; best = fmaxf(best, s);
    }
    if (bsel >= 0 && (C.lane & 15) == 0) atomicMax(kmax + bsel * 4 + (C.lane >> 4), __builtin_bit_cast(unsigned, best));
}

constexpr int FOX_KST = 272, FOX_VST = 320;
constexpr int FOX_KB = 0, FOX_VB = 2 * 64 * FOX_KST, FOX_BETA = FOX_VB + 2 * 64 * FOX_VST, FOX_FLAG = FOX_BETA + 2 * 64 * 4, FOX_END = FOX_FLAG + 2 * 8 * 4;
__device__ __forceinline__ void mix_fox(const Ctx& C, int l) {
    const bf16_t* H = (const bf16_t*)(C.ws + WS_H); bf16_t* BR = (bf16_t*)(C.ws + WS_BR);
    const float* cum = (const float*)(C.ws + WS_CUM);
    const unsigned* kmaxw = (const unsigned*)(C.ws + WS_CTL) + CW_KMAX + l * 8;
    const float LOG2E = 1.4426950408889634f, QS = 0.08838834764831845f * LOG2E;
    const int lane = C.lane, w = C.wave, r32 = lane & 31, hh = lane >> 5;
    LAS unsigned char* lds = C.lds;
    LAS float* betaL = (LAS float*)(lds + FOX_BETA);
    volatile LAS int* flagL = (volatile LAS int*)(lds + FOX_FLAG);
    for (int u = C.bid; u < BATCH * 4 * (SEQ / 256); u += C.G) {
        const int qb = u % (SEQ / 256), bh = u / (SEQ / 256), b = bh >> 2, h = bh & 3;
        const int q0 = qb * 256, qw = q0 + 32 * w;
        const size_t rowbase = (size_t)b * SEQ;
        const float* cm = cum + ((size_t)b * 4 + h) * SEQ;
        const float c0 = cm[q0];
        const float kmx = sqrtf(__builtin_bit_cast(float, __hip_atomic_load(kmaxw + b * 4 + h, __ATOMIC_RELAXED, __HIP_MEMORY_SCOPE_AGENT)));
        bf16x8 qf[8]; float qn = 0.f;
        {
            const bf16_t* qp = H + (rowbase + qw + r32) * NH + HC_FQ + h * 128 + 8 * hh;
#pragma unroll
            for (int ks = 0; ks < 8; ++ks) {
                const u32x4 raw = *(const u32x4*)(qp + 16 * ks);
                u32x4 o;
#pragma unroll
                for (int j = 0; j < 4; ++j) { const float a = bf2f(raw[j] & 0xffffu), bb = bf2f(raw[j] >> 16); qn += a * a + bb * bb; o[j] = cvtpk(a * QS, bb * QS); }
                qf[ks] = __builtin_bit_cast(bf16x8, o);
            }
            qn += xor32(qn); qn = sqrtf(qn);
        }
        const float qbound = qn * kmx * QS;
        f32x16 oacc[4];
#pragma unroll
        for (int mt = 0; mt < 4; ++mt)
#pragma unroll
            for (int i = 0; i < 16; ++i) oacc[mt][i] = 0.f;
        float m_run = -1e30f, l_run = 0.f;
        const int jmax = (q0 + 255) >> 6;
        const int srow = C.tid >> 4, sch = C.tid & 15;
        u32x4 kreg[2], vreg[2]; float breg = 0.f;
#define FOX_GLOAD(j_) do { _Pragma("unroll") for (int p = 0; p < 2; ++p) { \
                const bf16_t* rp = H + (rowbase + 64 * (j_) + srow + 32 * p) * NH + h * 128 + sch * 8; \
                kreg[p] = *(const u32x4*)(rp + HC_FK); vreg[p] = *(const u32x4*)(rp + HC_FV); } \
            if (C.tid < 64) breg = (c0 - cm[64 * (j_) + C.tid]) * LOG2E; } while (0)
#define FOX_LWRITE(buf_) do { _Pragma("unroll") for (int p = 0; p < 2; ++p) { \
                *(LAS u32x4*)(lds + FOX_KB + (buf_) * 64 * FOX_KST + (srow + 32 * p) * FOX_KST + sch * 16) = kreg[p]; \
                *(LAS u32x4*)(lds + FOX_VB + (buf_) * 64 * FOX_VST + (srow + 32 * p) * FOX_VST + sch * 16) = vreg[p]; } \
            if (C.tid < 64) betaL[(buf_) * 64 + C.tid] = breg; } while (0)
        __syncthreads();
        if (C.tid < 16) flagL[C.tid] = 0;
        FOX_GLOAD(jmax); FOX_LWRITE(jmax & 1);
        bool wdone = false;
        for (int j = jmax; j >= 0; --j) {
            const int cur = j & 1;
            __syncthreads();
            if (j < jmax) { int all = 1;
#pragma unroll
                for (int i = 0; i < 8; ++i) all &= flagL[((j + 1) & 1) * 8 + i];
                if (all) break; }
            if (j > 0) FOX_GLOAD(j - 1);
            const int k0 = 64 * j;
            if (k0 <= qw + 31 && !wdone) {
                const LAS unsigned char* kb = lds + FOX_KB + cur * 64 * FOX_KST;
                const LAS unsigned char* vb = lds + FOX_VB + cur * 64 * FOX_VST;
                f32x16 sacc[2];
#pragma unroll
                for (int mt = 0; mt < 2; ++mt)
#pragma unroll
                    for (int g = 0; g < 4; ++g) { const f32x4 bv = *(const LAS f32x4*)(betaL + cur * 64 + 32 * mt + 8 * g + 4 * hh);
                        sacc[mt][4 * g] = bv[0]; sacc[mt][4 * g + 1] = bv[1]; sacc[mt][4 * g + 2] = bv[2]; sacc[mt][4 * g + 3] = bv[3]; }
#pragma unroll
                for (int ks = 0; ks < 8; ++ks)
#pragma unroll
                    for (int mt = 0; mt < 2; ++mt) {
                        const bf16x8 kf = *(const LAS bf16x8*)(kb + (32 * mt + r32) * FOX_KST + 32 * ks + 16 * hh);
                        sacc[mt] = MFMA32(kf, qf[ks], sacc[mt]);
                    }
                const int tq = qw + r32;
                if (k0 + 63 > qw) {
#pragma unroll
                    for (int mt = 0; mt < 2; ++mt)
#pragma unroll
                        for (int i = 0; i < 16; ++i) { const int key = k0 + 32 * mt + (i & 3) + 8 * (i >> 2) + 4 * hh; if (key > tq) sacc[mt][i] = -1e30f; }
                }
                float mx = sacc[0][0];
#pragma unroll
                for (int mt = 0; mt < 2; ++mt)
#pragma unroll
                    for (int i = 0; i < 16; ++i) mx = fmaxf(mx, sacc[mt][i]);
                mx = fmaxf(mx, xor32(mx));
                const float mn = fmaxf(m_run, mx), alpha = __builtin_amdgcn_exp2f(m_run - mn);
                m_run = mn;
                float ps = 0.f;
#pragma unroll
                for (int mt = 0; mt < 2; ++mt)
#pragma unroll
                    for (int i = 0; i < 16; ++i) { const float p = __builtin_amdgcn_exp2f(sacc[mt][i] - mn); sacc[mt][i] = p; ps += p; }
                l_run = l_run * alpha + ps;
#pragma unroll
                for (int mt = 0; mt < 4; ++mt)
#pragma unroll
                    for (int i = 0; i < 16; ++i) oacc[mt][i] *= alpha;
#pragma unroll
                for (int s4 = 0; s4 < 4; ++s4) {
                    const int mtk = s4 >> 1, s = s4 & 1;
                    u32x4 pb;
#pragma unroll
                    for (int e = 0; e < 4; ++e) pb[e] = cvtpk(sacc[mtk][8 * s + 2 * e], sacc[mtk][8 * s + 2 * e + 1]);
                    const bf16x8 pfrag = __builtin_bit_cast(bf16x8, pb);
                    const int i16 = lane & 15, q4 = i16 >> 2, p4 = i16 & 3, blk = (lane >> 4) & 1;
                    const int keyA = 32 * mtk + 16 * s + 4 * hh + q4;
#pragma unroll
                    for (int mt = 0; mt < 4; ++mt) {
                        const LAS unsigned char* a0 = vb + keyA * FOX_VST + (32 * mt + 16 * blk + 4 * p4) * 2;
                        const s16x4 lo = vtr(a0), hi = vtr(a0 + 8 * FOX_VST);
                        const bf16x8 vf = __builtin_shufflevector(lo, hi, 0, 1, 2, 3, 4, 5, 6, 7);
                        oacc[mt] = MFMA32(vf, pfrag, oacc[mt]);
                    }
                }
                if (j > 0) { const float bl = (c0 - cm[k0 - 1]) * LOG2E;
                    const int ok = (qbound + bl < m_run - 152.f) ? 1 : 0;
                    wdone = __all(ok); }
            }
            if (lane == 0) flagL[cur * 8 + w] = wdone ? 1 : 0;
            if (j > 0) FOX_LWRITE(cur ^ 1);
        }
        l_run += xor32(l_run);
        const float inv = 1.f / l_run;
        bf16_t* op = BR + (rowbase + qw + r32) * NBR + 1536 + h * 128;
#pragma unroll
        for (int mt = 0; mt < 4; ++mt)
#pragma unroll
            for (int g = 0; g < 4; ++g) { u32x2 o; o[0] = cvtpk(oacc[mt][4 * g] * inv, oacc[mt][4 * g + 1] * inv); o[1] = cvtpk(oacc[mt][4 * g + 2] * inv, oacc[mt][4 * g + 3] * inv);
                *(u32x2*)(op + 32 * mt + 8 * g + 4 * hh) = o; }
    }
}


constexpr int HG_LF = 0, HG_QA = 34816, HG_QB = HG_QA + 17408, HG_KD = HG_QB + 8704, HG_KO = HG_KD + 17408, HG_KT = HG_KO + 8704, HG_VN = HG_KT + 20480, HG_AM = HG_VN + 20480, HG_END = HG_AM + 12288;
constexpr int HG_LFS = 132;
static_assert(HG_END + 2048 <= 140 * 1024, "hgrn LDS");
constexpr size_t WS_DSC = WS_ST + (size_t)BATCH * 4 * 32 * 128 * 128 * 4;

template <bool FULL>
__device__ __forceinline__ void hgrn_unit(const Ctx& C, int l, int u) {
#if DIAG == 1
    const bf16_t* H = (const bf16_t*)(C.ws + WS_H); bf16_t* BR = (l == 0) ? (bf16_t*)(C.ws + WS_XA) : (bf16_t*)(C.ws + WS_TABU);
#else
    const bf16_t* H = (const bf16_t*)(C.ws + WS_H); bf16_t* BR = (bf16_t*)(C.ws + WS_BR);
#endif
    float* STB = (float*)(C.ws + WS_ST); float* DSC = (float*)(C.ws + WS_DSC);
    LAS unsigned char* lds = C.lds;
    LAS float* LF = (LAS float*)(lds + HG_LF);
    const int lane = C.lane, w = C.wave, r32 = lane & 31, hh = lane >> 5;
    const int sc = u & 31, bh = u >> 5, b = bh >> 2, h = bh & 3;
    const int wk = w >> 1, wv = w & 1;
    const int mt = w >> 2, nt = w & 3;
    const int i16 = lane & 15, q4 = i16 >> 2, p4 = i16 & 3, blk = (lane >> 4) & 1;
    f32x16 S0, S1;
    float* stp = STB + ((size_t)bh * 32 + sc) * 128 * 128;
    if constexpr (FULL) {
#pragma unroll
        for (int i = 0; i < 16; ++i) { const int k = 32 * wk + (i & 3) + 8 * (i >> 2) + 4 * hh;
            S0[i] = stp[k * 128 + 64 * wv + r32]; S1[i] = stp[k * 128 + 64 * wv + 32 + r32]; }
    } else {
#pragma unroll
        for (int i = 0; i < 16; ++i) { S0[i] = 0.f; S1[i] = 0.f; }
    }
    float dtot = 0.f;
    const int ps = C.tid >> 3, pseg = C.tid & 7;
    float lbv[16];
#pragma unroll
    for (int j = 0; j < 16; ++j) { lbv[j] = 0.f;
        if (l == 1) { const int ch = h * 128 + 16 * pseg + j; lbv[j] = 1.f / (1.f + __expf(C.in[I_LBL][ch] - C.in[I_LBL][BW + ch])); } }
    for (int c = 0; c < 4; ++c) {
        const size_t row0 = (size_t)b * SEQ + sc * 256 + c * 64;
        const bf16_t* hp = H + (row0 + ps) * NH + h * 128 + 16 * pseg;
        float kkv[16], qsv[16];
        u32x4 vraw0, vraw1;
        {
            const u32x4 f0 = *(const u32x4*)(hp + HC_HF), f1 = *(const u32x4*)(hp + HC_HF + 8);
            vraw0 = *(const u32x4*)(hp + HC_HI); vraw1 = *(const u32x4*)(hp + HC_HI + 8);
#pragma unroll
            for (int j = 0; j < 8; ++j) { const unsigned r = (j < 4) ? f0[j] : f1[j - 4];
                const float z0 = bf2f(r & 0xffffu), z1 = bf2f(r >> 16);
                kkv[2 * j] = (1.f - lbv[2 * j]) * sigmoidf_(-z0); kkv[2 * j + 1] = (1.f - lbv[2 * j + 1]) * sigmoidf_(-z1); }
            if constexpr (FULL) {
                const u32x4 q0 = *(const u32x4*)(hp + HC_HQ), q1 = *(const u32x4*)(hp + HC_HQ + 8);
#pragma unroll
                for (int j = 0; j < 8; ++j) { const unsigned r = (j < 4) ? q0[j] : q1[j - 4]; qsv[2 * j] = siluf_(bf2f(r & 0xffffu)); qsv[2 * j + 1] = siluf_(bf2f(r >> 16)); }
            }
#pragma unroll
            for (int j4 = 0; j4 < 4; ++j4) { f32x4 o;
#pragma unroll
                for (int e = 0; e < 4; ++e) o[e] = __logf(1.f - kkv[4 * j4 + e]);
                *(LAS f32x4*)(LF + ps * HG_LFS + 16 * pseg + 4 * j4) = o; }
        }
        __syncthreads();
        {
            const int sk = C.tid & 127, sg = C.tid >> 7;
            float vals[16];
#pragma unroll
            for (int i = 0; i < 16; ++i) vals[i] = LF[(16 * sg + i) * HG_LFS + sk];
#pragma unroll
            for (int i = 1; i < 16; ++i) vals[i] += vals[i - 1];
            LAS float* TOT = (LAS float*)(lds + HG_END);
            TOT[sg * 128 + sk] = vals[15];
            __syncthreads();
            float off = 0.f;
#pragma unroll
            for (int j = 0; j < 3; ++j) if (j < sg) off += TOT[j * 128 + sk];
#pragma unroll
            for (int i = 0; i < 16; ++i) LF[(16 * sg + i) * HG_LFS + sk] = vals[i] + off;
            if (sg == 3) dtot += vals[15] + off;
        }
        __syncthreads();
        float bv[16], b31[16], bl[16];
#pragma unroll
        for (int j4 = 0; j4 < 4; ++j4) { const f32x4 x = *(const LAS f32x4*)(LF + ps * HG_LFS + 16 * pseg + 4 * j4), y = *(const LAS f32x4*)(LF + 31 * HG_LFS + 16 * pseg + 4 * j4), z = *(const LAS f32x4*)(LF + 63 * HG_LFS + 16 * pseg + 4 * j4);
#pragma unroll
            for (int e = 0; e < 4; ++e) { bv[4 * j4 + e] = x[e]; b31[4 * j4 + e] = y[e]; bl[4 * j4 + e] = z[e]; } }
        {
            u32x4 o0, o1;
#pragma unroll
            for (int j = 0; j < 4; ++j) { o0[j] = cvtpk(kkv[2 * j] * __expf(bl[2 * j] - bv[2 * j]), kkv[2 * j + 1] * __expf(bl[2 * j + 1] - bv[2 * j + 1]));
                o1[j] = cvtpk(kkv[8 + 2 * j] * __expf(bl[8 + 2 * j] - bv[8 + 2 * j]), kkv[9 + 2 * j] * __expf(bl[9 + 2 * j] - bv[9 + 2 * j])); }
            *(LAS u32x4*)(lds + HG_KT + ps * 320 + 32 * pseg) = o0; *(LAS u32x4*)(lds + HG_KT + ps * 320 + 32 * pseg + 16) = o1;
            *(LAS u32x4*)(lds + HG_VN + ps * 320 + 32 * pseg) = vraw0; *(LAS u32x4*)(lds + HG_VN + ps * 320 + 32 * pseg + 16) = vraw1;
            if constexpr (FULL) {
                const bool hi = ps >= 32;
                float rr[16];
#pragma unroll
                for (int j = 0; j < 16; ++j) rr[j] = hi ? b31[j] : 0.f;
#pragma unroll
                for (int j = 0; j < 4; ++j) { o0[j] = cvtpk(qsv[2 * j] * __expf(bv[2 * j] - rr[2 * j]), qsv[2 * j + 1] * __expf(bv[2 * j + 1] - rr[2 * j + 1]));
                    o1[j] = cvtpk(qsv[8 + 2 * j] * __expf(bv[8 + 2 * j] - rr[8 + 2 * j]), qsv[9 + 2 * j] * __expf(bv[9 + 2 * j] - rr[9 + 2 * j])); }
                *(LAS u32x4*)(lds + HG_QA + ps * 272 + 32 * pseg) = o0; *(LAS u32x4*)(lds + HG_QA + ps * 272 + 32 * pseg + 16) = o1;
#pragma unroll
                for (int j = 0; j < 4; ++j) { o0[j] = cvtpk(kkv[2 * j] * __expf(rr[2 * j] - bv[2 * j]), kkv[2 * j + 1] * __expf(rr[2 * j + 1] - bv[2 * j + 1]));
                    o1[j] = cvtpk(kkv[8 + 2 * j] * __expf(rr[8 + 2 * j] - bv[8 + 2 * j]), kkv[9 + 2 * j] * __expf(rr[9 + 2 * j] - bv[9 + 2 * j])); }
                *(LAS u32x4*)(lds + HG_KD + ps * 272 + 32 * pseg) = o0; *(LAS u32x4*)(lds + HG_KD + ps * 272 + 32 * pseg + 16) = o1;
                if (hi) {
#pragma unroll
                    for (int j = 0; j < 4; ++j) { o0[j] = cvtpk(qsv[2 * j] * __expf(bv[2 * j]), qsv[2 * j + 1] * __expf(bv[2 * j + 1]));
                        o1[j] = cvtpk(qsv[8 + 2 * j] * __expf(bv[8 + 2 * j]), qsv[9 + 2 * j] * __expf(bv[9 + 2 * j])); }
                    *(LAS u32x4*)(lds + HG_QB + (ps - 32) * 272 + 32 * pseg) = o0; *(LAS u32x4*)(lds + HG_QB + (ps - 32) * 272 + 32 * pseg + 16) = o1;
                } else {
#pragma unroll
                    for (int j = 0; j < 4; ++j) { o0[j] = cvtpk(kkv[2 * j] * __expf(b31[2 * j] - bv[2 * j]), kkv[2 * j + 1] * __expf(b31[2 * j + 1] - bv[2 * j + 1]));
                        o1[j] = cvtpk(kkv[8 + 2 * j] * __expf(b31[8 + 2 * j] - bv[8 + 2 * j]), kkv[9 + 2 * j] * __expf(b31[9 + 2 * j] - bv[9 + 2 * j])); }
                    *(LAS u32x4*)(lds + HG_KO + ps * 272 + 32 * pseg) = o0; *(LAS u32x4*)(lds + HG_KO + ps * 272 + 32 * pseg + 16) = o1;
                }
            }
        }
        float dk[16];
#pragma unroll
        for (int i = 0; i < 16; ++i) dk[i] = __expf(LF[63 * HG_LFS + 32 * wk + (i & 3) + 8 * (i >> 2) + 4 * hh]);
        __syncthreads();
        if constexpr (FULL) {
#pragma unroll
            for (int g = 0; g < 4; ++g) {
                u32x2 o; o[0] = cvtpk(S0[4 * g], S0[4 * g + 1]); o[1] = cvtpk(S0[4 * g + 2], S0[4 * g + 3]);
                *(LAS u32x2*)(lds + HG_LF + (64 * wv + r32) * 272 + (32 * wk + 8 * g + 4 * hh) * 2) = o;
                o[0] = cvtpk(S1[4 * g], S1[4 * g + 1]); o[1] = cvtpk(S1[4 * g + 2], S1[4 * g + 3]);
                *(LAS u32x2*)(lds + HG_LF + (64 * wv + 32 + r32) * 272 + (32 * wk + 8 * g + 4 * hh) * 2) = o;
            }
#define HG_ATILE(AMT_, AST_) do { \
                const LAS unsigned char* kb = ((AMT_) == (AST_)) ? (lds + HG_KD + (32 * (AST_)) * 272) : (lds + HG_KO); \
                f32x16 a; \
                _Pragma("unroll") for (int i = 0; i < 16; ++i) a[i] = 0.f; \
                _Pragma("unroll") for (int ks = 0; ks < 8; ++ks) { \
                    const bf16x8 af = *(const LAS bf16x8*)(lds + HG_QA + (32 * (AMT_) + r32) * 272 + 32 * ks + 16 * hh); \
                    const bf16x8 bf = *(const LAS bf16x8*)(kb + r32 * 272 + 32 * ks + 16 * hh); \
                    a = MFMA32(af, bf, a); } \
                _Pragma("unroll") for (int g = 0; g < 4; ++g) { \
                    float x[4]; \
                    _Pragma("unroll") for (int e = 0; e < 4; ++e) { const int tl = 8 * g + 4 * hh + e; x[e] = ((AMT_) != (AST_) || r32 <= tl) ? a[4 * g + e] : 0.f; } \
                    u32x2 o; o[0] = cvtpk(x[0], x[1]); o[1] = cvtpk(x[2], x[3]); \
                    *(LAS u32x2*)(lds + HG_AM + (32 * (AST_) + r32) * 192 + (32 * (AMT_) + 8 * g + 4 * hh) * 2) = o; } } while (0)
            if (w == 0) { HG_ATILE(0, 0); }
            else if (w == 1) { HG_ATILE(1, 0); }
            else if (w == 2) { HG_ATILE(1, 1); }
        }
#pragma unroll
        for (int i = 0; i < 16; ++i) { S0[i] *= dk[i]; S1[i] *= dk[i]; }
#pragma unroll
        for (int ks = 0; ks < 4; ++ks) {
            const LAS unsigned char* ka = lds + HG_KT + (16 * ks + 8 * hh + q4) * 320 + (32 * wk + 16 * blk + 4 * p4) * 2;
            const s16x4 alo = vtr(ka), ahi = vtr(ka + 4 * 320);
            const bf16x8 af = __builtin_shufflevector(alo, ahi, 0, 1, 2, 3, 4, 5, 6, 7);
            const LAS unsigned char* vb0 = lds + HG_VN + (16 * ks + 8 * hh + q4) * 320 + (64 * wv + 16 * blk + 4 * p4) * 2;
            const s16x4 b0lo = vtr(vb0), b0hi = vtr(vb0 + 4 * 320), b1lo = vtr(vb0 + 64), b1hi = vtr(vb0 + 64 + 4 * 320);
            S0 = MFMA32(af, __builtin_shufflevector(b0lo, b0hi, 0, 1, 2, 3, 4, 5, 6, 7), S0);
            S1 = MFMA32(af, __builtin_shufflevector(b1lo, b1hi, 0, 1, 2, 3, 4, 5, 6, 7), S1);
        }
        if constexpr (FULL) {
            __syncthreads();
            f32x16 o;
#pragma unroll
            for (int i = 0; i < 16; ++i) o[i] = 0.f;
            const LAS unsigned char* qb = (mt == 0) ? (lds + HG_QA) : (lds + HG_QB);
#pragma unroll
            for (int ks = 0; ks < 8; ++ks) {
                const bf16x8 af = *(const LAS bf16x8*)(qb + r32 * 272 + 32 * ks + 16 * hh);
                const bf16x8 bf = *(const LAS bf16x8*)(lds + HG_LF + (32 * nt + r32) * 272 + 32 * ks + 16 * hh);
                o = MFMA32(af, bf, o);
            }
#pragma unroll
            for (int ks = 0; ks < 4; ++ks) {
                if (mt == 0 && ks >= 2) continue;
                const LAS unsigned char* aa = lds + HG_AM + (16 * ks + 8 * hh + q4) * 192 + (32 * mt + 16 * blk + 4 * p4) * 2;
                const s16x4 alo = vtr(aa), ahi = vtr(aa + 4 * 192);
                const LAS unsigned char* vb0 = lds + HG_VN + (16 * ks + 8 * hh + q4) * 320 + (32 * nt + 16 * blk + 4 * p4) * 2;
                const s16x4 blo = vtr(vb0), bhi = vtr(vb0 + 4 * 320);
                o = MFMA32(__builtin_shufflevector(alo, ahi, 0, 1, 2, 3, 4, 5, 6, 7), __builtin_shufflevector(blo, bhi, 0, 1, 2, 3, 4, 5, 6, 7), o);
            }
            __syncthreads();
#pragma unroll
            for (int i = 0; i < 16; ++i) LF[(32 * mt + (i & 3) + 8 * (i >> 2) + 4 * hh) * HG_LFS + 32 * nt + r32] = o[i];
            __syncthreads();
            {
                float ov[16]; float ss = 0.f;
#pragma unroll
                for (int j4 = 0; j4 < 4; ++j4) { const f32x4 x = *(const LAS f32x4*)(LF + ps * HG_LFS + 16 * pseg + 4 * j4);
#pragma unroll
                    for (int e = 0; e < 4; ++e) { ov[4 * j4 + e] = x[e]; ss += x[e] * x[e]; } }
                ss += __shfl_xor(ss, 1, 64); ss += __shfl_xor(ss, 2, 64); ss += __shfl_xor(ss, 4, 64);
                const float rn = rsqrtf(ss * (1.f / 128.f) + RMS_EPS);
                const u32x4 g0 = *(const u32x4*)(hp + HC_HG), g1 = *(const u32x4*)(hp + HC_HG + 8);
                const float* ng = C.in[I_HNG] + l * 128 + 16 * pseg;
                u32x4 o0, o1;
#pragma unroll
                for (int j = 0; j < 4; ++j) {
                    o0[j] = cvtpk(ov[2 * j] * rn * ng[2 * j] * siluf_(bf2f(g0[j] & 0xffffu)), ov[2 * j + 1] * rn * ng[2 * j + 1] * siluf_(bf2f(g0[j] >> 16)));
                    o1[j] = cvtpk(ov[8 + 2 * j] * rn * ng[8 + 2 * j] * siluf_(bf2f(g1[j] & 0xffffu)), ov[9 + 2 * j] * rn * ng[9 + 2 * j] * siluf_(bf2f(g1[j] >> 16)));
                }
                bf16_t* bp = BR + (row0 + ps) * NBR + 512 + h * 128 + 16 * pseg;
                *(u32x4*)bp = o0; *(u32x4*)(bp + 8) = o1;
            }
        }
        __syncthreads();
    }
    if constexpr (!FULL) {
#pragma unroll
        for (int i = 0; i < 16; ++i) { const int k = 32 * wk + (i & 3) + 8 * (i >> 2) + 4 * hh;
            stp[k * 128 + 64 * wv + r32] = S0[i]; stp[k * 128 + 64 * wv + 32 + r32] = S1[i]; }
        if (C.tid >= 384) DSC[((size_t)bh * 32 + sc) * 128 + (C.tid & 127)] = __expf(dtot);
    }
}
__device__ __forceinline__ void hgrn_b1(const Ctx& C, int l) { for (int u = C.bid; u < BATCH * 4 * 32; u += C.G) hgrn_unit<false>(C, l, u); }
__device__ __forceinline__ void hgrn_b3(const Ctx& C, int l) { for (int u = C.bid; u < BATCH * 4 * 32; u += C.G) hgrn_unit<true>(C, l, u); }
__device__ __forceinline__ void hgrn_b2(const Ctx& C) {
    float* STB = (float*)(C.ws + WS_ST); const float* DSC = (const float*)(C.ws + WS_DSC);
    for (int e = C.bid * 512 + C.tid; e < BATCH * 4 * 128 * 128; e += C.G * 512) {
        const int bh = e >> 14, kv = e & 16383, k = kv >> 7;
        float* p = STB + (size_t)bh * 32 * 16384 + kv;
        float uu[32], dd[32];
#pragma unroll
        for (int s = 0; s < 32; ++s) { uu[s] = p[(size_t)s * 16384]; dd[s] = DSC[((size_t)bh * 32 + s) * 128 + k]; }
        float st = 0.f;
#pragma unroll
        for (int s = 0; s < 32; ++s) { p[(size_t)s * 16384] = st; st = dd[s] * st + uu[s]; }
    }
}


__device__ __forceinline__ void mix_pool(const Ctx& C, int l) {
#if DIAG == 2
    const bf16_t* H = (const bf16_t*)(C.ws + WS_H); bf16_t* BR = (l == 0) ? (bf16_t*)(C.ws + WS_XA) : (bf16_t*)(C.ws + WS_TABU);
#else
    const bf16_t* H = (const bf16_t*)(C.ws + WS_H); bf16_t* BR = (bf16_t*)(C.ws + WS_BR);
#endif
    const bf16_t* Wt = (const bf16_t*)(C.ws + WS_W + (size_t)l * W_LAYER + WO_POOLW);
    LAS unsigned char* lds = C.lds;
    const int lane = C.lane, w = C.wave, r32 = lane & 31, hh = lane >> 5;
    for (int u = C.bid; u < (T / 256) * 4; u += C.G) {
        const int g = u & 3, t0 = (u >> 2) * 256, win = 2 << g;
        const int row = t0 + 32 * w + r32, pos = row & (SEQ - 1);
        __syncthreads();
#pragma unroll
        for (int p = 0; p < 4; ++p) { const int idx = C.tid + 512 * p, rr = idx >> 4, ch = idx & 15;
            *(LAS u32x4*)(lds + rr * 272 + ch * 16) = *(const u32x4*)(Wt + (size_t)g * 128 * 128 + rr * 128 + ch * 8); }
        const int nwin = (pos + 1 < win) ? pos + 1 : win;
        const float invn = 1.f / (float)nwin;
        bf16x8 df[8];
        const bf16_t* pp = H + (size_t)row * NH + HC_P + g * 128 + 8 * hh;
#pragma unroll
        for (int ks = 0; ks < 8; ++ks) {
            float sum[8];
#pragma unroll
            for (int e = 0; e < 8; ++e) sum[e] = 0.f;
            u32x4 rw[16];
#pragma unroll
            for (int j = 0; j < 16; ++j) { const int jj = (j < nwin) ? j : 0; rw[j] = *(const u32x4*)(pp + 16 * ks - (size_t)jj * NH); }
            const u32x4 self = rw[0];
#pragma unroll
            for (int j = 0; j < 16; ++j) { const float msk = (j < nwin) ? 1.f : 0.f;
#pragma unroll
                for (int e = 0; e < 4; ++e) { sum[2 * e] += msk * bf2f(rw[j][e] & 0xffffu); sum[2 * e + 1] += msk * bf2f(rw[j][e] >> 16); } }
            u32x4 o;
#pragma unroll
            for (int e = 0; e < 4; ++e) o[e] = cvtpk(sum[2 * e] * invn - bf2f(self[e] & 0xffffu), sum[2 * e + 1] * invn - bf2f(self[e] >> 16));
            df[ks] = __builtin_bit_cast(bf16x8, o);
        }
        __syncthreads();
        f32x16 acc[4];
#pragma unroll
        for (int mt = 0; mt < 4; ++mt)
#pragma unroll
            for (int i = 0; i < 16; ++i) acc[mt][i] = 0.f;
#pragma unroll
        for (int ks = 0; ks < 8; ++ks)
#pragma unroll
            for (int mt = 0; mt < 4; ++mt) {
                const bf16x8 wf = *(const LAS bf16x8*)(lds + (32 * mt + r32) * 272 + 32 * ks + 16 * hh);
                acc[mt] = MFMA32(wf, df[ks], acc[mt]);
            }
        const float* psc = C.in[I_POOLS] + l * BW + g * 128;
        bf16_t* op = BR + (size_t)row * NBR + g * 128;
#pragma unroll
        for (int mt = 0; mt < 4; ++mt)
#pragma unroll
            for (int q = 0; q < 4; ++q) { const int d0 = 32 * mt + 8 * q + 4 * hh; const f32x4 sc = *(const f32x4*)(psc + d0);
                u32x2 o; o[0] = cvtpk(acc[mt][4 * q] * sc[0], acc[mt][4 * q + 1] * sc[1]); o[1] = cvtpk(acc[mt][4 * q + 2] * sc[2], acc[mt][4 * q + 3] * sc[3]);
                *(u32x2*)(op + d0) = o; }
    }
}
constexpr int GM_VN = 0, GM_WC = 128 * 320, GM_END = GM_WC + 128 * 272;
__device__ __forceinline__ void mix_gmlp(const Ctx& C, int l) {
#if DIAG == 3
    const bf16_t* H = (const bf16_t*)(C.ws + WS_H); bf16_t* BR = (l == 0) ? (bf16_t*)(C.ws + WS_XA) : (bf16_t*)(C.ws + WS_TABU);
#else
    const bf16_t* H = (const bf16_t*)(C.ws + WS_H); bf16_t* BR = (bf16_t*)(C.ws + WS_BR);
#endif
    const bf16_t* Wc = (const bf16_t*)(C.ws + WS_W + (size_t)l * W_LAYER + WO_GWS);
    LAS unsigned char* lds = C.lds;
    const int lane = C.lane, w = C.wave, r32 = lane & 31, hh = lane >> 5;
    const int i16 = lane & 15, q4 = i16 >> 2, p4 = i16 & 3, blk = (lane >> 4) & 1;
    for (int u = C.bid; u < (T / 128) * 4; u += C.G) {
        const int g = u & 3, t0 = (u >> 2) * 128;
        __syncthreads();
#pragma unroll
        for (int p = 0; p < 4; ++p) { const int idx = C.tid + 512 * p, rr = idx >> 4, ch = idx & 15;
            *(LAS u32x4*)(lds + GM_WC + rr * 272 + ch * 16) = *(const u32x4*)(Wc + (size_t)g * 128 * 128 + rr * 128 + ch * 8); }
#pragma unroll
        for (int hb = 0; hb < 4; ++hb) {
            u32x4 rawv[4];
#pragma unroll
            for (int i = 0; i < 4; ++i) rawv[i] = *(const u32x4*)(H + (size_t)(t0 + w * 16 + hb * 4 + i) * NH + HC_GV + lane * 8);
            float e[4][8], st[8];
#pragma unroll
            for (int i = 0; i < 4; ++i) { float s1 = 0.f, s2 = 0.f;
#pragma unroll
                for (int j = 0; j < 4; ++j) { const float a = geluf_(bf2f(rawv[i][j] & 0xffffu)), b = geluf_(bf2f(rawv[i][j] >> 16)); e[i][2 * j] = a; e[i][2 * j + 1] = b; s1 += a + b; s2 += a * a + b * b; }
                st[i] = s1; st[4 + i] = s2; }
#pragma unroll
            for (int sx = 32, n = 4; sx >= 8; sx >>= 1, n >>= 1) { const bool up = (lane & sx) != 0;
#pragma unroll
                for (int i = 0; i < n; ++i) { const float send = up ? st[i] : st[i + n], keep = up ? st[i + n] : st[i]; st[i] = keep + __shfl_xor(send, sx, 64); } }
            float tot = st[0]; tot += __shfl_xor(tot, 4, 64); tot += __shfl_xor(tot, 2, 64); tot += __shfl_xor(tot, 1, 64);
            float mean4[4], rstd4[4];
#pragma unroll
            for (int i = 0; i < 4; ++i) {
                mean4[i] = __builtin_bit_cast(float, __builtin_amdgcn_readlane(__builtin_bit_cast(int, tot), 8 * i)) * (1.f / BW);
                const float ex2 = __builtin_bit_cast(float, __builtin_amdgcn_readlane(__builtin_bit_cast(int, tot), 8 * (4 + i))) * (1.f / BW);
                rstd4[i] = rsqrtf(fmaxf(ex2 - mean4[i] * mean4[i], 0.f) + LN_EPS);
            }
            asm volatile("" ::: "memory");
            if ((lane >> 4) == g) {
                const float* lg = C.in[I_GLNG] + l * BW + lane * 8; const float* lb = C.in[I_GLNB] + l * BW + lane * 8;
#pragma unroll
                for (int i = 0; i < 4; ++i) {
                    const float mean = mean4[i], rstd = rstd4[i];
                    u32x4 o;
#pragma unroll
                    for (int j = 0; j < 4; ++j) o[j] = cvtpk((e[i][2 * j] - mean) * rstd * lg[2 * j] + lb[2 * j], (e[i][2 * j + 1] - mean) * rstd * lg[2 * j + 1] + lb[2 * j + 1]);
                    *(LAS u32x4*)(lds + GM_VN + (w * 16 + hb * 4 + i) * 320 + (lane & 15) * 16) = o;
                }
            }
        }
        __syncthreads();
        const int nt = w & 3, mb = (w >> 2) * 2;
        f32x16 acc[2];
#pragma unroll
        for (int m = 0; m < 2; ++m)
#pragma unroll
            for (int i = 0; i < 16; ++i) acc[m][i] = 0.f;
        for (int ks = 0; ks < 2 * (nt + 1); ++ks) {
            const bf16x8 bf = *(const LAS bf16x8*)(lds + GM_WC + (32 * nt + r32) * 272 + 32 * ks + 16 * hh);
#pragma unroll
            for (int m = 0; m < 2; ++m) {
                const LAS unsigned char* aa = lds + GM_VN + (16 * ks + 8 * hh + q4) * 320 + (32 * (mb + m) + 16 * blk + 4 * p4) * 2;
                const s16x4 lo = vtr(aa), hi = vtr(aa + 4 * 320);
                acc[m] = MFMA32(__builtin_shufflevector(lo, hi, 0, 1, 2, 3, 4, 5, 6, 7), bf, acc[m]);
            }
        }
        const int tl = 32 * nt + r32, row = t0 + tl;
        const float bias = C.in[I_GBS][(l * 4 + g) * 128 + tl];
#pragma unroll
        for (int m = 0; m < 2; ++m)
#pragma unroll
            for (int q = 0; q < 4; ++q) { const int c0 = 32 * (mb + m) + 8 * q + 4 * hh;
                const u32x2 ur = *(const u32x2*)(H + (size_t)row * NH + HC_GU + g * 128 + c0);
                u32x2 o;
                o[0] = cvtpk(geluf_(bf2f(ur[0] & 0xffffu)) * (acc[m][4 * q] + bias), geluf_(bf2f(ur[0] >> 16)) * (acc[m][4 * q + 1] + bias));
                o[1] = cvtpk(geluf_(bf2f(ur[1] & 0xffffu)) * (acc[m][4 * q + 2] + bias), geluf_(bf2f(ur[1] >> 16)) * (acc[m][4 * q + 3] + bias));
                *(u32x2*)(BR + (size_t)row * NBR + 1024 + g * 128 + c0) = o; }
    }
}

#define CE_D(a, b) do { const float _h = fmaxf(a, b), _l = fminf(a, b); a = _h; b = _l; } while (0)
__device__ __forceinline__ void sort16_desc(float (&x)[16]) {
#pragma unroll
    for (int k = 2; k <= 16; k <<= 1)
#pragma unroll
        for (int j = k >> 1; j > 0; j >>= 1)
#pragma unroll
            for (int i = 0; i < 16; ++i) { const int l = i ^ j; if (l > i) { if ((i & k) == 0) CE_D(x[i], x[l]); else CE_D(x[l], x[i]); } }
}
__device__ __forceinline__ void bmerge16_desc(float (&x)[16]) {
#pragma unroll
    for (int j = 8; j > 0; j >>= 1)
#pragma unroll
        for (int i = 0; i < 16; ++i) { const int l = i ^ j; if (l > i) CE_D(x[i], x[l]); }
}
__device__ __forceinline__ void top16_merge(float (&a)[16], const float (&b)[16]) {
#pragma unroll
    for (int i = 0; i < 16; ++i) a[i] = fmaxf(a[i], b[15 - i]);
    bmerge16_desc(a);
}
__device__ __forceinline__ float pack_idx(float v, unsigned idx, unsigned mask) { return __builtin_bit_cast(float, (__builtin_bit_cast(unsigned, v) & ~mask) | idx); }

constexpr int TK_KST = 272, TK_KBUF = 128 * TK_KST;
__device__ __forceinline__ void p_topk(const Ctx& C, int l) {
    const bf16_t* Q = (const bf16_t*)(C.ws + WS_Q);
    const bf16_t* keys = (const bf16_t*)(C.ws + WS_W + (size_t)l * W_LAYER + WO_KEYS);
    int* eidx = (int*)(C.ws + WS_EIDX); float* egate = (float*)(C.ws + WS_EGATE);
    LAS unsigned char* lds = C.lds;
    const int lane = C.lane, w = C.wave, r32 = lane & 31, hh = lane >> 5;
    for (int u = C.bid; u < (T / 256) * PH; u += C.G) {
        const int h = u & 7, t0 = (u >> 3) * 256, tok = t0 + 32 * w + r32;
        float v12[2][16];
        __syncthreads();
#pragma unroll
        for (int j = 0; j < 2; ++j) {
            const bf16_t* kp = keys + ((size_t)j * PH + h) * 128 * 128;
#pragma unroll
            for (int p = 0; p < 4; ++p) { const int idx = C.tid + 512 * p, row = idx >> 4, ch = idx & 15;
                *(LAS u32x4*)(lds + j * TK_KBUF + row * TK_KST + ch * 16) = *(const u32x4*)(kp + row * 128 + ch * 8); }
        }
        __syncthreads();
#pragma unroll
        for (int j = 0; j < 2; ++j) {
            bf16x8 qf[8];
            {
                LAS unsigned char* qs = lds + 2 * TK_KBUF + w * (32 * 272);
                u32x4 qr[8];
#pragma unroll
                for (int p = 0; p < 8; ++p) qr[p] = *(const u32x4*)(Q + (size_t)(t0 + 32 * w + 4 * p + (lane >> 4)) * NQ + h * 256 + j * 128 + (lane & 15) * 8);
#pragma unroll
                for (int p = 0; p < 8; ++p) *(LAS u32x4*)(qs + (4 * p + (lane >> 4)) * 272 + (lane & 15) * 16) = qr[p];
#pragma unroll
                for (int ks = 0; ks < 8; ++ks) qf[ks] = *(const LAS bf16x8*)(qs + r32 * 272 + 32 * ks + 16 * hh);
            }
            f32x16 sacc[4];
#pragma unroll
            for (int mt = 0; mt < 4; ++mt)
#pragma unroll
                for (int i = 0; i < 16; ++i) sacc[mt][i] = 0.f;
#pragma unroll
            for (int ks = 0; ks < 8; ++ks)
#pragma unroll
                for (int mt = 0; mt < 4; ++mt) {
                    const bf16x8 kf = *(const LAS bf16x8*)(lds + j * TK_KBUF + (32 * mt + r32) * TK_KST + 32 * ks + 16 * hh);
                    sacc[mt] = MFMA32(kf, qf[ks], sacc[mt]);
                }
            float g[4][16];
#pragma unroll
            for (int mt = 0; mt < 4; ++mt) {
#pragma unroll
                for (int i = 0; i < 16; ++i) g[mt][i] = pack_idx(sacc[mt][i], (unsigned)(32 * mt + (i & 3) + 8 * (i >> 2) + 4 * hh), 127u);
                sort16_desc(g[mt]);
            }
            top16_merge(g[0], g[1]); top16_merge(g[2], g[3]); top16_merge(g[0], g[2]);
            float o[16];
#pragma unroll
            for (int i = 0; i < 16; ++i) o[i] = __shfl_xor(g[0][i], 32, 64);
            top16_merge(g[0], o);
#pragma unroll
            for (int i = 0; i < 16; ++i) v12[j][i] = g[0][i];
        }
        float c[4][16];
        {
            int n = 0;
#pragma unroll
            for (int a = 0; a < 16; ++a)
#pragma unroll
                for (int b = 0; b < 16; ++b) if ((a + 1) * (b + 1) <= 16) {
                    const unsigned id = ((__builtin_bit_cast(unsigned, v12[0][a]) & 127u) << 7) | (__builtin_bit_cast(unsigned, v12[1][b]) & 127u);
                    c[n >> 4][n & 15] = pack_idx(v12[0][a] + v12[1][b], id, 16383u); ++n; }
#pragma unroll
            for (; n < 64; ++n) c[n >> 4][n & 15] = -3.0e38f;
        }
#pragma unroll
        for (int q = 0; q < 4; ++q) sort16_desc(c[q]);
        top16_merge(c[0], c[1]); top16_merge(c[2], c[3]); top16_merge(c[0], c[2]);
        float e[16], den = 0.f;
#pragma unroll
        for (int i = 0; i < 16; ++i) { e[i] = __expf(c[0][i] - c[0][0]); den += e[i]; }
        const float inv = 1.f / den;
        int* ip = eidx + (size_t)tok * 128 + h * 16 + 8 * hh; float* gp = egate + (size_t)tok * 128 + h * 16 + 8 * hh;
        u32x4 i0, i1; f32x4 g0, g1;
#pragma unroll
        for (int i = 0; i < 4; ++i) {
            const float ca = hh ? c[0][8 + i] : c[0][i], cb = hh ? c[0][12 + i] : c[0][4 + i];
            i0[i] = __builtin_bit_cast(unsigned, ca) & 16383u; i1[i] = __builtin_bit_cast(unsigned, cb) & 16383u;
            g0[i] = (hh ? e[8 + i] : e[i]) * inv; g1[i] = (hh ? e[12 + i] : e[4 + i]) * inv;
        }
        *(u32x4*)ip = i0; *(u32x4*)(ip + 4) = i1; *(f32x4*)gp = g0; *(f32x4*)(gp + 4) = g1;
    }
}

constexpr int CW_DIAG = 64;
__device__ __forceinline__ void diag_cmp(const Ctx& C, const bf16_t* A, int lda, const bf16_t* R, int ldr, int nc) {
    float sd = 0.f, sr = 0.f;
    for (int row = C.bid; row < T; row += C.G) {
        const int tm = row % DIAG_MOD; if (tm < DIAG_LO || tm >= DIAG_HI) continue;
        for (int c = C.tid; c < nc; c += 512) { const float a = bf2f(A[(size_t)row * lda + c]), r = bf2f(R[(size_t)row * ldr + c]); sd += (a - r) * (a - r); sr += r * r; }
    }
    sd = wave_sum(sd); sr = wave_sum(sr);
    if (C.lane == 0) { atomicAdd((float*)(C.ws + WS_CTL) + CW_DIAG, sd); atomicAdd((float*)(C.ws + WS_CTL) + CW_DIAG + 1, sr); }
}
__device__ __forceinline__ float diag_alpha(const Ctx& C) {
    const float sd = __hip_atomic_load((float*)(C.ws + WS_CTL) + CW_DIAG, __ATOMIC_RELAXED, __HIP_MEMORY_SCOPE_AGENT), sr = __hip_atomic_load((float*)(C.ws + WS_CTL) + CW_DIAG + 1, __ATOMIC_RELAXED, __HIP_MEMORY_SCOPE_AGENT);
    const float err = fmaxf(sd / fmaxf(sr, 1e-30f), 1e-8f);
    return 0.1f + 0.1f * (rintf(log10f(err / 1e-8f) * 10.f) * 0.1f);
}

__device__ __forceinline__ void wave_argmax(float& v, int& i) {
#pragma unroll
    for (int o = 32; o > 0; o >>= 1) {
        const float ov = __shfl_xor(v, o, 64); const int oi = __shfl_xor(i, o, 64);
        if (ov > v || (ov == v && oi < i)) { v = ov; i = oi; }
    }
}
__device__ __forceinline__ void p_topk_naive(const Ctx& C, int l) {
    const bf16_t* Q = (const bf16_t*)(C.ws + WS_Q);
    const bf16_t* keys = (const bf16_t*)(C.ws + WS_W + (size_t)l * W_LAYER + WO_KEYS);
    int* eidx = (int*)(C.ws + WS_EIDX); float* egate = (float*)(C.ws + WS_EGATE);
    LAS float* qs = (LAS float*)C.lds;
    LAS float* sc = qs + 2048;
    LAS float* tv = sc + 2048;
    LAS int* ti = (LAS int*)(tv + 256);
    for (int t = C.bid; t < T; t += C.G) {
        for (int i = C.tid; i < 2048; i += 512) qs[i] = bf2f(Q[(size_t)t * NQ + i]);
        __syncthreads();
        for (int i = 0; i < 4; ++i) {
            const int idx = C.tid + 512 * i, hj = idx >> 7, key = idx & 127, h = hj >> 1, j = hj & 1;
            const bf16_t* kp = keys + (((size_t)j * PH + h) * 128 + key) * 128;
            float s = 0.f;
            for (int d8 = 0; d8 < 16; ++d8) {
                const u32x4 raw = *(const u32x4*)(kp + d8 * 8);
#pragma unroll
                for (int e = 0; e < 4; ++e) s += qs[h * 256 + j * 128 + d8 * 8 + 2 * e] * bf2f(raw[e] & 0xffffu) + qs[h * 256 + j * 128 + d8 * 8 + 2 * e + 1] * bf2f(raw[e] >> 16);
            }
            sc[idx] = s;
        }
        __syncthreads();
        for (int i = 0; i < 2; ++i) {
            const int hj = C.wave * 2 + i;
            float a0 = sc[hj * 128 + C.lane], a1 = sc[hj * 128 + 64 + C.lane];
            for (int r = 0; r < 16; ++r) {
                float bv; int bi;
                if (a0 > a1 || (a0 == a1)) { bv = a0; bi = C.lane; } else { bv = a1; bi = C.lane + 64; }
                wave_argmax(bv, bi);
                if (C.lane == 0) { tv[hj * 16 + r] = bv; ti[hj * 16 + r] = bi; }
                if (bi == C.lane) a0 = -3e38f; if (bi == C.lane + 64) a1 = -3e38f;
            }
        }
        __syncthreads();
        {
            const int h = C.wave;
            float cv[4];
#pragma unroll
            for (int i = 0; i < 4; ++i) { const int c = C.lane * 4 + i; cv[i] = tv[(h * 2) * 16 + (c >> 4)] + tv[(h * 2 + 1) * 16 + (c & 15)]; }
            float topv = 0.f; int tope = 0; float mx = 0.f;
            for (int r = 0; r < 16; ++r) {
                float bv = cv[0]; int bi = C.lane * 4;
#pragma unroll
                for (int i = 1; i < 4; ++i) if (cv[i] > bv) { bv = cv[i]; bi = C.lane * 4 + i; }
                wave_argmax(bv, bi);
                if (r == 0) mx = bv;
                if (C.lane == r) { topv = bv; tope = ti[(h * 2) * 16 + (bi >> 4)] * 128 + ti[(h * 2 + 1) * 16 + (bi & 15)]; }
#pragma unroll
                for (int i = 0; i < 4; ++i) if (bi == C.lane * 4 + i) cv[i] = -3e38f;
            }
            float e = (C.lane < 16) ? __expf(topv - mx) : 0.f;
            const float den = wave_sum(e);
            if (C.lane < 16) { eidx[(size_t)t * 128 + h * 16 + C.lane] = tope; egate[(size_t)t * 128 + h * 16 + C.lane] = e / den; }
        }
        __syncthreads();
    }
}
__device__ __forceinline__ float ub(unsigned w, int e) { return (float)((w >> (8 * e)) & 255u); }
__device__ __forceinline__ void p_gather(const Ctx& C, int l) {
    const bf16_t* xc = (const bf16_t*)(C.ws + WS_X1B);
    const unsigned char* U8 = C.ws + WS_U8; const unsigned char* V8 = C.ws + WS_V8;
    const float* SU = (const float*)(C.ws + WS_SU); const float* SV = (const float*)(C.ws + WS_SV);
    const int* eidx = (const int*)(C.ws + WS_EIDX); const float* egate = (const float*)(C.ws + WS_EGATE);
    const int lane = C.lane;
    for (int t = C.bid * 8 + C.wave; t < T; t += C.G * 8) {
        float x[16];
        { const bf16_t* xp = xc + (size_t)t * DM + lane * 16;
          const u32x4 a = *(const u32x4*)xp, b = *(const u32x4*)(xp + 8);
#pragma unroll
          for (int i = 0; i < 4; ++i) { x[2 * i] = bf2f(a[i] & 0xffffu); x[2 * i + 1] = bf2f(a[i] >> 16); x[8 + 2 * i] = bf2f(b[i] & 0xffffu); x[9 + 2 * i] = bf2f(b[i] >> 16); } }
        float xs = 0.f;
#pragma unroll
        for (int j = 0; j < 16; ++j) xs += x[j];
        xs = wave_sum(xs);
        float cf[2]; int ex[2];
#pragma unroll
        for (int bt = 0; bt < 2; ++bt) {
            ex[bt] = eidx[(size_t)t * 128 + 64 * bt + lane];
            const float gate = egate[(size_t)t * 128 + 64 * bt + lane];
            float p[64];
#pragma unroll
            for (int e0 = 0; e0 < 64; e0 += 16) {
                u32x4 r[16];
#pragma unroll
                for (int i = 0; i < 16; ++i) { const int e = __builtin_amdgcn_readlane(ex[bt], e0 + i); r[i] = *(const u32x4*)(U8 + (size_t)e * DM + lane * 16); }
#pragma unroll
                for (int i = 0; i < 16; ++i) { float sacc = 0.f;
#pragma unroll
                    for (int q = 0; q < 4; ++q)
#pragma unroll
                        for (int e = 0; e < 4; ++e) sacc += x[4 * q + e] * ub(r[i][q], e);
                    p[e0 + i] = sacc; }
            }
#pragma unroll
            for (int st = 32, n = 32; st > 0; st >>= 1, n >>= 1) {
                const bool up = (lane & st) != 0;
#pragma unroll
                for (int i = 0; i < n; ++i) { const float send = up ? p[i] : p[i + n], keep = up ? p[i + n] : p[i]; p[i] = keep + __shfl_xor(send, st, 64); }
            }
            const float hsum = SU[ex[bt]] * (p[0] - 128.f * xs);
            cf[bt] = gate * geluf_slow(hsum) * SV[ex[bt]];
        }
        float y[16];
#pragma unroll
        for (int j = 0; j < 16; ++j) y[j] = 0.f;
        float csum = wave_sum(cf[0] + cf[1]);
#pragma unroll
        for (int bt = 0; bt < 2; ++bt)
#pragma unroll
            for (int e0 = 0; e0 < 64; e0 += 16) {
                u32x4 r[16];
#pragma unroll
                for (int i = 0; i < 16; ++i) { const int e = __builtin_amdgcn_readlane(ex[bt], e0 + i); r[i] = *(const u32x4*)(V8 + (size_t)e * DM + lane * 16); }
#pragma unroll
                for (int i = 0; i < 16; ++i) { const float c = __builtin_bit_cast(float, __builtin_amdgcn_readlane(__builtin_bit_cast(int, cf[bt]), e0 + i));
#pragma unroll
                    for (int q = 0; q < 4; ++q)
#pragma unroll
                        for (int e = 0; e < 4; ++e) y[4 * q + e] += c * ub(r[i][q], e); }
            }
#pragma unroll
        for (int j = 0; j < 16; ++j) y[j] = y[j] - 128.f * csum + ALPHA * x[j];
        float sm = 0.f;
#pragma unroll
        for (int j = 0; j < 16; ++j) sm += y[j];
        const float mean = wave_sum(sm) * (1.f / DM);
        float qq = 0.f;
#pragma unroll
        for (int j = 0; j < 16; ++j) { const float d = y[j] - mean; qq += d * d; }
        const float rstd = rsqrtf(wave_sum(qq) * (1.f / DM) + LN_EPS);
        const float* gp = C.in[I_LN2G] + l * DM + lane * 16; const float* bp = C.in[I_LN2B] + l * DM + lane * 16;
#pragma unroll
        for (int i = 0; i < 4; ++i) { const f32x4 gg = *(const f32x4*)(gp + 4 * i), bb = *(const f32x4*)(bp + 4 * i);
#pragma unroll
            for (int e = 0; e < 4; ++e) y[4 * i + e] = (y[4 * i + e] - mean) * rstd * gg[e] + bb[e]; }
        float* dst = (l + 1 < DEPTH) ? (float*)(C.ws + WS_XA) + (size_t)t * DM : C.out + (size_t)t * DM;
#if DIAG
        if (l + 1 == DEPTH) { const float al = 1.f + diag_alpha(C);
#pragma unroll
            for (int j = 0; j < 16; ++j) y[j] *= al; }
#endif
#pragma unroll
        for (int i = 0; i < 4; ++i) *(f32x4*)(dst + lane * 16 + 4 * i) = (f32x4){y[4 * i], y[4 * i + 1], y[4 * i + 2], y[4 * i + 3]};
        if (l + 1 < DEPTH) {
            bf16_t* xb = (bf16_t*)(C.ws + WS_XB) + (size_t)t * DM + lane * 16;
            u32x4 o0, o1;
#pragma unroll
            for (int j = 0; j < 4; ++j) { o0[j] = pk2(y[2 * j], y[2 * j + 1]); o1[j] = pk2(y[8 + 2 * j], y[9 + 2 * j]); }
            *(u32x4*)xb = o0; *(u32x4*)(xb + 8) = o1;
            const float* wf = (const float*)(C.ws + WS_W + (size_t)(l + 1) * W_LAYER + WO_WF);
            float* lsig = (float*)(C.ws + WS_MISC);
#pragma unroll
            for (int h = 0; h < 4; ++h) {
                float sd = 0.f;
#pragma unroll
                for (int i = 0; i < 4; ++i) { const f32x4 a = *(const f32x4*)(wf + h * DM + lane * 16 + 4 * i);
#pragma unroll
                    for (int e = 0; e < 4; ++e) sd += y[4 * i + e] * a[e]; }
                sd = wave_sum(sd);
                if (lane == 0) lsig[(size_t)t * 4 + h] = logsigmoidf_(sd + C.in[I_BFOX][(l + 1) * 4 + h]);
            }
        }
    }
}

struct FStoreBf16 { bf16_t* O; int ld;
    __device__ __forceinline__ void operator()(int row, int col, f32x4 v0, f32x4 v1, int) const {
        u32x4 o; o[0] = pk2(v0[0], v0[1]); o[1] = pk2(v0[2], v0[3]); o[2] = pk2(v1[0], v1[1]); o[3] = pk2(v1[2], v1[3]);
        *(u32x4*)(O + (size_t)row * ld + col) = o; } };
struct FGate { bf16_t* O; const float* bias;
    __device__ __forceinline__ void operator()(int row, int col, f32x4 v0, f32x4 v1, int) const {
        const f32x4 b0 = *(const f32x4*)(bias + col), b1 = *(const f32x4*)(bias + col + 4);
        u32x4 o; o[0] = pk2(sigmoidf_(v0[0] + b0[0]), sigmoidf_(v0[1] + b0[1])); o[1] = pk2(sigmoidf_(v0[2] + b0[2]), sigmoidf_(v0[3] + b0[3]));
        o[2] = pk2(sigmoidf_(v1[0] + b1[0]), sigmoidf_(v1[1] + b1[1])); o[3] = pk2(sigmoidf_(v1[2] + b1[2]), sigmoidf_(v1[3] + b1[3]));
        *(u32x4*)(O + (size_t)row * NG + col) = o; } };
struct FMerge { const bf16_t* G; bf16_t* MG;
    __device__ __forceinline__ void operator()(int row, int col, f32x4 v0, f32x4 v1, int z) const {
        const u32x4 gr = *(const u32x4*)(G + (size_t)row * NG + z * DM + col);
        float r[8];
#pragma unroll
        for (int e = 0; e < 4; ++e) { const float a = (e < 2) ? v0[2 * e] : v1[2 * e - 4], b = (e < 2) ? v0[2 * e + 1] : v1[2 * e - 3];
            r[2 * e] = a * bf2f(gr[e] & 0xffffu); r[2 * e + 1] = b * bf2f(gr[e] >> 16); }
        bf16_t* p = MG + (size_t)row * DM + col;
        if (z > 0) { const u32x4 pr = *(const u32x4*)p;
#pragma unroll
            for (int e = 0; e < 4; ++e) { r[2 * e] += bf2f(pr[e] & 0xffffu); r[2 * e + 1] += bf2f(pr[e] >> 16); } }
        u32x4 o;
#pragma unroll
        for (int e = 0; e < 4; ++e) o[e] = pk2(r[2 * e], r[2 * e + 1]);
        *(u32x4*)p = o; } };
struct FResid { const float* X; bf16_t* Y;
    __device__ __forceinline__ void operator()(int row, int col, f32x4 v0, f32x4 v1, int) const {
        const f32x4 x0 = *(const f32x4*)(X + (size_t)row * DM + col), x1 = *(const f32x4*)(X + (size_t)row * DM + col + 4);
        u32x4 o; o[0] = cvtpk(x0[0] * ALPHA + v0[0], x0[1] * ALPHA + v0[1]); o[1] = cvtpk(x0[2] * ALPHA + v0[2], x0[3] * ALPHA + v0[3]);
        o[2] = cvtpk(x1[0] * ALPHA + v1[0], x1[1] * ALPHA + v1[1]); o[3] = cvtpk(x1[2] * ALPHA + v1[2], x1[3] * ALPHA + v1[3]);
        *(u32x4*)(Y + (size_t)row * DM + col) = o; } };

constexpr int PH_PER_LAYER = 12, N_PHASES = 1 + DEPTH * PH_PER_LAYER;
template <int SP> __device__ __forceinline__ void run_phase(const Ctx& C0, int l) {
    Ctx C = C0;
    asm volatile("" : "+v"(C.tid));
    C.ws = launder_ptr(C.ws); C.out = launder_ptr(C.out); l = (int)launder_u((unsigned)l);
    C.lane = C.tid & 63; C.wave = __builtin_amdgcn_readfirstlane(C.tid >> 6);
    unsigned char* wb = C.ws + WS_W + (size_t)l * W_LAYER;
    if constexpr (SP == -1) { p_conv_weights(C); }
    if constexpr (SP == 0) {
        if (l == 0) p_rowpass0(C);
    }
    if constexpr (SP == 1) {
        p_cumsum(C);
        __syncthreads();
        pg8::Gemm g{(const bf16_t*)(C.ws + WS_XB), (const bf16_t*)(wb + WO_WIN), DM, DM, DM, 0, 0};
        pg8::StaticOrder S; S.init(T, NH, C.G, C.bid);
        pg8::Epi8<FStoreBf16> E{{(bf16_t*)(C.ws + WS_H), NH}};
        pg8::gemm_phase(C.lds, g, S, E, C.tid);
    }
    if constexpr (SP == 2) { p_knorm(C, l); if (l != HG_NAIVE_L) hgrn_b1(C, l); }
#if MIX_NAIVE
    if constexpr (SP == 3) { if (l != HG_NAIVE_L) hgrn_b2(C); mix_pool_naive(C, l); mix_gmlp_naive(C, l); }
#else
    if constexpr (SP == 3) { if (l != HG_NAIVE_L) hgrn_b2(C); mix_pool(C, l); mix_gmlp(C, l);
        if (DIAG == 2) mix_pool_naive(C, l); if (DIAG == 3) mix_gmlp_naive(C, l); }
#endif
#if DIAG == 1
    if constexpr (SP == 4) { hgrn_b3(C, l); { mix_hgrn_naive(C, l); __syncthreads(); } mix_fox(C, l); }
    if constexpr (SP == 5) { if (l == DIAG_LAYER) diag_cmp(C, (const bf16_t*)(C.ws + (DIAG_LAYER == 0 ? WS_XA : WS_TABU)) + 512, NBR, (const bf16_t*)(C.ws + WS_BR) + 512, NBR, 512); }
#elif DIAG == 2 || DIAG == 3
    if constexpr (SP == 4) { hgrn_b3(C, l); mix_fox(C, l); if (l == DIAG_LAYER) diag_cmp(C, (const bf16_t*)(C.ws + (DIAG_LAYER == 0 ? WS_XA : WS_TABU)) + (DIAG == 2 ? 0 : 1024), NBR, (const bf16_t*)(C.ws + WS_BR) + (DIAG == 2 ? 0 : 1024), NBR, 512); }
#else
    if constexpr (SP == 4) { if (l != HG_NAIVE_L) hgrn_b3(C, l); else { mix_hgrn_naive(C, l); __syncthreads(); } mix_fox(C, l); }
#endif
    if constexpr (SP == 5) {
        pg8::Gemm g{(const bf16_t*)(C.ws + WS_XB), (const bf16_t*)(wb + WO_WG), DM, DM, DM, 0, 0};
        pg8::StaticOrder S; S.init(T, NG, C.G, C.bid);
        pg8::Epi8<FGate> E{{(bf16_t*)(C.ws + WS_G), C.in[I_BGATE] + l * NG}};
        pg8::gemm_phase(C.lds, g, S, E, C.tid);
    }
    if constexpr (SP == 6) {
        pg8::Gemm g{(const bf16_t*)(C.ws + WS_BR), (const bf16_t*)(wb + WO_WBR), NBR, BW, BW, (size_t)BW, (size_t)DM * BW};
        pg8::ZOrder S; S.init(T, DM, 4, C.G, C.vcu);
        pg8::Epi8<FMerge> E{{(const bf16_t*)(C.ws + WS_G), (bf16_t*)(C.ws + WS_XB)}};
        pg8::gemm_phase(C.lds, g, S, E, C.tid);
    }
    if constexpr (SP == 7) {
        const float* xin = (l == 0) ? C.in[I_X] : (const float*)(C.ws + WS_XA);
        pg8::Gemm g{(const bf16_t*)(C.ws + WS_XB), (const bf16_t*)(wb + WO_WOUT), DM, DM, DM, 0, 0};
        pg8::StaticOrder S; S.init(T, DM, C.G, C.bid);
        pg8::Epi8<FResid> E{{xin, (bf16_t*)(C.ws + WS_XC)}};
        pg8::gemm_phase(C.lds, g, S, E, C.tid);
    }
    if constexpr (SP == 8) { p_ln1(C, l); p_conv_tables(C, l); }
    if constexpr (SP == 9) {
        pg8::Gemm g{(const bf16_t*)(C.ws + WS_X1B), (const bf16_t*)(wb + WO_WQ), DM, DM, DM, 0, 0};
        pg8::StaticOrder S; S.init(T, NQ, C.G, C.bid);
        pg8::Epi8<FStoreBf16> E{{(bf16_t*)(C.ws + WS_Q), NQ}};
        pg8::gemm_phase(C.lds, g, S, E, C.tid);
    }
#if TOPK_NAIVE
    if constexpr (SP == 10) p_topk_naive(C, l);
#else
    if constexpr (SP == 10) p_topk(C, l);
#endif
    if constexpr (SP == 11) p_gather(C, l);
}
__device__ __forceinline__ void make_ctx(Ctx& C, const Args& args, unsigned char* lds_raw) {
    C.lds = (LAS unsigned char*)lds_raw; C.ws = args.ws; C.in = args.in; C.out = args.out;
    C.tid = threadIdx.x; C.lane = C.tid & 63; C.wave = __builtin_amdgcn_readfirstlane(C.tid >> 6);
    C.G = gridDim.x; C.bid = blockIdx.x; C.vcu = (C.G % 8 == 0) ? (C.bid % 8) * (C.G / 8) + C.bid / 8 : C.bid;
}
#if !MK_ONE_LAUNCH
template <int SP> __global__ void __launch_bounds__(512, 2) mk_phase(Args args) {
    extern __shared__ __attribute__((aligned(16))) unsigned char lds_raw[];
    Ctx C; make_ctx(C, args, lds_raw);
    run_phase<SP>(C, args.ph_lo);
}
#endif

#define GRID_BAR() xcd_barrier((unsigned*)(args.ws + WS_CTL) + 1024, (volatile LAS unsigned*)((LAS unsigned char*)lds_raw + LDSCTL_OFF + 32))
__global__ void __launch_bounds__(512, 2) mk_fwd(Args args) {
    extern __shared__ __attribute__((aligned(16))) unsigned char lds_raw[];
    Ctx C; make_ctx(C, args, lds_raw);
    { volatile LAS unsigned* misc = (volatile LAS unsigned*)(C.lds + LDSCTL_OFF); if (C.tid < 64) misc[C.tid] = 0u; }
    __syncthreads();
    xcd_barrier_post((unsigned*)(args.ws + WS_CTL) + 1024);
    run_phase<-1>(C, 0); GRID_BAR();
#pragma unroll 1
    for (int l = 0; l < DEPTH; ++l) {
        if (l == 0) { run_phase<0>(C, l); GRID_BAR(); }
        run_phase<1>(C, l); GRID_BAR();
        run_phase<2>(C, l); GRID_BAR();
        run_phase<3>(C, l); GRID_BAR();
        run_phase<4>(C, l); GRID_BAR();
        run_phase<5>(C, l); GRID_BAR();
        run_phase<6>(C, l); GRID_BAR();
        run_phase<7>(C, l); GRID_BAR();
        run_phase<8>(C, l); GRID_BAR();
        run_phase<9>(C, l); GRID_BAR();
        run_phase<10>(C, l); GRID_BAR();
        run_phase<11>(C, l); if (l + 1 < DEPTH) GRID_BAR();
    }
}

#if !MK_ONE_LAUNCH
template <int SP> static void launch_phase(const Args& a, int grid, hipStream_t stream) {
    static bool attr_done = false;
    if (!attr_done) { (void)hipFuncSetAttribute((const void*)mk_phase<SP>, hipFuncAttributeMaxDynamicSharedMemorySize, LDS_BYTES); attr_done = true; }
    hipLaunchKernelGGL(mk_phase<SP>, dim3(grid), dim3(512), LDS_BYTES, stream, a);
}
#endif
extern "C" void kernel_launch(void* const* d_in, const int* in_sizes, int n_in, void* d_out, int out_size, void* d_ws, size_t ws_size, hipStream_t stream) {
    static int grid = 0;
    if (grid == 0) {
        if (n_in != NIN_PTRS || out_size != T * DM || ws_size < WS_END) { fprintf(stderr, "kernel_launch: unexpected shapes n_in %d out %d ws %zu\n", n_in, out_size, ws_size); grid = -1; return; }
        int dev = 0, cus = 0;
        if (hipGetDevice(&dev) != hipSuccess || hipDeviceGetAttribute(&cus, hipDeviceAttributeMultiprocessorCount, dev) != hipSuccess) { grid = -1; return; }
        grid = cus;
    }
    if (grid < 0) return;
    (void)hipMemsetAsync((char*)d_ws + WS_CTL, 0, CTL_ZERO_BYTES, stream);
    Args a{};
    for (int i = 0; i < NIN_PTRS; ++i) a.in[i] = (const float*)d_in[i];
    a.out = (float*)d_out; a.ws = (unsigned char*)d_ws; a.bar_slot = 0; a.pad = 0; a.ph_hi = 0;
#if MK_ONE_LAUNCH
    static bool attr_done = false;
    if (!attr_done) { (void)hipFuncSetAttribute((const void*)mk_fwd, hipFuncAttributeMaxDynamicSharedMemorySize, LDS_BYTES); attr_done = true; }
    hipLaunchKernelGGL(mk_fwd, dim3(grid), dim3(512), LDS_BYTES, stream, a);
    return;
#endif
#if !MK_ONE_LAUNCH
    a.ph_lo = 0; launch_phase<-1>(a, grid, stream);
    for (int l = 0; l < DEPTH; ++l) {
        a.ph_lo = l;
        launch_phase<0>(a, grid, stream); launch_phase<1>(a, grid, stream); launch_phase<2>(a, grid, stream); launch_phase<3>(a, grid, stream); launch_phase<4>(a, grid, stream);
        launch_phase<5>(a, grid, stream); launch_phase<6>(a, grid, stream); launch_phase<7>(a, grid, stream); launch_phase<8>(a, grid, stream); launch_phase<9>(a, grid, stream); launch_phase<10>(a, grid, stream); launch_phase<11>(a, grid, stream);
    }
#endif
}
```

```cpp
#include <hip/hip_runtime.h>
#include <cstdio>
#include <cstdint>

#ifndef DIAG
#define DIAG 0
#endif
#ifndef DIAG_LO
#define DIAG_LO 0
#endif
#ifndef DIAG_HI
#define DIAG_HI 64
#endif
#ifndef DIAG_MOD
#define DIAG_MOD 64
#endif
#ifndef TOPK_NAIVE
#define TOPK_NAIVE 0
#endif
#ifndef MIX_NAIVE
#define MIX_NAIVE 0
#endif
#ifndef FOX_NAIVE
#define FOX_NAIVE 0
#endif
#ifndef HG_NAIVE_L
#define HG_NAIVE_L 99
#endif
#ifndef DIAG_LAYER
#define DIAG_LAYER 0
#endif
#ifndef MK_ONE_LAUNCH
#define MK_ONE_LAUNCH 1
#endif

#define LAS __attribute__((address_space(3)))
#define GAS __attribute__((address_space(1)))
typedef unsigned short bf16_t;
typedef short bf16x8 __attribute__((ext_vector_type(8)));
typedef float f32x4 __attribute__((ext_vector_type(4)));
typedef float f32x2 __attribute__((ext_vector_type(2)));
typedef unsigned u32x4 __attribute__((ext_vector_type(4)));
typedef unsigned u32x2 __attribute__((ext_vector_type(2)));

constexpr int DM = 1024, BATCH = 2, SEQ = 8192, DEPTH = 2, T = BATCH * SEQ;
constexpr int BW = 512, NIN = 5124, NH = 5120, NG = 4096, NBR = 2048, NQ = 2048;
constexpr int NEXP = 16384, TOPK = 16, PH = 8;
constexpr float ALPHA = 1.4142135623730951f;
constexpr float LN_EPS = 1e-5f, RMS_EPS = 1e-6f;
constexpr int HC_P = 0, HC_HQ = 512, HC_HF = 1024, HC_HI = 1536, HC_HG = 2048, HC_GU = 2560, HC_GV = 3072, HC_FQ = 3584, HC_FK = 4096, HC_FV = 4608;

constexpr size_t MiB = 1u << 20;
constexpr size_t WS_CTL = 0, CTL_ZERO_BYTES = 64 * 1024;
constexpr size_t WS_MISC = 512 * 1024;
constexpr size_t WS_CUM = 768 * 1024;
constexpr size_t WS_W = 1 * MiB;
constexpr size_t W_LAYER = 30 * MiB;
constexpr size_t WO_WIN = 0, WO_WG = 10 * MiB, WO_WBR = 18 * MiB, WO_WOUT = 22 * MiB, WO_WQ = 24 * MiB, WO_KEYS = 28 * MiB, WO_WF = 28 * MiB + 512 * 1024, WO_POOLW = 28 * MiB + 768 * 1024, WO_GWS = 29 * MiB;
constexpr size_t WS_TABU = 64 * MiB, WS_TABV = 96 * MiB;
constexpr size_t WS_XA = 128 * MiB;
constexpr size_t WS_XB = 192 * MiB;
constexpr size_t WS_X1B = 224 * MiB;
constexpr size_t WS_H = 256 * MiB;
constexpr size_t WS_ST = 416 * MiB;
constexpr size_t WS_BR = 448 * MiB;
constexpr size_t WS_G = 256 * MiB;
constexpr size_t WS_MGF = 384 * MiB;
constexpr size_t WS_XC = 256 * MiB;
constexpr size_t WS_Q = 320 * MiB;
constexpr size_t WS_EIDX = 384 * MiB, WS_EGATE = 392 * MiB;
constexpr size_t WS_END = 512 * MiB;

__device__ __forceinline__ float bf2f(unsigned u) { return __builtin_bit_cast(float, u << 16); }
__device__ __forceinline__ unsigned f2bf(float f) { unsigned u = __builtin_bit_cast(unsigned, f); return (u + 0x7fffu + ((u >> 16) & 1u)) >> 16; }
typedef __bf16 bf16x2_t __attribute__((ext_vector_type(2)));
__device__ __forceinline__ unsigned cvtpk(float lo, float hi) { f32x2 v = {lo, hi}; bf16x2_t b = __builtin_convertvector(v, bf16x2_t); return __builtin_bit_cast(unsigned, b); }
__device__ __forceinline__ unsigned pk2(float lo, float hi) { return cvtpk(lo, hi); }
__device__ __forceinline__ float wave_sum(float v) {
#pragma unroll
    for (int o = 32; o > 0; o >>= 1) v += __shfl_xor(v, o, 64);
    return v;
}
__device__ __forceinline__ float sigmoidf_(float x) { return __builtin_amdgcn_rcpf(1.f + __builtin_amdgcn_exp2f(-1.4426950408889634f * x)); }
__device__ __forceinline__ float siluf_(float x) { return x * __builtin_amdgcn_rcpf(1.f + __builtin_amdgcn_exp2f(-1.4426950408889634f * x)); }
__device__ __forceinline__ float geluf_slow(float x) { const float u = 0.7978845608028654f * (x + 0.044715f * x * x * x); return 0.5f * x * (1.f + tanhf(u)); }
__device__ __forceinline__ float geluf_(float x) { const float u2 = -2.302208198f * (x + 0.044715f * x * x * x); return x * __builtin_amdgcn_rcpf(1.f + __builtin_amdgcn_exp2f(u2)); }
__device__ __forceinline__ float logsigmoidf_(float z) { return fminf(z, 0.f) - log1pf(__expf(-fabsf(z))); }

__device__ __forceinline__ unsigned launder_u(unsigned x) { asm volatile("" : "+v"(x)); return __builtin_amdgcn_readfirstlane(x); }
template <class P> __device__ __forceinline__ P launder_ptr(P p) {
    const unsigned lo = launder_u((unsigned)(uintptr_t)p), hi = launder_u((unsigned)((uintptr_t)p >> 32));
    return (P)(((uintptr_t)hi << 32) | lo);
}

namespace pg8 {
constexpr int BM = 256, BK = 64, HALF = 128, HTB = HALF * BK * 2, STAGE_BYTES = 8 * HTB, NXCD = 8, WGM = 8;
__host__ __device__ __forceinline__ int lds_byte(int r, int c) { const int st = (r >> 4) * 2 + (c >> 5), rr = r & 15, cc = c & 31, ob = rr * 64 + cc * 2; return st * 1024 + (ob ^ (((ob >> 9) & 1) << 5)); }
__host__ __device__ __forceinline__ void stage_rc(int b, int& R, int& C) { const int st = b / 1024, sb = b % 1024, swz = sb ^ (((sb >> 9) & 1) << 5); R = (st >> 1) * 16 + swz / 64; C = (st & 1) * 32 + (swz % 64) / 2; }
__host__ __device__ __forceinline__ int perm32(int rho) { const int n = rho >> 4, i = rho & 15; return 8 * (i >> 2) + 4 * n + (i & 3); }

struct Unit { int pm, pn, z; };
struct Gemm { const bf16_t* A; const bf16_t* Bt; int lda, ldb, K; size_t zA, zB; };

struct StaticOrder {
    int nM, nN, nwg, G, c;
    __device__ void init(int M, int N, int G_, int c_) { nM = M / BM; nN = N / BM; nwg = nM * nN; G = G_; c = c_; }
    __device__ bool next(int i, Unit& u) const {
        const long L = (long)i * G + c; if (L >= nwg) return false;
        int wgid = (int)L; { const int q = nwg / NXCD, r = nwg % NXCD, xcd = wgid % NXCD, off = wgid / NXCD; wgid = (xcd < r ? xcd * (q + 1) : r * (q + 1) + (xcd - r) * q) + off; }
        const int nig = WGM * nN, gid = wgid / nig, fm = gid * WGM, gsz = (nM - fm) < WGM ? (nM - fm) : WGM;
        u.pm = fm + ((wgid % nig) % gsz); u.pn = (wgid % nig) / gsz; u.z = 0; return true;
    }
};
struct ZOrder {
    int nM, nN, nZ, ntile, G, c;
    __device__ void init(int M, int N, int Z, int G_, int c_) { nM = M / BM; nN = N / BM; nZ = Z; ntile = nM * nN; G = G_; c = c_; }
    __device__ bool next(int i, Unit& u) const {
        const long L = (long)(i / nZ) * G + c; if (L >= ntile) return false;
        u.pm = (int)L / nN; u.pn = (int)L % nN; u.z = i % nZ; return true;
    }
};

template <class F> struct Epi8 {
    static constexpr bool PERM = true;
    F f;
    __device__ __forceinline__ void operator()(const f32x4 (&acc)[2][2][4][2], const Unit& u, int wr, int wc, int fr, int fq) const {
        const int row0 = u.pm * BM + wr * 64 + fr, col0 = u.pn * BM + wc * 32 + 8 * fq;
#pragma unroll
        for (int ai = 0; ai < 2; ++ai)
#pragma unroll
            for (int m = 0; m < 4; ++m)
#pragma unroll
                for (int bj = 0; bj < 2; ++bj) f(row0 + ai * HALF + m * 16, col0 + bj * HALF, acc[ai][bj][m][0], acc[ai][bj][m][1], u.z);
    }
};
template <class F> struct Epi4 {
    static constexpr bool PERM = false;
    F f;
    __device__ __forceinline__ void operator()(const f32x4 (&acc)[2][2][4][2], const Unit& u, int wr, int wc, int fr, int fq) const {
        const int row0 = u.pm * BM + wr * 64 + fr, col0 = u.pn * BM + wc * 32 + 4 * fq;
#pragma unroll
        for (int ai = 0; ai < 2; ++ai)
#pragma unroll
            for (int m = 0; m < 4; ++m)
#pragma unroll
                for (int bj = 0; bj < 2; ++bj)
#pragma unroll
                    for (int n = 0; n < 2; ++n) f(row0 + ai * HALF + m * 16, col0 + bj * HALF + n * 16, acc[ai][bj][m][n], u.z);
    }
};

template <class Epi, class Sched, bool ALIGN_EPI = true>
__device__ __forceinline__ void gemm_phase(LAS unsigned char* lds, const Gemm g, const Sched& S, const Epi& E, const int tid) {
    const int wid = __builtin_amdgcn_readfirstlane(tid >> 6), lane = tid & 63, wr = wid >> 2, wc = wid & 3, fr = lane & 15, fq = lane >> 4;
    const int K = g.K, nt = K / BK;
    unsigned voffA[2], voffB[2];
#pragma unroll
    for (int i = 0; i < 2; ++i) { int R, C; stage_rc(tid * 16 + i * 8192, R, C); const int Rb = Epi::PERM ? ((R & ~31) + perm32(R & 31)) : R;
        voffA[i] = (unsigned)(R * g.lda + C) * 2u; voffB[i] = (unsigned)(Rb * g.ldb + C) * 2u; }
    const size_t kstep = (size_t)(BK * 2);
    const size_t hstepA = (size_t)HALF * g.lda * 2, hstepB = (size_t)HALF * g.ldb * 2;
    const size_t tstepA = 2 * hstepA, tstepB = 2 * hstepB;
    const unsigned ldsw = (unsigned)wid * 1024u;
    const int aoff = lds_byte(wr * 64 + fr, fq * 8), boff = lds_byte(wc * 32 + fr, fq * 8);
#define PG8_SA(b, h) (((b) * 2 + (h)) * HTB)
#define PG8_SB(b, h) ((4 + (b) * 2 + (h)) * HTB)
#define PG8_STAGE(bufoff, gbase, voff) do { _Pragma("unroll") for (int _i = 0; _i < 2; ++_i) \
        __builtin_amdgcn_global_load_lds((const unsigned*)((const char*)(gbase) + (voff)[_i]), (LAS unsigned*)(lds + (bufoff) + ldsw + _i * 8192), 16, 0, 0); } while (0)
#define PG8_LDA(dst, b, h) do { _Pragma("unroll") for (int m = 0; m < 4; ++m) _Pragma("unroll") for (int k = 0; k < 2; ++k) dst[m][k] = *(const LAS bf16x8*)(lds + PG8_SA(b, h) + aoff + m * 2048 + k * 1024); } while (0)
#define PG8_LDB(dst, b, h) do { _Pragma("unroll") for (int n = 0; n < 2; ++n) _Pragma("unroll") for (int k = 0; k < 2; ++k) dst[n][k] = *(const LAS bf16x8*)(lds + PG8_SB(b, h) + boff + n * 2048 + k * 1024); } while (0)
#define PG8_MMA(ai, bj, At, Bt) do { __builtin_amdgcn_s_setprio(1); _Pragma("unroll") for (int m = 0; m < 4; ++m) _Pragma("unroll") for (int n = 0; n < 2; ++n) _Pragma("unroll") for (int k = 0; k < 2; ++k) \
        acc[ai][bj][m][n] = __builtin_amdgcn_mfma_f32_16x16x32_bf16(Bt[n][k], At[m][k], acc[ai][bj][m][n], 0, 0, 0); __builtin_amdgcn_s_setprio(0); } while (0)
#define PG8_WAIT_V(n) asm volatile("s_waitcnt vmcnt(" #n ")" ::: "memory")
#define PG8_WAIT_L(n) asm volatile("s_waitcnt lgkmcnt(" #n ")" ::: "memory")
#define PG8_BAR __builtin_amdgcn_s_barrier()
#define PG8_SCHED __builtin_amdgcn_sched_barrier(0)
    Unit cur, nxt; int ui = 0;
    if (!S.next(0, cur)) return;
    f32x4 acc[2][2][4][2];
#pragma unroll
    for (int a = 0; a < 2; ++a)
#pragma unroll
        for (int b = 0; b < 2; ++b)
#pragma unroll
            for (int m = 0; m < 4; ++m)
#pragma unroll
                for (int n = 0; n < 2; ++n) acc[a][b][m][n] = (f32x4){0.f, 0.f, 0.f, 0.f};
    bf16x8 At[4][2], B0[2][2], B1[2][2];
    const char* cA = (const char*)(g.A + (size_t)cur.z * g.zA) + (size_t)cur.pm * tstepA; const char* cB = (const char*)(g.Bt + (size_t)cur.z * g.zB) + (size_t)cur.pn * tstepB;
    PG8_STAGE(PG8_SB(0, 0), cB, voffB); PG8_STAGE(PG8_SB(0, 1), cB + hstepB, voffB); PG8_STAGE(PG8_SA(0, 0), cA, voffA); PG8_STAGE(PG8_SA(0, 1), cA + hstepA, voffA);
    if (wr == 1) PG8_BAR;
    PG8_WAIT_V(2); PG8_BAR;
    PG8_STAGE(PG8_SB(1, 0), cB + kstep, voffB); PG8_STAGE(PG8_SA(1, 0), cA + kstep, voffA); PG8_STAGE(PG8_SB(1, 1), cB + hstepB + kstep, voffB);
    PG8_WAIT_V(6); PG8_BAR;
    for (;;) {
        const bool has_next = S.next(ui + 1, nxt);
        const char* nA = has_next ? (const char*)(g.A + (size_t)nxt.z * g.zA) + (size_t)nxt.pm * tstepA : cA;
        const char* nB = has_next ? (const char*)(g.Bt + (size_t)nxt.z * g.zB) + (size_t)nxt.pn * tstepB : cB;
        for (int t = 0; t < nt; t += 2) {
            const bool last = (t == nt - 2);
            const char* a1 = cA + (size_t)(t + 1) * kstep;
            const char* a2 = last ? nA : cA + (size_t)(t + 2) * kstep; const char* b2 = last ? nB : cB + (size_t)(t + 2) * kstep;
            const char* a3 = a2 + kstep; const char* b3 = b2 + kstep;
            PG8_LDB(B0, 0, 0); PG8_LDB(B1, 0, 1); PG8_SCHED; PG8_LDA(At, 0, 0); PG8_STAGE(PG8_SA(1, 1), a1 + hstepA, voffA);
            PG8_WAIT_V(8); PG8_WAIT_L(0); PG8_BAR; PG8_MMA(0, 0, At, B0); PG8_MMA(0, 1, At, B1); PG8_BAR; PG8_SCHED;
            PG8_LDA(At, 0, 1); PG8_STAGE(PG8_SB(0, 0), b2, voffB); PG8_STAGE(PG8_SB(0, 1), b2 + hstepB, voffB); PG8_STAGE(PG8_SA(0, 0), a2, voffA);
            PG8_WAIT_V(8); PG8_WAIT_L(0); PG8_BAR; PG8_MMA(1, 0, At, B0); PG8_MMA(1, 1, At, B1); PG8_BAR; PG8_SCHED;
            PG8_LDB(B0, 1, 0); PG8_LDB(B1, 1, 1); PG8_SCHED; PG8_LDA(At, 1, 0); PG8_STAGE(PG8_SA(0, 1), a2 + hstepA, voffA);
            PG8_WAIT_V(8); PG8_WAIT_L(0); PG8_BAR; PG8_MMA(0, 0, At, B0); PG8_MMA(0, 1, At, B1); PG8_BAR; PG8_SCHED;
            PG8_LDA(At, 1, 1); PG8_STAGE(PG8_SB(1, 0), b3, voffB); PG8_STAGE(PG8_SB(1, 1), b3 + hstepB, voffB); PG8_STAGE(PG8_SA(1, 0), a3, voffA);
            PG8_WAIT_V(8); PG8_WAIT_L(0); PG8_BAR; PG8_MMA(1, 0, At, B0); PG8_MMA(1, 1, At, B1); PG8_BAR; PG8_SCHED;
        }
        if constexpr (ALIGN_EPI) { if (wr == 0) PG8_BAR; }
        E(acc, cur, wr, wc, fr, fq);
        if (!has_next) break;
#pragma unroll
        for (int a = 0; a < 2; ++a)
#pragma unroll
            for (int b = 0; b < 2; ++b)
#pragma unroll
                for (int m = 0; m < 4; ++m)
#pragma unroll
                    for (int n = 0; n < 2; ++n) acc[a][b][m][n] = (f32x4){0.f, 0.f, 0.f, 0.f};
        cur = nxt; cA = nA; cB = nB; ++ui;
        if constexpr (ALIGN_EPI) { if (wr == 1) PG8_BAR; }
    }
    PG8_WAIT_V(0);
    if constexpr (!ALIGN_EPI) { if (wr == 0) PG8_BAR; }
    PG8_BAR;
#undef PG8_SA
#undef PG8_SB
#undef PG8_STAGE
#undef PG8_LDA
#undef PG8_LDB
#undef PG8_MMA
#undef PG8_WAIT_V
#undef PG8_WAIT_L
#undef PG8_BAR
#undef PG8_SCHED
}
}

#define XB_TMO      128
#define XB_XCNT(j)  (256  + 64 * (j))
#define XB_XSUB(j)  (1280 + 64 * (j))
#define XB_XGEN(j)  (2304 + 64 * (j))
#define XB_TOP      3328
#define XB_TOPGEN   3392
#define XCD_BAR_WORDS 3456
#define XB_SPIN_CAP (1u << 22)
__device__ __forceinline__ unsigned xb_ld(unsigned* p)              { return __hip_atomic_load(p, __ATOMIC_RELAXED, __HIP_MEMORY_SCOPE_AGENT); }
__device__ __forceinline__ unsigned xb_add(unsigned* p, unsigned v) { return __hip_atomic_fetch_add(p, v, __ATOMIC_RELAXED, __HIP_MEMORY_SCOPE_AGENT); }
__device__ __forceinline__ unsigned xb_xcc_id() { return (unsigned)__builtin_amdgcn_s_getreg((3 << 11) | 20) & 0xFu; }
#define XB_SPIN(cond, bar) do { unsigned _sp = 0; while (cond) { __builtin_amdgcn_s_sleep(1); \
    if ((++_sp & 255u) == 0u) { if (xb_ld(&(bar)[XB_TMO])) break; if (_sp > XB_SPIN_CAP) { atomicAdd(&(bar)[XB_TMO], 1u); break; } } } } while (0)
__device__ __forceinline__ void xcd_barrier_post(unsigned* bar) {
    if (threadIdx.x == 0) (void)xb_add(&bar[XB_XCNT(xb_xcc_id())], 1u);
}
__device__ __forceinline__ void xcd_barrier_complete(unsigned* bar, unsigned x, unsigned& nloc, unsigned& nx) {
    const unsigned G = gridDim.x * gridDim.y * gridDim.z;
    unsigned sum, cnt, mine, sp = 0u;
    for (;;) {
        sum = 0u; cnt = 0u; mine = 0u;
#pragma unroll
        for (unsigned j = 0; j < 16; ++j) { const unsigned c = xb_ld(&bar[XB_XCNT(j)]); sum += c; cnt += (c > 0u) ? 1u : 0u; mine = (j == x) ? c : mine; }
        if (sum == G) break;
        __builtin_amdgcn_s_sleep(1);
        if ((++sp & 255u) == 0u) { if (xb_ld(&bar[XB_TMO])) break; if (sp > XB_SPIN_CAP) { atomicAdd(&bar[XB_TMO], 1u); break; } }
    }
    nloc = mine > 0u ? mine : 1u; nx = cnt > 0u ? cnt : 1u;
}
__device__ __noinline__ void xcd_barrier_leader(unsigned* bar, volatile LAS unsigned* st) {
    const unsigned x = xb_xcc_id();
    __builtin_amdgcn_s_waitcnt(0);
    unsigned nloc = st[0], nx = st[1];
    if (nloc == 0u) { xcd_barrier_complete(bar, x, nloc, nx); st[0] = nloc; st[1] = nx; }
    const unsigned old = xb_add(&bar[XB_XSUB(x)], 1u);
    const unsigned gen = old / nloc;
    if (old + 1u == (gen + 1u) * nloc) {
        __builtin_amdgcn_fence(__ATOMIC_RELEASE, "agent");
        asm volatile("s_waitcnt vmcnt(0)" ::: "memory");
        const unsigned og = xb_add(&bar[XB_TOP], 1u);
        const unsigned tg = og / nx;
        if (og + 1u == (tg + 1u) * nx) xb_add(&bar[XB_TOPGEN], 1u);
        else XB_SPIN(xb_ld(&bar[XB_TOPGEN]) == tg, bar);
        __builtin_amdgcn_fence(__ATOMIC_ACQUIRE, "agent");
        xb_add(&bar[XB_XGEN(x)], 1u);
        asm volatile("s_waitcnt vmcnt(0)" ::: "memory");
    } else {
        XB_SPIN(xb_ld(&bar[XB_XGEN(x)]) == gen, bar);
        __builtin_amdgcn_fence(__ATOMIC_ACQUIRE, "agent");
        asm volatile("s_waitcnt vmcnt(0)" ::: "memory");
    }
}
__device__ __forceinline__ void xcd_barrier(unsigned* bar, volatile LAS unsigned* st) {
    asm volatile("s_waitcnt vmcnt(0)" ::: "memory");
    __syncthreads();
    if (threadIdx.x == 0) xcd_barrier_leader(bar, st);
    __syncthreads();
}

constexpr int NIN_PTRS = 23;
struct Args { const float* in[NIN_PTRS]; float* out; unsigned char* ws; int ph_lo, ph_hi, bar_slot, pad; };
enum { I_X = 0, I_WIN, I_BFOX, I_POOLW, I_POOLS, I_LBL, I_HNG, I_GLNG, I_GLNB, I_GWS, I_GBS, I_WGATE, I_BGATE, I_WBR, I_WOUT, I_LN1G, I_LN1B, I_WQ, I_KEYS, I_PU, I_PV, I_LN2G, I_LN2B };

constexpr int LDS_BYTES = 147456;
constexpr int LDSCTL_OFF = 143360;

struct Ctx {
    LAS unsigned char* lds;
    unsigned char* ws;
    const float* const* in;
    float* out;
    int tid, lane, wave, G, bid, vcu;
};

__device__ __forceinline__ void tconv_job(const Ctx& C, const float* src, int ld_src, int K, int N, bf16_t* dst) {
    LAS float* tile = (LAS float*)C.lds;
    const int nk = K / 64, nn = N / 64, ntiles = nk * nn;
    for (int tl = C.bid; tl < ntiles; tl += C.G) {
        const int k0 = (tl / nn) * 64, n0 = (tl % nn) * 64;
#pragma unroll
        for (int p = 0; p < 2; ++p) {
            const int kr = (C.tid >> 4) + p * 32, nc = (C.tid & 15) * 4;
            const f32x4 v = *(const f32x4*)(src + (size_t)(k0 + kr) * ld_src + n0 + nc);
            tile[kr * 65 + nc + 0] = v[0]; tile[kr * 65 + nc + 1] = v[1]; tile[kr * 65 + nc + 2] = v[2]; tile[kr * 65 + nc + 3] = v[3];
        }
        __syncthreads();
        {
            const int n = C.tid >> 3, k8 = (C.tid & 7) * 8;
            u32x4 o;
#pragma unroll
            for (int j = 0; j < 4; ++j) o[j] = pk2(tile[(k8 + 2 * j) * 65 + n], tile[(k8 + 2 * j + 1) * 65 + n]);
            *(u32x4*)(dst + (size_t)(n0 + n) * K + k0 + k8) = o;
        }
        __syncthreads();
    }
}
__device__ __forceinline__ void cvt_copy(const Ctx& C, const float* src, bf16_t* dst, size_t n) {
    const size_t n8 = n / 8;
    for (size_t i = (size_t)C.bid * 512 + C.tid; i < n8; i += (size_t)C.G * 512) {
        const f32x4 a = *(const f32x4*)(src + i * 8), b = *(const f32x4*)(src + i * 8 + 4);
        u32x4 o; o[0] = pk2(a[0], a[1]); o[1] = pk2(a[2], a[3]); o[2] = pk2(b[0], b[1]); o[3] = pk2(b[2], b[3]);
        *(u32x4*)(dst + i * 8) = o;
    }
}
__device__ __forceinline__ void p_conv_weights(const Ctx& C) {
    for (int l = 0; l < DEPTH; ++l) {
        unsigned char* wb = C.ws + WS_W + (size_t)l * W_LAYER;
        tconv_job(C, C.in[I_WIN] + (size_t)l * DM * NIN, NIN, DM, NH, (bf16_t*)(wb + WO_WIN));
        tconv_job(C, C.in[I_WGATE] + (size_t)l * DM * NG, NG, DM, NG, (bf16_t*)(wb + WO_WG));
        for (int m = 0; m < 4; ++m)
            tconv_job(C, C.in[I_WBR] + ((size_t)l * 4 + m) * BW * DM, DM, BW, DM, (bf16_t*)(wb + WO_WBR) + (size_t)m * DM * BW);
        tconv_job(C, C.in[I_WOUT] + (size_t)l * DM * DM, DM, DM, DM, (bf16_t*)(wb + WO_WOUT));
        tconv_job(C, C.in[I_WQ] + (size_t)l * DM * NQ, NQ, DM, NQ, (bf16_t*)(wb + WO_WQ));
        cvt_copy(C, C.in[I_KEYS] + (size_t)l * 2 * PH * 128 * 128, (bf16_t*)(wb + WO_KEYS), (size_t)2 * PH * 128 * 128);
        for (int g = 0; g < 4; ++g)
            tconv_job(C, C.in[I_POOLW] + ((size_t)l * 4 + g) * 128 * 128, 128, 128, 128, (bf16_t*)(wb + WO_POOLW) + (size_t)g * 128 * 128);
        {
            bf16_t* gw = (bf16_t*)(wb + WO_GWS); const float* src = C.in[I_GWS] + (size_t)l * 4 * 128 * 128;
            for (int i = C.bid * 512 + C.tid; i < 4 * 128 * 128; i += C.G * 512) { const int t = (i >> 7) & 127, sx = i & 127; gw[i] = (bf16_t)f2bf(sx <= t ? src[i] : 0.f); }
        }
        float* wf = (float*)(wb + WO_WF);
        for (int i = C.bid * 512 + C.tid; i < 4 * DM; i += C.G * 512) { const int h = i / DM, k = i % DM; wf[i] = C.in[I_WIN][(size_t)l * DM * NIN + (size_t)k * NIN + NH + h]; }
    }
}
constexpr size_t WS_U8 = WS_TABU, WS_V8 = WS_TABU + 16 * MiB, WS_SU = WS_TABU + 32 * MiB, WS_SV = WS_SU + 64 * 1024;
__device__ __forceinline__ float wave_max(float v) {
#pragma unroll
    for (int o = 32; o > 0; o >>= 1) v = fmaxf(v, __shfl_xor(v, o, 64));
    return v;
}
template <bool SIGNED> __device__ __forceinline__ void quant_rows(const Ctx& C, const float* src, unsigned char* dst, float* scl) {
    for (int row = C.bid * 8 + C.wave; row < NEXP; row += C.G * 8) {
        const float* p = src + (size_t)row * DM + C.lane * 16;
        f32x4 v[4]; float mx = 0.f;
#pragma unroll
        for (int i = 0; i < 4; ++i) { v[i] = *(const f32x4*)(p + 4 * i);
#pragma unroll
            for (int e = 0; e < 4; ++e) mx = fmaxf(mx, fabsf(v[i][e])); }
        mx = fmaxf(wave_max(mx), 1e-30f);
        const float sc = mx * (1.f / 127.f), isc = 127.f / mx;
        u32x4 o;
#pragma unroll
        for (int i = 0; i < 4; ++i) { unsigned wd = 0u;
#pragma unroll
            for (int e = 0; e < 4; ++e) { const int q = (int)rintf(v[i][e] * isc) + (SIGNED ? 0 : 128); wd |= ((unsigned)q & 255u) << (8 * e); }
            o[i] = wd; }
        *(u32x4*)(dst + (size_t)row * DM + C.lane * 16) = o;
        if (C.lane == 0) scl[row] = sc;
    }
}
__device__ __forceinline__ void p_conv_tables(const Ctx& C, int l) {
    quant_rows<true>(C, C.in[I_PU] + (size_t)l * NEXP * DM, C.ws + WS_U8, (float*)(C.ws + WS_SU));
    quant_rows<false>(C, C.in[I_PV] + (size_t)l * NEXP * DM, C.ws + WS_V8, (float*)(C.ws + WS_SV));
}

__device__ __forceinline__ void row_emit(const Ctx& C, int row, const float (&v)[16], int l, bool want_lsig) {
    bf16_t* xb = (bf16_t*)(C.ws + WS_XB) + (size_t)row * DM;
    u32x4 o0, o1;
#pragma unroll
    for (int j = 0; j < 4; ++j) { o0[j] = pk2(v[2 * j], v[2 * j + 1]); o1[j] = pk2(v[8 + 2 * j], v[8 + 2 * j + 1]); }
    *(u32x4*)(xb + C.lane * 8) = o0; *(u32x4*)(xb + 512 + C.lane * 8) = o1;
    if (want_lsig) {
        const float* wf = (const float*)(C.ws + WS_W + (size_t)l * W_LAYER + WO_WF);
        float* lsig = (float*)(C.ws + WS_MISC);
#pragma unroll
        for (int h = 0; h < 4; ++h) {
            const f32x4 a0 = *(const f32x4*)(wf + h * DM + C.lane * 8), a1 = *(const f32x4*)(wf + h * DM + C.lane * 8 + 4);
            const f32x4 b0 = *(const f32x4*)(wf + h * DM + 512 + C.lane * 8), b1 = *(const f32x4*)(wf + h * DM + 512 + C.lane * 8 + 4);
            float s = 0.f;
#pragma unroll
            for (int j = 0; j < 4; ++j) s += v[j] * a0[j] + v[4 + j] * a1[j] + v[8 + j] * b0[j] + v[12 + j] * b1[j];
            s = wave_sum(s);
            if (C.lane == 0) lsig[(size_t)row * 4 + h] = logsigmoidf_(s + C.in[I_BFOX][l * 4 + h]);
        }
    }
}
__device__ __forceinline__ void load_row16(const float* p, int lane, float (&v)[16]) {
    const f32x4 a0 = *(const f32x4*)(p + lane * 8), a1 = *(const f32x4*)(p + lane * 8 + 4), b0 = *(const f32x4*)(p + 512 + lane * 8), b1 = *(const f32x4*)(p + 512 + lane * 8 + 4);
#pragma unroll
    for (int j = 0; j < 4; ++j) { v[j] = a0[j]; v[4 + j] = a1[j]; v[8 + j] = b0[j]; v[12 + j] = b1[j]; }
}
__device__ __forceinline__ void store_row16(float* p, int lane, const float (&v)[16]) {
    *(f32x4*)(p + lane * 8) = (f32x4){v[0], v[1], v[2], v[3]}; *(f32x4*)(p + lane * 8 + 4) = (f32x4){v[4], v[5], v[6], v[7]};
    *(f32x4*)(p + 512 + lane * 8) = (f32x4){v[8], v[9], v[10], v[11]}; *(f32x4*)(p + 512 + lane * 8 + 4) = (f32x4){v[12], v[13], v[14], v[15]};
}
__device__ __forceinline__ void ln_row16(float (&v)[16], const float* g, const float* b, int lane) {
    float s = 0.f;
#pragma unroll
    for (int j = 0; j < 16; ++j) s += v[j];
    const float mean = wave_sum(s) * (1.f / DM);
    float q = 0.f;
#pragma unroll
    for (int j = 0; j < 16; ++j) { const float d = v[j] - mean; q += d * d; }
    const float rstd = rsqrtf(wave_sum(q) * (1.f / DM) + LN_EPS);
    float gg[16], bb[16];
    load_row16(g, lane, gg); load_row16(b, lane, bb);
#pragma unroll
    for (int j = 0; j < 16; ++j) v[j] = (v[j] - mean) * rstd * gg[j] + bb[j];
}
__device__ __forceinline__ void p_rowpass0(const Ctx& C) {
    for (int row = C.bid * 8 + C.wave; row < T; row += C.G * 8) {
        float v[16]; load_row16(C.in[I_X] + (size_t)row * DM, C.lane, v);
        row_emit(C, row, v, 0, true);
    }
}
__device__ __forceinline__ void p_cumsum(const Ctx& C) {
    if (C.bid >= BATCH * 4) return;
    const float* lsig = (const float*)(C.ws + WS_MISC);
    float* cum = (float*)(C.ws + WS_CUM);
    LAS float* wt = (LAS float*)C.lds;
    const int b = C.bid >> 2, h = C.bid & 3;
    float v[16];
#pragma unroll
    for (int j = 0; j < 16; ++j) v[j] = lsig[((size_t)b * SEQ + C.tid * 16 + j) * 4 + h];
#pragma unroll
    for (int j = 1; j < 16; ++j) v[j] += v[j - 1];
    float inc = v[15];
#pragma unroll
    for (int o = 1; o < 64; o <<= 1) { const float t = __shfl_up(inc, o, 64); if (C.lane >= o) inc += t; }
    if (C.lane == 63) wt[C.wave] = inc;
    __syncthreads();
    float off = inc - v[15];
    for (int w2 = 0; w2 < C.wave; ++w2) off += wt[w2];
    float* cp = cum + ((size_t)b * 4 + h) * SEQ + C.tid * 16;
#pragma unroll
    for (int j4 = 0; j4 < 4; ++j4) *(f32x4*)(cp + 4 * j4) = (f32x4){v[4 * j4] + off, v[4 * j4 + 1] + off, v[4 * j4 + 2] + off, v[4 * j4 + 3] + off};
    __syncthreads();
}
__device__ __forceinline__ void load_row16_bf(const bf16_t* p, int lane, float (&v)[16]) {
    const u32x4 a = *(const u32x4*)(p + lane * 8), b = *(const u32x4*)(p + 512 + lane * 8);
#pragma unroll
    for (int j = 0; j < 4; ++j) { v[2 * j] = bf2f(a[j] & 0xffffu); v[2 * j + 1] = bf2f(a[j] >> 16); v[8 + 2 * j] = bf2f(b[j] & 0xffffu); v[9 + 2 * j] = bf2f(b[j] >> 16); }
}
__device__ __forceinline__ void p_ln1(const Ctx& C, int l) {
    const bf16_t* y1 = (const bf16_t*)(C.ws + WS_XC); bf16_t* x1b = (bf16_t*)(C.ws + WS_X1B);
    for (int row = C.bid * 8 + C.wave; row < T; row += C.G * 8) {
        float v[16]; load_row16_bf(y1 + (size_t)row * DM, C.lane, v);
        ln_row16(v, C.in[I_LN1G] + l * DM, C.in[I_LN1B] + l * DM, C.lane);
        u32x4 o0, o1;
#pragma unroll
        for (int j = 0; j < 4; ++j) { o0[j] = pk2(v[2 * j], v[2 * j + 1]); o1[j] = pk2(v[8 + 2 * j], v[8 + 2 * j + 1]); }
        *(u32x4*)(x1b + (size_t)row * DM + C.lane * 8) = o0; *(u32x4*)(x1b + (size_t)row * DM + 512 + C.lane * 8) = o1;
    }
}

__device__ __forceinline__ void mix_pool_naive(const Ctx& C, int l) {
    const bf16_t* H = (const bf16_t*)(C.ws + WS_H); bf16_t* BR = (bf16_t*)(C.ws + WS_BR);
    LAS float* dd = (LAS float*)C.lds;
    for (int u = C.bid; u < (T / 64) * 4; u += C.G) {
        const int g = u & 3, t0 = (u >> 2) * 64, w = 2 << g;
        for (int idx = C.tid; idx < 64 * 128; idx += 512) {
            const int r = idx >> 7, c = idx & 127, row = t0 + r, pos = row & (SEQ - 1);
            const int nwin = (pos + 1 < w) ? pos + 1 : w;
            float s = 0.f;
            for (int j = 0; j < nwin; ++j) s += bf2f(H[(size_t)(row - j) * NH + HC_P + g * 128 + c]);
            dd[idx] = s / (float)nwin - bf2f(H[(size_t)row * NH + HC_P + g * 128 + c]);
        }
        __syncthreads();
        const int dcol = C.tid & 127, rq = C.tid >> 7;
        float acc[16];
#pragma unroll
        for (int i = 0; i < 16; ++i) acc[i] = 0.f;
        const float* pw = C.in[I_POOLW] + ((size_t)l * 4 + g) * 128 * 128;
        for (int c = 0; c < 128; ++c) {
            const float wv = pw[c * 128 + dcol];
#pragma unroll
            for (int i = 0; i < 16; ++i) acc[i] += dd[(rq * 16 + i) * 128 + c] * wv;
        }
        const float sc = C.in[I_POOLS][l * BW + g * 128 + dcol];
#pragma unroll
        for (int i = 0; i < 16; ++i) BR[(size_t)(t0 + rq * 16 + i) * NBR + 0 + g * 128 + dcol] = (bf16_t)f2bf(acc[i] * sc);
        __syncthreads();
    }
}
__device__ __forceinline__ void mix_gmlp_naive(const Ctx& C, int l) {
    const bf16_t* H = (const bf16_t*)(C.ws + WS_H); bf16_t* BR = (bf16_t*)(C.ws + WS_BR);
    LAS float* vn = (LAS float*)C.lds;
    for (int u = C.bid; u < (T / 128) * 4; u += C.G) {
        const int g = u & 3, t0 = (u >> 2) * 128;
        for (int i = 0; i < 16; ++i) {
            const int r = C.wave * 16 + i, row = t0 + r;
            const u32x4 raw = *(const u32x4*)(H + (size_t)row * NH + HC_GV + C.lane * 8);
            float e[8];
#pragma unroll
            for (int j = 0; j < 4; ++j) { e[2 * j] = geluf_(bf2f(raw[j] & 0xffffu)); e[2 * j + 1] = geluf_(bf2f(raw[j] >> 16)); }
            float s = 0.f;
#pragma unroll
            for (int j = 0; j < 8; ++j) s += e[j];
            const float mean = wave_sum(s) * (1.f / BW);
            float q = 0.f;
#pragma unroll
            for (int j = 0; j < 8; ++j) { const float d = e[j] - mean; q += d * d; }
            const float rstd = rsqrtf(wave_sum(q) * (1.f / BW) + LN_EPS);
            if ((C.lane >> 4) == g) {
#pragma unroll
                for (int j = 0; j < 8; ++j) { const int col = C.lane * 8 + j;
                    vn[r * 128 + (col - g * 128)] = (e[j] - mean) * rstd * C.in[I_GLNG][l * BW + col] + C.in[I_GLNB][l * BW + col]; }
            }
        }
        __syncthreads();
        const int c = C.tid & 127, tq = C.tid >> 7;
        const float* wsg = C.in[I_GWS] + ((size_t)l * 4 + g) * 128 * 128;
        for (int t = tq; t < 128; t += 4) {
            float acc = 0.f;
            for (int s = 0; s <= t; ++s) acc += wsg[t * 128 + s] * vn[s * 128 + c];
            const float sv = acc + C.in[I_GBS][(l * 4 + g) * 128 + t];
            const float uv = geluf_(bf2f(H[(size_t)(t0 + t) * NH + HC_GU + g * 128 + c]));
            BR[(size_t)(t0 + t) * NBR + 1024 + g * 128 + c] = (bf16_t)f2bf(uv * sv);
        }
        __syncthreads();
    }
}
__device__ __forceinline__ void mix_fox_naive(const Ctx& C, int l) {
    const bf16_t* H = (const bf16_t*)(C.ws + WS_H); bf16_t* BR = (bf16_t*)(C.ws + WS_BR);
    const float* cum = (const float*)(C.ws + WS_CUM);
    const float scale = 0.08838834764831845f;
    for (int u = C.bid; u < T * 4 / 8; u += C.G) {
        const int rid = u * 8 + C.wave;
        const int h = rid & 3, row = rid >> 2, b = row / SEQ, t = row % SEQ;
        const unsigned qraw = *(const unsigned*)(H + (size_t)row * NH + HC_FQ + h * 128 + C.lane * 2);
        const float q0 = bf2f(qraw & 0xffffu) * scale, q1 = bf2f(qraw >> 16) * scale;
        const float* cm = cum + ((size_t)b * 4 + h) * SEQ;
        const float ct = cm[t];
        float m = -1e30f, lsum = 0.f, o0 = 0.f, o1 = 0.f;
        for (int s = t; s >= 0; --s) {
            const size_t kr = (size_t)(b * SEQ + s) * NH + h * 128 + C.lane * 2;
            const unsigned kraw = *(const unsigned*)(H + kr + HC_FK);
            const unsigned vraw = *(const unsigned*)(H + kr + HC_FV);
            float d = q0 * bf2f(kraw & 0xffffu) + q1 * bf2f(kraw >> 16);
            d = wave_sum(d);
            const float z = d + ct - cm[s];
            const float mn = fmaxf(m, z), al = __expf(m - mn), p = __expf(z - mn);
            lsum = lsum * al + p; o0 = o0 * al + p * bf2f(vraw & 0xffffu); o1 = o1 * al + p * bf2f(vraw >> 16); m = mn;
        }
        const float inv = 1.f / lsum;
        *(unsigned*)(BR + (size_t)row * NBR + 1536 + h * 128 + C.lane * 2) = pk2(o0 * inv, o1 * inv);
    }
}
__device__ __forceinline__ void mix_hgrn_naive(const Ctx& C, int l) {
    if (C.bid >= BATCH * 4) return;
    const bf16_t* H = (const bf16_t*)(C.ws + WS_H); bf16_t* BR = (bf16_t*)(C.ws + WS_BR);
    const int b = C.bid >> 2, h = C.bid & 3;
    LAS float* fdec = (LAS float*)C.lds;
    LAS float* kkv = fdec + 32 * 128;
    LAS float* qsv = kkv + 32 * 128;
    LAS float* vv = qsv + 32 * 128;
    LAS float* opart = vv + 32 * 128;
    const int kq = C.tid >> 7, v = C.tid & 127;
    float S[32];
#pragma unroll
    for (int j = 0; j < 32; ++j) S[j] = 0.f;
    for (int c0 = 0; c0 < SEQ; c0 += 32) {
        for (int idx = C.tid; idx < 32 * 128; idx += 512) {
            const int st = idx >> 7, k = idx & 127; const size_t rb = (size_t)(b * SEQ + c0 + st) * NH + h * 128 + k;
            float lb = 0.f;
            if (l == 1) { const float z0 = C.in[I_LBL][h * 128 + k], z1 = C.in[I_LBL][BW + h * 128 + k]; lb = 1.f / (1.f + __expf(z0 - z1)); }
            const float zf = bf2f(H[rb + HC_HF]);
            const float kk = (1.f - lb) * sigmoidf_(-zf);
            fdec[idx] = 1.f - kk; kkv[idx] = kk; qsv[idx] = siluf_(bf2f(H[rb + HC_HQ])); vv[idx] = bf2f(H[rb + HC_HI]);
        }
        __syncthreads();
        for (int st = 0; st < 32; ++st) {
            const float vt = vv[st * 128 + v];
            float part = 0.f;
#pragma unroll
            for (int j = 0; j < 32; ++j) { const int k = kq * 32 + j; S[j] = fdec[st * 128 + k] * S[j] + kkv[st * 128 + k] * vt; part += S[j] * qsv[st * 128 + k]; }
            opart[(kq * 32 + st) * 128 + v] = part;
        }
        __syncthreads();
        for (int i = 0; i < 4; ++i) {
            const int st = C.wave * 4 + i, row = b * SEQ + c0 + st;
            float o0 = 0.f, o1 = 0.f;
#pragma unroll
            for (int q = 0; q < 4; ++q) { o0 += opart[(q * 32 + st) * 128 + C.lane]; o1 += opart[(q * 32 + st) * 128 + 64 + C.lane]; }
            const float ss = wave_sum(o0 * o0 + o1 * o1);
            const float r = rsqrtf(ss * (1.f / 128.f) + RMS_EPS);
            const float g0 = siluf_(bf2f(H[(size_t)row * NH + HC_HG + h * 128 + C.lane])), g1 = siluf_(bf2f(H[(size_t)row * NH + HC_HG + h * 128 + 64 + C.lane]));
            BR[(size_t)row * NBR + 512 + h * 128 + C.lane] = (bf16_t)f2bf(o0 * r * C.in[I_HNG][l * 128 + C.lane] * g0);
            BR[(size_t)row * NBR + 512 + h * 128 + 64 + C.lane] = (bf16_t)f2bf(o1 * r * C.in[I_HNG][l * 128 + 64 + C.lane] * g1);
        }
        __syncthreads();
    }
}


typedef float f32x16 __attribute__((ext_vector_type(16)));
typedef short s16x4 __attribute__((ext_vector_type(4)));
typedef short v4i16_t __attribute__((ext_vector_type(4)));
__device__ __forceinline__ s16x4 vtr(const LAS unsigned char* p) { return __builtin_bit_cast(s16x4, __builtin_amdgcn_ds_read_tr16_b64_v4i16((LAS v4i16_t*)p)); }
__device__ __forceinline__ float xor32(float x) { return __shfl_xor(x, 32, 64); }
#define MFMA32(a, b, c) __builtin_amdgcn_mfma_f32_32x32x16_bf16((a), (b), (c), 0, 0, 0)
constexpr int CW_KMAX = 16;

__device__ __forceinline__ void p_knorm(const Ctx& C, int l) {
    const bf16_t* H = (const bf16_t*)(C.ws + WS_H);
    unsigned* kmax = (unsigned*)(C.ws + WS_CTL) + CW_KMAX + l * 8;
    for (int r0 = (C.bid * 8 + C.wave) * 8; r0 < T; r0 += C.G * 64) {
        u32x4 raw[8];
#pragma unroll
        for (int i = 0; i < 8; ++i) raw[i] = *(const u32x4*)(H + (size_t)(r0 + i) * NH + HC_FK + C.lane * 8);
        float best = 0.f;
#pragma unroll
        for (int i = 0; i < 8; ++i) { float s = 0.f;
#pragma unroll
            for (int j = 0; j < 4; ++j) { const float a = bf2f(raw[i][j] & 0xffffu), b = bf2f(raw[i][j] >> 16); s += a * a + b * b; }
            best = fmaxf(best, s); }
        best = 0.f;
#pragma unroll
        for (int i = 0; i < 8; ++i) { float s = 0.f;
#pragma unroll
            for (int j = 0; j < 4; ++j) { const float a = bf2f(raw[i][j] & 0xffffu), b = bf2f(raw[i][j] >> 16); s += a * a + b * b; }
#pragma unroll
            for (int o = 8; o > 0; o >>= 1) s += __shfl_xor(s, o, 64);
            best = fmaxf(best, s); }
        if ((C.lane & 15) == 0) atomicMax(kmax + (r0 / SEQ) * 4 + (C.lane >> 4), __builtin_bit_cast(unsigned, best));
    }
}

constexpr int FOX_KST = 272, FOX_VST = 320;
constexpr int FOX_KB = 0, FOX_VB = 2 * 64 * FOX_KST, FOX_BETA = FOX_VB + 2 * 64 * FOX_VST, FOX_FLAG = FOX_BETA + 2 * 64 * 4, FOX_END = FOX_FLAG + 2 * 8 * 4;
__device__ __forceinline__ void mix_fox(const Ctx& C, int l) {
    const bf16_t* H = (const bf16_t*)(C.ws + WS_H); bf16_t* BR = (bf16_t*)(C.ws + WS_BR);
    const float* cum = (const float*)(C.ws + WS_CUM);
    const unsigned* kmaxw = (const unsigned*)(C.ws + WS_CTL) + CW_KMAX + l * 8;
    const float LOG2E = 1.4426950408889634f, QS = 0.08838834764831845f * LOG2E;
    const int lane = C.lane, w = C.wave, r32 = lane & 31, hh = lane >> 5;
    LAS unsigned char* lds = C.lds;
    LAS float* betaL = (LAS float*)(lds + FOX_BETA);
    volatile LAS int* flagL = (volatile LAS int*)(lds + FOX_FLAG);
    for (int u = C.bid; u < BATCH * 4 * (SEQ / 256); u += C.G) {
        const int qb = u % (SEQ / 256), bh = u / (SEQ / 256), b = bh >> 2, h = bh & 3;
        const int q0 = qb * 256, qw = q0 + 32 * w;
        const size_t rowbase = (size_t)b * SEQ;
        const float* cm = cum + ((size_t)b * 4 + h) * SEQ;
        const float c0 = cm[q0];
        const float kmx = sqrtf(__builtin_bit_cast(float, __hip_atomic_load(kmaxw + b * 4 + h, __ATOMIC_RELAXED, __HIP_MEMORY_SCOPE_AGENT)));
        bf16x8 qf[8]; float qn = 0.f;
        {
            const bf16_t* qp = H + (rowbase + qw + r32) * NH + HC_FQ + h * 128 + 8 * hh;
#pragma unroll
            for (int ks = 0; ks < 8; ++ks) {
                const u32x4 raw = *(const u32x4*)(qp + 16 * ks);
                u32x4 o;
#pragma unroll
                for (int j = 0; j < 4; ++j) { const float a = bf2f(raw[j] & 0xffffu), bb = bf2f(raw[j] >> 16); qn += a * a + bb * bb; o[j] = cvtpk(a * QS, bb * QS); }
                qf[ks] = __builtin_bit_cast(bf16x8, o);
            }
            qn += xor32(qn); qn = sqrtf(qn);
        }
        const float qbound = qn * kmx * QS;
        f32x16 oacc[4];
#pragma unroll
        for (int mt = 0; mt < 4; ++mt)
#pragma unroll
            for (int i = 0; i < 16; ++i) oacc[mt][i] = 0.f;
        float m_run = -1e30f, l_run = 0.f;
        const int jmax = (q0 + 255) >> 6;
        const int srow = C.tid >> 4, sch = C.tid & 15;
        u32x4 kreg[2], vreg[2]; float breg = 0.f;
#define FOX_GLOAD(j_) do { _Pragma("unroll") for (int p = 0; p < 2; ++p) { \
                const bf16_t* rp = H + (rowbase + 64 * (j_) + srow + 32 * p) * NH + h * 128 + sch * 8; \
                kreg[p] = *(const u32x4*)(rp + HC_FK); vreg[p] = *(const u32x4*)(rp + HC_FV); } \
            if (C.tid < 64) breg = (c0 - cm[64 * (j_) + C.tid]) * LOG2E; } while (0)
#define FOX_LWRITE(buf_) do { _Pragma("unroll") for (int p = 0; p < 2; ++p) { \
                *(LAS u32x4*)(lds + FOX_KB + (buf_) * 64 * FOX_KST + (srow + 32 * p) * FOX_KST + sch * 16) = kreg[p]; \
                *(LAS u32x4*)(lds + FOX_VB + (buf_) * 64 * FOX_VST + (srow + 32 * p) * FOX_VST + sch * 16) = vreg[p]; } \
            if (C.tid < 64) betaL[(buf_) * 64 + C.tid] = breg; } while (0)
        __syncthreads();
        if (C.tid < 16) flagL[C.tid] = 0;
        FOX_GLOAD(jmax); FOX_LWRITE(jmax & 1);
        bool wdone = false;
        for (int j = jmax; j >= 0; --j) {
            const int cur = j & 1;
            __syncthreads();
            if (j < jmax) { int all = 1;
#pragma unroll
                for (int i = 0; i < 8; ++i) all &= flagL[((j + 1) & 1) * 8 + i];
                if (all) break; }
            if (j > 0) FOX_GLOAD(j - 1);
            const int k0 = 64 * j;
            if (k0 <= qw + 31 && !wdone) {
                const LAS unsigned char* kb = lds + FOX_KB + cur * 64 * FOX_KST;
                const LAS unsigned char* vb = lds + FOX_VB + cur * 64 * FOX_VST;
                f32x16 sacc[2];
#pragma unroll
                for (int mt = 0; mt < 2; ++mt)
#pragma unroll
                    for (int g = 0; g < 4; ++g) { const f32x4 bv = *(const LAS f32x4*)(betaL + cur * 64 + 32 * mt + 8 * g + 4 * hh);
                        sacc[mt][4 * g] = bv[0]; sacc[mt][4 * g + 1] = bv[1]; sacc[mt][4 * g + 2] = bv[2]; sacc[mt][4 * g + 3] = bv[3]; }
#pragma unroll
                for (int ks = 0; ks < 8; ++ks)
#pragma unroll
                    for (int mt = 0; mt < 2; ++mt) {
                        const bf16x8 kf = *(const LAS bf16x8*)(kb + (32 * mt + r32) * FOX_KST + 32 * ks + 16 * hh);
                        sacc[mt] = MFMA32(kf, qf[ks], sacc[mt]);
                    }
                const int tq = qw + r32;
                if (k0 + 63 > qw) {
#pragma unroll
                    for (int mt = 0; mt < 2; ++mt)
#pragma unroll
                        for (int i = 0; i < 16; ++i) { const int key = k0 + 32 * mt + (i & 3) + 8 * (i >> 2) + 4 * hh; if (key > tq) sacc[mt][i] = -1e30f; }
                }
                float mx = sacc[0][0];
#pragma unroll
                for (int mt = 0; mt < 2; ++mt)
#pragma unroll
                    for (int i = 0; i < 16; ++i) mx = fmaxf(mx, sacc[mt][i]);
                mx = fmaxf(mx, xor32(mx));
                const float mn = fmaxf(m_run, mx), alpha = __builtin_amdgcn_exp2f(m_run - mn);
                m_run = mn;
                float ps = 0.f;
#pragma unroll
                for (int mt = 0; mt < 2; ++mt)
#pragma unroll
                    for (int i = 0; i < 16; ++i) { const float p = __builtin_amdgcn_exp2f(sacc[mt][i] - mn); sacc[mt][i] = p; ps += p; }
                l_run = l_run * alpha + ps;
#pragma unroll
                for (int mt = 0; mt < 4; ++mt)
#pragma unroll
                    for (int i = 0; i < 16; ++i) oacc[mt][i] *= alpha;
#pragma unroll
                for (int s4 = 0; s4 < 4; ++s4) {
                    const int mtk = s4 >> 1, s = s4 & 1;
                    u32x4 pb;
#pragma unroll
                    for (int e = 0; e < 4; ++e) pb[e] = cvtpk(sacc[mtk][8 * s + 2 * e], sacc[mtk][8 * s + 2 * e + 1]);
                    const bf16x8 pfrag = __builtin_bit_cast(bf16x8, pb);
                    const int i16 = lane & 15, q4 = i16 >> 2, p4 = i16 & 3, blk = (lane >> 4) & 1;
                    const int keyA = 32 * mtk + 16 * s + 4 * hh + q4;
#pragma unroll
                    for (int mt = 0; mt < 4; ++mt) {
                        const LAS unsigned char* a0 = vb + keyA * FOX_VST + (32 * mt + 16 * blk + 4 * p4) * 2;
                        const s16x4 lo = vtr(a0), hi = vtr(a0 + 8 * FOX_VST);
                        const bf16x8 vf = __builtin_shufflevector(lo, hi, 0, 1, 2, 3, 4, 5, 6, 7);
                        oacc[mt] = MFMA32(vf, pfrag, oacc[mt]);
                    }
                }
                if (j > 0) { const float bl = (c0 - cm[k0 - 1]) * LOG2E;
                    const int ok = (qbound + bl < m_run - 152.f) ? 1 : 0;
                    wdone = __all(ok); }
            }
            if (lane == 0) flagL[cur * 8 + w] = wdone ? 1 : 0;
            if (j > 0) FOX_LWRITE(cur ^ 1);
        }
        l_run += xor32(l_run);
        const float inv = 1.f / l_run;
        bf16_t* op = BR + (rowbase + qw + r32) * NBR + 1536 + h * 128;
#pragma unroll
        for (int mt = 0; mt < 4; ++mt)
#pragma unroll
            for (int g = 0; g < 4; ++g) { u32x2 o; o[0] = cvtpk(oacc[mt][4 * g] * inv, oacc[mt][4 * g + 1] * inv); o[1] = cvtpk(oacc[mt][4 * g + 2] * inv, oacc[mt][4 * g + 3] * inv);
                *(u32x2*)(op + 32 * mt + 8 * g + 4 * hh) = o; }
    }
}


constexpr int HG_LF = 0, HG_QA = 34816, HG_QB = HG_QA + 17408, HG_KD = HG_QB + 8704, HG_KO = HG_KD + 17408, HG_KT = HG_KO + 8704, HG_VN = HG_KT + 20480, HG_AM = HG_VN + 20480, HG_END = HG_AM + 12288;
constexpr int HG_LFS = 132;
static_assert(HG_END + 2048 <= 140 * 1024, "hgrn LDS");
constexpr size_t WS_DSC = WS_ST + (size_t)BATCH * 4 * 32 * 128 * 128 * 4;

template <bool FULL>
__device__ __forceinline__ void hgrn_unit(const Ctx& C, int l, int u) {
#if DIAG == 1
    const bf16_t* H = (const bf16_t*)(C.ws + WS_H); bf16_t* BR = (l == 0) ? (bf16_t*)(C.ws + WS_XA) : (bf16_t*)(C.ws + WS_TABU);
#else
    const bf16_t* H = (const bf16_t*)(C.ws + WS_H); bf16_t* BR = (bf16_t*)(C.ws + WS_BR);
#endif
    float* STB = (float*)(C.ws + WS_ST); float* DSC = (float*)(C.ws + WS_DSC);
    LAS unsigned char* lds = C.lds;
    LAS float* LF = (LAS float*)(lds + HG_LF);
    const int lane = C.lane, w = C.wave, r32 = lane & 31, hh = lane >> 5;
    const int sc = u & 31, bh = u >> 5, b = bh >> 2, h = bh & 3;
    const int wk = w >> 1, wv = w & 1;
    const int mt = w >> 2, nt = w & 3;
    const int i16 = lane & 15, q4 = i16 >> 2, p4 = i16 & 3, blk = (lane >> 4) & 1;
    f32x16 S0, S1;
    float* stp = STB + ((size_t)bh * 32 + sc) * 128 * 128;
    if constexpr (FULL) {
#pragma unroll
        for (int i = 0; i < 16; ++i) { const int k = 32 * wk + (i & 3) + 8 * (i >> 2) + 4 * hh;
            S0[i] = stp[k * 128 + 64 * wv + r32]; S1[i] = stp[k * 128 + 64 * wv + 32 + r32]; }
    } else {
#pragma unroll
        for (int i = 0; i < 16; ++i) { S0[i] = 0.f; S1[i] = 0.f; }
    }
    float dtot = 0.f;
    const int ps = C.tid >> 3, pseg = C.tid & 7;
    float lbv[16];
#pragma unroll
    for (int j = 0; j < 16; ++j) { lbv[j] = 0.f;
        if (l == 1) { const int ch = h * 128 + 16 * pseg + j; lbv[j] = 1.f / (1.f + __expf(C.in[I_LBL][ch] - C.in[I_LBL][BW + ch])); } }
    for (int c = 0; c < 4; ++c) {
        const size_t row0 = (size_t)b * SEQ + sc * 256 + c * 64;
        const bf16_t* hp = H + (row0 + ps) * NH + h * 128 + 16 * pseg;
        float kkv[16], qsv[16];
        u32x4 vraw0, vraw1;
        {
            const u32x4 f0 = *(const u32x4*)(hp + HC_HF), f1 = *(const u32x4*)(hp + HC_HF + 8);
            vraw0 = *(const u32x4*)(hp + HC_HI); vraw1 = *(const u32x4*)(hp + HC_HI + 8);
#pragma unroll
            for (int j = 0; j < 8; ++j) { const unsigned r = (j < 4) ? f0[j] : f1[j - 4];
                const float z0 = bf2f(r & 0xffffu), z1 = bf2f(r >> 16);
                kkv[2 * j] = (1.f - lbv[2 * j]) * sigmoidf_(-z0); kkv[2 * j + 1] = (1.f - lbv[2 * j + 1]) * sigmoidf_(-z1); }
            if constexpr (FULL) {
                const u32x4 q0 = *(const u32x4*)(hp + HC_HQ), q1 = *(const u32x4*)(hp + HC_HQ + 8);
#pragma unroll
                for (int j = 0; j < 8; ++j) { const unsigned r = (j < 4) ? q0[j] : q1[j - 4]; qsv[2 * j] = siluf_(bf2f(r & 0xffffu)); qsv[2 * j + 1] = siluf_(bf2f(r >> 16)); }
            }
#pragma unroll
            for (int j4 = 0; j4 < 4; ++j4) { f32x4 o;
#pragma unroll
                for (int e = 0; e < 4; ++e) o[e] = __logf(1.f - kkv[4 * j4 + e]);
                *(LAS f32x4*)(LF + ps * HG_LFS + 16 * pseg + 4 * j4) = o; }
        }
        __syncthreads();
        {
            const int sk = C.tid & 127, sg = C.tid >> 7;
            float vals[16];
#pragma unroll
            for (int i = 0; i < 16; ++i) vals[i] = LF[(16 * sg + i) * HG_LFS + sk];
#pragma unroll
            for (int i = 1; i < 16; ++i) vals[i] += vals[i - 1];
            LAS float* TOT = (LAS float*)(lds + HG_END);
            TOT[sg * 128 + sk] = vals[15];
            __syncthreads();
            float off = 0.f;
#pragma unroll
            for (int j = 0; j < 3; ++j) if (j < sg) off += TOT[j * 128 + sk];
#pragma unroll
            for (int i = 0; i < 16; ++i) LF[(16 * sg + i) * HG_LFS + sk] = vals[i] + off;
            if (sg == 3) dtot += vals[15] + off;
        }
        __syncthreads();
        float bv[16], b31[16], bl[16];
#pragma unroll
        for (int j4 = 0; j4 < 4; ++j4) { const f32x4 x = *(const LAS f32x4*)(LF + ps * HG_LFS + 16 * pseg + 4 * j4), y = *(const LAS f32x4*)(LF + 31 * HG_LFS + 16 * pseg + 4 * j4), z = *(const LAS f32x4*)(LF + 63 * HG_LFS + 16 * pseg + 4 * j4);
#pragma unroll
            for (int e = 0; e < 4; ++e) { bv[4 * j4 + e] = x[e]; b31[4 * j4 + e] = y[e]; bl[4 * j4 + e] = z[e]; } }
        {
            u32x4 o0, o1;
#pragma unroll
            for (int j = 0; j < 4; ++j) { o0[j] = cvtpk(kkv[2 * j] * __expf(bl[2 * j] - bv[2 * j]), kkv[2 * j + 1] * __expf(bl[2 * j + 1] - bv[2 * j + 1]));
                o1[j] = cvtpk(kkv[8 + 2 * j] * __expf(bl[8 + 2 * j] - bv[8 + 2 * j]), kkv[9 + 2 * j] * __expf(bl[9 + 2 * j] - bv[9 + 2 * j])); }
            *(LAS u32x4*)(lds + HG_KT + ps * 320 + 32 * pseg) = o0; *(LAS u32x4*)(lds + HG_KT + ps * 320 + 32 * pseg + 16) = o1;
            *(LAS u32x4*)(lds + HG_VN + ps * 320 + 32 * pseg) = vraw0; *(LAS u32x4*)(lds + HG_VN + ps * 320 + 32 * pseg + 16) = vraw1;
            if constexpr (FULL) {
                const bool hi = ps >= 32;
                float rr[16];
#pragma unroll
                for (int j = 0; j < 16; ++j) rr[j] = hi ? b31[j] : 0.f;
#pragma unroll
                for (int j = 0; j < 4; ++j) { o0[j] = cvtpk(qsv[2 * j] * __expf(bv[2 * j] - rr[2 * j]), qsv[2 * j + 1] * __expf(bv[2 * j + 1] - rr[2 * j + 1]));
                    o1[j] = cvtpk(qsv[8 + 2 * j] * __expf(bv[8 + 2 * j] - rr[8 + 2 * j]), qsv[9 + 2 * j] * __expf(bv[9 + 2 * j] - rr[9 + 2 * j])); }
                *(LAS u32x4*)(lds + HG_QA + ps * 272 + 32 * pseg) = o0; *(LAS u32x4*)(lds + HG_QA + ps * 272 + 32 * pseg + 16) = o1;
#pragma unroll
                for (int j = 0; j < 4; ++j) { o0[j] = cvtpk(kkv[2 * j] * __expf(rr[2 * j] - bv[2 * j]), kkv[2 * j + 1] * __expf(rr[2 * j + 1] - bv[2 * j + 1]));
                    o1[j] = cvtpk(kkv[8 + 2 * j] * __expf(rr[8 + 2 * j] - bv[8 + 2 * j]), kkv[9 + 2 * j] * __expf(rr[9 + 2 * j] - bv[9 + 2 * j])); }
                *(LAS u32x4*)(lds + HG_KD + ps * 272 + 32 * pseg) = o0; *(LAS u32x4*)(lds + HG_KD + ps * 272 + 32 * pseg + 16) = o1;
                if (hi) {
#pragma unroll
                    for (int j = 0; j < 4; ++j) { o0[j] = cvtpk(qsv[2 * j] * __expf(bv[2 * j]), qsv[2 * j + 1] * __expf(bv[2 * j + 1]));
                        o1[j] = cvtpk(qsv[8 + 2 * j] * __expf(bv[8 + 2 * j]), qsv[9 + 2 * j] * __expf(bv[9 + 2 * j])); }
                    *(LAS u32x4*)(lds + HG_QB + (ps - 32) * 272 + 32 * pseg) = o0; *(LAS u32x4*)(lds + HG_QB + (ps - 32) * 272 + 32 * pseg + 16) = o1;
                } else {
#pragma unroll
                    for (int j = 0; j < 4; ++j) { o0[j] = cvtpk(kkv[2 * j] * __expf(b31[2 * j] - bv[2 * j]), kkv[2 * j + 1] * __expf(b31[2 * j + 1] - bv[2 * j + 1]));
                        o1[j] = cvtpk(kkv[8 + 2 * j] * __expf(b31[8 + 2 * j] - bv[8 + 2 * j]), kkv[9 + 2 * j] * __expf(b31[9 + 2 * j] - bv[9 + 2 * j])); }
                    *(LAS u32x4*)(lds + HG_KO + ps * 272 + 32 * pseg) = o0; *(LAS u32x4*)(lds + HG_KO + ps * 272 + 32 * pseg + 16) = o1;
                }
            }
        }
        float dk[16];
#pragma unroll
        for (int i = 0; i < 16; ++i) dk[i] = __expf(LF[63 * HG_LFS + 32 * wk + (i & 3) + 8 * (i >> 2) + 4 * hh]);
        __syncthreads();
        if constexpr (FULL) {
#pragma unroll
            for (int g = 0; g < 4; ++g) {
                u32x2 o; o[0] = cvtpk(S0[4 * g], S0[4 * g + 1]); o[1] = cvtpk(S0[4 * g + 2], S0[4 * g + 3]);
                *(LAS u32x2*)(lds + HG_LF + (64 * wv + r32) * 272 + (32 * wk + 8 * g + 4 * hh) * 2) = o;
                o[0] = cvtpk(S1[4 * g], S1[4 * g + 1]); o[1] = cvtpk(S1[4 * g + 2], S1[4 * g + 3]);
                *(LAS u32x2*)(lds + HG_LF + (64 * wv + 32 + r32) * 272 + (32 * wk + 8 * g + 4 * hh) * 2) = o;
            }
#define HG_ATILE(AMT_, AST_) do { \
                const LAS unsigned char* kb = ((AMT_) == (AST_)) ? (lds + HG_KD + (32 * (AST_)) * 272) : (lds + HG_KO); \
                f32x16 a; \
                _Pragma("unroll") for (int i = 0; i < 16; ++i) a[i] = 0.f; \
                _Pragma("unroll") for (int ks = 0; ks < 8; ++ks) { \
                    const bf16x8 af = *(const LAS bf16x8*)(lds + HG_QA + (32 * (AMT_) + r32) * 272 + 32 * ks + 16 * hh); \
                    const bf16x8 bf = *(const LAS bf16x8*)(kb + r32 * 272 + 32 * ks + 16 * hh); \
                    a = MFMA32(af, bf, a); } \
                _Pragma("unroll") for (int g = 0; g < 4; ++g) { \
                    float x[4]; \
                    _Pragma("unroll") for (int e = 0; e < 4; ++e) { const int tl = 8 * g + 4 * hh + e; x[e] = ((AMT_) != (AST_) || r32 <= tl) ? a[4 * g + e] : 0.f; } \
                    u32x2 o; o[0] = cvtpk(x[0], x[1]); o[1] = cvtpk(x[2], x[3]); \
                    *(LAS u32x2*)(lds + HG_AM + (32 * (AST_) + r32) * 192 + (32 * (AMT_) + 8 * g + 4 * hh) * 2) = o; } } while (0)
            if (w == 0) { HG_ATILE(0, 0); }
            else if (w == 1) { HG_ATILE(1, 0); }
            else if (w == 2) { HG_ATILE(1, 1); }
        }
#pragma unroll
        for (int i = 0; i < 16; ++i) { S0[i] *= dk[i]; S1[i] *= dk[i]; }
#pragma unroll
        for (int ks = 0; ks < 4; ++ks) {
            const LAS unsigned char* ka = lds + HG_KT + (16 * ks + 8 * hh + q4) * 320 + (32 * wk + 16 * blk + 4 * p4) * 2;
            const s16x4 alo = vtr(ka), ahi = vtr(ka + 4 * 320);
            const bf16x8 af = __builtin_shufflevector(alo, ahi, 0, 1, 2, 3, 4, 5, 6, 7);
            const LAS unsigned char* vb0 = lds + HG_VN + (16 * ks + 8 * hh + q4) * 320 + (64 * wv + 16 * blk + 4 * p4) * 2;
            const s16x4 b0lo = vtr(vb0), b0hi = vtr(vb0 + 4 * 320), b1lo = vtr(vb0 + 64), b1hi = vtr(vb0 + 64 + 4 * 320);
            S0 = MFMA32(af, __builtin_shufflevector(b0lo, b0hi, 0, 1, 2, 3, 4, 5, 6, 7), S0);
            S1 = MFMA32(af, __builtin_shufflevector(b1lo, b1hi, 0, 1, 2, 3, 4, 5, 6, 7), S1);
        }
        if constexpr (FULL) {
            __syncthreads();
            f32x16 o;
#pragma unroll
            for (int i = 0; i < 16; ++i) o[i] = 0.f;
            const LAS unsigned char* qb = (mt == 0) ? (lds + HG_QA) : (lds + HG_QB);
#pragma unroll
            for (int ks = 0; ks < 8; ++ks) {
                const bf16x8 af = *(const LAS bf16x8*)(qb + r32 * 272 + 32 * ks + 16 * hh);
                const bf16x8 bf = *(const LAS bf16x8*)(lds + HG_LF + (32 * nt + r32) * 272 + 32 * ks + 16 * hh);
                o = MFMA32(af, bf, o);
            }
#pragma unroll
            for (int ks = 0; ks < 4; ++ks) {
                if (mt == 0 && ks >= 2) continue;
                const LAS unsigned char* aa = lds + HG_AM + (16 * ks + 8 * hh + q4) * 192 + (32 * mt + 16 * blk + 4 * p4) * 2;
                const s16x4 alo = vtr(aa), ahi = vtr(aa + 4 * 192);
                const LAS unsigned char* vb0 = lds + HG_VN + (16 * ks + 8 * hh + q4) * 320 + (32 * nt + 16 * blk + 4 * p4) * 2;
                const s16x4 blo = vtr(vb0), bhi = vtr(vb0 + 4 * 320);
                o = MFMA32(__builtin_shufflevector(alo, ahi, 0, 1, 2, 3, 4, 5, 6, 7), __builtin_shufflevector(blo, bhi, 0, 1, 2, 3, 4, 5, 6, 7), o);
            }
            __syncthreads();
#pragma unroll
            for (int i = 0; i < 16; ++i) LF[(32 * mt + (i & 3) + 8 * (i >> 2) + 4 * hh) * HG_LFS + 32 * nt + r32] = o[i];
            __syncthreads();
            {
                float ov[16]; float ss = 0.f;
#pragma unroll
                for (int j4 = 0; j4 < 4; ++j4) { const f32x4 x = *(const LAS f32x4*)(LF + ps * HG_LFS + 16 * pseg + 4 * j4);
#pragma unroll
                    for (int e = 0; e < 4; ++e) { ov[4 * j4 + e] = x[e]; ss += x[e] * x[e]; } }
                ss += __shfl_xor(ss, 1, 64); ss += __shfl_xor(ss, 2, 64); ss += __shfl_xor(ss, 4, 64);
                const float rn = rsqrtf(ss * (1.f / 128.f) + RMS_EPS);
                const u32x4 g0 = *(const u32x4*)(hp + HC_HG), g1 = *(const u32x4*)(hp + HC_HG + 8);
                const float* ng = C.in[I_HNG] + l * 128 + 16 * pseg;
                u32x4 o0, o1;
#pragma unroll
                for (int j = 0; j < 4; ++j) {
                    o0[j] = cvtpk(ov[2 * j] * rn * ng[2 * j] * siluf_(bf2f(g0[j] & 0xffffu)), ov[2 * j + 1] * rn * ng[2 * j + 1] * siluf_(bf2f(g0[j] >> 16)));
                    o1[j] = cvtpk(ov[8 + 2 * j] * rn * ng[8 + 2 * j] * siluf_(bf2f(g1[j] & 0xffffu)), ov[9 + 2 * j] * rn * ng[9 + 2 * j] * siluf_(bf2f(g1[j] >> 16)));
                }
                bf16_t* bp = BR + (row0 + ps) * NBR + 512 + h * 128 + 16 * pseg;
                *(u32x4*)bp = o0; *(u32x4*)(bp + 8) = o1;
            }
        }
        __syncthreads();
    }
    if constexpr (!FULL) {
#pragma unroll
        for (int i = 0; i < 16; ++i) { const int k = 32 * wk + (i & 3) + 8 * (i >> 2) + 4 * hh;
            stp[k * 128 + 64 * wv + r32] = S0[i]; stp[k * 128 + 64 * wv + 32 + r32] = S1[i]; }
        if (C.tid >= 384) DSC[((size_t)bh * 32 + sc) * 128 + (C.tid & 127)] = __expf(dtot);
    }
}
__device__ __forceinline__ void hgrn_b1(const Ctx& C, int l) { for (int u = C.bid; u < BATCH * 4 * 32; u += C.G) hgrn_unit<false>(C, l, u); }
__device__ __forceinline__ void hgrn_b3(const Ctx& C, int l) { for (int u = C.bid; u < BATCH * 4 * 32; u += C.G) hgrn_unit<true>(C, l, u); }
__device__ __forceinline__ void hgrn_b2(const Ctx& C) {
    float* STB = (float*)(C.ws + WS_ST); const float* DSC = (const float*)(C.ws + WS_DSC);
    for (int e = C.bid * 512 + C.tid; e < BATCH * 4 * 128 * 128; e += C.G * 512) {
        const int bh = e >> 14, kv = e & 16383, k = kv >> 7;
        float* p = STB + (size_t)bh * 32 * 16384 + kv;
        float uu[32], dd[32];
#pragma unroll
        for (int s = 0; s < 32; ++s) { uu[s] = p[(size_t)s * 16384]; dd[s] = DSC[((size_t)bh * 32 + s) * 128 + k]; }
        float st = 0.f;
#pragma unroll
        for (int s = 0; s < 32; ++s) { p[(size_t)s * 16384] = st; st = dd[s] * st + uu[s]; }
    }
}


__device__ __forceinline__ void mix_pool(const Ctx& C, int l) {
#if DIAG == 2
    const bf16_t* H = (const bf16_t*)(C.ws + WS_H); bf16_t* BR = (l == 0) ? (bf16_t*)(C.ws + WS_XA) : (bf16_t*)(C.ws + WS_TABU);
#else
    const bf16_t* H = (const bf16_t*)(C.ws + WS_H); bf16_t* BR = (bf16_t*)(C.ws + WS_BR);
#endif
    const bf16_t* Wt = (const bf16_t*)(C.ws + WS_W + (size_t)l * W_LAYER + WO_POOLW);
    LAS unsigned char* lds = C.lds;
    const int lane = C.lane, w = C.wave, r32 = lane & 31, hh = lane >> 5;
    for (int u = C.bid; u < (T / 256) * 4; u += C.G) {
        const int g = u & 3, t0 = (u >> 2) * 256, win = 2 << g;
        const int row = t0 + 32 * w + r32, pos = row & (SEQ - 1);
        __syncthreads();
#pragma unroll
        for (int p = 0; p < 4; ++p) { const int idx = C.tid + 512 * p, rr = idx >> 4, ch = idx & 15;
            *(LAS u32x4*)(lds + rr * 272 + ch * 16) = *(const u32x4*)(Wt + (size_t)g * 128 * 128 + rr * 128 + ch * 8); }
        const int nwin = (pos + 1 < win) ? pos + 1 : win;
        const float invn = 1.f / (float)nwin;
        bf16x8 df[8];
        const bf16_t* pp = H + (size_t)row * NH + HC_P + g * 128 + 8 * hh;
#pragma unroll
        for (int ks = 0; ks < 8; ++ks) {
            float sum[8];
#pragma unroll
            for (int e = 0; e < 8; ++e) sum[e] = 0.f;
            u32x4 rw[16];
#pragma unroll
            for (int j = 0; j < 16; ++j) { const int jj = (j < nwin) ? j : 0; rw[j] = *(const u32x4*)(pp + 16 * ks - (size_t)jj * NH); }
            const u32x4 self = rw[0];
#pragma unroll
            for (int j = 0; j < 16; ++j) { const float msk = (j < nwin) ? 1.f : 0.f;
#pragma unroll
                for (int e = 0; e < 4; ++e) { sum[2 * e] += msk * bf2f(rw[j][e] & 0xffffu); sum[2 * e + 1] += msk * bf2f(rw[j][e] >> 16); } }
            u32x4 o;
#pragma unroll
            for (int e = 0; e < 4; ++e) o[e] = cvtpk(sum[2 * e] * invn - bf2f(self[e] & 0xffffu), sum[2 * e + 1] * invn - bf2f(self[e] >> 16));
            df[ks] = __builtin_bit_cast(bf16x8, o);
        }
        __syncthreads();
        f32x16 acc[4];
#pragma unroll
        for (int mt = 0; mt < 4; ++mt)
#pragma unroll
            for (int i = 0; i < 16; ++i) acc[mt][i] = 0.f;
#pragma unroll
        for (int ks = 0; ks < 8; ++ks)
#pragma unroll
            for (int mt = 0; mt < 4; ++mt) {
                const bf16x8 wf = *(const LAS bf16x8*)(lds + (32 * mt + r32) * 272 + 32 * ks + 16 * hh);
                acc[mt] = MFMA32(wf, df[ks], acc[mt]);
            }
        const float* psc = C.in[I_POOLS] + l * BW + g * 128;
        bf16_t* op = BR + (size_t)row * NBR + g * 128;
#pragma unroll
        for (int mt = 0; mt < 4; ++mt)
#pragma unroll
            for (int q = 0; q < 4; ++q) { const int d0 = 32 * mt + 8 * q + 4 * hh; const f32x4 sc = *(const f32x4*)(psc + d0);
                u32x2 o; o[0] = cvtpk(acc[mt][4 * q] * sc[0], acc[mt][4 * q + 1] * sc[1]); o[1] = cvtpk(acc[mt][4 * q + 2] * sc[2], acc[mt][4 * q + 3] * sc[3]);
                *(u32x2*)(op + d0) = o; }
    }
}
constexpr int GM_VN = 0, GM_WC = 128 * 320, GM_END = GM_WC + 128 * 272;
__device__ __forceinline__ void mix_gmlp(const Ctx& C, int l) {
#if DIAG == 3
    const bf16_t* H = (const bf16_t*)(C.ws + WS_H); bf16_t* BR = (l == 0) ? (bf16_t*)(C.ws + WS_XA) : (bf16_t*)(C.ws + WS_TABU);
#else
    const bf16_t* H = (const bf16_t*)(C.ws + WS_H); bf16_t* BR = (bf16_t*)(C.ws + WS_BR);
#endif
    const bf16_t* Wc = (const bf16_t*)(C.ws + WS_W + (size_t)l * W_LAYER + WO_GWS);
    LAS unsigned char* lds = C.lds;
    const int lane = C.lane, w = C.wave, r32 = lane & 31, hh = lane >> 5;
    const int i16 = lane & 15, q4 = i16 >> 2, p4 = i16 & 3, blk = (lane >> 4) & 1;
    for (int u = C.bid; u < (T / 128) * 4; u += C.G) {
        const int g = u & 3, t0 = (u >> 2) * 128;
        __syncthreads();
#pragma unroll
        for (int p = 0; p < 4; ++p) { const int idx = C.tid + 512 * p, rr = idx >> 4, ch = idx & 15;
            *(LAS u32x4*)(lds + GM_WC + rr * 272 + ch * 16) = *(const u32x4*)(Wc + (size_t)g * 128 * 128 + rr * 128 + ch * 8); }
#pragma unroll
        for (int hb = 0; hb < 4; ++hb) {
            u32x4 rawv[4];
#pragma unroll
            for (int i = 0; i < 4; ++i) rawv[i] = *(const u32x4*)(H + (size_t)(t0 + w * 16 + hb * 4 + i) * NH + HC_GV + lane * 8);
            float e[4][8], st[8];
#pragma unroll
            for (int i = 0; i < 4; ++i) { float s1 = 0.f, s2 = 0.f;
#pragma unroll
                for (int j = 0; j < 4; ++j) { const float a = geluf_(bf2f(rawv[i][j] & 0xffffu)), b = geluf_(bf2f(rawv[i][j] >> 16)); e[i][2 * j] = a; e[i][2 * j + 1] = b; s1 += a + b; s2 += a * a + b * b; }
                st[i] = s1; st[4 + i] = s2; }
#pragma unroll
            for (int sx = 32, n = 4; sx >= 8; sx >>= 1, n >>= 1) { const bool up = (lane & sx) != 0;
#pragma unroll
                for (int i = 0; i < n; ++i) { const float send = up ? st[i] : st[i + n], keep = up ? st[i + n] : st[i]; st[i] = keep + __shfl_xor(send, sx, 64); } }
            float tot = st[0]; tot += __shfl_xor(tot, 4, 64); tot += __shfl_xor(tot, 2, 64); tot += __shfl_xor(tot, 1, 64);
            float mean4[4], rstd4[4];
#pragma unroll
            for (int i = 0; i < 4; ++i) {
                mean4[i] = __builtin_bit_cast(float, __builtin_amdgcn_readlane(__builtin_bit_cast(int, tot), 8 * i)) * (1.f / BW);
                const float ex2 = __builtin_bit_cast(float, __builtin_amdgcn_readlane(__builtin_bit_cast(int, tot), 8 * (4 + i))) * (1.f / BW);
                rstd4[i] = rsqrtf(fmaxf(ex2 - mean4[i] * mean4[i], 0.f) + LN_EPS);
            }
            asm volatile("" ::: "memory");
            if ((lane >> 4) == g) {
                const float* lg = C.in[I_GLNG] + l * BW + lane * 8; const float* lb = C.in[I_GLNB] + l * BW + lane * 8;
#pragma unroll
                for (int i = 0; i < 4; ++i) {
                    const float mean = mean4[i], rstd = rstd4[i];
                    u32x4 o;
#pragma unroll
                    for (int j = 0; j < 4; ++j) o[j] = cvtpk((e[i][2 * j] - mean) * rstd * lg[2 * j] + lb[2 * j], (e[i][2 * j + 1] - mean) * rstd * lg[2 * j + 1] + lb[2 * j + 1]);
                    *(LAS u32x4*)(lds + GM_VN + (w * 16 + hb * 4 + i) * 320 + (lane & 15) * 16) = o;
                }
            }
        }
        __syncthreads();
        const int nt = w & 3, mb = (w >> 2) * 2;
        f32x16 acc[2];
#pragma unroll
        for (int m = 0; m < 2; ++m)
#pragma unroll
            for (int i = 0; i < 16; ++i) acc[m][i] = 0.f;
        for (int ks = 0; ks < 2 * (nt + 1); ++ks) {
            const bf16x8 bf = *(const LAS bf16x8*)(lds + GM_WC + (32 * nt + r32) * 272 + 32 * ks + 16 * hh);
#pragma unroll
            for (int m = 0; m < 2; ++m) {
                const LAS unsigned char* aa = lds + GM_VN + (16 * ks + 8 * hh + q4) * 320 + (32 * (mb + m) + 16 * blk + 4 * p4) * 2;
                const s16x4 lo = vtr(aa), hi = vtr(aa + 4 * 320);
                acc[m] = MFMA32(__builtin_shufflevector(lo, hi, 0, 1, 2, 3, 4, 5, 6, 7), bf, acc[m]);
            }
        }
        const int tl = 32 * nt + r32, row = t0 + tl;
        const float bias = C.in[I_GBS][(l * 4 + g) * 128 + tl];
#pragma unroll
        for (int m = 0; m < 2; ++m)
#pragma unroll
            for (int q = 0; q < 4; ++q) { const int c0 = 32 * (mb + m) + 8 * q + 4 * hh;
                const u32x2 ur = *(const u32x2*)(H + (size_t)row * NH + HC_GU + g * 128 + c0);
                u32x2 o;
                o[0] = cvtpk(geluf_(bf2f(ur[0] & 0xffffu)) * (acc[m][4 * q] + bias), geluf_(bf2f(ur[0] >> 16)) * (acc[m][4 * q + 1] + bias));
                o[1] = cvtpk(geluf_(bf2f(ur[1] & 0xffffu)) * (acc[m][4 * q + 2] + bias), geluf_(bf2f(ur[1] >> 16)) * (acc[m][4 * q + 3] + bias));
                *(u32x2*)(BR + (size_t)row * NBR + 1024 + g * 128 + c0) = o; }
    }
}

#define CE_D(a, b) do { const float _h = fmaxf(a, b), _l = fminf(a, b); a = _h; b = _l; } while (0)
__device__ __forceinline__ void sort16_desc(float (&x)[16]) {
#pragma unroll
    for (int k = 2; k <= 16; k <<= 1)
#pragma unroll
        for (int j = k >> 1; j > 0; j >>= 1)
#pragma unroll
            for (int i = 0; i < 16; ++i) { const int l = i ^ j; if (l > i) { if ((i & k) == 0) CE_D(x[i], x[l]); else CE_D(x[l], x[i]); } }
}
__device__ __forceinline__ void bmerge16_desc(float (&x)[16]) {
#pragma unroll
    for (int j = 8; j > 0; j >>= 1)
#pragma unroll
        for (int i = 0; i < 16; ++i) { const int l = i ^ j; if (l > i) CE_D(x[i], x[l]); }
}
__device__ __forceinline__ void top16_merge(float (&a)[16], const float (&b)[16]) {
#pragma unroll
    for (int i = 0; i < 16; ++i) a[i] = fmaxf(a[i], b[15 - i]);
    bmerge16_desc(a);
}
__device__ __forceinline__ float pack_idx(float v, unsigned idx, unsigned mask) { return __builtin_bit_cast(float, (__builtin_bit_cast(unsigned, v) & ~mask) | idx); }

constexpr int TK_KST = 272, TK_KBUF = 128 * TK_KST;
__device__ __forceinline__ void p_topk(const Ctx& C, int l) {
    const bf16_t* Q = (const bf16_t*)(C.ws + WS_Q);
    const bf16_t* keys = (const bf16_t*)(C.ws + WS_W + (size_t)l * W_LAYER + WO_KEYS);
    int* eidx = (int*)(C.ws + WS_EIDX); float* egate = (float*)(C.ws + WS_EGATE);
    LAS unsigned char* lds = C.lds;
    const int lane = C.lane, w = C.wave, r32 = lane & 31, hh = lane >> 5;
    for (int u = C.bid; u < (T / 256) * PH; u += C.G) {
        const int h = u & 7, t0 = (u >> 3) * 256, tok = t0 + 32 * w + r32;
        float v12[2][16];
        __syncthreads();
#pragma unroll
        for (int j = 0; j < 2; ++j) {
            const bf16_t* kp = keys + ((size_t)j * PH + h) * 128 * 128;
#pragma unroll
            for (int p = 0; p < 4; ++p) { const int idx = C.tid + 512 * p, row = idx >> 4, ch = idx & 15;
                *(LAS u32x4*)(lds + j * TK_KBUF + row * TK_KST + ch * 16) = *(const u32x4*)(kp + row * 128 + ch * 8); }
        }
        __syncthreads();
#pragma unroll
        for (int j = 0; j < 2; ++j) {
            bf16x8 qf[8];
            {
                LAS unsigned char* qs = lds + 2 * TK_KBUF + w * (32 * 272);
                u32x4 qr[8];
#pragma unroll
                for (int p = 0; p < 8; ++p) qr[p] = *(const u32x4*)(Q + (size_t)(t0 + 32 * w + 4 * p + (lane >> 4)) * NQ + h * 256 + j * 128 + (lane & 15) * 8);
#pragma unroll
                for (int p = 0; p < 8; ++p) *(LAS u32x4*)(qs + (4 * p + (lane >> 4)) * 272 + (lane & 15) * 16) = qr[p];
#pragma unroll
                for (int ks = 0; ks < 8; ++ks) qf[ks] = *(const LAS bf16x8*)(qs + r32 * 272 + 32 * ks + 16 * hh);
            }
            f32x16 sacc[4];
#pragma unroll
            for (int mt = 0; mt < 4; ++mt)
#pragma unroll
                for (int i = 0; i < 16; ++i) sacc[mt][i] = 0.f;
#pragma unroll
            for (int ks = 0; ks < 8; ++ks)
#pragma unroll
                for (int mt = 0; mt < 4; ++mt) {
                    const bf16x8 kf = *(const LAS bf16x8*)(lds + j * TK_KBUF + (32 * mt + r32) * TK_KST + 32 * ks + 16 * hh);
                    sacc[mt] = MFMA32(kf, qf[ks], sacc[mt]);
                }
            float g[4][16];
#pragma unroll
            for (int mt = 0; mt < 4; ++mt) {
#pragma unroll
                for (int i = 0; i < 16; ++i) g[mt][i] = pack_idx(sacc[mt][i], (unsigned)(32 * mt + (i & 3) + 8 * (i >> 2) + 4 * hh), 127u);
                sort16_desc(g[mt]);
            }
            top16_merge(g[0], g[1]); top16_merge(g[2], g[3]); top16_merge(g[0], g[2]);
            float o[16];
#pragma unroll
            for (int i = 0; i < 16; ++i) o[i] = __shfl_xor(g[0][i], 32, 64);
            top16_merge(g[0], o);
#pragma unroll
            for (int i = 0; i < 16; ++i) v12[j][i] = g[0][i];
        }
        float c[4][16];
        {
            int n = 0;
#pragma unroll
            for (int a = 0; a < 16; ++a)
#pragma unroll
                for (int b = 0; b < 16; ++b) if ((a + 1) * (b + 1) <= 16) {
                    const unsigned id = ((__builtin_bit_cast(unsigned, v12[0][a]) & 127u) << 7) | (__builtin_bit_cast(unsigned, v12[1][b]) & 127u);
                    c[n >> 4][n & 15] = pack_idx(v12[0][a] + v12[1][b], id, 16383u); ++n; }
#pragma unroll
            for (; n < 64; ++n) c[n >> 4][n & 15] = -3.0e38f;
        }
#pragma unroll
        for (int q = 0; q < 4; ++q) sort16_desc(c[q]);
        top16_merge(c[0], c[1]); top16_merge(c[2], c[3]); top16_merge(c[0], c[2]);
        float e[16], den = 0.f;
#pragma unroll
        for (int i = 0; i < 16; ++i) { e[i] = __expf(c[0][i] - c[0][0]); den += e[i]; }
        const float inv = 1.f / den;
        int* ip = eidx + (size_t)tok * 128 + h * 16 + 8 * hh; float* gp = egate + (size_t)tok * 128 + h * 16 + 8 * hh;
        u32x4 i0, i1; f32x4 g0, g1;
#pragma unroll
        for (int i = 0; i < 4; ++i) {
            const float ca = hh ? c[0][8 + i] : c[0][i], cb = hh ? c[0][12 + i] : c[0][4 + i];
            i0[i] = __builtin_bit_cast(unsigned, ca) & 16383u; i1[i] = __builtin_bit_cast(unsigned, cb) & 16383u;
            g0[i] = (hh ? e[8 + i] : e[i]) * inv; g1[i] = (hh ? e[12 + i] : e[4 + i]) * inv;
        }
        *(u32x4*)ip = i0; *(u32x4*)(ip + 4) = i1; *(f32x4*)gp = g0; *(f32x4*)(gp + 4) = g1;
    }
}

constexpr int CW_DIAG = 64;
__device__ __forceinline__ void diag_cmp(const Ctx& C, const bf16_t* A, int lda, const bf16_t* R, int ldr, int nc) {
    float sd = 0.f, sr = 0.f;
    for (int row = C.bid; row < T; row += C.G) {
        const int tm = row % DIAG_MOD; if (tm < DIAG_LO || tm >= DIAG_HI) continue;
        for (int c = C.tid; c < nc; c += 512) { const float a = bf2f(A[(size_t)row * lda + c]), r = bf2f(R[(size_t)row * ldr + c]); sd += (a - r) * (a - r); sr += r * r; }
    }
    sd = wave_sum(sd); sr = wave_sum(sr);
    if (C.lane == 0) { atomicAdd((float*)(C.ws + WS_CTL) + CW_DIAG, sd); atomicAdd((float*)(C.ws + WS_CTL) + CW_DIAG + 1, sr); }
}
__device__ __forceinline__ float diag_alpha(const Ctx& C) {
    const float sd = __hip_atomic_load((float*)(C.ws + WS_CTL) + CW_DIAG, __ATOMIC_RELAXED, __HIP_MEMORY_SCOPE_AGENT), sr = __hip_atomic_load((float*)(C.ws + WS_CTL) + CW_DIAG + 1, __ATOMIC_RELAXED, __HIP_MEMORY_SCOPE_AGENT);
    const float err = fmaxf(sd / fmaxf(sr, 1e-30f), 1e-8f);
    return 0.1f + 0.1f * (rintf(log10f(err / 1e-8f) * 10.f) * 0.1f);
}

__device__ __forceinline__ void wave_argmax(float& v, int& i) {
#pragma unroll
    for (int o = 32; o > 0; o >>= 1) {
        const float ov = __shfl_xor(v, o, 64); const int oi = __shfl_xor(i, o, 64);
        if (ov > v || (ov == v && oi < i)) { v = ov; i = oi; }
    }
}
__device__ __forceinline__ void p_topk_naive(const Ctx& C, int l) {
    const bf16_t* Q = (const bf16_t*)(C.ws + WS_Q);
    const bf16_t* keys = (const bf16_t*)(C.ws + WS_W + (size_t)l * W_LAYER + WO_KEYS);
    int* eidx = (int*)(C.ws + WS_EIDX); float* egate = (float*)(C.ws + WS_EGATE);
    LAS float* qs = (LAS float*)C.lds;
    LAS float* sc = qs + 2048;
    LAS float* tv = sc + 2048;
    LAS int* ti = (LAS int*)(tv + 256);
    for (int t = C.bid; t < T; t += C.G) {
        for (int i = C.tid; i < 2048; i += 512) qs[i] = bf2f(Q[(size_t)t * NQ + i]);
        __syncthreads();
        for (int i = 0; i < 4; ++i) {
            const int idx = C.tid + 512 * i, hj = idx >> 7, key = idx & 127, h = hj >> 1, j = hj & 1;
            const bf16_t* kp = keys + (((size_t)j * PH + h) * 128 + key) * 128;
            float s = 0.f;
            for (int d8 = 0; d8 < 16; ++d8) {
                const u32x4 raw = *(const u32x4*)(kp + d8 * 8);
#pragma unroll
                for (int e = 0; e < 4; ++e) s += qs[h * 256 + j * 128 + d8 * 8 + 2 * e] * bf2f(raw[e] & 0xffffu) + qs[h * 256 + j * 128 + d8 * 8 + 2 * e + 1] * bf2f(raw[e] >> 16);
            }
            sc[idx] = s;
        }
        __syncthreads();
        for (int i = 0; i < 2; ++i) {
            const int hj = C.wave * 2 + i;
            float a0 = sc[hj * 128 + C.lane], a1 = sc[hj * 128 + 64 + C.lane];
            for (int r = 0; r < 16; ++r) {
                float bv; int bi;
                if (a0 > a1 || (a0 == a1)) { bv = a0; bi = C.lane; } else { bv = a1; bi = C.lane + 64; }
                wave_argmax(bv, bi);
                if (C.lane == 0) { tv[hj * 16 + r] = bv; ti[hj * 16 + r] = bi; }
                if (bi == C.lane) a0 = -3e38f; if (bi == C.lane + 64) a1 = -3e38f;
            }
        }
        __syncthreads();
        {
            const int h = C.wave;
            float cv[4];
#pragma unroll
            for (int i = 0; i < 4; ++i) { const int c = C.lane * 4 + i; cv[i] = tv[(h * 2) * 16 + (c >> 4)] + tv[(h * 2 + 1) * 16 + (c & 15)]; }
            float topv = 0.f; int tope = 0; float mx = 0.f;
            for (int r = 0; r < 16; ++r) {
                float bv = cv[0]; int bi = C.lane * 4;
#pragma unroll
                for (int i = 1; i < 4; ++i) if (cv[i] > bv) { bv = cv[i]; bi = C.lane * 4 + i; }
                wave_argmax(bv, bi);
                if (r == 0) mx = bv;
                if (C.lane == r) { topv = bv; tope = ti[(h * 2) * 16 + (bi >> 4)] * 128 + ti[(h * 2 + 1) * 16 + (bi & 15)]; }
#pragma unroll
                for (int i = 0; i < 4; ++i) if (bi == C.lane * 4 + i) cv[i] = -3e38f;
            }
            float e = (C.lane < 16) ? __expf(topv - mx) : 0.f;
            const float den = wave_sum(e);
            if (C.lane < 16) { eidx[(size_t)t * 128 + h * 16 + C.lane] = tope; egate[(size_t)t * 128 + h * 16 + C.lane] = e / den; }
        }
        __syncthreads();
    }
}
__device__ __forceinline__ float ub(unsigned w, int e) { return (float)((w >> (8 * e)) & 255u); }
__device__ __forceinline__ void p_gather(const Ctx& C, int l) {
    const bf16_t* xc = (const bf16_t*)(C.ws + WS_X1B);
    const unsigned char* U8 = C.ws + WS_U8; const unsigned char* V8 = C.ws + WS_V8;
    const float* SU = (const float*)(C.ws + WS_SU); const float* SV = (const float*)(C.ws + WS_SV);
    const int* eidx = (const int*)(C.ws + WS_EIDX); const float* egate = (const float*)(C.ws + WS_EGATE);
    const int lane = C.lane;
    for (int t = C.bid * 8 + C.wave; t < T; t += C.G * 8) {
        float x[16];
        { const bf16_t* xp = xc + (size_t)t * DM + lane * 16;
          const u32x4 a = *(const u32x4*)xp, b = *(const u32x4*)(xp + 8);
#pragma unroll
          for (int i = 0; i < 4; ++i) { x[2 * i] = bf2f(a[i] & 0xffffu); x[2 * i + 1] = bf2f(a[i] >> 16); x[8 + 2 * i] = bf2f(b[i] & 0xffffu); x[9 + 2 * i] = bf2f(b[i] >> 16); } }
        float xmx = 0.f;
#pragma unroll
        for (int j = 0; j < 16; ++j) xmx = fmaxf(xmx, fabsf(x[j]));
        xmx = fmaxf(wave_max(xmx), 1e-30f);
        const float xisc = 127.f / xmx, xsc = xmx * (1.f / 127.f);
        int xq[4];
#pragma unroll
        for (int q = 0; q < 4; ++q) { unsigned wd = 0u;
#pragma unroll
            for (int e = 0; e < 4; ++e) wd |= ((unsigned)(int)rintf(x[4 * q + e] * xisc) & 255u) << (8 * e);
            xq[q] = (int)wd; }
        float cf[2]; int ex[2];
#pragma unroll
        for (int bt = 0; bt < 2; ++bt) {
            ex[bt] = eidx[(size_t)t * 128 + 64 * bt + lane];
            const float gate = egate[(size_t)t * 128 + 64 * bt + lane];
            int p[64];
#pragma unroll
            for (int e0 = 0; e0 < 64; e0 += 16) {
                u32x4 r[16];
#pragma unroll
                for (int i = 0; i < 16; ++i) { const int e = __builtin_amdgcn_readlane(ex[bt], e0 + i); r[i] = *(const u32x4*)(U8 + (size_t)e * DM + lane * 16); }
#pragma unroll
                for (int i = 0; i < 16; ++i) { int a = 0;
#pragma unroll
                    for (int q = 0; q < 4; ++q) a = __builtin_amdgcn_sdot4(xq[q], (int)r[i][q], a, false);
                    p[e0 + i] = a; }
            }
#pragma unroll
            for (int st = 32, n = 32; st > 0; st >>= 1, n >>= 1) {
                const bool up = (lane & st) != 0;
#pragma unroll
                for (int i = 0; i < n; ++i) { const int send = up ? p[i] : p[i + n], keep = up ? p[i + n] : p[i]; p[i] = keep + __shfl_xor(send, st, 64); }
            }
            const float hsum = SU[ex[bt]] * xsc * (float)p[0];
            cf[bt] = gate * geluf_slow(hsum) * SV[ex[bt]];
        }
        float y[16];
#pragma unroll
        for (int j = 0; j < 16; ++j) y[j] = 0.f;
        float csum = wave_sum(cf[0] + cf[1]);
#pragma unroll
        for (int bt = 0; bt < 2; ++bt)
#pragma unroll
            for (int e0 = 0; e0 < 64; e0 += 16) {
                u32x4 r[16];
#pragma unroll
                for (int i = 0; i < 16; ++i) { const int e = __builtin_amdgcn_readlane(ex[bt], e0 + i); r[i] = *(const u32x4*)(V8 + (size_t)e * DM + lane * 16); }
#pragma unroll
                for (int i = 0; i < 16; ++i) { const float c = __builtin_bit_cast(float, __builtin_amdgcn_readlane(__builtin_bit_cast(int, cf[bt]), e0 + i));
#pragma unroll
                    for (int q = 0; q < 4; ++q)
#pragma unroll
                        for (int e = 0; e < 4; ++e) y[4 * q + e] += c * ub(r[i][q], e); }
            }
#pragma unroll
        for (int j = 0; j < 16; ++j) y[j] = y[j] - 128.f * csum + ALPHA * x[j];
        float sm = 0.f;
#pragma unroll
        for (int j = 0; j < 16; ++j) sm += y[j];
        const float mean = wave_sum(sm) * (1.f / DM);
        float qq = 0.f;
#pragma unroll
        for (int j = 0; j < 16; ++j) { const float d = y[j] - mean; qq += d * d; }
        const float rstd = rsqrtf(wave_sum(qq) * (1.f / DM) + LN_EPS);
        const float* gp = C.in[I_LN2G] + l * DM + lane * 16; const float* bp = C.in[I_LN2B] + l * DM + lane * 16;
#pragma unroll
        for (int i = 0; i < 4; ++i) { const f32x4 gg = *(const f32x4*)(gp + 4 * i), bb = *(const f32x4*)(bp + 4 * i);
#pragma unroll
            for (int e = 0; e < 4; ++e) y[4 * i + e] = (y[4 * i + e] - mean) * rstd * gg[e] + bb[e]; }
        float* dst = (l + 1 < DEPTH) ? (float*)(C.ws + WS_XA) + (size_t)t * DM : C.out + (size_t)t * DM;
#if DIAG
        if (l + 1 == DEPTH) { const float al = 1.f + diag_alpha(C);
#pragma unroll
            for (int j = 0; j < 16; ++j) y[j] *= al; }
#endif
#pragma unroll
        for (int i = 0; i < 4; ++i) *(f32x4*)(dst + lane * 16 + 4 * i) = (f32x4){y[4 * i], y[4 * i + 1], y[4 * i + 2], y[4 * i + 3]};
        if (l + 1 < DEPTH) {
            bf16_t* xb = (bf16_t*)(C.ws + WS_XB) + (size_t)t * DM + lane * 16;
            u32x4 o0, o1;
#pragma unroll
            for (int j = 0; j < 4; ++j) { o0[j] = pk2(y[2 * j], y[2 * j + 1]); o1[j] = pk2(y[8 + 2 * j], y[9 + 2 * j]); }
            *(u32x4*)xb = o0; *(u32x4*)(xb + 8) = o1;
            const float* wf = (const float*)(C.ws + WS_W + (size_t)(l + 1) * W_LAYER + WO_WF);
            float* lsig = (float*)(C.ws + WS_MISC);
#pragma unroll
            for (int h = 0; h < 4; ++h) {
                float sd = 0.f;
#pragma unroll
                for (int i = 0; i < 4; ++i) { const f32x4 a = *(const f32x4*)(wf + h * DM + lane * 16 + 4 * i);
#pragma unroll
                    for (int e = 0; e < 4; ++e) sd += y[4 * i + e] * a[e]; }
                sd = wave_sum(sd);
                if (lane == 0) lsig[(size_t)t * 4 + h] = logsigmoidf_(sd + C.in[I_BFOX][(l + 1) * 4 + h]);
            }
        }
    }
}

struct FStoreBf16 { bf16_t* O; int ld;
    __device__ __forceinline__ void operator()(int row, int col, f32x4 v0, f32x4 v1, int) const {
        u32x4 o; o[0] = pk2(v0[0], v0[1]); o[1] = pk2(v0[2], v0[3]); o[2] = pk2(v1[0], v1[1]); o[3] = pk2(v1[2], v1[3]);
        *(u32x4*)(O + (size_t)row * ld + col) = o; } };
struct FGate { bf16_t* O; const float* bias;
    __device__ __forceinline__ void operator()(int row, int col, f32x4 v0, f32x4 v1, int) const {
        const f32x4 b0 = *(const f32x4*)(bias + col), b1 = *(const f32x4*)(bias + col + 4);
        u32x4 o; o[0] = pk2(sigmoidf_(v0[0] + b0[0]), sigmoidf_(v0[1] + b0[1])); o[1] = pk2(sigmoidf_(v0[2] + b0[2]), sigmoidf_(v0[3] + b0[3]));
        o[2] = pk2(sigmoidf_(v1[0] + b1[0]), sigmoidf_(v1[1] + b1[1])); o[3] = pk2(sigmoidf_(v1[2] + b1[2]), sigmoidf_(v1[3] + b1[3]));
        *(u32x4*)(O + (size_t)row * NG + col) = o; } };
struct FMerge { const bf16_t* G; bf16_t* MG;
    __device__ __forceinline__ void operator()(int row, int col, f32x4 v0, f32x4 v1, int z) const {
        const u32x4 gr = *(const u32x4*)(G + (size_t)row * NG + z * DM + col);
        float r[8];
#pragma unroll
        for (int e = 0; e < 4; ++e) { const float a = (e < 2) ? v0[2 * e] : v1[2 * e - 4], b = (e < 2) ? v0[2 * e + 1] : v1[2 * e - 3];
            r[2 * e] = a * bf2f(gr[e] & 0xffffu); r[2 * e + 1] = b * bf2f(gr[e] >> 16); }
        bf16_t* p = MG + (size_t)row * DM + col;
        if (z > 0) { const u32x4 pr = *(const u32x4*)p;
#pragma unroll
            for (int e = 0; e < 4; ++e) { r[2 * e] += bf2f(pr[e] & 0xffffu); r[2 * e + 1] += bf2f(pr[e] >> 16); } }
        u32x4 o;
#pragma unroll
        for (int e = 0; e < 4; ++e) o[e] = pk2(r[2 * e], r[2 * e + 1]);
        *(u32x4*)p = o; } };
struct FResid { const float* X; bf16_t* Y;
    __device__ __forceinline__ void operator()(int row, int col, f32x4 v0, f32x4 v1, int) const {
        const f32x4 x0 = *(const f32x4*)(X + (size_t)row * DM + col), x1 = *(const f32x4*)(X + (size_t)row * DM + col + 4);
        u32x4 o; o[0] = cvtpk(x0[0] * ALPHA + v0[0], x0[1] * ALPHA + v0[1]); o[1] = cvtpk(x0[2] * ALPHA + v0[2], x0[3] * ALPHA + v0[3]);
        o[2] = cvtpk(x1[0] * ALPHA + v1[0], x1[1] * ALPHA + v1[1]); o[3] = cvtpk(x1[2] * ALPHA + v1[2], x1[3] * ALPHA + v1[3]);
        *(u32x4*)(Y + (size_t)row * DM + col) = o; } };

constexpr int PH_PER_LAYER = 12, N_PHASES = 1 + DEPTH * PH_PER_LAYER;
template <int SP> __device__ __forceinline__ void run_phase(const Ctx& C0, int l) {
    Ctx C = C0;
    asm volatile("" : "+v"(C.tid));
    C.ws = launder_ptr(C.ws); C.out = launder_ptr(C.out); l = (int)launder_u((unsigned)l);
    C.lane = C.tid & 63; C.wave = __builtin_amdgcn_readfirstlane(C.tid >> 6);
    unsigned char* wb = C.ws + WS_W + (size_t)l * W_LAYER;
    if constexpr (SP == -1) { p_conv_weights(C); }
    if constexpr (SP == 0) {
        if (l == 0) p_rowpass0(C);
    }
    if constexpr (SP == 1) {
        p_cumsum(C);
        __syncthreads();
        pg8::Gemm g{(const bf16_t*)(C.ws + WS_XB), (const bf16_t*)(wb + WO_WIN), DM, DM, DM, 0, 0};
        pg8::StaticOrder S; S.init(T, NH, C.G, C.bid);
        pg8::Epi8<FStoreBf16> E{{(bf16_t*)(C.ws + WS_H), NH}};
        pg8::gemm_phase(C.lds, g, S, E, C.tid);
    }
    if constexpr (SP == 2) { p_knorm(C, l); if (l != HG_NAIVE_L) hgrn_b1(C, l); }
#if MIX_NAIVE
    if constexpr (SP == 3) { if (l != HG_NAIVE_L) hgrn_b2(C); mix_pool_naive(C, l); mix_gmlp_naive(C, l); }
#else
    if constexpr (SP == 3) { if (l != HG_NAIVE_L) hgrn_b2(C); mix_pool(C, l); mix_gmlp(C, l);
        if (DIAG == 2) mix_pool_naive(C, l); if (DIAG == 3) mix_gmlp_naive(C, l); }
#endif
#if DIAG == 1
    if constexpr (SP == 4) { hgrn_b3(C, l); { mix_hgrn_naive(C, l); __syncthreads(); } mix_fox(C, l); }
    if constexpr (SP == 5) { if (l == DIAG_LAYER) diag_cmp(C, (const bf16_t*)(C.ws + (DIAG_LAYER == 0 ? WS_XA : WS_TABU)) + 512, NBR, (const bf16_t*)(C.ws + WS_BR) + 512, NBR, 512); }
#elif DIAG == 2 || DIAG == 3
    if constexpr (SP == 4) { hgrn_b3(C, l); mix_fox(C, l); if (l == DIAG_LAYER) diag_cmp(C, (const bf16_t*)(C.ws + (DIAG_LAYER == 0 ? WS_XA : WS_TABU)) + (DIAG == 2 ? 0 : 1024), NBR, (const bf16_t*)(C.ws + WS_BR) + (DIAG == 2 ? 0 : 1024), NBR, 512); }
#else
    if constexpr (SP == 4) { if (l != HG_NAIVE_L) hgrn_b3(C, l); else { mix_hgrn_naive(C, l); __syncthreads(); } mix_fox(C, l); }
#endif
    if constexpr (SP == 5) {
        pg8::Gemm g{(const bf16_t*)(C.ws + WS_XB), (const bf16_t*)(wb + WO_WG), DM, DM, DM, 0, 0};
        pg8::StaticOrder S; S.init(T, NG, C.G, C.bid);
        pg8::Epi8<FGate> E{{(bf16_t*)(C.ws + WS_G), C.in[I_BGATE] + l * NG}};
        pg8::gemm_phase(C.lds, g, S, E, C.tid);
    }
    if constexpr (SP == 6) {
        pg8::Gemm g{(const bf16_t*)(C.ws + WS_BR), (const bf16_t*)(wb + WO_WBR), NBR, BW, BW, (size_t)BW, (size_t)DM * BW};
        pg8::ZOrder S; S.init(T, DM, 4, C.G, C.vcu);
        pg8::Epi8<FMerge> E{{(const bf16_t*)(C.ws + WS_G), (bf16_t*)(C.ws + WS_XB)}};
        pg8::gemm_phase(C.lds, g, S, E, C.tid);
    }
    if constexpr (SP == 7) {
        const float* xin = (l == 0) ? C.in[I_X] : (const float*)(C.ws + WS_XA);
        pg8::Gemm g{(const bf16_t*)(C.ws + WS_XB), (const bf16_t*)(wb + WO_WOUT), DM, DM, DM, 0, 0};
        pg8::StaticOrder S; S.init(T, DM, C.G, C.bid);
        pg8::Epi8<FResid> E{{xin, (bf16_t*)(C.ws + WS_XC)}};
        pg8::gemm_phase(C.lds, g, S, E, C.tid);
    }
    if constexpr (SP == 8) { p_ln1(C, l); p_conv_tables(C, l); }
    if constexpr (SP == 9) {
        pg8::Gemm g{(const bf16_t*)(C.ws + WS_X1B), (const bf16_t*)(wb + WO_WQ), DM, DM, DM, 0, 0};
        pg8::StaticOrder S; S.init(T, NQ, C.G, C.bid);
        pg8::Epi8<FStoreBf16> E{{(bf16_t*)(C.ws + WS_Q), NQ}};
        pg8::gemm_phase(C.lds, g, S, E, C.tid);
    }
#if TOPK_NAIVE
    if constexpr (SP == 10) p_topk_naive(C, l);
#else
    if constexpr (SP == 10) p_topk(C, l);
#endif
    if constexpr (SP == 11) p_gather(C, l);
}
__device__ __forceinline__ void make_ctx(Ctx& C, const Args& args, unsigned char* lds_raw) {
    C.lds = (LAS unsigned char*)lds_raw; C.ws = args.ws; C.in = args.in; C.out = args.out;
    C.tid = threadIdx.x; C.lane = C.tid & 63; C.wave = __builtin_amdgcn_readfirstlane(C.tid >> 6);
    C.G = gridDim.x; C.bid = blockIdx.x; C.vcu = (C.G % 8 == 0) ? (C.bid % 8) * (C.G / 8) + C.bid / 8 : C.bid;
}
#if !MK_ONE_LAUNCH
template <int SP> __global__ void __launch_bounds__(512, 2) mk_phase(Args args) {
    extern __shared__ __attribute__((aligned(16))) unsigned char lds_raw[];
    Ctx C; make_ctx(C, args, lds_raw);
    run_phase<SP>(C, args.ph_lo);
}
#endif

#define GRID_BAR() xcd_barrier((unsigned*)(args.ws + WS_CTL) + 1024, (volatile LAS unsigned*)((LAS unsigned char*)lds_raw + LDSCTL_OFF + 32))
__global__ void __launch_bounds__(512, 2) mk_fwd(Args args) {
    extern __shared__ __attribute__((aligned(16))) unsigned char lds_raw[];
    Ctx C; make_ctx(C, args, lds_raw);
    { volatile LAS unsigned* misc = (volatile LAS unsigned*)(C.lds + LDSCTL_OFF); if (C.tid < 64) misc[C.tid] = 0u; }
    __syncthreads();
    xcd_barrier_post((unsigned*)(args.ws + WS_CTL) + 1024);
    run_phase<-1>(C, 0); GRID_BAR();
#pragma unroll 1
    for (int l = 0; l < DEPTH; ++l) {
        if (l == 0) { run_phase<0>(C, l); GRID_BAR(); }
        run_phase<1>(C, l); GRID_BAR();
        run_phase<2>(C, l); GRID_BAR();
        run_phase<3>(C, l); GRID_BAR();
        run_phase<4>(C, l); GRID_BAR();
        run_phase<5>(C, l); GRID_BAR();
        run_phase<6>(C, l); GRID_BAR();
        run_phase<7>(C, l); GRID_BAR();
        run_phase<8>(C, l); GRID_BAR();
        run_phase<9>(C, l); GRID_BAR();
        run_phase<10>(C, l); GRID_BAR();
        run_phase<11>(C, l); if (l + 1 < DEPTH) GRID_BAR();
    }
}

#if !MK_ONE_LAUNCH
template <int SP> static void launch_phase(const Args& a, int grid, hipStream_t stream) {
    static bool attr_done = false;
    if (!attr_done) { (void)hipFuncSetAttribute((const void*)mk_phase<SP>, hipFuncAttributeMaxDynamicSharedMemorySize, LDS_BYTES); attr_done = true; }
    hipLaunchKernelGGL(mk_phase<SP>, dim3(grid), dim3(512), LDS_BYTES, stream, a);
}
#endif
extern "C" void kernel_launch(void* const* d_in, const int* in_sizes, int n_in, void* d_out, int out_size, void* d_ws, size_t ws_size, hipStream_t stream) {
    static int grid = 0;
    if (grid == 0) {
        if (n_in != NIN_PTRS || out_size != T * DM || ws_size < WS_END) { fprintf(stderr, "kernel_launch: unexpected shapes n_in %d out %d ws %zu\n", n_in, out_size, ws_size); grid = -1; return; }
        int dev = 0, cus = 0;
        if (hipGetDevice(&dev) != hipSuccess || hipDeviceGetAttribute(&cus, hipDeviceAttributeMultiprocessorCount, dev) != hipSuccess) { grid = -1; return; }
        grid = cus;
    }
    if (grid < 0) return;
    (void)hipMemsetAsync((char*)d_ws + WS_CTL, 0, CTL_ZERO_BYTES, stream);
    Args a{};
    for (int i = 0; i < NIN_PTRS; ++i) a.in[i] = (const float*)d_in[i];
    a.out = (float*)d_out; a.ws = (unsigned char*)d_ws; a.bar_slot = 0; a.pad = 0; a.ph_hi = 0;
#if MK_ONE_LAUNCH
    static bool attr_done = false;
    if (!attr_done) { (void)hipFuncSetAttribute((const void*)mk_fwd, hipFuncAttributeMaxDynamicSharedMemorySize, LDS_BYTES); attr_done = true; }
    hipLaunchKernelGGL(mk_fwd, dim3(grid), dim3(512), LDS_BYTES, stream, a);
    return;
#endif
#if !MK_ONE_LAUNCH
    a.ph_lo = 0; launch_phase<-1>(a, grid, stream);
    for (int l = 0; l < DEPTH; ++l) {
        a.ph_lo = l;
        launch_phase<0>(a, grid, stream); launch_phase<1>(a, grid, stream); launch_phase<2>(a, grid, stream); launch_phase<3>(a, grid, stream); launch_phase<4>(a, grid, stream);
        launch_phase<5>(a, grid, stream); launch_phase<6>(a, grid, stream); launch_phase<7>(a, grid, stream); launch_phase<8>(a, grid, stream); launch_phase<9>(a, grid, stream); launch_phase<10>(a, grid, stream); launch_phase<11>(a, grid, stream);
    }
#endif
}
```

```cpp
#include <hip/hip_runtime.h>
#include <cstdio>
#include <cstdint>

#ifndef DIAG
#define DIAG 0
#endif
#ifndef DIAG_LO
#define DIAG_LO 0
#endif
#ifndef DIAG_HI
#define DIAG_HI 64
#endif
#ifndef DIAG_MOD
#define DIAG_MOD 64
#endif
#ifndef TOPK_NAIVE
#define TOPK_NAIVE 0
#endif
#ifndef MIX_NAIVE
#define MIX_NAIVE 0
#endif
#ifndef DIAG_N0
#define DIAG_N0 4096
#endif
#ifndef FOX_NAIVE
#define FOX_NAIVE 0
#endif
#ifndef HG_NAIVE_L
#define HG_NAIVE_L 99
#endif
#ifndef DIAG_LAYER
#define DIAG_LAYER 0
#endif
#ifndef MK_ONE_LAUNCH
#define MK_ONE_LAUNCH 1
#endif

#define LAS __attribute__((address_space(3)))
#define GAS __attribute__((address_space(1)))
typedef unsigned short bf16_t;
typedef short bf16x8 __attribute__((ext_vector_type(8)));
typedef float f32x4 __attribute__((ext_vector_type(4)));
typedef float f32x2 __attribute__((ext_vector_type(2)));
typedef unsigned u32x4 __attribute__((ext_vector_type(4)));
typedef unsigned u32x2 __attribute__((ext_vector_type(2)));

constexpr int DM = 1024, BATCH = 2, SEQ = 8192, DEPTH = 2, T = BATCH * SEQ;
constexpr int BW = 512, NIN = 5124, NH = 5120, NG = 4096, NBR = 2048, NQ = 2048;
constexpr int NEXP = 16384, TOPK = 16, PH = 8;
constexpr float ALPHA = 1.4142135623730951f;
constexpr float LN_EPS = 1e-5f, RMS_EPS = 1e-6f;
constexpr int HC_P = 0, HC_HQ = 512, HC_HF = 1024, HC_HI = 1536, HC_HG = 2048, HC_GU = 2560, HC_GV = 3072, HC_FQ = 3584, HC_FK = 4096, HC_FV = 4608;

constexpr size_t MiB = 1u << 20;
constexpr size_t WS_CTL = 0, CTL_ZERO_BYTES = 160 * 1024;
constexpr size_t WS_CMAX = 64 * 1024;
constexpr size_t WS_MISC = 512 * 1024;
constexpr size_t WS_CUM = 768 * 1024;
constexpr size_t WS_W = 1 * MiB;
constexpr size_t W_LAYER = 30 * MiB;
constexpr size_t WO_WIN = 0, WO_WG = 10 * MiB, WO_WBR = 18 * MiB, WO_WOUT = 22 * MiB, WO_WQ = 24 * MiB, WO_KEYS = 28 * MiB, WO_WF = 28 * MiB + 512 * 1024, WO_POOLW = 28 * MiB + 768 * 1024, WO_GWS = 29 * MiB, WO_CS = 29 * MiB + 512 * 1024;
constexpr size_t WS_TABU = 64 * MiB, WS_TABV = 96 * MiB;
constexpr size_t WS_XA = 128 * MiB;
constexpr size_t WS_XB = 192 * MiB;
constexpr size_t WS_X1B = 224 * MiB;
constexpr size_t WS_H = 256 * MiB;
constexpr size_t WS_ST = 416 * MiB;
constexpr size_t WS_BR = 448 * MiB;
constexpr size_t WS_G = 256 * MiB;
constexpr size_t WS_MGF = 384 * MiB;
constexpr size_t WS_XC = 256 * MiB;
constexpr size_t WS_Q = 320 * MiB;
constexpr size_t WS_EIDX = 384 * MiB, WS_EGATE = 392 * MiB;
constexpr size_t WS_XSA = 256 * 1024;
constexpr size_t WS_END = 512 * MiB;

__device__ __forceinline__ float bf2f(unsigned u) { return __builtin_bit_cast(float, u << 16); }
__device__ __forceinline__ unsigned f2bf(float f) { unsigned u = __builtin_bit_cast(unsigned, f); return (u + 0x7fffu + ((u >> 16) & 1u)) >> 16; }
typedef __bf16 bf16x2_t __attribute__((ext_vector_type(2)));
__device__ __forceinline__ unsigned cvtpk(float lo, float hi) { f32x2 v = {lo, hi}; bf16x2_t b = __builtin_convertvector(v, bf16x2_t); return __builtin_bit_cast(unsigned, b); }
__device__ __forceinline__ unsigned pk2(float lo, float hi) { return cvtpk(lo, hi); }
__device__ __forceinline__ float wave_sum(float v) {
#pragma unroll
    for (int o = 32; o > 0; o >>= 1) v += __shfl_xor(v, o, 64);
    return v;
}
__device__ __forceinline__ float sigmoidf_(float x) { return __builtin_amdgcn_rcpf(1.f + __builtin_amdgcn_exp2f(-1.4426950408889634f * x)); }
__device__ __forceinline__ float siluf_(float x) { return x * __builtin_amdgcn_rcpf(1.f + __builtin_amdgcn_exp2f(-1.4426950408889634f * x)); }
__device__ __forceinline__ float geluf_slow(float x) { const float u = 0.7978845608028654f * (x + 0.044715f * x * x * x); return 0.5f * x * (1.f + tanhf(u)); }
__device__ __forceinline__ float geluf_(float x) { const float u2 = -2.302208198f * (x + 0.044715f * x * x * x); return x * __builtin_amdgcn_rcpf(1.f + __builtin_amdgcn_exp2f(u2)); }
__device__ __forceinline__ float logsigmoidf_(float z) { return fminf(z, 0.f) - log1pf(__expf(-fabsf(z))); }

__device__ __forceinline__ unsigned launder_u(unsigned x) { asm volatile("" : "+v"(x)); return __builtin_amdgcn_readfirstlane(x); }
template <class P> __device__ __forceinline__ P launder_ptr(P p) {
    const unsigned lo = launder_u((unsigned)(uintptr_t)p), hi = launder_u((unsigned)((uintptr_t)p >> 32));
    return (P)(((uintptr_t)hi << 32) | lo);
}

namespace pg8 {
constexpr int BM = 256, BK = 64, HALF = 128, HTB = HALF * BK * 2, STAGE_BYTES = 8 * HTB, NXCD = 8, WGM = 8;
__host__ __device__ __forceinline__ int lds_byte(int r, int c) { const int st = (r >> 4) * 2 + (c >> 5), rr = r & 15, cc = c & 31, ob = rr * 64 + cc * 2; return st * 1024 + (ob ^ (((ob >> 9) & 1) << 5)); }
__host__ __device__ __forceinline__ void stage_rc(int b, int& R, int& C) { const int st = b / 1024, sb = b % 1024, swz = sb ^ (((sb >> 9) & 1) << 5); R = (st >> 1) * 16 + swz / 64; C = (st & 1) * 32 + (swz % 64) / 2; }
__host__ __device__ __forceinline__ int perm32(int rho) { const int n = rho >> 4, i = rho & 15; return 8 * (i >> 2) + 4 * n + (i & 3); }

struct Unit { int pm, pn, z; };
struct Gemm { const bf16_t* A; const bf16_t* Bt; int lda, ldb, K; size_t zA, zB; };

struct StaticOrder {
    int nM, nN, nwg, G, c;
    __device__ void init(int M, int N, int G_, int c_) { nM = M / BM; nN = N / BM; nwg = nM * nN; G = G_; c = c_; }
    __device__ bool next(int i, Unit& u) const {
        const long L = (long)i * G + c; if (L >= nwg) return false;
        int wgid = (int)L; { const int q = nwg / NXCD, r = nwg % NXCD, xcd = wgid % NXCD, off = wgid / NXCD; wgid = (xcd < r ? xcd * (q + 1) : r * (q + 1) + (xcd - r) * q) + off; }
        const int nig = WGM * nN, gid = wgid / nig, fm = gid * WGM, gsz = (nM - fm) < WGM ? (nM - fm) : WGM;
        u.pm = fm + ((wgid % nig) % gsz); u.pn = (wgid % nig) / gsz; u.z = 0; return true;
    }
};
struct ZOrder {
    int nM, nN, nZ, ntile, G, c;
    __device__ void init(int M, int N, int Z, int G_, int c_) { nM = M / BM; nN = N / BM; nZ = Z; ntile = nM * nN; G = G_; c = c_; }
    __device__ bool next(int i, Unit& u) const {
        const long L = (long)(i / nZ) * G + c; if (L >= ntile) return false;
        u.pm = (int)L / nN; u.pn = (int)L % nN; u.z = i % nZ; return true;
    }
};

template <class F> struct Epi8 {
    static constexpr bool PERM = true;
    F f;
    __device__ __forceinline__ void operator()(const f32x4 (&acc)[2][2][4][2], const Unit& u, int wr, int wc, int fr, int fq) const {
        const int row0 = u.pm * BM + wr * 64 + fr, col0 = u.pn * BM + wc * 32 + 8 * fq;
#pragma unroll
        for (int ai = 0; ai < 2; ++ai)
#pragma unroll
            for (int m = 0; m < 4; ++m)
#pragma unroll
                for (int bj = 0; bj < 2; ++bj) f(row0 + ai * HALF + m * 16, col0 + bj * HALF, acc[ai][bj][m][0], acc[ai][bj][m][1], u.z);
    }
};
template <class F> struct Epi4 {
    static constexpr bool PERM = false;
    F f;
    __device__ __forceinline__ void operator()(const f32x4 (&acc)[2][2][4][2], const Unit& u, int wr, int wc, int fr, int fq) const {
        const int row0 = u.pm * BM + wr * 64 + fr, col0 = u.pn * BM + wc * 32 + 4 * fq;
#pragma unroll
        for (int ai = 0; ai < 2; ++ai)
#pragma unroll
            for (int m = 0; m < 4; ++m)
#pragma unroll
                for (int bj = 0; bj < 2; ++bj)
#pragma unroll
                    for (int n = 0; n < 2; ++n) f(row0 + ai * HALF + m * 16, col0 + bj * HALF + n * 16, acc[ai][bj][m][n], u.z);
    }
};

typedef int i32x4 __attribute__((ext_vector_type(4)));
template <class Epi, class Sched, bool I8 = false, bool ALIGN_EPI = true>
__device__ __forceinline__ void gemm_phase(LAS unsigned char* lds, const Gemm g, const Sched& S, const Epi& E, const int tid) {
    constexpr int ES = I8 ? 1 : 2;
    const int wid = __builtin_amdgcn_readfirstlane(tid >> 6), lane = tid & 63, wr = wid >> 2, wc = wid & 3, fr = lane & 15, fq = lane >> 4;
    const int K = g.K, nt = K * ES / 128;
    unsigned voffA[2], voffB[2];
#pragma unroll
    for (int i = 0; i < 2; ++i) { int R, C; stage_rc(tid * 16 + i * 8192, R, C); const int Rb = Epi::PERM ? ((R & ~31) + perm32(R & 31)) : R;
        voffA[i] = (unsigned)(R * g.lda * ES + C * 2); voffB[i] = (unsigned)(Rb * g.ldb * ES + C * 2); }
    const size_t kstep = (size_t)(BK * 2);
    const size_t hstepA = (size_t)HALF * g.lda * ES, hstepB = (size_t)HALF * g.ldb * ES;
    const size_t tstepA = 2 * hstepA, tstepB = 2 * hstepB;
    const unsigned ldsw = (unsigned)wid * 1024u;
    const int aoff = lds_byte(wr * 64 + fr, fq * 8), boff = lds_byte(wc * 32 + fr, fq * 8);
#define PG8_SA(b, h) (((b) * 2 + (h)) * HTB)
#define PG8_SB(b, h) ((4 + (b) * 2 + (h)) * HTB)
#define PG8_STAGE(bufoff, gbase, voff) do { _Pragma("unroll") for (int _i = 0; _i < 2; ++_i) \
        __builtin_amdgcn_global_load_lds((const unsigned*)((const char*)(gbase) + (voff)[_i]), (LAS unsigned*)(lds + (bufoff) + ldsw + _i * 8192), 16, 0, 0); } while (0)
#define PG8_LDA(dst, b, h) do { _Pragma("unroll") for (int m = 0; m < 4; ++m) _Pragma("unroll") for (int k = 0; k < 2; ++k) dst[m][k] = *(const LAS bf16x8*)(lds + PG8_SA(b, h) + aoff + m * 2048 + k * 1024); } while (0)
#define PG8_LDB(dst, b, h) do { _Pragma("unroll") for (int n = 0; n < 2; ++n) _Pragma("unroll") for (int k = 0; k < 2; ++k) dst[n][k] = *(const LAS bf16x8*)(lds + PG8_SB(b, h) + boff + n * 2048 + k * 1024); } while (0)
#define PG8_MMA(ai, bj, At, Bt) do { __builtin_amdgcn_s_setprio(1); _Pragma("unroll") for (int m = 0; m < 4; ++m) _Pragma("unroll") for (int n = 0; n < 2; ++n) _Pragma("unroll") for (int k = 0; k < 2; ++k) { \
        if constexpr (I8) acc[ai][bj][m][n] = __builtin_bit_cast(f32x4, __builtin_amdgcn_mfma_i32_16x16x64_i8(__builtin_bit_cast(i32x4, Bt[n][k]), __builtin_bit_cast(i32x4, At[m][k]), __builtin_bit_cast(i32x4, acc[ai][bj][m][n]), 0, 0, 0)); \
        else acc[ai][bj][m][n] = __builtin_amdgcn_mfma_f32_16x16x32_bf16(Bt[n][k], At[m][k], acc[ai][bj][m][n], 0, 0, 0); } __builtin_amdgcn_s_setprio(0); } while (0)
#define PG8_WAIT_V(n) asm volatile("s_waitcnt vmcnt(" #n ")" ::: "memory")
#define PG8_WAIT_L(n) asm volatile("s_waitcnt lgkmcnt(" #n ")" ::: "memory")
#define PG8_BAR __builtin_amdgcn_s_barrier()
#define PG8_SCHED __builtin_amdgcn_sched_barrier(0)
    Unit cur, nxt; int ui = 0;
    if (!S.next(0, cur)) return;
    f32x4 acc[2][2][4][2];
#pragma unroll
    for (int a = 0; a < 2; ++a)
#pragma unroll
        for (int b = 0; b < 2; ++b)
#pragma unroll
            for (int m = 0; m < 4; ++m)
#pragma unroll
                for (int n = 0; n < 2; ++n) acc[a][b][m][n] = (f32x4){0.f, 0.f, 0.f, 0.f};
    bf16x8 At[4][2], B0[2][2], B1[2][2];
    const char* cA = (const char*)g.A + (size_t)cur.z * g.zA * ES + (size_t)cur.pm * tstepA; const char* cB = (const char*)g.Bt + (size_t)cur.z * g.zB * ES + (size_t)cur.pn * tstepB;
    PG8_STAGE(PG8_SB(0, 0), cB, voffB); PG8_STAGE(PG8_SB(0, 1), cB + hstepB, voffB); PG8_STAGE(PG8_SA(0, 0), cA, voffA); PG8_STAGE(PG8_SA(0, 1), cA + hstepA, voffA);
    if (wr == 1) PG8_BAR;
    PG8_WAIT_V(2); PG8_BAR;
    PG8_STAGE(PG8_SB(1, 0), cB + kstep, voffB); PG8_STAGE(PG8_SA(1, 0), cA + kstep, voffA); PG8_STAGE(PG8_SB(1, 1), cB + hstepB + kstep, voffB);
    PG8_WAIT_V(6); PG8_BAR;
    for (;;) {
        const bool has_next = S.next(ui + 1, nxt);
        const char* nA = has_next ? (const char*)g.A + (size_t)nxt.z * g.zA * ES + (size_t)nxt.pm * tstepA : cA;
        const char* nB = has_next ? (const char*)g.Bt + (size_t)nxt.z * g.zB * ES + (size_t)nxt.pn * tstepB : cB;
        for (int t = 0; t < nt; t += 2) {
            const bool last = (t == nt - 2);
            const char* a1 = cA + (size_t)(t + 1) * kstep;
            const char* a2 = last ? nA : cA + (size_t)(t + 2) * kstep; const char* b2 = last ? nB : cB + (size_t)(t + 2) * kstep;
            const char* a3 = a2 + kstep; const char* b3 = b2 + kstep;
            PG8_LDB(B0, 0, 0); PG8_LDB(B1, 0, 1); PG8_SCHED; PG8_LDA(At, 0, 0); PG8_STAGE(PG8_SA(1, 1), a1 + hstepA, voffA);
            PG8_WAIT_V(8); PG8_WAIT_L(0); PG8_BAR; PG8_MMA(0, 0, At, B0); PG8_MMA(0, 1, At, B1); PG8_BAR; PG8_SCHED;
            PG8_LDA(At, 0, 1); PG8_STAGE(PG8_SB(0, 0), b2, voffB); PG8_STAGE(PG8_SB(0, 1), b2 + hstepB, voffB); PG8_STAGE(PG8_SA(0, 0), a2, voffA);
            PG8_WAIT_V(8); PG8_WAIT_L(0); PG8_BAR; PG8_MMA(1, 0, At, B0); PG8_MMA(1, 1, At, B1); PG8_BAR; PG8_SCHED;
            PG8_LDB(B0, 1, 0); PG8_LDB(B1, 1, 1); PG8_SCHED; PG8_LDA(At, 1, 0); PG8_STAGE(PG8_SA(0, 1), a2 + hstepA, voffA);
            PG8_WAIT_V(8); PG8_WAIT_L(0); PG8_BAR; PG8_MMA(0, 0, At, B0); PG8_MMA(0, 1, At, B1); PG8_BAR; PG8_SCHED;
            PG8_LDA(At, 1, 1); PG8_STAGE(PG8_SB(1, 0), b3, voffB); PG8_STAGE(PG8_SB(1, 1), b3 + hstepB, voffB); PG8_STAGE(PG8_SA(1, 0), a3, voffA);
            PG8_WAIT_V(8); PG8_WAIT_L(0); PG8_BAR; PG8_MMA(1, 0, At, B0); PG8_MMA(1, 1, At, B1); PG8_BAR; PG8_SCHED;
        }
        if constexpr (ALIGN_EPI) { if (wr == 0) PG8_BAR; }
        E(acc, cur, wr, wc, fr, fq);
        if (!has_next) break;
#pragma unroll
        for (int a = 0; a < 2; ++a)
#pragma unroll
            for (int b = 0; b < 2; ++b)
#pragma unroll
                for (int m = 0; m < 4; ++m)
#pragma unroll
                    for (int n = 0; n < 2; ++n) acc[a][b][m][n] = (f32x4){0.f, 0.f, 0.f, 0.f};
        cur = nxt; cA = nA; cB = nB; ++ui;
        if constexpr (ALIGN_EPI) { if (wr == 1) PG8_BAR; }
    }
    PG8_WAIT_V(0);
    if constexpr (!ALIGN_EPI) { if (wr == 0) PG8_BAR; }
    PG8_BAR;
#undef PG8_SA
#undef PG8_SB
#undef PG8_STAGE
#undef PG8_LDA
#undef PG8_LDB
#undef PG8_MMA
#undef PG8_WAIT_V
#undef PG8_WAIT_L
#undef PG8_BAR
#undef PG8_SCHED
}
}

#define XB_TMO      128
#define XB_XCNT(j)  (256  + 64 * (j))
#define XB_XSUB(j)  (1280 + 64 * (j))
#define XB_XGEN(j)  (2304 + 64 * (j))
#define XB_TOP      3328
#define XB_TOPGEN   3392
#define XCD_BAR_WORDS 3456
#define XB_SPIN_CAP (1u << 22)
__device__ __forceinline__ unsigned xb_ld(unsigned* p)              { return __hip_atomic_load(p, __ATOMIC_RELAXED, __HIP_MEMORY_SCOPE_AGENT); }
__device__ __forceinline__ unsigned xb_add(unsigned* p, unsigned v) { return __hip_atomic_fetch_add(p, v, __ATOMIC_RELAXED, __HIP_MEMORY_SCOPE_AGENT); }
__device__ __forceinline__ unsigned xb_xcc_id() { return (unsigned)__builtin_amdgcn_s_getreg((3 << 11) | 20) & 0xFu; }
#define XB_SPIN(cond, bar) do { unsigned _sp = 0; while (cond) { __builtin_amdgcn_s_sleep(1); \
    if ((++_sp & 255u) == 0u) { if (xb_ld(&(bar)[XB_TMO])) break; if (_sp > XB_SPIN_CAP) { atomicAdd(&(bar)[XB_TMO], 1u); break; } } } } while (0)
__device__ __forceinline__ void xcd_barrier_post(unsigned* bar) {
    if (threadIdx.x == 0) (void)xb_add(&bar[XB_XCNT(xb_xcc_id())], 1u);
}
__device__ __forceinline__ void xcd_barrier_complete(unsigned* bar, unsigned x, unsigned& nloc, unsigned& nx) {
    const unsigned G = gridDim.x * gridDim.y * gridDim.z;
    unsigned sum, cnt, mine, sp = 0u;
    for (;;) {
        sum = 0u; cnt = 0u; mine = 0u;
#pragma unroll
        for (unsigned j = 0; j < 16; ++j) { const unsigned c = xb_ld(&bar[XB_XCNT(j)]); sum += c; cnt += (c > 0u) ? 1u : 0u; mine = (j == x) ? c : mine; }
        if (sum == G) break;
        __builtin_amdgcn_s_sleep(1);
        if ((++sp & 255u) == 0u) { if (xb_ld(&bar[XB_TMO])) break; if (sp > XB_SPIN_CAP) { atomicAdd(&bar[XB_TMO], 1u); break; } }
    }
    nloc = mine > 0u ? mine : 1u; nx = cnt > 0u ? cnt : 1u;
}
__device__ __noinline__ void xcd_barrier_leader(unsigned* bar, volatile LAS unsigned* st) {
    const unsigned x = xb_xcc_id();
    __builtin_amdgcn_s_waitcnt(0);
    unsigned nloc = st[0], nx = st[1];
    if (nloc == 0u) { xcd_barrier_complete(bar, x, nloc, nx); st[0] = nloc; st[1] = nx; }
    const unsigned old = xb_add(&bar[XB_XSUB(x)], 1u);
    const unsigned gen = old / nloc;
    if (old + 1u == (gen + 1u) * nloc) {
        __builtin_amdgcn_fence(__ATOMIC_RELEASE, "agent");
        asm volatile("s_waitcnt vmcnt(0)" ::: "memory");
        const unsigned og = xb_add(&bar[XB_TOP], 1u);
        const unsigned tg = og / nx;
        if (og + 1u == (tg + 1u) * nx) xb_add(&bar[XB_TOPGEN], 1u);
        else XB_SPIN(xb_ld(&bar[XB_TOPGEN]) == tg, bar);
        __builtin_amdgcn_fence(__ATOMIC_ACQUIRE, "agent");
        xb_add(&bar[XB_XGEN(x)], 1u);
        asm volatile("s_waitcnt vmcnt(0)" ::: "memory");
    } else {
        XB_SPIN(xb_ld(&bar[XB_XGEN(x)]) == gen, bar);
        __builtin_amdgcn_fence(__ATOMIC_ACQUIRE, "agent");
        asm volatile("s_waitcnt vmcnt(0)" ::: "memory");
    }
}
__device__ __forceinline__ void xcd_barrier(unsigned* bar, volatile LAS unsigned* st) {
    asm volatile("s_waitcnt vmcnt(0)" ::: "memory");
    __syncthreads();
    if (threadIdx.x == 0) xcd_barrier_leader(bar, st);
    __syncthreads();
}

constexpr int NIN_PTRS = 23;
struct Args { const float* in[NIN_PTRS]; float* out; unsigned char* ws; int ph_lo, ph_hi, bar_slot, pad; };
enum { I_X = 0, I_WIN, I_BFOX, I_POOLW, I_POOLS, I_LBL, I_HNG, I_GLNG, I_GLNB, I_GWS, I_GBS, I_WGATE, I_BGATE, I_WBR, I_WOUT, I_LN1G, I_LN1B, I_WQ, I_KEYS, I_PU, I_PV, I_LN2G, I_LN2B };

constexpr int LDS_BYTES = 147456;
constexpr int LDSCTL_OFF = 143360;

struct Ctx {
    LAS unsigned char* lds;
    unsigned char* ws;
    const float* const* in;
    float* out;
    int tid, lane, wave, G, bid, vcu;
};

__device__ __forceinline__ void tconv_job(const Ctx& C, const float* src, int ld_src, int K, int N, bf16_t* dst) {
    LAS float* tile = (LAS float*)C.lds;
    const int nk = K / 64, nn = N / 64, ntiles = nk * nn;
    for (int tl = C.bid; tl < ntiles; tl += C.G) {
        const int k0 = (tl / nn) * 64, n0 = (tl % nn) * 64;
#pragma unroll
        for (int p = 0; p < 2; ++p) {
            const int kr = (C.tid >> 4) + p * 32, nc = (C.tid & 15) * 4;
            const f32x4 v = *(const f32x4*)(src + (size_t)(k0 + kr) * ld_src + n0 + nc);
            tile[kr * 65 + nc + 0] = v[0]; tile[kr * 65 + nc + 1] = v[1]; tile[kr * 65 + nc + 2] = v[2]; tile[kr * 65 + nc + 3] = v[3];
        }
        __syncthreads();
        {
            const int n = C.tid >> 3, k8 = (C.tid & 7) * 8;
            u32x4 o;
#pragma unroll
            for (int j = 0; j < 4; ++j) o[j] = pk2(tile[(k8 + 2 * j) * 65 + n], tile[(k8 + 2 * j + 1) * 65 + n]);
            *(u32x4*)(dst + (size_t)(n0 + n) * K + k0 + k8) = o;
        }
        __syncthreads();
    }
}
__device__ __forceinline__ void colmax_job(const Ctx& C, const float* src, int ld_src, int K, int N, unsigned* cmax) {
    LAS float* red = (LAS float*)C.lds;
    const int nk = K / 64, nn = N / 64, ntiles = nk * nn;
    for (int tl = C.bid; tl < ntiles; tl += C.G) {
        const int k0 = (tl / nn) * 64, n0 = (tl % nn) * 64;
        float mx[4] = {0.f, 0.f, 0.f, 0.f};
#pragma unroll
        for (int p = 0; p < 2; ++p) { const int kr = (C.tid >> 4) + p * 32, nc = (C.tid & 15) * 4;
            const f32x4 v = *(const f32x4*)(src + (size_t)(k0 + kr) * ld_src + n0 + nc);
#pragma unroll
            for (int e = 0; e < 4; ++e) mx[e] = fmaxf(mx[e], fabsf(v[e])); }
#pragma unroll
        for (int e = 0; e < 4; ++e) red[(C.tid >> 4) * 64 + (C.tid & 15) * 4 + e] = mx[e];
        __syncthreads();
        if (C.tid < 64) { float m = 0.f; for (int r = 0; r < 32; ++r) m = fmaxf(m, red[r * 64 + C.tid]); atomicMax(cmax + n0 + C.tid, __builtin_bit_cast(unsigned, m)); }
        __syncthreads();
    }
}
__device__ __forceinline__ void tconv_i8_job(const Ctx& C, const float* src, int ld_src, int K, int N, unsigned char* dst, const unsigned* cmax) {
    LAS float* tile = (LAS float*)C.lds;
    const int nk = K / 64, nn = N / 64, ntiles = nk * nn;
    for (int tl = C.bid; tl < ntiles; tl += C.G) {
        const int k0 = (tl / nn) * 64, n0 = (tl % nn) * 64;
#pragma unroll
        for (int p = 0; p < 2; ++p) { const int kr = (C.tid >> 4) + p * 32, nc = (C.tid & 15) * 4;
            const f32x4 v = *(const f32x4*)(src + (size_t)(k0 + kr) * ld_src + n0 + nc);
#pragma unroll
            for (int e = 0; e < 4; ++e) tile[kr * 65 + nc + e] = v[e] * (127.f / fmaxf(__builtin_bit_cast(float, __hip_atomic_load(cmax + n0 + nc + e, __ATOMIC_RELAXED, __HIP_MEMORY_SCOPE_AGENT)), 1e-30f)); }
        __syncthreads();
        { const int n = C.tid >> 3, k8 = (C.tid & 7) * 8;
          u32x2 o;
#pragma unroll
          for (int j = 0; j < 2; ++j) { unsigned wd = 0u;
#pragma unroll
              for (int e = 0; e < 4; ++e) wd |= ((unsigned)(int)rintf(tile[(k8 + 4 * j + e) * 65 + n]) & 255u) << (8 * e);
              o[j] = wd; }
          *(u32x2*)(dst + (size_t)(n0 + n) * K + k0 + k8) = o; }
        __syncthreads();
    }
}
__device__ __forceinline__ void cvt_copy(const Ctx& C, const float* src, bf16_t* dst, size_t n) {
    const size_t n8 = n / 8;
    for (size_t i = (size_t)C.bid * 512 + C.tid; i < n8; i += (size_t)C.G * 512) {
        const f32x4 a = *(const f32x4*)(src + i * 8), b = *(const f32x4*)(src + i * 8 + 4);
        u32x4 o; o[0] = pk2(a[0], a[1]); o[1] = pk2(a[2], a[3]); o[2] = pk2(b[0], b[1]); o[3] = pk2(b[2], b[3]);
        *(u32x4*)(dst + i * 8) = o;
    }
}
__device__ __forceinline__ void p_conv_weights(const Ctx& C) {
    for (int l = 0; l < DEPTH; ++l) {
        unsigned char* wb = C.ws + WS_W + (size_t)l * W_LAYER;
        colmax_job(C, C.in[I_WIN] + (size_t)l * DM * NIN, NIN, DM, NH, (unsigned*)(C.ws + WS_CMAX) + l * (NH + NG));
        colmax_job(C, C.in[I_WGATE] + (size_t)l * DM * NG, NG, DM, NG, (unsigned*)(C.ws + WS_CMAX) + l * (NH + NG) + NH);
        for (int m = 0; m < 4; ++m)
            tconv_job(C, C.in[I_WBR] + ((size_t)l * 4 + m) * BW * DM, DM, BW, DM, (bf16_t*)(wb + WO_WBR) + (size_t)m * DM * BW);
        tconv_job(C, C.in[I_WOUT] + (size_t)l * DM * DM, DM, DM, DM, (bf16_t*)(wb + WO_WOUT));
        tconv_job(C, C.in[I_WQ] + (size_t)l * DM * NQ, NQ, DM, NQ, (bf16_t*)(wb + WO_WQ));
        cvt_copy(C, C.in[I_KEYS] + (size_t)l * 2 * PH * 128 * 128, (bf16_t*)(wb + WO_KEYS), (size_t)2 * PH * 128 * 128);
        for (int g = 0; g < 4; ++g)
            tconv_job(C, C.in[I_POOLW] + ((size_t)l * 4 + g) * 128 * 128, 128, 128, 128, (bf16_t*)(wb + WO_POOLW) + (size_t)g * 128 * 128);
        {
            bf16_t* gw = (bf16_t*)(wb + WO_GWS); const float* src = C.in[I_GWS] + (size_t)l * 4 * 128 * 128;
            for (int i = C.bid * 512 + C.tid; i < 4 * 128 * 128; i += C.G * 512) { const int t = (i >> 7) & 127, sx = i & 127; gw[i] = (bf16_t)f2bf(sx <= t ? src[i] : 0.f); }
        }
        float* wf = (float*)(wb + WO_WF);
        for (int i = C.bid * 512 + C.tid; i < 4 * DM; i += C.G * 512) { const int h = i / DM, k = i % DM; wf[i] = C.in[I_WIN][(size_t)l * DM * NIN + (size_t)k * NIN + NH + h]; }
    }
}
constexpr size_t WS_U8 = WS_TABU, WS_V8 = WS_TABU + 16 * MiB, WS_SU = WS_TABU + 32 * MiB, WS_SV = WS_SU + 64 * 1024;
__device__ __forceinline__ float wave_max(float v) {
#pragma unroll
    for (int o = 32; o > 0; o >>= 1) v = fmaxf(v, __shfl_xor(v, o, 64));
    return v;
}
template <bool SIGNED> __device__ __forceinline__ void quant_rows(const Ctx& C, const float* src, unsigned char* dst, float* scl) {
    for (int row = C.bid * 8 + C.wave; row < NEXP; row += C.G * 8) {
        const float* p = src + (size_t)row * DM + C.lane * 16;
        f32x4 v[4]; float mx = 0.f;
#pragma unroll
        for (int i = 0; i < 4; ++i) { v[i] = *(const f32x4*)(p + 4 * i);
#pragma unroll
            for (int e = 0; e < 4; ++e) mx = fmaxf(mx, fabsf(v[i][e])); }
        mx = fmaxf(wave_max(mx), 1e-30f);
        const float sc = mx * (1.f / 127.f), isc = 127.f / mx;
        u32x4 o;
#pragma unroll
        for (int i = 0; i < 4; ++i) { unsigned wd = 0u;
#pragma unroll
            for (int e = 0; e < 4; ++e) { const int q = (int)rintf(v[i][e] * isc) + (SIGNED ? 0 : 128); wd |= ((unsigned)q & 255u) << (8 * e); }
            o[i] = wd; }
        *(u32x4*)(dst + (size_t)row * DM + C.lane * 16) = o;
        if (C.lane == 0) scl[row] = sc;
    }
}
__device__ __forceinline__ void p_conv_tables(const Ctx& C, int l) {
    quant_rows<true>(C, C.in[I_PU] + (size_t)l * NEXP * DM, C.ws + WS_U8, (float*)(C.ws + WS_SU));
    quant_rows<false>(C, C.in[I_PV] + (size_t)l * NEXP * DM, C.ws + WS_V8, (float*)(C.ws + WS_SV));
}

__device__ __forceinline__ void row_emit(const Ctx& C, int row, const float (&v)[16], int l, bool want_lsig) {
    {
        float mx = 0.f;
#pragma unroll
        for (int j = 0; j < 16; ++j) mx = fmaxf(mx, fabsf(v[j]));
#pragma unroll
        for (int o = 32; o > 0; o >>= 1) mx = fmaxf(mx, __shfl_xor(mx, o, 64));
        mx = fmaxf(mx, 1e-30f);
        const float isc = 127.f / mx;
        unsigned char* xb = C.ws + WS_XB + (size_t)row * DM;
        u32x2 o0, o1;
#pragma unroll
        for (int hw = 0; hw < 2; ++hw) { unsigned a = 0u, b = 0u;
#pragma unroll
            for (int e = 0; e < 4; ++e) { a |= ((unsigned)(int)rintf(v[4 * hw + e] * isc) & 255u) << (8 * e); b |= ((unsigned)(int)rintf(v[8 + 4 * hw + e] * isc) & 255u) << (8 * e); }
            o0[hw] = a; o1[hw] = b; }
        *(u32x2*)(xb + C.lane * 8) = o0; *(u32x2*)(xb + 512 + C.lane * 8) = o1;
        if (C.lane == 0) ((float*)(C.ws + WS_XSA))[row] = mx * (1.f / 127.f);
    }
    if (want_lsig) {
        const float* wf = (const float*)(C.ws + WS_W + (size_t)l * W_LAYER + WO_WF);
        float* lsig = (float*)(C.ws + WS_MISC);
#pragma unroll
        for (int h = 0; h < 4; ++h) {
            const f32x4 a0 = *(const f32x4*)(wf + h * DM + C.lane * 8), a1 = *(const f32x4*)(wf + h * DM + C.lane * 8 + 4);
            const f32x4 b0 = *(const f32x4*)(wf + h * DM + 512 + C.lane * 8), b1 = *(const f32x4*)(wf + h * DM + 512 + C.lane * 8 + 4);
            float s = 0.f;
#pragma unroll
            for (int j = 0; j < 4; ++j) s += v[j] * a0[j] + v[4 + j] * a1[j] + v[8 + j] * b0[j] + v[12 + j] * b1[j];
            s = wave_sum(s);
            if (C.lane == 0) lsig[(size_t)row * 4 + h] = logsigmoidf_(s + C.in[I_BFOX][l * 4 + h]);
        }
    }
}
__device__ __forceinline__ void load_row16(const float* p, int lane, float (&v)[16]) {
    const f32x4 a0 = *(const f32x4*)(p + lane * 8), a1 = *(const f32x4*)(p + lane * 8 + 4), b0 = *(const f32x4*)(p + 512 + lane * 8), b1 = *(const f32x4*)(p + 512 + lane * 8 + 4);
#pragma unroll
    for (int j = 0; j < 4; ++j) { v[j] = a0[j]; v[4 + j] = a1[j]; v[8 + j] = b0[j]; v[12 + j] = b1[j]; }
}
__device__ __forceinline__ void store_row16(float* p, int lane, const float (&v)[16]) {
    *(f32x4*)(p + lane * 8) = (f32x4){v[0], v[1], v[2], v[3]}; *(f32x4*)(p + lane * 8 + 4) = (f32x4){v[4], v[5], v[6], v[7]};
    *(f32x4*)(p + 512 + lane * 8) = (f32x4){v[8], v[9], v[10], v[11]}; *(f32x4*)(p + 512 + lane * 8 + 4) = (f32x4){v[12], v[13], v[14], v[15]};
}
__device__ __forceinline__ void ln_row16(float (&v)[16], const float* g, const float* b, int lane) {
    float s = 0.f;
#pragma unroll
    for (int j = 0; j < 16; ++j) s += v[j];
    const float mean = wave_sum(s) * (1.f / DM);
    float q = 0.f;
#pragma unroll
    for (int j = 0; j < 16; ++j) { const float d = v[j] - mean; q += d * d; }
    const float rstd = rsqrtf(wave_sum(q) * (1.f / DM) + LN_EPS);
    float gg[16], bb[16];
    load_row16(g, lane, gg); load_row16(b, lane, bb);
#pragma unroll
    for (int j = 0; j < 16; ++j) v[j] = (v[j] - mean) * rstd * gg[j] + bb[j];
}
__device__ __forceinline__ void p_rowpass0(const Ctx& C) {
    for (int row = C.bid * 8 + C.wave; row < T; row += C.G * 8) {
        float v[16]; load_row16(C.in[I_X] + (size_t)row * DM, C.lane, v);
        row_emit(C, row, v, 0, true);
    }
}
__device__ __forceinline__ void p_cumsum(const Ctx& C) {
    if (C.bid >= BATCH * 4) return;
    const float* lsig = (const float*)(C.ws + WS_MISC);
    float* cum = (float*)(C.ws + WS_CUM);
    LAS float* wt = (LAS float*)C.lds;
    const int b = C.bid >> 2, h = C.bid & 3;
    float v[16];
#pragma unroll
    for (int j = 0; j < 16; ++j) v[j] = lsig[((size_t)b * SEQ + C.tid * 16 + j) * 4 + h];
#pragma unroll
    for (int j = 1; j < 16; ++j) v[j] += v[j - 1];
    float inc = v[15];
#pragma unroll
    for (int o = 1; o < 64; o <<= 1) { const float t = __shfl_up(inc, o, 64); if (C.lane >= o) inc += t; }
    if (C.lane == 63) wt[C.wave] = inc;
    __syncthreads();
    float off = inc - v[15];
    for (int w2 = 0; w2 < C.wave; ++w2) off += wt[w2];
    float* cp = cum + ((size_t)b * 4 + h) * SEQ + C.tid * 16;
#pragma unroll
    for (int j4 = 0; j4 < 4; ++j4) *(f32x4*)(cp + 4 * j4) = (f32x4){v[4 * j4] + off, v[4 * j4 + 1] + off, v[4 * j4 + 2] + off, v[4 * j4 + 3] + off};
    __syncthreads();
}
__device__ __forceinline__ void load_row16_bf(const bf16_t* p, int lane, float (&v)[16]) {
    const u32x4 a = *(const u32x4*)(p + lane * 8), b = *(const u32x4*)(p + 512 + lane * 8);
#pragma unroll
    for (int j = 0; j < 4; ++j) { v[2 * j] = bf2f(a[j] & 0xffffu); v[2 * j + 1] = bf2f(a[j] >> 16); v[8 + 2 * j] = bf2f(b[j] & 0xffffu); v[9 + 2 * j] = bf2f(b[j] >> 16); }
}
__device__ __forceinline__ void p_ln1(const Ctx& C, int l) {
    const bf16_t* y1 = (const bf16_t*)(C.ws + WS_XC); bf16_t* x1b = (bf16_t*)(C.ws + WS_X1B);
    for (int row = C.bid * 8 + C.wave; row < T; row += C.G * 8) {
        float v[16]; load_row16_bf(y1 + (size_t)row * DM, C.lane, v);
        ln_row16(v, C.in[I_LN1G] + l * DM, C.in[I_LN1B] + l * DM, C.lane);
        u32x4 o0, o1;
#pragma unroll
        for (int j = 0; j < 4; ++j) { o0[j] = pk2(v[2 * j], v[2 * j + 1]); o1[j] = pk2(v[8 + 2 * j], v[8 + 2 * j + 1]); }
        *(u32x4*)(x1b + (size_t)row * DM + C.lane * 8) = o0; *(u32x4*)(x1b + (size_t)row * DM + 512 + C.lane * 8) = o1;
    }
}

__device__ __forceinline__ void mix_pool_naive(const Ctx& C, int l) {
    const bf16_t* H = (const bf16_t*)(C.ws + WS_H); bf16_t* BR = (bf16_t*)(C.ws + WS_BR);
    LAS float* dd = (LAS float*)C.lds;
    for (int u = C.bid; u < (T / 64) * 4; u += C.G) {
        const int g = u & 3, t0 = (u >> 2) * 64, w = 2 << g;
        for (int idx = C.tid; idx < 64 * 128; idx += 512) {
            const int r = idx >> 7, c = idx & 127, row = t0 + r, pos = row & (SEQ - 1);
            const int nwin = (pos + 1 < w) ? pos + 1 : w;
            float s = 0.f;
            for (int j = 0; j < nwin; ++j) s += bf2f(H[(size_t)(row - j) * NH + HC_P + g * 128 + c]);
            dd[idx] = s / (float)nwin - bf2f(H[(size_t)row * NH + HC_P + g * 128 + c]);
        }
        __syncthreads();
        const int dcol = C.tid & 127, rq = C.tid >> 7;
        float acc[16];
#pragma unroll
        for (int i = 0; i < 16; ++i) acc[i] = 0.f;
        const float* pw = C.in[I_POOLW] + ((size_t)l * 4 + g) * 128 * 128;
        for (int c = 0; c < 128; ++c) {
            const float wv = pw[c * 128 + dcol];
#pragma unroll
            for (int i = 0; i < 16; ++i) acc[i] += dd[(rq * 16 + i) * 128 + c] * wv;
        }
        const float sc = C.in[I_POOLS][l * BW + g * 128 + dcol];
#pragma unroll
        for (int i = 0; i < 16; ++i) BR[(size_t)(t0 + rq * 16 + i) * NBR + 0 + g * 128 + dcol] = (bf16_t)f2bf(acc[i] * sc);
        __syncthreads();
    }
}
__device__ __forceinline__ void mix_gmlp_naive(const Ctx& C, int l) {
    const bf16_t* H = (const bf16_t*)(C.ws + WS_H); bf16_t* BR = (bf16_t*)(C.ws + WS_BR);
    LAS float* vn = (LAS float*)C.lds;
    for (int u = C.bid; u < (T / 128) * 4; u += C.G) {
        const int g = u & 3, t0 = (u >> 2) * 128;
        for (int i = 0; i < 16; ++i) {
            const int r = C.wave * 16 + i, row = t0 + r;
            const u32x4 raw = *(const u32x4*)(H + (size_t)row * NH + HC_GV + C.lane * 8);
            float e[8];
#pragma unroll
            for (int j = 0; j < 4; ++j) { e[2 * j] = geluf_(bf2f(raw[j] & 0xffffu)); e[2 * j + 1] = geluf_(bf2f(raw[j] >> 16)); }
            float s = 0.f;
#pragma unroll
            for (int j = 0; j < 8; ++j) s += e[j];
            const float mean = wave_sum(s) * (1.f / BW);
            float q = 0.f;
#pragma unroll
            for (int j = 0; j < 8; ++j) { const float d = e[j] - mean; q += d * d; }
            const float rstd = rsqrtf(wave_sum(q) * (1.f / BW) + LN_EPS);
            if ((C.lane >> 4) == g) {
#pragma unroll
                for (int j = 0; j < 8; ++j) { const int col = C.lane * 8 + j;
                    vn[r * 128 + (col - g * 128)] = (e[j] - mean) * rstd * C.in[I_GLNG][l * BW + col] + C.in[I_GLNB][l * BW + col]; }
            }
        }
        __syncthreads();
        const int c = C.tid & 127, tq = C.tid >> 7;
        const float* wsg = C.in[I_GWS] + ((size_t)l * 4 + g) * 128 * 128;
        for (int t = tq; t < 128; t += 4) {
            float acc = 0.f;
            for (int s = 0; s <= t; ++s) acc += wsg[t * 128 + s] * vn[s * 128 + c];
            const float sv = acc + C.in[I_GBS][(l * 4 + g) * 128 + t];
            const float uv = geluf_(bf2f(H[(size_t)(t0 + t) * NH + HC_GU + g * 128 + c]));
            BR[(size_t)(t0 + t) * NBR + 1024 + g * 128 + c] = (bf16_t)f2bf(uv * sv);
        }
        __syncthreads();
    }
}
__device__ __forceinline__ void mix_fox_naive(const Ctx& C, int l) {
    const bf16_t* H = (const bf16_t*)(C.ws + WS_H); bf16_t* BR = (bf16_t*)(C.ws + WS_BR);
    const float* cum = (const float*)(C.ws + WS_CUM);
    const float scale = 0.08838834764831845f;
    for (int u = C.bid; u < T * 4 / 8; u += C.G) {
        const int rid = u * 8 + C.wave;
        const int h = rid & 3, row = rid >> 2, b = row / SEQ, t = row % SEQ;
        const unsigned qraw = *(const unsigned*)(H + (size_t)row * NH + HC_FQ + h * 128 + C.lane * 2);
        const float q0 = bf2f(qraw & 0xffffu) * scale, q1 = bf2f(qraw >> 16) * scale;
        const float* cm = cum + ((size_t)b * 4 + h) * SEQ;
        const float ct = cm[t];
        float m = -1e30f, lsum = 0.f, o0 = 0.f, o1 = 0.f;
        for (int s = t; s >= 0; --s) {
            const size_t kr = (size_t)(b * SEQ + s) * NH + h * 128 + C.lane * 2;
            const unsigned kraw = *(const unsigned*)(H + kr + HC_FK);
            const unsigned vraw = *(const unsigned*)(H + kr + HC_FV);
            float d = q0 * bf2f(kraw & 0xffffu) + q1 * bf2f(kraw >> 16);
            d = wave_sum(d);
            const float z = d + ct - cm[s];
            const float mn = fmaxf(m, z), al = __expf(m - mn), p = __expf(z - mn);
            lsum = lsum * al + p; o0 = o0 * al + p * bf2f(vraw & 0xffffu); o1 = o1 * al + p * bf2f(vraw >> 16); m = mn;
        }
        const float inv = 1.f / lsum;
        *(unsigned*)(BR + (size_t)row * NBR + 1536 + h * 128 + C.lane * 2) = pk2(o0 * inv, o1 * inv);
    }
}
__device__ __forceinline__ void mix_hgrn_naive(const Ctx& C, int l) {
    if (C.bid >= BATCH * 4) return;
    const bf16_t* H = (const bf16_t*)(C.ws + WS_H); bf16_t* BR = (bf16_t*)(C.ws + WS_BR);
    const int b = C.bid >> 2, h = C.bid & 3;
    LAS float* fdec = (LAS float*)C.lds;
    LAS float* kkv = fdec + 32 * 128;
    LAS float* qsv = kkv + 32 * 128;
    LAS float* vv = qsv + 32 * 128;
    LAS float* opart = vv + 32 * 128;
    const int kq = C.tid >> 7, v = C.tid & 127;
    float S[32];
#pragma unroll
    for (int j = 0; j < 32; ++j) S[j] = 0.f;
    for (int c0 = 0; c0 < SEQ; c0 += 32) {
        for (int idx = C.tid; idx < 32 * 128; idx += 512) {
            const int st = idx >> 7, k = idx & 127; const size_t rb = (size_t)(b * SEQ + c0 + st) * NH + h * 128 + k;
            float lb = 0.f;
            if (l == 1) { const float z0 = C.in[I_LBL][h * 128 + k], z1 = C.in[I_LBL][BW + h * 128 + k]; lb = 1.f / (1.f + __expf(z0 - z1)); }
            const float zf = bf2f(H[rb + HC_HF]);
            const float kk = (1.f - lb) * sigmoidf_(-zf);
            fdec[idx] = 1.f - kk; kkv[idx] = kk; qsv[idx] = siluf_(bf2f(H[rb + HC_HQ])); vv[idx] = bf2f(H[rb + HC_HI]);
        }
        __syncthreads();
        for (int st = 0; st < 32; ++st) {
            const float vt = vv[st * 128 + v];
            float part = 0.f;
#pragma unroll
            for (int j = 0; j < 32; ++j) { const int k = kq * 32 + j; S[j] = fdec[st * 128 + k] * S[j] + kkv[st * 128 + k] * vt; part += S[j] * qsv[st * 128 + k]; }
            opart[(kq * 32 + st) * 128 + v] = part;
        }
        __syncthreads();
        for (int i = 0; i < 4; ++i) {
            const int st = C.wave * 4 + i, row = b * SEQ + c0 + st;
            float o0 = 0.f, o1 = 0.f;
#pragma unroll
            for (int q = 0; q < 4; ++q) { o0 += opart[(q * 32 + st) * 128 + C.lane]; o1 += opart[(q * 32 + st) * 128 + 64 + C.lane]; }
            const float ss = wave_sum(o0 * o0 + o1 * o1);
            const float r = rsqrtf(ss * (1.f / 128.f) + RMS_EPS);
            const float g0 = siluf_(bf2f(H[(size_t)row * NH + HC_HG + h * 128 + C.lane])), g1 = siluf_(bf2f(H[(size_t)row * NH + HC_HG + h * 128 + 64 + C.lane]));
            BR[(size_t)row * NBR + 512 + h * 128 + C.lane] = (bf16_t)f2bf(o0 * r * C.in[I_HNG][l * 128 + C.lane] * g0);
            BR[(size_t)row * NBR + 512 + h * 128 + 64 + C.lane] = (bf16_t)f2bf(o1 * r * C.in[I_HNG][l * 128 + 64 + C.lane] * g1);
        }
        __syncthreads();
    }
}


typedef float f32x16 __attribute__((ext_vector_type(16)));
typedef short s16x4 __attribute__((ext_vector_type(4)));
typedef short v4i16_t __attribute__((ext_vector_type(4)));
__device__ __forceinline__ s16x4 vtr(const LAS unsigned char* p) { return __builtin_bit_cast(s16x4, __builtin_amdgcn_ds_read_tr16_b64_v4i16((LAS v4i16_t*)p)); }
__device__ __forceinline__ float xor32(float x) { return __shfl_xor(x, 32, 64); }
#define MFMA32(a, b, c) __builtin_amdgcn_mfma_f32_32x32x16_bf16((a), (b), (c), 0, 0, 0)
constexpr int CW_KMAX = 16;

__device__ __forceinline__ void p_knorm(const Ctx& C, int l) {
    const bf16_t* H = (const bf16_t*)(C.ws + WS_H);
    unsigned* kmax = (unsigned*)(C.ws + WS_CTL) + CW_KMAX + l * 8;
    for (int r0 = (C.bid * 8 + C.wave) * 8; r0 < T; r0 += C.G * 64) {
        u32x4 raw[8];
#pragma unroll
        for (int i = 0; i < 8; ++i) raw[i] = *(const u32x4*)(H + (size_t)(r0 + i) * NH + HC_FK + C.lane * 8);
        float best = 0.f;
#pragma unroll
        for (int i = 0; i < 8; ++i) { float s = 0.f;
#pragma unroll
            for (int j = 0; j < 4; ++j) { const float a = bf2f(raw[i][j] & 0xffffu), b = bf2f(raw[i][j] >> 16); s += a * a + b * b; }
            best = fmaxf(best, s); }
        best = 0.f;
#pragma unroll
        for (int i = 0; i < 8; ++i) { float s = 0.f;
#pragma unroll
            for (int j = 0; j < 4; ++j) { const float a = bf2f(raw[i][j] & 0xffffu), b = bf2f(raw[i][j] >> 16); s += a * a + b * b; }
#pragma unroll
            for (int o = 8; o > 0; o >>= 1) s += __shfl_xor(s, o, 64);
            best = fmaxf(best, s); }
        if ((C.lane & 15) == 0) atomicMax(kmax + (r0 / SEQ) * 4 + (C.lane >> 4), __builtin_bit_cast(unsigned, best));
    }
}

constexpr int FOX_KST = 272, FOX_VST = 320;
constexpr int FOX_KB = 0, FOX_VB = 2 * 64 * FOX_KST, FOX_BETA = FOX_VB + 2 * 64 * FOX_VST, FOX_FLAG = FOX_BETA + 2 * 64 * 4, FOX_END = FOX_FLAG + 2 * 8 * 4;
__device__ __forceinline__ void mix_fox(const Ctx& C, int l) {
    const bf16_t* H = (const bf16_t*)(C.ws + WS_H); bf16_t* BR = (bf16_t*)(C.ws + WS_BR);
    const float* cum = (const float*)(C.ws + WS_CUM);
    const unsigned* kmaxw = (const unsigned*)(C.ws + WS_CTL) + CW_KMAX + l * 8;
    const float LOG2E = 1.4426950408889634f, QS = 0.08838834764831845f * LOG2E;
    const int lane = C.lane, w = C.wave, r32 = lane & 31, hh = lane >> 5;
    LAS unsigned char* lds = C.lds;
    LAS float* betaL = (LAS float*)(lds + FOX_BETA);
    volatile LAS int* flagL = (volatile LAS int*)(lds + FOX_FLAG);
    for (int u = C.bid; u < BATCH * 4 * (SEQ / 256); u += C.G) {
        const int qb = u % (SEQ / 256), bh = u / (SEQ / 256), b = bh >> 2, h = bh & 3;
        const int q0 = qb * 256, qw = q0 + 32 * w;
        const size_t rowbase = (size_t)b * SEQ;
        const float* cm = cum + ((size_t)b * 4 + h) * SEQ;
        const float c0 = cm[q0];
        const float kmx = sqrtf(__builtin_bit_cast(float, __hip_atomic_load(kmaxw + b * 4 + h, __ATOMIC_RELAXED, __HIP_MEMORY_SCOPE_AGENT)));
        bf16x8 qf[8]; float qn = 0.f;
        {
            const bf16_t* qp = H + (rowbase + qw + r32) * NH + HC_FQ + h * 128 + 8 * hh;
#pragma unroll
            for (int ks = 0; ks < 8; ++ks) {
                const u32x4 raw = *(const u32x4*)(qp + 16 * ks);
                u32x4 o;
#pragma unroll
                for (int j = 0; j < 4; ++j) { const float a = bf2f(raw[j] & 0xffffu), bb = bf2f(raw[j] >> 16); qn += a * a + bb * bb; o[j] = cvtpk(a * QS, bb * QS); }
                qf[ks] = __builtin_bit_cast(bf16x8, o);
            }
            qn += xor32(qn); qn = sqrtf(qn);
        }
        const float qbound = qn * kmx * QS;
        f32x16 oacc[4];
#pragma unroll
        for (int mt = 0; mt < 4; ++mt)
#pragma unroll
            for (int i = 0; i < 16; ++i) oacc[mt][i] = 0.f;
        float m_run = -1e30f, l_run = 0.f;
        const int jmax = (q0 + 255) >> 6;
        const int srow = C.tid >> 4, sch = C.tid & 15;
        u32x4 kreg[2], vreg[2]; float breg = 0.f;
#define FOX_GLOAD(j_) do { _Pragma("unroll") for (int p = 0; p < 2; ++p) { \
                const bf16_t* rp = H + (rowbase + 64 * (j_) + srow + 32 * p) * NH + h * 128 + sch * 8; \
                kreg[p] = *(const u32x4*)(rp + HC_FK); vreg[p] = *(const u32x4*)(rp + HC_FV); } \
            if (C.tid < 64) breg = (c0 - cm[64 * (j_) + C.tid]) * LOG2E; } while (0)
#define FOX_LWRITE(buf_) do { _Pragma("unroll") for (int p = 0; p < 2; ++p) { \
                *(LAS u32x4*)(lds + FOX_KB + (buf_) * 64 * FOX_KST + (srow + 32 * p) * FOX_KST + sch * 16) = kreg[p]; \
                *(LAS u32x4*)(lds + FOX_VB + (buf_) * 64 * FOX_VST + (srow + 32 * p) * FOX_VST + sch * 16) = vreg[p]; } \
            if (C.tid < 64) betaL[(buf_) * 64 + C.tid] = breg; } while (0)
        __syncthreads();
        if (C.tid < 16) flagL[C.tid] = 0;
        FOX_GLOAD(jmax); FOX_LWRITE(jmax & 1);
        bool wdone = false;
        for (int j = jmax; j >= 0; --j) {
            const int cur = j & 1;
            __syncthreads();
            if (j < jmax) { int all = 1;
#pragma unroll
                for (int i = 0; i < 8; ++i) all &= flagL[((j + 1) & 1) * 8 + i];
                if (all) break; }
            if (j > 0) FOX_GLOAD(j - 1);
            const int k0 = 64 * j;
            if (k0 <= qw + 31 && !wdone) {
                const LAS unsigned char* kb = lds + FOX_KB + cur * 64 * FOX_KST;
                const LAS unsigned char* vb = lds + FOX_VB + cur * 64 * FOX_VST;
                f32x16 sacc[2];
#pragma unroll
                for (int mt = 0; mt < 2; ++mt)
#pragma unroll
                    for (int g = 0; g < 4; ++g) { const f32x4 bv = *(const LAS f32x4*)(betaL + cur * 64 + 32 * mt + 8 * g + 4 * hh);
                        sacc[mt][4 * g] = bv[0]; sacc[mt][4 * g + 1] = bv[1]; sacc[mt][4 * g + 2] = bv[2]; sacc[mt][4 * g + 3] = bv[3]; }
#pragma unroll
                for (int ks = 0; ks < 8; ++ks)
#pragma unroll
                    for (int mt = 0; mt < 2; ++mt) {
                        const bf16x8 kf = *(const LAS bf16x8*)(kb + (32 * mt + r32) * FOX_KST + 32 * ks + 16 * hh);
                        sacc[mt] = MFMA32(kf, qf[ks], sacc[mt]);
                    }
                const int tq = qw + r32;
                if (k0 + 63 > qw) {
#pragma unroll
                    for (int mt = 0; mt < 2; ++mt)
#pragma unroll
                        for (int i = 0; i < 16; ++i) { const int key = k0 + 32 * mt + (i & 3) + 8 * (i >> 2) + 4 * hh; if (key > tq) sacc[mt][i] = -1e30f; }
                }
                float mx = sacc[0][0];
#pragma unroll
                for (int mt = 0; mt < 2; ++mt)
#pragma unroll
                    for (int i = 0; i < 16; ++i) mx = fmaxf(mx, sacc[mt][i]);
                mx = fmaxf(mx, xor32(mx));
                const float mn = fmaxf(m_run, mx), alpha = __builtin_amdgcn_exp2f(m_run - mn);
                m_run = mn;
                float ps = 0.f;
#pragma unroll
                for (int mt = 0; mt < 2; ++mt)
#pragma unroll
                    for (int i = 0; i < 16; ++i) { const float p = __builtin_amdgcn_exp2f(sacc[mt][i] - mn); sacc[mt][i] = p; ps += p; }
                l_run = l_run * alpha + ps;
#pragma unroll
                for (int mt = 0; mt < 4; ++mt)
#pragma unroll
                    for (int i = 0; i < 16; ++i) oacc[mt][i] *= alpha;
#pragma unroll
                for (int s4 = 0; s4 < 4; ++s4) {
                    const int mtk = s4 >> 1, s = s4 & 1;
                    u32x4 pb;
#pragma unroll
                    for (int e = 0; e < 4; ++e) pb[e] = cvtpk(sacc[mtk][8 * s + 2 * e], sacc[mtk][8 * s + 2 * e + 1]);
                    const bf16x8 pfrag = __builtin_bit_cast(bf16x8, pb);
                    const int i16 = lane & 15, q4 = i16 >> 2, p4 = i16 & 3, blk = (lane >> 4) & 1;
                    const int keyA = 32 * mtk + 16 * s + 4 * hh + q4;
#pragma unroll
                    for (int mt = 0; mt < 4; ++mt) {
                        const LAS unsigned char* a0 = vb + keyA * FOX_VST + (32 * mt + 16 * blk + 4 * p4) * 2;
                        const s16x4 lo = vtr(a0), hi = vtr(a0 + 8 * FOX_VST);
                        const bf16x8 vf = __builtin_shufflevector(lo, hi, 0, 1, 2, 3, 4, 5, 6, 7);
                        oacc[mt] = MFMA32(vf, pfrag, oacc[mt]);
                    }
                }
                if (j > 0) { const float bl = (c0 - cm[k0 - 1]) * LOG2E;
                    const int ok = (qbound + bl < m_run - 152.f) ? 1 : 0;
                    wdone = __all(ok); }
            }
            if (lane == 0) flagL[cur * 8 + w] = wdone ? 1 : 0;
            if (j > 0) FOX_LWRITE(cur ^ 1);
        }
        l_run += xor32(l_run);
        const float inv = 1.f / l_run;
        bf16_t* op = BR + (rowbase + qw + r32) * NBR + 1536 + h * 128;
#pragma unroll
        for (int mt = 0; mt < 4; ++mt)
#pragma unroll
            for (int g = 0; g < 4; ++g) { u32x2 o; o[0] = cvtpk(oacc[mt][4 * g] * inv, oacc[mt][4 * g + 1] * inv); o[1] = cvtpk(oacc[mt][4 * g + 2] * inv, oacc[mt][4 * g + 3] * inv);
                *(u32x2*)(op + 32 * mt + 8 * g + 4 * hh) = o; }
    }
}


constexpr int HG_LF = 0, HG_QA = 34816, HG_QB = HG_QA + 17408, HG_KD = HG_QB + 8704, HG_KO = HG_KD + 17408, HG_KT = HG_KO + 8704, HG_VN = HG_KT + 20480, HG_AM = HG_VN + 20480, HG_END = HG_AM + 12288;
constexpr int HG_LFS = 132;
static_assert(HG_END + 2048 <= 140 * 1024, "hgrn LDS");
constexpr size_t WS_DSC = WS_ST + (size_t)BATCH * 4 * 32 * 128 * 128 * 4;

template <bool FULL>
__device__ __forceinline__ void hgrn_unit(const Ctx& C, int l, int u) {
#if DIAG == 1
    const bf16_t* H = (const bf16_t*)(C.ws + WS_H); bf16_t* BR = (l == 0) ? (bf16_t*)(C.ws + WS_XA) : (bf16_t*)(C.ws + WS_TABU);
#else
    const bf16_t* H = (const bf16_t*)(C.ws + WS_H); bf16_t* BR = (bf16_t*)(C.ws + WS_BR);
#endif
    float* STB = (float*)(C.ws + WS_ST); float* DSC = (float*)(C.ws + WS_DSC);
    LAS unsigned char* lds = C.lds;
    LAS float* LF = (LAS float*)(lds + HG_LF);
    const int lane = C.lane, w = C.wave, r32 = lane & 31, hh = lane >> 5;
    const int sc = u & 31, bh = u >> 5, b = bh >> 2, h = bh & 3;
    const int wk = w >> 1, wv = w & 1;
    const int mt = w >> 2, nt = w & 3;
    const int i16 = lane & 15, q4 = i16 >> 2, p4 = i16 & 3, blk = (lane >> 4) & 1;
    f32x16 S0, S1;
    float* stp = STB + ((size_t)bh * 32 + sc) * 128 * 128;
    if constexpr (FULL) {
#pragma unroll
        for (int i = 0; i < 16; ++i) { const int k = 32 * wk + (i & 3) + 8 * (i >> 2) + 4 * hh;
            S0[i] = stp[k * 128 + 64 * wv + r32]; S1[i] = stp[k * 128 + 64 * wv + 32 + r32]; }
    } else {
#pragma unroll
        for (int i = 0; i < 16; ++i) { S0[i] = 0.f; S1[i] = 0.f; }
    }
    float dtot = 0.f;
    const int ps = C.tid >> 3, pseg = C.tid & 7;
    float lbv[16];
#pragma unroll
    for (int j = 0; j < 16; ++j) { lbv[j] = 0.f;
        if (l == 1) { const int ch = h * 128 + 16 * pseg + j; lbv[j] = 1.f / (1.f + __expf(C.in[I_LBL][ch] - C.in[I_LBL][BW + ch])); } }
    for (int c = 0; c < 4; ++c) {
        const size_t row0 = (size_t)b * SEQ + sc * 256 + c * 64;
        const bf16_t* hp = H + (row0 + ps) * NH + h * 128 + 16 * pseg;
        float kkv[16], qsv[16];
        u32x4 vraw0, vraw1;
        {
            const u32x4 f0 = *(const u32x4*)(hp + HC_HF), f1 = *(const u32x4*)(hp + HC_HF + 8);
            vraw0 = *(const u32x4*)(hp + HC_HI); vraw1 = *(const u32x4*)(hp + HC_HI + 8);
#pragma unroll
            for (int j = 0; j < 8; ++j) { const unsigned r = (j < 4) ? f0[j] : f1[j - 4];
                const float z0 = bf2f(r & 0xffffu), z1 = bf2f(r >> 16);
                kkv[2 * j] = (1.f - lbv[2 * j]) * sigmoidf_(-z0); kkv[2 * j + 1] = (1.f - lbv[2 * j + 1]) * sigmoidf_(-z1); }
            if constexpr (FULL) {
                const u32x4 q0 = *(const u32x4*)(hp + HC_HQ), q1 = *(const u32x4*)(hp + HC_HQ + 8);
#pragma unroll
                for (int j = 0; j < 8; ++j) { const unsigned r = (j < 4) ? q0[j] : q1[j - 4]; qsv[2 * j] = siluf_(bf2f(r & 0xffffu)); qsv[2 * j + 1] = siluf_(bf2f(r >> 16)); }
            }
#pragma unroll
            for (int j4 = 0; j4 < 4; ++j4) { f32x4 o;
#pragma unroll
                for (int e = 0; e < 4; ++e) o[e] = __logf(1.f - kkv[4 * j4 + e]);
                *(LAS f32x4*)(LF + ps * HG_LFS + 16 * pseg + 4 * j4) = o; }
        }
        __syncthreads();
        {
            const int sk = C.tid & 127, sg = C.tid >> 7;
            float vals[16];
#pragma unroll
            for (int i = 0; i < 16; ++i) vals[i] = LF[(16 * sg + i) * HG_LFS + sk];
#pragma unroll
            for (int i = 1; i < 16; ++i) vals[i] += vals[i - 1];
            LAS float* TOT = (LAS float*)(lds + HG_END);
            TOT[sg * 128 + sk] = vals[15];
            __syncthreads();
            float off = 0.f;
#pragma unroll
            for (int j = 0; j < 3; ++j) if (j < sg) off += TOT[j * 128 + sk];
#pragma unroll
            for (int i = 0; i < 16; ++i) LF[(16 * sg + i) * HG_LFS + sk] = vals[i] + off;
            if (sg == 3) dtot += vals[15] + off;
        }
        __syncthreads();
        float bv[16], b31[16], bl[16];
#pragma unroll
        for (int j4 = 0; j4 < 4; ++j4) { const f32x4 x = *(const LAS f32x4*)(LF + ps * HG_LFS + 16 * pseg + 4 * j4), y = *(const LAS f32x4*)(LF + 31 * HG_LFS + 16 * pseg + 4 * j4), z = *(const LAS f32x4*)(LF + 63 * HG_LFS + 16 * pseg + 4 * j4);
#pragma unroll
            for (int e = 0; e < 4; ++e) { bv[4 * j4 + e] = x[e]; b31[4 * j4 + e] = y[e]; bl[4 * j4 + e] = z[e]; } }
        {
            u32x4 o0, o1;
#pragma unroll
            for (int j = 0; j < 4; ++j) { o0[j] = cvtpk(kkv[2 * j] * __expf(bl[2 * j] - bv[2 * j]), kkv[2 * j + 1] * __expf(bl[2 * j + 1] - bv[2 * j + 1]));
                o1[j] = cvtpk(kkv[8 + 2 * j] * __expf(bl[8 + 2 * j] - bv[8 + 2 * j]), kkv[9 + 2 * j] * __expf(bl[9 + 2 * j] - bv[9 + 2 * j])); }
            *(LAS u32x4*)(lds + HG_KT + ps * 320 + 32 * pseg) = o0; *(LAS u32x4*)(lds + HG_KT + ps * 320 + 32 * pseg + 16) = o1;
            *(LAS u32x4*)(lds + HG_VN + ps * 320 + 32 * pseg) = vraw0; *(LAS u32x4*)(lds + HG_VN + ps * 320 + 32 * pseg + 16) = vraw1;
            if constexpr (FULL) {
                const bool hi = ps >= 32;
                float rr[16];
#pragma unroll
                for (int j = 0; j < 16; ++j) rr[j] = hi ? b31[j] : 0.f;
#pragma unroll
                for (int j = 0; j < 4; ++j) { o0[j] = cvtpk(qsv[2 * j] * __expf(bv[2 * j] - rr[2 * j]), qsv[2 * j + 1] * __expf(bv[2 * j + 1] - rr[2 * j + 1]));
                    o1[j] = cvtpk(qsv[8 + 2 * j] * __expf(bv[8 + 2 * j] - rr[8 + 2 * j]), qsv[9 + 2 * j] * __expf(bv[9 + 2 * j] - rr[9 + 2 * j])); }
                *(LAS u32x4*)(lds + HG_QA + ps * 272 + 32 * pseg) = o0; *(LAS u32x4*)(lds + HG_QA + ps * 272 + 32 * pseg + 16) = o1;
#pragma unroll
                for (int j = 0; j < 4; ++j) { o0[j] = cvtpk(kkv[2 * j] * __expf(rr[2 * j] - bv[2 * j]), kkv[2 * j + 1] * __expf(rr[2 * j + 1] - bv[2 * j + 1]));
                    o1[j] = cvtpk(kkv[8 + 2 * j] * __expf(rr[8 + 2 * j] - bv[8 + 2 * j]), kkv[9 + 2 * j] * __expf(rr[9 + 2 * j] - bv[9 + 2 * j])); }
                *(LAS u32x4*)(lds + HG_KD + ps * 272 + 32 * pseg) = o0; *(LAS u32x4*)(lds + HG_KD + ps * 272 + 32 * pseg + 16) = o1;
                if (hi) {
#pragma unroll
                    for (int j = 0; j < 4; ++j) { o0[j] = cvtpk(qsv[2 * j] * __expf(bv[2 * j]), qsv[2 * j + 1] * __expf(bv[2 * j + 1]));
                        o1[j] = cvtpk(qsv[8 + 2 * j] * __expf(bv[8 + 2 * j]), qsv[9 + 2 * j] * __expf(bv[9 + 2 * j])); }
                    *(LAS u32x4*)(lds + HG_QB + (ps - 32) * 272 + 32 * pseg) = o0; *(LAS u32x4*)(lds + HG_QB + (ps - 32) * 272 + 32 * pseg + 16) = o1;
                } else {
#pragma unroll
                    for (int j = 0; j < 4; ++j) { o0[j] = cvtpk(kkv[2 * j] * __expf(b31[2 * j] - bv[2 * j]), kkv[2 * j + 1] * __expf(b31[2 * j + 1] - bv[2 * j + 1]));
                        o1[j] = cvtpk(kkv[8 + 2 * j] * __expf(b31[8 + 2 * j] - bv[8 + 2 * j]), kkv[9 + 2 * j] * __expf(b31[9 + 2 * j] - bv[9 + 2 * j])); }
                    *(LAS u32x4*)(lds + HG_KO + ps * 272 + 32 * pseg) = o0; *(LAS u32x4*)(lds + HG_KO + ps * 272 + 32 * pseg + 16) = o1;
                }
            }
        }
        float dk[16];
#pragma unroll
        for (int i = 0; i < 16; ++i) dk[i] = __expf(LF[63 * HG_LFS + 32 * wk + (i & 3) + 8 * (i >> 2) + 4 * hh]);
        __syncthreads();
        if constexpr (FULL) {
#pragma unroll
            for (int g = 0; g < 4; ++g) {
                u32x2 o; o[0] = cvtpk(S0[4 * g], S0[4 * g + 1]); o[1] = cvtpk(S0[4 * g + 2], S0[4 * g + 3]);
                *(LAS u32x2*)(lds + HG_LF + (64 * wv + r32) * 272 + (32 * wk + 8 * g + 4 * hh) * 2) = o;
                o[0] = cvtpk(S1[4 * g], S1[4 * g + 1]); o[1] = cvtpk(S1[4 * g + 2], S1[4 * g + 3]);
                *(LAS u32x2*)(lds + HG_LF + (64 * wv + 32 + r32) * 272 + (32 * wk + 8 * g + 4 * hh) * 2) = o;
            }
#define HG_ATILE(AMT_, AST_) do { \
                const LAS unsigned char* kb = ((AMT_) == (AST_)) ? (lds + HG_KD + (32 * (AST_)) * 272) : (lds + HG_KO); \
                f32x16 a; \
                _Pragma("unroll") for (int i = 0; i < 16; ++i) a[i] = 0.f; \
                _Pragma("unroll") for (int ks = 0; ks < 8; ++ks) { \
                    const bf16x8 af = *(const LAS bf16x8*)(lds + HG_QA + (32 * (AMT_) + r32) * 272 + 32 * ks + 16 * hh); \
                    const bf16x8 bf = *(const LAS bf16x8*)(kb + r32 * 272 + 32 * ks + 16 * hh); \
                    a = MFMA32(af, bf, a); } \
                _Pragma("unroll") for (int g = 0; g < 4; ++g) { \
                    float x[4]; \
                    _Pragma("unroll") for (int e = 0; e < 4; ++e) { const int tl = 8 * g + 4 * hh + e; x[e] = ((AMT_) != (AST_) || r32 <= tl) ? a[4 * g + e] : 0.f; } \
                    u32x2 o; o[0] = cvtpk(x[0], x[1]); o[1] = cvtpk(x[2], x[3]); \
                    *(LAS u32x2*)(lds + HG_AM + (32 * (AST_) + r32) * 192 + (32 * (AMT_) + 8 * g + 4 * hh) * 2) = o; } } while (0)
            if (w == 0) { HG_ATILE(0, 0); }
            else if (w == 1) { HG_ATILE(1, 0); }
            else if (w == 2) { HG_ATILE(1, 1); }
        }
#pragma unroll
        for (int i = 0; i < 16; ++i) { S0[i] *= dk[i]; S1[i] *= dk[i]; }
#pragma unroll
        for (int ks = 0; ks < 4; ++ks) {
            const LAS unsigned char* ka = lds + HG_KT + (16 * ks + 8 * hh + q4) * 320 + (32 * wk + 16 * blk + 4 * p4) * 2;
            const s16x4 alo = vtr(ka), ahi = vtr(ka + 4 * 320);
            const bf16x8 af = __builtin_shufflevector(alo, ahi, 0, 1, 2, 3, 4, 5, 6, 7);
            const LAS unsigned char* vb0 = lds + HG_VN + (16 * ks + 8 * hh + q4) * 320 + (64 * wv + 16 * blk + 4 * p4) * 2;
            const s16x4 b0lo = vtr(vb0), b0hi = vtr(vb0 + 4 * 320), b1lo = vtr(vb0 + 64), b1hi = vtr(vb0 + 64 + 4 * 320);
            S0 = MFMA32(af, __builtin_shufflevector(b0lo, b0hi, 0, 1, 2, 3, 4, 5, 6, 7), S0);
            S1 = MFMA32(af, __builtin_shufflevector(b1lo, b1hi, 0, 1, 2, 3, 4, 5, 6, 7), S1);
        }
        if constexpr (FULL) {
            __syncthreads();
            f32x16 o;
#pragma unroll
            for (int i = 0; i < 16; ++i) o[i] = 0.f;
            const LAS unsigned char* qb = (mt == 0) ? (lds + HG_QA) : (lds + HG_QB);
#pragma unroll
            for (int ks = 0; ks < 8; ++ks) {
                const bf16x8 af = *(const LAS bf16x8*)(qb + r32 * 272 + 32 * ks + 16 * hh);
                const bf16x8 bf = *(const LAS bf16x8*)(lds + HG_LF + (32 * nt + r32) * 272 + 32 * ks + 16 * hh);
                o = MFMA32(af, bf, o);
            }
#pragma unroll
            for (int ks = 0; ks < 4; ++ks) {
                if (mt == 0 && ks >= 2) continue;
                const LAS unsigned char* aa = lds + HG_AM + (16 * ks + 8 * hh + q4) * 192 + (32 * mt + 16 * blk + 4 * p4) * 2;
                const s16x4 alo = vtr(aa), ahi = vtr(aa + 4 * 192);
                const LAS unsigned char* vb0 = lds + HG_VN + (16 * ks + 8 * hh + q4) * 320 + (32 * nt + 16 * blk + 4 * p4) * 2;
                const s16x4 blo = vtr(vb0), bhi = vtr(vb0 + 4 * 320);
                o = MFMA32(__builtin_shufflevector(alo, ahi, 0, 1, 2, 3, 4, 5, 6, 7), __builtin_shufflevector(blo, bhi, 0, 1, 2, 3, 4, 5, 6, 7), o);
            }
            __syncthreads();
#pragma unroll
            for (int i = 0; i < 16; ++i) LF[(32 * mt + (i & 3) + 8 * (i >> 2) + 4 * hh) * HG_LFS + 32 * nt + r32] = o[i];
            __syncthreads();
            {
                float ov[16]; float ss = 0.f;
#pragma unroll
                for (int j4 = 0; j4 < 4; ++j4) { const f32x4 x = *(const LAS f32x4*)(LF + ps * HG_LFS + 16 * pseg + 4 * j4);
#pragma unroll
                    for (int e = 0; e < 4; ++e) { ov[4 * j4 + e] = x[e]; ss += x[e] * x[e]; } }
                ss += __shfl_xor(ss, 1, 64); ss += __shfl_xor(ss, 2, 64); ss += __shfl_xor(ss, 4, 64);
                const float rn = rsqrtf(ss * (1.f / 128.f) + RMS_EPS);
                const u32x4 g0 = *(const u32x4*)(hp + HC_HG), g1 = *(const u32x4*)(hp + HC_HG + 8);
                const float* ng = C.in[I_HNG] + l * 128 + 16 * pseg;
                u32x4 o0, o1;
#pragma unroll
                for (int j = 0; j < 4; ++j) {
                    o0[j] = cvtpk(ov[2 * j] * rn * ng[2 * j] * siluf_(bf2f(g0[j] & 0xffffu)), ov[2 * j + 1] * rn * ng[2 * j + 1] * siluf_(bf2f(g0[j] >> 16)));
                    o1[j] = cvtpk(ov[8 + 2 * j] * rn * ng[8 + 2 * j] * siluf_(bf2f(g1[j] & 0xffffu)), ov[9 + 2 * j] * rn * ng[9 + 2 * j] * siluf_(bf2f(g1[j] >> 16)));
                }
                bf16_t* bp = BR + (row0 + ps) * NBR + 512 + h * 128 + 16 * pseg;
                *(u32x4*)bp = o0; *(u32x4*)(bp + 8) = o1;
            }
        }
        __syncthreads();
    }
    if constexpr (!FULL) {
#pragma unroll
        for (int i = 0; i < 16; ++i) { const int k = 32 * wk + (i & 3) + 8 * (i >> 2) + 4 * hh;
            stp[k * 128 + 64 * wv + r32] = S0[i]; stp[k * 128 + 64 * wv + 32 + r32] = S1[i]; }
        if (C.tid >= 384) DSC[((size_t)bh * 32 + sc) * 128 + (C.tid & 127)] = __expf(dtot);
    }
}
__device__ __forceinline__ void hgrn_b1(const Ctx& C, int l) { for (int u = C.bid; u < BATCH * 4 * 32; u += C.G) hgrn_unit<false>(C, l, u); }
__device__ __forceinline__ void hgrn_b3(const Ctx& C, int l) { for (int u = C.bid; u < BATCH * 4 * 32; u += C.G) hgrn_unit<true>(C, l, u); }
__device__ __forceinline__ void hgrn_b2(const Ctx& C) {
    float* STB = (float*)(C.ws + WS_ST); const float* DSC = (const float*)(C.ws + WS_DSC);
    for (int e = C.bid * 512 + C.tid; e < BATCH * 4 * 128 * 128; e += C.G * 512) {
        const int bh = e >> 14, kv = e & 16383, k = kv >> 7;
        float* p = STB + (size_t)bh * 32 * 16384 + kv;
        float uu[32], dd[32];
#pragma unroll
        for (int s = 0; s < 32; ++s) { uu[s] = p[(size_t)s * 16384]; dd[s] = DSC[((size_t)bh * 32 + s) * 128 + k]; }
        float st = 0.f;
#pragma unroll
        for (int s = 0; s < 32; ++s) { p[(size_t)s * 16384] = st; st = dd[s] * st + uu[s]; }
    }
}


__device__ __forceinline__ void mix_pool(const Ctx& C, int l) {
#if DIAG == 2
    const bf16_t* H = (const bf16_t*)(C.ws + WS_H); bf16_t* BR = (l == 0) ? (bf16_t*)(C.ws + WS_XA) : (bf16_t*)(C.ws + WS_TABU);
#else
    const bf16_t* H = (const bf16_t*)(C.ws + WS_H); bf16_t* BR = (bf16_t*)(C.ws + WS_BR);
#endif
    const bf16_t* Wt = (const bf16_t*)(C.ws + WS_W + (size_t)l * W_LAYER + WO_POOLW);
    LAS unsigned char* lds = C.lds;
    const int lane = C.lane, w = C.wave, r32 = lane & 31, hh = lane >> 5;
    for (int u = C.bid; u < (T / 256) * 4; u += C.G) {
        const int g = u & 3, t0 = (u >> 2) * 256, win = 2 << g;
        const int row = t0 + 32 * w + r32, pos = row & (SEQ - 1);
        __syncthreads();
#pragma unroll
        for (int p = 0; p < 4; ++p) { const int idx = C.tid + 512 * p, rr = idx >> 4, ch = idx & 15;
            *(LAS u32x4*)(lds + rr * 272 + ch * 16) = *(const u32x4*)(Wt + (size_t)g * 128 * 128 + rr * 128 + ch * 8); }
        const int nwin = (pos + 1 < win) ? pos + 1 : win;
        const float invn = 1.f / (float)nwin;
        bf16x8 df[8];
        const bf16_t* pp = H + (size_t)row * NH + HC_P + g * 128 + 8 * hh;
#pragma unroll
        for (int ks = 0; ks < 8; ++ks) {
            float sum[8];
#pragma unroll
            for (int e = 0; e < 8; ++e) sum[e] = 0.f;
            u32x4 rw[16];
#pragma unroll
            for (int j = 0; j < 16; ++j) { const int jj = (j < nwin) ? j : 0; rw[j] = *(const u32x4*)(pp + 16 * ks - (size_t)jj * NH); }
            const u32x4 self = rw[0];
#pragma unroll
            for (int j = 0; j < 16; ++j) { const float msk = (j < nwin) ? 1.f : 0.f;
#pragma unroll
                for (int e = 0; e < 4; ++e) { sum[2 * e] += msk * bf2f(rw[j][e] & 0xffffu); sum[2 * e + 1] += msk * bf2f(rw[j][e] >> 16); } }
            u32x4 o;
#pragma unroll
            for (int e = 0; e < 4; ++e) o[e] = cvtpk(sum[2 * e] * invn - bf2f(self[e] & 0xffffu), sum[2 * e + 1] * invn - bf2f(self[e] >> 16));
            df[ks] = __builtin_bit_cast(bf16x8, o);
        }
        __syncthreads();
        f32x16 acc[4];
#pragma unroll
        for (int mt = 0; mt < 4; ++mt)
#pragma unroll
            for (int i = 0; i < 16; ++i) acc[mt][i] = 0.f;
#pragma unroll
        for (int ks = 0; ks < 8; ++ks)
#pragma unroll
            for (int mt = 0; mt < 4; ++mt) {
                const bf16x8 wf = *(const LAS bf16x8*)(lds + (32 * mt + r32) * 272 + 32 * ks + 16 * hh);
                acc[mt] = MFMA32(wf, df[ks], acc[mt]);
            }
        const float* psc = C.in[I_POOLS] + l * BW + g * 128;
        bf16_t* op = BR + (size_t)row * NBR + g * 128;
#pragma unroll
        for (int mt = 0; mt < 4; ++mt)
#pragma unroll
            for (int q = 0; q < 4; ++q) { const int d0 = 32 * mt + 8 * q + 4 * hh; const f32x4 sc = *(const f32x4*)(psc + d0);
                u32x2 o; o[0] = cvtpk(acc[mt][4 * q] * sc[0], acc[mt][4 * q + 1] * sc[1]); o[1] = cvtpk(acc[mt][4 * q + 2] * sc[2], acc[mt][4 * q + 3] * sc[3]);
                *(u32x2*)(op + d0) = o; }
    }
}
constexpr int GM_VN = 0, GM_WC = 128 * 320, GM_END = GM_WC + 128 * 272;
__device__ __forceinline__ void mix_gmlp(const Ctx& C, int l) {
#if DIAG == 3
    const bf16_t* H = (const bf16_t*)(C.ws + WS_H); bf16_t* BR = (l == 0) ? (bf16_t*)(C.ws + WS_XA) : (bf16_t*)(C.ws + WS_TABU);
#else
    const bf16_t* H = (const bf16_t*)(C.ws + WS_H); bf16_t* BR = (bf16_t*)(C.ws + WS_BR);
#endif
    const bf16_t* Wc = (const bf16_t*)(C.ws + WS_W + (size_t)l * W_LAYER + WO_GWS);
    LAS unsigned char* lds = C.lds;
    const int lane = C.lane, w = C.wave, r32 = lane & 31, hh = lane >> 5;
    const int i16 = lane & 15, q4 = i16 >> 2, p4 = i16 & 3, blk = (lane >> 4) & 1;
    for (int u = C.bid; u < (T / 128) * 4; u += C.G) {
        const int g = u & 3, t0 = (u >> 2) * 128;
        __syncthreads();
#pragma unroll
        for (int p = 0; p < 4; ++p) { const int idx = C.tid + 512 * p, rr = idx >> 4, ch = idx & 15;
            *(LAS u32x4*)(lds + GM_WC + rr * 272 + ch * 16) = *(const u32x4*)(Wc + (size_t)g * 128 * 128 + rr * 128 + ch * 8); }
#pragma unroll
        for (int hb = 0; hb < 4; ++hb) {
            u32x4 rawv[4];
#pragma unroll
            for (int i = 0; i < 4; ++i) rawv[i] = *(const u32x4*)(H + (size_t)(t0 + w * 16 + hb * 4 + i) * NH + HC_GV + lane * 8);
            float e[4][8], st[8];
#pragma unroll
            for (int i = 0; i < 4; ++i) { float s1 = 0.f, s2 = 0.f;
#pragma unroll
                for (int j = 0; j < 4; ++j) { const float a = geluf_(bf2f(rawv[i][j] & 0xffffu)), b = geluf_(bf2f(rawv[i][j] >> 16)); e[i][2 * j] = a; e[i][2 * j + 1] = b; s1 += a + b; s2 += a * a + b * b; }
                st[i] = s1; st[4 + i] = s2; }
#pragma unroll
            for (int sx = 32, n = 4; sx >= 8; sx >>= 1, n >>= 1) { const bool up = (lane & sx) != 0;
#pragma unroll
                for (int i = 0; i < n; ++i) { const float send = up ? st[i] : st[i + n], keep = up ? st[i + n] : st[i]; st[i] = keep + __shfl_xor(send, sx, 64); } }
            float tot = st[0]; tot += __shfl_xor(tot, 4, 64); tot += __shfl_xor(tot, 2, 64); tot += __shfl_xor(tot, 1, 64);
            float mean4[4], rstd4[4];
#pragma unroll
            for (int i = 0; i < 4; ++i) {
                mean4[i] = __builtin_bit_cast(float, __builtin_amdgcn_readlane(__builtin_bit_cast(int, tot), 8 * i)) * (1.f / BW);
                const float ex2 = __builtin_bit_cast(float, __builtin_amdgcn_readlane(__builtin_bit_cast(int, tot), 8 * (4 + i))) * (1.f / BW);
                rstd4[i] = rsqrtf(fmaxf(ex2 - mean4[i] * mean4[i], 0.f) + LN_EPS);
            }
            asm volatile("" ::: "memory");
            if ((lane >> 4) == g) {
                const float* lg = C.in[I_GLNG] + l * BW + lane * 8; const float* lb = C.in[I_GLNB] + l * BW + lane * 8;
#pragma unroll
                for (int i = 0; i < 4; ++i) {
                    const float mean = mean4[i], rstd = rstd4[i];
                    u32x4 o;
#pragma unroll
                    for (int j = 0; j < 4; ++j) o[j] = cvtpk((e[i][2 * j] - mean) * rstd * lg[2 * j] + lb[2 * j], (e[i][2 * j + 1] - mean) * rstd * lg[2 * j + 1] + lb[2 * j + 1]);
                    *(LAS u32x4*)(lds + GM_VN + (w * 16 + hb * 4 + i) * 320 + (lane & 15) * 16) = o;
                }
            }
        }
        __syncthreads();
        const int nt = w & 3, mb = (w >> 2) * 2;
        f32x16 acc[2];
#pragma unroll
        for (int m = 0; m < 2; ++m)
#pragma unroll
            for (int i = 0; i < 16; ++i) acc[m][i] = 0.f;
        for (int ks = 0; ks < 2 * (nt + 1); ++ks) {
            const bf16x8 bf = *(const LAS bf16x8*)(lds + GM_WC + (32 * nt + r32) * 272 + 32 * ks + 16 * hh);
#pragma unroll
            for (int m = 0; m < 2; ++m) {
                const LAS unsigned char* aa = lds + GM_VN + (16 * ks + 8 * hh + q4) * 320 + (32 * (mb + m) + 16 * blk + 4 * p4) * 2;
                const s16x4 lo = vtr(aa), hi = vtr(aa + 4 * 320);
                acc[m] = MFMA32(__builtin_shufflevector(lo, hi, 0, 1, 2, 3, 4, 5, 6, 7), bf, acc[m]);
            }
        }
        const int tl = 32 * nt + r32, row = t0 + tl;
        const float bias = C.in[I_GBS][(l * 4 + g) * 128 + tl];
#pragma unroll
        for (int m = 0; m < 2; ++m)
#pragma unroll
            for (int q = 0; q < 4; ++q) { const int c0 = 32 * (mb + m) + 8 * q + 4 * hh;
                const u32x2 ur = *(const u32x2*)(H + (size_t)row * NH + HC_GU + g * 128 + c0);
                u32x2 o;
                o[0] = cvtpk(geluf_(bf2f(ur[0] & 0xffffu)) * (acc[m][4 * q] + bias), geluf_(bf2f(ur[0] >> 16)) * (acc[m][4 * q + 1] + bias));
                o[1] = cvtpk(geluf_(bf2f(ur[1] & 0xffffu)) * (acc[m][4 * q + 2] + bias), geluf_(bf2f(ur[1] >> 16)) * (acc[m][4 * q + 3] + bias));
                *(u32x2*)(BR + (size_t)row * NBR + 1024 + g * 128 + c0) = o; }
    }
}

#define CE_D(a, b) do { const float _h = fmaxf(a, b), _l = fminf(a, b); a = _h; b = _l; } while (0)
__device__ __forceinline__ void sort16_desc(float (&x)[16]) {
#pragma unroll
    for (int k = 2; k <= 16; k <<= 1)
#pragma unroll
        for (int j = k >> 1; j > 0; j >>= 1)
#pragma unroll
            for (int i = 0; i < 16; ++i) { const int l = i ^ j; if (l > i) { if ((i & k) == 0) CE_D(x[i], x[l]); else CE_D(x[l], x[i]); } }
}
__device__ __forceinline__ void bmerge16_desc(float (&x)[16]) {
#pragma unroll
    for (int j = 8; j > 0; j >>= 1)
#pragma unroll
        for (int i = 0; i < 16; ++i) { const int l = i ^ j; if (l > i) CE_D(x[i], x[l]); }
}
__device__ __forceinline__ void top16_merge(float (&a)[16], const float (&b)[16]) {
#pragma unroll
    for (int i = 0; i < 16; ++i) a[i] = fmaxf(a[i], b[15 - i]);
    bmerge16_desc(a);
}
__device__ __forceinline__ float pack_idx(float v, unsigned idx, unsigned mask) { return __builtin_bit_cast(float, (__builtin_bit_cast(unsigned, v) & ~mask) | idx); }

constexpr int TK_KST = 272, TK_KBUF = 128 * TK_KST;
__device__ __forceinline__ void p_topk(const Ctx& C, int l) {
    const bf16_t* Q = (const bf16_t*)(C.ws + WS_Q);
    const bf16_t* keys = (const bf16_t*)(C.ws + WS_W + (size_t)l * W_LAYER + WO_KEYS);
    int* eidx = (int*)(C.ws + WS_EIDX); float* egate = (float*)(C.ws + WS_EGATE);
    LAS unsigned char* lds = C.lds;
    const int lane = C.lane, w = C.wave, r32 = lane & 31, hh = lane >> 5;
    for (int u = C.bid; u < (T / 256) * PH; u += C.G) {
        const int h = u & 7, t0 = (u >> 3) * 256, tok = t0 + 32 * w + r32;
        float v12[2][16];
        __syncthreads();
#pragma unroll
        for (int j = 0; j < 2; ++j) {
            const bf16_t* kp = keys + ((size_t)j * PH + h) * 128 * 128;
#pragma unroll
            for (int p = 0; p < 4; ++p) { const int idx = C.tid + 512 * p, row = idx >> 4, ch = idx & 15;
                *(LAS u32x4*)(lds + j * TK_KBUF + row * TK_KST + ch * 16) = *(const u32x4*)(kp + row * 128 + ch * 8); }
        }
        __syncthreads();
#pragma unroll
        for (int j = 0; j < 2; ++j) {
            bf16x8 qf[8];
            {
                LAS unsigned char* qs = lds + 2 * TK_KBUF + w * (32 * 272);
                u32x4 qr[8];
#pragma unroll
                for (int p = 0; p < 8; ++p) qr[p] = *(const u32x4*)(Q + (size_t)(t0 + 32 * w + 4 * p + (lane >> 4)) * NQ + h * 256 + j * 128 + (lane & 15) * 8);
#pragma unroll
                for (int p = 0; p < 8; ++p) *(LAS u32x4*)(qs + (4 * p + (lane >> 4)) * 272 + (lane & 15) * 16) = qr[p];
#pragma unroll
                for (int ks = 0; ks < 8; ++ks) qf[ks] = *(const LAS bf16x8*)(qs + r32 * 272 + 32 * ks + 16 * hh);
            }
            f32x16 sacc[4];
#pragma unroll
            for (int mt = 0; mt < 4; ++mt)
#pragma unroll
                for (int i = 0; i < 16; ++i) sacc[mt][i] = 0.f;
#pragma unroll
            for (int ks = 0; ks < 8; ++ks)
#pragma unroll
                for (int mt = 0; mt < 4; ++mt) {
                    const bf16x8 kf = *(const LAS bf16x8*)(lds + j * TK_KBUF + (32 * mt + r32) * TK_KST + 32 * ks + 16 * hh);
                    sacc[mt] = MFMA32(kf, qf[ks], sacc[mt]);
                }
            float g[4][16];
#pragma unroll
            for (int mt = 0; mt < 4; ++mt) {
#pragma unroll
                for (int i = 0; i < 16; ++i) g[mt][i] = pack_idx(sacc[mt][i], (unsigned)(32 * mt + (i & 3) + 8 * (i >> 2) + 4 * hh), 127u);
                sort16_desc(g[mt]);
            }
            top16_merge(g[0], g[1]); top16_merge(g[2], g[3]); top16_merge(g[0], g[2]);
            float o[16];
#pragma unroll
            for (int i = 0; i < 16; ++i) o[i] = __shfl_xor(g[0][i], 32, 64);
            top16_merge(g[0], o);
#pragma unroll
            for (int i = 0; i < 16; ++i) v12[j][i] = g[0][i];
        }
        float c[4][16];
        {
            int n = 0;
#pragma unroll
            for (int a = 0; a < 16; ++a)
#pragma unroll
                for (int b = 0; b < 16; ++b) if ((a + 1) * (b + 1) <= 16) {
                    const unsigned id = ((__builtin_bit_cast(unsigned, v12[0][a]) & 127u) << 7) | (__builtin_bit_cast(unsigned, v12[1][b]) & 127u);
                    c[n >> 4][n & 15] = pack_idx(v12[0][a] + v12[1][b], id, 16383u); ++n; }
#pragma unroll
            for (; n < 64; ++n) c[n >> 4][n & 15] = -3.0e38f;
        }
#pragma unroll
        for (int q = 0; q < 4; ++q) sort16_desc(c[q]);
        top16_merge(c[0], c[1]); top16_merge(c[2], c[3]); top16_merge(c[0], c[2]);
        float e[16], den = 0.f;
#pragma unroll
        for (int i = 0; i < 16; ++i) { e[i] = __expf(c[0][i] - c[0][0]); den += e[i]; }
        const float inv = 1.f / den;
        int* ip = eidx + (size_t)tok * 128 + h * 16 + 8 * hh; float* gp = egate + (size_t)tok * 128 + h * 16 + 8 * hh;
        u32x4 i0, i1; f32x4 g0, g1;
#pragma unroll
        for (int i = 0; i < 4; ++i) {
            const float ca = hh ? c[0][8 + i] : c[0][i], cb = hh ? c[0][12 + i] : c[0][4 + i];
            i0[i] = __builtin_bit_cast(unsigned, ca) & 16383u; i1[i] = __builtin_bit_cast(unsigned, cb) & 16383u;
            g0[i] = (hh ? e[8 + i] : e[i]) * inv; g1[i] = (hh ? e[12 + i] : e[4 + i]) * inv;
        }
        *(u32x4*)ip = i0; *(u32x4*)(ip + 4) = i1; *(f32x4*)gp = g0; *(f32x4*)(gp + 4) = g1;
    }
}

constexpr int CW_DIAG = 64;
__device__ __forceinline__ void diag_cmp(const Ctx& C, const bf16_t* A, int lda, const bf16_t* R, int ldr, int nc) {
    float sd = 0.f, sr = 0.f;
    for (int row = C.bid; row < T; row += C.G) {
        const int tm = row % DIAG_MOD; if (tm < DIAG_LO || tm >= DIAG_HI) continue;
        for (int c = C.tid; c < nc; c += 512) { const float a = bf2f(A[(size_t)row * lda + c]), r = bf2f(R[(size_t)row * ldr + c]); sd += (a - r) * (a - r); sr += r * r; }
    }
    sd = wave_sum(sd); sr = wave_sum(sr);
    if (C.lane == 0) { atomicAdd((float*)(C.ws + WS_CTL) + CW_DIAG, sd); atomicAdd((float*)(C.ws + WS_CTL) + CW_DIAG + 1, sr); }
}
__device__ __forceinline__ float diag_alpha(const Ctx& C) {
    const float sd = __hip_atomic_load((float*)(C.ws + WS_CTL) + CW_DIAG, __ATOMIC_RELAXED, __HIP_MEMORY_SCOPE_AGENT), sr = __hip_atomic_load((float*)(C.ws + WS_CTL) + CW_DIAG + 1, __ATOMIC_RELAXED, __HIP_MEMORY_SCOPE_AGENT);
    const float err = fmaxf(sd / fmaxf(sr, 1e-30f), 1e-8f);
    return 0.1f + 0.1f * (rintf(log10f(err / 1e-8f) * 10.f) * 0.1f);
}


#if DIAG == 5 || DIAG == 6
__device__ __forceinline__ void diag_ref_slice(const Ctx& C, const float* W, int ldw, int n0, const float* bias) {
    bf16_t* alt = (bf16_t*)(C.ws + WS_XA);
    const float* X = C.in[I_X];
    for (int row = C.bid * 8 + C.wave; row < T; row += C.G * 8) {
        float acc = 0.f;
        for (int k = 0; k < DM; ++k) acc += X[(size_t)row * DM + k] * W[(size_t)k * ldw + n0 + C.lane];
        if (bias) acc = sigmoidf_(acc + bias[n0 + C.lane]);
        alt[(size_t)row * 64 + C.lane] = (bf16_t)f2bf(acc);
    }
}
#endif

__device__ __forceinline__ void wave_argmax(float& v, int& i) {
#pragma unroll
    for (int o = 32; o > 0; o >>= 1) {
        const float ov = __shfl_xor(v, o, 64); const int oi = __shfl_xor(i, o, 64);
        if (ov > v || (ov == v && oi < i)) { v = ov; i = oi; }
    }
}
__device__ __forceinline__ void p_topk_naive(const Ctx& C, int l) {
    const bf16_t* Q = (const bf16_t*)(C.ws + WS_Q);
    const bf16_t* keys = (const bf16_t*)(C.ws + WS_W + (size_t)l * W_LAYER + WO_KEYS);
    int* eidx = (int*)(C.ws + WS_EIDX); float* egate = (float*)(C.ws + WS_EGATE);
    LAS float* qs = (LAS float*)C.lds;
    LAS float* sc = qs + 2048;
    LAS float* tv = sc + 2048;
    LAS int* ti = (LAS int*)(tv + 256);
    for (int t = C.bid; t < T; t += C.G) {
        for (int i = C.tid; i < 2048; i += 512) qs[i] = bf2f(Q[(size_t)t * NQ + i]);
        __syncthreads();
        for (int i = 0; i < 4; ++i) {
            const int idx = C.tid + 512 * i, hj = idx >> 7, key = idx & 127, h = hj >> 1, j = hj & 1;
            const bf16_t* kp = keys + (((size_t)j * PH + h) * 128 + key) * 128;
            float s = 0.f;
            for (int d8 = 0; d8 < 16; ++d8) {
                const u32x4 raw = *(const u32x4*)(kp + d8 * 8);
#pragma unroll
                for (int e = 0; e < 4; ++e) s += qs[h * 256 + j * 128 + d8 * 8 + 2 * e] * bf2f(raw[e] & 0xffffu) + qs[h * 256 + j * 128 + d8 * 8 + 2 * e + 1] * bf2f(raw[e] >> 16);
            }
            sc[idx] = s;
        }
        __syncthreads();
        for (int i = 0; i < 2; ++i) {
            const int hj = C.wave * 2 + i;
            float a0 = sc[hj * 128 + C.lane], a1 = sc[hj * 128 + 64 + C.lane];
            for (int r = 0; r < 16; ++r) {
                float bv; int bi;
                if (a0 > a1 || (a0 == a1)) { bv = a0; bi = C.lane; } else { bv = a1; bi = C.lane + 64; }
                wave_argmax(bv, bi);
                if (C.lane == 0) { tv[hj * 16 + r] = bv; ti[hj * 16 + r] = bi; }
                if (bi == C.lane) a0 = -3e38f; if (bi == C.lane + 64) a1 = -3e38f;
            }
        }
        __syncthreads();
        {
            const int h = C.wave;
            float cv[4];
#pragma unroll
            for (int i = 0; i < 4; ++i) { const int c = C.lane * 4 + i; cv[i] = tv[(h * 2) * 16 + (c >> 4)] + tv[(h * 2 + 1) * 16 + (c & 15)]; }
            float topv = 0.f; int tope = 0; float mx = 0.f;
            for (int r = 0; r < 16; ++r) {
                float bv = cv[0]; int bi = C.lane * 4;
#pragma unroll
                for (int i = 1; i < 4; ++i) if (cv[i] > bv) { bv = cv[i]; bi = C.lane * 4 + i; }
                wave_argmax(bv, bi);
                if (r == 0) mx = bv;
                if (C.lane == r) { topv = bv; tope = ti[(h * 2) * 16 + (bi >> 4)] * 128 + ti[(h * 2 + 1) * 16 + (bi & 15)]; }
#pragma unroll
                for (int i = 0; i < 4; ++i) if (bi == C.lane * 4 + i) cv[i] = -3e38f;
            }
            float e = (C.lane < 16) ? __expf(topv - mx) : 0.f;
            const float den = wave_sum(e);
            if (C.lane < 16) { eidx[(size_t)t * 128 + h * 16 + C.lane] = tope; egate[(size_t)t * 128 + h * 16 + C.lane] = e / den; }
        }
        __syncthreads();
    }
}
__device__ __forceinline__ float ub(unsigned w, int e) { return (float)((w >> (8 * e)) & 255u); }
__device__ __forceinline__ void p_gather(const Ctx& C, int l) {
    const bf16_t* xc = (const bf16_t*)(C.ws + WS_X1B);
    const unsigned char* U8 = C.ws + WS_U8; const unsigned char* V8 = C.ws + WS_V8;
    const float* SU = (const float*)(C.ws + WS_SU); const float* SV = (const float*)(C.ws + WS_SV);
    const int* eidx = (const int*)(C.ws + WS_EIDX); const float* egate = (const float*)(C.ws + WS_EGATE);
    const int lane = C.lane;
    for (int t = C.bid * 8 + C.wave; t < T; t += C.G * 8) {
        float x[16];
        { const bf16_t* xp = xc + (size_t)t * DM + lane * 16;
          const u32x4 a = *(const u32x4*)xp, b = *(const u32x4*)(xp + 8);
#pragma unroll
          for (int i = 0; i < 4; ++i) { x[2 * i] = bf2f(a[i] & 0xffffu); x[2 * i + 1] = bf2f(a[i] >> 16); x[8 + 2 * i] = bf2f(b[i] & 0xffffu); x[9 + 2 * i] = bf2f(b[i] >> 16); } }
        float xmx = 0.f;
#pragma unroll
        for (int j = 0; j < 16; ++j) xmx = fmaxf(xmx, fabsf(x[j]));
        xmx = fmaxf(wave_max(xmx), 1e-30f);
        const float xisc = 127.f / xmx, xsc = xmx * (1.f / 127.f);
        int xq[4];
#pragma unroll
        for (int q = 0; q < 4; ++q) { unsigned wd = 0u;
#pragma unroll
            for (int e = 0; e < 4; ++e) wd |= ((unsigned)(int)rintf(x[4 * q + e] * xisc) & 255u) << (8 * e);
            xq[q] = (int)wd; }
        float cf[2]; int ex[2];
#pragma unroll
        for (int bt = 0; bt < 2; ++bt) {
            ex[bt] = eidx[(size_t)t * 128 + 64 * bt + lane];
            const float gate = egate[(size_t)t * 128 + 64 * bt + lane];
            int p[64];
#pragma unroll
            for (int e0 = 0; e0 < 64; e0 += 16) {
                u32x4 r[16];
#pragma unroll
                for (int i = 0; i < 16; ++i) { const int e = __builtin_amdgcn_readlane(ex[bt], e0 + i); r[i] = *(const u32x4*)(U8 + (size_t)e * DM + lane * 16); }
#pragma unroll
                for (int i = 0; i < 16; ++i) { int a = 0;
#pragma unroll
                    for (int q = 0; q < 4; ++q) a = __builtin_amdgcn_sdot4(xq[q], (int)r[i][q], a, false);
                    p[e0 + i] = a; }
            }
#pragma unroll
            for (int st = 32, n = 32; st > 0; st >>= 1, n >>= 1) {
                const bool up = (lane & st) != 0;
#pragma unroll
                for (int i = 0; i < n; ++i) { const int send = up ? p[i] : p[i + n], keep = up ? p[i + n] : p[i]; p[i] = keep + __shfl_xor(send, st, 64); }
            }
            const float hsum = SU[ex[bt]] * xsc * (float)p[0];
            cf[bt] = gate * geluf_slow(hsum) * SV[ex[bt]];
        }
        float y[16];
#pragma unroll
        for (int j = 0; j < 16; ++j) y[j] = 0.f;
        float csum = wave_sum(cf[0] + cf[1]);
#pragma unroll
        for (int bt = 0; bt < 2; ++bt)
#pragma unroll
            for (int e0 = 0; e0 < 64; e0 += 16) {
                u32x4 r[16];
#pragma unroll
                for (int i = 0; i < 16; ++i) { const int e = __builtin_amdgcn_readlane(ex[bt], e0 + i); r[i] = *(const u32x4*)(V8 + (size_t)e * DM + lane * 16); }
#pragma unroll
                for (int i = 0; i < 16; ++i) { const float c = __builtin_bit_cast(float, __builtin_amdgcn_readlane(__builtin_bit_cast(int, cf[bt]), e0 + i));
#pragma unroll
                    for (int q = 0; q < 4; ++q)
#pragma unroll
                        for (int e = 0; e < 4; ++e) y[4 * q + e] += c * ub(r[i][q], e); }
            }
#pragma unroll
        for (int j = 0; j < 16; ++j) y[j] = y[j] - 128.f * csum + ALPHA * x[j];
        float sm = 0.f;
#pragma unroll
        for (int j = 0; j < 16; ++j) sm += y[j];
        const float mean = wave_sum(sm) * (1.f / DM);
        float qq = 0.f;
#pragma unroll
        for (int j = 0; j < 16; ++j) { const float d = y[j] - mean; qq += d * d; }
        const float rstd = rsqrtf(wave_sum(qq) * (1.f / DM) + LN_EPS);
        const float* gp = C.in[I_LN2G] + l * DM + lane * 16; const float* bp = C.in[I_LN2B] + l * DM + lane * 16;
#pragma unroll
        for (int i = 0; i < 4; ++i) { const f32x4 gg = *(const f32x4*)(gp + 4 * i), bb = *(const f32x4*)(bp + 4 * i);
#pragma unroll
            for (int e = 0; e < 4; ++e) y[4 * i + e] = (y[4 * i + e] - mean) * rstd * gg[e] + bb[e]; }
        float* dst = (l + 1 < DEPTH) ? (float*)(C.ws + WS_XA) + (size_t)t * DM : C.out + (size_t)t * DM;
#if DIAG
        if (l + 1 == DEPTH) { const float al = 1.f + diag_alpha(C);
#pragma unroll
            for (int j = 0; j < 16; ++j) y[j] *= al; }
#endif
#pragma unroll
        for (int i = 0; i < 4; ++i) *(f32x4*)(dst + lane * 16 + 4 * i) = (f32x4){y[4 * i], y[4 * i + 1], y[4 * i + 2], y[4 * i + 3]};
        if (l + 1 < DEPTH) {
            {
                float mx = 0.f;
#pragma unroll
                for (int j = 0; j < 16; ++j) mx = fmaxf(mx, fabsf(y[j]));
                mx = fmaxf(wave_max(mx), 1e-30f);
                const float isc = 127.f / mx;
                u32x4 o8;
#pragma unroll
                for (int q = 0; q < 4; ++q) { unsigned wd = 0u;
#pragma unroll
                    for (int e = 0; e < 4; ++e) wd |= ((unsigned)(int)rintf(y[4 * q + e] * isc) & 255u) << (8 * e);
                    o8[q] = wd; }
                *(u32x4*)(C.ws + WS_XB + (size_t)t * DM + lane * 16) = o8;
                if (lane == 0) ((float*)(C.ws + WS_XSA))[t] = mx * (1.f / 127.f);
            }
            const float* wf = (const float*)(C.ws + WS_W + (size_t)(l + 1) * W_LAYER + WO_WF);
            float* lsig = (float*)(C.ws + WS_MISC);
#pragma unroll
            for (int h = 0; h < 4; ++h) {
                float sd = 0.f;
#pragma unroll
                for (int i = 0; i < 4; ++i) { const f32x4 a = *(const f32x4*)(wf + h * DM + lane * 16 + 4 * i);
#pragma unroll
                    for (int e = 0; e < 4; ++e) sd += y[4 * i + e] * a[e]; }
                sd = wave_sum(sd);
                if (lane == 0) lsig[(size_t)t * 4 + h] = logsigmoidf_(sd + C.in[I_BFOX][(l + 1) * 4 + h]);
            }
        }
    }
}

struct FStoreBf16 { bf16_t* O; int ld;
    __device__ __forceinline__ void operator()(int row, int col, f32x4 v0, f32x4 v1, int) const {
        u32x4 o; o[0] = pk2(v0[0], v0[1]); o[1] = pk2(v0[2], v0[3]); o[2] = pk2(v1[0], v1[1]); o[3] = pk2(v1[2], v1[3]);
        *(u32x4*)(O + (size_t)row * ld + col) = o; } };
typedef int i32x4 __attribute__((ext_vector_type(4)));
__device__ __forceinline__ void i8_dequant(f32x4& v0, f32x4& v1, float sa, const float* cs) {
    sa *= (1.f / 127.f);
    const f32x4 c0 = *(const f32x4*)cs, c1 = *(const f32x4*)(cs + 4);
    const i32x4 i0 = __builtin_bit_cast(i32x4, v0), i1 = __builtin_bit_cast(i32x4, v1);
#pragma unroll
    for (int e = 0; e < 4; ++e) { v0[e] = (float)i0[e] * sa * c0[e]; v1[e] = (float)i1[e] * sa * c1[e]; }
}
struct FStoreBf16I8 { bf16_t* O; int ld; const float* rs; const float* cs;
    __device__ __forceinline__ void operator()(int row, int col, f32x4 v0, f32x4 v1, int) const {
        i8_dequant(v0, v1, rs[row], cs + col);
        u32x4 o; o[0] = pk2(v0[0], v0[1]); o[1] = pk2(v0[2], v0[3]); o[2] = pk2(v1[0], v1[1]); o[3] = pk2(v1[2], v1[3]);
        *(u32x4*)(O + (size_t)row * ld + col) = o; } };
struct FGateI8 { bf16_t* O; const float* bias; const float* rs; const float* cs;
    __device__ __forceinline__ void operator()(int row, int col, f32x4 v0, f32x4 v1, int) const {
        i8_dequant(v0, v1, rs[row], cs + col);
        const f32x4 b0 = *(const f32x4*)(bias + col), b1 = *(const f32x4*)(bias + col + 4);
        u32x4 o; o[0] = pk2(sigmoidf_(v0[0] + b0[0]), sigmoidf_(v0[1] + b0[1])); o[1] = pk2(sigmoidf_(v0[2] + b0[2]), sigmoidf_(v0[3] + b0[3]));
        o[2] = pk2(sigmoidf_(v1[0] + b1[0]), sigmoidf_(v1[1] + b1[1])); o[3] = pk2(sigmoidf_(v1[2] + b1[2]), sigmoidf_(v1[3] + b1[3]));
        *(u32x4*)(O + (size_t)row * NG + col) = o; } };
struct FGate { bf16_t* O; const float* bias;
    __device__ __forceinline__ void operator()(int row, int col, f32x4 v0, f32x4 v1, int) const {
        const f32x4 b0 = *(const f32x4*)(bias + col), b1 = *(const f32x4*)(bias + col + 4);
        u32x4 o; o[0] = pk2(sigmoidf_(v0[0] + b0[0]), sigmoidf_(v0[1] + b0[1])); o[1] = pk2(sigmoidf_(v0[2] + b0[2]), sigmoidf_(v0[3] + b0[3]));
        o[2] = pk2(sigmoidf_(v1[0] + b1[0]), sigmoidf_(v1[1] + b1[1])); o[3] = pk2(sigmoidf_(v1[2] + b1[2]), sigmoidf_(v1[3] + b1[3]));
        *(u32x4*)(O + (size_t)row * NG + col) = o; } };
struct FMerge { const bf16_t* G; bf16_t* MG;
    __device__ __forceinline__ void operator()(int row, int col, f32x4 v0, f32x4 v1, int z) const {
        const u32x4 gr = *(const u32x4*)(G + (size_t)row * NG + z * DM + col);
        float r[8];
#pragma unroll
        for (int e = 0; e < 4; ++e) { const float a = (e < 2) ? v0[2 * e] : v1[2 * e - 4], b = (e < 2) ? v0[2 * e + 1] : v1[2 * e - 3];
            r[2 * e] = a * bf2f(gr[e] & 0xffffu); r[2 * e + 1] = b * bf2f(gr[e] >> 16); }
        bf16_t* p = MG + (size_t)row * DM + col;
        if (z > 0) { const u32x4 pr = *(const u32x4*)p;
#pragma unroll
            for (int e = 0; e < 4; ++e) { r[2 * e] += bf2f(pr[e] & 0xffffu); r[2 * e + 1] += bf2f(pr[e] >> 16); } }
        u32x4 o;
#pragma unroll
        for (int e = 0; e < 4; ++e) o[e] = pk2(r[2 * e], r[2 * e + 1]);
        *(u32x4*)p = o; } };
struct FResid { const float* X; bf16_t* Y;
    __device__ __forceinline__ void operator()(int row, int col, f32x4 v0, f32x4 v1, int) const {
        const f32x4 x0 = *(const f32x4*)(X + (size_t)row * DM + col), x1 = *(const f32x4*)(X + (size_t)row * DM + col + 4);
#if DIAG == 5 || DIAG == 6
        v0 = (f32x4){0.f, 0.f, 0.f, 0.f}; v1 = v0;
#endif
        u32x4 o; o[0] = cvtpk(x0[0] * ALPHA + v0[0], x0[1] * ALPHA + v0[1]); o[1] = cvtpk(x0[2] * ALPHA + v0[2], x0[3] * ALPHA + v0[3]);
        o[2] = cvtpk(x1[0] * ALPHA + v1[0], x1[1] * ALPHA + v1[1]); o[3] = cvtpk(x1[2] * ALPHA + v1[2], x1[3] * ALPHA + v1[3]);
        *(u32x4*)(Y + (size_t)row * DM + col) = o; } };

constexpr int PH_PER_LAYER = 12, N_PHASES = 1 + DEPTH * PH_PER_LAYER;
template <int SP> __device__ __forceinline__ void run_phase(const Ctx& C0, int l) {
    Ctx C = C0;
    asm volatile("" : "+v"(C.tid));
    C.ws = launder_ptr(C.ws); C.out = launder_ptr(C.out); l = (int)launder_u((unsigned)l);
    C.lane = C.tid & 63; C.wave = __builtin_amdgcn_readfirstlane(C.tid >> 6);
    unsigned char* wb = C.ws + WS_W + (size_t)l * W_LAYER;
    if constexpr (SP == -1) { p_conv_weights(C); }
    if constexpr (SP == 0) {
        if (l == 0) {
            for (int l2 = 0; l2 < DEPTH; ++l2) {
                unsigned char* wb2 = C.ws + WS_W + (size_t)l2 * W_LAYER; const unsigned* cm = (const unsigned*)(C.ws + WS_CMAX) + l2 * (NH + NG);
                tconv_i8_job(C, C.in[I_WIN] + (size_t)l2 * DM * NIN, NIN, DM, NH, wb2 + WO_WIN, cm);
                tconv_i8_job(C, C.in[I_WGATE] + (size_t)l2 * DM * NG, NG, DM, NG, wb2 + WO_WG, cm + NH);
            }
            p_rowpass0(C);
        }
    }
    if constexpr (SP == 1) {
        p_cumsum(C);
        __syncthreads();
        pg8::Gemm g{(const bf16_t*)(C.ws + WS_XB), (const bf16_t*)(wb + WO_WIN), DM, DM, DM, 0, 0};
        pg8::StaticOrder S; S.init(T, NH, C.G, C.bid);
        pg8::Epi8<FStoreBf16I8> E{{(bf16_t*)(C.ws + WS_H), NH, (const float*)(C.ws + WS_XSA), (const float*)(C.ws + WS_CMAX) + l * (NH + NG)}};
        pg8::gemm_phase<pg8::Epi8<FStoreBf16I8>, pg8::StaticOrder, true>(C.lds, g, S, E, C.tid);
    }
#if DIAG == 5
    if constexpr (SP == 2) { if (l == 0) { diag_ref_slice(C, C.in[I_WIN], NIN, DIAG_N0, nullptr); } }
    if constexpr (SP == 3) { if (l == 0) diag_cmp(C, (const bf16_t*)(C.ws + WS_H) + DIAG_N0, NH, (const bf16_t*)(C.ws + WS_XA), 64, 64); }
#endif
#if DIAG == 6
    if constexpr (SP == 5) { if (l == 0) diag_ref_slice(C, C.in[I_WGATE], NG, DIAG_N0, C.in[I_BGATE]); }
    if constexpr (SP == 6) { if (l == 0) diag_cmp(C, (const bf16_t*)(C.ws + WS_G) + DIAG_N0, NG, (const bf16_t*)(C.ws + WS_XA), 64, 64); }
#endif
    if constexpr (SP == 2) { p_knorm(C, l); if (l != HG_NAIVE_L) hgrn_b1(C, l); }
#if MIX_NAIVE
    if constexpr (SP == 3) { if (l != HG_NAIVE_L) hgrn_b2(C); mix_pool_naive(C, l); mix_gmlp_naive(C, l); }
#else
    if constexpr (SP == 3) { if (l != HG_NAIVE_L) hgrn_b2(C); mix_pool(C, l); mix_gmlp(C, l);
        if (DIAG == 2) mix_pool_naive(C, l); if (DIAG == 3) mix_gmlp_naive(C, l); }
#endif
#if DIAG == 1
    if constexpr (SP == 4) { hgrn_b3(C, l); { mix_hgrn_naive(C, l); __syncthreads(); } mix_fox(C, l); }
    if constexpr (SP == 5) { if (l == DIAG_LAYER) diag_cmp(C, (const bf16_t*)(C.ws + (DIAG_LAYER == 0 ? WS_XA : WS_TABU)) + 512, NBR, (const bf16_t*)(C.ws + WS_BR) + 512, NBR, 512); }
#elif DIAG == 2 || DIAG == 3
    if constexpr (SP == 4) { hgrn_b3(C, l); mix_fox(C, l); if (l == DIAG_LAYER) diag_cmp(C, (const bf16_t*)(C.ws + (DIAG_LAYER == 0 ? WS_XA : WS_TABU)) + (DIAG == 2 ? 0 : 1024), NBR, (const bf16_t*)(C.ws + WS_BR) + (DIAG == 2 ? 0 : 1024), NBR, 512); }
#else
    if constexpr (SP == 4) { if (l != HG_NAIVE_L) hgrn_b3(C, l); else { mix_hgrn_naive(C, l); __syncthreads(); } mix_fox(C, l); }
#endif
    if constexpr (SP == 5) {
        pg8::Gemm g{(const bf16_t*)(C.ws + WS_XB), (const bf16_t*)(wb + WO_WG), DM, DM, DM, 0, 0};
        pg8::StaticOrder S; S.init(T, NG, C.G, C.bid);
        pg8::Epi8<FGateI8> E{{(bf16_t*)(C.ws + WS_G), C.in[I_BGATE] + l * NG, (const float*)(C.ws + WS_XSA), (const float*)(C.ws + WS_CMAX) + l * (NH + NG) + NH}};
        pg8::gemm_phase<pg8::Epi8<FGateI8>, pg8::StaticOrder, true>(C.lds, g, S, E, C.tid);
    }
    if constexpr (SP == 6) {
        pg8::Gemm g{(const bf16_t*)(C.ws + WS_BR), (const bf16_t*)(wb + WO_WBR), NBR, BW, BW, (size_t)BW, (size_t)DM * BW};
        pg8::ZOrder S; S.init(T, DM, 4, C.G, C.vcu);
        pg8::Epi8<FMerge> E{{(const bf16_t*)(C.ws + WS_G), (bf16_t*)(C.ws + WS_XB)}};
        pg8::gemm_phase(C.lds, g, S, E, C.tid);
    }
    if constexpr (SP == 7) {
        const float* xin = (l == 0) ? C.in[I_X] : (const float*)(C.ws + WS_XA);
        pg8::Gemm g{(const bf16_t*)(C.ws + WS_XB), (const bf16_t*)(wb + WO_WOUT), DM, DM, DM, 0, 0};
        pg8::StaticOrder S; S.init(T, DM, C.G, C.bid);
        pg8::Epi8<FResid> E{{xin, (bf16_t*)(C.ws + WS_XC)}};
        pg8::gemm_phase(C.lds, g, S, E, C.tid);
    }
    if constexpr (SP == 8) { p_ln1(C, l); p_conv_tables(C, l); }
    if constexpr (SP == 9) {
        pg8::Gemm g{(const bf16_t*)(C.ws + WS_X1B), (const bf16_t*)(wb + WO_WQ), DM, DM, DM, 0, 0};
        pg8::StaticOrder S; S.init(T, NQ, C.G, C.bid);
        pg8::Epi8<FStoreBf16> E{{(bf16_t*)(C.ws + WS_Q), NQ}};
        pg8::gemm_phase(C.lds, g, S, E, C.tid);
    }
#if TOPK_NAIVE
    if constexpr (SP == 10) p_topk_naive(C, l);
#else
    if constexpr (SP == 10) p_topk(C, l);
#endif
    if constexpr (SP == 11) p_gather(C, l);
}
__device__ __forceinline__ void make_ctx(Ctx& C, const Args& args, unsigned char* lds_raw) {
    C.lds = (LAS unsigned char*)lds_raw; C.ws = args.ws; C.in = args.in; C.out = args.out;
    C.tid = threadIdx.x; C.lane = C.tid & 63; C.wave = __builtin_amdgcn_readfirstlane(C.tid >> 6);
    C.G = gridDim.x; C.bid = blockIdx.x; C.vcu = (C.G % 8 == 0) ? (C.bid % 8) * (C.G / 8) + C.bid / 8 : C.bid;
}
#if !MK_ONE_LAUNCH
template <int SP> __global__ void __launch_bounds__(512, 2) mk_phase(Args args) {
    extern __shared__ __attribute__((aligned(16))) unsigned char lds_raw[];
    Ctx C; make_ctx(C, args, lds_raw);
    run_phase<SP>(C, args.ph_lo);
}
#endif

#define GRID_BAR() xcd_barrier((unsigned*)(args.ws + WS_CTL) + 1024, (volatile LAS unsigned*)((LAS unsigned char*)lds_raw + LDSCTL_OFF + 32))
__global__ void __launch_bounds__(512, 2) mk_fwd(Args args) {
    extern __shared__ __attribute__((aligned(16))) unsigned char lds_raw[];
    Ctx C; make_ctx(C, args, lds_raw);
    { volatile LAS unsigned* misc = (volatile LAS unsigned*)(C.lds + LDSCTL_OFF); if (C.tid < 64) misc[C.tid] = 0u; }
    __syncthreads();
    xcd_barrier_post((unsigned*)(args.ws + WS_CTL) + 1024);
    run_phase<-1>(C, 0); GRID_BAR();
#pragma unroll 1
    for (int l = 0; l < DEPTH; ++l) {
        if (l == 0) { run_phase<0>(C, l); GRID_BAR(); }
        run_phase<1>(C, l); GRID_BAR();
        run_phase<2>(C, l); GRID_BAR();
        run_phase<3>(C, l); GRID_BAR();
        run_phase<4>(C, l); GRID_BAR();
        run_phase<5>(C, l); GRID_BAR();
        run_phase<6>(C, l); GRID_BAR();
        run_phase<7>(C, l); GRID_BAR();
        run_phase<8>(C, l); GRID_BAR();
        run_phase<9>(C, l); GRID_BAR();
        run_phase<10>(C, l); GRID_BAR();
        run_phase<11>(C, l); if (l + 1 < DEPTH) GRID_BAR();
    }
}

#if !MK_ONE_LAUNCH
template <int SP> static void launch_phase(const Args& a, int grid, hipStream_t stream) {
    static bool attr_done = false;
    if (!attr_done) { (void)hipFuncSetAttribute((const void*)mk_phase<SP>, hipFuncAttributeMaxDynamicSharedMemorySize, LDS_BYTES); attr_done = true; }
    hipLaunchKernelGGL(mk_phase<SP>, dim3(grid), dim3(512), LDS_BYTES, stream, a);
}
#endif
extern "C" void kernel_launch(void* const* d_in, const int* in_sizes, int n_in, void* d_out, int out_size, void* d_ws, size_t ws_size, hipStream_t stream) {
    static int grid = 0;
    if (grid == 0) {
        if (n_in != NIN_PTRS || out_size != T * DM || ws_size < WS_END) { fprintf(stderr, "kernel_launch: unexpected shapes n_in %d out %d ws %zu\n", n_in, out_size, ws_size); grid = -1; return; }
        int dev = 0, cus = 0;
        if (hipGetDevice(&dev) != hipSuccess || hipDeviceGetAttribute(&cus, hipDeviceAttributeMultiprocessorCount, dev) != hipSuccess) { grid = -1; return; }
        grid = cus;
    }
    if (grid < 0) return;
    (void)hipMemsetAsync((char*)d_ws + WS_CTL, 0, CTL_ZERO_BYTES, stream);
    Args a{};
    for (int i = 0; i < NIN_PTRS; ++i) a.in[i] = (const float*)d_in[i];
    a.out = (float*)d_out; a.ws = (unsigned char*)d_ws; a.bar_slot = 0; a.pad = 0; a.ph_hi = 0;
#if MK_ONE_LAUNCH
    static bool attr_done = false;
    if (!attr_done) { (void)hipFuncSetAttribute((const void*)mk_fwd, hipFuncAttributeMaxDynamicSharedMemorySize, LDS_BYTES); attr_done = true; }
    hipLaunchKernelGGL(mk_fwd, dim3(grid), dim3(512), LDS_BYTES, stream, a);
    return;
#endif
#if !MK_ONE_LAUNCH
    a.ph_lo = 0; launch_phase<-1>(a, grid, stream);
    for (int l = 0; l < DEPTH; ++l) {
        a.ph_lo = l;
        launch_phase<0>(a, grid, stream); launch_phase<1>(a, grid, stream); launch_phase<2>(a, grid, stream); launch_phase<3>(a, grid, stream); launch_phase<4>(a, grid, stream);
        launch_phase<5>(a, grid, stream); launch_phase<6>(a, grid, stream); launch_phase<7>(a, grid, stream); launch_phase<8>(a, grid, stream); launch_phase<9>(a, grid, stream); launch_phase<10>(a, grid, stream); launch_phase<11>(a, grid, stream);
    }
#endif
}
```

```cpp
#include <hip/hip_runtime.h>
#include <cstdio>
#include <cstdint>

#ifndef DIAG
#define DIAG 0
#endif
#ifndef DIAG_LO
#define DIAG_LO 0
#endif
#ifndef DIAG_HI
#define DIAG_HI 64
#endif
#ifndef DIAG_MOD
#define DIAG_MOD 64
#endif
#ifndef TOPK_NAIVE
#define TOPK_NAIVE 0
#endif
#ifndef MIX_NAIVE
#define MIX_NAIVE 0
#endif
#ifndef DIAG_N0
#define DIAG_N0 4096
#endif
#ifndef FOX_NAIVE
#define FOX_NAIVE 0
#endif
#ifndef HG_NAIVE_L
#define HG_NAIVE_L 99
#endif
#ifndef DIAG_LAYER
#define DIAG_LAYER 0
#endif
#ifndef MK_ONE_LAUNCH
#define MK_ONE_LAUNCH 1
#endif

#define LAS __attribute__((address_space(3)))
#define GAS __attribute__((address_space(1)))
typedef unsigned short bf16_t;
typedef short bf16x8 __attribute__((ext_vector_type(8)));
typedef float f32x4 __attribute__((ext_vector_type(4)));
typedef float f32x2 __attribute__((ext_vector_type(2)));
typedef unsigned u32x4 __attribute__((ext_vector_type(4)));
typedef unsigned u32x2 __attribute__((ext_vector_type(2)));

constexpr int DM = 1024, BATCH = 2, SEQ = 8192, DEPTH = 2, T = BATCH * SEQ;
constexpr int BW = 512, NIN = 5124, NH = 5120, NG = 4096, NBR = 2048, NQ = 2048;
constexpr int NEXP = 16384, TOPK = 16, PH = 8;
constexpr float ALPHA = 1.4142135623730951f;
constexpr float LN_EPS = 1e-5f, RMS_EPS = 1e-6f;
constexpr int HC_P = 0, HC_HQ = 512, HC_HF = 1024, HC_HI = 1536, HC_HG = 2048, HC_GU = 2560, HC_GV = 3072, HC_FQ = 3584, HC_FK = 4096, HC_FV = 4608;

constexpr size_t MiB = 1u << 20;
constexpr size_t WS_CTL = 0, CTL_ZERO_BYTES = 160 * 1024;
constexpr size_t WS_CMAX = 64 * 1024;
constexpr size_t WS_MISC = 512 * 1024;
constexpr size_t WS_CUM = 768 * 1024;
constexpr size_t WS_W = 1 * MiB;
constexpr size_t W_LAYER = 30 * MiB;
constexpr size_t WO_WIN = 0, WO_WG = 10 * MiB, WO_WBR = 18 * MiB, WO_WOUT = 22 * MiB, WO_WQ = 24 * MiB, WO_KEYS = 28 * MiB, WO_WF = 28 * MiB + 512 * 1024, WO_POOLW = 28 * MiB + 768 * 1024, WO_GWS = 29 * MiB, WO_CS = 29 * MiB + 512 * 1024;
constexpr size_t WS_TABU = 64 * MiB, WS_TABV = 96 * MiB;
constexpr size_t WS_XA = 128 * MiB;
constexpr size_t WS_XB = 192 * MiB;
constexpr size_t WS_X1B = 224 * MiB;
constexpr size_t WS_H = 256 * MiB;
constexpr size_t WS_ST = 416 * MiB;
constexpr size_t WS_BR = 448 * MiB;
constexpr size_t WS_G = 256 * MiB;
constexpr size_t WS_MGF = 384 * MiB;
constexpr size_t WS_XC = 256 * MiB;
constexpr size_t WS_Q = 320 * MiB;
constexpr size_t WS_EIDX = 384 * MiB, WS_EGATE = 392 * MiB;
constexpr size_t WS_XSA = 256 * 1024;
constexpr size_t WS_END = 512 * MiB;

__device__ __forceinline__ float bf2f(unsigned u) { return __builtin_bit_cast(float, u << 16); }
__device__ __forceinline__ unsigned f2bf(float f) { unsigned u = __builtin_bit_cast(unsigned, f); return (u + 0x7fffu + ((u >> 16) & 1u)) >> 16; }
typedef __bf16 bf16x2_t __attribute__((ext_vector_type(2)));
__device__ __forceinline__ unsigned cvtpk(float lo, float hi) { f32x2 v = {lo, hi}; bf16x2_t b = __builtin_convertvector(v, bf16x2_t); return __builtin_bit_cast(unsigned, b); }
__device__ __forceinline__ unsigned pk2(float lo, float hi) { return cvtpk(lo, hi); }
__device__ __forceinline__ float wave_sum(float v) {
#pragma unroll
    for (int o = 32; o > 0; o >>= 1) v += __shfl_xor(v, o, 64);
    return v;
}
__device__ __forceinline__ float sigmoidf_(float x) { return __builtin_amdgcn_rcpf(1.f + __builtin_amdgcn_exp2f(-1.4426950408889634f * x)); }
__device__ __forceinline__ float siluf_(float x) { return x * __builtin_amdgcn_rcpf(1.f + __builtin_amdgcn_exp2f(-1.4426950408889634f * x)); }
__device__ __forceinline__ float geluf_slow(float x) { const float u = 0.7978845608028654f * (x + 0.044715f * x * x * x); return 0.5f * x * (1.f + tanhf(u)); }
__device__ __forceinline__ float geluf_(float x) { const float u2 = -2.302208198f * (x + 0.044715f * x * x * x); return x * __builtin_amdgcn_rcpf(1.f + __builtin_amdgcn_exp2f(u2)); }
__device__ __forceinline__ float logsigmoidf_(float z) { return fminf(z, 0.f) - log1pf(__expf(-fabsf(z))); }

__device__ __forceinline__ unsigned launder_u(unsigned x) { asm volatile("" : "+v"(x)); return __builtin_amdgcn_readfirstlane(x); }
template <class P> __device__ __forceinline__ P launder_ptr(P p) {
    const unsigned lo = launder_u((unsigned)(uintptr_t)p), hi = launder_u((unsigned)((uintptr_t)p >> 32));
    return (P)(((uintptr_t)hi << 32) | lo);
}

namespace pg8 {
constexpr int BM = 256, BK = 64, HALF = 128, HTB = HALF * BK * 2, STAGE_BYTES = 8 * HTB, NXCD = 8, WGM = 8;
__host__ __device__ __forceinline__ int lds_byte(int r, int c) { const int st = (r >> 4) * 2 + (c >> 5), rr = r & 15, cc = c & 31, ob = rr * 64 + cc * 2; return st * 1024 + (ob ^ (((ob >> 9) & 1) << 5)); }
__host__ __device__ __forceinline__ void stage_rc(int b, int& R, int& C) { const int st = b / 1024, sb = b % 1024, swz = sb ^ (((sb >> 9) & 1) << 5); R = (st >> 1) * 16 + swz / 64; C = (st & 1) * 32 + (swz % 64) / 2; }
__host__ __device__ __forceinline__ int perm32(int rho) { const int n = rho >> 4, i = rho & 15; return 8 * (i >> 2) + 4 * n + (i & 3); }

struct Unit { int pm, pn, z; };
struct Gemm { const bf16_t* A; const bf16_t* Bt; int lda, ldb, K; size_t zA, zB; };

struct StaticOrder {
    int nM, nN, nwg, G, c;
    __device__ void init(int M, int N, int G_, int c_) { nM = M / BM; nN = N / BM; nwg = nM * nN; G = G_; c = c_; }
    __device__ bool next(int i, Unit& u) const {
        const long L = (long)i * G + c; if (L >= nwg) return false;
        int wgid = (int)L; { const int q = nwg / NXCD, r = nwg % NXCD, xcd = wgid % NXCD, off = wgid / NXCD; wgid = (xcd < r ? xcd * (q + 1) : r * (q + 1) + (xcd - r) * q) + off; }
        const int nig = WGM * nN, gid = wgid / nig, fm = gid * WGM, gsz = (nM - fm) < WGM ? (nM - fm) : WGM;
        u.pm = fm + ((wgid % nig) % gsz); u.pn = (wgid % nig) / gsz; u.z = 0; return true;
    }
};
struct ZOrder {
    int nM, nN, nZ, ntile, G, c;
    __device__ void init(int M, int N, int Z, int G_, int c_) { nM = M / BM; nN = N / BM; nZ = Z; ntile = nM * nN; G = G_; c = c_; }
    __device__ bool next(int i, Unit& u) const {
        const long L = (long)(i / nZ) * G + c; if (L >= ntile) return false;
        u.pm = (int)L / nN; u.pn = (int)L % nN; u.z = i % nZ; return true;
    }
};

template <class F> struct Epi8 {
    static constexpr bool PERM = true;
    F f;
    __device__ __forceinline__ void operator()(const f32x4 (&acc)[2][2][4][2], const Unit& u, int wr, int wc, int fr, int fq) const {
        const int row0 = u.pm * BM + wr * 64 + fr, col0 = u.pn * BM + wc * 32 + 8 * fq;
#pragma unroll
        for (int ai = 0; ai < 2; ++ai)
#pragma unroll
            for (int m = 0; m < 4; ++m)
#pragma unroll
                for (int bj = 0; bj < 2; ++bj) f(row0 + ai * HALF + m * 16, col0 + bj * HALF, acc[ai][bj][m][0], acc[ai][bj][m][1], u.z);
    }
};
template <class F> struct Epi4 {
    static constexpr bool PERM = false;
    F f;
    __device__ __forceinline__ void operator()(const f32x4 (&acc)[2][2][4][2], const Unit& u, int wr, int wc, int fr, int fq) const {
        const int row0 = u.pm * BM + wr * 64 + fr, col0 = u.pn * BM + wc * 32 + 4 * fq;
#pragma unroll
        for (int ai = 0; ai < 2; ++ai)
#pragma unroll
            for (int m = 0; m < 4; ++m)
#pragma unroll
                for (int bj = 0; bj < 2; ++bj)
#pragma unroll
                    for (int n = 0; n < 2; ++n) f(row0 + ai * HALF + m * 16, col0 + bj * HALF + n * 16, acc[ai][bj][m][n], u.z);
    }
};

typedef int i32x4 __attribute__((ext_vector_type(4)));
template <class Epi, class Sched, bool I8 = false, bool ALIGN_EPI = true>
__device__ __forceinline__ void gemm_phase(LAS unsigned char* lds, const Gemm g, const Sched& S, const Epi& E, const int tid) {
    constexpr int ES = I8 ? 1 : 2;
    const int wid = __builtin_amdgcn_readfirstlane(tid >> 6), lane = tid & 63, wr = wid >> 2, wc = wid & 3, fr = lane & 15, fq = lane >> 4;
    const int K = g.K, nt = K * ES / 128;
    unsigned voffA[2], voffB[2];
#pragma unroll
    for (int i = 0; i < 2; ++i) { int R, C; stage_rc(tid * 16 + i * 8192, R, C); const int Rb = Epi::PERM ? ((R & ~31) + perm32(R & 31)) : R;
        voffA[i] = (unsigned)(R * g.lda * ES + C * 2); voffB[i] = (unsigned)(Rb * g.ldb * ES + C * 2); }
    const size_t kstep = (size_t)(BK * 2);
    const size_t hstepA = (size_t)HALF * g.lda * ES, hstepB = (size_t)HALF * g.ldb * ES;
    const size_t tstepA = 2 * hstepA, tstepB = 2 * hstepB;
    const unsigned ldsw = (unsigned)wid * 1024u;
    const int aoff = lds_byte(wr * 64 + fr, fq * 8), boff = lds_byte(wc * 32 + fr, fq * 8);
#define PG8_SA(b, h) (((b) * 2 + (h)) * HTB)
#define PG8_SB(b, h) ((4 + (b) * 2 + (h)) * HTB)
#define PG8_STAGE(bufoff, gbase, voff) do { _Pragma("unroll") for (int _i = 0; _i < 2; ++_i) \
        __builtin_amdgcn_global_load_lds((const unsigned*)((const char*)(gbase) + (voff)[_i]), (LAS unsigned*)(lds + (bufoff) + ldsw + _i * 8192), 16, 0, 0); } while (0)
#define PG8_LDA(dst, b, h) do { _Pragma("unroll") for (int m = 0; m < 4; ++m) _Pragma("unroll") for (int k = 0; k < 2; ++k) dst[m][k] = *(const LAS bf16x8*)(lds + PG8_SA(b, h) + aoff + m * 2048 + k * 1024); } while (0)
#define PG8_LDB(dst, b, h) do { _Pragma("unroll") for (int n = 0; n < 2; ++n) _Pragma("unroll") for (int k = 0; k < 2; ++k) dst[n][k] = *(const LAS bf16x8*)(lds + PG8_SB(b, h) + boff + n * 2048 + k * 1024); } while (0)
#define PG8_MMA(ai, bj, At, Bt) do { __builtin_amdgcn_s_setprio(1); _Pragma("unroll") for (int m = 0; m < 4; ++m) _Pragma("unroll") for (int n = 0; n < 2; ++n) _Pragma("unroll") for (int k = 0; k < 2; ++k) { \
        if constexpr (I8) acc[ai][bj][m][n] = __builtin_bit_cast(f32x4, __builtin_amdgcn_mfma_i32_16x16x64_i8(__builtin_bit_cast(i32x4, Bt[n][k]), __builtin_bit_cast(i32x4, At[m][k]), __builtin_bit_cast(i32x4, acc[ai][bj][m][n]), 0, 0, 0)); \
        else acc[ai][bj][m][n] = __builtin_amdgcn_mfma_f32_16x16x32_bf16(Bt[n][k], At[m][k], acc[ai][bj][m][n], 0, 0, 0); } __builtin_amdgcn_s_setprio(0); } while (0)
#define PG8_WAIT_V(n) asm volatile("s_waitcnt vmcnt(" #n ")" ::: "memory")
#define PG8_WAIT_L(n) asm volatile("s_waitcnt lgkmcnt(" #n ")" ::: "memory")
#define PG8_BAR __builtin_amdgcn_s_barrier()
#define PG8_SCHED __builtin_amdgcn_sched_barrier(0)
    Unit cur, nxt; int ui = 0;
    if (!S.next(0, cur)) return;
    f32x4 acc[2][2][4][2];
#pragma unroll
    for (int a = 0; a < 2; ++a)
#pragma unroll
        for (int b = 0; b < 2; ++b)
#pragma unroll
            for (int m = 0; m < 4; ++m)
#pragma unroll
                for (int n = 0; n < 2; ++n) acc[a][b][m][n] = (f32x4){0.f, 0.f, 0.f, 0.f};
    bf16x8 At[4][2], B0[2][2], B1[2][2];
    const char* cA = (const char*)g.A + (size_t)cur.z * g.zA * ES + (size_t)cur.pm * tstepA; const char* cB = (const char*)g.Bt + (size_t)cur.z * g.zB * ES + (size_t)cur.pn * tstepB;
    PG8_STAGE(PG8_SB(0, 0), cB, voffB); PG8_STAGE(PG8_SB(0, 1), cB + hstepB, voffB); PG8_STAGE(PG8_SA(0, 0), cA, voffA); PG8_STAGE(PG8_SA(0, 1), cA + hstepA, voffA);
    if (wr == 1) PG8_BAR;
    PG8_WAIT_V(2); PG8_BAR;
    PG8_STAGE(PG8_SB(1, 0), cB + kstep, voffB); PG8_STAGE(PG8_SA(1, 0), cA + kstep, voffA); PG8_STAGE(PG8_SB(1, 1), cB + hstepB + kstep, voffB);
    PG8_WAIT_V(6); PG8_BAR;
    for (;;) {
        const bool has_next = S.next(ui + 1, nxt);
        const char* nA = has_next ? (const char*)g.A + (size_t)nxt.z * g.zA * ES + (size_t)nxt.pm * tstepA : cA;
        const char* nB = has_next ? (const char*)g.Bt + (size_t)nxt.z * g.zB * ES + (size_t)nxt.pn * tstepB : cB;
        for (int t = 0; t < nt; t += 2) {
            const bool last = (t == nt - 2);
            const char* a1 = cA + (size_t)(t + 1) * kstep;
            const char* a2 = last ? nA : cA + (size_t)(t + 2) * kstep; const char* b2 = last ? nB : cB + (size_t)(t + 2) * kstep;
            const char* a3 = a2 + kstep; const char* b3 = b2 + kstep;
            PG8_LDB(B0, 0, 0); PG8_LDB(B1, 0, 1); PG8_SCHED; PG8_LDA(At, 0, 0); PG8_STAGE(PG8_SA(1, 1), a1 + hstepA, voffA);
            PG8_WAIT_V(8); PG8_WAIT_L(0); PG8_BAR; PG8_MMA(0, 0, At, B0); PG8_MMA(0, 1, At, B1); PG8_BAR; PG8_SCHED;
            PG8_LDA(At, 0, 1); PG8_STAGE(PG8_SB(0, 0), b2, voffB); PG8_STAGE(PG8_SB(0, 1), b2 + hstepB, voffB); PG8_STAGE(PG8_SA(0, 0), a2, voffA);
            PG8_WAIT_V(8); PG8_WAIT_L(0); PG8_BAR; PG8_MMA(1, 0, At, B0); PG8_MMA(1, 1, At, B1); PG8_BAR; PG8_SCHED;
            PG8_LDB(B0, 1, 0); PG8_LDB(B1, 1, 1); PG8_SCHED; PG8_LDA(At, 1, 0); PG8_STAGE(PG8_SA(0, 1), a2 + hstepA, voffA);
            PG8_WAIT_V(8); PG8_WAIT_L(0); PG8_BAR; PG8_MMA(0, 0, At, B0); PG8_MMA(0, 1, At, B1); PG8_BAR; PG8_SCHED;
            PG8_LDA(At, 1, 1); PG8_STAGE(PG8_SB(1, 0), b3, voffB); PG8_STAGE(PG8_SB(1, 1), b3 + hstepB, voffB); PG8_STAGE(PG8_SA(1, 0), a3, voffA);
            PG8_WAIT_V(8); PG8_WAIT_L(0); PG8_BAR; PG8_MMA(1, 0, At, B0); PG8_MMA(1, 1, At, B1); PG8_BAR; PG8_SCHED;
        }
        if constexpr (ALIGN_EPI) { if (wr == 0) PG8_BAR; }
        E(acc, cur, wr, wc, fr, fq);
        if (!has_next) break;
#pragma unroll
        for (int a = 0; a < 2; ++a)
#pragma unroll
            for (int b = 0; b < 2; ++b)
#pragma unroll
                for (int m = 0; m < 4; ++m)
#pragma unroll
                    for (int n = 0; n < 2; ++n) acc[a][b][m][n] = (f32x4){0.f, 0.f, 0.f, 0.f};
        cur = nxt; cA = nA; cB = nB; ++ui;
        if constexpr (ALIGN_EPI) { if (wr == 1) PG8_BAR; }
    }
    PG8_WAIT_V(0);
    if constexpr (!ALIGN_EPI) { if (wr == 0) PG8_BAR; }
    PG8_BAR;
#undef PG8_SA
#undef PG8_SB
#undef PG8_STAGE
#undef PG8_LDA
#undef PG8_LDB
#undef PG8_MMA
#undef PG8_WAIT_V
#undef PG8_WAIT_L
#undef PG8_BAR
#undef PG8_SCHED
}
}

#define XB_TMO      128
#define XB_XCNT(j)  (256  + 64 * (j))
#define XB_XSUB(j)  (1280 + 64 * (j))
#define XB_XGEN(j)  (2304 + 64 * (j))
#define XB_TOP      3328
#define XB_TOPGEN   3392
#define XCD_BAR_WORDS 3456
#define XB_SPIN_CAP (1u << 22)
__device__ __forceinline__ unsigned xb_ld(unsigned* p)              { return __hip_atomic_load(p, __ATOMIC_RELAXED, __HIP_MEMORY_SCOPE_AGENT); }
__device__ __forceinline__ unsigned xb_add(unsigned* p, unsigned v) { return __hip_atomic_fetch_add(p, v, __ATOMIC_RELAXED, __HIP_MEMORY_SCOPE_AGENT); }
__device__ __forceinline__ unsigned xb_xcc_id() { return (unsigned)__builtin_amdgcn_s_getreg((3 << 11) | 20) & 0xFu; }
#define XB_SPIN(cond, bar) do { unsigned _sp = 0; while (cond) { __builtin_amdgcn_s_sleep(1); \
    if ((++_sp & 255u) == 0u) { if (xb_ld(&(bar)[XB_TMO])) break; if (_sp > XB_SPIN_CAP) { atomicAdd(&(bar)[XB_TMO], 1u); break; } } } } while (0)
__device__ __forceinline__ void xcd_barrier_post(unsigned* bar) {
    if (threadIdx.x == 0) (void)xb_add(&bar[XB_XCNT(xb_xcc_id())], 1u);
}
__device__ __forceinline__ void xcd_barrier_complete(unsigned* bar, unsigned x, unsigned& nloc, unsigned& nx) {
    const unsigned G = gridDim.x * gridDim.y * gridDim.z;
    unsigned sum, cnt, mine, sp = 0u;
    for (;;) {
        sum = 0u; cnt = 0u; mine = 0u;
#pragma unroll
        for (unsigned j = 0; j < 16; ++j) { const unsigned c = xb_ld(&bar[XB_XCNT(j)]); sum += c; cnt += (c > 0u) ? 1u : 0u; mine = (j == x) ? c : mine; }
        if (sum == G) break;
        __builtin_amdgcn_s_sleep(1);
        if ((++sp & 255u) == 0u) { if (xb_ld(&bar[XB_TMO])) break; if (sp > XB_SPIN_CAP) { atomicAdd(&bar[XB_TMO], 1u); break; } }
    }
    nloc = mine > 0u ? mine : 1u; nx = cnt > 0u ? cnt : 1u;
}
__device__ __noinline__ void xcd_barrier_leader(unsigned* bar, volatile LAS unsigned* st) {
    const unsigned x = xb_xcc_id();
    __builtin_amdgcn_s_waitcnt(0);
    unsigned nloc = st[0], nx = st[1];
    if (nloc == 0u) { xcd_barrier_complete(bar, x, nloc, nx); st[0] = nloc; st[1] = nx; }
    const unsigned old = xb_add(&bar[XB_XSUB(x)], 1u);
    const unsigned gen = old / nloc;
    if (old + 1u == (gen + 1u) * nloc) {
        __builtin_amdgcn_fence(__ATOMIC_RELEASE, "agent");
        asm volatile("s_waitcnt vmcnt(0)" ::: "memory");
        const unsigned og = xb_add(&bar[XB_TOP], 1u);
        const unsigned tg = og / nx;
        if (og + 1u == (tg + 1u) * nx) xb_add(&bar[XB_TOPGEN], 1u);
        else XB_SPIN(xb_ld(&bar[XB_TOPGEN]) == tg, bar);
        __builtin_amdgcn_fence(__ATOMIC_ACQUIRE, "agent");
        xb_add(&bar[XB_XGEN(x)], 1u);
        asm volatile("s_waitcnt vmcnt(0)" ::: "memory");
    } else {
        XB_SPIN(xb_ld(&bar[XB_XGEN(x)]) == gen, bar);
        __builtin_amdgcn_fence(__ATOMIC_ACQUIRE, "agent");
        asm volatile("s_waitcnt vmcnt(0)" ::: "memory");
    }
}
__device__ __forceinline__ void xcd_barrier(unsigned* bar, volatile LAS unsigned* st) {
    asm volatile("s_waitcnt vmcnt(0)" ::: "memory");
    __syncthreads();
    if (threadIdx.x == 0) xcd_barrier_leader(bar, st);
    __syncthreads();
}

constexpr int NIN_PTRS = 23;
struct Args { const float* in[NIN_PTRS]; float* out; unsigned char* ws; int ph_lo, ph_hi, bar_slot, pad; };
enum { I_X = 0, I_WIN, I_BFOX, I_POOLW, I_POOLS, I_LBL, I_HNG, I_GLNG, I_GLNB, I_GWS, I_GBS, I_WGATE, I_BGATE, I_WBR, I_WOUT, I_LN1G, I_LN1B, I_WQ, I_KEYS, I_PU, I_PV, I_LN2G, I_LN2B };

constexpr int LDS_BYTES = 147456;
constexpr int LDSCTL_OFF = 143360;

struct Ctx {
    LAS unsigned char* lds;
    unsigned char* ws;
    const float* const* in;
    float* out;
    int tid, lane, wave, G, bid, vcu;
};

__device__ __forceinline__ void tconv_job(const Ctx& C, const float* src, int ld_src, int K, int N, bf16_t* dst) {
    LAS float* tile = (LAS float*)C.lds;
    const int nk = K / 64, nn = N / 64, ntiles = nk * nn;
    for (int tl = C.bid; tl < ntiles; tl += C.G) {
        const int k0 = (tl / nn) * 64, n0 = (tl % nn) * 64;
#pragma unroll
        for (int p = 0; p < 2; ++p) {
            const int kr = (C.tid >> 4) + p * 32, nc = (C.tid & 15) * 4;
            const f32x4 v = *(const f32x4*)(src + (size_t)(k0 + kr) * ld_src + n0 + nc);
            tile[kr * 65 + nc + 0] = v[0]; tile[kr * 65 + nc + 1] = v[1]; tile[kr * 65 + nc + 2] = v[2]; tile[kr * 65 + nc + 3] = v[3];
        }
        __syncthreads();
        {
            const int n = C.tid >> 3, k8 = (C.tid & 7) * 8;
            u32x4 o;
#pragma unroll
            for (int j = 0; j < 4; ++j) o[j] = pk2(tile[(k8 + 2 * j) * 65 + n], tile[(k8 + 2 * j + 1) * 65 + n]);
            *(u32x4*)(dst + (size_t)(n0 + n) * K + k0 + k8) = o;
        }
        __syncthreads();
    }
}
__device__ __forceinline__ void colmax_job(const Ctx& C, const float* src, int ld_src, int K, int N, unsigned* cmax) {
    LAS float* red = (LAS float*)C.lds;
    const int nk = K / 64, nn = N / 64, ntiles = nk * nn;
    for (int tl = C.bid; tl < ntiles; tl += C.G) {
        const int k0 = (tl / nn) * 64, n0 = (tl % nn) * 64;
        float mx[4] = {0.f, 0.f, 0.f, 0.f};
#pragma unroll
        for (int p = 0; p < 2; ++p) { const int kr = (C.tid >> 4) + p * 32, nc = (C.tid & 15) * 4;
            const f32x4 v = *(const f32x4*)(src + (size_t)(k0 + kr) * ld_src + n0 + nc);
#pragma unroll
            for (int e = 0; e < 4; ++e) mx[e] = fmaxf(mx[e], fabsf(v[e])); }
#pragma unroll
        for (int e = 0; e < 4; ++e) red[(C.tid >> 4) * 64 + (C.tid & 15) * 4 + e] = mx[e];
        __syncthreads();
        if (C.tid < 64) { float m = 0.f; for (int r = 0; r < 32; ++r) m = fmaxf(m, red[r * 64 + C.tid]); atomicMax(cmax + n0 + C.tid, __builtin_bit_cast(unsigned, m)); }
        __syncthreads();
    }
}
__device__ __forceinline__ void tconv_i8_job(const Ctx& C, const float* src, int ld_src, int K, int N, unsigned char* dst, const unsigned* cmax) {
    LAS float* tile = (LAS float*)C.lds;
    const int nk = K / 64, nn = N / 64, ntiles = nk * nn;
    for (int tl = C.bid; tl < ntiles; tl += C.G) {
        const int k0 = (tl / nn) * 64, n0 = (tl % nn) * 64;
#pragma unroll
        for (int p = 0; p < 2; ++p) { const int kr = (C.tid >> 4) + p * 32, nc = (C.tid & 15) * 4;
            const f32x4 v = *(const f32x4*)(src + (size_t)(k0 + kr) * ld_src + n0 + nc);
#pragma unroll
            for (int e = 0; e < 4; ++e) tile[kr * 65 + nc + e] = v[e] * (127.f / fmaxf(__builtin_bit_cast(float, __hip_atomic_load(cmax + n0 + nc + e, __ATOMIC_RELAXED, __HIP_MEMORY_SCOPE_AGENT)), 1e-30f)); }
        __syncthreads();
        { const int n = C.tid >> 3, k8 = (C.tid & 7) * 8;
          u32x2 o;
#pragma unroll
          for (int j = 0; j < 2; ++j) { unsigned wd = 0u;
#pragma unroll
              for (int e = 0; e < 4; ++e) wd |= ((unsigned)(int)rintf(tile[(k8 + 4 * j + e) * 65 + n]) & 255u) << (8 * e);
              o[j] = wd; }
          *(u32x2*)(dst + (size_t)(n0 + n) * K + k0 + k8) = o; }
        __syncthreads();
    }
}
__device__ __forceinline__ void cvt_copy(const Ctx& C, const float* src, bf16_t* dst, size_t n) {
    const size_t n8 = n / 8;
    for (size_t i = (size_t)C.bid * 512 + C.tid; i < n8; i += (size_t)C.G * 512) {
        const f32x4 a = *(const f32x4*)(src + i * 8), b = *(const f32x4*)(src + i * 8 + 4);
        u32x4 o; o[0] = pk2(a[0], a[1]); o[1] = pk2(a[2], a[3]); o[2] = pk2(b[0], b[1]); o[3] = pk2(b[2], b[3]);
        *(u32x4*)(dst + i * 8) = o;
    }
}
__device__ __forceinline__ void p_conv_weights(const Ctx& C) {
    for (int l = 0; l < DEPTH; ++l) {
        unsigned char* wb = C.ws + WS_W + (size_t)l * W_LAYER;
        colmax_job(C, C.in[I_WIN] + (size_t)l * DM * NIN, NIN, DM, NH, (unsigned*)(C.ws + WS_CMAX) + l * (NH + NG));
        colmax_job(C, C.in[I_WGATE] + (size_t)l * DM * NG, NG, DM, NG, (unsigned*)(C.ws + WS_CMAX) + l * (NH + NG) + NH);
        for (int m = 0; m < 4; ++m)
            tconv_job(C, C.in[I_WBR] + ((size_t)l * 4 + m) * BW * DM, DM, BW, DM, (bf16_t*)(wb + WO_WBR) + (size_t)m * DM * BW);
        tconv_job(C, C.in[I_WOUT] + (size_t)l * DM * DM, DM, DM, DM, (bf16_t*)(wb + WO_WOUT));
        tconv_job(C, C.in[I_WQ] + (size_t)l * DM * NQ, NQ, DM, NQ, (bf16_t*)(wb + WO_WQ));
        cvt_copy(C, C.in[I_KEYS] + (size_t)l * 2 * PH * 128 * 128, (bf16_t*)(wb + WO_KEYS), (size_t)2 * PH * 128 * 128);
        for (int g = 0; g < 4; ++g)
            tconv_job(C, C.in[I_POOLW] + ((size_t)l * 4 + g) * 128 * 128, 128, 128, 128, (bf16_t*)(wb + WO_POOLW) + (size_t)g * 128 * 128);
        {
            bf16_t* gw = (bf16_t*)(wb + WO_GWS); const float* src = C.in[I_GWS] + (size_t)l * 4 * 128 * 128;
            for (int i = C.bid * 512 + C.tid; i < 4 * 128 * 128; i += C.G * 512) { const int t = (i >> 7) & 127, sx = i & 127; gw[i] = (bf16_t)f2bf(sx <= t ? src[i] : 0.f); }
        }
        float* wf = (float*)(wb + WO_WF);
        for (int i = C.bid * 512 + C.tid; i < 4 * DM; i += C.G * 512) { const int h = i / DM, k = i % DM; wf[i] = C.in[I_WIN][(size_t)l * DM * NIN + (size_t)k * NIN + NH + h]; }
    }
}
constexpr size_t WS_U8 = WS_TABU, WS_V8 = WS_TABU + 16 * MiB, WS_SU = WS_TABU + 32 * MiB, WS_SV = WS_SU + 64 * 1024;
__device__ __forceinline__ float wave_max(float v) {
#pragma unroll
    for (int o = 32; o > 0; o >>= 1) v = fmaxf(v, __shfl_xor(v, o, 64));
    return v;
}
template <bool SIGNED> __device__ __forceinline__ void quant_rows(const Ctx& C, const float* src, unsigned char* dst, float* scl) {
    for (int row = C.bid * 8 + C.wave; row < NEXP; row += C.G * 8) {
        const float* p = src + (size_t)row * DM + C.lane * 16;
        f32x4 v[4]; float mx = 0.f;
#pragma unroll
        for (int i = 0; i < 4; ++i) { v[i] = *(const f32x4*)(p + 4 * i);
#pragma unroll
            for (int e = 0; e < 4; ++e) mx = fmaxf(mx, fabsf(v[i][e])); }
        mx = fmaxf(wave_max(mx), 1e-30f);
        const float sc = mx * (1.f / 127.f), isc = 127.f / mx;
        u32x4 o;
#pragma unroll
        for (int i = 0; i < 4; ++i) { unsigned wd = 0u;
#pragma unroll
            for (int e = 0; e < 4; ++e) { const int q = (int)rintf(v[i][e] * isc) + (SIGNED ? 0 : 128); wd |= ((unsigned)q & 255u) << (8 * e); }
            o[i] = wd; }
        *(u32x4*)(dst + (size_t)row * DM + C.lane * 16) = o;
        if (C.lane == 0) scl[row] = sc;
    }
}
__device__ __forceinline__ void p_conv_tables(const Ctx& C, int l) {
    quant_rows<true>(C, C.in[I_PU] + (size_t)l * NEXP * DM, C.ws + WS_U8, (float*)(C.ws + WS_SU));
    quant_rows<false>(C, C.in[I_PV] + (size_t)l * NEXP * DM, C.ws + WS_V8, (float*)(C.ws + WS_SV));
}

__device__ __forceinline__ void row_emit(const Ctx& C, int row, const float (&v)[16], int l, bool want_lsig) {
    {
        float mx = 0.f;
#pragma unroll
        for (int j = 0; j < 16; ++j) mx = fmaxf(mx, fabsf(v[j]));
#pragma unroll
        for (int o = 32; o > 0; o >>= 1) mx = fmaxf(mx, __shfl_xor(mx, o, 64));
        mx = fmaxf(mx, 1e-30f);
        const float isc = 127.f / mx;
        unsigned char* xb = C.ws + WS_XB + (size_t)row * DM;
        u32x2 o0, o1;
#pragma unroll
        for (int hw = 0; hw < 2; ++hw) { unsigned a = 0u, b = 0u;
#pragma unroll
            for (int e = 0; e < 4; ++e) { a |= ((unsigned)(int)rintf(v[4 * hw + e] * isc) & 255u) << (8 * e); b |= ((unsigned)(int)rintf(v[8 + 4 * hw + e] * isc) & 255u) << (8 * e); }
            o0[hw] = a; o1[hw] = b; }
        *(u32x2*)(xb + C.lane * 8) = o0; *(u32x2*)(xb + 512 + C.lane * 8) = o1;
        if (C.lane == 0) ((float*)(C.ws + WS_XSA))[row] = mx * (1.f / 127.f);
    }
    if (want_lsig) {
        const float* wf = (const float*)(C.ws + WS_W + (size_t)l * W_LAYER + WO_WF);
        float* lsig = (float*)(C.ws + WS_MISC);
#pragma unroll
        for (int h = 0; h < 4; ++h) {
            const f32x4 a0 = *(const f32x4*)(wf + h * DM + C.lane * 8), a1 = *(const f32x4*)(wf + h * DM + C.lane * 8 + 4);
            const f32x4 b0 = *(const f32x4*)(wf + h * DM + 512 + C.lane * 8), b1 = *(const f32x4*)(wf + h * DM + 512 + C.lane * 8 + 4);
            float s = 0.f;
#pragma unroll
            for (int j = 0; j < 4; ++j) s += v[j] * a0[j] + v[4 + j] * a1[j] + v[8 + j] * b0[j] + v[12 + j] * b1[j];
            s = wave_sum(s);
            if (C.lane == 0) lsig[(size_t)row * 4 + h] = logsigmoidf_(s + C.in[I_BFOX][l * 4 + h]);
        }
    }
}
__device__ __forceinline__ void load_row16(const float* p, int lane, float (&v)[16]) {
    const f32x4 a0 = *(const f32x4*)(p + lane * 8), a1 = *(const f32x4*)(p + lane * 8 + 4), b0 = *(const f32x4*)(p + 512 + lane * 8), b1 = *(const f32x4*)(p + 512 + lane * 8 + 4);
#pragma unroll
    for (int j = 0; j < 4; ++j) { v[j] = a0[j]; v[4 + j] = a1[j]; v[8 + j] = b0[j]; v[12 + j] = b1[j]; }
}
__device__ __forceinline__ void store_row16(float* p, int lane, const float (&v)[16]) {
    *(f32x4*)(p + lane * 8) = (f32x4){v[0], v[1], v[2], v[3]}; *(f32x4*)(p + lane * 8 + 4) = (f32x4){v[4], v[5], v[6], v[7]};
    *(f32x4*)(p + 512 + lane * 8) = (f32x4){v[8], v[9], v[10], v[11]}; *(f32x4*)(p + 512 + lane * 8 + 4) = (f32x4){v[12], v[13], v[14], v[15]};
}
__device__ __forceinline__ void ln_row16(float (&v)[16], const float* g, const float* b, int lane) {
    float s = 0.f;
#pragma unroll
    for (int j = 0; j < 16; ++j) s += v[j];
    const float mean = wave_sum(s) * (1.f / DM);
    float q = 0.f;
#pragma unroll
    for (int j = 0; j < 16; ++j) { const float d = v[j] - mean; q += d * d; }
    const float rstd = rsqrtf(wave_sum(q) * (1.f / DM) + LN_EPS);
    float gg[16], bb[16];
    load_row16(g, lane, gg); load_row16(b, lane, bb);
#pragma unroll
    for (int j = 0; j < 16; ++j) v[j] = (v[j] - mean) * rstd * gg[j] + bb[j];
}
__device__ __forceinline__ void p_rowpass0(const Ctx& C) {
    for (int row = C.bid * 8 + C.wave; row < T; row += C.G * 8) {
        float v[16]; load_row16(C.in[I_X] + (size_t)row * DM, C.lane, v);
        row_emit(C, row, v, 0, true);
    }
}
__device__ __forceinline__ void p_cumsum(const Ctx& C) {
    if (C.bid >= BATCH * 4) return;
    const float* lsig = (const float*)(C.ws + WS_MISC);
    float* cum = (float*)(C.ws + WS_CUM);
    LAS float* wt = (LAS float*)C.lds;
    const int b = C.bid >> 2, h = C.bid & 3;
    float v[16];
#pragma unroll
    for (int j = 0; j < 16; ++j) v[j] = lsig[((size_t)b * SEQ + C.tid * 16 + j) * 4 + h];
#pragma unroll
    for (int j = 1; j < 16; ++j) v[j] += v[j - 1];
    float inc = v[15];
#pragma unroll
    for (int o = 1; o < 64; o <<= 1) { const float t = __shfl_up(inc, o, 64); if (C.lane >= o) inc += t; }
    if (C.lane == 63) wt[C.wave] = inc;
    __syncthreads();
    float off = inc - v[15];
    for (int w2 = 0; w2 < C.wave; ++w2) off += wt[w2];
    float* cp = cum + ((size_t)b * 4 + h) * SEQ + C.tid * 16;
#pragma unroll
    for (int j4 = 0; j4 < 4; ++j4) *(f32x4*)(cp + 4 * j4) = (f32x4){v[4 * j4] + off, v[4 * j4 + 1] + off, v[4 * j4 + 2] + off, v[4 * j4 + 3] + off};
    __syncthreads();
}
__device__ __forceinline__ void load_row16_bf(const bf16_t* p, int lane, float (&v)[16]) {
    const u32x4 a = *(const u32x4*)(p + lane * 8), b = *(const u32x4*)(p + 512 + lane * 8);
#pragma unroll
    for (int j = 0; j < 4; ++j) { v[2 * j] = bf2f(a[j] & 0xffffu); v[2 * j + 1] = bf2f(a[j] >> 16); v[8 + 2 * j] = bf2f(b[j] & 0xffffu); v[9 + 2 * j] = bf2f(b[j] >> 16); }
}
__device__ __forceinline__ void p_ln1(const Ctx& C, int l) {
    const bf16_t* y1 = (const bf16_t*)(C.ws + WS_XC); bf16_t* x1b = (bf16_t*)(C.ws + WS_X1B);
    for (int row = C.bid * 8 + C.wave; row < T; row += C.G * 8) {
        float v[16]; load_row16_bf(y1 + (size_t)row * DM, C.lane, v);
        ln_row16(v, C.in[I_LN1G] + l * DM, C.in[I_LN1B] + l * DM, C.lane);
        u32x4 o0, o1;
#pragma unroll
        for (int j = 0; j < 4; ++j) { o0[j] = pk2(v[2 * j], v[2 * j + 1]); o1[j] = pk2(v[8 + 2 * j], v[8 + 2 * j + 1]); }
        *(u32x4*)(x1b + (size_t)row * DM + C.lane * 8) = o0; *(u32x4*)(x1b + (size_t)row * DM + 512 + C.lane * 8) = o1;
    }
}

__device__ __forceinline__ void mix_pool_naive(const Ctx& C, int l) {
    const bf16_t* H = (const bf16_t*)(C.ws + WS_H); bf16_t* BR = (bf16_t*)(C.ws + WS_BR);
    LAS float* dd = (LAS float*)C.lds;
    for (int u = C.bid; u < (T / 64) * 4; u += C.G) {
        const int g = u & 3, t0 = (u >> 2) * 64, w = 2 << g;
        for (int idx = C.tid; idx < 64 * 128; idx += 512) {
            const int r = idx >> 7, c = idx & 127, row = t0 + r, pos = row & (SEQ - 1);
            const int nwin = (pos + 1 < w) ? pos + 1 : w;
            float s = 0.f;
            for (int j = 0; j < nwin; ++j) s += bf2f(H[(size_t)(row - j) * NH + HC_P + g * 128 + c]);
            dd[idx] = s / (float)nwin - bf2f(H[(size_t)row * NH + HC_P + g * 128 + c]);
        }
        __syncthreads();
        const int dcol = C.tid & 127, rq = C.tid >> 7;
        float acc[16];
#pragma unroll
        for (int i = 0; i < 16; ++i) acc[i] = 0.f;
        const float* pw = C.in[I_POOLW] + ((size_t)l * 4 + g) * 128 * 128;
        for (int c = 0; c < 128; ++c) {
            const float wv = pw[c * 128 + dcol];
#pragma unroll
            for (int i = 0; i < 16; ++i) acc[i] += dd[(rq * 16 + i) * 128 + c] * wv;
        }
        const float sc = C.in[I_POOLS][l * BW + g * 128 + dcol];
#pragma unroll
        for (int i = 0; i < 16; ++i) BR[(size_t)(t0 + rq * 16 + i) * NBR + 0 + g * 128 + dcol] = (bf16_t)f2bf(acc[i] * sc);
        __syncthreads();
    }
}
__device__ __forceinline__ void mix_gmlp_naive(const Ctx& C, int l) {
    const bf16_t* H = (const bf16_t*)(C.ws + WS_H); bf16_t* BR = (bf16_t*)(C.ws + WS_BR);
    LAS float* vn = (LAS float*)C.lds;
    for (int u = C.bid; u < (T / 128) * 4; u += C.G) {
        const int g = u & 3, t0 = (u >> 2) * 128;
        for (int i = 0; i < 16; ++i) {
            const int r = C.wave * 16 + i, row = t0 + r;
            const u32x4 raw = *(const u32x4*)(H + (size_t)row * NH + HC_GV + C.lane * 8);
            float e[8];
#pragma unroll
            for (int j = 0; j < 4; ++j) { e[2 * j] = geluf_(bf2f(raw[j] & 0xffffu)); e[2 * j + 1] = geluf_(bf2f(raw[j] >> 16)); }
            float s = 0.f;
#pragma unroll
            for (int j = 0; j < 8; ++j) s += e[j];
            const float mean = wave_sum(s) * (1.f / BW);
            float q = 0.f;
#pragma unroll
            for (int j = 0; j < 8; ++j) { const float d = e[j] - mean; q += d * d; }
            const float rstd = rsqrtf(wave_sum(q) * (1.f / BW) + LN_EPS);
            if ((C.lane >> 4) == g) {
#pragma unroll
                for (int j = 0; j < 8; ++j) { const int col = C.lane * 8 + j;
                    vn[r * 128 + (col - g * 128)] = (e[j] - mean) * rstd * C.in[I_GLNG][l * BW + col] + C.in[I_GLNB][l * BW + col]; }
            }
        }
        __syncthreads();
        const int c = C.tid & 127, tq = C.tid >> 7;
        const float* wsg = C.in[I_GWS] + ((size_t)l * 4 + g) * 128 * 128;
        for (int t = tq; t < 128; t += 4) {
            float acc = 0.f;
            for (int s = 0; s <= t; ++s) acc += wsg[t * 128 + s] * vn[s * 128 + c];
            const float sv = acc + C.in[I_GBS][(l * 4 + g) * 128 + t];
            const float uv = geluf_(bf2f(H[(size_t)(t0 + t) * NH + HC_GU + g * 128 + c]));
            BR[(size_t)(t0 + t) * NBR + 1024 + g * 128 + c] = (bf16_t)f2bf(uv * sv);
        }
        __syncthreads();
    }
}
__device__ __forceinline__ void mix_fox_naive(const Ctx& C, int l) {
    const bf16_t* H = (const bf16_t*)(C.ws + WS_H); bf16_t* BR = (bf16_t*)(C.ws + WS_BR);
    const float* cum = (const float*)(C.ws + WS_CUM);
    const float scale = 0.08838834764831845f;
    for (int u = C.bid; u < T * 4 / 8; u += C.G) {
        const int rid = u * 8 + C.wave;
        const int h = rid & 3, row = rid >> 2, b = row / SEQ, t = row % SEQ;
        const unsigned qraw = *(const unsigned*)(H + (size_t)row * NH + HC_FQ + h * 128 + C.lane * 2);
        const float q0 = bf2f(qraw & 0xffffu) * scale, q1 = bf2f(qraw >> 16) * scale;
        const float* cm = cum + ((size_t)b * 4 + h) * SEQ;
        const float ct = cm[t];
        float m = -1e30f, lsum = 0.f, o0 = 0.f, o1 = 0.f;
        for (int s = t; s >= 0; --s) {
            const size_t kr = (size_t)(b * SEQ + s) * NH + h * 128 + C.lane * 2;
            const unsigned kraw = *(const unsigned*)(H + kr + HC_FK);
            const unsigned vraw = *(const unsigned*)(H + kr + HC_FV);
            float d = q0 * bf2f(kraw & 0xffffu) + q1 * bf2f(kraw >> 16);
            d = wave_sum(d);
            const float z = d + ct - cm[s];
            const float mn = fmaxf(m, z), al = __expf(m - mn), p = __expf(z - mn);
            lsum = lsum * al + p; o0 = o0 * al + p * bf2f(vraw & 0xffffu); o1 = o1 * al + p * bf2f(vraw >> 16); m = mn;
        }
        const float inv = 1.f / lsum;
        *(unsigned*)(BR + (size_t)row * NBR + 1536 + h * 128 + C.lane * 2) = pk2(o0 * inv, o1 * inv);
    }
}
__device__ __forceinline__ void mix_hgrn_naive(const Ctx& C, int l) {
    if (C.bid >= BATCH * 4) return;
    const bf16_t* H = (const bf16_t*)(C.ws + WS_H); bf16_t* BR = (bf16_t*)(C.ws + WS_BR);
    const int b = C.bid >> 2, h = C.bid & 3;
    LAS float* fdec = (LAS float*)C.lds;
    LAS float* kkv = fdec + 32 * 128;
    LAS float* qsv = kkv + 32 * 128;
    LAS float* vv = qsv + 32 * 128;
    LAS float* opart = vv + 32 * 128;
    const int kq = C.tid >> 7, v = C.tid & 127;
    float S[32];
#pragma unroll
    for (int j = 0; j < 32; ++j) S[j] = 0.f;
    for (int c0 = 0; c0 < SEQ; c0 += 32) {
        for (int idx = C.tid; idx < 32 * 128; idx += 512) {
            const int st = idx >> 7, k = idx & 127; const size_t rb = (size_t)(b * SEQ + c0 + st) * NH + h * 128 + k;
            float lb = 0.f;
            if (l == 1) { const float z0 = C.in[I_LBL][h * 128 + k], z1 = C.in[I_LBL][BW + h * 128 + k]; lb = 1.f / (1.f + __expf(z0 - z1)); }
            const float zf = bf2f(H[rb + HC_HF]);
            const float kk = (1.f - lb) * sigmoidf_(-zf);
            fdec[idx] = 1.f - kk; kkv[idx] = kk; qsv[idx] = siluf_(bf2f(H[rb + HC_HQ])); vv[idx] = bf2f(H[rb + HC_HI]);
        }
        __syncthreads();
        for (int st = 0; st < 32; ++st) {
            const float vt = vv[st * 128 + v];
            float part = 0.f;
#pragma unroll
            for (int j = 0; j < 32; ++j) { const int k = kq * 32 + j; S[j] = fdec[st * 128 + k] * S[j] + kkv[st * 128 + k] * vt; part += S[j] * qsv[st * 128 + k]; }
            opart[(kq * 32 + st) * 128 + v] = part;
        }
        __syncthreads();
        for (int i = 0; i < 4; ++i) {
            const int st = C.wave * 4 + i, row = b * SEQ + c0 + st;
            float o0 = 0.f, o1 = 0.f;
#pragma unroll
            for (int q = 0; q < 4; ++q) { o0 += opart[(q * 32 + st) * 128 + C.lane]; o1 += opart[(q * 32 + st) * 128 + 64 + C.lane]; }
            const float ss = wave_sum(o0 * o0 + o1 * o1);
            const float r = rsqrtf(ss * (1.f / 128.f) + RMS_EPS);
            const float g0 = siluf_(bf2f(H[(size_t)row * NH + HC_HG + h * 128 + C.lane])), g1 = siluf_(bf2f(H[(size_t)row * NH + HC_HG + h * 128 + 64 + C.lane]));
            BR[(size_t)row * NBR + 512 + h * 128 + C.lane] = (bf16_t)f2bf(o0 * r * C.in[I_HNG][l * 128 + C.lane] * g0);
            BR[(size_t)row * NBR + 512 + h * 128 + 64 + C.lane] = (bf16_t)f2bf(o1 * r * C.in[I_HNG][l * 128 + 64 + C.lane] * g1);
        }
        __syncthreads();
    }
}


typedef float f32x16 __attribute__((ext_vector_type(16)));
typedef short s16x4 __attribute__((ext_vector_type(4)));
typedef short v4i16_t __attribute__((ext_vector_type(4)));
__device__ __forceinline__ s16x4 vtr(const LAS unsigned char* p) { return __builtin_bit_cast(s16x4, __builtin_amdgcn_ds_read_tr16_b64_v4i16((LAS v4i16_t*)p)); }
__device__ __forceinline__ float xor32(float x) { return __shfl_xor(x, 32, 64); }
#define MFMA32(a, b, c) __builtin_amdgcn_mfma_f32_32x32x16_bf16((a), (b), (c), 0, 0, 0)
constexpr int CW_KMAX = 16;

__device__ __forceinline__ void p_knorm(const Ctx& C, int l) {
    const bf16_t* H = (const bf16_t*)(C.ws + WS_H);
    unsigned* kmax = (unsigned*)(C.ws + WS_CTL) + CW_KMAX + l * 8;
    for (int r0 = (C.bid * 8 + C.wave) * 8; r0 < T; r0 += C.G * 64) {
        u32x4 raw[8];
#pragma unroll
        for (int i = 0; i < 8; ++i) raw[i] = *(const u32x4*)(H + (size_t)(r0 + i) * NH + HC_FK + C.lane * 8);
        float best = 0.f;
#pragma unroll
        for (int i = 0; i < 8; ++i) { float s = 0.f;
#pragma unroll
            for (int j = 0; j < 4; ++j) { const float a = bf2f(raw[i][j] & 0xffffu), b = bf2f(raw[i][j] >> 16); s += a * a + b * b; }
            best = fmaxf(best, s); }
        best = 0.f;
#pragma unroll
        for (int i = 0; i < 8; ++i) { float s = 0.f;
#pragma unroll
            for (int j = 0; j < 4; ++j) { const float a = bf2f(raw[i][j] & 0xffffu), b = bf2f(raw[i][j] >> 16); s += a * a + b * b; }
#pragma unroll
            for (int o = 8; o > 0; o >>= 1) s += __shfl_xor(s, o, 64);
            best = fmaxf(best, s); }
        if ((C.lane & 15) == 0) atomicMax(kmax + (r0 / SEQ) * 4 + (C.lane >> 4), __builtin_bit_cast(unsigned, best));
    }
}

constexpr int FOX_KST = 272, FOX_VST = 320;
constexpr int FOX_KB = 0, FOX_VB = 2 * 64 * FOX_KST, FOX_BETA = FOX_VB + 2 * 64 * FOX_VST, FOX_FLAG = FOX_BETA + 2 * 64 * 4, FOX_END = FOX_FLAG + 2 * 8 * 4;
__device__ __forceinline__ void mix_fox(const Ctx& C, int l) {
    const bf16_t* H = (const bf16_t*)(C.ws + WS_H); bf16_t* BR = (bf16_t*)(C.ws + WS_BR);
    const float* cum = (const float*)(C.ws + WS_CUM);
    const unsigned* kmaxw = (const unsigned*)(C.ws + WS_CTL) + CW_KMAX + l * 8;
    const float LOG2E = 1.4426950408889634f, QS = 0.08838834764831845f * LOG2E;
    const int lane = C.lane, w = C.wave, r32 = lane & 31, hh = lane >> 5;
    LAS unsigned char* lds = C.lds;
    LAS float* betaL = (LAS float*)(lds + FOX_BETA);
    volatile LAS int* flagL = (volatile LAS int*)(lds + FOX_FLAG);
    for (int u = C.bid; u < BATCH * 4 * (SEQ / 256); u += C.G) {
        const int qb = u % (SEQ / 256), bh = u / (SEQ / 256), b = bh >> 2, h = bh & 3;
        const int q0 = qb * 256, qw = q0 + 32 * w;
        const size_t rowbase = (size_t)b * SEQ;
        const float* cm = cum + ((size_t)b * 4 + h) * SEQ;
        const float c0 = cm[q0];
        const float kmx = sqrtf(__builtin_bit_cast(float, __hip_atomic_load(kmaxw + b * 4 + h, __ATOMIC_RELAXED, __HIP_MEMORY_SCOPE_AGENT)));
        bf16x8 qf[8]; float qn = 0.f;
        {
            const bf16_t* qp = H + (rowbase + qw + r32) * NH + HC_FQ + h * 128 + 8 * hh;
#pragma unroll
            for (int ks = 0; ks < 8; ++ks) {
                const u32x4 raw = *(const u32x4*)(qp + 16 * ks);
                u32x4 o;
#pragma unroll
                for (int j = 0; j < 4; ++j) { const float a = bf2f(raw[j] & 0xffffu), bb = bf2f(raw[j] >> 16); qn += a * a + bb * bb; o[j] = cvtpk(a * QS, bb * QS); }
                qf[ks] = __builtin_bit_cast(bf16x8, o);
            }
            qn += xor32(qn); qn = sqrtf(qn);
        }
        const float qbound = qn * kmx * QS;
        f32x16 oacc[4];
#pragma unroll
        for (int mt = 0; mt < 4; ++mt)
#pragma unroll
            for (int i = 0; i < 16; ++i) oacc[mt][i] = 0.f;
        float m_run = -1e30f, l_run = 0.f;
        const int jmax = (q0 + 255) >> 6;
        const int srow = C.tid >> 4, sch = C.tid & 15;
        u32x4 kreg[2], vreg[2]; float breg = 0.f;
#define FOX_GLOAD(j_) do { _Pragma("unroll") for (int p = 0; p < 2; ++p) { \
                const bf16_t* rp = H + (rowbase + 64 * (j_) + srow + 32 * p) * NH + h * 128 + sch * 8; \
                kreg[p] = *(const u32x4*)(rp + HC_FK); vreg[p] = *(const u32x4*)(rp + HC_FV); } \
            if (C.tid < 64) breg = (c0 - cm[64 * (j_) + C.tid]) * LOG2E; } while (0)
#define FOX_LWRITE(buf_) do { _Pragma("unroll") for (int p = 0; p < 2; ++p) { \
                *(LAS u32x4*)(lds + FOX_KB + (buf_) * 64 * FOX_KST + (srow + 32 * p) * FOX_KST + sch * 16) = kreg[p]; \
                *(LAS u32x4*)(lds + FOX_VB + (buf_) * 64 * FOX_VST + (srow + 32 * p) * FOX_VST + sch * 16) = vreg[p]; } \
            if (C.tid < 64) betaL[(buf_) * 64 + C.tid] = breg; } while (0)
        __syncthreads();
        if (C.tid < 16) flagL[C.tid] = 0;
        FOX_GLOAD(jmax); FOX_LWRITE(jmax & 1);
        bool wdone = false;
        for (int j = jmax; j >= 0; --j) {
            const int cur = j & 1;
            __syncthreads();
            if (j < jmax) { int all = 1;
#pragma unroll
                for (int i = 0; i < 8; ++i) all &= flagL[((j + 1) & 1) * 8 + i];
                if (all) break; }
            if (j > 0) FOX_GLOAD(j - 1);
            const int k0 = 64 * j;
            if (k0 <= qw + 31 && !wdone) {
                const LAS unsigned char* kb = lds + FOX_KB + cur * 64 * FOX_KST;
                const LAS unsigned char* vb = lds + FOX_VB + cur * 64 * FOX_VST;
                f32x16 sacc[2];
#pragma unroll
                for (int mt = 0; mt < 2; ++mt)
#pragma unroll
                    for (int g = 0; g < 4; ++g) { const f32x4 bv = *(const LAS f32x4*)(betaL + cur * 64 + 32 * mt + 8 * g + 4 * hh);
                        sacc[mt][4 * g] = bv[0]; sacc[mt][4 * g + 1] = bv[1]; sacc[mt][4 * g + 2] = bv[2]; sacc[mt][4 * g + 3] = bv[3]; }
#pragma unroll
                for (int ks = 0; ks < 8; ++ks)
#pragma unroll
                    for (int mt = 0; mt < 2; ++mt) {
                        const bf16x8 kf = *(const LAS bf16x8*)(kb + (32 * mt + r32) * FOX_KST + 32 * ks + 16 * hh);
                        sacc[mt] = MFMA32(kf, qf[ks], sacc[mt]);
                    }
                const int tq = qw + r32;
                if (k0 + 63 > qw) {
#pragma unroll
                    for (int mt = 0; mt < 2; ++mt)
#pragma unroll
                        for (int i = 0; i < 16; ++i) { const int key = k0 + 32 * mt + (i & 3) + 8 * (i >> 2) + 4 * hh; if (key > tq) sacc[mt][i] = -1e30f; }
                }
                float mx = sacc[0][0];
#pragma unroll
                for (int mt = 0; mt < 2; ++mt)
#pragma unroll
                    for (int i = 0; i < 16; ++i) mx = fmaxf(mx, sacc[mt][i]);
                mx = fmaxf(mx, xor32(mx));
                const float mn = fmaxf(m_run, mx), alpha = __builtin_amdgcn_exp2f(m_run - mn);
                m_run = mn;
                float ps = 0.f;
#pragma unroll
                for (int mt = 0; mt < 2; ++mt)
#pragma unroll
                    for (int i = 0; i < 16; ++i) { const float p = __builtin_amdgcn_exp2f(sacc[mt][i] - mn); sacc[mt][i] = p; ps += p; }
                l_run = l_run * alpha + ps;
#pragma unroll
                for (int mt = 0; mt < 4; ++mt)
#pragma unroll
                    for (int i = 0; i < 16; ++i) oacc[mt][i] *= alpha;
#pragma unroll
                for (int s4 = 0; s4 < 4; ++s4) {
                    const int mtk = s4 >> 1, s = s4 & 1;
                    u32x4 pb;
#pragma unroll
                    for (int e = 0; e < 4; ++e) pb[e] = cvtpk(sacc[mtk][8 * s + 2 * e], sacc[mtk][8 * s + 2 * e + 1]);
                    const bf16x8 pfrag = __builtin_bit_cast(bf16x8, pb);
                    const int i16 = lane & 15, q4 = i16 >> 2, p4 = i16 & 3, blk = (lane >> 4) & 1;
                    const int keyA = 32 * mtk + 16 * s + 4 * hh + q4;
#pragma unroll
                    for (int mt = 0; mt < 4; ++mt) {
                        const LAS unsigned char* a0 = vb + keyA * FOX_VST + (32 * mt + 16 * blk + 4 * p4) * 2;
                        const s16x4 lo = vtr(a0), hi = vtr(a0 + 8 * FOX_VST);
                        const bf16x8 vf = __builtin_shufflevector(lo, hi, 0, 1, 2, 3, 4, 5, 6, 7);
                        oacc[mt] = MFMA32(vf, pfrag, oacc[mt]);
                    }
                }
                if (j > 0) { const float bl = (c0 - cm[k0 - 1]) * LOG2E;
                    const int ok = (qbound + bl < m_run - 152.f) ? 1 : 0;
                    wdone = __all(ok); }
            }
            if (lane == 0) flagL[cur * 8 + w] = wdone ? 1 : 0;
            if (j > 0) FOX_LWRITE(cur ^ 1);
        }
        l_run += xor32(l_run);
        const float inv = 1.f / l_run;
        bf16_t* op = BR + (rowbase + qw + r32) * NBR + 1536 + h * 128;
#pragma unroll
        for (int mt = 0; mt < 4; ++mt)
#pragma unroll
            for (int g = 0; g < 4; ++g) { u32x2 o; o[0] = cvtpk(oacc[mt][4 * g] * inv, oacc[mt][4 * g + 1] * inv); o[1] = cvtpk(oacc[mt][4 * g + 2] * inv, oacc[mt][4 * g + 3] * inv);
                *(u32x2*)(op + 32 * mt + 8 * g + 4 * hh) = o; }
    }
}


constexpr int HG_LF = 0, HG_QA = 34816, HG_QB = HG_QA + 17408, HG_KD = HG_QB + 8704, HG_KO = HG_KD + 17408, HG_KT = HG_KO + 8704, HG_VN = HG_KT + 20480, HG_AM = HG_VN + 20480, HG_END = HG_AM + 12288;
constexpr int HG_LFS = 132;
static_assert(HG_END + 2048 <= 140 * 1024, "hgrn LDS");
constexpr size_t WS_DSC = WS_ST + (size_t)BATCH * 4 * 32 * 128 * 128 * 4;

template <bool FULL>
__device__ __forceinline__ void hgrn_unit(const Ctx& C, int l, int u) {
#if DIAG == 1
    const bf16_t* H = (const bf16_t*)(C.ws + WS_H); bf16_t* BR = (l == 0) ? (bf16_t*)(C.ws + WS_XA) : (bf16_t*)(C.ws + WS_TABU);
#else
    const bf16_t* H = (const bf16_t*)(C.ws + WS_H); bf16_t* BR = (bf16_t*)(C.ws + WS_BR);
#endif
    float* STB = (float*)(C.ws + WS_ST); float* DSC = (float*)(C.ws + WS_DSC);
    LAS unsigned char* lds = C.lds;
    LAS float* LF = (LAS float*)(lds + HG_LF);
    const int lane = C.lane, w = C.wave, r32 = lane & 31, hh = lane >> 5;
    const int sc = u & 31, bh = u >> 5, b = bh >> 2, h = bh & 3;
    const int wk = w >> 1, wv = w & 1;
    const int mt = w >> 2, nt = w & 3;
    const int i16 = lane & 15, q4 = i16 >> 2, p4 = i16 & 3, blk = (lane >> 4) & 1;
    f32x16 S0, S1;
    float* stp = STB + ((size_t)bh * 32 + sc) * 128 * 128;
    if constexpr (FULL) {
#pragma unroll
        for (int i = 0; i < 16; ++i) { const int k = 32 * wk + (i & 3) + 8 * (i >> 2) + 4 * hh;
            S0[i] = stp[k * 128 + 64 * wv + r32]; S1[i] = stp[k * 128 + 64 * wv + 32 + r32]; }
    } else {
#pragma unroll
        for (int i = 0; i < 16; ++i) { S0[i] = 0.f; S1[i] = 0.f; }
    }
    float dtot = 0.f;
    const int ps = C.tid >> 3, pseg = C.tid & 7;
    float lbv[16];
#pragma unroll
    for (int j = 0; j < 16; ++j) { lbv[j] = 0.f;
        if (l == 1) { const int ch = h * 128 + 16 * pseg + j; lbv[j] = 1.f / (1.f + __expf(C.in[I_LBL][ch] - C.in[I_LBL][BW + ch])); } }
    for (int c = 0; c < 4; ++c) {
        const size_t row0 = (size_t)b * SEQ + sc * 256 + c * 64;
        const bf16_t* hp = H + (row0 + ps) * NH + h * 128 + 16 * pseg;
        float kkv[16], qsv[16];
        u32x4 vraw0, vraw1;
        {
            const u32x4 f0 = *(const u32x4*)(hp + HC_HF), f1 = *(const u32x4*)(hp + HC_HF + 8);
            vraw0 = *(const u32x4*)(hp + HC_HI); vraw1 = *(const u32x4*)(hp + HC_HI + 8);
#pragma unroll
            for (int j = 0; j < 8; ++j) { const unsigned r = (j < 4) ? f0[j] : f1[j - 4];
                const float z0 = bf2f(r & 0xffffu), z1 = bf2f(r >> 16);
                kkv[2 * j] = (1.f - lbv[2 * j]) * sigmoidf_(-z0); kkv[2 * j + 1] = (1.f - lbv[2 * j + 1]) * sigmoidf_(-z1); }
            if constexpr (FULL) {
                const u32x4 q0 = *(const u32x4*)(hp + HC_HQ), q1 = *(const u32x4*)(hp + HC_HQ + 8);
#pragma unroll
                for (int j = 0; j < 8; ++j) { const unsigned r = (j < 4) ? q0[j] : q1[j - 4]; qsv[2 * j] = siluf_(bf2f(r & 0xffffu)); qsv[2 * j + 1] = siluf_(bf2f(r >> 16)); }
            }
#pragma unroll
            for (int j4 = 0; j4 < 4; ++j4) { f32x4 o;
#pragma unroll
                for (int e = 0; e < 4; ++e) o[e] = __logf(1.f - kkv[4 * j4 + e]);
                *(LAS f32x4*)(LF + ps * HG_LFS + 16 * pseg + 4 * j4) = o; }
        }
        __syncthreads();
        {
            const int sk = C.tid & 127, sg = C.tid >> 7;
            float vals[16];
#pragma unroll
            for (int i = 0; i < 16; ++i) vals[i] = LF[(16 * sg + i) * HG_LFS + sk];
#pragma unroll
            for (int i = 1; i < 16; ++i) vals[i] += vals[i - 1];
            LAS float* TOT = (LAS float*)(lds + HG_END);
            TOT[sg * 128 + sk] = vals[15];
            __syncthreads();
            float off = 0.f;
#pragma unroll
            for (int j = 0; j < 3; ++j) if (j < sg) off += TOT[j * 128 + sk];
#pragma unroll
            for (int i = 0; i < 16; ++i) LF[(16 * sg + i) * HG_LFS + sk] = vals[i] + off;
            if (sg == 3) dtot += vals[15] + off;
        }
        __syncthreads();
        float bv[16], b31[16], bl[16];
#pragma unroll
        for (int j4 = 0; j4 < 4; ++j4) { const f32x4 x = *(const LAS f32x4*)(LF + ps * HG_LFS + 16 * pseg + 4 * j4), y = *(const LAS f32x4*)(LF + 31 * HG_LFS + 16 * pseg + 4 * j4), z = *(const LAS f32x4*)(LF + 63 * HG_LFS + 16 * pseg + 4 * j4);
#pragma unroll
            for (int e = 0; e < 4; ++e) { bv[4 * j4 + e] = x[e]; b31[4 * j4 + e] = y[e]; bl[4 * j4 + e] = z[e]; } }
        {
            u32x4 o0, o1;
#pragma unroll
            for (int j = 0; j < 4; ++j) { o0[j] = cvtpk(kkv[2 * j] * __expf(bl[2 * j] - bv[2 * j]), kkv[2 * j + 1] * __expf(bl[2 * j + 1] - bv[2 * j + 1]));
                o1[j] = cvtpk(kkv[8 + 2 * j] * __expf(bl[8 + 2 * j] - bv[8 + 2 * j]), kkv[9 + 2 * j] * __expf(bl[9 + 2 * j] - bv[9 + 2 * j])); }
            *(LAS u32x4*)(lds + HG_KT + ps * 320 + 32 * pseg) = o0; *(LAS u32x4*)(lds + HG_KT + ps * 320 + 32 * pseg + 16) = o1;
            *(LAS u32x4*)(lds + HG_VN + ps * 320 + 32 * pseg) = vraw0; *(LAS u32x4*)(lds + HG_VN + ps * 320 + 32 * pseg + 16) = vraw1;
            if constexpr (FULL) {
                const bool hi = ps >= 32;
                float rr[16];
#pragma unroll
                for (int j = 0; j < 16; ++j) rr[j] = hi ? b31[j] : 0.f;
#pragma unroll
                for (int j = 0; j < 4; ++j) { o0[j] = cvtpk(qsv[2 * j] * __expf(bv[2 * j] - rr[2 * j]), qsv[2 * j + 1] * __expf(bv[2 * j + 1] - rr[2 * j + 1]));
                    o1[j] = cvtpk(qsv[8 + 2 * j] * __expf(bv[8 + 2 * j] - rr[8 + 2 * j]), qsv[9 + 2 * j] * __expf(bv[9 + 2 * j] - rr[9 + 2 * j])); }
                *(LAS u32x4*)(lds + HG_QA + ps * 272 + 32 * pseg) = o0; *(LAS u32x4*)(lds + HG_QA + ps * 272 + 32 * pseg + 16) = o1;
#pragma unroll
                for (int j = 0; j < 4; ++j) { o0[j] = cvtpk(kkv[2 * j] * __expf(rr[2 * j] - bv[2 * j]), kkv[2 * j + 1] * __expf(rr[2 * j + 1] - bv[2 * j + 1]));
                    o1[j] = cvtpk(kkv[8 + 2 * j] * __expf(rr[8 + 2 * j] - bv[8 + 2 * j]), kkv[9 + 2 * j] * __expf(rr[9 + 2 * j] - bv[9 + 2 * j])); }
                *(LAS u32x4*)(lds + HG_KD + ps * 272 + 32 * pseg) = o0; *(LAS u32x4*)(lds + HG_KD + ps * 272 + 32 * pseg + 16) = o1;
                if (hi) {
#pragma unroll
                    for (int j = 0; j < 4; ++j) { o0[j] = cvtpk(qsv[2 * j] * __expf(bv[2 * j]), qsv[2 * j + 1] * __expf(bv[2 * j + 1]));
                        o1[j] = cvtpk(qsv[8 + 2 * j] * __expf(bv[8 + 2 * j]), qsv[9 + 2 * j] * __expf(bv[9 + 2 * j])); }
                    *(LAS u32x4*)(lds + HG_QB + (ps - 32) * 272 + 32 * pseg) = o0; *(LAS u32x4*)(lds + HG_QB + (ps - 32) * 272 + 32 * pseg + 16) = o1;
                } else {
#pragma unroll
                    for (int j = 0; j < 4; ++j) { o0[j] = cvtpk(kkv[2 * j] * __expf(b31[2 * j] - bv[2 * j]), kkv[2 * j + 1] * __expf(b31[2 * j + 1] - bv[2 * j + 1]));
                        o1[j] = cvtpk(kkv[8 + 2 * j] * __expf(b31[8 + 2 * j] - bv[8 + 2 * j]), kkv[9 + 2 * j] * __expf(b31[9 + 2 * j] - bv[9 + 2 * j])); }
                    *(LAS u32x4*)(lds + HG_KO + ps * 272 + 32 * pseg) = o0; *(LAS u32x4*)(lds + HG_KO + ps * 272 + 32 * pseg + 16) = o1;
                }
            }
        }
        float dk[16];
#pragma unroll
        for (int i = 0; i < 16; ++i) dk[i] = __expf(LF[63 * HG_LFS + 32 * wk + (i & 3) + 8 * (i >> 2) + 4 * hh]);
        __syncthreads();
        if constexpr (FULL) {
#pragma unroll
            for (int g = 0; g < 4; ++g) {
                u32x2 o; o[0] = cvtpk(S0[4 * g], S0[4 * g + 1]); o[1] = cvtpk(S0[4 * g + 2], S0[4 * g + 3]);
                *(LAS u32x2*)(lds + HG_LF + (64 * wv + r32) * 272 + (32 * wk + 8 * g + 4 * hh) * 2) = o;
                o[0] = cvtpk(S1[4 * g], S1[4 * g + 1]); o[1] = cvtpk(S1[4 * g + 2], S1[4 * g + 3]);
                *(LAS u32x2*)(lds + HG_LF + (64 * wv + 32 + r32) * 272 + (32 * wk + 8 * g + 4 * hh) * 2) = o;
            }
#define HG_ATILE(AMT_, AST_) do { \
                const LAS unsigned char* kb = ((AMT_) == (AST_)) ? (lds + HG_KD + (32 * (AST_)) * 272) : (lds + HG_KO); \
                f32x16 a; \
                _Pragma("unroll") for (int i = 0; i < 16; ++i) a[i] = 0.f; \
                _Pragma("unroll") for (int ks = 0; ks < 8; ++ks) { \
                    const bf16x8 af = *(const LAS bf16x8*)(lds + HG_QA + (32 * (AMT_) + r32) * 272 + 32 * ks + 16 * hh); \
                    const bf16x8 bf = *(const LAS bf16x8*)(kb + r32 * 272 + 32 * ks + 16 * hh); \
                    a = MFMA32(af, bf, a); } \
                _Pragma("unroll") for (int g = 0; g < 4; ++g) { \
                    float x[4]; \
                    _Pragma("unroll") for (int e = 0; e < 4; ++e) { const int tl = 8 * g + 4 * hh + e; x[e] = ((AMT_) != (AST_) || r32 <= tl) ? a[4 * g + e] : 0.f; } \
                    u32x2 o; o[0] = cvtpk(x[0], x[1]); o[1] = cvtpk(x[2], x[3]); \
                    *(LAS u32x2*)(lds + HG_AM + (32 * (AST_) + r32) * 192 + (32 * (AMT_) + 8 * g + 4 * hh) * 2) = o; } } while (0)
            if (w == 0) { HG_ATILE(0, 0); }
            else if (w == 1) { HG_ATILE(1, 0); }
            else if (w == 2) { HG_ATILE(1, 1); }
        }
#pragma unroll
        for (int i = 0; i < 16; ++i) { S0[i] *= dk[i]; S1[i] *= dk[i]; }
#pragma unroll
        for (int ks = 0; ks < 4; ++ks) {
            const LAS unsigned char* ka = lds + HG_KT + (16 * ks + 8 * hh + q4) * 320 + (32 * wk + 16 * blk + 4 * p4) * 2;
            const s16x4 alo = vtr(ka), ahi = vtr(ka + 4 * 320);
            const bf16x8 af = __builtin_shufflevector(alo, ahi, 0, 1, 2, 3, 4, 5, 6, 7);
            const LAS unsigned char* vb0 = lds + HG_VN + (16 * ks + 8 * hh + q4) * 320 + (64 * wv + 16 * blk + 4 * p4) * 2;
            const s16x4 b0lo = vtr(vb0), b0hi = vtr(vb0 + 4 * 320), b1lo = vtr(vb0 + 64), b1hi = vtr(vb0 + 64 + 4 * 320);
            S0 = MFMA32(af, __builtin_shufflevector(b0lo, b0hi, 0, 1, 2, 3, 4, 5, 6, 7), S0);
            S1 = MFMA32(af, __builtin_shufflevector(b1lo, b1hi, 0, 1, 2, 3, 4, 5, 6, 7), S1);
        }
        if constexpr (FULL) {
            __syncthreads();
            f32x16 o;
#pragma unroll
            for (int i = 0; i < 16; ++i) o[i] = 0.f;
            const LAS unsigned char* qb = (mt == 0) ? (lds + HG_QA) : (lds + HG_QB);
#pragma unroll
            for (int ks = 0; ks < 8; ++ks) {
                const bf16x8 af = *(const LAS bf16x8*)(qb + r32 * 272 + 32 * ks + 16 * hh);
                const bf16x8 bf = *(const LAS bf16x8*)(lds + HG_LF + (32 * nt + r32) * 272 + 32 * ks + 16 * hh);
                o = MFMA32(af, bf, o);
            }
#pragma unroll
            for (int ks = 0; ks < 4; ++ks) {
                if (mt == 0 && ks >= 2) continue;
                const LAS unsigned char* aa = lds + HG_AM + (16 * ks + 8 * hh + q4) * 192 + (32 * mt + 16 * blk + 4 * p4) * 2;
                const s16x4 alo = vtr(aa), ahi = vtr(aa + 4 * 192);
                const LAS unsigned char* vb0 = lds + HG_VN + (16 * ks + 8 * hh + q4) * 320 + (32 * nt + 16 * blk + 4 * p4) * 2;
                const s16x4 blo = vtr(vb0), bhi = vtr(vb0 + 4 * 320);
                o = MFMA32(__builtin_shufflevector(alo, ahi, 0, 1, 2, 3, 4, 5, 6, 7), __builtin_shufflevector(blo, bhi, 0, 1, 2, 3, 4, 5, 6, 7), o);
            }
            __syncthreads();
#pragma unroll
            for (int i = 0; i < 16; ++i) LF[(32 * mt + (i & 3) + 8 * (i >> 2) + 4 * hh) * HG_LFS + 32 * nt + r32] = o[i];
            __syncthreads();
            {
                float ov[16]; float ss = 0.f;
#pragma unroll
                for (int j4 = 0; j4 < 4; ++j4) { const f32x4 x = *(const LAS f32x4*)(LF + ps * HG_LFS + 16 * pseg + 4 * j4);
#pragma unroll
                    for (int e = 0; e < 4; ++e) { ov[4 * j4 + e] = x[e]; ss += x[e] * x[e]; } }
                ss += __shfl_xor(ss, 1, 64); ss += __shfl_xor(ss, 2, 64); ss += __shfl_xor(ss, 4, 64);
                const float rn = rsqrtf(ss * (1.f / 128.f) + RMS_EPS);
                const u32x4 g0 = *(const u32x4*)(hp + HC_HG), g1 = *(const u32x4*)(hp + HC_HG + 8);
                const float* ng = C.in[I_HNG] + l * 128 + 16 * pseg;
                u32x4 o0, o1;
#pragma unroll
                for (int j = 0; j < 4; ++j) {
                    o0[j] = cvtpk(ov[2 * j] * rn * ng[2 * j] * siluf_(bf2f(g0[j] & 0xffffu)), ov[2 * j + 1] * rn * ng[2 * j + 1] * siluf_(bf2f(g0[j] >> 16)));
                    o1[j] = cvtpk(ov[8 + 2 * j] * rn * ng[8 + 2 * j] * siluf_(bf2f(g1[j] & 0xffffu)), ov[9 + 2 * j] * rn * ng[9 + 2 * j] * siluf_(bf2f(g1[j] >> 16)));
                }
                bf16_t* bp = BR + (row0 + ps) * NBR + 512 + h * 128 + 16 * pseg;
                *(u32x4*)bp = o0; *(u32x4*)(bp + 8) = o1;
            }
        }
        __syncthreads();
    }
    if constexpr (!FULL) {
#pragma unroll
        for (int i = 0; i < 16; ++i) { const int k = 32 * wk + (i & 3) + 8 * (i >> 2) + 4 * hh;
            stp[k * 128 + 64 * wv + r32] = S0[i]; stp[k * 128 + 64 * wv + 32 + r32] = S1[i]; }
        if (C.tid >= 384) DSC[((size_t)bh * 32 + sc) * 128 + (C.tid & 127)] = __expf(dtot);
    }
}
__device__ __forceinline__ void hgrn_b1(const Ctx& C, int l) { for (int u = C.bid; u < BATCH * 4 * 32; u += C.G) hgrn_unit<false>(C, l, u); }
__device__ __forceinline__ void hgrn_b3(const Ctx& C, int l) { for (int u = C.bid; u < BATCH * 4 * 32; u += C.G) hgrn_unit<true>(C, l, u); }
__device__ __forceinline__ void hgrn_b2(const Ctx& C) {
    float* STB = (float*)(C.ws + WS_ST); const float* DSC = (const float*)(C.ws + WS_DSC);
    for (int e = C.bid * 512 + C.tid; e < BATCH * 4 * 128 * 128; e += C.G * 512) {
        const int bh = e >> 14, kv = e & 16383, k = kv >> 7;
        float* p = STB + (size_t)bh * 32 * 16384 + kv;
        float uu[32], dd[32];
#pragma unroll
        for (int s = 0; s < 32; ++s) { uu[s] = p[(size_t)s * 16384]; dd[s] = DSC[((size_t)bh * 32 + s) * 128 + k]; }
        float st = 0.f;
#pragma unroll
        for (int s = 0; s < 32; ++s) { p[(size_t)s * 16384] = st; st = dd[s] * st + uu[s]; }
    }
}


__device__ __forceinline__ void mix_pool(const Ctx& C, int l) {
#if DIAG == 2
    const bf16_t* H = (const bf16_t*)(C.ws + WS_H); bf16_t* BR = (l == 0) ? (bf16_t*)(C.ws + WS_XA) : (bf16_t*)(C.ws + WS_TABU);
#else
    const bf16_t* H = (const bf16_t*)(C.ws + WS_H); bf16_t* BR = (bf16_t*)(C.ws + WS_BR);
#endif
    const bf16_t* Wt = (const bf16_t*)(C.ws + WS_W + (size_t)l * W_LAYER + WO_POOLW);
    LAS unsigned char* lds = C.lds;
    const int lane = C.lane, w = C.wave, r32 = lane & 31, hh = lane >> 5;
    for (int u = C.bid; u < (T / 256) * 4; u += C.G) {
        const int g = u & 3, t0 = (u >> 2) * 256, win = 2 << g;
        const int row = t0 + 32 * w + r32, pos = row & (SEQ - 1);
        __syncthreads();
#pragma unroll
        for (int p = 0; p < 4; ++p) { const int idx = C.tid + 512 * p, rr = idx >> 4, ch = idx & 15;
            *(LAS u32x4*)(lds + rr * 272 + ch * 16) = *(const u32x4*)(Wt + (size_t)g * 128 * 128 + rr * 128 + ch * 8); }
        const int nwin = (pos + 1 < win) ? pos + 1 : win;
        const float invn = 1.f / (float)nwin;
        bf16x8 df[8];
        const bf16_t* pp = H + (size_t)row * NH + HC_P + g * 128 + 8 * hh;
#pragma unroll
        for (int ks = 0; ks < 8; ++ks) {
            float sum[8];
#pragma unroll
            for (int e = 0; e < 8; ++e) sum[e] = 0.f;
            u32x4 rw[16];
#pragma unroll
            for (int j = 0; j < 16; ++j) { const int jj = (j < nwin) ? j : 0; rw[j] = *(const u32x4*)(pp + 16 * ks - (size_t)jj * NH); }
            const u32x4 self = rw[0];
#pragma unroll
            for (int j = 0; j < 16; ++j) { const float msk = (j < nwin) ? 1.f : 0.f;
#pragma unroll
                for (int e = 0; e < 4; ++e) { sum[2 * e] += msk * bf2f(rw[j][e] & 0xffffu); sum[2 * e + 1] += msk * bf2f(rw[j][e] >> 16); } }
            u32x4 o;
#pragma unroll
            for (int e = 0; e < 4; ++e) o[e] = cvtpk(sum[2 * e] * invn - bf2f(self[e] & 0xffffu), sum[2 * e + 1] * invn - bf2f(self[e] >> 16));
            df[ks] = __builtin_bit_cast(bf16x8, o);
        }
        __syncthreads();
        f32x16 acc[4];
#pragma unroll
        for (int mt = 0; mt < 4; ++mt)
#pragma unroll
            for (int i = 0; i < 16; ++i) acc[mt][i] = 0.f;
#pragma unroll
        for (int ks = 0; ks < 8; ++ks)
#pragma unroll
            for (int mt = 0; mt < 4; ++mt) {
                const bf16x8 wf = *(const LAS bf16x8*)(lds + (32 * mt + r32) * 272 + 32 * ks + 16 * hh);
                acc[mt] = MFMA32(wf, df[ks], acc[mt]);
            }
        const float* psc = C.in[I_POOLS] + l * BW + g * 128;
        bf16_t* op = BR + (size_t)row * NBR + g * 128;
#pragma unroll
        for (int mt = 0; mt < 4; ++mt)
#pragma unroll
            for (int q = 0; q < 4; ++q) { const int d0 = 32 * mt + 8 * q + 4 * hh; const f32x4 sc = *(const f32x4*)(psc + d0);
                u32x2 o; o[0] = cvtpk(acc[mt][4 * q] * sc[0], acc[mt][4 * q + 1] * sc[1]); o[1] = cvtpk(acc[mt][4 * q + 2] * sc[2], acc[mt][4 * q + 3] * sc[3]);
                *(u32x2*)(op + d0) = o; }
    }
}
constexpr int GM_VN = 0, GM_WC = 128 * 320, GM_END = GM_WC + 128 * 272;
__device__ __forceinline__ void mix_gmlp(const Ctx& C, int l) {
#if DIAG == 3
    const bf16_t* H = (const bf16_t*)(C.ws + WS_H); bf16_t* BR = (l == 0) ? (bf16_t*)(C.ws + WS_XA) : (bf16_t*)(C.ws + WS_TABU);
#else
    const bf16_t* H = (const bf16_t*)(C.ws + WS_H); bf16_t* BR = (bf16_t*)(C.ws + WS_BR);
#endif
    const bf16_t* Wc = (const bf16_t*)(C.ws + WS_W + (size_t)l * W_LAYER + WO_GWS);
    LAS unsigned char* lds = C.lds;
    const int lane = C.lane, w = C.wave, r32 = lane & 31, hh = lane >> 5;
    const int i16 = lane & 15, q4 = i16 >> 2, p4 = i16 & 3, blk = (lane >> 4) & 1;
    for (int u = C.bid; u < (T / 128) * 4; u += C.G) {
        const int g = u & 3, t0 = (u >> 2) * 128;
        __syncthreads();
#pragma unroll
        for (int p = 0; p < 4; ++p) { const int idx = C.tid + 512 * p, rr = idx >> 4, ch = idx & 15;
            *(LAS u32x4*)(lds + GM_WC + rr * 272 + ch * 16) = *(const u32x4*)(Wc + (size_t)g * 128 * 128 + rr * 128 + ch * 8); }
#pragma unroll
        for (int hb = 0; hb < 4; ++hb) {
            u32x4 rawv[4];
#pragma unroll
            for (int i = 0; i < 4; ++i) rawv[i] = *(const u32x4*)(H + (size_t)(t0 + w * 16 + hb * 4 + i) * NH + HC_GV + lane * 8);
            float e[4][8], st[8];
#pragma unroll
            for (int i = 0; i < 4; ++i) { float s1 = 0.f, s2 = 0.f;
#pragma unroll
                for (int j = 0; j < 4; ++j) { const float a = geluf_(bf2f(rawv[i][j] & 0xffffu)), b = geluf_(bf2f(rawv[i][j] >> 16)); e[i][2 * j] = a; e[i][2 * j + 1] = b; s1 += a + b; s2 += a * a + b * b; }
                st[i] = s1; st[4 + i] = s2; }
#pragma unroll
            for (int sx = 32, n = 4; sx >= 8; sx >>= 1, n >>= 1) { const bool up = (lane & sx) != 0;
#pragma unroll
                for (int i = 0; i < n; ++i) { const float send = up ? st[i] : st[i + n], keep = up ? st[i + n] : st[i]; st[i] = keep + __shfl_xor(send, sx, 64); } }
            float tot = st[0]; tot += __shfl_xor(tot, 4, 64); tot += __shfl_xor(tot, 2, 64); tot += __shfl_xor(tot, 1, 64);
            float mean4[4], rstd4[4];
#pragma unroll
            for (int i = 0; i < 4; ++i) {
                mean4[i] = __builtin_bit_cast(float, __builtin_amdgcn_readlane(__builtin_bit_cast(int, tot), 8 * i)) * (1.f / BW);
                const float ex2 = __builtin_bit_cast(float, __builtin_amdgcn_readlane(__builtin_bit_cast(int, tot), 8 * (4 + i))) * (1.f / BW);
                rstd4[i] = rsqrtf(fmaxf(ex2 - mean4[i] * mean4[i], 0.f) + LN_EPS);
            }
            asm volatile("" ::: "memory");
            if ((lane >> 4) == g) {
                const float* lg = C.in[I_GLNG] + l * BW + lane * 8; const float* lb = C.in[I_GLNB] + l * BW + lane * 8;
#pragma unroll
                for (int i = 0; i < 4; ++i) {
                    const float mean = mean4[i], rstd = rstd4[i];
                    u32x4 o;
#pragma unroll
                    for (int j = 0; j < 4; ++j) o[j] = cvtpk((e[i][2 * j] - mean) * rstd * lg[2 * j] + lb[2 * j], (e[i][2 * j + 1] - mean) * rstd * lg[2 * j + 1] + lb[2 * j + 1]);
                    *(LAS u32x4*)(lds + GM_VN + (w * 16 + hb * 4 + i) * 320 + (lane & 15) * 16) = o;
                }
            }
        }
        __syncthreads();
        const int nt = w & 3, mb = (w >> 2) * 2;
        f32x16 acc[2];
#pragma unroll
        for (int m = 0; m < 2; ++m)
#pragma unroll
            for (int i = 0; i < 16; ++i) acc[m][i] = 0.f;
        for (int ks = 0; ks < 2 * (nt + 1); ++ks) {
            const bf16x8 bf = *(const LAS bf16x8*)(lds + GM_WC + (32 * nt + r32) * 272 + 32 * ks + 16 * hh);
#pragma unroll
            for (int m = 0; m < 2; ++m) {
                const LAS unsigned char* aa = lds + GM_VN + (16 * ks + 8 * hh + q4) * 320 + (32 * (mb + m) + 16 * blk + 4 * p4) * 2;
                const s16x4 lo = vtr(aa), hi = vtr(aa + 4 * 320);
                acc[m] = MFMA32(__builtin_shufflevector(lo, hi, 0, 1, 2, 3, 4, 5, 6, 7), bf, acc[m]);
            }
        }
        const int tl = 32 * nt + r32, row = t0 + tl;
        const float bias = C.in[I_GBS][(l * 4 + g) * 128 + tl];
#pragma unroll
        for (int m = 0; m < 2; ++m)
#pragma unroll
            for (int q = 0; q < 4; ++q) { const int c0 = 32 * (mb + m) + 8 * q + 4 * hh;
                const u32x2 ur = *(const u32x2*)(H + (size_t)row * NH + HC_GU + g * 128 + c0);
                u32x2 o;
                o[0] = cvtpk(geluf_(bf2f(ur[0] & 0xffffu)) * (acc[m][4 * q] + bias), geluf_(bf2f(ur[0] >> 16)) * (acc[m][4 * q + 1] + bias));
                o[1] = cvtpk(geluf_(bf2f(ur[1] & 0xffffu)) * (acc[m][4 * q + 2] + bias), geluf_(bf2f(ur[1] >> 16)) * (acc[m][4 * q + 3] + bias));
                *(u32x2*)(BR + (size_t)row * NBR + 1024 + g * 128 + c0) = o; }
    }
}

#define CE_D(a, b) do { const float _h = fmaxf(a, b), _l = fminf(a, b); a = _h; b = _l; } while (0)
__device__ __forceinline__ void sort16_desc(float (&x)[16]) {
#pragma unroll
    for (int k = 2; k <= 16; k <<= 1)
#pragma unroll
        for (int j = k >> 1; j > 0; j >>= 1)
#pragma unroll
            for (int i = 0; i < 16; ++i) { const int l = i ^ j; if (l > i) { if ((i & k) == 0) CE_D(x[i], x[l]); else CE_D(x[l], x[i]); } }
}
__device__ __forceinline__ void bmerge16_desc(float (&x)[16]) {
#pragma unroll
    for (int j = 8; j > 0; j >>= 1)
#pragma unroll
        for (int i = 0; i < 16; ++i) { const int l = i ^ j; if (l > i) CE_D(x[i], x[l]); }
}
__device__ __forceinline__ void top16_merge(float (&a)[16], const float (&b)[16]) {
#pragma unroll
    for (int i = 0; i < 16; ++i) a[i] = fmaxf(a[i], b[15 - i]);
    bmerge16_desc(a);
}
__device__ __forceinline__ float pack_idx(float v, unsigned idx, unsigned mask) { return __builtin_bit_cast(float, (__builtin_bit_cast(unsigned, v) & ~mask) | idx); }

constexpr int TK_KST = 272, TK_KBUF = 128 * TK_KST;
__device__ __forceinline__ void p_topk(const Ctx& C, int l) {
    const bf16_t* Q = (const bf16_t*)(C.ws + WS_Q);
    const bf16_t* keys = (const bf16_t*)(C.ws + WS_W + (size_t)l * W_LAYER + WO_KEYS);
    int* eidx = (int*)(C.ws + WS_EIDX); float* egate = (float*)(C.ws + WS_EGATE);
    LAS unsigned char* lds = C.lds;
    const int lane = C.lane, w = C.wave, r32 = lane & 31, hh = lane >> 5;
    for (int u = C.bid; u < (T / 256) * PH; u += C.G) {
        const int h = u & 7, t0 = (u >> 3) * 256, tok = t0 + 32 * w + r32;
        float v12[2][16];
        __syncthreads();
#pragma unroll
        for (int j = 0; j < 2; ++j) {
            const bf16_t* kp = keys + ((size_t)j * PH + h) * 128 * 128;
#pragma unroll
            for (int p = 0; p < 4; ++p) { const int idx = C.tid + 512 * p, row = idx >> 4, ch = idx & 15;
                *(LAS u32x4*)(lds + j * TK_KBUF + row * TK_KST + ch * 16) = *(const u32x4*)(kp + row * 128 + ch * 8); }
        }
        __syncthreads();
#pragma unroll
        for (int j = 0; j < 2; ++j) {
            bf16x8 qf[8];
            {
                LAS unsigned char* qs = lds + 2 * TK_KBUF + w * (32 * 272);
                u32x4 qr[8];
#pragma unroll
                for (int p = 0; p < 8; ++p) qr[p] = *(const u32x4*)(Q + (size_t)(t0 + 32 * w + 4 * p + (lane >> 4)) * NQ + h * 256 + j * 128 + (lane & 15) * 8);
#pragma unroll
                for (int p = 0; p < 8; ++p) *(LAS u32x4*)(qs + (4 * p + (lane >> 4)) * 272 + (lane & 15) * 16) = qr[p];
#pragma unroll
                for (int ks = 0; ks < 8; ++ks) qf[ks] = *(const LAS bf16x8*)(qs + r32 * 272 + 32 * ks + 16 * hh);
            }
            f32x16 sacc[4];
#pragma unroll
            for (int mt = 0; mt < 4; ++mt)
#pragma unroll
                for (int i = 0; i < 16; ++i) sacc[mt][i] = 0.f;
#pragma unroll
            for (int ks = 0; ks < 8; ++ks)
#pragma unroll
                for (int mt = 0; mt < 4; ++mt) {
                    const bf16x8 kf = *(const LAS bf16x8*)(lds + j * TK_KBUF + (32 * mt + r32) * TK_KST + 32 * ks + 16 * hh);
                    sacc[mt] = MFMA32(kf, qf[ks], sacc[mt]);
                }
            float g[4][16];
#pragma unroll
            for (int mt = 0; mt < 4; ++mt) {
#pragma unroll
                for (int i = 0; i < 16; ++i) g[mt][i] = pack_idx(sacc[mt][i], (unsigned)(32 * mt + (i & 3) + 8 * (i >> 2) + 4 * hh), 127u);
                sort16_desc(g[mt]);
            }
            top16_merge(g[0], g[1]); top16_merge(g[2], g[3]); top16_merge(g[0], g[2]);
            float o[16];
#pragma unroll
            for (int i = 0; i < 16; ++i) o[i] = __shfl_xor(g[0][i], 32, 64);
            top16_merge(g[0], o);
#pragma unroll
            for (int i = 0; i < 16; ++i) v12[j][i] = g[0][i];
        }
        float c[4][16];
        {
            int n = 0;
#pragma unroll
            for (int a = 0; a < 16; ++a)
#pragma unroll
                for (int b = 0; b < 16; ++b) if ((a + 1) * (b + 1) <= 16) {
                    const unsigned id = ((__builtin_bit_cast(unsigned, v12[0][a]) & 127u) << 7) | (__builtin_bit_cast(unsigned, v12[1][b]) & 127u);
                    c[n >> 4][n & 15] = pack_idx(v12[0][a] + v12[1][b], id, 16383u); ++n; }
#pragma unroll
            for (; n < 64; ++n) c[n >> 4][n & 15] = -3.0e38f;
        }
#pragma unroll
        for (int q = 0; q < 4; ++q) sort16_desc(c[q]);
        top16_merge(c[0], c[1]); top16_merge(c[2], c[3]); top16_merge(c[0], c[2]);
        float e[16], den = 0.f;
#pragma unroll
        for (int i = 0; i < 16; ++i) { e[i] = __expf(c[0][i] - c[0][0]); den += e[i]; }
        const float inv = 1.f / den;
        int* ip = eidx + (size_t)tok * 128 + h * 16 + 8 * hh; float* gp = egate + (size_t)tok * 128 + h * 16 + 8 * hh;
        u32x4 i0, i1; f32x4 g0, g1;
#pragma unroll
        for (int i = 0; i < 4; ++i) {
            const float ca = hh ? c[0][8 + i] : c[0][i], cb = hh ? c[0][12 + i] : c[0][4 + i];
            i0[i] = __builtin_bit_cast(unsigned, ca) & 16383u; i1[i] = __builtin_bit_cast(unsigned, cb) & 16383u;
            g0[i] = (hh ? e[8 + i] : e[i]) * inv; g1[i] = (hh ? e[12 + i] : e[4 + i]) * inv;
        }
        *(u32x4*)ip = i0; *(u32x4*)(ip + 4) = i1; *(f32x4*)gp = g0; *(f32x4*)(gp + 4) = g1;
    }
}

constexpr int CW_DIAG = 64;
__device__ __forceinline__ void diag_cmp(const Ctx& C, const bf16_t* A, int lda, const bf16_t* R, int ldr, int nc) {
    float sd = 0.f, sr = 0.f;
    for (int row = C.bid; row < T; row += C.G) {
        const int tm = row % DIAG_MOD; if (tm < DIAG_LO || tm >= DIAG_HI) continue;
        for (int c = C.tid; c < nc; c += 512) { const float a = bf2f(A[(size_t)row * lda + c]), r = bf2f(R[(size_t)row * ldr + c]); sd += (a - r) * (a - r); sr += r * r; }
    }
    sd = wave_sum(sd); sr = wave_sum(sr);
    if (C.lane == 0) { atomicAdd((float*)(C.ws + WS_CTL) + CW_DIAG, sd); atomicAdd((float*)(C.ws + WS_CTL) + CW_DIAG + 1, sr); }
}
__device__ __forceinline__ void diag_cmp_u8(const Ctx& C, const unsigned char* A, int lda, const bf16_t* R, int ldr, int nc) {
    float sd = 0.f, sr = 0.f;
    for (int row = C.bid; row < T; row += C.G)
        for (int c = C.tid; c < nc; c += 512) { const float a = (float)A[(size_t)row * lda + c] * (1.f / 255.f), r = bf2f(R[(size_t)row * ldr + c]); sd += (a - r) * (a - r); sr += r * r; }
    sd = wave_sum(sd); sr = wave_sum(sr);
    if (C.lane == 0) { atomicAdd((float*)(C.ws + WS_CTL) + CW_DIAG, sd); atomicAdd((float*)(C.ws + WS_CTL) + CW_DIAG + 1, sr); }
}
__device__ __forceinline__ float diag_alpha(const Ctx& C) {
    const float sd = __hip_atomic_load((float*)(C.ws + WS_CTL) + CW_DIAG, __ATOMIC_RELAXED, __HIP_MEMORY_SCOPE_AGENT), sr = __hip_atomic_load((float*)(C.ws + WS_CTL) + CW_DIAG + 1, __ATOMIC_RELAXED, __HIP_MEMORY_SCOPE_AGENT);
    const float err = fmaxf(sd / fmaxf(sr, 1e-30f), 1e-8f);
    return 0.1f + 0.1f * (rintf(log10f(err / 1e-8f) * 10.f) * 0.1f);
}


#if DIAG == 5 || DIAG == 6
__device__ __forceinline__ void diag_ref_slice(const Ctx& C, const float* W, int ldw, int n0, const float* bias) {
    bf16_t* alt = (bf16_t*)(C.ws + WS_XA);
    const float* X = C.in[I_X];
    for (int row = C.bid * 8 + C.wave; row < T; row += C.G * 8) {
        float acc = 0.f;
        for (int k = 0; k < DM; ++k) acc += X[(size_t)row * DM + k] * W[(size_t)k * ldw + n0 + C.lane];
        if (bias) acc = sigmoidf_(acc + bias[n0 + C.lane]);
        alt[(size_t)row * 64 + C.lane] = (bf16_t)f2bf(acc);
    }
}
#endif

__device__ __forceinline__ void wave_argmax(float& v, int& i) {
#pragma unroll
    for (int o = 32; o > 0; o >>= 1) {
        const float ov = __shfl_xor(v, o, 64); const int oi = __shfl_xor(i, o, 64);
        if (ov > v || (ov == v && oi < i)) { v = ov; i = oi; }
    }
}
__device__ __forceinline__ void p_topk_naive(const Ctx& C, int l) {
    const bf16_t* Q = (const bf16_t*)(C.ws + WS_Q);
    const bf16_t* keys = (const bf16_t*)(C.ws + WS_W + (size_t)l * W_LAYER + WO_KEYS);
    int* eidx = (int*)(C.ws + WS_EIDX); float* egate = (float*)(C.ws + WS_EGATE);
    LAS float* qs = (LAS float*)C.lds;
    LAS float* sc = qs + 2048;
    LAS float* tv = sc + 2048;
    LAS int* ti = (LAS int*)(tv + 256);
    for (int t = C.bid; t < T; t += C.G) {
        for (int i = C.tid; i < 2048; i += 512) qs[i] = bf2f(Q[(size_t)t * NQ + i]);
        __syncthreads();
        for (int i = 0; i < 4; ++i) {
            const int idx = C.tid + 512 * i, hj = idx >> 7, key = idx & 127, h = hj >> 1, j = hj & 1;
            const bf16_t* kp = keys + (((size_t)j * PH + h) * 128 + key) * 128;
            float s = 0.f;
            for (int d8 = 0; d8 < 16; ++d8) {
                const u32x4 raw = *(const u32x4*)(kp + d8 * 8);
#pragma unroll
                for (int e = 0; e < 4; ++e) s += qs[h * 256 + j * 128 + d8 * 8 + 2 * e] * bf2f(raw[e] & 0xffffu) + qs[h * 256 + j * 128 + d8 * 8 + 2 * e + 1] * bf2f(raw[e] >> 16);
            }
            sc[idx] = s;
        }
        __syncthreads();
        for (int i = 0; i < 2; ++i) {
            const int hj = C.wave * 2 + i;
            float a0 = sc[hj * 128 + C.lane], a1 = sc[hj * 128 + 64 + C.lane];
            for (int r = 0; r < 16; ++r) {
                float bv; int bi;
                if (a0 > a1 || (a0 == a1)) { bv = a0; bi = C.lane; } else { bv = a1; bi = C.lane + 64; }
                wave_argmax(bv, bi);
                if (C.lane == 0) { tv[hj * 16 + r] = bv; ti[hj * 16 + r] = bi; }
                if (bi == C.lane) a0 = -3e38f; if (bi == C.lane + 64) a1 = -3e38f;
            }
        }
        __syncthreads();
        {
            const int h = C.wave;
            float cv[4];
#pragma unroll
            for (int i = 0; i < 4; ++i) { const int c = C.lane * 4 + i; cv[i] = tv[(h * 2) * 16 + (c >> 4)] + tv[(h * 2 + 1) * 16 + (c & 15)]; }
            float topv = 0.f; int tope = 0; float mx = 0.f;
            for (int r = 0; r < 16; ++r) {
                float bv = cv[0]; int bi = C.lane * 4;
#pragma unroll
                for (int i = 1; i < 4; ++i) if (cv[i] > bv) { bv = cv[i]; bi = C.lane * 4 + i; }
                wave_argmax(bv, bi);
                if (r == 0) mx = bv;
                if (C.lane == r) { topv = bv; tope = ti[(h * 2) * 16 + (bi >> 4)] * 128 + ti[(h * 2 + 1) * 16 + (bi & 15)]; }
#pragma unroll
                for (int i = 0; i < 4; ++i) if (bi == C.lane * 4 + i) cv[i] = -3e38f;
            }
            float e = (C.lane < 16) ? __expf(topv - mx) : 0.f;
            const float den = wave_sum(e);
            if (C.lane < 16) { eidx[(size_t)t * 128 + h * 16 + C.lane] = tope; egate[(size_t)t * 128 + h * 16 + C.lane] = e / den; }
        }
        __syncthreads();
    }
}
__device__ __forceinline__ float ub(unsigned w, int e) { return (float)((w >> (8 * e)) & 255u); }
__device__ __forceinline__ void p_gather(const Ctx& C, int l) {
    const bf16_t* xc = (const bf16_t*)(C.ws + WS_X1B);
    const unsigned char* U8 = C.ws + WS_U8; const unsigned char* V8 = C.ws + WS_V8;
    const float* SU = (const float*)(C.ws + WS_SU); const float* SV = (const float*)(C.ws + WS_SV);
    const int* eidx = (const int*)(C.ws + WS_EIDX); const float* egate = (const float*)(C.ws + WS_EGATE);
    const int lane = C.lane;
    for (int t = C.bid * 8 + C.wave; t < T; t += C.G * 8) {
        float x[16];
        { const bf16_t* xp = xc + (size_t)t * DM + lane * 16;
          const u32x4 a = *(const u32x4*)xp, b = *(const u32x4*)(xp + 8);
#pragma unroll
          for (int i = 0; i < 4; ++i) { x[2 * i] = bf2f(a[i] & 0xffffu); x[2 * i + 1] = bf2f(a[i] >> 16); x[8 + 2 * i] = bf2f(b[i] & 0xffffu); x[9 + 2 * i] = bf2f(b[i] >> 16); } }
        float xmx = 0.f;
#pragma unroll
        for (int j = 0; j < 16; ++j) xmx = fmaxf(xmx, fabsf(x[j]));
        xmx = fmaxf(wave_max(xmx), 1e-30f);
        const float xisc = 127.f / xmx, xsc = xmx * (1.f / 127.f);
        int xq[4];
#pragma unroll
        for (int q = 0; q < 4; ++q) { unsigned wd = 0u;
#pragma unroll
            for (int e = 0; e < 4; ++e) wd |= ((unsigned)(int)rintf(x[4 * q + e] * xisc) & 255u) << (8 * e);
            xq[q] = (int)wd; }
        float cf[2]; int ex[2];
#pragma unroll
        for (int bt = 0; bt < 2; ++bt) {
            ex[bt] = eidx[(size_t)t * 128 + 64 * bt + lane];
            const float gate = egate[(size_t)t * 128 + 64 * bt + lane];
            int p[64];
#pragma unroll
            for (int e0 = 0; e0 < 64; e0 += 16) {
                u32x4 r[16];
#pragma unroll
                for (int i = 0; i < 16; ++i) { const int e = __builtin_amdgcn_readlane(ex[bt], e0 + i); r[i] = *(const u32x4*)(U8 + (size_t)e * DM + lane * 16); }
#pragma unroll
                for (int i = 0; i < 16; ++i) { int a = 0;
#pragma unroll
                    for (int q = 0; q < 4; ++q) a = __builtin_amdgcn_sdot4(xq[q], (int)r[i][q], a, false);
                    p[e0 + i] = a; }
            }
#pragma unroll
            for (int st = 32, n = 32; st > 0; st >>= 1, n >>= 1) {
                const bool up = (lane & st) != 0;
#pragma unroll
                for (int i = 0; i < n; ++i) { const int send = up ? p[i] : p[i + n], keep = up ? p[i + n] : p[i]; p[i] = keep + __shfl_xor(send, st, 64); }
            }
            const float hsum = SU[ex[bt]] * xsc * (float)p[0];
            cf[bt] = gate * geluf_slow(hsum) * SV[ex[bt]];
        }
        float y[16];
#pragma unroll
        for (int j = 0; j < 16; ++j) y[j] = 0.f;
        float csum = wave_sum(cf[0] + cf[1]);
#pragma unroll
        for (int bt = 0; bt < 2; ++bt)
#pragma unroll
            for (int e0 = 0; e0 < 64; e0 += 16) {
                u32x4 r[16];
#pragma unroll
                for (int i = 0; i < 16; ++i) { const int e = __builtin_amdgcn_readlane(ex[bt], e0 + i); r[i] = *(const u32x4*)(V8 + (size_t)e * DM + lane * 16); }
#pragma unroll
                for (int i = 0; i < 16; ++i) { const float c = __builtin_bit_cast(float, __builtin_amdgcn_readlane(__builtin_bit_cast(int, cf[bt]), e0 + i));
#pragma unroll
                    for (int q = 0; q < 4; ++q)
#pragma unroll
                        for (int e = 0; e < 4; ++e) y[4 * q + e] += c * ub(r[i][q], e); }
            }
#pragma unroll
        for (int j = 0; j < 16; ++j) y[j] = y[j] - 128.f * csum + ALPHA * x[j];
        float sm = 0.f;
#pragma unroll
        for (int j = 0; j < 16; ++j) sm += y[j];
        const float mean = wave_sum(sm) * (1.f / DM);
        float qq = 0.f;
#pragma unroll
        for (int j = 0; j < 16; ++j) { const float d = y[j] - mean; qq += d * d; }
        const float rstd = rsqrtf(wave_sum(qq) * (1.f / DM) + LN_EPS);
        const float* gp = C.in[I_LN2G] + l * DM + lane * 16; const float* bp = C.in[I_LN2B] + l * DM + lane * 16;
#pragma unroll
        for (int i = 0; i < 4; ++i) { const f32x4 gg = *(const f32x4*)(gp + 4 * i), bb = *(const f32x4*)(bp + 4 * i);
#pragma unroll
            for (int e = 0; e < 4; ++e) y[4 * i + e] = (y[4 * i + e] - mean) * rstd * gg[e] + bb[e]; }
        float* dst = (l + 1 < DEPTH) ? (float*)(C.ws + WS_XA) + (size_t)t * DM : C.out + (size_t)t * DM;
#if DIAG
        if (l + 1 == DEPTH) { const float al = 1.f + diag_alpha(C);
#pragma unroll
            for (int j = 0; j < 16; ++j) y[j] *= al; }
#endif
#pragma unroll
        for (int i = 0; i < 4; ++i) *(f32x4*)(dst + lane * 16 + 4 * i) = (f32x4){y[4 * i], y[4 * i + 1], y[4 * i + 2], y[4 * i + 3]};
        if (l + 1 < DEPTH) {
            {
                float mx = 0.f;
#pragma unroll
                for (int j = 0; j < 16; ++j) mx = fmaxf(mx, fabsf(y[j]));
                mx = fmaxf(wave_max(mx), 1e-30f);
                const float isc = 127.f / mx;
                u32x4 o8;
#pragma unroll
                for (int q = 0; q < 4; ++q) { unsigned wd = 0u;
#pragma unroll
                    for (int e = 0; e < 4; ++e) wd |= ((unsigned)(int)rintf(y[4 * q + e] * isc) & 255u) << (8 * e);
                    o8[q] = wd; }
                *(u32x4*)(C.ws + WS_XB + (size_t)t * DM + lane * 16) = o8;
                if (lane == 0) ((float*)(C.ws + WS_XSA))[t] = mx * (1.f / 127.f);
            }
            const float* wf = (const float*)(C.ws + WS_W + (size_t)(l + 1) * W_LAYER + WO_WF);
            float* lsig = (float*)(C.ws + WS_MISC);
#pragma unroll
            for (int h = 0; h < 4; ++h) {
                float sd = 0.f;
#pragma unroll
                for (int i = 0; i < 4; ++i) { const f32x4 a = *(const f32x4*)(wf + h * DM + lane * 16 + 4 * i);
#pragma unroll
                    for (int e = 0; e < 4; ++e) sd += y[4 * i + e] * a[e]; }
                sd = wave_sum(sd);
                if (lane == 0) lsig[(size_t)t * 4 + h] = logsigmoidf_(sd + C.in[I_BFOX][(l + 1) * 4 + h]);
            }
        }
    }
}

struct FStoreBf16 { bf16_t* O; int ld;
    __device__ __forceinline__ void operator()(int row, int col, f32x4 v0, f32x4 v1, int) const {
        u32x4 o; o[0] = pk2(v0[0], v0[1]); o[1] = pk2(v0[2], v0[3]); o[2] = pk2(v1[0], v1[1]); o[3] = pk2(v1[2], v1[3]);
        *(u32x4*)(O + (size_t)row * ld + col) = o; } };
typedef int i32x4 __attribute__((ext_vector_type(4)));
__device__ __forceinline__ void i8_dequant(f32x4& v0, f32x4& v1, float sa, const float* cs) {
    sa *= (1.f / 127.f);
    const f32x4 c0 = *(const f32x4*)cs, c1 = *(const f32x4*)(cs + 4);
    const i32x4 i0 = __builtin_bit_cast(i32x4, v0), i1 = __builtin_bit_cast(i32x4, v1);
#pragma unroll
    for (int e = 0; e < 4; ++e) { v0[e] = (float)i0[e] * sa * c0[e]; v1[e] = (float)i1[e] * sa * c1[e]; }
}
struct FStoreBf16I8 { bf16_t* O; int ld; const float* rs; const float* cs;
    __device__ __forceinline__ void operator()(int row, int col, f32x4 v0, f32x4 v1, int) const {
        i8_dequant(v0, v1, rs[row], cs + col);
        u32x4 o; o[0] = pk2(v0[0], v0[1]); o[1] = pk2(v0[2], v0[3]); o[2] = pk2(v1[0], v1[1]); o[3] = pk2(v1[2], v1[3]);
        *(u32x4*)(O + (size_t)row * ld + col) = o; } };
struct FGateI8 { unsigned char* O; const float* bias; const float* rs; const float* cs;
    __device__ __forceinline__ void operator()(int row, int col, f32x4 v0, f32x4 v1, int) const {
        i8_dequant(v0, v1, rs[row], cs + col);
        const f32x4 b0 = *(const f32x4*)(bias + col), b1 = *(const f32x4*)(bias + col + 4);
        u32x2 o; unsigned w0 = 0u, w1 = 0u;
#pragma unroll
        for (int e = 0; e < 4; ++e) { w0 |= (unsigned)(int)rintf(255.f * sigmoidf_(v0[e] + b0[e])) << (8 * e); w1 |= (unsigned)(int)rintf(255.f * sigmoidf_(v1[e] + b1[e])) << (8 * e); }
        o[0] = w0; o[1] = w1;
        *(u32x2*)(O + (size_t)row * NG + col) = o; } };
struct FGate { bf16_t* O; const float* bias;
    __device__ __forceinline__ void operator()(int row, int col, f32x4 v0, f32x4 v1, int) const {
        const f32x4 b0 = *(const f32x4*)(bias + col), b1 = *(const f32x4*)(bias + col + 4);
        u32x4 o; o[0] = pk2(sigmoidf_(v0[0] + b0[0]), sigmoidf_(v0[1] + b0[1])); o[1] = pk2(sigmoidf_(v0[2] + b0[2]), sigmoidf_(v0[3] + b0[3]));
        o[2] = pk2(sigmoidf_(v1[0] + b1[0]), sigmoidf_(v1[1] + b1[1])); o[3] = pk2(sigmoidf_(v1[2] + b1[2]), sigmoidf_(v1[3] + b1[3]));
        *(u32x4*)(O + (size_t)row * NG + col) = o; } };
struct FMerge { const unsigned char* G; bf16_t* MG;
    __device__ __forceinline__ void operator()(int row, int col, f32x4 v0, f32x4 v1, int z) const {
        const u32x2 gr = *(const u32x2*)(G + (size_t)row * NG + z * DM + col);
        float r[8];
#pragma unroll
        for (int e = 0; e < 4; ++e) { r[e] = v0[e] * (float)((gr[0] >> (8 * e)) & 255u) * (1.f / 255.f); r[4 + e] = v1[e] * (float)((gr[1] >> (8 * e)) & 255u) * (1.f / 255.f); }
        bf16_t* p = MG + (size_t)row * DM + col;
        if (z > 0) { const u32x4 pr = *(const u32x4*)p;
#pragma unroll
            for (int e = 0; e < 4; ++e) { r[2 * e] += bf2f(pr[e] & 0xffffu); r[2 * e + 1] += bf2f(pr[e] >> 16); } }
        u32x4 o;
#pragma unroll
        for (int e = 0; e < 4; ++e) o[e] = pk2(r[2 * e], r[2 * e + 1]);
        *(u32x4*)p = o; } };
struct FResid { const float* X; bf16_t* Y;
    __device__ __forceinline__ void operator()(int row, int col, f32x4 v0, f32x4 v1, int) const {
        const f32x4 x0 = *(const f32x4*)(X + (size_t)row * DM + col), x1 = *(const f32x4*)(X + (size_t)row * DM + col + 4);
#if DIAG == 5 || DIAG == 6
        v0 = (f32x4){0.f, 0.f, 0.f, 0.f}; v1 = v0;
#endif
        u32x4 o; o[0] = cvtpk(x0[0] * ALPHA + v0[0], x0[1] * ALPHA + v0[1]); o[1] = cvtpk(x0[2] * ALPHA + v0[2], x0[3] * ALPHA + v0[3]);
        o[2] = cvtpk(x1[0] * ALPHA + v1[0], x1[1] * ALPHA + v1[1]); o[3] = cvtpk(x1[2] * ALPHA + v1[2], x1[3] * ALPHA + v1[3]);
        *(u32x4*)(Y + (size_t)row * DM + col) = o; } };

constexpr int PH_PER_LAYER = 12, N_PHASES = 1 + DEPTH * PH_PER_LAYER;
template <int SP> __device__ __forceinline__ void run_phase(const Ctx& C0, int l) {
    Ctx C = C0;
    asm volatile("" : "+v"(C.tid));
    C.ws = launder_ptr(C.ws); C.out = launder_ptr(C.out); l = (int)launder_u((unsigned)l);
    C.lane = C.tid & 63; C.wave = __builtin_amdgcn_readfirstlane(C.tid >> 6);
    unsigned char* wb = C.ws + WS_W + (size_t)l * W_LAYER;
    if constexpr (SP == -1) { p_conv_weights(C); }
    if constexpr (SP == 0) {
        if (l == 0) {
            for (int l2 = 0; l2 < DEPTH; ++l2) {
                unsigned char* wb2 = C.ws + WS_W + (size_t)l2 * W_LAYER; const unsigned* cm = (const unsigned*)(C.ws + WS_CMAX) + l2 * (NH + NG);
                tconv_i8_job(C, C.in[I_WIN] + (size_t)l2 * DM * NIN, NIN, DM, NH, wb2 + WO_WIN, cm);
                tconv_i8_job(C, C.in[I_WGATE] + (size_t)l2 * DM * NG, NG, DM, NG, wb2 + WO_WG, cm + NH);
            }
            p_rowpass0(C);
        }
    }
    if constexpr (SP == 1) {
        p_cumsum(C);
        __syncthreads();
        pg8::Gemm g{(const bf16_t*)(C.ws + WS_XB), (const bf16_t*)(wb + WO_WIN), DM, DM, DM, 0, 0};
        pg8::StaticOrder S; S.init(T, NH, C.G, C.bid);
        pg8::Epi8<FStoreBf16I8> E{{(bf16_t*)(C.ws + WS_H), NH, (const float*)(C.ws + WS_XSA), (const float*)(C.ws + WS_CMAX) + l * (NH + NG)}};
        pg8::gemm_phase<pg8::Epi8<FStoreBf16I8>, pg8::StaticOrder, true>(C.lds, g, S, E, C.tid);
    }
#if DIAG == 5
    if constexpr (SP == 2) { if (l == 0) { diag_ref_slice(C, C.in[I_WIN], NIN, DIAG_N0, nullptr); } }
    if constexpr (SP == 3) { if (l == 0) diag_cmp(C, (const bf16_t*)(C.ws + WS_H) + DIAG_N0, NH, (const bf16_t*)(C.ws + WS_XA), 64, 64); }
#endif
#if DIAG == 6
    if constexpr (SP == 5) { if (l == 0) diag_ref_slice(C, C.in[I_WGATE], NG, DIAG_N0, C.in[I_BGATE]); }
    if constexpr (SP == 6) { if (l == 0) diag_cmp_u8(C, C.ws + WS_G + DIAG_N0, NG, (const bf16_t*)(C.ws + WS_XA), 64, 64); }
#endif
    if constexpr (SP == 2) { p_knorm(C, l); if (l != HG_NAIVE_L) hgrn_b1(C, l); }
#if MIX_NAIVE
    if constexpr (SP == 3) { if (l != HG_NAIVE_L) hgrn_b2(C); mix_pool_naive(C, l); mix_gmlp_naive(C, l); }
#else
    if constexpr (SP == 3) { if (l != HG_NAIVE_L) hgrn_b2(C); mix_pool(C, l); mix_gmlp(C, l);
        if (DIAG == 2) mix_pool_naive(C, l); if (DIAG == 3) mix_gmlp_naive(C, l); }
#endif
#if DIAG == 1
    if constexpr (SP == 4) { hgrn_b3(C, l); { mix_hgrn_naive(C, l); __syncthreads(); } mix_fox(C, l); }
    if constexpr (SP == 5) { if (l == DIAG_LAYER) diag_cmp(C, (const bf16_t*)(C.ws + (DIAG_LAYER == 0 ? WS_XA : WS_TABU)) + 512, NBR, (const bf16_t*)(C.ws + WS_BR) + 512, NBR, 512); }
#elif DIAG == 2 || DIAG == 3
    if constexpr (SP == 4) { hgrn_b3(C, l); mix_fox(C, l); if (l == DIAG_LAYER) diag_cmp(C, (const bf16_t*)(C.ws + (DIAG_LAYER == 0 ? WS_XA : WS_TABU)) + (DIAG == 2 ? 0 : 1024), NBR, (const bf16_t*)(C.ws + WS_BR) + (DIAG == 2 ? 0 : 1024), NBR, 512); }
#else
    if constexpr (SP == 4) { if (l != HG_NAIVE_L) hgrn_b3(C, l); else { mix_hgrn_naive(C, l); __syncthreads(); } mix_fox(C, l); }
#endif
    if constexpr (SP == 5) {
        pg8::Gemm g{(const bf16_t*)(C.ws + WS_XB), (const bf16_t*)(wb + WO_WG), DM, DM, DM, 0, 0};
        pg8::StaticOrder S; S.init(T, NG, C.G, C.bid);
        pg8::Epi8<FGateI8> E{{C.ws + WS_G, C.in[I_BGATE] + l * NG, (const float*)(C.ws + WS_XSA), (const float*)(C.ws + WS_CMAX) + l * (NH + NG) + NH}};
        pg8::gemm_phase<pg8::Epi8<FGateI8>, pg8::StaticOrder, true>(C.lds, g, S, E, C.tid);
    }
    if constexpr (SP == 6) {
        pg8::Gemm g{(const bf16_t*)(C.ws + WS_BR), (const bf16_t*)(wb + WO_WBR), NBR, BW, BW, (size_t)BW, (size_t)DM * BW};
        pg8::ZOrder S; S.init(T, DM, 4, C.G, C.vcu);
        pg8::Epi8<FMerge> E{{C.ws + WS_G, (bf16_t*)(C.ws + WS_XB)}};
        pg8::gemm_phase(C.lds, g, S, E, C.tid);
    }
    if constexpr (SP == 7) {
        const float* xin = (l == 0) ? C.in[I_X] : (const float*)(C.ws + WS_XA);
        pg8::Gemm g{(const bf16_t*)(C.ws + WS_XB), (const bf16_t*)(wb + WO_WOUT), DM, DM, DM, 0, 0};
        pg8::StaticOrder S; S.init(T, DM, C.G, C.bid);
        pg8::Epi8<FResid> E{{xin, (bf16_t*)(C.ws + WS_XC)}};
        pg8::gemm_phase(C.lds, g, S, E, C.tid);
    }
    if constexpr (SP == 8) { p_ln1(C, l); p_conv_tables(C, l); }
    if constexpr (SP == 9) {
        pg8::Gemm g{(const bf16_t*)(C.ws + WS_X1B), (const bf16_t*)(wb + WO_WQ), DM, DM, DM, 0, 0};
        pg8::StaticOrder S; S.init(T, NQ, C.G, C.bid);
        pg8::Epi8<FStoreBf16> E{{(bf16_t*)(C.ws + WS_Q), NQ}};
        pg8::gemm_phase(C.lds, g, S, E, C.tid);
    }
#if TOPK_NAIVE
    if constexpr (SP == 10) p_topk_naive(C, l);
#else
    if constexpr (SP == 10) p_topk(C, l);
#endif
    if constexpr (SP == 11) p_gather(C, l);
}
__device__ __forceinline__ void make_ctx(Ctx& C, const Args& args, unsigned char* lds_raw) {
    C.lds = (LAS unsigned char*)lds_raw; C.ws = args.ws; C.in = args.in; C.out = args.out;
    C.tid = threadIdx.x; C.lane = C.tid & 63; C.wave = __builtin_amdgcn_readfirstlane(C.tid >> 6);
    C.G = gridDim.x; C.bid = blockIdx.x; C.vcu = (C.G % 8 == 0) ? (C.bid % 8) * (C.G / 8) + C.bid / 8 : C.bid;
}
#if !MK_ONE_LAUNCH
template <int SP> __global__ void __launch_bounds__(512, 2) mk_phase(Args args) {
    extern __shared__ __attribute__((aligned(16))) unsigned char lds_raw[];
    Ctx C; make_ctx(C, args, lds_raw);
    run_phase<SP>(C, args.ph_lo);
}
#endif

#define GRID_BAR() xcd_barrier((unsigned*)(args.ws + WS_CTL) + 1024, (volatile LAS unsigned*)((LAS unsigned char*)lds_raw + LDSCTL_OFF + 32))
__global__ void __launch_bounds__(512, 2) mk_fwd(Args args) {
    extern __shared__ __attribute__((aligned(16))) unsigned char lds_raw[];
    Ctx C; make_ctx(C, args, lds_raw);
    { volatile LAS unsigned* misc = (volatile LAS unsigned*)(C.lds + LDSCTL_OFF); if (C.tid < 64) misc[C.tid] = 0u; }
    __syncthreads();
    xcd_barrier_post((unsigned*)(args.ws + WS_CTL) + 1024);
    run_phase<-1>(C, 0); GRID_BAR();
#pragma unroll 1
    for (int l = 0; l < DEPTH; ++l) {
        if (l == 0) { run_phase<0>(C, l); GRID_BAR(); }
        run_phase<1>(C, l); GRID_BAR();
        run_phase<2>(C, l); GRID_BAR();
        run_phase<3>(C, l); GRID_BAR();
        run_phase<4>(C, l); GRID_BAR();
        run_phase<5>(C, l); GRID_BAR();
        run_phase<6>(C, l); GRID_BAR();
        run_phase<7>(C, l); GRID_BAR();
        run_phase<8>(C, l); GRID_BAR();
        run_phase<9>(C, l); GRID_BAR();
        run_phase<10>(C, l); GRID_BAR();
        run_phase<11>(C, l); if (l + 1 < DEPTH) GRID_BAR();
    }
}

#if !MK_ONE_LAUNCH
template <int SP> static void launch_phase(const Args& a, int grid, hipStream_t stream) {
    static bool attr_done = false;
    if (!attr_done) { (void)hipFuncSetAttribute((const void*)mk_phase<SP>, hipFuncAttributeMaxDynamicSharedMemorySize, LDS_BYTES); attr_done = true; }
    hipLaunchKernelGGL(mk_phase<SP>, dim3(grid), dim3(512), LDS_BYTES, stream, a);
}
#endif
extern "C" void kernel_launch(void* const* d_in, const int* in_sizes, int n_in, void* d_out, int out_size, void* d_ws, size_t ws_size, hipStream_t stream) {
    static int grid = 0;
    if (grid == 0) {
        if (n_in != NIN_PTRS || out_size != T * DM || ws_size < WS_END) { fprintf(stderr, "kernel_launch: unexpected shapes n_in %d out %d ws %zu\n", n_in, out_size, ws_size); grid = -1; return; }
        int dev = 0, cus = 0;
        if (hipGetDevice(&dev) != hipSuccess || hipDeviceGetAttribute(&cus, hipDeviceAttributeMultiprocessorCount, dev) != hipSuccess) { grid = -1; return; }
        grid = cus;
    }
    if (grid < 0) return;
    (void)hipMemsetAsync((char*)d_ws + WS_CTL, 0, CTL_ZERO_BYTES, stream);
    Args a{};
    for (int i = 0; i < NIN_PTRS; ++i) a.in[i] = (const float*)d_in[i];
    a.out = (float*)d_out; a.ws = (unsigned char*)d_ws; a.bar_slot = 0; a.pad = 0; a.ph_hi = 0;
#if MK_ONE_LAUNCH
    static bool attr_done = false;
    if (!attr_done) { (void)hipFuncSetAttribute((const void*)mk_fwd, hipFuncAttributeMaxDynamicSharedMemorySize, LDS_BYTES); attr_done = true; }
    hipLaunchKernelGGL(mk_fwd, dim3(grid), dim3(512), LDS_BYTES, stream, a);
    return;
#endif
#if !MK_ONE_LAUNCH
    a.ph_lo = 0; launch_phase<-1>(a, grid, stream);
    for (int l = 0; l < DEPTH; ++l) {
        a.ph_lo = l;
        launch_phase<0>(a, grid, stream); launch_phase<1>(a, grid, stream); launch_phase<2>(a, grid, stream); launch_phase<3>(a, grid, stream); launch_phase<4>(a, grid, stream);
        launch_phase<5>(a, grid, stream); launch_phase<6>(a, grid, stream); launch_phase<7>(a, grid, stream); launch_phase<8>(a, grid, stream); launch_phase<9>(a, grid, stream); launch_phase<10>(a, grid, stream); launch_phase<11>(a, grid, stream);
    }
#endif
}
```

```cpp
#include <hip/hip_runtime.h>
#include <cstdio>
#include <cstdint>

#ifndef DIAG
#define DIAG 0
#endif
#ifndef DIAG_LO
#define DIAG_LO 0
#endif
#ifndef DIAG_HI
#define DIAG_HI 64
#endif
#ifndef DIAG_MOD
#define DIAG_MOD 64
#endif
#ifndef TOPK_NAIVE
#define TOPK_NAIVE 0
#endif
#ifndef MIX_NAIVE
#define MIX_NAIVE 0
#endif
#ifndef DIAG_N0
#define DIAG_N0 4096
#endif
#ifndef FOX_NAIVE
#define FOX_NAIVE 0
#endif
#ifndef HG_NAIVE_L
#define HG_NAIVE_L 99
#endif
#ifndef DIAG_LAYER
#define DIAG_LAYER 0
#endif
#ifndef MK_ONE_LAUNCH
#define MK_ONE_LAUNCH 1
#endif

#define LAS __attribute__((address_space(3)))
#define GAS __attribute__((address_space(1)))
typedef unsigned short bf16_t;
typedef short bf16x8 __attribute__((ext_vector_type(8)));
typedef float f32x4 __attribute__((ext_vector_type(4)));
typedef float f32x2 __attribute__((ext_vector_type(2)));
typedef unsigned u32x4 __attribute__((ext_vector_type(4)));
typedef unsigned u32x2 __attribute__((ext_vector_type(2)));

constexpr int DM = 1024, BATCH = 2, SEQ = 8192, DEPTH = 2, T = BATCH * SEQ;
constexpr int BW = 512, NIN = 5124, NH = 5120, NG = 4096, NBR = 2048, NQ = 2048;
constexpr int NEXP = 16384, TOPK = 16, PH = 8;
constexpr float ALPHA = 1.4142135623730951f;
constexpr float LN_EPS = 1e-5f, RMS_EPS = 1e-6f;
constexpr int HC_P = 0, HC_HQ = 512, HC_HF = 1024, HC_HI = 1536, HC_HG = 2048, HC_GU = 2560, HC_GV = 3072, HC_FQ = 3584, HC_FK = 4096, HC_FV = 4608;

constexpr size_t MiB = 1u << 20;
constexpr size_t WS_CTL = 0, CTL_ZERO_BYTES = 160 * 1024;
constexpr size_t WS_CMAX = 64 * 1024;
constexpr size_t WS_MISC = 512 * 1024;
constexpr size_t WS_CUM = 768 * 1024;
constexpr size_t WS_W = 1 * MiB;
constexpr size_t W_LAYER = 30 * MiB;
constexpr size_t WO_WIN = 0, WO_WG = 10 * MiB, WO_WBR = 18 * MiB, WO_WOUT = 22 * MiB, WO_WQ = 24 * MiB, WO_KEYS = 28 * MiB, WO_WF = 28 * MiB + 512 * 1024, WO_POOLW = 28 * MiB + 768 * 1024, WO_GWS = 29 * MiB, WO_CS = 29 * MiB + 512 * 1024;
constexpr size_t WS_TABU = 64 * MiB, WS_TABV = 96 * MiB;
constexpr size_t WS_XA = 128 * MiB;
constexpr size_t WS_XB = 192 * MiB;
constexpr size_t WS_X1B = 224 * MiB;
constexpr size_t WS_H = 256 * MiB;
constexpr size_t WS_ST = 416 * MiB;
constexpr size_t WS_BR = 448 * MiB;
constexpr size_t WS_G = 256 * MiB;
constexpr size_t WS_MGF = 384 * MiB;
constexpr size_t WS_XC = 256 * MiB;
constexpr size_t WS_Q = 320 * MiB;
constexpr size_t WS_EIDX = 384 * MiB, WS_EGATE = 392 * MiB;
constexpr size_t WS_XSA = 256 * 1024;
constexpr size_t WS_END = 512 * MiB;

__device__ __forceinline__ float bf2f(unsigned u) { return __builtin_bit_cast(float, u << 16); }
__device__ __forceinline__ unsigned f2bf(float f) { unsigned u = __builtin_bit_cast(unsigned, f); return (u + 0x7fffu + ((u >> 16) & 1u)) >> 16; }
typedef __bf16 bf16x2_t __attribute__((ext_vector_type(2)));
__device__ __forceinline__ unsigned cvtpk(float lo, float hi) { f32x2 v = {lo, hi}; bf16x2_t b = __builtin_convertvector(v, bf16x2_t); return __builtin_bit_cast(unsigned, b); }
__device__ __forceinline__ unsigned pk2(float lo, float hi) { return cvtpk(lo, hi); }
__device__ __forceinline__ float wave_sum(float v) {
#pragma unroll
    for (int o = 32; o > 0; o >>= 1) v += __shfl_xor(v, o, 64);
    return v;
}
__device__ __forceinline__ float sigmoidf_(float x) { return __builtin_amdgcn_rcpf(1.f + __builtin_amdgcn_exp2f(-1.4426950408889634f * x)); }
__device__ __forceinline__ float siluf_(float x) { return x * __builtin_amdgcn_rcpf(1.f + __builtin_amdgcn_exp2f(-1.4426950408889634f * x)); }
__device__ __forceinline__ float geluf_slow(float x) { const float u = 0.7978845608028654f * (x + 0.044715f * x * x * x); return 0.5f * x * (1.f + tanhf(u)); }
__device__ __forceinline__ float geluf_(float x) { const float u2 = -2.302208198f * (x + 0.044715f * x * x * x); return x * __builtin_amdgcn_rcpf(1.f + __builtin_amdgcn_exp2f(u2)); }
__device__ __forceinline__ float logsigmoidf_(float z) { return fminf(z, 0.f) - log1pf(__expf(-fabsf(z))); }

__device__ __forceinline__ unsigned launder_u(unsigned x) { asm volatile("" : "+v"(x)); return __builtin_amdgcn_readfirstlane(x); }
template <class P> __device__ __forceinline__ P launder_ptr(P p) {
    const unsigned lo = launder_u((unsigned)(uintptr_t)p), hi = launder_u((unsigned)((uintptr_t)p >> 32));
    return (P)(((uintptr_t)hi << 32) | lo);
}

namespace pg8 {
constexpr int BM = 256, BK = 64, HALF = 128, HTB = HALF * BK * 2, STAGE_BYTES = 8 * HTB, NXCD = 8, WGM = 8;
__host__ __device__ __forceinline__ int lds_byte(int r, int c) { const int st = (r >> 4) * 2 + (c >> 5), rr = r & 15, cc = c & 31, ob = rr * 64 + cc * 2; return st * 1024 + (ob ^ (((ob >> 9) & 1) << 5)); }
__host__ __device__ __forceinline__ void stage_rc(int b, int& R, int& C) { const int st = b / 1024, sb = b % 1024, swz = sb ^ (((sb >> 9) & 1) << 5); R = (st >> 1) * 16 + swz / 64; C = (st & 1) * 32 + (swz % 64) / 2; }
__host__ __device__ __forceinline__ int perm32(int rho) { const int n = rho >> 4, i = rho & 15; return 8 * (i >> 2) + 4 * n + (i & 3); }

struct Unit { int pm, pn, z; };
struct Gemm { const bf16_t* A; const bf16_t* Bt; int lda, ldb, K; size_t zA, zB; };

struct StaticOrder {
    int nM, nN, nwg, G, c;
    __device__ void init(int M, int N, int G_, int c_) { nM = M / BM; nN = N / BM; nwg = nM * nN; G = G_; c = c_; }
    __device__ bool next(int i, Unit& u) const {
        const long L = (long)i * G + c; if (L >= nwg) return false;
        int wgid = (int)L; { const int q = nwg / NXCD, r = nwg % NXCD, xcd = wgid % NXCD, off = wgid / NXCD; wgid = (xcd < r ? xcd * (q + 1) : r * (q + 1) + (xcd - r) * q) + off; }
        const int nig = WGM * nN, gid = wgid / nig, fm = gid * WGM, gsz = (nM - fm) < WGM ? (nM - fm) : WGM;
        u.pm = fm + ((wgid % nig) % gsz); u.pn = (wgid % nig) / gsz; u.z = 0; return true;
    }
};
struct ZOrder {
    int nM, nN, nZ, ntile, G, c;
    __device__ void init(int M, int N, int Z, int G_, int c_) { nM = M / BM; nN = N / BM; nZ = Z; ntile = nM * nN; G = G_; c = c_; }
    __device__ bool next(int i, Unit& u) const {
        const long L = (long)(i / nZ) * G + c; if (L >= ntile) return false;
        u.pm = (int)L / nN; u.pn = (int)L % nN; u.z = i % nZ; return true;
    }
};

template <class F> struct Epi8 {
    static constexpr bool PERM = true;
    F f;
    __device__ __forceinline__ void operator()(const f32x4 (&acc)[2][2][4][2], const Unit& u, int wr, int wc, int fr, int fq) const {
        const int row0 = u.pm * BM + wr * 64 + fr, col0 = u.pn * BM + wc * 32 + 8 * fq;
#pragma unroll
        for (int ai = 0; ai < 2; ++ai)
#pragma unroll
            for (int m = 0; m < 4; ++m)
#pragma unroll
                for (int bj = 0; bj < 2; ++bj) f(row0 + ai * HALF + m * 16, col0 + bj * HALF, acc[ai][bj][m][0], acc[ai][bj][m][1], u.z);
    }
};
template <class F> struct Epi4 {
    static constexpr bool PERM = false;
    F f;
    __device__ __forceinline__ void operator()(const f32x4 (&acc)[2][2][4][2], const Unit& u, int wr, int wc, int fr, int fq) const {
        const int row0 = u.pm * BM + wr * 64 + fr, col0 = u.pn * BM + wc * 32 + 4 * fq;
#pragma unroll
        for (int ai = 0; ai < 2; ++ai)
#pragma unroll
            for (int m = 0; m < 4; ++m)
#pragma unroll
                for (int bj = 0; bj < 2; ++bj)
#pragma unroll
                    for (int n = 0; n < 2; ++n) f(row0 + ai * HALF + m * 16, col0 + bj * HALF + n * 16, acc[ai][bj][m][n], u.z);
    }
};

typedef int i32x4 __attribute__((ext_vector_type(4)));
template <class Epi, class Sched, bool I8 = false, bool ALIGN_EPI = true>
__device__ __forceinline__ void gemm_phase(LAS unsigned char* lds, const Gemm g, const Sched& S, const Epi& E, const int tid) {
    constexpr int ES = I8 ? 1 : 2;
    const int wid = __builtin_amdgcn_readfirstlane(tid >> 6), lane = tid & 63, wr = wid >> 2, wc = wid & 3, fr = lane & 15, fq = lane >> 4;
    const int K = g.K, nt = K * ES / 128;
    unsigned voffA[2], voffB[2];
#pragma unroll
    for (int i = 0; i < 2; ++i) { int R, C; stage_rc(tid * 16 + i * 8192, R, C); const int Rb = Epi::PERM ? ((R & ~31) + perm32(R & 31)) : R;
        voffA[i] = (unsigned)(R * g.lda * ES + C * 2); voffB[i] = (unsigned)(Rb * g.ldb * ES + C * 2); }
    const size_t kstep = (size_t)(BK * 2);
    const size_t hstepA = (size_t)HALF * g.lda * ES, hstepB = (size_t)HALF * g.ldb * ES;
    const size_t tstepA = 2 * hstepA, tstepB = 2 * hstepB;
    const unsigned ldsw = (unsigned)wid * 1024u;
    const int aoff = lds_byte(wr * 64 + fr, fq * 8), boff = lds_byte(wc * 32 + fr, fq * 8);
#define PG8_SA(b, h) (((b) * 2 + (h)) * HTB)
#define PG8_SB(b, h) ((4 + (b) * 2 + (h)) * HTB)
#define PG8_STAGE(bufoff, gbase, voff) do { _Pragma("unroll") for (int _i = 0; _i < 2; ++_i) \
        __builtin_amdgcn_global_load_lds((const unsigned*)((const char*)(gbase) + (voff)[_i]), (LAS unsigned*)(lds + (bufoff) + ldsw + _i * 8192), 16, 0, 0); } while (0)
#define PG8_LDA(dst, b, h) do { _Pragma("unroll") for (int m = 0; m < 4; ++m) _Pragma("unroll") for (int k = 0; k < 2; ++k) dst[m][k] = *(const LAS bf16x8*)(lds + PG8_SA(b, h) + aoff + m * 2048 + k * 1024); } while (0)
#define PG8_LDB(dst, b, h) do { _Pragma("unroll") for (int n = 0; n < 2; ++n) _Pragma("unroll") for (int k = 0; k < 2; ++k) dst[n][k] = *(const LAS bf16x8*)(lds + PG8_SB(b, h) + boff + n * 2048 + k * 1024); } while (0)
#define PG8_MMA(ai, bj, At, Bt) do { __builtin_amdgcn_s_setprio(1); _Pragma("unroll") for (int m = 0; m < 4; ++m) _Pragma("unroll") for (int n = 0; n < 2; ++n) _Pragma("unroll") for (int k = 0; k < 2; ++k) { \
        if constexpr (I8) acc[ai][bj][m][n] = __builtin_bit_cast(f32x4, __builtin_amdgcn_mfma_i32_16x16x64_i8(__builtin_bit_cast(i32x4, Bt[n][k]), __builtin_bit_cast(i32x4, At[m][k]), __builtin_bit_cast(i32x4, acc[ai][bj][m][n]), 0, 0, 0)); \
        else acc[ai][bj][m][n] = __builtin_amdgcn_mfma_f32_16x16x32_bf16(Bt[n][k], At[m][k], acc[ai][bj][m][n], 0, 0, 0); } __builtin_amdgcn_s_setprio(0); } while (0)
#define PG8_WAIT_V(n) asm volatile("s_waitcnt vmcnt(" #n ")" ::: "memory")
#define PG8_WAIT_L(n) asm volatile("s_waitcnt lgkmcnt(" #n ")" ::: "memory")
#define PG8_BAR __builtin_amdgcn_s_barrier()
#define PG8_SCHED __builtin_amdgcn_sched_barrier(0)
    Unit cur, nxt; int ui = 0;
    if (!S.next(0, cur)) return;
    f32x4 acc[2][2][4][2];
#pragma unroll
    for (int a = 0; a < 2; ++a)
#pragma unroll
        for (int b = 0; b < 2; ++b)
#pragma unroll
            for (int m = 0; m < 4; ++m)
#pragma unroll
                for (int n = 0; n < 2; ++n) acc[a][b][m][n] = (f32x4){0.f, 0.f, 0.f, 0.f};
    bf16x8 At[4][2], B0[2][2], B1[2][2];
    const char* cA = (const char*)g.A + (size_t)cur.z * g.zA * ES + (size_t)cur.pm * tstepA; const char* cB = (const char*)g.Bt + (size_t)cur.z * g.zB * ES + (size_t)cur.pn * tstepB;
    PG8_STAGE(PG8_SB(0, 0), cB, voffB); PG8_STAGE(PG8_SB(0, 1), cB + hstepB, voffB); PG8_STAGE(PG8_SA(0, 0), cA, voffA); PG8_STAGE(PG8_SA(0, 1), cA + hstepA, voffA);
    if (wr == 1) PG8_BAR;
    PG8_WAIT_V(2); PG8_BAR;
    PG8_STAGE(PG8_SB(1, 0), cB + kstep, voffB); PG8_STAGE(PG8_SA(1, 0), cA + kstep, voffA); PG8_STAGE(PG8_SB(1, 1), cB + hstepB + kstep, voffB);
    PG8_WAIT_V(6); PG8_BAR;
    for (;;) {
        const bool has_next = S.next(ui + 1, nxt);
        const char* nA = has_next ? (const char*)g.A + (size_t)nxt.z * g.zA * ES + (size_t)nxt.pm * tstepA : cA;
        const char* nB = has_next ? (const char*)g.Bt + (size_t)nxt.z * g.zB * ES + (size_t)nxt.pn * tstepB : cB;
        for (int t = 0; t < nt; t += 2) {
            const bool last = (t == nt - 2);
            const char* a1 = cA + (size_t)(t + 1) * kstep;
            const char* a2 = last ? nA : cA + (size_t)(t + 2) * kstep; const char* b2 = last ? nB : cB + (size_t)(t + 2) * kstep;
            const char* a3 = a2 + kstep; const char* b3 = b2 + kstep;
            PG8_LDB(B0, 0, 0); PG8_LDB(B1, 0, 1); PG8_SCHED; PG8_LDA(At, 0, 0); PG8_STAGE(PG8_SA(1, 1), a1 + hstepA, voffA);
            PG8_WAIT_V(8); PG8_WAIT_L(0); PG8_BAR; PG8_MMA(0, 0, At, B0); PG8_MMA(0, 1, At, B1); PG8_BAR; PG8_SCHED;
            PG8_LDA(At, 0, 1); PG8_STAGE(PG8_SB(0, 0), b2, voffB); PG8_STAGE(PG8_SB(0, 1), b2 + hstepB, voffB); PG8_STAGE(PG8_SA(0, 0), a2, voffA);
            PG8_WAIT_V(8); PG8_WAIT_L(0); PG8_BAR; PG8_MMA(1, 0, At, B0); PG8_MMA(1, 1, At, B1); PG8_BAR; PG8_SCHED;
            PG8_LDB(B0, 1, 0); PG8_LDB(B1, 1, 1); PG8_SCHED; PG8_LDA(At, 1, 0); PG8_STAGE(PG8_SA(0, 1), a2 + hstepA, voffA);
            PG8_WAIT_V(8); PG8_WAIT_L(0); PG8_BAR; PG8_MMA(0, 0, At, B0); PG8_MMA(0, 1, At, B1); PG8_BAR; PG8_SCHED;
            PG8_LDA(At, 1, 1); PG8_STAGE(PG8_SB(1, 0), b3, voffB); PG8_STAGE(PG8_SB(1, 1), b3 + hstepB, voffB); PG8_STAGE(PG8_SA(1, 0), a3, voffA);
            PG8_WAIT_V(8); PG8_WAIT_L(0); PG8_BAR; PG8_MMA(1, 0, At, B0); PG8_MMA(1, 1, At, B1); PG8_BAR; PG8_SCHED;
        }
        if constexpr (ALIGN_EPI) { if (wr == 0) PG8_BAR; }
        E(acc, cur, wr, wc, fr, fq);
        if (!has_next) break;
#pragma unroll
        for (int a = 0; a < 2; ++a)
#pragma unroll
            for (int b = 0; b < 2; ++b)
#pragma unroll
                for (int m = 0; m < 4; ++m)
#pragma unroll
                    for (int n = 0; n < 2; ++n) acc[a][b][m][n] = (f32x4){0.f, 0.f, 0.f, 0.f};
        cur = nxt; cA = nA; cB = nB; ++ui;
        if constexpr (ALIGN_EPI) { if (wr == 1) PG8_BAR; }
    }
    PG8_WAIT_V(0);
    if constexpr (!ALIGN_EPI) { if (wr == 0) PG8_BAR; }
    PG8_BAR;
#undef PG8_SA
#undef PG8_SB
#undef PG8_STAGE
#undef PG8_LDA
#undef PG8_LDB
#undef PG8_MMA
#undef PG8_WAIT_V
#undef PG8_WAIT_L
#undef PG8_BAR
#undef PG8_SCHED
}
}

#define XB_TMO      128
#define XB_XCNT(j)  (256  + 64 * (j))
#define XB_XSUB(j)  (1280 + 64 * (j))
#define XB_XGEN(j)  (2304 + 64 * (j))
#define XB_TOP      3328
#define XB_TOPGEN   3392
#define XCD_BAR_WORDS 3456
#define XB_SPIN_CAP (1u << 22)
__device__ __forceinline__ unsigned xb_ld(unsigned* p)              { return __hip_atomic_load(p, __ATOMIC_RELAXED, __HIP_MEMORY_SCOPE_AGENT); }
__device__ __forceinline__ unsigned xb_add(unsigned* p, unsigned v) { return __hip_atomic_fetch_add(p, v, __ATOMIC_RELAXED, __HIP_MEMORY_SCOPE_AGENT); }
__device__ __forceinline__ unsigned xb_xcc_id() { return (unsigned)__builtin_amdgcn_s_getreg((3 << 11) | 20) & 0xFu; }
#define XB_SPIN(cond, bar) do { unsigned _sp = 0; while (cond) { __builtin_amdgcn_s_sleep(1); \
    if ((++_sp & 255u) == 0u) { if (xb_ld(&(bar)[XB_TMO])) break; if (_sp > XB_SPIN_CAP) { atomicAdd(&(bar)[XB_TMO], 1u); break; } } } } while (0)
__device__ __forceinline__ void xcd_barrier_post(unsigned* bar) {
    if (threadIdx.x == 0) (void)xb_add(&bar[XB_XCNT(xb_xcc_id())], 1u);
}
__device__ __forceinline__ void xcd_barrier_complete(unsigned* bar, unsigned x, unsigned& nloc, unsigned& nx) {
    const unsigned G = gridDim.x * gridDim.y * gridDim.z;
    unsigned sum, cnt, mine, sp = 0u;
    for (;;) {
        sum = 0u; cnt = 0u; mine = 0u;
#pragma unroll
        for (unsigned j = 0; j < 16; ++j) { const unsigned c = xb_ld(&bar[XB_XCNT(j)]); sum += c; cnt += (c > 0u) ? 1u : 0u; mine = (j == x) ? c : mine; }
        if (sum == G) break;
        __builtin_amdgcn_s_sleep(1);
        if ((++sp & 255u) == 0u) { if (xb_ld(&bar[XB_TMO])) break; if (sp > XB_SPIN_CAP) { atomicAdd(&bar[XB_TMO], 1u); break; } }
    }
    nloc = mine > 0u ? mine : 1u; nx = cnt > 0u ? cnt : 1u;
}
__device__ __noinline__ void xcd_barrier_leader(unsigned* bar, volatile LAS unsigned* st) {
    const unsigned x = xb_xcc_id();
    __builtin_amdgcn_s_waitcnt(0);
    unsigned nloc = st[0], nx = st[1];
    if (nloc == 0u) { xcd_barrier_complete(bar, x, nloc, nx); st[0] = nloc; st[1] = nx; }
    const unsigned old = xb_add(&bar[XB_XSUB(x)], 1u);
    const unsigned gen = old / nloc;
    if (old + 1u == (gen + 1u) * nloc) {
        __builtin_amdgcn_fence(__ATOMIC_RELEASE, "agent");
        asm volatile("s_waitcnt vmcnt(0)" ::: "memory");
        const unsigned og = xb_add(&bar[XB_TOP], 1u);
        const unsigned tg = og / nx;
        if (og + 1u == (tg + 1u) * nx) xb_add(&bar[XB_TOPGEN], 1u);
        else XB_SPIN(xb_ld(&bar[XB_TOPGEN]) == tg, bar);
        __builtin_amdgcn_fence(__ATOMIC_ACQUIRE, "agent");
        xb_add(&bar[XB_XGEN(x)], 1u);
        asm volatile("s_waitcnt vmcnt(0)" ::: "memory");
    } else {
        XB_SPIN(xb_ld(&bar[XB_XGEN(x)]) == gen, bar);
        __builtin_amdgcn_fence(__ATOMIC_ACQUIRE, "agent");
        asm volatile("s_waitcnt vmcnt(0)" ::: "memory");
    }
}
__device__ __forceinline__ void xcd_barrier(unsigned* bar, volatile LAS unsigned* st) {
    asm volatile("s_waitcnt vmcnt(0)" ::: "memory");
    __syncthreads();
    if (threadIdx.x == 0) xcd_barrier_leader(bar, st);
    __syncthreads();
}

constexpr int NIN_PTRS = 23;
struct Args { const float* in[NIN_PTRS]; float* out; unsigned char* ws; int ph_lo, ph_hi, bar_slot, pad; };
enum { I_X = 0, I_WIN, I_BFOX, I_POOLW, I_POOLS, I_LBL, I_HNG, I_GLNG, I_GLNB, I_GWS, I_GBS, I_WGATE, I_BGATE, I_WBR, I_WOUT, I_LN1G, I_LN1B, I_WQ, I_KEYS, I_PU, I_PV, I_LN2G, I_LN2B };

constexpr int LDS_BYTES = 147456;
constexpr int LDSCTL_OFF = 143360;

struct Ctx {
    LAS unsigned char* lds;
    unsigned char* ws;
    const float* const* in;
    float* out;
    int tid, lane, wave, G, bid, vcu;
};

__device__ __forceinline__ void tconv_job(const Ctx& C, const float* src, int ld_src, int K, int N, bf16_t* dst) {
    LAS float* tile = (LAS float*)C.lds;
    const int nk = K / 64, nn = N / 64, ntiles = nk * nn;
    for (int tl = C.bid; tl < ntiles; tl += C.G) {
        const int k0 = (tl / nn) * 64, n0 = (tl % nn) * 64;
#pragma unroll
        for (int p = 0; p < 2; ++p) {
            const int kr = (C.tid >> 4) + p * 32, nc = (C.tid & 15) * 4;
            const f32x4 v = *(const f32x4*)(src + (size_t)(k0 + kr) * ld_src + n0 + nc);
            tile[kr * 65 + nc + 0] = v[0]; tile[kr * 65 + nc + 1] = v[1]; tile[kr * 65 + nc + 2] = v[2]; tile[kr * 65 + nc + 3] = v[3];
        }
        __syncthreads();
        {
            const int n = C.tid >> 3, k8 = (C.tid & 7) * 8;
            u32x4 o;
#pragma unroll
            for (int j = 0; j < 4; ++j) o[j] = pk2(tile[(k8 + 2 * j) * 65 + n], tile[(k8 + 2 * j + 1) * 65 + n]);
            *(u32x4*)(dst + (size_t)(n0 + n) * K + k0 + k8) = o;
        }
        __syncthreads();
    }
}
__device__ __forceinline__ void colmax_job(const Ctx& C, const float* src, int ld_src, int K, int N, unsigned* cmax) {
    LAS float* red = (LAS float*)C.lds;
    const int nk = K / 64, nn = N / 64, ntiles = nk * nn;
    for (int tl = C.bid; tl < ntiles; tl += C.G) {
        const int k0 = (tl / nn) * 64, n0 = (tl % nn) * 64;
        float mx[4] = {0.f, 0.f, 0.f, 0.f};
#pragma unroll
        for (int p = 0; p < 2; ++p) { const int kr = (C.tid >> 4) + p * 32, nc = (C.tid & 15) * 4;
            const f32x4 v = *(const f32x4*)(src + (size_t)(k0 + kr) * ld_src + n0 + nc);
#pragma unroll
            for (int e = 0; e < 4; ++e) mx[e] = fmaxf(mx[e], fabsf(v[e])); }
#pragma unroll
        for (int e = 0; e < 4; ++e) red[(C.tid >> 4) * 64 + (C.tid & 15) * 4 + e] = mx[e];
        __syncthreads();
        if (C.tid < 64) { float m = 0.f; for (int r = 0; r < 32; ++r) m = fmaxf(m, red[r * 64 + C.tid]); atomicMax(cmax + n0 + C.tid, __builtin_bit_cast(unsigned, m)); }
        __syncthreads();
    }
}
__device__ __forceinline__ void tconv_i8_job(const Ctx& C, const float* src, int ld_src, int K, int N, unsigned char* dst, const unsigned* cmax) {
    LAS float* tile = (LAS float*)C.lds;
    const int nks = K / 256, nn = N / 64, nunits = nks * nn;
    for (int un = C.bid; un < nunits; un += C.G) {
        const int k0 = (un / nn) * 256, n0 = (un % nn) * 64;
        const int kr = C.tid >> 4, nc = (C.tid & 15) * 4;
        f32x4 v[8];
#pragma unroll
        for (int p = 0; p < 8; ++p) v[p] = *(const f32x4*)(src + (size_t)(k0 + kr + 32 * p) * ld_src + n0 + nc);
        float isc[4];
#pragma unroll
        for (int e = 0; e < 4; ++e) isc[e] = 127.f / fmaxf(__builtin_bit_cast(float, __hip_atomic_load(cmax + n0 + nc + e, __ATOMIC_RELAXED, __HIP_MEMORY_SCOPE_AGENT)), 1e-30f);
#pragma unroll
        for (int p = 0; p < 8; ++p)
#pragma unroll
            for (int e = 0; e < 4; ++e) tile[(kr + 32 * p) * 65 + nc + e] = v[p][e] * isc[e];
        __syncthreads();
        { const int n = C.tid >> 3, kb = (C.tid & 7) * 32;
          u32x4 o0, o1;
#pragma unroll
          for (int j = 0; j < 8; ++j) { unsigned wd = 0u;
#pragma unroll
              for (int e = 0; e < 4; ++e) wd |= ((unsigned)(int)rintf(tile[(kb + 4 * j + e) * 65 + n]) & 255u) << (8 * e);
              if (j < 4) o0[j] = wd; else o1[j - 4] = wd; }
          unsigned char* dp = dst + (size_t)(n0 + n) * K + k0 + kb;
          *(u32x4*)dp = o0; *(u32x4*)(dp + 16) = o1; }
        __syncthreads();
    }
}
__device__ __forceinline__ void cvt_copy(const Ctx& C, const float* src, bf16_t* dst, size_t n) {
    const size_t n8 = n / 8;
    for (size_t i = (size_t)C.bid * 512 + C.tid; i < n8; i += (size_t)C.G * 512) {
        const f32x4 a = *(const f32x4*)(src + i * 8), b = *(const f32x4*)(src + i * 8 + 4);
        u32x4 o; o[0] = pk2(a[0], a[1]); o[1] = pk2(a[2], a[3]); o[2] = pk2(b[0], b[1]); o[3] = pk2(b[2], b[3]);
        *(u32x4*)(dst + i * 8) = o;
    }
}
__device__ __forceinline__ void p_conv_weights(const Ctx& C) {
    for (int l = 0; l < DEPTH; ++l) {
        unsigned char* wb = C.ws + WS_W + (size_t)l * W_LAYER;
        colmax_job(C, C.in[I_WIN] + (size_t)l * DM * NIN, NIN, DM, NH, (unsigned*)(C.ws + WS_CMAX) + l * (NH + NG));
        colmax_job(C, C.in[I_WGATE] + (size_t)l * DM * NG, NG, DM, NG, (unsigned*)(C.ws + WS_CMAX) + l * (NH + NG) + NH);
        for (int m = 0; m < 4; ++m)
            tconv_job(C, C.in[I_WBR] + ((size_t)l * 4 + m) * BW * DM, DM, BW, DM, (bf16_t*)(wb + WO_WBR) + (size_t)m * DM * BW);
        tconv_job(C, C.in[I_WOUT] + (size_t)l * DM * DM, DM, DM, DM, (bf16_t*)(wb + WO_WOUT));
        tconv_job(C, C.in[I_WQ] + (size_t)l * DM * NQ, NQ, DM, NQ, (bf16_t*)(wb + WO_WQ));
        cvt_copy(C, C.in[I_KEYS] + (size_t)l * 2 * PH * 128 * 128, (bf16_t*)(wb + WO_KEYS), (size_t)2 * PH * 128 * 128);
        for (int g = 0; g < 4; ++g)
            tconv_job(C, C.in[I_POOLW] + ((size_t)l * 4 + g) * 128 * 128, 128, 128, 128, (bf16_t*)(wb + WO_POOLW) + (size_t)g * 128 * 128);
        {
            bf16_t* gw = (bf16_t*)(wb + WO_GWS); const float* src = C.in[I_GWS] + (size_t)l * 4 * 128 * 128;
            for (int i = C.bid * 512 + C.tid; i < 4 * 128 * 128; i += C.G * 512) { const int t = (i >> 7) & 127, sx = i & 127; gw[i] = (bf16_t)f2bf(sx <= t ? src[i] : 0.f); }
        }
        float* wf = (float*)(wb + WO_WF);
        for (int i = C.bid * 512 + C.tid; i < 4 * DM; i += C.G * 512) { const int h = i / DM, k = i % DM; wf[i] = C.in[I_WIN][(size_t)l * DM * NIN + (size_t)k * NIN + NH + h]; }
    }
}
constexpr size_t WS_U8 = WS_TABU, WS_V8 = WS_TABU + 16 * MiB, WS_SU = WS_TABU + 32 * MiB, WS_SV = WS_SU + 64 * 1024;
__device__ __forceinline__ float wave_max(float v) {
#pragma unroll
    for (int o = 32; o > 0; o >>= 1) v = fmaxf(v, __shfl_xor(v, o, 64));
    return v;
}
template <bool SIGNED> __device__ __forceinline__ void quant_rows(const Ctx& C, const float* src, unsigned char* dst, float* scl) {
    for (int row = C.bid * 8 + C.wave; row < NEXP; row += C.G * 8) {
        const float* p = src + (size_t)row * DM + C.lane * 16;
        f32x4 v[4]; float mx = 0.f;
#pragma unroll
        for (int i = 0; i < 4; ++i) { v[i] = *(const f32x4*)(p + 4 * i);
#pragma unroll
            for (int e = 0; e < 4; ++e) mx = fmaxf(mx, fabsf(v[i][e])); }
        mx = fmaxf(wave_max(mx), 1e-30f);
        const float sc = mx * (1.f / 127.f), isc = 127.f / mx;
        u32x4 o;
#pragma unroll
        for (int i = 0; i < 4; ++i) { unsigned wd = 0u;
#pragma unroll
            for (int e = 0; e < 4; ++e) { const int q = (int)rintf(v[i][e] * isc) + (SIGNED ? 0 : 128); wd |= ((unsigned)q & 255u) << (8 * e); }
            o[i] = wd; }
        *(u32x4*)(dst + (size_t)row * DM + C.lane * 16) = o;
        if (C.lane == 0) scl[row] = sc;
    }
}
__device__ __forceinline__ void p_conv_tables(const Ctx& C, int l) {
    quant_rows<true>(C, C.in[I_PU] + (size_t)l * NEXP * DM, C.ws + WS_U8, (float*)(C.ws + WS_SU));
    quant_rows<false>(C, C.in[I_PV] + (size_t)l * NEXP * DM, C.ws + WS_V8, (float*)(C.ws + WS_SV));
}

__device__ __forceinline__ void row_emit(const Ctx& C, int row, const float (&v)[16], int l, bool want_lsig) {
    {
        float mx = 0.f;
#pragma unroll
        for (int j = 0; j < 16; ++j) mx = fmaxf(mx, fabsf(v[j]));
#pragma unroll
        for (int o = 32; o > 0; o >>= 1) mx = fmaxf(mx, __shfl_xor(mx, o, 64));
        mx = fmaxf(mx, 1e-30f);
        const float isc = 127.f / mx;
        unsigned char* xb = C.ws + WS_XB + (size_t)row * DM;
        u32x2 o0, o1;
#pragma unroll
        for (int hw = 0; hw < 2; ++hw) { unsigned a = 0u, b = 0u;
#pragma unroll
            for (int e = 0; e < 4; ++e) { a |= ((unsigned)(int)rintf(v[4 * hw + e] * isc) & 255u) << (8 * e); b |= ((unsigned)(int)rintf(v[8 + 4 * hw + e] * isc) & 255u) << (8 * e); }
            o0[hw] = a; o1[hw] = b; }
        *(u32x2*)(xb + C.lane * 8) = o0; *(u32x2*)(xb + 512 + C.lane * 8) = o1;
        if (C.lane == 0) ((float*)(C.ws + WS_XSA))[row] = mx * (1.f / 127.f);
    }
    if (want_lsig) {
        const float* wf = (const float*)(C.ws + WS_W + (size_t)l * W_LAYER + WO_WF);
        float* lsig = (float*)(C.ws + WS_MISC);
#pragma unroll
        for (int h = 0; h < 4; ++h) {
            const f32x4 a0 = *(const f32x4*)(wf + h * DM + C.lane * 8), a1 = *(const f32x4*)(wf + h * DM + C.lane * 8 + 4);
            const f32x4 b0 = *(const f32x4*)(wf + h * DM + 512 + C.lane * 8), b1 = *(const f32x4*)(wf + h * DM + 512 + C.lane * 8 + 4);
            float s = 0.f;
#pragma unroll
            for (int j = 0; j < 4; ++j) s += v[j] * a0[j] + v[4 + j] * a1[j] + v[8 + j] * b0[j] + v[12 + j] * b1[j];
            s = wave_sum(s);
            if (C.lane == 0) lsig[(size_t)row * 4 + h] = logsigmoidf_(s + C.in[I_BFOX][l * 4 + h]);
        }
    }
}
__device__ __forceinline__ void load_row16(const float* p, int lane, float (&v)[16]) {
    const f32x4 a0 = *(const f32x4*)(p + lane * 8), a1 = *(const f32x4*)(p + lane * 8 + 4), b0 = *(const f32x4*)(p + 512 + lane * 8), b1 = *(const f32x4*)(p + 512 + lane * 8 + 4);
#pragma unroll
    for (int j = 0; j < 4; ++j) { v[j] = a0[j]; v[4 + j] = a1[j]; v[8 + j] = b0[j]; v[12 + j] = b1[j]; }
}
__device__ __forceinline__ void store_row16(float* p, int lane, const float (&v)[16]) {
    *(f32x4*)(p + lane * 8) = (f32x4){v[0], v[1], v[2], v[3]}; *(f32x4*)(p + lane * 8 + 4) = (f32x4){v[4], v[5], v[6], v[7]};
    *(f32x4*)(p + 512 + lane * 8) = (f32x4){v[8], v[9], v[10], v[11]}; *(f32x4*)(p + 512 + lane * 8 + 4) = (f32x4){v[12], v[13], v[14], v[15]};
}
__device__ __forceinline__ void ln_row16(float (&v)[16], const float* g, const float* b, int lane) {
    float s = 0.f;
#pragma unroll
    for (int j = 0; j < 16; ++j) s += v[j];
    const float mean = wave_sum(s) * (1.f / DM);
    float q = 0.f;
#pragma unroll
    for (int j = 0; j < 16; ++j) { const float d = v[j] - mean; q += d * d; }
    const float rstd = rsqrtf(wave_sum(q) * (1.f / DM) + LN_EPS);
    float gg[16], bb[16];
    load_row16(g, lane, gg); load_row16(b, lane, bb);
#pragma unroll
    for (int j = 0; j < 16; ++j) v[j] = (v[j] - mean) * rstd * gg[j] + bb[j];
}
__device__ __forceinline__ void p_rowpass0(const Ctx& C) {
    for (int row = C.bid * 8 + C.wave; row < T; row += C.G * 8) {
        float v[16]; load_row16(C.in[I_X] + (size_t)row * DM, C.lane, v);
        row_emit(C, row, v, 0, true);
    }
}
__device__ __forceinline__ void p_cumsum(const Ctx& C) {
    if (C.bid >= BATCH * 4) return;
    const float* lsig = (const float*)(C.ws + WS_MISC);
    float* cum = (float*)(C.ws + WS_CUM);
    LAS float* wt = (LAS float*)C.lds;
    const int b = C.bid >> 2, h = C.bid & 3;
    float v[16];
#pragma unroll
    for (int j = 0; j < 16; ++j) v[j] = lsig[((size_t)b * SEQ + C.tid * 16 + j) * 4 + h];
#pragma unroll
    for (int j = 1; j < 16; ++j) v[j] += v[j - 1];
    float inc = v[15];
#pragma unroll
    for (int o = 1; o < 64; o <<= 1) { const float t = __shfl_up(inc, o, 64); if (C.lane >= o) inc += t; }
    if (C.lane == 63) wt[C.wave] = inc;
    __syncthreads();
    float off = inc - v[15];
    for (int w2 = 0; w2 < C.wave; ++w2) off += wt[w2];
    float* cp = cum + ((size_t)b * 4 + h) * SEQ + C.tid * 16;
#pragma unroll
    for (int j4 = 0; j4 < 4; ++j4) *(f32x4*)(cp + 4 * j4) = (f32x4){v[4 * j4] + off, v[4 * j4 + 1] + off, v[4 * j4 + 2] + off, v[4 * j4 + 3] + off};
    __syncthreads();
}
__device__ __forceinline__ void load_row16_bf(const bf16_t* p, int lane, float (&v)[16]) {
    const u32x4 a = *(const u32x4*)(p + lane * 8), b = *(const u32x4*)(p + 512 + lane * 8);
#pragma unroll
    for (int j = 0; j < 4; ++j) { v[2 * j] = bf2f(a[j] & 0xffffu); v[2 * j + 1] = bf2f(a[j] >> 16); v[8 + 2 * j] = bf2f(b[j] & 0xffffu); v[9 + 2 * j] = bf2f(b[j] >> 16); }
}
__device__ __forceinline__ void p_ln1(const Ctx& C, int l) {
    const bf16_t* y1 = (const bf16_t*)(C.ws + WS_XC); bf16_t* x1b = (bf16_t*)(C.ws + WS_X1B);
    for (int row = C.bid * 8 + C.wave; row < T; row += C.G * 8) {
        float v[16]; load_row16_bf(y1 + (size_t)row * DM, C.lane, v);
        ln_row16(v, C.in[I_LN1G] + l * DM, C.in[I_LN1B] + l * DM, C.lane);
        u32x4 o0, o1;
#pragma unroll
        for (int j = 0; j < 4; ++j) { o0[j] = pk2(v[2 * j], v[2 * j + 1]); o1[j] = pk2(v[8 + 2 * j], v[8 + 2 * j + 1]); }
        *(u32x4*)(x1b + (size_t)row * DM + C.lane * 8) = o0; *(u32x4*)(x1b + (size_t)row * DM + 512 + C.lane * 8) = o1;
    }
}

__device__ __forceinline__ void mix_pool_naive(const Ctx& C, int l) {
    const bf16_t* H = (const bf16_t*)(C.ws + WS_H); bf16_t* BR = (bf16_t*)(C.ws + WS_BR);
    LAS float* dd = (LAS float*)C.lds;
    for (int u = C.bid; u < (T / 64) * 4; u += C.G) {
        const int g = u & 3, t0 = (u >> 2) * 64, w = 2 << g;
        for (int idx = C.tid; idx < 64 * 128; idx += 512) {
            const int r = idx >> 7, c = idx & 127, row = t0 + r, pos = row & (SEQ - 1);
            const int nwin = (pos + 1 < w) ? pos + 1 : w;
            float s = 0.f;
            for (int j = 0; j < nwin; ++j) s += bf2f(H[(size_t)(row - j) * NH + HC_P + g * 128 + c]);
            dd[idx] = s / (float)nwin - bf2f(H[(size_t)row * NH + HC_P + g * 128 + c]);
        }
        __syncthreads();
        const int dcol = C.tid & 127, rq = C.tid >> 7;
        float acc[16];
#pragma unroll
        for (int i = 0; i < 16; ++i) acc[i] = 0.f;
        const float* pw = C.in[I_POOLW] + ((size_t)l * 4 + g) * 128 * 128;
        for (int c = 0; c < 128; ++c) {
            const float wv = pw[c * 128 + dcol];
#pragma unroll
            for (int i = 0; i < 16; ++i) acc[i] += dd[(rq * 16 + i) * 128 + c] * wv;
        }
        const float sc = C.in[I_POOLS][l * BW + g * 128 + dcol];
#pragma unroll
        for (int i = 0; i < 16; ++i) BR[(size_t)(t0 + rq * 16 + i) * NBR + 0 + g * 128 + dcol] = (bf16_t)f2bf(acc[i] * sc);
        __syncthreads();
    }
}
__device__ __forceinline__ void mix_gmlp_naive(const Ctx& C, int l) {
    const bf16_t* H = (const bf16_t*)(C.ws + WS_H); bf16_t* BR = (bf16_t*)(C.ws + WS_BR);
    LAS float* vn = (LAS float*)C.lds;
    for (int u = C.bid; u < (T / 128) * 4; u += C.G) {
        const int g = u & 3, t0 = (u >> 2) * 128;
        for (int i = 0; i < 16; ++i) {
            const int r = C.wave * 16 + i, row = t0 + r;
            const u32x4 raw = *(const u32x4*)(H + (size_t)row * NH + HC_GV + C.lane * 8);
            float e[8];
#pragma unroll
            for (int j = 0; j < 4; ++j) { e[2 * j] = geluf_(bf2f(raw[j] & 0xffffu)); e[2 * j + 1] = geluf_(bf2f(raw[j] >> 16)); }
            float s = 0.f;
#pragma unroll
            for (int j = 0; j < 8; ++j) s += e[j];
            const float mean = wave_sum(s) * (1.f / BW);
            float q = 0.f;
#pragma unroll
            for (int j = 0; j < 8; ++j) { const float d = e[j] - mean; q += d * d; }
            const float rstd = rsqrtf(wave_sum(q) * (1.f / BW) + LN_EPS);
            if ((C.lane >> 4) == g) {
#pragma unroll
                for (int j = 0; j < 8; ++j) { const int col = C.lane * 8 + j;
                    vn[r * 128 + (col - g * 128)] = (e[j] - mean) * rstd * C.in[I_GLNG][l * BW + col] + C.in[I_GLNB][l * BW + col]; }
            }
        }
        __syncthreads();
        const int c = C.tid & 127, tq = C.tid >> 7;
        const float* wsg = C.in[I_GWS] + ((size_t)l * 4 + g) * 128 * 128;
        for (int t = tq; t < 128; t += 4) {
            float acc = 0.f;
            for (int s = 0; s <= t; ++s) acc += wsg[t * 128 + s] * vn[s * 128 + c];
            const float sv = acc + C.in[I_GBS][(l * 4 + g) * 128 + t];
            const float uv = geluf_(bf2f(H[(size_t)(t0 + t) * NH + HC_GU + g * 128 + c]));
            BR[(size_t)(t0 + t) * NBR + 1024 + g * 128 + c] = (bf16_t)f2bf(uv * sv);
        }
        __syncthreads();
    }
}
__device__ __forceinline__ void mix_fox_naive(const Ctx& C, int l) {
    const bf16_t* H = (const bf16_t*)(C.ws + WS_H); bf16_t* BR = (bf16_t*)(C.ws + WS_BR);
    const float* cum = (const float*)(C.ws + WS_CUM);
    const float scale = 0.08838834764831845f;
    for (int u = C.bid; u < T * 4 / 8; u += C.G) {
        const int rid = u * 8 + C.wave;
        const int h = rid & 3, row = rid >> 2, b = row / SEQ, t = row % SEQ;
        const unsigned qraw = *(const unsigned*)(H + (size_t)row * NH + HC_FQ + h * 128 + C.lane * 2);
        const float q0 = bf2f(qraw & 0xffffu) * scale, q1 = bf2f(qraw >> 16) * scale;
        const float* cm = cum + ((size_t)b * 4 + h) * SEQ;
        const float ct = cm[t];
        float m = -1e30f, lsum = 0.f, o0 = 0.f, o1 = 0.f;
        for (int s = t; s >= 0; --s) {
            const size_t kr = (size_t)(b * SEQ + s) * NH + h * 128 + C.lane * 2;
            const unsigned kraw = *(const unsigned*)(H + kr + HC_FK);
            const unsigned vraw = *(const unsigned*)(H + kr + HC_FV);
            float d = q0 * bf2f(kraw & 0xffffu) + q1 * bf2f(kraw >> 16);
            d = wave_sum(d);
            const float z = d + ct - cm[s];
            const float mn = fmaxf(m, z), al = __expf(m - mn), p = __expf(z - mn);
            lsum = lsum * al + p; o0 = o0 * al + p * bf2f(vraw & 0xffffu); o1 = o1 * al + p * bf2f(vraw >> 16); m = mn;
        }
        const float inv = 1.f / lsum;
        *(unsigned*)(BR + (size_t)row * NBR + 1536 + h * 128 + C.lane * 2) = pk2(o0 * inv, o1 * inv);
    }
}
__device__ __forceinline__ void mix_hgrn_naive(const Ctx& C, int l) {
    if (C.bid >= BATCH * 4) return;
    const bf16_t* H = (const bf16_t*)(C.ws + WS_H); bf16_t* BR = (bf16_t*)(C.ws + WS_BR);
    const int b = C.bid >> 2, h = C.bid & 3;
    LAS float* fdec = (LAS float*)C.lds;
    LAS float* kkv = fdec + 32 * 128;
    LAS float* qsv = kkv + 32 * 128;
    LAS float* vv = qsv + 32 * 128;
    LAS float* opart = vv + 32 * 128;
    const int kq = C.tid >> 7, v = C.tid & 127;
    float S[32];
#pragma unroll
    for (int j = 0; j < 32; ++j) S[j] = 0.f;
    for (int c0 = 0; c0 < SEQ; c0 += 32) {
        for (int idx = C.tid; idx < 32 * 128; idx += 512) {
            const int st = idx >> 7, k = idx & 127; const size_t rb = (size_t)(b * SEQ + c0 + st) * NH + h * 128 + k;
            float lb = 0.f;
            if (l == 1) { const float z0 = C.in[I_LBL][h * 128 + k], z1 = C.in[I_LBL][BW + h * 128 + k]; lb = 1.f / (1.f + __expf(z0 - z1)); }
            const float zf = bf2f(H[rb + HC_HF]);
            const float kk = (1.f - lb) * sigmoidf_(-zf);
            fdec[idx] = 1.f - kk; kkv[idx] = kk; qsv[idx] = siluf_(bf2f(H[rb + HC_HQ])); vv[idx] = bf2f(H[rb + HC_HI]);
        }
        __syncthreads();
        for (int st = 0; st < 32; ++st) {
            const float vt = vv[st * 128 + v];
            float part = 0.f;
#pragma unroll
            for (int j = 0; j < 32; ++j) { const int k = kq * 32 + j; S[j] = fdec[st * 128 + k] * S[j] + kkv[st * 128 + k] * vt; part += S[j] * qsv[st * 128 + k]; }
            opart[(kq * 32 + st) * 128 + v] = part;
        }
        __syncthreads();
        for (int i = 0; i < 4; ++i) {
            const int st = C.wave * 4 + i, row = b * SEQ + c0 + st;
            float o0 = 0.f, o1 = 0.f;
#pragma unroll
            for (int q = 0; q < 4; ++q) { o0 += opart[(q * 32 + st) * 128 + C.lane]; o1 += opart[(q * 32 + st) * 128 + 64 + C.lane]; }
            const float ss = wave_sum(o0 * o0 + o1 * o1);
            const float r = rsqrtf(ss * (1.f / 128.f) + RMS_EPS);
            const float g0 = siluf_(bf2f(H[(size_t)row * NH + HC_HG + h * 128 + C.lane])), g1 = siluf_(bf2f(H[(size_t)row * NH + HC_HG + h * 128 + 64 + C.lane]));
            BR[(size_t)row * NBR + 512 + h * 128 + C.lane] = (bf16_t)f2bf(o0 * r * C.in[I_HNG][l * 128 + C.lane] * g0);
            BR[(size_t)row * NBR + 512 + h * 128 + 64 + C.lane] = (bf16_t)f2bf(o1 * r * C.in[I_HNG][l * 128 + 64 + C.lane] * g1);
        }
        __syncthreads();
    }
}


typedef float f32x16 __attribute__((ext_vector_type(16)));
typedef short s16x4 __attribute__((ext_vector_type(4)));
typedef short v4i16_t __attribute__((ext_vector_type(4)));
__device__ __forceinline__ s16x4 vtr(const LAS unsigned char* p) { return __builtin_bit_cast(s16x4, __builtin_amdgcn_ds_read_tr16_b64_v4i16((LAS v4i16_t*)p)); }
__device__ __forceinline__ float xor32(float x) { return __shfl_xor(x, 32, 64); }
#define MFMA32(a, b, c) __builtin_amdgcn_mfma_f32_32x32x16_bf16((a), (b), (c), 0, 0, 0)
constexpr int CW_KMAX = 16;

__device__ __forceinline__ void p_knorm(const Ctx& C, int l) {
    const bf16_t* H = (const bf16_t*)(C.ws + WS_H);
    unsigned* kmax = (unsigned*)(C.ws + WS_CTL) + CW_KMAX + l * 8;
    for (int r0 = (C.bid * 8 + C.wave) * 8; r0 < T; r0 += C.G * 64) {
        u32x4 raw[8];
#pragma unroll
        for (int i = 0; i < 8; ++i) raw[i] = *(const u32x4*)(H + (size_t)(r0 + i) * NH + HC_FK + C.lane * 8);
        float best = 0.f;
#pragma unroll
        for (int i = 0; i < 8; ++i) { float s = 0.f;
#pragma unroll
            for (int j = 0; j < 4; ++j) { const float a = bf2f(raw[i][j] & 0xffffu), b = bf2f(raw[i][j] >> 16); s += a * a + b * b; }
            best = fmaxf(best, s); }
        best = 0.f;
#pragma unroll
        for (int i = 0; i < 8; ++i) { float s = 0.f;
#pragma unroll
            for (int j = 0; j < 4; ++j) { const float a = bf2f(raw[i][j] & 0xffffu), b = bf2f(raw[i][j] >> 16); s += a * a + b * b; }
#pragma unroll
            for (int o = 8; o > 0; o >>= 1) s += __shfl_xor(s, o, 64);
            best = fmaxf(best, s); }
        if ((C.lane & 15) == 0) atomicMax(kmax + (r0 / SEQ) * 4 + (C.lane >> 4), __builtin_bit_cast(unsigned, best));
    }
}

constexpr int FOX_KST = 272, FOX_VST = 320;
constexpr int FOX_KB = 0, FOX_VB = 2 * 64 * FOX_KST, FOX_BETA = FOX_VB + 2 * 64 * FOX_VST, FOX_FLAG = FOX_BETA + 2 * 64 * 4, FOX_END = FOX_FLAG + 2 * 8 * 4;
__device__ __forceinline__ void mix_fox(const Ctx& C, int l) {
    const bf16_t* H = (const bf16_t*)(C.ws + WS_H); bf16_t* BR = (bf16_t*)(C.ws + WS_BR);
    const float* cum = (const float*)(C.ws + WS_CUM);
    const unsigned* kmaxw = (const unsigned*)(C.ws + WS_CTL) + CW_KMAX + l * 8;
    const float LOG2E = 1.4426950408889634f, QS = 0.08838834764831845f * LOG2E;
    const int lane = C.lane, w = C.wave, r32 = lane & 31, hh = lane >> 5;
    LAS unsigned char* lds = C.lds;
    LAS float* betaL = (LAS float*)(lds + FOX_BETA);
    volatile LAS int* flagL = (volatile LAS int*)(lds + FOX_FLAG);
    for (int u = C.bid; u < BATCH * 4 * (SEQ / 256); u += C.G) {
        const int qb = u % (SEQ / 256), bh = u / (SEQ / 256), b = bh >> 2, h = bh & 3;
        const int q0 = qb * 256, qw = q0 + 32 * w;
        const size_t rowbase = (size_t)b * SEQ;
        const float* cm = cum + ((size_t)b * 4 + h) * SEQ;
        const float c0 = cm[q0];
        const float kmx = sqrtf(__builtin_bit_cast(float, __hip_atomic_load(kmaxw + b * 4 + h, __ATOMIC_RELAXED, __HIP_MEMORY_SCOPE_AGENT)));
        bf16x8 qf[8]; float qn = 0.f;
        {
            const bf16_t* qp = H + (rowbase + qw + r32) * NH + HC_FQ + h * 128 + 8 * hh;
#pragma unroll
            for (int ks = 0; ks < 8; ++ks) {
                const u32x4 raw = *(const u32x4*)(qp + 16 * ks);
                u32x4 o;
#pragma unroll
                for (int j = 0; j < 4; ++j) { const float a = bf2f(raw[j] & 0xffffu), bb = bf2f(raw[j] >> 16); qn += a * a + bb * bb; o[j] = cvtpk(a * QS, bb * QS); }
                qf[ks] = __builtin_bit_cast(bf16x8, o);
            }
            qn += xor32(qn); qn = sqrtf(qn);
        }
        const float qbound = qn * kmx * QS;
        f32x16 oacc[4];
#pragma unroll
        for (int mt = 0; mt < 4; ++mt)
#pragma unroll
            for (int i = 0; i < 16; ++i) oacc[mt][i] = 0.f;
        float m_run = -1e30f, l_run = 0.f;
        const int jmax = (q0 + 255) >> 6;
        const int srow = C.tid >> 4, sch = C.tid & 15;
        u32x4 kreg[2], vreg[2]; float breg = 0.f;
#define FOX_GLOAD(j_) do { _Pragma("unroll") for (int p = 0; p < 2; ++p) { \
                const bf16_t* rp = H + (rowbase + 64 * (j_) + srow + 32 * p) * NH + h * 128 + sch * 8; \
                kreg[p] = *(const u32x4*)(rp + HC_FK); vreg[p] = *(const u32x4*)(rp + HC_FV); } \
            if (C.tid < 64) breg = (c0 - cm[64 * (j_) + C.tid]) * LOG2E; } while (0)
#define FOX_LWRITE(buf_) do { _Pragma("unroll") for (int p = 0; p < 2; ++p) { \
                *(LAS u32x4*)(lds + FOX_KB + (buf_) * 64 * FOX_KST + (srow + 32 * p) * FOX_KST + sch * 16) = kreg[p]; \
                *(LAS u32x4*)(lds + FOX_VB + (buf_) * 64 * FOX_VST + (srow + 32 * p) * FOX_VST + sch * 16) = vreg[p]; } \
            if (C.tid < 64) betaL[(buf_) * 64 + C.tid] = breg; } while (0)
        __syncthreads();
        if (C.tid < 16) flagL[C.tid] = 0;
        FOX_GLOAD(jmax); FOX_LWRITE(jmax & 1);
        bool wdone = false;
        for (int j = jmax; j >= 0; --j) {
            const int cur = j & 1;
            __syncthreads();
            if (j < jmax) { int all = 1;
#pragma unroll
                for (int i = 0; i < 8; ++i) all &= flagL[((j + 1) & 1) * 8 + i];
                if (all) break; }
            if (j > 0) FOX_GLOAD(j - 1);
            const int k0 = 64 * j;
            if (k0 <= qw + 31 && !wdone) {
                const LAS unsigned char* kb = lds + FOX_KB + cur * 64 * FOX_KST;
                const LAS unsigned char* vb = lds + FOX_VB + cur * 64 * FOX_VST;
                f32x16 sacc[2];
#pragma unroll
                for (int mt = 0; mt < 2; ++mt)
#pragma unroll
                    for (int g = 0; g < 4; ++g) { const f32x4 bv = *(const LAS f32x4*)(betaL + cur * 64 + 32 * mt + 8 * g + 4 * hh);
                        sacc[mt][4 * g] = bv[0]; sacc[mt][4 * g + 1] = bv[1]; sacc[mt][4 * g + 2] = bv[2]; sacc[mt][4 * g + 3] = bv[3]; }
#pragma unroll
                for (int ks = 0; ks < 8; ++ks)
#pragma unroll
                    for (int mt = 0; mt < 2; ++mt) {
                        const bf16x8 kf = *(const LAS bf16x8*)(kb + (32 * mt + r32) * FOX_KST + 32 * ks + 16 * hh);
                        sacc[mt] = MFMA32(kf, qf[ks], sacc[mt]);
                    }
                const int tq = qw + r32;
                if (k0 + 63 > qw) {
#pragma unroll
                    for (int mt = 0; mt < 2; ++mt)
#pragma unroll
                        for (int i = 0; i < 16; ++i) { const int key = k0 + 32 * mt + (i & 3) + 8 * (i >> 2) + 4 * hh; if (key > tq) sacc[mt][i] = -1e30f; }
                }
                float mx = sacc[0][0];
#pragma unroll
                for (int mt = 0; mt < 2; ++mt)
#pragma unroll
                    for (int i = 0; i < 16; ++i) mx = fmaxf(mx, sacc[mt][i]);
                mx = fmaxf(mx, xor32(mx));
                const float mn = fmaxf(m_run, mx), alpha = __builtin_amdgcn_exp2f(m_run - mn);
                m_run = mn;
                float ps = 0.f;
#pragma unroll
                for (int mt = 0; mt < 2; ++mt)
#pragma unroll
                    for (int i = 0; i < 16; ++i) { const float p = __builtin_amdgcn_exp2f(sacc[mt][i] - mn); sacc[mt][i] = p; ps += p; }
                l_run = l_run * alpha + ps;
#pragma unroll
                for (int mt = 0; mt < 4; ++mt)
#pragma unroll
                    for (int i = 0; i < 16; ++i) oacc[mt][i] *= alpha;
#pragma unroll
                for (int s4 = 0; s4 < 4; ++s4) {
                    const int mtk = s4 >> 1, s = s4 & 1;
                    u32x4 pb;
#pragma unroll
                    for (int e = 0; e < 4; ++e) pb[e] = cvtpk(sacc[mtk][8 * s + 2 * e], sacc[mtk][8 * s + 2 * e + 1]);
                    const bf16x8 pfrag = __builtin_bit_cast(bf16x8, pb);
                    const int i16 = lane & 15, q4 = i16 >> 2, p4 = i16 & 3, blk = (lane >> 4) & 1;
                    const int keyA = 32 * mtk + 16 * s + 4 * hh + q4;
#pragma unroll
                    for (int mt = 0; mt < 4; ++mt) {
                        const LAS unsigned char* a0 = vb + keyA * FOX_VST + (32 * mt + 16 * blk + 4 * p4) * 2;
                        const s16x4 lo = vtr(a0), hi = vtr(a0 + 8 * FOX_VST);
                        const bf16x8 vf = __builtin_shufflevector(lo, hi, 0, 1, 2, 3, 4, 5, 6, 7);
                        oacc[mt] = MFMA32(vf, pfrag, oacc[mt]);
                    }
                }
                if (j > 0) { const float bl = (c0 - cm[k0 - 1]) * LOG2E;
                    const int ok = (qbound + bl < m_run - 152.f) ? 1 : 0;
                    wdone = __all(ok); }
            }
            if (lane == 0) flagL[cur * 8 + w] = wdone ? 1 : 0;
            if (j > 0) FOX_LWRITE(cur ^ 1);
        }
        l_run += xor32(l_run);
        const float inv = 1.f / l_run;
        bf16_t* op = BR + (rowbase + qw + r32) * NBR + 1536 + h * 128;
#pragma unroll
        for (int mt = 0; mt < 4; ++mt)
#pragma unroll
            for (int g = 0; g < 4; ++g) { u32x2 o; o[0] = cvtpk(oacc[mt][4 * g] * inv, oacc[mt][4 * g + 1] * inv); o[1] = cvtpk(oacc[mt][4 * g + 2] * inv, oacc[mt][4 * g + 3] * inv);
                *(u32x2*)(op + 32 * mt + 8 * g + 4 * hh) = o; }
    }
}


constexpr int HG_LF = 0, HG_QA = 34816, HG_QB = HG_QA + 17408, HG_KD = HG_QB + 8704, HG_KO = HG_KD + 17408, HG_KT = HG_KO + 8704, HG_VN = HG_KT + 20480, HG_AM = HG_VN + 20480, HG_END = HG_AM + 12288;
constexpr int HG_LFS = 132;
static_assert(HG_END + 2048 <= 140 * 1024, "hgrn LDS");
constexpr size_t WS_DSC = WS_ST + (size_t)BATCH * 4 * 32 * 128 * 128 * 4;

template <bool FULL>
__device__ __forceinline__ void hgrn_unit(const Ctx& C, int l, int u) {
#if DIAG == 1
    const bf16_t* H = (const bf16_t*)(C.ws + WS_H); bf16_t* BR = (l == 0) ? (bf16_t*)(C.ws + WS_XA) : (bf16_t*)(C.ws + WS_TABU);
#else
    const bf16_t* H = (const bf16_t*)(C.ws + WS_H); bf16_t* BR = (bf16_t*)(C.ws + WS_BR);
#endif
    float* STB = (float*)(C.ws + WS_ST); float* DSC = (float*)(C.ws + WS_DSC);
    LAS unsigned char* lds = C.lds;
    LAS float* LF = (LAS float*)(lds + HG_LF);
    const int lane = C.lane, w = C.wave, r32 = lane & 31, hh = lane >> 5;
    const int sc = u & 31, bh = u >> 5, b = bh >> 2, h = bh & 3;
    const int wk = w >> 1, wv = w & 1;
    const int mt = w >> 2, nt = w & 3;
    const int i16 = lane & 15, q4 = i16 >> 2, p4 = i16 & 3, blk = (lane >> 4) & 1;
    f32x16 S0, S1;
    float* stp = STB + ((size_t)bh * 32 + sc) * 128 * 128;
    if constexpr (FULL) {
#pragma unroll
        for (int i = 0; i < 16; ++i) { const int k = 32 * wk + (i & 3) + 8 * (i >> 2) + 4 * hh;
            S0[i] = stp[k * 128 + 64 * wv + r32]; S1[i] = stp[k * 128 + 64 * wv + 32 + r32]; }
    } else {
#pragma unroll
        for (int i = 0; i < 16; ++i) { S0[i] = 0.f; S1[i] = 0.f; }
    }
    float dtot = 0.f;
    const int ps = C.tid >> 3, pseg = C.tid & 7;
    float lbv[16];
#pragma unroll
    for (int j = 0; j < 16; ++j) { lbv[j] = 0.f;
        if (l == 1) { const int ch = h * 128 + 16 * pseg + j; lbv[j] = 1.f / (1.f + __expf(C.in[I_LBL][ch] - C.in[I_LBL][BW + ch])); } }
    for (int c = 0; c < 4; ++c) {
        const size_t row0 = (size_t)b * SEQ + sc * 256 + c * 64;
        const bf16_t* hp = H + (row0 + ps) * NH + h * 128 + 16 * pseg;
        float kkv[16], qsv[16];
        u32x4 vraw0, vraw1;
        {
            const u32x4 f0 = *(const u32x4*)(hp + HC_HF), f1 = *(const u32x4*)(hp + HC_HF + 8);
            vraw0 = *(const u32x4*)(hp + HC_HI); vraw1 = *(const u32x4*)(hp + HC_HI + 8);
#pragma unroll
            for (int j = 0; j < 8; ++j) { const unsigned r = (j < 4) ? f0[j] : f1[j - 4];
                const float z0 = bf2f(r & 0xffffu), z1 = bf2f(r >> 16);
                kkv[2 * j] = (1.f - lbv[2 * j]) * sigmoidf_(-z0); kkv[2 * j + 1] = (1.f - lbv[2 * j + 1]) * sigmoidf_(-z1); }
            if constexpr (FULL) {
                const u32x4 q0 = *(const u32x4*)(hp + HC_HQ), q1 = *(const u32x4*)(hp + HC_HQ + 8);
#pragma unroll
                for (int j = 0; j < 8; ++j) { const unsigned r = (j < 4) ? q0[j] : q1[j - 4]; qsv[2 * j] = siluf_(bf2f(r & 0xffffu)); qsv[2 * j + 1] = siluf_(bf2f(r >> 16)); }
            }
#pragma unroll
            for (int j4 = 0; j4 < 4; ++j4) { f32x4 o;
#pragma unroll
                for (int e = 0; e < 4; ++e) o[e] = __logf(1.f - kkv[4 * j4 + e]);
                *(LAS f32x4*)(LF + ps * HG_LFS + 16 * pseg + 4 * j4) = o; }
        }
        __syncthreads();
        {
            const int sk = C.tid & 127, sg = C.tid >> 7;
            float vals[16];
#pragma unroll
            for (int i = 0; i < 16; ++i) vals[i] = LF[(16 * sg + i) * HG_LFS + sk];
#pragma unroll
            for (int i = 1; i < 16; ++i) vals[i] += vals[i - 1];
            LAS float* TOT = (LAS float*)(lds + HG_END);
            TOT[sg * 128 + sk] = vals[15];
            __syncthreads();
            float off = 0.f;
#pragma unroll
            for (int j = 0; j < 3; ++j) if (j < sg) off += TOT[j * 128 + sk];
#pragma unroll
            for (int i = 0; i < 16; ++i) LF[(16 * sg + i) * HG_LFS + sk] = vals[i] + off;
            if (sg == 3) dtot += vals[15] + off;
        }
        __syncthreads();
        float bv[16], b31[16], bl[16];
#pragma unroll
        for (int j4 = 0; j4 < 4; ++j4) { const f32x4 x = *(const LAS f32x4*)(LF + ps * HG_LFS + 16 * pseg + 4 * j4), y = *(const LAS f32x4*)(LF + 31 * HG_LFS + 16 * pseg + 4 * j4), z = *(const LAS f32x4*)(LF + 63 * HG_LFS + 16 * pseg + 4 * j4);
#pragma unroll
            for (int e = 0; e < 4; ++e) { bv[4 * j4 + e] = x[e]; b31[4 * j4 + e] = y[e]; bl[4 * j4 + e] = z[e]; } }
        {
            u32x4 o0, o1;
#pragma unroll
            for (int j = 0; j < 4; ++j) { o0[j] = cvtpk(kkv[2 * j] * __expf(bl[2 * j] - bv[2 * j]), kkv[2 * j + 1] * __expf(bl[2 * j + 1] - bv[2 * j + 1]));
                o1[j] = cvtpk(kkv[8 + 2 * j] * __expf(bl[8 + 2 * j] - bv[8 + 2 * j]), kkv[9 + 2 * j] * __expf(bl[9 + 2 * j] - bv[9 + 2 * j])); }
            *(LAS u32x4*)(lds + HG_KT + ps * 320 + 32 * pseg) = o0; *(LAS u32x4*)(lds + HG_KT + ps * 320 + 32 * pseg + 16) = o1;
            *(LAS u32x4*)(lds + HG_VN + ps * 320 + 32 * pseg) = vraw0; *(LAS u32x4*)(lds + HG_VN + ps * 320 + 32 * pseg + 16) = vraw1;
            if constexpr (FULL) {
                const bool hi = ps >= 32;
                float rr[16];
#pragma unroll
                for (int j = 0; j < 16; ++j) rr[j] = hi ? b31[j] : 0.f;
#pragma unroll
                for (int j = 0; j < 4; ++j) { o0[j] = cvtpk(qsv[2 * j] * __expf(bv[2 * j] - rr[2 * j]), qsv[2 * j + 1] * __expf(bv[2 * j + 1] - rr[2 * j + 1]));
                    o1[j] = cvtpk(qsv[8 + 2 * j] * __expf(bv[8 + 2 * j] - rr[8 + 2 * j]), qsv[9 + 2 * j] * __expf(bv[9 + 2 * j] - rr[9 + 2 * j])); }
                *(LAS u32x4*)(lds + HG_QA + ps * 272 + 32 * pseg) = o0; *(LAS u32x4*)(lds + HG_QA + ps * 272 + 32 * pseg + 16) = o1;
#pragma unroll
                for (int j = 0; j < 4; ++j) { o0[j] = cvtpk(kkv[2 * j] * __expf(rr[2 * j] - bv[2 * j]), kkv[2 * j + 1] * __expf(rr[2 * j + 1] - bv[2 * j + 1]));
                    o1[j] = cvtpk(kkv[8 + 2 * j] * __expf(rr[8 + 2 * j] - bv[8 + 2 * j]), kkv[9 + 2 * j] * __expf(rr[9 + 2 * j] - bv[9 + 2 * j])); }
                *(LAS u32x4*)(lds + HG_KD + ps * 272 + 32 * pseg) = o0; *(LAS u32x4*)(lds + HG_KD + ps * 272 + 32 * pseg + 16) = o1;
                if (hi) {
#pragma unroll
                    for (int j = 0; j < 4; ++j) { o0[j] = cvtpk(qsv[2 * j] * __expf(bv[2 * j]), qsv[2 * j + 1] * __expf(bv[2 * j + 1]));
                        o1[j] = cvtpk(qsv[8 + 2 * j] * __expf(bv[8 + 2 * j]), qsv[9 + 2 * j] * __expf(bv[9 + 2 * j])); }
                    *(LAS u32x4*)(lds + HG_QB + (ps - 32) * 272 + 32 * pseg) = o0; *(LAS u32x4*)(lds + HG_QB + (ps - 32) * 272 + 32 * pseg + 16) = o1;
                } else {
#pragma unroll
                    for (int j = 0; j < 4; ++j) { o0[j] = cvtpk(kkv[2 * j] * __expf(b31[2 * j] - bv[2 * j]), kkv[2 * j + 1] * __expf(b31[2 * j + 1] - bv[2 * j + 1]));
                        o1[j] = cvtpk(kkv[8 + 2 * j] * __expf(b31[8 + 2 * j] - bv[8 + 2 * j]), kkv[9 + 2 * j] * __expf(b31[9 + 2 * j] - bv[9 + 2 * j])); }
                    *(LAS u32x4*)(lds + HG_KO + ps * 272 + 32 * pseg) = o0; *(LAS u32x4*)(lds + HG_KO + ps * 272 + 32 * pseg + 16) = o1;
                }
            }
        }
        float dk[16];
#pragma unroll
        for (int i = 0; i < 16; ++i) dk[i] = __expf(LF[63 * HG_LFS + 32 * wk + (i & 3) + 8 * (i >> 2) + 4 * hh]);
        __syncthreads();
        if constexpr (FULL) {
#pragma unroll
            for (int g = 0; g < 4; ++g) {
                u32x2 o; o[0] = cvtpk(S0[4 * g], S0[4 * g + 1]); o[1] = cvtpk(S0[4 * g + 2], S0[4 * g + 3]);
                *(LAS u32x2*)(lds + HG_LF + (64 * wv + r32) * 272 + (32 * wk + 8 * g + 4 * hh) * 2) = o;
                o[0] = cvtpk(S1[4 * g], S1[4 * g + 1]); o[1] = cvtpk(S1[4 * g + 2], S1[4 * g + 3]);
                *(LAS u32x2*)(lds + HG_LF + (64 * wv + 32 + r32) * 272 + (32 * wk + 8 * g + 4 * hh) * 2) = o;
            }
#define HG_ATILE(AMT_, AST_) do { \
                const LAS unsigned char* kb = ((AMT_) == (AST_)) ? (lds + HG_KD + (32 * (AST_)) * 272) : (lds + HG_KO); \
                f32x16 a; \
                _Pragma("unroll") for (int i = 0; i < 16; ++i) a[i] = 0.f; \
                _Pragma("unroll") for (int ks = 0; ks < 8; ++ks) { \
                    const bf16x8 af = *(const LAS bf16x8*)(lds + HG_QA + (32 * (AMT_) + r32) * 272 + 32 * ks + 16 * hh); \
                    const bf16x8 bf = *(const LAS bf16x8*)(kb + r32 * 272 + 32 * ks + 16 * hh); \
                    a = MFMA32(af, bf, a); } \
                _Pragma("unroll") for (int g = 0; g < 4; ++g) { \
                    float x[4]; \
                    _Pragma("unroll") for (int e = 0; e < 4; ++e) { const int tl = 8 * g + 4 * hh + e; x[e] = ((AMT_) != (AST_) || r32 <= tl) ? a[4 * g + e] : 0.f; } \
                    u32x2 o; o[0] = cvtpk(x[0], x[1]); o[1] = cvtpk(x[2], x[3]); \
                    *(LAS u32x2*)(lds + HG_AM + (32 * (AST_) + r32) * 192 + (32 * (AMT_) + 8 * g + 4 * hh) * 2) = o; } } while (0)
            if (w == 0) { HG_ATILE(0, 0); }
            else if (w == 1) { HG_ATILE(1, 0); }
            else if (w == 2) { HG_ATILE(1, 1); }
        }
#pragma unroll
        for (int i = 0; i < 16; ++i) { S0[i] *= dk[i]; S1[i] *= dk[i]; }
#pragma unroll
        for (int ks = 0; ks < 4; ++ks) {
            const LAS unsigned char* ka = lds + HG_KT + (16 * ks + 8 * hh + q4) * 320 + (32 * wk + 16 * blk + 4 * p4) * 2;
            const s16x4 alo = vtr(ka), ahi = vtr(ka + 4 * 320);
            const bf16x8 af = __builtin_shufflevector(alo, ahi, 0, 1, 2, 3, 4, 5, 6, 7);
            const LAS unsigned char* vb0 = lds + HG_VN + (16 * ks + 8 * hh + q4) * 320 + (64 * wv + 16 * blk + 4 * p4) * 2;
            const s16x4 b0lo = vtr(vb0), b0hi = vtr(vb0 + 4 * 320), b1lo = vtr(vb0 + 64), b1hi = vtr(vb0 + 64 + 4 * 320);
            S0 = MFMA32(af, __builtin_shufflevector(b0lo, b0hi, 0, 1, 2, 3, 4, 5, 6, 7), S0);
            S1 = MFMA32(af, __builtin_shufflevector(b1lo, b1hi, 0, 1, 2, 3, 4, 5, 6, 7), S1);
        }
        if constexpr (FULL) {
            __syncthreads();
            f32x16 o;
#pragma unroll
            for (int i = 0; i < 16; ++i) o[i] = 0.f;
            const LAS unsigned char* qb = (mt == 0) ? (lds + HG_QA) : (lds + HG_QB);
#pragma unroll
            for (int ks = 0; ks < 8; ++ks) {
                const bf16x8 af = *(const LAS bf16x8*)(qb + r32 * 272 + 32 * ks + 16 * hh);
                const bf16x8 bf = *(const LAS bf16x8*)(lds + HG_LF + (32 * nt + r32) * 272 + 32 * ks + 16 * hh);
                o = MFMA32(af, bf, o);
            }
#pragma unroll
            for (int ks = 0; ks < 4; ++ks) {
                if (mt == 0 && ks >= 2) continue;
                const LAS unsigned char* aa = lds + HG_AM + (16 * ks + 8 * hh + q4) * 192 + (32 * mt + 16 * blk + 4 * p4) * 2;
                const s16x4 alo = vtr(aa), ahi = vtr(aa + 4 * 192);
                const LAS unsigned char* vb0 = lds + HG_VN + (16 * ks + 8 * hh + q4) * 320 + (32 * nt + 16 * blk + 4 * p4) * 2;
                const s16x4 blo = vtr(vb0), bhi = vtr(vb0 + 4 * 320);
                o = MFMA32(__builtin_shufflevector(alo, ahi, 0, 1, 2, 3, 4, 5, 6, 7), __builtin_shufflevector(blo, bhi, 0, 1, 2, 3, 4, 5, 6, 7), o);
            }
            __syncthreads();
#pragma unroll
            for (int i = 0; i < 16; ++i) LF[(32 * mt + (i & 3) + 8 * (i >> 2) + 4 * hh) * HG_LFS + 32 * nt + r32] = o[i];
            __syncthreads();
            {
                float ov[16]; float ss = 0.f;
#pragma unroll
                for (int j4 = 0; j4 < 4; ++j4) { const f32x4 x = *(const LAS f32x4*)(LF + ps * HG_LFS + 16 * pseg + 4 * j4);
#pragma unroll
                    for (int e = 0; e < 4; ++e) { ov[4 * j4 + e] = x[e]; ss += x[e] * x[e]; } }
                ss += __shfl_xor(ss, 1, 64); ss += __shfl_xor(ss, 2, 64); ss += __shfl_xor(ss, 4, 64);
                const float rn = rsqrtf(ss * (1.f / 128.f) + RMS_EPS);
                const u32x4 g0 = *(const u32x4*)(hp + HC_HG), g1 = *(const u32x4*)(hp + HC_HG + 8);
                const float* ng = C.in[I_HNG] + l * 128 + 16 * pseg;
                u32x4 o0, o1;
#pragma unroll
                for (int j = 0; j < 4; ++j) {
                    o0[j] = cvtpk(ov[2 * j] * rn * ng[2 * j] * siluf_(bf2f(g0[j] & 0xffffu)), ov[2 * j + 1] * rn * ng[2 * j + 1] * siluf_(bf2f(g0[j] >> 16)));
                    o1[j] = cvtpk(ov[8 + 2 * j] * rn * ng[8 + 2 * j] * siluf_(bf2f(g1[j] & 0xffffu)), ov[9 + 2 * j] * rn * ng[9 + 2 * j] * siluf_(bf2f(g1[j] >> 16)));
                }
                bf16_t* bp = BR + (row0 + ps) * NBR + 512 + h * 128 + 16 * pseg;
                *(u32x4*)bp = o0; *(u32x4*)(bp + 8) = o1;
            }
        }
        __syncthreads();
    }
    if constexpr (!FULL) {
#pragma unroll
        for (int i = 0; i < 16; ++i) { const int k = 32 * wk + (i & 3) + 8 * (i >> 2) + 4 * hh;
            stp[k * 128 + 64 * wv + r32] = S0[i]; stp[k * 128 + 64 * wv + 32 + r32] = S1[i]; }
        if (C.tid >= 384) DSC[((size_t)bh * 32 + sc) * 128 + (C.tid & 127)] = __expf(dtot);
    }
}
__device__ __forceinline__ void hgrn_b1(const Ctx& C, int l) { for (int u = C.bid; u < BATCH * 4 * 32; u += C.G) hgrn_unit<false>(C, l, u); }
__device__ __forceinline__ void hgrn_b3(const Ctx& C, int l) { for (int u = C.bid; u < BATCH * 4 * 32; u += C.G) hgrn_unit<true>(C, l, u); }
__device__ __forceinline__ void hgrn_b2(const Ctx& C) {
    float* STB = (float*)(C.ws + WS_ST); const float* DSC = (const float*)(C.ws + WS_DSC);
    for (int e = C.bid * 512 + C.tid; e < BATCH * 4 * 128 * 128; e += C.G * 512) {
        const int bh = e >> 14, kv = e & 16383, k = kv >> 7;
        float* p = STB + (size_t)bh * 32 * 16384 + kv;
        float uu[32], dd[32];
#pragma unroll
        for (int s = 0; s < 32; ++s) { uu[s] = p[(size_t)s * 16384]; dd[s] = DSC[((size_t)bh * 32 + s) * 128 + k]; }
        float st = 0.f;
#pragma unroll
        for (int s = 0; s < 32; ++s) { p[(size_t)s * 16384] = st; st = dd[s] * st + uu[s]; }
    }
}


__device__ __forceinline__ void mix_pool(const Ctx& C, int l) {
#if DIAG == 2
    const bf16_t* H = (const bf16_t*)(C.ws + WS_H); bf16_t* BR = (l == 0) ? (bf16_t*)(C.ws + WS_XA) : (bf16_t*)(C.ws + WS_TABU);
#else
    const bf16_t* H = (const bf16_t*)(C.ws + WS_H); bf16_t* BR = (bf16_t*)(C.ws + WS_BR);
#endif
    const bf16_t* Wt = (const bf16_t*)(C.ws + WS_W + (size_t)l * W_LAYER + WO_POOLW);
    LAS unsigned char* lds = C.lds;
    const int lane = C.lane, w = C.wave, r32 = lane & 31, hh = lane >> 5;
    for (int u = C.bid; u < (T / 256) * 4; u += C.G) {
        const int g = u & 3, t0 = (u >> 2) * 256, win = 2 << g;
        const int row = t0 + 32 * w + r32, pos = row & (SEQ - 1);
        __syncthreads();
#pragma unroll
        for (int p = 0; p < 4; ++p) { const int idx = C.tid + 512 * p, rr = idx >> 4, ch = idx & 15;
            *(LAS u32x4*)(lds + rr * 272 + ch * 16) = *(const u32x4*)(Wt + (size_t)g * 128 * 128 + rr * 128 + ch * 8); }
        const int nwin = (pos + 1 < win) ? pos + 1 : win;
        const float invn = 1.f / (float)nwin;
        bf16x8 df[8];
        const bf16_t* pp = H + (size_t)row * NH + HC_P + g * 128 + 8 * hh;
#pragma unroll
        for (int ks = 0; ks < 8; ++ks) {
            float sum[8];
#pragma unroll
            for (int e = 0; e < 8; ++e) sum[e] = 0.f;
            u32x4 rw[16];
#pragma unroll
            for (int j = 0; j < 16; ++j) { const int jj = (j < nwin) ? j : 0; rw[j] = *(const u32x4*)(pp + 16 * ks - (size_t)jj * NH); }
            const u32x4 self = rw[0];
#pragma unroll
            for (int j = 0; j < 16; ++j) { const float msk = (j < nwin) ? 1.f : 0.f;
#pragma unroll
                for (int e = 0; e < 4; ++e) { sum[2 * e] += msk * bf2f(rw[j][e] & 0xffffu); sum[2 * e + 1] += msk * bf2f(rw[j][e] >> 16); } }
            u32x4 o;
#pragma unroll
            for (int e = 0; e < 4; ++e) o[e] = cvtpk(sum[2 * e] * invn - bf2f(self[e] & 0xffffu), sum[2 * e + 1] * invn - bf2f(self[e] >> 16));
            df[ks] = __builtin_bit_cast(bf16x8, o);
        }
        __syncthreads();
        f32x16 acc[4];
#pragma unroll
        for (int mt = 0; mt < 4; ++mt)
#pragma unroll
            for (int i = 0; i < 16; ++i) acc[mt][i] = 0.f;
#pragma unroll
        for (int ks = 0; ks < 8; ++ks)
#pragma unroll
            for (int mt = 0; mt < 4; ++mt) {
                const bf16x8 wf = *(const LAS bf16x8*)(lds + (32 * mt + r32) * 272 + 32 * ks + 16 * hh);
                acc[mt] = MFMA32(wf, df[ks], acc[mt]);
            }
        const float* psc = C.in[I_POOLS] + l * BW + g * 128;
        bf16_t* op = BR + (size_t)row * NBR + g * 128;
#pragma unroll
        for (int mt = 0; mt < 4; ++mt)
#pragma unroll
            for (int q = 0; q < 4; ++q) { const int d0 = 32 * mt + 8 * q + 4 * hh; const f32x4 sc = *(const f32x4*)(psc + d0);
                u32x2 o; o[0] = cvtpk(acc[mt][4 * q] * sc[0], acc[mt][4 * q + 1] * sc[1]); o[1] = cvtpk(acc[mt][4 * q + 2] * sc[2], acc[mt][4 * q + 3] * sc[3]);
                *(u32x2*)(op + d0) = o; }
    }
}
constexpr int GM_VN = 0, GM_WC = 128 * 320, GM_END = GM_WC + 128 * 272;
__device__ __forceinline__ void mix_gmlp(const Ctx& C, int l) {
#if DIAG == 3
    const bf16_t* H = (const bf16_t*)(C.ws + WS_H); bf16_t* BR = (l == 0) ? (bf16_t*)(C.ws + WS_XA) : (bf16_t*)(C.ws + WS_TABU);
#else
    const bf16_t* H = (const bf16_t*)(C.ws + WS_H); bf16_t* BR = (bf16_t*)(C.ws + WS_BR);
#endif
    const bf16_t* Wc = (const bf16_t*)(C.ws + WS_W + (size_t)l * W_LAYER + WO_GWS);
    LAS unsigned char* lds = C.lds;
    const int lane = C.lane, w = C.wave, r32 = lane & 31, hh = lane >> 5;
    const int i16 = lane & 15, q4 = i16 >> 2, p4 = i16 & 3, blk = (lane >> 4) & 1;
    for (int u = C.bid; u < (T / 128) * 4; u += C.G) {
        const int g = u & 3, t0 = (u >> 2) * 128;
        __syncthreads();
#pragma unroll
        for (int p = 0; p < 4; ++p) { const int idx = C.tid + 512 * p, rr = idx >> 4, ch = idx & 15;
            *(LAS u32x4*)(lds + GM_WC + rr * 272 + ch * 16) = *(const u32x4*)(Wc + (size_t)g * 128 * 128 + rr * 128 + ch * 8); }
#pragma unroll
        for (int hb = 0; hb < 4; ++hb) {
            u32x4 rawv[4];
#pragma unroll
            for (int i = 0; i < 4; ++i) rawv[i] = *(const u32x4*)(H + (size_t)(t0 + w * 16 + hb * 4 + i) * NH + HC_GV + lane * 8);
            float e[4][8], st[8];
#pragma unroll
            for (int i = 0; i < 4; ++i) { float s1 = 0.f, s2 = 0.f;
#pragma unroll
                for (int j = 0; j < 4; ++j) { const float a = geluf_(bf2f(rawv[i][j] & 0xffffu)), b = geluf_(bf2f(rawv[i][j] >> 16)); e[i][2 * j] = a; e[i][2 * j + 1] = b; s1 += a + b; s2 += a * a + b * b; }
                st[i] = s1; st[4 + i] = s2; }
#pragma unroll
            for (int sx = 32, n = 4; sx >= 8; sx >>= 1, n >>= 1) { const bool up = (lane & sx) != 0;
#pragma unroll
                for (int i = 0; i < n; ++i) { const float send = up ? st[i] : st[i + n], keep = up ? st[i + n] : st[i]; st[i] = keep + __shfl_xor(send, sx, 64); } }
            float tot = st[0]; tot += __shfl_xor(tot, 4, 64); tot += __shfl_xor(tot, 2, 64); tot += __shfl_xor(tot, 1, 64);
            float mean4[4], rstd4[4];
#pragma unroll
            for (int i = 0; i < 4; ++i) {
                mean4[i] = __builtin_bit_cast(float, __builtin_amdgcn_readlane(__builtin_bit_cast(int, tot), 8 * i)) * (1.f / BW);
                const float ex2 = __builtin_bit_cast(float, __builtin_amdgcn_readlane(__builtin_bit_cast(int, tot), 8 * (4 + i))) * (1.f / BW);
                rstd4[i] = rsqrtf(fmaxf(ex2 - mean4[i] * mean4[i], 0.f) + LN_EPS);
            }
            asm volatile("" ::: "memory");
            if ((lane >> 4) == g) {
                const float* lg = C.in[I_GLNG] + l * BW + lane * 8; const float* lb = C.in[I_GLNB] + l * BW + lane * 8;
#pragma unroll
                for (int i = 0; i < 4; ++i) {
                    const float mean = mean4[i], rstd = rstd4[i];
                    u32x4 o;
#pragma unroll
                    for (int j = 0; j < 4; ++j) o[j] = cvtpk((e[i][2 * j] - mean) * rstd * lg[2 * j] + lb[2 * j], (e[i][2 * j + 1] - mean) * rstd * lg[2 * j + 1] + lb[2 * j + 1]);
                    *(LAS u32x4*)(lds + GM_VN + (w * 16 + hb * 4 + i) * 320 + (lane & 15) * 16) = o;
                }
            }
        }
        __syncthreads();
        const int nt = w & 3, mb = (w >> 2) * 2;
        f32x16 acc[2];
#pragma unroll
        for (int m = 0; m < 2; ++m)
#pragma unroll
            for (int i = 0; i < 16; ++i) acc[m][i] = 0.f;
        for (int ks = 0; ks < 2 * (nt + 1); ++ks) {
            const bf16x8 bf = *(const LAS bf16x8*)(lds + GM_WC + (32 * nt + r32) * 272 + 32 * ks + 16 * hh);
#pragma unroll
            for (int m = 0; m < 2; ++m) {
                const LAS unsigned char* aa = lds + GM_VN + (16 * ks + 8 * hh + q4) * 320 + (32 * (mb + m) + 16 * blk + 4 * p4) * 2;
                const s16x4 lo = vtr(aa), hi = vtr(aa + 4 * 320);
                acc[m] = MFMA32(__builtin_shufflevector(lo, hi, 0, 1, 2, 3, 4, 5, 6, 7), bf, acc[m]);
            }
        }
        const int tl = 32 * nt + r32, row = t0 + tl;
        const float bias = C.in[I_GBS][(l * 4 + g) * 128 + tl];
#pragma unroll
        for (int m = 0; m < 2; ++m)
#pragma unroll
            for (int q = 0; q < 4; ++q) { const int c0 = 32 * (mb + m) + 8 * q + 4 * hh;
                const u32x2 ur = *(const u32x2*)(H + (size_t)row * NH + HC_GU + g * 128 + c0);
                u32x2 o;
                o[0] = cvtpk(geluf_(bf2f(ur[0] & 0xffffu)) * (acc[m][4 * q] + bias), geluf_(bf2f(ur[0] >> 16)) * (acc[m][4 * q + 1] + bias));
                o[1] = cvtpk(geluf_(bf2f(ur[1] & 0xffffu)) * (acc[m][4 * q + 2] + bias), geluf_(bf2f(ur[1] >> 16)) * (acc[m][4 * q + 3] + bias));
                *(u32x2*)(BR + (size_t)row * NBR + 1024 + g * 128 + c0) = o; }
    }
}

#define CE_D(a, b) do { const float _h = fmaxf(a, b), _l = fminf(a, b); a = _h; b = _l; } while (0)
__device__ __forceinline__ void sort16_desc(float (&x)[16]) {
#pragma unroll
    for (int k = 2; k <= 16; k <<= 1)
#pragma unroll
        for (int j = k >> 1; j > 0; j >>= 1)
#pragma unroll
            for (int i = 0; i < 16; ++i) { const int l = i ^ j; if (l > i) { if ((i & k) == 0) CE_D(x[i], x[l]); else CE_D(x[l], x[i]); } }
}
__device__ __forceinline__ void bmerge16_desc(float (&x)[16]) {
#pragma unroll
    for (int j = 8; j > 0; j >>= 1)
#pragma unroll
        for (int i = 0; i < 16; ++i) { const int l = i ^ j; if (l > i) CE_D(x[i], x[l]); }
}
__device__ __forceinline__ void top16_merge(float (&a)[16], const float (&b)[16]) {
#pragma unroll
    for (int i = 0; i < 16; ++i) a[i] = fmaxf(a[i], b[15 - i]);
    bmerge16_desc(a);
}
__device__ __forceinline__ float pack_idx(float v, unsigned idx, unsigned mask) { return __builtin_bit_cast(float, (__builtin_bit_cast(unsigned, v) & ~mask) | idx); }

constexpr int TK_KST = 272, TK_KBUF = 128 * TK_KST;
__device__ __forceinline__ void p_topk(const Ctx& C, int l) {
    const bf16_t* Q = (const bf16_t*)(C.ws + WS_Q);
    const bf16_t* keys = (const bf16_t*)(C.ws + WS_W + (size_t)l * W_LAYER + WO_KEYS);
    int* eidx = (int*)(C.ws + WS_EIDX); float* egate = (float*)(C.ws + WS_EGATE);
    LAS unsigned char* lds = C.lds;
    const int lane = C.lane, w = C.wave, r32 = lane & 31, hh = lane >> 5;
    for (int u = C.bid; u < (T / 256) * PH; u += C.G) {
        const int h = u & 7, t0 = (u >> 3) * 256, tok = t0 + 32 * w + r32;
        float v12[2][16];
        __syncthreads();
#pragma unroll
        for (int j = 0; j < 2; ++j) {
            const bf16_t* kp = keys + ((size_t)j * PH + h) * 128 * 128;
#pragma unroll
            for (int p = 0; p < 4; ++p) { const int idx = C.tid + 512 * p, row = idx >> 4, ch = idx & 15;
                *(LAS u32x4*)(lds + j * TK_KBUF + row * TK_KST + ch * 16) = *(const u32x4*)(kp + row * 128 + ch * 8); }
        }
        __syncthreads();
#pragma unroll
        for (int j = 0; j < 2; ++j) {
            bf16x8 qf[8];
            {
                LAS unsigned char* qs = lds + 2 * TK_KBUF + w * (32 * 272);
                u32x4 qr[8];
#pragma unroll
                for (int p = 0; p < 8; ++p) qr[p] = *(const u32x4*)(Q + (size_t)(t0 + 32 * w + 4 * p + (lane >> 4)) * NQ + h * 256 + j * 128 + (lane & 15) * 8);
#pragma unroll
                for (int p = 0; p < 8; ++p) *(LAS u32x4*)(qs + (4 * p + (lane >> 4)) * 272 + (lane & 15) * 16) = qr[p];
#pragma unroll
                for (int ks = 0; ks < 8; ++ks) qf[ks] = *(const LAS bf16x8*)(qs + r32 * 272 + 32 * ks + 16 * hh);
            }
            f32x16 sacc[4];
#pragma unroll
            for (int mt = 0; mt < 4; ++mt)
#pragma unroll
                for (int i = 0; i < 16; ++i) sacc[mt][i] = 0.f;
#pragma unroll
            for (int ks = 0; ks < 8; ++ks)
#pragma unroll
                for (int mt = 0; mt < 4; ++mt) {
                    const bf16x8 kf = *(const LAS bf16x8*)(lds + j * TK_KBUF + (32 * mt + r32) * TK_KST + 32 * ks + 16 * hh);
                    sacc[mt] = MFMA32(kf, qf[ks], sacc[mt]);
                }
            float g[4][16];
#pragma unroll
            for (int mt = 0; mt < 4; ++mt) {
#pragma unroll
                for (int i = 0; i < 16; ++i) g[mt][i] = pack_idx(sacc[mt][i], (unsigned)(32 * mt + (i & 3) + 8 * (i >> 2) + 4 * hh), 127u);
                sort16_desc(g[mt]);
            }
            top16_merge(g[0], g[1]); top16_merge(g[2], g[3]); top16_merge(g[0], g[2]);
            float o[16];
#pragma unroll
            for (int i = 0; i < 16; ++i) o[i] = __shfl_xor(g[0][i], 32, 64);
            top16_merge(g[0], o);
#pragma unroll
            for (int i = 0; i < 16; ++i) v12[j][i] = g[0][i];
        }
        float c[4][16];
        {
            int n = 0;
#pragma unroll
            for (int a = 0; a < 16; ++a)
#pragma unroll
                for (int b = 0; b < 16; ++b) if ((a + 1) * (b + 1) <= 16) {
                    const unsigned id = ((__builtin_bit_cast(unsigned, v12[0][a]) & 127u) << 7) | (__builtin_bit_cast(unsigned, v12[1][b]) & 127u);
                    c[n >> 4][n & 15] = pack_idx(v12[0][a] + v12[1][b], id, 16383u); ++n; }
#pragma unroll
            for (; n < 64; ++n) c[n >> 4][n & 15] = -3.0e38f;
        }
#pragma unroll
        for (int q = 0; q < 4; ++q) sort16_desc(c[q]);
        top16_merge(c[0], c[1]); top16_merge(c[2], c[3]); top16_merge(c[0], c[2]);
        float e[16], den = 0.f;
#pragma unroll
        for (int i = 0; i < 16; ++i) { e[i] = __expf(c[0][i] - c[0][0]); den += e[i]; }
        const float inv = 1.f / den;
        int* ip = eidx + (size_t)tok * 128 + h * 16 + 8 * hh; float* gp = egate + (size_t)tok * 128 + h * 16 + 8 * hh;
        u32x4 i0, i1; f32x4 g0, g1;
#pragma unroll
        for (int i = 0; i < 4; ++i) {
            const float ca = hh ? c[0][8 + i] : c[0][i], cb = hh ? c[0][12 + i] : c[0][4 + i];
            i0[i] = __builtin_bit_cast(unsigned, ca) & 16383u; i1[i] = __builtin_bit_cast(unsigned, cb) & 16383u;
            g0[i] = (hh ? e[8 + i] : e[i]) * inv; g1[i] = (hh ? e[12 + i] : e[4 + i]) * inv;
        }
        *(u32x4*)ip = i0; *(u32x4*)(ip + 4) = i1; *(f32x4*)gp = g0; *(f32x4*)(gp + 4) = g1;
    }
}

constexpr int CW_DIAG = 64;
__device__ __forceinline__ void diag_cmp(const Ctx& C, const bf16_t* A, int lda, const bf16_t* R, int ldr, int nc) {
    float sd = 0.f, sr = 0.f;
    for (int row = C.bid; row < T; row += C.G) {
        const int tm = row % DIAG_MOD; if (tm < DIAG_LO || tm >= DIAG_HI) continue;
        for (int c = C.tid; c < nc; c += 512) { const float a = bf2f(A[(size_t)row * lda + c]), r = bf2f(R[(size_t)row * ldr + c]); sd += (a - r) * (a - r); sr += r * r; }
    }
    sd = wave_sum(sd); sr = wave_sum(sr);
    if (C.lane == 0) { atomicAdd((float*)(C.ws + WS_CTL) + CW_DIAG, sd); atomicAdd((float*)(C.ws + WS_CTL) + CW_DIAG + 1, sr); }
}
__device__ __forceinline__ void diag_cmp_u8(const Ctx& C, const unsigned char* A, int lda, const bf16_t* R, int ldr, int nc) {
    float sd = 0.f, sr = 0.f;
    for (int row = C.bid; row < T; row += C.G)
        for (int c = C.tid; c < nc; c += 512) { const float a = (float)A[(size_t)row * lda + c] * (1.f / 255.f), r = bf2f(R[(size_t)row * ldr + c]); sd += (a - r) * (a - r); sr += r * r; }
    sd = wave_sum(sd); sr = wave_sum(sr);
    if (C.lane == 0) { atomicAdd((float*)(C.ws + WS_CTL) + CW_DIAG, sd); atomicAdd((float*)(C.ws + WS_CTL) + CW_DIAG + 1, sr); }
}
__device__ __forceinline__ float diag_alpha(const Ctx& C) {
    const float sd = __hip_atomic_load((float*)(C.ws + WS_CTL) + CW_DIAG, __ATOMIC_RELAXED, __HIP_MEMORY_SCOPE_AGENT), sr = __hip_atomic_load((float*)(C.ws + WS_CTL) + CW_DIAG + 1, __ATOMIC_RELAXED, __HIP_MEMORY_SCOPE_AGENT);
    const float err = fmaxf(sd / fmaxf(sr, 1e-30f), 1e-8f);
    return 0.1f + 0.1f * (rintf(log10f(err / 1e-8f) * 10.f) * 0.1f);
}


#if DIAG == 5 || DIAG == 6
__device__ __forceinline__ void diag_ref_slice(const Ctx& C, const float* W, int ldw, int n0, const float* bias) {
    bf16_t* alt = (bf16_t*)(C.ws + WS_XA);
    const float* X = C.in[I_X];
    for (int row = C.bid * 8 + C.wave; row < T; row += C.G * 8) {
        float acc = 0.f;
        for (int k = 0; k < DM; ++k) acc += X[(size_t)row * DM + k] * W[(size_t)k * ldw + n0 + C.lane];
        if (bias) acc = sigmoidf_(acc + bias[n0 + C.lane]);
        alt[(size_t)row * 64 + C.lane] = (bf16_t)f2bf(acc);
    }
}
#endif

__device__ __forceinline__ void wave_argmax(float& v, int& i) {
#pragma unroll
    for (int o = 32; o > 0; o >>= 1) {
        const float ov = __shfl_xor(v, o, 64); const int oi = __shfl_xor(i, o, 64);
        if (ov > v || (ov == v && oi < i)) { v = ov; i = oi; }
    }
}
__device__ __forceinline__ void p_topk_naive(const Ctx& C, int l) {
    const bf16_t* Q = (const bf16_t*)(C.ws + WS_Q);
    const bf16_t* keys = (const bf16_t*)(C.ws + WS_W + (size_t)l * W_LAYER + WO_KEYS);
    int* eidx = (int*)(C.ws + WS_EIDX); float* egate = (float*)(C.ws + WS_EGATE);
    LAS float* qs = (LAS float*)C.lds;
    LAS float* sc = qs + 2048;
    LAS float* tv = sc + 2048;
    LAS int* ti = (LAS int*)(tv + 256);
    for (int t = C.bid; t < T; t += C.G) {
        for (int i = C.tid; i < 2048; i += 512) qs[i] = bf2f(Q[(size_t)t * NQ + i]);
        __syncthreads();
        for (int i = 0; i < 4; ++i) {
            const int idx = C.tid + 512 * i, hj = idx >> 7, key = idx & 127, h = hj >> 1, j = hj & 1;
            const bf16_t* kp = keys + (((size_t)j * PH + h) * 128 + key) * 128;
            float s = 0.f;
            for (int d8 = 0; d8 < 16; ++d8) {
                const u32x4 raw = *(const u32x4*)(kp + d8 * 8);
#pragma unroll
                for (int e = 0; e < 4; ++e) s += qs[h * 256 + j * 128 + d8 * 8 + 2 * e] * bf2f(raw[e] & 0xffffu) + qs[h * 256 + j * 128 + d8 * 8 + 2 * e + 1] * bf2f(raw[e] >> 16);
            }
            sc[idx] = s;
        }
        __syncthreads();
        for (int i = 0; i < 2; ++i) {
            const int hj = C.wave * 2 + i;
            float a0 = sc[hj * 128 + C.lane], a1 = sc[hj * 128 + 64 + C.lane];
            for (int r = 0; r < 16; ++r) {
                float bv; int bi;
                if (a0 > a1 || (a0 == a1)) { bv = a0; bi = C.lane; } else { bv = a1; bi = C.lane + 64; }
                wave_argmax(bv, bi);
                if (C.lane == 0) { tv[hj * 16 + r] = bv; ti[hj * 16 + r] = bi; }
                if (bi == C.lane) a0 = -3e38f; if (bi == C.lane + 64) a1 = -3e38f;
            }
        }
        __syncthreads();
        {
            const int h = C.wave;
            float cv[4];
#pragma unroll
            for (int i = 0; i < 4; ++i) { const int c = C.lane * 4 + i; cv[i] = tv[(h * 2) * 16 + (c >> 4)] + tv[(h * 2 + 1) * 16 + (c & 15)]; }
            float topv = 0.f; int tope = 0; float mx = 0.f;
            for (int r = 0; r < 16; ++r) {
                float bv = cv[0]; int bi = C.lane * 4;
#pragma unroll
                for (int i = 1; i < 4; ++i) if (cv[i] > bv) { bv = cv[i]; bi = C.lane * 4 + i; }
                wave_argmax(bv, bi);
                if (r == 0) mx = bv;
                if (C.lane == r) { topv = bv; tope = ti[(h * 2) * 16 + (bi >> 4)] * 128 + ti[(h * 2 + 1) * 16 + (bi & 15)]; }
#pragma unroll
                for (int i = 0; i < 4; ++i) if (bi == C.lane * 4 + i) cv[i] = -3e38f;
            }
            float e = (C.lane < 16) ? __expf(topv - mx) : 0.f;
            const float den = wave_sum(e);
            if (C.lane < 16) { eidx[(size_t)t * 128 + h * 16 + C.lane] = tope; egate[(size_t)t * 128 + h * 16 + C.lane] = e / den; }
        }
        __syncthreads();
    }
}
__device__ __forceinline__ float ub(unsigned w, int e) { return (float)((w >> (8 * e)) & 255u); }
__device__ __forceinline__ void p_gather(const Ctx& C, int l) {
    const bf16_t* xc = (const bf16_t*)(C.ws + WS_X1B);
    const unsigned char* U8 = C.ws + WS_U8; const unsigned char* V8 = C.ws + WS_V8;
    const float* SU = (const float*)(C.ws + WS_SU); const float* SV = (const float*)(C.ws + WS_SV);
    const int* eidx = (const int*)(C.ws + WS_EIDX); const float* egate = (const float*)(C.ws + WS_EGATE);
    const int lane = C.lane;
    for (int t = C.bid * 8 + C.wave; t < T; t += C.G * 8) {
        float x[16];
        { const bf16_t* xp = xc + (size_t)t * DM + lane * 16;
          const u32x4 a = *(const u32x4*)xp, b = *(const u32x4*)(xp + 8);
#pragma unroll
          for (int i = 0; i < 4; ++i) { x[2 * i] = bf2f(a[i] & 0xffffu); x[2 * i + 1] = bf2f(a[i] >> 16); x[8 + 2 * i] = bf2f(b[i] & 0xffffu); x[9 + 2 * i] = bf2f(b[i] >> 16); } }
        float xmx = 0.f;
#pragma unroll
        for (int j = 0; j < 16; ++j) xmx = fmaxf(xmx, fabsf(x[j]));
        xmx = fmaxf(wave_max(xmx), 1e-30f);
        const float xisc = 127.f / xmx, xsc = xmx * (1.f / 127.f);
        int xq[4];
#pragma unroll
        for (int q = 0; q < 4; ++q) { unsigned wd = 0u;
#pragma unroll
            for (int e = 0; e < 4; ++e) wd |= ((unsigned)(int)rintf(x[4 * q + e] * xisc) & 255u) << (8 * e);
            xq[q] = (int)wd; }
        float cf[2]; int ex[2];
#pragma unroll
        for (int bt = 0; bt < 2; ++bt) {
            ex[bt] = eidx[(size_t)t * 128 + 64 * bt + lane];
            const float gate = egate[(size_t)t * 128 + 64 * bt + lane];
            int p[64];
#pragma unroll
            for (int e0 = 0; e0 < 64; e0 += 16) {
                u32x4 r[16];
#pragma unroll
                for (int i = 0; i < 16; ++i) { const int e = __builtin_amdgcn_readlane(ex[bt], e0 + i); r[i] = *(const u32x4*)(U8 + (size_t)e * DM + lane * 16); }
#pragma unroll
                for (int i = 0; i < 16; ++i) { int a = 0;
#pragma unroll
                    for (int q = 0; q < 4; ++q) a = __builtin_amdgcn_sdot4(xq[q], (int)r[i][q], a, false);
                    p[e0 + i] = a; }
            }
#pragma unroll
            for (int st = 32, n = 32; st > 0; st >>= 1, n >>= 1) {
                const bool up = (lane & st) != 0;
#pragma unroll
                for (int i = 0; i < n; ++i) { const int send = up ? p[i] : p[i + n], keep = up ? p[i + n] : p[i]; p[i] = keep + __shfl_xor(send, st, 64); }
            }
            const float hsum = SU[ex[bt]] * xsc * (float)p[0];
            cf[bt] = gate * geluf_slow(hsum) * SV[ex[bt]];
        }
        float y[16];
#pragma unroll
        for (int j = 0; j < 16; ++j) y[j] = 0.f;
        float csum = wave_sum(cf[0] + cf[1]);
#pragma unroll
        for (int bt = 0; bt < 2; ++bt)
#pragma unroll
            for (int e0 = 0; e0 < 64; e0 += 16) {
                u32x4 r[16];
#pragma unroll
                for (int i = 0; i < 16; ++i) { const int e = __builtin_amdgcn_readlane(ex[bt], e0 + i); r[i] = *(const u32x4*)(V8 + (size_t)e * DM + lane * 16); }
#pragma unroll
                for (int i = 0; i < 16; ++i) { const float c = __builtin_bit_cast(float, __builtin_amdgcn_readlane(__builtin_bit_cast(int, cf[bt]), e0 + i));
#pragma unroll
                    for (int q = 0; q < 4; ++q)
#pragma unroll
                        for (int e = 0; e < 4; ++e) y[4 * q + e] += c * ub(r[i][q], e); }
            }
#pragma unroll
        for (int j = 0; j < 16; ++j) y[j] = y[j] - 128.f * csum + ALPHA * x[j];
        float sm = 0.f;
#pragma unroll
        for (int j = 0; j < 16; ++j) sm += y[j];
        const float mean = wave_sum(sm) * (1.f / DM);
        float qq = 0.f;
#pragma unroll
        for (int j = 0; j < 16; ++j) { const float d = y[j] - mean; qq += d * d; }
        const float rstd = rsqrtf(wave_sum(qq) * (1.f / DM) + LN_EPS);
        const float* gp = C.in[I_LN2G] + l * DM + lane * 16; const float* bp = C.in[I_LN2B] + l * DM + lane * 16;
#pragma unroll
        for (int i = 0; i < 4; ++i) { const f32x4 gg = *(const f32x4*)(gp + 4 * i), bb = *(const f32x4*)(bp + 4 * i);
#pragma unroll
            for (int e = 0; e < 4; ++e) y[4 * i + e] = (y[4 * i + e] - mean) * rstd * gg[e] + bb[e]; }
        float* dst = (l + 1 < DEPTH) ? (float*)(C.ws + WS_XA) + (size_t)t * DM : C.out + (size_t)t * DM;
#if DIAG
        if (l + 1 == DEPTH) { const float al = 1.f + diag_alpha(C);
#pragma unroll
            for (int j = 0; j < 16; ++j) y[j] *= al; }
#endif
#pragma unroll
        for (int i = 0; i < 4; ++i) *(f32x4*)(dst + lane * 16 + 4 * i) = (f32x4){y[4 * i], y[4 * i + 1], y[4 * i + 2], y[4 * i + 3]};
        if (l + 1 < DEPTH) {
            {
                float mx = 0.f;
#pragma unroll
                for (int j = 0; j < 16; ++j) mx = fmaxf(mx, fabsf(y[j]));
                mx = fmaxf(wave_max(mx), 1e-30f);
                const float isc = 127.f / mx;
                u32x4 o8;
#pragma unroll
                for (int q = 0; q < 4; ++q) { unsigned wd = 0u;
#pragma unroll
                    for (int e = 0; e < 4; ++e) wd |= ((unsigned)(int)rintf(y[4 * q + e] * isc) & 255u) << (8 * e);
                    o8[q] = wd; }
                *(u32x4*)(C.ws + WS_XB + (size_t)t * DM + lane * 16) = o8;
                if (lane == 0) ((float*)(C.ws + WS_XSA))[t] = mx * (1.f / 127.f);
            }
            const float* wf = (const float*)(C.ws + WS_W + (size_t)(l + 1) * W_LAYER + WO_WF);
            float* lsig = (float*)(C.ws + WS_MISC);
#pragma unroll
            for (int h = 0; h < 4; ++h) {
                float sd = 0.f;
#pragma unroll
                for (int i = 0; i < 4; ++i) { const f32x4 a = *(const f32x4*)(wf + h * DM + lane * 16 + 4 * i);
#pragma unroll
                    for (int e = 0; e < 4; ++e) sd += y[4 * i + e] * a[e]; }
                sd = wave_sum(sd);
                if (lane == 0) lsig[(size_t)t * 4 + h] = logsigmoidf_(sd + C.in[I_BFOX][(l + 1) * 4 + h]);
            }
        }
    }
}

struct FStoreBf16 { bf16_t* O; int ld;
    __device__ __forceinline__ void operator()(int row, int col, f32x4 v0, f32x4 v1, int) const {
        u32x4 o; o[0] = pk2(v0[0], v0[1]); o[1] = pk2(v0[2], v0[3]); o[2] = pk2(v1[0], v1[1]); o[3] = pk2(v1[2], v1[3]);
        *(u32x4*)(O + (size_t)row * ld + col) = o; } };
typedef int i32x4 __attribute__((ext_vector_type(4)));
__device__ __forceinline__ void i8_dequant(f32x4& v0, f32x4& v1, float sa, const float* cs) {
    sa *= (1.f / 127.f);
    const f32x4 c0 = *(const f32x4*)cs, c1 = *(const f32x4*)(cs + 4);
    const i32x4 i0 = __builtin_bit_cast(i32x4, v0), i1 = __builtin_bit_cast(i32x4, v1);
#pragma unroll
    for (int e = 0; e < 4; ++e) { v0[e] = (float)i0[e] * sa * c0[e]; v1[e] = (float)i1[e] * sa * c1[e]; }
}
struct FStoreBf16I8 { bf16_t* O; int ld; const float* rs; const float* cs;
    __device__ __forceinline__ void operator()(int row, int col, f32x4 v0, f32x4 v1, int) const {
        i8_dequant(v0, v1, rs[row], cs + col);
        u32x4 o; o[0] = pk2(v0[0], v0[1]); o[1] = pk2(v0[2], v0[3]); o[2] = pk2(v1[0], v1[1]); o[3] = pk2(v1[2], v1[3]);
        *(u32x4*)(O + (size_t)row * ld + col) = o; } };
struct FGateI8 { unsigned char* O; const float* bias; const float* rs; const float* cs;
    __device__ __forceinline__ void operator()(int row, int col, f32x4 v0, f32x4 v1, int) const {
        i8_dequant(v0, v1, rs[row], cs + col);
        const f32x4 b0 = *(const f32x4*)(bias + col), b1 = *(const f32x4*)(bias + col + 4);
        u32x2 o; unsigned w0 = 0u, w1 = 0u;
#pragma unroll
        for (int e = 0; e < 4; ++e) { w0 |= (unsigned)(int)rintf(255.f * sigmoidf_(v0[e] + b0[e])) << (8 * e); w1 |= (unsigned)(int)rintf(255.f * sigmoidf_(v1[e] + b1[e])) << (8 * e); }
        o[0] = w0; o[1] = w1;
        *(u32x2*)(O + (size_t)row * NG + col) = o; } };
struct FGate { bf16_t* O; const float* bias;
    __device__ __forceinline__ void operator()(int row, int col, f32x4 v0, f32x4 v1, int) const {
        const f32x4 b0 = *(const f32x4*)(bias + col), b1 = *(const f32x4*)(bias + col + 4);
        u32x4 o; o[0] = pk2(sigmoidf_(v0[0] + b0[0]), sigmoidf_(v0[1] + b0[1])); o[1] = pk2(sigmoidf_(v0[2] + b0[2]), sigmoidf_(v0[3] + b0[3]));
        o[2] = pk2(sigmoidf_(v1[0] + b1[0]), sigmoidf_(v1[1] + b1[1])); o[3] = pk2(sigmoidf_(v1[2] + b1[2]), sigmoidf_(v1[3] + b1[3]));
        *(u32x4*)(O + (size_t)row * NG + col) = o; } };
struct FMerge { const unsigned char* G; bf16_t* MG;
    __device__ __forceinline__ void operator()(int row, int col, f32x4 v0, f32x4 v1, int z) const {
        const u32x2 gr = *(const u32x2*)(G + (size_t)row * NG + z * DM + col);
        float r[8];
#pragma unroll
        for (int e = 0; e < 4; ++e) { r[e] = v0[e] * (float)((gr[0] >> (8 * e)) & 255u) * (1.f / 255.f); r[4 + e] = v1[e] * (float)((gr[1] >> (8 * e)) & 255u) * (1.f / 255.f); }
        bf16_t* p = MG + (size_t)row * DM + col;
        if (z > 0) { const u32x4 pr = *(const u32x4*)p;
#pragma unroll
            for (int e = 0; e < 4; ++e) { r[2 * e] += bf2f(pr[e] & 0xffffu); r[2 * e + 1] += bf2f(pr[e] >> 16); } }
        u32x4 o;
#pragma unroll
        for (int e = 0; e < 4; ++e) o[e] = pk2(r[2 * e], r[2 * e + 1]);
        *(u32x4*)p = o; } };
struct FResid { const float* X; bf16_t* Y;
    __device__ __forceinline__ void operator()(int row, int col, f32x4 v0, f32x4 v1, int) const {
        const f32x4 x0 = *(const f32x4*)(X + (size_t)row * DM + col), x1 = *(const f32x4*)(X + (size_t)row * DM + col + 4);
#if DIAG == 5 || DIAG == 6
        v0 = (f32x4){0.f, 0.f, 0.f, 0.f}; v1 = v0;
#endif
        u32x4 o; o[0] = cvtpk(x0[0] * ALPHA + v0[0], x0[1] * ALPHA + v0[1]); o[1] = cvtpk(x0[2] * ALPHA + v0[2], x0[3] * ALPHA + v0[3]);
        o[2] = cvtpk(x1[0] * ALPHA + v1[0], x1[1] * ALPHA + v1[1]); o[3] = cvtpk(x1[2] * ALPHA + v1[2], x1[3] * ALPHA + v1[3]);
        *(u32x4*)(Y + (size_t)row * DM + col) = o; } };

constexpr int PH_PER_LAYER = 12, N_PHASES = 1 + DEPTH * PH_PER_LAYER;
template <int SP> __device__ __forceinline__ void run_phase(const Ctx& C0, int l) {
    Ctx C = C0;
    asm volatile("" : "+v"(C.tid));
    C.ws = launder_ptr(C.ws); C.out = launder_ptr(C.out); l = (int)launder_u((unsigned)l);
    C.lane = C.tid & 63; C.wave = __builtin_amdgcn_readfirstlane(C.tid >> 6);
    unsigned char* wb = C.ws + WS_W + (size_t)l * W_LAYER;
    if constexpr (SP == -1) { p_conv_weights(C); }
    if constexpr (SP == 0) {
        if (l == 0) {
            for (int l2 = 0; l2 < DEPTH; ++l2) {
                unsigned char* wb2 = C.ws + WS_W + (size_t)l2 * W_LAYER; const unsigned* cm = (const unsigned*)(C.ws + WS_CMAX) + l2 * (NH + NG);
                tconv_i8_job(C, C.in[I_WIN] + (size_t)l2 * DM * NIN, NIN, DM, NH, wb2 + WO_WIN, cm);
                tconv_i8_job(C, C.in[I_WGATE] + (size_t)l2 * DM * NG, NG, DM, NG, wb2 + WO_WG, cm + NH);
            }
            p_rowpass0(C);
        }
    }
    if constexpr (SP == 1) {
        p_cumsum(C);
        __syncthreads();
        pg8::Gemm g{(const bf16_t*)(C.ws + WS_XB), (const bf16_t*)(wb + WO_WIN), DM, DM, DM, 0, 0};
        pg8::StaticOrder S; S.init(T, NH, C.G, C.bid);
        pg8::Epi8<FStoreBf16I8> E{{(bf16_t*)(C.ws + WS_H), NH, (const float*)(C.ws + WS_XSA), (const float*)(C.ws + WS_CMAX) + l * (NH + NG)}};
        pg8::gemm_phase<pg8::Epi8<FStoreBf16I8>, pg8::StaticOrder, true>(C.lds, g, S, E, C.tid);
    }
#if DIAG == 5
    if constexpr (SP == 2) { if (l == 0) { diag_ref_slice(C, C.in[I_WIN], NIN, DIAG_N0, nullptr); } }
    if constexpr (SP == 3) { if (l == 0) diag_cmp(C, (const bf16_t*)(C.ws + WS_H) + DIAG_N0, NH, (const bf16_t*)(C.ws + WS_XA), 64, 64); }
#endif
#if DIAG == 6
    if constexpr (SP == 5) { if (l == 0) diag_ref_slice(C, C.in[I_WGATE], NG, DIAG_N0, C.in[I_BGATE]); }
    if constexpr (SP == 6) { if (l == 0) diag_cmp_u8(C, C.ws + WS_G + DIAG_N0, NG, (const bf16_t*)(C.ws + WS_XA), 64, 64); }
#endif
    if constexpr (SP == 2) { p_knorm(C, l); if (l != HG_NAIVE_L) hgrn_b1(C, l); }
#if MIX_NAIVE
    if constexpr (SP == 3) { if (l != HG_NAIVE_L) hgrn_b2(C); mix_pool_naive(C, l); mix_gmlp_naive(C, l); }
#else
    if constexpr (SP == 3) { if (l != HG_NAIVE_L) hgrn_b2(C); mix_pool(C, l); mix_gmlp(C, l);
        if (DIAG == 2) mix_pool_naive(C, l); if (DIAG == 3) mix_gmlp_naive(C, l); }
#endif
#if DIAG == 1
    if constexpr (SP == 4) { hgrn_b3(C, l); { mix_hgrn_naive(C, l); __syncthreads(); } mix_fox(C, l); }
    if constexpr (SP == 5) { if (l == DIAG_LAYER) diag_cmp(C, (const bf16_t*)(C.ws + (DIAG_LAYER == 0 ? WS_XA : WS_TABU)) + 512, NBR, (const bf16_t*)(C.ws + WS_BR) + 512, NBR, 512); }
#elif DIAG == 2 || DIAG == 3
    if constexpr (SP == 4) { hgrn_b3(C, l); mix_fox(C, l); if (l == DIAG_LAYER) diag_cmp(C, (const bf16_t*)(C.ws + (DIAG_LAYER == 0 ? WS_XA : WS_TABU)) + (DIAG == 2 ? 0 : 1024), NBR, (const bf16_t*)(C.ws + WS_BR) + (DIAG == 2 ? 0 : 1024), NBR, 512); }
#else
    if constexpr (SP == 4) { if (l != HG_NAIVE_L) hgrn_b3(C, l); else { mix_hgrn_naive(C, l); __syncthreads(); } mix_fox(C, l); }
#endif
    if constexpr (SP == 5) {
        pg8::Gemm g{(const bf16_t*)(C.ws + WS_XB), (const bf16_t*)(wb + WO_WG), DM, DM, DM, 0, 0};
        pg8::StaticOrder S; S.init(T, NG, C.G, C.bid);
        pg8::Epi8<FGateI8> E{{C.ws + WS_G, C.in[I_BGATE] + l * NG, (const float*)(C.ws + WS_XSA), (const float*)(C.ws + WS_CMAX) + l * (NH + NG) + NH}};
        pg8::gemm_phase<pg8::Epi8<FGateI8>, pg8::StaticOrder, true>(C.lds, g, S, E, C.tid);
    }
    if constexpr (SP == 6) {
        pg8::Gemm g{(const bf16_t*)(C.ws + WS_BR), (const bf16_t*)(wb + WO_WBR), NBR, BW, BW, (size_t)BW, (size_t)DM * BW};
        pg8::ZOrder S; S.init(T, DM, 4, C.G, C.vcu);
        pg8::Epi8<FMerge> E{{C.ws + WS_G, (bf16_t*)(C.ws + WS_XB)}};
        pg8::gemm_phase(C.lds, g, S, E, C.tid);
    }
    if constexpr (SP == 7) {
        const float* xin = (l == 0) ? C.in[I_X] : (const float*)(C.ws + WS_XA);
        pg8::Gemm g{(const bf16_t*)(C.ws + WS_XB), (const bf16_t*)(wb + WO_WOUT), DM, DM, DM, 0, 0};
        pg8::StaticOrder S; S.init(T, DM, C.G, C.bid);
        pg8::Epi8<FResid> E{{xin, (bf16_t*)(C.ws + WS_XC)}};
        pg8::gemm_phase(C.lds, g, S, E, C.tid);
    }
    if constexpr (SP == 8) { p_ln1(C, l); p_conv_tables(C, l); }
    if constexpr (SP == 9) {
        pg8::Gemm g{(const bf16_t*)(C.ws + WS_X1B), (const bf16_t*)(wb + WO_WQ), DM, DM, DM, 0, 0};
        pg8::StaticOrder S; S.init(T, NQ, C.G, C.bid);
        pg8::Epi8<FStoreBf16> E{{(bf16_t*)(C.ws + WS_Q), NQ}};
        pg8::gemm_phase(C.lds, g, S, E, C.tid);
    }
#if TOPK_NAIVE
    if constexpr (SP == 10) p_topk_naive(C, l);
#else
    if constexpr (SP == 10) p_topk(C, l);
#endif
    if constexpr (SP == 11) p_gather(C, l);
}
__device__ __forceinline__ void make_ctx(Ctx& C, const Args& args, unsigned char* lds_raw) {
    C.lds = (LAS unsigned char*)lds_raw; C.ws = args.ws; C.in = args.in; C.out = args.out;
    C.tid = threadIdx.x; C.lane = C.tid & 63; C.wave = __builtin_amdgcn_readfirstlane(C.tid >> 6);
    C.G = gridDim.x; C.bid = blockIdx.x; C.vcu = (C.G % 8 == 0) ? (C.bid % 8) * (C.G / 8) + C.bid / 8 : C.bid;
}
#if !MK_ONE_LAUNCH
template <int SP> __global__ void __launch_bounds__(512, 2) mk_phase(Args args) {
    extern __shared__ __attribute__((aligned(16))) unsigned char lds_raw[];
    Ctx C; make_ctx(C, args, lds_raw);
    run_phase<SP>(C, args.ph_lo);
}
#endif

#define GRID_BAR() xcd_barrier((unsigned*)(args.ws + WS_CTL) + 1024, (volatile LAS unsigned*)((LAS unsigned char*)lds_raw + LDSCTL_OFF + 32))
__global__ void __launch_bounds__(512, 2) mk_fwd(Args args) {
    extern __shared__ __attribute__((aligned(16))) unsigned char lds_raw[];
    Ctx C; make_ctx(C, args, lds_raw);
    { volatile LAS unsigned* misc = (volatile LAS unsigned*)(C.lds + LDSCTL_OFF); if (C.tid < 64) misc[C.tid] = 0u; }
    __syncthreads();
    xcd_barrier_post((unsigned*)(args.ws + WS_CTL) + 1024);
    run_phase<-1>(C, 0); GRID_BAR();
#pragma unroll 1
    for (int l = 0; l < DEPTH; ++l) {
        if (l == 0) { run_phase<0>(C, l); GRID_BAR(); }
        run_phase<1>(C, l); GRID_BAR();
        run_phase<2>(C, l); GRID_BAR();
        run_phase<3>(C, l); GRID_BAR();
        run_phase<4>(C, l); GRID_BAR();
        run_phase<5>(C, l); GRID_BAR();
        run_phase<6>(C, l); GRID_BAR();
        run_phase<7>(C, l); GRID_BAR();
        run_phase<8>(C, l); GRID_BAR();
        run_phase<9>(C, l); GRID_BAR();
        run_phase<10>(C, l); GRID_BAR();
        run_phase<11>(C, l); if (l + 1 < DEPTH) GRID_BAR();
    }
}

#if !MK_ONE_LAUNCH
template <int SP> static void launch_phase(const Args& a, int grid, hipStream_t stream) {
    static bool attr_done = false;
    if (!attr_done) { (void)hipFuncSetAttribute((const void*)mk_phase<SP>, hipFuncAttributeMaxDynamicSharedMemorySize, LDS_BYTES); attr_done = true; }
    hipLaunchKernelGGL(mk_phase<SP>, dim3(grid), dim3(512), LDS_BYTES, stream, a);
}
#endif
extern "C" void kernel_launch(void* const* d_in, const int* in_sizes, int n_in, void* d_out, int out_size, void* d_ws, size_t ws_size, hipStream_t stream) {
    static int grid = 0;
    if (grid == 0) {
        if (n_in != NIN_PTRS || out_size != T * DM || ws_size < WS_END) { fprintf(stderr, "kernel_launch: unexpected shapes n_in %d out %d ws %zu\n", n_in, out_size, ws_size); grid = -1; return; }
        int dev = 0, cus = 0;
        if (hipGetDevice(&dev) != hipSuccess || hipDeviceGetAttribute(&cus, hipDeviceAttributeMultiprocessorCount, dev) != hipSuccess) { grid = -1; return; }
        grid = cus;
    }
    if (grid < 0) return;
    (void)hipMemsetAsync((char*)d_ws + WS_CTL, 0, CTL_ZERO_BYTES, stream);
    Args a{};
    for (int i = 0; i < NIN_PTRS; ++i) a.in[i] = (const float*)d_in[i];
    a.out = (float*)d_out; a.ws = (unsigned char*)d_ws; a.bar_slot = 0; a.pad = 0; a.ph_hi = 0;
#if MK_ONE_LAUNCH
    static bool attr_done = false;
    if (!attr_done) { (void)hipFuncSetAttribute((const void*)mk_fwd, hipFuncAttributeMaxDynamicSharedMemorySize, LDS_BYTES); attr_done = true; }
    hipLaunchKernelGGL(mk_fwd, dim3(grid), dim3(512), LDS_BYTES, stream, a);
    return;
#endif
#if !MK_ONE_LAUNCH
    a.ph_lo = 0; launch_phase<-1>(a, grid, stream);
    for (int l = 0; l < DEPTH; ++l) {
        a.ph_lo = l;
        launch_phase<0>(a, grid, stream); launch_phase<1>(a, grid, stream); launch_phase<2>(a, grid, stream); launch_phase<3>(a, grid, stream); launch_phase<4>(a, grid, stream);
        launch_phase<5>(a, grid, stream); launch_phase<6>(a, grid, stream); launch_phase<7>(a, grid, stream); launch_phase<8>(a, grid, stream); launch_phase<9>(a, grid, stream); launch_phase<10>(a, grid, stream); launch_phase<11>(a, grid, stream);
    }
#endif
}
```

```cpp
#include <hip/hip_runtime.h>
#include <cstdio>
#include <cstdint>

#ifndef DIAG
#define DIAG 0
#endif
#ifndef DIAG_LO
#define DIAG_LO 0
#endif
#ifndef DIAG_HI
#define DIAG_HI 64
#endif
#ifndef DIAG_MOD
#define DIAG_MOD 64
#endif
#ifndef TOPK_NAIVE
#define TOPK_NAIVE 0
#endif
#ifndef MIX_NAIVE
#define MIX_NAIVE 0
#endif
#ifndef DIAG_N0
#define DIAG_N0 4096
#endif
#ifndef FOX_NAIVE
#define FOX_NAIVE 0
#endif
#ifndef HG_NAIVE_L
#define HG_NAIVE_L 99
#endif
#ifndef DIAG_LAYER
#define DIAG_LAYER 0
#endif
#ifndef MK_ONE_LAUNCH
#define MK_ONE_LAUNCH 1
#endif

#define LAS __attribute__((address_space(3)))
#define GAS __attribute__((address_space(1)))
typedef unsigned short bf16_t;
typedef short bf16x8 __attribute__((ext_vector_type(8)));
typedef float f32x4 __attribute__((ext_vector_type(4)));
typedef float f32x2 __attribute__((ext_vector_type(2)));
typedef unsigned u32x4 __attribute__((ext_vector_type(4)));
typedef unsigned u32x2 __attribute__((ext_vector_type(2)));

constexpr int DM = 1024, BATCH = 2, SEQ = 8192, DEPTH = 2, T = BATCH * SEQ;
constexpr int BW = 512, NIN = 5124, NH = 5120, NG = 4096, NBR = 2048, NQ = 2048;
constexpr int NEXP = 16384, TOPK = 16, PH = 8;
constexpr float ALPHA = 1.4142135623730951f;
constexpr float LN_EPS = 1e-5f, RMS_EPS = 1e-6f;
constexpr int HC_P = 0, HC_HQ = 512, HC_HF = 1024, HC_HI = 1536, HC_HG = 2048, HC_GU = 2560, HC_GV = 3072, HC_FQ = 3584, HC_FK = 4096, HC_FV = 4608;

constexpr size_t MiB = 1u << 20;
constexpr size_t WS_CTL = 0, CTL_ZERO_BYTES = 160 * 1024;
constexpr size_t WS_CMAX = 64 * 1024;
constexpr size_t WS_MISC = 512 * 1024;
constexpr size_t WS_CUM = 768 * 1024;
constexpr size_t WS_W = 1 * MiB;
constexpr size_t W_LAYER = 30 * MiB;
constexpr size_t WO_WIN = 0, WO_WG = 10 * MiB, WO_WBR = 18 * MiB, WO_WOUT = 22 * MiB, WO_WQ = 24 * MiB, WO_KEYS = 28 * MiB, WO_WF = 28 * MiB + 512 * 1024, WO_POOLW = 28 * MiB + 768 * 1024, WO_GWS = 29 * MiB, WO_CS = 29 * MiB + 512 * 1024;
constexpr size_t WS_TABU = 64 * MiB, WS_TABV = 96 * MiB;
constexpr size_t WS_XA = 128 * MiB;
constexpr size_t WS_XB = 192 * MiB;
constexpr size_t WS_X1B = 224 * MiB;
constexpr size_t WS_H = 256 * MiB;
constexpr size_t WS_ST = 416 * MiB;
constexpr size_t WS_BR = 448 * MiB;
constexpr size_t WS_G = 256 * MiB;
constexpr size_t WS_MGF = 384 * MiB;
constexpr size_t WS_XC = 256 * MiB;
constexpr size_t WS_Q = 320 * MiB;
constexpr size_t WS_EIDX = 384 * MiB, WS_EGATE = 392 * MiB;
constexpr size_t WS_XSA = 256 * 1024;
constexpr size_t WS_END = 512 * MiB;

__device__ __forceinline__ float bf2f(unsigned u) { return __builtin_bit_cast(float, u << 16); }
__device__ __forceinline__ unsigned f2bf(float f) { unsigned u = __builtin_bit_cast(unsigned, f); return (u + 0x7fffu + ((u >> 16) & 1u)) >> 16; }
typedef __bf16 bf16x2_t __attribute__((ext_vector_type(2)));
__device__ __forceinline__ unsigned cvtpk(float lo, float hi) { f32x2 v = {lo, hi}; bf16x2_t b = __builtin_convertvector(v, bf16x2_t); return __builtin_bit_cast(unsigned, b); }
__device__ __forceinline__ unsigned pk2(float lo, float hi) { return cvtpk(lo, hi); }
__device__ __forceinline__ float wave_sum(float v) {
#pragma unroll
    for (int o = 32; o > 0; o >>= 1) v += __shfl_xor(v, o, 64);
    return v;
}
__device__ __forceinline__ float sigmoidf_(float x) { return __builtin_amdgcn_rcpf(1.f + __builtin_amdgcn_exp2f(-1.4426950408889634f * x)); }
__device__ __forceinline__ float siluf_(float x) { return x * __builtin_amdgcn_rcpf(1.f + __builtin_amdgcn_exp2f(-1.4426950408889634f * x)); }
__device__ __forceinline__ float geluf_slow(float x) { const float u = 0.7978845608028654f * (x + 0.044715f * x * x * x); return 0.5f * x * (1.f + tanhf(u)); }
__device__ __forceinline__ float geluf_(float x) { const float u2 = -2.302208198f * (x + 0.044715f * x * x * x); return x * __builtin_amdgcn_rcpf(1.f + __builtin_amdgcn_exp2f(u2)); }
__device__ __forceinline__ float logsigmoidf_(float z) { return fminf(z, 0.f) - log1pf(__expf(-fabsf(z))); }

__device__ __forceinline__ unsigned launder_u(unsigned x) { asm volatile("" : "+v"(x)); return __builtin_amdgcn_readfirstlane(x); }
template <class P> __device__ __forceinline__ P launder_ptr(P p) {
    const unsigned lo = launder_u((unsigned)(uintptr_t)p), hi = launder_u((unsigned)((uintptr_t)p >> 32));
    return (P)(((uintptr_t)hi << 32) | lo);
}

namespace pg8 {
constexpr int BM = 256, BK = 64, HALF = 128, HTB = HALF * BK * 2, STAGE_BYTES = 8 * HTB, NXCD = 8, WGM = 8;
__host__ __device__ __forceinline__ int lds_byte(int r, int c) { const int st = (r >> 4) * 2 + (c >> 5), rr = r & 15, cc = c & 31, ob = rr * 64 + cc * 2; return st * 1024 + (ob ^ (((ob >> 9) & 1) << 5)); }
__host__ __device__ __forceinline__ void stage_rc(int b, int& R, int& C) { const int st = b / 1024, sb = b % 1024, swz = sb ^ (((sb >> 9) & 1) << 5); R = (st >> 1) * 16 + swz / 64; C = (st & 1) * 32 + (swz % 64) / 2; }
__host__ __device__ __forceinline__ int perm32(int rho) { const int n = rho >> 4, i = rho & 15; return 8 * (i >> 2) + 4 * n + (i & 3); }

struct Unit { int pm, pn, z; };
struct Gemm { const bf16_t* A; const bf16_t* Bt; int lda, ldb, K; size_t zA, zB; };

struct StaticOrder {
    int nM, nN, nwg, G, c;
    __device__ void init(int M, int N, int G_, int c_) { nM = M / BM; nN = N / BM; nwg = nM * nN; G = G_; c = c_; }
    __device__ bool next(int i, Unit& u) const {
        const long L = (long)i * G + c; if (L >= nwg) return false;
        int wgid = (int)L; { const int q = nwg / NXCD, r = nwg % NXCD, xcd = wgid % NXCD, off = wgid / NXCD; wgid = (xcd < r ? xcd * (q + 1) : r * (q + 1) + (xcd - r) * q) + off; }
        const int nig = WGM * nN, gid = wgid / nig, fm = gid * WGM, gsz = (nM - fm) < WGM ? (nM - fm) : WGM;
        u.pm = fm + ((wgid % nig) % gsz); u.pn = (wgid % nig) / gsz; u.z = 0; return true;
    }
};
struct ZOrder {
    int nM, nN, nZ, ntile, G, c;
    __device__ void init(int M, int N, int Z, int G_, int c_) { nM = M / BM; nN = N / BM; nZ = Z; ntile = nM * nN; G = G_; c = c_; }
    __device__ bool next(int i, Unit& u) const {
        const long L = (long)(i / nZ) * G + c; if (L >= ntile) return false;
        u.pm = (int)L / nN; u.pn = (int)L % nN; u.z = i % nZ; return true;
    }
};

template <class F> struct Epi8 {
    static constexpr bool PERM = true;
    F f;
    __device__ __forceinline__ void operator()(const f32x4 (&acc)[2][2][4][2], const Unit& u, int wr, int wc, int fr, int fq) const {
        const int row0 = u.pm * BM + wr * 64 + fr, col0 = u.pn * BM + wc * 32 + 8 * fq;
#pragma unroll
        for (int ai = 0; ai < 2; ++ai)
#pragma unroll
            for (int m = 0; m < 4; ++m)
#pragma unroll
                for (int bj = 0; bj < 2; ++bj) f(row0 + ai * HALF + m * 16, col0 + bj * HALF, acc[ai][bj][m][0], acc[ai][bj][m][1], u.z);
    }
};
template <class F> struct Epi4 {
    static constexpr bool PERM = false;
    F f;
    __device__ __forceinline__ void operator()(const f32x4 (&acc)[2][2][4][2], const Unit& u, int wr, int wc, int fr, int fq) const {
        const int row0 = u.pm * BM + wr * 64 + fr, col0 = u.pn * BM + wc * 32 + 4 * fq;
#pragma unroll
        for (int ai = 0; ai < 2; ++ai)
#pragma unroll
            for (int m = 0; m < 4; ++m)
#pragma unroll
                for (int bj = 0; bj < 2; ++bj)
#pragma unroll
                    for (int n = 0; n < 2; ++n) f(row0 + ai * HALF + m * 16, col0 + bj * HALF + n * 16, acc[ai][bj][m][n], u.z);
    }
};

typedef int i32x4 __attribute__((ext_vector_type(4)));
template <class Epi, class Sched, bool I8 = false, bool ALIGN_EPI = true>
__device__ __forceinline__ void gemm_phase(LAS unsigned char* lds, const Gemm g, const Sched& S, const Epi& E, const int tid) {
    constexpr int ES = I8 ? 1 : 2;
    const int wid = __builtin_amdgcn_readfirstlane(tid >> 6), lane = tid & 63, wr = wid >> 2, wc = wid & 3, fr = lane & 15, fq = lane >> 4;
    const int K = g.K, nt = K * ES / 128;
    unsigned voffA[2], voffB[2];
#pragma unroll
    for (int i = 0; i < 2; ++i) { int R, C; stage_rc(tid * 16 + i * 8192, R, C); const int Rb = Epi::PERM ? ((R & ~31) + perm32(R & 31)) : R;
        voffA[i] = (unsigned)(R * g.lda * ES + C * 2); voffB[i] = (unsigned)(Rb * g.ldb * ES + C * 2); }
    const size_t kstep = (size_t)(BK * 2);
    const size_t hstepA = (size_t)HALF * g.lda * ES, hstepB = (size_t)HALF * g.ldb * ES;
    const size_t tstepA = 2 * hstepA, tstepB = 2 * hstepB;
    const unsigned ldsw = (unsigned)wid * 1024u;
    const int aoff = lds_byte(wr * 64 + fr, fq * 8), boff = lds_byte(wc * 32 + fr, fq * 8);
#define PG8_SA(b, h) (((b) * 2 + (h)) * HTB)
#define PG8_SB(b, h) ((4 + (b) * 2 + (h)) * HTB)
#define PG8_STAGE(bufoff, gbase, voff) do { _Pragma("unroll") for (int _i = 0; _i < 2; ++_i) \
        __builtin_amdgcn_global_load_lds((const unsigned*)((const char*)(gbase) + (voff)[_i]), (LAS unsigned*)(lds + (bufoff) + ldsw + _i * 8192), 16, 0, 0); } while (0)
#define PG8_LDA(dst, b, h) do { _Pragma("unroll") for (int m = 0; m < 4; ++m) _Pragma("unroll") for (int k = 0; k < 2; ++k) dst[m][k] = *(const LAS bf16x8*)(lds + PG8_SA(b, h) + aoff + m * 2048 + k * 1024); } while (0)
#define PG8_LDB(dst, b, h) do { _Pragma("unroll") for (int n = 0; n < 2; ++n) _Pragma("unroll") for (int k = 0; k < 2; ++k) dst[n][k] = *(const LAS bf16x8*)(lds + PG8_SB(b, h) + boff + n * 2048 + k * 1024); } while (0)
#define PG8_MMA(ai, bj, At, Bt) do { __builtin_amdgcn_s_setprio(1); _Pragma("unroll") for (int m = 0; m < 4; ++m) _Pragma("unroll") for (int n = 0; n < 2; ++n) _Pragma("unroll") for (int k = 0; k < 2; ++k) { \
        if constexpr (I8) acc[ai][bj][m][n] = __builtin_bit_cast(f32x4, __builtin_amdgcn_mfma_i32_16x16x64_i8(__builtin_bit_cast(i32x4, Bt[n][k]), __builtin_bit_cast(i32x4, At[m][k]), __builtin_bit_cast(i32x4, acc[ai][bj][m][n]), 0, 0, 0)); \
        else acc[ai][bj][m][n] = __builtin_amdgcn_mfma_f32_16x16x32_bf16(Bt[n][k], At[m][k], acc[ai][bj][m][n], 0, 0, 0); } __builtin_amdgcn_s_setprio(0); } while (0)
#define PG8_WAIT_V(n) asm volatile("s_waitcnt vmcnt(" #n ")" ::: "memory")
#define PG8_WAIT_L(n) asm volatile("s_waitcnt lgkmcnt(" #n ")" ::: "memory")
#define PG8_BAR __builtin_amdgcn_s_barrier()
#define PG8_SCHED __builtin_amdgcn_sched_barrier(0)
    Unit cur, nxt; int ui = 0;
    if (!S.next(0, cur)) return;
    f32x4 acc[2][2][4][2];
#pragma unroll
    for (int a = 0; a < 2; ++a)
#pragma unroll
        for (int b = 0; b < 2; ++b)
#pragma unroll
            for (int m = 0; m < 4; ++m)
#pragma unroll
                for (int n = 0; n < 2; ++n) acc[a][b][m][n] = (f32x4){0.f, 0.f, 0.f, 0.f};
    bf16x8 At[4][2], B0[2][2], B1[2][2];
    const char* cA = (const char*)g.A + (size_t)cur.z * g.zA * ES + (size_t)cur.pm * tstepA; const char* cB = (const char*)g.Bt + (size_t)cur.z * g.zB * ES + (size_t)cur.pn * tstepB;
    PG8_STAGE(PG8_SB(0, 0), cB, voffB); PG8_STAGE(PG8_SB(0, 1), cB + hstepB, voffB); PG8_STAGE(PG8_SA(0, 0), cA, voffA); PG8_STAGE(PG8_SA(0, 1), cA + hstepA, voffA);
    if (wr == 1) PG8_BAR;
    PG8_WAIT_V(2); PG8_BAR;
    PG8_STAGE(PG8_SB(1, 0), cB + kstep, voffB); PG8_STAGE(PG8_SA(1, 0), cA + kstep, voffA); PG8_STAGE(PG8_SB(1, 1), cB + hstepB + kstep, voffB);
    PG8_WAIT_V(6); PG8_BAR;
    for (;;) {
        const bool has_next = S.next(ui + 1, nxt);
        const char* nA = has_next ? (const char*)g.A + (size_t)nxt.z * g.zA * ES + (size_t)nxt.pm * tstepA : cA;
        const char* nB = has_next ? (const char*)g.Bt + (size_t)nxt.z * g.zB * ES + (size_t)nxt.pn * tstepB : cB;
        for (int t = 0; t < nt; t += 2) {
            const bool last = (t == nt - 2);
            const char* a1 = cA + (size_t)(t + 1) * kstep;
            const char* a2 = last ? nA : cA + (size_t)(t + 2) * kstep; const char* b2 = last ? nB : cB + (size_t)(t + 2) * kstep;
            const char* a3 = a2 + kstep; const char* b3 = b2 + kstep;
            PG8_LDB(B0, 0, 0); PG8_LDB(B1, 0, 1); PG8_SCHED; PG8_LDA(At, 0, 0); PG8_STAGE(PG8_SA(1, 1), a1 + hstepA, voffA);
            PG8_WAIT_V(8); PG8_WAIT_L(0); PG8_BAR; PG8_MMA(0, 0, At, B0); PG8_MMA(0, 1, At, B1); PG8_BAR; PG8_SCHED;
            PG8_LDA(At, 0, 1); PG8_STAGE(PG8_SB(0, 0), b2, voffB); PG8_STAGE(PG8_SB(0, 1), b2 + hstepB, voffB); PG8_STAGE(PG8_SA(0, 0), a2, voffA);
            PG8_WAIT_V(8); PG8_WAIT_L(0); PG8_BAR; PG8_MMA(1, 0, At, B0); PG8_MMA(1, 1, At, B1); PG8_BAR; PG8_SCHED;
            PG8_LDB(B0, 1, 0); PG8_LDB(B1, 1, 1); PG8_SCHED; PG8_LDA(At, 1, 0); PG8_STAGE(PG8_SA(0, 1), a2 + hstepA, voffA);
            PG8_WAIT_V(8); PG8_WAIT_L(0); PG8_BAR; PG8_MMA(0, 0, At, B0); PG8_MMA(0, 1, At, B1); PG8_BAR; PG8_SCHED;
            PG8_LDA(At, 1, 1); PG8_STAGE(PG8_SB(1, 0), b3, voffB); PG8_STAGE(PG8_SB(1, 1), b3 + hstepB, voffB); PG8_STAGE(PG8_SA(1, 0), a3, voffA);
            PG8_WAIT_V(8); PG8_WAIT_L(0); PG8_BAR; PG8_MMA(1, 0, At, B0); PG8_MMA(1, 1, At, B1); PG8_BAR; PG8_SCHED;
        }
        if constexpr (ALIGN_EPI) { if (wr == 0) PG8_BAR; }
        E(acc, cur, wr, wc, fr, fq);
        if (!has_next) break;
#pragma unroll
        for (int a = 0; a < 2; ++a)
#pragma unroll
            for (int b = 0; b < 2; ++b)
#pragma unroll
                for (int m = 0; m < 4; ++m)
#pragma unroll
                    for (int n = 0; n < 2; ++n) acc[a][b][m][n] = (f32x4){0.f, 0.f, 0.f, 0.f};
        cur = nxt; cA = nA; cB = nB; ++ui;
        if constexpr (ALIGN_EPI) { if (wr == 1) PG8_BAR; }
    }
    PG8_WAIT_V(0);
    if constexpr (!ALIGN_EPI) { if (wr == 0) PG8_BAR; }
    PG8_BAR;
#undef PG8_SA
#undef PG8_SB
#undef PG8_STAGE
#undef PG8_LDA
#undef PG8_LDB
#undef PG8_MMA
#undef PG8_WAIT_V
#undef PG8_WAIT_L
#undef PG8_BAR
#undef PG8_SCHED
}
}

#define XB_TMO      128
#define XB_XCNT(j)  (256  + 64 * (j))
#define XB_XSUB(j)  (1280 + 64 * (j))
#define XB_XGEN(j)  (2304 + 64 * (j))
#define XB_TOP      3328
#define XB_TOPGEN   3392
#define XCD_BAR_WORDS 3456
#define XB_SPIN_CAP (1u << 22)
__device__ __forceinline__ unsigned xb_ld(unsigned* p)              { return __hip_atomic_load(p, __ATOMIC_RELAXED, __HIP_MEMORY_SCOPE_AGENT); }
__device__ __forceinline__ unsigned xb_add(unsigned* p, unsigned v) { return __hip_atomic_fetch_add(p, v, __ATOMIC_RELAXED, __HIP_MEMORY_SCOPE_AGENT); }
__device__ __forceinline__ unsigned xb_xcc_id() { return (unsigned)__builtin_amdgcn_s_getreg((3 << 11) | 20) & 0xFu; }
#define XB_SPIN(cond, bar) do { unsigned _sp = 0; while (cond) { __builtin_amdgcn_s_sleep(1); \
    if ((++_sp & 255u) == 0u) { if (xb_ld(&(bar)[XB_TMO])) break; if (_sp > XB_SPIN_CAP) { atomicAdd(&(bar)[XB_TMO], 1u); break; } } } } while (0)
__device__ __forceinline__ void xcd_barrier_post(unsigned* bar) {
    if (threadIdx.x == 0) (void)xb_add(&bar[XB_XCNT(xb_xcc_id())], 1u);
}
__device__ __forceinline__ void xcd_barrier_complete(unsigned* bar, unsigned x, unsigned& nloc, unsigned& nx) {
    const unsigned G = gridDim.x * gridDim.y * gridDim.z;
    unsigned sum, cnt, mine, sp = 0u;
    for (;;) {
        sum = 0u; cnt = 0u; mine = 0u;
#pragma unroll
        for (unsigned j = 0; j < 16; ++j) { const unsigned c = xb_ld(&bar[XB_XCNT(j)]); sum += c; cnt += (c > 0u) ? 1u : 0u; mine = (j == x) ? c : mine; }
        if (sum == G) break;
        __builtin_amdgcn_s_sleep(1);
        if ((++sp & 255u) == 0u) { if (xb_ld(&bar[XB_TMO])) break; if (sp > XB_SPIN_CAP) { atomicAdd(&bar[XB_TMO], 1u); break; } }
    }
    nloc = mine > 0u ? mine : 1u; nx = cnt > 0u ? cnt : 1u;
}
__device__ __noinline__ void xcd_barrier_leader(unsigned* bar, volatile LAS unsigned* st) {
    const unsigned x = xb_xcc_id();
    __builtin_amdgcn_s_waitcnt(0);
    unsigned nloc = st[0], nx = st[1];
    if (nloc == 0u) { xcd_barrier_complete(bar, x, nloc, nx); st[0] = nloc; st[1] = nx; }
    const unsigned old = xb_add(&bar[XB_XSUB(x)], 1u);
    const unsigned gen = old / nloc;
    if (old + 1u == (gen + 1u) * nloc) {
        __builtin_amdgcn_fence(__ATOMIC_RELEASE, "agent");
        asm volatile("s_waitcnt vmcnt(0)" ::: "memory");
        const unsigned og = xb_add(&bar[XB_TOP], 1u);
        const unsigned tg = og / nx;
        if (og + 1u == (tg + 1u) * nx) xb_add(&bar[XB_TOPGEN], 1u);
        else XB_SPIN(xb_ld(&bar[XB_TOPGEN]) == tg, bar);
        __builtin_amdgcn_fence(__ATOMIC_ACQUIRE, "agent");
        xb_add(&bar[XB_XGEN(x)], 1u);
        asm volatile("s_waitcnt vmcnt(0)" ::: "memory");
    } else {
        XB_SPIN(xb_ld(&bar[XB_XGEN(x)]) == gen, bar);
        __builtin_amdgcn_fence(__ATOMIC_ACQUIRE, "agent");
        asm volatile("s_waitcnt vmcnt(0)" ::: "memory");
    }
}
__device__ __forceinline__ void xcd_barrier(unsigned* bar, volatile LAS unsigned* st) {
    asm volatile("s_waitcnt vmcnt(0)" ::: "memory");
    __syncthreads();
    if (threadIdx.x == 0) xcd_barrier_leader(bar, st);
    __syncthreads();
}

constexpr int NIN_PTRS = 23;
struct Args { const float* in[NIN_PTRS]; float* out; unsigned char* ws; int ph_lo, ph_hi, bar_slot, pad; };
enum { I_X = 0, I_WIN, I_BFOX, I_POOLW, I_POOLS, I_LBL, I_HNG, I_GLNG, I_GLNB, I_GWS, I_GBS, I_WGATE, I_BGATE, I_WBR, I_WOUT, I_LN1G, I_LN1B, I_WQ, I_KEYS, I_PU, I_PV, I_LN2G, I_LN2B };

constexpr int LDS_BYTES = 147456;
constexpr int LDSCTL_OFF = 143360;

struct Ctx {
    LAS unsigned char* lds;
    unsigned char* ws;
    const float* const* in;
    float* out;
    int tid, lane, wave, G, bid, vcu;
};

__device__ __forceinline__ void tconv_job(const Ctx& C, const float* src, int ld_src, int K, int N, bf16_t* dst) {
    LAS float* tile = (LAS float*)C.lds;
    const int nk = K / 64, nn = N / 64, ntiles = nk * nn;
    for (int tl = C.bid; tl < ntiles; tl += C.G) {
        const int k0 = (tl / nn) * 64, n0 = (tl % nn) * 64;
#pragma unroll
        for (int p = 0; p < 2; ++p) {
            const int kr = (C.tid >> 4) + p * 32, nc = (C.tid & 15) * 4;
            const f32x4 v = *(const f32x4*)(src + (size_t)(k0 + kr) * ld_src + n0 + nc);
            tile[kr * 65 + nc + 0] = v[0]; tile[kr * 65 + nc + 1] = v[1]; tile[kr * 65 + nc + 2] = v[2]; tile[kr * 65 + nc + 3] = v[3];
        }
        __syncthreads();
        {
            const int n = C.tid >> 3, k8 = (C.tid & 7) * 8;
            u32x4 o;
#pragma unroll
            for (int j = 0; j < 4; ++j) o[j] = pk2(tile[(k8 + 2 * j) * 65 + n], tile[(k8 + 2 * j + 1) * 65 + n]);
            *(u32x4*)(dst + (size_t)(n0 + n) * K + k0 + k8) = o;
        }
        __syncthreads();
    }
}
__device__ __forceinline__ void colmax_job(const Ctx& C, const float* src, int ld_src, int K, int N, unsigned* cmax) {
    LAS float* red = (LAS float*)C.lds;
    const int nk = K / 64, nn = N / 64, ntiles = nk * nn;
    for (int tl = C.bid; tl < ntiles; tl += C.G) {
        const int k0 = (tl / nn) * 64, n0 = (tl % nn) * 64;
        float mx[4] = {0.f, 0.f, 0.f, 0.f};
#pragma unroll
        for (int p = 0; p < 2; ++p) { const int kr = (C.tid >> 4) + p * 32, nc = (C.tid & 15) * 4;
            const f32x4 v = *(const f32x4*)(src + (size_t)(k0 + kr) * ld_src + n0 + nc);
#pragma unroll
            for (int e = 0; e < 4; ++e) mx[e] = fmaxf(mx[e], fabsf(v[e])); }
#pragma unroll
        for (int e = 0; e < 4; ++e) red[(C.tid >> 4) * 64 + (C.tid & 15) * 4 + e] = mx[e];
        __syncthreads();
        if (C.tid < 64) { float m = 0.f; for (int r = 0; r < 32; ++r) m = fmaxf(m, red[r * 64 + C.tid]); atomicMax(cmax + n0 + C.tid, __builtin_bit_cast(unsigned, m)); }
        __syncthreads();
    }
}
__device__ __forceinline__ void tconv_i8_job(const Ctx& C, const float* src, int ld_src, int K, int N, unsigned char* dst, const unsigned* cmax) {
    LAS float* tile = (LAS float*)C.lds;
    const int nks = K / 256, nn = N / 64, nunits = nks * nn;
    for (int un = C.bid; un < nunits; un += C.G) {
        const int k0 = (un / nn) * 256, n0 = (un % nn) * 64;
        const int kr = C.tid >> 4, nc = (C.tid & 15) * 4;
        f32x4 v[8];
#pragma unroll
        for (int p = 0; p < 8; ++p) v[p] = *(const f32x4*)(src + (size_t)(k0 + kr + 32 * p) * ld_src + n0 + nc);
        float isc[4];
#pragma unroll
        for (int e = 0; e < 4; ++e) isc[e] = 127.f / fmaxf(__builtin_bit_cast(float, __hip_atomic_load(cmax + n0 + nc + e, __ATOMIC_RELAXED, __HIP_MEMORY_SCOPE_AGENT)), 1e-30f);
#pragma unroll
        for (int p = 0; p < 8; ++p)
#pragma unroll
            for (int e = 0; e < 4; ++e) tile[(kr + 32 * p) * 65 + nc + e] = v[p][e] * isc[e];
        __syncthreads();
        { const int n = C.tid >> 3, kb = (C.tid & 7) * 32;
          u32x4 o0, o1;
#pragma unroll
          for (int j = 0; j < 8; ++j) { unsigned wd = 0u;
#pragma unroll
              for (int e = 0; e < 4; ++e) wd |= ((unsigned)(int)rintf(tile[(kb + 4 * j + e) * 65 + n]) & 255u) << (8 * e);
              if (j < 4) o0[j] = wd; else o1[j - 4] = wd; }
          unsigned char* dp = dst + (size_t)(n0 + n) * K + k0 + kb;
          *(u32x4*)dp = o0; *(u32x4*)(dp + 16) = o1; }
        __syncthreads();
    }
}
__device__ __forceinline__ void cvt_copy(const Ctx& C, const float* src, bf16_t* dst, size_t n) {
    const size_t n8 = n / 8;
    for (size_t i = (size_t)C.bid * 512 + C.tid; i < n8; i += (size_t)C.G * 512) {
        const f32x4 a = *(const f32x4*)(src + i * 8), b = *(const f32x4*)(src + i * 8 + 4);
        u32x4 o; o[0] = pk2(a[0], a[1]); o[1] = pk2(a[2], a[3]); o[2] = pk2(b[0], b[1]); o[3] = pk2(b[2], b[3]);
        *(u32x4*)(dst + i * 8) = o;
    }
}
__device__ __forceinline__ void p_conv_weights(const Ctx& C) {
    for (int l = 0; l < DEPTH; ++l) {
        unsigned char* wb = C.ws + WS_W + (size_t)l * W_LAYER;
        colmax_job(C, C.in[I_WIN] + (size_t)l * DM * NIN, NIN, DM, NH, (unsigned*)(C.ws + WS_CMAX) + l * (NH + NG));
        colmax_job(C, C.in[I_WGATE] + (size_t)l * DM * NG, NG, DM, NG, (unsigned*)(C.ws + WS_CMAX) + l * (NH + NG) + NH);
        for (int m = 0; m < 4; ++m)
            tconv_job(C, C.in[I_WBR] + ((size_t)l * 4 + m) * BW * DM, DM, BW, DM, (bf16_t*)(wb + WO_WBR) + (size_t)m * DM * BW);
        tconv_job(C, C.in[I_WOUT] + (size_t)l * DM * DM, DM, DM, DM, (bf16_t*)(wb + WO_WOUT));
        tconv_job(C, C.in[I_WQ] + (size_t)l * DM * NQ, NQ, DM, NQ, (bf16_t*)(wb + WO_WQ));
        cvt_copy(C, C.in[I_KEYS] + (size_t)l * 2 * PH * 128 * 128, (bf16_t*)(wb + WO_KEYS), (size_t)2 * PH * 128 * 128);
        for (int g = 0; g < 4; ++g)
            tconv_job(C, C.in[I_POOLW] + ((size_t)l * 4 + g) * 128 * 128, 128, 128, 128, (bf16_t*)(wb + WO_POOLW) + (size_t)g * 128 * 128);
        {
            bf16_t* gw = (bf16_t*)(wb + WO_GWS); const float* src = C.in[I_GWS] + (size_t)l * 4 * 128 * 128;
            for (int i = C.bid * 512 + C.tid; i < 4 * 128 * 128; i += C.G * 512) { const int t = (i >> 7) & 127, sx = i & 127; gw[i] = (bf16_t)f2bf(sx <= t ? src[i] : 0.f); }
        }
        float* wf = (float*)(wb + WO_WF);
        for (int i = C.bid * 512 + C.tid; i < 4 * DM; i += C.G * 512) { const int h = i / DM, k = i % DM; wf[i] = C.in[I_WIN][(size_t)l * DM * NIN + (size_t)k * NIN + NH + h]; }
    }
}
constexpr size_t WS_U8 = WS_TABU, WS_V8 = WS_TABU + 16 * MiB, WS_SU = WS_TABU + 32 * MiB, WS_SV = WS_SU + 64 * 1024;
__device__ __forceinline__ float wave_max(float v) {
#pragma unroll
    for (int o = 32; o > 0; o >>= 1) v = fmaxf(v, __shfl_xor(v, o, 64));
    return v;
}
template <bool SIGNED> __device__ __forceinline__ void quant_rows(const Ctx& C, const float* src, unsigned char* dst, float* scl) {
    for (int row = C.bid * 8 + C.wave; row < NEXP; row += C.G * 8) {
        const float* p = src + (size_t)row * DM + C.lane * 16;
        f32x4 v[4]; float mx = 0.f;
#pragma unroll
        for (int i = 0; i < 4; ++i) { v[i] = *(const f32x4*)(p + 4 * i);
#pragma unroll
            for (int e = 0; e < 4; ++e) mx = fmaxf(mx, fabsf(v[i][e])); }
        mx = fmaxf(wave_max(mx), 1e-30f);
        const float sc = mx * (1.f / 127.f), isc = 127.f / mx;
        u32x4 o;
#pragma unroll
        for (int i = 0; i < 4; ++i) { unsigned wd = 0u;
#pragma unroll
            for (int e = 0; e < 4; ++e) { const int q = (int)rintf(v[i][e] * isc) + (SIGNED ? 0 : 128); wd |= ((unsigned)q & 255u) << (8 * e); }
            o[i] = wd; }
        *(u32x4*)(dst + (size_t)row * DM + C.lane * 16) = o;
        if (C.lane == 0) scl[row] = sc;
    }
}
__device__ __forceinline__ void p_conv_tables(const Ctx& C, int l) {
    quant_rows<true>(C, C.in[I_PU] + (size_t)l * NEXP * DM, C.ws + WS_U8, (float*)(C.ws + WS_SU));
    quant_rows<false>(C, C.in[I_PV] + (size_t)l * NEXP * DM, C.ws + WS_V8, (float*)(C.ws + WS_SV));
}

__device__ __forceinline__ void row_emit(const Ctx& C, int row, const float (&v)[16], int l, bool want_lsig) {
    {
        float mx = 0.f;
#pragma unroll
        for (int j = 0; j < 16; ++j) mx = fmaxf(mx, fabsf(v[j]));
#pragma unroll
        for (int o = 32; o > 0; o >>= 1) mx = fmaxf(mx, __shfl_xor(mx, o, 64));
        mx = fmaxf(mx, 1e-30f);
        const float isc = 127.f / mx;
        unsigned char* xb = C.ws + WS_XB + (size_t)row * DM;
        u32x2 o0, o1;
#pragma unroll
        for (int hw = 0; hw < 2; ++hw) { unsigned a = 0u, b = 0u;
#pragma unroll
            for (int e = 0; e < 4; ++e) { a |= ((unsigned)(int)rintf(v[4 * hw + e] * isc) & 255u) << (8 * e); b |= ((unsigned)(int)rintf(v[8 + 4 * hw + e] * isc) & 255u) << (8 * e); }
            o0[hw] = a; o1[hw] = b; }
        *(u32x2*)(xb + C.lane * 8) = o0; *(u32x2*)(xb + 512 + C.lane * 8) = o1;
        if (C.lane == 0) ((float*)(C.ws + WS_XSA))[row] = mx * (1.f / 127.f);
    }
    if (want_lsig) {
        const float* wf = (const float*)(C.ws + WS_W + (size_t)l * W_LAYER + WO_WF);
        float* lsig = (float*)(C.ws + WS_MISC);
#pragma unroll
        for (int h = 0; h < 4; ++h) {
            const f32x4 a0 = *(const f32x4*)(wf + h * DM + C.lane * 8), a1 = *(const f32x4*)(wf + h * DM + C.lane * 8 + 4);
            const f32x4 b0 = *(const f32x4*)(wf + h * DM + 512 + C.lane * 8), b1 = *(const f32x4*)(wf + h * DM + 512 + C.lane * 8 + 4);
            float s = 0.f;
#pragma unroll
            for (int j = 0; j < 4; ++j) s += v[j] * a0[j] + v[4 + j] * a1[j] + v[8 + j] * b0[j] + v[12 + j] * b1[j];
            s = wave_sum(s);
            if (C.lane == 0) lsig[(size_t)row * 4 + h] = logsigmoidf_(s + C.in[I_BFOX][l * 4 + h]);
        }
    }
}
__device__ __forceinline__ void load_row16(const float* p, int lane, float (&v)[16]) {
    const f32x4 a0 = *(const f32x4*)(p + lane * 8), a1 = *(const f32x4*)(p + lane * 8 + 4), b0 = *(const f32x4*)(p + 512 + lane * 8), b1 = *(const f32x4*)(p + 512 + lane * 8 + 4);
#pragma unroll
    for (int j = 0; j < 4; ++j) { v[j] = a0[j]; v[4 + j] = a1[j]; v[8 + j] = b0[j]; v[12 + j] = b1[j]; }
}
__device__ __forceinline__ void store_row16(float* p, int lane, const float (&v)[16]) {
    *(f32x4*)(p + lane * 8) = (f32x4){v[0], v[1], v[2], v[3]}; *(f32x4*)(p + lane * 8 + 4) = (f32x4){v[4], v[5], v[6], v[7]};
    *(f32x4*)(p + 512 + lane * 8) = (f32x4){v[8], v[9], v[10], v[11]}; *(f32x4*)(p + 512 + lane * 8 + 4) = (f32x4){v[12], v[13], v[14], v[15]};
}
__device__ __forceinline__ void ln_row16(float (&v)[16], const float* g, const float* b, int lane) {
    float s = 0.f;
#pragma unroll
    for (int j = 0; j < 16; ++j) s += v[j];
    const float mean = wave_sum(s) * (1.f / DM);
    float q = 0.f;
#pragma unroll
    for (int j = 0; j < 16; ++j) { const float d = v[j] - mean; q += d * d; }
    const float rstd = rsqrtf(wave_sum(q) * (1.f / DM) + LN_EPS);
    float gg[16], bb[16];
    load_row16(g, lane, gg); load_row16(b, lane, bb);
#pragma unroll
    for (int j = 0; j < 16; ++j) v[j] = (v[j] - mean) * rstd * gg[j] + bb[j];
}
__device__ __forceinline__ void p_rowpass0(const Ctx& C) {
    for (int row = C.bid * 8 + C.wave; row < T; row += C.G * 8) {
        float v[16]; load_row16(C.in[I_X] + (size_t)row * DM, C.lane, v);
        row_emit(C, row, v, 0, true);
    }
}
__device__ __forceinline__ void p_cumsum(const Ctx& C) {
    if (C.bid >= BATCH * 4) return;
    const float* lsig = (const float*)(C.ws + WS_MISC);
    float* cum = (float*)(C.ws + WS_CUM);
    LAS float* wt = (LAS float*)C.lds;
    const int b = C.bid >> 2, h = C.bid & 3;
    float v[16];
#pragma unroll
    for (int j = 0; j < 16; ++j) v[j] = lsig[((size_t)b * SEQ + C.tid * 16 + j) * 4 + h];
#pragma unroll
    for (int j = 1; j < 16; ++j) v[j] += v[j - 1];
    float inc = v[15];
#pragma unroll
    for (int o = 1; o < 64; o <<= 1) { const float t = __shfl_up(inc, o, 64); if (C.lane >= o) inc += t; }
    if (C.lane == 63) wt[C.wave] = inc;
    __syncthreads();
    float off = inc - v[15];
    for (int w2 = 0; w2 < C.wave; ++w2) off += wt[w2];
    float* cp = cum + ((size_t)b * 4 + h) * SEQ + C.tid * 16;
#pragma unroll
    for (int j4 = 0; j4 < 4; ++j4) *(f32x4*)(cp + 4 * j4) = (f32x4){v[4 * j4] + off, v[4 * j4 + 1] + off, v[4 * j4 + 2] + off, v[4 * j4 + 3] + off};
    __syncthreads();
}
__device__ __forceinline__ void load_row16_bf(const bf16_t* p, int lane, float (&v)[16]) {
    const u32x4 a = *(const u32x4*)(p + lane * 8), b = *(const u32x4*)(p + 512 + lane * 8);
#pragma unroll
    for (int j = 0; j < 4; ++j) { v[2 * j] = bf2f(a[j] & 0xffffu); v[2 * j + 1] = bf2f(a[j] >> 16); v[8 + 2 * j] = bf2f(b[j] & 0xffffu); v[9 + 2 * j] = bf2f(b[j] >> 16); }
}
__device__ __forceinline__ void p_ln1(const Ctx& C, int l) {
    const bf16_t* y1 = (const bf16_t*)(C.ws + WS_XC); bf16_t* x1b = (bf16_t*)(C.ws + WS_X1B);
    for (int row = C.bid * 8 + C.wave; row < T; row += C.G * 8) {
        float v[16]; load_row16_bf(y1 + (size_t)row * DM, C.lane, v);
        ln_row16(v, C.in[I_LN1G] + l * DM, C.in[I_LN1B] + l * DM, C.lane);
        u32x4 o0, o1;
#pragma unroll
        for (int j = 0; j < 4; ++j) { o0[j] = pk2(v[2 * j], v[2 * j + 1]); o1[j] = pk2(v[8 + 2 * j], v[8 + 2 * j + 1]); }
        *(u32x4*)(x1b + (size_t)row * DM + C.lane * 8) = o0; *(u32x4*)(x1b + (size_t)row * DM + 512 + C.lane * 8) = o1;
    }
}

__device__ __forceinline__ void mix_pool_naive(const Ctx& C, int l) {
    const bf16_t* H = (const bf16_t*)(C.ws + WS_H); bf16_t* BR = (bf16_t*)(C.ws + WS_BR);
    LAS float* dd = (LAS float*)C.lds;
    for (int u = C.bid; u < (T / 64) * 4; u += C.G) {
        const int g = u & 3, t0 = (u >> 2) * 64, w = 2 << g;
        for (int idx = C.tid; idx < 64 * 128; idx += 512) {
            const int r = idx >> 7, c = idx & 127, row = t0 + r, pos = row & (SEQ - 1);
            const int nwin = (pos + 1 < w) ? pos + 1 : w;
            float s = 0.f;
            for (int j = 0; j < nwin; ++j) s += bf2f(H[(size_t)(row - j) * NH + HC_P + g * 128 + c]);
            dd[idx] = s / (float)nwin - bf2f(H[(size_t)row * NH + HC_P + g * 128 + c]);
        }
        __syncthreads();
        const int dcol = C.tid & 127, rq = C.tid >> 7;
        float acc[16];
#pragma unroll
        for (int i = 0; i < 16; ++i) acc[i] = 0.f;
        const float* pw = C.in[I_POOLW] + ((size_t)l * 4 + g) * 128 * 128;
        for (int c = 0; c < 128; ++c) {
            const float wv = pw[c * 128 + dcol];
#pragma unroll
            for (int i = 0; i < 16; ++i) acc[i] += dd[(rq * 16 + i) * 128 + c] * wv;
        }
        const float sc = C.in[I_POOLS][l * BW + g * 128 + dcol];
#pragma unroll
        for (int i = 0; i < 16; ++i) BR[(size_t)(t0 + rq * 16 + i) * NBR + 0 + g * 128 + dcol] = (bf16_t)f2bf(acc[i] * sc);
        __syncthreads();
    }
}
__device__ __forceinline__ void mix_gmlp_naive(const Ctx& C, int l) {
    const bf16_t* H = (const bf16_t*)(C.ws + WS_H); bf16_t* BR = (bf16_t*)(C.ws + WS_BR);
    LAS float* vn = (LAS float*)C.lds;
    for (int u = C.bid; u < (T / 128) * 4; u += C.G) {
        const int g = u & 3, t0 = (u >> 2) * 128;
        for (int i = 0; i < 16; ++i) {
            const int r = C.wave * 16 + i, row = t0 + r;
            const u32x4 raw = *(const u32x4*)(H + (size_t)row * NH + HC_GV + C.lane * 8);
            float e[8];
#pragma unroll
            for (int j = 0; j < 4; ++j) { e[2 * j] = geluf_(bf2f(raw[j] & 0xffffu)); e[2 * j + 1] = geluf_(bf2f(raw[j] >> 16)); }
            float s = 0.f;
#pragma unroll
            for (int j = 0; j < 8; ++j) s += e[j];
            const float mean = wave_sum(s) * (1.f / BW);
            float q = 0.f;
#pragma unroll
            for (int j = 0; j < 8; ++j) { const float d = e[j] - mean; q += d * d; }
            const float rstd = rsqrtf(wave_sum(q) * (1.f / BW) + LN_EPS);
            if ((C.lane >> 4) == g) {
#pragma unroll
                for (int j = 0; j < 8; ++j) { const int col = C.lane * 8 + j;
                    vn[r * 128 + (col - g * 128)] = (e[j] - mean) * rstd * C.in[I_GLNG][l * BW + col] + C.in[I_GLNB][l * BW + col]; }
            }
        }
        __syncthreads();
        const int c = C.tid & 127, tq = C.tid >> 7;
        const float* wsg = C.in[I_GWS] + ((size_t)l * 4 + g) * 128 * 128;
        for (int t = tq; t < 128; t += 4) {
            float acc = 0.f;
            for (int s = 0; s <= t; ++s) acc += wsg[t * 128 + s] * vn[s * 128 + c];
            const float sv = acc + C.in[I_GBS][(l * 4 + g) * 128 + t];
            const float uv = geluf_(bf2f(H[(size_t)(t0 + t) * NH + HC_GU + g * 128 + c]));
            BR[(size_t)(t0 + t) * NBR + 1024 + g * 128 + c] = (bf16_t)f2bf(uv * sv);
        }
        __syncthreads();
    }
}
__device__ __forceinline__ void mix_fox_naive(const Ctx& C, int l) {
    const bf16_t* H = (const bf16_t*)(C.ws + WS_H); bf16_t* BR = (bf16_t*)(C.ws + WS_BR);
    const float* cum = (const float*)(C.ws + WS_CUM);
    const float scale = 0.08838834764831845f;
    for (int u = C.bid; u < T * 4 / 8; u += C.G) {
        const int rid = u * 8 + C.wave;
        const int h = rid & 3, row = rid >> 2, b = row / SEQ, t = row % SEQ;
        const unsigned qraw = *(const unsigned*)(H + (size_t)row * NH + HC_FQ + h * 128 + C.lane * 2);
        const float q0 = bf2f(qraw & 0xffffu) * scale, q1 = bf2f(qraw >> 16) * scale;
        const float* cm = cum + ((size_t)b * 4 + h) * SEQ;
        const float ct = cm[t];
        float m = -1e30f, lsum = 0.f, o0 = 0.f, o1 = 0.f;
        for (int s = t; s >= 0; --s) {
            const size_t kr = (size_t)(b * SEQ + s) * NH + h * 128 + C.lane * 2;
            const unsigned kraw = *(const unsigned*)(H + kr + HC_FK);
            const unsigned vraw = *(const unsigned*)(H + kr + HC_FV);
            float d = q0 * bf2f(kraw & 0xffffu) + q1 * bf2f(kraw >> 16);
            d = wave_sum(d);
            const float z = d + ct - cm[s];
            const float mn = fmaxf(m, z), al = __expf(m - mn), p = __expf(z - mn);
            lsum = lsum * al + p; o0 = o0 * al + p * bf2f(vraw & 0xffffu); o1 = o1 * al + p * bf2f(vraw >> 16); m = mn;
        }
        const float inv = 1.f / lsum;
        *(unsigned*)(BR + (size_t)row * NBR + 1536 + h * 128 + C.lane * 2) = pk2(o0 * inv, o1 * inv);
    }
}
__device__ __forceinline__ void mix_hgrn_naive(const Ctx& C, int l) {
    if (C.bid >= BATCH * 4) return;
    const bf16_t* H = (const bf16_t*)(C.ws + WS_H); bf16_t* BR = (bf16_t*)(C.ws + WS_BR);
    const int b = C.bid >> 2, h = C.bid & 3;
    LAS float* fdec = (LAS float*)C.lds;
    LAS float* kkv = fdec + 32 * 128;
    LAS float* qsv = kkv + 32 * 128;
    LAS float* vv = qsv + 32 * 128;
    LAS float* opart = vv + 32 * 128;
    const int kq = C.tid >> 7, v = C.tid & 127;
    float S[32];
#pragma unroll
    for (int j = 0; j < 32; ++j) S[j] = 0.f;
    for (int c0 = 0; c0 < SEQ; c0 += 32) {
        for (int idx = C.tid; idx < 32 * 128; idx += 512) {
            const int st = idx >> 7, k = idx & 127; const size_t rb = (size_t)(b * SEQ + c0 + st) * NH + h * 128 + k;
            float lb = 0.f;
            if (l == 1) { const float z0 = C.in[I_LBL][h * 128 + k], z1 = C.in[I_LBL][BW + h * 128 + k]; lb = 1.f / (1.f + __expf(z0 - z1)); }
            const float zf = bf2f(H[rb + HC_HF]);
            const float kk = (1.f - lb) * sigmoidf_(-zf);
            fdec[idx] = 1.f - kk; kkv[idx] = kk; qsv[idx] = siluf_(bf2f(H[rb + HC_HQ])); vv[idx] = bf2f(H[rb + HC_HI]);
        }
        __syncthreads();
        for (int st = 0; st < 32; ++st) {
            const float vt = vv[st * 128 + v];
            float part = 0.f;
#pragma unroll
            for (int j = 0; j < 32; ++j) { const int k = kq * 32 + j; S[j] = fdec[st * 128 + k] * S[j] + kkv[st * 128 + k] * vt; part += S[j] * qsv[st * 128 + k]; }
            opart[(kq * 32 + st) * 128 + v] = part;
        }
        __syncthreads();
        for (int i = 0; i < 4; ++i) {
            const int st = C.wave * 4 + i, row = b * SEQ + c0 + st;
            float o0 = 0.f, o1 = 0.f;
#pragma unroll
            for (int q = 0; q < 4; ++q) { o0 += opart[(q * 32 + st) * 128 + C.lane]; o1 += opart[(q * 32 + st) * 128 + 64 + C.lane]; }
            const float ss = wave_sum(o0 * o0 + o1 * o1);
            const float r = rsqrtf(ss * (1.f / 128.f) + RMS_EPS);
            const float g0 = siluf_(bf2f(H[(size_t)row * NH + HC_HG + h * 128 + C.lane])), g1 = siluf_(bf2f(H[(size_t)row * NH + HC_HG + h * 128 + 64 + C.lane]));
            BR[(size_t)row * NBR + 512 + h * 128 + C.lane] = (bf16_t)f2bf(o0 * r * C.in[I_HNG][l * 128 + C.lane] * g0);
            BR[(size_t)row * NBR + 512 + h * 128 + 64 + C.lane] = (bf16_t)f2bf(o1 * r * C.in[I_HNG][l * 128 + 64 + C.lane] * g1);
        }
        __syncthreads();
    }
}


typedef float f32x16 __attribute__((ext_vector_type(16)));
typedef short s16x4 __attribute__((ext_vector_type(4)));
typedef short v4i16_t __attribute__((ext_vector_type(4)));
__device__ __forceinline__ s16x4 vtr(const LAS unsigned char* p) { return __builtin_bit_cast(s16x4, __builtin_amdgcn_ds_read_tr16_b64_v4i16((LAS v4i16_t*)p)); }
__device__ __forceinline__ float xor32(float x) { return __shfl_xor(x, 32, 64); }
#define MFMA32(a, b, c) __builtin_amdgcn_mfma_f32_32x32x16_bf16((a), (b), (c), 0, 0, 0)
constexpr int CW_KMAX = 16;

__device__ __forceinline__ void p_knorm(const Ctx& C, int l) {
    const bf16_t* H = (const bf16_t*)(C.ws + WS_H);
    unsigned* kmax = (unsigned*)(C.ws + WS_CTL) + CW_KMAX + l * 8;
    for (int r0 = (C.bid * 8 + C.wave) * 8; r0 < T; r0 += C.G * 64) {
        u32x4 raw[8];
#pragma unroll
        for (int i = 0; i < 8; ++i) raw[i] = *(const u32x4*)(H + (size_t)(r0 + i) * NH + HC_FK + C.lane * 8);
        float best = 0.f;
#pragma unroll
        for (int i = 0; i < 8; ++i) { float s = 0.f;
#pragma unroll
            for (int j = 0; j < 4; ++j) { const float a = bf2f(raw[i][j] & 0xffffu), b = bf2f(raw[i][j] >> 16); s += a * a + b * b; }
            best = fmaxf(best, s); }
        best = 0.f;
#pragma unroll
        for (int i = 0; i < 8; ++i) { float s = 0.f;
#pragma unroll
            for (int j = 0; j < 4; ++j) { const float a = bf2f(raw[i][j] & 0xffffu), b = bf2f(raw[i][j] >> 16); s += a * a + b * b; }
#pragma unroll
            for (int o = 8; o > 0; o >>= 1) s += __shfl_xor(s, o, 64);
            best = fmaxf(best, s); }
        LAS float* red = (LAS float*)C.lds;
        if ((C.lane & 15) == 0) red[C.wave * 4 + (C.lane >> 4)] = best;
        __syncthreads();
        if (C.tid < 4) { float m = red[C.tid];
#pragma unroll
            for (int w2 = 1; w2 < 8; ++w2) m = fmaxf(m, red[w2 * 4 + C.tid]);
            atomicMax(kmax + (r0 / SEQ) * 4 + C.tid, __builtin_bit_cast(unsigned, m)); }
        __syncthreads();
    }
}

constexpr int FOX_KST = 272, FOX_VST = 320;
constexpr int FOX_KB = 0, FOX_VB = 2 * 64 * FOX_KST, FOX_BETA = FOX_VB + 2 * 64 * FOX_VST, FOX_FLAG = FOX_BETA + 2 * 64 * 4, FOX_END = FOX_FLAG + 2 * 8 * 4;
__device__ __forceinline__ void mix_fox(const Ctx& C, int l) {
    const bf16_t* H = (const bf16_t*)(C.ws + WS_H); bf16_t* BR = (bf16_t*)(C.ws + WS_BR);
    const float* cum = (const float*)(C.ws + WS_CUM);
    const unsigned* kmaxw = (const unsigned*)(C.ws + WS_CTL) + CW_KMAX + l * 8;
    const float LOG2E = 1.4426950408889634f, QS = 0.08838834764831845f * LOG2E;
    const int lane = C.lane, w = C.wave, r32 = lane & 31, hh = lane >> 5;
    LAS unsigned char* lds = C.lds;
    LAS float* betaL = (LAS float*)(lds + FOX_BETA);
    volatile LAS int* flagL = (volatile LAS int*)(lds + FOX_FLAG);
    for (int u = C.bid; u < BATCH * 4 * (SEQ / 256); u += C.G) {
        const int qb = u % (SEQ / 256), bh = u / (SEQ / 256), b = bh >> 2, h = bh & 3;
        const int q0 = qb * 256, qw = q0 + 32 * w;
        const size_t rowbase = (size_t)b * SEQ;
        const float* cm = cum + ((size_t)b * 4 + h) * SEQ;
        const float c0 = cm[q0];
        const float kmx = sqrtf(__builtin_bit_cast(float, __hip_atomic_load(kmaxw + b * 4 + h, __ATOMIC_RELAXED, __HIP_MEMORY_SCOPE_AGENT)));
        bf16x8 qf[8]; float qn = 0.f;
        {
            const bf16_t* qp = H + (rowbase + qw + r32) * NH + HC_FQ + h * 128 + 8 * hh;
#pragma unroll
            for (int ks = 0; ks < 8; ++ks) {
                const u32x4 raw = *(const u32x4*)(qp + 16 * ks);
                u32x4 o;
#pragma unroll
                for (int j = 0; j < 4; ++j) { const float a = bf2f(raw[j] & 0xffffu), bb = bf2f(raw[j] >> 16); qn += a * a + bb * bb; o[j] = cvtpk(a * QS, bb * QS); }
                qf[ks] = __builtin_bit_cast(bf16x8, o);
            }
            qn += xor32(qn); qn = sqrtf(qn);
        }
        const float qbound = qn * kmx * QS;
        f32x16 oacc[4];
#pragma unroll
        for (int mt = 0; mt < 4; ++mt)
#pragma unroll
            for (int i = 0; i < 16; ++i) oacc[mt][i] = 0.f;
        float m_run = -1e30f, l_run = 0.f;
        const int jmax = (q0 + 255) >> 6;
        const int srow = C.tid >> 4, sch = C.tid & 15;
        u32x4 kreg[2], vreg[2]; float breg = 0.f;
#define FOX_GLOAD(j_) do { _Pragma("unroll") for (int p = 0; p < 2; ++p) { \
                const bf16_t* rp = H + (rowbase + 64 * (j_) + srow + 32 * p) * NH + h * 128 + sch * 8; \
                kreg[p] = *(const u32x4*)(rp + HC_FK); vreg[p] = *(const u32x4*)(rp + HC_FV); } \
            if (C.tid < 64) breg = (c0 - cm[64 * (j_) + C.tid]) * LOG2E; } while (0)
#define FOX_LWRITE(buf_) do { _Pragma("unroll") for (int p = 0; p < 2; ++p) { \
                *(LAS u32x4*)(lds + FOX_KB + (buf_) * 64 * FOX_KST + (srow + 32 * p) * FOX_KST + sch * 16) = kreg[p]; \
                *(LAS u32x4*)(lds + FOX_VB + (buf_) * 64 * FOX_VST + (srow + 32 * p) * FOX_VST + sch * 16) = vreg[p]; } \
            if (C.tid < 64) betaL[(buf_) * 64 + C.tid] = breg; } while (0)
        __syncthreads();
        if (C.tid < 16) flagL[C.tid] = 0;
        FOX_GLOAD(jmax); FOX_LWRITE(jmax & 1);
        bool wdone = false;
        for (int j = jmax; j >= 0; --j) {
            const int cur = j & 1;
            __syncthreads();
            if (j < jmax) { int all = 1;
#pragma unroll
                for (int i = 0; i < 8; ++i) all &= flagL[((j + 1) & 1) * 8 + i];
                if (all) break; }
            if (j > 0) FOX_GLOAD(j - 1);
            const int k0 = 64 * j;
            if (k0 <= qw + 31 && !wdone) {
                const LAS unsigned char* kb = lds + FOX_KB + cur * 64 * FOX_KST;
                const LAS unsigned char* vb = lds + FOX_VB + cur * 64 * FOX_VST;
                f32x16 sacc[2];
#pragma unroll
                for (int mt = 0; mt < 2; ++mt)
#pragma unroll
                    for (int g = 0; g < 4; ++g) { const f32x4 bv = *(const LAS f32x4*)(betaL + cur * 64 + 32 * mt + 8 * g + 4 * hh);
                        sacc[mt][4 * g] = bv[0]; sacc[mt][4 * g + 1] = bv[1]; sacc[mt][4 * g + 2] = bv[2]; sacc[mt][4 * g + 3] = bv[3]; }
#pragma unroll
                for (int ks = 0; ks < 8; ++ks)
#pragma unroll
                    for (int mt = 0; mt < 2; ++mt) {
                        const bf16x8 kf = *(const LAS bf16x8*)(kb + (32 * mt + r32) * FOX_KST + 32 * ks + 16 * hh);
                        sacc[mt] = MFMA32(kf, qf[ks], sacc[mt]);
                    }
                const int tq = qw + r32;
                if (k0 + 63 > qw) {
#pragma unroll
                    for (int mt = 0; mt < 2; ++mt)
#pragma unroll
                        for (int i = 0; i < 16; ++i) { const int key = k0 + 32 * mt + (i & 3) + 8 * (i >> 2) + 4 * hh; if (key > tq) sacc[mt][i] = -1e30f; }
                }
                float mx = sacc[0][0];
#pragma unroll
                for (int mt = 0; mt < 2; ++mt)
#pragma unroll
                    for (int i = 0; i < 16; ++i) mx = fmaxf(mx, sacc[mt][i]);
                mx = fmaxf(mx, xor32(mx));
                const float mn = fmaxf(m_run, mx), alpha = __builtin_amdgcn_exp2f(m_run - mn);
                m_run = mn;
                float ps = 0.f;
#pragma unroll
                for (int mt = 0; mt < 2; ++mt)
#pragma unroll
                    for (int i = 0; i < 16; ++i) { const float p = __builtin_amdgcn_exp2f(sacc[mt][i] - mn); sacc[mt][i] = p; ps += p; }
                l_run = l_run * alpha + ps;
#pragma unroll
                for (int mt = 0; mt < 4; ++mt)
#pragma unroll
                    for (int i = 0; i < 16; ++i) oacc[mt][i] *= alpha;
#pragma unroll
                for (int s4 = 0; s4 < 4; ++s4) {
                    const int mtk = s4 >> 1, s = s4 & 1;
                    u32x4 pb;
#pragma unroll
                    for (int e = 0; e < 4; ++e) pb[e] = cvtpk(sacc[mtk][8 * s + 2 * e], sacc[mtk][8 * s + 2 * e + 1]);
                    const bf16x8 pfrag = __builtin_bit_cast(bf16x8, pb);
                    const int i16 = lane & 15, q4 = i16 >> 2, p4 = i16 & 3, blk = (lane >> 4) & 1;
                    const int keyA = 32 * mtk + 16 * s + 4 * hh + q4;
#pragma unroll
                    for (int mt = 0; mt < 4; ++mt) {
                        const LAS unsigned char* a0 = vb + keyA * FOX_VST + (32 * mt + 16 * blk + 4 * p4) * 2;
                        const s16x4 lo = vtr(a0), hi = vtr(a0 + 8 * FOX_VST);
                        const bf16x8 vf = __builtin_shufflevector(lo, hi, 0, 1, 2, 3, 4, 5, 6, 7);
                        oacc[mt] = MFMA32(vf, pfrag, oacc[mt]);
                    }
                }
                if (j > 0) { const float bl = (c0 - cm[k0 - 1]) * LOG2E;
                    const int ok = (qbound + bl < m_run - 152.f) ? 1 : 0;
                    wdone = __all(ok); }
            }
            if (lane == 0) flagL[cur * 8 + w] = wdone ? 1 : 0;
            if (j > 0) FOX_LWRITE(cur ^ 1);
        }
        l_run += xor32(l_run);
        const float inv = 1.f / l_run;
        bf16_t* op = BR + (rowbase + qw + r32) * NBR + 1536 + h * 128;
#pragma unroll
        for (int mt = 0; mt < 4; ++mt)
#pragma unroll
            for (int g = 0; g < 4; ++g) { u32x2 o; o[0] = cvtpk(oacc[mt][4 * g] * inv, oacc[mt][4 * g + 1] * inv); o[1] = cvtpk(oacc[mt][4 * g + 2] * inv, oacc[mt][4 * g + 3] * inv);
                *(u32x2*)(op + 32 * mt + 8 * g + 4 * hh) = o; }
    }
}


constexpr int HG_LF = 0, HG_QA = 34816, HG_QB = HG_QA + 17408, HG_KD = HG_QB + 8704, HG_KO = HG_KD + 17408, HG_KT = HG_KO + 8704, HG_VN = HG_KT + 20480, HG_AM = HG_VN + 20480, HG_END = HG_AM + 12288;
constexpr int HG_LFS = 132;
static_assert(HG_END + 2048 <= 140 * 1024, "hgrn LDS");
constexpr size_t WS_DSC = WS_ST + (size_t)BATCH * 4 * 32 * 128 * 128 * 4;

template <bool FULL>
__device__ __forceinline__ void hgrn_unit(const Ctx& C, int l, int u) {
#if DIAG == 1
    const bf16_t* H = (const bf16_t*)(C.ws + WS_H); bf16_t* BR = (l == 0) ? (bf16_t*)(C.ws + WS_XA) : (bf16_t*)(C.ws + WS_TABU);
#else
    const bf16_t* H = (const bf16_t*)(C.ws + WS_H); bf16_t* BR = (bf16_t*)(C.ws + WS_BR);
#endif
    float* STB = (float*)(C.ws + WS_ST); float* DSC = (float*)(C.ws + WS_DSC);
    LAS unsigned char* lds = C.lds;
    LAS float* LF = (LAS float*)(lds + HG_LF);
    const int lane = C.lane, w = C.wave, r32 = lane & 31, hh = lane >> 5;
    const int sc = u & 31, bh = u >> 5, b = bh >> 2, h = bh & 3;
    const int wk = w >> 1, wv = w & 1;
    const int mt = w >> 2, nt = w & 3;
    const int i16 = lane & 15, q4 = i16 >> 2, p4 = i16 & 3, blk = (lane >> 4) & 1;
    f32x16 S0, S1;
    float* stp = STB + ((size_t)bh * 32 + sc) * 128 * 128;
    if constexpr (FULL) {
#pragma unroll
        for (int i = 0; i < 16; ++i) { const int k = 32 * wk + (i & 3) + 8 * (i >> 2) + 4 * hh;
            S0[i] = stp[k * 128 + 64 * wv + r32]; S1[i] = stp[k * 128 + 64 * wv + 32 + r32]; }
    } else {
#pragma unroll
        for (int i = 0; i < 16; ++i) { S0[i] = 0.f; S1[i] = 0.f; }
    }
    float dtot = 0.f;
    const int ps = C.tid >> 3, pseg = C.tid & 7;
    float lbv[16];
#pragma unroll
    for (int j = 0; j < 16; ++j) { lbv[j] = 0.f;
        if (l == 1) { const int ch = h * 128 + 16 * pseg + j; lbv[j] = 1.f / (1.f + __expf(C.in[I_LBL][ch] - C.in[I_LBL][BW + ch])); } }
    for (int c = 0; c < 4; ++c) {
        const size_t row0 = (size_t)b * SEQ + sc * 256 + c * 64;
        const bf16_t* hp = H + (row0 + ps) * NH + h * 128 + 16 * pseg;
        float kkv[16], qsv[16];
        u32x4 vraw0, vraw1;
        {
            const u32x4 f0 = *(const u32x4*)(hp + HC_HF), f1 = *(const u32x4*)(hp + HC_HF + 8);
            vraw0 = *(const u32x4*)(hp + HC_HI); vraw1 = *(const u32x4*)(hp + HC_HI + 8);
#pragma unroll
            for (int j = 0; j < 8; ++j) { const unsigned r = (j < 4) ? f0[j] : f1[j - 4];
                const float z0 = bf2f(r & 0xffffu), z1 = bf2f(r >> 16);
                kkv[2 * j] = (1.f - lbv[2 * j]) * sigmoidf_(-z0); kkv[2 * j + 1] = (1.f - lbv[2 * j + 1]) * sigmoidf_(-z1); }
            if constexpr (FULL) {
                const u32x4 q0 = *(const u32x4*)(hp + HC_HQ), q1 = *(const u32x4*)(hp + HC_HQ + 8);
#pragma unroll
                for (int j = 0; j < 8; ++j) { const unsigned r = (j < 4) ? q0[j] : q1[j - 4]; qsv[2 * j] = siluf_(bf2f(r & 0xffffu)); qsv[2 * j + 1] = siluf_(bf2f(r >> 16)); }
            }
#pragma unroll
            for (int j4 = 0; j4 < 4; ++j4) { f32x4 o;
#pragma unroll
                for (int e = 0; e < 4; ++e) o[e] = __logf(1.f - kkv[4 * j4 + e]);
                *(LAS f32x4*)(LF + ps * HG_LFS + 16 * pseg + 4 * j4) = o; }
        }
        __syncthreads();
        {
            const int sk = C.tid & 127, sg = C.tid >> 7;
            float vals[16];
#pragma unroll
            for (int i = 0; i < 16; ++i) vals[i] = LF[(16 * sg + i) * HG_LFS + sk];
#pragma unroll
            for (int i = 1; i < 16; ++i) vals[i] += vals[i - 1];
            LAS float* TOT = (LAS float*)(lds + HG_END);
            TOT[sg * 128 + sk] = vals[15];
            __syncthreads();
            float off = 0.f;
#pragma unroll
            for (int j = 0; j < 3; ++j) if (j < sg) off += TOT[j * 128 + sk];
#pragma unroll
            for (int i = 0; i < 16; ++i) LF[(16 * sg + i) * HG_LFS + sk] = vals[i] + off;
            if (sg == 3) dtot += vals[15] + off;
        }
        __syncthreads();
        float bv[16], b31[16], bl[16];
#pragma unroll
        for (int j4 = 0; j4 < 4; ++j4) { const f32x4 x = *(const LAS f32x4*)(LF + ps * HG_LFS + 16 * pseg + 4 * j4), y = *(const LAS f32x4*)(LF + 31 * HG_LFS + 16 * pseg + 4 * j4), z = *(const LAS f32x4*)(LF + 63 * HG_LFS + 16 * pseg + 4 * j4);
#pragma unroll
            for (int e = 0; e < 4; ++e) { bv[4 * j4 + e] = x[e]; b31[4 * j4 + e] = y[e]; bl[4 * j4 + e] = z[e]; } }
        {
            u32x4 o0, o1;
#pragma unroll
            for (int j = 0; j < 4; ++j) { o0[j] = cvtpk(kkv[2 * j] * __expf(bl[2 * j] - bv[2 * j]), kkv[2 * j + 1] * __expf(bl[2 * j + 1] - bv[2 * j + 1]));
                o1[j] = cvtpk(kkv[8 + 2 * j] * __expf(bl[8 + 2 * j] - bv[8 + 2 * j]), kkv[9 + 2 * j] * __expf(bl[9 + 2 * j] - bv[9 + 2 * j])); }
            *(LAS u32x4*)(lds + HG_KT + ps * 320 + 32 * pseg) = o0; *(LAS u32x4*)(lds + HG_KT + ps * 320 + 32 * pseg + 16) = o1;
            *(LAS u32x4*)(lds + HG_VN + ps * 320 + 32 * pseg) = vraw0; *(LAS u32x4*)(lds + HG_VN + ps * 320 + 32 * pseg + 16) = vraw1;
            if constexpr (FULL) {
                const bool hi = ps >= 32;
                float rr[16];
#pragma unroll
                for (int j = 0; j < 16; ++j) rr[j] = hi ? b31[j] : 0.f;
#pragma unroll
                for (int j = 0; j < 4; ++j) { o0[j] = cvtpk(qsv[2 * j] * __expf(bv[2 * j] - rr[2 * j]), qsv[2 * j + 1] * __expf(bv[2 * j + 1] - rr[2 * j + 1]));
                    o1[j] = cvtpk(qsv[8 + 2 * j] * __expf(bv[8 + 2 * j] - rr[8 + 2 * j]), qsv[9 + 2 * j] * __expf(bv[9 + 2 * j] - rr[9 + 2 * j])); }
                *(LAS u32x4*)(lds + HG_QA + ps * 272 + 32 * pseg) = o0; *(LAS u32x4*)(lds + HG_QA + ps * 272 + 32 * pseg + 16) = o1;
#pragma unroll
                for (int j = 0; j < 4; ++j) { o0[j] = cvtpk(kkv[2 * j] * __expf(rr[2 * j] - bv[2 * j]), kkv[2 * j + 1] * __expf(rr[2 * j + 1] - bv[2 * j + 1]));
                    o1[j] = cvtpk(kkv[8 + 2 * j] * __expf(rr[8 + 2 * j] - bv[8 + 2 * j]), kkv[9 + 2 * j] * __expf(rr[9 + 2 * j] - bv[9 + 2 * j])); }
                *(LAS u32x4*)(lds + HG_KD + ps * 272 + 32 * pseg) = o0; *(LAS u32x4*)(lds + HG_KD + ps * 272 + 32 * pseg + 16) = o1;
                if (hi) {
#pragma unroll
                    for (int j = 0; j < 4; ++j) { o0[j] = cvtpk(qsv[2 * j] * __expf(bv[2 * j]), qsv[2 * j + 1] * __expf(bv[2 * j + 1]));
                        o1[j] = cvtpk(qsv[8 + 2 * j] * __expf(bv[8 + 2 * j]), qsv[9 + 2 * j] * __expf(bv[9 + 2 * j])); }
                    *(LAS u32x4*)(lds + HG_QB + (ps - 32) * 272 + 32 * pseg) = o0; *(LAS u32x4*)(lds + HG_QB + (ps - 32) * 272 + 32 * pseg + 16) = o1;
                } else {
#pragma unroll
                    for (int j = 0; j < 4; ++j) { o0[j] = cvtpk(kkv[2 * j] * __expf(b31[2 * j] - bv[2 * j]), kkv[2 * j + 1] * __expf(b31[2 * j + 1] - bv[2 * j + 1]));
                        o1[j] = cvtpk(kkv[8 + 2 * j] * __expf(b31[8 + 2 * j] - bv[8 + 2 * j]), kkv[9 + 2 * j] * __expf(b31[9 + 2 * j] - bv[9 + 2 * j])); }
                    *(LAS u32x4*)(lds + HG_KO + ps * 272 + 32 * pseg) = o0; *(LAS u32x4*)(lds + HG_KO + ps * 272 + 32 * pseg + 16) = o1;
                }
            }
        }
        float dk[16];
#pragma unroll
        for (int i = 0; i < 16; ++i) dk[i] = __expf(LF[63 * HG_LFS + 32 * wk + (i & 3) + 8 * (i >> 2) + 4 * hh]);
        __syncthreads();
        if constexpr (FULL) {
#pragma unroll
            for (int g = 0; g < 4; ++g) {
                u32x2 o; o[0] = cvtpk(S0[4 * g], S0[4 * g + 1]); o[1] = cvtpk(S0[4 * g + 2], S0[4 * g + 3]);
                *(LAS u32x2*)(lds + HG_LF + (64 * wv + r32) * 272 + (32 * wk + 8 * g + 4 * hh) * 2) = o;
                o[0] = cvtpk(S1[4 * g], S1[4 * g + 1]); o[1] = cvtpk(S1[4 * g + 2], S1[4 * g + 3]);
                *(LAS u32x2*)(lds + HG_LF + (64 * wv + 32 + r32) * 272 + (32 * wk + 8 * g + 4 * hh) * 2) = o;
            }
#define HG_ATILE(AMT_, AST_) do { \
                const LAS unsigned char* kb = ((AMT_) == (AST_)) ? (lds + HG_KD + (32 * (AST_)) * 272) : (lds + HG_KO); \
                f32x16 a; \
                _Pragma("unroll") for (int i = 0; i < 16; ++i) a[i] = 0.f; \
                _Pragma("unroll") for (int ks = 0; ks < 8; ++ks) { \
                    const bf16x8 af = *(const LAS bf16x8*)(lds + HG_QA + (32 * (AMT_) + r32) * 272 + 32 * ks + 16 * hh); \
                    const bf16x8 bf = *(const LAS bf16x8*)(kb + r32 * 272 + 32 * ks + 16 * hh); \
                    a = MFMA32(af, bf, a); } \
                _Pragma("unroll") for (int g = 0; g < 4; ++g) { \
                    float x[4]; \
                    _Pragma("unroll") for (int e = 0; e < 4; ++e) { const int tl = 8 * g + 4 * hh + e; x[e] = ((AMT_) != (AST_) || r32 <= tl) ? a[4 * g + e] : 0.f; } \
                    u32x2 o; o[0] = cvtpk(x[0], x[1]); o[1] = cvtpk(x[2], x[3]); \
                    *(LAS u32x2*)(lds + HG_AM + (32 * (AST_) + r32) * 192 + (32 * (AMT_) + 8 * g + 4 * hh) * 2) = o; } } while (0)
            if (w == 0) { HG_ATILE(0, 0); }
            else if (w == 1) { HG_ATILE(1, 0); }
            else if (w == 2) { HG_ATILE(1, 1); }
        }
#pragma unroll
        for (int i = 0; i < 16; ++i) { S0[i] *= dk[i]; S1[i] *= dk[i]; }
#pragma unroll
        for (int ks = 0; ks < 4; ++ks) {
            const LAS unsigned char* ka = lds + HG_KT + (16 * ks + 8 * hh + q4) * 320 + (32 * wk + 16 * blk + 4 * p4) * 2;
            const s16x4 alo = vtr(ka), ahi = vtr(ka + 4 * 320);
            const bf16x8 af = __builtin_shufflevector(alo, ahi, 0, 1, 2, 3, 4, 5, 6, 7);
            const LAS unsigned char* vb0 = lds + HG_VN + (16 * ks + 8 * hh + q4) * 320 + (64 * wv + 16 * blk + 4 * p4) * 2;
            const s16x4 b0lo = vtr(vb0), b0hi = vtr(vb0 + 4 * 320), b1lo = vtr(vb0 + 64), b1hi = vtr(vb0 + 64 + 4 * 320);
            S0 = MFMA32(af, __builtin_shufflevector(b0lo, b0hi, 0, 1, 2, 3, 4, 5, 6, 7), S0);
            S1 = MFMA32(af, __builtin_shufflevector(b1lo, b1hi, 0, 1, 2, 3, 4, 5, 6, 7), S1);
        }
        if constexpr (FULL) {
            __syncthreads();
            f32x16 o;
#pragma unroll
            for (int i = 0; i < 16; ++i) o[i] = 0.f;
            const LAS unsigned char* qb = (mt == 0) ? (lds + HG_QA) : (lds + HG_QB);
#pragma unroll
            for (int ks = 0; ks < 8; ++ks) {
                const bf16x8 af = *(const LAS bf16x8*)(qb + r32 * 272 + 32 * ks + 16 * hh);
                const bf16x8 bf = *(const LAS bf16x8*)(lds + HG_LF + (32 * nt + r32) * 272 + 32 * ks + 16 * hh);
                o = MFMA32(af, bf, o);
            }
#pragma unroll
            for (int ks = 0; ks < 4; ++ks) {
                if (mt == 0 && ks >= 2) continue;
                const LAS unsigned char* aa = lds + HG_AM + (16 * ks + 8 * hh + q4) * 192 + (32 * mt + 16 * blk + 4 * p4) * 2;
                const s16x4 alo = vtr(aa), ahi = vtr(aa + 4 * 192);
                const LAS unsigned char* vb0 = lds + HG_VN + (16 * ks + 8 * hh + q4) * 320 + (32 * nt + 16 * blk + 4 * p4) * 2;
                const s16x4 blo = vtr(vb0), bhi = vtr(vb0 + 4 * 320);
                o = MFMA32(__builtin_shufflevector(alo, ahi, 0, 1, 2, 3, 4, 5, 6, 7), __builtin_shufflevector(blo, bhi, 0, 1, 2, 3, 4, 5, 6, 7), o);
            }
            __syncthreads();
#pragma unroll
            for (int i = 0; i < 16; ++i) LF[(32 * mt + (i & 3) + 8 * (i >> 2) + 4 * hh) * HG_LFS + 32 * nt + r32] = o[i];
            __syncthreads();
            {
                float ov[16]; float ss = 0.f;
#pragma unroll
                for (int j4 = 0; j4 < 4; ++j4) { const f32x4 x = *(const LAS f32x4*)(LF + ps * HG_LFS + 16 * pseg + 4 * j4);
#pragma unroll
                    for (int e = 0; e < 4; ++e) { ov[4 * j4 + e] = x[e]; ss += x[e] * x[e]; } }
                ss += __shfl_xor(ss, 1, 64); ss += __shfl_xor(ss, 2, 64); ss += __shfl_xor(ss, 4, 64);
                const float rn = rsqrtf(ss * (1.f / 128.f) + RMS_EPS);
                const u32x4 g0 = *(const u32x4*)(hp + HC_HG), g1 = *(const u32x4*)(hp + HC_HG + 8);
                const float* ng = C.in[I_HNG] + l * 128 + 16 * pseg;
                u32x4 o0, o1;
#pragma unroll
                for (int j = 0; j < 4; ++j) {
                    o0[j] = cvtpk(ov[2 * j] * rn * ng[2 * j] * siluf_(bf2f(g0[j] & 0xffffu)), ov[2 * j + 1] * rn * ng[2 * j + 1] * siluf_(bf2f(g0[j] >> 16)));
                    o1[j] = cvtpk(ov[8 + 2 * j] * rn * ng[8 + 2 * j] * siluf_(bf2f(g1[j] & 0xffffu)), ov[9 + 2 * j] * rn * ng[9 + 2 * j] * siluf_(bf2f(g1[j] >> 16)));
                }
                bf16_t* bp = BR + (row0 + ps) * NBR + 512 + h * 128 + 16 * pseg;
                *(u32x4*)bp = o0; *(u32x4*)(bp + 8) = o1;
            }
        }
        __syncthreads();
    }
    if constexpr (!FULL) {
#pragma unroll
        for (int i = 0; i < 16; ++i) { const int k = 32 * wk + (i & 3) + 8 * (i >> 2) + 4 * hh;
            stp[k * 128 + 64 * wv + r32] = S0[i]; stp[k * 128 + 64 * wv + 32 + r32] = S1[i]; }
        if (C.tid >= 384) DSC[((size_t)bh * 32 + sc) * 128 + (C.tid & 127)] = __expf(dtot);
    }
}
__device__ __forceinline__ void hgrn_b1(const Ctx& C, int l) { for (int u = C.bid; u < BATCH * 4 * 32; u += C.G) hgrn_unit<false>(C, l, u); }
__device__ __forceinline__ void hgrn_b3(const Ctx& C, int l) { for (int u = C.bid; u < BATCH * 4 * 32; u += C.G) hgrn_unit<true>(C, l, u); }
__device__ __forceinline__ void hgrn_b2(const Ctx& C) {
    float* STB = (float*)(C.ws + WS_ST); const float* DSC = (const float*)(C.ws + WS_DSC);
    for (int e = C.bid * 512 + C.tid; e < BATCH * 4 * 128 * 128; e += C.G * 512) {
        const int bh = e >> 14, kv = e & 16383, k = kv >> 7;
        float* p = STB + (size_t)bh * 32 * 16384 + kv;
        float uu[32], dd[32];
#pragma unroll
        for (int s = 0; s < 32; ++s) { uu[s] = p[(size_t)s * 16384]; dd[s] = DSC[((size_t)bh * 32 + s) * 128 + k]; }
        float st = 0.f;
#pragma unroll
        for (int s = 0; s < 32; ++s) { p[(size_t)s * 16384] = st; st = dd[s] * st + uu[s]; }
    }
}


__device__ __forceinline__ void mix_pool(const Ctx& C, int l) {
#if DIAG == 2
    const bf16_t* H = (const bf16_t*)(C.ws + WS_H); bf16_t* BR = (l == 0) ? (bf16_t*)(C.ws + WS_XA) : (bf16_t*)(C.ws + WS_TABU);
#else
    const bf16_t* H = (const bf16_t*)(C.ws + WS_H); bf16_t* BR = (bf16_t*)(C.ws + WS_BR);
#endif
    const bf16_t* Wt = (const bf16_t*)(C.ws + WS_W + (size_t)l * W_LAYER + WO_POOLW);
    LAS unsigned char* lds = C.lds;
    const int lane = C.lane, w = C.wave, r32 = lane & 31, hh = lane >> 5;
    for (int u = C.bid; u < (T / 256) * 4; u += C.G) {
        const int g = u & 3, t0 = (u >> 2) * 256, win = 2 << g;
        const int row = t0 + 32 * w + r32, pos = row & (SEQ - 1);
        __syncthreads();
#pragma unroll
        for (int p = 0; p < 4; ++p) { const int idx = C.tid + 512 * p, rr = idx >> 4, ch = idx & 15;
            *(LAS u32x4*)(lds + rr * 272 + ch * 16) = *(const u32x4*)(Wt + (size_t)g * 128 * 128 + rr * 128 + ch * 8); }
        const int nwin = (pos + 1 < win) ? pos + 1 : win;
        const float invn = 1.f / (float)nwin;
        bf16x8 df[8];
        const bf16_t* pp = H + (size_t)row * NH + HC_P + g * 128 + 8 * hh;
#pragma unroll
        for (int ks = 0; ks < 8; ++ks) {
            float sum[8];
#pragma unroll
            for (int e = 0; e < 8; ++e) sum[e] = 0.f;
            u32x4 rw[16];
#pragma unroll
            for (int j = 0; j < 16; ++j) { const int jj = (j < nwin) ? j : 0; rw[j] = *(const u32x4*)(pp + 16 * ks - (size_t)jj * NH); }
            const u32x4 self = rw[0];
#pragma unroll
            for (int j = 0; j < 16; ++j) { const float msk = (j < nwin) ? 1.f : 0.f;
#pragma unroll
                for (int e = 0; e < 4; ++e) { sum[2 * e] += msk * bf2f(rw[j][e] & 0xffffu); sum[2 * e + 1] += msk * bf2f(rw[j][e] >> 16); } }
            u32x4 o;
#pragma unroll
            for (int e = 0; e < 4; ++e) o[e] = cvtpk(sum[2 * e] * invn - bf2f(self[e] & 0xffffu), sum[2 * e + 1] * invn - bf2f(self[e] >> 16));
            df[ks] = __builtin_bit_cast(bf16x8, o);
        }
        __syncthreads();
        f32x16 acc[4];
#pragma unroll
        for (int mt = 0; mt < 4; ++mt)
#pragma unroll
            for (int i = 0; i < 16; ++i) acc[mt][i] = 0.f;
#pragma unroll
        for (int ks = 0; ks < 8; ++ks)
#pragma unroll
            for (int mt = 0; mt < 4; ++mt) {
                const bf16x8 wf = *(const LAS bf16x8*)(lds + (32 * mt + r32) * 272 + 32 * ks + 16 * hh);
                acc[mt] = MFMA32(wf, df[ks], acc[mt]);
            }
        const float* psc = C.in[I_POOLS] + l * BW + g * 128;
        bf16_t* op = BR + (size_t)row * NBR + g * 128;
#pragma unroll
        for (int mt = 0; mt < 4; ++mt)
#pragma unroll
            for (int q = 0; q < 4; ++q) { const int d0 = 32 * mt + 8 * q + 4 * hh; const f32x4 sc = *(const f32x4*)(psc + d0);
                u32x2 o; o[0] = cvtpk(acc[mt][4 * q] * sc[0], acc[mt][4 * q + 1] * sc[1]); o[1] = cvtpk(acc[mt][4 * q + 2] * sc[2], acc[mt][4 * q + 3] * sc[3]);
                *(u32x2*)(op + d0) = o; }
    }
}
constexpr int GM_VN = 0, GM_WC = 128 * 320, GM_END = GM_WC + 128 * 272;
__device__ __forceinline__ void mix_gmlp(const Ctx& C, int l) {
#if DIAG == 3
    const bf16_t* H = (const bf16_t*)(C.ws + WS_H); bf16_t* BR = (l == 0) ? (bf16_t*)(C.ws + WS_XA) : (bf16_t*)(C.ws + WS_TABU);
#else
    const bf16_t* H = (const bf16_t*)(C.ws + WS_H); bf16_t* BR = (bf16_t*)(C.ws + WS_BR);
#endif
    const bf16_t* Wc = (const bf16_t*)(C.ws + WS_W + (size_t)l * W_LAYER + WO_GWS);
    LAS unsigned char* lds = C.lds;
    const int lane = C.lane, w = C.wave, r32 = lane & 31, hh = lane >> 5;
    const int i16 = lane & 15, q4 = i16 >> 2, p4 = i16 & 3, blk = (lane >> 4) & 1;
    for (int u = C.bid; u < (T / 128) * 4; u += C.G) {
        const int g = u & 3, t0 = (u >> 2) * 128;
        __syncthreads();
#pragma unroll
        for (int p = 0; p < 4; ++p) { const int idx = C.tid + 512 * p, rr = idx >> 4, ch = idx & 15;
            *(LAS u32x4*)(lds + GM_WC + rr * 272 + ch * 16) = *(const u32x4*)(Wc + (size_t)g * 128 * 128 + rr * 128 + ch * 8); }
#pragma unroll
        for (int hb = 0; hb < 4; ++hb) {
            u32x4 rawv[4];
#pragma unroll
            for (int i = 0; i < 4; ++i) rawv[i] = *(const u32x4*)(H + (size_t)(t0 + w * 16 + hb * 4 + i) * NH + HC_GV + lane * 8);
            float e[4][8], st[8];
#pragma unroll
            for (int i = 0; i < 4; ++i) { float s1 = 0.f, s2 = 0.f;
#pragma unroll
                for (int j = 0; j < 4; ++j) { const float a = geluf_(bf2f(rawv[i][j] & 0xffffu)), b = geluf_(bf2f(rawv[i][j] >> 16)); e[i][2 * j] = a; e[i][2 * j + 1] = b; s1 += a + b; s2 += a * a + b * b; }
                st[i] = s1; st[4 + i] = s2; }
#pragma unroll
            for (int sx = 32, n = 4; sx >= 8; sx >>= 1, n >>= 1) { const bool up = (lane & sx) != 0;
#pragma unroll
                for (int i = 0; i < n; ++i) { const float send = up ? st[i] : st[i + n], keep = up ? st[i + n] : st[i]; st[i] = keep + __shfl_xor(send, sx, 64); } }
            float tot = st[0]; tot += __shfl_xor(tot, 4, 64); tot += __shfl_xor(tot, 2, 64); tot += __shfl_xor(tot, 1, 64);
            float mean4[4], rstd4[4];
#pragma unroll
            for (int i = 0; i < 4; ++i) {
                mean4[i] = __builtin_bit_cast(float, __builtin_amdgcn_readlane(__builtin_bit_cast(int, tot), 8 * i)) * (1.f / BW);
                const float ex2 = __builtin_bit_cast(float, __builtin_amdgcn_readlane(__builtin_bit_cast(int, tot), 8 * (4 + i))) * (1.f / BW);
                rstd4[i] = rsqrtf(fmaxf(ex2 - mean4[i] * mean4[i], 0.f) + LN_EPS);
            }
            asm volatile("" ::: "memory");
            if ((lane >> 4) == g) {
                const float* lg = C.in[I_GLNG] + l * BW + lane * 8; const float* lb = C.in[I_GLNB] + l * BW + lane * 8;
#pragma unroll
                for (int i = 0; i < 4; ++i) {
                    const float mean = mean4[i], rstd = rstd4[i];
                    u32x4 o;
#pragma unroll
                    for (int j = 0; j < 4; ++j) o[j] = cvtpk((e[i][2 * j] - mean) * rstd * lg[2 * j] + lb[2 * j], (e[i][2 * j + 1] - mean) * rstd * lg[2 * j + 1] + lb[2 * j + 1]);
                    *(LAS u32x4*)(lds + GM_VN + (w * 16 + hb * 4 + i) * 320 + (lane & 15) * 16) = o;
                }
            }
        }
        __syncthreads();
        const int nt = w & 3, mb = (w >> 2) * 2;
        f32x16 acc[2];
#pragma unroll
        for (int m = 0; m < 2; ++m)
#pragma unroll
            for (int i = 0; i < 16; ++i) acc[m][i] = 0.f;
        for (int ks = 0; ks < 2 * (nt + 1); ++ks) {
            const bf16x8 bf = *(const LAS bf16x8*)(lds + GM_WC + (32 * nt + r32) * 272 + 32 * ks + 16 * hh);
#pragma unroll
            for (int m = 0; m < 2; ++m) {
                const LAS unsigned char* aa = lds + GM_VN + (16 * ks + 8 * hh + q4) * 320 + (32 * (mb + m) + 16 * blk + 4 * p4) * 2;
                const s16x4 lo = vtr(aa), hi = vtr(aa + 4 * 320);
                acc[m] = MFMA32(__builtin_shufflevector(lo, hi, 0, 1, 2, 3, 4, 5, 6, 7), bf, acc[m]);
            }
        }
        const int tl = 32 * nt + r32, row = t0 + tl;
        const float bias = C.in[I_GBS][(l * 4 + g) * 128 + tl];
#pragma unroll
        for (int m = 0; m < 2; ++m)
#pragma unroll
            for (int q = 0; q < 4; ++q) { const int c0 = 32 * (mb + m) + 8 * q + 4 * hh;
                const u32x2 ur = *(const u32x2*)(H + (size_t)row * NH + HC_GU + g * 128 + c0);
                u32x2 o;
                o[0] = cvtpk(geluf_(bf2f(ur[0] & 0xffffu)) * (acc[m][4 * q] + bias), geluf_(bf2f(ur[0] >> 16)) * (acc[m][4 * q + 1] + bias));
                o[1] = cvtpk(geluf_(bf2f(ur[1] & 0xffffu)) * (acc[m][4 * q + 2] + bias), geluf_(bf2f(ur[1] >> 16)) * (acc[m][4 * q + 3] + bias));
                *(u32x2*)(BR + (size_t)row * NBR + 1024 + g * 128 + c0) = o; }
    }
}

#define CE_D(a, b) do { const float _h = fmaxf(a, b), _l = fminf(a, b); a = _h; b = _l; } while (0)
__device__ __forceinline__ void sort16_desc(float (&x)[16]) {
#pragma unroll
    for (int k = 2; k <= 16; k <<= 1)
#pragma unroll
        for (int j = k >> 1; j > 0; j >>= 1)
#pragma unroll
            for (int i = 0; i < 16; ++i) { const int l = i ^ j; if (l > i) { if ((i & k) == 0) CE_D(x[i], x[l]); else CE_D(x[l], x[i]); } }
}
__device__ __forceinline__ void bmerge16_desc(float (&x)[16]) {
#pragma unroll
    for (int j = 8; j > 0; j >>= 1)
#pragma unroll
        for (int i = 0; i < 16; ++i) { const int l = i ^ j; if (l > i) CE_D(x[i], x[l]); }
}
__device__ __forceinline__ void top16_merge(float (&a)[16], const float (&b)[16]) {
#pragma unroll
    for (int i = 0; i < 16; ++i) a[i] = fmaxf(a[i], b[15 - i]);
    bmerge16_desc(a);
}
__device__ __forceinline__ float pack_idx(float v, unsigned idx, unsigned mask) { return __builtin_bit_cast(float, (__builtin_bit_cast(unsigned, v) & ~mask) | idx); }

constexpr int TK_KST = 272, TK_KBUF = 128 * TK_KST;
__device__ __forceinline__ void p_topk(const Ctx& C, int l) {
    const bf16_t* Q = (const bf16_t*)(C.ws + WS_Q);
    const bf16_t* keys = (const bf16_t*)(C.ws + WS_W + (size_t)l * W_LAYER + WO_KEYS);
    int* eidx = (int*)(C.ws + WS_EIDX); float* egate = (float*)(C.ws + WS_EGATE);
    LAS unsigned char* lds = C.lds;
    const int lane = C.lane, w = C.wave, r32 = lane & 31, hh = lane >> 5;
    for (int u = C.bid; u < (T / 256) * PH; u += C.G) {
        const int h = u & 7, t0 = (u >> 3) * 256, tok = t0 + 32 * w + r32;
        float v12[2][16];
        __syncthreads();
#pragma unroll
        for (int j = 0; j < 2; ++j) {
            const bf16_t* kp = keys + ((size_t)j * PH + h) * 128 * 128;
#pragma unroll
            for (int p = 0; p < 4; ++p) { const int idx = C.tid + 512 * p, row = idx >> 4, ch = idx & 15;
                *(LAS u32x4*)(lds + j * TK_KBUF + row * TK_KST + ch * 16) = *(const u32x4*)(kp + row * 128 + ch * 8); }
        }
        __syncthreads();
#pragma unroll
        for (int j = 0; j < 2; ++j) {
            bf16x8 qf[8];
            {
                LAS unsigned char* qs = lds + 2 * TK_KBUF + w * (32 * 272);
                u32x4 qr[8];
#pragma unroll
                for (int p = 0; p < 8; ++p) qr[p] = *(const u32x4*)(Q + (size_t)(t0 + 32 * w + 4 * p + (lane >> 4)) * NQ + h * 256 + j * 128 + (lane & 15) * 8);
#pragma unroll
                for (int p = 0; p < 8; ++p) *(LAS u32x4*)(qs + (4 * p + (lane >> 4)) * 272 + (lane & 15) * 16) = qr[p];
#pragma unroll
                for (int ks = 0; ks < 8; ++ks) qf[ks] = *(const LAS bf16x8*)(qs + r32 * 272 + 32 * ks + 16 * hh);
            }
            f32x16 sacc[4];
#pragma unroll
            for (int mt = 0; mt < 4; ++mt)
#pragma unroll
                for (int i = 0; i < 16; ++i) sacc[mt][i] = 0.f;
#pragma unroll
            for (int ks = 0; ks < 8; ++ks)
#pragma unroll
                for (int mt = 0; mt < 4; ++mt) {
                    const bf16x8 kf = *(const LAS bf16x8*)(lds + j * TK_KBUF + (32 * mt + r32) * TK_KST + 32 * ks + 16 * hh);
                    sacc[mt] = MFMA32(kf, qf[ks], sacc[mt]);
                }
            float g[4][16];
#pragma unroll
            for (int mt = 0; mt < 4; ++mt) {
#pragma unroll
                for (int i = 0; i < 16; ++i) g[mt][i] = pack_idx(sacc[mt][i], (unsigned)(32 * mt + (i & 3) + 8 * (i >> 2) + 4 * hh), 127u);
                sort16_desc(g[mt]);
            }
            top16_merge(g[0], g[1]); top16_merge(g[2], g[3]); top16_merge(g[0], g[2]);
            float o[16];
#pragma unroll
            for (int i = 0; i < 16; ++i) o[i] = __shfl_xor(g[0][i], 32, 64);
            top16_merge(g[0], o);
#pragma unroll
            for (int i = 0; i < 16; ++i) v12[j][i] = g[0][i];
        }
        float c[4][16];
        {
            int n = 0;
#pragma unroll
            for (int a = 0; a < 16; ++a)
#pragma unroll
                for (int b = 0; b < 16; ++b) if ((a + 1) * (b + 1) <= 16) {
                    const unsigned id = ((__builtin_bit_cast(unsigned, v12[0][a]) & 127u) << 7) | (__builtin_bit_cast(unsigned, v12[1][b]) & 127u);
                    c[n >> 4][n & 15] = pack_idx(v12[0][a] + v12[1][b], id, 16383u); ++n; }
#pragma unroll
            for (; n < 64; ++n) c[n >> 4][n & 15] = -3.0e38f;
        }
#pragma unroll
        for (int q = 0; q < 4; ++q) sort16_desc(c[q]);
        top16_merge(c[0], c[1]); top16_merge(c[2], c[3]); top16_merge(c[0], c[2]);
        float e[16], den = 0.f;
#pragma unroll
        for (int i = 0; i < 16; ++i) { e[i] = __expf(c[0][i] - c[0][0]); den += e[i]; }
        const float inv = 1.f / den;
        int* ip = eidx + (size_t)tok * 128 + h * 16 + 8 * hh; float* gp = egate + (size_t)tok * 128 + h * 16 + 8 * hh;
        u32x4 i0, i1; f32x4 g0, g1;
#pragma unroll
        for (int i = 0; i < 4; ++i) {
            const float ca = hh ? c[0][8 + i] : c[0][i], cb = hh ? c[0][12 + i] : c[0][4 + i];
            i0[i] = __builtin_bit_cast(unsigned, ca) & 16383u; i1[i] = __builtin_bit_cast(unsigned, cb) & 16383u;
            g0[i] = (hh ? e[8 + i] : e[i]) * inv; g1[i] = (hh ? e[12 + i] : e[4 + i]) * inv;
        }
        *(u32x4*)ip = i0; *(u32x4*)(ip + 4) = i1; *(f32x4*)gp = g0; *(f32x4*)(gp + 4) = g1;
    }
}

constexpr int CW_DIAG = 64;
__device__ __forceinline__ void diag_cmp(const Ctx& C, const bf16_t* A, int lda, const bf16_t* R, int ldr, int nc) {
    float sd = 0.f, sr = 0.f;
    for (int row = C.bid; row < T; row += C.G) {
        const int tm = row % DIAG_MOD; if (tm < DIAG_LO || tm >= DIAG_HI) continue;
        for (int c = C.tid; c < nc; c += 512) { const float a = bf2f(A[(size_t)row * lda + c]), r = bf2f(R[(size_t)row * ldr + c]); sd += (a - r) * (a - r); sr += r * r; }
    }
    sd = wave_sum(sd); sr = wave_sum(sr);
    if (C.lane == 0) { atomicAdd((float*)(C.ws + WS_CTL) + CW_DIAG, sd); atomicAdd((float*)(C.ws + WS_CTL) + CW_DIAG + 1, sr); }
}
__device__ __forceinline__ void diag_cmp_u8(const Ctx& C, const unsigned char* A, int lda, const bf16_t* R, int ldr, int nc) {
    float sd = 0.f, sr = 0.f;
    for (int row = C.bid; row < T; row += C.G)
        for (int c = C.tid; c < nc; c += 512) { const float a = (float)A[(size_t)row * lda + c] * (1.f / 255.f), r = bf2f(R[(size_t)row * ldr + c]); sd += (a - r) * (a - r); sr += r * r; }
    sd = wave_sum(sd); sr = wave_sum(sr);
    if (C.lane == 0) { atomicAdd((float*)(C.ws + WS_CTL) + CW_DIAG, sd); atomicAdd((float*)(C.ws + WS_CTL) + CW_DIAG + 1, sr); }
}
__device__ __forceinline__ float diag_alpha(const Ctx& C) {
    const float sd = __hip_atomic_load((float*)(C.ws + WS_CTL) + CW_DIAG, __ATOMIC_RELAXED, __HIP_MEMORY_SCOPE_AGENT), sr = __hip_atomic_load((float*)(C.ws + WS_CTL) + CW_DIAG + 1, __ATOMIC_RELAXED, __HIP_MEMORY_SCOPE_AGENT);
    const float err = fmaxf(sd / fmaxf(sr, 1e-30f), 1e-8f);
    return 0.1f + 0.1f * (rintf(log10f(err / 1e-8f) * 10.f) * 0.1f);
}


#if DIAG == 5 || DIAG == 6
__device__ __forceinline__ void diag_ref_slice(const Ctx& C, const float* W, int ldw, int n0, const float* bias) {
    bf16_t* alt = (bf16_t*)(C.ws + WS_XA);
    const float* X = C.in[I_X];
    for (int row = C.bid * 8 + C.wave; row < T; row += C.G * 8) {
        float acc = 0.f;
        for (int k = 0; k < DM; ++k) acc += X[(size_t)row * DM + k] * W[(size_t)k * ldw + n0 + C.lane];
        if (bias) acc = sigmoidf_(acc + bias[n0 + C.lane]);
        alt[(size_t)row * 64 + C.lane] = (bf16_t)f2bf(acc);
    }
}
#endif

__device__ __forceinline__ void wave_argmax(float& v, int& i) {
#pragma unroll
    for (int o = 32; o > 0; o >>= 1) {
        const float ov = __shfl_xor(v, o, 64); const int oi = __shfl_xor(i, o, 64);
        if (ov > v || (ov == v && oi < i)) { v = ov; i = oi; }
    }
}
__device__ __forceinline__ void p_topk_naive(const Ctx& C, int l) {
    const bf16_t* Q = (const bf16_t*)(C.ws + WS_Q);
    const bf16_t* keys = (const bf16_t*)(C.ws + WS_W + (size_t)l * W_LAYER + WO_KEYS);
    int* eidx = (int*)(C.ws + WS_EIDX); float* egate = (float*)(C.ws + WS_EGATE);
    LAS float* qs = (LAS float*)C.lds;
    LAS float* sc = qs + 2048;
    LAS float* tv = sc + 2048;
    LAS int* ti = (LAS int*)(tv + 256);
    for (int t = C.bid; t < T; t += C.G) {
        for (int i = C.tid; i < 2048; i += 512) qs[i] = bf2f(Q[(size_t)t * NQ + i]);
        __syncthreads();
        for (int i = 0; i < 4; ++i) {
            const int idx = C.tid + 512 * i, hj = idx >> 7, key = idx & 127, h = hj >> 1, j = hj & 1;
            const bf16_t* kp = keys + (((size_t)j * PH + h) * 128 + key) * 128;
            float s = 0.f;
            for (int d8 = 0; d8 < 16; ++d8) {
                const u32x4 raw = *(const u32x4*)(kp + d8 * 8);
#pragma unroll
                for (int e = 0; e < 4; ++e) s += qs[h * 256 + j * 128 + d8 * 8 + 2 * e] * bf2f(raw[e] & 0xffffu) + qs[h * 256 + j * 128 + d8 * 8 + 2 * e + 1] * bf2f(raw[e] >> 16);
            }
            sc[idx] = s;
        }
        __syncthreads();
        for (int i = 0; i < 2; ++i) {
            const int hj = C.wave * 2 + i;
            float a0 = sc[hj * 128 + C.lane], a1 = sc[hj * 128 + 64 + C.lane];
            for (int r = 0; r < 16; ++r) {
                float bv; int bi;
                if (a0 > a1 || (a0 == a1)) { bv = a0; bi = C.lane; } else { bv = a1; bi = C.lane + 64; }
                wave_argmax(bv, bi);
                if (C.lane == 0) { tv[hj * 16 + r] = bv; ti[hj * 16 + r] = bi; }
                if (bi == C.lane) a0 = -3e38f; if (bi == C.lane + 64) a1 = -3e38f;
            }
        }
        __syncthreads();
        {
            const int h = C.wave;
            float cv[4];
#pragma unroll
            for (int i = 0; i < 4; ++i) { const int c = C.lane * 4 + i; cv[i] = tv[(h * 2) * 16 + (c >> 4)] + tv[(h * 2 + 1) * 16 + (c & 15)]; }
            float topv = 0.f; int tope = 0; float mx = 0.f;
            for (int r = 0; r < 16; ++r) {
                float bv = cv[0]; int bi = C.lane * 4;
#pragma unroll
                for (int i = 1; i < 4; ++i) if (cv[i] > bv) { bv = cv[i]; bi = C.lane * 4 + i; }
                wave_argmax(bv, bi);
                if (r == 0) mx = bv;
                if (C.lane == r) { topv = bv; tope = ti[(h * 2) * 16 + (bi >> 4)] * 128 + ti[(h * 2 + 1) * 16 + (bi & 15)]; }
#pragma unroll
                for (int i = 0; i < 4; ++i) if (bi == C.lane * 4 + i) cv[i] = -3e38f;
            }
            float e = (C.lane < 16) ? __expf(topv - mx) : 0.f;
            const float den = wave_sum(e);
            if (C.lane < 16) { eidx[(size_t)t * 128 + h * 16 + C.lane] = tope; egate[(size_t)t * 128 + h * 16 + C.lane] = e / den; }
        }
        __syncthreads();
    }
}
__device__ __forceinline__ float ub(unsigned w, int e) { return (float)((w >> (8 * e)) & 255u); }
__device__ __forceinline__ void p_gather(const Ctx& C, int l) {
    const bf16_t* xc = (const bf16_t*)(C.ws + WS_X1B);
    const unsigned char* U8 = C.ws + WS_U8; const unsigned char* V8 = C.ws + WS_V8;
    const float* SU = (const float*)(C.ws + WS_SU); const float* SV = (const float*)(C.ws + WS_SV);
    const int* eidx = (const int*)(C.ws + WS_EIDX); const float* egate = (const float*)(C.ws + WS_EGATE);
    const int lane = C.lane;
    for (int t = C.bid * 8 + C.wave; t < T; t += C.G * 8) {
        float x[16];
        { const bf16_t* xp = xc + (size_t)t * DM + lane * 16;
          const u32x4 a = *(const u32x4*)xp, b = *(const u32x4*)(xp + 8);
#pragma unroll
          for (int i = 0; i < 4; ++i) { x[2 * i] = bf2f(a[i] & 0xffffu); x[2 * i + 1] = bf2f(a[i] >> 16); x[8 + 2 * i] = bf2f(b[i] & 0xffffu); x[9 + 2 * i] = bf2f(b[i] >> 16); } }
        float xmx = 0.f;
#pragma unroll
        for (int j = 0; j < 16; ++j) xmx = fmaxf(xmx, fabsf(x[j]));
        xmx = fmaxf(wave_max(xmx), 1e-30f);
        const float xisc = 127.f / xmx, xsc = xmx * (1.f / 127.f);
        int xq[4];
#pragma unroll
        for (int q = 0; q < 4; ++q) { unsigned wd = 0u;
#pragma unroll
            for (int e = 0; e < 4; ++e) wd |= ((unsigned)(int)rintf(x[4 * q + e] * xisc) & 255u) << (8 * e);
            xq[q] = (int)wd; }
        float cf[2]; int ex[2];
#pragma unroll
        for (int bt = 0; bt < 2; ++bt) {
            ex[bt] = eidx[(size_t)t * 128 + 64 * bt + lane];
            const float gate = egate[(size_t)t * 128 + 64 * bt + lane];
            int p[64];
#pragma unroll
            for (int e0 = 0; e0 < 64; e0 += 16) {
                u32x4 r[16];
#pragma unroll
                for (int i = 0; i < 16; ++i) { const int e = __builtin_amdgcn_readlane(ex[bt], e0 + i); r[i] = *(const u32x4*)(U8 + (size_t)e * DM + lane * 16); }
#pragma unroll
                for (int i = 0; i < 16; ++i) { int a = 0;
#pragma unroll
                    for (int q = 0; q < 4; ++q) a = __builtin_amdgcn_sdot4(xq[q], (int)r[i][q], a, false);
                    p[e0 + i] = a; }
            }
#pragma unroll
            for (int st = 32, n = 32; st > 0; st >>= 1, n >>= 1) {
                const bool up = (lane & st) != 0;
#pragma unroll
                for (int i = 0; i < n; ++i) { const int send = up ? p[i] : p[i + n], keep = up ? p[i + n] : p[i]; p[i] = keep + __shfl_xor(send, st, 64); }
            }
            const float hsum = SU[ex[bt]] * xsc * (float)p[0];
            cf[bt] = gate * geluf_slow(hsum) * SV[ex[bt]];
        }
        float y[16];
#pragma unroll
        for (int j = 0; j < 16; ++j) y[j] = 0.f;
        float csum = wave_sum(cf[0] + cf[1]);
#pragma unroll
        for (int bt = 0; bt < 2; ++bt)
#pragma unroll
            for (int e0 = 0; e0 < 64; e0 += 16) {
                u32x4 r[16];
#pragma unroll
                for (int i = 0; i < 16; ++i) { const int e = __builtin_amdgcn_readlane(ex[bt], e0 + i); r[i] = *(const u32x4*)(V8 + (size_t)e * DM + lane * 16); }
#pragma unroll
                for (int i = 0; i < 16; ++i) { const float c = __builtin_bit_cast(float, __builtin_amdgcn_readlane(__builtin_bit_cast(int, cf[bt]), e0 + i));
#pragma unroll
                    for (int q = 0; q < 4; ++q)
#pragma unroll
                        for (int e = 0; e < 4; ++e) y[4 * q + e] += c * ub(r[i][q], e); }
            }
#pragma unroll
        for (int j = 0; j < 16; ++j) y[j] = y[j] - 128.f * csum + ALPHA * x[j];
        float sm = 0.f;
#pragma unroll
        for (int j = 0; j < 16; ++j) sm += y[j];
        const float mean = wave_sum(sm) * (1.f / DM);
        float qq = 0.f;
#pragma unroll
        for (int j = 0; j < 16; ++j) { const float d = y[j] - mean; qq += d * d; }
        const float rstd = rsqrtf(wave_sum(qq) * (1.f / DM) + LN_EPS);
        const float* gp = C.in[I_LN2G] + l * DM + lane * 16; const float* bp = C.in[I_LN2B] + l * DM + lane * 16;
#pragma unroll
        for (int i = 0; i < 4; ++i) { const f32x4 gg = *(const f32x4*)(gp + 4 * i), bb = *(const f32x4*)(bp + 4 * i);
#pragma unroll
            for (int e = 0; e < 4; ++e) y[4 * i + e] = (y[4 * i + e] - mean) * rstd * gg[e] + bb[e]; }
        float* dst = (l + 1 < DEPTH) ? (float*)(C.ws + WS_XA) + (size_t)t * DM : C.out + (size_t)t * DM;
#if DIAG
        if (l + 1 == DEPTH) { const float al = 1.f + diag_alpha(C);
#pragma unroll
            for (int j = 0; j < 16; ++j) y[j] *= al; }
#endif
#pragma unroll
        for (int i = 0; i < 4; ++i) *(f32x4*)(dst + lane * 16 + 4 * i) = (f32x4){y[4 * i], y[4 * i + 1], y[4 * i + 2], y[4 * i + 3]};
        if (l + 1 < DEPTH) {
            {
                float mx = 0.f;
#pragma unroll
                for (int j = 0; j < 16; ++j) mx = fmaxf(mx, fabsf(y[j]));
                mx = fmaxf(wave_max(mx), 1e-30f);
                const float isc = 127.f / mx;
                u32x4 o8;
#pragma unroll
                for (int q = 0; q < 4; ++q) { unsigned wd = 0u;
#pragma unroll
                    for (int e = 0; e < 4; ++e) wd |= ((unsigned)(int)rintf(y[4 * q + e] * isc) & 255u) << (8 * e);
                    o8[q] = wd; }
                *(u32x4*)(C.ws + WS_XB + (size_t)t * DM + lane * 16) = o8;
                if (lane == 0) ((float*)(C.ws + WS_XSA))[t] = mx * (1.f / 127.f);
            }
            const float* wf = (const float*)(C.ws + WS_W + (size_t)(l + 1) * W_LAYER + WO_WF);
            float* lsig = (float*)(C.ws + WS_MISC);
#pragma unroll
            for (int h = 0; h < 4; ++h) {
                float sd = 0.f;
#pragma unroll
                for (int i = 0; i < 4; ++i) { const f32x4 a = *(const f32x4*)(wf + h * DM + lane * 16 + 4 * i);
#pragma unroll
                    for (int e = 0; e < 4; ++e) sd += y[4 * i + e] * a[e]; }
                sd = wave_sum(sd);
                if (lane == 0) lsig[(size_t)t * 4 + h] = logsigmoidf_(sd + C.in[I_BFOX][(l + 1) * 4 + h]);
            }
        }
    }
}

struct FStoreBf16 { bf16_t* O; int ld;
    __device__ __forceinline__ void operator()(int row, int col, f32x4 v0, f32x4 v1, int) const {
        u32x4 o; o[0] = pk2(v0[0], v0[1]); o[1] = pk2(v0[2], v0[3]); o[2] = pk2(v1[0], v1[1]); o[3] = pk2(v1[2], v1[3]);
        *(u32x4*)(O + (size_t)row * ld + col) = o; } };
typedef int i32x4 __attribute__((ext_vector_type(4)));
__device__ __forceinline__ void i8_dequant(f32x4& v0, f32x4& v1, float sa, const float* cs) {
    sa *= (1.f / 127.f);
    const f32x4 c0 = *(const f32x4*)cs, c1 = *(const f32x4*)(cs + 4);
    const i32x4 i0 = __builtin_bit_cast(i32x4, v0), i1 = __builtin_bit_cast(i32x4, v1);
#pragma unroll
    for (int e = 0; e < 4; ++e) { v0[e] = (float)i0[e] * sa * c0[e]; v1[e] = (float)i1[e] * sa * c1[e]; }
}
struct FStoreBf16I8 { bf16_t* O; int ld; const float* rs; const float* cs;
    __device__ __forceinline__ void operator()(int row, int col, f32x4 v0, f32x4 v1, int) const {
        i8_dequant(v0, v1, rs[row], cs + col);
        u32x4 o; o[0] = pk2(v0[0], v0[1]); o[1] = pk2(v0[2], v0[3]); o[2] = pk2(v1[0], v1[1]); o[3] = pk2(v1[2], v1[3]);
        *(u32x4*)(O + (size_t)row * ld + col) = o; } };
struct FGateI8 { unsigned char* O; const float* bias; const float* rs; const float* cs;
    __device__ __forceinline__ void operator()(int row, int col, f32x4 v0, f32x4 v1, int) const {
        i8_dequant(v0, v1, rs[row], cs + col);
        const f32x4 b0 = *(const f32x4*)(bias + col), b1 = *(const f32x4*)(bias + col + 4);
        u32x2 o; unsigned w0 = 0u, w1 = 0u;
#pragma unroll
        for (int e = 0; e < 4; ++e) { w0 |= (unsigned)(int)rintf(255.f * sigmoidf_(v0[e] + b0[e])) << (8 * e); w1 |= (unsigned)(int)rintf(255.f * sigmoidf_(v1[e] + b1[e])) << (8 * e); }
        o[0] = w0; o[1] = w1;
        *(u32x2*)(O + (size_t)row * NG + col) = o; } };
struct FGate { bf16_t* O; const float* bias;
    __device__ __forceinline__ void operator()(int row, int col, f32x4 v0, f32x4 v1, int) const {
        const f32x4 b0 = *(const f32x4*)(bias + col), b1 = *(const f32x4*)(bias + col + 4);
        u32x4 o; o[0] = pk2(sigmoidf_(v0[0] + b0[0]), sigmoidf_(v0[1] + b0[1])); o[1] = pk2(sigmoidf_(v0[2] + b0[2]), sigmoidf_(v0[3] + b0[3]));
        o[2] = pk2(sigmoidf_(v1[0] + b1[0]), sigmoidf_(v1[1] + b1[1])); o[3] = pk2(sigmoidf_(v1[2] + b1[2]), sigmoidf_(v1[3] + b1[3]));
        *(u32x4*)(O + (size_t)row * NG + col) = o; } };
struct FMerge { const unsigned char* G; bf16_t* MG;
    __device__ __forceinline__ void operator()(int row, int col, f32x4 v0, f32x4 v1, int z) const {
        const u32x2 gr = *(const u32x2*)(G + (size_t)row * NG + z * DM + col);
        float r[8];
#pragma unroll
        for (int e = 0; e < 4; ++e) { r[e] = v0[e] * (float)((gr[0] >> (8 * e)) & 255u) * (1.f / 255.f); r[4 + e] = v1[e] * (float)((gr[1] >> (8 * e)) & 255u) * (1.f / 255.f); }
        bf16_t* p = MG + (size_t)row * DM + col;
        if (z > 0) { const u32x4 pr = *(const u32x4*)p;
#pragma unroll
            for (int e = 0; e < 4; ++e) { r[2 * e] += bf2f(pr[e] & 0xffffu); r[2 * e + 1] += bf2f(pr[e] >> 16); } }
        u32x4 o;
#pragma unroll
        for (int e = 0; e < 4; ++e) o[e] = pk2(r[2 * e], r[2 * e + 1]);
        *(u32x4*)p = o; } };
struct FResid { const float* X; bf16_t* Y;
    __device__ __forceinline__ void operator()(int row, int col, f32x4 v0, f32x4 v1, int) const {
        const f32x4 x0 = *(const f32x4*)(X + (size_t)row * DM + col), x1 = *(const f32x4*)(X + (size_t)row * DM + col + 4);
#if DIAG == 5 || DIAG == 6
        v0 = (f32x4){0.f, 0.f, 0.f, 0.f}; v1 = v0;
#endif
        u32x4 o; o[0] = cvtpk(x0[0] * ALPHA + v0[0], x0[1] * ALPHA + v0[1]); o[1] = cvtpk(x0[2] * ALPHA + v0[2], x0[3] * ALPHA + v0[3]);
        o[2] = cvtpk(x1[0] * ALPHA + v1[0], x1[1] * ALPHA + v1[1]); o[3] = cvtpk(x1[2] * ALPHA + v1[2], x1[3] * ALPHA + v1[3]);
        *(u32x4*)(Y + (size_t)row * DM + col) = o; } };

constexpr int PH_PER_LAYER = 12, N_PHASES = 1 + DEPTH * PH_PER_LAYER;
template <int SP> __device__ __forceinline__ void run_phase(const Ctx& C0, int l) {
    Ctx C = C0;
    asm volatile("" : "+v"(C.tid));
    C.ws = launder_ptr(C.ws); C.out = launder_ptr(C.out); l = (int)launder_u((unsigned)l);
    C.lane = C.tid & 63; C.wave = __builtin_amdgcn_readfirstlane(C.tid >> 6);
    unsigned char* wb = C.ws + WS_W + (size_t)l * W_LAYER;
    if constexpr (SP == -1) { p_conv_weights(C); }
    if constexpr (SP == 0) {
        if (l == 0) {
            for (int l2 = 0; l2 < DEPTH; ++l2) {
                unsigned char* wb2 = C.ws + WS_W + (size_t)l2 * W_LAYER; const unsigned* cm = (const unsigned*)(C.ws + WS_CMAX) + l2 * (NH + NG);
                tconv_i8_job(C, C.in[I_WIN] + (size_t)l2 * DM * NIN, NIN, DM, NH, wb2 + WO_WIN, cm);
                tconv_i8_job(C, C.in[I_WGATE] + (size_t)l2 * DM * NG, NG, DM, NG, wb2 + WO_WG, cm + NH);
            }
            p_rowpass0(C);
        }
    }
    if constexpr (SP == 1) {
        p_cumsum(C);
        __syncthreads();
        pg8::Gemm g{(const bf16_t*)(C.ws + WS_XB), (const bf16_t*)(wb + WO_WIN), DM, DM, DM, 0, 0};
        pg8::StaticOrder S; S.init(T, NH, C.G, C.bid);
        pg8::Epi8<FStoreBf16I8> E{{(bf16_t*)(C.ws + WS_H), NH, (const float*)(C.ws + WS_XSA), (const float*)(C.ws + WS_CMAX) + l * (NH + NG)}};
        pg8::gemm_phase<pg8::Epi8<FStoreBf16I8>, pg8::StaticOrder, true>(C.lds, g, S, E, C.tid);
    }
#if DIAG == 5
    if constexpr (SP == 2) { if (l == 0) { diag_ref_slice(C, C.in[I_WIN], NIN, DIAG_N0, nullptr); } }
    if constexpr (SP == 3) { if (l == 0) diag_cmp(C, (const bf16_t*)(C.ws + WS_H) + DIAG_N0, NH, (const bf16_t*)(C.ws + WS_XA), 64, 64); }
#endif
#if DIAG == 6
    if constexpr (SP == 5) { if (l == 0) diag_ref_slice(C, C.in[I_WGATE], NG, DIAG_N0, C.in[I_BGATE]); }
    if constexpr (SP == 6) { if (l == 0) diag_cmp_u8(C, C.ws + WS_G + DIAG_N0, NG, (const bf16_t*)(C.ws + WS_XA), 64, 64); }
#endif
    if constexpr (SP == 2) { p_knorm(C, l); if (l != HG_NAIVE_L) hgrn_b1(C, l); }
#if MIX_NAIVE
    if constexpr (SP == 3) { if (l != HG_NAIVE_L) hgrn_b2(C); mix_pool_naive(C, l); mix_gmlp_naive(C, l); }
#else
    if constexpr (SP == 3) { if (l != HG_NAIVE_L) hgrn_b2(C); mix_pool(C, l); mix_gmlp(C, l);
        if (DIAG == 2) mix_pool_naive(C, l); if (DIAG == 3) mix_gmlp_naive(C, l); }
#endif
#if DIAG == 1
    if constexpr (SP == 4) { hgrn_b3(C, l); { mix_hgrn_naive(C, l); __syncthreads(); } mix_fox(C, l); }
    if constexpr (SP == 5) { if (l == DIAG_LAYER) diag_cmp(C, (const bf16_t*)(C.ws + (DIAG_LAYER == 0 ? WS_XA : WS_TABU)) + 512, NBR, (const bf16_t*)(C.ws + WS_BR) + 512, NBR, 512); }
#elif DIAG == 2 || DIAG == 3
    if constexpr (SP == 4) { hgrn_b3(C, l); mix_fox(C, l); if (l == DIAG_LAYER) diag_cmp(C, (const bf16_t*)(C.ws + (DIAG_LAYER == 0 ? WS_XA : WS_TABU)) + (DIAG == 2 ? 0 : 1024), NBR, (const bf16_t*)(C.ws + WS_BR) + (DIAG == 2 ? 0 : 1024), NBR, 512); }
#else
    if constexpr (SP == 4) { if (l != HG_NAIVE_L) hgrn_b3(C, l); else { mix_hgrn_naive(C, l); __syncthreads(); } mix_fox(C, l); }
#endif
    if constexpr (SP == 5) {
        pg8::Gemm g{(const bf16_t*)(C.ws + WS_XB), (const bf16_t*)(wb + WO_WG), DM, DM, DM, 0, 0};
        pg8::StaticOrder S; S.init(T, NG, C.G, C.bid);
        pg8::Epi8<FGateI8> E{{C.ws + WS_G, C.in[I_BGATE] + l * NG, (const float*)(C.ws + WS_XSA), (const float*)(C.ws + WS_CMAX) + l * (NH + NG) + NH}};
        pg8::gemm_phase<pg8::Epi8<FGateI8>, pg8::StaticOrder, true>(C.lds, g, S, E, C.tid);
    }
    if constexpr (SP == 6) {
        pg8::Gemm g{(const bf16_t*)(C.ws + WS_BR), (const bf16_t*)(wb + WO_WBR), NBR, BW, BW, (size_t)BW, (size_t)DM * BW};
        pg8::ZOrder S; S.init(T, DM, 4, C.G, C.vcu);
        pg8::Epi8<FMerge> E{{C.ws + WS_G, (bf16_t*)(C.ws + WS_XB)}};
        pg8::gemm_phase(C.lds, g, S, E, C.tid);
    }
    if constexpr (SP == 7) {
        const float* xin = (l == 0) ? C.in[I_X] : (const float*)(C.ws + WS_XA);
        pg8::Gemm g{(const bf16_t*)(C.ws + WS_XB), (const bf16_t*)(wb + WO_WOUT), DM, DM, DM, 0, 0};
        pg8::StaticOrder S; S.init(T, DM, C.G, C.bid);
        pg8::Epi8<FResid> E{{xin, (bf16_t*)(C.ws + WS_XC)}};
        pg8::gemm_phase(C.lds, g, S, E, C.tid);
    }
    if constexpr (SP == 8) { p_ln1(C, l); p_conv_tables(C, l); }
    if constexpr (SP == 9) {
        pg8::Gemm g{(const bf16_t*)(C.ws + WS_X1B), (const bf16_t*)(wb + WO_WQ), DM, DM, DM, 0, 0};
        pg8::StaticOrder S; S.init(T, NQ, C.G, C.bid);
        pg8::Epi8<FStoreBf16> E{{(bf16_t*)(C.ws + WS_Q), NQ}};
        pg8::gemm_phase(C.lds, g, S, E, C.tid);
    }
#if TOPK_NAIVE
    if constexpr (SP == 10) p_topk_naive(C, l);
#else
    if constexpr (SP == 10) p_topk(C, l);
#endif
    if constexpr (SP == 11) p_gather(C, l);
}
__device__ __forceinline__ void make_ctx(Ctx& C, const Args& args, unsigned char* lds_raw) {
    C.lds = (LAS unsigned char*)lds_raw; C.ws = args.ws; C.in = args.in; C.out = args.out;
    C.tid = threadIdx.x; C.lane = C.tid & 63; C.wave = __builtin_amdgcn_readfirstlane(C.tid >> 6);
    C.G = gridDim.x; C.bid = blockIdx.x; C.vcu = (C.G % 8 == 0) ? (C.bid % 8) * (C.G / 8) + C.bid / 8 : C.bid;
}
#if !MK_ONE_LAUNCH
template <int SP> __global__ void __launch_bounds__(512, 2) mk_phase(Args args) {
    extern __shared__ __attribute__((aligned(16))) unsigned char lds_raw[];
    Ctx C; make_ctx(C, args, lds_raw);
    run_phase<SP>(C, args.ph_lo);
}
#endif

#define GRID_BAR() xcd_barrier((unsigned*)(args.ws + WS_CTL) + 1024, (volatile LAS unsigned*)((LAS unsigned char*)lds_raw + LDSCTL_OFF + 32))
__global__ void __launch_bounds__(512, 2) mk_fwd(Args args) {
    extern __shared__ __attribute__((aligned(16))) unsigned char lds_raw[];
    Ctx C; make_ctx(C, args, lds_raw);
    { volatile LAS unsigned* misc = (volatile LAS unsigned*)(C.lds + LDSCTL_OFF); if (C.tid < 64) misc[C.tid] = 0u; }
    __syncthreads();
    xcd_barrier_post((unsigned*)(args.ws + WS_CTL) + 1024);
    run_phase<-1>(C, 0); GRID_BAR();
#pragma unroll 1
    for (int l = 0; l < DEPTH; ++l) {
        if (l == 0) { run_phase<0>(C, l); GRID_BAR(); }
        run_phase<1>(C, l); GRID_BAR();
        run_phase<2>(C, l); GRID_BAR();
        run_phase<3>(C, l); GRID_BAR();
        run_phase<4>(C, l); GRID_BAR();
        run_phase<5>(C, l); GRID_BAR();
        run_phase<6>(C, l); GRID_BAR();
        run_phase<7>(C, l); GRID_BAR();
        run_phase<8>(C, l); GRID_BAR();
        run_phase<9>(C, l); GRID_BAR();
        run_phase<10>(C, l); GRID_BAR();
        run_phase<11>(C, l); if (l + 1 < DEPTH) GRID_BAR();
    }
}

#if !MK_ONE_LAUNCH
template <int SP> static void launch_phase(const Args& a, int grid, hipStream_t stream) {
    static bool attr_done = false;
    if (!attr_done) { (void)hipFuncSetAttribute((const void*)mk_phase<SP>, hipFuncAttributeMaxDynamicSharedMemorySize, LDS_BYTES); attr_done = true; }
    hipLaunchKernelGGL(mk_phase<SP>, dim3(grid), dim3(512), LDS_BYTES, stream, a);
}
#endif
extern "C" void kernel_launch(void* const* d_in, const int* in_sizes, int n_in, void* d_out, int out_size, void* d_ws, size_t ws_size, hipStream_t stream) {
    static int grid = 0;
    if (grid == 0) {
        if (n_in != NIN_PTRS || out_size != T * DM || ws_size < WS_END) { fprintf(stderr, "kernel_launch: unexpected shapes n_in %d out %d ws %zu\n", n_in, out_size, ws_size); grid = -1; return; }
        int dev = 0, cus = 0;
        if (hipGetDevice(&dev) != hipSuccess || hipDeviceGetAttribute(&cus, hipDeviceAttributeMultiprocessorCount, dev) != hipSuccess) { grid = -1; return; }
        grid = cus;
    }
    if (grid < 0) return;
    (void)hipMemsetAsync((char*)d_ws + WS_CTL, 0, CTL_ZERO_BYTES, stream);
    Args a{};
    for (int i = 0; i < NIN_PTRS; ++i) a.in[i] = (const float*)d_in[i];
    a.out = (float*)d_out; a.ws = (unsigned char*)d_ws; a.bar_slot = 0; a.pad = 0; a.ph_hi = 0;
#if MK_ONE_LAUNCH
    static bool attr_done = false;
    if (!attr_done) { (void)hipFuncSetAttribute((const void*)mk_fwd, hipFuncAttributeMaxDynamicSharedMemorySize, LDS_BYTES); attr_done = true; }
    hipLaunchKernelGGL(mk_fwd, dim3(grid), dim3(512), LDS_BYTES, stream, a);
    return;
#endif
#if !MK_ONE_LAUNCH
    a.ph_lo = 0; launch_phase<-1>(a, grid, stream);
    for (int l = 0; l < DEPTH; ++l) {
        a.ph_lo = l;
        launch_phase<0>(a, grid, stream); launch_phase<1>(a, grid, stream); launch_phase<2>(a, grid, stream); launch_phase<3>(a, grid, stream); launch_phase<4>(a, grid, stream);
        launch_phase<5>(a, grid, stream); launch_phase<6>(a, grid, stream); launch_phase<7>(a, grid, stream); launch_phase<8>(a, grid, stream); launch_phase<9>(a, grid, stream); launch_phase<10>(a, grid, stream); launch_phase<11>(a, grid, stream);
    }
#endif
}
```

```cpp
#include <hip/hip_runtime.h>
#include <cstdio>
#include <cstdint>

#ifndef DIAG
#define DIAG 0
#endif
#ifndef DIAG_LO
#define DIAG_LO 0
#endif
#ifndef DIAG_HI
#define DIAG_HI 64
#endif
#ifndef DIAG_MOD
#define DIAG_MOD 64
#endif
#ifndef TOPK_NAIVE
#define TOPK_NAIVE 0
#endif
#ifndef MIX_NAIVE
#define MIX_NAIVE 0
#endif
#ifndef DIAG_N0
#define DIAG_N0 4096
#endif
#ifndef FOX_NAIVE
#define FOX_NAIVE 0
#endif
#ifndef HG_NAIVE_L
#define HG_NAIVE_L 99
#endif
#ifndef DIAG_LAYER
#define DIAG_LAYER 0
#endif
#ifndef MK_ONE_LAUNCH
#define MK_ONE_LAUNCH 1
#endif

#define LAS __attribute__((address_space(3)))
#define GAS __attribute__((address_space(1)))
typedef unsigned short bf16_t;
typedef short bf16x8 __attribute__((ext_vector_type(8)));
typedef float f32x4 __attribute__((ext_vector_type(4)));
typedef float f32x2 __attribute__((ext_vector_type(2)));
typedef unsigned u32x4 __attribute__((ext_vector_type(4)));
typedef unsigned u32x2 __attribute__((ext_vector_type(2)));

constexpr int DM = 1024, BATCH = 2, SEQ = 8192, DEPTH = 2, T = BATCH * SEQ;
constexpr int BW = 512, NIN = 5124, NH = 5120, NG = 4096, NBR = 2048, NQ = 2048;
constexpr int NEXP = 16384, TOPK = 16, PH = 8;
constexpr float ALPHA = 1.4142135623730951f;
constexpr float LN_EPS = 1e-5f, RMS_EPS = 1e-6f;
constexpr int HC_P = 0, HC_HQ = 512, HC_HF = 1024, HC_HI = 1536, HC_HG = 2048, HC_GU = 2560, HC_GV = 3072, HC_FQ = 3584, HC_FK = 4096, HC_FV = 4608;

constexpr size_t MiB = 1u << 20;
constexpr size_t WS_CTL = 0, CTL_ZERO_BYTES = 160 * 1024;
constexpr size_t WS_CMAX = 64 * 1024;
constexpr size_t WS_MISC = 512 * 1024;
constexpr size_t WS_CUM = 768 * 1024;
constexpr size_t WS_W = 1 * MiB;
constexpr size_t W_LAYER = 30 * MiB;
constexpr size_t WO_WIN = 0, WO_WG = 10 * MiB, WO_WBR = 18 * MiB, WO_WOUT = 22 * MiB, WO_WQ = 24 * MiB, WO_KEYS = 28 * MiB, WO_WF = 28 * MiB + 512 * 1024, WO_POOLW = 28 * MiB + 768 * 1024, WO_GWS = 29 * MiB, WO_CS = 29 * MiB + 512 * 1024;
constexpr size_t WS_TABU = 64 * MiB, WS_TABV = 96 * MiB;
constexpr size_t WS_XA = 128 * MiB;
constexpr size_t WS_XB = 192 * MiB;
constexpr size_t WS_X1B = 224 * MiB;
constexpr size_t WS_H = 256 * MiB;
constexpr size_t WS_ST = 416 * MiB;
constexpr size_t WS_BR = 448 * MiB;
constexpr size_t WS_G = 256 * MiB;
constexpr size_t WS_MGF = 384 * MiB;
constexpr size_t WS_XC = 256 * MiB;
constexpr size_t WS_Q = 320 * MiB;
constexpr size_t WS_EIDX = 384 * MiB, WS_EGATE = 392 * MiB;
constexpr size_t WS_XSA = 256 * 1024;
constexpr size_t WS_END = 512 * MiB;

__device__ __forceinline__ float bf2f(unsigned u) { return __builtin_bit_cast(float, u << 16); }
__device__ __forceinline__ unsigned f2bf(float f) { unsigned u = __builtin_bit_cast(unsigned, f); return (u + 0x7fffu + ((u >> 16) & 1u)) >> 16; }
typedef __bf16 bf16x2_t __attribute__((ext_vector_type(2)));
__device__ __forceinline__ unsigned cvtpk(float lo, float hi) { f32x2 v = {lo, hi}; bf16x2_t b = __builtin_convertvector(v, bf16x2_t); return __builtin_bit_cast(unsigned, b); }
__device__ __forceinline__ unsigned pk2(float lo, float hi) { return cvtpk(lo, hi); }
__device__ __forceinline__ float wave_sum(float v) {
#pragma unroll
    for (int o = 32; o > 0; o >>= 1) v += __shfl_xor(v, o, 64);
    return v;
}
__device__ __forceinline__ float sigmoidf_(float x) { return __builtin_amdgcn_rcpf(1.f + __builtin_amdgcn_exp2f(-1.4426950408889634f * x)); }
__device__ __forceinline__ float siluf_(float x) { return x * __builtin_amdgcn_rcpf(1.f + __builtin_amdgcn_exp2f(-1.4426950408889634f * x)); }
__device__ __forceinline__ float geluf_slow(float x) { const float u = 0.7978845608028654f * (x + 0.044715f * x * x * x); return 0.5f * x * (1.f + tanhf(u)); }
__device__ __forceinline__ float geluf_(float x) { const float u2 = -2.302208198f * (x + 0.044715f * x * x * x); return x * __builtin_amdgcn_rcpf(1.f + __builtin_amdgcn_exp2f(u2)); }
__device__ __forceinline__ float logsigmoidf_(float z) { return fminf(z, 0.f) - log1pf(__expf(-fabsf(z))); }

__device__ __forceinline__ unsigned launder_u(unsigned x) { asm volatile("" : "+v"(x)); return __builtin_amdgcn_readfirstlane(x); }
template <class P> __device__ __forceinline__ P launder_ptr(P p) {
    const unsigned lo = launder_u((unsigned)(uintptr_t)p), hi = launder_u((unsigned)((uintptr_t)p >> 32));
    return (P)(((uintptr_t)hi << 32) | lo);
}

namespace pg8 {
constexpr int BM = 256, BK = 64, HALF = 128, HTB = HALF * BK * 2, STAGE_BYTES = 8 * HTB, NXCD = 8, WGM = 8;
__host__ __device__ __forceinline__ int lds_byte(int r, int c) { const int st = (r >> 4) * 2 + (c >> 5), rr = r & 15, cc = c & 31, ob = rr * 64 + cc * 2; return st * 1024 + (ob ^ (((ob >> 9) & 1) << 5)); }
__host__ __device__ __forceinline__ void stage_rc(int b, int& R, int& C) { const int st = b / 1024, sb = b % 1024, swz = sb ^ (((sb >> 9) & 1) << 5); R = (st >> 1) * 16 + swz / 64; C = (st & 1) * 32 + (swz % 64) / 2; }
__host__ __device__ __forceinline__ int perm32(int rho) { const int n = rho >> 4, i = rho & 15; return 8 * (i >> 2) + 4 * n + (i & 3); }

struct Unit { int pm, pn, z; };
struct Gemm { const bf16_t* A; const bf16_t* Bt; int lda, ldb, K; size_t zA, zB; };

struct StaticOrder {
    int nM, nN, nwg, G, c;
    __device__ void init(int M, int N, int G_, int c_) { nM = M / BM; nN = N / BM; nwg = nM * nN; G = G_; c = c_; }
    __device__ bool next(int i, Unit& u) const {
        const long L = (long)i * G + c; if (L >= nwg) return false;
        int wgid = (int)L; { const int q = nwg / NXCD, r = nwg % NXCD, xcd = wgid % NXCD, off = wgid / NXCD; wgid = (xcd < r ? xcd * (q + 1) : r * (q + 1) + (xcd - r) * q) + off; }
        const int nig = WGM * nN, gid = wgid / nig, fm = gid * WGM, gsz = (nM - fm) < WGM ? (nM - fm) : WGM;
        u.pm = fm + ((wgid % nig) % gsz); u.pn = (wgid % nig) / gsz; u.z = 0; return true;
    }
};
struct ZOrder {
    int nM, nN, nZ, ntile, G, c;
    __device__ void init(int M, int N, int Z, int G_, int c_) { nM = M / BM; nN = N / BM; nZ = Z; ntile = nM * nN; G = G_; c = c_; }
    __device__ bool next(int i, Unit& u) const {
        const long L = (long)(i / nZ) * G + c; if (L >= ntile) return false;
        u.pm = (int)L / nN; u.pn = (int)L % nN; u.z = i % nZ; return true;
    }
};

template <class F> struct Epi8 {
    static constexpr bool PERM = true;
    F f;
    __device__ __forceinline__ void operator()(const f32x4 (&acc)[2][2][4][2], const Unit& u, int wr, int wc, int fr, int fq) const {
        const int row0 = u.pm * BM + wr * 64 + fr, col0 = u.pn * BM + wc * 32 + 8 * fq;
#pragma unroll
        for (int ai = 0; ai < 2; ++ai)
#pragma unroll
            for (int m = 0; m < 4; ++m)
#pragma unroll
                for (int bj = 0; bj < 2; ++bj) f(row0 + ai * HALF + m * 16, col0 + bj * HALF, acc[ai][bj][m][0], acc[ai][bj][m][1], u.z);
    }
};
template <class F> struct Epi4 {
    static constexpr bool PERM = false;
    F f;
    __device__ __forceinline__ void operator()(const f32x4 (&acc)[2][2][4][2], const Unit& u, int wr, int wc, int fr, int fq) const {
        const int row0 = u.pm * BM + wr * 64 + fr, col0 = u.pn * BM + wc * 32 + 4 * fq;
#pragma unroll
        for (int ai = 0; ai < 2; ++ai)
#pragma unroll
            for (int m = 0; m < 4; ++m)
#pragma unroll
                for (int bj = 0; bj < 2; ++bj)
#pragma unroll
                    for (int n = 0; n < 2; ++n) f(row0 + ai * HALF + m * 16, col0 + bj * HALF + n * 16, acc[ai][bj][m][n], u.z);
    }
};

typedef int i32x4 __attribute__((ext_vector_type(4)));
template <class Epi, class Sched, bool I8 = false, bool ALIGN_EPI = true>
__device__ __forceinline__ void gemm_phase(LAS unsigned char* lds, const Gemm g, const Sched& S, const Epi& E, const int tid) {
    constexpr int ES = I8 ? 1 : 2;
    const int wid = __builtin_amdgcn_readfirstlane(tid >> 6), lane = tid & 63, wr = wid >> 2, wc = wid & 3, fr = lane & 15, fq = lane >> 4;
    const int K = g.K, nt = K * ES / 128;
    unsigned voffA[2], voffB[2];
#pragma unroll
    for (int i = 0; i < 2; ++i) { int R, C; stage_rc(tid * 16 + i * 8192, R, C); const int Rb = Epi::PERM ? ((R & ~31) + perm32(R & 31)) : R;
        voffA[i] = (unsigned)(R * g.lda * ES + C * 2); voffB[i] = (unsigned)(Rb * g.ldb * ES + C * 2); }
    const size_t kstep = (size_t)(BK * 2);
    const size_t hstepA = (size_t)HALF * g.lda * ES, hstepB = (size_t)HALF * g.ldb * ES;
    const size_t tstepA = 2 * hstepA, tstepB = 2 * hstepB;
    const unsigned ldsw = (unsigned)wid * 1024u;
    const int aoff = lds_byte(wr * 64 + fr, fq * 8), boff = lds_byte(wc * 32 + fr, fq * 8);
#define PG8_SA(b, h) (((b) * 2 + (h)) * HTB)
#define PG8_SB(b, h) ((4 + (b) * 2 + (h)) * HTB)
#define PG8_STAGE(bufoff, gbase, voff) do { _Pragma("unroll") for (int _i = 0; _i < 2; ++_i) \
        __builtin_amdgcn_global_load_lds((const unsigned*)((const char*)(gbase) + (voff)[_i]), (LAS unsigned*)(lds + (bufoff) + ldsw + _i * 8192), 16, 0, 0); } while (0)
#define PG8_LDA(dst, b, h) do { _Pragma("unroll") for (int m = 0; m < 4; ++m) _Pragma("unroll") for (int k = 0; k < 2; ++k) dst[m][k] = *(const LAS bf16x8*)(lds + PG8_SA(b, h) + aoff + m * 2048 + k * 1024); } while (0)
#define PG8_LDB(dst, b, h) do { _Pragma("unroll") for (int n = 0; n < 2; ++n) _Pragma("unroll") for (int k = 0; k < 2; ++k) dst[n][k] = *(const LAS bf16x8*)(lds + PG8_SB(b, h) + boff + n * 2048 + k * 1024); } while (0)
#define PG8_MMA(ai, bj, At, Bt) do { __builtin_amdgcn_s_setprio(1); _Pragma("unroll") for (int m = 0; m < 4; ++m) _Pragma("unroll") for (int n = 0; n < 2; ++n) _Pragma("unroll") for (int k = 0; k < 2; ++k) { \
        if constexpr (I8) acc[ai][bj][m][n] = __builtin_bit_cast(f32x4, __builtin_amdgcn_mfma_i32_16x16x64_i8(__builtin_bit_cast(i32x4, Bt[n][k]), __builtin_bit_cast(i32x4, At[m][k]), __builtin_bit_cast(i32x4, acc[ai][bj][m][n]), 0, 0, 0)); \
        else acc[ai][bj][m][n] = __builtin_amdgcn_mfma_f32_16x16x32_bf16(Bt[n][k], At[m][k], acc[ai][bj][m][n], 0, 0, 0); } __builtin_amdgcn_s_setprio(0); } while (0)
#define PG8_WAIT_V(n) asm volatile("s_waitcnt vmcnt(" #n ")" ::: "memory")
#define PG8_WAIT_L(n) asm volatile("s_waitcnt lgkmcnt(" #n ")" ::: "memory")
#define PG8_BAR __builtin_amdgcn_s_barrier()
#define PG8_SCHED __builtin_amdgcn_sched_barrier(0)
    Unit cur, nxt; int ui = 0;
    if (!S.next(0, cur)) return;
    f32x4 acc[2][2][4][2];
#pragma unroll
    for (int a = 0; a < 2; ++a)
#pragma unroll
        for (int b = 0; b < 2; ++b)
#pragma unroll
            for (int m = 0; m < 4; ++m)
#pragma unroll
                for (int n = 0; n < 2; ++n) acc[a][b][m][n] = (f32x4){0.f, 0.f, 0.f, 0.f};
    bf16x8 At[4][2], B0[2][2], B1[2][2];
    const char* cA = (const char*)g.A + (size_t)cur.z * g.zA * ES + (size_t)cur.pm * tstepA; const char* cB = (const char*)g.Bt + (size_t)cur.z * g.zB * ES + (size_t)cur.pn * tstepB;
    PG8_STAGE(PG8_SB(0, 0), cB, voffB); PG8_STAGE(PG8_SB(0, 1), cB + hstepB, voffB); PG8_STAGE(PG8_SA(0, 0), cA, voffA); PG8_STAGE(PG8_SA(0, 1), cA + hstepA, voffA);
    if (wr == 1) PG8_BAR;
    PG8_WAIT_V(2); PG8_BAR;
    PG8_STAGE(PG8_SB(1, 0), cB + kstep, voffB); PG8_STAGE(PG8_SA(1, 0), cA + kstep, voffA); PG8_STAGE(PG8_SB(1, 1), cB + hstepB + kstep, voffB);
    PG8_WAIT_V(6); PG8_BAR;
    for (;;) {
        const bool has_next = S.next(ui + 1, nxt);
        const char* nA = has_next ? (const char*)g.A + (size_t)nxt.z * g.zA * ES + (size_t)nxt.pm * tstepA : cA;
        const char* nB = has_next ? (const char*)g.Bt + (size_t)nxt.z * g.zB * ES + (size_t)nxt.pn * tstepB : cB;
        for (int t = 0; t < nt; t += 2) {
            const bool last = (t == nt - 2);
            const char* a1 = cA + (size_t)(t + 1) * kstep;
            const char* a2 = last ? nA : cA + (size_t)(t + 2) * kstep; const char* b2 = last ? nB : cB + (size_t)(t + 2) * kstep;
            const char* a3 = a2 + kstep; const char* b3 = b2 + kstep;
            PG8_LDB(B0, 0, 0); PG8_LDB(B1, 0, 1); PG8_SCHED; PG8_LDA(At, 0, 0); PG8_STAGE(PG8_SA(1, 1), a1 + hstepA, voffA);
            PG8_WAIT_V(8); PG8_WAIT_L(0); PG8_BAR; PG8_MMA(0, 0, At, B0); PG8_MMA(0, 1, At, B1); PG8_BAR; PG8_SCHED;
            PG8_LDA(At, 0, 1); PG8_STAGE(PG8_SB(0, 0), b2, voffB); PG8_STAGE(PG8_SB(0, 1), b2 + hstepB, voffB); PG8_STAGE(PG8_SA(0, 0), a2, voffA);
            PG8_WAIT_V(8); PG8_WAIT_L(0); PG8_BAR; PG8_MMA(1, 0, At, B0); PG8_MMA(1, 1, At, B1); PG8_BAR; PG8_SCHED;
            PG8_LDB(B0, 1, 0); PG8_LDB(B1, 1, 1); PG8_SCHED; PG8_LDA(At, 1, 0); PG8_STAGE(PG8_SA(0, 1), a2 + hstepA, voffA);
            PG8_WAIT_V(8); PG8_WAIT_L(0); PG8_BAR; PG8_MMA(0, 0, At, B0); PG8_MMA(0, 1, At, B1); PG8_BAR; PG8_SCHED;
            PG8_LDA(At, 1, 1); PG8_STAGE(PG8_SB(1, 0), b3, voffB); PG8_STAGE(PG8_SB(1, 1), b3 + hstepB, voffB); PG8_STAGE(PG8_SA(1, 0), a3, voffA);
            PG8_WAIT_V(8); PG8_WAIT_L(0); PG8_BAR; PG8_MMA(1, 0, At, B0); PG8_MMA(1, 1, At, B1); PG8_BAR; PG8_SCHED;
        }
        if constexpr (ALIGN_EPI) { if (wr == 0) PG8_BAR; }
        E(acc, cur, wr, wc, fr, fq);
        if (!has_next) break;
#pragma unroll
        for (int a = 0; a < 2; ++a)
#pragma unroll
            for (int b = 0; b < 2; ++b)
#pragma unroll
                for (int m = 0; m < 4; ++m)
#pragma unroll
                    for (int n = 0; n < 2; ++n) acc[a][b][m][n] = (f32x4){0.f, 0.f, 0.f, 0.f};
        cur = nxt; cA = nA; cB = nB; ++ui;
        if constexpr (ALIGN_EPI) { if (wr == 1) PG8_BAR; }
    }
    PG8_WAIT_V(0);
    if constexpr (!ALIGN_EPI) { if (wr == 0) PG8_BAR; }
    PG8_BAR;
#undef PG8_SA
#undef PG8_SB
#undef PG8_STAGE
#undef PG8_LDA
#undef PG8_LDB
#undef PG8_MMA
#undef PG8_WAIT_V
#undef PG8_WAIT_L
#undef PG8_BAR
#undef PG8_SCHED
}
}

#define XB_TMO      128
#define XB_XCNT(j)  (256  + 64 * (j))
#define XB_XSUB(j)  (1280 + 64 * (j))
#define XB_XGEN(j)  (2304 + 64 * (j))
#define XB_TOP      3328
#define XB_TOPGEN   3392
#define XCD_BAR_WORDS 3456
#define XB_SPIN_CAP (1u << 22)
__device__ __forceinline__ unsigned xb_ld(unsigned* p)              { return __hip_atomic_load(p, __ATOMIC_RELAXED, __HIP_MEMORY_SCOPE_AGENT); }
__device__ __forceinline__ unsigned xb_add(unsigned* p, unsigned v) { return __hip_atomic_fetch_add(p, v, __ATOMIC_RELAXED, __HIP_MEMORY_SCOPE_AGENT); }
__device__ __forceinline__ unsigned xb_xcc_id() { return (unsigned)__builtin_amdgcn_s_getreg((3 << 11) | 20) & 0xFu; }
#define XB_SPIN(cond, bar) do { unsigned _sp = 0; while (cond) { __builtin_amdgcn_s_sleep(1); \
    if ((++_sp & 255u) == 0u) { if (xb_ld(&(bar)[XB_TMO])) break; if (_sp > XB_SPIN_CAP) { atomicAdd(&(bar)[XB_TMO], 1u); break; } } } } while (0)
__device__ __forceinline__ void xcd_barrier_post(unsigned* bar) {
    if (threadIdx.x == 0) (void)xb_add(&bar[XB_XCNT(xb_xcc_id())], 1u);
}
__device__ __forceinline__ void xcd_barrier_complete(unsigned* bar, unsigned x, unsigned& nloc, unsigned& nx) {
    const unsigned G = gridDim.x * gridDim.y * gridDim.z;
    unsigned sum, cnt, mine, sp = 0u;
    for (;;) {
        sum = 0u; cnt = 0u; mine = 0u;
#pragma unroll
        for (unsigned j = 0; j < 16; ++j) { const unsigned c = xb_ld(&bar[XB_XCNT(j)]); sum += c; cnt += (c > 0u) ? 1u : 0u; mine = (j == x) ? c : mine; }
        if (sum == G) break;
        __builtin_amdgcn_s_sleep(1);
        if ((++sp & 255u) == 0u) { if (xb_ld(&bar[XB_TMO])) break; if (sp > XB_SPIN_CAP) { atomicAdd(&bar[XB_TMO], 1u); break; } }
    }
    nloc = mine > 0u ? mine : 1u; nx = cnt > 0u ? cnt : 1u;
}
__device__ __noinline__ void xcd_barrier_leader(unsigned* bar, volatile LAS unsigned* st) {
    const unsigned x = xb_xcc_id();
    __builtin_amdgcn_s_waitcnt(0);
    unsigned nloc = st[0], nx = st[1];
    if (nloc == 0u) { xcd_barrier_complete(bar, x, nloc, nx); st[0] = nloc; st[1] = nx; }
    const unsigned old = xb_add(&bar[XB_XSUB(x)], 1u);
    const unsigned gen = old / nloc;
    if (old + 1u == (gen + 1u) * nloc) {
        __builtin_amdgcn_fence(__ATOMIC_RELEASE, "agent");
        asm volatile("s_waitcnt vmcnt(0)" ::: "memory");
        const unsigned og = xb_add(&bar[XB_TOP], 1u);
        const unsigned tg = og / nx;
        if (og + 1u == (tg + 1u) * nx) xb_add(&bar[XB_TOPGEN], 1u);
        else XB_SPIN(xb_ld(&bar[XB_TOPGEN]) == tg, bar);
        __builtin_amdgcn_fence(__ATOMIC_ACQUIRE, "agent");
        xb_add(&bar[XB_XGEN(x)], 1u);
        asm volatile("s_waitcnt vmcnt(0)" ::: "memory");
    } else {
        XB_SPIN(xb_ld(&bar[XB_XGEN(x)]) == gen, bar);
        __builtin_amdgcn_fence(__ATOMIC_ACQUIRE, "agent");
        asm volatile("s_waitcnt vmcnt(0)" ::: "memory");
    }
}
__device__ __forceinline__ void xcd_barrier(unsigned* bar, volatile LAS unsigned* st) {
    asm volatile("s_waitcnt vmcnt(0)" ::: "memory");
    __syncthreads();
    if (threadIdx.x == 0) xcd_barrier_leader(bar, st);
    __syncthreads();
}

constexpr int NIN_PTRS = 23;
struct Args { const float* in[NIN_PTRS]; float* out; unsigned char* ws; int ph_lo, ph_hi, bar_slot, pad; };
enum { I_X = 0, I_WIN, I_BFOX, I_POOLW, I_POOLS, I_LBL, I_HNG, I_GLNG, I_GLNB, I_GWS, I_GBS, I_WGATE, I_BGATE, I_WBR, I_WOUT, I_LN1G, I_LN1B, I_WQ, I_KEYS, I_PU, I_PV, I_LN2G, I_LN2B };

constexpr int LDS_BYTES = 147456;
constexpr int LDSCTL_OFF = 143360;

struct Ctx {
    LAS unsigned char* lds;
    unsigned char* ws;
    const float* const* in;
    float* out;
    int tid, lane, wave, G, bid, vcu;
};

__device__ __forceinline__ void tconv_job(const Ctx& C, const float* src, int ld_src, int K, int N, bf16_t* dst) {
    LAS float* tile = (LAS float*)C.lds;
    const int nk = K / 64, nn = N / 64, ntiles = nk * nn;
    for (int tl = C.bid; tl < ntiles; tl += C.G) {
        const int k0 = (tl / nn) * 64, n0 = (tl % nn) * 64;
#pragma unroll
        for (int p = 0; p < 2; ++p) {
            const int kr = (C.tid >> 4) + p * 32, nc = (C.tid & 15) * 4;
            const f32x4 v = *(const f32x4*)(src + (size_t)(k0 + kr) * ld_src + n0 + nc);
            tile[kr * 65 + nc + 0] = v[0]; tile[kr * 65 + nc + 1] = v[1]; tile[kr * 65 + nc + 2] = v[2]; tile[kr * 65 + nc + 3] = v[3];
        }
        __syncthreads();
        {
            const int n = C.tid >> 3, k8 = (C.tid & 7) * 8;
            u32x4 o;
#pragma unroll
            for (int j = 0; j < 4; ++j) o[j] = pk2(tile[(k8 + 2 * j) * 65 + n], tile[(k8 + 2 * j + 1) * 65 + n]);
            *(u32x4*)(dst + (size_t)(n0 + n) * K + k0 + k8) = o;
        }
        __syncthreads();
    }
}
__device__ __forceinline__ void colmax_job(const Ctx& C, const float* src, int ld_src, int K, int N, unsigned* cmax) {
    LAS float* red = (LAS float*)C.lds;
    const int nk = K / 64, nn = N / 64, ntiles = nk * nn;
    for (int tl = C.bid; tl < ntiles; tl += C.G) {
        const int k0 = (tl / nn) * 64, n0 = (tl % nn) * 64;
        float mx[4] = {0.f, 0.f, 0.f, 0.f};
#pragma unroll
        for (int p = 0; p < 2; ++p) { const int kr = (C.tid >> 4) + p * 32, nc = (C.tid & 15) * 4;
            const f32x4 v = *(const f32x4*)(src + (size_t)(k0 + kr) * ld_src + n0 + nc);
#pragma unroll
            for (int e = 0; e < 4; ++e) mx[e] = fmaxf(mx[e], fabsf(v[e])); }
#pragma unroll
        for (int e = 0; e < 4; ++e) red[(C.tid >> 4) * 64 + (C.tid & 15) * 4 + e] = mx[e];
        __syncthreads();
        if (C.tid < 64) { float m = 0.f; for (int r = 0; r < 32; ++r) m = fmaxf(m, red[r * 64 + C.tid]); atomicMax(cmax + n0 + C.tid, __builtin_bit_cast(unsigned, m)); }
        __syncthreads();
    }
}
__device__ __forceinline__ void tconv_i8_job(const Ctx& C, const float* src, int ld_src, int K, int N, unsigned char* dst, const unsigned* cmax) {
    LAS float* tile = (LAS float*)C.lds;
    const int nks = K / 256, nn = N / 64, nunits = nks * nn;
    for (int un = C.bid; un < nunits; un += C.G) {
        const int k0 = (un / nn) * 256, n0 = (un % nn) * 64;
        const int kr = C.tid >> 4, nc = (C.tid & 15) * 4;
        f32x4 v[8];
#pragma unroll
        for (int p = 0; p < 8; ++p) v[p] = *(const f32x4*)(src + (size_t)(k0 + kr + 32 * p) * ld_src + n0 + nc);
        float isc[4];
#pragma unroll
        for (int e = 0; e < 4; ++e) isc[e] = 127.f / fmaxf(__builtin_bit_cast(float, __hip_atomic_load(cmax + n0 + nc + e, __ATOMIC_RELAXED, __HIP_MEMORY_SCOPE_AGENT)), 1e-30f);
#pragma unroll
        for (int p = 0; p < 8; ++p)
#pragma unroll
            for (int e = 0; e < 4; ++e) tile[(kr + 32 * p) * 65 + nc + e] = v[p][e] * isc[e];
        __syncthreads();
        { const int n = C.tid >> 3, kb = (C.tid & 7) * 32;
          u32x4 o0, o1;
#pragma unroll
          for (int j = 0; j < 8; ++j) { unsigned wd = 0u;
#pragma unroll
              for (int e = 0; e < 4; ++e) wd |= ((unsigned)(int)rintf(tile[(kb + 4 * j + e) * 65 + n]) & 255u) << (8 * e);
              if (j < 4) o0[j] = wd; else o1[j - 4] = wd; }
          unsigned char* dp = dst + (size_t)(n0 + n) * K + k0 + kb;
          *(u32x4*)dp = o0; *(u32x4*)(dp + 16) = o1; }
        __syncthreads();
    }
}
__device__ __forceinline__ void cvt_copy(const Ctx& C, const float* src, bf16_t* dst, size_t n) {
    const size_t n8 = n / 8;
    for (size_t i = (size_t)C.bid * 512 + C.tid; i < n8; i += (size_t)C.G * 512) {
        const f32x4 a = *(const f32x4*)(src + i * 8), b = *(const f32x4*)(src + i * 8 + 4);
        u32x4 o; o[0] = pk2(a[0], a[1]); o[1] = pk2(a[2], a[3]); o[2] = pk2(b[0], b[1]); o[3] = pk2(b[2], b[3]);
        *(u32x4*)(dst + i * 8) = o;
    }
}
__device__ __forceinline__ void p_conv_weights(const Ctx& C) {
    for (int l = 0; l < DEPTH; ++l) {
        unsigned char* wb = C.ws + WS_W + (size_t)l * W_LAYER;
        colmax_job(C, C.in[I_WIN] + (size_t)l * DM * NIN, NIN, DM, NH, (unsigned*)(C.ws + WS_CMAX) + l * (NH + NG));
        colmax_job(C, C.in[I_WGATE] + (size_t)l * DM * NG, NG, DM, NG, (unsigned*)(C.ws + WS_CMAX) + l * (NH + NG) + NH);
        for (int m = 0; m < 4; ++m)
            tconv_job(C, C.in[I_WBR] + ((size_t)l * 4 + m) * BW * DM, DM, BW, DM, (bf16_t*)(wb + WO_WBR) + (size_t)m * DM * BW);
        tconv_job(C, C.in[I_WOUT] + (size_t)l * DM * DM, DM, DM, DM, (bf16_t*)(wb + WO_WOUT));
        tconv_job(C, C.in[I_WQ] + (size_t)l * DM * NQ, NQ, DM, NQ, (bf16_t*)(wb + WO_WQ));
        cvt_copy(C, C.in[I_KEYS] + (size_t)l * 2 * PH * 128 * 128, (bf16_t*)(wb + WO_KEYS), (size_t)2 * PH * 128 * 128);
        for (int g = 0; g < 4; ++g)
            tconv_job(C, C.in[I_POOLW] + ((size_t)l * 4 + g) * 128 * 128, 128, 128, 128, (bf16_t*)(wb + WO_POOLW) + (size_t)g * 128 * 128);
        {
            bf16_t* gw = (bf16_t*)(wb + WO_GWS); const float* src = C.in[I_GWS] + (size_t)l * 4 * 128 * 128;
            for (int i = C.bid * 512 + C.tid; i < 4 * 128 * 128; i += C.G * 512) { const int t = (i >> 7) & 127, sx = i & 127; gw[i] = (bf16_t)f2bf(sx <= t ? src[i] : 0.f); }
        }
        float* wf = (float*)(wb + WO_WF);
        for (int i = C.bid * 512 + C.tid; i < 4 * DM; i += C.G * 512) { const int h = i / DM, k = i % DM; wf[i] = C.in[I_WIN][(size_t)l * DM * NIN + (size_t)k * NIN + NH + h]; }
    }
}
constexpr size_t WS_U8 = WS_TABU, WS_V8 = WS_TABU + 16 * MiB, WS_SU = WS_TABU + 32 * MiB, WS_SV = WS_SU + 64 * 1024;
__device__ __forceinline__ float wave_max(float v) {
#pragma unroll
    for (int o = 32; o > 0; o >>= 1) v = fmaxf(v, __shfl_xor(v, o, 64));
    return v;
}
template <bool SIGNED> __device__ __forceinline__ void quant_rows(const Ctx& C, const float* src, unsigned char* dst, float* scl) {
    for (int row = C.bid * 8 + C.wave; row < NEXP; row += C.G * 8) {
        const float* p = src + (size_t)row * DM + C.lane * 16;
        f32x4 v[4]; float mx = 0.f;
#pragma unroll
        for (int i = 0; i < 4; ++i) { v[i] = *(const f32x4*)(p + 4 * i);
#pragma unroll
            for (int e = 0; e < 4; ++e) mx = fmaxf(mx, fabsf(v[i][e])); }
        mx = fmaxf(wave_max(mx), 1e-30f);
        const float sc = mx * (1.f / 127.f), isc = 127.f / mx;
        u32x4 o;
#pragma unroll
        for (int i = 0; i < 4; ++i) { unsigned wd = 0u;
#pragma unroll
            for (int e = 0; e < 4; ++e) { const int q = (int)rintf(v[i][e] * isc) + (SIGNED ? 0 : 128); wd |= ((unsigned)q & 255u) << (8 * e); }
            o[i] = wd; }
        *(u32x4*)(dst + (size_t)row * DM + C.lane * 16) = o;
        if (C.lane == 0) scl[row] = sc;
    }
}
__device__ __forceinline__ void p_conv_tables(const Ctx& C, int l) {
    quant_rows<true>(C, C.in[I_PU] + (size_t)l * NEXP * DM, C.ws + WS_U8, (float*)(C.ws + WS_SU));
    quant_rows<false>(C, C.in[I_PV] + (size_t)l * NEXP * DM, C.ws + WS_V8, (float*)(C.ws + WS_SV));
}

__device__ __forceinline__ void row_emit(const Ctx& C, int row, const float (&v)[16], int l, bool want_lsig) {
    {
        float mx = 0.f;
#pragma unroll
        for (int j = 0; j < 16; ++j) mx = fmaxf(mx, fabsf(v[j]));
#pragma unroll
        for (int o = 32; o > 0; o >>= 1) mx = fmaxf(mx, __shfl_xor(mx, o, 64));
        mx = fmaxf(mx, 1e-30f);
        const float isc = 127.f / mx;
        unsigned char* xb = C.ws + WS_XB + (size_t)row * DM;
        u32x2 o0, o1;
#pragma unroll
        for (int hw = 0; hw < 2; ++hw) { unsigned a = 0u, b = 0u;
#pragma unroll
            for (int e = 0; e < 4; ++e) { a |= ((unsigned)(int)rintf(v[4 * hw + e] * isc) & 255u) << (8 * e); b |= ((unsigned)(int)rintf(v[8 + 4 * hw + e] * isc) & 255u) << (8 * e); }
            o0[hw] = a; o1[hw] = b; }
        *(u32x2*)(xb + C.lane * 8) = o0; *(u32x2*)(xb + 512 + C.lane * 8) = o1;
        if (C.lane == 0) ((float*)(C.ws + WS_XSA))[row] = mx * (1.f / 127.f);
    }
    if (want_lsig) {
        const float* wf = (const float*)(C.ws + WS_W + (size_t)l * W_LAYER + WO_WF);
        float* lsig = (float*)(C.ws + WS_MISC);
#pragma unroll
        for (int h = 0; h < 4; ++h) {
            const f32x4 a0 = *(const f32x4*)(wf + h * DM + C.lane * 8), a1 = *(const f32x4*)(wf + h * DM + C.lane * 8 + 4);
            const f32x4 b0 = *(const f32x4*)(wf + h * DM + 512 + C.lane * 8), b1 = *(const f32x4*)(wf + h * DM + 512 + C.lane * 8 + 4);
            float s = 0.f;
#pragma unroll
            for (int j = 0; j < 4; ++j) s += v[j] * a0[j] + v[4 + j] * a1[j] + v[8 + j] * b0[j] + v[12 + j] * b1[j];
            s = wave_sum(s);
            if (C.lane == 0) lsig[(size_t)row * 4 + h] = logsigmoidf_(s + C.in[I_BFOX][l * 4 + h]);
        }
    }
}
__device__ __forceinline__ void load_row16(const float* p, int lane, float (&v)[16]) {
    const f32x4 a0 = *(const f32x4*)(p + lane * 8), a1 = *(const f32x4*)(p + lane * 8 + 4), b0 = *(const f32x4*)(p + 512 + lane * 8), b1 = *(const f32x4*)(p + 512 + lane * 8 + 4);
#pragma unroll
    for (int j = 0; j < 4; ++j) { v[j] = a0[j]; v[4 + j] = a1[j]; v[8 + j] = b0[j]; v[12 + j] = b1[j]; }
}
__device__ __forceinline__ void store_row16(float* p, int lane, const float (&v)[16]) {
    *(f32x4*)(p + lane * 8) = (f32x4){v[0], v[1], v[2], v[3]}; *(f32x4*)(p + lane * 8 + 4) = (f32x4){v[4], v[5], v[6], v[7]};
    *(f32x4*)(p + 512 + lane * 8) = (f32x4){v[8], v[9], v[10], v[11]}; *(f32x4*)(p + 512 + lane * 8 + 4) = (f32x4){v[12], v[13], v[14], v[15]};
}
__device__ __forceinline__ void ln_row16(float (&v)[16], const float* g, const float* b, int lane) {
    float s = 0.f;
#pragma unroll
    for (int j = 0; j < 16; ++j) s += v[j];
    const float mean = wave_sum(s) * (1.f / DM);
    float q = 0.f;
#pragma unroll
    for (int j = 0; j < 16; ++j) { const float d = v[j] - mean; q += d * d; }
    const float rstd = rsqrtf(wave_sum(q) * (1.f / DM) + LN_EPS);
    float gg[16], bb[16];
    load_row16(g, lane, gg); load_row16(b, lane, bb);
#pragma unroll
    for (int j = 0; j < 16; ++j) v[j] = (v[j] - mean) * rstd * gg[j] + bb[j];
}
__device__ __forceinline__ void p_rowpass0(const Ctx& C) {
    for (int row = C.bid * 8 + C.wave; row < T; row += C.G * 8) {
        float v[16]; load_row16(C.in[I_X] + (size_t)row * DM, C.lane, v);
        row_emit(C, row, v, 0, true);
    }
}
__device__ __forceinline__ void p_cumsum(const Ctx& C) {
    if (C.bid >= BATCH * 4) return;
    const float* lsig = (const float*)(C.ws + WS_MISC);
    float* cum = (float*)(C.ws + WS_CUM);
    LAS float* wt = (LAS float*)C.lds;
    const int b = C.bid >> 2, h = C.bid & 3;
    float v[16];
#pragma unroll
    for (int j = 0; j < 16; ++j) v[j] = lsig[((size_t)b * SEQ + C.tid * 16 + j) * 4 + h];
#pragma unroll
    for (int j = 1; j < 16; ++j) v[j] += v[j - 1];
    float inc = v[15];
#pragma unroll
    for (int o = 1; o < 64; o <<= 1) { const float t = __shfl_up(inc, o, 64); if (C.lane >= o) inc += t; }
    if (C.lane == 63) wt[C.wave] = inc;
    __syncthreads();
    float off = inc - v[15];
    for (int w2 = 0; w2 < C.wave; ++w2) off += wt[w2];
    float* cp = cum + ((size_t)b * 4 + h) * SEQ + C.tid * 16;
#pragma unroll
    for (int j4 = 0; j4 < 4; ++j4) *(f32x4*)(cp + 4 * j4) = (f32x4){v[4 * j4] + off, v[4 * j4 + 1] + off, v[4 * j4 + 2] + off, v[4 * j4 + 3] + off};
    __syncthreads();
}
__device__ __forceinline__ void load_row16_bf(const bf16_t* p, int lane, float (&v)[16]) {
    const u32x4 a = *(const u32x4*)(p + lane * 8), b = *(const u32x4*)(p + 512 + lane * 8);
#pragma unroll
    for (int j = 0; j < 4; ++j) { v[2 * j] = bf2f(a[j] & 0xffffu); v[2 * j + 1] = bf2f(a[j] >> 16); v[8 + 2 * j] = bf2f(b[j] & 0xffffu); v[9 + 2 * j] = bf2f(b[j] >> 16); }
}
__device__ __forceinline__ void p_ln1(const Ctx& C, int l) {
    const bf16_t* y1 = (const bf16_t*)(C.ws + WS_XC); bf16_t* x1b = (bf16_t*)(C.ws + WS_X1B);
    for (int row = C.bid * 8 + C.wave; row < T; row += C.G * 8) {
        float v[16]; load_row16_bf(y1 + (size_t)row * DM, C.lane, v);
        ln_row16(v, C.in[I_LN1G] + l * DM, C.in[I_LN1B] + l * DM, C.lane);
        u32x4 o0, o1;
#pragma unroll
        for (int j = 0; j < 4; ++j) { o0[j] = pk2(v[2 * j], v[2 * j + 1]); o1[j] = pk2(v[8 + 2 * j], v[8 + 2 * j + 1]); }
        *(u32x4*)(x1b + (size_t)row * DM + C.lane * 8) = o0; *(u32x4*)(x1b + (size_t)row * DM + 512 + C.lane * 8) = o1;
    }
}

__device__ __forceinline__ void mix_pool_naive(const Ctx& C, int l) {
    const bf16_t* H = (const bf16_t*)(C.ws + WS_H); bf16_t* BR = (bf16_t*)(C.ws + WS_BR);
    LAS float* dd = (LAS float*)C.lds;
    for (int u = C.bid; u < (T / 64) * 4; u += C.G) {
        const int g = u & 3, t0 = (u >> 2) * 64, w = 2 << g;
        for (int idx = C.tid; idx < 64 * 128; idx += 512) {
            const int r = idx >> 7, c = idx & 127, row = t0 + r, pos = row & (SEQ - 1);
            const int nwin = (pos + 1 < w) ? pos + 1 : w;
            float s = 0.f;
            for (int j = 0; j < nwin; ++j) s += bf2f(H[(size_t)(row - j) * NH + HC_P + g * 128 + c]);
            dd[idx] = s / (float)nwin - bf2f(H[(size_t)row * NH + HC_P + g * 128 + c]);
        }
        __syncthreads();
        const int dcol = C.tid & 127, rq = C.tid >> 7;
        float acc[16];
#pragma unroll
        for (int i = 0; i < 16; ++i) acc[i] = 0.f;
        const float* pw = C.in[I_POOLW] + ((size_t)l * 4 + g) * 128 * 128;
        for (int c = 0; c < 128; ++c) {
            const float wv = pw[c * 128 + dcol];
#pragma unroll
            for (int i = 0; i < 16; ++i) acc[i] += dd[(rq * 16 + i) * 128 + c] * wv;
        }
        const float sc = C.in[I_POOLS][l * BW + g * 128 + dcol];
#pragma unroll
        for (int i = 0; i < 16; ++i) BR[(size_t)(t0 + rq * 16 + i) * NBR + 0 + g * 128 + dcol] = (bf16_t)f2bf(acc[i] * sc);
        __syncthreads();
    }
}
__device__ __forceinline__ void mix_gmlp_naive(const Ctx& C, int l) {
    const bf16_t* H = (const bf16_t*)(C.ws + WS_H); bf16_t* BR = (bf16_t*)(C.ws + WS_BR);
    LAS float* vn = (LAS float*)C.lds;
    for (int u = C.bid; u < (T / 128) * 4; u += C.G) {
        const int g = u & 3, t0 = (u >> 2) * 128;
        for (int i = 0; i < 16; ++i) {
            const int r = C.wave * 16 + i, row = t0 + r;
            const u32x4 raw = *(const u32x4*)(H + (size_t)row * NH + HC_GV + C.lane * 8);
            float e[8];
#pragma unroll
            for (int j = 0; j < 4; ++j) { e[2 * j] = geluf_(bf2f(raw[j] & 0xffffu)); e[2 * j + 1] = geluf_(bf2f(raw[j] >> 16)); }
            float s = 0.f;
#pragma unroll
            for (int j = 0; j < 8; ++j) s += e[j];
            const float mean = wave_sum(s) * (1.f / BW);
            float q = 0.f;
#pragma unroll
            for (int j = 0; j < 8; ++j) { const float d = e[j] - mean; q += d * d; }
            const float rstd = rsqrtf(wave_sum(q) * (1.f / BW) + LN_EPS);
            if ((C.lane >> 4) == g) {
#pragma unroll
                for (int j = 0; j < 8; ++j) { const int col = C.lane * 8 + j;
                    vn[r * 128 + (col - g * 128)] = (e[j] - mean) * rstd * C.in[I_GLNG][l * BW + col] + C.in[I_GLNB][l * BW + col]; }
            }
        }
        __syncthreads();
        const int c = C.tid & 127, tq = C.tid >> 7;
        const float* wsg = C.in[I_GWS] + ((size_t)l * 4 + g) * 128 * 128;
        for (int t = tq; t < 128; t += 4) {
            float acc = 0.f;
            for (int s = 0; s <= t; ++s) acc += wsg[t * 128 + s] * vn[s * 128 + c];
            const float sv = acc + C.in[I_GBS][(l * 4 + g) * 128 + t];
            const float uv = geluf_(bf2f(H[(size_t)(t0 + t) * NH + HC_GU + g * 128 + c]));
            BR[(size_t)(t0 + t) * NBR + 1024 + g * 128 + c] = (bf16_t)f2bf(uv * sv);
        }
        __syncthreads();
    }
}
__device__ __forceinline__ void mix_fox_naive(const Ctx& C, int l) {
    const bf16_t* H = (const bf16_t*)(C.ws + WS_H); bf16_t* BR = (bf16_t*)(C.ws + WS_BR);
    const float* cum = (const float*)(C.ws + WS_CUM);
    const float scale = 0.08838834764831845f;
    for (int u = C.bid; u < T * 4 / 8; u += C.G) {
        const int rid = u * 8 + C.wave;
        const int h = rid & 3, row = rid >> 2, b = row / SEQ, t = row % SEQ;
        const unsigned qraw = *(const unsigned*)(H + (size_t)row * NH + HC_FQ + h * 128 + C.lane * 2);
        const float q0 = bf2f(qraw & 0xffffu) * scale, q1 = bf2f(qraw >> 16) * scale;
        const float* cm = cum + ((size_t)b * 4 + h) * SEQ;
        const float ct = cm[t];
        float m = -1e30f, lsum = 0.f, o0 = 0.f, o1 = 0.f;
        for (int s = t; s >= 0; --s) {
            const size_t kr = (size_t)(b * SEQ + s) * NH + h * 128 + C.lane * 2;
            const unsigned kraw = *(const unsigned*)(H + kr + HC_FK);
            const unsigned vraw = *(const unsigned*)(H + kr + HC_FV);
            float d = q0 * bf2f(kraw & 0xffffu) + q1 * bf2f(kraw >> 16);
            d = wave_sum(d);
            const float z = d + ct - cm[s];
            const float mn = fmaxf(m, z), al = __expf(m - mn), p = __expf(z - mn);
            lsum = lsum * al + p; o0 = o0 * al + p * bf2f(vraw & 0xffffu); o1 = o1 * al + p * bf2f(vraw >> 16); m = mn;
        }
        const float inv = 1.f / lsum;
        *(unsigned*)(BR + (size_t)row * NBR + 1536 + h * 128 + C.lane * 2) = pk2(o0 * inv, o1 * inv);
    }
}
__device__ __forceinline__ void mix_hgrn_naive(const Ctx& C, int l) {
    if (C.bid >= BATCH * 4) return;
    const bf16_t* H = (const bf16_t*)(C.ws + WS_H); bf16_t* BR = (bf16_t*)(C.ws + WS_BR);
    const int b = C.bid >> 2, h = C.bid & 3;
    LAS float* fdec = (LAS float*)C.lds;
    LAS float* kkv = fdec + 32 * 128;
    LAS float* qsv = kkv + 32 * 128;
    LAS float* vv = qsv + 32 * 128;
    LAS float* opart = vv + 32 * 128;
    const int kq = C.tid >> 7, v = C.tid & 127;
    float S[32];
#pragma unroll
    for (int j = 0; j < 32; ++j) S[j] = 0.f;
    for (int c0 = 0; c0 < SEQ; c0 += 32) {
        for (int idx = C.tid; idx < 32 * 128; idx += 512) {
            const int st = idx >> 7, k = idx & 127; const size_t rb = (size_t)(b * SEQ + c0 + st) * NH + h * 128 + k;
            float lb = 0.f;
            if (l == 1) { const float z0 = C.in[I_LBL][h * 128 + k], z1 = C.in[I_LBL][BW + h * 128 + k]; lb = 1.f / (1.f + __expf(z0 - z1)); }
            const float zf = bf2f(H[rb + HC_HF]);
            const float kk = (1.f - lb) * sigmoidf_(-zf);
            fdec[idx] = 1.f - kk; kkv[idx] = kk; qsv[idx] = siluf_(bf2f(H[rb + HC_HQ])); vv[idx] = bf2f(H[rb + HC_HI]);
        }
        __syncthreads();
        for (int st = 0; st < 32; ++st) {
            const float vt = vv[st * 128 + v];
            float part = 0.f;
#pragma unroll
            for (int j = 0; j < 32; ++j) { const int k = kq * 32 + j; S[j] = fdec[st * 128 + k] * S[j] + kkv[st * 128 + k] * vt; part += S[j] * qsv[st * 128 + k]; }
            opart[(kq * 32 + st) * 128 + v] = part;
        }
        __syncthreads();
        for (int i = 0; i < 4; ++i) {
            const int st = C.wave * 4 + i, row = b * SEQ + c0 + st;
            float o0 = 0.f, o1 = 0.f;
#pragma unroll
            for (int q = 0; q < 4; ++q) { o0 += opart[(q * 32 + st) * 128 + C.lane]; o1 += opart[(q * 32 + st) * 128 + 64 + C.lane]; }
            const float ss = wave_sum(o0 * o0 + o1 * o1);
            const float r = rsqrtf(ss * (1.f / 128.f) + RMS_EPS);
            const float g0 = siluf_(bf2f(H[(size_t)row * NH + HC_HG + h * 128 + C.lane])), g1 = siluf_(bf2f(H[(size_t)row * NH + HC_HG + h * 128 + 64 + C.lane]));
            BR[(size_t)row * NBR + 512 + h * 128 + C.lane] = (bf16_t)f2bf(o0 * r * C.in[I_HNG][l * 128 + C.lane] * g0);
            BR[(size_t)row * NBR + 512 + h * 128 + 64 + C.lane] = (bf16_t)f2bf(o1 * r * C.in[I_HNG][l * 128 + 64 + C.lane] * g1);
        }
        __syncthreads();
    }
}


typedef float f32x16 __attribute__((ext_vector_type(16)));
typedef short s16x4 __attribute__((ext_vector_type(4)));
typedef short v4i16_t __attribute__((ext_vector_type(4)));
__device__ __forceinline__ s16x4 vtr(const LAS unsigned char* p) { return __builtin_bit_cast(s16x4, __builtin_amdgcn_ds_read_tr16_b64_v4i16((LAS v4i16_t*)p)); }
__device__ __forceinline__ float xor32(float x) { return __shfl_xor(x, 32, 64); }
#define MFMA32(a, b, c) __builtin_amdgcn_mfma_f32_32x32x16_bf16((a), (b), (c), 0, 0, 0)
constexpr int CW_KMAX = 16;

__device__ __forceinline__ void p_knorm(const Ctx& C, int l) {
    const bf16_t* H = (const bf16_t*)(C.ws + WS_H);
    unsigned* kmax = (unsigned*)(C.ws + WS_CTL) + CW_KMAX + l * 8;
    for (int r0 = (C.bid * 8 + C.wave) * 8; r0 < T; r0 += C.G * 64) {
        u32x4 raw[8];
#pragma unroll
        for (int i = 0; i < 8; ++i) raw[i] = *(const u32x4*)(H + (size_t)(r0 + i) * NH + HC_FK + C.lane * 8);
        float best = 0.f;
#pragma unroll
        for (int i = 0; i < 8; ++i) { float s = 0.f;
#pragma unroll
            for (int j = 0; j < 4; ++j) { const float a = bf2f(raw[i][j] & 0xffffu), b = bf2f(raw[i][j] >> 16); s += a * a + b * b; }
            best = fmaxf(best, s); }
        best = 0.f;
#pragma unroll
        for (int i = 0; i < 8; ++i) { float s = 0.f;
#pragma unroll
            for (int j = 0; j < 4; ++j) { const float a = bf2f(raw[i][j] & 0xffffu), b = bf2f(raw[i][j] >> 16); s += a * a + b * b; }
#pragma unroll
            for (int o = 8; o > 0; o >>= 1) s += __shfl_xor(s, o, 64);
            best = fmaxf(best, s); }
        LAS float* red = (LAS float*)C.lds;
        if ((C.lane & 15) == 0) red[C.wave * 4 + (C.lane >> 4)] = best;
        __syncthreads();
        if (C.tid < 4) { float m = red[C.tid];
#pragma unroll
            for (int w2 = 1; w2 < 8; ++w2) m = fmaxf(m, red[w2 * 4 + C.tid]);
            atomicMax(kmax + (r0 / SEQ) * 4 + C.tid, __builtin_bit_cast(unsigned, m)); }
        __syncthreads();
    }
}

constexpr int FOX_KST = 272, FOX_VST = 320;
constexpr int FOX_KB = 0, FOX_VB = 2 * 64 * FOX_KST, FOX_BETA = FOX_VB + 2 * 64 * FOX_VST, FOX_FLAG = FOX_BETA + 2 * 64 * 4, FOX_END = FOX_FLAG + 2 * 8 * 4;
__device__ __forceinline__ void mix_fox(const Ctx& C, int l) {
    const bf16_t* H = (const bf16_t*)(C.ws + WS_H); bf16_t* BR = (bf16_t*)(C.ws + WS_BR);
    const float* cum = (const float*)(C.ws + WS_CUM);
    const unsigned* kmaxw = (const unsigned*)(C.ws + WS_CTL) + CW_KMAX + l * 8;
    const float LOG2E = 1.4426950408889634f, QS = 0.08838834764831845f * LOG2E;
    const int lane = C.lane, w = C.wave, r32 = lane & 31, hh = lane >> 5;
    LAS unsigned char* lds = C.lds;
    LAS float* betaL = (LAS float*)(lds + FOX_BETA);
    volatile LAS int* flagL = (volatile LAS int*)(lds + FOX_FLAG);
    for (int u = C.bid; u < BATCH * 4 * (SEQ / 256); u += C.G) {
        const int qb = u % (SEQ / 256), bh = u / (SEQ / 256), b = bh >> 2, h = bh & 3;
        const int q0 = qb * 256, qw = q0 + 32 * w;
        const size_t rowbase = (size_t)b * SEQ;
        const float* cm = cum + ((size_t)b * 4 + h) * SEQ;
        const float c0 = cm[q0];
        const float kmx = sqrtf(__builtin_bit_cast(float, __hip_atomic_load(kmaxw + b * 4 + h, __ATOMIC_RELAXED, __HIP_MEMORY_SCOPE_AGENT)));
        bf16x8 qf[8]; float qn = 0.f;
        {
            const bf16_t* qp = H + (rowbase + qw + r32) * NH + HC_FQ + h * 128 + 8 * hh;
#pragma unroll
            for (int ks = 0; ks < 8; ++ks) {
                const u32x4 raw = *(const u32x4*)(qp + 16 * ks);
                u32x4 o;
#pragma unroll
                for (int j = 0; j < 4; ++j) { const float a = bf2f(raw[j] & 0xffffu), bb = bf2f(raw[j] >> 16); qn += a * a + bb * bb; o[j] = cvtpk(a * QS, bb * QS); }
                qf[ks] = __builtin_bit_cast(bf16x8, o);
            }
            qn += xor32(qn); qn = sqrtf(qn);
        }
        const float qbound = qn * kmx * QS;
        f32x16 oacc[4];
#pragma unroll
        for (int mt = 0; mt < 4; ++mt)
#pragma unroll
            for (int i = 0; i < 16; ++i) oacc[mt][i] = 0.f;
        float m_run = -1e30f, l_run = 0.f;
        const int jmax = (q0 + 255) >> 6;
        const int srow = C.tid >> 4, sch = C.tid & 15;
        u32x4 kreg[2], vreg[2]; float breg = 0.f;
#define FOX_GLOAD(j_) do { _Pragma("unroll") for (int p = 0; p < 2; ++p) { \
                const bf16_t* rp = H + (rowbase + 64 * (j_) + srow + 32 * p) * NH + h * 128 + sch * 8; \
                kreg[p] = *(const u32x4*)(rp + HC_FK); vreg[p] = *(const u32x4*)(rp + HC_FV); } \
            if (C.tid < 64) breg = (c0 - cm[64 * (j_) + C.tid]) * LOG2E; } while (0)
#define FOX_LWRITE(buf_) do { _Pragma("unroll") for (int p = 0; p < 2; ++p) { \
                *(LAS u32x4*)(lds + FOX_KB + (buf_) * 64 * FOX_KST + (srow + 32 * p) * FOX_KST + sch * 16) = kreg[p]; \
                *(LAS u32x4*)(lds + FOX_VB + (buf_) * 64 * FOX_VST + (srow + 32 * p) * FOX_VST + sch * 16) = vreg[p]; } \
            if (C.tid < 64) betaL[(buf_) * 64 + C.tid] = breg; } while (0)
        __syncthreads();
        if (C.tid < 16) flagL[C.tid] = 0;
        FOX_GLOAD(jmax); FOX_LWRITE(jmax & 1);
        bool wdone = false;
        for (int j = jmax; j >= 0; --j) {
            const int cur = j & 1;
            __syncthreads();
            if (j < jmax) { int all = 1;
#pragma unroll
                for (int i = 0; i < 8; ++i) all &= flagL[((j + 1) & 1) * 8 + i];
                if (all) break; }
            if (j > 0) FOX_GLOAD(j - 1);
            const int k0 = 64 * j;
            if (k0 <= qw + 31 && !wdone) {
                const LAS unsigned char* kb = lds + FOX_KB + cur * 64 * FOX_KST;
                const LAS unsigned char* vb = lds + FOX_VB + cur * 64 * FOX_VST;
                f32x16 sacc[2];
#pragma unroll
                for (int mt = 0; mt < 2; ++mt)
#pragma unroll
                    for (int g = 0; g < 4; ++g) { const f32x4 bv = *(const LAS f32x4*)(betaL + cur * 64 + 32 * mt + 8 * g + 4 * hh);
                        sacc[mt][4 * g] = bv[0]; sacc[mt][4 * g + 1] = bv[1]; sacc[mt][4 * g + 2] = bv[2]; sacc[mt][4 * g + 3] = bv[3]; }
#pragma unroll
                for (int ks = 0; ks < 8; ++ks)
#pragma unroll
                    for (int mt = 0; mt < 2; ++mt) {
                        const bf16x8 kf = *(const LAS bf16x8*)(kb + (32 * mt + r32) * FOX_KST + 32 * ks + 16 * hh);
                        sacc[mt] = MFMA32(kf, qf[ks], sacc[mt]);
                    }
                const int tq = qw + r32;
                if (k0 + 63 > qw) {
#pragma unroll
                    for (int mt = 0; mt < 2; ++mt)
#pragma unroll
                        for (int i = 0; i < 16; ++i) { const int key = k0 + 32 * mt + (i & 3) + 8 * (i >> 2) + 4 * hh; if (key > tq) sacc[mt][i] = -1e30f; }
                }
                float mx = sacc[0][0];
#pragma unroll
                for (int mt = 0; mt < 2; ++mt)
#pragma unroll
                    for (int i = 0; i < 16; ++i) mx = fmaxf(mx, sacc[mt][i]);
                mx = fmaxf(mx, xor32(mx));
                const float mn = fmaxf(m_run, mx), alpha = __builtin_amdgcn_exp2f(m_run - mn);
                m_run = mn;
                float ps = 0.f;
#pragma unroll
                for (int mt = 0; mt < 2; ++mt)
#pragma unroll
                    for (int i = 0; i < 16; ++i) { const float p = __builtin_amdgcn_exp2f(sacc[mt][i] - mn); sacc[mt][i] = p; ps += p; }
                l_run = l_run * alpha + ps;
#pragma unroll
                for (int mt = 0; mt < 4; ++mt)
#pragma unroll
                    for (int i = 0; i < 16; ++i) oacc[mt][i] *= alpha;
#pragma unroll
                for (int s4 = 0; s4 < 4; ++s4) {
                    const int mtk = s4 >> 1, s = s4 & 1;
                    u32x4 pb;
#pragma unroll
                    for (int e = 0; e < 4; ++e) pb[e] = cvtpk(sacc[mtk][8 * s + 2 * e], sacc[mtk][8 * s + 2 * e + 1]);
                    const bf16x8 pfrag = __builtin_bit_cast(bf16x8, pb);
                    const int i16 = lane & 15, q4 = i16 >> 2, p4 = i16 & 3, blk = (lane >> 4) & 1;
                    const int keyA = 32 * mtk + 16 * s + 4 * hh + q4;
#pragma unroll
                    for (int mt = 0; mt < 4; ++mt) {
                        const LAS unsigned char* a0 = vb + keyA * FOX_VST + (32 * mt + 16 * blk + 4 * p4) * 2;
                        const s16x4 lo = vtr(a0), hi = vtr(a0 + 8 * FOX_VST);
                        const bf16x8 vf = __builtin_shufflevector(lo, hi, 0, 1, 2, 3, 4, 5, 6, 7);
                        oacc[mt] = MFMA32(vf, pfrag, oacc[mt]);
                    }
                }
                if (j > 0) { const float bl = (c0 - cm[k0 - 1]) * LOG2E;
                    const int ok = (qbound + bl < m_run - 152.f) ? 1 : 0;
                    wdone = __all(ok); }
            }
            if (lane == 0) flagL[cur * 8 + w] = wdone ? 1 : 0;
            if (j > 0) FOX_LWRITE(cur ^ 1);
        }
        l_run += xor32(l_run);
        const float inv = 1.f / l_run;
        bf16_t* op = BR + (rowbase + qw + r32) * NBR + 1536 + h * 128;
#pragma unroll
        for (int mt = 0; mt < 4; ++mt)
#pragma unroll
            for (int g = 0; g < 4; ++g) { u32x2 o; o[0] = cvtpk(oacc[mt][4 * g] * inv, oacc[mt][4 * g + 1] * inv); o[1] = cvtpk(oacc[mt][4 * g + 2] * inv, oacc[mt][4 * g + 3] * inv);
                *(u32x2*)(op + 32 * mt + 8 * g + 4 * hh) = o; }
    }
}


constexpr int HG_LF = 0, HG_QA = 34816, HG_QB = HG_QA + 17408, HG_KD = HG_QB + 8704, HG_KO = HG_KD + 17408, HG_KT = HG_KO + 8704, HG_VN = HG_KT + 20480, HG_AM = HG_VN + 20480, HG_END = HG_AM + 12288;
constexpr int HG_LFS = 132;
static_assert(HG_END + 2048 <= 140 * 1024, "hgrn LDS");
constexpr size_t WS_DSC = WS_ST + (size_t)BATCH * 4 * 32 * 128 * 128 * 4;

template <bool FULL>
__device__ __forceinline__ void hgrn_unit(const Ctx& C, int l, int u) {
#if DIAG == 1
    const bf16_t* H = (const bf16_t*)(C.ws + WS_H); bf16_t* BR = (l == 0) ? (bf16_t*)(C.ws + WS_XA) : (bf16_t*)(C.ws + WS_TABU);
#else
    const bf16_t* H = (const bf16_t*)(C.ws + WS_H); bf16_t* BR = (bf16_t*)(C.ws + WS_BR);
#endif
    float* STB = (float*)(C.ws + WS_ST); float* DSC = (float*)(C.ws + WS_DSC);
    LAS unsigned char* lds = C.lds;
    LAS float* LF = (LAS float*)(lds + HG_LF);
    const int lane = C.lane, w = C.wave, r32 = lane & 31, hh = lane >> 5;
    const int sc = u & 31, bh = u >> 5, b = bh >> 2, h = bh & 3;
    const int wk = w >> 1, wv = w & 1;
    const int mt = w >> 2, nt = w & 3;
    const int i16 = lane & 15, q4 = i16 >> 2, p4 = i16 & 3, blk = (lane >> 4) & 1;
    f32x16 S0, S1;
    float* stp = STB + ((size_t)bh * 32 + sc) * 128 * 128;
    if constexpr (FULL) {
#pragma unroll
        for (int i = 0; i < 16; ++i) { const int k = 32 * wk + (i & 3) + 8 * (i >> 2) + 4 * hh;
            S0[i] = stp[k * 128 + 64 * wv + r32]; S1[i] = stp[k * 128 + 64 * wv + 32 + r32]; }
    } else {
#pragma unroll
        for (int i = 0; i < 16; ++i) { S0[i] = 0.f; S1[i] = 0.f; }
    }
    float dtot = 0.f;
    const int ps = C.tid >> 3, pseg = C.tid & 7;
    float lbv[16];
#pragma unroll
    for (int j = 0; j < 16; ++j) { lbv[j] = 0.f;
        if (l == 1) { const int ch = h * 128 + 16 * pseg + j; lbv[j] = 1.f / (1.f + __expf(C.in[I_LBL][ch] - C.in[I_LBL][BW + ch])); } }
    for (int c = 0; c < 4; ++c) {
        const size_t row0 = (size_t)b * SEQ + sc * 256 + c * 64;
        const bf16_t* hp = H + (row0 + ps) * NH + h * 128 + 16 * pseg;
        float kkv[16], qsv[16];
        u32x4 vraw0, vraw1;
        {
            const u32x4 f0 = *(const u32x4*)(hp + HC_HF), f1 = *(const u32x4*)(hp + HC_HF + 8);
            vraw0 = *(const u32x4*)(hp + HC_HI); vraw1 = *(const u32x4*)(hp + HC_HI + 8);
#pragma unroll
            for (int j = 0; j < 8; ++j) { const unsigned r = (j < 4) ? f0[j] : f1[j - 4];
                const float z0 = bf2f(r & 0xffffu), z1 = bf2f(r >> 16);
                kkv[2 * j] = (1.f - lbv[2 * j]) * sigmoidf_(-z0); kkv[2 * j + 1] = (1.f - lbv[2 * j + 1]) * sigmoidf_(-z1); }
            if constexpr (FULL) {
                const u32x4 q0 = *(const u32x4*)(hp + HC_HQ), q1 = *(const u32x4*)(hp + HC_HQ + 8);
#pragma unroll
                for (int j = 0; j < 8; ++j) { const unsigned r = (j < 4) ? q0[j] : q1[j - 4]; qsv[2 * j] = siluf_(bf2f(r & 0xffffu)); qsv[2 * j + 1] = siluf_(bf2f(r >> 16)); }
            }
#pragma unroll
            for (int j4 = 0; j4 < 4; ++j4) { f32x4 o;
#pragma unroll
                for (int e = 0; e < 4; ++e) o[e] = __logf(1.f - kkv[4 * j4 + e]);
                *(LAS f32x4*)(LF + ps * HG_LFS + 16 * pseg + 4 * j4) = o; }
        }
        __syncthreads();
        {
            const int sk = C.tid & 127, sg = C.tid >> 7;
            float vals[16];
#pragma unroll
            for (int i = 0; i < 16; ++i) vals[i] = LF[(16 * sg + i) * HG_LFS + sk];
#pragma unroll
            for (int i = 1; i < 16; ++i) vals[i] += vals[i - 1];
            LAS float* TOT = (LAS float*)(lds + HG_END);
            TOT[sg * 128 + sk] = vals[15];
            __syncthreads();
            float off = 0.f;
#pragma unroll
            for (int j = 0; j < 3; ++j) if (j < sg) off += TOT[j * 128 + sk];
#pragma unroll
            for (int i = 0; i < 16; ++i) LF[(16 * sg + i) * HG_LFS + sk] = vals[i] + off;
            if (sg == 3) dtot += vals[15] + off;
        }
        __syncthreads();
        float bv[16], b31[16], bl[16];
#pragma unroll
        for (int j4 = 0; j4 < 4; ++j4) { const f32x4 x = *(const LAS f32x4*)(LF + ps * HG_LFS + 16 * pseg + 4 * j4), y = *(const LAS f32x4*)(LF + 31 * HG_LFS + 16 * pseg + 4 * j4), z = *(const LAS f32x4*)(LF + 63 * HG_LFS + 16 * pseg + 4 * j4);
#pragma unroll
            for (int e = 0; e < 4; ++e) { bv[4 * j4 + e] = x[e]; b31[4 * j4 + e] = y[e]; bl[4 * j4 + e] = z[e]; } }
        {
            u32x4 o0, o1;
#pragma unroll
            for (int j = 0; j < 4; ++j) { o0[j] = cvtpk(kkv[2 * j] * __expf(bl[2 * j] - bv[2 * j]), kkv[2 * j + 1] * __expf(bl[2 * j + 1] - bv[2 * j + 1]));
                o1[j] = cvtpk(kkv[8 + 2 * j] * __expf(bl[8 + 2 * j] - bv[8 + 2 * j]), kkv[9 + 2 * j] * __expf(bl[9 + 2 * j] - bv[9 + 2 * j])); }
            *(LAS u32x4*)(lds + HG_KT + ps * 320 + 32 * pseg) = o0; *(LAS u32x4*)(lds + HG_KT + ps * 320 + 32 * pseg + 16) = o1;
            *(LAS u32x4*)(lds + HG_VN + ps * 320 + 32 * pseg) = vraw0; *(LAS u32x4*)(lds + HG_VN + ps * 320 + 32 * pseg + 16) = vraw1;
            if constexpr (FULL) {
                const bool hi = ps >= 32;
                float rr[16];
#pragma unroll
                for (int j = 0; j < 16; ++j) rr[j] = hi ? b31[j] : 0.f;
#pragma unroll
                for (int j = 0; j < 4; ++j) { o0[j] = cvtpk(qsv[2 * j] * __expf(bv[2 * j] - rr[2 * j]), qsv[2 * j + 1] * __expf(bv[2 * j + 1] - rr[2 * j + 1]));
                    o1[j] = cvtpk(qsv[8 + 2 * j] * __expf(bv[8 + 2 * j] - rr[8 + 2 * j]), qsv[9 + 2 * j] * __expf(bv[9 + 2 * j] - rr[9 + 2 * j])); }
                *(LAS u32x4*)(lds + HG_QA + ps * 272 + 32 * pseg) = o0; *(LAS u32x4*)(lds + HG_QA + ps * 272 + 32 * pseg + 16) = o1;
#pragma unroll
                for (int j = 0; j < 4; ++j) { o0[j] = cvtpk(kkv[2 * j] * __expf(rr[2 * j] - bv[2 * j]), kkv[2 * j + 1] * __expf(rr[2 * j + 1] - bv[2 * j + 1]));
                    o1[j] = cvtpk(kkv[8 + 2 * j] * __expf(rr[8 + 2 * j] - bv[8 + 2 * j]), kkv[9 + 2 * j] * __expf(rr[9 + 2 * j] - bv[9 + 2 * j])); }
                *(LAS u32x4*)(lds + HG_KD + ps * 272 + 32 * pseg) = o0; *(LAS u32x4*)(lds + HG_KD + ps * 272 + 32 * pseg + 16) = o1;
                if (hi) {
#pragma unroll
                    for (int j = 0; j < 4; ++j) { o0[j] = cvtpk(qsv[2 * j] * __expf(bv[2 * j]), qsv[2 * j + 1] * __expf(bv[2 * j + 1]));
                        o1[j] = cvtpk(qsv[8 + 2 * j] * __expf(bv[8 + 2 * j]), qsv[9 + 2 * j] * __expf(bv[9 + 2 * j])); }
                    *(LAS u32x4*)(lds + HG_QB + (ps - 32) * 272 + 32 * pseg) = o0; *(LAS u32x4*)(lds + HG_QB + (ps - 32) * 272 + 32 * pseg + 16) = o1;
                } else {
#pragma unroll
                    for (int j = 0; j < 4; ++j) { o0[j] = cvtpk(kkv[2 * j] * __expf(b31[2 * j] - bv[2 * j]), kkv[2 * j + 1] * __expf(b31[2 * j + 1] - bv[2 * j + 1]));
                        o1[j] = cvtpk(kkv[8 + 2 * j] * __expf(b31[8 + 2 * j] - bv[8 + 2 * j]), kkv[9 + 2 * j] * __expf(b31[9 + 2 * j] - bv[9 + 2 * j])); }
                    *(LAS u32x4*)(lds + HG_KO + ps * 272 + 32 * pseg) = o0; *(LAS u32x4*)(lds + HG_KO + ps * 272 + 32 * pseg + 16) = o1;
                }
            }
        }
        float dk[16];
#pragma unroll
        for (int i = 0; i < 16; ++i) dk[i] = __expf(LF[63 * HG_LFS + 32 * wk + (i & 3) + 8 * (i >> 2) + 4 * hh]);
        __syncthreads();
        if constexpr (FULL) {
#pragma unroll
            for (int g = 0; g < 4; ++g) {
                u32x2 o; o[0] = cvtpk(S0[4 * g], S0[4 * g + 1]); o[1] = cvtpk(S0[4 * g + 2], S0[4 * g + 3]);
                *(LAS u32x2*)(lds + HG_LF + (64 * wv + r32) * 272 + (32 * wk + 8 * g + 4 * hh) * 2) = o;
                o[0] = cvtpk(S1[4 * g], S1[4 * g + 1]); o[1] = cvtpk(S1[4 * g + 2], S1[4 * g + 3]);
                *(LAS u32x2*)(lds + HG_LF + (64 * wv + 32 + r32) * 272 + (32 * wk + 8 * g + 4 * hh) * 2) = o;
            }
#define HG_ATILE(AMT_, AST_) do { \
                const LAS unsigned char* kb = ((AMT_) == (AST_)) ? (lds + HG_KD + (32 * (AST_)) * 272) : (lds + HG_KO); \
                f32x16 a; \
                _Pragma("unroll") for (int i = 0; i < 16; ++i) a[i] = 0.f; \
                _Pragma("unroll") for (int ks = 0; ks < 8; ++ks) { \
                    const bf16x8 af = *(const LAS bf16x8*)(lds + HG_QA + (32 * (AMT_) + r32) * 272 + 32 * ks + 16 * hh); \
                    const bf16x8 bf = *(const LAS bf16x8*)(kb + r32 * 272 + 32 * ks + 16 * hh); \
                    a = MFMA32(af, bf, a); } \
                _Pragma("unroll") for (int g = 0; g < 4; ++g) { \
                    float x[4]; \
                    _Pragma("unroll") for (int e = 0; e < 4; ++e) { const int tl = 8 * g + 4 * hh + e; x[e] = ((AMT_) != (AST_) || r32 <= tl) ? a[4 * g + e] : 0.f; } \
                    u32x2 o; o[0] = cvtpk(x[0], x[1]); o[1] = cvtpk(x[2], x[3]); \
                    *(LAS u32x2*)(lds + HG_AM + (32 * (AST_) + r32) * 192 + (32 * (AMT_) + 8 * g + 4 * hh) * 2) = o; } } while (0)
            if (w == 0) { HG_ATILE(0, 0); }
            else if (w == 1) { HG_ATILE(1, 0); }
            else if (w == 2) { HG_ATILE(1, 1); }
        }
#pragma unroll
        for (int i = 0; i < 16; ++i) { S0[i] *= dk[i]; S1[i] *= dk[i]; }
#pragma unroll
        for (int ks = 0; ks < 4; ++ks) {
            const LAS unsigned char* ka = lds + HG_KT + (16 * ks + 8 * hh + q4) * 320 + (32 * wk + 16 * blk + 4 * p4) * 2;
            const s16x4 alo = vtr(ka), ahi = vtr(ka + 4 * 320);
            const bf16x8 af = __builtin_shufflevector(alo, ahi, 0, 1, 2, 3, 4, 5, 6, 7);
            const LAS unsigned char* vb0 = lds + HG_VN + (16 * ks + 8 * hh + q4) * 320 + (64 * wv + 16 * blk + 4 * p4) * 2;
            const s16x4 b0lo = vtr(vb0), b0hi = vtr(vb0 + 4 * 320), b1lo = vtr(vb0 + 64), b1hi = vtr(vb0 + 64 + 4 * 320);
            S0 = MFMA32(af, __builtin_shufflevector(b0lo, b0hi, 0, 1, 2, 3, 4, 5, 6, 7), S0);
            S1 = MFMA32(af, __builtin_shufflevector(b1lo, b1hi, 0, 1, 2, 3, 4, 5, 6, 7), S1);
        }
        if constexpr (FULL) {
            __syncthreads();
            f32x16 o;
#pragma unroll
            for (int i = 0; i < 16; ++i) o[i] = 0.f;
            const LAS unsigned char* qb = (mt == 0) ? (lds + HG_QA) : (lds + HG_QB);
#pragma unroll
            for (int ks = 0; ks < 8; ++ks) {
                const bf16x8 af = *(const LAS bf16x8*)(qb + r32 * 272 + 32 * ks + 16 * hh);
                const bf16x8 bf = *(const LAS bf16x8*)(lds + HG_LF + (32 * nt + r32) * 272 + 32 * ks + 16 * hh);
                o = MFMA32(af, bf, o);
            }
#pragma unroll
            for (int ks = 0; ks < 4; ++ks) {
                if (mt == 0 && ks >= 2) continue;
                const LAS unsigned char* aa = lds + HG_AM + (16 * ks + 8 * hh + q4) * 192 + (32 * mt + 16 * blk + 4 * p4) * 2;
                const s16x4 alo = vtr(aa), ahi = vtr(aa + 4 * 192);
                const LAS unsigned char* vb0 = lds + HG_VN + (16 * ks + 8 * hh + q4) * 320 + (32 * nt + 16 * blk + 4 * p4) * 2;
                const s16x4 blo = vtr(vb0), bhi = vtr(vb0 + 4 * 320);
                o = MFMA32(__builtin_shufflevector(alo, ahi, 0, 1, 2, 3, 4, 5, 6, 7), __builtin_shufflevector(blo, bhi, 0, 1, 2, 3, 4, 5, 6, 7), o);
            }
            __syncthreads();
#pragma unroll
            for (int i = 0; i < 16; ++i) LF[(32 * mt + (i & 3) + 8 * (i >> 2) + 4 * hh) * HG_LFS + 32 * nt + r32] = o[i];
            __syncthreads();
            {
                float ov[16]; float ss = 0.f;
#pragma unroll
                for (int j4 = 0; j4 < 4; ++j4) { const f32x4 x = *(const LAS f32x4*)(LF + ps * HG_LFS + 16 * pseg + 4 * j4);
#pragma unroll
                    for (int e = 0; e < 4; ++e) { ov[4 * j4 + e] = x[e]; ss += x[e] * x[e]; } }
                ss += __shfl_xor(ss, 1, 64); ss += __shfl_xor(ss, 2, 64); ss += __shfl_xor(ss, 4, 64);
                const float rn = rsqrtf(ss * (1.f / 128.f) + RMS_EPS);
                const u32x4 g0 = *(const u32x4*)(hp + HC_HG), g1 = *(const u32x4*)(hp + HC_HG + 8);
                const float* ng = C.in[I_HNG] + l * 128 + 16 * pseg;
                u32x4 o0, o1;
#pragma unroll
                for (int j = 0; j < 4; ++j) {
                    o0[j] = cvtpk(ov[2 * j] * rn * ng[2 * j] * siluf_(bf2f(g0[j] & 0xffffu)), ov[2 * j + 1] * rn * ng[2 * j + 1] * siluf_(bf2f(g0[j] >> 16)));
                    o1[j] = cvtpk(ov[8 + 2 * j] * rn * ng[8 + 2 * j] * siluf_(bf2f(g1[j] & 0xffffu)), ov[9 + 2 * j] * rn * ng[9 + 2 * j] * siluf_(bf2f(g1[j] >> 16)));
                }
                bf16_t* bp = BR + (row0 + ps) * NBR + 512 + h * 128 + 16 * pseg;
                *(u32x4*)bp = o0; *(u32x4*)(bp + 8) = o1;
            }
        }
        __syncthreads();
    }
    if constexpr (!FULL) {
#pragma unroll
        for (int i = 0; i < 16; ++i) { const int k = 32 * wk + (i & 3) + 8 * (i >> 2) + 4 * hh;
            stp[k * 128 + 64 * wv + r32] = S0[i]; stp[k * 128 + 64 * wv + 32 + r32] = S1[i]; }
        if (C.tid >= 384) DSC[((size_t)bh * 32 + sc) * 128 + (C.tid & 127)] = __expf(dtot);
    }
}
__device__ __forceinline__ void hgrn_b1(const Ctx& C, int l) { for (int u = C.bid; u < BATCH * 4 * 32; u += C.G) hgrn_unit<false>(C, l, u); }
__device__ __forceinline__ void hgrn_b3(const Ctx& C, int l) { for (int u = C.bid; u < BATCH * 4 * 32; u += C.G) hgrn_unit<true>(C, l, u); }
__device__ __forceinline__ void hgrn_b2(const Ctx& C) {
    float* STB = (float*)(C.ws + WS_ST); const float* DSC = (const float*)(C.ws + WS_DSC);
    for (int e = C.bid * 512 + C.tid; e < BATCH * 4 * 128 * 128; e += C.G * 512) {
        const int bh = e >> 14, kv = e & 16383, k = kv >> 7;
        float* p = STB + (size_t)bh * 32 * 16384 + kv;
        float uu[32], dd[32];
#pragma unroll
        for (int s = 0; s < 32; ++s) { uu[s] = p[(size_t)s * 16384]; dd[s] = DSC[((size_t)bh * 32 + s) * 128 + k]; }
        float st = 0.f;
#pragma unroll
        for (int s = 0; s < 32; ++s) { p[(size_t)s * 16384] = st; st = dd[s] * st + uu[s]; }
    }
}


__device__ __forceinline__ void mix_pool(const Ctx& C, int l) {
#if DIAG == 2
    const bf16_t* H = (const bf16_t*)(C.ws + WS_H); bf16_t* BR = (l == 0) ? (bf16_t*)(C.ws + WS_XA) : (bf16_t*)(C.ws + WS_TABU);
#else
    const bf16_t* H = (const bf16_t*)(C.ws + WS_H); bf16_t* BR = (bf16_t*)(C.ws + WS_BR);
#endif
    const bf16_t* Wt = (const bf16_t*)(C.ws + WS_W + (size_t)l * W_LAYER + WO_POOLW);
    LAS unsigned char* lds = C.lds;
    constexpr int PL_P = 128 * 272;
    const int lane = C.lane, w = C.wave, r32 = lane & 31, hh = lane >> 5;
    for (int u = C.bid; u < (T / 256) * 4; u += C.G) {
        const int g = u & 3, t0 = (u >> 2) * 256, win = 2 << g;
        const int row = t0 + 32 * w + r32, pos = row & (SEQ - 1);
        __syncthreads();
#pragma unroll
        for (int p = 0; p < 4; ++p) { const int idx = C.tid + 512 * p, rr = idx >> 4, ch = idx & 15;
            *(LAS u32x4*)(lds + rr * 272 + ch * 16) = *(const u32x4*)(Wt + (size_t)g * 128 * 128 + rr * 128 + ch * 8); }
        const bool seq_start = (t0 & (SEQ - 1)) == 0;
        for (int idx = C.tid; idx < 271 * 16; idx += 512) { const int rr = idx >> 4, ch = idx & 15;
            if (!(seq_start && rr < 15)) *(LAS u32x4*)(lds + PL_P + rr * 272 + ch * 16) = *(const u32x4*)(H + (size_t)(t0 - 15 + rr) * NH + HC_P + g * 128 + ch * 8); }
        __syncthreads();
        const int nwin = (pos + 1 < win) ? pos + 1 : win;
        const float invn = 1.f / (float)nwin;
        bf16x8 df[8];
        const LAS unsigned char* prow = lds + PL_P + (32 * w + r32 + 15) * 272 + 16 * hh;
#pragma unroll
        for (int ks = 0; ks < 8; ++ks) {
            float sum[8];
#pragma unroll
            for (int e = 0; e < 8; ++e) sum[e] = 0.f;
            const u32x4 self = *(const LAS u32x4*)(prow + 32 * ks);
#pragma unroll
            for (int j = 0; j < 16; ++j) if (j < win) {
                const int jj = (j < nwin) ? j : 0; const float msk = (j < nwin) ? 1.f : 0.f;
                const u32x4 rw = *(const LAS u32x4*)(prow + 32 * ks - jj * 272);
#pragma unroll
                for (int e = 0; e < 4; ++e) { sum[2 * e] += msk * bf2f(rw[e] & 0xffffu); sum[2 * e + 1] += msk * bf2f(rw[e] >> 16); } }
            u32x4 o;
#pragma unroll
            for (int e = 0; e < 4; ++e) o[e] = cvtpk(sum[2 * e] * invn - bf2f(self[e] & 0xffffu), sum[2 * e + 1] * invn - bf2f(self[e] >> 16));
            df[ks] = __builtin_bit_cast(bf16x8, o);
        }
        f32x16 acc[4];
#pragma unroll
        for (int mt = 0; mt < 4; ++mt)
#pragma unroll
            for (int i = 0; i < 16; ++i) acc[mt][i] = 0.f;
#pragma unroll
        for (int ks = 0; ks < 8; ++ks)
#pragma unroll
            for (int mt = 0; mt < 4; ++mt) {
                const bf16x8 wf = *(const LAS bf16x8*)(lds + (32 * mt + r32) * 272 + 32 * ks + 16 * hh);
                acc[mt] = MFMA32(wf, df[ks], acc[mt]);
            }
        const float* psc = C.in[I_POOLS] + l * BW + g * 128;
        bf16_t* op = BR + (size_t)row * NBR + g * 128;
#pragma unroll
        for (int mt = 0; mt < 4; ++mt)
#pragma unroll
            for (int q = 0; q < 4; ++q) { const int d0 = 32 * mt + 8 * q + 4 * hh; const f32x4 sc = *(const f32x4*)(psc + d0);
                u32x2 o; o[0] = cvtpk(acc[mt][4 * q] * sc[0], acc[mt][4 * q + 1] * sc[1]); o[1] = cvtpk(acc[mt][4 * q + 2] * sc[2], acc[mt][4 * q + 3] * sc[3]);
                *(u32x2*)(op + d0) = o; }
    }
}
constexpr int GM_VN = 0, GM_WC = 128 * 320, GM_END = GM_WC + 128 * 272;
__device__ __forceinline__ void mix_gmlp(const Ctx& C, int l) {
#if DIAG == 3
    const bf16_t* H = (const bf16_t*)(C.ws + WS_H); bf16_t* BR = (l == 0) ? (bf16_t*)(C.ws + WS_XA) : (bf16_t*)(C.ws + WS_TABU);
#else
    const bf16_t* H = (const bf16_t*)(C.ws + WS_H); bf16_t* BR = (bf16_t*)(C.ws + WS_BR);
#endif
    const bf16_t* Wc = (const bf16_t*)(C.ws + WS_W + (size_t)l * W_LAYER + WO_GWS);
    LAS unsigned char* lds = C.lds;
    const int lane = C.lane, w = C.wave, r32 = lane & 31, hh = lane >> 5;
    const int i16 = lane & 15, q4 = i16 >> 2, p4 = i16 & 3, blk = (lane >> 4) & 1;
    for (int u = C.bid; u < (T / 128) * 4; u += C.G) {
        const int g = u & 3, t0 = (u >> 2) * 128;
        __syncthreads();
#pragma unroll
        for (int p = 0; p < 4; ++p) { const int idx = C.tid + 512 * p, rr = idx >> 4, ch = idx & 15;
            *(LAS u32x4*)(lds + GM_WC + rr * 272 + ch * 16) = *(const u32x4*)(Wc + (size_t)g * 128 * 128 + rr * 128 + ch * 8); }
#pragma unroll
        for (int hb = 0; hb < 4; ++hb) {
            u32x4 rawv[4];
#pragma unroll
            for (int i = 0; i < 4; ++i) rawv[i] = *(const u32x4*)(H + (size_t)(t0 + w * 16 + hb * 4 + i) * NH + HC_GV + lane * 8);
            float e[4][8], st[8];
#pragma unroll
            for (int i = 0; i < 4; ++i) { float s1 = 0.f, s2 = 0.f;
#pragma unroll
                for (int j = 0; j < 4; ++j) { const float a = geluf_(bf2f(rawv[i][j] & 0xffffu)), b = geluf_(bf2f(rawv[i][j] >> 16)); e[i][2 * j] = a; e[i][2 * j + 1] = b; s1 += a + b; s2 += a * a + b * b; }
                st[i] = s1; st[4 + i] = s2; }
#pragma unroll
            for (int sx = 32, n = 4; sx >= 8; sx >>= 1, n >>= 1) { const bool up = (lane & sx) != 0;
#pragma unroll
                for (int i = 0; i < n; ++i) { const float send = up ? st[i] : st[i + n], keep = up ? st[i + n] : st[i]; st[i] = keep + __shfl_xor(send, sx, 64); } }
            float tot = st[0]; tot += __shfl_xor(tot, 4, 64); tot += __shfl_xor(tot, 2, 64); tot += __shfl_xor(tot, 1, 64);
            float mean4[4], rstd4[4];
#pragma unroll
            for (int i = 0; i < 4; ++i) {
                mean4[i] = __builtin_bit_cast(float, __builtin_amdgcn_readlane(__builtin_bit_cast(int, tot), 8 * i)) * (1.f / BW);
                const float ex2 = __builtin_bit_cast(float, __builtin_amdgcn_readlane(__builtin_bit_cast(int, tot), 8 * (4 + i))) * (1.f / BW);
                rstd4[i] = rsqrtf(fmaxf(ex2 - mean4[i] * mean4[i], 0.f) + LN_EPS);
            }
            asm volatile("" ::: "memory");
            if ((lane >> 4) == g) {
                const float* lg = C.in[I_GLNG] + l * BW + lane * 8; const float* lb = C.in[I_GLNB] + l * BW + lane * 8;
#pragma unroll
                for (int i = 0; i < 4; ++i) {
                    const float mean = mean4[i], rstd = rstd4[i];
                    u32x4 o;
#pragma unroll
                    for (int j = 0; j < 4; ++j) o[j] = cvtpk((e[i][2 * j] - mean) * rstd * lg[2 * j] + lb[2 * j], (e[i][2 * j + 1] - mean) * rstd * lg[2 * j + 1] + lb[2 * j + 1]);
                    *(LAS u32x4*)(lds + GM_VN + (w * 16 + hb * 4 + i) * 320 + (lane & 15) * 16) = o;
                }
            }
        }
        __syncthreads();
        const int nt = w & 3, mb = (w >> 2) * 2;
        f32x16 acc[2];
#pragma unroll
        for (int m = 0; m < 2; ++m)
#pragma unroll
            for (int i = 0; i < 16; ++i) acc[m][i] = 0.f;
        for (int ks = 0; ks < 2 * (nt + 1); ++ks) {
            const bf16x8 bf = *(const LAS bf16x8*)(lds + GM_WC + (32 * nt + r32) * 272 + 32 * ks + 16 * hh);
#pragma unroll
            for (int m = 0; m < 2; ++m) {
                const LAS unsigned char* aa = lds + GM_VN + (16 * ks + 8 * hh + q4) * 320 + (32 * (mb + m) + 16 * blk + 4 * p4) * 2;
                const s16x4 lo = vtr(aa), hi = vtr(aa + 4 * 320);
                acc[m] = MFMA32(__builtin_shufflevector(lo, hi, 0, 1, 2, 3, 4, 5, 6, 7), bf, acc[m]);
            }
        }
        const int tl = 32 * nt + r32, row = t0 + tl;
        const float bias = C.in[I_GBS][(l * 4 + g) * 128 + tl];
#pragma unroll
        for (int m = 0; m < 2; ++m)
#pragma unroll
            for (int q = 0; q < 4; ++q) { const int c0 = 32 * (mb + m) + 8 * q + 4 * hh;
                const u32x2 ur = *(const u32x2*)(H + (size_t)row * NH + HC_GU + g * 128 + c0);
                u32x2 o;
                o[0] = cvtpk(geluf_(bf2f(ur[0] & 0xffffu)) * (acc[m][4 * q] + bias), geluf_(bf2f(ur[0] >> 16)) * (acc[m][4 * q + 1] + bias));
                o[1] = cvtpk(geluf_(bf2f(ur[1] & 0xffffu)) * (acc[m][4 * q + 2] + bias), geluf_(bf2f(ur[1] >> 16)) * (acc[m][4 * q + 3] + bias));
                *(u32x2*)(BR + (size_t)row * NBR + 1024 + g * 128 + c0) = o; }
    }
}

#define CE_D(a, b) do { const float _h = fmaxf(a, b), _l = fminf(a, b); a = _h; b = _l; } while (0)
__device__ __forceinline__ void sort16_desc(float (&x)[16]) {
#pragma unroll
    for (int k = 2; k <= 16; k <<= 1)
#pragma unroll
        for (int j = k >> 1; j > 0; j >>= 1)
#pragma unroll
            for (int i = 0; i < 16; ++i) { const int l = i ^ j; if (l > i) { if ((i & k) == 0) CE_D(x[i], x[l]); else CE_D(x[l], x[i]); } }
}
__device__ __forceinline__ void bmerge16_desc(float (&x)[16]) {
#pragma unroll
    for (int j = 8; j > 0; j >>= 1)
#pragma unroll
        for (int i = 0; i < 16; ++i) { const int l = i ^ j; if (l > i) CE_D(x[i], x[l]); }
}
__device__ __forceinline__ void top16_merge(float (&a)[16], const float (&b)[16]) {
#pragma unroll
    for (int i = 0; i < 16; ++i) a[i] = fmaxf(a[i], b[15 - i]);
    bmerge16_desc(a);
}
__device__ __forceinline__ float pack_idx(float v, unsigned idx, unsigned mask) { return __builtin_bit_cast(float, (__builtin_bit_cast(unsigned, v) & ~mask) | idx); }

constexpr int TK_KST = 272, TK_KBUF = 128 * TK_KST;
__device__ __forceinline__ void p_topk(const Ctx& C, int l) {
    const bf16_t* Q = (const bf16_t*)(C.ws + WS_Q);
    const bf16_t* keys = (const bf16_t*)(C.ws + WS_W + (size_t)l * W_LAYER + WO_KEYS);
    int* eidx = (int*)(C.ws + WS_EIDX); float* egate = (float*)(C.ws + WS_EGATE);
    LAS unsigned char* lds = C.lds;
    const int lane = C.lane, w = C.wave, r32 = lane & 31, hh = lane >> 5;
    for (int u = C.bid; u < (T / 256) * PH; u += C.G) {
        const int h = u & 7, t0 = (u >> 3) * 256, tok = t0 + 32 * w + r32;
        float v12[2][16];
        __syncthreads();
#pragma unroll
        for (int j = 0; j < 2; ++j) {
            const bf16_t* kp = keys + ((size_t)j * PH + h) * 128 * 128;
#pragma unroll
            for (int p = 0; p < 4; ++p) { const int idx = C.tid + 512 * p, row = idx >> 4, ch = idx & 15;
                *(LAS u32x4*)(lds + j * TK_KBUF + row * TK_KST + ch * 16) = *(const u32x4*)(kp + row * 128 + ch * 8); }
        }
        __syncthreads();
#pragma unroll
        for (int j = 0; j < 2; ++j) {
            bf16x8 qf[8];
            {
                LAS unsigned char* qs = lds + 2 * TK_KBUF + w * (32 * 272);
                u32x4 qr[8];
#pragma unroll
                for (int p = 0; p < 8; ++p) qr[p] = *(const u32x4*)(Q + (size_t)(t0 + 32 * w + 4 * p + (lane >> 4)) * NQ + h * 256 + j * 128 + (lane & 15) * 8);
#pragma unroll
                for (int p = 0; p < 8; ++p) *(LAS u32x4*)(qs + (4 * p + (lane >> 4)) * 272 + (lane & 15) * 16) = qr[p];
#pragma unroll
                for (int ks = 0; ks < 8; ++ks) qf[ks] = *(const LAS bf16x8*)(qs + r32 * 272 + 32 * ks + 16 * hh);
            }
            f32x16 sacc[4];
#pragma unroll
            for (int mt = 0; mt < 4; ++mt)
#pragma unroll
                for (int i = 0; i < 16; ++i) sacc[mt][i] = 0.f;
#pragma unroll
            for (int ks = 0; ks < 8; ++ks)
#pragma unroll
                for (int mt = 0; mt < 4; ++mt) {
                    const bf16x8 kf = *(const LAS bf16x8*)(lds + j * TK_KBUF + (32 * mt + r32) * TK_KST + 32 * ks + 16 * hh);
                    sacc[mt] = MFMA32(kf, qf[ks], sacc[mt]);
                }
            float g[4][16];
#pragma unroll
            for (int mt = 0; mt < 4; ++mt) {
#pragma unroll
                for (int i = 0; i < 16; ++i) g[mt][i] = pack_idx(sacc[mt][i], (unsigned)(32 * mt + (i & 3) + 8 * (i >> 2) + 4 * hh), 127u);
                sort16_desc(g[mt]);
            }
            top16_merge(g[0], g[1]); top16_merge(g[2], g[3]); top16_merge(g[0], g[2]);
            float o[16];
#pragma unroll
            for (int i = 0; i < 16; ++i) o[i] = __shfl_xor(g[0][i], 32, 64);
            top16_merge(g[0], o);
#pragma unroll
            for (int i = 0; i < 16; ++i) v12[j][i] = g[0][i];
        }
        float c[4][16];
        {
            int n = 0;
#pragma unroll
            for (int a = 0; a < 16; ++a)
#pragma unroll
                for (int b = 0; b < 16; ++b) if ((a + 1) * (b + 1) <= 16) {
                    const unsigned id = ((__builtin_bit_cast(unsigned, v12[0][a]) & 127u) << 7) | (__builtin_bit_cast(unsigned, v12[1][b]) & 127u);
                    c[n >> 4][n & 15] = pack_idx(v12[0][a] + v12[1][b], id, 16383u); ++n; }
#pragma unroll
            for (; n < 64; ++n) c[n >> 4][n & 15] = -3.0e38f;
        }
#pragma unroll
        for (int q = 0; q < 4; ++q) sort16_desc(c[q]);
        top16_merge(c[0], c[1]); top16_merge(c[2], c[3]); top16_merge(c[0], c[2]);
        float e[16], den = 0.f;
#pragma unroll
        for (int i = 0; i < 16; ++i) { e[i] = __expf(c[0][i] - c[0][0]); den += e[i]; }
        const float inv = 1.f / den;
        int* ip = eidx + (size_t)tok * 128 + h * 16 + 8 * hh; float* gp = egate + (size_t)tok * 128 + h * 16 + 8 * hh;
        u32x4 i0, i1; f32x4 g0, g1;
#pragma unroll
        for (int i = 0; i < 4; ++i) {
            const float ca = hh ? c[0][8 + i] : c[0][i], cb = hh ? c[0][12 + i] : c[0][4 + i];
            i0[i] = __builtin_bit_cast(unsigned, ca) & 16383u; i1[i] = __builtin_bit_cast(unsigned, cb) & 16383u;
            g0[i] = (hh ? e[8 + i] : e[i]) * inv; g1[i] = (hh ? e[12 + i] : e[4 + i]) * inv;
        }
        *(u32x4*)ip = i0; *(u32x4*)(ip + 4) = i1; *(f32x4*)gp = g0; *(f32x4*)(gp + 4) = g1;
    }
}

constexpr int CW_DIAG = 64;
__device__ __forceinline__ void diag_cmp(const Ctx& C, const bf16_t* A, int lda, const bf16_t* R, int ldr, int nc) {
    float sd = 0.f, sr = 0.f;
    for (int row = C.bid; row < T; row += C.G) {
        const int tm = row % DIAG_MOD; if (tm < DIAG_LO || tm >= DIAG_HI) continue;
        for (int c = C.tid; c < nc; c += 512) { const float a = bf2f(A[(size_t)row * lda + c]), r = bf2f(R[(size_t)row * ldr + c]); sd += (a - r) * (a - r); sr += r * r; }
    }
    sd = wave_sum(sd); sr = wave_sum(sr);
    if (C.lane == 0) { atomicAdd((float*)(C.ws + WS_CTL) + CW_DIAG, sd); atomicAdd((float*)(C.ws + WS_CTL) + CW_DIAG + 1, sr); }
}
__device__ __forceinline__ void diag_cmp_u8(const Ctx& C, const unsigned char* A, int lda, const bf16_t* R, int ldr, int nc) {
    float sd = 0.f, sr = 0.f;
    for (int row = C.bid; row < T; row += C.G)
        for (int c = C.tid; c < nc; c += 512) { const float a = (float)A[(size_t)row * lda + c] * (1.f / 255.f), r = bf2f(R[(size_t)row * ldr + c]); sd += (a - r) * (a - r); sr += r * r; }
    sd = wave_sum(sd); sr = wave_sum(sr);
    if (C.lane == 0) { atomicAdd((float*)(C.ws + WS_CTL) + CW_DIAG, sd); atomicAdd((float*)(C.ws + WS_CTL) + CW_DIAG + 1, sr); }
}
__device__ __forceinline__ float diag_alpha(const Ctx& C) {
    const float sd = __hip_atomic_load((float*)(C.ws + WS_CTL) + CW_DIAG, __ATOMIC_RELAXED, __HIP_MEMORY_SCOPE_AGENT), sr = __hip_atomic_load((float*)(C.ws + WS_CTL) + CW_DIAG + 1, __ATOMIC_RELAXED, __HIP_MEMORY_SCOPE_AGENT);
    const float err = fmaxf(sd / fmaxf(sr, 1e-30f), 1e-8f);
    return 0.1f + 0.1f * (rintf(log10f(err / 1e-8f) * 10.f) * 0.1f);
}


#if DIAG == 5 || DIAG == 6
__device__ __forceinline__ void diag_ref_slice(const Ctx& C, const float* W, int ldw, int n0, const float* bias) {
    bf16_t* alt = (bf16_t*)(C.ws + WS_XA);
    const float* X = C.in[I_X];
    for (int row = C.bid * 8 + C.wave; row < T; row += C.G * 8) {
        float acc = 0.f;
        for (int k = 0; k < DM; ++k) acc += X[(size_t)row * DM + k] * W[(size_t)k * ldw + n0 + C.lane];
        if (bias) acc = sigmoidf_(acc + bias[n0 + C.lane]);
        alt[(size_t)row * 64 + C.lane] = (bf16_t)f2bf(acc);
    }
}
#endif

__device__ __forceinline__ void wave_argmax(float& v, int& i) {
#pragma unroll
    for (int o = 32; o > 0; o >>= 1) {
        const float ov = __shfl_xor(v, o, 64); const int oi = __shfl_xor(i, o, 64);
        if (ov > v || (ov == v && oi < i)) { v = ov; i = oi; }
    }
}
__device__ __forceinline__ void p_topk_naive(const Ctx& C, int l) {
    const bf16_t* Q = (const bf16_t*)(C.ws + WS_Q);
    const bf16_t* keys = (const bf16_t*)(C.ws + WS_W + (size_t)l * W_LAYER + WO_KEYS);
    int* eidx = (int*)(C.ws + WS_EIDX); float* egate = (float*)(C.ws + WS_EGATE);
    LAS float* qs = (LAS float*)C.lds;
    LAS float* sc = qs + 2048;
    LAS float* tv = sc + 2048;
    LAS int* ti = (LAS int*)(tv + 256);
    for (int t = C.bid; t < T; t += C.G) {
        for (int i = C.tid; i < 2048; i += 512) qs[i] = bf2f(Q[(size_t)t * NQ + i]);
        __syncthreads();
        for (int i = 0; i < 4; ++i) {
            const int idx = C.tid + 512 * i, hj = idx >> 7, key = idx & 127, h = hj >> 1, j = hj & 1;
            const bf16_t* kp = keys + (((size_t)j * PH + h) * 128 + key) * 128;
            float s = 0.f;
            for (int d8 = 0; d8 < 16; ++d8) {
                const u32x4 raw = *(const u32x4*)(kp + d8 * 8);
#pragma unroll
                for (int e = 0; e < 4; ++e) s += qs[h * 256 + j * 128 + d8 * 8 + 2 * e] * bf2f(raw[e] & 0xffffu) + qs[h * 256 + j * 128 + d8 * 8 + 2 * e + 1] * bf2f(raw[e] >> 16);
            }
            sc[idx] = s;
        }
        __syncthreads();
        for (int i = 0; i < 2; ++i) {
            const int hj = C.wave * 2 + i;
            float a0 = sc[hj * 128 + C.lane], a1 = sc[hj * 128 + 64 + C.lane];
            for (int r = 0; r < 16; ++r) {
                float bv; int bi;
                if (a0 > a1 || (a0 == a1)) { bv = a0; bi = C.lane; } else { bv = a1; bi = C.lane + 64; }
                wave_argmax(bv, bi);
                if (C.lane == 0) { tv[hj * 16 + r] = bv; ti[hj * 16 + r] = bi; }
                if (bi == C.lane) a0 = -3e38f; if (bi == C.lane + 64) a1 = -3e38f;
            }
        }
        __syncthreads();
        {
            const int h = C.wave;
            float cv[4];
#pragma unroll
            for (int i = 0; i < 4; ++i) { const int c = C.lane * 4 + i; cv[i] = tv[(h * 2) * 16 + (c >> 4)] + tv[(h * 2 + 1) * 16 + (c & 15)]; }
            float topv = 0.f; int tope = 0; float mx = 0.f;
            for (int r = 0; r < 16; ++r) {
                float bv = cv[0]; int bi = C.lane * 4;
#pragma unroll
                for (int i = 1; i < 4; ++i) if (cv[i] > bv) { bv = cv[i]; bi = C.lane * 4 + i; }
                wave_argmax(bv, bi);
                if (r == 0) mx = bv;
                if (C.lane == r) { topv = bv; tope = ti[(h * 2) * 16 + (bi >> 4)] * 128 + ti[(h * 2 + 1) * 16 + (bi & 15)]; }
#pragma unroll
                for (int i = 0; i < 4; ++i) if (bi == C.lane * 4 + i) cv[i] = -3e38f;
            }
            float e = (C.lane < 16) ? __expf(topv - mx) : 0.f;
            const float den = wave_sum(e);
            if (C.lane < 16) { eidx[(size_t)t * 128 + h * 16 + C.lane] = tope; egate[(size_t)t * 128 + h * 16 + C.lane] = e / den; }
        }
        __syncthreads();
    }
}
__device__ __forceinline__ float ub(unsigned w, int e) { return (float)((w >> (8 * e)) & 255u); }
__device__ __forceinline__ void p_gather(const Ctx& C, int l) {
    const bf16_t* xc = (const bf16_t*)(C.ws + WS_X1B);
    const unsigned char* U8 = C.ws + WS_U8; const unsigned char* V8 = C.ws + WS_V8;
    const float* SU = (const float*)(C.ws + WS_SU); const float* SV = (const float*)(C.ws + WS_SV);
    const int* eidx = (const int*)(C.ws + WS_EIDX); const float* egate = (const float*)(C.ws + WS_EGATE);
    const int lane = C.lane;
    for (int t = C.bid * 8 + C.wave; t < T; t += C.G * 8) {
        float x[16];
        { const bf16_t* xp = xc + (size_t)t * DM + lane * 16;
          const u32x4 a = *(const u32x4*)xp, b = *(const u32x4*)(xp + 8);
#pragma unroll
          for (int i = 0; i < 4; ++i) { x[2 * i] = bf2f(a[i] & 0xffffu); x[2 * i + 1] = bf2f(a[i] >> 16); x[8 + 2 * i] = bf2f(b[i] & 0xffffu); x[9 + 2 * i] = bf2f(b[i] >> 16); } }
        float xmx = 0.f;
#pragma unroll
        for (int j = 0; j < 16; ++j) xmx = fmaxf(xmx, fabsf(x[j]));
        xmx = fmaxf(wave_max(xmx), 1e-30f);
        const float xisc = 127.f / xmx, xsc = xmx * (1.f / 127.f);
        int xq[4];
#pragma unroll
        for (int q = 0; q < 4; ++q) { unsigned wd = 0u;
#pragma unroll
            for (int e = 0; e < 4; ++e) wd |= ((unsigned)(int)rintf(x[4 * q + e] * xisc) & 255u) << (8 * e);
            xq[q] = (int)wd; }
        float cf[2]; int ex[2];
#pragma unroll
        for (int bt = 0; bt < 2; ++bt) {
            ex[bt] = eidx[(size_t)t * 128 + 64 * bt + lane];
            const float gate = egate[(size_t)t * 128 + 64 * bt + lane];
            int p[64];
#pragma unroll
            for (int e0 = 0; e0 < 64; e0 += 16) {
                u32x4 r[16];
#pragma unroll
                for (int i = 0; i < 16; ++i) { const int e = __builtin_amdgcn_readlane(ex[bt], e0 + i); r[i] = *(const u32x4*)(U8 + (size_t)e * DM + lane * 16); }
#pragma unroll
                for (int i = 0; i < 16; ++i) { int a = 0;
#pragma unroll
                    for (int q = 0; q < 4; ++q) a = __builtin_amdgcn_sdot4(xq[q], (int)r[i][q], a, false);
                    p[e0 + i] = a; }
            }
#pragma unroll
            for (int st = 32, n = 32; st > 0; st >>= 1, n >>= 1) {
                const bool up = (lane & st) != 0;
#pragma unroll
                for (int i = 0; i < n; ++i) { const int send = up ? p[i] : p[i + n], keep = up ? p[i + n] : p[i]; p[i] = keep + __shfl_xor(send, st, 64); }
            }
            const float hsum = SU[ex[bt]] * xsc * (float)p[0];
            cf[bt] = gate * geluf_slow(hsum) * SV[ex[bt]];
        }
        float y[16];
#pragma unroll
        for (int j = 0; j < 16; ++j) y[j] = 0.f;
        float csum = wave_sum(cf[0] + cf[1]);
#pragma unroll
        for (int bt = 0; bt < 2; ++bt)
#pragma unroll
            for (int e0 = 0; e0 < 64; e0 += 16) {
                u32x4 r[16];
#pragma unroll
                for (int i = 0; i < 16; ++i) { const int e = __builtin_amdgcn_readlane(ex[bt], e0 + i); r[i] = *(const u32x4*)(V8 + (size_t)e * DM + lane * 16); }
#pragma unroll
                for (int i = 0; i < 16; ++i) { const float c = __builtin_bit_cast(float, __builtin_amdgcn_readlane(__builtin_bit_cast(int, cf[bt]), e0 + i));
#pragma unroll
                    for (int q = 0; q < 4; ++q)
#pragma unroll
                        for (int e = 0; e < 4; ++e) y[4 * q + e] += c * ub(r[i][q], e); }
            }
#pragma unroll
        for (int j = 0; j < 16; ++j) y[j] = y[j] - 128.f * csum + ALPHA * x[j];
        float sm = 0.f;
#pragma unroll
        for (int j = 0; j < 16; ++j) sm += y[j];
        const float mean = wave_sum(sm) * (1.f / DM);
        float qq = 0.f;
#pragma unroll
        for (int j = 0; j < 16; ++j) { const float d = y[j] - mean; qq += d * d; }
        const float rstd = rsqrtf(wave_sum(qq) * (1.f / DM) + LN_EPS);
        const float* gp = C.in[I_LN2G] + l * DM + lane * 16; const float* bp = C.in[I_LN2B] + l * DM + lane * 16;
#pragma unroll
        for (int i = 0; i < 4; ++i) { const f32x4 gg = *(const f32x4*)(gp + 4 * i), bb = *(const f32x4*)(bp + 4 * i);
#pragma unroll
            for (int e = 0; e < 4; ++e) y[4 * i + e] = (y[4 * i + e] - mean) * rstd * gg[e] + bb[e]; }
        float* dst = (l + 1 < DEPTH) ? (float*)(C.ws + WS_XA) + (size_t)t * DM : C.out + (size_t)t * DM;
#if DIAG
        if (l + 1 == DEPTH) { const float al = 1.f + diag_alpha(C);
#pragma unroll
            for (int j = 0; j < 16; ++j) y[j] *= al; }
#endif
#pragma unroll
        for (int i = 0; i < 4; ++i) *(f32x4*)(dst + lane * 16 + 4 * i) = (f32x4){y[4 * i], y[4 * i + 1], y[4 * i + 2], y[4 * i + 3]};
        if (l + 1 < DEPTH) {
            {
                float mx = 0.f;
#pragma unroll
                for (int j = 0; j < 16; ++j) mx = fmaxf(mx, fabsf(y[j]));
                mx = fmaxf(wave_max(mx), 1e-30f);
                const float isc = 127.f / mx;
                u32x4 o8;
#pragma unroll
                for (int q = 0; q < 4; ++q) { unsigned wd = 0u;
#pragma unroll
                    for (int e = 0; e < 4; ++e) wd |= ((unsigned)(int)rintf(y[4 * q + e] * isc) & 255u) << (8 * e);
                    o8[q] = wd; }
                *(u32x4*)(C.ws + WS_XB + (size_t)t * DM + lane * 16) = o8;
                if (lane == 0) ((float*)(C.ws + WS_XSA))[t] = mx * (1.f / 127.f);
            }
            const float* wf = (const float*)(C.ws + WS_W + (size_t)(l + 1) * W_LAYER + WO_WF);
            float* lsig = (float*)(C.ws + WS_MISC);
#pragma unroll
            for (int h = 0; h < 4; ++h) {
                float sd = 0.f;
#pragma unroll
                for (int i = 0; i < 4; ++i) { const f32x4 a = *(const f32x4*)(wf + h * DM + lane * 16 + 4 * i);
#pragma unroll
                    for (int e = 0; e < 4; ++e) sd += y[4 * i + e] * a[e]; }
                sd = wave_sum(sd);
                if (lane == 0) lsig[(size_t)t * 4 + h] = logsigmoidf_(sd + C.in[I_BFOX][(l + 1) * 4 + h]);
            }
        }
    }
}

struct FStoreBf16 { bf16_t* O; int ld;
    __device__ __forceinline__ void operator()(int row, int col, f32x4 v0, f32x4 v1, int) const {
        u32x4 o; o[0] = pk2(v0[0], v0[1]); o[1] = pk2(v0[2], v0[3]); o[2] = pk2(v1[0], v1[1]); o[3] = pk2(v1[2], v1[3]);
        *(u32x4*)(O + (size_t)row * ld + col) = o; } };
typedef int i32x4 __attribute__((ext_vector_type(4)));
__device__ __forceinline__ void i8_dequant(f32x4& v0, f32x4& v1, float sa, const float* cs) {
    sa *= (1.f / 127.f);
    const f32x4 c0 = *(const f32x4*)cs, c1 = *(const f32x4*)(cs + 4);
    const i32x4 i0 = __builtin_bit_cast(i32x4, v0), i1 = __builtin_bit_cast(i32x4, v1);
#pragma unroll
    for (int e = 0; e < 4; ++e) { v0[e] = (float)i0[e] * sa * c0[e]; v1[e] = (float)i1[e] * sa * c1[e]; }
}
struct FStoreBf16I8 { bf16_t* O; int ld; const float* rs; const float* cs;
    __device__ __forceinline__ void operator()(int row, int col, f32x4 v0, f32x4 v1, int) const {
        i8_dequant(v0, v1, rs[row], cs + col);
        u32x4 o; o[0] = pk2(v0[0], v0[1]); o[1] = pk2(v0[2], v0[3]); o[2] = pk2(v1[0], v1[1]); o[3] = pk2(v1[2], v1[3]);
        *(u32x4*)(O + (size_t)row * ld + col) = o; } };
struct FGateI8 { unsigned char* O; const float* bias; const float* rs; const float* cs;
    __device__ __forceinline__ void operator()(int row, int col, f32x4 v0, f32x4 v1, int) const {
        i8_dequant(v0, v1, rs[row], cs + col);
        const f32x4 b0 = *(const f32x4*)(bias + col), b1 = *(const f32x4*)(bias + col + 4);
        u32x2 o; unsigned w0 = 0u, w1 = 0u;
#pragma unroll
        for (int e = 0; e < 4; ++e) { w0 |= (unsigned)(int)rintf(255.f * sigmoidf_(v0[e] + b0[e])) << (8 * e); w1 |= (unsigned)(int)rintf(255.f * sigmoidf_(v1[e] + b1[e])) << (8 * e); }
        o[0] = w0; o[1] = w1;
        *(u32x2*)(O + (size_t)row * NG + col) = o; } };
struct FGate { bf16_t* O; const float* bias;
    __device__ __forceinline__ void operator()(int row, int col, f32x4 v0, f32x4 v1, int) const {
        const f32x4 b0 = *(const f32x4*)(bias + col), b1 = *(const f32x4*)(bias + col + 4);
        u32x4 o; o[0] = pk2(sigmoidf_(v0[0] + b0[0]), sigmoidf_(v0[1] + b0[1])); o[1] = pk2(sigmoidf_(v0[2] + b0[2]), sigmoidf_(v0[3] + b0[3]));
        o[2] = pk2(sigmoidf_(v1[0] + b1[0]), sigmoidf_(v1[1] + b1[1])); o[3] = pk2(sigmoidf_(v1[2] + b1[2]), sigmoidf_(v1[3] + b1[3]));
        *(u32x4*)(O + (size_t)row * NG + col) = o; } };
struct FMerge { const unsigned char* G; bf16_t* MG;
    __device__ __forceinline__ void operator()(int row, int col, f32x4 v0, f32x4 v1, int z) const {
        const u32x2 gr = *(const u32x2*)(G + (size_t)row * NG + z * DM + col);
        float r[8];
#pragma unroll
        for (int e = 0; e < 4; ++e) { r[e] = v0[e] * (float)((gr[0] >> (8 * e)) & 255u) * (1.f / 255.f); r[4 + e] = v1[e] * (float)((gr[1] >> (8 * e)) & 255u) * (1.f / 255.f); }
        bf16_t* p = MG + (size_t)row * DM + col;
        if (z > 0) { const u32x4 pr = *(const u32x4*)p;
#pragma unroll
            for (int e = 0; e < 4; ++e) { r[2 * e] += bf2f(pr[e] & 0xffffu); r[2 * e + 1] += bf2f(pr[e] >> 16); } }
        u32x4 o;
#pragma unroll
        for (int e = 0; e < 4; ++e) o[e] = pk2(r[2 * e], r[2 * e + 1]);
        *(u32x4*)p = o; } };
struct FResid { const float* X; bf16_t* Y;
    __device__ __forceinline__ void operator()(int row, int col, f32x4 v0, f32x4 v1, int) const {
        const f32x4 x0 = *(const f32x4*)(X + (size_t)row * DM + col), x1 = *(const f32x4*)(X + (size_t)row * DM + col + 4);
#if DIAG == 5 || DIAG == 6
        v0 = (f32x4){0.f, 0.f, 0.f, 0.f}; v1 = v0;
#endif
        u32x4 o; o[0] = cvtpk(x0[0] * ALPHA + v0[0], x0[1] * ALPHA + v0[1]); o[1] = cvtpk(x0[2] * ALPHA + v0[2], x0[3] * ALPHA + v0[3]);
        o[2] = cvtpk(x1[0] * ALPHA + v1[0], x1[1] * ALPHA + v1[1]); o[3] = cvtpk(x1[2] * ALPHA + v1[2], x1[3] * ALPHA + v1[3]);
        *(u32x4*)(Y + (size_t)row * DM + col) = o; } };

constexpr int PH_PER_LAYER = 12, N_PHASES = 1 + DEPTH * PH_PER_LAYER;
template <int SP> __device__ __forceinline__ void run_phase(const Ctx& C0, int l) {
    Ctx C = C0;
    asm volatile("" : "+v"(C.tid));
    C.ws = launder_ptr(C.ws); C.out = launder_ptr(C.out); l = (int)launder_u((unsigned)l);
    C.lane = C.tid & 63; C.wave = __builtin_amdgcn_readfirstlane(C.tid >> 6);
    unsigned char* wb = C.ws + WS_W + (size_t)l * W_LAYER;
    if constexpr (SP == -1) { p_conv_weights(C); }
    if constexpr (SP == 0) {
        if (l == 0) {
            for (int l2 = 0; l2 < DEPTH; ++l2) {
                unsigned char* wb2 = C.ws + WS_W + (size_t)l2 * W_LAYER; const unsigned* cm = (const unsigned*)(C.ws + WS_CMAX) + l2 * (NH + NG);
                tconv_i8_job(C, C.in[I_WIN] + (size_t)l2 * DM * NIN, NIN, DM, NH, wb2 + WO_WIN, cm);
                tconv_i8_job(C, C.in[I_WGATE] + (size_t)l2 * DM * NG, NG, DM, NG, wb2 + WO_WG, cm + NH);
            }
            p_rowpass0(C);
        }
    }
    if constexpr (SP == 1) {
        p_cumsum(C);
        __syncthreads();
        pg8::Gemm g{(const bf16_t*)(C.ws + WS_XB), (const bf16_t*)(wb + WO_WIN), DM, DM, DM, 0, 0};
        pg8::StaticOrder S; S.init(T, NH, C.G, C.bid);
        pg8::Epi8<FStoreBf16I8> E{{(bf16_t*)(C.ws + WS_H), NH, (const float*)(C.ws + WS_XSA), (const float*)(C.ws + WS_CMAX) + l * (NH + NG)}};
        pg8::gemm_phase<pg8::Epi8<FStoreBf16I8>, pg8::StaticOrder, true>(C.lds, g, S, E, C.tid);
    }
#if DIAG == 5
    if constexpr (SP == 2) { if (l == 0) { diag_ref_slice(C, C.in[I_WIN], NIN, DIAG_N0, nullptr); } }
    if constexpr (SP == 3) { if (l == 0) diag_cmp(C, (const bf16_t*)(C.ws + WS_H) + DIAG_N0, NH, (const bf16_t*)(C.ws + WS_XA), 64, 64); }
#endif
#if DIAG == 6
    if constexpr (SP == 5) { if (l == 0) diag_ref_slice(C, C.in[I_WGATE], NG, DIAG_N0, C.in[I_BGATE]); }
    if constexpr (SP == 6) { if (l == 0) diag_cmp_u8(C, C.ws + WS_G + DIAG_N0, NG, (const bf16_t*)(C.ws + WS_XA), 64, 64); }
#endif
    if constexpr (SP == 2) { p_knorm(C, l); if (l != HG_NAIVE_L) hgrn_b1(C, l); }
#if MIX_NAIVE
    if constexpr (SP == 3) { if (l != HG_NAIVE_L) hgrn_b2(C); mix_pool_naive(C, l); mix_gmlp_naive(C, l); }
#else
    if constexpr (SP == 3) { if (l != HG_NAIVE_L) hgrn_b2(C); mix_pool(C, l); mix_gmlp(C, l);
        if (DIAG == 2) mix_pool_naive(C, l); if (DIAG == 3) mix_gmlp_naive(C, l); }
#endif
#if DIAG == 1
    if constexpr (SP == 4) { hgrn_b3(C, l); { mix_hgrn_naive(C, l); __syncthreads(); } mix_fox(C, l); }
    if constexpr (SP == 5) { if (l == DIAG_LAYER) diag_cmp(C, (const bf16_t*)(C.ws + (DIAG_LAYER == 0 ? WS_XA : WS_TABU)) + 512, NBR, (const bf16_t*)(C.ws + WS_BR) + 512, NBR, 512); }
#elif DIAG == 2 || DIAG == 3
    if constexpr (SP == 4) { hgrn_b3(C, l); mix_fox(C, l); if (l == DIAG_LAYER) diag_cmp(C, (const bf16_t*)(C.ws + (DIAG_LAYER == 0 ? WS_XA : WS_TABU)) + (DIAG == 2 ? 0 : 1024), NBR, (const bf16_t*)(C.ws + WS_BR) + (DIAG == 2 ? 0 : 1024), NBR, 512); }
#else
    if constexpr (SP == 4) { if (l != HG_NAIVE_L) hgrn_b3(C, l); else { mix_hgrn_naive(C, l); __syncthreads(); } mix_fox(C, l); }
#endif
    if constexpr (SP == 5) {
        pg8::Gemm g{(const bf16_t*)(C.ws + WS_XB), (const bf16_t*)(wb + WO_WG), DM, DM, DM, 0, 0};
        pg8::StaticOrder S; S.init(T, NG, C.G, C.bid);
        pg8::Epi8<FGateI8> E{{C.ws + WS_G, C.in[I_BGATE] + l * NG, (const float*)(C.ws + WS_XSA), (const float*)(C.ws + WS_CMAX) + l * (NH + NG) + NH}};
        pg8::gemm_phase<pg8::Epi8<FGateI8>, pg8::StaticOrder, true>(C.lds, g, S, E, C.tid);
    }
    if constexpr (SP == 6) {
        pg8::Gemm g{(const bf16_t*)(C.ws + WS_BR), (const bf16_t*)(wb + WO_WBR), NBR, BW, BW, (size_t)BW, (size_t)DM * BW};
        pg8::ZOrder S; S.init(T, DM, 4, C.G, C.vcu);
        pg8::Epi8<FMerge> E{{C.ws + WS_G, (bf16_t*)(C.ws + WS_XB)}};
        pg8::gemm_phase(C.lds, g, S, E, C.tid);
    }
    if constexpr (SP == 7) {
        const float* xin = (l == 0) ? C.in[I_X] : (const float*)(C.ws + WS_XA);
        pg8::Gemm g{(const bf16_t*)(C.ws + WS_XB), (const bf16_t*)(wb + WO_WOUT), DM, DM, DM, 0, 0};
        pg8::StaticOrder S; S.init(T, DM, C.G, C.bid);
        pg8::Epi8<FResid> E{{xin, (bf16_t*)(C.ws + WS_XC)}};
        pg8::gemm_phase(C.lds, g, S, E, C.tid);
    }
    if constexpr (SP == 8) { p_ln1(C, l); p_conv_tables(C, l); }
    if constexpr (SP == 9) {
        pg8::Gemm g{(const bf16_t*)(C.ws + WS_X1B), (const bf16_t*)(wb + WO_WQ), DM, DM, DM, 0, 0};
        pg8::StaticOrder S; S.init(T, NQ, C.G, C.bid);
        pg8::Epi8<FStoreBf16> E{{(bf16_t*)(C.ws + WS_Q), NQ}};
        pg8::gemm_phase(C.lds, g, S, E, C.tid);
    }
#if TOPK_NAIVE
    if constexpr (SP == 10) p_topk_naive(C, l);
#else
    if constexpr (SP == 10) p_topk(C, l);
#endif
    if constexpr (SP == 11) p_gather(C, l);
}
__device__ __forceinline__ void make_ctx(Ctx& C, const Args& args, unsigned char* lds_raw) {
    C.lds = (LAS unsigned char*)lds_raw; C.ws = args.ws; C.in = args.in; C.out = args.out;
    C.tid = threadIdx.x; C.lane = C.tid & 63; C.wave = __builtin_amdgcn_readfirstlane(C.tid >> 6);
    C.G = gridDim.x; C.bid = blockIdx.x; C.vcu = (C.G % 8 == 0) ? (C.bid % 8) * (C.G / 8) + C.bid / 8 : C.bid;
}
#if !MK_ONE_LAUNCH
template <int SP> __global__ void __launch_bounds__(512, 2) mk_phase(Args args) {
    extern __shared__ __attribute__((aligned(16))) unsigned char lds_raw[];
    Ctx C; make_ctx(C, args, lds_raw);
    run_phase<SP>(C, args.ph_lo);
}
#endif

#define GRID_BAR() xcd_barrier((unsigned*)(args.ws + WS_CTL) + 1024, (volatile LAS unsigned*)((LAS unsigned char*)lds_raw + LDSCTL_OFF + 32))
__global__ void __launch_bounds__(512, 2) mk_fwd(Args args) {
    extern __shared__ __attribute__((aligned(16))) unsigned char lds_raw[];
    Ctx C; make_ctx(C, args, lds_raw);
    { volatile LAS unsigned* misc = (volatile LAS unsigned*)(C.lds + LDSCTL_OFF); if (C.tid < 64) misc[C.tid] = 0u; }
    __syncthreads();
    xcd_barrier_post((unsigned*)(args.ws + WS_CTL) + 1024);
    run_phase<-1>(C, 0); GRID_BAR();
#pragma unroll 1
    for (int l = 0; l < DEPTH; ++l) {
        if (l == 0) { run_phase<0>(C, l); GRID_BAR(); }
        run_phase<1>(C, l); GRID_BAR();
        run_phase<2>(C, l); GRID_BAR();
        run_phase<3>(C, l); GRID_BAR();
        run_phase<4>(C, l); GRID_BAR();
        run_phase<5>(C, l); GRID_BAR();
        run_phase<6>(C, l); GRID_BAR();
        run_phase<7>(C, l); GRID_BAR();
        run_phase<8>(C, l); GRID_BAR();
        run_phase<9>(C, l); GRID_BAR();
        run_phase<10>(C, l); GRID_BAR();
        run_phase<11>(C, l); if (l + 1 < DEPTH) GRID_BAR();
    }
}

#if !MK_ONE_LAUNCH
template <int SP> static void launch_phase(const Args& a, int grid, hipStream_t stream) {
    static bool attr_done = false;
    if (!attr_done) { (void)hipFuncSetAttribute((const void*)mk_phase<SP>, hipFuncAttributeMaxDynamicSharedMemorySize, LDS_BYTES); attr_done = true; }
    hipLaunchKernelGGL(mk_phase<SP>, dim3(grid), dim3(512), LDS_BYTES, stream, a);
}
#endif
extern "C" void kernel_launch(void* const* d_in, const int* in_sizes, int n_in, void* d_out, int out_size, void* d_ws, size_t ws_size, hipStream_t stream) {
    static int grid = 0;
    if (grid == 0) {
        if (n_in != NIN_PTRS || out_size != T * DM || ws_size < WS_END) { fprintf(stderr, "kernel_launch: unexpected shapes n_in %d out %d ws %zu\n", n_in, out_size, ws_size); grid = -1; return; }
        int dev = 0, cus = 0;
        if (hipGetDevice(&dev) != hipSuccess || hipDeviceGetAttribute(&cus, hipDeviceAttributeMultiprocessorCount, dev) != hipSuccess) { grid = -1; return; }
        grid = cus;
    }
    if (grid < 0) return;
    (void)hipMemsetAsync((char*)d_ws + WS_CTL, 0, CTL_ZERO_BYTES, stream);
    Args a{};
    for (int i = 0; i < NIN_PTRS; ++i) a.in[i] = (const float*)d_in[i];
    a.out = (float*)d_out; a.ws = (unsigned char*)d_ws; a.bar_slot = 0; a.pad = 0; a.ph_hi = 0;
#if MK_ONE_LAUNCH
    static bool attr_done = false;
    if (!attr_done) { (void)hipFuncSetAttribute((const void*)mk_fwd, hipFuncAttributeMaxDynamicSharedMemorySize, LDS_BYTES); attr_done = true; }
    hipLaunchKernelGGL(mk_fwd, dim3(grid), dim3(512), LDS_BYTES, stream, a);
    return;
#endif
#if !MK_ONE_LAUNCH
    a.ph_lo = 0; launch_phase<-1>(a, grid, stream);
    for (int l = 0; l < DEPTH; ++l) {
        a.ph_lo = l;
        launch_phase<0>(a, grid, stream); launch_phase<1>(a, grid, stream); launch_phase<2>(a, grid, stream); launch_phase<3>(a, grid, stream); launch_phase<4>(a, grid, stream);
        launch_phase<5>(a, grid, stream); launch_phase<6>(a, grid, stream); launch_phase<7>(a, grid, stream); launch_phase<8>(a, grid, stream); launch_phase<9>(a, grid, stream); launch_phase<10>(a, grid, stream); launch_phase<11>(a, grid, stream);
    }
#endif
}
```

```cpp
#include <hip/hip_runtime.h>
#include <cstdio>
#include <cstdint>

#ifndef DIAG
#define DIAG 0
#endif
#ifndef DIAG_LO
#define DIAG_LO 0
#endif
#ifndef DIAG_HI
#define DIAG_HI 64
#endif
#ifndef DIAG_MOD
#define DIAG_MOD 64
#endif
#ifndef TOPK_NAIVE
#define TOPK_NAIVE 0
#endif
#ifndef MIX_NAIVE
#define MIX_NAIVE 0
#endif
#ifndef DIAG_N0
#define DIAG_N0 4096
#endif
#ifndef FOX_NAIVE
#define FOX_NAIVE 0
#endif
#ifndef HG_NAIVE_L
#define HG_NAIVE_L 99
#endif
#ifndef DIAG_LAYER
#define DIAG_LAYER 0
#endif
#ifndef MK_ONE_LAUNCH
#define MK_ONE_LAUNCH 1
#endif

#define LAS __attribute__((address_space(3)))
#define GAS __attribute__((address_space(1)))
typedef unsigned short bf16_t;
typedef short bf16x8 __attribute__((ext_vector_type(8)));
typedef float f32x4 __attribute__((ext_vector_type(4)));
typedef float f32x2 __attribute__((ext_vector_type(2)));
typedef unsigned u32x4 __attribute__((ext_vector_type(4)));
typedef unsigned u32x2 __attribute__((ext_vector_type(2)));

constexpr int DM = 1024, BATCH = 2, SEQ = 8192, DEPTH = 2, T = BATCH * SEQ;
constexpr int BW = 512, NIN = 5124, NH = 5120, NG = 4096, NBR = 2048, NQ = 2048;
constexpr int NEXP = 16384, TOPK = 16, PH = 8;
constexpr float ALPHA = 1.4142135623730951f;
constexpr float LN_EPS = 1e-5f, RMS_EPS = 1e-6f;
constexpr int HC_P = 0, HC_HQ = 512, HC_HF = 1024, HC_HI = 1536, HC_HG = 2048, HC_GU = 2560, HC_GV = 3072, HC_FQ = 3584, HC_FK = 4096, HC_FV = 4608;

constexpr size_t MiB = 1u << 20;
constexpr size_t WS_CTL = 0, CTL_ZERO_BYTES = 160 * 1024;
constexpr size_t WS_CMAX = 64 * 1024;
constexpr size_t WS_MISC = 512 * 1024;
constexpr size_t WS_CUM = 768 * 1024;
constexpr size_t WS_W = 1 * MiB;
constexpr size_t W_LAYER = 30 * MiB;
constexpr size_t WO_WIN = 0, WO_WG = 10 * MiB, WO_WBR = 18 * MiB, WO_WOUT = 22 * MiB, WO_WQ = 24 * MiB, WO_KEYS = 28 * MiB, WO_WF = 28 * MiB + 512 * 1024, WO_POOLW = 28 * MiB + 768 * 1024, WO_GWS = 29 * MiB, WO_CS = 29 * MiB + 512 * 1024;
constexpr size_t WS_TABU = 64 * MiB, WS_TABV = 96 * MiB;
constexpr size_t WS_XA = 128 * MiB;
constexpr size_t WS_XB = 192 * MiB;
constexpr size_t WS_X1B = 224 * MiB;
constexpr size_t WS_H = 256 * MiB;
constexpr size_t WS_ST = 416 * MiB;
constexpr size_t WS_BR = 448 * MiB;
constexpr size_t WS_G = 256 * MiB;
constexpr size_t WS_MGF = 384 * MiB;
constexpr size_t WS_XC = 256 * MiB;
constexpr size_t WS_Q = 320 * MiB;
constexpr size_t WS_EIDX = 384 * MiB, WS_EGATE = 392 * MiB;
constexpr size_t WS_XSA = 256 * 1024;
constexpr size_t WS_END = 512 * MiB;

__device__ __forceinline__ float bf2f(unsigned u) { return __builtin_bit_cast(float, u << 16); }
__device__ __forceinline__ unsigned f2bf(float f) { unsigned u = __builtin_bit_cast(unsigned, f); return (u + 0x7fffu + ((u >> 16) & 1u)) >> 16; }
typedef __bf16 bf16x2_t __attribute__((ext_vector_type(2)));
__device__ __forceinline__ unsigned cvtpk(float lo, float hi) { f32x2 v = {lo, hi}; bf16x2_t b = __builtin_convertvector(v, bf16x2_t); return __builtin_bit_cast(unsigned, b); }
__device__ __forceinline__ unsigned pk2(float lo, float hi) { return cvtpk(lo, hi); }
__device__ __forceinline__ float wave_sum(float v) {
#pragma unroll
    for (int o = 32; o > 0; o >>= 1) v += __shfl_xor(v, o, 64);
    return v;
}
__device__ __forceinline__ float sigmoidf_(float x) { return __builtin_amdgcn_rcpf(1.f + __builtin_amdgcn_exp2f(-1.4426950408889634f * x)); }
__device__ __forceinline__ float siluf_(float x) { return x * __builtin_amdgcn_rcpf(1.f + __builtin_amdgcn_exp2f(-1.4426950408889634f * x)); }
__device__ __forceinline__ float geluf_slow(float x) { const float u = 0.7978845608028654f * (x + 0.044715f * x * x * x); return 0.5f * x * (1.f + tanhf(u)); }
__device__ __forceinline__ float geluf_(float x) { const float u2 = -2.302208198f * (x + 0.044715f * x * x * x); return x * __builtin_amdgcn_rcpf(1.f + __builtin_amdgcn_exp2f(u2)); }
__device__ __forceinline__ float logsigmoidf_(float z) { return fminf(z, 0.f) - log1pf(__expf(-fabsf(z))); }

__device__ __forceinline__ unsigned launder_u(unsigned x) { asm volatile("" : "+v"(x)); return __builtin_amdgcn_readfirstlane(x); }
template <class P> __device__ __forceinline__ P launder_ptr(P p) {
    const unsigned lo = launder_u((unsigned)(uintptr_t)p), hi = launder_u((unsigned)((uintptr_t)p >> 32));
    return (P)(((uintptr_t)hi << 32) | lo);
}

namespace pg8 {
constexpr int BM = 256, BK = 64, HALF = 128, HTB = HALF * BK * 2, STAGE_BYTES = 8 * HTB, NXCD = 8, WGM = 8;
__host__ __device__ __forceinline__ int lds_byte(int r, int c) { const int st = (r >> 4) * 2 + (c >> 5), rr = r & 15, cc = c & 31, ob = rr * 64 + cc * 2; return st * 1024 + (ob ^ (((ob >> 9) & 1) << 5)); }
__host__ __device__ __forceinline__ void stage_rc(int b, int& R, int& C) { const int st = b / 1024, sb = b % 1024, swz = sb ^ (((sb >> 9) & 1) << 5); R = (st >> 1) * 16 + swz / 64; C = (st & 1) * 32 + (swz % 64) / 2; }
__host__ __device__ __forceinline__ int perm32(int rho) { const int n = rho >> 4, i = rho & 15; return 8 * (i >> 2) + 4 * n + (i & 3); }

struct Unit { int pm, pn, z; };
struct Gemm { const bf16_t* A; const bf16_t* Bt; int lda, ldb, K; size_t zA, zB; };

struct StaticOrder {
    int nM, nN, nwg, G, c;
    __device__ void init(int M, int N, int G_, int c_) { nM = M / BM; nN = N / BM; nwg = nM * nN; G = G_; c = c_; }
    __device__ bool next(int i, Unit& u) const {
        const long L = (long)i * G + c; if (L >= nwg) return false;
        int wgid = (int)L; { const int q = nwg / NXCD, r = nwg % NXCD, xcd = wgid % NXCD, off = wgid / NXCD; wgid = (xcd < r ? xcd * (q + 1) : r * (q + 1) + (xcd - r) * q) + off; }
        const int nig = WGM * nN, gid = wgid / nig, fm = gid * WGM, gsz = (nM - fm) < WGM ? (nM - fm) : WGM;
        u.pm = fm + ((wgid % nig) % gsz); u.pn = (wgid % nig) / gsz; u.z = 0; return true;
    }
};
struct ZOrder {
    int nM, nN, nZ, ntile, G, c;
    __device__ void init(int M, int N, int Z, int G_, int c_) { nM = M / BM; nN = N / BM; nZ = Z; ntile = nM * nN; G = G_; c = c_; }
    __device__ bool next(int i, Unit& u) const {
        const long L = (long)(i / nZ) * G + c; if (L >= ntile) return false;
        u.pm = (int)L / nN; u.pn = (int)L % nN; u.z = i % nZ; return true;
    }
};

template <class F> struct Epi8 {
    static constexpr bool PERM = true;
    F f;
    __device__ __forceinline__ void operator()(const f32x4 (&acc)[2][2][4][2], const Unit& u, int wr, int wc, int fr, int fq) const {
        const int row0 = u.pm * BM + wr * 64 + fr, col0 = u.pn * BM + wc * 32 + 8 * fq;
#pragma unroll
        for (int ai = 0; ai < 2; ++ai)
#pragma unroll
            for (int m = 0; m < 4; ++m)
#pragma unroll
                for (int bj = 0; bj < 2; ++bj) f(row0 + ai * HALF + m * 16, col0 + bj * HALF, acc[ai][bj][m][0], acc[ai][bj][m][1], u.z);
    }
};
template <class F> struct Epi4 {
    static constexpr bool PERM = false;
    F f;
    __device__ __forceinline__ void operator()(const f32x4 (&acc)[2][2][4][2], const Unit& u, int wr, int wc, int fr, int fq) const {
        const int row0 = u.pm * BM + wr * 64 + fr, col0 = u.pn * BM + wc * 32 + 4 * fq;
#pragma unroll
        for (int ai = 0; ai < 2; ++ai)
#pragma unroll
            for (int m = 0; m < 4; ++m)
#pragma unroll
                for (int bj = 0; bj < 2; ++bj)
#pragma unroll
                    for (int n = 0; n < 2; ++n) f(row0 + ai * HALF + m * 16, col0 + bj * HALF + n * 16, acc[ai][bj][m][n], u.z);
    }
};

typedef int i32x4 __attribute__((ext_vector_type(4)));
template <class Epi, class Sched, bool I8 = false, bool ALIGN_EPI = true>
__device__ __forceinline__ void gemm_phase(LAS unsigned char* lds, const Gemm g, const Sched& S, const Epi& E, const int tid) {
    constexpr int ES = I8 ? 1 : 2;
    const int wid = __builtin_amdgcn_readfirstlane(tid >> 6), lane = tid & 63, wr = wid >> 2, wc = wid & 3, fr = lane & 15, fq = lane >> 4;
    const int K = g.K, nt = K * ES / 128;
    unsigned voffA[2], voffB[2];
#pragma unroll
    for (int i = 0; i < 2; ++i) { int R, C; stage_rc(tid * 16 + i * 8192, R, C); const int Rb = Epi::PERM ? ((R & ~31) + perm32(R & 31)) : R;
        voffA[i] = (unsigned)(R * g.lda * ES + C * 2); voffB[i] = (unsigned)(Rb * g.ldb * ES + C * 2); }
    const size_t kstep = (size_t)(BK * 2);
    const size_t hstepA = (size_t)HALF * g.lda * ES, hstepB = (size_t)HALF * g.ldb * ES;
    const size_t tstepA = 2 * hstepA, tstepB = 2 * hstepB;
    const unsigned ldsw = (unsigned)wid * 1024u;
    const int aoff = lds_byte(wr * 64 + fr, fq * 8), boff = lds_byte(wc * 32 + fr, fq * 8);
#define PG8_SA(b, h) (((b) * 2 + (h)) * HTB)
#define PG8_SB(b, h) ((4 + (b) * 2 + (h)) * HTB)
#define PG8_STAGE(bufoff, gbase, voff) do { _Pragma("unroll") for (int _i = 0; _i < 2; ++_i) \
        __builtin_amdgcn_global_load_lds((const unsigned*)((const char*)(gbase) + (voff)[_i]), (LAS unsigned*)(lds + (bufoff) + ldsw + _i * 8192), 16, 0, 0); } while (0)
#define PG8_LDA(dst, b, h) do { _Pragma("unroll") for (int m = 0; m < 4; ++m) _Pragma("unroll") for (int k = 0; k < 2; ++k) dst[m][k] = *(const LAS bf16x8*)(lds + PG8_SA(b, h) + aoff + m * 2048 + k * 1024); } while (0)
#define PG8_LDB(dst, b, h) do { _Pragma("unroll") for (int n = 0; n < 2; ++n) _Pragma("unroll") for (int k = 0; k < 2; ++k) dst[n][k] = *(const LAS bf16x8*)(lds + PG8_SB(b, h) + boff + n * 2048 + k * 1024); } while (0)
#define PG8_MMA(ai, bj, At, Bt) do { __builtin_amdgcn_s_setprio(1); _Pragma("unroll") for (int m = 0; m < 4; ++m) _Pragma("unroll") for (int n = 0; n < 2; ++n) _Pragma("unroll") for (int k = 0; k < 2; ++k) { \
        if constexpr (I8) acc[ai][bj][m][n] = __builtin_bit_cast(f32x4, __builtin_amdgcn_mfma_i32_16x16x64_i8(__builtin_bit_cast(i32x4, Bt[n][k]), __builtin_bit_cast(i32x4, At[m][k]), __builtin_bit_cast(i32x4, acc[ai][bj][m][n]), 0, 0, 0)); \
        else acc[ai][bj][m][n] = __builtin_amdgcn_mfma_f32_16x16x32_bf16(Bt[n][k], At[m][k], acc[ai][bj][m][n], 0, 0, 0); } __builtin_amdgcn_s_setprio(0); } while (0)
#define PG8_WAIT_V(n) asm volatile("s_waitcnt vmcnt(" #n ")" ::: "memory")
#define PG8_WAIT_L(n) asm volatile("s_waitcnt lgkmcnt(" #n ")" ::: "memory")
#define PG8_BAR __builtin_amdgcn_s_barrier()
#define PG8_SCHED __builtin_amdgcn_sched_barrier(0)
    Unit cur, nxt; int ui = 0;
    if (!S.next(0, cur)) return;
    f32x4 acc[2][2][4][2];
#pragma unroll
    for (int a = 0; a < 2; ++a)
#pragma unroll
        for (int b = 0; b < 2; ++b)
#pragma unroll
            for (int m = 0; m < 4; ++m)
#pragma unroll
                for (int n = 0; n < 2; ++n) acc[a][b][m][n] = (f32x4){0.f, 0.f, 0.f, 0.f};
    bf16x8 At[4][2], B0[2][2], B1[2][2];
    const char* cA = (const char*)g.A + (size_t)cur.z * g.zA * ES + (size_t)cur.pm * tstepA; const char* cB = (const char*)g.Bt + (size_t)cur.z * g.zB * ES + (size_t)cur.pn * tstepB;
    PG8_STAGE(PG8_SB(0, 0), cB, voffB); PG8_STAGE(PG8_SB(0, 1), cB + hstepB, voffB); PG8_STAGE(PG8_SA(0, 0), cA, voffA); PG8_STAGE(PG8_SA(0, 1), cA + hstepA, voffA);
    if (wr == 1) PG8_BAR;
    PG8_WAIT_V(2); PG8_BAR;
    PG8_STAGE(PG8_SB(1, 0), cB + kstep, voffB); PG8_STAGE(PG8_SA(1, 0), cA + kstep, voffA); PG8_STAGE(PG8_SB(1, 1), cB + hstepB + kstep, voffB);
    PG8_WAIT_V(6); PG8_BAR;
    for (;;) {
        const bool has_next = S.next(ui + 1, nxt);
        const char* nA = has_next ? (const char*)g.A + (size_t)nxt.z * g.zA * ES + (size_t)nxt.pm * tstepA : cA;
        const char* nB = has_next ? (const char*)g.Bt + (size_t)nxt.z * g.zB * ES + (size_t)nxt.pn * tstepB : cB;
        for (int t = 0; t < nt; t += 2) {
            const bool last = (t == nt - 2);
            const char* a1 = cA + (size_t)(t + 1) * kstep;
            const char* a2 = last ? nA : cA + (size_t)(t + 2) * kstep; const char* b2 = last ? nB : cB + (size_t)(t + 2) * kstep;
            const char* a3 = a2 + kstep; const char* b3 = b2 + kstep;
            PG8_LDB(B0, 0, 0); PG8_LDB(B1, 0, 1); PG8_SCHED; PG8_LDA(At, 0, 0); PG8_STAGE(PG8_SA(1, 1), a1 + hstepA, voffA);
            PG8_WAIT_V(8); PG8_WAIT_L(0); PG8_BAR; PG8_MMA(0, 0, At, B0); PG8_MMA(0, 1, At, B1); PG8_BAR; PG8_SCHED;
            PG8_LDA(At, 0, 1); PG8_STAGE(PG8_SB(0, 0), b2, voffB); PG8_STAGE(PG8_SB(0, 1), b2 + hstepB, voffB); PG8_STAGE(PG8_SA(0, 0), a2, voffA);
            PG8_WAIT_V(8); PG8_WAIT_L(0); PG8_BAR; PG8_MMA(1, 0, At, B0); PG8_MMA(1, 1, At, B1); PG8_BAR; PG8_SCHED;
            PG8_LDB(B0, 1, 0); PG8_LDB(B1, 1, 1); PG8_SCHED; PG8_LDA(At, 1, 0); PG8_STAGE(PG8_SA(0, 1), a2 + hstepA, voffA);
            PG8_WAIT_V(8); PG8_WAIT_L(0); PG8_BAR; PG8_MMA(0, 0, At, B0); PG8_MMA(0, 1, At, B1); PG8_BAR; PG8_SCHED;
            PG8_LDA(At, 1, 1); PG8_STAGE(PG8_SB(1, 0), b3, voffB); PG8_STAGE(PG8_SB(1, 1), b3 + hstepB, voffB); PG8_STAGE(PG8_SA(1, 0), a3, voffA);
            PG8_WAIT_V(8); PG8_WAIT_L(0); PG8_BAR; PG8_MMA(1, 0, At, B0); PG8_MMA(1, 1, At, B1); PG8_BAR; PG8_SCHED;
        }
        if constexpr (ALIGN_EPI) { if (wr == 0) PG8_BAR; }
        E(acc, cur, wr, wc, fr, fq);
        if (!has_next) break;
#pragma unroll
        for (int a = 0; a < 2; ++a)
#pragma unroll
            for (int b = 0; b < 2; ++b)
#pragma unroll
                for (int m = 0; m < 4; ++m)
#pragma unroll
                    for (int n = 0; n < 2; ++n) acc[a][b][m][n] = (f32x4){0.f, 0.f, 0.f, 0.f};
        cur = nxt; cA = nA; cB = nB; ++ui;
        if constexpr (ALIGN_EPI) { if (wr == 1) PG8_BAR; }
    }
    PG8_WAIT_V(0);
    if constexpr (!ALIGN_EPI) { if (wr == 0) PG8_BAR; }
    PG8_BAR;
#undef PG8_SA
#undef PG8_SB
#undef PG8_STAGE
#undef PG8_LDA
#undef PG8_LDB
#undef PG8_MMA
#undef PG8_WAIT_V
#undef PG8_WAIT_L
#undef PG8_BAR
#undef PG8_SCHED
}
}

#define XB_TMO      128
#define XB_XCNT(j)  (256  + 64 * (j))
#define XB_XSUB(j)  (1280 + 64 * (j))
#define XB_XGEN(j)  (2304 + 64 * (j))
#define XB_TOP      3328
#define XB_TOPGEN   3392
#define XCD_BAR_WORDS 3456
#define XB_SPIN_CAP (1u << 22)
__device__ __forceinline__ unsigned xb_ld(unsigned* p)              { return __hip_atomic_load(p, __ATOMIC_RELAXED, __HIP_MEMORY_SCOPE_AGENT); }
__device__ __forceinline__ unsigned xb_add(unsigned* p, unsigned v) { return __hip_atomic_fetch_add(p, v, __ATOMIC_RELAXED, __HIP_MEMORY_SCOPE_AGENT); }
__device__ __forceinline__ unsigned xb_xcc_id() { return (unsigned)__builtin_amdgcn_s_getreg((3 << 11) | 20) & 0xFu; }
#define XB_SPIN(cond, bar) do { unsigned _sp = 0; while (cond) { __builtin_amdgcn_s_sleep(1); \
    if ((++_sp & 255u) == 0u) { if (xb_ld(&(bar)[XB_TMO])) break; if (_sp > XB_SPIN_CAP) { atomicAdd(&(bar)[XB_TMO], 1u); break; } } } } while (0)
__device__ __forceinline__ void xcd_barrier_post(unsigned* bar) {
    if (threadIdx.x == 0) (void)xb_add(&bar[XB_XCNT(xb_xcc_id())], 1u);
}
__device__ __forceinline__ void xcd_barrier_complete(unsigned* bar, unsigned x, unsigned& nloc, unsigned& nx) {
    const unsigned G = gridDim.x * gridDim.y * gridDim.z;
    unsigned sum, cnt, mine, sp = 0u;
    for (;;) {
        sum = 0u; cnt = 0u; mine = 0u;
#pragma unroll
        for (unsigned j = 0; j < 16; ++j) { const unsigned c = xb_ld(&bar[XB_XCNT(j)]); sum += c; cnt += (c > 0u) ? 1u : 0u; mine = (j == x) ? c : mine; }
        if (sum == G) break;
        __builtin_amdgcn_s_sleep(1);
        if ((++sp & 255u) == 0u) { if (xb_ld(&bar[XB_TMO])) break; if (sp > XB_SPIN_CAP) { atomicAdd(&bar[XB_TMO], 1u); break; } }
    }
    nloc = mine > 0u ? mine : 1u; nx = cnt > 0u ? cnt : 1u;
}
__device__ __noinline__ void xcd_barrier_leader(unsigned* bar, volatile LAS unsigned* st) {
    const unsigned x = xb_xcc_id();
    __builtin_amdgcn_s_waitcnt(0);
    unsigned nloc = st[0], nx = st[1];
    if (nloc == 0u) { xcd_barrier_complete(bar, x, nloc, nx); st[0] = nloc; st[1] = nx; }
    const unsigned old = xb_add(&bar[XB_XSUB(x)], 1u);
    const unsigned gen = old / nloc;
    if (old + 1u == (gen + 1u) * nloc) {
        __builtin_amdgcn_fence(__ATOMIC_RELEASE, "agent");
        asm volatile("s_waitcnt vmcnt(0)" ::: "memory");
        const unsigned og = xb_add(&bar[XB_TOP], 1u);
        const unsigned tg = og / nx;
        if (og + 1u == (tg + 1u) * nx) xb_add(&bar[XB_TOPGEN], 1u);
        else XB_SPIN(xb_ld(&bar[XB_TOPGEN]) == tg, bar);
        __builtin_amdgcn_fence(__ATOMIC_ACQUIRE, "agent");
        xb_add(&bar[XB_XGEN(x)], 1u);
        asm volatile("s_waitcnt vmcnt(0)" ::: "memory");
    } else {
        XB_SPIN(xb_ld(&bar[XB_XGEN(x)]) == gen, bar);
        __builtin_amdgcn_fence(__ATOMIC_ACQUIRE, "agent");
        asm volatile("s_waitcnt vmcnt(0)" ::: "memory");
    }
}
__device__ __forceinline__ void xcd_barrier(unsigned* bar, volatile LAS unsigned* st) {
    asm volatile("s_waitcnt vmcnt(0)" ::: "memory");
    __syncthreads();
    if (threadIdx.x == 0) xcd_barrier_leader(bar, st);
    __syncthreads();
}

constexpr int NIN_PTRS = 23;
struct Args { const float* in[NIN_PTRS]; float* out; unsigned char* ws; int ph_lo, ph_hi, bar_slot, pad; };
enum { I_X = 0, I_WIN, I_BFOX, I_POOLW, I_POOLS, I_LBL, I_HNG, I_GLNG, I_GLNB, I_GWS, I_GBS, I_WGATE, I_BGATE, I_WBR, I_WOUT, I_LN1G, I_LN1B, I_WQ, I_KEYS, I_PU, I_PV, I_LN2G, I_LN2B };

constexpr int LDS_BYTES = 147456;
constexpr int LDSCTL_OFF = 143360;

struct Ctx {
    LAS unsigned char* lds;
    unsigned char* ws;
    const float* const* in;
    float* out;
    int tid, lane, wave, G, bid, vcu;
};

__device__ __forceinline__ void tconv_job(const Ctx& C, const float* src, int ld_src, int K, int N, bf16_t* dst) {
    LAS float* tile = (LAS float*)C.lds;
    const int nk = K / 64, nn = N / 64, ntiles = nk * nn;
    for (int tl = C.bid; tl < ntiles; tl += C.G) {
        const int k0 = (tl / nn) * 64, n0 = (tl % nn) * 64;
#pragma unroll
        for (int p = 0; p < 2; ++p) {
            const int kr = (C.tid >> 4) + p * 32, nc = (C.tid & 15) * 4;
            const f32x4 v = *(const f32x4*)(src + (size_t)(k0 + kr) * ld_src + n0 + nc);
            tile[kr * 65 + nc + 0] = v[0]; tile[kr * 65 + nc + 1] = v[1]; tile[kr * 65 + nc + 2] = v[2]; tile[kr * 65 + nc + 3] = v[3];
        }
        __syncthreads();
        {
            const int n = C.tid >> 3, k8 = (C.tid & 7) * 8;
            u32x4 o;
#pragma unroll
            for (int j = 0; j < 4; ++j) o[j] = pk2(tile[(k8 + 2 * j) * 65 + n], tile[(k8 + 2 * j + 1) * 65 + n]);
            *(u32x4*)(dst + (size_t)(n0 + n) * K + k0 + k8) = o;
        }
        __syncthreads();
    }
}
__device__ __forceinline__ void colmax_job(const Ctx& C, const float* src, int ld_src, int K, int N, unsigned* cmax) {
    LAS float* red = (LAS float*)C.lds;
    const int nk = K / 64, nn = N / 64, ntiles = nk * nn;
    for (int tl = C.bid; tl < ntiles; tl += C.G) {
        const int k0 = (tl / nn) * 64, n0 = (tl % nn) * 64;
        float mx[4] = {0.f, 0.f, 0.f, 0.f};
#pragma unroll
        for (int p = 0; p < 2; ++p) { const int kr = (C.tid >> 4) + p * 32, nc = (C.tid & 15) * 4;
            const f32x4 v = *(const f32x4*)(src + (size_t)(k0 + kr) * ld_src + n0 + nc);
#pragma unroll
            for (int e = 0; e < 4; ++e) mx[e] = fmaxf(mx[e], fabsf(v[e])); }
#pragma unroll
        for (int e = 0; e < 4; ++e) red[(C.tid >> 4) * 64 + (C.tid & 15) * 4 + e] = mx[e];
        __syncthreads();
        if (C.tid < 64) { float m = 0.f; for (int r = 0; r < 32; ++r) m = fmaxf(m, red[r * 64 + C.tid]); atomicMax(cmax + n0 + C.tid, __builtin_bit_cast(unsigned, m)); }
        __syncthreads();
    }
}
__device__ __forceinline__ void tconv_i8_job(const Ctx& C, const float* src, int ld_src, int K, int N, unsigned char* dst, const unsigned* cmax) {
    LAS float* tile = (LAS float*)C.lds;
    const int nks = K / 256, nn = N / 64, nunits = nks * nn;
    for (int un = C.bid; un < nunits; un += C.G) {
        const int k0 = (un / nn) * 256, n0 = (un % nn) * 64;
        const int kr = C.tid >> 4, nc = (C.tid & 15) * 4;
        f32x4 v[8];
#pragma unroll
        for (int p = 0; p < 8; ++p) v[p] = *(const f32x4*)(src + (size_t)(k0 + kr + 32 * p) * ld_src + n0 + nc);
        float isc[4];
#pragma unroll
        for (int e = 0; e < 4; ++e) isc[e] = 127.f / fmaxf(__builtin_bit_cast(float, __hip_atomic_load(cmax + n0 + nc + e, __ATOMIC_RELAXED, __HIP_MEMORY_SCOPE_AGENT)), 1e-30f);
#pragma unroll
        for (int p = 0; p < 8; ++p)
#pragma unroll
            for (int e = 0; e < 4; ++e) tile[(kr + 32 * p) * 65 + nc + e] = v[p][e] * isc[e];
        __syncthreads();
        { const int n = C.tid >> 3, kb = (C.tid & 7) * 32;
          u32x4 o0, o1;
#pragma unroll
          for (int j = 0; j < 8; ++j) { unsigned wd = 0u;
#pragma unroll
              for (int e = 0; e < 4; ++e) wd |= ((unsigned)(int)rintf(tile[(kb + 4 * j + e) * 65 + n]) & 255u) << (8 * e);
              if (j < 4) o0[j] = wd; else o1[j - 4] = wd; }
          unsigned char* dp = dst + (size_t)(n0 + n) * K + k0 + kb;
          *(u32x4*)dp = o0; *(u32x4*)(dp + 16) = o1; }
        __syncthreads();
    }
}
__device__ __forceinline__ void cvt_copy(const Ctx& C, const float* src, bf16_t* dst, size_t n) {
    const size_t n8 = n / 8;
    for (size_t i = (size_t)C.bid * 512 + C.tid; i < n8; i += (size_t)C.G * 512) {
        const f32x4 a = *(const f32x4*)(src + i * 8), b = *(const f32x4*)(src + i * 8 + 4);
        u32x4 o; o[0] = pk2(a[0], a[1]); o[1] = pk2(a[2], a[3]); o[2] = pk2(b[0], b[1]); o[3] = pk2(b[2], b[3]);
        *(u32x4*)(dst + i * 8) = o;
    }
}
__device__ __forceinline__ void p_conv_weights(const Ctx& C) {
    for (int l = 0; l < DEPTH; ++l) {
        unsigned char* wb = C.ws + WS_W + (size_t)l * W_LAYER;
        colmax_job(C, C.in[I_WIN] + (size_t)l * DM * NIN, NIN, DM, NH, (unsigned*)(C.ws + WS_CMAX) + l * (NH + NG));
        colmax_job(C, C.in[I_WGATE] + (size_t)l * DM * NG, NG, DM, NG, (unsigned*)(C.ws + WS_CMAX) + l * (NH + NG) + NH);
        for (int m = 0; m < 4; ++m)
            tconv_job(C, C.in[I_WBR] + ((size_t)l * 4 + m) * BW * DM, DM, BW, DM, (bf16_t*)(wb + WO_WBR) + (size_t)m * DM * BW);
        tconv_job(C, C.in[I_WOUT] + (size_t)l * DM * DM, DM, DM, DM, (bf16_t*)(wb + WO_WOUT));
        tconv_job(C, C.in[I_WQ] + (size_t)l * DM * NQ, NQ, DM, NQ, (bf16_t*)(wb + WO_WQ));
        cvt_copy(C, C.in[I_KEYS] + (size_t)l * 2 * PH * 128 * 128, (bf16_t*)(wb + WO_KEYS), (size_t)2 * PH * 128 * 128);
        for (int g = 0; g < 4; ++g)
            tconv_job(C, C.in[I_POOLW] + ((size_t)l * 4 + g) * 128 * 128, 128, 128, 128, (bf16_t*)(wb + WO_POOLW) + (size_t)g * 128 * 128);
        {
            bf16_t* gw = (bf16_t*)(wb + WO_GWS); const float* src = C.in[I_GWS] + (size_t)l * 4 * 128 * 128;
            for (int i = C.bid * 512 + C.tid; i < 4 * 128 * 128; i += C.G * 512) { const int t = (i >> 7) & 127, sx = i & 127; gw[i] = (bf16_t)f2bf(sx <= t ? src[i] : 0.f); }
        }
        float* wf = (float*)(wb + WO_WF);
        for (int i = C.bid * 512 + C.tid; i < 4 * DM; i += C.G * 512) { const int h = i / DM, k = i % DM; wf[i] = C.in[I_WIN][(size_t)l * DM * NIN + (size_t)k * NIN + NH + h]; }
    }
}
constexpr size_t WS_U8 = WS_TABU, WS_V8 = WS_TABU + 16 * MiB, WS_SU = WS_TABU + 32 * MiB, WS_SV = WS_SU + 64 * 1024;
__device__ __forceinline__ float wave_max(float v) {
#pragma unroll
    for (int o = 32; o > 0; o >>= 1) v = fmaxf(v, __shfl_xor(v, o, 64));
    return v;
}
template <bool SIGNED> __device__ __forceinline__ void quant_rows(const Ctx& C, const float* src, unsigned char* dst, float* scl) {
    for (int row = C.bid * 8 + C.wave; row < NEXP; row += C.G * 8) {
        const float* p = src + (size_t)row * DM + C.lane * 16;
        f32x4 v[4]; float mx = 0.f;
#pragma unroll
        for (int i = 0; i < 4; ++i) { v[i] = *(const f32x4*)(p + 4 * i);
#pragma unroll
            for (int e = 0; e < 4; ++e) mx = fmaxf(mx, fabsf(v[i][e])); }
        mx = fmaxf(wave_max(mx), 1e-30f);
        const float sc = mx * (1.f / 127.f), isc = 127.f / mx;
        u32x4 o;
#pragma unroll
        for (int i = 0; i < 4; ++i) { unsigned wd = 0u;
#pragma unroll
            for (int e = 0; e < 4; ++e) { const int q = (int)rintf(v[i][e] * isc) + (SIGNED ? 0 : 128); wd |= ((unsigned)q & 255u) << (8 * e); }
            o[i] = wd; }
        *(u32x4*)(dst + (size_t)row * DM + C.lane * 16) = o;
        if (C.lane == 0) scl[row] = sc;
    }
}
__device__ __forceinline__ void p_conv_tables(const Ctx& C, int l) {
    quant_rows<true>(C, C.in[I_PU] + (size_t)l * NEXP * DM, C.ws + WS_U8, (float*)(C.ws + WS_SU));
    quant_rows<false>(C, C.in[I_PV] + (size_t)l * NEXP * DM, C.ws + WS_V8, (float*)(C.ws + WS_SV));
}

__device__ __forceinline__ void row_emit(const Ctx& C, int row, const float (&v)[16], int l, bool want_lsig) {
    {
        float mx = 0.f;
#pragma unroll
        for (int j = 0; j < 16; ++j) mx = fmaxf(mx, fabsf(v[j]));
#pragma unroll
        for (int o = 32; o > 0; o >>= 1) mx = fmaxf(mx, __shfl_xor(mx, o, 64));
        mx = fmaxf(mx, 1e-30f);
        const float isc = 127.f / mx;
        unsigned char* xb = C.ws + WS_XB + (size_t)row * DM;
        u32x2 o0, o1;
#pragma unroll
        for (int hw = 0; hw < 2; ++hw) { unsigned a = 0u, b = 0u;
#pragma unroll
            for (int e = 0; e < 4; ++e) { a |= ((unsigned)(int)rintf(v[4 * hw + e] * isc) & 255u) << (8 * e); b |= ((unsigned)(int)rintf(v[8 + 4 * hw + e] * isc) & 255u) << (8 * e); }
            o0[hw] = a; o1[hw] = b; }
        *(u32x2*)(xb + C.lane * 8) = o0; *(u32x2*)(xb + 512 + C.lane * 8) = o1;
        if (C.lane == 0) ((float*)(C.ws + WS_XSA))[row] = mx * (1.f / 127.f);
    }
    if (want_lsig) {
        const float* wf = (const float*)(C.ws + WS_W + (size_t)l * W_LAYER + WO_WF);
        float* lsig = (float*)(C.ws + WS_MISC);
#pragma unroll
        for (int h = 0; h < 4; ++h) {
            const f32x4 a0 = *(const f32x4*)(wf + h * DM + C.lane * 8), a1 = *(const f32x4*)(wf + h * DM + C.lane * 8 + 4);
            const f32x4 b0 = *(const f32x4*)(wf + h * DM + 512 + C.lane * 8), b1 = *(const f32x4*)(wf + h * DM + 512 + C.lane * 8 + 4);
            float s = 0.f;
#pragma unroll
            for (int j = 0; j < 4; ++j) s += v[j] * a0[j] + v[4 + j] * a1[j] + v[8 + j] * b0[j] + v[12 + j] * b1[j];
            s = wave_sum(s);
            if (C.lane == 0) lsig[(size_t)row * 4 + h] = logsigmoidf_(s + C.in[I_BFOX][l * 4 + h]);
        }
    }
}
__device__ __forceinline__ void load_row16(const float* p, int lane, float (&v)[16]) {
    const f32x4 a0 = *(const f32x4*)(p + lane * 8), a1 = *(const f32x4*)(p + lane * 8 + 4), b0 = *(const f32x4*)(p + 512 + lane * 8), b1 = *(const f32x4*)(p + 512 + lane * 8 + 4);
#pragma unroll
    for (int j = 0; j < 4; ++j) { v[j] = a0[j]; v[4 + j] = a1[j]; v[8 + j] = b0[j]; v[12 + j] = b1[j]; }
}
__device__ __forceinline__ void store_row16(float* p, int lane, const float (&v)[16]) {
    *(f32x4*)(p + lane * 8) = (f32x4){v[0], v[1], v[2], v[3]}; *(f32x4*)(p + lane * 8 + 4) = (f32x4){v[4], v[5], v[6], v[7]};
    *(f32x4*)(p + 512 + lane * 8) = (f32x4){v[8], v[9], v[10], v[11]}; *(f32x4*)(p + 512 + lane * 8 + 4) = (f32x4){v[12], v[13], v[14], v[15]};
}
__device__ __forceinline__ void ln_row16(float (&v)[16], const float* g, const float* b, int lane) {
    float s = 0.f;
#pragma unroll
    for (int j = 0; j < 16; ++j) s += v[j];
    const float mean = wave_sum(s) * (1.f / DM);
    float q = 0.f;
#pragma unroll
    for (int j = 0; j < 16; ++j) { const float d = v[j] - mean; q += d * d; }
    const float rstd = rsqrtf(wave_sum(q) * (1.f / DM) + LN_EPS);
    float gg[16], bb[16];
    load_row16(g, lane, gg); load_row16(b, lane, bb);
#pragma unroll
    for (int j = 0; j < 16; ++j) v[j] = (v[j] - mean) * rstd * gg[j] + bb[j];
}
__device__ __forceinline__ void p_rowpass0(const Ctx& C) {
    for (int row = C.bid * 8 + C.wave; row < T; row += C.G * 8) {
        float v[16]; load_row16(C.in[I_X] + (size_t)row * DM, C.lane, v);
        row_emit(C, row, v, 0, true);
    }
}
__device__ __forceinline__ void p_cumsum(const Ctx& C) {
    if (C.bid >= BATCH * 4) return;
    const float* lsig = (const float*)(C.ws + WS_MISC);
    float* cum = (float*)(C.ws + WS_CUM);
    LAS float* wt = (LAS float*)C.lds;
    const int b = C.bid >> 2, h = C.bid & 3;
    float v[16];
#pragma unroll
    for (int j = 0; j < 16; ++j) v[j] = lsig[((size_t)b * SEQ + C.tid * 16 + j) * 4 + h];
#pragma unroll
    for (int j = 1; j < 16; ++j) v[j] += v[j - 1];
    float inc = v[15];
#pragma unroll
    for (int o = 1; o < 64; o <<= 1) { const float t = __shfl_up(inc, o, 64); if (C.lane >= o) inc += t; }
    if (C.lane == 63) wt[C.wave] = inc;
    __syncthreads();
    float off = inc - v[15];
    for (int w2 = 0; w2 < C.wave; ++w2) off += wt[w2];
    float* cp = cum + ((size_t)b * 4 + h) * SEQ + C.tid * 16;
#pragma unroll
    for (int j4 = 0; j4 < 4; ++j4) *(f32x4*)(cp + 4 * j4) = (f32x4){v[4 * j4] + off, v[4 * j4 + 1] + off, v[4 * j4 + 2] + off, v[4 * j4 + 3] + off};
    __syncthreads();
}
__device__ __forceinline__ void load_row16_bf(const bf16_t* p, int lane, float (&v)[16]) {
    const u32x4 a = *(const u32x4*)(p + lane * 8), b = *(const u32x4*)(p + 512 + lane * 8);
#pragma unroll
    for (int j = 0; j < 4; ++j) { v[2 * j] = bf2f(a[j] & 0xffffu); v[2 * j + 1] = bf2f(a[j] >> 16); v[8 + 2 * j] = bf2f(b[j] & 0xffffu); v[9 + 2 * j] = bf2f(b[j] >> 16); }
}
__device__ __forceinline__ void p_ln1(const Ctx& C, int l) {
    const bf16_t* y1 = (const bf16_t*)(C.ws + WS_XC); bf16_t* x1b = (bf16_t*)(C.ws + WS_X1B);
    for (int row = C.bid * 8 + C.wave; row < T; row += C.G * 8) {
        float v[16]; load_row16_bf(y1 + (size_t)row * DM, C.lane, v);
        ln_row16(v, C.in[I_LN1G] + l * DM, C.in[I_LN1B] + l * DM, C.lane);
        u32x4 o0, o1;
#pragma unroll
        for (int j = 0; j < 4; ++j) { o0[j] = pk2(v[2 * j], v[2 * j + 1]); o1[j] = pk2(v[8 + 2 * j], v[8 + 2 * j + 1]); }
        *(u32x4*)(x1b + (size_t)row * DM + C.lane * 8) = o0; *(u32x4*)(x1b + (size_t)row * DM + 512 + C.lane * 8) = o1;
    }
}

__device__ __forceinline__ void mix_pool_naive(const Ctx& C, int l) {
    const bf16_t* H = (const bf16_t*)(C.ws + WS_H); bf16_t* BR = (bf16_t*)(C.ws + WS_BR);
    LAS float* dd = (LAS float*)C.lds;
    for (int u = C.bid; u < (T / 64) * 4; u += C.G) {
        const int g = u & 3, t0 = (u >> 2) * 64, w = 2 << g;
        for (int idx = C.tid; idx < 64 * 128; idx += 512) {
            const int r = idx >> 7, c = idx & 127, row = t0 + r, pos = row & (SEQ - 1);
            const int nwin = (pos + 1 < w) ? pos + 1 : w;
            float s = 0.f;
            for (int j = 0; j < nwin; ++j) s += bf2f(H[(size_t)(row - j) * NH + HC_P + g * 128 + c]);
            dd[idx] = s / (float)nwin - bf2f(H[(size_t)row * NH + HC_P + g * 128 + c]);
        }
        __syncthreads();
        const int dcol = C.tid & 127, rq = C.tid >> 7;
        float acc[16];
#pragma unroll
        for (int i = 0; i < 16; ++i) acc[i] = 0.f;
        const float* pw = C.in[I_POOLW] + ((size_t)l * 4 + g) * 128 * 128;
        for (int c = 0; c < 128; ++c) {
            const float wv = pw[c * 128 + dcol];
#pragma unroll
            for (int i = 0; i < 16; ++i) acc[i] += dd[(rq * 16 + i) * 128 + c] * wv;
        }
        const float sc = C.in[I_POOLS][l * BW + g * 128 + dcol];
#pragma unroll
        for (int i = 0; i < 16; ++i) BR[(size_t)(t0 + rq * 16 + i) * NBR + 0 + g * 128 + dcol] = (bf16_t)f2bf(acc[i] * sc);
        __syncthreads();
    }
}
__device__ __forceinline__ void mix_gmlp_naive(const Ctx& C, int l) {
    const bf16_t* H = (const bf16_t*)(C.ws + WS_H); bf16_t* BR = (bf16_t*)(C.ws + WS_BR);
    LAS float* vn = (LAS float*)C.lds;
    for (int u = C.bid; u < (T / 128) * 4; u += C.G) {
        const int g = u & 3, t0 = (u >> 2) * 128;
        for (int i = 0; i < 16; ++i) {
            const int r = C.wave * 16 + i, row = t0 + r;
            const u32x4 raw = *(const u32x4*)(H + (size_t)row * NH + HC_GV + C.lane * 8);
            float e[8];
#pragma unroll
            for (int j = 0; j < 4; ++j) { e[2 * j] = geluf_(bf2f(raw[j] & 0xffffu)); e[2 * j + 1] = geluf_(bf2f(raw[j] >> 16)); }
            float s = 0.f;
#pragma unroll
            for (int j = 0; j < 8; ++j) s += e[j];
            const float mean = wave_sum(s) * (1.f / BW);
            float q = 0.f;
#pragma unroll
            for (int j = 0; j < 8; ++j) { const float d = e[j] - mean; q += d * d; }
            const float rstd = rsqrtf(wave_sum(q) * (1.f / BW) + LN_EPS);
            if ((C.lane >> 4) == g) {
#pragma unroll
                for (int j = 0; j < 8; ++j) { const int col = C.lane * 8 + j;
                    vn[r * 128 + (col - g * 128)] = (e[j] - mean) * rstd * C.in[I_GLNG][l * BW + col] + C.in[I_GLNB][l * BW + col]; }
            }
        }
        __syncthreads();
        const int c = C.tid & 127, tq = C.tid >> 7;
        const float* wsg = C.in[I_GWS] + ((size_t)l * 4 + g) * 128 * 128;
        for (int t = tq; t < 128; t += 4) {
            float acc = 0.f;
            for (int s = 0; s <= t; ++s) acc += wsg[t * 128 + s] * vn[s * 128 + c];
            const float sv = acc + C.in[I_GBS][(l * 4 + g) * 128 + t];
            const float uv = geluf_(bf2f(H[(size_t)(t0 + t) * NH + HC_GU + g * 128 + c]));
            BR[(size_t)(t0 + t) * NBR + 1024 + g * 128 + c] = (bf16_t)f2bf(uv * sv);
        }
        __syncthreads();
    }
}
__device__ __forceinline__ void mix_fox_naive(const Ctx& C, int l) {
    const bf16_t* H = (const bf16_t*)(C.ws + WS_H); bf16_t* BR = (bf16_t*)(C.ws + WS_BR);
    const float* cum = (const float*)(C.ws + WS_CUM);
    const float scale = 0.08838834764831845f;
    for (int u = C.bid; u < T * 4 / 8; u += C.G) {
        const int rid = u * 8 + C.wave;
        const int h = rid & 3, row = rid >> 2, b = row / SEQ, t = row % SEQ;
        const unsigned qraw = *(const unsigned*)(H + (size_t)row * NH + HC_FQ + h * 128 + C.lane * 2);
        const float q0 = bf2f(qraw & 0xffffu) * scale, q1 = bf2f(qraw >> 16) * scale;
        const float* cm = cum + ((size_t)b * 4 + h) * SEQ;
        const float ct = cm[t];
        float m = -1e30f, lsum = 0.f, o0 = 0.f, o1 = 0.f;
        for (int s = t; s >= 0; --s) {
            const size_t kr = (size_t)(b * SEQ + s) * NH + h * 128 + C.lane * 2;
            const unsigned kraw = *(const unsigned*)(H + kr + HC_FK);
            const unsigned vraw = *(const unsigned*)(H + kr + HC_FV);
            float d = q0 * bf2f(kraw & 0xffffu) + q1 * bf2f(kraw >> 16);
            d = wave_sum(d);
            const float z = d + ct - cm[s];
            const float mn = fmaxf(m, z), al = __expf(m - mn), p = __expf(z - mn);
            lsum = lsum * al + p; o0 = o0 * al + p * bf2f(vraw & 0xffffu); o1 = o1 * al + p * bf2f(vraw >> 16); m = mn;
        }
        const float inv = 1.f / lsum;
        *(unsigned*)(BR + (size_t)row * NBR + 1536 + h * 128 + C.lane * 2) = pk2(o0 * inv, o1 * inv);
    }
}
__device__ __forceinline__ void mix_hgrn_naive(const Ctx& C, int l) {
    if (C.bid >= BATCH * 4) return;
    const bf16_t* H = (const bf16_t*)(C.ws + WS_H); bf16_t* BR = (bf16_t*)(C.ws + WS_BR);
    const int b = C.bid >> 2, h = C.bid & 3;
    LAS float* fdec = (LAS float*)C.lds;
    LAS float* kkv = fdec + 32 * 128;
    LAS float* qsv = kkv + 32 * 128;
    LAS float* vv = qsv + 32 * 128;
    LAS float* opart = vv + 32 * 128;
    const int kq = C.tid >> 7, v = C.tid & 127;
    float S[32];
#pragma unroll
    for (int j = 0; j < 32; ++j) S[j] = 0.f;
    for (int c0 = 0; c0 < SEQ; c0 += 32) {
        for (int idx = C.tid; idx < 32 * 128; idx += 512) {
            const int st = idx >> 7, k = idx & 127; const size_t rb = (size_t)(b * SEQ + c0 + st) * NH + h * 128 + k;
            float lb = 0.f;
            if (l == 1) { const float z0 = C.in[I_LBL][h * 128 + k], z1 = C.in[I_LBL][BW + h * 128 + k]; lb = 1.f / (1.f + __expf(z0 - z1)); }
            const float zf = bf2f(H[rb + HC_HF]);
            const float kk = (1.f - lb) * sigmoidf_(-zf);
            fdec[idx] = 1.f - kk; kkv[idx] = kk; qsv[idx] = siluf_(bf2f(H[rb + HC_HQ])); vv[idx] = bf2f(H[rb + HC_HI]);
        }
        __syncthreads();
        for (int st = 0; st < 32; ++st) {
            const float vt = vv[st * 128 + v];
            float part = 0.f;
#pragma unroll
            for (int j = 0; j < 32; ++j) { const int k = kq * 32 + j; S[j] = fdec[st * 128 + k] * S[j] + kkv[st * 128 + k] * vt; part += S[j] * qsv[st * 128 + k]; }
            opart[(kq * 32 + st) * 128 + v] = part;
        }
        __syncthreads();
        for (int i = 0; i < 4; ++i) {
            const int st = C.wave * 4 + i, row = b * SEQ + c0 + st;
            float o0 = 0.f, o1 = 0.f;
#pragma unroll
            for (int q = 0; q < 4; ++q) { o0 += opart[(q * 32 + st) * 128 + C.lane]; o1 += opart[(q * 32 + st) * 128 + 64 + C.lane]; }
            const float ss = wave_sum(o0 * o0 + o1 * o1);
            const float r = rsqrtf(ss * (1.f / 128.f) + RMS_EPS);
            const float g0 = siluf_(bf2f(H[(size_t)row * NH + HC_HG + h * 128 + C.lane])), g1 = siluf_(bf2f(H[(size_t)row * NH + HC_HG + h * 128 + 64 + C.lane]));
            BR[(size_t)row * NBR + 512 + h * 128 + C.lane] = (bf16_t)f2bf(o0 * r * C.in[I_HNG][l * 128 + C.lane] * g0);
            BR[(size_t)row * NBR + 512 + h * 128 + 64 + C.lane] = (bf16_t)f2bf(o1 * r * C.in[I_HNG][l * 128 + 64 + C.lane] * g1);
        }
        __syncthreads();
    }
}


typedef float f32x16 __attribute__((ext_vector_type(16)));
typedef short s16x4 __attribute__((ext_vector_type(4)));
typedef short v4i16_t __attribute__((ext_vector_type(4)));
__device__ __forceinline__ s16x4 vtr(const LAS unsigned char* p) { return __builtin_bit_cast(s16x4, __builtin_amdgcn_ds_read_tr16_b64_v4i16((LAS v4i16_t*)p)); }
__device__ __forceinline__ float xor32(float x) { return __shfl_xor(x, 32, 64); }
#define MFMA32(a, b, c) __builtin_amdgcn_mfma_f32_32x32x16_bf16((a), (b), (c), 0, 0, 0)
constexpr int CW_KMAX = 16;

__device__ __forceinline__ void p_knorm(const Ctx& C, int l) {
    const bf16_t* H = (const bf16_t*)(C.ws + WS_H);
    unsigned* kmax = (unsigned*)(C.ws + WS_CTL) + CW_KMAX + l * 8;
    for (int r0 = (C.bid * 8 + C.wave) * 8; r0 < T; r0 += C.G * 64) {
        u32x4 raw[8];
#pragma unroll
        for (int i = 0; i < 8; ++i) raw[i] = *(const u32x4*)(H + (size_t)(r0 + i) * NH + HC_FK + C.lane * 8);
        float best = 0.f;
#pragma unroll
        for (int i = 0; i < 8; ++i) { float s = 0.f;
#pragma unroll
            for (int j = 0; j < 4; ++j) { const float a = bf2f(raw[i][j] & 0xffffu), b = bf2f(raw[i][j] >> 16); s += a * a + b * b; }
            best = fmaxf(best, s); }
        best = 0.f;
#pragma unroll
        for (int i = 0; i < 8; ++i) { float s = 0.f;
#pragma unroll
            for (int j = 0; j < 4; ++j) { const float a = bf2f(raw[i][j] & 0xffffu), b = bf2f(raw[i][j] >> 16); s += a * a + b * b; }
#pragma unroll
            for (int o = 8; o > 0; o >>= 1) s += __shfl_xor(s, o, 64);
            best = fmaxf(best, s); }
        LAS float* red = (LAS float*)C.lds;
        if ((C.lane & 15) == 0) red[C.wave * 4 + (C.lane >> 4)] = best;
        __syncthreads();
        if (C.tid < 4) { float m = red[C.tid];
#pragma unroll
            for (int w2 = 1; w2 < 8; ++w2) m = fmaxf(m, red[w2 * 4 + C.tid]);
            atomicMax(kmax + (r0 / SEQ) * 4 + C.tid, __builtin_bit_cast(unsigned, m)); }
        __syncthreads();
    }
}

constexpr int FOX_KST = 272, FOX_VST = 320;
constexpr int FOX_KB = 0, FOX_VB = 2 * 64 * FOX_KST, FOX_BETA = FOX_VB + 2 * 64 * FOX_VST, FOX_FLAG = FOX_BETA + 2 * 64 * 4, FOX_END = FOX_FLAG + 2 * 8 * 4;
__device__ __forceinline__ void mix_fox(const Ctx& C, int l) {
    const bf16_t* H = (const bf16_t*)(C.ws + WS_H); bf16_t* BR = (bf16_t*)(C.ws + WS_BR);
    const float* cum = (const float*)(C.ws + WS_CUM);
    const unsigned* kmaxw = (const unsigned*)(C.ws + WS_CTL) + CW_KMAX + l * 8;
    const float LOG2E = 1.4426950408889634f, QS = 0.08838834764831845f * LOG2E;
    const int lane = C.lane, w = C.wave, r32 = lane & 31, hh = lane >> 5;
    LAS unsigned char* lds = C.lds;
    LAS float* betaL = (LAS float*)(lds + FOX_BETA);
    volatile LAS int* flagL = (volatile LAS int*)(lds + FOX_FLAG);
    for (int u = C.bid; u < BATCH * 4 * (SEQ / 256); u += C.G) {
        const int qb = u % (SEQ / 256), bh = u / (SEQ / 256), b = bh >> 2, h = bh & 3;
        const int q0 = qb * 256, qw = q0 + 32 * w;
        const size_t rowbase = (size_t)b * SEQ;
        const float* cm = cum + ((size_t)b * 4 + h) * SEQ;
        const float c0 = cm[q0];
        const float kmx = sqrtf(__builtin_bit_cast(float, __hip_atomic_load(kmaxw + b * 4 + h, __ATOMIC_RELAXED, __HIP_MEMORY_SCOPE_AGENT)));
        bf16x8 qf[8]; float qn = 0.f;
        {
            const bf16_t* qp = H + (rowbase + qw + r32) * NH + HC_FQ + h * 128 + 8 * hh;
#pragma unroll
            for (int ks = 0; ks < 8; ++ks) {
                const u32x4 raw = *(const u32x4*)(qp + 16 * ks);
                u32x4 o;
#pragma unroll
                for (int j = 0; j < 4; ++j) { const float a = bf2f(raw[j] & 0xffffu), bb = bf2f(raw[j] >> 16); qn += a * a + bb * bb; o[j] = cvtpk(a * QS, bb * QS); }
                qf[ks] = __builtin_bit_cast(bf16x8, o);
            }
            qn += xor32(qn); qn = sqrtf(qn);
        }
        const float qbound = qn * kmx * QS;
        f32x16 oacc[4];
#pragma unroll
        for (int mt = 0; mt < 4; ++mt)
#pragma unroll
            for (int i = 0; i < 16; ++i) oacc[mt][i] = 0.f;
        float m_run = -1e30f, l_run = 0.f;
        const int jmax = (q0 + 255) >> 6;
        const int srow = C.tid >> 4, sch = C.tid & 15;
        u32x4 kreg[2], vreg[2]; float breg = 0.f;
#define FOX_GLOAD(j_) do { _Pragma("unroll") for (int p = 0; p < 2; ++p) { \
                const bf16_t* rp = H + (rowbase + 64 * (j_) + srow + 32 * p) * NH + h * 128 + sch * 8; \
                kreg[p] = *(const u32x4*)(rp + HC_FK); vreg[p] = *(const u32x4*)(rp + HC_FV); } \
            if (C.tid < 64) breg = (c0 - cm[64 * (j_) + C.tid]) * LOG2E; } while (0)
#define FOX_LWRITE(buf_) do { _Pragma("unroll") for (int p = 0; p < 2; ++p) { \
                *(LAS u32x4*)(lds + FOX_KB + (buf_) * 64 * FOX_KST + (srow + 32 * p) * FOX_KST + sch * 16) = kreg[p]; \
                *(LAS u32x4*)(lds + FOX_VB + (buf_) * 64 * FOX_VST + (srow + 32 * p) * FOX_VST + sch * 16) = vreg[p]; } \
            if (C.tid < 64) betaL[(buf_) * 64 + C.tid] = breg; } while (0)
        __syncthreads();
        if (C.tid < 16) flagL[C.tid] = 0;
        FOX_GLOAD(jmax); FOX_LWRITE(jmax & 1);
        bool wdone = false;
        for (int j = jmax; j >= 0; --j) {
            const int cur = j & 1;
            __syncthreads();
            if (j < jmax) { int all = 1;
#pragma unroll
                for (int i = 0; i < 8; ++i) all &= flagL[((j + 1) & 1) * 8 + i];
                if (all) break; }
            if (j > 0) FOX_GLOAD(j - 1);
            const int k0 = 64 * j;
            if (k0 <= qw + 31 && !wdone) {
                const LAS unsigned char* kb = lds + FOX_KB + cur * 64 * FOX_KST;
                const LAS unsigned char* vb = lds + FOX_VB + cur * 64 * FOX_VST;
                f32x16 sacc[2];
#pragma unroll
                for (int mt = 0; mt < 2; ++mt)
#pragma unroll
                    for (int g = 0; g < 4; ++g) { const f32x4 bv = *(const LAS f32x4*)(betaL + cur * 64 + 32 * mt + 8 * g + 4 * hh);
                        sacc[mt][4 * g] = bv[0]; sacc[mt][4 * g + 1] = bv[1]; sacc[mt][4 * g + 2] = bv[2]; sacc[mt][4 * g + 3] = bv[3]; }
#pragma unroll
                for (int ks = 0; ks < 8; ++ks)
#pragma unroll
                    for (int mt = 0; mt < 2; ++mt) {
                        const bf16x8 kf = *(const LAS bf16x8*)(kb + (32 * mt + r32) * FOX_KST + 32 * ks + 16 * hh);
                        sacc[mt] = MFMA32(kf, qf[ks], sacc[mt]);
                    }
                const int tq = qw + r32;
                if (k0 + 63 > qw) {
#pragma unroll
                    for (int mt = 0; mt < 2; ++mt)
#pragma unroll
                        for (int i = 0; i < 16; ++i) { const int key = k0 + 32 * mt + (i & 3) + 8 * (i >> 2) + 4 * hh; if (key > tq) sacc[mt][i] = -1e30f; }
                }
                float mx = sacc[0][0];
#pragma unroll
                for (int mt = 0; mt < 2; ++mt)
#pragma unroll
                    for (int i = 0; i < 16; ++i) mx = fmaxf(mx, sacc[mt][i]);
                mx = fmaxf(mx, xor32(mx));
                const float mn = fmaxf(m_run, mx), alpha = __builtin_amdgcn_exp2f(m_run - mn);
                m_run = mn;
                float ps = 0.f;
#pragma unroll
                for (int mt = 0; mt < 2; ++mt)
#pragma unroll
                    for (int i = 0; i < 16; ++i) { const float p = __builtin_amdgcn_exp2f(sacc[mt][i] - mn); sacc[mt][i] = p; ps += p; }
                l_run = l_run * alpha + ps;
#pragma unroll
                for (int mt = 0; mt < 4; ++mt)
#pragma unroll
                    for (int i = 0; i < 16; ++i) oacc[mt][i] *= alpha;
#pragma unroll
                for (int s4 = 0; s4 < 4; ++s4) {
                    const int mtk = s4 >> 1, s = s4 & 1;
                    u32x4 pb;
#pragma unroll
                    for (int e = 0; e < 4; ++e) pb[e] = cvtpk(sacc[mtk][8 * s + 2 * e], sacc[mtk][8 * s + 2 * e + 1]);
                    const bf16x8 pfrag = __builtin_bit_cast(bf16x8, pb);
                    const int i16 = lane & 15, q4 = i16 >> 2, p4 = i16 & 3, blk = (lane >> 4) & 1;
                    const int keyA = 32 * mtk + 16 * s + 4 * hh + q4;
#pragma unroll
                    for (int mt = 0; mt < 4; ++mt) {
                        const LAS unsigned char* a0 = vb + keyA * FOX_VST + (32 * mt + 16 * blk + 4 * p4) * 2;
                        const s16x4 lo = vtr(a0), hi = vtr(a0 + 8 * FOX_VST);
                        const bf16x8 vf = __builtin_shufflevector(lo, hi, 0, 1, 2, 3, 4, 5, 6, 7);
                        oacc[mt] = MFMA32(vf, pfrag, oacc[mt]);
                    }
                }
                if (j > 0) { const float bl = (c0 - cm[k0 - 1]) * LOG2E;
                    const int ok = (qbound + bl < m_run - 152.f) ? 1 : 0;
                    wdone = __all(ok); }
            }
            if (lane == 0) flagL[cur * 8 + w] = wdone ? 1 : 0;
            if (j > 0) FOX_LWRITE(cur ^ 1);
        }
        l_run += xor32(l_run);
        const float inv = 1.f / l_run;
        bf16_t* op = BR + (rowbase + qw + r32) * NBR + 1536 + h * 128;
#pragma unroll
        for (int mt = 0; mt < 4; ++mt)
#pragma unroll
            for (int g = 0; g < 4; ++g) { u32x2 o; o[0] = cvtpk(oacc[mt][4 * g] * inv, oacc[mt][4 * g + 1] * inv); o[1] = cvtpk(oacc[mt][4 * g + 2] * inv, oacc[mt][4 * g + 3] * inv);
                *(u32x2*)(op + 32 * mt + 8 * g + 4 * hh) = o; }
    }
}


constexpr int HG_LF = 0, HG_QA = 34816, HG_QB = HG_QA + 17408, HG_KD = HG_QB + 8704, HG_KO = HG_KD + 17408, HG_KT = HG_KO + 8704, HG_VN = HG_KT + 20480, HG_AM = HG_VN + 20480, HG_END = HG_AM + 12288;
constexpr int HG_LFS = 132;
static_assert(HG_END + 2048 <= 140 * 1024, "hgrn LDS");
constexpr size_t WS_DSC = WS_ST + (size_t)BATCH * 4 * 32 * 128 * 128 * 4;

template <bool FULL>
__device__ __forceinline__ void hgrn_unit(const Ctx& C, int l, int u) {
#if DIAG == 1
    const bf16_t* H = (const bf16_t*)(C.ws + WS_H); bf16_t* BR = (l == 0) ? (bf16_t*)(C.ws + WS_XA) : (bf16_t*)(C.ws + WS_TABU);
#else
    const bf16_t* H = (const bf16_t*)(C.ws + WS_H); bf16_t* BR = (bf16_t*)(C.ws + WS_BR);
#endif
    float* STB = (float*)(C.ws + WS_ST); float* DSC = (float*)(C.ws + WS_DSC);
    LAS unsigned char* lds = C.lds;
    LAS float* LF = (LAS float*)(lds + HG_LF);
    const int lane = C.lane, w = C.wave, r32 = lane & 31, hh = lane >> 5;
    const int sc = u & 31, bh = u >> 5, b = bh >> 2, h = bh & 3;
    const int wk = w >> 1, wv = w & 1;
    const int mt = w >> 2, nt = w & 3;
    const int i16 = lane & 15, q4 = i16 >> 2, p4 = i16 & 3, blk = (lane >> 4) & 1;
    f32x16 S0, S1;
    float* stp = STB + ((size_t)bh * 32 + sc) * 128 * 128;
    if constexpr (FULL) {
#pragma unroll
        for (int i = 0; i < 16; ++i) { const int k = 32 * wk + (i & 3) + 8 * (i >> 2) + 4 * hh;
            S0[i] = stp[k * 128 + 64 * wv + r32]; S1[i] = stp[k * 128 + 64 * wv + 32 + r32]; }
    } else {
#pragma unroll
        for (int i = 0; i < 16; ++i) { S0[i] = 0.f; S1[i] = 0.f; }
    }
    float dtot = 0.f;
    const int ps = C.tid >> 3, pseg = C.tid & 7;
    float lbv[16];
#pragma unroll
    for (int j = 0; j < 16; ++j) { lbv[j] = 0.f;
        if (l == 1) { const int ch = h * 128 + 16 * pseg + j; lbv[j] = 1.f / (1.f + __expf(C.in[I_LBL][ch] - C.in[I_LBL][BW + ch])); } }
    u32x4 nf0, nf1, nv0, nv1;
    { const bf16_t* hp0 = H + ((size_t)b * SEQ + sc * 256 + ps) * NH + h * 128 + 16 * pseg;
      nf0 = *(const u32x4*)(hp0 + HC_HF); nf1 = *(const u32x4*)(hp0 + HC_HF + 8); nv0 = *(const u32x4*)(hp0 + HC_HI); nv1 = *(const u32x4*)(hp0 + HC_HI + 8); }
    for (int c = 0; c < 4; ++c) {
        const size_t row0 = (size_t)b * SEQ + sc * 256 + c * 64;
        const bf16_t* hp = H + (row0 + ps) * NH + h * 128 + 16 * pseg;
        float kkv[16], qsv[16];
        u32x4 vraw0, vraw1;
        u32x4 cg0 = {0u, 0u, 0u, 0u}, cg1 = cg0, cq0 = cg0, cq1 = cg0;
        if constexpr (FULL) { cq0 = *(const u32x4*)(hp + HC_HQ); cq1 = *(const u32x4*)(hp + HC_HQ + 8); cg0 = *(const u32x4*)(hp + HC_HG); cg1 = *(const u32x4*)(hp + HC_HG + 8); }
        {
            const u32x4 f0 = nf0, f1 = nf1;
            vraw0 = nv0; vraw1 = nv1;
            if (c < 3) { const bf16_t* hn = hp + (size_t)64 * NH;
                nf0 = *(const u32x4*)(hn + HC_HF); nf1 = *(const u32x4*)(hn + HC_HF + 8); nv0 = *(const u32x4*)(hn + HC_HI); nv1 = *(const u32x4*)(hn + HC_HI + 8); }
#pragma unroll
            for (int j = 0; j < 8; ++j) { const unsigned r = (j < 4) ? f0[j] : f1[j - 4];
                const float z0 = bf2f(r & 0xffffu), z1 = bf2f(r >> 16);
                kkv[2 * j] = (1.f - lbv[2 * j]) * sigmoidf_(-z0); kkv[2 * j + 1] = (1.f - lbv[2 * j + 1]) * sigmoidf_(-z1); }
            if constexpr (FULL) {
#pragma unroll
                for (int j = 0; j < 8; ++j) { const unsigned r = (j < 4) ? cq0[j] : cq1[j - 4]; qsv[2 * j] = siluf_(bf2f(r & 0xffffu)); qsv[2 * j + 1] = siluf_(bf2f(r >> 16)); }
            }
#pragma unroll
            for (int j4 = 0; j4 < 4; ++j4) { f32x4 o;
#pragma unroll
                for (int e = 0; e < 4; ++e) o[e] = __logf(1.f - kkv[4 * j4 + e]);
                *(LAS f32x4*)(LF + ps * HG_LFS + 16 * pseg + 4 * j4) = o; }
        }
        __syncthreads();
        {
            const int sk = C.tid & 127, sg = C.tid >> 7;
            float vals[16];
#pragma unroll
            for (int i = 0; i < 16; ++i) vals[i] = LF[(16 * sg + i) * HG_LFS + sk];
#pragma unroll
            for (int i = 1; i < 16; ++i) vals[i] += vals[i - 1];
            LAS float* TOT = (LAS float*)(lds + HG_END);
            TOT[sg * 128 + sk] = vals[15];
            __syncthreads();
            float off = 0.f;
#pragma unroll
            for (int j = 0; j < 3; ++j) if (j < sg) off += TOT[j * 128 + sk];
#pragma unroll
            for (int i = 0; i < 16; ++i) LF[(16 * sg + i) * HG_LFS + sk] = vals[i] + off;
            if (sg == 3) dtot += vals[15] + off;
        }
        __syncthreads();
        float bv[16], b31[16], bl[16];
#pragma unroll
        for (int j4 = 0; j4 < 4; ++j4) { const f32x4 x = *(const LAS f32x4*)(LF + ps * HG_LFS + 16 * pseg + 4 * j4), y = *(const LAS f32x4*)(LF + 31 * HG_LFS + 16 * pseg + 4 * j4), z = *(const LAS f32x4*)(LF + 63 * HG_LFS + 16 * pseg + 4 * j4);
#pragma unroll
            for (int e = 0; e < 4; ++e) { bv[4 * j4 + e] = x[e]; b31[4 * j4 + e] = y[e]; bl[4 * j4 + e] = z[e]; } }
        {
            u32x4 o0, o1;
#pragma unroll
            for (int j = 0; j < 4; ++j) { o0[j] = cvtpk(kkv[2 * j] * __expf(bl[2 * j] - bv[2 * j]), kkv[2 * j + 1] * __expf(bl[2 * j + 1] - bv[2 * j + 1]));
                o1[j] = cvtpk(kkv[8 + 2 * j] * __expf(bl[8 + 2 * j] - bv[8 + 2 * j]), kkv[9 + 2 * j] * __expf(bl[9 + 2 * j] - bv[9 + 2 * j])); }
            *(LAS u32x4*)(lds + HG_KT + ps * 320 + 32 * pseg) = o0; *(LAS u32x4*)(lds + HG_KT + ps * 320 + 32 * pseg + 16) = o1;
            *(LAS u32x4*)(lds + HG_VN + ps * 320 + 32 * pseg) = vraw0; *(LAS u32x4*)(lds + HG_VN + ps * 320 + 32 * pseg + 16) = vraw1;
            if constexpr (FULL) {
                const bool hi = ps >= 32;
                float rr[16];
#pragma unroll
                for (int j = 0; j < 16; ++j) rr[j] = hi ? b31[j] : 0.f;
#pragma unroll
                for (int j = 0; j < 4; ++j) { o0[j] = cvtpk(qsv[2 * j] * __expf(bv[2 * j] - rr[2 * j]), qsv[2 * j + 1] * __expf(bv[2 * j + 1] - rr[2 * j + 1]));
                    o1[j] = cvtpk(qsv[8 + 2 * j] * __expf(bv[8 + 2 * j] - rr[8 + 2 * j]), qsv[9 + 2 * j] * __expf(bv[9 + 2 * j] - rr[9 + 2 * j])); }
                *(LAS u32x4*)(lds + HG_QA + ps * 272 + 32 * pseg) = o0; *(LAS u32x4*)(lds + HG_QA + ps * 272 + 32 * pseg + 16) = o1;
#pragma unroll
                for (int j = 0; j < 4; ++j) { o0[j] = cvtpk(kkv[2 * j] * __expf(rr[2 * j] - bv[2 * j]), kkv[2 * j + 1] * __expf(rr[2 * j + 1] - bv[2 * j + 1]));
                    o1[j] = cvtpk(kkv[8 + 2 * j] * __expf(rr[8 + 2 * j] - bv[8 + 2 * j]), kkv[9 + 2 * j] * __expf(rr[9 + 2 * j] - bv[9 + 2 * j])); }
                *(LAS u32x4*)(lds + HG_KD + ps * 272 + 32 * pseg) = o0; *(LAS u32x4*)(lds + HG_KD + ps * 272 + 32 * pseg + 16) = o1;
                if (hi) {
#pragma unroll
                    for (int j = 0; j < 4; ++j) { o0[j] = cvtpk(qsv[2 * j] * __expf(bv[2 * j]), qsv[2 * j + 1] * __expf(bv[2 * j + 1]));
                        o1[j] = cvtpk(qsv[8 + 2 * j] * __expf(bv[8 + 2 * j]), qsv[9 + 2 * j] * __expf(bv[9 + 2 * j])); }
                    *(LAS u32x4*)(lds + HG_QB + (ps - 32) * 272 + 32 * pseg) = o0; *(LAS u32x4*)(lds + HG_QB + (ps - 32) * 272 + 32 * pseg + 16) = o1;
                } else {
#pragma unroll
                    for (int j = 0; j < 4; ++j) { o0[j] = cvtpk(kkv[2 * j] * __expf(b31[2 * j] - bv[2 * j]), kkv[2 * j + 1] * __expf(b31[2 * j + 1] - bv[2 * j + 1]));
                        o1[j] = cvtpk(kkv[8 + 2 * j] * __expf(b31[8 + 2 * j] - bv[8 + 2 * j]), kkv[9 + 2 * j] * __expf(b31[9 + 2 * j] - bv[9 + 2 * j])); }
                    *(LAS u32x4*)(lds + HG_KO + ps * 272 + 32 * pseg) = o0; *(LAS u32x4*)(lds + HG_KO + ps * 272 + 32 * pseg + 16) = o1;
                }
            }
        }
        float dk[16];
#pragma unroll
        for (int i = 0; i < 16; ++i) dk[i] = __expf(LF[63 * HG_LFS + 32 * wk + (i & 3) + 8 * (i >> 2) + 4 * hh]);
        __syncthreads();
        if constexpr (FULL) {
#pragma unroll
            for (int g = 0; g < 4; ++g) {
                u32x2 o; o[0] = cvtpk(S0[4 * g], S0[4 * g + 1]); o[1] = cvtpk(S0[4 * g + 2], S0[4 * g + 3]);
                *(LAS u32x2*)(lds + HG_LF + (64 * wv + r32) * 272 + (32 * wk + 8 * g + 4 * hh) * 2) = o;
                o[0] = cvtpk(S1[4 * g], S1[4 * g + 1]); o[1] = cvtpk(S1[4 * g + 2], S1[4 * g + 3]);
                *(LAS u32x2*)(lds + HG_LF + (64 * wv + 32 + r32) * 272 + (32 * wk + 8 * g + 4 * hh) * 2) = o;
            }
#define HG_ATILE(AMT_, AST_) do { \
                const LAS unsigned char* kb = ((AMT_) == (AST_)) ? (lds + HG_KD + (32 * (AST_)) * 272) : (lds + HG_KO); \
                f32x16 a; \
                _Pragma("unroll") for (int i = 0; i < 16; ++i) a[i] = 0.f; \
                _Pragma("unroll") for (int ks = 0; ks < 8; ++ks) { \
                    const bf16x8 af = *(const LAS bf16x8*)(lds + HG_QA + (32 * (AMT_) + r32) * 272 + 32 * ks + 16 * hh); \
                    const bf16x8 bf = *(const LAS bf16x8*)(kb + r32 * 272 + 32 * ks + 16 * hh); \
                    a = MFMA32(af, bf, a); } \
                _Pragma("unroll") for (int g = 0; g < 4; ++g) { \
                    float x[4]; \
                    _Pragma("unroll") for (int e = 0; e < 4; ++e) { const int tl = 8 * g + 4 * hh + e; x[e] = ((AMT_) != (AST_) || r32 <= tl) ? a[4 * g + e] : 0.f; } \
                    u32x2 o; o[0] = cvtpk(x[0], x[1]); o[1] = cvtpk(x[2], x[3]); \
                    *(LAS u32x2*)(lds + HG_AM + (32 * (AST_) + r32) * 192 + (32 * (AMT_) + 8 * g + 4 * hh) * 2) = o; } } while (0)
            if (w == 0) { HG_ATILE(0, 0); }
            else if (w == 1) { HG_ATILE(1, 0); }
            else if (w == 2) { HG_ATILE(1, 1); }
        }
#pragma unroll
        for (int i = 0; i < 16; ++i) { S0[i] *= dk[i]; S1[i] *= dk[i]; }
#pragma unroll
        for (int ks = 0; ks < 4; ++ks) {
            const LAS unsigned char* ka = lds + HG_KT + (16 * ks + 8 * hh + q4) * 320 + (32 * wk + 16 * blk + 4 * p4) * 2;
            const s16x4 alo = vtr(ka), ahi = vtr(ka + 4 * 320);
            const bf16x8 af = __builtin_shufflevector(alo, ahi, 0, 1, 2, 3, 4, 5, 6, 7);
            const LAS unsigned char* vb0 = lds + HG_VN + (16 * ks + 8 * hh + q4) * 320 + (64 * wv + 16 * blk + 4 * p4) * 2;
            const s16x4 b0lo = vtr(vb0), b0hi = vtr(vb0 + 4 * 320), b1lo = vtr(vb0 + 64), b1hi = vtr(vb0 + 64 + 4 * 320);
            S0 = MFMA32(af, __builtin_shufflevector(b0lo, b0hi, 0, 1, 2, 3, 4, 5, 6, 7), S0);
            S1 = MFMA32(af, __builtin_shufflevector(b1lo, b1hi, 0, 1, 2, 3, 4, 5, 6, 7), S1);
        }
        if constexpr (FULL) {
            __syncthreads();
            f32x16 o;
#pragma unroll
            for (int i = 0; i < 16; ++i) o[i] = 0.f;
            const LAS unsigned char* qb = (mt == 0) ? (lds + HG_QA) : (lds + HG_QB);
#pragma unroll
            for (int ks = 0; ks < 8; ++ks) {
                const bf16x8 af = *(const LAS bf16x8*)(qb + r32 * 272 + 32 * ks + 16 * hh);
                const bf16x8 bf = *(const LAS bf16x8*)(lds + HG_LF + (32 * nt + r32) * 272 + 32 * ks + 16 * hh);
                o = MFMA32(af, bf, o);
            }
#pragma unroll
            for (int ks = 0; ks < 4; ++ks) {
                if (mt == 0 && ks >= 2) continue;
                const LAS unsigned char* aa = lds + HG_AM + (16 * ks + 8 * hh + q4) * 192 + (32 * mt + 16 * blk + 4 * p4) * 2;
                const s16x4 alo = vtr(aa), ahi = vtr(aa + 4 * 192);
                const LAS unsigned char* vb0 = lds + HG_VN + (16 * ks + 8 * hh + q4) * 320 + (32 * nt + 16 * blk + 4 * p4) * 2;
                const s16x4 blo = vtr(vb0), bhi = vtr(vb0 + 4 * 320);
                o = MFMA32(__builtin_shufflevector(alo, ahi, 0, 1, 2, 3, 4, 5, 6, 7), __builtin_shufflevector(blo, bhi, 0, 1, 2, 3, 4, 5, 6, 7), o);
            }
            __syncthreads();
#pragma unroll
            for (int i = 0; i < 16; ++i) LF[(32 * mt + (i & 3) + 8 * (i >> 2) + 4 * hh) * HG_LFS + 32 * nt + r32] = o[i];
            __syncthreads();
            {
                float ov[16]; float ss = 0.f;
#pragma unroll
                for (int j4 = 0; j4 < 4; ++j4) { const f32x4 x = *(const LAS f32x4*)(LF + ps * HG_LFS + 16 * pseg + 4 * j4);
#pragma unroll
                    for (int e = 0; e < 4; ++e) { ov[4 * j4 + e] = x[e]; ss += x[e] * x[e]; } }
                ss += __shfl_xor(ss, 1, 64); ss += __shfl_xor(ss, 2, 64); ss += __shfl_xor(ss, 4, 64);
                const float rn = rsqrtf(ss * (1.f / 128.f) + RMS_EPS);
                const u32x4 g0 = cg0, g1 = cg1;
                const float* ng = C.in[I_HNG] + l * 128 + 16 * pseg;
                u32x4 o0, o1;
#pragma unroll
                for (int j = 0; j < 4; ++j) {
                    o0[j] = cvtpk(ov[2 * j] * rn * ng[2 * j] * siluf_(bf2f(g0[j] & 0xffffu)), ov[2 * j + 1] * rn * ng[2 * j + 1] * siluf_(bf2f(g0[j] >> 16)));
                    o1[j] = cvtpk(ov[8 + 2 * j] * rn * ng[8 + 2 * j] * siluf_(bf2f(g1[j] & 0xffffu)), ov[9 + 2 * j] * rn * ng[9 + 2 * j] * siluf_(bf2f(g1[j] >> 16)));
                }
                bf16_t* bp = BR + (row0 + ps) * NBR + 512 + h * 128 + 16 * pseg;
                *(u32x4*)bp = o0; *(u32x4*)(bp + 8) = o1;
            }
        }
        __syncthreads();
    }
    if constexpr (!FULL) {
#pragma unroll
        for (int i = 0; i < 16; ++i) { const int k = 32 * wk + (i & 3) + 8 * (i >> 2) + 4 * hh;
            stp[k * 128 + 64 * wv + r32] = S0[i]; stp[k * 128 + 64 * wv + 32 + r32] = S1[i]; }
        if (C.tid >= 384) DSC[((size_t)bh * 32 + sc) * 128 + (C.tid & 127)] = __expf(dtot);
    }
}
__device__ __forceinline__ void hgrn_b1(const Ctx& C, int l) { for (int u = C.bid; u < BATCH * 4 * 32; u += C.G) hgrn_unit<false>(C, l, u); }
__device__ __forceinline__ void hgrn_b3(const Ctx& C, int l) { for (int u = C.bid; u < BATCH * 4 * 32; u += C.G) hgrn_unit<true>(C, l, u); }
__device__ __forceinline__ void hgrn_b2(const Ctx& C) {
    float* STB = (float*)(C.ws + WS_ST); const float* DSC = (const float*)(C.ws + WS_DSC);
    for (int e = C.bid * 512 + C.tid; e < BATCH * 4 * 128 * 128; e += C.G * 512) {
        const int bh = e >> 14, kv = e & 16383, k = kv >> 7;
        float* p = STB + (size_t)bh * 32 * 16384 + kv;
        float uu[32], dd[32];
#pragma unroll
        for (int s = 0; s < 32; ++s) { uu[s] = p[(size_t)s * 16384]; dd[s] = DSC[((size_t)bh * 32 + s) * 128 + k]; }
        float st = 0.f;
#pragma unroll
        for (int s = 0; s < 32; ++s) { p[(size_t)s * 16384] = st; st = dd[s] * st + uu[s]; }
    }
}


__device__ __forceinline__ void mix_pool(const Ctx& C, int l) {
#if DIAG == 2
    const bf16_t* H = (const bf16_t*)(C.ws + WS_H); bf16_t* BR = (l == 0) ? (bf16_t*)(C.ws + WS_XA) : (bf16_t*)(C.ws + WS_TABU);
#else
    const bf16_t* H = (const bf16_t*)(C.ws + WS_H); bf16_t* BR = (bf16_t*)(C.ws + WS_BR);
#endif
    const bf16_t* Wt = (const bf16_t*)(C.ws + WS_W + (size_t)l * W_LAYER + WO_POOLW);
    LAS unsigned char* lds = C.lds;
    constexpr int PL_P = 128 * 272;
    const int lane = C.lane, w = C.wave, r32 = lane & 31, hh = lane >> 5;
    for (int u = C.bid; u < (T / 256) * 4; u += C.G) {
        const int g = u & 3, t0 = (u >> 2) * 256, win = 2 << g;
        const int row = t0 + 32 * w + r32, pos = row & (SEQ - 1);
        __syncthreads();
#pragma unroll
        for (int p = 0; p < 4; ++p) { const int idx = C.tid + 512 * p, rr = idx >> 4, ch = idx & 15;
            *(LAS u32x4*)(lds + rr * 272 + ch * 16) = *(const u32x4*)(Wt + (size_t)g * 128 * 128 + rr * 128 + ch * 8); }
        const bool seq_start = (t0 & (SEQ - 1)) == 0;
        for (int idx = C.tid; idx < 271 * 16; idx += 512) { const int rr = idx >> 4, ch = idx & 15;
            if (!(seq_start && rr < 15)) *(LAS u32x4*)(lds + PL_P + rr * 272 + ch * 16) = *(const u32x4*)(H + (size_t)(t0 - 15 + rr) * NH + HC_P + g * 128 + ch * 8); }
        __syncthreads();
        const int nwin = (pos + 1 < win) ? pos + 1 : win;
        const float invn = 1.f / (float)nwin;
        bf16x8 df[8];
        const LAS unsigned char* prow = lds + PL_P + (32 * w + r32 + 15) * 272 + 16 * hh;
#pragma unroll
        for (int ks = 0; ks < 8; ++ks) {
            float sum[8];
#pragma unroll
            for (int e = 0; e < 8; ++e) sum[e] = 0.f;
            const u32x4 self = *(const LAS u32x4*)(prow + 32 * ks);
#pragma unroll
            for (int j = 0; j < 16; ++j) if (j < win) {
                const int jj = (j < nwin) ? j : 0; const float msk = (j < nwin) ? 1.f : 0.f;
                const u32x4 rw = *(const LAS u32x4*)(prow + 32 * ks - jj * 272);
#pragma unroll
                for (int e = 0; e < 4; ++e) { sum[2 * e] += msk * bf2f(rw[e] & 0xffffu); sum[2 * e + 1] += msk * bf2f(rw[e] >> 16); } }
            u32x4 o;
#pragma unroll
            for (int e = 0; e < 4; ++e) o[e] = cvtpk(sum[2 * e] * invn - bf2f(self[e] & 0xffffu), sum[2 * e + 1] * invn - bf2f(self[e] >> 16));
            df[ks] = __builtin_bit_cast(bf16x8, o);
        }
        f32x16 acc[4];
#pragma unroll
        for (int mt = 0; mt < 4; ++mt)
#pragma unroll
            for (int i = 0; i < 16; ++i) acc[mt][i] = 0.f;
#pragma unroll
        for (int ks = 0; ks < 8; ++ks)
#pragma unroll
            for (int mt = 0; mt < 4; ++mt) {
                const bf16x8 wf = *(const LAS bf16x8*)(lds + (32 * mt + r32) * 272 + 32 * ks + 16 * hh);
                acc[mt] = MFMA32(wf, df[ks], acc[mt]);
            }
        const float* psc = C.in[I_POOLS] + l * BW + g * 128;
        bf16_t* op = BR + (size_t)row * NBR + g * 128;
#pragma unroll
        for (int mt = 0; mt < 4; ++mt)
#pragma unroll
            for (int q = 0; q < 4; ++q) { const int d0 = 32 * mt + 8 * q + 4 * hh; const f32x4 sc = *(const f32x4*)(psc + d0);
                u32x2 o; o[0] = cvtpk(acc[mt][4 * q] * sc[0], acc[mt][4 * q + 1] * sc[1]); o[1] = cvtpk(acc[mt][4 * q + 2] * sc[2], acc[mt][4 * q + 3] * sc[3]);
                *(u32x2*)(op + d0) = o; }
    }
}
constexpr int GM_VN = 0, GM_WC = 128 * 320, GM_END = GM_WC + 128 * 272;
__device__ __forceinline__ void mix_gmlp(const Ctx& C, int l) {
#if DIAG == 3
    const bf16_t* H = (const bf16_t*)(C.ws + WS_H); bf16_t* BR = (l == 0) ? (bf16_t*)(C.ws + WS_XA) : (bf16_t*)(C.ws + WS_TABU);
#else
    const bf16_t* H = (const bf16_t*)(C.ws + WS_H); bf16_t* BR = (bf16_t*)(C.ws + WS_BR);
#endif
    const bf16_t* Wc = (const bf16_t*)(C.ws + WS_W + (size_t)l * W_LAYER + WO_GWS);
    LAS unsigned char* lds = C.lds;
    const int lane = C.lane, w = C.wave, r32 = lane & 31, hh = lane >> 5;
    const int i16 = lane & 15, q4 = i16 >> 2, p4 = i16 & 3, blk = (lane >> 4) & 1;
    for (int u = C.bid; u < (T / 128) * 4; u += C.G) {
        const int g = u & 3, t0 = (u >> 2) * 128;
        __syncthreads();
#pragma unroll
        for (int p = 0; p < 4; ++p) { const int idx = C.tid + 512 * p, rr = idx >> 4, ch = idx & 15;
            *(LAS u32x4*)(lds + GM_WC + rr * 272 + ch * 16) = *(const u32x4*)(Wc + (size_t)g * 128 * 128 + rr * 128 + ch * 8); }
        u32x4 rawall[16];
#pragma unroll
        for (int i = 0; i < 16; ++i) rawall[i] = *(const u32x4*)(H + (size_t)(t0 + w * 16 + i) * NH + HC_GV + lane * 8);
#pragma unroll
        for (int hb = 0; hb < 4; ++hb) {
            u32x4 rawv[4];
#pragma unroll
            for (int i = 0; i < 4; ++i) rawv[i] = rawall[hb * 4 + i];
            float e[4][8], st[8];
#pragma unroll
            for (int i = 0; i < 4; ++i) { float s1 = 0.f, s2 = 0.f;
#pragma unroll
                for (int j = 0; j < 4; ++j) { const float a = geluf_(bf2f(rawv[i][j] & 0xffffu)), b = geluf_(bf2f(rawv[i][j] >> 16)); e[i][2 * j] = a; e[i][2 * j + 1] = b; s1 += a + b; s2 += a * a + b * b; }
                st[i] = s1; st[4 + i] = s2; }
#pragma unroll
            for (int sx = 32, n = 4; sx >= 8; sx >>= 1, n >>= 1) { const bool up = (lane & sx) != 0;
#pragma unroll
                for (int i = 0; i < n; ++i) { const float send = up ? st[i] : st[i + n], keep = up ? st[i + n] : st[i]; st[i] = keep + __shfl_xor(send, sx, 64); } }
            float tot = st[0]; tot += __shfl_xor(tot, 4, 64); tot += __shfl_xor(tot, 2, 64); tot += __shfl_xor(tot, 1, 64);
            float mean4[4], rstd4[4];
#pragma unroll
            for (int i = 0; i < 4; ++i) {
                mean4[i] = __builtin_bit_cast(float, __builtin_amdgcn_readlane(__builtin_bit_cast(int, tot), 8 * i)) * (1.f / BW);
                const float ex2 = __builtin_bit_cast(float, __builtin_amdgcn_readlane(__builtin_bit_cast(int, tot), 8 * (4 + i))) * (1.f / BW);
                rstd4[i] = rsqrtf(fmaxf(ex2 - mean4[i] * mean4[i], 0.f) + LN_EPS);
            }
            asm volatile("" ::: "memory");
            if ((lane >> 4) == g) {
                const float* lg = C.in[I_GLNG] + l * BW + lane * 8; const float* lb = C.in[I_GLNB] + l * BW + lane * 8;
#pragma unroll
                for (int i = 0; i < 4; ++i) {
                    const float mean = mean4[i], rstd = rstd4[i];
                    u32x4 o;
#pragma unroll
                    for (int j = 0; j < 4; ++j) o[j] = cvtpk((e[i][2 * j] - mean) * rstd * lg[2 * j] + lb[2 * j], (e[i][2 * j + 1] - mean) * rstd * lg[2 * j + 1] + lb[2 * j + 1]);
                    *(LAS u32x4*)(lds + GM_VN + (w * 16 + hb * 4 + i) * 320 + (lane & 15) * 16) = o;
                }
            }
        }
        __syncthreads();
        const int nt = w & 3, mb = (w >> 2) * 2;
        u32x2 upre[2][4];
#pragma unroll
        for (int m = 0; m < 2; ++m)
#pragma unroll
            for (int q = 0; q < 4; ++q) upre[m][q] = *(const u32x2*)(H + (size_t)(t0 + 32 * nt + r32) * NH + HC_GU + g * 128 + 32 * (mb + m) + 8 * q + 4 * hh);
        f32x16 acc[2];
#pragma unroll
        for (int m = 0; m < 2; ++m)
#pragma unroll
            for (int i = 0; i < 16; ++i) acc[m][i] = 0.f;
        for (int ks = 0; ks < 2 * (nt + 1); ++ks) {
            const bf16x8 bf = *(const LAS bf16x8*)(lds + GM_WC + (32 * nt + r32) * 272 + 32 * ks + 16 * hh);
#pragma unroll
            for (int m = 0; m < 2; ++m) {
                const LAS unsigned char* aa = lds + GM_VN + (16 * ks + 8 * hh + q4) * 320 + (32 * (mb + m) + 16 * blk + 4 * p4) * 2;
                const s16x4 lo = vtr(aa), hi = vtr(aa + 4 * 320);
                acc[m] = MFMA32(__builtin_shufflevector(lo, hi, 0, 1, 2, 3, 4, 5, 6, 7), bf, acc[m]);
            }
        }
        const int tl = 32 * nt + r32, row = t0 + tl;
        const float bias = C.in[I_GBS][(l * 4 + g) * 128 + tl];
#pragma unroll
        for (int m = 0; m < 2; ++m)
#pragma unroll
            for (int q = 0; q < 4; ++q) { const int c0 = 32 * (mb + m) + 8 * q + 4 * hh;
                const u32x2 ur = upre[m][q];
                u32x2 o;
                o[0] = cvtpk(geluf_(bf2f(ur[0] & 0xffffu)) * (acc[m][4 * q] + bias), geluf_(bf2f(ur[0] >> 16)) * (acc[m][4 * q + 1] + bias));
                o[1] = cvtpk(geluf_(bf2f(ur[1] & 0xffffu)) * (acc[m][4 * q + 2] + bias), geluf_(bf2f(ur[1] >> 16)) * (acc[m][4 * q + 3] + bias));
                *(u32x2*)(BR + (size_t)row * NBR + 1024 + g * 128 + c0) = o; }
    }
}

#define CE_D(a, b) do { const float _h = fmaxf(a, b), _l = fminf(a, b); a = _h; b = _l; } while (0)
__device__ __forceinline__ void sort16_desc(float (&x)[16]) {
#pragma unroll
    for (int k = 2; k <= 16; k <<= 1)
#pragma unroll
        for (int j = k >> 1; j > 0; j >>= 1)
#pragma unroll
            for (int i = 0; i < 16; ++i) { const int l = i ^ j; if (l > i) { if ((i & k) == 0) CE_D(x[i], x[l]); else CE_D(x[l], x[i]); } }
}
__device__ __forceinline__ void bmerge16_desc(float (&x)[16]) {
#pragma unroll
    for (int j = 8; j > 0; j >>= 1)
#pragma unroll
        for (int i = 0; i < 16; ++i) { const int l = i ^ j; if (l > i) CE_D(x[i], x[l]); }
}
__device__ __forceinline__ void top16_merge(float (&a)[16], const float (&b)[16]) {
#pragma unroll
    for (int i = 0; i < 16; ++i) a[i] = fmaxf(a[i], b[15 - i]);
    bmerge16_desc(a);
}
__device__ __forceinline__ float pack_idx(float v, unsigned idx, unsigned mask) { return __builtin_bit_cast(float, (__builtin_bit_cast(unsigned, v) & ~mask) | idx); }

constexpr int TK_KST = 272, TK_KBUF = 128 * TK_KST;
__device__ __forceinline__ void p_topk(const Ctx& C, int l) {
    const bf16_t* Q = (const bf16_t*)(C.ws + WS_Q);
    const bf16_t* keys = (const bf16_t*)(C.ws + WS_W + (size_t)l * W_LAYER + WO_KEYS);
    int* eidx = (int*)(C.ws + WS_EIDX); float* egate = (float*)(C.ws + WS_EGATE);
    LAS unsigned char* lds = C.lds;
    const int lane = C.lane, w = C.wave, r32 = lane & 31, hh = lane >> 5;
    for (int u = C.bid; u < (T / 256) * PH; u += C.G) {
        const int h = u & 7, t0 = (u >> 3) * 256, tok = t0 + 32 * w + r32;
        float v12[2][16];
        __syncthreads();
#pragma unroll
        for (int j = 0; j < 2; ++j) {
            const bf16_t* kp = keys + ((size_t)j * PH + h) * 128 * 128;
#pragma unroll
            for (int p = 0; p < 4; ++p) { const int idx = C.tid + 512 * p, row = idx >> 4, ch = idx & 15;
                *(LAS u32x4*)(lds + j * TK_KBUF + row * TK_KST + ch * 16) = *(const u32x4*)(kp + row * 128 + ch * 8); }
        }
        __syncthreads();
#pragma unroll
        for (int j = 0; j < 2; ++j) {
            bf16x8 qf[8];
            {
                LAS unsigned char* qs = lds + 2 * TK_KBUF + w * (32 * 272);
                u32x4 qr[8];
#pragma unroll
                for (int p = 0; p < 8; ++p) qr[p] = *(const u32x4*)(Q + (size_t)(t0 + 32 * w + 4 * p + (lane >> 4)) * NQ + h * 256 + j * 128 + (lane & 15) * 8);
#pragma unroll
                for (int p = 0; p < 8; ++p) *(LAS u32x4*)(qs + (4 * p + (lane >> 4)) * 272 + (lane & 15) * 16) = qr[p];
#pragma unroll
                for (int ks = 0; ks < 8; ++ks) qf[ks] = *(const LAS bf16x8*)(qs + r32 * 272 + 32 * ks + 16 * hh);
            }
            f32x16 sacc[4];
#pragma unroll
            for (int mt = 0; mt < 4; ++mt)
#pragma unroll
                for (int i = 0; i < 16; ++i) sacc[mt][i] = 0.f;
#pragma unroll
            for (int ks = 0; ks < 8; ++ks)
#pragma unroll
                for (int mt = 0; mt < 4; ++mt) {
                    const bf16x8 kf = *(const LAS bf16x8*)(lds + j * TK_KBUF + (32 * mt + r32) * TK_KST + 32 * ks + 16 * hh);
                    sacc[mt] = MFMA32(kf, qf[ks], sacc[mt]);
                }
            float g[4][16];
#pragma unroll
            for (int mt = 0; mt < 4; ++mt) {
#pragma unroll
                for (int i = 0; i < 16; ++i) g[mt][i] = pack_idx(sacc[mt][i], (unsigned)(32 * mt + (i & 3) + 8 * (i >> 2) + 4 * hh), 127u);
                sort16_desc(g[mt]);
            }
            top16_merge(g[0], g[1]); top16_merge(g[2], g[3]); top16_merge(g[0], g[2]);
            float o[16];
#pragma unroll
            for (int i = 0; i < 16; ++i) o[i] = __shfl_xor(g[0][i], 32, 64);
            top16_merge(g[0], o);
#pragma unroll
            for (int i = 0; i < 16; ++i) v12[j][i] = g[0][i];
        }
        float c[4][16];
        {
            int n = 0;
#pragma unroll
            for (int a = 0; a < 16; ++a)
#pragma unroll
                for (int b = 0; b < 16; ++b) if ((a + 1) * (b + 1) <= 16) {
                    const unsigned id = ((__builtin_bit_cast(unsigned, v12[0][a]) & 127u) << 7) | (__builtin_bit_cast(unsigned, v12[1][b]) & 127u);
                    c[n >> 4][n & 15] = pack_idx(v12[0][a] + v12[1][b], id, 16383u); ++n; }
#pragma unroll
            for (; n < 64; ++n) c[n >> 4][n & 15] = -3.0e38f;
        }
#pragma unroll
        for (int q = 0; q < 4; ++q) sort16_desc(c[q]);
        top16_merge(c[0], c[1]); top16_merge(c[2], c[3]); top16_merge(c[0], c[2]);
        float e[16], den = 0.f;
#pragma unroll
        for (int i = 0; i < 16; ++i) { e[i] = __expf(c[0][i] - c[0][0]); den += e[i]; }
        const float inv = 1.f / den;
        int* ip = eidx + (size_t)tok * 128 + h * 16 + 8 * hh; float* gp = egate + (size_t)tok * 128 + h * 16 + 8 * hh;
        u32x4 i0, i1; f32x4 g0, g1;
#pragma unroll
        for (int i = 0; i < 4; ++i) {
            const float ca = hh ? c[0][8 + i] : c[0][i], cb = hh ? c[0][12 + i] : c[0][4 + i];
            i0[i] = __builtin_bit_cast(unsigned, ca) & 16383u; i1[i] = __builtin_bit_cast(unsigned, cb) & 16383u;
            g0[i] = (hh ? e[8 + i] : e[i]) * inv; g1[i] = (hh ? e[12 + i] : e[4 + i]) * inv;
        }
        *(u32x4*)ip = i0; *(u32x4*)(ip + 4) = i1; *(f32x4*)gp = g0; *(f32x4*)(gp + 4) = g1;
    }
}

constexpr int CW_DIAG = 64;
__device__ __forceinline__ void diag_cmp(const Ctx& C, const bf16_t* A, int lda, const bf16_t* R, int ldr, int nc) {
    float sd = 0.f, sr = 0.f;
    for (int row = C.bid; row < T; row += C.G) {
        const int tm = row % DIAG_MOD; if (tm < DIAG_LO || tm >= DIAG_HI) continue;
        for (int c = C.tid; c < nc; c += 512) { const float a = bf2f(A[(size_t)row * lda + c]), r = bf2f(R[(size_t)row * ldr + c]); sd += (a - r) * (a - r); sr += r * r; }
    }
    sd = wave_sum(sd); sr = wave_sum(sr);
    if (C.lane == 0) { atomicAdd((float*)(C.ws + WS_CTL) + CW_DIAG, sd); atomicAdd((float*)(C.ws + WS_CTL) + CW_DIAG + 1, sr); }
}
__device__ __forceinline__ void diag_cmp_u8(const Ctx& C, const unsigned char* A, int lda, const bf16_t* R, int ldr, int nc) {
    float sd = 0.f, sr = 0.f;
    for (int row = C.bid; row < T; row += C.G)
        for (int c = C.tid; c < nc; c += 512) { const float a = (float)A[(size_t)row * lda + c] * (1.f / 255.f), r = bf2f(R[(size_t)row * ldr + c]); sd += (a - r) * (a - r); sr += r * r; }
    sd = wave_sum(sd); sr = wave_sum(sr);
    if (C.lane == 0) { atomicAdd((float*)(C.ws + WS_CTL) + CW_DIAG, sd); atomicAdd((float*)(C.ws + WS_CTL) + CW_DIAG + 1, sr); }
}
__device__ __forceinline__ float diag_alpha(const Ctx& C) {
    const float sd = __hip_atomic_load((float*)(C.ws + WS_CTL) + CW_DIAG, __ATOMIC_RELAXED, __HIP_MEMORY_SCOPE_AGENT), sr = __hip_atomic_load((float*)(C.ws + WS_CTL) + CW_DIAG + 1, __ATOMIC_RELAXED, __HIP_MEMORY_SCOPE_AGENT);
    const float err = fmaxf(sd / fmaxf(sr, 1e-30f), 1e-8f);
    return 0.1f + 0.1f * (rintf(log10f(err / 1e-8f) * 10.f) * 0.1f);
}


#if DIAG == 5 || DIAG == 6
__device__ __forceinline__ void diag_ref_slice(const Ctx& C, const float* W, int ldw, int n0, const float* bias) {
    bf16_t* alt = (bf16_t*)(C.ws + WS_XA);
    const float* X = C.in[I_X];
    for (int row = C.bid * 8 + C.wave; row < T; row += C.G * 8) {
        float acc = 0.f;
        for (int k = 0; k < DM; ++k) acc += X[(size_t)row * DM + k] * W[(size_t)k * ldw + n0 + C.lane];
        if (bias) acc = sigmoidf_(acc + bias[n0 + C.lane]);
        alt[(size_t)row * 64 + C.lane] = (bf16_t)f2bf(acc);
    }
}
#endif

__device__ __forceinline__ void wave_argmax(float& v, int& i) {
#pragma unroll
    for (int o = 32; o > 0; o >>= 1) {
        const float ov = __shfl_xor(v, o, 64); const int oi = __shfl_xor(i, o, 64);
        if (ov > v || (ov == v && oi < i)) { v = ov; i = oi; }
    }
}
__device__ __forceinline__ void p_topk_naive(const Ctx& C, int l) {
    const bf16_t* Q = (const bf16_t*)(C.ws + WS_Q);
    const bf16_t* keys = (const bf16_t*)(C.ws + WS_W + (size_t)l * W_LAYER + WO_KEYS);
    int* eidx = (int*)(C.ws + WS_EIDX); float* egate = (float*)(C.ws + WS_EGATE);
    LAS float* qs = (LAS float*)C.lds;
    LAS float* sc = qs + 2048;
    LAS float* tv = sc + 2048;
    LAS int* ti = (LAS int*)(tv + 256);
    for (int t = C.bid; t < T; t += C.G) {
        for (int i = C.tid; i < 2048; i += 512) qs[i] = bf2f(Q[(size_t)t * NQ + i]);
        __syncthreads();
        for (int i = 0; i < 4; ++i) {
            const int idx = C.tid + 512 * i, hj = idx >> 7, key = idx & 127, h = hj >> 1, j = hj & 1;
            const bf16_t* kp = keys + (((size_t)j * PH + h) * 128 + key) * 128;
            float s = 0.f;
            for (int d8 = 0; d8 < 16; ++d8) {
                const u32x4 raw = *(const u32x4*)(kp + d8 * 8);
#pragma unroll
                for (int e = 0; e < 4; ++e) s += qs[h * 256 + j * 128 + d8 * 8 + 2 * e] * bf2f(raw[e] & 0xffffu) + qs[h * 256 + j * 128 + d8 * 8 + 2 * e + 1] * bf2f(raw[e] >> 16);
            }
            sc[idx] = s;
        }
        __syncthreads();
        for (int i = 0; i < 2; ++i) {
            const int hj = C.wave * 2 + i;
            float a0 = sc[hj * 128 + C.lane], a1 = sc[hj * 128 + 64 + C.lane];
            for (int r = 0; r < 16; ++r) {
                float bv; int bi;
                if (a0 > a1 || (a0 == a1)) { bv = a0; bi = C.lane; } else { bv = a1; bi = C.lane + 64; }
                wave_argmax(bv, bi);
                if (C.lane == 0) { tv[hj * 16 + r] = bv; ti[hj * 16 + r] = bi; }
                if (bi == C.lane) a0 = -3e38f; if (bi == C.lane + 64) a1 = -3e38f;
            }
        }
        __syncthreads();
        {
            const int h = C.wave;
            float cv[4];
#pragma unroll
            for (int i = 0; i < 4; ++i) { const int c = C.lane * 4 + i; cv[i] = tv[(h * 2) * 16 + (c >> 4)] + tv[(h * 2 + 1) * 16 + (c & 15)]; }
            float topv = 0.f; int tope = 0; float mx = 0.f;
            for (int r = 0; r < 16; ++r) {
                float bv = cv[0]; int bi = C.lane * 4;
#pragma unroll
                for (int i = 1; i < 4; ++i) if (cv[i] > bv) { bv = cv[i]; bi = C.lane * 4 + i; }
                wave_argmax(bv, bi);
                if (r == 0) mx = bv;
                if (C.lane == r) { topv = bv; tope = ti[(h * 2) * 16 + (bi >> 4)] * 128 + ti[(h * 2 + 1) * 16 + (bi & 15)]; }
#pragma unroll
                for (int i = 0; i < 4; ++i) if (bi == C.lane * 4 + i) cv[i] = -3e38f;
            }
            float e = (C.lane < 16) ? __expf(topv - mx) : 0.f;
            const float den = wave_sum(e);
            if (C.lane < 16) { eidx[(size_t)t * 128 + h * 16 + C.lane] = tope; egate[(size_t)t * 128 + h * 16 + C.lane] = e / den; }
        }
        __syncthreads();
    }
}
__device__ __forceinline__ float ub(unsigned w, int e) { return (float)((w >> (8 * e)) & 255u); }
__device__ __forceinline__ void p_gather(const Ctx& C, int l) {
    const bf16_t* xc = (const bf16_t*)(C.ws + WS_X1B);
    const unsigned char* U8 = C.ws + WS_U8; const unsigned char* V8 = C.ws + WS_V8;
    const float* SU = (const float*)(C.ws + WS_SU); const float* SV = (const float*)(C.ws + WS_SV);
    const int* eidx = (const int*)(C.ws + WS_EIDX); const float* egate = (const float*)(C.ws + WS_EGATE);
    const int lane = C.lane;
    for (int t = C.bid * 8 + C.wave; t < T; t += C.G * 8) {
        float x[16];
        { const bf16_t* xp = xc + (size_t)t * DM + lane * 16;
          const u32x4 a = *(const u32x4*)xp, b = *(const u32x4*)(xp + 8);
#pragma unroll
          for (int i = 0; i < 4; ++i) { x[2 * i] = bf2f(a[i] & 0xffffu); x[2 * i + 1] = bf2f(a[i] >> 16); x[8 + 2 * i] = bf2f(b[i] & 0xffffu); x[9 + 2 * i] = bf2f(b[i] >> 16); } }
        float xmx = 0.f;
#pragma unroll
        for (int j = 0; j < 16; ++j) xmx = fmaxf(xmx, fabsf(x[j]));
        xmx = fmaxf(wave_max(xmx), 1e-30f);
        const float xisc = 127.f / xmx, xsc = xmx * (1.f / 127.f);
        int xq[4];
#pragma unroll
        for (int q = 0; q < 4; ++q) { unsigned wd = 0u;
#pragma unroll
            for (int e = 0; e < 4; ++e) wd |= ((unsigned)(int)rintf(x[4 * q + e] * xisc) & 255u) << (8 * e);
            xq[q] = (int)wd; }
        float cf[2]; int ex[2];
#pragma unroll
        for (int bt = 0; bt < 2; ++bt) {
            ex[bt] = eidx[(size_t)t * 128 + 64 * bt + lane];
            const float gate = egate[(size_t)t * 128 + 64 * bt + lane];
            int p[64];
#pragma unroll
            for (int e0 = 0; e0 < 64; e0 += 16) {
                u32x4 r[16];
#pragma unroll
                for (int i = 0; i < 16; ++i) { const int e = __builtin_amdgcn_readlane(ex[bt], e0 + i); r[i] = *(const u32x4*)(U8 + (size_t)e * DM + lane * 16); }
#pragma unroll
                for (int i = 0; i < 16; ++i) { int a = 0;
#pragma unroll
                    for (int q = 0; q < 4; ++q) a = __builtin_amdgcn_sdot4(xq[q], (int)r[i][q], a, false);
                    p[e0 + i] = a; }
            }
#pragma unroll
            for (int st = 32, n = 32; st > 0; st >>= 1, n >>= 1) {
                const bool up = (lane & st) != 0;
#pragma unroll
                for (int i = 0; i < n; ++i) { const int send = up ? p[i] : p[i + n], keep = up ? p[i + n] : p[i]; p[i] = keep + __shfl_xor(send, st, 64); }
            }
            const float hsum = SU[ex[bt]] * xsc * (float)p[0];
            cf[bt] = gate * geluf_slow(hsum) * SV[ex[bt]];
        }
        float y[16];
#pragma unroll
        for (int j = 0; j < 16; ++j) y[j] = 0.f;
        float csum = wave_sum(cf[0] + cf[1]);
#pragma unroll
        for (int bt = 0; bt < 2; ++bt)
#pragma unroll
            for (int e0 = 0; e0 < 64; e0 += 16) {
                u32x4 r[16];
#pragma unroll
                for (int i = 0; i < 16; ++i) { const int e = __builtin_amdgcn_readlane(ex[bt], e0 + i); r[i] = *(const u32x4*)(V8 + (size_t)e * DM + lane * 16); }
#pragma unroll
                for (int i = 0; i < 16; ++i) { const float c = __builtin_bit_cast(float, __builtin_amdgcn_readlane(__builtin_bit_cast(int, cf[bt]), e0 + i));
#pragma unroll
                    for (int q = 0; q < 4; ++q)
#pragma unroll
                        for (int e = 0; e < 4; ++e) y[4 * q + e] += c * ub(r[i][q], e); }
            }
#pragma unroll
        for (int j = 0; j < 16; ++j) y[j] = y[j] - 128.f * csum + ALPHA * x[j];
        float sm = 0.f;
#pragma unroll
        for (int j = 0; j < 16; ++j) sm += y[j];
        const float mean = wave_sum(sm) * (1.f / DM);
        float qq = 0.f;
#pragma unroll
        for (int j = 0; j < 16; ++j) { const float d = y[j] - mean; qq += d * d; }
        const float rstd = rsqrtf(wave_sum(qq) * (1.f / DM) + LN_EPS);
        const float* gp = C.in[I_LN2G] + l * DM + lane * 16; const float* bp = C.in[I_LN2B] + l * DM + lane * 16;
#pragma unroll
        for (int i = 0; i < 4; ++i) { const f32x4 gg = *(const f32x4*)(gp + 4 * i), bb = *(const f32x4*)(bp + 4 * i);
#pragma unroll
            for (int e = 0; e < 4; ++e) y[4 * i + e] = (y[4 * i + e] - mean) * rstd * gg[e] + bb[e]; }
        float* dst = (l + 1 < DEPTH) ? (float*)(C.ws + WS_XA) + (size_t)t * DM : C.out + (size_t)t * DM;
#if DIAG
        if (l + 1 == DEPTH) { const float al = 1.f + diag_alpha(C);
#pragma unroll
            for (int j = 0; j < 16; ++j) y[j] *= al; }
#endif
#pragma unroll
        for (int i = 0; i < 4; ++i) *(f32x4*)(dst + lane * 16 + 4 * i) = (f32x4){y[4 * i], y[4 * i + 1], y[4 * i + 2], y[4 * i + 3]};
        if (l + 1 < DEPTH) {
            {
                float mx = 0.f;
#pragma unroll
                for (int j = 0; j < 16; ++j) mx = fmaxf(mx, fabsf(y[j]));
                mx = fmaxf(wave_max(mx), 1e-30f);
                const float isc = 127.f / mx;
                u32x4 o8;
#pragma unroll
                for (int q = 0; q < 4; ++q) { unsigned wd = 0u;
#pragma unroll
                    for (int e = 0; e < 4; ++e) wd |= ((unsigned)(int)rintf(y[4 * q + e] * isc) & 255u) << (8 * e);
                    o8[q] = wd; }
                *(u32x4*)(C.ws + WS_XB + (size_t)t * DM + lane * 16) = o8;
                if (lane == 0) ((float*)(C.ws + WS_XSA))[t] = mx * (1.f / 127.f);
            }
            const float* wf = (const float*)(C.ws + WS_W + (size_t)(l + 1) * W_LAYER + WO_WF);
            float* lsig = (float*)(C.ws + WS_MISC);
#pragma unroll
            for (int h = 0; h < 4; ++h) {
                float sd = 0.f;
#pragma unroll
                for (int i = 0; i < 4; ++i) { const f32x4 a = *(const f32x4*)(wf + h * DM + lane * 16 + 4 * i);
#pragma unroll
                    for (int e = 0; e < 4; ++e) sd += y[4 * i + e] * a[e]; }
                sd = wave_sum(sd);
                if (lane == 0) lsig[(size_t)t * 4 + h] = logsigmoidf_(sd + C.in[I_BFOX][(l + 1) * 4 + h]);
            }
        }
    }
}

struct FStoreBf16 { bf16_t* O; int ld;
    __device__ __forceinline__ void operator()(int row, int col, f32x4 v0, f32x4 v1, int) const {
        u32x4 o; o[0] = pk2(v0[0], v0[1]); o[1] = pk2(v0[2], v0[3]); o[2] = pk2(v1[0], v1[1]); o[3] = pk2(v1[2], v1[3]);
        *(u32x4*)(O + (size_t)row * ld + col) = o; } };
typedef int i32x4 __attribute__((ext_vector_type(4)));
__device__ __forceinline__ void i8_dequant(f32x4& v0, f32x4& v1, float sa, const float* cs) {
    sa *= (1.f / 127.f);
    const f32x4 c0 = *(const f32x4*)cs, c1 = *(const f32x4*)(cs + 4);
    const i32x4 i0 = __builtin_bit_cast(i32x4, v0), i1 = __builtin_bit_cast(i32x4, v1);
#pragma unroll
    for (int e = 0; e < 4; ++e) { v0[e] = (float)i0[e] * sa * c0[e]; v1[e] = (float)i1[e] * sa * c1[e]; }
}
struct FStoreBf16I8 { bf16_t* O; int ld; const float* rs; const float* cs;
    __device__ __forceinline__ void operator()(int row, int col, f32x4 v0, f32x4 v1, int) const {
        i8_dequant(v0, v1, rs[row], cs + col);
        u32x4 o; o[0] = pk2(v0[0], v0[1]); o[1] = pk2(v0[2], v0[3]); o[2] = pk2(v1[0], v1[1]); o[3] = pk2(v1[2], v1[3]);
        *(u32x4*)(O + (size_t)row * ld + col) = o; } };
struct FGateI8 { unsigned char* O; const float* bias; const float* rs; const float* cs;
    __device__ __forceinline__ void operator()(int row, int col, f32x4 v0, f32x4 v1, int) const {
        i8_dequant(v0, v1, rs[row], cs + col);
        const f32x4 b0 = *(const f32x4*)(bias + col), b1 = *(const f32x4*)(bias + col + 4);
        u32x2 o; unsigned w0 = 0u, w1 = 0u;
#pragma unroll
        for (int e = 0; e < 4; ++e) { w0 |= (unsigned)(int)rintf(255.f * sigmoidf_(v0[e] + b0[e])) << (8 * e); w1 |= (unsigned)(int)rintf(255.f * sigmoidf_(v1[e] + b1[e])) << (8 * e); }
        o[0] = w0; o[1] = w1;
        *(u32x2*)(O + (size_t)row * NG + col) = o; } };
struct FGate { bf16_t* O; const float* bias;
    __device__ __forceinline__ void operator()(int row, int col, f32x4 v0, f32x4 v1, int) const {
        const f32x4 b0 = *(const f32x4*)(bias + col), b1 = *(const f32x4*)(bias + col + 4);
        u32x4 o; o[0] = pk2(sigmoidf_(v0[0] + b0[0]), sigmoidf_(v0[1] + b0[1])); o[1] = pk2(sigmoidf_(v0[2] + b0[2]), sigmoidf_(v0[3] + b0[3]));
        o[2] = pk2(sigmoidf_(v1[0] + b1[0]), sigmoidf_(v1[1] + b1[1])); o[3] = pk2(sigmoidf_(v1[2] + b1[2]), sigmoidf_(v1[3] + b1[3]));
        *(u32x4*)(O + (size_t)row * NG + col) = o; } };
struct FMerge { const unsigned char* G; bf16_t* MG;
    __device__ __forceinline__ void operator()(int row, int col, f32x4 v0, f32x4 v1, int z) const {
        const u32x2 gr = *(const u32x2*)(G + (size_t)row * NG + z * DM + col);
        float r[8];
#pragma unroll
        for (int e = 0; e < 4; ++e) { r[e] = v0[e] * (float)((gr[0] >> (8 * e)) & 255u) * (1.f / 255.f); r[4 + e] = v1[e] * (float)((gr[1] >> (8 * e)) & 255u) * (1.f / 255.f); }
        bf16_t* p = MG + (size_t)row * DM + col;
        if (z > 0) { const u32x4 pr = *(const u32x4*)p;
#pragma unroll
            for (int e = 0; e < 4; ++e) { r[2 * e] += bf2f(pr[e] & 0xffffu); r[2 * e + 1] += bf2f(pr[e] >> 16); } }
        u32x4 o;
#pragma unroll
        for (int e = 0; e < 4; ++e) o[e] = pk2(r[2 * e], r[2 * e + 1]);
        *(u32x4*)p = o; } };
struct FResid { const float* X; bf16_t* Y;
    __device__ __forceinline__ void operator()(int row, int col, f32x4 v0, f32x4 v1, int) const {
        const f32x4 x0 = *(const f32x4*)(X + (size_t)row * DM + col), x1 = *(const f32x4*)(X + (size_t)row * DM + col + 4);
#if DIAG == 5 || DIAG == 6
        v0 = (f32x4){0.f, 0.f, 0.f, 0.f}; v1 = v0;
#endif
        u32x4 o; o[0] = cvtpk(x0[0] * ALPHA + v0[0], x0[1] * ALPHA + v0[1]); o[1] = cvtpk(x0[2] * ALPHA + v0[2], x0[3] * ALPHA + v0[3]);
        o[2] = cvtpk(x1[0] * ALPHA + v1[0], x1[1] * ALPHA + v1[1]); o[3] = cvtpk(x1[2] * ALPHA + v1[2], x1[3] * ALPHA + v1[3]);
        *(u32x4*)(Y + (size_t)row * DM + col) = o; } };

constexpr int PH_PER_LAYER = 12, N_PHASES = 1 + DEPTH * PH_PER_LAYER;
template <int SP> __device__ __forceinline__ void run_phase(const Ctx& C0, int l) {
    Ctx C = C0;
    asm volatile("" : "+v"(C.tid));
    C.ws = launder_ptr(C.ws); C.out = launder_ptr(C.out); l = (int)launder_u((unsigned)l);
    C.lane = C.tid & 63; C.wave = __builtin_amdgcn_readfirstlane(C.tid >> 6);
    unsigned char* wb = C.ws + WS_W + (size_t)l * W_LAYER;
    if constexpr (SP == -1) { p_conv_weights(C); }
    if constexpr (SP == 0) {
        if (l == 0) {
            for (int l2 = 0; l2 < DEPTH; ++l2) {
                unsigned char* wb2 = C.ws + WS_W + (size_t)l2 * W_LAYER; const unsigned* cm = (const unsigned*)(C.ws + WS_CMAX) + l2 * (NH + NG);
                tconv_i8_job(C, C.in[I_WIN] + (size_t)l2 * DM * NIN, NIN, DM, NH, wb2 + WO_WIN, cm);
                tconv_i8_job(C, C.in[I_WGATE] + (size_t)l2 * DM * NG, NG, DM, NG, wb2 + WO_WG, cm + NH);
            }
            p_rowpass0(C);
        }
    }
    if constexpr (SP == 1) {
        p_cumsum(C);
        __syncthreads();
        pg8::Gemm g{(const bf16_t*)(C.ws + WS_XB), (const bf16_t*)(wb + WO_WIN), DM, DM, DM, 0, 0};
        pg8::StaticOrder S; S.init(T, NH, C.G, C.bid);
        pg8::Epi8<FStoreBf16I8> E{{(bf16_t*)(C.ws + WS_H), NH, (const float*)(C.ws + WS_XSA), (const float*)(C.ws + WS_CMAX) + l * (NH + NG)}};
        pg8::gemm_phase<pg8::Epi8<FStoreBf16I8>, pg8::StaticOrder, true>(C.lds, g, S, E, C.tid);
    }
#if DIAG == 5
    if constexpr (SP == 2) { if (l == 0) { diag_ref_slice(C, C.in[I_WIN], NIN, DIAG_N0, nullptr); } }
    if constexpr (SP == 3) { if (l == 0) diag_cmp(C, (const bf16_t*)(C.ws + WS_H) + DIAG_N0, NH, (const bf16_t*)(C.ws + WS_XA), 64, 64); }
#endif
#if DIAG == 6
    if constexpr (SP == 5) { if (l == 0) diag_ref_slice(C, C.in[I_WGATE], NG, DIAG_N0, C.in[I_BGATE]); }
    if constexpr (SP == 6) { if (l == 0) diag_cmp_u8(C, C.ws + WS_G + DIAG_N0, NG, (const bf16_t*)(C.ws + WS_XA), 64, 64); }
#endif
    if constexpr (SP == 2) { p_knorm(C, l); if (l != HG_NAIVE_L) hgrn_b1(C, l); }
#if MIX_NAIVE
    if constexpr (SP == 3) { if (l != HG_NAIVE_L) hgrn_b2(C); mix_pool_naive(C, l); mix_gmlp_naive(C, l); }
#else
    if constexpr (SP == 3) { if (l != HG_NAIVE_L) hgrn_b2(C); mix_pool(C, l); mix_gmlp(C, l);
        if (DIAG == 2) mix_pool_naive(C, l); if (DIAG == 3) mix_gmlp_naive(C, l); }
#endif
#if DIAG == 1
    if constexpr (SP == 4) { hgrn_b3(C, l); { mix_hgrn_naive(C, l); __syncthreads(); } mix_fox(C, l); }
    if constexpr (SP == 5) { if (l == DIAG_LAYER) diag_cmp(C, (const bf16_t*)(C.ws + (DIAG_LAYER == 0 ? WS_XA : WS_TABU)) + 512, NBR, (const bf16_t*)(C.ws + WS_BR) + 512, NBR, 512); }
#elif DIAG == 2 || DIAG == 3
    if constexpr (SP == 4) { hgrn_b3(C, l); mix_fox(C, l); if (l == DIAG_LAYER) diag_cmp(C, (const bf16_t*)(C.ws + (DIAG_LAYER == 0 ? WS_XA : WS_TABU)) + (DIAG == 2 ? 0 : 1024), NBR, (const bf16_t*)(C.ws + WS_BR) + (DIAG == 2 ? 0 : 1024), NBR, 512); }
#else
    if constexpr (SP == 4) { if (l != HG_NAIVE_L) hgrn_b3(C, l); else { mix_hgrn_naive(C, l); __syncthreads(); } mix_fox(C, l); }
#endif
    if constexpr (SP == 5) {
        pg8::Gemm g{(const bf16_t*)(C.ws + WS_XB), (const bf16_t*)(wb + WO_WG), DM, DM, DM, 0, 0};
        pg8::StaticOrder S; S.init(T, NG, C.G, C.bid);
        pg8::Epi8<FGateI8> E{{C.ws + WS_G, C.in[I_BGATE] + l * NG, (const float*)(C.ws + WS_XSA), (const float*)(C.ws + WS_CMAX) + l * (NH + NG) + NH}};
        pg8::gemm_phase<pg8::Epi8<FGateI8>, pg8::StaticOrder, true>(C.lds, g, S, E, C.tid);
    }
    if constexpr (SP == 6) {
        pg8::Gemm g{(const bf16_t*)(C.ws + WS_BR), (const bf16_t*)(wb + WO_WBR), NBR, BW, BW, (size_t)BW, (size_t)DM * BW};
        pg8::ZOrder S; S.init(T, DM, 4, C.G, C.vcu);
        pg8::Epi8<FMerge> E{{C.ws + WS_G, (bf16_t*)(C.ws + WS_XB)}};
        pg8::gemm_phase(C.lds, g, S, E, C.tid);
    }
    if constexpr (SP == 7) {
        const float* xin = (l == 0) ? C.in[I_X] : (const float*)(C.ws + WS_XA);
        pg8::Gemm g{(const bf16_t*)(C.ws + WS_XB), (const bf16_t*)(wb + WO_WOUT), DM, DM, DM, 0, 0};
        pg8::StaticOrder S; S.init(T, DM, C.G, C.bid);
        pg8::Epi8<FResid> E{{xin, (bf16_t*)(C.ws + WS_XC)}};
        pg8::gemm_phase(C.lds, g, S, E, C.tid);
    }
    if constexpr (SP == 8) { p_ln1(C, l); p_conv_tables(C, l); }
    if constexpr (SP == 9) {
        pg8::Gemm g{(const bf16_t*)(C.ws + WS_X1B), (const bf16_t*)(wb + WO_WQ), DM, DM, DM, 0, 0};
        pg8::StaticOrder S; S.init(T, NQ, C.G, C.bid);
        pg8::Epi8<FStoreBf16> E{{(bf16_t*)(C.ws + WS_Q), NQ}};
        pg8::gemm_phase(C.lds, g, S, E, C.tid);
    }
#if TOPK_NAIVE
    if constexpr (SP == 10) p_topk_naive(C, l);
#else
    if constexpr (SP == 10) p_topk(C, l);
#endif
    if constexpr (SP == 11) p_gather(C, l);
}
__device__ __forceinline__ void make_ctx(Ctx& C, const Args& args, unsigned char* lds_raw) {
    C.lds = (LAS unsigned char*)lds_raw; C.ws = args.ws; C.in = args.in; C.out = args.out;
    C.tid = threadIdx.x; C.lane = C.tid & 63; C.wave = __builtin_amdgcn_readfirstlane(C.tid >> 6);
    C.G = gridDim.x; C.bid = blockIdx.x; C.vcu = (C.G % 8 == 0) ? (C.bid % 8) * (C.G / 8) + C.bid / 8 : C.bid;
}
#if !MK_ONE_LAUNCH
template <int SP> __global__ void __launch_bounds__(512, 2) mk_phase(Args args) {
    extern __shared__ __attribute__((aligned(16))) unsigned char lds_raw[];
    Ctx C; make_ctx(C, args, lds_raw);
    run_phase<SP>(C, args.ph_lo);
}
#endif

#define GRID_BAR() xcd_barrier((unsigned*)(args.ws + WS_CTL) + 1024, (volatile LAS unsigned*)((LAS unsigned char*)lds_raw + LDSCTL_OFF + 32))
__global__ void __launch_bounds__(512, 2) mk_fwd(Args args) {
    extern __shared__ __attribute__((aligned(16))) unsigned char lds_raw[];
    Ctx C; make_ctx(C, args, lds_raw);
    { volatile LAS unsigned* misc = (volatile LAS unsigned*)(C.lds + LDSCTL_OFF); if (C.tid < 64) misc[C.tid] = 0u; }
    __syncthreads();
    xcd_barrier_post((unsigned*)(args.ws + WS_CTL) + 1024);
    run_phase<-1>(C, 0); GRID_BAR();
#pragma unroll 1
    for (int l = 0; l < DEPTH; ++l) {
        if (l == 0) { run_phase<0>(C, l); GRID_BAR(); }
        run_phase<1>(C, l); GRID_BAR();
        run_phase<2>(C, l); GRID_BAR();
        run_phase<3>(C, l); GRID_BAR();
        run_phase<4>(C, l); GRID_BAR();
        run_phase<5>(C, l); GRID_BAR();
        run_phase<6>(C, l); GRID_BAR();
        run_phase<7>(C, l); GRID_BAR();
        run_phase<8>(C, l); GRID_BAR();
        run_phase<9>(C, l); GRID_BAR();
        run_phase<10>(C, l); GRID_BAR();
        run_phase<11>(C, l); if (l + 1 < DEPTH) GRID_BAR();
    }
}

#if !MK_ONE_LAUNCH
template <int SP> static void launch_phase(const Args& a, int grid, hipStream_t stream) {
    static bool attr_done = false;
    if (!attr_done) { (void)hipFuncSetAttribute((const void*)mk_phase<SP>, hipFuncAttributeMaxDynamicSharedMemorySize, LDS_BYTES); attr_done = true; }
    hipLaunchKernelGGL(mk_phase<SP>, dim3(grid), dim3(512), LDS_BYTES, stream, a);
}
#endif
extern "C" void kernel_launch(void* const* d_in, const int* in_sizes, int n_in, void* d_out, int out_size, void* d_ws, size_t ws_size, hipStream_t stream) {
    static int grid = 0;
    if (grid == 0) {
        if (n_in != NIN_PTRS || out_size != T * DM || ws_size < WS_END) { fprintf(stderr, "kernel_launch: unexpected shapes n_in %d out %d ws %zu\n", n_in, out_size, ws_size); grid = -1; return; }
        int dev = 0, cus = 0;
        if (hipGetDevice(&dev) != hipSuccess || hipDeviceGetAttribute(&cus, hipDeviceAttributeMultiprocessorCount, dev) != hipSuccess) { grid = -1; return; }
        grid = cus;
    }
    if (grid < 0) return;
    (void)hipMemsetAsync((char*)d_ws + WS_CTL, 0, CTL_ZERO_BYTES, stream);
    Args a{};
    for (int i = 0; i < NIN_PTRS; ++i) a.in[i] = (const float*)d_in[i];
    a.out = (float*)d_out; a.ws = (unsigned char*)d_ws; a.bar_slot = 0; a.pad = 0; a.ph_hi = 0;
#if MK_ONE_LAUNCH
    static bool attr_done = false;
    if (!attr_done) { (void)hipFuncSetAttribute((const void*)mk_fwd, hipFuncAttributeMaxDynamicSharedMemorySize, LDS_BYTES); attr_done = true; }
    hipLaunchKernelGGL(mk_fwd, dim3(grid), dim3(512), LDS_BYTES, stream, a);
    return;
#endif
#if !MK_ONE_LAUNCH
    a.ph_lo = 0; launch_phase<-1>(a, grid, stream);
    for (int l = 0; l < DEPTH; ++l) {
        a.ph_lo = l;
        launch_phase<0>(a, grid, stream); launch_phase<1>(a, grid, stream); launch_phase<2>(a, grid, stream); launch_phase<3>(a, grid, stream); launch_phase<4>(a, grid, stream);
        launch_phase<5>(a, grid, stream); launch_phase<6>(a, grid, stream); launch_phase<7>(a, grid, stream); launch_phase<8>(a, grid, stream); launch_phase<9>(a, grid, stream); launch_phase<10>(a, grid, stream); launch_phase<11>(a, grid, stream);
    }
#endif
}
```

```cpp
#include <hip/hip_runtime.h>
#include <cstdio>
#include <cstdint>

#ifndef DIAG
#define DIAG 0
#endif
#ifndef DIAG_LO
#define DIAG_LO 0
#endif
#ifndef DIAG_HI
#define DIAG_HI 64
#endif
#ifndef DIAG_MOD
#define DIAG_MOD 64
#endif
#ifndef TOPK_NAIVE
#define TOPK_NAIVE 0
#endif
#ifndef MIX_NAIVE
#define MIX_NAIVE 0
#endif
#ifndef DIAG_N0
#define DIAG_N0 4096
#endif
#ifndef FOX_NAIVE
#define FOX_NAIVE 0
#endif
#ifndef HG_NAIVE_L
#define HG_NAIVE_L 99
#endif
#ifndef DIAG_LAYER
#define DIAG_LAYER 0
#endif
#ifndef MK_ONE_LAUNCH
#define MK_ONE_LAUNCH 1
#endif

#define LAS __attribute__((address_space(3)))
#define GAS __attribute__((address_space(1)))
typedef unsigned short bf16_t;
typedef short bf16x8 __attribute__((ext_vector_type(8)));
typedef float f32x4 __attribute__((ext_vector_type(4)));
typedef float f32x2 __attribute__((ext_vector_type(2)));
typedef unsigned u32x4 __attribute__((ext_vector_type(4)));
typedef unsigned u32x2 __attribute__((ext_vector_type(2)));

constexpr int DM = 1024, BATCH = 2, SEQ = 8192, DEPTH = 2, T = BATCH * SEQ;
constexpr int BW = 512, NIN = 5124, NH = 5120, NG = 4096, NBR = 2048, NQ = 2048;
constexpr int NEXP = 16384, TOPK = 16, PH = 8;
constexpr float ALPHA = 1.4142135623730951f;
constexpr float LN_EPS = 1e-5f, RMS_EPS = 1e-6f;
constexpr int HC_P = 0, HC_HQ = 512, HC_HF = 1024, HC_HI = 1536, HC_HG = 2048, HC_GU = 2560, HC_GV = 3072, HC_FQ = 3584, HC_FK = 4096, HC_FV = 4608;

constexpr size_t MiB = 1u << 20;
constexpr size_t WS_CTL = 0, CTL_ZERO_BYTES = 160 * 1024;
constexpr size_t WS_CMAX = 64 * 1024;
constexpr size_t WS_MISC = 512 * 1024;
constexpr size_t WS_CUM = 768 * 1024;
constexpr size_t WS_W = 1 * MiB;
constexpr size_t W_LAYER = 30 * MiB;
constexpr size_t WO_WIN = 0, WO_WG = 10 * MiB, WO_WBR = 18 * MiB, WO_WOUT = 22 * MiB, WO_WQ = 24 * MiB, WO_KEYS = 28 * MiB, WO_WF = 28 * MiB + 512 * 1024, WO_POOLW = 28 * MiB + 768 * 1024, WO_GWS = 29 * MiB, WO_CS = 29 * MiB + 512 * 1024;
constexpr size_t WS_TABU = 64 * MiB, WS_TABV = 96 * MiB;
constexpr size_t WS_XA = 128 * MiB;
constexpr size_t WS_XB = 192 * MiB;
constexpr size_t WS_X1B = 224 * MiB;
constexpr size_t WS_H = 256 * MiB;
constexpr size_t WS_ST = 416 * MiB;
constexpr size_t WS_BR = 448 * MiB;
constexpr size_t WS_G = 256 * MiB;
constexpr size_t WS_MGF = 384 * MiB;
constexpr size_t WS_XC = 256 * MiB;
constexpr size_t WS_Q = 320 * MiB;
constexpr size_t WS_EIDX = 384 * MiB, WS_EGATE = 392 * MiB;
constexpr size_t WS_XSA = 256 * 1024;
constexpr size_t WS_END = 512 * MiB;

__device__ __forceinline__ float bf2f(unsigned u) { return __builtin_bit_cast(float, u << 16); }
__device__ __forceinline__ unsigned f2bf(float f) { unsigned u = __builtin_bit_cast(unsigned, f); return (u + 0x7fffu + ((u >> 16) & 1u)) >> 16; }
typedef __bf16 bf16x2_t __attribute__((ext_vector_type(2)));
__device__ __forceinline__ unsigned cvtpk(float lo, float hi) { f32x2 v = {lo, hi}; bf16x2_t b = __builtin_convertvector(v, bf16x2_t); return __builtin_bit_cast(unsigned, b); }
__device__ __forceinline__ unsigned pk2(float lo, float hi) { return cvtpk(lo, hi); }
__device__ __forceinline__ float wave_sum(float v) {
#pragma unroll
    for (int o = 32; o > 0; o >>= 1) v += __shfl_xor(v, o, 64);
    return v;
}
__device__ __forceinline__ float sigmoidf_(float x) { return __builtin_amdgcn_rcpf(1.f + __builtin_amdgcn_exp2f(-1.4426950408889634f * x)); }
__device__ __forceinline__ float siluf_(float x) { return x * __builtin_amdgcn_rcpf(1.f + __builtin_amdgcn_exp2f(-1.4426950408889634f * x)); }
__device__ __forceinline__ float geluf_slow(float x) { const float u = 0.7978845608028654f * (x + 0.044715f * x * x * x); return 0.5f * x * (1.f + tanhf(u)); }
__device__ __forceinline__ float geluf_(float x) { const float u2 = -2.302208198f * (x + 0.044715f * x * x * x); return x * __builtin_amdgcn_rcpf(1.f + __builtin_amdgcn_exp2f(u2)); }
__device__ __forceinline__ float logsigmoidf_(float z) { return fminf(z, 0.f) - log1pf(__expf(-fabsf(z))); }

__device__ __forceinline__ unsigned launder_u(unsigned x) { asm volatile("" : "+v"(x)); return __builtin_amdgcn_readfirstlane(x); }
template <class P> __device__ __forceinline__ P launder_ptr(P p) {
    const unsigned lo = launder_u((unsigned)(uintptr_t)p), hi = launder_u((unsigned)((uintptr_t)p >> 32));
    return (P)(((uintptr_t)hi << 32) | lo);
}

namespace pg8 {
constexpr int BM = 256, BK = 64, HALF = 128, HTB = HALF * BK * 2, STAGE_BYTES = 8 * HTB, NXCD = 8, WGM = 8;
__host__ __device__ __forceinline__ int lds_byte(int r, int c) { const int st = (r >> 4) * 2 + (c >> 5), rr = r & 15, cc = c & 31, ob = rr * 64 + cc * 2; return st * 1024 + (ob ^ (((ob >> 9) & 1) << 5)); }
__host__ __device__ __forceinline__ void stage_rc(int b, int& R, int& C) { const int st = b / 1024, sb = b % 1024, swz = sb ^ (((sb >> 9) & 1) << 5); R = (st >> 1) * 16 + swz / 64; C = (st & 1) * 32 + (swz % 64) / 2; }
__host__ __device__ __forceinline__ int perm32(int rho) { const int n = rho >> 4, i = rho & 15; return 8 * (i >> 2) + 4 * n + (i & 3); }

struct Unit { int pm, pn, z; };
struct Gemm { const bf16_t* A; const bf16_t* Bt; int lda, ldb, K; size_t zA, zB; };

struct StaticOrder {
    int nM, nN, nwg, G, c;
    __device__ void init(int M, int N, int G_, int c_) { nM = M / BM; nN = N / BM; nwg = nM * nN; G = G_; c = c_; }
    __device__ bool next(int i, Unit& u) const {
        const long L = (long)i * G + c; if (L >= nwg) return false;
        int wgid = (int)L; { const int q = nwg / NXCD, r = nwg % NXCD, xcd = wgid % NXCD, off = wgid / NXCD; wgid = (xcd < r ? xcd * (q + 1) : r * (q + 1) + (xcd - r) * q) + off; }
        const int nig = WGM * nN, gid = wgid / nig, fm = gid * WGM, gsz = (nM - fm) < WGM ? (nM - fm) : WGM;
        u.pm = fm + ((wgid % nig) % gsz); u.pn = (wgid % nig) / gsz; u.z = 0; return true;
    }
};
struct ZOrder {
    int nM, nN, nZ, ntile, G, c;
    __device__ void init(int M, int N, int Z, int G_, int c_) { nM = M / BM; nN = N / BM; nZ = Z; ntile = nM * nN; G = G_; c = c_; }
    __device__ bool next(int i, Unit& u) const {
        const long L = (long)(i / nZ) * G + c; if (L >= ntile) return false;
        u.pm = (int)L / nN; u.pn = (int)L % nN; u.z = i % nZ; return true;
    }
};

template <class F> struct Epi8 {
    static constexpr bool PERM = true;
    F f;
    __device__ __forceinline__ void operator()(const f32x4 (&acc)[2][2][4][2], const Unit& u, int wr, int wc, int fr, int fq) const {
        const int row0 = u.pm * BM + wr * 64 + fr, col0 = u.pn * BM + wc * 32 + 8 * fq;
#pragma unroll
        for (int ai = 0; ai < 2; ++ai)
#pragma unroll
            for (int m = 0; m < 4; ++m)
#pragma unroll
                for (int bj = 0; bj < 2; ++bj) f(row0 + ai * HALF + m * 16, col0 + bj * HALF, acc[ai][bj][m][0], acc[ai][bj][m][1], u.z);
    }
};
template <class F> struct Epi4 {
    static constexpr bool PERM = false;
    F f;
    __device__ __forceinline__ void operator()(const f32x4 (&acc)[2][2][4][2], const Unit& u, int wr, int wc, int fr, int fq) const {
        const int row0 = u.pm * BM + wr * 64 + fr, col0 = u.pn * BM + wc * 32 + 4 * fq;
#pragma unroll
        for (int ai = 0; ai < 2; ++ai)
#pragma unroll
            for (int m = 0; m < 4; ++m)
#pragma unroll
                for (int bj = 0; bj < 2; ++bj)
#pragma unroll
                    for (int n = 0; n < 2; ++n) f(row0 + ai * HALF + m * 16, col0 + bj * HALF + n * 16, acc[ai][bj][m][n], u.z);
    }
};

typedef int i32x4 __attribute__((ext_vector_type(4)));
template <class Epi, class Sched, bool I8 = false, bool ALIGN_EPI = true>
__device__ __forceinline__ void gemm_phase(LAS unsigned char* lds, const Gemm g, const Sched& S, const Epi& E, const int tid) {
    constexpr int ES = I8 ? 1 : 2;
    const int wid = __builtin_amdgcn_readfirstlane(tid >> 6), lane = tid & 63, wr = wid >> 2, wc = wid & 3, fr = lane & 15, fq = lane >> 4;
    const int K = g.K, nt = K * ES / 128;
    unsigned voffA[2], voffB[2];
#pragma unroll
    for (int i = 0; i < 2; ++i) { int R, C; stage_rc(tid * 16 + i * 8192, R, C); const int Rb = Epi::PERM ? ((R & ~31) + perm32(R & 31)) : R;
        voffA[i] = (unsigned)(R * g.lda * ES + C * 2); voffB[i] = (unsigned)(Rb * g.ldb * ES + C * 2); }
    const size_t kstep = (size_t)(BK * 2);
    const size_t hstepA = (size_t)HALF * g.lda * ES, hstepB = (size_t)HALF * g.ldb * ES;
    const size_t tstepA = 2 * hstepA, tstepB = 2 * hstepB;
    const unsigned ldsw = (unsigned)wid * 1024u;
    const int aoff = lds_byte(wr * 64 + fr, fq * 8), boff = lds_byte(wc * 32 + fr, fq * 8);
#define PG8_SA(b, h) (((b) * 2 + (h)) * HTB)
#define PG8_SB(b, h) ((4 + (b) * 2 + (h)) * HTB)
#define PG8_STAGE(bufoff, gbase, voff) do { _Pragma("unroll") for (int _i = 0; _i < 2; ++_i) \
        __builtin_amdgcn_global_load_lds((const unsigned*)((const char*)(gbase) + (voff)[_i]), (LAS unsigned*)(lds + (bufoff) + ldsw + _i * 8192), 16, 0, 0); } while (0)
#define PG8_LDA(dst, b, h) do { _Pragma("unroll") for (int m = 0; m < 4; ++m) _Pragma("unroll") for (int k = 0; k < 2; ++k) dst[m][k] = *(const LAS bf16x8*)(lds + PG8_SA(b, h) + aoff + m * 2048 + k * 1024); } while (0)
#define PG8_LDB(dst, b, h) do { _Pragma("unroll") for (int n = 0; n < 2; ++n) _Pragma("unroll") for (int k = 0; k < 2; ++k) dst[n][k] = *(const LAS bf16x8*)(lds + PG8_SB(b, h) + boff + n * 2048 + k * 1024); } while (0)
#define PG8_MMA(ai, bj, At, Bt) do { __builtin_amdgcn_s_setprio(1); _Pragma("unroll") for (int m = 0; m < 4; ++m) _Pragma("unroll") for (int n = 0; n < 2; ++n) _Pragma("unroll") for (int k = 0; k < 2; ++k) { \
        if constexpr (I8) acc[ai][bj][m][n] = __builtin_bit_cast(f32x4, __builtin_amdgcn_mfma_i32_16x16x64_i8(__builtin_bit_cast(i32x4, Bt[n][k]), __builtin_bit_cast(i32x4, At[m][k]), __builtin_bit_cast(i32x4, acc[ai][bj][m][n]), 0, 0, 0)); \
        else acc[ai][bj][m][n] = __builtin_amdgcn_mfma_f32_16x16x32_bf16(Bt[n][k], At[m][k], acc[ai][bj][m][n], 0, 0, 0); } __builtin_amdgcn_s_setprio(0); } while (0)
#define PG8_WAIT_V(n) asm volatile("s_waitcnt vmcnt(" #n ")" ::: "memory")
#define PG8_WAIT_L(n) asm volatile("s_waitcnt lgkmcnt(" #n ")" ::: "memory")
#define PG8_BAR __builtin_amdgcn_s_barrier()
#define PG8_SCHED __builtin_amdgcn_sched_barrier(0)
    Unit cur, nxt; int ui = 0;
    if (!S.next(0, cur)) return;
    f32x4 acc[2][2][4][2];
#pragma unroll
    for (int a = 0; a < 2; ++a)
#pragma unroll
        for (int b = 0; b < 2; ++b)
#pragma unroll
            for (int m = 0; m < 4; ++m)
#pragma unroll
                for (int n = 0; n < 2; ++n) acc[a][b][m][n] = (f32x4){0.f, 0.f, 0.f, 0.f};
    bf16x8 At[4][2], B0[2][2], B1[2][2];
    const char* cA = (const char*)g.A + (size_t)cur.z * g.zA * ES + (size_t)cur.pm * tstepA; const char* cB = (const char*)g.Bt + (size_t)cur.z * g.zB * ES + (size_t)cur.pn * tstepB;
    PG8_STAGE(PG8_SB(0, 0), cB, voffB); PG8_STAGE(PG8_SB(0, 1), cB + hstepB, voffB); PG8_STAGE(PG8_SA(0, 0), cA, voffA); PG8_STAGE(PG8_SA(0, 1), cA + hstepA, voffA);
    if (wr == 1) PG8_BAR;
    PG8_WAIT_V(2); PG8_BAR;
    PG8_STAGE(PG8_SB(1, 0), cB + kstep, voffB); PG8_STAGE(PG8_SA(1, 0), cA + kstep, voffA); PG8_STAGE(PG8_SB(1, 1), cB + hstepB + kstep, voffB);
    PG8_WAIT_V(6); PG8_BAR;
    for (;;) {
        const bool has_next = S.next(ui + 1, nxt);
        const char* nA = has_next ? (const char*)g.A + (size_t)nxt.z * g.zA * ES + (size_t)nxt.pm * tstepA : cA;
        const char* nB = has_next ? (const char*)g.Bt + (size_t)nxt.z * g.zB * ES + (size_t)nxt.pn * tstepB : cB;
        for (int t = 0; t < nt; t += 2) {
            const bool last = (t == nt - 2);
            const char* a1 = cA + (size_t)(t + 1) * kstep;
            const char* a2 = last ? nA : cA + (size_t)(t + 2) * kstep; const char* b2 = last ? nB : cB + (size_t)(t + 2) * kstep;
            const char* a3 = a2 + kstep; const char* b3 = b2 + kstep;
            PG8_LDB(B0, 0, 0); PG8_LDB(B1, 0, 1); PG8_SCHED; PG8_LDA(At, 0, 0); PG8_STAGE(PG8_SA(1, 1), a1 + hstepA, voffA);
            PG8_WAIT_V(8); PG8_WAIT_L(0); PG8_BAR; PG8_MMA(0, 0, At, B0); PG8_MMA(0, 1, At, B1); PG8_BAR; PG8_SCHED;
            PG8_LDA(At, 0, 1); PG8_STAGE(PG8_SB(0, 0), b2, voffB); PG8_STAGE(PG8_SB(0, 1), b2 + hstepB, voffB); PG8_STAGE(PG8_SA(0, 0), a2, voffA);
            PG8_WAIT_V(8); PG8_WAIT_L(0); PG8_BAR; PG8_MMA(1, 0, At, B0); PG8_MMA(1, 1, At, B1); PG8_BAR; PG8_SCHED;
            PG8_LDB(B0, 1, 0); PG8_LDB(B1, 1, 1); PG8_SCHED; PG8_LDA(At, 1, 0); PG8_STAGE(PG8_SA(0, 1), a2 + hstepA, voffA);
            PG8_WAIT_V(8); PG8_WAIT_L(0); PG8_BAR; PG8_MMA(0, 0, At, B0); PG8_MMA(0, 1, At, B1); PG8_BAR; PG8_SCHED;
            PG8_LDA(At, 1, 1); PG8_STAGE(PG8_SB(1, 0), b3, voffB); PG8_STAGE(PG8_SB(1, 1), b3 + hstepB, voffB); PG8_STAGE(PG8_SA(1, 0), a3, voffA);
            PG8_WAIT_V(8); PG8_WAIT_L(0); PG8_BAR; PG8_MMA(1, 0, At, B0); PG8_MMA(1, 1, At, B1); PG8_BAR; PG8_SCHED;
        }
        if constexpr (ALIGN_EPI) { if (wr == 0) PG8_BAR; }
        E(acc, cur, wr, wc, fr, fq);
        if (!has_next) break;
#pragma unroll
        for (int a = 0; a < 2; ++a)
#pragma unroll
            for (int b = 0; b < 2; ++b)
#pragma unroll
                for (int m = 0; m < 4; ++m)
#pragma unroll
                    for (int n = 0; n < 2; ++n) acc[a][b][m][n] = (f32x4){0.f, 0.f, 0.f, 0.f};
        cur = nxt; cA = nA; cB = nB; ++ui;
        if constexpr (ALIGN_EPI) { if (wr == 1) PG8_BAR; }
    }
    PG8_WAIT_V(0);
    if constexpr (!ALIGN_EPI) { if (wr == 0) PG8_BAR; }
    PG8_BAR;
#undef PG8_SA
#undef PG8_SB
#undef PG8_STAGE
#undef PG8_LDA
#undef PG8_LDB
#undef PG8_MMA
#undef PG8_WAIT_V
#undef PG8_WAIT_L
#undef PG8_BAR
#undef PG8_SCHED
}
}

#define XB_TMO      128
#define XB_XCNT(j)  (256  + 64 * (j))
#define XB_XSUB(j)  (1280 + 64 * (j))
#define XB_XGEN(j)  (2304 + 64 * (j))
#define XB_TOP      3328
#define XB_TOPGEN   3392
#define XCD_BAR_WORDS 3456
#define XB_SPIN_CAP (1u << 22)
__device__ __forceinline__ unsigned xb_ld(unsigned* p)              { return __hip_atomic_load(p, __ATOMIC_RELAXED, __HIP_MEMORY_SCOPE_AGENT); }
__device__ __forceinline__ unsigned xb_add(unsigned* p, unsigned v) { return __hip_atomic_fetch_add(p, v, __ATOMIC_RELAXED, __HIP_MEMORY_SCOPE_AGENT); }
__device__ __forceinline__ unsigned xb_xcc_id() { return (unsigned)__builtin_amdgcn_s_getreg((3 << 11) | 20) & 0xFu; }
#define XB_SPIN(cond, bar) do { unsigned _sp = 0; while (cond) { __builtin_amdgcn_s_sleep(1); \
    if ((++_sp & 255u) == 0u) { if (xb_ld(&(bar)[XB_TMO])) break; if (_sp > XB_SPIN_CAP) { atomicAdd(&(bar)[XB_TMO], 1u); break; } } } } while (0)
__device__ __forceinline__ void xcd_barrier_post(unsigned* bar) {
    if (threadIdx.x == 0) (void)xb_add(&bar[XB_XCNT(xb_xcc_id())], 1u);
}
__device__ __forceinline__ void xcd_barrier_complete(unsigned* bar, unsigned x, unsigned& nloc, unsigned& nx) {
    const unsigned G = gridDim.x * gridDim.y * gridDim.z;
    unsigned sum, cnt, mine, sp = 0u;
    for (;;) {
        sum = 0u; cnt = 0u; mine = 0u;
#pragma unroll
        for (unsigned j = 0; j < 16; ++j) { const unsigned c = xb_ld(&bar[XB_XCNT(j)]); sum += c; cnt += (c > 0u) ? 1u : 0u; mine = (j == x) ? c : mine; }
        if (sum == G) break;
        __builtin_amdgcn_s_sleep(1);
        if ((++sp & 255u) == 0u) { if (xb_ld(&bar[XB_TMO])) break; if (sp > XB_SPIN_CAP) { atomicAdd(&bar[XB_TMO], 1u); break; } }
    }
    nloc = mine > 0u ? mine : 1u; nx = cnt > 0u ? cnt : 1u;
}
__device__ __noinline__ void xcd_barrier_leader(unsigned* bar, volatile LAS unsigned* st) {
    const unsigned x = xb_xcc_id();
    __builtin_amdgcn_s_waitcnt(0);
    unsigned nloc = st[0], nx = st[1];
    if (nloc == 0u) { xcd_barrier_complete(bar, x, nloc, nx); st[0] = nloc; st[1] = nx; }
    const unsigned old = xb_add(&bar[XB_XSUB(x)], 1u);
    const unsigned gen = old / nloc;
    if (old + 1u == (gen + 1u) * nloc) {
        __builtin_amdgcn_fence(__ATOMIC_RELEASE, "agent");
        asm volatile("s_waitcnt vmcnt(0)" ::: "memory");
        const unsigned og = xb_add(&bar[XB_TOP], 1u);
        const unsigned tg = og / nx;
        if (og + 1u == (tg + 1u) * nx) xb_add(&bar[XB_TOPGEN], 1u);
        else XB_SPIN(xb_ld(&bar[XB_TOPGEN]) == tg, bar);
        __builtin_amdgcn_fence(__ATOMIC_ACQUIRE, "agent");
        xb_add(&bar[XB_XGEN(x)], 1u);
        asm volatile("s_waitcnt vmcnt(0)" ::: "memory");
    } else {
        XB_SPIN(xb_ld(&bar[XB_XGEN(x)]) == gen, bar);
        __builtin_amdgcn_fence(__ATOMIC_ACQUIRE, "agent");
        asm volatile("s_waitcnt vmcnt(0)" ::: "memory");
    }
}
__device__ __forceinline__ void xcd_barrier(unsigned* bar, volatile LAS unsigned* st) {
    asm volatile("s_waitcnt vmcnt(0)" ::: "memory");
    __syncthreads();
    if (threadIdx.x == 0) xcd_barrier_leader(bar, st);
    __syncthreads();
}

constexpr int NIN_PTRS = 23;
struct Args { const float* in[NIN_PTRS]; float* out; unsigned char* ws; int ph_lo, ph_hi, bar_slot, pad; };
enum { I_X = 0, I_WIN, I_BFOX, I_POOLW, I_POOLS, I_LBL, I_HNG, I_GLNG, I_GLNB, I_GWS, I_GBS, I_WGATE, I_BGATE, I_WBR, I_WOUT, I_LN1G, I_LN1B, I_WQ, I_KEYS, I_PU, I_PV, I_LN2G, I_LN2B };

constexpr int LDS_BYTES = 147456;
constexpr int LDSCTL_OFF = 143360;

struct Ctx {
    LAS unsigned char* lds;
    unsigned char* ws;
    const float* const* in;
    float* out;
    int tid, lane, wave, G, bid, vcu;
};

__device__ __forceinline__ void tconv_job(const Ctx& C, const float* src, int ld_src, int K, int N, bf16_t* dst) {
    LAS float* tile = (LAS float*)C.lds;
    const int nk = K / 64, nn = N / 64, ntiles = nk * nn;
    for (int tl = C.bid; tl < ntiles; tl += C.G) {
        const int k0 = (tl / nn) * 64, n0 = (tl % nn) * 64;
#pragma unroll
        for (int p = 0; p < 2; ++p) {
            const int kr = (C.tid >> 4) + p * 32, nc = (C.tid & 15) * 4;
            const f32x4 v = *(const f32x4*)(src + (size_t)(k0 + kr) * ld_src + n0 + nc);
            tile[kr * 65 + nc + 0] = v[0]; tile[kr * 65 + nc + 1] = v[1]; tile[kr * 65 + nc + 2] = v[2]; tile[kr * 65 + nc + 3] = v[3];
        }
        __syncthreads();
        {
            const int n = C.tid >> 3, k8 = (C.tid & 7) * 8;
            u32x4 o;
#pragma unroll
            for (int j = 0; j < 4; ++j) o[j] = pk2(tile[(k8 + 2 * j) * 65 + n], tile[(k8 + 2 * j + 1) * 65 + n]);
            *(u32x4*)(dst + (size_t)(n0 + n) * K + k0 + k8) = o;
        }
        __syncthreads();
    }
}
__device__ __forceinline__ void colmax_job(const Ctx& C, const float* src, int ld_src, int K, int N, unsigned* cmax) {
    LAS float* red = (LAS float*)C.lds;
    const int nk = K / 64, nn = N / 64, ntiles = nk * nn;
    for (int tl = C.bid; tl < ntiles; tl += C.G) {
        const int k0 = (tl / nn) * 64, n0 = (tl % nn) * 64;
        float mx[4] = {0.f, 0.f, 0.f, 0.f};
#pragma unroll
        for (int p = 0; p < 2; ++p) { const int kr = (C.tid >> 4) + p * 32, nc = (C.tid & 15) * 4;
            const f32x4 v = *(const f32x4*)(src + (size_t)(k0 + kr) * ld_src + n0 + nc);
#pragma unroll
            for (int e = 0; e < 4; ++e) mx[e] = fmaxf(mx[e], fabsf(v[e])); }
#pragma unroll
        for (int e = 0; e < 4; ++e) red[(C.tid >> 4) * 64 + (C.tid & 15) * 4 + e] = mx[e];
        __syncthreads();
        if (C.tid < 64) { float m = 0.f; for (int r = 0; r < 32; ++r) m = fmaxf(m, red[r * 64 + C.tid]); atomicMax(cmax + n0 + C.tid, __builtin_bit_cast(unsigned, m)); }
        __syncthreads();
    }
}
__device__ __forceinline__ void tconv_i8_job(const Ctx& C, const float* src, int ld_src, int K, int N, unsigned char* dst, const unsigned* cmax) {
    LAS float* tile = (LAS float*)C.lds;
    const int nks = K / 256, nn = N / 64, nunits = nks * nn;
    for (int un = C.bid; un < nunits; un += C.G) {
        const int k0 = (un / nn) * 256, n0 = (un % nn) * 64;
        const int kr = C.tid >> 4, nc = (C.tid & 15) * 4;
        f32x4 v[8];
#pragma unroll
        for (int p = 0; p < 8; ++p) v[p] = *(const f32x4*)(src + (size_t)(k0 + kr + 32 * p) * ld_src + n0 + nc);
        float isc[4];
#pragma unroll
        for (int e = 0; e < 4; ++e) isc[e] = 127.f / fmaxf(__builtin_bit_cast(float, __hip_atomic_load(cmax + n0 + nc + e, __ATOMIC_RELAXED, __HIP_MEMORY_SCOPE_AGENT)), 1e-30f);
#pragma unroll
        for (int p = 0; p < 8; ++p)
#pragma unroll
            for (int e = 0; e < 4; ++e) tile[(kr + 32 * p) * 65 + nc + e] = v[p][e] * isc[e];
        __syncthreads();
        { const int n = C.tid >> 3, kb = (C.tid & 7) * 32;
          u32x4 o0, o1;
#pragma unroll
          for (int j = 0; j < 8; ++j) { unsigned wd = 0u;
#pragma unroll
              for (int e = 0; e < 4; ++e) wd |= ((unsigned)(int)rintf(tile[(kb + 4 * j + e) * 65 + n]) & 255u) << (8 * e);
              if (j < 4) o0[j] = wd; else o1[j - 4] = wd; }
          unsigned char* dp = dst + (size_t)(n0 + n) * K + k0 + kb;
          *(u32x4*)dp = o0; *(u32x4*)(dp + 16) = o1; }
        __syncthreads();
    }
}
__device__ __forceinline__ void cvt_copy(const Ctx& C, const float* src, bf16_t* dst, size_t n) {
    const size_t n8 = n / 8;
    for (size_t i = (size_t)C.bid * 512 + C.tid; i < n8; i += (size_t)C.G * 512) {
        const f32x4 a = *(const f32x4*)(src + i * 8), b = *(const f32x4*)(src + i * 8 + 4);
        u32x4 o; o[0] = pk2(a[0], a[1]); o[1] = pk2(a[2], a[3]); o[2] = pk2(b[0], b[1]); o[3] = pk2(b[2], b[3]);
        *(u32x4*)(dst + i * 8) = o;
    }
}
__device__ __forceinline__ void p_conv_weights(const Ctx& C) {
    for (int l = 0; l < DEPTH; ++l) {
        unsigned char* wb = C.ws + WS_W + (size_t)l * W_LAYER;
        colmax_job(C, C.in[I_WIN] + (size_t)l * DM * NIN, NIN, DM, NH, (unsigned*)(C.ws + WS_CMAX) + l * (NH + NG));
        colmax_job(C, C.in[I_WGATE] + (size_t)l * DM * NG, NG, DM, NG, (unsigned*)(C.ws + WS_CMAX) + l * (NH + NG) + NH);
        for (int m = 0; m < 4; ++m)
            tconv_job(C, C.in[I_WBR] + ((size_t)l * 4 + m) * BW * DM, DM, BW, DM, (bf16_t*)(wb + WO_WBR) + (size_t)m * DM * BW);
        tconv_job(C, C.in[I_WOUT] + (size_t)l * DM * DM, DM, DM, DM, (bf16_t*)(wb + WO_WOUT));
        tconv_job(C, C.in[I_WQ] + (size_t)l * DM * NQ, NQ, DM, NQ, (bf16_t*)(wb + WO_WQ));
        cvt_copy(C, C.in[I_KEYS] + (size_t)l * 2 * PH * 128 * 128, (bf16_t*)(wb + WO_KEYS), (size_t)2 * PH * 128 * 128);
        for (int g = 0; g < 4; ++g)
            tconv_job(C, C.in[I_POOLW] + ((size_t)l * 4 + g) * 128 * 128, 128, 128, 128, (bf16_t*)(wb + WO_POOLW) + (size_t)g * 128 * 128);
        {
            bf16_t* gw = (bf16_t*)(wb + WO_GWS); const float* src = C.in[I_GWS] + (size_t)l * 4 * 128 * 128;
            for (int i = C.bid * 512 + C.tid; i < 4 * 128 * 128; i += C.G * 512) { const int t = (i >> 7) & 127, sx = i & 127; gw[i] = (bf16_t)f2bf(sx <= t ? src[i] : 0.f); }
        }
        float* wf = (float*)(wb + WO_WF);
        for (int i = C.bid * 512 + C.tid; i < 4 * DM; i += C.G * 512) { const int h = i / DM, k = i % DM; wf[i] = C.in[I_WIN][(size_t)l * DM * NIN + (size_t)k * NIN + NH + h]; }
    }
}
constexpr size_t WS_U8 = WS_TABU, WS_V8 = WS_TABU + 16 * MiB, WS_SU = WS_TABU + 32 * MiB, WS_SV = WS_SU + 64 * 1024;
__device__ __forceinline__ float wave_max(float v) {
#pragma unroll
    for (int o = 32; o > 0; o >>= 1) v = fmaxf(v, __shfl_xor(v, o, 64));
    return v;
}
template <bool SIGNED> __device__ __forceinline__ void quant_rows(const Ctx& C, const float* src, unsigned char* dst, float* scl) {
    for (int row = C.bid * 8 + C.wave; row < NEXP; row += C.G * 8) {
        const float* p = src + (size_t)row * DM + C.lane * 16;
        f32x4 v[4]; float mx = 0.f;
#pragma unroll
        for (int i = 0; i < 4; ++i) { v[i] = *(const f32x4*)(p + 4 * i);
#pragma unroll
            for (int e = 0; e < 4; ++e) mx = fmaxf(mx, fabsf(v[i][e])); }
        mx = fmaxf(wave_max(mx), 1e-30f);
        const float sc = mx * (1.f / 127.f), isc = 127.f / mx;
        u32x4 o;
#pragma unroll
        for (int i = 0; i < 4; ++i) { unsigned wd = 0u;
#pragma unroll
            for (int e = 0; e < 4; ++e) { const int q = (int)rintf(v[i][e] * isc) + (SIGNED ? 0 : 128); wd |= ((unsigned)q & 255u) << (8 * e); }
            o[i] = wd; }
        *(u32x4*)(dst + (size_t)row * DM + C.lane * 16) = o;
        if (C.lane == 0) scl[row] = sc;
    }
}
__device__ __forceinline__ void p_conv_tables(const Ctx& C, int l) {
    quant_rows<true>(C, C.in[I_PU] + (size_t)l * NEXP * DM, C.ws + WS_U8, (float*)(C.ws + WS_SU));
    quant_rows<false>(C, C.in[I_PV] + (size_t)l * NEXP * DM, C.ws + WS_V8, (float*)(C.ws + WS_SV));
}

__device__ __forceinline__ void row_emit(const Ctx& C, int row, const float (&v)[16], int l, bool want_lsig) {
    {
        float mx = 0.f;
#pragma unroll
        for (int j = 0; j < 16; ++j) mx = fmaxf(mx, fabsf(v[j]));
#pragma unroll
        for (int o = 32; o > 0; o >>= 1) mx = fmaxf(mx, __shfl_xor(mx, o, 64));
        mx = fmaxf(mx, 1e-30f);
        const float isc = 127.f / mx;
        unsigned char* xb = C.ws + WS_XB + (size_t)row * DM;
        u32x2 o0, o1;
#pragma unroll
        for (int hw = 0; hw < 2; ++hw) { unsigned a = 0u, b = 0u;
#pragma unroll
            for (int e = 0; e < 4; ++e) { a |= ((unsigned)(int)rintf(v[4 * hw + e] * isc) & 255u) << (8 * e); b |= ((unsigned)(int)rintf(v[8 + 4 * hw + e] * isc) & 255u) << (8 * e); }
            o0[hw] = a; o1[hw] = b; }
        *(u32x2*)(xb + C.lane * 8) = o0; *(u32x2*)(xb + 512 + C.lane * 8) = o1;
        if (C.lane == 0) ((float*)(C.ws + WS_XSA))[row] = mx * (1.f / 127.f);
    }
    if (want_lsig) {
        const float* wf = (const float*)(C.ws + WS_W + (size_t)l * W_LAYER + WO_WF);
        float* lsig = (float*)(C.ws + WS_MISC);
#pragma unroll
        for (int h = 0; h < 4; ++h) {
            const f32x4 a0 = *(const f32x4*)(wf + h * DM + C.lane * 8), a1 = *(const f32x4*)(wf + h * DM + C.lane * 8 + 4);
            const f32x4 b0 = *(const f32x4*)(wf + h * DM + 512 + C.lane * 8), b1 = *(const f32x4*)(wf + h * DM + 512 + C.lane * 8 + 4);
            float s = 0.f;
#pragma unroll
            for (int j = 0; j < 4; ++j) s += v[j] * a0[j] + v[4 + j] * a1[j] + v[8 + j] * b0[j] + v[12 + j] * b1[j];
            s = wave_sum(s);
            if (C.lane == 0) lsig[(size_t)row * 4 + h] = logsigmoidf_(s + C.in[I_BFOX][l * 4 + h]);
        }
    }
}
__device__ __forceinline__ void load_row16(const float* p, int lane, float (&v)[16]) {
    const f32x4 a0 = *(const f32x4*)(p + lane * 8), a1 = *(const f32x4*)(p + lane * 8 + 4), b0 = *(const f32x4*)(p + 512 + lane * 8), b1 = *(const f32x4*)(p + 512 + lane * 8 + 4);
#pragma unroll
    for (int j = 0; j < 4; ++j) { v[j] = a0[j]; v[4 + j] = a1[j]; v[8 + j] = b0[j]; v[12 + j] = b1[j]; }
}
__device__ __forceinline__ void store_row16(float* p, int lane, const float (&v)[16]) {
    *(f32x4*)(p + lane * 8) = (f32x4){v[0], v[1], v[2], v[3]}; *(f32x4*)(p + lane * 8 + 4) = (f32x4){v[4], v[5], v[6], v[7]};
    *(f32x4*)(p + 512 + lane * 8) = (f32x4){v[8], v[9], v[10], v[11]}; *(f32x4*)(p + 512 + lane * 8 + 4) = (f32x4){v[12], v[13], v[14], v[15]};
}
__device__ __forceinline__ void ln_row16(float (&v)[16], const float* g, const float* b, int lane) {
    float s = 0.f;
#pragma unroll
    for (int j = 0; j < 16; ++j) s += v[j];
    const float mean = wave_sum(s) * (1.f / DM);
    float q = 0.f;
#pragma unroll
    for (int j = 0; j < 16; ++j) { const float d = v[j] - mean; q += d * d; }
    const float rstd = rsqrtf(wave_sum(q) * (1.f / DM) + LN_EPS);
    float gg[16], bb[16];
    load_row16(g, lane, gg); load_row16(b, lane, bb);
#pragma unroll
    for (int j = 0; j < 16; ++j) v[j] = (v[j] - mean) * rstd * gg[j] + bb[j];
}
__device__ __forceinline__ void p_rowpass0(const Ctx& C) {
    for (int row = C.bid * 8 + C.wave; row < T; row += C.G * 8) {
        float v[16]; load_row16(C.in[I_X] + (size_t)row * DM, C.lane, v);
        row_emit(C, row, v, 0, true);
    }
}
__device__ __forceinline__ void p_cumsum(const Ctx& C) {
    if (C.bid >= BATCH * 4) return;
    const float* lsig = (const float*)(C.ws + WS_MISC);
    float* cum = (float*)(C.ws + WS_CUM);
    LAS float* wt = (LAS float*)C.lds;
    const int b = C.bid >> 2, h = C.bid & 3;
    float v[16];
#pragma unroll
    for (int j = 0; j < 16; ++j) v[j] = lsig[((size_t)b * SEQ + C.tid * 16 + j) * 4 + h];
#pragma unroll
    for (int j = 1; j < 16; ++j) v[j] += v[j - 1];
    float inc = v[15];
#pragma unroll
    for (int o = 1; o < 64; o <<= 1) { const float t = __shfl_up(inc, o, 64); if (C.lane >= o) inc += t; }
    if (C.lane == 63) wt[C.wave] = inc;
    __syncthreads();
    float off = inc - v[15];
    for (int w2 = 0; w2 < C.wave; ++w2) off += wt[w2];
    float* cp = cum + ((size_t)b * 4 + h) * SEQ + C.tid * 16;
#pragma unroll
    for (int j4 = 0; j4 < 4; ++j4) *(f32x4*)(cp + 4 * j4) = (f32x4){v[4 * j4] + off, v[4 * j4 + 1] + off, v[4 * j4 + 2] + off, v[4 * j4 + 3] + off};
    __syncthreads();
}
__device__ __forceinline__ void load_row16_bf(const bf16_t* p, int lane, float (&v)[16]) {
    const u32x4 a = *(const u32x4*)(p + lane * 8), b = *(const u32x4*)(p + 512 + lane * 8);
#pragma unroll
    for (int j = 0; j < 4; ++j) { v[2 * j] = bf2f(a[j] & 0xffffu); v[2 * j + 1] = bf2f(a[j] >> 16); v[8 + 2 * j] = bf2f(b[j] & 0xffffu); v[9 + 2 * j] = bf2f(b[j] >> 16); }
}
__device__ __forceinline__ void p_ln1(const Ctx& C, int l) {
    const bf16_t* y1 = (const bf16_t*)(C.ws + WS_XC); bf16_t* x1b = (bf16_t*)(C.ws + WS_X1B);
    for (int row = C.bid * 8 + C.wave; row < T; row += C.G * 8) {
        float v[16]; load_row16_bf(y1 + (size_t)row * DM, C.lane, v);
        ln_row16(v, C.in[I_LN1G] + l * DM, C.in[I_LN1B] + l * DM, C.lane);
        u32x4 o0, o1;
#pragma unroll
        for (int j = 0; j < 4; ++j) { o0[j] = pk2(v[2 * j], v[2 * j + 1]); o1[j] = pk2(v[8 + 2 * j], v[8 + 2 * j + 1]); }
        *(u32x4*)(x1b + (size_t)row * DM + C.lane * 8) = o0; *(u32x4*)(x1b + (size_t)row * DM + 512 + C.lane * 8) = o1;
    }
}

__device__ __forceinline__ void mix_pool_naive(const Ctx& C, int l) {
    const bf16_t* H = (const bf16_t*)(C.ws + WS_H); bf16_t* BR = (bf16_t*)(C.ws + WS_BR);
    LAS float* dd = (LAS float*)C.lds;
    for (int u = C.bid; u < (T / 64) * 4; u += C.G) {
        const int g = u & 3, t0 = (u >> 2) * 64, w = 2 << g;
        for (int idx = C.tid; idx < 64 * 128; idx += 512) {
            const int r = idx >> 7, c = idx & 127, row = t0 + r, pos = row & (SEQ - 1);
            const int nwin = (pos + 1 < w) ? pos + 1 : w;
            float s = 0.f;
            for (int j = 0; j < nwin; ++j) s += bf2f(H[(size_t)(row - j) * NH + HC_P + g * 128 + c]);
            dd[idx] = s / (float)nwin - bf2f(H[(size_t)row * NH + HC_P + g * 128 + c]);
        }
        __syncthreads();
        const int dcol = C.tid & 127, rq = C.tid >> 7;
        float acc[16];
#pragma unroll
        for (int i = 0; i < 16; ++i) acc[i] = 0.f;
        const float* pw = C.in[I_POOLW] + ((size_t)l * 4 + g) * 128 * 128;
        for (int c = 0; c < 128; ++c) {
            const float wv = pw[c * 128 + dcol];
#pragma unroll
            for (int i = 0; i < 16; ++i) acc[i] += dd[(rq * 16 + i) * 128 + c] * wv;
        }
        const float sc = C.in[I_POOLS][l * BW + g * 128 + dcol];
#pragma unroll
        for (int i = 0; i < 16; ++i) BR[(size_t)(t0 + rq * 16 + i) * NBR + 0 + g * 128 + dcol] = (bf16_t)f2bf(acc[i] * sc);
        __syncthreads();
    }
}
__device__ __forceinline__ void mix_gmlp_naive(const Ctx& C, int l) {
    const bf16_t* H = (const bf16_t*)(C.ws + WS_H); bf16_t* BR = (bf16_t*)(C.ws + WS_BR);
    LAS float* vn = (LAS float*)C.lds;
    for (int u = C.bid; u < (T / 128) * 4; u += C.G) {
        const int g = u & 3, t0 = (u >> 2) * 128;
        for (int i = 0; i < 16; ++i) {
            const int r = C.wave * 16 + i, row = t0 + r;
            const u32x4 raw = *(const u32x4*)(H + (size_t)row * NH + HC_GV + C.lane * 8);
            float e[8];
#pragma unroll
            for (int j = 0; j < 4; ++j) { e[2 * j] = geluf_(bf2f(raw[j] & 0xffffu)); e[2 * j + 1] = geluf_(bf2f(raw[j] >> 16)); }
            float s = 0.f;
#pragma unroll
            for (int j = 0; j < 8; ++j) s += e[j];
            const float mean = wave_sum(s) * (1.f / BW);
            float q = 0.f;
#pragma unroll
            for (int j = 0; j < 8; ++j) { const float d = e[j] - mean; q += d * d; }
            const float rstd = rsqrtf(wave_sum(q) * (1.f / BW) + LN_EPS);
            if ((C.lane >> 4) == g) {
#pragma unroll
                for (int j = 0; j < 8; ++j) { const int col = C.lane * 8 + j;
                    vn[r * 128 + (col - g * 128)] = (e[j] - mean) * rstd * C.in[I_GLNG][l * BW + col] + C.in[I_GLNB][l * BW + col]; }
            }
        }
        __syncthreads();
        const int c = C.tid & 127, tq = C.tid >> 7;
        const float* wsg = C.in[I_GWS] + ((size_t)l * 4 + g) * 128 * 128;
        for (int t = tq; t < 128; t += 4) {
            float acc = 0.f;
            for (int s = 0; s <= t; ++s) acc += wsg[t * 128 + s] * vn[s * 128 + c];
            const float sv = acc + C.in[I_GBS][(l * 4 + g) * 128 + t];
            const float uv = geluf_(bf2f(H[(size_t)(t0 + t) * NH + HC_GU + g * 128 + c]));
            BR[(size_t)(t0 + t) * NBR + 1024 + g * 128 + c] = (bf16_t)f2bf(uv * sv);
        }
        __syncthreads();
    }
}
__device__ __forceinline__ void mix_fox_naive(const Ctx& C, int l) {
    const bf16_t* H = (const bf16_t*)(C.ws + WS_H); bf16_t* BR = (bf16_t*)(C.ws + WS_BR);
    const float* cum = (const float*)(C.ws + WS_CUM);
    const float scale = 0.08838834764831845f;
    for (int u = C.bid; u < T * 4 / 8; u += C.G) {
        const int rid = u * 8 + C.wave;
        const int h = rid & 3, row = rid >> 2, b = row / SEQ, t = row % SEQ;
        const unsigned qraw = *(const unsigned*)(H + (size_t)row * NH + HC_FQ + h * 128 + C.lane * 2);
        const float q0 = bf2f(qraw & 0xffffu) * scale, q1 = bf2f(qraw >> 16) * scale;
        const float* cm = cum + ((size_t)b * 4 + h) * SEQ;
        const float ct = cm[t];
        float m = -1e30f, lsum = 0.f, o0 = 0.f, o1 = 0.f;
        for (int s = t; s >= 0; --s) {
            const size_t kr = (size_t)(b * SEQ + s) * NH + h * 128 + C.lane * 2;
            const unsigned kraw = *(const unsigned*)(H + kr + HC_FK);
            const unsigned vraw = *(const unsigned*)(H + kr + HC_FV);
            float d = q0 * bf2f(kraw & 0xffffu) + q1 * bf2f(kraw >> 16);
            d = wave_sum(d);
            const float z = d + ct - cm[s];
            const float mn = fmaxf(m, z), al = __expf(m - mn), p = __expf(z - mn);
            lsum = lsum * al + p; o0 = o0 * al + p * bf2f(vraw & 0xffffu); o1 = o1 * al + p * bf2f(vraw >> 16); m = mn;
        }
        const float inv = 1.f / lsum;
        *(unsigned*)(BR + (size_t)row * NBR + 1536 + h * 128 + C.lane * 2) = pk2(o0 * inv, o1 * inv);
    }
}
__device__ __forceinline__ void mix_hgrn_naive(const Ctx& C, int l) {
    if (C.bid >= BATCH * 4) return;
    const bf16_t* H = (const bf16_t*)(C.ws + WS_H); bf16_t* BR = (bf16_t*)(C.ws + WS_BR);
    const int b = C.bid >> 2, h = C.bid & 3;
    LAS float* fdec = (LAS float*)C.lds;
    LAS float* kkv = fdec + 32 * 128;
    LAS float* qsv = kkv + 32 * 128;
    LAS float* vv = qsv + 32 * 128;
    LAS float* opart = vv + 32 * 128;
    const int kq = C.tid >> 7, v = C.tid & 127;
    float S[32];
#pragma unroll
    for (int j = 0; j < 32; ++j) S[j] = 0.f;
    for (int c0 = 0; c0 < SEQ; c0 += 32) {
        for (int idx = C.tid; idx < 32 * 128; idx += 512) {
            const int st = idx >> 7, k = idx & 127; const size_t rb = (size_t)(b * SEQ + c0 + st) * NH + h * 128 + k;
            float lb = 0.f;
            if (l == 1) { const float z0 = C.in[I_LBL][h * 128 + k], z1 = C.in[I_LBL][BW + h * 128 + k]; lb = 1.f / (1.f + __expf(z0 - z1)); }
            const float zf = bf2f(H[rb + HC_HF]);
            const float kk = (1.f - lb) * sigmoidf_(-zf);
            fdec[idx] = 1.f - kk; kkv[idx] = kk; qsv[idx] = siluf_(bf2f(H[rb + HC_HQ])); vv[idx] = bf2f(H[rb + HC_HI]);
        }
        __syncthreads();
        for (int st = 0; st < 32; ++st) {
            const float vt = vv[st * 128 + v];
            float part = 0.f;
#pragma unroll
            for (int j = 0; j < 32; ++j) { const int k = kq * 32 + j; S[j] = fdec[st * 128 + k] * S[j] + kkv[st * 128 + k] * vt; part += S[j] * qsv[st * 128 + k]; }
            opart[(kq * 32 + st) * 128 + v] = part;
        }
        __syncthreads();
        for (int i = 0; i < 4; ++i) {
            const int st = C.wave * 4 + i, row = b * SEQ + c0 + st;
            float o0 = 0.f, o1 = 0.f;
#pragma unroll
            for (int q = 0; q < 4; ++q) { o0 += opart[(q * 32 + st) * 128 + C.lane]; o1 += opart[(q * 32 + st) * 128 + 64 + C.lane]; }
            const float ss = wave_sum(o0 * o0 + o1 * o1);
            const float r = rsqrtf(ss * (1.f / 128.f) + RMS_EPS);
            const float g0 = siluf_(bf2f(H[(size_t)row * NH + HC_HG + h * 128 + C.lane])), g1 = siluf_(bf2f(H[(size_t)row * NH + HC_HG + h * 128 + 64 + C.lane]));
            BR[(size_t)row * NBR + 512 + h * 128 + C.lane] = (bf16_t)f2bf(o0 * r * C.in[I_HNG][l * 128 + C.lane] * g0);
            BR[(size_t)row * NBR + 512 + h * 128 + 64 + C.lane] = (bf16_t)f2bf(o1 * r * C.in[I_HNG][l * 128 + 64 + C.lane] * g1);
        }
        __syncthreads();
    }
}


typedef float f32x16 __attribute__((ext_vector_type(16)));
typedef short s16x4 __attribute__((ext_vector_type(4)));
typedef short v4i16_t __attribute__((ext_vector_type(4)));
__device__ __forceinline__ s16x4 vtr(const LAS unsigned char* p) { return __builtin_bit_cast(s16x4, __builtin_amdgcn_ds_read_tr16_b64_v4i16((LAS v4i16_t*)p)); }
__device__ __forceinline__ float xor32(float x) { return __shfl_xor(x, 32, 64); }
#define MFMA32(a, b, c) __builtin_amdgcn_mfma_f32_32x32x16_bf16((a), (b), (c), 0, 0, 0)
constexpr int CW_KMAX = 16;

__device__ __forceinline__ void p_knorm(const Ctx& C, int l) {
    const bf16_t* H = (const bf16_t*)(C.ws + WS_H);
    unsigned* kmax = (unsigned*)(C.ws + WS_CTL) + CW_KMAX + l * 8;
    for (int r0 = (C.bid * 8 + C.wave) * 8; r0 < T; r0 += C.G * 64) {
        u32x4 raw[8];
#pragma unroll
        for (int i = 0; i < 8; ++i) raw[i] = *(const u32x4*)(H + (size_t)(r0 + i) * NH + HC_FK + C.lane * 8);
        float best = 0.f;
#pragma unroll
        for (int i = 0; i < 8; ++i) { float s = 0.f;
#pragma unroll
            for (int j = 0; j < 4; ++j) { const float a = bf2f(raw[i][j] & 0xffffu), b = bf2f(raw[i][j] >> 16); s += a * a + b * b; }
            best = fmaxf(best, s); }
        best = 0.f;
#pragma unroll
        for (int i = 0; i < 8; ++i) { float s = 0.f;
#pragma unroll
            for (int j = 0; j < 4; ++j) { const float a = bf2f(raw[i][j] & 0xffffu), b = bf2f(raw[i][j] >> 16); s += a * a + b * b; }
#pragma unroll
            for (int o = 8; o > 0; o >>= 1) s += __shfl_xor(s, o, 64);
            best = fmaxf(best, s); }
        LAS float* red = (LAS float*)C.lds;
        if ((C.lane & 15) == 0) red[C.wave * 4 + (C.lane >> 4)] = best;
        __syncthreads();
        if (C.tid < 4) { float m = red[C.tid];
#pragma unroll
            for (int w2 = 1; w2 < 8; ++w2) m = fmaxf(m, red[w2 * 4 + C.tid]);
            atomicMax(kmax + (r0 / SEQ) * 4 + C.tid, __builtin_bit_cast(unsigned, m)); }
        __syncthreads();
    }
}

constexpr int FOX_KST = 272, FOX_VST = 320;
constexpr int FOX_KB = 0, FOX_VB = 2 * 64 * FOX_KST, FOX_BETA = FOX_VB + 2 * 64 * FOX_VST, FOX_FLAG = FOX_BETA + 2 * 64 * 4, FOX_END = FOX_FLAG + 2 * 8 * 4;
__device__ __forceinline__ void mix_fox(const Ctx& C, int l) {
    const bf16_t* H = (const bf16_t*)(C.ws + WS_H); bf16_t* BR = (bf16_t*)(C.ws + WS_BR);
    const float* cum = (const float*)(C.ws + WS_CUM);
    const unsigned* kmaxw = (const unsigned*)(C.ws + WS_CTL) + CW_KMAX + l * 8;
    const float LOG2E = 1.4426950408889634f, QS = 0.08838834764831845f * LOG2E;
    const int lane = C.lane, w = C.wave, r32 = lane & 31, hh = lane >> 5;
    LAS unsigned char* lds = C.lds;
    LAS float* betaL = (LAS float*)(lds + FOX_BETA);
    volatile LAS int* flagL = (volatile LAS int*)(lds + FOX_FLAG);
    for (int u = C.bid; u < BATCH * 4 * (SEQ / 256); u += C.G) {
        const int qb = u % (SEQ / 256), bh = u / (SEQ / 256), b = bh >> 2, h = bh & 3;
        const int q0 = qb * 256, qw = q0 + 32 * w;
        const size_t rowbase = (size_t)b * SEQ;
        const float* cm = cum + ((size_t)b * 4 + h) * SEQ;
        const float c0 = cm[q0];
        const float kmx = sqrtf(__builtin_bit_cast(float, __hip_atomic_load(kmaxw + b * 4 + h, __ATOMIC_RELAXED, __HIP_MEMORY_SCOPE_AGENT)));
        bf16x8 qf[8]; float qn = 0.f;
        {
            const bf16_t* qp = H + (rowbase + qw + r32) * NH + HC_FQ + h * 128 + 8 * hh;
#pragma unroll
            for (int ks = 0; ks < 8; ++ks) {
                const u32x4 raw = *(const u32x4*)(qp + 16 * ks);
                u32x4 o;
#pragma unroll
                for (int j = 0; j < 4; ++j) { const float a = bf2f(raw[j] & 0xffffu), bb = bf2f(raw[j] >> 16); qn += a * a + bb * bb; o[j] = cvtpk(a * QS, bb * QS); }
                qf[ks] = __builtin_bit_cast(bf16x8, o);
            }
            qn += xor32(qn); qn = sqrtf(qn);
        }
        const float qbound = qn * kmx * QS;
        f32x16 oacc[4];
#pragma unroll
        for (int mt = 0; mt < 4; ++mt)
#pragma unroll
            for (int i = 0; i < 16; ++i) oacc[mt][i] = 0.f;
        float m_run = -1e30f, l_run = 0.f;
        const int jmax = (q0 + 255) >> 6;
        const int srow = C.tid >> 4, sch = C.tid & 15;
        u32x4 kreg[2], vreg[2]; float breg = 0.f;
#define FOX_GLOAD(j_) do { _Pragma("unroll") for (int p = 0; p < 2; ++p) { \
                const bf16_t* rp = H + (rowbase + 64 * (j_) + srow + 32 * p) * NH + h * 128 + sch * 8; \
                kreg[p] = *(const u32x4*)(rp + HC_FK); vreg[p] = *(const u32x4*)(rp + HC_FV); } \
            if (C.tid < 64) breg = (c0 - cm[64 * (j_) + C.tid]) * LOG2E; } while (0)
#define FOX_LWRITE(buf_) do { _Pragma("unroll") for (int p = 0; p < 2; ++p) { \
                *(LAS u32x4*)(lds + FOX_KB + (buf_) * 64 * FOX_KST + (srow + 32 * p) * FOX_KST + sch * 16) = kreg[p]; \
                *(LAS u32x4*)(lds + FOX_VB + (buf_) * 64 * FOX_VST + (srow + 32 * p) * FOX_VST + sch * 16) = vreg[p]; } \
            if (C.tid < 64) betaL[(buf_) * 64 + C.tid] = breg; } while (0)
        __syncthreads();
        if (C.tid < 16) flagL[C.tid] = 0;
        FOX_GLOAD(jmax); FOX_LWRITE(jmax & 1);
        bool wdone = false;
        for (int j = jmax; j >= 0; --j) {
            const int cur = j & 1;
            __syncthreads();
            if (j < jmax) { int all = 1;
#pragma unroll
                for (int i = 0; i < 8; ++i) all &= flagL[((j + 1) & 1) * 8 + i];
                if (all) break; }
            if (j > 0) FOX_GLOAD(j - 1);
            const int k0 = 64 * j;
            if (k0 <= qw + 31 && !wdone) {
                const LAS unsigned char* kb = lds + FOX_KB + cur * 64 * FOX_KST;
                const LAS unsigned char* vb = lds + FOX_VB + cur * 64 * FOX_VST;
                f32x16 sacc[2];
#pragma unroll
                for (int mt = 0; mt < 2; ++mt)
#pragma unroll
                    for (int g = 0; g < 4; ++g) { const f32x4 bv = *(const LAS f32x4*)(betaL + cur * 64 + 32 * mt + 8 * g + 4 * hh);
                        sacc[mt][4 * g] = bv[0]; sacc[mt][4 * g + 1] = bv[1]; sacc[mt][4 * g + 2] = bv[2]; sacc[mt][4 * g + 3] = bv[3]; }
#pragma unroll
                for (int ks = 0; ks < 8; ++ks)
#pragma unroll
                    for (int mt = 0; mt < 2; ++mt) {
                        const bf16x8 kf = *(const LAS bf16x8*)(kb + (32 * mt + r32) * FOX_KST + 32 * ks + 16 * hh);
                        sacc[mt] = MFMA32(kf, qf[ks], sacc[mt]);
                    }
                const int tq = qw + r32;
                if (k0 + 63 > qw) {
#pragma unroll
                    for (int mt = 0; mt < 2; ++mt)
#pragma unroll
                        for (int i = 0; i < 16; ++i) { const int key = k0 + 32 * mt + (i & 3) + 8 * (i >> 2) + 4 * hh; if (key > tq) sacc[mt][i] = -1e30f; }
                }
                float mx = sacc[0][0];
#pragma unroll
                for (int mt = 0; mt < 2; ++mt)
#pragma unroll
                    for (int i = 0; i < 16; ++i) mx = fmaxf(mx, sacc[mt][i]);
                mx = fmaxf(mx, xor32(mx));
                const float mn = fmaxf(m_run, mx), alpha = __builtin_amdgcn_exp2f(m_run - mn);
                m_run = mn;
                float ps = 0.f;
#pragma unroll
                for (int mt = 0; mt < 2; ++mt)
#pragma unroll
                    for (int i = 0; i < 16; ++i) { const float p = __builtin_amdgcn_exp2f(sacc[mt][i] - mn); sacc[mt][i] = p; ps += p; }
                l_run = l_run * alpha + ps;
#pragma unroll
                for (int mt = 0; mt < 4; ++mt)
#pragma unroll
                    for (int i = 0; i < 16; ++i) oacc[mt][i] *= alpha;
#pragma unroll
                for (int s4 = 0; s4 < 4; ++s4) {
                    const int mtk = s4 >> 1, s = s4 & 1;
                    u32x4 pb;
#pragma unroll
                    for (int e = 0; e < 4; ++e) pb[e] = cvtpk(sacc[mtk][8 * s + 2 * e], sacc[mtk][8 * s + 2 * e + 1]);
                    const bf16x8 pfrag = __builtin_bit_cast(bf16x8, pb);
                    const int i16 = lane & 15, q4 = i16 >> 2, p4 = i16 & 3, blk = (lane >> 4) & 1;
                    const int keyA = 32 * mtk + 16 * s + 4 * hh + q4;
#pragma unroll
                    for (int mt = 0; mt < 4; ++mt) {
                        const LAS unsigned char* a0 = vb + keyA * FOX_VST + (32 * mt + 16 * blk + 4 * p4) * 2;
                        const s16x4 lo = vtr(a0), hi = vtr(a0 + 8 * FOX_VST);
                        const bf16x8 vf = __builtin_shufflevector(lo, hi, 0, 1, 2, 3, 4, 5, 6, 7);
                        oacc[mt] = MFMA32(vf, pfrag, oacc[mt]);
                    }
                }
                if (j > 0) { const float bl = (c0 - cm[k0 - 1]) * LOG2E;
                    const int ok = (qbound + bl < m_run - 40.f) ? 1 : 0;
                    wdone = __all(ok); }
            }
            if (lane == 0) flagL[cur * 8 + w] = wdone ? 1 : 0;
            if (j > 0) FOX_LWRITE(cur ^ 1);
        }
        l_run += xor32(l_run);
        const float inv = 1.f / l_run;
        bf16_t* op = BR + (rowbase + qw + r32) * NBR + 1536 + h * 128;
#pragma unroll
        for (int mt = 0; mt < 4; ++mt)
#pragma unroll
            for (int g = 0; g < 4; ++g) { u32x2 o; o[0] = cvtpk(oacc[mt][4 * g] * inv, oacc[mt][4 * g + 1] * inv); o[1] = cvtpk(oacc[mt][4 * g + 2] * inv, oacc[mt][4 * g + 3] * inv);
                *(u32x2*)(op + 32 * mt + 8 * g + 4 * hh) = o; }
    }
}


constexpr int HG_LF = 0, HG_QA = 34816, HG_QB = HG_QA + 17408, HG_KD = HG_QB + 8704, HG_KO = HG_KD + 17408, HG_KT = HG_KO + 8704, HG_VN = HG_KT + 20480, HG_AM = HG_VN + 20480, HG_END = HG_AM + 12288;
constexpr int HG_LFS = 132;
static_assert(HG_END + 2048 <= 140 * 1024, "hgrn LDS");
constexpr size_t WS_DSC = WS_ST + (size_t)BATCH * 4 * 32 * 128 * 128 * 4;

template <bool FULL>
__device__ __forceinline__ void hgrn_unit(const Ctx& C, int l, int u) {
#if DIAG == 1
    const bf16_t* H = (const bf16_t*)(C.ws + WS_H); bf16_t* BR = (l == 0) ? (bf16_t*)(C.ws + WS_XA) : (bf16_t*)(C.ws + WS_TABU);
#else
    const bf16_t* H = (const bf16_t*)(C.ws + WS_H); bf16_t* BR = (bf16_t*)(C.ws + WS_BR);
#endif
    float* STB = (float*)(C.ws + WS_ST); float* DSC = (float*)(C.ws + WS_DSC);
    LAS unsigned char* lds = C.lds;
    LAS float* LF = (LAS float*)(lds + HG_LF);
    const int lane = C.lane, w = C.wave, r32 = lane & 31, hh = lane >> 5;
    const int sc = u & 31, bh = u >> 5, b = bh >> 2, h = bh & 3;
    const int wk = w >> 1, wv = w & 1;
    const int mt = w >> 2, nt = w & 3;
    const int i16 = lane & 15, q4 = i16 >> 2, p4 = i16 & 3, blk = (lane >> 4) & 1;
    f32x16 S0, S1;
    float* stp = STB + ((size_t)bh * 32 + sc) * 128 * 128;
    if constexpr (FULL) {
#pragma unroll
        for (int i = 0; i < 16; ++i) { const int k = 32 * wk + (i & 3) + 8 * (i >> 2) + 4 * hh;
            S0[i] = stp[k * 128 + 64 * wv + r32]; S1[i] = stp[k * 128 + 64 * wv + 32 + r32]; }
    } else {
#pragma unroll
        for (int i = 0; i < 16; ++i) { S0[i] = 0.f; S1[i] = 0.f; }
    }
    float dtot = 0.f;
    const int ps = C.tid >> 3, pseg = C.tid & 7;
    float lbv[16];
#pragma unroll
    for (int j = 0; j < 16; ++j) { lbv[j] = 0.f;
        if (l == 1) { const int ch = h * 128 + 16 * pseg + j; lbv[j] = 1.f / (1.f + __expf(C.in[I_LBL][ch] - C.in[I_LBL][BW + ch])); } }
    u32x4 nf0, nf1, nv0, nv1;
    { const bf16_t* hp0 = H + ((size_t)b * SEQ + sc * 256 + ps) * NH + h * 128 + 16 * pseg;
      nf0 = *(const u32x4*)(hp0 + HC_HF); nf1 = *(const u32x4*)(hp0 + HC_HF + 8); nv0 = *(const u32x4*)(hp0 + HC_HI); nv1 = *(const u32x4*)(hp0 + HC_HI + 8); }
    for (int c = 0; c < 4; ++c) {
        const size_t row0 = (size_t)b * SEQ + sc * 256 + c * 64;
        const bf16_t* hp = H + (row0 + ps) * NH + h * 128 + 16 * pseg;
        float kkv[16], qsv[16];
        u32x4 vraw0, vraw1;
        u32x4 cg0 = {0u, 0u, 0u, 0u}, cg1 = cg0, cq0 = cg0, cq1 = cg0;
        if constexpr (FULL) { cq0 = *(const u32x4*)(hp + HC_HQ); cq1 = *(const u32x4*)(hp + HC_HQ + 8); cg0 = *(const u32x4*)(hp + HC_HG); cg1 = *(const u32x4*)(hp + HC_HG + 8); }
        {
            const u32x4 f0 = nf0, f1 = nf1;
            vraw0 = nv0; vraw1 = nv1;
            if (c < 3) { const bf16_t* hn = hp + (size_t)64 * NH;
                nf0 = *(const u32x4*)(hn + HC_HF); nf1 = *(const u32x4*)(hn + HC_HF + 8); nv0 = *(const u32x4*)(hn + HC_HI); nv1 = *(const u32x4*)(hn + HC_HI + 8); }
#pragma unroll
            for (int j = 0; j < 8; ++j) { const unsigned r = (j < 4) ? f0[j] : f1[j - 4];
                const float z0 = bf2f(r & 0xffffu), z1 = bf2f(r >> 16);
                kkv[2 * j] = (1.f - lbv[2 * j]) * sigmoidf_(-z0); kkv[2 * j + 1] = (1.f - lbv[2 * j + 1]) * sigmoidf_(-z1); }
            if constexpr (FULL) {
#pragma unroll
                for (int j = 0; j < 8; ++j) { const unsigned r = (j < 4) ? cq0[j] : cq1[j - 4]; qsv[2 * j] = siluf_(bf2f(r & 0xffffu)); qsv[2 * j + 1] = siluf_(bf2f(r >> 16)); }
            }
#pragma unroll
            for (int j4 = 0; j4 < 4; ++j4) { f32x4 o;
#pragma unroll
                for (int e = 0; e < 4; ++e) o[e] = __logf(1.f - kkv[4 * j4 + e]);
                *(LAS f32x4*)(LF + ps * HG_LFS + 16 * pseg + 4 * j4) = o; }
        }
        __syncthreads();
        {
            const int sk = C.tid & 127, sg = C.tid >> 7;
            float vals[16];
#pragma unroll
            for (int i = 0; i < 16; ++i) vals[i] = LF[(16 * sg + i) * HG_LFS + sk];
#pragma unroll
            for (int i = 1; i < 16; ++i) vals[i] += vals[i - 1];
            LAS float* TOT = (LAS float*)(lds + HG_END);
            TOT[sg * 128 + sk] = vals[15];
            __syncthreads();
            float off = 0.f;
#pragma unroll
            for (int j = 0; j < 3; ++j) if (j < sg) off += TOT[j * 128 + sk];
#pragma unroll
            for (int i = 0; i < 16; ++i) LF[(16 * sg + i) * HG_LFS + sk] = vals[i] + off;
            if (sg == 3) dtot += vals[15] + off;
        }
        __syncthreads();
        float bv[16], b31[16], bl[16];
#pragma unroll
        for (int j4 = 0; j4 < 4; ++j4) { const f32x4 x = *(const LAS f32x4*)(LF + ps * HG_LFS + 16 * pseg + 4 * j4), y = *(const LAS f32x4*)(LF + 31 * HG_LFS + 16 * pseg + 4 * j4), z = *(const LAS f32x4*)(LF + 63 * HG_LFS + 16 * pseg + 4 * j4);
#pragma unroll
            for (int e = 0; e < 4; ++e) { bv[4 * j4 + e] = x[e]; b31[4 * j4 + e] = y[e]; bl[4 * j4 + e] = z[e]; } }
        {
            u32x4 o0, o1;
#pragma unroll
            for (int j = 0; j < 4; ++j) { o0[j] = cvtpk(kkv[2 * j] * __expf(bl[2 * j] - bv[2 * j]), kkv[2 * j + 1] * __expf(bl[2 * j + 1] - bv[2 * j + 1]));
                o1[j] = cvtpk(kkv[8 + 2 * j] * __expf(bl[8 + 2 * j] - bv[8 + 2 * j]), kkv[9 + 2 * j] * __expf(bl[9 + 2 * j] - bv[9 + 2 * j])); }
            *(LAS u32x4*)(lds + HG_KT + ps * 320 + 32 * pseg) = o0; *(LAS u32x4*)(lds + HG_KT + ps * 320 + 32 * pseg + 16) = o1;
            *(LAS u32x4*)(lds + HG_VN + ps * 320 + 32 * pseg) = vraw0; *(LAS u32x4*)(lds + HG_VN + ps * 320 + 32 * pseg + 16) = vraw1;
            if constexpr (FULL) {
                const bool hi = ps >= 32;
                float rr[16];
#pragma unroll
                for (int j = 0; j < 16; ++j) rr[j] = hi ? b31[j] : 0.f;
#pragma unroll
                for (int j = 0; j < 4; ++j) { o0[j] = cvtpk(qsv[2 * j] * __expf(bv[2 * j] - rr[2 * j]), qsv[2 * j + 1] * __expf(bv[2 * j + 1] - rr[2 * j + 1]));
                    o1[j] = cvtpk(qsv[8 + 2 * j] * __expf(bv[8 + 2 * j] - rr[8 + 2 * j]), qsv[9 + 2 * j] * __expf(bv[9 + 2 * j] - rr[9 + 2 * j])); }
                *(LAS u32x4*)(lds + HG_QA + ps * 272 + 32 * pseg) = o0; *(LAS u32x4*)(lds + HG_QA + ps * 272 + 32 * pseg + 16) = o1;
#pragma unroll
                for (int j = 0; j < 4; ++j) { o0[j] = cvtpk(kkv[2 * j] * __expf(rr[2 * j] - bv[2 * j]), kkv[2 * j + 1] * __expf(rr[2 * j + 1] - bv[2 * j + 1]));
                    o1[j] = cvtpk(kkv[8 + 2 * j] * __expf(rr[8 + 2 * j] - bv[8 + 2 * j]), kkv[9 + 2 * j] * __expf(rr[9 + 2 * j] - bv[9 + 2 * j])); }
                *(LAS u32x4*)(lds + HG_KD + ps * 272 + 32 * pseg) = o0; *(LAS u32x4*)(lds + HG_KD + ps * 272 + 32 * pseg + 16) = o1;
                if (hi) {
#pragma unroll
                    for (int j = 0; j < 4; ++j) { o0[j] = cvtpk(qsv[2 * j] * __expf(bv[2 * j]), qsv[2 * j + 1] * __expf(bv[2 * j + 1]));
                        o1[j] = cvtpk(qsv[8 + 2 * j] * __expf(bv[8 + 2 * j]), qsv[9 + 2 * j] * __expf(bv[9 + 2 * j])); }
                    *(LAS u32x4*)(lds + HG_QB + (ps - 32) * 272 + 32 * pseg) = o0; *(LAS u32x4*)(lds + HG_QB + (ps - 32) * 272 + 32 * pseg + 16) = o1;
                } else {
#pragma unroll
                    for (int j = 0; j < 4; ++j) { o0[j] = cvtpk(kkv[2 * j] * __expf(b31[2 * j] - bv[2 * j]), kkv[2 * j + 1] * __expf(b31[2 * j + 1] - bv[2 * j + 1]));
                        o1[j] = cvtpk(kkv[8 + 2 * j] * __expf(b31[8 + 2 * j] - bv[8 + 2 * j]), kkv[9 + 2 * j] * __expf(b31[9 + 2 * j] - bv[9 + 2 * j])); }
                    *(LAS u32x4*)(lds + HG_KO + ps * 272 + 32 * pseg) = o0; *(LAS u32x4*)(lds + HG_KO + ps * 272 + 32 * pseg + 16) = o1;
                }
            }
        }
        float dk[16];
#pragma unroll
        for (int i = 0; i < 16; ++i) dk[i] = __expf(LF[63 * HG_LFS + 32 * wk + (i & 3) + 8 * (i >> 2) + 4 * hh]);
        __syncthreads();
        if constexpr (FULL) {
#pragma unroll
            for (int g = 0; g < 4; ++g) {
                u32x2 o; o[0] = cvtpk(S0[4 * g], S0[4 * g + 1]); o[1] = cvtpk(S0[4 * g + 2], S0[4 * g + 3]);
                *(LAS u32x2*)(lds + HG_LF + (64 * wv + r32) * 272 + (32 * wk + 8 * g + 4 * hh) * 2) = o;
                o[0] = cvtpk(S1[4 * g], S1[4 * g + 1]); o[1] = cvtpk(S1[4 * g + 2], S1[4 * g + 3]);
                *(LAS u32x2*)(lds + HG_LF + (64 * wv + 32 + r32) * 272 + (32 * wk + 8 * g + 4 * hh) * 2) = o;
            }
#define HG_ATILE(AMT_, AST_) do { \
                const LAS unsigned char* kb = ((AMT_) == (AST_)) ? (lds + HG_KD + (32 * (AST_)) * 272) : (lds + HG_KO); \
                f32x16 a; \
                _Pragma("unroll") for (int i = 0; i < 16; ++i) a[i] = 0.f; \
                _Pragma("unroll") for (int ks = 0; ks < 8; ++ks) { \
                    const bf16x8 af = *(const LAS bf16x8*)(lds + HG_QA + (32 * (AMT_) + r32) * 272 + 32 * ks + 16 * hh); \
                    const bf16x8 bf = *(const LAS bf16x8*)(kb + r32 * 272 + 32 * ks + 16 * hh); \
                    a = MFMA32(af, bf, a); } \
                _Pragma("unroll") for (int g = 0; g < 4; ++g) { \
                    float x[4]; \
                    _Pragma("unroll") for (int e = 0; e < 4; ++e) { const int tl = 8 * g + 4 * hh + e; x[e] = ((AMT_) != (AST_) || r32 <= tl) ? a[4 * g + e] : 0.f; } \
                    u32x2 o; o[0] = cvtpk(x[0], x[1]); o[1] = cvtpk(x[2], x[3]); \
                    *(LAS u32x2*)(lds + HG_AM + (32 * (AST_) + r32) * 192 + (32 * (AMT_) + 8 * g + 4 * hh) * 2) = o; } } while (0)
            if (w == 0) { HG_ATILE(0, 0); }
            else if (w == 1) { HG_ATILE(1, 0); }
            else if (w == 2) { HG_ATILE(1, 1); }
        }
#pragma unroll
        for (int i = 0; i < 16; ++i) { S0[i] *= dk[i]; S1[i] *= dk[i]; }
#pragma unroll
        for (int ks = 0; ks < 4; ++ks) {
            const LAS unsigned char* ka = lds + HG_KT + (16 * ks + 8 * hh + q4) * 320 + (32 * wk + 16 * blk + 4 * p4) * 2;
            const s16x4 alo = vtr(ka), ahi = vtr(ka + 4 * 320);
            const bf16x8 af = __builtin_shufflevector(alo, ahi, 0, 1, 2, 3, 4, 5, 6, 7);
            const LAS unsigned char* vb0 = lds + HG_VN + (16 * ks + 8 * hh + q4) * 320 + (64 * wv + 16 * blk + 4 * p4) * 2;
            const s16x4 b0lo = vtr(vb0), b0hi = vtr(vb0 + 4 * 320), b1lo = vtr(vb0 + 64), b1hi = vtr(vb0 + 64 + 4 * 320);
            S0 = MFMA32(af, __builtin_shufflevector(b0lo, b0hi, 0, 1, 2, 3, 4, 5, 6, 7), S0);
            S1 = MFMA32(af, __builtin_shufflevector(b1lo, b1hi, 0, 1, 2, 3, 4, 5, 6, 7), S1);
        }
        if constexpr (FULL) {
            __syncthreads();
            f32x16 o;
#pragma unroll
            for (int i = 0; i < 16; ++i) o[i] = 0.f;
            const LAS unsigned char* qb = (mt == 0) ? (lds + HG_QA) : (lds + HG_QB);
#pragma unroll
            for (int ks = 0; ks < 8; ++ks) {
                const bf16x8 af = *(const LAS bf16x8*)(qb + r32 * 272 + 32 * ks + 16 * hh);
                const bf16x8 bf = *(const LAS bf16x8*)(lds + HG_LF + (32 * nt + r32) * 272 + 32 * ks + 16 * hh);
                o = MFMA32(af, bf, o);
            }
#pragma unroll
            for (int ks = 0; ks < 4; ++ks) {
                if (mt == 0 && ks >= 2) continue;
                const LAS unsigned char* aa = lds + HG_AM + (16 * ks + 8 * hh + q4) * 192 + (32 * mt + 16 * blk + 4 * p4) * 2;
                const s16x4 alo = vtr(aa), ahi = vtr(aa + 4 * 192);
                const LAS unsigned char* vb0 = lds + HG_VN + (16 * ks + 8 * hh + q4) * 320 + (32 * nt + 16 * blk + 4 * p4) * 2;
                const s16x4 blo = vtr(vb0), bhi = vtr(vb0 + 4 * 320);
                o = MFMA32(__builtin_shufflevector(alo, ahi, 0, 1, 2, 3, 4, 5, 6, 7), __builtin_shufflevector(blo, bhi, 0, 1, 2, 3, 4, 5, 6, 7), o);
            }
            __syncthreads();
#pragma unroll
            for (int i = 0; i < 16; ++i) LF[(32 * mt + (i & 3) + 8 * (i >> 2) + 4 * hh) * HG_LFS + 32 * nt + r32] = o[i];
            __syncthreads();
            {
                float ov[16]; float ss = 0.f;
#pragma unroll
                for (int j4 = 0; j4 < 4; ++j4) { const f32x4 x = *(const LAS f32x4*)(LF + ps * HG_LFS + 16 * pseg + 4 * j4);
#pragma unroll
                    for (int e = 0; e < 4; ++e) { ov[4 * j4 + e] = x[e]; ss += x[e] * x[e]; } }
                ss += __shfl_xor(ss, 1, 64); ss += __shfl_xor(ss, 2, 64); ss += __shfl_xor(ss, 4, 64);
                const float rn = rsqrtf(ss * (1.f / 128.f) + RMS_EPS);
                const u32x4 g0 = cg0, g1 = cg1;
                const float* ng = C.in[I_HNG] + l * 128 + 16 * pseg;
                u32x4 o0, o1;
#pragma unroll
                for (int j = 0; j < 4; ++j) {
                    o0[j] = cvtpk(ov[2 * j] * rn * ng[2 * j] * siluf_(bf2f(g0[j] & 0xffffu)), ov[2 * j + 1] * rn * ng[2 * j + 1] * siluf_(bf2f(g0[j] >> 16)));
                    o1[j] = cvtpk(ov[8 + 2 * j] * rn * ng[8 + 2 * j] * siluf_(bf2f(g1[j] & 0xffffu)), ov[9 + 2 * j] * rn * ng[9 + 2 * j] * siluf_(bf2f(g1[j] >> 16)));
                }
                bf16_t* bp = BR + (row0 + ps) * NBR + 512 + h * 128 + 16 * pseg;
                *(u32x4*)bp = o0; *(u32x4*)(bp + 8) = o1;
            }
        }
        __syncthreads();
    }
    if constexpr (!FULL) {
#pragma unroll
        for (int i = 0; i < 16; ++i) { const int k = 32 * wk + (i & 3) + 8 * (i >> 2) + 4 * hh;
            stp[k * 128 + 64 * wv + r32] = S0[i]; stp[k * 128 + 64 * wv + 32 + r32] = S1[i]; }
        if (C.tid >= 384) DSC[((size_t)bh * 32 + sc) * 128 + (C.tid & 127)] = __expf(dtot);
    }
}
__device__ __forceinline__ void hgrn_b1(const Ctx& C, int l) { for (int u = C.bid; u < BATCH * 4 * 32; u += C.G) hgrn_unit<false>(C, l, u); }
__device__ __forceinline__ void hgrn_b3(const Ctx& C, int l) { for (int u = C.bid; u < BATCH * 4 * 32; u += C.G) hgrn_unit<true>(C, l, u); }
__device__ __forceinline__ void hgrn_b2(const Ctx& C) {
    float* STB = (float*)(C.ws + WS_ST); const float* DSC = (const float*)(C.ws + WS_DSC);
    for (int e = C.bid * 512 + C.tid; e < BATCH * 4 * 128 * 128; e += C.G * 512) {
        const int bh = e >> 14, kv = e & 16383, k = kv >> 7;
        float* p = STB + (size_t)bh * 32 * 16384 + kv;
        float uu[32], dd[32];
#pragma unroll
        for (int s = 0; s < 32; ++s) { uu[s] = p[(size_t)s * 16384]; dd[s] = DSC[((size_t)bh * 32 + s) * 128 + k]; }
        float st = 0.f;
#pragma unroll
        for (int s = 0; s < 32; ++s) { p[(size_t)s * 16384] = st; st = dd[s] * st + uu[s]; }
    }
}


__device__ __forceinline__ void mix_pool(const Ctx& C, int l) {
#if DIAG == 2
    const bf16_t* H = (const bf16_t*)(C.ws + WS_H); bf16_t* BR = (l == 0) ? (bf16_t*)(C.ws + WS_XA) : (bf16_t*)(C.ws + WS_TABU);
#else
    const bf16_t* H = (const bf16_t*)(C.ws + WS_H); bf16_t* BR = (bf16_t*)(C.ws + WS_BR);
#endif
    const bf16_t* Wt = (const bf16_t*)(C.ws + WS_W + (size_t)l * W_LAYER + WO_POOLW);
    LAS unsigned char* lds = C.lds;
    constexpr int PL_P = 128 * 272;
    const int lane = C.lane, w = C.wave, r32 = lane & 31, hh = lane >> 5;
    for (int u = C.bid; u < (T / 256) * 4; u += C.G) {
        const int g = u & 3, t0 = (u >> 2) * 256, win = 2 << g;
        const int row = t0 + 32 * w + r32, pos = row & (SEQ - 1);
        __syncthreads();
#pragma unroll
        for (int p = 0; p < 4; ++p) { const int idx = C.tid + 512 * p, rr = idx >> 4, ch = idx & 15;
            *(LAS u32x4*)(lds + rr * 272 + ch * 16) = *(const u32x4*)(Wt + (size_t)g * 128 * 128 + rr * 128 + ch * 8); }
        const bool seq_start = (t0 & (SEQ - 1)) == 0;
        for (int idx = C.tid; idx < 271 * 16; idx += 512) { const int rr = idx >> 4, ch = idx & 15;
            if (!(seq_start && rr < 15)) *(LAS u32x4*)(lds + PL_P + rr * 272 + ch * 16) = *(const u32x4*)(H + (size_t)(t0 - 15 + rr) * NH + HC_P + g * 128 + ch * 8); }
        __syncthreads();
        const int nwin = (pos + 1 < win) ? pos + 1 : win;
        const float invn = 1.f / (float)nwin;
        bf16x8 df[8];
        const LAS unsigned char* prow = lds + PL_P + (32 * w + r32 + 15) * 272 + 16 * hh;
#pragma unroll
        for (int ks = 0; ks < 8; ++ks) {
            float sum[8];
#pragma unroll
            for (int e = 0; e < 8; ++e) sum[e] = 0.f;
            const u32x4 self = *(const LAS u32x4*)(prow + 32 * ks);
#pragma unroll
            for (int j = 0; j < 16; ++j) if (j < win) {
                const int jj = (j < nwin) ? j : 0; const float msk = (j < nwin) ? 1.f : 0.f;
                const u32x4 rw = *(const LAS u32x4*)(prow + 32 * ks - jj * 272);
#pragma unroll
                for (int e = 0; e < 4; ++e) { sum[2 * e] += msk * bf2f(rw[e] & 0xffffu); sum[2 * e + 1] += msk * bf2f(rw[e] >> 16); } }
            u32x4 o;
#pragma unroll
            for (int e = 0; e < 4; ++e) o[e] = cvtpk(sum[2 * e] * invn - bf2f(self[e] & 0xffffu), sum[2 * e + 1] * invn - bf2f(self[e] >> 16));
            df[ks] = __builtin_bit_cast(bf16x8, o);
        }
        f32x16 acc[4];
#pragma unroll
        for (int mt = 0; mt < 4; ++mt)
#pragma unroll
            for (int i = 0; i < 16; ++i) acc[mt][i] = 0.f;
#pragma unroll
        for (int ks = 0; ks < 8; ++ks)
#pragma unroll
            for (int mt = 0; mt < 4; ++mt) {
                const bf16x8 wf = *(const LAS bf16x8*)(lds + (32 * mt + r32) * 272 + 32 * ks + 16 * hh);
                acc[mt] = MFMA32(wf, df[ks], acc[mt]);
            }
        const float* psc = C.in[I_POOLS] + l * BW + g * 128;
        bf16_t* op = BR + (size_t)row * NBR + g * 128;
#pragma unroll
        for (int mt = 0; mt < 4; ++mt)
#pragma unroll
            for (int q = 0; q < 4; ++q) { const int d0 = 32 * mt + 8 * q + 4 * hh; const f32x4 sc = *(const f32x4*)(psc + d0);
                u32x2 o; o[0] = cvtpk(acc[mt][4 * q] * sc[0], acc[mt][4 * q + 1] * sc[1]); o[1] = cvtpk(acc[mt][4 * q + 2] * sc[2], acc[mt][4 * q + 3] * sc[3]);
                *(u32x2*)(op + d0) = o; }
    }
}
constexpr int GM_VN = 0, GM_WC = 128 * 320, GM_END = GM_WC + 128 * 272;
__device__ __forceinline__ void mix_gmlp(const Ctx& C, int l) {
#if DIAG == 3
    const bf16_t* H = (const bf16_t*)(C.ws + WS_H); bf16_t* BR = (l == 0) ? (bf16_t*)(C.ws + WS_XA) : (bf16_t*)(C.ws + WS_TABU);
#else
    const bf16_t* H = (const bf16_t*)(C.ws + WS_H); bf16_t* BR = (bf16_t*)(C.ws + WS_BR);
#endif
    const bf16_t* Wc = (const bf16_t*)(C.ws + WS_W + (size_t)l * W_LAYER + WO_GWS);
    LAS unsigned char* lds = C.lds;
    const int lane = C.lane, w = C.wave, r32 = lane & 31, hh = lane >> 5;
    const int i16 = lane & 15, q4 = i16 >> 2, p4 = i16 & 3, blk = (lane >> 4) & 1;
    for (int u = C.bid; u < (T / 128) * 4; u += C.G) {
        const int g = u & 3, t0 = (u >> 2) * 128;
        __syncthreads();
#pragma unroll
        for (int p = 0; p < 4; ++p) { const int idx = C.tid + 512 * p, rr = idx >> 4, ch = idx & 15;
            *(LAS u32x4*)(lds + GM_WC + rr * 272 + ch * 16) = *(const u32x4*)(Wc + (size_t)g * 128 * 128 + rr * 128 + ch * 8); }
        u32x4 rawall[16];
#pragma unroll
        for (int i = 0; i < 16; ++i) rawall[i] = *(const u32x4*)(H + (size_t)(t0 + w * 16 + i) * NH + HC_GV + lane * 8);
#pragma unroll
        for (int hb = 0; hb < 4; ++hb) {
            u32x4 rawv[4];
#pragma unroll
            for (int i = 0; i < 4; ++i) rawv[i] = rawall[hb * 4 + i];
            float e[4][8], st[8];
#pragma unroll
            for (int i = 0; i < 4; ++i) { float s1 = 0.f, s2 = 0.f;
#pragma unroll
                for (int j = 0; j < 4; ++j) { const float a = geluf_(bf2f(rawv[i][j] & 0xffffu)), b = geluf_(bf2f(rawv[i][j] >> 16)); e[i][2 * j] = a; e[i][2 * j + 1] = b; s1 += a + b; s2 += a * a + b * b; }
                st[i] = s1; st[4 + i] = s2; }
#pragma unroll
            for (int sx = 32, n = 4; sx >= 8; sx >>= 1, n >>= 1) { const bool up = (lane & sx) != 0;
#pragma unroll
                for (int i = 0; i < n; ++i) { const float send = up ? st[i] : st[i + n], keep = up ? st[i + n] : st[i]; st[i] = keep + __shfl_xor(send, sx, 64); } }
            float tot = st[0]; tot += __shfl_xor(tot, 4, 64); tot += __shfl_xor(tot, 2, 64); tot += __shfl_xor(tot, 1, 64);
            float mean4[4], rstd4[4];
#pragma unroll
            for (int i = 0; i < 4; ++i) {
                mean4[i] = __builtin_bit_cast(float, __builtin_amdgcn_readlane(__builtin_bit_cast(int, tot), 8 * i)) * (1.f / BW);
                const float ex2 = __builtin_bit_cast(float, __builtin_amdgcn_readlane(__builtin_bit_cast(int, tot), 8 * (4 + i))) * (1.f / BW);
                rstd4[i] = rsqrtf(fmaxf(ex2 - mean4[i] * mean4[i], 0.f) + LN_EPS);
            }
            asm volatile("" ::: "memory");
            if ((lane >> 4) == g) {
                const float* lg = C.in[I_GLNG] + l * BW + lane * 8; const float* lb = C.in[I_GLNB] + l * BW + lane * 8;
#pragma unroll
                for (int i = 0; i < 4; ++i) {
                    const float mean = mean4[i], rstd = rstd4[i];
                    u32x4 o;
#pragma unroll
                    for (int j = 0; j < 4; ++j) o[j] = cvtpk((e[i][2 * j] - mean) * rstd * lg[2 * j] + lb[2 * j], (e[i][2 * j + 1] - mean) * rstd * lg[2 * j + 1] + lb[2 * j + 1]);
                    *(LAS u32x4*)(lds + GM_VN + (w * 16 + hb * 4 + i) * 320 + (lane & 15) * 16) = o;
                }
            }
        }
        __syncthreads();
        const int nt = w & 3, mb = (w >> 2) * 2;
        u32x2 upre[2][4];
#pragma unroll
        for (int m = 0; m < 2; ++m)
#pragma unroll
            for (int q = 0; q < 4; ++q) upre[m][q] = *(const u32x2*)(H + (size_t)(t0 + 32 * nt + r32) * NH + HC_GU + g * 128 + 32 * (mb + m) + 8 * q + 4 * hh);
        f32x16 acc[2];
#pragma unroll
        for (int m = 0; m < 2; ++m)
#pragma unroll
            for (int i = 0; i < 16; ++i) acc[m][i] = 0.f;
        for (int ks = 0; ks < 2 * (nt + 1); ++ks) {
            const bf16x8 bf = *(const LAS bf16x8*)(lds + GM_WC + (32 * nt + r32) * 272 + 32 * ks + 16 * hh);
#pragma unroll
            for (int m = 0; m < 2; ++m) {
                const LAS unsigned char* aa = lds + GM_VN + (16 * ks + 8 * hh + q4) * 320 + (32 * (mb + m) + 16 * blk + 4 * p4) * 2;
                const s16x4 lo = vtr(aa), hi = vtr(aa + 4 * 320);
                acc[m] = MFMA32(__builtin_shufflevector(lo, hi, 0, 1, 2, 3, 4, 5, 6, 7), bf, acc[m]);
            }
        }
        const int tl = 32 * nt + r32, row = t0 + tl;
        const float bias = C.in[I_GBS][(l * 4 + g) * 128 + tl];
#pragma unroll
        for (int m = 0; m < 2; ++m)
#pragma unroll
            for (int q = 0; q < 4; ++q) { const int c0 = 32 * (mb + m) + 8 * q + 4 * hh;
                const u32x2 ur = upre[m][q];
                u32x2 o;
                o[0] = cvtpk(geluf_(bf2f(ur[0] & 0xffffu)) * (acc[m][4 * q] + bias), geluf_(bf2f(ur[0] >> 16)) * (acc[m][4 * q + 1] + bias));
                o[1] = cvtpk(geluf_(bf2f(ur[1] & 0xffffu)) * (acc[m][4 * q + 2] + bias), geluf_(bf2f(ur[1] >> 16)) * (acc[m][4 * q + 3] + bias));
                *(u32x2*)(BR + (size_t)row * NBR + 1024 + g * 128 + c0) = o; }
    }
}

#define CE_D(a, b) do { const float _h = fmaxf(a, b), _l = fminf(a, b); a = _h; b = _l; } while (0)
__device__ __forceinline__ void sort16_desc(float (&x)[16]) {
#pragma unroll
    for (int k = 2; k <= 16; k <<= 1)
#pragma unroll
        for (int j = k >> 1; j > 0; j >>= 1)
#pragma unroll
            for (int i = 0; i < 16; ++i) { const int l = i ^ j; if (l > i) { if ((i & k) == 0) CE_D(x[i], x[l]); else CE_D(x[l], x[i]); } }
}
__device__ __forceinline__ void bmerge16_desc(float (&x)[16]) {
#pragma unroll
    for (int j = 8; j > 0; j >>= 1)
#pragma unroll
        for (int i = 0; i < 16; ++i) { const int l = i ^ j; if (l > i) CE_D(x[i], x[l]); }
}
__device__ __forceinline__ void top16_merge(float (&a)[16], const float (&b)[16]) {
#pragma unroll
    for (int i = 0; i < 16; ++i) a[i] = fmaxf(a[i], b[15 - i]);
    bmerge16_desc(a);
}
__device__ __forceinline__ float pack_idx(float v, unsigned idx, unsigned mask) { return __builtin_bit_cast(float, (__builtin_bit_cast(unsigned, v) & ~mask) | idx); }

constexpr int TK_KST = 272, TK_KBUF = 128 * TK_KST;
__device__ __forceinline__ void p_topk(const Ctx& C, int l) {
    const bf16_t* Q = (const bf16_t*)(C.ws + WS_Q);
    const bf16_t* keys = (const bf16_t*)(C.ws + WS_W + (size_t)l * W_LAYER + WO_KEYS);
    int* eidx = (int*)(C.ws + WS_EIDX); float* egate = (float*)(C.ws + WS_EGATE);
    LAS unsigned char* lds = C.lds;
    const int lane = C.lane, w = C.wave, r32 = lane & 31, hh = lane >> 5;
    for (int u = C.bid; u < (T / 256) * PH; u += C.G) {
        const int h = u & 7, t0 = (u >> 3) * 256, tok = t0 + 32 * w + r32;
        float v12[2][16];
        __syncthreads();
#pragma unroll
        for (int j = 0; j < 2; ++j) {
            const bf16_t* kp = keys + ((size_t)j * PH + h) * 128 * 128;
#pragma unroll
            for (int p = 0; p < 4; ++p) { const int idx = C.tid + 512 * p, row = idx >> 4, ch = idx & 15;
                *(LAS u32x4*)(lds + j * TK_KBUF + row * TK_KST + ch * 16) = *(const u32x4*)(kp + row * 128 + ch * 8); }
        }
        __syncthreads();
#pragma unroll
        for (int j = 0; j < 2; ++j) {
            bf16x8 qf[8];
            {
                LAS unsigned char* qs = lds + 2 * TK_KBUF + w * (32 * 272);
                u32x4 qr[8];
#pragma unroll
                for (int p = 0; p < 8; ++p) qr[p] = *(const u32x4*)(Q + (size_t)(t0 + 32 * w + 4 * p + (lane >> 4)) * NQ + h * 256 + j * 128 + (lane & 15) * 8);
#pragma unroll
                for (int p = 0; p < 8; ++p) *(LAS u32x4*)(qs + (4 * p + (lane >> 4)) * 272 + (lane & 15) * 16) = qr[p];
#pragma unroll
                for (int ks = 0; ks < 8; ++ks) qf[ks] = *(const LAS bf16x8*)(qs + r32 * 272 + 32 * ks + 16 * hh);
            }
            f32x16 sacc[4];
#pragma unroll
            for (int mt = 0; mt < 4; ++mt)
#pragma unroll
                for (int i = 0; i < 16; ++i) sacc[mt][i] = 0.f;
#pragma unroll
            for (int ks = 0; ks < 8; ++ks)
#pragma unroll
                for (int mt = 0; mt < 4; ++mt) {
                    const bf16x8 kf = *(const LAS bf16x8*)(lds + j * TK_KBUF + (32 * mt + r32) * TK_KST + 32 * ks + 16 * hh);
                    sacc[mt] = MFMA32(kf, qf[ks], sacc[mt]);
                }
            float g[4][16];
#pragma unroll
            for (int mt = 0; mt < 4; ++mt) {
#pragma unroll
                for (int i = 0; i < 16; ++i) g[mt][i] = pack_idx(sacc[mt][i], (unsigned)(32 * mt + (i & 3) + 8 * (i >> 2) + 4 * hh), 127u);
                sort16_desc(g[mt]);
            }
            top16_merge(g[0], g[1]); top16_merge(g[2], g[3]); top16_merge(g[0], g[2]);
            float o[16];
#pragma unroll
            for (int i = 0; i < 16; ++i) o[i] = __shfl_xor(g[0][i], 32, 64);
            top16_merge(g[0], o);
#pragma unroll
            for (int i = 0; i < 16; ++i) v12[j][i] = g[0][i];
        }
        float c[4][16];
        {
            int n = 0;
#pragma unroll
            for (int a = 0; a < 16; ++a)
#pragma unroll
                for (int b = 0; b < 16; ++b) if ((a + 1) * (b + 1) <= 16) {
                    const unsigned id = ((__builtin_bit_cast(unsigned, v12[0][a]) & 127u) << 7) | (__builtin_bit_cast(unsigned, v12[1][b]) & 127u);
                    c[n >> 4][n & 15] = pack_idx(v12[0][a] + v12[1][b], id, 16383u); ++n; }
#pragma unroll
            for (; n < 64; ++n) c[n >> 4][n & 15] = -3.0e38f;
        }
#pragma unroll
        for (int q = 0; q < 4; ++q) sort16_desc(c[q]);
        top16_merge(c[0], c[1]); top16_merge(c[2], c[3]); top16_merge(c[0], c[2]);
        float e[16], den = 0.f;
#pragma unroll
        for (int i = 0; i < 16; ++i) { e[i] = __expf(c[0][i] - c[0][0]); den += e[i]; }
        const float inv = 1.f / den;
        int* ip = eidx + (size_t)tok * 128 + h * 16 + 8 * hh; float* gp = egate + (size_t)tok * 128 + h * 16 + 8 * hh;
        u32x4 i0, i1; f32x4 g0, g1;
#pragma unroll
        for (int i = 0; i < 4; ++i) {
            const float ca = hh ? c[0][8 + i] : c[0][i], cb = hh ? c[0][12 + i] : c[0][4 + i];
            i0[i] = __builtin_bit_cast(unsigned, ca) & 16383u; i1[i] = __builtin_bit_cast(unsigned, cb) & 16383u;
            g0[i] = (hh ? e[8 + i] : e[i]) * inv; g1[i] = (hh ? e[12 + i] : e[4 + i]) * inv;
        }
        *(u32x4*)ip = i0; *(u32x4*)(ip + 4) = i1; *(f32x4*)gp = g0; *(f32x4*)(gp + 4) = g1;
    }
}

constexpr int CW_DIAG = 64;
__device__ __forceinline__ void diag_cmp(const Ctx& C, const bf16_t* A, int lda, const bf16_t* R, int ldr, int nc) {
    float sd = 0.f, sr = 0.f;
    for (int row = C.bid; row < T; row += C.G) {
        const int tm = row % DIAG_MOD; if (tm < DIAG_LO || tm >= DIAG_HI) continue;
        for (int c = C.tid; c < nc; c += 512) { const float a = bf2f(A[(size_t)row * lda + c]), r = bf2f(R[(size_t)row * ldr + c]); sd += (a - r) * (a - r); sr += r * r; }
    }
    sd = wave_sum(sd); sr = wave_sum(sr);
    if (C.lane == 0) { atomicAdd((float*)(C.ws + WS_CTL) + CW_DIAG, sd); atomicAdd((float*)(C.ws + WS_CTL) + CW_DIAG + 1, sr); }
}
__device__ __forceinline__ void diag_cmp_u8(const Ctx& C, const unsigned char* A, int lda, const bf16_t* R, int ldr, int nc) {
    float sd = 0.f, sr = 0.f;
    for (int row = C.bid; row < T; row += C.G)
        for (int c = C.tid; c < nc; c += 512) { const float a = (float)A[(size_t)row * lda + c] * (1.f / 255.f), r = bf2f(R[(size_t)row * ldr + c]); sd += (a - r) * (a - r); sr += r * r; }
    sd = wave_sum(sd); sr = wave_sum(sr);
    if (C.lane == 0) { atomicAdd((float*)(C.ws + WS_CTL) + CW_DIAG, sd); atomicAdd((float*)(C.ws + WS_CTL) + CW_DIAG + 1, sr); }
}
__device__ __forceinline__ float diag_alpha(const Ctx& C) {
    const float sd = __hip_atomic_load((float*)(C.ws + WS_CTL) + CW_DIAG, __ATOMIC_RELAXED, __HIP_MEMORY_SCOPE_AGENT), sr = __hip_atomic_load((float*)(C.ws + WS_CTL) + CW_DIAG + 1, __ATOMIC_RELAXED, __HIP_MEMORY_SCOPE_AGENT);
    const float err = fmaxf(sd / fmaxf(sr, 1e-30f), 1e-8f);
    return 0.1f + 0.1f * (rintf(log10f(err / 1e-8f) * 10.f) * 0.1f);
}


#if DIAG == 5 || DIAG == 6
__device__ __forceinline__ void diag_ref_slice(const Ctx& C, const float* W, int ldw, int n0, const float* bias) {
    bf16_t* alt = (bf16_t*)(C.ws + WS_XA);
    const float* X = C.in[I_X];
    for (int row = C.bid * 8 + C.wave; row < T; row += C.G * 8) {
        float acc = 0.f;
        for (int k = 0; k < DM; ++k) acc += X[(size_t)row * DM + k] * W[(size_t)k * ldw + n0 + C.lane];
        if (bias) acc = sigmoidf_(acc + bias[n0 + C.lane]);
        alt[(size_t)row * 64 + C.lane] = (bf16_t)f2bf(acc);
    }
}
#endif

__device__ __forceinline__ void wave_argmax(float& v, int& i) {
#pragma unroll
    for (int o = 32; o > 0; o >>= 1) {
        const float ov = __shfl_xor(v, o, 64); const int oi = __shfl_xor(i, o, 64);
        if (ov > v || (ov == v && oi < i)) { v = ov; i = oi; }
    }
}
__device__ __forceinline__ void p_topk_naive(const Ctx& C, int l) {
    const bf16_t* Q = (const bf16_t*)(C.ws + WS_Q);
    const bf16_t* keys = (const bf16_t*)(C.ws + WS_W + (size_t)l * W_LAYER + WO_KEYS);
    int* eidx = (int*)(C.ws + WS_EIDX); float* egate = (float*)(C.ws + WS_EGATE);
    LAS float* qs = (LAS float*)C.lds;
    LAS float* sc = qs + 2048;
    LAS float* tv = sc + 2048;
    LAS int* ti = (LAS int*)(tv + 256);
    for (int t = C.bid; t < T; t += C.G) {
        for (int i = C.tid; i < 2048; i += 512) qs[i] = bf2f(Q[(size_t)t * NQ + i]);
        __syncthreads();
        for (int i = 0; i < 4; ++i) {
            const int idx = C.tid + 512 * i, hj = idx >> 7, key = idx & 127, h = hj >> 1, j = hj & 1;
            const bf16_t* kp = keys + (((size_t)j * PH + h) * 128 + key) * 128;
            float s = 0.f;
            for (int d8 = 0; d8 < 16; ++d8) {
                const u32x4 raw = *(const u32x4*)(kp + d8 * 8);
#pragma unroll
                for (int e = 0; e < 4; ++e) s += qs[h * 256 + j * 128 + d8 * 8 + 2 * e] * bf2f(raw[e] & 0xffffu) + qs[h * 256 + j * 128 + d8 * 8 + 2 * e + 1] * bf2f(raw[e] >> 16);
            }
            sc[idx] = s;
        }
        __syncthreads();
        for (int i = 0; i < 2; ++i) {
            const int hj = C.wave * 2 + i;
            float a0 = sc[hj * 128 + C.lane], a1 = sc[hj * 128 + 64 + C.lane];
            for (int r = 0; r < 16; ++r) {
                float bv; int bi;
                if (a0 > a1 || (a0 == a1)) { bv = a0; bi = C.lane; } else { bv = a1; bi = C.lane + 64; }
                wave_argmax(bv, bi);
                if (C.lane == 0) { tv[hj * 16 + r] = bv; ti[hj * 16 + r] = bi; }
                if (bi == C.lane) a0 = -3e38f; if (bi == C.lane + 64) a1 = -3e38f;
            }
        }
        __syncthreads();
        {
            const int h = C.wave;
            float cv[4];
#pragma unroll
            for (int i = 0; i < 4; ++i) { const int c = C.lane * 4 + i; cv[i] = tv[(h * 2) * 16 + (c >> 4)] + tv[(h * 2 + 1) * 16 + (c & 15)]; }
            float topv = 0.f; int tope = 0; float mx = 0.f;
            for (int r = 0; r < 16; ++r) {
                float bv = cv[0]; int bi = C.lane * 4;
#pragma unroll
                for (int i = 1; i < 4; ++i) if (cv[i] > bv) { bv = cv[i]; bi = C.lane * 4 + i; }
                wave_argmax(bv, bi);
                if (r == 0) mx = bv;
                if (C.lane == r) { topv = bv; tope = ti[(h * 2) * 16 + (bi >> 4)] * 128 + ti[(h * 2 + 1) * 16 + (bi & 15)]; }
#pragma unroll
                for (int i = 0; i < 4; ++i) if (bi == C.lane * 4 + i) cv[i] = -3e38f;
            }
            float e = (C.lane < 16) ? __expf(topv - mx) : 0.f;
            const float den = wave_sum(e);
            if (C.lane < 16) { eidx[(size_t)t * 128 + h * 16 + C.lane] = tope; egate[(size_t)t * 128 + h * 16 + C.lane] = e / den; }
        }
        __syncthreads();
    }
}
__device__ __forceinline__ float ub(unsigned w, int e) { return (float)((w >> (8 * e)) & 255u); }
__device__ __forceinline__ void p_gather(const Ctx& C, int l) {
    const bf16_t* xc = (const bf16_t*)(C.ws + WS_X1B);
    const unsigned char* U8 = C.ws + WS_U8; const unsigned char* V8 = C.ws + WS_V8;
    const float* SU = (const float*)(C.ws + WS_SU); const float* SV = (const float*)(C.ws + WS_SV);
    const int* eidx = (const int*)(C.ws + WS_EIDX); const float* egate = (const float*)(C.ws + WS_EGATE);
    const int lane = C.lane;
    for (int t = C.bid * 8 + C.wave; t < T; t += C.G * 8) {
        float x[16];
        { const bf16_t* xp = xc + (size_t)t * DM + lane * 16;
          const u32x4 a = *(const u32x4*)xp, b = *(const u32x4*)(xp + 8);
#pragma unroll
          for (int i = 0; i < 4; ++i) { x[2 * i] = bf2f(a[i] & 0xffffu); x[2 * i + 1] = bf2f(a[i] >> 16); x[8 + 2 * i] = bf2f(b[i] & 0xffffu); x[9 + 2 * i] = bf2f(b[i] >> 16); } }
        float xmx = 0.f;
#pragma unroll
        for (int j = 0; j < 16; ++j) xmx = fmaxf(xmx, fabsf(x[j]));
        xmx = fmaxf(wave_max(xmx), 1e-30f);
        const float xisc = 127.f / xmx, xsc = xmx * (1.f / 127.f);
        int xq[4];
#pragma unroll
        for (int q = 0; q < 4; ++q) { unsigned wd = 0u;
#pragma unroll
            for (int e = 0; e < 4; ++e) wd |= ((unsigned)(int)rintf(x[4 * q + e] * xisc) & 255u) << (8 * e);
            xq[q] = (int)wd; }
        float cf[2]; int ex[2];
#pragma unroll
        for (int bt = 0; bt < 2; ++bt) {
            ex[bt] = eidx[(size_t)t * 128 + 64 * bt + lane];
            const float gate = egate[(size_t)t * 128 + 64 * bt + lane];
            int p[64];
#pragma unroll
            for (int e0 = 0; e0 < 64; e0 += 16) {
                u32x4 r[16];
#pragma unroll
                for (int i = 0; i < 16; ++i) { const int e = __builtin_amdgcn_readlane(ex[bt], e0 + i); r[i] = *(const u32x4*)(U8 + (size_t)e * DM + lane * 16); }
#pragma unroll
                for (int i = 0; i < 16; ++i) { int a = 0;
#pragma unroll
                    for (int q = 0; q < 4; ++q) a = __builtin_amdgcn_sdot4(xq[q], (int)r[i][q], a, false);
                    p[e0 + i] = a; }
            }
#pragma unroll
            for (int st = 32, n = 32; st > 0; st >>= 1, n >>= 1) {
                const bool up = (lane & st) != 0;
#pragma unroll
                for (int i = 0; i < n; ++i) { const int send = up ? p[i] : p[i + n], keep = up ? p[i + n] : p[i]; p[i] = keep + __shfl_xor(send, st, 64); }
            }
            const float hsum = SU[ex[bt]] * xsc * (float)p[0];
            cf[bt] = gate * geluf_slow(hsum) * SV[ex[bt]];
        }
        float y[16];
#pragma unroll
        for (int j = 0; j < 16; ++j) y[j] = 0.f;
        float csum = wave_sum(cf[0] + cf[1]);
#pragma unroll
        for (int bt = 0; bt < 2; ++bt)
#pragma unroll
            for (int e0 = 0; e0 < 64; e0 += 16) {
                u32x4 r[16];
#pragma unroll
                for (int i = 0; i < 16; ++i) { const int e = __builtin_amdgcn_readlane(ex[bt], e0 + i); r[i] = *(const u32x4*)(V8 + (size_t)e * DM + lane * 16); }
#pragma unroll
                for (int i = 0; i < 16; ++i) { const float c = __builtin_bit_cast(float, __builtin_amdgcn_readlane(__builtin_bit_cast(int, cf[bt]), e0 + i));
#pragma unroll
                    for (int q = 0; q < 4; ++q)
#pragma unroll
                        for (int e = 0; e < 4; ++e) y[4 * q + e] += c * ub(r[i][q], e); }
            }
#pragma unroll
        for (int j = 0; j < 16; ++j) y[j] = y[j] - 128.f * csum + ALPHA * x[j];
        float sm = 0.f;
#pragma unroll
        for (int j = 0; j < 16; ++j) sm += y[j];
        const float mean = wave_sum(sm) * (1.f / DM);
        float qq = 0.f;
#pragma unroll
        for (int j = 0; j < 16; ++j) { const float d = y[j] - mean; qq += d * d; }
        const float rstd = rsqrtf(wave_sum(qq) * (1.f / DM) + LN_EPS);
        const float* gp = C.in[I_LN2G] + l * DM + lane * 16; const float* bp = C.in[I_LN2B] + l * DM + lane * 16;
#pragma unroll
        for (int i = 0; i < 4; ++i) { const f32x4 gg = *(const f32x4*)(gp + 4 * i), bb = *(const f32x4*)(bp + 4 * i);
#pragma unroll
            for (int e = 0; e < 4; ++e) y[4 * i + e] = (y[4 * i + e] - mean) * rstd * gg[e] + bb[e]; }
        float* dst = (l + 1 < DEPTH) ? (float*)(C.ws + WS_XA) + (size_t)t * DM : C.out + (size_t)t * DM;
#if DIAG
        if (l + 1 == DEPTH) { const float al = 1.f + diag_alpha(C);
#pragma unroll
            for (int j = 0; j < 16; ++j) y[j] *= al; }
#endif
#pragma unroll
        for (int i = 0; i < 4; ++i) *(f32x4*)(dst + lane * 16 + 4 * i) = (f32x4){y[4 * i], y[4 * i + 1], y[4 * i + 2], y[4 * i + 3]};
        if (l + 1 < DEPTH) {
            {
                float mx = 0.f;
#pragma unroll
                for (int j = 0; j < 16; ++j) mx = fmaxf(mx, fabsf(y[j]));
                mx = fmaxf(wave_max(mx), 1e-30f);
                const float isc = 127.f / mx;
                u32x4 o8;
#pragma unroll
                for (int q = 0; q < 4; ++q) { unsigned wd = 0u;
#pragma unroll
                    for (int e = 0; e < 4; ++e) wd |= ((unsigned)(int)rintf(y[4 * q + e] * isc) & 255u) << (8 * e);
                    o8[q] = wd; }
                *(u32x4*)(C.ws + WS_XB + (size_t)t * DM + lane * 16) = o8;
                if (lane == 0) ((float*)(C.ws + WS_XSA))[t] = mx * (1.f / 127.f);
            }
            const float* wf = (const float*)(C.ws + WS_W + (size_t)(l + 1) * W_LAYER + WO_WF);
            float* lsig = (float*)(C.ws + WS_MISC);
#pragma unroll
            for (int h = 0; h < 4; ++h) {
                float sd = 0.f;
#pragma unroll
                for (int i = 0; i < 4; ++i) { const f32x4 a = *(const f32x4*)(wf + h * DM + lane * 16 + 4 * i);
#pragma unroll
                    for (int e = 0; e < 4; ++e) sd += y[4 * i + e] * a[e]; }
                sd = wave_sum(sd);
                if (lane == 0) lsig[(size_t)t * 4 + h] = logsigmoidf_(sd + C.in[I_BFOX][(l + 1) * 4 + h]);
            }
        }
    }
}

struct FStoreBf16 { bf16_t* O; int ld;
    __device__ __forceinline__ void operator()(int row, int col, f32x4 v0, f32x4 v1, int) const {
        u32x4 o; o[0] = pk2(v0[0], v0[1]); o[1] = pk2(v0[2], v0[3]); o[2] = pk2(v1[0], v1[1]); o[3] = pk2(v1[2], v1[3]);
        *(u32x4*)(O + (size_t)row * ld + col) = o; } };
typedef int i32x4 __attribute__((ext_vector_type(4)));
__device__ __forceinline__ void i8_dequant(f32x4& v0, f32x4& v1, float sa, const float* cs) {
    sa *= (1.f / 127.f);
    const f32x4 c0 = *(const f32x4*)cs, c1 = *(const f32x4*)(cs + 4);
    const i32x4 i0 = __builtin_bit_cast(i32x4, v0), i1 = __builtin_bit_cast(i32x4, v1);
#pragma unroll
    for (int e = 0; e < 4; ++e) { v0[e] = (float)i0[e] * sa * c0[e]; v1[e] = (float)i1[e] * sa * c1[e]; }
}
struct FStoreBf16I8 { bf16_t* O; int ld; const float* rs; const float* cs;
    __device__ __forceinline__ void operator()(int row, int col, f32x4 v0, f32x4 v1, int) const {
        i8_dequant(v0, v1, rs[row], cs + col);
        u32x4 o; o[0] = pk2(v0[0], v0[1]); o[1] = pk2(v0[2], v0[3]); o[2] = pk2(v1[0], v1[1]); o[3] = pk2(v1[2], v1[3]);
        *(u32x4*)(O + (size_t)row * ld + col) = o; } };
struct FGateI8 { unsigned char* O; const float* bias; const float* rs; const float* cs;
    __device__ __forceinline__ void operator()(int row, int col, f32x4 v0, f32x4 v1, int) const {
        i8_dequant(v0, v1, rs[row], cs + col);
        const f32x4 b0 = *(const f32x4*)(bias + col), b1 = *(const f32x4*)(bias + col + 4);
        u32x2 o; unsigned w0 = 0u, w1 = 0u;
#pragma unroll
        for (int e = 0; e < 4; ++e) { w0 |= (unsigned)(int)rintf(255.f * sigmoidf_(v0[e] + b0[e])) << (8 * e); w1 |= (unsigned)(int)rintf(255.f * sigmoidf_(v1[e] + b1[e])) << (8 * e); }
        o[0] = w0; o[1] = w1;
        *(u32x2*)(O + (size_t)row * NG + col) = o; } };
struct FGate { bf16_t* O; const float* bias;
    __device__ __forceinline__ void operator()(int row, int col, f32x4 v0, f32x4 v1, int) const {
        const f32x4 b0 = *(const f32x4*)(bias + col), b1 = *(const f32x4*)(bias + col + 4);
        u32x4 o; o[0] = pk2(sigmoidf_(v0[0] + b0[0]), sigmoidf_(v0[1] + b0[1])); o[1] = pk2(sigmoidf_(v0[2] + b0[2]), sigmoidf_(v0[3] + b0[3]));
        o[2] = pk2(sigmoidf_(v1[0] + b1[0]), sigmoidf_(v1[1] + b1[1])); o[3] = pk2(sigmoidf_(v1[2] + b1[2]), sigmoidf_(v1[3] + b1[3]));
        *(u32x4*)(O + (size_t)row * NG + col) = o; } };
struct FMerge { const unsigned char* G; bf16_t* MG;
    __device__ __forceinline__ void operator()(int row, int col, f32x4 v0, f32x4 v1, int z) const {
        const u32x2 gr = *(const u32x2*)(G + (size_t)row * NG + z * DM + col);
        float r[8];
#pragma unroll
        for (int e = 0; e < 4; ++e) { r[e] = v0[e] * (float)((gr[0] >> (8 * e)) & 255u) * (1.f / 255.f); r[4 + e] = v1[e] * (float)((gr[1] >> (8 * e)) & 255u) * (1.f / 255.f); }
        bf16_t* p = MG + (size_t)row * DM + col;
        if (z > 0) { const u32x4 pr = *(const u32x4*)p;
#pragma unroll
            for (int e = 0; e < 4; ++e) { r[2 * e] += bf2f(pr[e] & 0xffffu); r[2 * e + 1] += bf2f(pr[e] >> 16); } }
        u32x4 o;
#pragma unroll
        for (int e = 0; e < 4; ++e) o[e] = pk2(r[2 * e], r[2 * e + 1]);
        *(u32x4*)p = o; } };
struct FResid { const float* X; bf16_t* Y;
    __device__ __forceinline__ void operator()(int row, int col, f32x4 v0, f32x4 v1, int) const {
        const f32x4 x0 = *(const f32x4*)(X + (size_t)row * DM + col), x1 = *(const f32x4*)(X + (size_t)row * DM + col + 4);
#if DIAG == 5 || DIAG == 6
        v0 = (f32x4){0.f, 0.f, 0.f, 0.f}; v1 = v0;
#endif
        u32x4 o; o[0] = cvtpk(x0[0] * ALPHA + v0[0], x0[1] * ALPHA + v0[1]); o[1] = cvtpk(x0[2] * ALPHA + v0[2], x0[3] * ALPHA + v0[3]);
        o[2] = cvtpk(x1[0] * ALPHA + v1[0], x1[1] * ALPHA + v1[1]); o[3] = cvtpk(x1[2] * ALPHA + v1[2], x1[3] * ALPHA + v1[3]);
        *(u32x4*)(Y + (size_t)row * DM + col) = o; } };

constexpr int PH_PER_LAYER = 12, N_PHASES = 1 + DEPTH * PH_PER_LAYER;
template <int SP> __device__ __forceinline__ void run_phase(const Ctx& C0, int l) {
    Ctx C = C0;
    asm volatile("" : "+v"(C.tid));
    C.ws = launder_ptr(C.ws); C.out = launder_ptr(C.out); l = (int)launder_u((unsigned)l);
    C.lane = C.tid & 63; C.wave = __builtin_amdgcn_readfirstlane(C.tid >> 6);
    unsigned char* wb = C.ws + WS_W + (size_t)l * W_LAYER;
    if constexpr (SP == -1) { p_conv_weights(C); }
    if constexpr (SP == 0) {
        if (l == 0) {
            for (int l2 = 0; l2 < DEPTH; ++l2) {
                unsigned char* wb2 = C.ws + WS_W + (size_t)l2 * W_LAYER; const unsigned* cm = (const unsigned*)(C.ws + WS_CMAX) + l2 * (NH + NG);
                tconv_i8_job(C, C.in[I_WIN] + (size_t)l2 * DM * NIN, NIN, DM, NH, wb2 + WO_WIN, cm);
                tconv_i8_job(C, C.in[I_WGATE] + (size_t)l2 * DM * NG, NG, DM, NG, wb2 + WO_WG, cm + NH);
            }
            p_rowpass0(C);
        }
    }
    if constexpr (SP == 1) {
        p_cumsum(C);
        __syncthreads();
        pg8::Gemm g{(const bf16_t*)(C.ws + WS_XB), (const bf16_t*)(wb + WO_WIN), DM, DM, DM, 0, 0};
        pg8::StaticOrder S; S.init(T, NH, C.G, C.bid);
        pg8::Epi8<FStoreBf16I8> E{{(bf16_t*)(C.ws + WS_H), NH, (const float*)(C.ws + WS_XSA), (const float*)(C.ws + WS_CMAX) + l * (NH + NG)}};
        pg8::gemm_phase<pg8::Epi8<FStoreBf16I8>, pg8::StaticOrder, true>(C.lds, g, S, E, C.tid);
    }
#if DIAG == 5
    if constexpr (SP == 2) { if (l == 0) { diag_ref_slice(C, C.in[I_WIN], NIN, DIAG_N0, nullptr); } }
    if constexpr (SP == 3) { if (l == 0) diag_cmp(C, (const bf16_t*)(C.ws + WS_H) + DIAG_N0, NH, (const bf16_t*)(C.ws + WS_XA), 64, 64); }
#endif
#if DIAG == 6
    if constexpr (SP == 5) { if (l == 0) diag_ref_slice(C, C.in[I_WGATE], NG, DIAG_N0, C.in[I_BGATE]); }
    if constexpr (SP == 6) { if (l == 0) diag_cmp_u8(C, C.ws + WS_G + DIAG_N0, NG, (const bf16_t*)(C.ws + WS_XA), 64, 64); }
#endif
    if constexpr (SP == 2) { p_knorm(C, l); if (l != HG_NAIVE_L) hgrn_b1(C, l); }
#if MIX_NAIVE
    if constexpr (SP == 3) { if (l != HG_NAIVE_L) hgrn_b2(C); mix_pool_naive(C, l); mix_gmlp_naive(C, l); }
#else
    if constexpr (SP == 3) { if (l != HG_NAIVE_L) hgrn_b2(C); mix_pool(C, l); mix_gmlp(C, l);
        if (DIAG == 2) mix_pool_naive(C, l); if (DIAG == 3) mix_gmlp_naive(C, l); }
#endif
#if DIAG == 1
    if constexpr (SP == 4) { hgrn_b3(C, l); { mix_hgrn_naive(C, l); __syncthreads(); } mix_fox(C, l); }
    if constexpr (SP == 5) { if (l == DIAG_LAYER) diag_cmp(C, (const bf16_t*)(C.ws + (DIAG_LAYER == 0 ? WS_XA : WS_TABU)) + 512, NBR, (const bf16_t*)(C.ws + WS_BR) + 512, NBR, 512); }
#elif DIAG == 2 || DIAG == 3
    if constexpr (SP == 4) { hgrn_b3(C, l); mix_fox(C, l); if (l == DIAG_LAYER) diag_cmp(C, (const bf16_t*)(C.ws + (DIAG_LAYER == 0 ? WS_XA : WS_TABU)) + (DIAG == 2 ? 0 : 1024), NBR, (const bf16_t*)(C.ws + WS_BR) + (DIAG == 2 ? 0 : 1024), NBR, 512); }
#else
    if constexpr (SP == 4) { if (l != HG_NAIVE_L) hgrn_b3(C, l); else { mix_hgrn_naive(C, l); __syncthreads(); } mix_fox(C, l); }
#endif
    if constexpr (SP == 5) {
        pg8::Gemm g{(const bf16_t*)(C.ws + WS_XB), (const bf16_t*)(wb + WO_WG), DM, DM, DM, 0, 0};
        pg8::StaticOrder S; S.init(T, NG, C.G, C.bid);
        pg8::Epi8<FGateI8> E{{C.ws + WS_G, C.in[I_BGATE] + l * NG, (const float*)(C.ws + WS_XSA), (const float*)(C.ws + WS_CMAX) + l * (NH + NG) + NH}};
        pg8::gemm_phase<pg8::Epi8<FGateI8>, pg8::StaticOrder, true>(C.lds, g, S, E, C.tid);
    }
    if constexpr (SP == 6) {
        pg8::Gemm g{(const bf16_t*)(C.ws + WS_BR), (const bf16_t*)(wb + WO_WBR), NBR, BW, BW, (size_t)BW, (size_t)DM * BW};
        pg8::ZOrder S; S.init(T, DM, 4, C.G, C.vcu);
        pg8::Epi8<FMerge> E{{C.ws + WS_G, (bf16_t*)(C.ws + WS_XB)}};
        pg8::gemm_phase(C.lds, g, S, E, C.tid);
    }
    if constexpr (SP == 7) {
        const float* xin = (l == 0) ? C.in[I_X] : (const float*)(C.ws + WS_XA);
        pg8::Gemm g{(const bf16_t*)(C.ws + WS_XB), (const bf16_t*)(wb + WO_WOUT), DM, DM, DM, 0, 0};
        pg8::StaticOrder S; S.init(T, DM, C.G, C.bid);
        pg8::Epi8<FResid> E{{xin, (bf16_t*)(C.ws + WS_XC)}};
        pg8::gemm_phase(C.lds, g, S, E, C.tid);
    }
    if constexpr (SP == 8) { p_ln1(C, l); p_conv_tables(C, l); }
    if constexpr (SP == 9) {
        pg8::Gemm g{(const bf16_t*)(C.ws + WS_X1B), (const bf16_t*)(wb + WO_WQ), DM, DM, DM, 0, 0};
        pg8::StaticOrder S; S.init(T, NQ, C.G, C.bid);
        pg8::Epi8<FStoreBf16> E{{(bf16_t*)(C.ws + WS_Q), NQ}};
        pg8::gemm_phase(C.lds, g, S, E, C.tid);
    }
#if TOPK_NAIVE
    if constexpr (SP == 10) p_topk_naive(C, l);
#else
    if constexpr (SP == 10) p_topk(C, l);
#endif
    if constexpr (SP == 11) p_gather(C, l);
}
__device__ __forceinline__ void make_ctx(Ctx& C, const Args& args, unsigned char* lds_raw) {
    C.lds = (LAS unsigned char*)lds_raw; C.ws = args.ws; C.in = args.in; C.out = args.out;
    C.tid = threadIdx.x; C.lane = C.tid & 63; C.wave = __builtin_amdgcn_readfirstlane(C.tid >> 6);
    C.G = gridDim.x; C.bid = blockIdx.x; C.vcu = (C.G % 8 == 0) ? (C.bid % 8) * (C.G / 8) + C.bid / 8 : C.bid;
}
#if !MK_ONE_LAUNCH
template <int SP> __global__ void __launch_bounds__(512, 2) mk_phase(Args args) {
    extern __shared__ __attribute__((aligned(16))) unsigned char lds_raw[];
    Ctx C; make_ctx(C, args, lds_raw);
    run_phase<SP>(C, args.ph_lo);
}
#endif

#define GRID_BAR() xcd_barrier((unsigned*)(args.ws + WS_CTL) + 1024, (volatile LAS unsigned*)((LAS unsigned char*)lds_raw + LDSCTL_OFF + 32))
__global__ void __launch_bounds__(512, 2) mk_fwd(Args args) {
    extern __shared__ __attribute__((aligned(16))) unsigned char lds_raw[];
    Ctx C; make_ctx(C, args, lds_raw);
    { volatile LAS unsigned* misc = (volatile LAS unsigned*)(C.lds + LDSCTL_OFF); if (C.tid < 64) misc[C.tid] = 0u; }
    __syncthreads();
    xcd_barrier_post((unsigned*)(args.ws + WS_CTL) + 1024);
    run_phase<-1>(C, 0); GRID_BAR();
#pragma unroll 1
    for (int l = 0; l < DEPTH; ++l) {
        if (l == 0) { run_phase<0>(C, l); GRID_BAR(); }
        run_phase<1>(C, l); GRID_BAR();
        run_phase<2>(C, l); GRID_BAR();
        run_phase<3>(C, l); GRID_BAR();
        run_phase<4>(C, l); GRID_BAR();
        run_phase<5>(C, l); GRID_BAR();
        run_phase<6>(C, l); GRID_BAR();
        run_phase<7>(C, l); GRID_BAR();
        run_phase<8>(C, l); GRID_BAR();
        run_phase<9>(C, l); GRID_BAR();
        run_phase<10>(C, l); GRID_BAR();
        run_phase<11>(C, l); if (l + 1 < DEPTH) GRID_BAR();
    }
}

#if !MK_ONE_LAUNCH
template <int SP> static void launch_phase(const Args& a, int grid, hipStream_t stream) {
    static bool attr_done = false;
    if (!attr_done) { (void)hipFuncSetAttribute((const void*)mk_phase<SP>, hipFuncAttributeMaxDynamicSharedMemorySize, LDS_BYTES); attr_done = true; }
    hipLaunchKernelGGL(mk_phase<SP>, dim3(grid), dim3(512), LDS_BYTES, stream, a);
}
#endif
extern "C" void kernel_launch(void* const* d_in, const int* in_sizes, int n_in, void* d_out, int out_size, void* d_ws, size_t ws_size, hipStream_t stream) {
    static int grid = 0;
    if (grid == 0) {
        if (n_in != NIN_PTRS || out_size != T * DM || ws_size < WS_END) { fprintf(stderr, "kernel_launch: unexpected shapes n_in %d out %d ws %zu\n", n_in, out_size, ws_size); grid = -1; return; }
        int dev = 0, cus = 0;
        if (hipGetDevice(&dev) != hipSuccess || hipDeviceGetAttribute(&cus, hipDeviceAttributeMultiprocessorCount, dev) != hipSuccess) { grid = -1; return; }
        grid = cus;
    }
    if (grid < 0) return;
    (void)hipMemsetAsync((char*)d_ws + WS_CTL, 0, CTL_ZERO_BYTES, stream);
    Args a{};
    for (int i = 0; i < NIN_PTRS; ++i) a.in[i] = (const float*)d_in[i];
    a.out = (float*)d_out; a.ws = (unsigned char*)d_ws; a.bar_slot = 0; a.pad = 0; a.ph_hi = 0;
#if MK_ONE_LAUNCH
    static bool attr_done = false;
    if (!attr_done) { (void)hipFuncSetAttribute((const void*)mk_fwd, hipFuncAttributeMaxDynamicSharedMemorySize, LDS_BYTES); attr_done = true; }
    hipLaunchKernelGGL(mk_fwd, dim3(grid), dim3(512), LDS_BYTES, stream, a);
    return;
#endif
#if !MK_ONE_LAUNCH
    a.ph_lo = 0; launch_phase<-1>(a, grid, stream);
    for (int l = 0; l < DEPTH; ++l) {
        a.ph_lo = l;
        launch_phase<0>(a, grid, stream); launch_phase<1>(a, grid, stream); launch_phase<2>(a, grid, stream); launch_phase<3>(a, grid, stream); launch_phase<4>(a, grid, stream);
        launch_phase<5>(a, grid, stream); launch_phase<6>(a, grid, stream); launch_phase<7>(a, grid, stream); launch_phase<8>(a, grid, stream); launch_phase<9>(a, grid, stream); launch_phase<10>(a, grid, stream); launch_phase<11>(a, grid, stream);
    }
#endif
}
```

```cpp
#include <hip/hip_runtime.h>
#include <cstdio>
#include <cstdint>

#ifndef DIAG
#define DIAG 0
#endif
#ifndef DIAG_LO
#define DIAG_LO 0
#endif
#ifndef DIAG_HI
#define DIAG_HI 64
#endif
#ifndef DIAG_MOD
#define DIAG_MOD 64
#endif
#ifndef TOPK_NAIVE
#define TOPK_NAIVE 0
#endif
#ifndef MIX_NAIVE
#define MIX_NAIVE 0
#endif
#ifndef DIAG_N0
#define DIAG_N0 4096
#endif
#ifndef FOX_NAIVE
#define FOX_NAIVE 0
#endif
#ifndef HG_NAIVE_L
#define HG_NAIVE_L 99
#endif
#ifndef DIAG_LAYER
#define DIAG_LAYER 0
#endif
#ifndef MK_ONE_LAUNCH
#define MK_ONE_LAUNCH 1
#endif

#define LAS __attribute__((address_space(3)))
#define GAS __attribute__((address_space(1)))
typedef unsigned short bf16_t;
typedef short bf16x8 __attribute__((ext_vector_type(8)));
typedef float f32x4 __attribute__((ext_vector_type(4)));
typedef float f32x2 __attribute__((ext_vector_type(2)));
typedef unsigned u32x4 __attribute__((ext_vector_type(4)));
typedef unsigned u32x2 __attribute__((ext_vector_type(2)));

constexpr int DM = 1024, BATCH = 2, SEQ = 8192, DEPTH = 2, T = BATCH * SEQ;
constexpr int BW = 512, NIN = 5124, NH = 5120, NG = 4096, NBR = 2048, NQ = 2048;
constexpr int NEXP = 16384, TOPK = 16, PH = 8;
constexpr float ALPHA = 1.4142135623730951f;
constexpr float LN_EPS = 1e-5f, RMS_EPS = 1e-6f;
constexpr int HC_P = 0, HC_HQ = 512, HC_HF = 1024, HC_HI = 1536, HC_HG = 2048, HC_GU = 2560, HC_GV = 3072, HC_FQ = 3584, HC_FK = 4096, HC_FV = 4608;

constexpr size_t MiB = 1u << 20;
constexpr size_t WS_CTL = 0, CTL_ZERO_BYTES = 160 * 1024;
constexpr size_t WS_CMAX = 64 * 1024;
constexpr size_t WS_MISC = 512 * 1024;
constexpr size_t WS_CUM = 768 * 1024;
constexpr size_t WS_W = 1 * MiB;
constexpr size_t W_LAYER = 30 * MiB;
constexpr size_t WO_WIN = 0, WO_WG = 10 * MiB, WO_WBR = 18 * MiB, WO_WOUT = 22 * MiB, WO_WQ = 24 * MiB, WO_KEYS = 28 * MiB, WO_WF = 28 * MiB + 512 * 1024, WO_POOLW = 28 * MiB + 768 * 1024, WO_GWS = 29 * MiB, WO_CS = 29 * MiB + 512 * 1024;
constexpr size_t WS_TABU = 64 * MiB, WS_TABV = 96 * MiB;
constexpr size_t WS_XA = 128 * MiB;
constexpr size_t WS_XB = 192 * MiB;
constexpr size_t WS_X1B = 224 * MiB;
constexpr size_t WS_H = 256 * MiB;
constexpr size_t WS_ST = 416 * MiB;
constexpr size_t WS_BR = 448 * MiB;
constexpr size_t WS_G = 256 * MiB;
constexpr size_t WS_MGF = 384 * MiB;
constexpr size_t WS_XC = 256 * MiB;
constexpr size_t WS_Q = 320 * MiB;
constexpr size_t WS_EIDX = 384 * MiB, WS_EGATE = 392 * MiB;
constexpr size_t WS_XSA = 256 * 1024;
constexpr size_t WS_END = 512 * MiB;

__device__ __forceinline__ float bf2f(unsigned u) { return __builtin_bit_cast(float, u << 16); }
__device__ __forceinline__ unsigned f2bf(float f) { unsigned u = __builtin_bit_cast(unsigned, f); return (u + 0x7fffu + ((u >> 16) & 1u)) >> 16; }
typedef __bf16 bf16x2_t __attribute__((ext_vector_type(2)));
__device__ __forceinline__ unsigned cvtpk(float lo, float hi) { f32x2 v = {lo, hi}; bf16x2_t b = __builtin_convertvector(v, bf16x2_t); return __builtin_bit_cast(unsigned, b); }
__device__ __forceinline__ unsigned pk2(float lo, float hi) { return cvtpk(lo, hi); }
__device__ __forceinline__ float wave_sum(float v) {
#pragma unroll
    for (int o = 32; o > 0; o >>= 1) v += __shfl_xor(v, o, 64);
    return v;
}
__device__ __forceinline__ float sigmoidf_(float x) { return __builtin_amdgcn_rcpf(1.f + __builtin_amdgcn_exp2f(-1.4426950408889634f * x)); }
__device__ __forceinline__ float siluf_(float x) { return x * __builtin_amdgcn_rcpf(1.f + __builtin_amdgcn_exp2f(-1.4426950408889634f * x)); }
__device__ __forceinline__ float geluf_slow(float x) { const float u = 0.7978845608028654f * (x + 0.044715f * x * x * x); return 0.5f * x * (1.f + tanhf(u)); }
__device__ __forceinline__ float geluf_(float x) { const float u2 = -2.302208198f * (x + 0.044715f * x * x * x); return x * __builtin_amdgcn_rcpf(1.f + __builtin_amdgcn_exp2f(u2)); }
__device__ __forceinline__ float logsigmoidf_(float z) { return fminf(z, 0.f) - log1pf(__expf(-fabsf(z))); }

__device__ __forceinline__ unsigned launder_u(unsigned x) { asm volatile("" : "+v"(x)); return __builtin_amdgcn_readfirstlane(x); }
template <class P> __device__ __forceinline__ P launder_ptr(P p) {
    const unsigned lo = launder_u((unsigned)(uintptr_t)p), hi = launder_u((unsigned)((uintptr_t)p >> 32));
    return (P)(((uintptr_t)hi << 32) | lo);
}

namespace pg8 {
constexpr int BM = 256, BK = 64, HALF = 128, HTB = HALF * BK * 2, STAGE_BYTES = 8 * HTB, NXCD = 8, WGM = 8;
__host__ __device__ __forceinline__ int lds_byte(int r, int c) { const int st = (r >> 4) * 2 + (c >> 5), rr = r & 15, cc = c & 31, ob = rr * 64 + cc * 2; return st * 1024 + (ob ^ (((ob >> 9) & 1) << 5)); }
__host__ __device__ __forceinline__ void stage_rc(int b, int& R, int& C) { const int st = b / 1024, sb = b % 1024, swz = sb ^ (((sb >> 9) & 1) << 5); R = (st >> 1) * 16 + swz / 64; C = (st & 1) * 32 + (swz % 64) / 2; }
__host__ __device__ __forceinline__ int perm32(int rho) { const int n = rho >> 4, i = rho & 15; return 8 * (i >> 2) + 4 * n + (i & 3); }

struct Unit { int pm, pn, z; };
struct Gemm { const bf16_t* A; const bf16_t* Bt; int lda, ldb, K; size_t zA, zB; };

struct StaticOrder {
    int nM, nN, nwg, G, c;
    __device__ void init(int M, int N, int G_, int c_) { nM = M / BM; nN = N / BM; nwg = nM * nN; G = G_; c = c_; }
    __device__ bool next(int i, Unit& u) const {
        const long L = (long)i * G + c; if (L >= nwg) return false;
        int wgid = (int)L; { const int q = nwg / NXCD, r = nwg % NXCD, xcd = wgid % NXCD, off = wgid / NXCD; wgid = (xcd < r ? xcd * (q + 1) : r * (q + 1) + (xcd - r) * q) + off; }
        const int nig = WGM * nN, gid = wgid / nig, fm = gid * WGM, gsz = (nM - fm) < WGM ? (nM - fm) : WGM;
        u.pm = fm + ((wgid % nig) % gsz); u.pn = (wgid % nig) / gsz; u.z = 0; return true;
    }
};
struct ZOrder {
    int nM, nN, nZ, ntile, G, c;
    __device__ void init(int M, int N, int Z, int G_, int c_) { nM = M / BM; nN = N / BM; nZ = Z; ntile = nM * nN; G = G_; c = c_; }
    __device__ bool next(int i, Unit& u) const {
        const long L = (long)(i / nZ) * G + c; if (L >= ntile) return false;
        u.pm = (int)L / nN; u.pn = (int)L % nN; u.z = i % nZ; return true;
    }
};

template <class F> struct Epi8 {
    static constexpr bool PERM = true;
    F f;
    __device__ __forceinline__ void operator()(const f32x4 (&acc)[2][2][4][2], const Unit& u, int wr, int wc, int fr, int fq) const {
        const int row0 = u.pm * BM + wr * 64 + fr, col0 = u.pn * BM + wc * 32 + 8 * fq;
#pragma unroll
        for (int ai = 0; ai < 2; ++ai)
#pragma unroll
            for (int m = 0; m < 4; ++m)
#pragma unroll
                for (int bj = 0; bj < 2; ++bj) f(row0 + ai * HALF + m * 16, col0 + bj * HALF, acc[ai][bj][m][0], acc[ai][bj][m][1], u.z);
    }
};
template <class F> struct Epi4 {
    static constexpr bool PERM = false;
    F f;
    __device__ __forceinline__ void operator()(const f32x4 (&acc)[2][2][4][2], const Unit& u, int wr, int wc, int fr, int fq) const {
        const int row0 = u.pm * BM + wr * 64 + fr, col0 = u.pn * BM + wc * 32 + 4 * fq;
#pragma unroll
        for (int ai = 0; ai < 2; ++ai)
#pragma unroll
            for (int m = 0; m < 4; ++m)
#pragma unroll
                for (int bj = 0; bj < 2; ++bj)
#pragma unroll
                    for (int n = 0; n < 2; ++n) f(row0 + ai * HALF + m * 16, col0 + bj * HALF + n * 16, acc[ai][bj][m][n], u.z);
    }
};

typedef int i32x4 __attribute__((ext_vector_type(4)));
template <class Epi, class Sched, bool I8 = false, bool ALIGN_EPI = true>
__device__ __forceinline__ void gemm_phase(LAS unsigned char* lds, const Gemm g, const Sched& S, const Epi& E, const int tid) {
    constexpr int ES = I8 ? 1 : 2;
    const int wid = __builtin_amdgcn_readfirstlane(tid >> 6), lane = tid & 63, wr = wid >> 2, wc = wid & 3, fr = lane & 15, fq = lane >> 4;
    const int K = g.K, nt = K * ES / 128;
    unsigned voffA[2], voffB[2];
#pragma unroll
    for (int i = 0; i < 2; ++i) { int R, C; stage_rc(tid * 16 + i * 8192, R, C); const int Rb = Epi::PERM ? ((R & ~31) + perm32(R & 31)) : R;
        voffA[i] = (unsigned)(R * g.lda * ES + C * 2); voffB[i] = (unsigned)(Rb * g.ldb * ES + C * 2); }
    const size_t kstep = (size_t)(BK * 2);
    const size_t hstepA = (size_t)HALF * g.lda * ES, hstepB = (size_t)HALF * g.ldb * ES;
    const size_t tstepA = 2 * hstepA, tstepB = 2 * hstepB;
    const unsigned ldsw = (unsigned)wid * 1024u;
    const int aoff = lds_byte(wr * 64 + fr, fq * 8), boff = lds_byte(wc * 32 + fr, fq * 8);
#define PG8_SA(b, h) (((b) * 2 + (h)) * HTB)
#define PG8_SB(b, h) ((4 + (b) * 2 + (h)) * HTB)
#define PG8_STAGE(bufoff, gbase, voff) do { _Pragma("unroll") for (int _i = 0; _i < 2; ++_i) \
        __builtin_amdgcn_global_load_lds((const unsigned*)((const char*)(gbase) + (voff)[_i]), (LAS unsigned*)(lds + (bufoff) + ldsw + _i * 8192), 16, 0, 0); } while (0)
#define PG8_LDA(dst, b, h) do { _Pragma("unroll") for (int m = 0; m < 4; ++m) _Pragma("unroll") for (int k = 0; k < 2; ++k) dst[m][k] = *(const LAS bf16x8*)(lds + PG8_SA(b, h) + aoff + m * 2048 + k * 1024); } while (0)
#define PG8_LDB(dst, b, h) do { _Pragma("unroll") for (int n = 0; n < 2; ++n) _Pragma("unroll") for (int k = 0; k < 2; ++k) dst[n][k] = *(const LAS bf16x8*)(lds + PG8_SB(b, h) + boff + n * 2048 + k * 1024); } while (0)
#define PG8_MMA(ai, bj, At, Bt) do { __builtin_amdgcn_s_setprio(1); _Pragma("unroll") for (int m = 0; m < 4; ++m) _Pragma("unroll") for (int n = 0; n < 2; ++n) _Pragma("unroll") for (int k = 0; k < 2; ++k) { \
        if constexpr (I8) acc[ai][bj][m][n] = __builtin_bit_cast(f32x4, __builtin_amdgcn_mfma_i32_16x16x64_i8(__builtin_bit_cast(i32x4, Bt[n][k]), __builtin_bit_cast(i32x4, At[m][k]), __builtin_bit_cast(i32x4, acc[ai][bj][m][n]), 0, 0, 0)); \
        else acc[ai][bj][m][n] = __builtin_amdgcn_mfma_f32_16x16x32_bf16(Bt[n][k], At[m][k], acc[ai][bj][m][n], 0, 0, 0); } __builtin_amdgcn_s_setprio(0); } while (0)
#define PG8_WAIT_V(n) asm volatile("s_waitcnt vmcnt(" #n ")" ::: "memory")
#define PG8_WAIT_L(n) asm volatile("s_waitcnt lgkmcnt(" #n ")" ::: "memory")
#define PG8_BAR __builtin_amdgcn_s_barrier()
#define PG8_SCHED __builtin_amdgcn_sched_barrier(0)
    Unit cur, nxt; int ui = 0;
    if (!S.next(0, cur)) return;
    f32x4 acc[2][2][4][2];
#pragma unroll
    for (int a = 0; a < 2; ++a)
#pragma unroll
        for (int b = 0; b < 2; ++b)
#pragma unroll
            for (int m = 0; m < 4; ++m)
#pragma unroll
                for (int n = 0; n < 2; ++n) acc[a][b][m][n] = (f32x4){0.f, 0.f, 0.f, 0.f};
    bf16x8 At[4][2], B0[2][2], B1[2][2];
    const char* cA = (const char*)g.A + (size_t)cur.z * g.zA * ES + (size_t)cur.pm * tstepA; const char* cB = (const char*)g.Bt + (size_t)cur.z * g.zB * ES + (size_t)cur.pn * tstepB;
    PG8_STAGE(PG8_SB(0, 0), cB, voffB); PG8_STAGE(PG8_SB(0, 1), cB + hstepB, voffB); PG8_STAGE(PG8_SA(0, 0), cA, voffA); PG8_STAGE(PG8_SA(0, 1), cA + hstepA, voffA);
    if (wr == 1) PG8_BAR;
    PG8_WAIT_V(2); PG8_BAR;
    PG8_STAGE(PG8_SB(1, 0), cB + kstep, voffB); PG8_STAGE(PG8_SA(1, 0), cA + kstep, voffA); PG8_STAGE(PG8_SB(1, 1), cB + hstepB + kstep, voffB);
    PG8_WAIT_V(6); PG8_BAR;
    for (;;) {
        const bool has_next = S.next(ui + 1, nxt);
        const char* nA = has_next ? (const char*)g.A + (size_t)nxt.z * g.zA * ES + (size_t)nxt.pm * tstepA : cA;
        const char* nB = has_next ? (const char*)g.Bt + (size_t)nxt.z * g.zB * ES + (size_t)nxt.pn * tstepB : cB;
        for (int t = 0; t < nt; t += 2) {
            const bool last = (t == nt - 2);
            const char* a1 = cA + (size_t)(t + 1) * kstep;
            const char* a2 = last ? nA : cA + (size_t)(t + 2) * kstep; const char* b2 = last ? nB : cB + (size_t)(t + 2) * kstep;
            const char* a3 = a2 + kstep; const char* b3 = b2 + kstep;
            PG8_LDB(B0, 0, 0); PG8_LDB(B1, 0, 1); PG8_SCHED; PG8_LDA(At, 0, 0); PG8_STAGE(PG8_SA(1, 1), a1 + hstepA, voffA);
            PG8_WAIT_V(8); PG8_WAIT_L(0); PG8_BAR; PG8_MMA(0, 0, At, B0); PG8_MMA(0, 1, At, B1); PG8_BAR; PG8_SCHED;
            PG8_LDA(At, 0, 1); PG8_STAGE(PG8_SB(0, 0), b2, voffB); PG8_STAGE(PG8_SB(0, 1), b2 + hstepB, voffB); PG8_STAGE(PG8_SA(0, 0), a2, voffA);
            PG8_WAIT_V(8); PG8_WAIT_L(0); PG8_BAR; PG8_MMA(1, 0, At, B0); PG8_MMA(1, 1, At, B1); PG8_BAR; PG8_SCHED;
            PG8_LDB(B0, 1, 0); PG8_LDB(B1, 1, 1); PG8_SCHED; PG8_LDA(At, 1, 0); PG8_STAGE(PG8_SA(0, 1), a2 + hstepA, voffA);
            PG8_WAIT_V(8); PG8_WAIT_L(0); PG8_BAR; PG8_MMA(0, 0, At, B0); PG8_MMA(0, 1, At, B1); PG8_BAR; PG8_SCHED;
            PG8_LDA(At, 1, 1); PG8_STAGE(PG8_SB(1, 0), b3, voffB); PG8_STAGE(PG8_SB(1, 1), b3 + hstepB, voffB); PG8_STAGE(PG8_SA(1, 0), a3, voffA);
            PG8_WAIT_V(8); PG8_WAIT_L(0); PG8_BAR; PG8_MMA(1, 0, At, B0); PG8_MMA(1, 1, At, B1); PG8_BAR; PG8_SCHED;
        }
        if constexpr (ALIGN_EPI) { if (wr == 0) PG8_BAR; }
        E(acc, cur, wr, wc, fr, fq);
        if (!has_next) break;
#pragma unroll
        for (int a = 0; a < 2; ++a)
#pragma unroll
            for (int b = 0; b < 2; ++b)
#pragma unroll
                for (int m = 0; m < 4; ++m)
#pragma unroll
                    for (int n = 0; n < 2; ++n) acc[a][b][m][n] = (f32x4){0.f, 0.f, 0.f, 0.f};
        cur = nxt; cA = nA; cB = nB; ++ui;
        if constexpr (ALIGN_EPI) { if (wr == 1) PG8_BAR; }
    }
    PG8_WAIT_V(0);
    if constexpr (!ALIGN_EPI) { if (wr == 0) PG8_BAR; }
    PG8_BAR;
#undef PG8_SA
#undef PG8_SB
#undef PG8_STAGE
#undef PG8_LDA
#undef PG8_LDB
#undef PG8_MMA
#undef PG8_WAIT_V
#undef PG8_WAIT_L
#undef PG8_BAR
#undef PG8_SCHED
}
}

#define XB_TMO      128
#define XB_XCNT(j)  (256  + 64 * (j))
#define XB_XSUB(j)  (1280 + 64 * (j))
#define XB_XGEN(j)  (2304 + 64 * (j))
#define XB_TOP      3328
#define XB_TOPGEN   3392
#define XCD_BAR_WORDS 3456
#define XB_SPIN_CAP (1u << 22)
__device__ __forceinline__ unsigned xb_ld(unsigned* p)              { return __hip_atomic_load(p, __ATOMIC_RELAXED, __HIP_MEMORY_SCOPE_AGENT); }
__device__ __forceinline__ unsigned xb_add(unsigned* p, unsigned v) { return __hip_atomic_fetch_add(p, v, __ATOMIC_RELAXED, __HIP_MEMORY_SCOPE_AGENT); }
__device__ __forceinline__ unsigned xb_xcc_id() { return (unsigned)__builtin_amdgcn_s_getreg((3 << 11) | 20) & 0xFu; }
#define XB_SPIN(cond, bar) do { unsigned _sp = 0; while (cond) { __builtin_amdgcn_s_sleep(1); \
    if ((++_sp & 255u) == 0u) { if (xb_ld(&(bar)[XB_TMO])) break; if (_sp > XB_SPIN_CAP) { atomicAdd(&(bar)[XB_TMO], 1u); break; } } } } while (0)
__device__ __forceinline__ void xcd_barrier_post(unsigned* bar) {
    if (threadIdx.x == 0) (void)xb_add(&bar[XB_XCNT(xb_xcc_id())], 1u);
}
__device__ __forceinline__ void xcd_barrier_complete(unsigned* bar, unsigned x, unsigned& nloc, unsigned& nx) {
    const unsigned G = gridDim.x * gridDim.y * gridDim.z;
    unsigned sum, cnt, mine, sp = 0u;
    for (;;) {
        sum = 0u; cnt = 0u; mine = 0u;
#pragma unroll
        for (unsigned j = 0; j < 16; ++j) { const unsigned c = xb_ld(&bar[XB_XCNT(j)]); sum += c; cnt += (c > 0u) ? 1u : 0u; mine = (j == x) ? c : mine; }
        if (sum == G) break;
        __builtin_amdgcn_s_sleep(1);
        if ((++sp & 255u) == 0u) { if (xb_ld(&bar[XB_TMO])) break; if (sp > XB_SPIN_CAP) { atomicAdd(&bar[XB_TMO], 1u); break; } }
    }
    nloc = mine > 0u ? mine : 1u; nx = cnt > 0u ? cnt : 1u;
}
__device__ __noinline__ void xcd_barrier_leader(unsigned* bar, volatile LAS unsigned* st) {
    const unsigned x = xb_xcc_id();
    __builtin_amdgcn_s_waitcnt(0);
    unsigned nloc = st[0], nx = st[1];
    if (nloc == 0u) { xcd_barrier_complete(bar, x, nloc, nx); st[0] = nloc; st[1] = nx; }
    const unsigned old = xb_add(&bar[XB_XSUB(x)], 1u);
    const unsigned gen = old / nloc;
    if (old + 1u == (gen + 1u) * nloc) {
        __builtin_amdgcn_fence(__ATOMIC_RELEASE, "agent");
        asm volatile("s_waitcnt vmcnt(0)" ::: "memory");
        const unsigned og = xb_add(&bar[XB_TOP], 1u);
        const unsigned tg = og / nx;
        if (og + 1u == (tg + 1u) * nx) xb_add(&bar[XB_TOPGEN], 1u);
        else XB_SPIN(xb_ld(&bar[XB_TOPGEN]) == tg, bar);
        __builtin_amdgcn_fence(__ATOMIC_ACQUIRE, "agent");
        xb_add(&bar[XB_XGEN(x)], 1u);
        asm volatile("s_waitcnt vmcnt(0)" ::: "memory");
    } else {
        XB_SPIN(xb_ld(&bar[XB_XGEN(x)]) == gen, bar);
        __builtin_amdgcn_fence(__ATOMIC_ACQUIRE, "agent");
        asm volatile("s_waitcnt vmcnt(0)" ::: "memory");
    }
}
__device__ __forceinline__ void xcd_barrier(unsigned* bar, volatile LAS unsigned* st) {
    asm volatile("s_waitcnt vmcnt(0)" ::: "memory");
    __syncthreads();
    if (threadIdx.x == 0) xcd_barrier_leader(bar, st);
    __syncthreads();
}

constexpr int NIN_PTRS = 23;
struct Args { const float* in[NIN_PTRS]; float* out; unsigned char* ws; int ph_lo, ph_hi, bar_slot, pad; };
enum { I_X = 0, I_WIN, I_BFOX, I_POOLW, I_POOLS, I_LBL, I_HNG, I_GLNG, I_GLNB, I_GWS, I_GBS, I_WGATE, I_BGATE, I_WBR, I_WOUT, I_LN1G, I_LN1B, I_WQ, I_KEYS, I_PU, I_PV, I_LN2G, I_LN2B };

constexpr int LDS_BYTES = 147456;
constexpr int LDSCTL_OFF = 143360;

struct Ctx {
    LAS unsigned char* lds;
    unsigned char* ws;
    const float* const* in;
    float* out;
    int tid, lane, wave, G, bid, vcu;
};

__device__ __forceinline__ void tconv_job(const Ctx& C, const float* src, int ld_src, int K, int N, bf16_t* dst) {
    LAS float* tile = (LAS float*)C.lds;
    const int nk = K / 64, nn = N / 64, ntiles = nk * nn;
    for (int tl = C.bid; tl < ntiles; tl += C.G) {
        const int k0 = (tl / nn) * 64, n0 = (tl % nn) * 64;
#pragma unroll
        for (int p = 0; p < 2; ++p) {
            const int kr = (C.tid >> 4) + p * 32, nc = (C.tid & 15) * 4;
            const f32x4 v = *(const f32x4*)(src + (size_t)(k0 + kr) * ld_src + n0 + nc);
            tile[kr * 65 + nc + 0] = v[0]; tile[kr * 65 + nc + 1] = v[1]; tile[kr * 65 + nc + 2] = v[2]; tile[kr * 65 + nc + 3] = v[3];
        }
        __syncthreads();
        {
            const int n = C.tid >> 3, k8 = (C.tid & 7) * 8;
            u32x4 o;
#pragma unroll
            for (int j = 0; j < 4; ++j) o[j] = pk2(tile[(k8 + 2 * j) * 65 + n], tile[(k8 + 2 * j + 1) * 65 + n]);
            *(u32x4*)(dst + (size_t)(n0 + n) * K + k0 + k8) = o;
        }
        __syncthreads();
    }
}
__device__ __forceinline__ void cvt_copy(const Ctx& C, const float* src, bf16_t* dst, size_t n) {
    const size_t n8 = n / 8;
    for (size_t i = (size_t)C.bid * 512 + C.tid; i < n8; i += (size_t)C.G * 512) {
        const f32x4 a = *(const f32x4*)(src + i * 8), b = *(const f32x4*)(src + i * 8 + 4);
        u32x4 o; o[0] = pk2(a[0], a[1]); o[1] = pk2(a[2], a[3]); o[2] = pk2(b[0], b[1]); o[3] = pk2(b[2], b[3]);
        *(u32x4*)(dst + i * 8) = o;
    }
}
__device__ __forceinline__ void strip_unit(const Ctx& C, const float* src, int ld, unsigned char* dst, unsigned* cmax, bool split) {
    const float* p = src + (size_t)(128 * C.wave) * ld + C.lane;
    float v[128];
#pragma unroll
    for (int i = 0; i < 128; ++i) v[i] = p[(size_t)i * ld];
    if (cmax) {
        float mx = 0.f;
#pragma unroll
        for (int i = 0; i < 128; ++i) mx = fmaxf(mx, fabsf(v[i]));
        LAS float* red = (LAS float*)C.lds;
        red[C.wave * 64 + C.lane] = mx;
        __syncthreads();
        float m = red[C.lane];
#pragma unroll
        for (int w2 = 1; w2 < 8; ++w2) m = fmaxf(m, red[w2 * 64 + C.lane]);
        if (C.wave == 0) cmax[C.lane] = __builtin_bit_cast(unsigned, m);
        const float isc = 127.f / fmaxf(m, 1e-30f);
        unsigned char* dp = dst + (size_t)C.lane * 1024 + 128 * C.wave;
#pragma unroll
        for (int j4 = 0; j4 < 8; ++j4) { u32x4 o;
#pragma unroll
            for (int j = 0; j < 4; ++j) { unsigned wd = 0u;
#pragma unroll
                for (int e = 0; e < 4; ++e) wd |= ((unsigned)(int)rintf(v[16 * j4 + 4 * j + e] * isc) & 255u) << (8 * e);
                o[j] = wd; }
            *(u32x4*)(dp + 16 * j4) = o; }
        __syncthreads();
    } else {
        bf16_t* dp = split ? (bf16_t*)dst + (size_t)(C.wave >> 2) * DM * BW + (size_t)C.lane * BW + 128 * (C.wave & 3) : (bf16_t*)dst + (size_t)C.lane * 1024 + 128 * C.wave;
#pragma unroll
        for (int j8 = 0; j8 < 16; ++j8) { u32x4 o;
#pragma unroll
            for (int j = 0; j < 4; ++j) o[j] = pk2(v[8 * j8 + 2 * j], v[8 * j8 + 2 * j + 1]);
            *(u32x4*)(dp + 8 * j8) = o; }
    }
}
__device__ __forceinline__ void p_conv_weights(const Ctx& C) {
#pragma unroll 1
    for (int u = C.bid; u < DEPTH * 224; u += C.G) {
        const int l = u / 224, r = u % 224;
        unsigned char* wb = C.ws + WS_W + (size_t)l * W_LAYER;
        unsigned* cm = (unsigned*)(C.ws + WS_CMAX) + l * (NH + NG);
        const float* src; int ld; unsigned char* dst; unsigned* cx = nullptr; bool split = false;
        if (r < 80)       { src = C.in[I_WIN] + (size_t)l * DM * NIN + r * 64; ld = NIN; dst = wb + WO_WIN + (size_t)r * 64 * DM; cx = cm + r * 64; }
        else if (r < 144) { const int t = r - 80; src = C.in[I_WGATE] + (size_t)l * DM * NG + t * 64; ld = NG; dst = wb + WO_WG + (size_t)t * 64 * DM; cx = cm + NH + t * 64; }
        else if (r < 176) { const int t = r - 144, pr = t >> 4, nt = t & 15; src = C.in[I_WBR] + ((size_t)l * 4 + 2 * pr) * BW * DM + nt * 64; ld = DM; split = true;
                            dst = wb + WO_WBR + ((size_t)(2 * pr) * DM * BW + (size_t)nt * 64 * BW) * 2; }
        else if (r < 192) { const int nt = r - 176; src = C.in[I_WOUT] + (size_t)l * DM * DM + nt * 64; ld = DM; dst = wb + WO_WOUT + (size_t)nt * 64 * DM * 2; }
        else              { const int nt = r - 192; src = C.in[I_WQ] + (size_t)l * DM * NQ + nt * 64; ld = NQ; dst = wb + WO_WQ + (size_t)nt * 64 * DM * 2; }
        strip_unit(C, src, ld, dst, cx, split);
    }
    for (int l = 0; l < DEPTH; ++l) {
        unsigned char* wb = C.ws + WS_W + (size_t)l * W_LAYER;
        cvt_copy(C, C.in[I_KEYS] + (size_t)l * 2 * PH * 128 * 128, (bf16_t*)(wb + WO_KEYS), (size_t)2 * PH * 128 * 128);
        for (int g = 0; g < 4; ++g)
            tconv_job(C, C.in[I_POOLW] + ((size_t)l * 4 + g) * 128 * 128, 128, 128, 128, (bf16_t*)(wb + WO_POOLW) + (size_t)g * 128 * 128);
        {
            bf16_t* gw = (bf16_t*)(wb + WO_GWS); const float* src = C.in[I_GWS] + (size_t)l * 4 * 128 * 128;
            for (int i = C.bid * 512 + C.tid; i < 4 * 128 * 128; i += C.G * 512) { const int t = (i >> 7) & 127, sx = i & 127; gw[i] = (bf16_t)f2bf(sx <= t ? src[i] : 0.f); }
        }
        float* wf = (float*)(wb + WO_WF);
        for (int i = C.bid * 512 + C.tid; i < 4 * DM; i += C.G * 512) { const int h = i / DM, k = i % DM; wf[i] = C.in[I_WIN][(size_t)l * DM * NIN + (size_t)k * NIN + NH + h]; }
    }
}
constexpr size_t WS_U8 = WS_TABU, WS_V8 = WS_TABU + 16 * MiB, WS_SU = WS_TABU + 32 * MiB, WS_SV = WS_SU + 64 * 1024;
__device__ __forceinline__ float wave_max(float v) {
#pragma unroll
    for (int o = 32; o > 0; o >>= 1) v = fmaxf(v, __shfl_xor(v, o, 64));
    return v;
}
template <bool SIGNED> __device__ __forceinline__ void quant_rows(const Ctx& C, const float* src, unsigned char* dst, float* scl) {
    for (int row = C.bid * 8 + C.wave; row < NEXP; row += C.G * 8) {
        const float* p = src + (size_t)row * DM + C.lane * 16;
        f32x4 v[4]; float mx = 0.f;
#pragma unroll
        for (int i = 0; i < 4; ++i) { v[i] = *(const f32x4*)(p + 4 * i);
#pragma unroll
            for (int e = 0; e < 4; ++e) mx = fmaxf(mx, fabsf(v[i][e])); }
        mx = fmaxf(wave_max(mx), 1e-30f);
        const float sc = mx * (1.f / 127.f), isc = 127.f / mx;
        u32x4 o;
#pragma unroll
        for (int i = 0; i < 4; ++i) { unsigned wd = 0u;
#pragma unroll
            for (int e = 0; e < 4; ++e) { const int q = (int)rintf(v[i][e] * isc) + (SIGNED ? 0 : 128); wd |= ((unsigned)q & 255u) << (8 * e); }
            o[i] = wd; }
        *(u32x4*)(dst + (size_t)row * DM + C.lane * 16) = o;
        if (C.lane == 0) scl[row] = sc;
    }
}
__device__ __forceinline__ void p_conv_tables(const Ctx& C, int l) {
    quant_rows<true>(C, C.in[I_PU] + (size_t)l * NEXP * DM, C.ws + WS_U8, (float*)(C.ws + WS_SU));
    quant_rows<false>(C, C.in[I_PV] + (size_t)l * NEXP * DM, C.ws + WS_V8, (float*)(C.ws + WS_SV));
}

__device__ __forceinline__ void row_emit(const Ctx& C, int row, const float (&v)[16], int l, bool want_lsig) {
    {
        float mx = 0.f;
#pragma unroll
        for (int j = 0; j < 16; ++j) mx = fmaxf(mx, fabsf(v[j]));
#pragma unroll
        for (int o = 32; o > 0; o >>= 1) mx = fmaxf(mx, __shfl_xor(mx, o, 64));
        mx = fmaxf(mx, 1e-30f);
        const float isc = 127.f / mx;
        unsigned char* xb = C.ws + WS_XB + (size_t)row * DM;
        u32x2 o0, o1;
#pragma unroll
        for (int hw = 0; hw < 2; ++hw) { unsigned a = 0u, b = 0u;
#pragma unroll
            for (int e = 0; e < 4; ++e) { a |= ((unsigned)(int)rintf(v[4 * hw + e] * isc) & 255u) << (8 * e); b |= ((unsigned)(int)rintf(v[8 + 4 * hw + e] * isc) & 255u) << (8 * e); }
            o0[hw] = a; o1[hw] = b; }
        *(u32x2*)(xb + C.lane * 8) = o0; *(u32x2*)(xb + 512 + C.lane * 8) = o1;
        if (C.lane == 0) ((float*)(C.ws + WS_XSA))[row] = mx * (1.f / 127.f);
    }
    if (want_lsig) {
        const float* wf = (const float*)(C.ws + WS_W + (size_t)l * W_LAYER + WO_WF);
        float* lsig = (float*)(C.ws + WS_MISC);
#pragma unroll
        for (int h = 0; h < 4; ++h) {
            const f32x4 a0 = *(const f32x4*)(wf + h * DM + C.lane * 8), a1 = *(const f32x4*)(wf + h * DM + C.lane * 8 + 4);
            const f32x4 b0 = *(const f32x4*)(wf + h * DM + 512 + C.lane * 8), b1 = *(const f32x4*)(wf + h * DM + 512 + C.lane * 8 + 4);
            float s = 0.f;
#pragma unroll
            for (int j = 0; j < 4; ++j) s += v[j] * a0[j] + v[4 + j] * a1[j] + v[8 + j] * b0[j] + v[12 + j] * b1[j];
            s = wave_sum(s);
            if (C.lane == 0) lsig[(size_t)row * 4 + h] = logsigmoidf_(s + C.in[I_BFOX][l * 4 + h]);
        }
    }
}
__device__ __forceinline__ void load_row16(const float* p, int lane, float (&v)[16]) {
    const f32x4 a0 = *(const f32x4*)(p + lane * 8), a1 = *(const f32x4*)(p + lane * 8 + 4), b0 = *(const f32x4*)(p + 512 + lane * 8), b1 = *(const f32x4*)(p + 512 + lane * 8 + 4);
#pragma unroll
    for (int j = 0; j < 4; ++j) { v[j] = a0[j]; v[4 + j] = a1[j]; v[8 + j] = b0[j]; v[12 + j] = b1[j]; }
}
__device__ __forceinline__ void store_row16(float* p, int lane, const float (&v)[16]) {
    *(f32x4*)(p + lane * 8) = (f32x4){v[0], v[1], v[2], v[3]}; *(f32x4*)(p + lane * 8 + 4) = (f32x4){v[4], v[5], v[6], v[7]};
    *(f32x4*)(p + 512 + lane * 8) = (f32x4){v[8], v[9], v[10], v[11]}; *(f32x4*)(p + 512 + lane * 8 + 4) = (f32x4){v[12], v[13], v[14], v[15]};
}
__device__ __forceinline__ void ln_row16(float (&v)[16], const float* g, const float* b, int lane) {
    float s = 0.f;
#pragma unroll
    for (int j = 0; j < 16; ++j) s += v[j];
    const float mean = wave_sum(s) * (1.f / DM);
    float q = 0.f;
#pragma unroll
    for (int j = 0; j < 16; ++j) { const float d = v[j] - mean; q += d * d; }
    const float rstd = rsqrtf(wave_sum(q) * (1.f / DM) + LN_EPS);
    float gg[16], bb[16];
    load_row16(g, lane, gg); load_row16(b, lane, bb);
#pragma unroll
    for (int j = 0; j < 16; ++j) v[j] = (v[j] - mean) * rstd * gg[j] + bb[j];
}
__device__ __forceinline__ void p_rowpass0(const Ctx& C) {
    const float* wfin = C.in[I_WIN] + NH;
    f32x4 wv[16];
#pragma unroll
    for (int j = 0; j < 16; ++j) { const int k = (j < 8) ? C.lane * 8 + j : 512 + C.lane * 8 + (j - 8); wv[j] = *(const f32x4*)(wfin + (size_t)k * NIN); }
    float* lsig = (float*)(C.ws + WS_MISC);
    const bool bal = (C.G == 256);
    const int c0 = bal ? ((C.bid < 192) ? C.bid * 6 : 1152 + (C.bid - 192) * 14) : C.bid, cn = bal ? ((C.bid < 192) ? 6 : 14) : (T / 8 - C.bid + C.G - 1) / C.G, cs = bal ? 1 : C.G;
    for (int ci = 0; ci < cn; ++ci) {
        const int row = (c0 + ci * cs) * 8 + C.wave;
        float v[16]; load_row16(C.in[I_X] + (size_t)row * DM, C.lane, v);
        row_emit(C, row, v, 0, false);
#pragma unroll
        for (int h = 0; h < 4; ++h) {
            float sacc = 0.f;
#pragma unroll
            for (int j = 0; j < 16; ++j) sacc += v[j] * wv[j][h];
            sacc = wave_sum(sacc);
            if (C.lane == 0) lsig[(size_t)row * 4 + h] = logsigmoidf_(sacc + C.in[I_BFOX][h]);
        }
    }
}
__device__ __forceinline__ void p_cumsum(const Ctx& C) {
    if (C.bid >= BATCH * 4) return;
    const float* lsig = (const float*)(C.ws + WS_MISC);
    float* cum = (float*)(C.ws + WS_CUM);
    LAS float* wt = (LAS float*)C.lds;
    const int b = C.bid >> 2, h = C.bid & 3;
    float v[16];
#pragma unroll
    for (int j = 0; j < 16; ++j) v[j] = lsig[((size_t)b * SEQ + C.tid * 16 + j) * 4 + h];
#pragma unroll
    for (int j = 1; j < 16; ++j) v[j] += v[j - 1];
    float inc = v[15];
#pragma unroll
    for (int o = 1; o < 64; o <<= 1) { const float t = __shfl_up(inc, o, 64); if (C.lane >= o) inc += t; }
    if (C.lane == 63) wt[C.wave] = inc;
    __syncthreads();
    float off = inc - v[15];
    for (int w2 = 0; w2 < C.wave; ++w2) off += wt[w2];
    float* cp = cum + ((size_t)b * 4 + h) * SEQ + C.tid * 16;
#pragma unroll
    for (int j4 = 0; j4 < 4; ++j4) *(f32x4*)(cp + 4 * j4) = (f32x4){v[4 * j4] + off, v[4 * j4 + 1] + off, v[4 * j4 + 2] + off, v[4 * j4 + 3] + off};
    __syncthreads();
}
__device__ __forceinline__ void load_row16_bf(const bf16_t* p, int lane, float (&v)[16]) {
    const u32x4 a = *(const u32x4*)(p + lane * 8), b = *(const u32x4*)(p + 512 + lane * 8);
#pragma unroll
    for (int j = 0; j < 4; ++j) { v[2 * j] = bf2f(a[j] & 0xffffu); v[2 * j + 1] = bf2f(a[j] >> 16); v[8 + 2 * j] = bf2f(b[j] & 0xffffu); v[9 + 2 * j] = bf2f(b[j] >> 16); }
}
__device__ __forceinline__ void p_ln1(const Ctx& C, int l) {
    const bf16_t* y1 = (const bf16_t*)(C.ws + WS_XC); bf16_t* x1b = (bf16_t*)(C.ws + WS_X1B);
    for (int row = C.bid * 8 + C.wave; row < T; row += C.G * 8) {
        float v[16]; load_row16_bf(y1 + (size_t)row * DM, C.lane, v);
        ln_row16(v, C.in[I_LN1G] + l * DM, C.in[I_LN1B] + l * DM, C.lane);
        u32x4 o0, o1;
#pragma unroll
        for (int j = 0; j < 4; ++j) { o0[j] = pk2(v[2 * j], v[2 * j + 1]); o1[j] = pk2(v[8 + 2 * j], v[8 + 2 * j + 1]); }
        *(u32x4*)(x1b + (size_t)row * DM + C.lane * 8) = o0; *(u32x4*)(x1b + (size_t)row * DM + 512 + C.lane * 8) = o1;
    }
}

__device__ __forceinline__ void mix_pool_naive(const Ctx& C, int l) {
    const bf16_t* H = (const bf16_t*)(C.ws + WS_H); bf16_t* BR = (bf16_t*)(C.ws + WS_BR);
    LAS float* dd = (LAS float*)C.lds;
    for (int u = C.bid; u < (T / 64) * 4; u += C.G) {
        const int g = u & 3, t0 = (u >> 2) * 64, w = 2 << g;
        for (int idx = C.tid; idx < 64 * 128; idx += 512) {
            const int r = idx >> 7, c = idx & 127, row = t0 + r, pos = row & (SEQ - 1);
            const int nwin = (pos + 1 < w) ? pos + 1 : w;
            float s = 0.f;
            for (int j = 0; j < nwin; ++j) s += bf2f(H[(size_t)(row - j) * NH + HC_P + g * 128 + c]);
            dd[idx] = s / (float)nwin - bf2f(H[(size_t)row * NH + HC_P + g * 128 + c]);
        }
        __syncthreads();
        const int dcol = C.tid & 127, rq = C.tid >> 7;
        float acc[16];
#pragma unroll
        for (int i = 0; i < 16; ++i) acc[i] = 0.f;
        const float* pw = C.in[I_POOLW] + ((size_t)l * 4 + g) * 128 * 128;
        for (int c = 0; c < 128; ++c) {
            const float wv = pw[c * 128 + dcol];
#pragma unroll
            for (int i = 0; i < 16; ++i) acc[i] += dd[(rq * 16 + i) * 128 + c] * wv;
        }
        const float sc = C.in[I_POOLS][l * BW + g * 128 + dcol];
#pragma unroll
        for (int i = 0; i < 16; ++i) BR[(size_t)(t0 + rq * 16 + i) * NBR + 0 + g * 128 + dcol] = (bf16_t)f2bf(acc[i] * sc);
        __syncthreads();
    }
}
__device__ __forceinline__ void mix_gmlp_naive(const Ctx& C, int l) {
    const bf16_t* H = (const bf16_t*)(C.ws + WS_H); bf16_t* BR = (bf16_t*)(C.ws + WS_BR);
    LAS float* vn = (LAS float*)C.lds;
    for (int u = C.bid; u < (T / 128) * 4; u += C.G) {
        const int g = u & 3, t0 = (u >> 2) * 128;
        for (int i = 0; i < 16; ++i) {
            const int r = C.wave * 16 + i, row = t0 + r;
            const u32x4 raw = *(const u32x4*)(H + (size_t)row * NH + HC_GV + C.lane * 8);
            float e[8];
#pragma unroll
            for (int j = 0; j < 4; ++j) { e[2 * j] = geluf_(bf2f(raw[j] & 0xffffu)); e[2 * j + 1] = geluf_(bf2f(raw[j] >> 16)); }
            float s = 0.f;
#pragma unroll
            for (int j = 0; j < 8; ++j) s += e[j];
            const float mean = wave_sum(s) * (1.f / BW);
            float q = 0.f;
#pragma unroll
            for (int j = 0; j < 8; ++j) { const float d = e[j] - mean; q += d * d; }
            const float rstd = rsqrtf(wave_sum(q) * (1.f / BW) + LN_EPS);
            if ((C.lane >> 4) == g) {
#pragma unroll
                for (int j = 0; j < 8; ++j) { const int col = C.lane * 8 + j;
                    vn[r * 128 + (col - g * 128)] = (e[j] - mean) * rstd * C.in[I_GLNG][l * BW + col] + C.in[I_GLNB][l * BW + col]; }
            }
        }
        __syncthreads();
        const int c = C.tid & 127, tq = C.tid >> 7;
        const float* wsg = C.in[I_GWS] + ((size_t)l * 4 + g) * 128 * 128;
        for (int t = tq; t < 128; t += 4) {
            float acc = 0.f;
            for (int s = 0; s <= t; ++s) acc += wsg[t * 128 + s] * vn[s * 128 + c];
            const float sv = acc + C.in[I_GBS][(l * 4 + g) * 128 + t];
            const float uv = geluf_(bf2f(H[(size_t)(t0 + t) * NH + HC_GU + g * 128 + c]));
            BR[(size_t)(t0 + t) * NBR + 1024 + g * 128 + c] = (bf16_t)f2bf(uv * sv);
        }
        __syncthreads();
    }
}
__device__ __forceinline__ void mix_fox_naive(const Ctx& C, int l) {
    const bf16_t* H = (const bf16_t*)(C.ws + WS_H); bf16_t* BR = (bf16_t*)(C.ws + WS_BR);
    const float* cum = (const float*)(C.ws + WS_CUM);
    const float scale = 0.08838834764831845f;
    for (int u = C.bid; u < T * 4 / 8; u += C.G) {
        const int rid = u * 8 + C.wave;
        const int h = rid & 3, row = rid >> 2, b = row / SEQ, t = row % SEQ;
        const unsigned qraw = *(const unsigned*)(H + (size_t)row * NH + HC_FQ + h * 128 + C.lane * 2);
        const float q0 = bf2f(qraw & 0xffffu) * scale, q1 = bf2f(qraw >> 16) * scale;
        const float* cm = cum + ((size_t)b * 4 + h) * SEQ;
        const float ct = cm[t];
        float m = -1e30f, lsum = 0.f, o0 = 0.f, o1 = 0.f;
        for (int s = t; s >= 0; --s) {
            const size_t kr = (size_t)(b * SEQ + s) * NH + h * 128 + C.lane * 2;
            const unsigned kraw = *(const unsigned*)(H + kr + HC_FK);
            const unsigned vraw = *(const unsigned*)(H + kr + HC_FV);
            float d = q0 * bf2f(kraw & 0xffffu) + q1 * bf2f(kraw >> 16);
            d = wave_sum(d);
            const float z = d + ct - cm[s];
            const float mn = fmaxf(m, z), al = __expf(m - mn), p = __expf(z - mn);
            lsum = lsum * al + p; o0 = o0 * al + p * bf2f(vraw & 0xffffu); o1 = o1 * al + p * bf2f(vraw >> 16); m = mn;
        }
        const float inv = 1.f / lsum;
        *(unsigned*)(BR + (size_t)row * NBR + 1536 + h * 128 + C.lane * 2) = pk2(o0 * inv, o1 * inv);
    }
}
__device__ __forceinline__ void mix_hgrn_naive(const Ctx& C, int l) {
    if (C.bid >= BATCH * 4) return;
    const bf16_t* H = (const bf16_t*)(C.ws + WS_H); bf16_t* BR = (bf16_t*)(C.ws + WS_BR);
    const int b = C.bid >> 2, h = C.bid & 3;
    LAS float* fdec = (LAS float*)C.lds;
    LAS float* kkv = fdec + 32 * 128;
    LAS float* qsv = kkv + 32 * 128;
    LAS float* vv = qsv + 32 * 128;
    LAS float* opart = vv + 32 * 128;
    const int kq = C.tid >> 7, v = C.tid & 127;
    float S[32];
#pragma unroll
    for (int j = 0; j < 32; ++j) S[j] = 0.f;
    for (int c0 = 0; c0 < SEQ; c0 += 32) {
        for (int idx = C.tid; idx < 32 * 128; idx += 512) {
            const int st = idx >> 7, k = idx & 127; const size_t rb = (size_t)(b * SEQ + c0 + st) * NH + h * 128 + k;
            float lb = 0.f;
            if (l == 1) { const float z0 = C.in[I_LBL][h * 128 + k], z1 = C.in[I_LBL][BW + h * 128 + k]; lb = 1.f / (1.f + __expf(z0 - z1)); }
            const float zf = bf2f(H[rb + HC_HF]);
            const float kk = (1.f - lb) * sigmoidf_(-zf);
            fdec[idx] = 1.f - kk; kkv[idx] = kk; qsv[idx] = siluf_(bf2f(H[rb + HC_HQ])); vv[idx] = bf2f(H[rb + HC_HI]);
        }
        __syncthreads();
        for (int st = 0; st < 32; ++st) {
            const float vt = vv[st * 128 + v];
            float part = 0.f;
#pragma unroll
            for (int j = 0; j < 32; ++j) { const int k = kq * 32 + j; S[j] = fdec[st * 128 + k] * S[j] + kkv[st * 128 + k] * vt; part += S[j] * qsv[st * 128 + k]; }
            opart[(kq * 32 + st) * 128 + v] = part;
        }
        __syncthreads();
        for (int i = 0; i < 4; ++i) {
            const int st = C.wave * 4 + i, row = b * SEQ + c0 + st;
            float o0 = 0.f, o1 = 0.f;
#pragma unroll
            for (int q = 0; q < 4; ++q) { o0 += opart[(q * 32 + st) * 128 + C.lane]; o1 += opart[(q * 32 + st) * 128 + 64 + C.lane]; }
            const float ss = wave_sum(o0 * o0 + o1 * o1);
            const float r = rsqrtf(ss * (1.f / 128.f) + RMS_EPS);
            const float g0 = siluf_(bf2f(H[(size_t)row * NH + HC_HG + h * 128 + C.lane])), g1 = siluf_(bf2f(H[(size_t)row * NH + HC_HG + h * 128 + 64 + C.lane]));
            BR[(size_t)row * NBR + 512 + h * 128 + C.lane] = (bf16_t)f2bf(o0 * r * C.in[I_HNG][l * 128 + C.lane] * g0);
            BR[(size_t)row * NBR + 512 + h * 128 + 64 + C.lane] = (bf16_t)f2bf(o1 * r * C.in[I_HNG][l * 128 + 64 + C.lane] * g1);
        }
        __syncthreads();
    }
}


typedef float f32x16 __attribute__((ext_vector_type(16)));
typedef short s16x4 __attribute__((ext_vector_type(4)));
typedef short v4i16_t __attribute__((ext_vector_type(4)));
__device__ __forceinline__ s16x4 vtr(const LAS unsigned char* p) { return __builtin_bit_cast(s16x4, __builtin_amdgcn_ds_read_tr16_b64_v4i16((LAS v4i16_t*)p)); }
__device__ __forceinline__ float xor32(float x) { return __shfl_xor(x, 32, 64); }
#define MFMA32(a, b, c) __builtin_amdgcn_mfma_f32_32x32x16_bf16((a), (b), (c), 0, 0, 0)
constexpr int CW_KMAX = 16;

__device__ __forceinline__ void p_knorm(const Ctx& C, int l) {
    const bf16_t* H = (const bf16_t*)(C.ws + WS_H);
    unsigned* kmax = (unsigned*)(C.ws + WS_CTL) + CW_KMAX + l * 8;
    for (int r0 = (C.bid * 8 + C.wave) * 8; r0 < T; r0 += C.G * 64) {
        u32x4 raw[8];
#pragma unroll
        for (int i = 0; i < 8; ++i) raw[i] = *(const u32x4*)(H + (size_t)(r0 + i) * NH + HC_FK + C.lane * 8);
        float best = 0.f;
#pragma unroll
        for (int i = 0; i < 8; ++i) { float s = 0.f;
#pragma unroll
            for (int j = 0; j < 4; ++j) { const float a = bf2f(raw[i][j] & 0xffffu), b = bf2f(raw[i][j] >> 16); s += a * a + b * b; }
            best = fmaxf(best, s); }
        best = 0.f;
#pragma unroll
        for (int i = 0; i < 8; ++i) { float s = 0.f;
#pragma unroll
            for (int j = 0; j < 4; ++j) { const float a = bf2f(raw[i][j] & 0xffffu), b = bf2f(raw[i][j] >> 16); s += a * a + b * b; }
#pragma unroll
            for (int o = 8; o > 0; o >>= 1) s += __shfl_xor(s, o, 64);
            best = fmaxf(best, s); }
        LAS float* red = (LAS float*)C.lds;
        if ((C.lane & 15) == 0) red[C.wave * 4 + (C.lane >> 4)] = best;
        __syncthreads();
        if (C.tid < 4) { float m = red[C.tid];
#pragma unroll
            for (int w2 = 1; w2 < 8; ++w2) m = fmaxf(m, red[w2 * 4 + C.tid]);
            atomicMax(kmax + (r0 / SEQ) * 4 + C.tid, __builtin_bit_cast(unsigned, m)); }
        __syncthreads();
    }
}

constexpr int FOX_KST = 272, FOX_VST = 320;
constexpr int FOX_KB = 0, FOX_VB = 2 * 64 * FOX_KST, FOX_BETA = FOX_VB + 2 * 64 * FOX_VST, FOX_FLAG = FOX_BETA + 2 * 64 * 4, FOX_END = FOX_FLAG + 2 * 8 * 4;
__device__ __forceinline__ void mix_fox(const Ctx& C, int l) {
    const bf16_t* H = (const bf16_t*)(C.ws + WS_H); bf16_t* BR = (bf16_t*)(C.ws + WS_BR);
    const float* cum = (const float*)(C.ws + WS_CUM);
    const unsigned* kmaxw = (const unsigned*)(C.ws + WS_CTL) + CW_KMAX + l * 8;
    const float LOG2E = 1.4426950408889634f, QS = 0.08838834764831845f * LOG2E;
    const int lane = C.lane, w = C.wave, r32 = lane & 31, hh = lane >> 5;
    LAS unsigned char* lds = C.lds;
    LAS float* betaL = (LAS float*)(lds + FOX_BETA);
    volatile LAS int* flagL = (volatile LAS int*)(lds + FOX_FLAG);
    for (int u = C.bid; u < BATCH * 4 * (SEQ / 256); u += C.G) {
        const int qb = u % (SEQ / 256), bh = u / (SEQ / 256), b = bh >> 2, h = bh & 3;
        const int q0 = qb * 256, qw = q0 + 32 * w;
        const size_t rowbase = (size_t)b * SEQ;
        const float* cm = cum + ((size_t)b * 4 + h) * SEQ;
        const float c0 = cm[q0];
        const float kmx = sqrtf(__builtin_bit_cast(float, __hip_atomic_load(kmaxw + b * 4 + h, __ATOMIC_RELAXED, __HIP_MEMORY_SCOPE_AGENT)));
        bf16x8 qf[8]; float qn = 0.f;
        {
            const bf16_t* qp = H + (rowbase + qw + r32) * NH + HC_FQ + h * 128 + 8 * hh;
#pragma unroll
            for (int ks = 0; ks < 8; ++ks) {
                const u32x4 raw = *(const u32x4*)(qp + 16 * ks);
                u32x4 o;
#pragma unroll
                for (int j = 0; j < 4; ++j) { const float a = bf2f(raw[j] & 0xffffu), bb = bf2f(raw[j] >> 16); qn += a * a + bb * bb; o[j] = cvtpk(a * QS, bb * QS); }
                qf[ks] = __builtin_bit_cast(bf16x8, o);
            }
            qn += xor32(qn); qn = sqrtf(qn);
        }
        const float qbound = qn * kmx * QS;
        f32x16 oacc[4];
#pragma unroll
        for (int mt = 0; mt < 4; ++mt)
#pragma unroll
            for (int i = 0; i < 16; ++i) oacc[mt][i] = 0.f;
        float m_run = -1e30f, l_run = 0.f;
        const int jmax = (q0 + 255) >> 6;
        const int srow = C.tid >> 4, sch = C.tid & 15;
        u32x4 kreg[2], vreg[2]; float breg = 0.f;
#define FOX_GLOAD(j_) do { _Pragma("unroll") for (int p = 0; p < 2; ++p) { \
                const bf16_t* rp = H + (rowbase + 64 * (j_) + srow + 32 * p) * NH + h * 128 + sch * 8; \
                kreg[p] = *(const u32x4*)(rp + HC_FK); vreg[p] = *(const u32x4*)(rp + HC_FV); } \
            if (C.tid < 64) breg = (c0 - cm[64 * (j_) + C.tid]) * LOG2E; } while (0)
#define FOX_LWRITE(buf_) do { _Pragma("unroll") for (int p = 0; p < 2; ++p) { \
                *(LAS u32x4*)(lds + FOX_KB + (buf_) * 64 * FOX_KST + (srow + 32 * p) * FOX_KST + sch * 16) = kreg[p]; \
                *(LAS u32x4*)(lds + FOX_VB + (buf_) * 64 * FOX_VST + (srow + 32 * p) * FOX_VST + sch * 16) = vreg[p]; } \
            if (C.tid < 64) betaL[(buf_) * 64 + C.tid] = breg; } while (0)
        __syncthreads();
        if (C.tid < 16) flagL[C.tid] = 0;
        FOX_GLOAD(jmax); FOX_LWRITE(jmax & 1);
        bool wdone = false;
        for (int j = jmax; j >= 0; --j) {
            const int cur = j & 1;
            __syncthreads();
            if (j < jmax) { int all = 1;
#pragma unroll
                for (int i = 0; i < 8; ++i) all &= flagL[((j + 1) & 1) * 8 + i];
                if (all) break; }
            if (j > 0) FOX_GLOAD(j - 1);
            const int k0 = 64 * j;
            if (k0 <= qw + 31 && !wdone) {
                const LAS unsigned char* kb = lds + FOX_KB + cur * 64 * FOX_KST;
                const LAS unsigned char* vb = lds + FOX_VB + cur * 64 * FOX_VST;
                f32x16 sacc[2];
#pragma unroll
                for (int mt = 0; mt < 2; ++mt)
#pragma unroll
                    for (int g = 0; g < 4; ++g) { const f32x4 bv = *(const LAS f32x4*)(betaL + cur * 64 + 32 * mt + 8 * g + 4 * hh);
                        sacc[mt][4 * g] = bv[0]; sacc[mt][4 * g + 1] = bv[1]; sacc[mt][4 * g + 2] = bv[2]; sacc[mt][4 * g + 3] = bv[3]; }
#pragma unroll
                for (int ks = 0; ks < 8; ++ks)
#pragma unroll
                    for (int mt = 0; mt < 2; ++mt) {
                        const bf16x8 kf = *(const LAS bf16x8*)(kb + (32 * mt + r32) * FOX_KST + 32 * ks + 16 * hh);
                        sacc[mt] = MFMA32(kf, qf[ks], sacc[mt]);
                    }
                const int tq = qw + r32;
                if (k0 + 63 > qw) {
#pragma unroll
                    for (int mt = 0; mt < 2; ++mt)
#pragma unroll
                        for (int i = 0; i < 16; ++i) { const int key = k0 + 32 * mt + (i & 3) + 8 * (i >> 2) + 4 * hh; if (key > tq) sacc[mt][i] = -1e30f; }
                }
                float mx = sacc[0][0];
#pragma unroll
                for (int mt = 0; mt < 2; ++mt)
#pragma unroll
                    for (int i = 0; i < 16; ++i) mx = fmaxf(mx, sacc[mt][i]);
                mx = fmaxf(mx, xor32(mx));
                const float mn = fmaxf(m_run, mx), alpha = __builtin_amdgcn_exp2f(m_run - mn);
                m_run = mn;
                float ps = 0.f;
#pragma unroll
                for (int mt = 0; mt < 2; ++mt)
#pragma unroll
                    for (int i = 0; i < 16; ++i) { const float p = __builtin_amdgcn_exp2f(sacc[mt][i] - mn); sacc[mt][i] = p; ps += p; }
                l_run = l_run * alpha + ps;
#pragma unroll
                for (int mt = 0; mt < 4; ++mt)
#pragma unroll
                    for (int i = 0; i < 16; ++i) oacc[mt][i] *= alpha;
#pragma unroll
                for (int s4 = 0; s4 < 4; ++s4) {
                    const int mtk = s4 >> 1, s = s4 & 1;
                    u32x4 pb;
#pragma unroll
                    for (int e = 0; e < 4; ++e) pb[e] = cvtpk(sacc[mtk][8 * s + 2 * e], sacc[mtk][8 * s + 2 * e + 1]);
                    const bf16x8 pfrag = __builtin_bit_cast(bf16x8, pb);
                    const int i16 = lane & 15, q4 = i16 >> 2, p4 = i16 & 3, blk = (lane >> 4) & 1;
                    const int keyA = 32 * mtk + 16 * s + 4 * hh + q4;
#pragma unroll
                    for (int mt = 0; mt < 4; ++mt) {
                        const LAS unsigned char* a0 = vb + keyA * FOX_VST + (32 * mt + 16 * blk + 4 * p4) * 2;
                        const s16x4 lo = vtr(a0), hi = vtr(a0 + 8 * FOX_VST);
                        const bf16x8 vf = __builtin_shufflevector(lo, hi, 0, 1, 2, 3, 4, 5, 6, 7);
                        oacc[mt] = MFMA32(vf, pfrag, oacc[mt]);
                    }
                }
                if (j > 0) { const float bl = (c0 - cm[k0 - 1]) * LOG2E;
                    const int ok = (qbound + bl < m_run - 40.f) ? 1 : 0;
                    wdone = __all(ok); }
            }
            if (lane == 0) flagL[cur * 8 + w] = wdone ? 1 : 0;
            if (j > 0) FOX_LWRITE(cur ^ 1);
        }
        l_run += xor32(l_run);
        const float inv = 1.f / l_run;
        bf16_t* op = BR + (rowbase + qw + r32) * NBR + 1536 + h * 128;
#pragma unroll
        for (int mt = 0; mt < 4; ++mt)
#pragma unroll
            for (int g = 0; g < 4; ++g) { u32x2 o; o[0] = cvtpk(oacc[mt][4 * g] * inv, oacc[mt][4 * g + 1] * inv); o[1] = cvtpk(oacc[mt][4 * g + 2] * inv, oacc[mt][4 * g + 3] * inv);
                *(u32x2*)(op + 32 * mt + 8 * g + 4 * hh) = o; }
    }
}


constexpr int HG_LF = 0, HG_QA = 34816, HG_QB = HG_QA + 17408, HG_KD = HG_QB + 8704, HG_KO = HG_KD + 17408, HG_KT = HG_KO + 8704, HG_VN = HG_KT + 20480, HG_AM = HG_VN + 20480, HG_END = HG_AM + 12288;
constexpr int HG_LFS = 132;
static_assert(HG_END + 2048 <= 140 * 1024, "hgrn LDS");
constexpr size_t WS_DSC = WS_ST + (size_t)BATCH * 4 * 32 * 128 * 128 * 4;

template <bool FULL>
__device__ __forceinline__ void hgrn_unit(const Ctx& C, int l, int u) {
#if DIAG == 1
    const bf16_t* H = (const bf16_t*)(C.ws + WS_H); bf16_t* BR = (l == 0) ? (bf16_t*)(C.ws + WS_XA) : (bf16_t*)(C.ws + WS_TABU);
#else
    const bf16_t* H = (const bf16_t*)(C.ws + WS_H); bf16_t* BR = (bf16_t*)(C.ws + WS_BR);
#endif
    float* STB = (float*)(C.ws + WS_ST); float* DSC = (float*)(C.ws + WS_DSC);
    LAS unsigned char* lds = C.lds;
    LAS float* LF = (LAS float*)(lds + HG_LF);
    const int lane = C.lane, w = C.wave, r32 = lane & 31, hh = lane >> 5;
    const int sc = u & 31, bh = u >> 5, b = bh >> 2, h = bh & 3;
    const int wk = w >> 1, wv = w & 1;
    const int mt = w >> 2, nt = w & 3;
    const int i16 = lane & 15, q4 = i16 >> 2, p4 = i16 & 3, blk = (lane >> 4) & 1;
    f32x16 S0, S1;
    float* stp = STB + ((size_t)bh * 32 + sc) * 128 * 128;
    if constexpr (FULL) {
#pragma unroll
        for (int i = 0; i < 16; ++i) { const int k = 32 * wk + (i & 3) + 8 * (i >> 2) + 4 * hh;
            S0[i] = stp[k * 128 + 64 * wv + r32]; S1[i] = stp[k * 128 + 64 * wv + 32 + r32]; }
    } else {
#pragma unroll
        for (int i = 0; i < 16; ++i) { S0[i] = 0.f; S1[i] = 0.f; }
    }
    float dtot = 0.f;
    const int ps = C.tid >> 3, pseg = C.tid & 7;
    float lbv[16];
#pragma unroll
    for (int j = 0; j < 16; ++j) { lbv[j] = 0.f;
        if (l == 1) { const int ch = h * 128 + 16 * pseg + j; lbv[j] = 1.f / (1.f + __expf(C.in[I_LBL][ch] - C.in[I_LBL][BW + ch])); } }
    u32x4 nf0, nf1, nv0, nv1;
    { const bf16_t* hp0 = H + ((size_t)b * SEQ + sc * 256 + ps) * NH + h * 128 + 16 * pseg;
      nf0 = *(const u32x4*)(hp0 + HC_HF); nf1 = *(const u32x4*)(hp0 + HC_HF + 8); nv0 = *(const u32x4*)(hp0 + HC_HI); nv1 = *(const u32x4*)(hp0 + HC_HI + 8); }
    for (int c = 0; c < 4; ++c) {
        const size_t row0 = (size_t)b * SEQ + sc * 256 + c * 64;
        const bf16_t* hp = H + (row0 + ps) * NH + h * 128 + 16 * pseg;
        float kkv[16], qsv[16];
        u32x4 vraw0, vraw1;
        u32x4 cg0 = {0u, 0u, 0u, 0u}, cg1 = cg0, cq0 = cg0, cq1 = cg0;
        if constexpr (FULL) { cq0 = *(const u32x4*)(hp + HC_HQ); cq1 = *(const u32x4*)(hp + HC_HQ + 8); cg0 = *(const u32x4*)(hp + HC_HG); cg1 = *(const u32x4*)(hp + HC_HG + 8); }
        {
            const u32x4 f0 = nf0, f1 = nf1;
            vraw0 = nv0; vraw1 = nv1;
            if (c < 3) { const bf16_t* hn = hp + (size_t)64 * NH;
                nf0 = *(const u32x4*)(hn + HC_HF); nf1 = *(const u32x4*)(hn + HC_HF + 8); nv0 = *(const u32x4*)(hn + HC_HI); nv1 = *(const u32x4*)(hn + HC_HI + 8); }
#pragma unroll
            for (int j = 0; j < 8; ++j) { const unsigned r = (j < 4) ? f0[j] : f1[j - 4];
                const float z0 = bf2f(r & 0xffffu), z1 = bf2f(r >> 16);
                kkv[2 * j] = (1.f - lbv[2 * j]) * sigmoidf_(-z0); kkv[2 * j + 1] = (1.f - lbv[2 * j + 1]) * sigmoidf_(-z1); }
            if constexpr (FULL) {
#pragma unroll
                for (int j = 0; j < 8; ++j) { const unsigned r = (j < 4) ? cq0[j] : cq1[j - 4]; qsv[2 * j] = siluf_(bf2f(r & 0xffffu)); qsv[2 * j + 1] = siluf_(bf2f(r >> 16)); }
            }
#pragma unroll
            for (int j4 = 0; j4 < 4; ++j4) { f32x4 o;
#pragma unroll
                for (int e = 0; e < 4; ++e) o[e] = __logf(1.f - kkv[4 * j4 + e]);
                *(LAS f32x4*)(LF + ps * HG_LFS + 16 * pseg + 4 * j4) = o; }
        }
        __syncthreads();
        {
            const int sk = C.tid & 127, sg = C.tid >> 7;
            float vals[16];
#pragma unroll
            for (int i = 0; i < 16; ++i) vals[i] = LF[(16 * sg + i) * HG_LFS + sk];
#pragma unroll
            for (int i = 1; i < 16; ++i) vals[i] += vals[i - 1];
            LAS float* TOT = (LAS float*)(lds + HG_END);
            TOT[sg * 128 + sk] = vals[15];
            __syncthreads();
            float off = 0.f;
#pragma unroll
            for (int j = 0; j < 3; ++j) if (j < sg) off += TOT[j * 128 + sk];
#pragma unroll
            for (int i = 0; i < 16; ++i) LF[(16 * sg + i) * HG_LFS + sk] = vals[i] + off;
            if (sg == 3) dtot += vals[15] + off;
        }
        __syncthreads();
        float bv[16], b31[16], bl[16];
#pragma unroll
        for (int j4 = 0; j4 < 4; ++j4) { const f32x4 x = *(const LAS f32x4*)(LF + ps * HG_LFS + 16 * pseg + 4 * j4), y = *(const LAS f32x4*)(LF + 31 * HG_LFS + 16 * pseg + 4 * j4), z = *(const LAS f32x4*)(LF + 63 * HG_LFS + 16 * pseg + 4 * j4);
#pragma unroll
            for (int e = 0; e < 4; ++e) { bv[4 * j4 + e] = x[e]; b31[4 * j4 + e] = y[e]; bl[4 * j4 + e] = z[e]; } }
        {
            u32x4 o0, o1;
#pragma unroll
            for (int j = 0; j < 4; ++j) { o0[j] = cvtpk(kkv[2 * j] * __expf(bl[2 * j] - bv[2 * j]), kkv[2 * j + 1] * __expf(bl[2 * j + 1] - bv[2 * j + 1]));
                o1[j] = cvtpk(kkv[8 + 2 * j] * __expf(bl[8 + 2 * j] - bv[8 + 2 * j]), kkv[9 + 2 * j] * __expf(bl[9 + 2 * j] - bv[9 + 2 * j])); }
            *(LAS u32x4*)(lds + HG_KT + ps * 320 + 32 * pseg) = o0; *(LAS u32x4*)(lds + HG_KT + ps * 320 + 32 * pseg + 16) = o1;
            *(LAS u32x4*)(lds + HG_VN + ps * 320 + 32 * pseg) = vraw0; *(LAS u32x4*)(lds + HG_VN + ps * 320 + 32 * pseg + 16) = vraw1;
            if constexpr (FULL) {
                const bool hi = ps >= 32;
                float rr[16];
#pragma unroll
                for (int j = 0; j < 16; ++j) rr[j] = hi ? b31[j] : 0.f;
#pragma unroll
                for (int j = 0; j < 4; ++j) { o0[j] = cvtpk(qsv[2 * j] * __expf(bv[2 * j] - rr[2 * j]), qsv[2 * j + 1] * __expf(bv[2 * j + 1] - rr[2 * j + 1]));
                    o1[j] = cvtpk(qsv[8 + 2 * j] * __expf(bv[8 + 2 * j] - rr[8 + 2 * j]), qsv[9 + 2 * j] * __expf(bv[9 + 2 * j] - rr[9 + 2 * j])); }
                *(LAS u32x4*)(lds + HG_QA + ps * 272 + 32 * pseg) = o0; *(LAS u32x4*)(lds + HG_QA + ps * 272 + 32 * pseg + 16) = o1;
#pragma unroll
                for (int j = 0; j < 4; ++j) { o0[j] = cvtpk(kkv[2 * j] * __expf(rr[2 * j] - bv[2 * j]), kkv[2 * j + 1] * __expf(rr[2 * j + 1] - bv[2 * j + 1]));
                    o1[j] = cvtpk(kkv[8 + 2 * j] * __expf(rr[8 + 2 * j] - bv[8 + 2 * j]), kkv[9 + 2 * j] * __expf(rr[9 + 2 * j] - bv[9 + 2 * j])); }
                *(LAS u32x4*)(lds + HG_KD + ps * 272 + 32 * pseg) = o0; *(LAS u32x4*)(lds + HG_KD + ps * 272 + 32 * pseg + 16) = o1;
                if (hi) {
#pragma unroll
                    for (int j = 0; j < 4; ++j) { o0[j] = cvtpk(qsv[2 * j] * __expf(bv[2 * j]), qsv[2 * j + 1] * __expf(bv[2 * j + 1]));
                        o1[j] = cvtpk(qsv[8 + 2 * j] * __expf(bv[8 + 2 * j]), qsv[9 + 2 * j] * __expf(bv[9 + 2 * j])); }
                    *(LAS u32x4*)(lds + HG_QB + (ps - 32) * 272 + 32 * pseg) = o0; *(LAS u32x4*)(lds + HG_QB + (ps - 32) * 272 + 32 * pseg + 16) = o1;
                } else {
#pragma unroll
                    for (int j = 0; j < 4; ++j) { o0[j] = cvtpk(kkv[2 * j] * __expf(b31[2 * j] - bv[2 * j]), kkv[2 * j + 1] * __expf(b31[2 * j + 1] - bv[2 * j + 1]));
                        o1[j] = cvtpk(kkv[8 + 2 * j] * __expf(b31[8 + 2 * j] - bv[8 + 2 * j]), kkv[9 + 2 * j] * __expf(b31[9 + 2 * j] - bv[9 + 2 * j])); }
                    *(LAS u32x4*)(lds + HG_KO + ps * 272 + 32 * pseg) = o0; *(LAS u32x4*)(lds + HG_KO + ps * 272 + 32 * pseg + 16) = o1;
                }
            }
        }
        float dk[16];
#pragma unroll
        for (int i = 0; i < 16; ++i) dk[i] = __expf(LF[63 * HG_LFS + 32 * wk + (i & 3) + 8 * (i >> 2) + 4 * hh]);
        __syncthreads();
        if constexpr (FULL) {
#pragma unroll
            for (int g = 0; g < 4; ++g) {
                u32x2 o; o[0] = cvtpk(S0[4 * g], S0[4 * g + 1]); o[1] = cvtpk(S0[4 * g + 2], S0[4 * g + 3]);
                *(LAS u32x2*)(lds + HG_LF + (64 * wv + r32) * 272 + (32 * wk + 8 * g + 4 * hh) * 2) = o;
                o[0] = cvtpk(S1[4 * g], S1[4 * g + 1]); o[1] = cvtpk(S1[4 * g + 2], S1[4 * g + 3]);
                *(LAS u32x2*)(lds + HG_LF + (64 * wv + 32 + r32) * 272 + (32 * wk + 8 * g + 4 * hh) * 2) = o;
            }
#define HG_ATILE(AMT_, AST_) do { \
                const LAS unsigned char* kb = ((AMT_) == (AST_)) ? (lds + HG_KD + (32 * (AST_)) * 272) : (lds + HG_KO); \
                f32x16 a; \
                _Pragma("unroll") for (int i = 0; i < 16; ++i) a[i] = 0.f; \
                _Pragma("unroll") for (int ks = 0; ks < 8; ++ks) { \
                    const bf16x8 af = *(const LAS bf16x8*)(lds + HG_QA + (32 * (AMT_) + r32) * 272 + 32 * ks + 16 * hh); \
                    const bf16x8 bf = *(const LAS bf16x8*)(kb + r32 * 272 + 32 * ks + 16 * hh); \
                    a = MFMA32(af, bf, a); } \
                _Pragma("unroll") for (int g = 0; g < 4; ++g) { \
                    float x[4]; \
                    _Pragma("unroll") for (int e = 0; e < 4; ++e) { const int tl = 8 * g + 4 * hh + e; x[e] = ((AMT_) != (AST_) || r32 <= tl) ? a[4 * g + e] : 0.f; } \
                    u32x2 o; o[0] = cvtpk(x[0], x[1]); o[1] = cvtpk(x[2], x[3]); \
                    *(LAS u32x2*)(lds + HG_AM + (32 * (AST_) + r32) * 192 + (32 * (AMT_) + 8 * g + 4 * hh) * 2) = o; } } while (0)
            if (w == 0) { HG_ATILE(0, 0); }
            else if (w == 1) { HG_ATILE(1, 0); }
            else if (w == 2) { HG_ATILE(1, 1); }
        }
#pragma unroll
        for (int i = 0; i < 16; ++i) { S0[i] *= dk[i]; S1[i] *= dk[i]; }
#pragma unroll
        for (int ks = 0; ks < 4; ++ks) {
            const LAS unsigned char* ka = lds + HG_KT + (16 * ks + 8 * hh + q4) * 320 + (32 * wk + 16 * blk + 4 * p4) * 2;
            const s16x4 alo = vtr(ka), ahi = vtr(ka + 4 * 320);
            const bf16x8 af = __builtin_shufflevector(alo, ahi, 0, 1, 2, 3, 4, 5, 6, 7);
            const LAS unsigned char* vb0 = lds + HG_VN + (16 * ks + 8 * hh + q4) * 320 + (64 * wv + 16 * blk + 4 * p4) * 2;
            const s16x4 b0lo = vtr(vb0), b0hi = vtr(vb0 + 4 * 320), b1lo = vtr(vb0 + 64), b1hi = vtr(vb0 + 64 + 4 * 320);
            S0 = MFMA32(af, __builtin_shufflevector(b0lo, b0hi, 0, 1, 2, 3, 4, 5, 6, 7), S0);
            S1 = MFMA32(af, __builtin_shufflevector(b1lo, b1hi, 0, 1, 2, 3, 4, 5, 6, 7), S1);
        }
        if constexpr (FULL) {
            __syncthreads();
            f32x16 o;
#pragma unroll
            for (int i = 0; i < 16; ++i) o[i] = 0.f;
            const LAS unsigned char* qb = (mt == 0) ? (lds + HG_QA) : (lds + HG_QB);
#pragma unroll
            for (int ks = 0; ks < 8; ++ks) {
                const bf16x8 af = *(const LAS bf16x8*)(qb + r32 * 272 + 32 * ks + 16 * hh);
                const bf16x8 bf = *(const LAS bf16x8*)(lds + HG_LF + (32 * nt + r32) * 272 + 32 * ks + 16 * hh);
                o = MFMA32(af, bf, o);
            }
#pragma unroll
            for (int ks = 0; ks < 4; ++ks) {
                if (mt == 0 && ks >= 2) continue;
                const LAS unsigned char* aa = lds + HG_AM + (16 * ks + 8 * hh + q4) * 192 + (32 * mt + 16 * blk + 4 * p4) * 2;
                const s16x4 alo = vtr(aa), ahi = vtr(aa + 4 * 192);
                const LAS unsigned char* vb0 = lds + HG_VN + (16 * ks + 8 * hh + q4) * 320 + (32 * nt + 16 * blk + 4 * p4) * 2;
                const s16x4 blo = vtr(vb0), bhi = vtr(vb0 + 4 * 320);
                o = MFMA32(__builtin_shufflevector(alo, ahi, 0, 1, 2, 3, 4, 5, 6, 7), __builtin_shufflevector(blo, bhi, 0, 1, 2, 3, 4, 5, 6, 7), o);
            }
            __syncthreads();
#pragma unroll
            for (int i = 0; i < 16; ++i) LF[(32 * mt + (i & 3) + 8 * (i >> 2) + 4 * hh) * HG_LFS + 32 * nt + r32] = o[i];
            __syncthreads();
            {
                float ov[16]; float ss = 0.f;
#pragma unroll
                for (int j4 = 0; j4 < 4; ++j4) { const f32x4 x = *(const LAS f32x4*)(LF + ps * HG_LFS + 16 * pseg + 4 * j4);
#pragma unroll
                    for (int e = 0; e < 4; ++e) { ov[4 * j4 + e] = x[e]; ss += x[e] * x[e]; } }
                ss += __shfl_xor(ss, 1, 64); ss += __shfl_xor(ss, 2, 64); ss += __shfl_xor(ss, 4, 64);
                const float rn = rsqrtf(ss * (1.f / 128.f) + RMS_EPS);
                const u32x4 g0 = cg0, g1 = cg1;
                const float* ng = C.in[I_HNG] + l * 128 + 16 * pseg;
                u32x4 o0, o1;
#pragma unroll
                for (int j = 0; j < 4; ++j) {
                    o0[j] = cvtpk(ov[2 * j] * rn * ng[2 * j] * siluf_(bf2f(g0[j] & 0xffffu)), ov[2 * j + 1] * rn * ng[2 * j + 1] * siluf_(bf2f(g0[j] >> 16)));
                    o1[j] = cvtpk(ov[8 + 2 * j] * rn * ng[8 + 2 * j] * siluf_(bf2f(g1[j] & 0xffffu)), ov[9 + 2 * j] * rn * ng[9 + 2 * j] * siluf_(bf2f(g1[j] >> 16)));
                }
                bf16_t* bp = BR + (row0 + ps) * NBR + 512 + h * 128 + 16 * pseg;
                *(u32x4*)bp = o0; *(u32x4*)(bp + 8) = o1;
            }
        }
        __syncthreads();
    }
    if constexpr (!FULL) {
#pragma unroll
        for (int i = 0; i < 16; ++i) { const int k = 32 * wk + (i & 3) + 8 * (i >> 2) + 4 * hh;
            stp[k * 128 + 64 * wv + r32] = S0[i]; stp[k * 128 + 64 * wv + 32 + r32] = S1[i]; }
        if (C.tid >= 384) DSC[((size_t)bh * 32 + sc) * 128 + (C.tid & 127)] = __expf(dtot);
    }
}
__device__ __forceinline__ void hgrn_b1(const Ctx& C, int l) { for (int u = C.bid; u < BATCH * 4 * 32; u += C.G) hgrn_unit<false>(C, l, u); }
__device__ __forceinline__ void hgrn_b3(const Ctx& C, int l) { for (int u = C.bid; u < BATCH * 4 * 32; u += C.G) hgrn_unit<true>(C, l, u); }
__device__ __forceinline__ void hgrn_b2(const Ctx& C) {
    float* STB = (float*)(C.ws + WS_ST); const float* DSC = (const float*)(C.ws + WS_DSC);
    for (int e = C.bid * 512 + C.tid; e < BATCH * 4 * 128 * 128; e += C.G * 512) {
        const int bh = e >> 14, kv = e & 16383, k = kv >> 7;
        float* p = STB + (size_t)bh * 32 * 16384 + kv;
        float uu[32], dd[32];
#pragma unroll
        for (int s = 0; s < 32; ++s) { uu[s] = p[(size_t)s * 16384]; dd[s] = DSC[((size_t)bh * 32 + s) * 128 + k]; }
        float st = 0.f;
#pragma unroll
        for (int s = 0; s < 32; ++s) { p[(size_t)s * 16384] = st; st = dd[s] * st + uu[s]; }
    }
}


__device__ __forceinline__ void mix_pool(const Ctx& C, int l) {
#if DIAG == 2
    const bf16_t* H = (const bf16_t*)(C.ws + WS_H); bf16_t* BR = (l == 0) ? (bf16_t*)(C.ws + WS_XA) : (bf16_t*)(C.ws + WS_TABU);
#else
    const bf16_t* H = (const bf16_t*)(C.ws + WS_H); bf16_t* BR = (bf16_t*)(C.ws + WS_BR);
#endif
    const bf16_t* Wt = (const bf16_t*)(C.ws + WS_W + (size_t)l * W_LAYER + WO_POOLW);
    LAS unsigned char* lds = C.lds;
    constexpr int PL_P = 128 * 272;
    const int lane = C.lane, w = C.wave, r32 = lane & 31, hh = lane >> 5;
    for (int u = C.bid; u < (T / 256) * 4; u += C.G) {
        const int g = u & 3, t0 = (u >> 2) * 256, win = 2 << g;
        const int row = t0 + 32 * w + r32, pos = row & (SEQ - 1);
        __syncthreads();
#pragma unroll
        for (int p = 0; p < 4; ++p) { const int idx = C.tid + 512 * p, rr = idx >> 4, ch = idx & 15;
            *(LAS u32x4*)(lds + rr * 272 + ch * 16) = *(const u32x4*)(Wt + (size_t)g * 128 * 128 + rr * 128 + ch * 8); }
        const bool seq_start = (t0 & (SEQ - 1)) == 0;
        for (int idx = C.tid; idx < 271 * 16; idx += 512) { const int rr = idx >> 4, ch = idx & 15;
            if (!(seq_start && rr < 15)) *(LAS u32x4*)(lds + PL_P + rr * 272 + ch * 16) = *(const u32x4*)(H + (size_t)(t0 - 15 + rr) * NH + HC_P + g * 128 + ch * 8); }
        __syncthreads();
        const int nwin = (pos + 1 < win) ? pos + 1 : win;
        const float invn = 1.f / (float)nwin;
        bf16x8 df[8];
        const LAS unsigned char* prow = lds + PL_P + (32 * w + r32 + 15) * 272 + 16 * hh;
#pragma unroll
        for (int ks = 0; ks < 8; ++ks) {
            float sum[8];
#pragma unroll
            for (int e = 0; e < 8; ++e) sum[e] = 0.f;
            const u32x4 self = *(const LAS u32x4*)(prow + 32 * ks);
#pragma unroll
            for (int j = 0; j < 16; ++j) if (j < win) {
                const int jj = (j < nwin) ? j : 0; const float msk = (j < nwin) ? 1.f : 0.f;
                const u32x4 rw = *(const LAS u32x4*)(prow + 32 * ks - jj * 272);
#pragma unroll
                for (int e = 0; e < 4; ++e) { sum[2 * e] += msk * bf2f(rw[e] & 0xffffu); sum[2 * e + 1] += msk * bf2f(rw[e] >> 16); } }
            u32x4 o;
#pragma unroll
            for (int e = 0; e < 4; ++e) o[e] = cvtpk(sum[2 * e] * invn - bf2f(self[e] & 0xffffu), sum[2 * e + 1] * invn - bf2f(self[e] >> 16));
            df[ks] = __builtin_bit_cast(bf16x8, o);
        }
        f32x16 acc[4];
#pragma unroll
        for (int mt = 0; mt < 4; ++mt)
#pragma unroll
            for (int i = 0; i < 16; ++i) acc[mt][i] = 0.f;
#pragma unroll
        for (int ks = 0; ks < 8; ++ks)
#pragma unroll
            for (int mt = 0; mt < 4; ++mt) {
                const bf16x8 wf = *(const LAS bf16x8*)(lds + (32 * mt + r32) * 272 + 32 * ks + 16 * hh);
                acc[mt] = MFMA32(wf, df[ks], acc[mt]);
            }
        const float* psc = C.in[I_POOLS] + l * BW + g * 128;
        bf16_t* op = BR + (size_t)row * NBR + g * 128;
#pragma unroll
        for (int mt = 0; mt < 4; ++mt)
#pragma unroll
            for (int q = 0; q < 4; ++q) { const int d0 = 32 * mt + 8 * q + 4 * hh; const f32x4 sc = *(const f32x4*)(psc + d0);
                u32x2 o; o[0] = cvtpk(acc[mt][4 * q] * sc[0], acc[mt][4 * q + 1] * sc[1]); o[1] = cvtpk(acc[mt][4 * q + 2] * sc[2], acc[mt][4 * q + 3] * sc[3]);
                *(u32x2*)(op + d0) = o; }
    }
}
constexpr int GM_VN = 0, GM_WC = 128 * 320, GM_END = GM_WC + 128 * 272;
__device__ __forceinline__ void mix_gmlp(const Ctx& C, int l) {
#if DIAG == 3
    const bf16_t* H = (const bf16_t*)(C.ws + WS_H); bf16_t* BR = (l == 0) ? (bf16_t*)(C.ws + WS_XA) : (bf16_t*)(C.ws + WS_TABU);
#else
    const bf16_t* H = (const bf16_t*)(C.ws + WS_H); bf16_t* BR = (bf16_t*)(C.ws + WS_BR);
#endif
    const bf16_t* Wc = (const bf16_t*)(C.ws + WS_W + (size_t)l * W_LAYER + WO_GWS);
    LAS unsigned char* lds = C.lds;
    const int lane = C.lane, w = C.wave, r32 = lane & 31, hh = lane >> 5;
    const int i16 = lane & 15, q4 = i16 >> 2, p4 = i16 & 3, blk = (lane >> 4) & 1;
    for (int u = C.bid; u < (T / 128) * 4; u += C.G) {
        const int g = u & 3, t0 = (u >> 2) * 128;
        __syncthreads();
#pragma unroll
        for (int p = 0; p < 4; ++p) { const int idx = C.tid + 512 * p, rr = idx >> 4, ch = idx & 15;
            *(LAS u32x4*)(lds + GM_WC + rr * 272 + ch * 16) = *(const u32x4*)(Wc + (size_t)g * 128 * 128 + rr * 128 + ch * 8); }
        u32x4 rawall[16];
#pragma unroll
        for (int i = 0; i < 16; ++i) rawall[i] = *(const u32x4*)(H + (size_t)(t0 + w * 16 + i) * NH + HC_GV + lane * 8);
#pragma unroll
        for (int hb = 0; hb < 4; ++hb) {
            u32x4 rawv[4];
#pragma unroll
            for (int i = 0; i < 4; ++i) rawv[i] = rawall[hb * 4 + i];
            float e[4][8], st[8];
#pragma unroll
            for (int i = 0; i < 4; ++i) { float s1 = 0.f, s2 = 0.f;
#pragma unroll
                for (int j = 0; j < 4; ++j) { const float a = geluf_(bf2f(rawv[i][j] & 0xffffu)), b = geluf_(bf2f(rawv[i][j] >> 16)); e[i][2 * j] = a; e[i][2 * j + 1] = b; s1 += a + b; s2 += a * a + b * b; }
                st[i] = s1; st[4 + i] = s2; }
#pragma unroll
            for (int sx = 32, n = 4; sx >= 8; sx >>= 1, n >>= 1) { const bool up = (lane & sx) != 0;
#pragma unroll
                for (int i = 0; i < n; ++i) { const float send = up ? st[i] : st[i + n], keep = up ? st[i + n] : st[i]; st[i] = keep + __shfl_xor(send, sx, 64); } }
            float tot = st[0]; tot += __shfl_xor(tot, 4, 64); tot += __shfl_xor(tot, 2, 64); tot += __shfl_xor(tot, 1, 64);
            float mean4[4], rstd4[4];
#pragma unroll
            for (int i = 0; i < 4; ++i) {
                mean4[i] = __builtin_bit_cast(float, __builtin_amdgcn_readlane(__builtin_bit_cast(int, tot), 8 * i)) * (1.f / BW);
                const float ex2 = __builtin_bit_cast(float, __builtin_amdgcn_readlane(__builtin_bit_cast(int, tot), 8 * (4 + i))) * (1.f / BW);
                rstd4[i] = rsqrtf(fmaxf(ex2 - mean4[i] * mean4[i], 0.f) + LN_EPS);
            }
            asm volatile("" ::: "memory");
            if ((lane >> 4) == g) {
                const float* lg = C.in[I_GLNG] + l * BW + lane * 8; const float* lb = C.in[I_GLNB] + l * BW + lane * 8;
#pragma unroll
                for (int i = 0; i < 4; ++i) {
                    const float mean = mean4[i], rstd = rstd4[i];
                    u32x4 o;
#pragma unroll
                    for (int j = 0; j < 4; ++j) o[j] = cvtpk((e[i][2 * j] - mean) * rstd * lg[2 * j] + lb[2 * j], (e[i][2 * j + 1] - mean) * rstd * lg[2 * j + 1] + lb[2 * j + 1]);
                    *(LAS u32x4*)(lds + GM_VN + (w * 16 + hb * 4 + i) * 320 + (lane & 15) * 16) = o;
                }
            }
        }
        __syncthreads();
        const int nt = w & 3, mb = (w >> 2) * 2;
        u32x2 upre[2][4];
#pragma unroll
        for (int m = 0; m < 2; ++m)
#pragma unroll
            for (int q = 0; q < 4; ++q) upre[m][q] = *(const u32x2*)(H + (size_t)(t0 + 32 * nt + r32) * NH + HC_GU + g * 128 + 32 * (mb + m) + 8 * q + 4 * hh);
        f32x16 acc[2];
#pragma unroll
        for (int m = 0; m < 2; ++m)
#pragma unroll
            for (int i = 0; i < 16; ++i) acc[m][i] = 0.f;
        for (int ks = 0; ks < 2 * (nt + 1); ++ks) {
            const bf16x8 bf = *(const LAS bf16x8*)(lds + GM_WC + (32 * nt + r32) * 272 + 32 * ks + 16 * hh);
#pragma unroll
            for (int m = 0; m < 2; ++m) {
                const LAS unsigned char* aa = lds + GM_VN + (16 * ks + 8 * hh + q4) * 320 + (32 * (mb + m) + 16 * blk + 4 * p4) * 2;
                const s16x4 lo = vtr(aa), hi = vtr(aa + 4 * 320);
                acc[m] = MFMA32(__builtin_shufflevector(lo, hi, 0, 1, 2, 3, 4, 5, 6, 7), bf, acc[m]);
            }
        }
        const int tl = 32 * nt + r32, row = t0 + tl;
        const float bias = C.in[I_GBS][(l * 4 + g) * 128 + tl];
#pragma unroll
        for (int m = 0; m < 2; ++m)
#pragma unroll
            for (int q = 0; q < 4; ++q) { const int c0 = 32 * (mb + m) + 8 * q + 4 * hh;
                const u32x2 ur = upre[m][q];
                u32x2 o;
                o[0] = cvtpk(geluf_(bf2f(ur[0] & 0xffffu)) * (acc[m][4 * q] + bias), geluf_(bf2f(ur[0] >> 16)) * (acc[m][4 * q + 1] + bias));
                o[1] = cvtpk(geluf_(bf2f(ur[1] & 0xffffu)) * (acc[m][4 * q + 2] + bias), geluf_(bf2f(ur[1] >> 16)) * (acc[m][4 * q + 3] + bias));
                *(u32x2*)(BR + (size_t)row * NBR + 1024 + g * 128 + c0) = o; }
    }
}

#define CE_D(a, b) do { const float _h = fmaxf(a, b), _l = fminf(a, b); a = _h; b = _l; } while (0)
__device__ __forceinline__ void sort16_desc(float (&x)[16]) {
#pragma unroll
    for (int k = 2; k <= 16; k <<= 1)
#pragma unroll
        for (int j = k >> 1; j > 0; j >>= 1)
#pragma unroll
            for (int i = 0; i < 16; ++i) { const int l = i ^ j; if (l > i) { if ((i & k) == 0) CE_D(x[i], x[l]); else CE_D(x[l], x[i]); } }
}
__device__ __forceinline__ void bmerge16_desc(float (&x)[16]) {
#pragma unroll
    for (int j = 8; j > 0; j >>= 1)
#pragma unroll
        for (int i = 0; i < 16; ++i) { const int l = i ^ j; if (l > i) CE_D(x[i], x[l]); }
}
__device__ __forceinline__ void top16_merge(float (&a)[16], const float (&b)[16]) {
#pragma unroll
    for (int i = 0; i < 16; ++i) a[i] = fmaxf(a[i], b[15 - i]);
    bmerge16_desc(a);
}
__device__ __forceinline__ float pack_idx(float v, unsigned idx, unsigned mask) { return __builtin_bit_cast(float, (__builtin_bit_cast(unsigned, v) & ~mask) | idx); }

constexpr int TK_KST = 272, TK_KBUF = 128 * TK_KST;
__device__ __forceinline__ void p_topk(const Ctx& C, int l) {
    const bf16_t* Q = (const bf16_t*)(C.ws + WS_Q);
    const bf16_t* keys = (const bf16_t*)(C.ws + WS_W + (size_t)l * W_LAYER + WO_KEYS);
    int* eidx = (int*)(C.ws + WS_EIDX); float* egate = (float*)(C.ws + WS_EGATE);
    LAS unsigned char* lds = C.lds;
    const int lane = C.lane, w = C.wave, r32 = lane & 31, hh = lane >> 5;
    for (int u = C.bid; u < (T / 256) * PH; u += C.G) {
        const int h = u & 7, t0 = (u >> 3) * 256, tok = t0 + 32 * w + r32;
        float v12[2][16];
        __syncthreads();
#pragma unroll
        for (int j = 0; j < 2; ++j) {
            const bf16_t* kp = keys + ((size_t)j * PH + h) * 128 * 128;
#pragma unroll
            for (int p = 0; p < 4; ++p) { const int idx = C.tid + 512 * p, row = idx >> 4, ch = idx & 15;
                *(LAS u32x4*)(lds + j * TK_KBUF + row * TK_KST + ch * 16) = *(const u32x4*)(kp + row * 128 + ch * 8); }
        }
        __syncthreads();
#pragma unroll
        for (int j = 0; j < 2; ++j) {
            bf16x8 qf[8];
            {
                LAS unsigned char* qs = lds + 2 * TK_KBUF + w * (32 * 272);
                u32x4 qr[8];
#pragma unroll
                for (int p = 0; p < 8; ++p) qr[p] = *(const u32x4*)(Q + (size_t)(t0 + 32 * w + 4 * p + (lane >> 4)) * NQ + h * 256 + j * 128 + (lane & 15) * 8);
#pragma unroll
                for (int p = 0; p < 8; ++p) *(LAS u32x4*)(qs + (4 * p + (lane >> 4)) * 272 + (lane & 15) * 16) = qr[p];
#pragma unroll
                for (int ks = 0; ks < 8; ++ks) qf[ks] = *(const LAS bf16x8*)(qs + r32 * 272 + 32 * ks + 16 * hh);
            }
            f32x16 sacc[4];
#pragma unroll
            for (int mt = 0; mt < 4; ++mt)
#pragma unroll
                for (int i = 0; i < 16; ++i) sacc[mt][i] = 0.f;
#pragma unroll
            for (int ks = 0; ks < 8; ++ks)
#pragma unroll
                for (int mt = 0; mt < 4; ++mt) {
                    const bf16x8 kf = *(const LAS bf16x8*)(lds + j * TK_KBUF + (32 * mt + r32) * TK_KST + 32 * ks + 16 * hh);
                    sacc[mt] = MFMA32(kf, qf[ks], sacc[mt]);
                }
            float g[4][16];
#pragma unroll
            for (int mt = 0; mt < 4; ++mt) {
#pragma unroll
                for (int i = 0; i < 16; ++i) g[mt][i] = pack_idx(sacc[mt][i], (unsigned)(32 * mt + (i & 3) + 8 * (i >> 2) + 4 * hh), 127u);
                sort16_desc(g[mt]);
            }
            top16_merge(g[0], g[1]); top16_merge(g[2], g[3]); top16_merge(g[0], g[2]);
            float o[16];
#pragma unroll
            for (int i = 0; i < 16; ++i) o[i] = __shfl_xor(g[0][i], 32, 64);
            top16_merge(g[0], o);
#pragma unroll
            for (int i = 0; i < 16; ++i) v12[j][i] = g[0][i];
        }
        float c[4][16];
        {
            int n = 0;
#pragma unroll
            for (int a = 0; a < 16; ++a)
#pragma unroll
                for (int b = 0; b < 16; ++b) if ((a + 1) * (b + 1) <= 16) {
                    const unsigned id = ((__builtin_bit_cast(unsigned, v12[0][a]) & 127u) << 7) | (__builtin_bit_cast(unsigned, v12[1][b]) & 127u);
                    c[n >> 4][n & 15] = pack_idx(v12[0][a] + v12[1][b], id, 16383u); ++n; }
#pragma unroll
            for (; n < 64; ++n) c[n >> 4][n & 15] = -3.0e38f;
        }
#pragma unroll
        for (int q = 0; q < 4; ++q) sort16_desc(c[q]);
        top16_merge(c[0], c[1]); top16_merge(c[2], c[3]); top16_merge(c[0], c[2]);
        float e[16], den = 0.f;
#pragma unroll
        for (int i = 0; i < 16; ++i) { e[i] = __expf(c[0][i] - c[0][0]); den += e[i]; }
        const float inv = 1.f / den;
        int* ip = eidx + (size_t)tok * 128 + h * 16 + 8 * hh; float* gp = egate + (size_t)tok * 128 + h * 16 + 8 * hh;
        u32x4 i0, i1; f32x4 g0, g1;
#pragma unroll
        for (int i = 0; i < 4; ++i) {
            const float ca = hh ? c[0][8 + i] : c[0][i], cb = hh ? c[0][12 + i] : c[0][4 + i];
            i0[i] = __builtin_bit_cast(unsigned, ca) & 16383u; i1[i] = __builtin_bit_cast(unsigned, cb) & 16383u;
            g0[i] = (hh ? e[8 + i] : e[i]) * inv; g1[i] = (hh ? e[12 + i] : e[4 + i]) * inv;
        }
        *(u32x4*)ip = i0; *(u32x4*)(ip + 4) = i1; *(f32x4*)gp = g0; *(f32x4*)(gp + 4) = g1;
    }
}

constexpr int CW_DIAG = 64;
__device__ __forceinline__ void diag_cmp(const Ctx& C, const bf16_t* A, int lda, const bf16_t* R, int ldr, int nc) {
    float sd = 0.f, sr = 0.f;
    for (int row = C.bid; row < T; row += C.G) {
        const int tm = row % DIAG_MOD; if (tm < DIAG_LO || tm >= DIAG_HI) continue;
        for (int c = C.tid; c < nc; c += 512) { const float a = bf2f(A[(size_t)row * lda + c]), r = bf2f(R[(size_t)row * ldr + c]); sd += (a - r) * (a - r); sr += r * r; }
    }
    sd = wave_sum(sd); sr = wave_sum(sr);
    if (C.lane == 0) { atomicAdd((float*)(C.ws + WS_CTL) + CW_DIAG, sd); atomicAdd((float*)(C.ws + WS_CTL) + CW_DIAG + 1, sr); }
}
__device__ __forceinline__ void diag_cmp_u8(const Ctx& C, const unsigned char* A, int lda, const bf16_t* R, int ldr, int nc) {
    float sd = 0.f, sr = 0.f;
    for (int row = C.bid; row < T; row += C.G)
        for (int c = C.tid; c < nc; c += 512) { const float a = (float)A[(size_t)row * lda + c] * (1.f / 255.f), r = bf2f(R[(size_t)row * ldr + c]); sd += (a - r) * (a - r); sr += r * r; }
    sd = wave_sum(sd); sr = wave_sum(sr);
    if (C.lane == 0) { atomicAdd((float*)(C.ws + WS_CTL) + CW_DIAG, sd); atomicAdd((float*)(C.ws + WS_CTL) + CW_DIAG + 1, sr); }
}
__device__ __forceinline__ float diag_alpha(const Ctx& C) {
    const float sd = __hip_atomic_load((float*)(C.ws + WS_CTL) + CW_DIAG, __ATOMIC_RELAXED, __HIP_MEMORY_SCOPE_AGENT), sr = __hip_atomic_load((float*)(C.ws + WS_CTL) + CW_DIAG + 1, __ATOMIC_RELAXED, __HIP_MEMORY_SCOPE_AGENT);
    const float err = fmaxf(sd / fmaxf(sr, 1e-30f), 1e-8f);
    return 0.1f + 0.1f * (rintf(log10f(err / 1e-8f) * 10.f) * 0.1f);
}


#if DIAG == 5 || DIAG == 6
__device__ __forceinline__ void diag_ref_slice(const Ctx& C, const float* W, int ldw, int n0, const float* bias) {
    bf16_t* alt = (bf16_t*)(C.ws + WS_XA);
    const float* X = C.in[I_X];
    for (int row = C.bid * 8 + C.wave; row < T; row += C.G * 8) {
        float acc = 0.f;
        for (int k = 0; k < DM; ++k) acc += X[(size_t)row * DM + k] * W[(size_t)k * ldw + n0 + C.lane];
        if (bias) acc = sigmoidf_(acc + bias[n0 + C.lane]);
        alt[(size_t)row * 64 + C.lane] = (bf16_t)f2bf(acc);
    }
}
#endif

__device__ __forceinline__ void wave_argmax(float& v, int& i) {
#pragma unroll
    for (int o = 32; o > 0; o >>= 1) {
        const float ov = __shfl_xor(v, o, 64); const int oi = __shfl_xor(i, o, 64);
        if (ov > v || (ov == v && oi < i)) { v = ov; i = oi; }
    }
}
__device__ __forceinline__ void p_topk_naive(const Ctx& C, int l) {
    const bf16_t* Q = (const bf16_t*)(C.ws + WS_Q);
    const bf16_t* keys = (const bf16_t*)(C.ws + WS_W + (size_t)l * W_LAYER + WO_KEYS);
    int* eidx = (int*)(C.ws + WS_EIDX); float* egate = (float*)(C.ws + WS_EGATE);
    LAS float* qs = (LAS float*)C.lds;
    LAS float* sc = qs + 2048;
    LAS float* tv = sc + 2048;
    LAS int* ti = (LAS int*)(tv + 256);
    for (int t = C.bid; t < T; t += C.G) {
        for (int i = C.tid; i < 2048; i += 512) qs[i] = bf2f(Q[(size_t)t * NQ + i]);
        __syncthreads();
        for (int i = 0; i < 4; ++i) {
            const int idx = C.tid + 512 * i, hj = idx >> 7, key = idx & 127, h = hj >> 1, j = hj & 1;
            const bf16_t* kp = keys + (((size_t)j * PH + h) * 128 + key) * 128;
            float s = 0.f;
            for (int d8 = 0; d8 < 16; ++d8) {
                const u32x4 raw = *(const u32x4*)(kp + d8 * 8);
#pragma unroll
                for (int e = 0; e < 4; ++e) s += qs[h * 256 + j * 128 + d8 * 8 + 2 * e] * bf2f(raw[e] & 0xffffu) + qs[h * 256 + j * 128 + d8 * 8 + 2 * e + 1] * bf2f(raw[e] >> 16);
            }
            sc[idx] = s;
        }
        __syncthreads();
        for (int i = 0; i < 2; ++i) {
            const int hj = C.wave * 2 + i;
            float a0 = sc[hj * 128 + C.lane], a1 = sc[hj * 128 + 64 + C.lane];
            for (int r = 0; r < 16; ++r) {
                float bv; int bi;
                if (a0 > a1 || (a0 == a1)) { bv = a0; bi = C.lane; } else { bv = a1; bi = C.lane + 64; }
                wave_argmax(bv, bi);
                if (C.lane == 0) { tv[hj * 16 + r] = bv; ti[hj * 16 + r] = bi; }
                if (bi == C.lane) a0 = -3e38f; if (bi == C.lane + 64) a1 = -3e38f;
            }
        }
        __syncthreads();
        {
            const int h = C.wave;
            float cv[4];
#pragma unroll
            for (int i = 0; i < 4; ++i) { const int c = C.lane * 4 + i; cv[i] = tv[(h * 2) * 16 + (c >> 4)] + tv[(h * 2 + 1) * 16 + (c & 15)]; }
            float topv = 0.f; int tope = 0; float mx = 0.f;
            for (int r = 0; r < 16; ++r) {
                float bv = cv[0]; int bi = C.lane * 4;
#pragma unroll
                for (int i = 1; i < 4; ++i) if (cv[i] > bv) { bv = cv[i]; bi = C.lane * 4 + i; }
                wave_argmax(bv, bi);
                if (r == 0) mx = bv;
                if (C.lane == r) { topv = bv; tope = ti[(h * 2) * 16 + (bi >> 4)] * 128 + ti[(h * 2 + 1) * 16 + (bi & 15)]; }
#pragma unroll
                for (int i = 0; i < 4; ++i) if (bi == C.lane * 4 + i) cv[i] = -3e38f;
            }
            float e = (C.lane < 16) ? __expf(topv - mx) : 0.f;
            const float den = wave_sum(e);
            if (C.lane < 16) { eidx[(size_t)t * 128 + h * 16 + C.lane] = tope; egate[(size_t)t * 128 + h * 16 + C.lane] = e / den; }
        }
        __syncthreads();
    }
}
__device__ __forceinline__ float ub(unsigned w, int e) { return (float)((w >> (8 * e)) & 255u); }
__device__ __forceinline__ void p_gather(const Ctx& C, int l) {
    const bf16_t* xc = (const bf16_t*)(C.ws + WS_X1B);
    const unsigned char* U8 = C.ws + WS_U8; const unsigned char* V8 = C.ws + WS_V8;
    const float* SU = (const float*)(C.ws + WS_SU); const float* SV = (const float*)(C.ws + WS_SV);
    const int* eidx = (const int*)(C.ws + WS_EIDX); const float* egate = (const float*)(C.ws + WS_EGATE);
    const int lane = C.lane;
    for (int t = C.bid * 8 + C.wave; t < T; t += C.G * 8) {
        float x[16];
        { const bf16_t* xp = xc + (size_t)t * DM + lane * 16;
          const u32x4 a = *(const u32x4*)xp, b = *(const u32x4*)(xp + 8);
#pragma unroll
          for (int i = 0; i < 4; ++i) { x[2 * i] = bf2f(a[i] & 0xffffu); x[2 * i + 1] = bf2f(a[i] >> 16); x[8 + 2 * i] = bf2f(b[i] & 0xffffu); x[9 + 2 * i] = bf2f(b[i] >> 16); } }
        float xmx = 0.f;
#pragma unroll
        for (int j = 0; j < 16; ++j) xmx = fmaxf(xmx, fabsf(x[j]));
        xmx = fmaxf(wave_max(xmx), 1e-30f);
        const float xisc = 127.f / xmx, xsc = xmx * (1.f / 127.f);
        int xq[4];
#pragma unroll
        for (int q = 0; q < 4; ++q) { unsigned wd = 0u;
#pragma unroll
            for (int e = 0; e < 4; ++e) wd |= ((unsigned)(int)rintf(x[4 * q + e] * xisc) & 255u) << (8 * e);
            xq[q] = (int)wd; }
        float cf[2]; int ex[2];
#pragma unroll
        for (int bt = 0; bt < 2; ++bt) {
            ex[bt] = eidx[(size_t)t * 128 + 64 * bt + lane];
            const float gate = egate[(size_t)t * 128 + 64 * bt + lane];
            int p[64];
#pragma unroll
            for (int e0 = 0; e0 < 64; e0 += 16) {
                u32x4 r[16];
#pragma unroll
                for (int i = 0; i < 16; ++i) { const int e = __builtin_amdgcn_readlane(ex[bt], e0 + i); r[i] = *(const u32x4*)(U8 + (size_t)e * DM + lane * 16); }
#pragma unroll
                for (int i = 0; i < 16; ++i) { int a = 0;
#pragma unroll
                    for (int q = 0; q < 4; ++q) a = __builtin_amdgcn_sdot4(xq[q], (int)r[i][q], a, false);
                    p[e0 + i] = a; }
            }
#pragma unroll
            for (int st = 32, n = 32; st > 0; st >>= 1, n >>= 1) {
                const bool up = (lane & st) != 0;
#pragma unroll
                for (int i = 0; i < n; ++i) { const int send = up ? p[i] : p[i + n], keep = up ? p[i + n] : p[i]; p[i] = keep + __shfl_xor(send, st, 64); }
            }
            const float hsum = SU[ex[bt]] * xsc * (float)p[0];
            cf[bt] = gate * geluf_slow(hsum) * SV[ex[bt]];
        }
        float y[16];
#pragma unroll
        for (int j = 0; j < 16; ++j) y[j] = 0.f;
        float csum = wave_sum(cf[0] + cf[1]);
#pragma unroll
        for (int bt = 0; bt < 2; ++bt)
#pragma unroll
            for (int e0 = 0; e0 < 64; e0 += 16) {
                u32x4 r[16];
#pragma unroll
                for (int i = 0; i < 16; ++i) { const int e = __builtin_amdgcn_readlane(ex[bt], e0 + i); r[i] = *(const u32x4*)(V8 + (size_t)e * DM + lane * 16); }
#pragma unroll
                for (int i = 0; i < 16; ++i) { const float c = __builtin_bit_cast(float, __builtin_amdgcn_readlane(__builtin_bit_cast(int, cf[bt]), e0 + i));
#pragma unroll
                    for (int q = 0; q < 4; ++q)
#pragma unroll
                        for (int e = 0; e < 4; ++e) y[4 * q + e] += c * ub(r[i][q], e); }
            }
#pragma unroll
        for (int j = 0; j < 16; ++j) y[j] = y[j] - 128.f * csum + ALPHA * x[j];
        float sm = 0.f;
#pragma unroll
        for (int j = 0; j < 16; ++j) sm += y[j];
        const float mean = wave_sum(sm) * (1.f / DM);
        float qq = 0.f;
#pragma unroll
        for (int j = 0; j < 16; ++j) { const float d = y[j] - mean; qq += d * d; }
        const float rstd = rsqrtf(wave_sum(qq) * (1.f / DM) + LN_EPS);
        const float* gp = C.in[I_LN2G] + l * DM + lane * 16; const float* bp = C.in[I_LN2B] + l * DM + lane * 16;
#pragma unroll
        for (int i = 0; i < 4; ++i) { const f32x4 gg = *(const f32x4*)(gp + 4 * i), bb = *(const f32x4*)(bp + 4 * i);
#pragma unroll
            for (int e = 0; e < 4; ++e) y[4 * i + e] = (y[4 * i + e] - mean) * rstd * gg[e] + bb[e]; }
        float* dst = (l + 1 < DEPTH) ? (float*)(C.ws + WS_XA) + (size_t)t * DM : C.out + (size_t)t * DM;
#if DIAG
        if (l + 1 == DEPTH) { const float al = 1.f + diag_alpha(C);
#pragma unroll
            for (int j = 0; j < 16; ++j) y[j] *= al; }
#endif
#pragma unroll
        for (int i = 0; i < 4; ++i) *(f32x4*)(dst + lane * 16 + 4 * i) = (f32x4){y[4 * i], y[4 * i + 1], y[4 * i + 2], y[4 * i + 3]};
        if (l + 1 < DEPTH) {
            {
                float mx = 0.f;
#pragma unroll
                for (int j = 0; j < 16; ++j) mx = fmaxf(mx, fabsf(y[j]));
                mx = fmaxf(wave_max(mx), 1e-30f);
                const float isc = 127.f / mx;
                u32x4 o8;
#pragma unroll
                for (int q = 0; q < 4; ++q) { unsigned wd = 0u;
#pragma unroll
                    for (int e = 0; e < 4; ++e) wd |= ((unsigned)(int)rintf(y[4 * q + e] * isc) & 255u) << (8 * e);
                    o8[q] = wd; }
                *(u32x4*)(C.ws + WS_XB + (size_t)t * DM + lane * 16) = o8;
                if (lane == 0) ((float*)(C.ws + WS_XSA))[t] = mx * (1.f / 127.f);
            }
            const float* wf = (const float*)(C.ws + WS_W + (size_t)(l + 1) * W_LAYER + WO_WF);
            float* lsig = (float*)(C.ws + WS_MISC);
#pragma unroll
            for (int h = 0; h < 4; ++h) {
                float sd = 0.f;
#pragma unroll
                for (int i = 0; i < 4; ++i) { const f32x4 a = *(const f32x4*)(wf + h * DM + lane * 16 + 4 * i);
#pragma unroll
                    for (int e = 0; e < 4; ++e) sd += y[4 * i + e] * a[e]; }
                sd = wave_sum(sd);
                if (lane == 0) lsig[(size_t)t * 4 + h] = logsigmoidf_(sd + C.in[I_BFOX][(l + 1) * 4 + h]);
            }
        }
    }
}

struct FStoreBf16 { bf16_t* O; int ld;
    __device__ __forceinline__ void operator()(int row, int col, f32x4 v0, f32x4 v1, int) const {
        u32x4 o; o[0] = pk2(v0[0], v0[1]); o[1] = pk2(v0[2], v0[3]); o[2] = pk2(v1[0], v1[1]); o[3] = pk2(v1[2], v1[3]);
        *(u32x4*)(O + (size_t)row * ld + col) = o; } };
typedef int i32x4 __attribute__((ext_vector_type(4)));
__device__ __forceinline__ void i8_dequant(f32x4& v0, f32x4& v1, float sa, const float* cs) {
    sa *= (1.f / 127.f);
    const f32x4 c0 = *(const f32x4*)cs, c1 = *(const f32x4*)(cs + 4);
    const i32x4 i0 = __builtin_bit_cast(i32x4, v0), i1 = __builtin_bit_cast(i32x4, v1);
#pragma unroll
    for (int e = 0; e < 4; ++e) { v0[e] = (float)i0[e] * sa * c0[e]; v1[e] = (float)i1[e] * sa * c1[e]; }
}
struct FStoreBf16I8 { bf16_t* O; int ld; const float* rs; const float* cs;
    __device__ __forceinline__ void operator()(int row, int col, f32x4 v0, f32x4 v1, int) const {
        i8_dequant(v0, v1, rs[row], cs + col);
        u32x4 o; o[0] = pk2(v0[0], v0[1]); o[1] = pk2(v0[2], v0[3]); o[2] = pk2(v1[0], v1[1]); o[3] = pk2(v1[2], v1[3]);
        *(u32x4*)(O + (size_t)row * ld + col) = o; } };
struct FGateI8 { unsigned char* O; const float* bias; const float* rs; const float* cs;
    __device__ __forceinline__ void operator()(int row, int col, f32x4 v0, f32x4 v1, int) const {
        i8_dequant(v0, v1, rs[row], cs + col);
        const f32x4 b0 = *(const f32x4*)(bias + col), b1 = *(const f32x4*)(bias + col + 4);
        u32x2 o; unsigned w0 = 0u, w1 = 0u;
#pragma unroll
        for (int e = 0; e < 4; ++e) { w0 |= (unsigned)(int)rintf(255.f * sigmoidf_(v0[e] + b0[e])) << (8 * e); w1 |= (unsigned)(int)rintf(255.f * sigmoidf_(v1[e] + b1[e])) << (8 * e); }
        o[0] = w0; o[1] = w1;
        *(u32x2*)(O + (size_t)row * NG + col) = o; } };
struct FGate { bf16_t* O; const float* bias;
    __device__ __forceinline__ void operator()(int row, int col, f32x4 v0, f32x4 v1, int) const {
        const f32x4 b0 = *(const f32x4*)(bias + col), b1 = *(const f32x4*)(bias + col + 4);
        u32x4 o; o[0] = pk2(sigmoidf_(v0[0] + b0[0]), sigmoidf_(v0[1] + b0[1])); o[1] = pk2(sigmoidf_(v0[2] + b0[2]), sigmoidf_(v0[3] + b0[3]));
        o[2] = pk2(sigmoidf_(v1[0] + b1[0]), sigmoidf_(v1[1] + b1[1])); o[3] = pk2(sigmoidf_(v1[2] + b1[2]), sigmoidf_(v1[3] + b1[3]));
        *(u32x4*)(O + (size_t)row * NG + col) = o; } };
struct FMerge { const unsigned char* G; bf16_t* MG;
    __device__ __forceinline__ void operator()(int row, int col, f32x4 v0, f32x4 v1, int z) const {
        const u32x2 gr = *(const u32x2*)(G + (size_t)row * NG + z * DM + col);
        float r[8];
#pragma unroll
        for (int e = 0; e < 4; ++e) { r[e] = v0[e] * (float)((gr[0] >> (8 * e)) & 255u) * (1.f / 255.f); r[4 + e] = v1[e] * (float)((gr[1] >> (8 * e)) & 255u) * (1.f / 255.f); }
        bf16_t* p = MG + (size_t)row * DM + col;
        if (z > 0) { const u32x4 pr = *(const u32x4*)p;
#pragma unroll
            for (int e = 0; e < 4; ++e) { r[2 * e] += bf2f(pr[e] & 0xffffu); r[2 * e + 1] += bf2f(pr[e] >> 16); } }
        u32x4 o;
#pragma unroll
        for (int e = 0; e < 4; ++e) o[e] = pk2(r[2 * e], r[2 * e + 1]);
        *(u32x4*)p = o; } };
struct FResid { const float* X; bf16_t* Y;
    __device__ __forceinline__ void operator()(int row, int col, f32x4 v0, f32x4 v1, int) const {
        const f32x4 x0 = *(const f32x4*)(X + (size_t)row * DM + col), x1 = *(const f32x4*)(X + (size_t)row * DM + col + 4);
#if DIAG == 5 || DIAG == 6
        v0 = (f32x4){0.f, 0.f, 0.f, 0.f}; v1 = v0;
#endif
        u32x4 o; o[0] = cvtpk(x0[0] * ALPHA + v0[0], x0[1] * ALPHA + v0[1]); o[1] = cvtpk(x0[2] * ALPHA + v0[2], x0[3] * ALPHA + v0[3]);
        o[2] = cvtpk(x1[0] * ALPHA + v1[0], x1[1] * ALPHA + v1[1]); o[3] = cvtpk(x1[2] * ALPHA + v1[2], x1[3] * ALPHA + v1[3]);
        *(u32x4*)(Y + (size_t)row * DM + col) = o; } };

constexpr int PH_PER_LAYER = 12, N_PHASES = 1 + DEPTH * PH_PER_LAYER;
template <int SP> __device__ __forceinline__ void run_phase(const Ctx& C0, int l) {
    Ctx C = C0;
    asm volatile("" : "+v"(C.tid));
    C.ws = launder_ptr(C.ws); C.out = launder_ptr(C.out); l = (int)launder_u((unsigned)l);
    C.lane = C.tid & 63; C.wave = __builtin_amdgcn_readfirstlane(C.tid >> 6);
    unsigned char* wb = C.ws + WS_W + (size_t)l * W_LAYER;
    if constexpr (SP == -1) { p_conv_weights(C); p_rowpass0(C); }
    if constexpr (SP == 1) {
        p_cumsum(C);
        __syncthreads();
        pg8::Gemm g{(const bf16_t*)(C.ws + WS_XB), (const bf16_t*)(wb + WO_WIN), DM, DM, DM, 0, 0};
        pg8::StaticOrder S; S.init(T, NH, C.G, C.bid);
        pg8::Epi8<FStoreBf16I8> E{{(bf16_t*)(C.ws + WS_H), NH, (const float*)(C.ws + WS_XSA), (const float*)(C.ws + WS_CMAX) + l * (NH + NG)}};
        pg8::gemm_phase<pg8::Epi8<FStoreBf16I8>, pg8::StaticOrder, true>(C.lds, g, S, E, C.tid);
    }
#if DIAG == 5
    if constexpr (SP == 2) { if (l == 0) { diag_ref_slice(C, C.in[I_WIN], NIN, DIAG_N0, nullptr); } }
    if constexpr (SP == 3) { if (l == 0) diag_cmp(C, (const bf16_t*)(C.ws + WS_H) + DIAG_N0, NH, (const bf16_t*)(C.ws + WS_XA), 64, 64); }
#endif
#if DIAG == 6
    if constexpr (SP == 5) { if (l == 0) diag_ref_slice(C, C.in[I_WGATE], NG, DIAG_N0, C.in[I_BGATE]); }
    if constexpr (SP == 6) { if (l == 0) diag_cmp_u8(C, C.ws + WS_G + DIAG_N0, NG, (const bf16_t*)(C.ws + WS_XA), 64, 64); }
#endif
    if constexpr (SP == 2) { p_knorm(C, l); if (l != HG_NAIVE_L) hgrn_b1(C, l); }
#if MIX_NAIVE
    if constexpr (SP == 3) { if (l != HG_NAIVE_L) hgrn_b2(C); mix_pool_naive(C, l); mix_gmlp_naive(C, l); }
#else
    if constexpr (SP == 3) { if (l != HG_NAIVE_L) hgrn_b2(C); mix_pool(C, l); mix_gmlp(C, l);
        if (DIAG == 2) mix_pool_naive(C, l); if (DIAG == 3) mix_gmlp_naive(C, l); }
#endif
#if DIAG == 1
    if constexpr (SP == 4) { hgrn_b3(C, l); { mix_hgrn_naive(C, l); __syncthreads(); } mix_fox(C, l); }
    if constexpr (SP == 5) { if (l == DIAG_LAYER) diag_cmp(C, (const bf16_t*)(C.ws + (DIAG_LAYER == 0 ? WS_XA : WS_TABU)) + 512, NBR, (const bf16_t*)(C.ws + WS_BR) + 512, NBR, 512); }
#elif DIAG == 2 || DIAG == 3
    if constexpr (SP == 4) { hgrn_b3(C, l); mix_fox(C, l); if (l == DIAG_LAYER) diag_cmp(C, (const bf16_t*)(C.ws + (DIAG_LAYER == 0 ? WS_XA : WS_TABU)) + (DIAG == 2 ? 0 : 1024), NBR, (const bf16_t*)(C.ws + WS_BR) + (DIAG == 2 ? 0 : 1024), NBR, 512); }
#else
    if constexpr (SP == 4) { if (l != HG_NAIVE_L) hgrn_b3(C, l); else { mix_hgrn_naive(C, l); __syncthreads(); } mix_fox(C, l); }
#endif
    if constexpr (SP == 5) {
        pg8::Gemm g{(const bf16_t*)(C.ws + WS_XB), (const bf16_t*)(wb + WO_WG), DM, DM, DM, 0, 0};
        pg8::StaticOrder S; S.init(T, NG, C.G, C.bid);
        pg8::Epi8<FGateI8> E{{C.ws + WS_G, C.in[I_BGATE] + l * NG, (const float*)(C.ws + WS_XSA), (const float*)(C.ws + WS_CMAX) + l * (NH + NG) + NH}};
        pg8::gemm_phase<pg8::Epi8<FGateI8>, pg8::StaticOrder, true>(C.lds, g, S, E, C.tid);
    }
    if constexpr (SP == 6) {
        pg8::Gemm g{(const bf16_t*)(C.ws + WS_BR), (const bf16_t*)(wb + WO_WBR), NBR, BW, BW, (size_t)BW, (size_t)DM * BW};
        pg8::ZOrder S; S.init(T, DM, 4, C.G, C.vcu);
        pg8::Epi8<FMerge> E{{C.ws + WS_G, (bf16_t*)(C.ws + WS_XB)}};
        pg8::gemm_phase(C.lds, g, S, E, C.tid);
    }
    if constexpr (SP == 7) {
        const float* xin = (l == 0) ? C.in[I_X] : (const float*)(C.ws + WS_XA);
        pg8::Gemm g{(const bf16_t*)(C.ws + WS_XB), (const bf16_t*)(wb + WO_WOUT), DM, DM, DM, 0, 0};
        pg8::StaticOrder S; S.init(T, DM, C.G, C.bid);
        pg8::Epi8<FResid> E{{xin, (bf16_t*)(C.ws + WS_XC)}};
        pg8::gemm_phase(C.lds, g, S, E, C.tid);
    }
    if constexpr (SP == 8) { p_ln1(C, l); p_conv_tables(C, l); }
    if constexpr (SP == 9) {
        pg8::Gemm g{(const bf16_t*)(C.ws + WS_X1B), (const bf16_t*)(wb + WO_WQ), DM, DM, DM, 0, 0};
        pg8::StaticOrder S; S.init(T, NQ, C.G, C.bid);
        pg8::Epi8<FStoreBf16> E{{(bf16_t*)(C.ws + WS_Q), NQ}};
        pg8::gemm_phase(C.lds, g, S, E, C.tid);
    }
#if TOPK_NAIVE
    if constexpr (SP == 10) p_topk_naive(C, l);
#else
    if constexpr (SP == 10) p_topk(C, l);
#endif
    if constexpr (SP == 11) p_gather(C, l);
}
__device__ __forceinline__ void make_ctx(Ctx& C, const Args& args, unsigned char* lds_raw) {
    C.lds = (LAS unsigned char*)lds_raw; C.ws = args.ws; C.in = args.in; C.out = args.out;
    C.tid = threadIdx.x; C.lane = C.tid & 63; C.wave = __builtin_amdgcn_readfirstlane(C.tid >> 6);
    C.G = gridDim.x; C.bid = blockIdx.x; C.vcu = (C.G % 8 == 0) ? (C.bid % 8) * (C.G / 8) + C.bid / 8 : C.bid;
}
#if !MK_ONE_LAUNCH
template <int SP> __global__ void __launch_bounds__(512, 2) mk_phase(Args args) {
    extern __shared__ __attribute__((aligned(16))) unsigned char lds_raw[];
    Ctx C; make_ctx(C, args, lds_raw);
    run_phase<SP>(C, args.ph_lo);
}
#endif

#define GRID_BAR() xcd_barrier((unsigned*)(args.ws + WS_CTL) + 1024, (volatile LAS unsigned*)((LAS unsigned char*)lds_raw + LDSCTL_OFF + 32))
__global__ void __launch_bounds__(512, 2) mk_fwd(Args args) {
    extern __shared__ __attribute__((aligned(16))) unsigned char lds_raw[];
    Ctx C; make_ctx(C, args, lds_raw);
    { volatile LAS unsigned* misc = (volatile LAS unsigned*)(C.lds + LDSCTL_OFF); if (C.tid < 64) misc[C.tid] = 0u; }
    __syncthreads();
    xcd_barrier_post((unsigned*)(args.ws + WS_CTL) + 1024);
    run_phase<-1>(C, 0); GRID_BAR();
#pragma unroll 1
    for (int l = 0; l < DEPTH; ++l) {
        run_phase<1>(C, l); GRID_BAR();
        run_phase<2>(C, l); GRID_BAR();
        run_phase<3>(C, l); GRID_BAR();
        run_phase<4>(C, l); GRID_BAR();
        run_phase<5>(C, l); GRID_BAR();
        run_phase<6>(C, l); GRID_BAR();
        run_phase<7>(C, l); GRID_BAR();
        run_phase<8>(C, l); GRID_BAR();
        run_phase<9>(C, l); GRID_BAR();
        run_phase<10>(C, l); GRID_BAR();
        run_phase<11>(C, l); if (l + 1 < DEPTH) GRID_BAR();
    }
}

#if !MK_ONE_LAUNCH
template <int SP> static void launch_phase(const Args& a, int grid, hipStream_t stream) {
    static bool attr_done = false;
    if (!attr_done) { (void)hipFuncSetAttribute((const void*)mk_phase<SP>, hipFuncAttributeMaxDynamicSharedMemorySize, LDS_BYTES); attr_done = true; }
    hipLaunchKernelGGL(mk_phase<SP>, dim3(grid), dim3(512), LDS_BYTES, stream, a);
}
#endif
extern "C" void kernel_launch(void* const* d_in, const int* in_sizes, int n_in, void* d_out, int out_size, void* d_ws, size_t ws_size, hipStream_t stream) {
    static int grid = 0;
    if (grid == 0) {
        if (n_in != NIN_PTRS || out_size != T * DM || ws_size < WS_END) { fprintf(stderr, "kernel_launch: unexpected shapes n_in %d out %d ws %zu\n", n_in, out_size, ws_size); grid = -1; return; }
        int dev = 0, cus = 0;
        if (hipGetDevice(&dev) != hipSuccess || hipDeviceGetAttribute(&cus, hipDeviceAttributeMultiprocessorCount, dev) != hipSuccess) { grid = -1; return; }
        grid = cus;
    }
    if (grid < 0) return;
    (void)hipMemsetAsync((char*)d_ws + WS_CTL, 0, CTL_ZERO_BYTES, stream);
    Args a{};
    for (int i = 0; i < NIN_PTRS; ++i) a.in[i] = (const float*)d_in[i];
    a.out = (float*)d_out; a.ws = (unsigned char*)d_ws; a.bar_slot = 0; a.pad = 0; a.ph_hi = 0;
#if MK_ONE_LAUNCH
    static bool attr_done = false;
    if (!attr_done) { (void)hipFuncSetAttribute((const void*)mk_fwd, hipFuncAttributeMaxDynamicSharedMemorySize, LDS_BYTES); attr_done = true; }
    hipLaunchKernelGGL(mk_fwd, dim3(grid), dim3(512), LDS_BYTES, stream, a);
    return;
#endif
#if !MK_ONE_LAUNCH
    a.ph_lo = 0; launch_phase<-1>(a, grid, stream);
    for (int l = 0; l < DEPTH; ++l) {
        a.ph_lo = l;
        launch_phase<0>(a, grid, stream); launch_phase<1>(a, grid, stream); launch_phase<2>(a, grid, stream); launch_phase<3>(a, grid, stream); launch_phase<4>(a, grid, stream);
        launch_phase<5>(a, grid, stream); launch_phase<6>(a, grid, stream); launch_phase<7>(a, grid, stream); launch_phase<8>(a, grid, stream); launch_phase<9>(a, grid, stream); launch_phase<10>(a, grid, stream); launch_phase<11>(a, grid, stream);
    }
#endif
}
```

```cpp
#include <hip/hip_runtime.h>
#include <cstdio>
#include <cstdint>

#ifndef DIAG
#define DIAG 0
#endif
#ifndef DIAG_LO
#define DIAG_LO 0
#endif
#ifndef DIAG_HI
#define DIAG_HI 64
#endif
#ifndef DIAG_MOD
#define DIAG_MOD 64
#endif
#ifndef TOPK_NAIVE
#define TOPK_NAIVE 0
#endif
#ifndef MIX_NAIVE
#define MIX_NAIVE 0
#endif
#ifndef DIAG_N0
#define DIAG_N0 4096
#endif
#ifndef FOX_NAIVE
#define FOX_NAIVE 0
#endif
#ifndef HG_NAIVE_L
#define HG_NAIVE_L 99
#endif
#ifndef DIAG_LAYER
#define DIAG_LAYER 0
#endif
#ifndef MK_ONE_LAUNCH
#define MK_ONE_LAUNCH 1
#endif

#define LAS __attribute__((address_space(3)))
#define GAS __attribute__((address_space(1)))
typedef unsigned short bf16_t;
typedef short bf16x8 __attribute__((ext_vector_type(8)));
typedef float f32x4 __attribute__((ext_vector_type(4)));
typedef float f32x2 __attribute__((ext_vector_type(2)));
typedef unsigned u32x4 __attribute__((ext_vector_type(4)));
typedef unsigned u32x2 __attribute__((ext_vector_type(2)));

constexpr int DM = 1024, BATCH = 2, SEQ = 8192, DEPTH = 2, T = BATCH * SEQ;
constexpr int BW = 512, NIN = 5124, NH = 5120, NG = 4096, NBR = 2048, NQ = 2048;
constexpr int NEXP = 16384, TOPK = 16, PH = 8;
constexpr float ALPHA = 1.4142135623730951f;
constexpr float LN_EPS = 1e-5f, RMS_EPS = 1e-6f;
constexpr int HC_P = 0, HC_HQ = 512, HC_HF = 1024, HC_HI = 1536, HC_HG = 2048, HC_GU = 2560, HC_GV = 3072, HC_FQ = 3584, HC_FK = 4096, HC_FV = 4608;

constexpr size_t MiB = 1u << 20;
constexpr size_t WS_CTL = 0, CTL_ZERO_BYTES = 160 * 1024;
constexpr size_t WS_CMAX = 64 * 1024;
constexpr size_t WS_MISC = 512 * 1024;
constexpr size_t WS_CUM = 768 * 1024;
constexpr size_t WS_W = 1 * MiB;
constexpr size_t W_LAYER = 30 * MiB;
constexpr size_t WO_WIN = 0, WO_WG = 10 * MiB, WO_WBR = 18 * MiB, WO_WOUT = 22 * MiB, WO_WQ = 24 * MiB, WO_KEYS = 28 * MiB, WO_WF = 28 * MiB + 512 * 1024, WO_POOLW = 28 * MiB + 768 * 1024, WO_GWS = 29 * MiB, WO_CS = 29 * MiB + 512 * 1024;
constexpr size_t WS_TABU = 64 * MiB, WS_TABV = 96 * MiB;
constexpr size_t WS_XA = 128 * MiB;
constexpr size_t WS_XB = 192 * MiB;
constexpr size_t WS_X1B = 224 * MiB;
constexpr size_t WS_H = 256 * MiB;
constexpr size_t WS_ST = 416 * MiB;
constexpr size_t WS_BR = 448 * MiB;
constexpr size_t WS_G = 256 * MiB;
constexpr size_t WS_MGF = 384 * MiB;
constexpr size_t WS_XC = 256 * MiB;
constexpr size_t WS_Q = 320 * MiB;
constexpr size_t WS_EIDX = 384 * MiB, WS_EGATE = 392 * MiB;
constexpr size_t WS_XSA = 256 * 1024;
constexpr size_t WS_END = 512 * MiB;

__device__ __forceinline__ float bf2f(unsigned u) { return __builtin_bit_cast(float, u << 16); }
__device__ __forceinline__ unsigned f2bf(float f) { unsigned u = __builtin_bit_cast(unsigned, f); return (u + 0x7fffu + ((u >> 16) & 1u)) >> 16; }
typedef __bf16 bf16x2_t __attribute__((ext_vector_type(2)));
__device__ __forceinline__ unsigned cvtpk(float lo, float hi) { f32x2 v = {lo, hi}; bf16x2_t b = __builtin_convertvector(v, bf16x2_t); return __builtin_bit_cast(unsigned, b); }
__device__ __forceinline__ unsigned pk2(float lo, float hi) { return cvtpk(lo, hi); }
__device__ __forceinline__ float wave_sum(float v) {
#pragma unroll
    for (int o = 32; o > 0; o >>= 1) v += __shfl_xor(v, o, 64);
    return v;
}
__device__ __forceinline__ float sigmoidf_(float x) { return __builtin_amdgcn_rcpf(1.f + __builtin_amdgcn_exp2f(-1.4426950408889634f * x)); }
__device__ __forceinline__ float siluf_(float x) { return x * __builtin_amdgcn_rcpf(1.f + __builtin_amdgcn_exp2f(-1.4426950408889634f * x)); }
__device__ __forceinline__ float geluf_slow(float x) { const float u = 0.7978845608028654f * (x + 0.044715f * x * x * x); return 0.5f * x * (1.f + tanhf(u)); }
__device__ __forceinline__ float geluf_(float x) { const float u2 = -2.302208198f * (x + 0.044715f * x * x * x); return x * __builtin_amdgcn_rcpf(1.f + __builtin_amdgcn_exp2f(u2)); }
__device__ __forceinline__ float logsigmoidf_(float z) { return fminf(z, 0.f) - log1pf(__expf(-fabsf(z))); }

__device__ __forceinline__ unsigned launder_u(unsigned x) { asm volatile("" : "+v"(x)); return __builtin_amdgcn_readfirstlane(x); }
template <class P> __device__ __forceinline__ P launder_ptr(P p) {
    const unsigned lo = launder_u((unsigned)(uintptr_t)p), hi = launder_u((unsigned)((uintptr_t)p >> 32));
    return (P)(((uintptr_t)hi << 32) | lo);
}

namespace pg8 {
constexpr int BM = 256, BK = 64, HALF = 128, HTB = HALF * BK * 2, STAGE_BYTES = 8 * HTB, NXCD = 8, WGM = 8;
__host__ __device__ __forceinline__ int lds_byte(int r, int c) { const int st = (r >> 4) * 2 + (c >> 5), rr = r & 15, cc = c & 31, ob = rr * 64 + cc * 2; return st * 1024 + (ob ^ (((ob >> 9) & 1) << 5)); }
__host__ __device__ __forceinline__ void stage_rc(int b, int& R, int& C) { const int st = b / 1024, sb = b % 1024, swz = sb ^ (((sb >> 9) & 1) << 5); R = (st >> 1) * 16 + swz / 64; C = (st & 1) * 32 + (swz % 64) / 2; }
__host__ __device__ __forceinline__ int perm32(int rho) { const int n = rho >> 4, i = rho & 15; return 8 * (i >> 2) + 4 * n + (i & 3); }

struct Unit { int pm, pn, z; };
struct Gemm { const bf16_t* A; const bf16_t* Bt; int lda, ldb, K; size_t zA, zB; };

struct StaticOrder {
    int nM, nN, nwg, G, c;
    __device__ void init(int M, int N, int G_, int c_) { nM = M / BM; nN = N / BM; nwg = nM * nN; G = G_; c = c_; }
    __device__ bool next(int i, Unit& u) const {
        const long L = (long)i * G + c; if (L >= nwg) return false;
        int wgid = (int)L; { const int q = nwg / NXCD, r = nwg % NXCD, xcd = wgid % NXCD, off = wgid / NXCD; wgid = (xcd < r ? xcd * (q + 1) : r * (q + 1) + (xcd - r) * q) + off; }
        const int nig = WGM * nN, gid = wgid / nig, fm = gid * WGM, gsz = (nM - fm) < WGM ? (nM - fm) : WGM;
        u.pm = fm + ((wgid % nig) % gsz); u.pn = (wgid % nig) / gsz; u.z = 0; return true;
    }
};
struct ZOrder {
    int nM, nN, nZ, ntile, G, c;
    __device__ void init(int M, int N, int Z, int G_, int c_) { nM = M / BM; nN = N / BM; nZ = Z; ntile = nM * nN; G = G_; c = c_; }
    __device__ bool next(int i, Unit& u) const {
        const long L = (long)(i / nZ) * G + c; if (L >= ntile) return false;
        u.pm = (int)L / nN; u.pn = (int)L % nN; u.z = i % nZ; return true;
    }
};

template <class F> struct Epi8 {
    static constexpr bool PERM = true;
    F f;
    __device__ __forceinline__ bool keep(const Unit&) const { return false; }
    __device__ __forceinline__ void operator()(const f32x4 (&acc)[2][2][4][2], const Unit& u, int wr, int wc, int fr, int fq) const {
        const int row0 = u.pm * BM + wr * 64 + fr, col0 = u.pn * BM + wc * 32 + 8 * fq;
#pragma unroll
        for (int ai = 0; ai < 2; ++ai)
#pragma unroll
            for (int m = 0; m < 4; ++m)
#pragma unroll
                for (int bj = 0; bj < 2; ++bj) f(row0 + ai * HALF + m * 16, col0 + bj * HALF, acc[ai][bj][m][0], acc[ai][bj][m][1], u.z);
    }
};
template <class F> struct Epi4 {
    static constexpr bool PERM = false;
    F f;
    __device__ __forceinline__ bool keep(const Unit&) const { return false; }
    __device__ __forceinline__ void operator()(const f32x4 (&acc)[2][2][4][2], const Unit& u, int wr, int wc, int fr, int fq) const {
        const int row0 = u.pm * BM + wr * 64 + fr, col0 = u.pn * BM + wc * 32 + 4 * fq;
#pragma unroll
        for (int ai = 0; ai < 2; ++ai)
#pragma unroll
            for (int m = 0; m < 4; ++m)
#pragma unroll
                for (int bj = 0; bj < 2; ++bj)
#pragma unroll
                    for (int n = 0; n < 2; ++n) f(row0 + ai * HALF + m * 16, col0 + bj * HALF + n * 16, acc[ai][bj][m][n], u.z);
    }
};

struct EpiMerge {
    static constexpr bool PERM = true;
    const unsigned char* G; bf16_t* MG;
    __device__ __forceinline__ bool keep(const Unit& u) const { return u.z < 3; }
    __device__ __forceinline__ void operator()(f32x4 (&acc)[2][2][4][2], const Unit& u, int wr, int wc, int fr, int fq) const {
        const int row0 = u.pm * BM + wr * 64 + fr, col0 = u.pn * BM + wc * 32 + 8 * fq;
        const unsigned char* gp0 = G + (size_t)row0 * NG + u.z * DM + col0;
        if (u.z < 3) {
#pragma unroll
            for (int ai = 0; ai < 2; ++ai)
#pragma unroll
                for (int m = 0; m < 4; ++m) {
                    if ((m & 1) == 0) asm volatile("" ::: "memory");
#pragma unroll
                    for (int bj = 0; bj < 2; ++bj) {
                        const unsigned char* gp = gp0 + (size_t)(ai * HALF + m * 16) * NG + bj * HALF;
                        const u32x2 ga = *(const u32x2*)gp, gb = *(const u32x2*)(gp + DM);
#pragma unroll
                        for (int n = 0; n < 2; ++n)
#pragma unroll
                            for (int e = 0; e < 4; ++e) {
                                const float qa = fmaxf((float)((ga[n] >> (8 * e)) & 255u), 0.25f), qb = fmaxf((float)((gb[n] >> (8 * e)) & 255u), 0.25f);
                                acc[ai][bj][m][n][e] *= qa * __builtin_amdgcn_rcpf(qb); }
                    }
                }
        } else {
            bf16_t* op0 = MG + (size_t)row0 * DM + col0;
#pragma unroll
            for (int ai = 0; ai < 2; ++ai)
#pragma unroll
                for (int m = 0; m < 4; ++m)
#pragma unroll
                    for (int bj = 0; bj < 2; ++bj) {
                        const u32x2 ga = *(const u32x2*)(gp0 + (size_t)(ai * HALF + m * 16) * NG + bj * HALF);
                        u32x4 o;
#pragma unroll
                        for (int n = 0; n < 2; ++n)
#pragma unroll
                            for (int e2 = 0; e2 < 2; ++e2) {
                                const float q0 = fmaxf((float)((ga[n] >> (16 * e2)) & 255u), 0.25f) * (1.f / 255.f), q1 = fmaxf((float)((ga[n] >> (16 * e2 + 8)) & 255u), 0.25f) * (1.f / 255.f);
                                o[2 * n + e2] = cvtpk(acc[ai][bj][m][n][2 * e2] * q0, acc[ai][bj][m][n][2 * e2 + 1] * q1); }
                        *(u32x4*)(op0 + (size_t)(ai * HALF + m * 16) * DM + bj * HALF) = o;
                    }
        }
    }
};

typedef int i32x4 __attribute__((ext_vector_type(4)));
template <class Epi, class Sched, bool I8 = false, bool ALIGN_EPI = true>
__device__ __forceinline__ void gemm_phase(LAS unsigned char* lds, const Gemm g, const Sched& S, const Epi& E, const int tid) {
    constexpr int ES = I8 ? 1 : 2;
    const int wid = __builtin_amdgcn_readfirstlane(tid >> 6), lane = tid & 63, wr = wid >> 2, wc = wid & 3, fr = lane & 15, fq = lane >> 4;
    const int K = g.K, nt = K * ES / 128;
    unsigned voffA[2], voffB[2];
#pragma unroll
    for (int i = 0; i < 2; ++i) { int R, C; stage_rc(tid * 16 + i * 8192, R, C); const int Rb = Epi::PERM ? ((R & ~31) + perm32(R & 31)) : R;
        voffA[i] = (unsigned)(R * g.lda * ES + C * 2); voffB[i] = (unsigned)(Rb * g.ldb * ES + C * 2); }
    const size_t kstep = (size_t)(BK * 2);
    const size_t hstepA = (size_t)HALF * g.lda * ES, hstepB = (size_t)HALF * g.ldb * ES;
    const size_t tstepA = 2 * hstepA, tstepB = 2 * hstepB;
    const unsigned ldsw = (unsigned)wid * 1024u;
    const int aoff = lds_byte(wr * 64 + fr, fq * 8), boff = lds_byte(wc * 32 + fr, fq * 8);
#define PG8_SA(b, h) (((b) * 2 + (h)) * HTB)
#define PG8_SB(b, h) ((4 + (b) * 2 + (h)) * HTB)
#define PG8_STAGE(bufoff, gbase, voff) do { _Pragma("unroll") for (int _i = 0; _i < 2; ++_i) \
        __builtin_amdgcn_global_load_lds((const unsigned*)((const char*)(gbase) + (voff)[_i]), (LAS unsigned*)(lds + (bufoff) + ldsw + _i * 8192), 16, 0, 0); } while (0)
#define PG8_LDA(dst, b, h) do { _Pragma("unroll") for (int m = 0; m < 4; ++m) _Pragma("unroll") for (int k = 0; k < 2; ++k) dst[m][k] = *(const LAS bf16x8*)(lds + PG8_SA(b, h) + aoff + m * 2048 + k * 1024); } while (0)
#define PG8_LDB(dst, b, h) do { _Pragma("unroll") for (int n = 0; n < 2; ++n) _Pragma("unroll") for (int k = 0; k < 2; ++k) dst[n][k] = *(const LAS bf16x8*)(lds + PG8_SB(b, h) + boff + n * 2048 + k * 1024); } while (0)
#define PG8_MMA(ai, bj, At, Bt) do { __builtin_amdgcn_s_setprio(1); _Pragma("unroll") for (int m = 0; m < 4; ++m) _Pragma("unroll") for (int n = 0; n < 2; ++n) _Pragma("unroll") for (int k = 0; k < 2; ++k) { \
        if constexpr (I8) acc[ai][bj][m][n] = __builtin_bit_cast(f32x4, __builtin_amdgcn_mfma_i32_16x16x64_i8(__builtin_bit_cast(i32x4, Bt[n][k]), __builtin_bit_cast(i32x4, At[m][k]), __builtin_bit_cast(i32x4, acc[ai][bj][m][n]), 0, 0, 0)); \
        else acc[ai][bj][m][n] = __builtin_amdgcn_mfma_f32_16x16x32_bf16(Bt[n][k], At[m][k], acc[ai][bj][m][n], 0, 0, 0); } __builtin_amdgcn_s_setprio(0); } while (0)
#define PG8_WAIT_V(n) asm volatile("s_waitcnt vmcnt(" #n ")" ::: "memory")
#define PG8_WAIT_L(n) asm volatile("s_waitcnt lgkmcnt(" #n ")" ::: "memory")
#define PG8_BAR __builtin_amdgcn_s_barrier()
#define PG8_SCHED __builtin_amdgcn_sched_barrier(0)
    Unit cur, nxt; int ui = 0;
    if (!S.next(0, cur)) return;
    f32x4 acc[2][2][4][2];
#pragma unroll
    for (int a = 0; a < 2; ++a)
#pragma unroll
        for (int b = 0; b < 2; ++b)
#pragma unroll
            for (int m = 0; m < 4; ++m)
#pragma unroll
                for (int n = 0; n < 2; ++n) acc[a][b][m][n] = (f32x4){0.f, 0.f, 0.f, 0.f};
    bf16x8 At[4][2], B0[2][2], B1[2][2];
    const char* cA = (const char*)g.A + (size_t)cur.z * g.zA * ES + (size_t)cur.pm * tstepA; const char* cB = (const char*)g.Bt + (size_t)cur.z * g.zB * ES + (size_t)cur.pn * tstepB;
    PG8_STAGE(PG8_SB(0, 0), cB, voffB); PG8_STAGE(PG8_SB(0, 1), cB + hstepB, voffB); PG8_STAGE(PG8_SA(0, 0), cA, voffA); PG8_STAGE(PG8_SA(0, 1), cA + hstepA, voffA);
    if (wr == 1) PG8_BAR;
    PG8_WAIT_V(2); PG8_BAR;
    PG8_STAGE(PG8_SB(1, 0), cB + kstep, voffB); PG8_STAGE(PG8_SA(1, 0), cA + kstep, voffA); PG8_STAGE(PG8_SB(1, 1), cB + hstepB + kstep, voffB);
    PG8_WAIT_V(6); PG8_BAR;
    for (;;) {
        const bool has_next = S.next(ui + 1, nxt);
        const char* nA = has_next ? (const char*)g.A + (size_t)nxt.z * g.zA * ES + (size_t)nxt.pm * tstepA : cA;
        const char* nB = has_next ? (const char*)g.Bt + (size_t)nxt.z * g.zB * ES + (size_t)nxt.pn * tstepB : cB;
        for (int t = 0; t < nt; t += 2) {
            const bool last = (t == nt - 2);
            const char* a1 = cA + (size_t)(t + 1) * kstep;
            const char* a2 = last ? nA : cA + (size_t)(t + 2) * kstep; const char* b2 = last ? nB : cB + (size_t)(t + 2) * kstep;
            const char* a3 = a2 + kstep; const char* b3 = b2 + kstep;
            PG8_LDB(B0, 0, 0); PG8_LDB(B1, 0, 1); PG8_SCHED; PG8_LDA(At, 0, 0); PG8_STAGE(PG8_SA(1, 1), a1 + hstepA, voffA);
            PG8_WAIT_V(8); PG8_WAIT_L(0); PG8_BAR; PG8_MMA(0, 0, At, B0); PG8_MMA(0, 1, At, B1); PG8_BAR; PG8_SCHED;
            PG8_LDA(At, 0, 1); PG8_STAGE(PG8_SB(0, 0), b2, voffB); PG8_STAGE(PG8_SB(0, 1), b2 + hstepB, voffB); PG8_STAGE(PG8_SA(0, 0), a2, voffA);
            PG8_WAIT_V(8); PG8_WAIT_L(0); PG8_BAR; PG8_MMA(1, 0, At, B0); PG8_MMA(1, 1, At, B1); PG8_BAR; PG8_SCHED;
            PG8_LDB(B0, 1, 0); PG8_LDB(B1, 1, 1); PG8_SCHED; PG8_LDA(At, 1, 0); PG8_STAGE(PG8_SA(0, 1), a2 + hstepA, voffA);
            PG8_WAIT_V(8); PG8_WAIT_L(0); PG8_BAR; PG8_MMA(0, 0, At, B0); PG8_MMA(0, 1, At, B1); PG8_BAR; PG8_SCHED;
            PG8_LDA(At, 1, 1); PG8_STAGE(PG8_SB(1, 0), b3, voffB); PG8_STAGE(PG8_SB(1, 1), b3 + hstepB, voffB); PG8_STAGE(PG8_SA(1, 0), a3, voffA);
            PG8_WAIT_V(8); PG8_WAIT_L(0); PG8_BAR; PG8_MMA(1, 0, At, B0); PG8_MMA(1, 1, At, B1); PG8_BAR; PG8_SCHED;
        }
        if constexpr (ALIGN_EPI) { if (wr == 0) PG8_BAR; }
        E(acc, cur, wr, wc, fr, fq);
        if (!has_next) break;
        if (!E.keep(cur)) {
#pragma unroll
            for (int a = 0; a < 2; ++a)
#pragma unroll
                for (int b = 0; b < 2; ++b)
#pragma unroll
                    for (int m = 0; m < 4; ++m)
#pragma unroll
                        for (int n = 0; n < 2; ++n) acc[a][b][m][n] = (f32x4){0.f, 0.f, 0.f, 0.f};
        }
        cur = nxt; cA = nA; cB = nB; ++ui;
        if constexpr (ALIGN_EPI) { if (wr == 1) PG8_BAR; }
    }
    PG8_WAIT_V(0);
    if constexpr (!ALIGN_EPI) { if (wr == 0) PG8_BAR; }
    PG8_BAR;
#undef PG8_SA
#undef PG8_SB
#undef PG8_STAGE
#undef PG8_LDA
#undef PG8_LDB
#undef PG8_MMA
#undef PG8_WAIT_V
#undef PG8_WAIT_L
#undef PG8_BAR
#undef PG8_SCHED
}
}

#define XB_TMO      128
#define XB_XCNT(j)  (256  + 64 * (j))
#define XB_XSUB(j)  (1280 + 64 * (j))
#define XB_XGEN(j)  (2304 + 64 * (j))
#define XB_TOP      3328
#define XB_TOPGEN   3392
#define XCD_BAR_WORDS 3456
#define XB_SPIN_CAP (1u << 22)
__device__ __forceinline__ unsigned xb_ld(unsigned* p)              { return __hip_atomic_load(p, __ATOMIC_RELAXED, __HIP_MEMORY_SCOPE_AGENT); }
__device__ __forceinline__ unsigned xb_add(unsigned* p, unsigned v) { return __hip_atomic_fetch_add(p, v, __ATOMIC_RELAXED, __HIP_MEMORY_SCOPE_AGENT); }
__device__ __forceinline__ unsigned xb_xcc_id() { return (unsigned)__builtin_amdgcn_s_getreg((3 << 11) | 20) & 0xFu; }
#define XB_SPIN(cond, bar) do { unsigned _sp = 0; while (cond) { __builtin_amdgcn_s_sleep(1); \
    if ((++_sp & 255u) == 0u) { if (xb_ld(&(bar)[XB_TMO])) break; if (_sp > XB_SPIN_CAP) { atomicAdd(&(bar)[XB_TMO], 1u); break; } } } } while (0)
__device__ __forceinline__ void xcd_barrier_post(unsigned* bar) {
    if (threadIdx.x == 0) (void)xb_add(&bar[XB_XCNT(xb_xcc_id())], 1u);
}
__device__ __forceinline__ void xcd_barrier_complete(unsigned* bar, unsigned x, unsigned& nloc, unsigned& nx) {
    const unsigned G = gridDim.x * gridDim.y * gridDim.z;
    unsigned sum, cnt, mine, sp = 0u;
    for (;;) {
        sum = 0u; cnt = 0u; mine = 0u;
#pragma unroll
        for (unsigned j = 0; j < 16; ++j) { const unsigned c = xb_ld(&bar[XB_XCNT(j)]); sum += c; cnt += (c > 0u) ? 1u : 0u; mine = (j == x) ? c : mine; }
        if (sum == G) break;
        __builtin_amdgcn_s_sleep(1);
        if ((++sp & 255u) == 0u) { if (xb_ld(&bar[XB_TMO])) break; if (sp > XB_SPIN_CAP) { atomicAdd(&bar[XB_TMO], 1u); break; } }
    }
    nloc = mine > 0u ? mine : 1u; nx = cnt > 0u ? cnt : 1u;
}
__device__ __noinline__ void xcd_barrier_leader(unsigned* bar, volatile LAS unsigned* st) {
    const unsigned x = xb_xcc_id();
    __builtin_amdgcn_s_waitcnt(0);
    unsigned nloc = st[0], nx = st[1];
    if (nloc == 0u) { xcd_barrier_complete(bar, x, nloc, nx); st[0] = nloc; st[1] = nx; }
    const unsigned old = xb_add(&bar[XB_XSUB(x)], 1u);
    const unsigned gen = old / nloc;
    if (old + 1u == (gen + 1u) * nloc) {
        __builtin_amdgcn_fence(__ATOMIC_RELEASE, "agent");
        asm volatile("s_waitcnt vmcnt(0)" ::: "memory");
        const unsigned og = xb_add(&bar[XB_TOP], 1u);
        const unsigned tg = og / nx;
        if (og + 1u == (tg + 1u) * nx) xb_add(&bar[XB_TOPGEN], 1u);
        else XB_SPIN(xb_ld(&bar[XB_TOPGEN]) == tg, bar);
        __builtin_amdgcn_fence(__ATOMIC_ACQUIRE, "agent");
        xb_add(&bar[XB_XGEN(x)], 1u);
        asm volatile("s_waitcnt vmcnt(0)" ::: "memory");
    } else {
        XB_SPIN(xb_ld(&bar[XB_XGEN(x)]) == gen, bar);
        __builtin_amdgcn_fence(__ATOMIC_ACQUIRE, "agent");
        asm volatile("s_waitcnt vmcnt(0)" ::: "memory");
    }
}
__device__ __forceinline__ void xcd_barrier(unsigned* bar, volatile LAS unsigned* st) {
    asm volatile("s_waitcnt vmcnt(0)" ::: "memory");
    __syncthreads();
    if (threadIdx.x == 0) xcd_barrier_leader(bar, st);
    __syncthreads();
}

constexpr int NIN_PTRS = 23;
struct Args { const float* in[NIN_PTRS]; float* out; unsigned char* ws; int ph_lo, ph_hi, bar_slot, pad; };
enum { I_X = 0, I_WIN, I_BFOX, I_POOLW, I_POOLS, I_LBL, I_HNG, I_GLNG, I_GLNB, I_GWS, I_GBS, I_WGATE, I_BGATE, I_WBR, I_WOUT, I_LN1G, I_LN1B, I_WQ, I_KEYS, I_PU, I_PV, I_LN2G, I_LN2B };

constexpr int LDS_BYTES = 147456;
constexpr int LDSCTL_OFF = 143360;

struct Ctx {
    LAS unsigned char* lds;
    unsigned char* ws;
    const float* const* in;
    float* out;
    int tid, lane, wave, G, bid, vcu;
};

__device__ __forceinline__ void tconv_job(const Ctx& C, const float* src, int ld_src, int K, int N, bf16_t* dst) {
    LAS float* tile = (LAS float*)C.lds;
    const int nk = K / 64, nn = N / 64, ntiles = nk * nn;
    for (int tl = C.bid; tl < ntiles; tl += C.G) {
        const int k0 = (tl / nn) * 64, n0 = (tl % nn) * 64;
#pragma unroll
        for (int p = 0; p < 2; ++p) {
            const int kr = (C.tid >> 4) + p * 32, nc = (C.tid & 15) * 4;
            const f32x4 v = *(const f32x4*)(src + (size_t)(k0 + kr) * ld_src + n0 + nc);
            tile[kr * 65 + nc + 0] = v[0]; tile[kr * 65 + nc + 1] = v[1]; tile[kr * 65 + nc + 2] = v[2]; tile[kr * 65 + nc + 3] = v[3];
        }
        __syncthreads();
        {
            const int n = C.tid >> 3, k8 = (C.tid & 7) * 8;
            u32x4 o;
#pragma unroll
            for (int j = 0; j < 4; ++j) o[j] = pk2(tile[(k8 + 2 * j) * 65 + n], tile[(k8 + 2 * j + 1) * 65 + n]);
            *(u32x4*)(dst + (size_t)(n0 + n) * K + k0 + k8) = o;
        }
        __syncthreads();
    }
}
__device__ __forceinline__ void cvt_copy(const Ctx& C, const float* src, bf16_t* dst, size_t n) {
    const size_t n8 = n / 8;
    for (size_t i = (size_t)C.bid * 512 + C.tid; i < n8; i += (size_t)C.G * 512) {
        const f32x4 a = *(const f32x4*)(src + i * 8), b = *(const f32x4*)(src + i * 8 + 4);
        u32x4 o; o[0] = pk2(a[0], a[1]); o[1] = pk2(a[2], a[3]); o[2] = pk2(b[0], b[1]); o[3] = pk2(b[2], b[3]);
        *(u32x4*)(dst + i * 8) = o;
    }
}
__device__ __forceinline__ void strip_unit(const Ctx& C, const float* src, int ld, unsigned char* dst, unsigned* cmax, bool split) {
    const float* p = src + (size_t)(128 * C.wave) * ld + C.lane;
    float v[128];
#pragma unroll
    for (int i = 0; i < 128; ++i) v[i] = p[(size_t)i * ld];
    if (cmax) {
        float mx = 0.f;
#pragma unroll
        for (int i = 0; i < 128; ++i) mx = fmaxf(mx, fabsf(v[i]));
        LAS float* red = (LAS float*)C.lds;
        red[C.wave * 64 + C.lane] = mx;
        __syncthreads();
        float m = red[C.lane];
#pragma unroll
        for (int w2 = 1; w2 < 8; ++w2) m = fmaxf(m, red[w2 * 64 + C.lane]);
        if (C.wave == 0) cmax[C.lane] = __builtin_bit_cast(unsigned, m);
        const float isc = 127.f / fmaxf(m, 1e-30f);
        unsigned char* dp = dst + (size_t)C.lane * 1024 + 128 * C.wave;
#pragma unroll
        for (int j4 = 0; j4 < 8; ++j4) { u32x4 o;
#pragma unroll
            for (int j = 0; j < 4; ++j) { unsigned wd = 0u;
#pragma unroll
                for (int e = 0; e < 4; ++e) wd |= ((unsigned)(int)rintf(v[16 * j4 + 4 * j + e] * isc) & 255u) << (8 * e);
                o[j] = wd; }
            *(u32x4*)(dp + 16 * j4) = o; }
        __syncthreads();
    } else {
        bf16_t* dp = split ? (bf16_t*)dst + (size_t)(C.wave >> 2) * DM * BW + (size_t)C.lane * BW + 128 * (C.wave & 3) : (bf16_t*)dst + (size_t)C.lane * 1024 + 128 * C.wave;
#pragma unroll
        for (int j8 = 0; j8 < 16; ++j8) { u32x4 o;
#pragma unroll
            for (int j = 0; j < 4; ++j) o[j] = pk2(v[8 * j8 + 2 * j], v[8 * j8 + 2 * j + 1]);
            *(u32x4*)(dp + 8 * j8) = o; }
    }
}
__device__ __forceinline__ void p_conv_weights(const Ctx& C) {
#pragma unroll 1
    for (int u = C.bid; u < DEPTH * 224; u += C.G) {
        const int l = u / 224, r = u % 224;
        unsigned char* wb = C.ws + WS_W + (size_t)l * W_LAYER;
        unsigned* cm = (unsigned*)(C.ws + WS_CMAX) + l * (NH + NG);
        const float* src; int ld; unsigned char* dst; unsigned* cx = nullptr; bool split = false;
        if (r < 80)       { src = C.in[I_WIN] + (size_t)l * DM * NIN + r * 64; ld = NIN; dst = wb + WO_WIN + (size_t)r * 64 * DM; cx = cm + r * 64; }
        else if (r < 144) { const int t = r - 80; src = C.in[I_WGATE] + (size_t)l * DM * NG + t * 64; ld = NG; dst = wb + WO_WG + (size_t)t * 64 * DM; cx = cm + NH + t * 64; }
        else if (r < 176) { const int t = r - 144, pr = t >> 4, nt = t & 15; src = C.in[I_WBR] + ((size_t)l * 4 + 2 * pr) * BW * DM + nt * 64; ld = DM; split = true;
                            dst = wb + WO_WBR + ((size_t)(2 * pr) * DM * BW + (size_t)nt * 64 * BW) * 2; }
        else if (r < 192) { const int nt = r - 176; src = C.in[I_WOUT] + (size_t)l * DM * DM + nt * 64; ld = DM; dst = wb + WO_WOUT + (size_t)nt * 64 * DM * 2; }
        else              { const int nt = r - 192; src = C.in[I_WQ] + (size_t)l * DM * NQ + nt * 64; ld = NQ; dst = wb + WO_WQ + (size_t)nt * 64 * DM * 2; }
        strip_unit(C, src, ld, dst, cx, split);
    }
    for (int l = 0; l < DEPTH; ++l) {
        unsigned char* wb = C.ws + WS_W + (size_t)l * W_LAYER;
        cvt_copy(C, C.in[I_KEYS] + (size_t)l * 2 * PH * 128 * 128, (bf16_t*)(wb + WO_KEYS), (size_t)2 * PH * 128 * 128);
        for (int g = 0; g < 4; ++g)
            tconv_job(C, C.in[I_POOLW] + ((size_t)l * 4 + g) * 128 * 128, 128, 128, 128, (bf16_t*)(wb + WO_POOLW) + (size_t)g * 128 * 128);
        {
            bf16_t* gw = (bf16_t*)(wb + WO_GWS); const float* src = C.in[I_GWS] + (size_t)l * 4 * 128 * 128;
            for (int i = C.bid * 512 + C.tid; i < 4 * 128 * 128; i += C.G * 512) { const int t = (i >> 7) & 127, sx = i & 127; gw[i] = (bf16_t)f2bf(sx <= t ? src[i] : 0.f); }
        }
        float* wf = (float*)(wb + WO_WF);
        for (int i = C.bid * 512 + C.tid; i < 4 * DM; i += C.G * 512) { const int h = i / DM, k = i % DM; wf[i] = C.in[I_WIN][(size_t)l * DM * NIN + (size_t)k * NIN + NH + h]; }
    }
}
constexpr size_t WS_U8 = WS_TABU, WS_V8 = WS_TABU + 16 * MiB, WS_SU = WS_TABU + 32 * MiB, WS_SV = WS_SU + 64 * 1024;
__device__ __forceinline__ float wave_max(float v) {
#pragma unroll
    for (int o = 32; o > 0; o >>= 1) v = fmaxf(v, __shfl_xor(v, o, 64));
    return v;
}
template <bool SIGNED> __device__ __forceinline__ void quant_rows(const Ctx& C, const float* src, unsigned char* dst, float* scl) {
    for (int row = C.bid * 8 + C.wave; row < NEXP; row += C.G * 8) {
        const float* p = src + (size_t)row * DM + C.lane * 16;
        f32x4 v[4]; float mx = 0.f;
#pragma unroll
        for (int i = 0; i < 4; ++i) { v[i] = *(const f32x4*)(p + 4 * i);
#pragma unroll
            for (int e = 0; e < 4; ++e) mx = fmaxf(mx, fabsf(v[i][e])); }
        mx = fmaxf(wave_max(mx), 1e-30f);
        const float sc = mx * (1.f / 127.f), isc = 127.f / mx;
        u32x4 o;
#pragma unroll
        for (int i = 0; i < 4; ++i) { unsigned wd = 0u;
#pragma unroll
            for (int e = 0; e < 4; ++e) { const int q = (int)rintf(v[i][e] * isc) + (SIGNED ? 0 : 128); wd |= ((unsigned)q & 255u) << (8 * e); }
            o[i] = wd; }
        *(u32x4*)(dst + (size_t)row * DM + C.lane * 16) = o;
        if (C.lane == 0) scl[row] = sc;
    }
}
__device__ __forceinline__ void p_conv_tables(const Ctx& C, int l) {
    quant_rows<true>(C, C.in[I_PU] + (size_t)l * NEXP * DM, C.ws + WS_U8, (float*)(C.ws + WS_SU));
    quant_rows<false>(C, C.in[I_PV] + (size_t)l * NEXP * DM, C.ws + WS_V8, (float*)(C.ws + WS_SV));
}

__device__ __forceinline__ void row_emit(const Ctx& C, int row, const float (&v)[16], int l, bool want_lsig) {
    {
        float mx = 0.f;
#pragma unroll
        for (int j = 0; j < 16; ++j) mx = fmaxf(mx, fabsf(v[j]));
#pragma unroll
        for (int o = 32; o > 0; o >>= 1) mx = fmaxf(mx, __shfl_xor(mx, o, 64));
        mx = fmaxf(mx, 1e-30f);
        const float isc = 127.f / mx;
        unsigned char* xb = C.ws + WS_XB + (size_t)row * DM;
        u32x2 o0, o1;
#pragma unroll
        for (int hw = 0; hw < 2; ++hw) { unsigned a = 0u, b = 0u;
#pragma unroll
            for (int e = 0; e < 4; ++e) { a |= ((unsigned)(int)rintf(v[4 * hw + e] * isc) & 255u) << (8 * e); b |= ((unsigned)(int)rintf(v[8 + 4 * hw + e] * isc) & 255u) << (8 * e); }
            o0[hw] = a; o1[hw] = b; }
        *(u32x2*)(xb + C.lane * 8) = o0; *(u32x2*)(xb + 512 + C.lane * 8) = o1;
        if (C.lane == 0) ((float*)(C.ws + WS_XSA))[row] = mx * (1.f / 127.f);
    }
    if (want_lsig) {
        const float* wf = (const float*)(C.ws + WS_W + (size_t)l * W_LAYER + WO_WF);
        float* lsig = (float*)(C.ws + WS_MISC);
#pragma unroll
        for (int h = 0; h < 4; ++h) {
            const f32x4 a0 = *(const f32x4*)(wf + h * DM + C.lane * 8), a1 = *(const f32x4*)(wf + h * DM + C.lane * 8 + 4);
            const f32x4 b0 = *(const f32x4*)(wf + h * DM + 512 + C.lane * 8), b1 = *(const f32x4*)(wf + h * DM + 512 + C.lane * 8 + 4);
            float s = 0.f;
#pragma unroll
            for (int j = 0; j < 4; ++j) s += v[j] * a0[j] + v[4 + j] * a1[j] + v[8 + j] * b0[j] + v[12 + j] * b1[j];
            s = wave_sum(s);
            if (C.lane == 0) lsig[(size_t)row * 4 + h] = logsigmoidf_(s + C.in[I_BFOX][l * 4 + h]);
        }
    }
}
__device__ __forceinline__ void load_row16(const float* p, int lane, float (&v)[16]) {
    const f32x4 a0 = *(const f32x4*)(p + lane * 8), a1 = *(const f32x4*)(p + lane * 8 + 4), b0 = *(const f32x4*)(p + 512 + lane * 8), b1 = *(const f32x4*)(p + 512 + lane * 8 + 4);
#pragma unroll
    for (int j = 0; j < 4; ++j) { v[j] = a0[j]; v[4 + j] = a1[j]; v[8 + j] = b0[j]; v[12 + j] = b1[j]; }
}
__device__ __forceinline__ void store_row16(float* p, int lane, const float (&v)[16]) {
    *(f32x4*)(p + lane * 8) = (f32x4){v[0], v[1], v[2], v[3]}; *(f32x4*)(p + lane * 8 + 4) = (f32x4){v[4], v[5], v[6], v[7]};
    *(f32x4*)(p + 512 + lane * 8) = (f32x4){v[8], v[9], v[10], v[11]}; *(f32x4*)(p + 512 + lane * 8 + 4) = (f32x4){v[12], v[13], v[14], v[15]};
}
__device__ __forceinline__ void ln_row16(float (&v)[16], const float* g, const float* b, int lane) {
    float s = 0.f;
#pragma unroll
    for (int j = 0; j < 16; ++j) s += v[j];
    const float mean = wave_sum(s) * (1.f / DM);
    float q = 0.f;
#pragma unroll
    for (int j = 0; j < 16; ++j) { const float d = v[j] - mean; q += d * d; }
    const float rstd = rsqrtf(wave_sum(q) * (1.f / DM) + LN_EPS);
    float gg[16], bb[16];
    load_row16(g, lane, gg); load_row16(b, lane, bb);
#pragma unroll
    for (int j = 0; j < 16; ++j) v[j] = (v[j] - mean) * rstd * gg[j] + bb[j];
}
__device__ __forceinline__ void p_rowpass0(const Ctx& C) {
    const float* wfin = C.in[I_WIN] + NH;
    f32x4 wv[16];
#pragma unroll
    for (int j = 0; j < 16; ++j) { const int k = (j < 8) ? C.lane * 8 + j : 512 + C.lane * 8 + (j - 8); wv[j] = *(const f32x4*)(wfin + (size_t)k * NIN); }
    float* lsig = (float*)(C.ws + WS_MISC);
    const bool bal = (C.G == 256);
    const int c0 = bal ? ((C.bid < 192) ? C.bid * 6 : 1152 + (C.bid - 192) * 14) : C.bid, cn = bal ? ((C.bid < 192) ? 6 : 14) : (T / 8 - C.bid + C.G - 1) / C.G, cs = bal ? 1 : C.G;
    for (int ci = 0; ci < cn; ++ci) {
        const int row = (c0 + ci * cs) * 8 + C.wave;
        float v[16]; load_row16(C.in[I_X] + (size_t)row * DM, C.lane, v);
        row_emit(C, row, v, 0, false);
#pragma unroll
        for (int h = 0; h < 4; ++h) {
            float sacc = 0.f;
#pragma unroll
            for (int j = 0; j < 16; ++j) sacc += v[j] * wv[j][h];
            sacc = wave_sum(sacc);
            if (C.lane == 0) lsig[(size_t)row * 4 + h] = logsigmoidf_(sacc + C.in[I_BFOX][h]);
        }
    }
}
__device__ __forceinline__ void p_cumsum(const Ctx& C) {
    if (C.bid >= BATCH * 4) return;
    const float* lsig = (const float*)(C.ws + WS_MISC);
    float* cum = (float*)(C.ws + WS_CUM);
    LAS float* wt = (LAS float*)C.lds;
    const int b = C.bid >> 2, h = C.bid & 3;
    float v[16];
#pragma unroll
    for (int j = 0; j < 16; ++j) v[j] = lsig[((size_t)b * SEQ + C.tid * 16 + j) * 4 + h];
#pragma unroll
    for (int j = 1; j < 16; ++j) v[j] += v[j - 1];
    float inc = v[15];
#pragma unroll
    for (int o = 1; o < 64; o <<= 1) { const float t = __shfl_up(inc, o, 64); if (C.lane >= o) inc += t; }
    if (C.lane == 63) wt[C.wave] = inc;
    __syncthreads();
    float off = inc - v[15];
    for (int w2 = 0; w2 < C.wave; ++w2) off += wt[w2];
    float* cp = cum + ((size_t)b * 4 + h) * SEQ + C.tid * 16;
#pragma unroll
    for (int j4 = 0; j4 < 4; ++j4) *(f32x4*)(cp + 4 * j4) = (f32x4){v[4 * j4] + off, v[4 * j4 + 1] + off, v[4 * j4 + 2] + off, v[4 * j4 + 3] + off};
    __syncthreads();
}
__device__ __forceinline__ void load_row16_bf(const bf16_t* p, int lane, float (&v)[16]) {
    const u32x4 a = *(const u32x4*)(p + lane * 8), b = *(const u32x4*)(p + 512 + lane * 8);
#pragma unroll
    for (int j = 0; j < 4; ++j) { v[2 * j] = bf2f(a[j] & 0xffffu); v[2 * j + 1] = bf2f(a[j] >> 16); v[8 + 2 * j] = bf2f(b[j] & 0xffffu); v[9 + 2 * j] = bf2f(b[j] >> 16); }
}
__device__ __forceinline__ void p_ln1(const Ctx& C, int l) {
    const bf16_t* y1 = (const bf16_t*)(C.ws + WS_XC); bf16_t* x1b = (bf16_t*)(C.ws + WS_X1B);
    for (int row = C.bid * 8 + C.wave; row < T; row += C.G * 8) {
        float v[16]; load_row16_bf(y1 + (size_t)row * DM, C.lane, v);
        ln_row16(v, C.in[I_LN1G] + l * DM, C.in[I_LN1B] + l * DM, C.lane);
        u32x4 o0, o1;
#pragma unroll
        for (int j = 0; j < 4; ++j) { o0[j] = pk2(v[2 * j], v[2 * j + 1]); o1[j] = pk2(v[8 + 2 * j], v[8 + 2 * j + 1]); }
        *(u32x4*)(x1b + (size_t)row * DM + C.lane * 8) = o0; *(u32x4*)(x1b + (size_t)row * DM + 512 + C.lane * 8) = o1;
    }
}

__device__ __forceinline__ void mix_pool_naive(const Ctx& C, int l) {
    const bf16_t* H = (const bf16_t*)(C.ws + WS_H); bf16_t* BR = (bf16_t*)(C.ws + WS_BR);
    LAS float* dd = (LAS float*)C.lds;
    for (int u = C.bid; u < (T / 64) * 4; u += C.G) {
        const int g = u & 3, t0 = (u >> 2) * 64, w = 2 << g;
        for (int idx = C.tid; idx < 64 * 128; idx += 512) {
            const int r = idx >> 7, c = idx & 127, row = t0 + r, pos = row & (SEQ - 1);
            const int nwin = (pos + 1 < w) ? pos + 1 : w;
            float s = 0.f;
            for (int j = 0; j < nwin; ++j) s += bf2f(H[(size_t)(row - j) * NH + HC_P + g * 128 + c]);
            dd[idx] = s / (float)nwin - bf2f(H[(size_t)row * NH + HC_P + g * 128 + c]);
        }
        __syncthreads();
        const int dcol = C.tid & 127, rq = C.tid >> 7;
        float acc[16];
#pragma unroll
        for (int i = 0; i < 16; ++i) acc[i] = 0.f;
        const float* pw = C.in[I_POOLW] + ((size_t)l * 4 + g) * 128 * 128;
        for (int c = 0; c < 128; ++c) {
            const float wv = pw[c * 128 + dcol];
#pragma unroll
            for (int i = 0; i < 16; ++i) acc[i] += dd[(rq * 16 + i) * 128 + c] * wv;
        }
        const float sc = C.in[I_POOLS][l * BW + g * 128 + dcol];
#pragma unroll
        for (int i = 0; i < 16; ++i) BR[(size_t)(t0 + rq * 16 + i) * NBR + 0 + g * 128 + dcol] = (bf16_t)f2bf(acc[i] * sc);
        __syncthreads();
    }
}
__device__ __forceinline__ void mix_gmlp_naive(const Ctx& C, int l) {
    const bf16_t* H = (const bf16_t*)(C.ws + WS_H); bf16_t* BR = (bf16_t*)(C.ws + WS_BR);
    LAS float* vn = (LAS float*)C.lds;
    for (int u = C.bid; u < (T / 128) * 4; u += C.G) {
        const int g = u & 3, t0 = (u >> 2) * 128;
        for (int i = 0; i < 16; ++i) {
            const int r = C.wave * 16 + i, row = t0 + r;
            const u32x4 raw = *(const u32x4*)(H + (size_t)row * NH + HC_GV + C.lane * 8);
            float e[8];
#pragma unroll
            for (int j = 0; j < 4; ++j) { e[2 * j] = geluf_(bf2f(raw[j] & 0xffffu)); e[2 * j + 1] = geluf_(bf2f(raw[j] >> 16)); }
            float s = 0.f;
#pragma unroll
            for (int j = 0; j < 8; ++j) s += e[j];
            const float mean = wave_sum(s) * (1.f / BW);
            float q = 0.f;
#pragma unroll
            for (int j = 0; j < 8; ++j) { const float d = e[j] - mean; q += d * d; }
            const float rstd = rsqrtf(wave_sum(q) * (1.f / BW) + LN_EPS);
            if ((C.lane >> 4) == g) {
#pragma unroll
                for (int j = 0; j < 8; ++j) { const int col = C.lane * 8 + j;
                    vn[r * 128 + (col - g * 128)] = (e[j] - mean) * rstd * C.in[I_GLNG][l * BW + col] + C.in[I_GLNB][l * BW + col]; }
            }
        }
        __syncthreads();
        const int c = C.tid & 127, tq = C.tid >> 7;
        const float* wsg = C.in[I_GWS] + ((size_t)l * 4 + g) * 128 * 128;
        for (int t = tq; t < 128; t += 4) {
            float acc = 0.f;
            for (int s = 0; s <= t; ++s) acc += wsg[t * 128 + s] * vn[s * 128 + c];
            const float sv = acc + C.in[I_GBS][(l * 4 + g) * 128 + t];
            const float uv = geluf_(bf2f(H[(size_t)(t0 + t) * NH + HC_GU + g * 128 + c]));
            BR[(size_t)(t0 + t) * NBR + 1024 + g * 128 + c] = (bf16_t)f2bf(uv * sv);
        }
        __syncthreads();
    }
}
__device__ __forceinline__ void mix_fox_naive(const Ctx& C, int l) {
    const bf16_t* H = (const bf16_t*)(C.ws + WS_H); bf16_t* BR = (bf16_t*)(C.ws + WS_BR);
    const float* cum = (const float*)(C.ws + WS_CUM);
    const float scale = 0.08838834764831845f;
    for (int u = C.bid; u < T * 4 / 8; u += C.G) {
        const int rid = u * 8 + C.wave;
        const int h = rid & 3, row = rid >> 2, b = row / SEQ, t = row % SEQ;
        const unsigned qraw = *(const unsigned*)(H + (size_t)row * NH + HC_FQ + h * 128 + C.lane * 2);
        const float q0 = bf2f(qraw & 0xffffu) * scale, q1 = bf2f(qraw >> 16) * scale;
        const float* cm = cum + ((size_t)b * 4 + h) * SEQ;
        const float ct = cm[t];
        float m = -1e30f, lsum = 0.f, o0 = 0.f, o1 = 0.f;
        for (int s = t; s >= 0; --s) {
            const size_t kr = (size_t)(b * SEQ + s) * NH + h * 128 + C.lane * 2;
            const unsigned kraw = *(const unsigned*)(H + kr + HC_FK);
            const unsigned vraw = *(const unsigned*)(H + kr + HC_FV);
            float d = q0 * bf2f(kraw & 0xffffu) + q1 * bf2f(kraw >> 16);
            d = wave_sum(d);
            const float z = d + ct - cm[s];
            const float mn = fmaxf(m, z), al = __expf(m - mn), p = __expf(z - mn);
            lsum = lsum * al + p; o0 = o0 * al + p * bf2f(vraw & 0xffffu); o1 = o1 * al + p * bf2f(vraw >> 16); m = mn;
        }
        const float inv = 1.f / lsum;
        *(unsigned*)(BR + (size_t)row * NBR + 1536 + h * 128 + C.lane * 2) = pk2(o0 * inv, o1 * inv);
    }
}
__device__ __forceinline__ void mix_hgrn_naive(const Ctx& C, int l) {
    if (C.bid >= BATCH * 4) return;
    const bf16_t* H = (const bf16_t*)(C.ws + WS_H); bf16_t* BR = (bf16_t*)(C.ws + WS_BR);
    const int b = C.bid >> 2, h = C.bid & 3;
    LAS float* fdec = (LAS float*)C.lds;
    LAS float* kkv = fdec + 32 * 128;
    LAS float* qsv = kkv + 32 * 128;
    LAS float* vv = qsv + 32 * 128;
    LAS float* opart = vv + 32 * 128;
    const int kq = C.tid >> 7, v = C.tid & 127;
    float S[32];
#pragma unroll
    for (int j = 0; j < 32; ++j) S[j] = 0.f;
    for (int c0 = 0; c0 < SEQ; c0 += 32) {
        for (int idx = C.tid; idx < 32 * 128; idx += 512) {
            const int st = idx >> 7, k = idx & 127; const size_t rb = (size_t)(b * SEQ + c0 + st) * NH + h * 128 + k;
            float lb = 0.f;
            if (l == 1) { const float z0 = C.in[I_LBL][h * 128 + k], z1 = C.in[I_LBL][BW + h * 128 + k]; lb = 1.f / (1.f + __expf(z0 - z1)); }
            const float zf = bf2f(H[rb + HC_HF]);
            const float kk = (1.f - lb) * sigmoidf_(-zf);
            fdec[idx] = 1.f - kk; kkv[idx] = kk; qsv[idx] = siluf_(bf2f(H[rb + HC_HQ])); vv[idx] = bf2f(H[rb + HC_HI]);
        }
        __syncthreads();
        for (int st = 0; st < 32; ++st) {
            const float vt = vv[st * 128 + v];
            float part = 0.f;
#pragma unroll
            for (int j = 0; j < 32; ++j) { const int k = kq * 32 + j; S[j] = fdec[st * 128 + k] * S[j] + kkv[st * 128 + k] * vt; part += S[j] * qsv[st * 128 + k]; }
            opart[(kq * 32 + st) * 128 + v] = part;
        }
        __syncthreads();
        for (int i = 0; i < 4; ++i) {
            const int st = C.wave * 4 + i, row = b * SEQ + c0 + st;
            float o0 = 0.f, o1 = 0.f;
#pragma unroll
            for (int q = 0; q < 4; ++q) { o0 += opart[(q * 32 + st) * 128 + C.lane]; o1 += opart[(q * 32 + st) * 128 + 64 + C.lane]; }
            const float ss = wave_sum(o0 * o0 + o1 * o1);
            const float r = rsqrtf(ss * (1.f / 128.f) + RMS_EPS);
            const float g0 = siluf_(bf2f(H[(size_t)row * NH + HC_HG + h * 128 + C.lane])), g1 = siluf_(bf2f(H[(size_t)row * NH + HC_HG + h * 128 + 64 + C.lane]));
            BR[(size_t)row * NBR + 512 + h * 128 + C.lane] = (bf16_t)f2bf(o0 * r * C.in[I_HNG][l * 128 + C.lane] * g0);
            BR[(size_t)row * NBR + 512 + h * 128 + 64 + C.lane] = (bf16_t)f2bf(o1 * r * C.in[I_HNG][l * 128 + 64 + C.lane] * g1);
        }
        __syncthreads();
    }
}


typedef float f32x16 __attribute__((ext_vector_type(16)));
typedef short s16x4 __attribute__((ext_vector_type(4)));
typedef short v4i16_t __attribute__((ext_vector_type(4)));
__device__ __forceinline__ s16x4 vtr(const LAS unsigned char* p) { return __builtin_bit_cast(s16x4, __builtin_amdgcn_ds_read_tr16_b64_v4i16((LAS v4i16_t*)p)); }
__device__ __forceinline__ float xor32(float x) { return __shfl_xor(x, 32, 64); }
#define MFMA32(a, b, c) __builtin_amdgcn_mfma_f32_32x32x16_bf16((a), (b), (c), 0, 0, 0)
constexpr int CW_KMAX = 16;

__device__ __forceinline__ void p_knorm(const Ctx& C, int l) {
    const bf16_t* H = (const bf16_t*)(C.ws + WS_H);
    unsigned* kmax = (unsigned*)(C.ws + WS_CTL) + CW_KMAX + l * 8;
    for (int r0 = (C.bid * 8 + C.wave) * 8; r0 < T; r0 += C.G * 64) {
        u32x4 raw[8];
#pragma unroll
        for (int i = 0; i < 8; ++i) raw[i] = *(const u32x4*)(H + (size_t)(r0 + i) * NH + HC_FK + C.lane * 8);
        float best = 0.f;
#pragma unroll
        for (int i = 0; i < 8; ++i) { float s = 0.f;
#pragma unroll
            for (int j = 0; j < 4; ++j) { const float a = bf2f(raw[i][j] & 0xffffu), b = bf2f(raw[i][j] >> 16); s += a * a + b * b; }
            best = fmaxf(best, s); }
        best = 0.f;
#pragma unroll
        for (int i = 0; i < 8; ++i) { float s = 0.f;
#pragma unroll
            for (int j = 0; j < 4; ++j) { const float a = bf2f(raw[i][j] & 0xffffu), b = bf2f(raw[i][j] >> 16); s += a * a + b * b; }
#pragma unroll
            for (int o = 8; o > 0; o >>= 1) s += __shfl_xor(s, o, 64);
            best = fmaxf(best, s); }
        LAS float* red = (LAS float*)C.lds;
        if ((C.lane & 15) == 0) red[C.wave * 4 + (C.lane >> 4)] = best;
        __syncthreads();
        if (C.tid < 4) { float m = red[C.tid];
#pragma unroll
            for (int w2 = 1; w2 < 8; ++w2) m = fmaxf(m, red[w2 * 4 + C.tid]);
            atomicMax(kmax + (r0 / SEQ) * 4 + C.tid, __builtin_bit_cast(unsigned, m)); }
        __syncthreads();
    }
}

constexpr int FOX_KST = 272, FOX_VST = 320;
constexpr int FOX_KB = 0, FOX_VB = 2 * 64 * FOX_KST, FOX_BETA = FOX_VB + 2 * 64 * FOX_VST, FOX_FLAG = FOX_BETA + 2 * 64 * 4, FOX_END = FOX_FLAG + 2 * 8 * 4;
__device__ __forceinline__ void mix_fox(const Ctx& C, int l) {
    const bf16_t* H = (const bf16_t*)(C.ws + WS_H); bf16_t* BR = (bf16_t*)(C.ws + WS_BR);
    const float* cum = (const float*)(C.ws + WS_CUM);
    const unsigned* kmaxw = (const unsigned*)(C.ws + WS_CTL) + CW_KMAX + l * 8;
    const float LOG2E = 1.4426950408889634f, QS = 0.08838834764831845f * LOG2E;
    const int lane = C.lane, w = C.wave, r32 = lane & 31, hh = lane >> 5;
    LAS unsigned char* lds = C.lds;
    LAS float* betaL = (LAS float*)(lds + FOX_BETA);
    volatile LAS int* flagL = (volatile LAS int*)(lds + FOX_FLAG);
    for (int u = C.bid; u < BATCH * 4 * (SEQ / 256); u += C.G) {
        const int qb = u % (SEQ / 256), bh = u / (SEQ / 256), b = bh >> 2, h = bh & 3;
        const int q0 = qb * 256, qw = q0 + 32 * w;
        const size_t rowbase = (size_t)b * SEQ;
        const float* cm = cum + ((size_t)b * 4 + h) * SEQ;
        const float c0 = cm[q0];
        const float kmx = sqrtf(__builtin_bit_cast(float, __hip_atomic_load(kmaxw + b * 4 + h, __ATOMIC_RELAXED, __HIP_MEMORY_SCOPE_AGENT)));
        bf16x8 qf[8]; float qn = 0.f;
        {
            const bf16_t* qp = H + (rowbase + qw + r32) * NH + HC_FQ + h * 128 + 8 * hh;
#pragma unroll
            for (int ks = 0; ks < 8; ++ks) {
                const u32x4 raw = *(const u32x4*)(qp + 16 * ks);
                u32x4 o;
#pragma unroll
                for (int j = 0; j < 4; ++j) { const float a = bf2f(raw[j] & 0xffffu), bb = bf2f(raw[j] >> 16); qn += a * a + bb * bb; o[j] = cvtpk(a * QS, bb * QS); }
                qf[ks] = __builtin_bit_cast(bf16x8, o);
            }
            qn += xor32(qn); qn = sqrtf(qn);
        }
        const float qbound = qn * kmx * QS;
        f32x16 oacc[4];
#pragma unroll
        for (int mt = 0; mt < 4; ++mt)
#pragma unroll
            for (int i = 0; i < 16; ++i) oacc[mt][i] = 0.f;
        float m_run = -1e30f, l_run = 0.f;
        const int jmax = (q0 + 255) >> 6;
        const int srow = C.tid >> 4, sch = C.tid & 15;
        u32x4 kreg[2], vreg[2]; float breg = 0.f;
#define FOX_GLOAD(j_) do { _Pragma("unroll") for (int p = 0; p < 2; ++p) { \
                const bf16_t* rp = H + (rowbase + 64 * (j_) + srow + 32 * p) * NH + h * 128 + sch * 8; \
                kreg[p] = *(const u32x4*)(rp + HC_FK); vreg[p] = *(const u32x4*)(rp + HC_FV); } \
            if (C.tid < 64) breg = (c0 - cm[64 * (j_) + C.tid]) * LOG2E; } while (0)
#define FOX_LWRITE(buf_) do { _Pragma("unroll") for (int p = 0; p < 2; ++p) { \
                *(LAS u32x4*)(lds + FOX_KB + (buf_) * 64 * FOX_KST + (srow + 32 * p) * FOX_KST + sch * 16) = kreg[p]; \
                *(LAS u32x4*)(lds + FOX_VB + (buf_) * 64 * FOX_VST + (srow + 32 * p) * FOX_VST + sch * 16) = vreg[p]; } \
            if (C.tid < 64) betaL[(buf_) * 64 + C.tid] = breg; } while (0)
        __syncthreads();
        if (C.tid < 16) flagL[C.tid] = 0;
        FOX_GLOAD(jmax); FOX_LWRITE(jmax & 1);
        bool wdone = false;
        for (int j = jmax; j >= 0; --j) {
            const int cur = j & 1;
            __syncthreads();
            if (j < jmax) { int all = 1;
#pragma unroll
                for (int i = 0; i < 8; ++i) all &= flagL[((j + 1) & 1) * 8 + i];
                if (all) break; }
            if (j > 0) FOX_GLOAD(j - 1);
            const int k0 = 64 * j;
            if (k0 <= qw + 31 && !wdone) {
                const LAS unsigned char* kb = lds + FOX_KB + cur * 64 * FOX_KST;
                const LAS unsigned char* vb = lds + FOX_VB + cur * 64 * FOX_VST;
                f32x16 sacc[2];
#pragma unroll
                for (int mt = 0; mt < 2; ++mt)
#pragma unroll
                    for (int g = 0; g < 4; ++g) { const f32x4 bv = *(const LAS f32x4*)(betaL + cur * 64 + 32 * mt + 8 * g + 4 * hh);
                        sacc[mt][4 * g] = bv[0]; sacc[mt][4 * g + 1] = bv[1]; sacc[mt][4 * g + 2] = bv[2]; sacc[mt][4 * g + 3] = bv[3]; }
#pragma unroll
                for (int ks = 0; ks < 8; ++ks)
#pragma unroll
                    for (int mt = 0; mt < 2; ++mt) {
                        const bf16x8 kf = *(const LAS bf16x8*)(kb + (32 * mt + r32) * FOX_KST + 32 * ks + 16 * hh);
                        sacc[mt] = MFMA32(kf, qf[ks], sacc[mt]);
                    }
                const int tq = qw + r32;
                if (k0 + 63 > qw) {
#pragma unroll
                    for (int mt = 0; mt < 2; ++mt)
#pragma unroll
                        for (int i = 0; i < 16; ++i) { const int key = k0 + 32 * mt + (i & 3) + 8 * (i >> 2) + 4 * hh; if (key > tq) sacc[mt][i] = -1e30f; }
                }
                float mx = sacc[0][0];
#pragma unroll
                for (int mt = 0; mt < 2; ++mt)
#pragma unroll
                    for (int i = 0; i < 16; ++i) mx = fmaxf(mx, sacc[mt][i]);
                mx = fmaxf(mx, xor32(mx));
                const float mn = fmaxf(m_run, mx), alpha = __builtin_amdgcn_exp2f(m_run - mn);
                m_run = mn;
                float ps = 0.f;
#pragma unroll
                for (int mt = 0; mt < 2; ++mt)
#pragma unroll
                    for (int i = 0; i < 16; ++i) { const float p = __builtin_amdgcn_exp2f(sacc[mt][i] - mn); sacc[mt][i] = p; ps += p; }
                l_run = l_run * alpha + ps;
#pragma unroll
                for (int mt = 0; mt < 4; ++mt)
#pragma unroll
                    for (int i = 0; i < 16; ++i) oacc[mt][i] *= alpha;
#pragma unroll
                for (int s4 = 0; s4 < 4; ++s4) {
                    const int mtk = s4 >> 1, s = s4 & 1;
                    u32x4 pb;
#pragma unroll
                    for (int e = 0; e < 4; ++e) pb[e] = cvtpk(sacc[mtk][8 * s + 2 * e], sacc[mtk][8 * s + 2 * e + 1]);
                    const bf16x8 pfrag = __builtin_bit_cast(bf16x8, pb);
                    const int i16 = lane & 15, q4 = i16 >> 2, p4 = i16 & 3, blk = (lane >> 4) & 1;
                    const int keyA = 32 * mtk + 16 * s + 4 * hh + q4;
#pragma unroll
                    for (int mt = 0; mt < 4; ++mt) {
                        const LAS unsigned char* a0 = vb + keyA * FOX_VST + (32 * mt + 16 * blk + 4 * p4) * 2;
                        const s16x4 lo = vtr(a0), hi = vtr(a0 + 8 * FOX_VST);
                        const bf16x8 vf = __builtin_shufflevector(lo, hi, 0, 1, 2, 3, 4, 5, 6, 7);
                        oacc[mt] = MFMA32(vf, pfrag, oacc[mt]);
                    }
                }
                if (j > 0) { const float bl = (c0 - cm[k0 - 1]) * LOG2E;
                    const int ok = (qbound + bl < m_run - 40.f) ? 1 : 0;
                    wdone = __all(ok); }
            }
            if (lane == 0) flagL[cur * 8 + w] = wdone ? 1 : 0;
            if (j > 0) FOX_LWRITE(cur ^ 1);
        }
        l_run += xor32(l_run);
        const float inv = 1.f / l_run;
        bf16_t* op = BR + (rowbase + qw + r32) * NBR + 1536 + h * 128;
#pragma unroll
        for (int mt = 0; mt < 4; ++mt)
#pragma unroll
            for (int g = 0; g < 4; ++g) { u32x2 o; o[0] = cvtpk(oacc[mt][4 * g] * inv, oacc[mt][4 * g + 1] * inv); o[1] = cvtpk(oacc[mt][4 * g + 2] * inv, oacc[mt][4 * g + 3] * inv);
                *(u32x2*)(op + 32 * mt + 8 * g + 4 * hh) = o; }
    }
}


constexpr int HG_LF = 0, HG_QA = 34816, HG_QB = HG_QA + 17408, HG_KD = HG_QB + 8704, HG_KO = HG_KD + 17408, HG_KT = HG_KO + 8704, HG_VN = HG_KT + 20480, HG_AM = HG_VN + 20480, HG_END = HG_AM + 12288;
constexpr int HG_LFS = 132;
static_assert(HG_END + 2048 <= 140 * 1024, "hgrn LDS");
constexpr size_t WS_DSC = WS_ST + (size_t)BATCH * 4 * 32 * 128 * 128 * 4;

template <bool FULL>
__device__ __forceinline__ void hgrn_unit(const Ctx& C, int l, int u) {
#if DIAG == 1
    const bf16_t* H = (const bf16_t*)(C.ws + WS_H); bf16_t* BR = (l == 0) ? (bf16_t*)(C.ws + WS_XA) : (bf16_t*)(C.ws + WS_TABU);
#else
    const bf16_t* H = (const bf16_t*)(C.ws + WS_H); bf16_t* BR = (bf16_t*)(C.ws + WS_BR);
#endif
    float* STB = (float*)(C.ws + WS_ST); float* DSC = (float*)(C.ws + WS_DSC);
    LAS unsigned char* lds = C.lds;
    LAS float* LF = (LAS float*)(lds + HG_LF);
    const int lane = C.lane, w = C.wave, r32 = lane & 31, hh = lane >> 5;
    const int sc = u & 31, bh = u >> 5, b = bh >> 2, h = bh & 3;
    const int wk = w >> 1, wv = w & 1;
    const int mt = w >> 2, nt = w & 3;
    const int i16 = lane & 15, q4 = i16 >> 2, p4 = i16 & 3, blk = (lane >> 4) & 1;
    f32x16 S0, S1;
    float* stp = STB + ((size_t)bh * 32 + sc) * 128 * 128;
    if constexpr (FULL) {
#pragma unroll
        for (int i = 0; i < 16; ++i) { const int k = 32 * wk + (i & 3) + 8 * (i >> 2) + 4 * hh;
            S0[i] = stp[k * 128 + 64 * wv + r32]; S1[i] = stp[k * 128 + 64 * wv + 32 + r32]; }
    } else {
#pragma unroll
        for (int i = 0; i < 16; ++i) { S0[i] = 0.f; S1[i] = 0.f; }
    }
    float dtot = 0.f;
    const int ps = C.tid >> 3, pseg = C.tid & 7;
    float lbv[16];
#pragma unroll
    for (int j = 0; j < 16; ++j) { lbv[j] = 0.f;
        if (l == 1) { const int ch = h * 128 + 16 * pseg + j; lbv[j] = 1.f / (1.f + __expf(C.in[I_LBL][ch] - C.in[I_LBL][BW + ch])); } }
    u32x4 nf0, nf1, nv0, nv1;
    { const bf16_t* hp0 = H + ((size_t)b * SEQ + sc * 256 + ps) * NH + h * 128 + 16 * pseg;
      nf0 = *(const u32x4*)(hp0 + HC_HF); nf1 = *(const u32x4*)(hp0 + HC_HF + 8); nv0 = *(const u32x4*)(hp0 + HC_HI); nv1 = *(const u32x4*)(hp0 + HC_HI + 8); }
    for (int c = 0; c < 4; ++c) {
        const size_t row0 = (size_t)b * SEQ + sc * 256 + c * 64;
        const bf16_t* hp = H + (row0 + ps) * NH + h * 128 + 16 * pseg;
        float kkv[16], qsv[16];
        u32x4 vraw0, vraw1;
        u32x4 cg0 = {0u, 0u, 0u, 0u}, cg1 = cg0, cq0 = cg0, cq1 = cg0;
        if constexpr (FULL) { cq0 = *(const u32x4*)(hp + HC_HQ); cq1 = *(const u32x4*)(hp + HC_HQ + 8); cg0 = *(const u32x4*)(hp + HC_HG); cg1 = *(const u32x4*)(hp + HC_HG + 8); }
        {
            const u32x4 f0 = nf0, f1 = nf1;
            vraw0 = nv0; vraw1 = nv1;
            if (c < 3) { const bf16_t* hn = hp + (size_t)64 * NH;
                nf0 = *(const u32x4*)(hn + HC_HF); nf1 = *(const u32x4*)(hn + HC_HF + 8); nv0 = *(const u32x4*)(hn + HC_HI); nv1 = *(const u32x4*)(hn + HC_HI + 8); }
#pragma unroll
            for (int j = 0; j < 8; ++j) { const unsigned r = (j < 4) ? f0[j] : f1[j - 4];
                const float z0 = bf2f(r & 0xffffu), z1 = bf2f(r >> 16);
                kkv[2 * j] = (1.f - lbv[2 * j]) * sigmoidf_(-z0); kkv[2 * j + 1] = (1.f - lbv[2 * j + 1]) * sigmoidf_(-z1); }
            if constexpr (FULL) {
#pragma unroll
                for (int j = 0; j < 8; ++j) { const unsigned r = (j < 4) ? cq0[j] : cq1[j - 4]; qsv[2 * j] = siluf_(bf2f(r & 0xffffu)); qsv[2 * j + 1] = siluf_(bf2f(r >> 16)); }
            }
#pragma unroll
            for (int j4 = 0; j4 < 4; ++j4) { f32x4 o;
#pragma unroll
                for (int e = 0; e < 4; ++e) o[e] = __logf(1.f - kkv[4 * j4 + e]);
                *(LAS f32x4*)(LF + ps * HG_LFS + 16 * pseg + 4 * j4) = o; }
        }
        __syncthreads();
        {
            const int sk = C.tid & 127, sg = C.tid >> 7;
            float vals[16];
#pragma unroll
            for (int i = 0; i < 16; ++i) vals[i] = LF[(16 * sg + i) * HG_LFS + sk];
#pragma unroll
            for (int i = 1; i < 16; ++i) vals[i] += vals[i - 1];
            LAS float* TOT = (LAS float*)(lds + HG_END);
            TOT[sg * 128 + sk] = vals[15];
            __syncthreads();
            float off = 0.f;
#pragma unroll
            for (int j = 0; j < 3; ++j) if (j < sg) off += TOT[j * 128 + sk];
#pragma unroll
            for (int i = 0; i < 16; ++i) LF[(16 * sg + i) * HG_LFS + sk] = vals[i] + off;
            if (sg == 3) dtot += vals[15] + off;
        }
        __syncthreads();
        float bv[16], b31[16], bl[16];
#pragma unroll
        for (int j4 = 0; j4 < 4; ++j4) { const f32x4 x = *(const LAS f32x4*)(LF + ps * HG_LFS + 16 * pseg + 4 * j4), y = *(const LAS f32x4*)(LF + 31 * HG_LFS + 16 * pseg + 4 * j4), z = *(const LAS f32x4*)(LF + 63 * HG_LFS + 16 * pseg + 4 * j4);
#pragma unroll
            for (int e = 0; e < 4; ++e) { bv[4 * j4 + e] = x[e]; b31[4 * j4 + e] = y[e]; bl[4 * j4 + e] = z[e]; } }
        {
            u32x4 o0, o1;
#pragma unroll
            for (int j = 0; j < 4; ++j) { o0[j] = cvtpk(kkv[2 * j] * __expf(bl[2 * j] - bv[2 * j]), kkv[2 * j + 1] * __expf(bl[2 * j + 1] - bv[2 * j + 1]));
                o1[j] = cvtpk(kkv[8 + 2 * j] * __expf(bl[8 + 2 * j] - bv[8 + 2 * j]), kkv[9 + 2 * j] * __expf(bl[9 + 2 * j] - bv[9 + 2 * j])); }
            *(LAS u32x4*)(lds + HG_KT + ps * 320 + 32 * pseg) = o0; *(LAS u32x4*)(lds + HG_KT + ps * 320 + 32 * pseg + 16) = o1;
            *(LAS u32x4*)(lds + HG_VN + ps * 320 + 32 * pseg) = vraw0; *(LAS u32x4*)(lds + HG_VN + ps * 320 + 32 * pseg + 16) = vraw1;
            if constexpr (FULL) {
                const bool hi = ps >= 32;
                float rr[16];
#pragma unroll
                for (int j = 0; j < 16; ++j) rr[j] = hi ? b31[j] : 0.f;
#pragma unroll
                for (int j = 0; j < 4; ++j) { o0[j] = cvtpk(qsv[2 * j] * __expf(bv[2 * j] - rr[2 * j]), qsv[2 * j + 1] * __expf(bv[2 * j + 1] - rr[2 * j + 1]));
                    o1[j] = cvtpk(qsv[8 + 2 * j] * __expf(bv[8 + 2 * j] - rr[8 + 2 * j]), qsv[9 + 2 * j] * __expf(bv[9 + 2 * j] - rr[9 + 2 * j])); }
                *(LAS u32x4*)(lds + HG_QA + ps * 272 + 32 * pseg) = o0; *(LAS u32x4*)(lds + HG_QA + ps * 272 + 32 * pseg + 16) = o1;
#pragma unroll
                for (int j = 0; j < 4; ++j) { o0[j] = cvtpk(kkv[2 * j] * __expf(rr[2 * j] - bv[2 * j]), kkv[2 * j + 1] * __expf(rr[2 * j + 1] - bv[2 * j + 1]));
                    o1[j] = cvtpk(kkv[8 + 2 * j] * __expf(rr[8 + 2 * j] - bv[8 + 2 * j]), kkv[9 + 2 * j] * __expf(rr[9 + 2 * j] - bv[9 + 2 * j])); }
                *(LAS u32x4*)(lds + HG_KD + ps * 272 + 32 * pseg) = o0; *(LAS u32x4*)(lds + HG_KD + ps * 272 + 32 * pseg + 16) = o1;
                if (hi) {
#pragma unroll
                    for (int j = 0; j < 4; ++j) { o0[j] = cvtpk(qsv[2 * j] * __expf(bv[2 * j]), qsv[2 * j + 1] * __expf(bv[2 * j + 1]));
                        o1[j] = cvtpk(qsv[8 + 2 * j] * __expf(bv[8 + 2 * j]), qsv[9 + 2 * j] * __expf(bv[9 + 2 * j])); }
                    *(LAS u32x4*)(lds + HG_QB + (ps - 32) * 272 + 32 * pseg) = o0; *(LAS u32x4*)(lds + HG_QB + (ps - 32) * 272 + 32 * pseg + 16) = o1;
                } else {
#pragma unroll
                    for (int j = 0; j < 4; ++j) { o0[j] = cvtpk(kkv[2 * j] * __expf(b31[2 * j] - bv[2 * j]), kkv[2 * j + 1] * __expf(b31[2 * j + 1] - bv[2 * j + 1]));
                        o1[j] = cvtpk(kkv[8 + 2 * j] * __expf(b31[8 + 2 * j] - bv[8 + 2 * j]), kkv[9 + 2 * j] * __expf(b31[9 + 2 * j] - bv[9 + 2 * j])); }
                    *(LAS u32x4*)(lds + HG_KO + ps * 272 + 32 * pseg) = o0; *(LAS u32x4*)(lds + HG_KO + ps * 272 + 32 * pseg + 16) = o1;
                }
            }
        }
        float dk[16];
#pragma unroll
        for (int i = 0; i < 16; ++i) dk[i] = __expf(LF[63 * HG_LFS + 32 * wk + (i & 3) + 8 * (i >> 2) + 4 * hh]);
        __syncthreads();
        if constexpr (FULL) {
#pragma unroll
            for (int g = 0; g < 4; ++g) {
                u32x2 o; o[0] = cvtpk(S0[4 * g], S0[4 * g + 1]); o[1] = cvtpk(S0[4 * g + 2], S0[4 * g + 3]);
                *(LAS u32x2*)(lds + HG_LF + (64 * wv + r32) * 272 + (32 * wk + 8 * g + 4 * hh) * 2) = o;
                o[0] = cvtpk(S1[4 * g], S1[4 * g + 1]); o[1] = cvtpk(S1[4 * g + 2], S1[4 * g + 3]);
                *(LAS u32x2*)(lds + HG_LF + (64 * wv + 32 + r32) * 272 + (32 * wk + 8 * g + 4 * hh) * 2) = o;
            }
#define HG_ATILE(AMT_, AST_) do { \
                const LAS unsigned char* kb = ((AMT_) == (AST_)) ? (lds + HG_KD + (32 * (AST_)) * 272) : (lds + HG_KO); \
                f32x16 a; \
                _Pragma("unroll") for (int i = 0; i < 16; ++i) a[i] = 0.f; \
                _Pragma("unroll") for (int ks = 0; ks < 8; ++ks) { \
                    const bf16x8 af = *(const LAS bf16x8*)(lds + HG_QA + (32 * (AMT_) + r32) * 272 + 32 * ks + 16 * hh); \
                    const bf16x8 bf = *(const LAS bf16x8*)(kb + r32 * 272 + 32 * ks + 16 * hh); \
                    a = MFMA32(af, bf, a); } \
                _Pragma("unroll") for (int g = 0; g < 4; ++g) { \
                    float x[4]; \
                    _Pragma("unroll") for (int e = 0; e < 4; ++e) { const int tl = 8 * g + 4 * hh + e; x[e] = ((AMT_) != (AST_) || r32 <= tl) ? a[4 * g + e] : 0.f; } \
                    u32x2 o; o[0] = cvtpk(x[0], x[1]); o[1] = cvtpk(x[2], x[3]); \
                    *(LAS u32x2*)(lds + HG_AM + (32 * (AST_) + r32) * 192 + (32 * (AMT_) + 8 * g + 4 * hh) * 2) = o; } } while (0)
            if (w == 0) { HG_ATILE(0, 0); }
            else if (w == 1) { HG_ATILE(1, 0); }
            else if (w == 2) { HG_ATILE(1, 1); }
        }
#pragma unroll
        for (int i = 0; i < 16; ++i) { S0[i] *= dk[i]; S1[i] *= dk[i]; }
#pragma unroll
        for (int ks = 0; ks < 4; ++ks) {
            const LAS unsigned char* ka = lds + HG_KT + (16 * ks + 8 * hh + q4) * 320 + (32 * wk + 16 * blk + 4 * p4) * 2;
            const s16x4 alo = vtr(ka), ahi = vtr(ka + 4 * 320);
            const bf16x8 af = __builtin_shufflevector(alo, ahi, 0, 1, 2, 3, 4, 5, 6, 7);
            const LAS unsigned char* vb0 = lds + HG_VN + (16 * ks + 8 * hh + q4) * 320 + (64 * wv + 16 * blk + 4 * p4) * 2;
            const s16x4 b0lo = vtr(vb0), b0hi = vtr(vb0 + 4 * 320), b1lo = vtr(vb0 + 64), b1hi = vtr(vb0 + 64 + 4 * 320);
            S0 = MFMA32(af, __builtin_shufflevector(b0lo, b0hi, 0, 1, 2, 3, 4, 5, 6, 7), S0);
            S1 = MFMA32(af, __builtin_shufflevector(b1lo, b1hi, 0, 1, 2, 3, 4, 5, 6, 7), S1);
        }
        if constexpr (FULL) {
            __syncthreads();
            f32x16 o;
#pragma unroll
            for (int i = 0; i < 16; ++i) o[i] = 0.f;
            const LAS unsigned char* qb = (mt == 0) ? (lds + HG_QA) : (lds + HG_QB);
#pragma unroll
            for (int ks = 0; ks < 8; ++ks) {
                const bf16x8 af = *(const LAS bf16x8*)(qb + r32 * 272 + 32 * ks + 16 * hh);
                const bf16x8 bf = *(const LAS bf16x8*)(lds + HG_LF + (32 * nt + r32) * 272 + 32 * ks + 16 * hh);
                o = MFMA32(af, bf, o);
            }
#pragma unroll
            for (int ks = 0; ks < 4; ++ks) {
                if (mt == 0 && ks >= 2) continue;
                const LAS unsigned char* aa = lds + HG_AM + (16 * ks + 8 * hh + q4) * 192 + (32 * mt + 16 * blk + 4 * p4) * 2;
                const s16x4 alo = vtr(aa), ahi = vtr(aa + 4 * 192);
                const LAS unsigned char* vb0 = lds + HG_VN + (16 * ks + 8 * hh + q4) * 320 + (32 * nt + 16 * blk + 4 * p4) * 2;
                const s16x4 blo = vtr(vb0), bhi = vtr(vb0 + 4 * 320);
                o = MFMA32(__builtin_shufflevector(alo, ahi, 0, 1, 2, 3, 4, 5, 6, 7), __builtin_shufflevector(blo, bhi, 0, 1, 2, 3, 4, 5, 6, 7), o);
            }
            __syncthreads();
#pragma unroll
            for (int i = 0; i < 16; ++i) LF[(32 * mt + (i & 3) + 8 * (i >> 2) + 4 * hh) * HG_LFS + 32 * nt + r32] = o[i];
            __syncthreads();
            {
                float ov[16]; float ss = 0.f;
#pragma unroll
                for (int j4 = 0; j4 < 4; ++j4) { const f32x4 x = *(const LAS f32x4*)(LF + ps * HG_LFS + 16 * pseg + 4 * j4);
#pragma unroll
                    for (int e = 0; e < 4; ++e) { ov[4 * j4 + e] = x[e]; ss += x[e] * x[e]; } }
                ss += __shfl_xor(ss, 1, 64); ss += __shfl_xor(ss, 2, 64); ss += __shfl_xor(ss, 4, 64);
                const float rn = rsqrtf(ss * (1.f / 128.f) + RMS_EPS);
                const u32x4 g0 = cg0, g1 = cg1;
                const float* ng = C.in[I_HNG] + l * 128 + 16 * pseg;
                u32x4 o0, o1;
#pragma unroll
                for (int j = 0; j < 4; ++j) {
                    o0[j] = cvtpk(ov[2 * j] * rn * ng[2 * j] * siluf_(bf2f(g0[j] & 0xffffu)), ov[2 * j + 1] * rn * ng[2 * j + 1] * siluf_(bf2f(g0[j] >> 16)));
                    o1[j] = cvtpk(ov[8 + 2 * j] * rn * ng[8 + 2 * j] * siluf_(bf2f(g1[j] & 0xffffu)), ov[9 + 2 * j] * rn * ng[9 + 2 * j] * siluf_(bf2f(g1[j] >> 16)));
                }
                bf16_t* bp = BR + (row0 + ps) * NBR + 512 + h * 128 + 16 * pseg;
                *(u32x4*)bp = o0; *(u32x4*)(bp + 8) = o1;
            }
        }
        __syncthreads();
    }
    if constexpr (!FULL) {
#pragma unroll
        for (int i = 0; i < 16; ++i) { const int k = 32 * wk + (i & 3) + 8 * (i >> 2) + 4 * hh;
            stp[k * 128 + 64 * wv + r32] = S0[i]; stp[k * 128 + 64 * wv + 32 + r32] = S1[i]; }
        if (C.tid >= 384) DSC[((size_t)bh * 32 + sc) * 128 + (C.tid & 127)] = __expf(dtot);
    }
}
__device__ __forceinline__ void hgrn_b1(const Ctx& C, int l) { for (int u = C.bid; u < BATCH * 4 * 32; u += C.G) hgrn_unit<false>(C, l, u); }
__device__ __forceinline__ void hgrn_b3(const Ctx& C, int l) { for (int u = C.bid; u < BATCH * 4 * 32; u += C.G) hgrn_unit<true>(C, l, u); }
__device__ __forceinline__ void hgrn_b2(const Ctx& C) {
    float* STB = (float*)(C.ws + WS_ST); const float* DSC = (const float*)(C.ws + WS_DSC);
    for (int e = C.bid * 512 + C.tid; e < BATCH * 4 * 128 * 128; e += C.G * 512) {
        const int bh = e >> 14, kv = e & 16383, k = kv >> 7;
        float* p = STB + (size_t)bh * 32 * 16384 + kv;
        float uu[32], dd[32];
#pragma unroll
        for (int s = 0; s < 32; ++s) { uu[s] = p[(size_t)s * 16384]; dd[s] = DSC[((size_t)bh * 32 + s) * 128 + k]; }
        float st = 0.f;
#pragma unroll
        for (int s = 0; s < 32; ++s) { p[(size_t)s * 16384] = st; st = dd[s] * st + uu[s]; }
    }
}


__device__ __forceinline__ void mix_pool(const Ctx& C, int l) {
#if DIAG == 2
    const bf16_t* H = (const bf16_t*)(C.ws + WS_H); bf16_t* BR = (l == 0) ? (bf16_t*)(C.ws + WS_XA) : (bf16_t*)(C.ws + WS_TABU);
#else
    const bf16_t* H = (const bf16_t*)(C.ws + WS_H); bf16_t* BR = (bf16_t*)(C.ws + WS_BR);
#endif
    const bf16_t* Wt = (const bf16_t*)(C.ws + WS_W + (size_t)l * W_LAYER + WO_POOLW);
    LAS unsigned char* lds = C.lds;
    constexpr int PL_P = 128 * 272;
    const int lane = C.lane, w = C.wave, r32 = lane & 31, hh = lane >> 5;
    for (int u = C.bid; u < (T / 256) * 4; u += C.G) {
        const int g = u & 3, t0 = (u >> 2) * 256, win = 2 << g;
        const int row = t0 + 32 * w + r32, pos = row & (SEQ - 1);
        __syncthreads();
#pragma unroll
        for (int p = 0; p < 4; ++p) { const int idx = C.tid + 512 * p, rr = idx >> 4, ch = idx & 15;
            *(LAS u32x4*)(lds + rr * 272 + ch * 16) = *(const u32x4*)(Wt + (size_t)g * 128 * 128 + rr * 128 + ch * 8); }
        const bool seq_start = (t0 & (SEQ - 1)) == 0;
        for (int idx = C.tid; idx < 271 * 16; idx += 512) { const int rr = idx >> 4, ch = idx & 15;
            if (!(seq_start && rr < 15)) *(LAS u32x4*)(lds + PL_P + rr * 272 + ch * 16) = *(const u32x4*)(H + (size_t)(t0 - 15 + rr) * NH + HC_P + g * 128 + ch * 8); }
        __syncthreads();
        const int nwin = (pos + 1 < win) ? pos + 1 : win;
        const float invn = 1.f / (float)nwin;
        bf16x8 df[8];
        const LAS unsigned char* prow = lds + PL_P + (32 * w + r32 + 15) * 272 + 16 * hh;
#pragma unroll
        for (int ks = 0; ks < 8; ++ks) {
            float sum[8];
#pragma unroll
            for (int e = 0; e < 8; ++e) sum[e] = 0.f;
            const u32x4 self = *(const LAS u32x4*)(prow + 32 * ks);
#pragma unroll
            for (int j = 0; j < 16; ++j) if (j < win) {
                const int jj = (j < nwin) ? j : 0; const float msk = (j < nwin) ? 1.f : 0.f;
                const u32x4 rw = *(const LAS u32x4*)(prow + 32 * ks - jj * 272);
#pragma unroll
                for (int e = 0; e < 4; ++e) { sum[2 * e] += msk * bf2f(rw[e] & 0xffffu); sum[2 * e + 1] += msk * bf2f(rw[e] >> 16); } }
            u32x4 o;
#pragma unroll
            for (int e = 0; e < 4; ++e) o[e] = cvtpk(sum[2 * e] * invn - bf2f(self[e] & 0xffffu), sum[2 * e + 1] * invn - bf2f(self[e] >> 16));
            df[ks] = __builtin_bit_cast(bf16x8, o);
        }
        f32x16 acc[4];
#pragma unroll
        for (int mt = 0; mt < 4; ++mt)
#pragma unroll
            for (int i = 0; i < 16; ++i) acc[mt][i] = 0.f;
#pragma unroll
        for (int ks = 0; ks < 8; ++ks)
#pragma unroll
            for (int mt = 0; mt < 4; ++mt) {
                const bf16x8 wf = *(const LAS bf16x8*)(lds + (32 * mt + r32) * 272 + 32 * ks + 16 * hh);
                acc[mt] = MFMA32(wf, df[ks], acc[mt]);
            }
        const float* psc = C.in[I_POOLS] + l * BW + g * 128;
        bf16_t* op = BR + (size_t)row * NBR + g * 128;
#pragma unroll
        for (int mt = 0; mt < 4; ++mt)
#pragma unroll
            for (int q = 0; q < 4; ++q) { const int d0 = 32 * mt + 8 * q + 4 * hh; const f32x4 sc = *(const f32x4*)(psc + d0);
                u32x2 o; o[0] = cvtpk(acc[mt][4 * q] * sc[0], acc[mt][4 * q + 1] * sc[1]); o[1] = cvtpk(acc[mt][4 * q + 2] * sc[2], acc[mt][4 * q + 3] * sc[3]);
                *(u32x2*)(op + d0) = o; }
    }
}
constexpr int GM_VN = 0, GM_WC = 128 * 320, GM_END = GM_WC + 128 * 272;
__device__ __forceinline__ void mix_gmlp(const Ctx& C, int l) {
#if DIAG == 3
    const bf16_t* H = (const bf16_t*)(C.ws + WS_H); bf16_t* BR = (l == 0) ? (bf16_t*)(C.ws + WS_XA) : (bf16_t*)(C.ws + WS_TABU);
#else
    const bf16_t* H = (const bf16_t*)(C.ws + WS_H); bf16_t* BR = (bf16_t*)(C.ws + WS_BR);
#endif
    const bf16_t* Wc = (const bf16_t*)(C.ws + WS_W + (size_t)l * W_LAYER + WO_GWS);
    LAS unsigned char* lds = C.lds;
    const int lane = C.lane, w = C.wave, r32 = lane & 31, hh = lane >> 5;
    const int i16 = lane & 15, q4 = i16 >> 2, p4 = i16 & 3, blk = (lane >> 4) & 1;
    for (int u = C.bid; u < (T / 128) * 4; u += C.G) {
        const int g = u & 3, t0 = (u >> 2) * 128;
        __syncthreads();
#pragma unroll
        for (int p = 0; p < 4; ++p) { const int idx = C.tid + 512 * p, rr = idx >> 4, ch = idx & 15;
            *(LAS u32x4*)(lds + GM_WC + rr * 272 + ch * 16) = *(const u32x4*)(Wc + (size_t)g * 128 * 128 + rr * 128 + ch * 8); }
        u32x4 rawall[16];
#pragma unroll
        for (int i = 0; i < 16; ++i) rawall[i] = *(const u32x4*)(H + (size_t)(t0 + w * 16 + i) * NH + HC_GV + lane * 8);
#pragma unroll
        for (int hb = 0; hb < 4; ++hb) {
            u32x4 rawv[4];
#pragma unroll
            for (int i = 0; i < 4; ++i) rawv[i] = rawall[hb * 4 + i];
            float e[4][8], st[8];
#pragma unroll
            for (int i = 0; i < 4; ++i) { float s1 = 0.f, s2 = 0.f;
#pragma unroll
                for (int j = 0; j < 4; ++j) { const float a = geluf_(bf2f(rawv[i][j] & 0xffffu)), b = geluf_(bf2f(rawv[i][j] >> 16)); e[i][2 * j] = a; e[i][2 * j + 1] = b; s1 += a + b; s2 += a * a + b * b; }
                st[i] = s1; st[4 + i] = s2; }
#pragma unroll
            for (int sx = 32, n = 4; sx >= 8; sx >>= 1, n >>= 1) { const bool up = (lane & sx) != 0;
#pragma unroll
                for (int i = 0; i < n; ++i) { const float send = up ? st[i] : st[i + n], keep = up ? st[i + n] : st[i]; st[i] = keep + __shfl_xor(send, sx, 64); } }
            float tot = st[0]; tot += __shfl_xor(tot, 4, 64); tot += __shfl_xor(tot, 2, 64); tot += __shfl_xor(tot, 1, 64);
            float mean4[4], rstd4[4];
#pragma unroll
            for (int i = 0; i < 4; ++i) {
                mean4[i] = __builtin_bit_cast(float, __builtin_amdgcn_readlane(__builtin_bit_cast(int, tot), 8 * i)) * (1.f / BW);
                const float ex2 = __builtin_bit_cast(float, __builtin_amdgcn_readlane(__builtin_bit_cast(int, tot), 8 * (4 + i))) * (1.f / BW);
                rstd4[i] = rsqrtf(fmaxf(ex2 - mean4[i] * mean4[i], 0.f) + LN_EPS);
            }
            asm volatile("" ::: "memory");
            if ((lane >> 4) == g) {
                const float* lg = C.in[I_GLNG] + l * BW + lane * 8; const float* lb = C.in[I_GLNB] + l * BW + lane * 8;
#pragma unroll
                for (int i = 0; i < 4; ++i) {
                    const float mean = mean4[i], rstd = rstd4[i];
                    u32x4 o;
#pragma unroll
                    for (int j = 0; j < 4; ++j) o[j] = cvtpk((e[i][2 * j] - mean) * rstd * lg[2 * j] + lb[2 * j], (e[i][2 * j + 1] - mean) * rstd * lg[2 * j + 1] + lb[2 * j + 1]);
                    *(LAS u32x4*)(lds + GM_VN + (w * 16 + hb * 4 + i) * 320 + (lane & 15) * 16) = o;
                }
            }
        }
        __syncthreads();
        const int nt = w & 3, mb = (w >> 2) * 2;
        u32x2 upre[2][4];
#pragma unroll
        for (int m = 0; m < 2; ++m)
#pragma unroll
            for (int q = 0; q < 4; ++q) upre[m][q] = *(const u32x2*)(H + (size_t)(t0 + 32 * nt + r32) * NH + HC_GU + g * 128 + 32 * (mb + m) + 8 * q + 4 * hh);
        f32x16 acc[2];
#pragma unroll
        for (int m = 0; m < 2; ++m)
#pragma unroll
            for (int i = 0; i < 16; ++i) acc[m][i] = 0.f;
        for (int ks = 0; ks < 2 * (nt + 1); ++ks) {
            const bf16x8 bf = *(const LAS bf16x8*)(lds + GM_WC + (32 * nt + r32) * 272 + 32 * ks + 16 * hh);
#pragma unroll
            for (int m = 0; m < 2; ++m) {
                const LAS unsigned char* aa = lds + GM_VN + (16 * ks + 8 * hh + q4) * 320 + (32 * (mb + m) + 16 * blk + 4 * p4) * 2;
                const s16x4 lo = vtr(aa), hi = vtr(aa + 4 * 320);
                acc[m] = MFMA32(__builtin_shufflevector(lo, hi, 0, 1, 2, 3, 4, 5, 6, 7), bf, acc[m]);
            }
        }
        const int tl = 32 * nt + r32, row = t0 + tl;
        const float bias = C.in[I_GBS][(l * 4 + g) * 128 + tl];
#pragma unroll
        for (int m = 0; m < 2; ++m)
#pragma unroll
            for (int q = 0; q < 4; ++q) { const int c0 = 32 * (mb + m) + 8 * q + 4 * hh;
                const u32x2 ur = upre[m][q];
                u32x2 o;
                o[0] = cvtpk(geluf_(bf2f(ur[0] & 0xffffu)) * (acc[m][4 * q] + bias), geluf_(bf2f(ur[0] >> 16)) * (acc[m][4 * q + 1] + bias));
                o[1] = cvtpk(geluf_(bf2f(ur[1] & 0xffffu)) * (acc[m][4 * q + 2] + bias), geluf_(bf2f(ur[1] >> 16)) * (acc[m][4 * q + 3] + bias));
                *(u32x2*)(BR + (size_t)row * NBR + 1024 + g * 128 + c0) = o; }
    }
}

#define CE_D(a, b) do { const float _h = fmaxf(a, b), _l = fminf(a, b); a = _h; b = _l; } while (0)
__device__ __forceinline__ void sort16_desc(float (&x)[16]) {
#define S16(a, b) CE_D(x[a], x[b])
    S16(0, 13); S16(1, 12); S16(2, 15); S16(3, 14); S16(4, 8); S16(5, 6); S16(7, 11); S16(9, 10);
    S16(0, 5); S16(1, 7); S16(2, 9); S16(3, 4); S16(6, 13); S16(8, 14); S16(10, 15); S16(11, 12);
    S16(0, 1); S16(2, 3); S16(4, 5); S16(6, 8); S16(7, 9); S16(10, 11); S16(12, 13); S16(14, 15);
    S16(0, 2); S16(1, 3); S16(4, 10); S16(5, 11); S16(6, 7); S16(8, 9); S16(12, 14); S16(13, 15);
    S16(1, 2); S16(3, 12); S16(4, 6); S16(5, 7); S16(8, 10); S16(9, 11); S16(13, 14);
    S16(1, 4); S16(2, 6); S16(5, 8); S16(7, 10); S16(9, 13); S16(11, 14);
    S16(2, 4); S16(3, 6); S16(9, 12); S16(11, 13);
    S16(3, 5); S16(6, 8); S16(7, 9); S16(10, 12);
    S16(3, 4); S16(5, 6); S16(7, 8); S16(9, 10); S16(11, 12);
    S16(6, 7); S16(8, 9);
#undef S16
}
__device__ __forceinline__ void bmerge16_desc(float (&x)[16]) {
#pragma unroll
    for (int j = 8; j > 0; j >>= 1)
#pragma unroll
        for (int i = 0; i < 16; ++i) { const int l = i ^ j; if (l > i) CE_D(x[i], x[l]); }
}
__device__ __forceinline__ void top16_merge(float (&a)[16], const float (&b)[16]) {
#pragma unroll
    for (int i = 0; i < 16; ++i) a[i] = fmaxf(a[i], b[15 - i]);
    bmerge16_desc(a);
}
__device__ __forceinline__ float pack_idx(float v, unsigned idx, unsigned mask) { return __builtin_bit_cast(float, (__builtin_bit_cast(unsigned, v) & ~mask) | idx); }

constexpr int TK_KST = 272, TK_KBUF = 128 * TK_KST;
__device__ __forceinline__ void p_topk(const Ctx& C, int l) {
    const bf16_t* Q = (const bf16_t*)(C.ws + WS_Q);
    const bf16_t* keys = (const bf16_t*)(C.ws + WS_W + (size_t)l * W_LAYER + WO_KEYS);
    int* eidx = (int*)(C.ws + WS_EIDX); float* egate = (float*)(C.ws + WS_EGATE);
    LAS unsigned char* lds = C.lds;
    const int lane = C.lane, w = C.wave, r32 = lane & 31, hh = lane >> 5;
    for (int u = C.bid; u < (T / 256) * PH; u += C.G) {
        const int h = u & 7, t0 = (u >> 3) * 256, tok = t0 + 32 * w + r32;
        float v12[2][16];
        __syncthreads();
#pragma unroll
        for (int j = 0; j < 2; ++j) {
            const bf16_t* kp = keys + ((size_t)j * PH + h) * 128 * 128;
#pragma unroll
            for (int p = 0; p < 4; ++p) { const int idx = C.tid + 512 * p, row = idx >> 4, ch = idx & 15;
                *(LAS u32x4*)(lds + j * TK_KBUF + row * TK_KST + ch * 16) = *(const u32x4*)(kp + row * 128 + ch * 8); }
        }
        __syncthreads();
#pragma unroll
        for (int j = 0; j < 2; ++j) {
            bf16x8 qf[8];
            {
                LAS unsigned char* qs = lds + 2 * TK_KBUF + w * (32 * 272);
                u32x4 qr[8];
#pragma unroll
                for (int p = 0; p < 8; ++p) qr[p] = *(const u32x4*)(Q + (size_t)(t0 + 32 * w + 4 * p + (lane >> 4)) * NQ + h * 256 + j * 128 + (lane & 15) * 8);
#pragma unroll
                for (int p = 0; p < 8; ++p) *(LAS u32x4*)(qs + (4 * p + (lane >> 4)) * 272 + (lane & 15) * 16) = qr[p];
#pragma unroll
                for (int ks = 0; ks < 8; ++ks) qf[ks] = *(const LAS bf16x8*)(qs + r32 * 272 + 32 * ks + 16 * hh);
            }
            f32x16 sacc[4];
#pragma unroll
            for (int mt = 0; mt < 4; ++mt)
#pragma unroll
                for (int i = 0; i < 16; ++i) sacc[mt][i] = 0.f;
#pragma unroll
            for (int ks = 0; ks < 8; ++ks)
#pragma unroll
                for (int mt = 0; mt < 4; ++mt) {
                    const bf16x8 kf = *(const LAS bf16x8*)(lds + j * TK_KBUF + (32 * mt + r32) * TK_KST + 32 * ks + 16 * hh);
                    sacc[mt] = MFMA32(kf, qf[ks], sacc[mt]);
                }
            float g[4][16];
#pragma unroll
            for (int mt = 0; mt < 4; ++mt) {
#pragma unroll
                for (int i = 0; i < 16; ++i) g[mt][i] = pack_idx(sacc[mt][i], (unsigned)(32 * mt + (i & 3) + 8 * (i >> 2) + 4 * hh), 127u);
                sort16_desc(g[mt]);
            }
            top16_merge(g[0], g[1]); top16_merge(g[2], g[3]); top16_merge(g[0], g[2]);
            float o[16];
#pragma unroll
            for (int i = 0; i < 16; ++i) o[i] = __shfl_xor(g[0][i], 32, 64);
            top16_merge(g[0], o);
#pragma unroll
            for (int i = 0; i < 16; ++i) v12[j][i] = g[0][i];
        }
        float c[4][16];
        {
            int n = 0;
#pragma unroll
            for (int a = 0; a < 16; ++a)
#pragma unroll
                for (int b = 0; b < 16; ++b) if ((a + 1) * (b + 1) <= 16) {
                    const unsigned id = ((__builtin_bit_cast(unsigned, v12[0][a]) & 127u) << 7) | (__builtin_bit_cast(unsigned, v12[1][b]) & 127u);
                    c[n >> 4][n & 15] = pack_idx(v12[0][a] + v12[1][b], id, 16383u); ++n; }
#pragma unroll
            for (; n < 64; ++n) c[n >> 4][n & 15] = -3.0e38f;
        }
        sort16_desc(c[1]); sort16_desc(c[2]); CE_D(c[3][0], c[3][1]);
        top16_merge(c[0], c[1]); top16_merge(c[2], c[3]); top16_merge(c[0], c[2]);
        float e[16], den = 0.f;
#pragma unroll
        for (int i = 0; i < 16; ++i) { e[i] = __expf(c[0][i] - c[0][0]); den += e[i]; }
        const float inv = 1.f / den;
        int* ip = eidx + (size_t)tok * 128 + h * 16 + 8 * hh; float* gp = egate + (size_t)tok * 128 + h * 16 + 8 * hh;
        u32x4 i0, i1; f32x4 g0, g1;
#pragma unroll
        for (int i = 0; i < 4; ++i) {
            const float ca = hh ? c[0][8 + i] : c[0][i], cb = hh ? c[0][12 + i] : c[0][4 + i];
            i0[i] = __builtin_bit_cast(unsigned, ca) & 16383u; i1[i] = __builtin_bit_cast(unsigned, cb) & 16383u;
            g0[i] = (hh ? e[8 + i] : e[i]) * inv; g1[i] = (hh ? e[12 + i] : e[4 + i]) * inv;
        }
        *(u32x4*)ip = i0; *(u32x4*)(ip + 4) = i1; *(f32x4*)gp = g0; *(f32x4*)(gp + 4) = g1;
    }
}

constexpr int CW_DIAG = 64;
__device__ __forceinline__ void diag_cmp(const Ctx& C, const bf16_t* A, int lda, const bf16_t* R, int ldr, int nc) {
    float sd = 0.f, sr = 0.f;
    for (int row = C.bid; row < T; row += C.G) {
        const int tm = row % DIAG_MOD; if (tm < DIAG_LO || tm >= DIAG_HI) continue;
        for (int c = C.tid; c < nc; c += 512) { const float a = bf2f(A[(size_t)row * lda + c]), r = bf2f(R[(size_t)row * ldr + c]); sd += (a - r) * (a - r); sr += r * r; }
    }
    sd = wave_sum(sd); sr = wave_sum(sr);
    if (C.lane == 0) { atomicAdd((float*)(C.ws + WS_CTL) + CW_DIAG, sd); atomicAdd((float*)(C.ws + WS_CTL) + CW_DIAG + 1, sr); }
}
__device__ __forceinline__ void diag_cmp_u8(const Ctx& C, const unsigned char* A, int lda, const bf16_t* R, int ldr, int nc) {
    float sd = 0.f, sr = 0.f;
    for (int row = C.bid; row < T; row += C.G)
        for (int c = C.tid; c < nc; c += 512) { const float a = (float)A[(size_t)row * lda + c] * (1.f / 255.f), r = bf2f(R[(size_t)row * ldr + c]); sd += (a - r) * (a - r); sr += r * r; }
    sd = wave_sum(sd); sr = wave_sum(sr);
    if (C.lane == 0) { atomicAdd((float*)(C.ws + WS_CTL) + CW_DIAG, sd); atomicAdd((float*)(C.ws + WS_CTL) + CW_DIAG + 1, sr); }
}
__device__ __forceinline__ float diag_alpha(const Ctx& C) {
    const float sd = __hip_atomic_load((float*)(C.ws + WS_CTL) + CW_DIAG, __ATOMIC_RELAXED, __HIP_MEMORY_SCOPE_AGENT), sr = __hip_atomic_load((float*)(C.ws + WS_CTL) + CW_DIAG + 1, __ATOMIC_RELAXED, __HIP_MEMORY_SCOPE_AGENT);
    const float err = fmaxf(sd / fmaxf(sr, 1e-30f), 1e-8f);
    return 0.1f + 0.1f * (rintf(log10f(err / 1e-8f) * 10.f) * 0.1f);
}


#if DIAG == 5 || DIAG == 6
__device__ __forceinline__ void diag_ref_slice(const Ctx& C, const float* W, int ldw, int n0, const float* bias) {
    bf16_t* alt = (bf16_t*)(C.ws + WS_XA);
    const float* X = C.in[I_X];
    for (int row = C.bid * 8 + C.wave; row < T; row += C.G * 8) {
        float acc = 0.f;
        for (int k = 0; k < DM; ++k) acc += X[(size_t)row * DM + k] * W[(size_t)k * ldw + n0 + C.lane];
        if (bias) acc = sigmoidf_(acc + bias[n0 + C.lane]);
        alt[(size_t)row * 64 + C.lane] = (bf16_t)f2bf(acc);
    }
}
#endif

__device__ __forceinline__ void wave_argmax(float& v, int& i) {
#pragma unroll
    for (int o = 32; o > 0; o >>= 1) {
        const float ov = __shfl_xor(v, o, 64); const int oi = __shfl_xor(i, o, 64);
        if (ov > v || (ov == v && oi < i)) { v = ov; i = oi; }
    }
}
__device__ __forceinline__ void p_topk_naive(const Ctx& C, int l) {
    const bf16_t* Q = (const bf16_t*)(C.ws + WS_Q);
    const bf16_t* keys = (const bf16_t*)(C.ws + WS_W + (size_t)l * W_LAYER + WO_KEYS);
    int* eidx = (int*)(C.ws + WS_EIDX); float* egate = (float*)(C.ws + WS_EGATE);
    LAS float* qs = (LAS float*)C.lds;
    LAS float* sc = qs + 2048;
    LAS float* tv = sc + 2048;
    LAS int* ti = (LAS int*)(tv + 256);
    for (int t = C.bid; t < T; t += C.G) {
        for (int i = C.tid; i < 2048; i += 512) qs[i] = bf2f(Q[(size_t)t * NQ + i]);
        __syncthreads();
        for (int i = 0; i < 4; ++i) {
            const int idx = C.tid + 512 * i, hj = idx >> 7, key = idx & 127, h = hj >> 1, j = hj & 1;
            const bf16_t* kp = keys + (((size_t)j * PH + h) * 128 + key) * 128;
            float s = 0.f;
            for (int d8 = 0; d8 < 16; ++d8) {
                const u32x4 raw = *(const u32x4*)(kp + d8 * 8);
#pragma unroll
                for (int e = 0; e < 4; ++e) s += qs[h * 256 + j * 128 + d8 * 8 + 2 * e] * bf2f(raw[e] & 0xffffu) + qs[h * 256 + j * 128 + d8 * 8 + 2 * e + 1] * bf2f(raw[e] >> 16);
            }
            sc[idx] = s;
        }
        __syncthreads();
        for (int i = 0; i < 2; ++i) {
            const int hj = C.wave * 2 + i;
            float a0 = sc[hj * 128 + C.lane], a1 = sc[hj * 128 + 64 + C.lane];
            for (int r = 0; r < 16; ++r) {
                float bv; int bi;
                if (a0 > a1 || (a0 == a1)) { bv = a0; bi = C.lane; } else { bv = a1; bi = C.lane + 64; }
                wave_argmax(bv, bi);
                if (C.lane == 0) { tv[hj * 16 + r] = bv; ti[hj * 16 + r] = bi; }
                if (bi == C.lane) a0 = -3e38f; if (bi == C.lane + 64) a1 = -3e38f;
            }
        }
        __syncthreads();
        {
            const int h = C.wave;
            float cv[4];
#pragma unroll
            for (int i = 0; i < 4; ++i) { const int c = C.lane * 4 + i; cv[i] = tv[(h * 2) * 16 + (c >> 4)] + tv[(h * 2 + 1) * 16 + (c & 15)]; }
            float topv = 0.f; int tope = 0; float mx = 0.f;
            for (int r = 0; r < 16; ++r) {
                float bv = cv[0]; int bi = C.lane * 4;
#pragma unroll
                for (int i = 1; i < 4; ++i) if (cv[i] > bv) { bv = cv[i]; bi = C.lane * 4 + i; }
                wave_argmax(bv, bi);
                if (r == 0) mx = bv;
                if (C.lane == r) { topv = bv; tope = ti[(h * 2) * 16 + (bi >> 4)] * 128 + ti[(h * 2 + 1) * 16 + (bi & 15)]; }
#pragma unroll
                for (int i = 0; i < 4; ++i) if (bi == C.lane * 4 + i) cv[i] = -3e38f;
            }
            float e = (C.lane < 16) ? __expf(topv - mx) : 0.f;
            const float den = wave_sum(e);
            if (C.lane < 16) { eidx[(size_t)t * 128 + h * 16 + C.lane] = tope; egate[(size_t)t * 128 + h * 16 + C.lane] = e / den; }
        }
        __syncthreads();
    }
}
__device__ __forceinline__ float ub(unsigned w, int e) { return (float)((w >> (8 * e)) & 255u); }
__device__ __forceinline__ void p_gather(const Ctx& C, int l) {
    const bf16_t* xc = (const bf16_t*)(C.ws + WS_X1B);
    const unsigned char* U8 = C.ws + WS_U8; const unsigned char* V8 = C.ws + WS_V8;
    const float* SU = (const float*)(C.ws + WS_SU); const float* SV = (const float*)(C.ws + WS_SV);
    const int* eidx = (const int*)(C.ws + WS_EIDX); const float* egate = (const float*)(C.ws + WS_EGATE);
    const int lane = C.lane;
    for (int t = C.bid * 8 + C.wave; t < T; t += C.G * 8) {
        float x[16];
        { const bf16_t* xp = xc + (size_t)t * DM + lane * 16;
          const u32x4 a = *(const u32x4*)xp, b = *(const u32x4*)(xp + 8);
#pragma unroll
          for (int i = 0; i < 4; ++i) { x[2 * i] = bf2f(a[i] & 0xffffu); x[2 * i + 1] = bf2f(a[i] >> 16); x[8 + 2 * i] = bf2f(b[i] & 0xffffu); x[9 + 2 * i] = bf2f(b[i] >> 16); } }
        float xmx = 0.f;
#pragma unroll
        for (int j = 0; j < 16; ++j) xmx = fmaxf(xmx, fabsf(x[j]));
        xmx = fmaxf(wave_max(xmx), 1e-30f);
        const float xisc = 127.f / xmx, xsc = xmx * (1.f / 127.f);
        int xq[4];
#pragma unroll
        for (int q = 0; q < 4; ++q) { unsigned wd = 0u;
#pragma unroll
            for (int e = 0; e < 4; ++e) wd |= ((unsigned)(int)rintf(x[4 * q + e] * xisc) & 255u) << (8 * e);
            xq[q] = (int)wd; }
        float cf[2]; int ex[2];
#pragma unroll
        for (int bt = 0; bt < 2; ++bt) {
            ex[bt] = eidx[(size_t)t * 128 + 64 * bt + lane];
            const float gate = egate[(size_t)t * 128 + 64 * bt + lane];
            int p[64];
#pragma unroll
            for (int e0 = 0; e0 < 64; e0 += 16) {
                u32x4 r[16];
#pragma unroll
                for (int i = 0; i < 16; ++i) { const int e = __builtin_amdgcn_readlane(ex[bt], e0 + i); r[i] = *(const u32x4*)(U8 + (size_t)e * DM + lane * 16); }
#pragma unroll
                for (int i = 0; i < 16; ++i) { int a = 0;
#pragma unroll
                    for (int q = 0; q < 4; ++q) a = __builtin_amdgcn_sdot4(xq[q], (int)r[i][q], a, false);
                    p[e0 + i] = a; }
            }
#pragma unroll
            for (int st = 32, n = 32; st > 0; st >>= 1, n >>= 1) {
                const bool up = (lane & st) != 0;
#pragma unroll
                for (int i = 0; i < n; ++i) { const int send = up ? p[i] : p[i + n], keep = up ? p[i + n] : p[i]; p[i] = keep + __shfl_xor(send, st, 64); }
            }
            const float hsum = SU[ex[bt]] * xsc * (float)p[0];
            cf[bt] = gate * geluf_slow(hsum) * SV[ex[bt]];
        }
        float y[16];
#pragma unroll
        for (int j = 0; j < 16; ++j) y[j] = 0.f;
        float csum = wave_sum(cf[0] + cf[1]);
#pragma unroll
        for (int bt = 0; bt < 2; ++bt)
#pragma unroll
            for (int e0 = 0; e0 < 64; e0 += 16) {
                u32x4 r[16];
#pragma unroll
                for (int i = 0; i < 16; ++i) { const int e = __builtin_amdgcn_readlane(ex[bt], e0 + i); r[i] = *(const u32x4*)(V8 + (size_t)e * DM + lane * 16); }
#pragma unroll
                for (int i = 0; i < 16; ++i) { const float c = __builtin_bit_cast(float, __builtin_amdgcn_readlane(__builtin_bit_cast(int, cf[bt]), e0 + i));
#pragma unroll
                    for (int q = 0; q < 4; ++q)
#pragma unroll
                        for (int e = 0; e < 4; ++e) y[4 * q + e] += c * ub(r[i][q], e); }
            }
#pragma unroll
        for (int j = 0; j < 16; ++j) y[j] = y[j] - 128.f * csum + ALPHA * x[j];
        float sm = 0.f;
#pragma unroll
        for (int j = 0; j < 16; ++j) sm += y[j];
        const float mean = wave_sum(sm) * (1.f / DM);
        float qq = 0.f;
#pragma unroll
        for (int j = 0; j < 16; ++j) { const float d = y[j] - mean; qq += d * d; }
        const float rstd = rsqrtf(wave_sum(qq) * (1.f / DM) + LN_EPS);
        const float* gp = C.in[I_LN2G] + l * DM + lane * 16; const float* bp = C.in[I_LN2B] + l * DM + lane * 16;
#pragma unroll
        for (int i = 0; i < 4; ++i) { const f32x4 gg = *(const f32x4*)(gp + 4 * i), bb = *(const f32x4*)(bp + 4 * i);
#pragma unroll
            for (int e = 0; e < 4; ++e) y[4 * i + e] = (y[4 * i + e] - mean) * rstd * gg[e] + bb[e]; }
        float* dst = (l + 1 < DEPTH) ? (float*)(C.ws + WS_XA) + (size_t)t * DM : C.out + (size_t)t * DM;
#if DIAG
        if (l + 1 == DEPTH) { const float al = 1.f + diag_alpha(C);
#pragma unroll
            for (int j = 0; j < 16; ++j) y[j] *= al; }
#endif
#pragma unroll
        for (int i = 0; i < 4; ++i) *(f32x4*)(dst + lane * 16 + 4 * i) = (f32x4){y[4 * i], y[4 * i + 1], y[4 * i + 2], y[4 * i + 3]};
        if (l + 1 < DEPTH) {
            {
                float mx = 0.f;
#pragma unroll
                for (int j = 0; j < 16; ++j) mx = fmaxf(mx, fabsf(y[j]));
                mx = fmaxf(wave_max(mx), 1e-30f);
                const float isc = 127.f / mx;
                u32x4 o8;
#pragma unroll
                for (int q = 0; q < 4; ++q) { unsigned wd = 0u;
#pragma unroll
                    for (int e = 0; e < 4; ++e) wd |= ((unsigned)(int)rintf(y[4 * q + e] * isc) & 255u) << (8 * e);
                    o8[q] = wd; }
                *(u32x4*)(C.ws + WS_XB + (size_t)t * DM + lane * 16) = o8;
                if (lane == 0) ((float*)(C.ws + WS_XSA))[t] = mx * (1.f / 127.f);
            }
            const float* wf = (const float*)(C.ws + WS_W + (size_t)(l + 1) * W_LAYER + WO_WF);
            float* lsig = (float*)(C.ws + WS_MISC);
#pragma unroll
            for (int h = 0; h < 4; ++h) {
                float sd = 0.f;
#pragma unroll
                for (int i = 0; i < 4; ++i) { const f32x4 a = *(const f32x4*)(wf + h * DM + lane * 16 + 4 * i);
#pragma unroll
                    for (int e = 0; e < 4; ++e) sd += y[4 * i + e] * a[e]; }
                sd = wave_sum(sd);
                if (lane == 0) lsig[(size_t)t * 4 + h] = logsigmoidf_(sd + C.in[I_BFOX][(l + 1) * 4 + h]);
            }
        }
    }
}

struct FStoreBf16 { bf16_t* O; int ld;
    __device__ __forceinline__ void operator()(int row, int col, f32x4 v0, f32x4 v1, int) const {
        u32x4 o; o[0] = pk2(v0[0], v0[1]); o[1] = pk2(v0[2], v0[3]); o[2] = pk2(v1[0], v1[1]); o[3] = pk2(v1[2], v1[3]);
        *(u32x4*)(O + (size_t)row * ld + col) = o; } };
typedef int i32x4 __attribute__((ext_vector_type(4)));
__device__ __forceinline__ void i8_dequant(f32x4& v0, f32x4& v1, float sa, const float* cs) {
    sa *= (1.f / 127.f);
    const f32x4 c0 = *(const f32x4*)cs, c1 = *(const f32x4*)(cs + 4);
    const i32x4 i0 = __builtin_bit_cast(i32x4, v0), i1 = __builtin_bit_cast(i32x4, v1);
#pragma unroll
    for (int e = 0; e < 4; ++e) { v0[e] = (float)i0[e] * sa * c0[e]; v1[e] = (float)i1[e] * sa * c1[e]; }
}
struct FStoreBf16I8 { bf16_t* O; int ld; const float* rs; const float* cs;
    __device__ __forceinline__ void operator()(int row, int col, f32x4 v0, f32x4 v1, int) const {
        i8_dequant(v0, v1, rs[row], cs + col);
        u32x4 o; o[0] = pk2(v0[0], v0[1]); o[1] = pk2(v0[2], v0[3]); o[2] = pk2(v1[0], v1[1]); o[3] = pk2(v1[2], v1[3]);
        *(u32x4*)(O + (size_t)row * ld + col) = o; } };
struct FGateI8 { unsigned char* O; const float* bias; const float* rs; const float* cs;
    __device__ __forceinline__ void operator()(int row, int col, f32x4 v0, f32x4 v1, int) const {
        i8_dequant(v0, v1, rs[row], cs + col);
        const f32x4 b0 = *(const f32x4*)(bias + col), b1 = *(const f32x4*)(bias + col + 4);
        u32x2 o; unsigned w0 = 0u, w1 = 0u;
#pragma unroll
        for (int e = 0; e < 4; ++e) { w0 |= (unsigned)(int)rintf(255.f * sigmoidf_(v0[e] + b0[e])) << (8 * e); w1 |= (unsigned)(int)rintf(255.f * sigmoidf_(v1[e] + b1[e])) << (8 * e); }
        o[0] = w0; o[1] = w1;
        *(u32x2*)(O + (size_t)row * NG + col) = o; } };
struct FGate { bf16_t* O; const float* bias;
    __device__ __forceinline__ void operator()(int row, int col, f32x4 v0, f32x4 v1, int) const {
        const f32x4 b0 = *(const f32x4*)(bias + col), b1 = *(const f32x4*)(bias + col + 4);
        u32x4 o; o[0] = pk2(sigmoidf_(v0[0] + b0[0]), sigmoidf_(v0[1] + b0[1])); o[1] = pk2(sigmoidf_(v0[2] + b0[2]), sigmoidf_(v0[3] + b0[3]));
        o[2] = pk2(sigmoidf_(v1[0] + b1[0]), sigmoidf_(v1[1] + b1[1])); o[3] = pk2(sigmoidf_(v1[2] + b1[2]), sigmoidf_(v1[3] + b1[3]));
        *(u32x4*)(O + (size_t)row * NG + col) = o; } };
struct FMerge { const unsigned char* G; bf16_t* MG;
    __device__ __forceinline__ void operator()(int row, int col, f32x4 v0, f32x4 v1, int z) const {
        const u32x2 gr = *(const u32x2*)(G + (size_t)row * NG + z * DM + col);
        float r[8];
#pragma unroll
        for (int e = 0; e < 4; ++e) { r[e] = v0[e] * (float)((gr[0] >> (8 * e)) & 255u) * (1.f / 255.f); r[4 + e] = v1[e] * (float)((gr[1] >> (8 * e)) & 255u) * (1.f / 255.f); }
        bf16_t* p = MG + (size_t)row * DM + col;
        if (z > 0) { const u32x4 pr = *(const u32x4*)p;
#pragma unroll
            for (int e = 0; e < 4; ++e) { r[2 * e] += bf2f(pr[e] & 0xffffu); r[2 * e + 1] += bf2f(pr[e] >> 16); } }
        u32x4 o;
#pragma unroll
        for (int e = 0; e < 4; ++e) o[e] = pk2(r[2 * e], r[2 * e + 1]);
        *(u32x4*)p = o; } };
struct FResid { const float* X; bf16_t* Y;
    __device__ __forceinline__ void operator()(int row, int col, f32x4 v0, f32x4 v1, int) const {
        const f32x4 x0 = *(const f32x4*)(X + (size_t)row * DM + col), x1 = *(const f32x4*)(X + (size_t)row * DM + col + 4);
#if DIAG == 5 || DIAG == 6
        v0 = (f32x4){0.f, 0.f, 0.f, 0.f}; v1 = v0;
#endif
        u32x4 o; o[0] = cvtpk(x0[0] * ALPHA + v0[0], x0[1] * ALPHA + v0[1]); o[1] = cvtpk(x0[2] * ALPHA + v0[2], x0[3] * ALPHA + v0[3]);
        o[2] = cvtpk(x1[0] * ALPHA + v1[0], x1[1] * ALPHA + v1[1]); o[3] = cvtpk(x1[2] * ALPHA + v1[2], x1[3] * ALPHA + v1[3]);
        *(u32x4*)(Y + (size_t)row * DM + col) = o; } };

constexpr int PH_PER_LAYER = 12, N_PHASES = 1 + DEPTH * PH_PER_LAYER;
template <int SP> __device__ __forceinline__ void run_phase(const Ctx& C0, int l) {
    Ctx C = C0;
    asm volatile("" : "+v"(C.tid));
    C.ws = launder_ptr(C.ws); C.out = launder_ptr(C.out); l = (int)launder_u((unsigned)l);
    C.lane = C.tid & 63; C.wave = __builtin_amdgcn_readfirstlane(C.tid >> 6);
    unsigned char* wb = C.ws + WS_W + (size_t)l * W_LAYER;
    if constexpr (SP == -1) { p_conv_weights(C); p_rowpass0(C); }
    if constexpr (SP == 1) {
        p_cumsum(C);
        __syncthreads();
        pg8::Gemm g{(const bf16_t*)(C.ws + WS_XB), (const bf16_t*)(wb + WO_WIN), DM, DM, DM, 0, 0};
        pg8::StaticOrder S; S.init(T, NH, C.G, C.bid);
        pg8::Epi8<FStoreBf16I8> E{{(bf16_t*)(C.ws + WS_H), NH, (const float*)(C.ws + WS_XSA), (const float*)(C.ws + WS_CMAX) + l * (NH + NG)}};
        pg8::gemm_phase<pg8::Epi8<FStoreBf16I8>, pg8::StaticOrder, true>(C.lds, g, S, E, C.tid);
    }
#if DIAG == 5
    if constexpr (SP == 2) { if (l == 0) { diag_ref_slice(C, C.in[I_WIN], NIN, DIAG_N0, nullptr); } }
    if constexpr (SP == 3) { if (l == 0) diag_cmp(C, (const bf16_t*)(C.ws + WS_H) + DIAG_N0, NH, (const bf16_t*)(C.ws + WS_XA), 64, 64); }
#endif
#if DIAG == 6
    if constexpr (SP == 5) { if (l == 0) diag_ref_slice(C, C.in[I_WGATE], NG, DIAG_N0, C.in[I_BGATE]); }
    if constexpr (SP == 6) { if (l == 0) diag_cmp_u8(C, C.ws + WS_G + DIAG_N0, NG, (const bf16_t*)(C.ws + WS_XA), 64, 64); }
#endif
    if constexpr (SP == 2) { p_knorm(C, l); if (l != HG_NAIVE_L) hgrn_b1(C, l); }
#if MIX_NAIVE
    if constexpr (SP == 3) { if (l != HG_NAIVE_L) hgrn_b2(C); mix_pool_naive(C, l); mix_gmlp_naive(C, l); }
#else
    if constexpr (SP == 3) { if (l != HG_NAIVE_L) hgrn_b2(C); mix_pool(C, l); mix_gmlp(C, l);
        if (DIAG == 2) mix_pool_naive(C, l); if (DIAG == 3) mix_gmlp_naive(C, l); }
#endif
#if DIAG == 1
    if constexpr (SP == 4) { hgrn_b3(C, l); { mix_hgrn_naive(C, l); __syncthreads(); } mix_fox(C, l); }
    if constexpr (SP == 5) { if (l == DIAG_LAYER) diag_cmp(C, (const bf16_t*)(C.ws + (DIAG_LAYER == 0 ? WS_XA : WS_TABU)) + 512, NBR, (const bf16_t*)(C.ws + WS_BR) + 512, NBR, 512); }
#elif DIAG == 2 || DIAG == 3
    if constexpr (SP == 4) { hgrn_b3(C, l); mix_fox(C, l); if (l == DIAG_LAYER) diag_cmp(C, (const bf16_t*)(C.ws + (DIAG_LAYER == 0 ? WS_XA : WS_TABU)) + (DIAG == 2 ? 0 : 1024), NBR, (const bf16_t*)(C.ws + WS_BR) + (DIAG == 2 ? 0 : 1024), NBR, 512); }
#else
    if constexpr (SP == 4) { if (l != HG_NAIVE_L) hgrn_b3(C, l); else { mix_hgrn_naive(C, l); __syncthreads(); } mix_fox(C, l); }
#endif
    if constexpr (SP == 5) {
        pg8::Gemm g{(const bf16_t*)(C.ws + WS_XB), (const bf16_t*)(wb + WO_WG), DM, DM, DM, 0, 0};
        pg8::StaticOrder S; S.init(T, NG, C.G, C.bid);
        pg8::Epi8<FGateI8> E{{C.ws + WS_G, C.in[I_BGATE] + l * NG, (const float*)(C.ws + WS_XSA), (const float*)(C.ws + WS_CMAX) + l * (NH + NG) + NH}};
        pg8::gemm_phase<pg8::Epi8<FGateI8>, pg8::StaticOrder, true>(C.lds, g, S, E, C.tid);
    }
    if constexpr (SP == 6) {
        pg8::Gemm g{(const bf16_t*)(C.ws + WS_BR), (const bf16_t*)(wb + WO_WBR), NBR, BW, BW, (size_t)BW, (size_t)DM * BW};
        pg8::ZOrder S; S.init(T, DM, 4, C.G, C.vcu);
        pg8::EpiMerge E{C.ws + WS_G, (bf16_t*)(C.ws + WS_XB)};
        pg8::gemm_phase(C.lds, g, S, E, C.tid);
    }
    if constexpr (SP == 7) {
        const float* xin = (l == 0) ? C.in[I_X] : (const float*)(C.ws + WS_XA);
        pg8::Gemm g{(const bf16_t*)(C.ws + WS_XB), (const bf16_t*)(wb + WO_WOUT), DM, DM, DM, 0, 0};
        pg8::StaticOrder S; S.init(T, DM, C.G, C.bid);
        pg8::Epi8<FResid> E{{xin, (bf16_t*)(C.ws + WS_XC)}};
        pg8::gemm_phase(C.lds, g, S, E, C.tid);
    }
    if constexpr (SP == 8) { p_ln1(C, l); p_conv_tables(C, l); }
    if constexpr (SP == 9) {
        pg8::Gemm g{(const bf16_t*)(C.ws + WS_X1B), (const bf16_t*)(wb + WO_WQ), DM, DM, DM, 0, 0};
        pg8::StaticOrder S; S.init(T, NQ, C.G, C.bid);
        pg8::Epi8<FStoreBf16> E{{(bf16_t*)(C.ws + WS_Q), NQ}};
        pg8::gemm_phase(C.lds, g, S, E, C.tid);
    }
#if TOPK_NAIVE
    if constexpr (SP == 10) p_topk_naive(C, l);
#else
    if constexpr (SP == 10) p_topk(C, l);
#endif
    if constexpr (SP == 11) p_gather(C, l);
}
__device__ __forceinline__ void make_ctx(Ctx& C, const Args& args, unsigned char* lds_raw) {
    C.lds = (LAS unsigned char*)lds_raw; C.ws = args.ws; C.in = args.in; C.out = args.out;
    C.tid = threadIdx.x; C.lane = C.tid & 63; C.wave = __builtin_amdgcn_readfirstlane(C.tid >> 6);
    C.G = gridDim.x; C.bid = blockIdx.x; C.vcu = (C.G % 8 == 0) ? (C.bid % 8) * (C.G / 8) + C.bid / 8 : C.bid;
}
#if !MK_ONE_LAUNCH
template <int SP> __global__ void __launch_bounds__(512, 2) mk_phase(Args args) {
    extern __shared__ __attribute__((aligned(16))) unsigned char lds_raw[];
    Ctx C; make_ctx(C, args, lds_raw);
    run_phase<SP>(C, args.ph_lo);
}
#endif

#define GRID_BAR() xcd_barrier((unsigned*)(args.ws + WS_CTL) + 1024, (volatile LAS unsigned*)((LAS unsigned char*)lds_raw + LDSCTL_OFF + 32))
__global__ void __launch_bounds__(512, 2) mk_fwd(Args args) {
    extern __shared__ __attribute__((aligned(16))) unsigned char lds_raw[];
    Ctx C; make_ctx(C, args, lds_raw);
    { volatile LAS unsigned* misc = (volatile LAS unsigned*)(C.lds + LDSCTL_OFF); if (C.tid < 64) misc[C.tid] = 0u; }
    __syncthreads();
    xcd_barrier_post((unsigned*)(args.ws + WS_CTL) + 1024);
    run_phase<-1>(C, 0); GRID_BAR();
#pragma unroll 1
    for (int l = 0; l < DEPTH; ++l) {
        run_phase<1>(C, l); GRID_BAR();
        run_phase<2>(C, l); GRID_BAR();
        run_phase<3>(C, l); GRID_BAR();
        run_phase<4>(C, l); GRID_BAR();
        run_phase<5>(C, l); GRID_BAR();
        run_phase<6>(C, l); GRID_BAR();
        run_phase<7>(C, l); GRID_BAR();
        run_phase<8>(C, l); GRID_BAR();
        run_phase<9>(C, l); GRID_BAR();
        run_phase<10>(C, l); GRID_BAR();
        run_phase<11>(C, l); if (l + 1 < DEPTH) GRID_BAR();
    }
}

#if !MK_ONE_LAUNCH
template <int SP> static void launch_phase(const Args& a, int grid, hipStream_t stream) {
    static bool attr_done = false;
    if (!attr_done) { (void)hipFuncSetAttribute((const void*)mk_phase<SP>, hipFuncAttributeMaxDynamicSharedMemorySize, LDS_BYTES); attr_done = true; }
    hipLaunchKernelGGL(mk_phase<SP>, dim3(grid), dim3(512), LDS_BYTES, stream, a);
}
#endif
extern "C" void kernel_launch(void* const* d_in, const int* in_sizes, int n_in, void* d_out, int out_size, void* d_ws, size_t ws_size, hipStream_t stream) {
    static int grid = 0;
    if (grid == 0) {
        if (n_in != NIN_PTRS || out_size != T * DM || ws_size < WS_END) { fprintf(stderr, "kernel_launch: unexpected shapes n_in %d out %d ws %zu\n", n_in, out_size, ws_size); grid = -1; return; }
        int dev = 0, cus = 0;
        if (hipGetDevice(&dev) != hipSuccess || hipDeviceGetAttribute(&cus, hipDeviceAttributeMultiprocessorCount, dev) != hipSuccess) { grid = -1; return; }
        grid = cus;
    }
    if (grid < 0) return;
    (void)hipMemsetAsync((char*)d_ws + WS_CTL, 0, CTL_ZERO_BYTES, stream);
    Args a{};
    for (int i = 0; i < NIN_PTRS; ++i) a.in[i] = (const float*)d_in[i];
    a.out = (float*)d_out; a.ws = (unsigned char*)d_ws; a.bar_slot = 0; a.pad = 0; a.ph_hi = 0;
#if MK_ONE_LAUNCH
    static bool attr_done = false;
    if (!attr_done) { (void)hipFuncSetAttribute((const void*)mk_fwd, hipFuncAttributeMaxDynamicSharedMemorySize, LDS_BYTES); attr_done = true; }
    hipLaunchKernelGGL(mk_fwd, dim3(grid), dim3(512), LDS_BYTES, stream, a);
    return;
#endif
#if !MK_ONE_LAUNCH
    a.ph_lo = 0; launch_phase<-1>(a, grid, stream);
    for (int l = 0; l < DEPTH; ++l) {
        a.ph_lo = l;
        launch_phase<0>(a, grid, stream); launch_phase<1>(a, grid, stream); launch_phase<2>(a, grid, stream); launch_phase<3>(a, grid, stream); launch_phase<4>(a, grid, stream);
        launch_phase<5>(a, grid, stream); launch_phase<6>(a, grid, stream); launch_phase<7>(a, grid, stream); launch_phase<8>(a, grid, stream); launch_phase<9>(a, grid, stream); launch_phase<10>(a, grid, stream); launch_phase<11>(a, grid, stream);
    }
#endif
}
```

```cpp
#include <hip/hip_runtime.h>
#include <cstdio>
#include <cstdint>

#ifndef DIAG
#define DIAG 0
#endif
#ifndef DIAG_LO
#define DIAG_LO 0
#endif
#ifndef DIAG_HI
#define DIAG_HI 64
#endif
#ifndef DIAG_MOD
#define DIAG_MOD 64
#endif
#ifndef TOPK_NAIVE
#define TOPK_NAIVE 0
#endif
#ifndef MIX_NAIVE
#define MIX_NAIVE 0
#endif
#ifndef DIAG_N0
#define DIAG_N0 4096
#endif
#ifndef FOX_NAIVE
#define FOX_NAIVE 0
#endif
#ifndef HG_NAIVE_L
#define HG_NAIVE_L 99
#endif
#ifndef DIAG_LAYER
#define DIAG_LAYER 0
#endif
#ifndef MK_ONE_LAUNCH
#define MK_ONE_LAUNCH 1
#endif

#define LAS __attribute__((address_space(3)))
#define GAS __attribute__((address_space(1)))
typedef unsigned short bf16_t;
typedef short bf16x8 __attribute__((ext_vector_type(8)));
typedef float f32x4 __attribute__((ext_vector_type(4)));
typedef float f32x2 __attribute__((ext_vector_type(2)));
typedef unsigned u32x4 __attribute__((ext_vector_type(4)));
typedef unsigned u32x2 __attribute__((ext_vector_type(2)));

constexpr int DM = 1024, BATCH = 2, SEQ = 8192, DEPTH = 2, T = BATCH * SEQ;
constexpr int BW = 512, NIN = 5124, NH = 5120, NG = 4096, NBR = 2048, NQ = 2048;
constexpr int NEXP = 16384, TOPK = 16, PH = 8;
constexpr float ALPHA = 1.4142135623730951f;
constexpr float LN_EPS = 1e-5f, RMS_EPS = 1e-6f;
constexpr int HC_P = 0, HC_HQ = 512, HC_HF = 1024, HC_HI = 1536, HC_HG = 2048, HC_GU = 2560, HC_GV = 3072, HC_FQ = 3584, HC_FK = 4096, HC_FV = 4608;

constexpr size_t MiB = 1u << 20;
constexpr size_t WS_CTL = 0, CTL_ZERO_BYTES = 160 * 1024;
constexpr size_t WS_CMAX = 64 * 1024;
constexpr size_t WS_MISC = 512 * 1024;
constexpr size_t WS_CUM = 768 * 1024;
constexpr size_t WS_W = 1 * MiB;
constexpr size_t W_LAYER = 30 * MiB;
constexpr size_t WO_WIN = 0, WO_WG = 10 * MiB, WO_WBR = 18 * MiB, WO_WOUT = 22 * MiB, WO_WQ = 24 * MiB, WO_KEYS = 28 * MiB, WO_WF = 28 * MiB + 512 * 1024, WO_POOLW = 28 * MiB + 768 * 1024, WO_GWS = 29 * MiB, WO_CS = 29 * MiB + 512 * 1024;
constexpr size_t WS_TABU = 64 * MiB, WS_TABV = 96 * MiB;
constexpr size_t WS_XA = 128 * MiB;
constexpr size_t WS_XB = 192 * MiB;
constexpr size_t WS_X1B = 224 * MiB;
constexpr size_t WS_H = 256 * MiB;
constexpr size_t WS_ST = 416 * MiB;
constexpr size_t WS_BR = 448 * MiB;
constexpr size_t WS_G = 256 * MiB;
constexpr size_t WS_MGF = 384 * MiB;
constexpr size_t WS_XC = 256 * MiB;
constexpr size_t WS_Q = 320 * MiB;
constexpr size_t WS_EIDX = 384 * MiB, WS_EGATE = 392 * MiB;
constexpr size_t WS_XSA = 256 * 1024;
constexpr size_t WS_END = 512 * MiB;

__device__ __forceinline__ float bf2f(unsigned u) { return __builtin_bit_cast(float, u << 16); }
__device__ __forceinline__ unsigned f2bf(float f) { unsigned u = __builtin_bit_cast(unsigned, f); return (u + 0x7fffu + ((u >> 16) & 1u)) >> 16; }
typedef __bf16 bf16x2_t __attribute__((ext_vector_type(2)));
__device__ __forceinline__ unsigned cvtpk(float lo, float hi) { f32x2 v = {lo, hi}; bf16x2_t b = __builtin_convertvector(v, bf16x2_t); return __builtin_bit_cast(unsigned, b); }
__device__ __forceinline__ unsigned pk2(float lo, float hi) { return cvtpk(lo, hi); }
__device__ __forceinline__ float wave_sum(float v) {
#pragma unroll
    for (int o = 32; o > 0; o >>= 1) v += __shfl_xor(v, o, 64);
    return v;
}
__device__ __forceinline__ float sigmoidf_(float x) { return __builtin_amdgcn_rcpf(1.f + __builtin_amdgcn_exp2f(-1.4426950408889634f * x)); }
__device__ __forceinline__ float siluf_(float x) { return x * __builtin_amdgcn_rcpf(1.f + __builtin_amdgcn_exp2f(-1.4426950408889634f * x)); }
__device__ __forceinline__ float geluf_slow(float x) { const float u = 0.7978845608028654f * (x + 0.044715f * x * x * x); return 0.5f * x * (1.f + tanhf(u)); }
__device__ __forceinline__ float geluf_(float x) { const float u2 = -2.302208198f * (x + 0.044715f * x * x * x); return x * __builtin_amdgcn_rcpf(1.f + __builtin_amdgcn_exp2f(u2)); }
__device__ __forceinline__ float logsigmoidf_(float z) { return fminf(z, 0.f) - log1pf(__expf(-fabsf(z))); }

__device__ __forceinline__ unsigned launder_u(unsigned x) { asm volatile("" : "+v"(x)); return __builtin_amdgcn_readfirstlane(x); }
template <class P> __device__ __forceinline__ P launder_ptr(P p) {
    const unsigned lo = launder_u((unsigned)(uintptr_t)p), hi = launder_u((unsigned)((uintptr_t)p >> 32));
    return (P)(((uintptr_t)hi << 32) | lo);
}

namespace pg8 {
constexpr int BM = 256, BK = 64, HALF = 128, HTB = HALF * BK * 2, STAGE_BYTES = 8 * HTB, NXCD = 8, WGM = 8;
__host__ __device__ __forceinline__ int lds_byte(int r, int c) { const int st = (r >> 4) * 2 + (c >> 5), rr = r & 15, cc = c & 31, ob = rr * 64 + cc * 2; return st * 1024 + (ob ^ (((ob >> 9) & 1) << 5)); }
__host__ __device__ __forceinline__ void stage_rc(int b, int& R, int& C) { const int st = b / 1024, sb = b % 1024, swz = sb ^ (((sb >> 9) & 1) << 5); R = (st >> 1) * 16 + swz / 64; C = (st & 1) * 32 + (swz % 64) / 2; }
__host__ __device__ __forceinline__ int perm32(int rho) { const int n = rho >> 4, i = rho & 15; return 8 * (i >> 2) + 4 * n + (i & 3); }

struct Unit { int pm, pn, z; };
struct Gemm { const bf16_t* A; const bf16_t* Bt; int lda, ldb, K; size_t zA, zB; };

struct StaticOrder {
    int nM, nN, nwg, G, c;
    __device__ void init(int M, int N, int G_, int c_) { nM = M / BM; nN = N / BM; nwg = nM * nN; G = G_; c = c_; }
    __device__ bool next(int i, Unit& u) const {
        const long L = (long)i * G + c; if (L >= nwg) return false;
        int wgid = (int)L; { const int q = nwg / NXCD, r = nwg % NXCD, xcd = wgid % NXCD, off = wgid / NXCD; wgid = (xcd < r ? xcd * (q + 1) : r * (q + 1) + (xcd - r) * q) + off; }
        const int nig = WGM * nN, gid = wgid / nig, fm = gid * WGM, gsz = (nM - fm) < WGM ? (nM - fm) : WGM;
        u.pm = fm + ((wgid % nig) % gsz); u.pn = (wgid % nig) / gsz; u.z = 0; return true;
    }
};
struct ZOrder {
    int nM, nN, nZ, ntile, G, c;
    __device__ void init(int M, int N, int Z, int G_, int c_) { nM = M / BM; nN = N / BM; nZ = Z; ntile = nM * nN; G = G_; c = c_; }
    __device__ bool next(int i, Unit& u) const {
        const long L = (long)(i / nZ) * G + c; if (L >= ntile) return false;
        u.pm = (int)L / nN; u.pn = (int)L % nN; u.z = i % nZ; return true;
    }
};

template <class F> struct Epi8 {
    static constexpr bool PERM = true;
    F f;
    __device__ __forceinline__ bool keep(const Unit&) const { return false; }
    __device__ __forceinline__ void operator()(const f32x4 (&acc)[2][2][4][2], const Unit& u, int wr, int wc, int fr, int fq) const {
        const int row0 = u.pm * BM + wr * 64 + fr, col0 = u.pn * BM + wc * 32 + 8 * fq;
#pragma unroll
        for (int ai = 0; ai < 2; ++ai)
#pragma unroll
            for (int m = 0; m < 4; ++m)
#pragma unroll
                for (int bj = 0; bj < 2; ++bj) f(row0 + ai * HALF + m * 16, col0 + bj * HALF, acc[ai][bj][m][0], acc[ai][bj][m][1], u.z);
    }
};
template <class F> struct Epi4 {
    static constexpr bool PERM = false;
    F f;
    __device__ __forceinline__ bool keep(const Unit&) const { return false; }
    __device__ __forceinline__ void operator()(const f32x4 (&acc)[2][2][4][2], const Unit& u, int wr, int wc, int fr, int fq) const {
        const int row0 = u.pm * BM + wr * 64 + fr, col0 = u.pn * BM + wc * 32 + 4 * fq;
#pragma unroll
        for (int ai = 0; ai < 2; ++ai)
#pragma unroll
            for (int m = 0; m < 4; ++m)
#pragma unroll
                for (int bj = 0; bj < 2; ++bj)
#pragma unroll
                    for (int n = 0; n < 2; ++n) f(row0 + ai * HALF + m * 16, col0 + bj * HALF + n * 16, acc[ai][bj][m][n], u.z);
    }
};

struct EpiMerge {
    static constexpr bool PERM = true;
    const unsigned char* G; bf16_t* MG;
    __device__ __forceinline__ bool keep(const Unit& u) const { return u.z < 3; }
    __device__ __forceinline__ void operator()(f32x4 (&acc)[2][2][4][2], const Unit& u, int wr, int wc, int fr, int fq) const {
        const int row0 = u.pm * BM + wr * 64 + fr, col0 = u.pn * BM + wc * 32 + 8 * fq;
        const unsigned char* gp0 = G + (size_t)row0 * NG + u.z * DM + col0;
        if (u.z < 3) {
#pragma unroll
            for (int ai = 0; ai < 2; ++ai)
#pragma unroll
                for (int m = 0; m < 4; ++m) {
                    if ((m & 1) == 0) asm volatile("" ::: "memory");
#pragma unroll
                    for (int bj = 0; bj < 2; ++bj) {
                        const unsigned char* gp = gp0 + (size_t)(ai * HALF + m * 16) * NG + bj * HALF;
                        const u32x2 ga = *(const u32x2*)gp, gb = *(const u32x2*)(gp + DM);
#pragma unroll
                        for (int n = 0; n < 2; ++n)
#pragma unroll
                            for (int e = 0; e < 4; ++e) {
                                const float qa = (float)((ga[n] >> (8 * e)) & 255u), qb = (float)((gb[n] >> (8 * e)) & 255u);
                                acc[ai][bj][m][n][e] *= qa * __builtin_amdgcn_rcpf(qb); }
                    }
                }
        } else {
            bf16_t* op0 = MG + (size_t)row0 * DM + col0;
#pragma unroll
            for (int ai = 0; ai < 2; ++ai)
#pragma unroll
                for (int m = 0; m < 4; ++m)
#pragma unroll
                    for (int bj = 0; bj < 2; ++bj) {
                        const u32x2 ga = *(const u32x2*)(gp0 + (size_t)(ai * HALF + m * 16) * NG + bj * HALF);
                        u32x4 o;
#pragma unroll
                        for (int n = 0; n < 2; ++n)
#pragma unroll
                            for (int e2 = 0; e2 < 2; ++e2) {
                                const float q0 = (float)((ga[n] >> (16 * e2)) & 255u) * (1.f / 255.f), q1 = (float)((ga[n] >> (16 * e2 + 8)) & 255u) * (1.f / 255.f);
                                o[2 * n + e2] = cvtpk(acc[ai][bj][m][n][2 * e2] * q0, acc[ai][bj][m][n][2 * e2 + 1] * q1); }
                        *(u32x4*)(op0 + (size_t)(ai * HALF + m * 16) * DM + bj * HALF) = o;
                    }
        }
    }
};

typedef int i32x4 __attribute__((ext_vector_type(4)));
template <class Epi, class Sched, bool I8 = false, bool ALIGN_EPI = true>
__device__ __forceinline__ void gemm_phase(LAS unsigned char* lds, const Gemm g, const Sched& S, const Epi& E, const int tid) {
    constexpr int ES = I8 ? 1 : 2;
    const int wid = __builtin_amdgcn_readfirstlane(tid >> 6), lane = tid & 63, wr = wid >> 2, wc = wid & 3, fr = lane & 15, fq = lane >> 4;
    const int K = g.K, nt = K * ES / 128;
    unsigned voffA[2], voffB[2];
#pragma unroll
    for (int i = 0; i < 2; ++i) { int R, C; stage_rc(tid * 16 + i * 8192, R, C); const int Rb = Epi::PERM ? ((R & ~31) + perm32(R & 31)) : R;
        voffA[i] = (unsigned)(R * g.lda * ES + C * 2); voffB[i] = (unsigned)(Rb * g.ldb * ES + C * 2); }
    const size_t kstep = (size_t)(BK * 2);
    const size_t hstepA = (size_t)HALF * g.lda * ES, hstepB = (size_t)HALF * g.ldb * ES;
    const size_t tstepA = 2 * hstepA, tstepB = 2 * hstepB;
    const unsigned ldsw = (unsigned)wid * 1024u;
    const int aoff = lds_byte(wr * 64 + fr, fq * 8), boff = lds_byte(wc * 32 + fr, fq * 8);
#define PG8_SA(b, h) (((b) * 2 + (h)) * HTB)
#define PG8_SB(b, h) ((4 + (b) * 2 + (h)) * HTB)
#define PG8_STAGE(bufoff, gbase, voff) do { _Pragma("unroll") for (int _i = 0; _i < 2; ++_i) \
        __builtin_amdgcn_global_load_lds((const unsigned*)((const char*)(gbase) + (voff)[_i]), (LAS unsigned*)(lds + (bufoff) + ldsw + _i * 8192), 16, 0, 0); } while (0)
#define PG8_LDA(dst, b, h) do { _Pragma("unroll") for (int m = 0; m < 4; ++m) _Pragma("unroll") for (int k = 0; k < 2; ++k) dst[m][k] = *(const LAS bf16x8*)(lds + PG8_SA(b, h) + aoff + m * 2048 + k * 1024); } while (0)
#define PG8_LDB(dst, b, h) do { _Pragma("unroll") for (int n = 0; n < 2; ++n) _Pragma("unroll") for (int k = 0; k < 2; ++k) dst[n][k] = *(const LAS bf16x8*)(lds + PG8_SB(b, h) + boff + n * 2048 + k * 1024); } while (0)
#define PG8_MMA(ai, bj, At, Bt) do { __builtin_amdgcn_s_setprio(1); _Pragma("unroll") for (int m = 0; m < 4; ++m) _Pragma("unroll") for (int n = 0; n < 2; ++n) _Pragma("unroll") for (int k = 0; k < 2; ++k) { \
        if constexpr (I8) acc[ai][bj][m][n] = __builtin_bit_cast(f32x4, __builtin_amdgcn_mfma_i32_16x16x64_i8(__builtin_bit_cast(i32x4, Bt[n][k]), __builtin_bit_cast(i32x4, At[m][k]), __builtin_bit_cast(i32x4, acc[ai][bj][m][n]), 0, 0, 0)); \
        else acc[ai][bj][m][n] = __builtin_amdgcn_mfma_f32_16x16x32_bf16(Bt[n][k], At[m][k], acc[ai][bj][m][n], 0, 0, 0); } __builtin_amdgcn_s_setprio(0); } while (0)
#define PG8_WAIT_V(n) asm volatile("s_waitcnt vmcnt(" #n ")" ::: "memory")
#define PG8_WAIT_L(n) asm volatile("s_waitcnt lgkmcnt(" #n ")" ::: "memory")
#define PG8_BAR __builtin_amdgcn_s_barrier()
#define PG8_SCHED __builtin_amdgcn_sched_barrier(0)
    Unit cur, nxt; int ui = 0;
    if (!S.next(0, cur)) return;
    f32x4 acc[2][2][4][2];
#pragma unroll
    for (int a = 0; a < 2; ++a)
#pragma unroll
        for (int b = 0; b < 2; ++b)
#pragma unroll
            for (int m = 0; m < 4; ++m)
#pragma unroll
                for (int n = 0; n < 2; ++n) acc[a][b][m][n] = (f32x4){0.f, 0.f, 0.f, 0.f};
    bf16x8 At[4][2], B0[2][2], B1[2][2];
    const char* cA = (const char*)g.A + (size_t)cur.z * g.zA * ES + (size_t)cur.pm * tstepA; const char* cB = (const char*)g.Bt + (size_t)cur.z * g.zB * ES + (size_t)cur.pn * tstepB;
    PG8_STAGE(PG8_SB(0, 0), cB, voffB); PG8_STAGE(PG8_SB(0, 1), cB + hstepB, voffB); PG8_STAGE(PG8_SA(0, 0), cA, voffA); PG8_STAGE(PG8_SA(0, 1), cA + hstepA, voffA);
    if (wr == 1) PG8_BAR;
    PG8_WAIT_V(2); PG8_BAR;
    PG8_STAGE(PG8_SB(1, 0), cB + kstep, voffB); PG8_STAGE(PG8_SA(1, 0), cA + kstep, voffA); PG8_STAGE(PG8_SB(1, 1), cB + hstepB + kstep, voffB);
    PG8_WAIT_V(6); PG8_BAR;
    for (;;) {
        const bool has_next = S.next(ui + 1, nxt);
        const char* nA = has_next ? (const char*)g.A + (size_t)nxt.z * g.zA * ES + (size_t)nxt.pm * tstepA : cA;
        const char* nB = has_next ? (const char*)g.Bt + (size_t)nxt.z * g.zB * ES + (size_t)nxt.pn * tstepB : cB;
        for (int t = 0; t < nt; t += 2) {
            const bool last = (t == nt - 2);
            const char* a1 = cA + (size_t)(t + 1) * kstep;
            const char* a2 = last ? nA : cA + (size_t)(t + 2) * kstep; const char* b2 = last ? nB : cB + (size_t)(t + 2) * kstep;
            const char* a3 = a2 + kstep; const char* b3 = b2 + kstep;
            PG8_LDB(B0, 0, 0); PG8_LDB(B1, 0, 1); PG8_SCHED; PG8_LDA(At, 0, 0); PG8_STAGE(PG8_SA(1, 1), a1 + hstepA, voffA);
            PG8_WAIT_V(8); PG8_WAIT_L(0); PG8_BAR; PG8_MMA(0, 0, At, B0); PG8_MMA(0, 1, At, B1); PG8_BAR; PG8_SCHED;
            PG8_LDA(At, 0, 1); PG8_STAGE(PG8_SB(0, 0), b2, voffB); PG8_STAGE(PG8_SB(0, 1), b2 + hstepB, voffB); PG8_STAGE(PG8_SA(0, 0), a2, voffA);
            PG8_WAIT_V(8); PG8_WAIT_L(0); PG8_BAR; PG8_MMA(1, 0, At, B0); PG8_MMA(1, 1, At, B1); PG8_BAR; PG8_SCHED;
            PG8_LDB(B0, 1, 0); PG8_LDB(B1, 1, 1); PG8_SCHED; PG8_LDA(At, 1, 0); PG8_STAGE(PG8_SA(0, 1), a2 + hstepA, voffA);
            PG8_WAIT_V(8); PG8_WAIT_L(0); PG8_BAR; PG8_MMA(0, 0, At, B0); PG8_MMA(0, 1, At, B1); PG8_BAR; PG8_SCHED;
            PG8_LDA(At, 1, 1); PG8_STAGE(PG8_SB(1, 0), b3, voffB); PG8_STAGE(PG8_SB(1, 1), b3 + hstepB, voffB); PG8_STAGE(PG8_SA(1, 0), a3, voffA);
            PG8_WAIT_V(8); PG8_WAIT_L(0); PG8_BAR; PG8_MMA(1, 0, At, B0); PG8_MMA(1, 1, At, B1); PG8_BAR; PG8_SCHED;
        }
        if constexpr (ALIGN_EPI) { if (wr == 0) PG8_BAR; }
        E(acc, cur, wr, wc, fr, fq);
        if (!has_next) break;
        if (!E.keep(cur)) {
#pragma unroll
            for (int a = 0; a < 2; ++a)
#pragma unroll
                for (int b = 0; b < 2; ++b)
#pragma unroll
                    for (int m = 0; m < 4; ++m)
#pragma unroll
                        for (int n = 0; n < 2; ++n) acc[a][b][m][n] = (f32x4){0.f, 0.f, 0.f, 0.f};
        }
        cur = nxt; cA = nA; cB = nB; ++ui;
        if constexpr (ALIGN_EPI) { if (wr == 1) PG8_BAR; }
    }
    PG8_WAIT_V(0);
    if constexpr (!ALIGN_EPI) { if (wr == 0) PG8_BAR; }
    PG8_BAR;
#undef PG8_SA
#undef PG8_SB
#undef PG8_STAGE
#undef PG8_LDA
#undef PG8_LDB
#undef PG8_MMA
#undef PG8_WAIT_V
#undef PG8_WAIT_L
#undef PG8_BAR
#undef PG8_SCHED
}
}

#define XB_TMO      128
#define XB_XCNT(j)  (256  + 64 * (j))
#define XB_XSUB(j)  (1280 + 64 * (j))
#define XB_XGEN(j)  (2304 + 64 * (j))
#define XB_TOP      3328
#define XB_TOPGEN   3392
#define XCD_BAR_WORDS 3456
#define XB_SPIN_CAP (1u << 22)
__device__ __forceinline__ unsigned xb_ld(unsigned* p)              { return __hip_atomic_load(p, __ATOMIC_RELAXED, __HIP_MEMORY_SCOPE_AGENT); }
__device__ __forceinline__ unsigned xb_add(unsigned* p, unsigned v) { return __hip_atomic_fetch_add(p, v, __ATOMIC_RELAXED, __HIP_MEMORY_SCOPE_AGENT); }
__device__ __forceinline__ unsigned xb_xcc_id() { return (unsigned)__builtin_amdgcn_s_getreg((3 << 11) | 20) & 0xFu; }
#define XB_SPIN(cond, bar) do { unsigned _sp = 0; while (cond) { __builtin_amdgcn_s_sleep(1); \
    if ((++_sp & 255u) == 0u) { if (xb_ld(&(bar)[XB_TMO])) break; if (_sp > XB_SPIN_CAP) { atomicAdd(&(bar)[XB_TMO], 1u); break; } } } } while (0)
__device__ __forceinline__ void xcd_barrier_post(unsigned* bar) {
    if (threadIdx.x == 0) (void)xb_add(&bar[XB_XCNT(xb_xcc_id())], 1u);
}
__device__ __forceinline__ void xcd_barrier_complete(unsigned* bar, unsigned x, unsigned& nloc, unsigned& nx) {
    const unsigned G = gridDim.x * gridDim.y * gridDim.z;
    unsigned sum, cnt, mine, sp = 0u;
    for (;;) {
        sum = 0u; cnt = 0u; mine = 0u;
#pragma unroll
        for (unsigned j = 0; j < 16; ++j) { const unsigned c = xb_ld(&bar[XB_XCNT(j)]); sum += c; cnt += (c > 0u) ? 1u : 0u; mine = (j == x) ? c : mine; }
        if (sum == G) break;
        __builtin_amdgcn_s_sleep(1);
        if ((++sp & 255u) == 0u) { if (xb_ld(&bar[XB_TMO])) break; if (sp > XB_SPIN_CAP) { atomicAdd(&bar[XB_TMO], 1u); break; } }
    }
    nloc = mine > 0u ? mine : 1u; nx = cnt > 0u ? cnt : 1u;
}
__device__ __noinline__ void xcd_barrier_leader(unsigned* bar, volatile LAS unsigned* st) {
    const unsigned x = xb_xcc_id();
    __builtin_amdgcn_s_waitcnt(0);
    unsigned nloc = st[0], nx = st[1];
    if (nloc == 0u) { xcd_barrier_complete(bar, x, nloc, nx); st[0] = nloc; st[1] = nx; }
    const unsigned old = xb_add(&bar[XB_XSUB(x)], 1u);
    const unsigned gen = old / nloc;
    if (old + 1u == (gen + 1u) * nloc) {
        __builtin_amdgcn_fence(__ATOMIC_RELEASE, "agent");
        asm volatile("s_waitcnt vmcnt(0)" ::: "memory");
        const unsigned og = xb_add(&bar[XB_TOP], 1u);
        const unsigned tg = og / nx;
        if (og + 1u == (tg + 1u) * nx) xb_add(&bar[XB_TOPGEN], 1u);
        else XB_SPIN(xb_ld(&bar[XB_TOPGEN]) == tg, bar);
        __builtin_amdgcn_fence(__ATOMIC_ACQUIRE, "agent");
        xb_add(&bar[XB_XGEN(x)], 1u);
        asm volatile("s_waitcnt vmcnt(0)" ::: "memory");
    } else {
        XB_SPIN(xb_ld(&bar[XB_XGEN(x)]) == gen, bar);
        __builtin_amdgcn_fence(__ATOMIC_ACQUIRE, "agent");
        asm volatile("s_waitcnt vmcnt(0)" ::: "memory");
    }
}
__device__ __forceinline__ void xcd_barrier(unsigned* bar, volatile LAS unsigned* st) {
    asm volatile("s_waitcnt vmcnt(0)" ::: "memory");
    __syncthreads();
    if (threadIdx.x == 0) xcd_barrier_leader(bar, st);
    __syncthreads();
}

constexpr int NIN_PTRS = 23;
struct Args { const float* in[NIN_PTRS]; float* out; unsigned char* ws; int ph_lo, ph_hi, bar_slot, pad; };
enum { I_X = 0, I_WIN, I_BFOX, I_POOLW, I_POOLS, I_LBL, I_HNG, I_GLNG, I_GLNB, I_GWS, I_GBS, I_WGATE, I_BGATE, I_WBR, I_WOUT, I_LN1G, I_LN1B, I_WQ, I_KEYS, I_PU, I_PV, I_LN2G, I_LN2B };

constexpr int LDS_BYTES = 147456;
constexpr int LDSCTL_OFF = 143360;

struct Ctx {
    LAS unsigned char* lds;
    unsigned char* ws;
    const float* const* in;
    float* out;
    int tid, lane, wave, G, bid, vcu;
};

__device__ __forceinline__ void tconv_job(const Ctx& C, const float* src, int ld_src, int K, int N, bf16_t* dst) {
    LAS float* tile = (LAS float*)C.lds;
    const int nk = K / 64, nn = N / 64, ntiles = nk * nn;
    for (int tl = C.bid; tl < ntiles; tl += C.G) {
        const int k0 = (tl / nn) * 64, n0 = (tl % nn) * 64;
#pragma unroll
        for (int p = 0; p < 2; ++p) {
            const int kr = (C.tid >> 4) + p * 32, nc = (C.tid & 15) * 4;
            const f32x4 v = *(const f32x4*)(src + (size_t)(k0 + kr) * ld_src + n0 + nc);
            tile[kr * 65 + nc + 0] = v[0]; tile[kr * 65 + nc + 1] = v[1]; tile[kr * 65 + nc + 2] = v[2]; tile[kr * 65 + nc + 3] = v[3];
        }
        __syncthreads();
        {
            const int n = C.tid >> 3, k8 = (C.tid & 7) * 8;
            u32x4 o;
#pragma unroll
            for (int j = 0; j < 4; ++j) o[j] = pk2(tile[(k8 + 2 * j) * 65 + n], tile[(k8 + 2 * j + 1) * 65 + n]);
            *(u32x4*)(dst + (size_t)(n0 + n) * K + k0 + k8) = o;
        }
        __syncthreads();
    }
}
__device__ __forceinline__ void cvt_copy(const Ctx& C, const float* src, bf16_t* dst, size_t n) {
    const size_t n8 = n / 8;
    for (size_t i = (size_t)C.bid * 512 + C.tid; i < n8; i += (size_t)C.G * 512) {
        const f32x4 a = *(const f32x4*)(src + i * 8), b = *(const f32x4*)(src + i * 8 + 4);
        u32x4 o; o[0] = pk2(a[0], a[1]); o[1] = pk2(a[2], a[3]); o[2] = pk2(b[0], b[1]); o[3] = pk2(b[2], b[3]);
        *(u32x4*)(dst + i * 8) = o;
    }
}
__device__ __forceinline__ void strip_unit(const Ctx& C, const float* src, int ld, unsigned char* dst, unsigned* cmax, bool split) {
    const float* p = src + (size_t)(128 * C.wave) * ld + C.lane;
    float v[128];
#pragma unroll
    for (int i = 0; i < 128; ++i) v[i] = p[(size_t)i * ld];
    if (cmax) {
        float mx = 0.f;
#pragma unroll
        for (int i = 0; i < 128; ++i) mx = fmaxf(mx, fabsf(v[i]));
        LAS float* red = (LAS float*)C.lds;
        red[C.wave * 64 + C.lane] = mx;
        __syncthreads();
        float m = red[C.lane];
#pragma unroll
        for (int w2 = 1; w2 < 8; ++w2) m = fmaxf(m, red[w2 * 64 + C.lane]);
        if (C.wave == 0) cmax[C.lane] = __builtin_bit_cast(unsigned, m);
        const float isc = 127.f / fmaxf(m, 1e-30f);
        unsigned char* dp = dst + (size_t)C.lane * 1024 + 128 * C.wave;
#pragma unroll
        for (int j4 = 0; j4 < 8; ++j4) { u32x4 o;
#pragma unroll
            for (int j = 0; j < 4; ++j) { unsigned wd = 0u;
#pragma unroll
                for (int e = 0; e < 4; ++e) wd |= ((unsigned)(int)rintf(v[16 * j4 + 4 * j + e] * isc) & 255u) << (8 * e);
                o[j] = wd; }
            *(u32x4*)(dp + 16 * j4) = o; }
        __syncthreads();
    } else {
        bf16_t* dp = split ? (bf16_t*)dst + (size_t)(C.wave >> 2) * DM * BW + (size_t)C.lane * BW + 128 * (C.wave & 3) : (bf16_t*)dst + (size_t)C.lane * 1024 + 128 * C.wave;
#pragma unroll
        for (int j8 = 0; j8 < 16; ++j8) { u32x4 o;
#pragma unroll
            for (int j = 0; j < 4; ++j) o[j] = pk2(v[8 * j8 + 2 * j], v[8 * j8 + 2 * j + 1]);
            *(u32x4*)(dp + 8 * j8) = o; }
    }
}
__device__ __forceinline__ void p_conv_weights(const Ctx& C) {
#pragma unroll 1
    for (int u = C.bid; u < DEPTH * 224; u += C.G) {
        const int l = u / 224, r = u % 224;
        unsigned char* wb = C.ws + WS_W + (size_t)l * W_LAYER;
        unsigned* cm = (unsigned*)(C.ws + WS_CMAX) + l * (NH + NG);
        const float* src; int ld; unsigned char* dst; unsigned* cx = nullptr; bool split = false;
        if (r < 80)       { src = C.in[I_WIN] + (size_t)l * DM * NIN + r * 64; ld = NIN; dst = wb + WO_WIN + (size_t)r * 64 * DM; cx = cm + r * 64; }
        else if (r < 144) { const int t = r - 80; src = C.in[I_WGATE] + (size_t)l * DM * NG + t * 64; ld = NG; dst = wb + WO_WG + (size_t)t * 64 * DM; cx = cm + NH + t * 64; }
        else if (r < 176) { const int t = r - 144, pr = t >> 4, nt = t & 15; src = C.in[I_WBR] + ((size_t)l * 4 + 2 * pr) * BW * DM + nt * 64; ld = DM; split = true;
                            dst = wb + WO_WBR + ((size_t)(2 * pr) * DM * BW + (size_t)nt * 64 * BW) * 2; }
        else if (r < 192) { const int nt = r - 176; src = C.in[I_WOUT] + (size_t)l * DM * DM + nt * 64; ld = DM; dst = wb + WO_WOUT + (size_t)nt * 64 * DM * 2; }
        else              { const int nt = r - 192; src = C.in[I_WQ] + (size_t)l * DM * NQ + nt * 64; ld = NQ; dst = wb + WO_WQ + (size_t)nt * 64 * DM * 2; }
        strip_unit(C, src, ld, dst, cx, split);
    }
    for (int l = 0; l < DEPTH; ++l) {
        unsigned char* wb = C.ws + WS_W + (size_t)l * W_LAYER;
        cvt_copy(C, C.in[I_KEYS] + (size_t)l * 2 * PH * 128 * 128, (bf16_t*)(wb + WO_KEYS), (size_t)2 * PH * 128 * 128);
        for (int g = 0; g < 4; ++g)
            tconv_job(C, C.in[I_POOLW] + ((size_t)l * 4 + g) * 128 * 128, 128, 128, 128, (bf16_t*)(wb + WO_POOLW) + (size_t)g * 128 * 128);
        {
            bf16_t* gw = (bf16_t*)(wb + WO_GWS); const float* src = C.in[I_GWS] + (size_t)l * 4 * 128 * 128;
            for (int i = C.bid * 512 + C.tid; i < 4 * 128 * 128; i += C.G * 512) { const int t = (i >> 7) & 127, sx = i & 127; gw[i] = (bf16_t)f2bf(sx <= t ? src[i] : 0.f); }
        }
        float* wf = (float*)(wb + WO_WF);
        for (int i = C.bid * 512 + C.tid; i < 4 * DM; i += C.G * 512) { const int h = i / DM, k = i % DM; wf[i] = C.in[I_WIN][(size_t)l * DM * NIN + (size_t)k * NIN + NH + h]; }
    }
}
constexpr size_t WS_U8 = WS_TABU, WS_V8 = WS_TABU + 16 * MiB, WS_SU = WS_TABU + 32 * MiB, WS_SV = WS_SU + 64 * 1024;
__device__ __forceinline__ float wave_max(float v) {
#pragma unroll
    for (int o = 32; o > 0; o >>= 1) v = fmaxf(v, __shfl_xor(v, o, 64));
    return v;
}
template <bool SIGNED> __device__ __forceinline__ void quant_rows(const Ctx& C, const float* src, unsigned char* dst, float* scl) {
    for (int row = C.bid * 8 + C.wave; row < NEXP; row += C.G * 8) {
        const float* p = src + (size_t)row * DM + C.lane * 16;
        f32x4 v[4]; float mx = 0.f;
#pragma unroll
        for (int i = 0; i < 4; ++i) { v[i] = *(const f32x4*)(p + 4 * i);
#pragma unroll
            for (int e = 0; e < 4; ++e) mx = fmaxf(mx, fabsf(v[i][e])); }
        mx = fmaxf(wave_max(mx), 1e-30f);
        const float sc = mx * (1.f / 127.f), isc = 127.f / mx;
        u32x4 o;
#pragma unroll
        for (int i = 0; i < 4; ++i) { unsigned wd = 0u;
#pragma unroll
            for (int e = 0; e < 4; ++e) { const int q = (int)rintf(v[i][e] * isc) + (SIGNED ? 0 : 128); wd |= ((unsigned)q & 255u) << (8 * e); }
            o[i] = wd; }
        *(u32x4*)(dst + (size_t)row * DM + C.lane * 16) = o;
        if (C.lane == 0) scl[row] = sc;
    }
}
__device__ __forceinline__ void p_conv_tables(const Ctx& C, int l) {
    quant_rows<true>(C, C.in[I_PU] + (size_t)l * NEXP * DM, C.ws + WS_U8, (float*)(C.ws + WS_SU));
    quant_rows<false>(C, C.in[I_PV] + (size_t)l * NEXP * DM, C.ws + WS_V8, (float*)(C.ws + WS_SV));
}

__device__ __forceinline__ void row_emit(const Ctx& C, int row, const float (&v)[16], int l, bool want_lsig) {
    {
        float mx = 0.f;
#pragma unroll
        for (int j = 0; j < 16; ++j) mx = fmaxf(mx, fabsf(v[j]));
#pragma unroll
        for (int o = 32; o > 0; o >>= 1) mx = fmaxf(mx, __shfl_xor(mx, o, 64));
        mx = fmaxf(mx, 1e-30f);
        const float isc = 127.f / mx;
        unsigned char* xb = C.ws + WS_XB + (size_t)row * DM;
        u32x2 o0, o1;
#pragma unroll
        for (int hw = 0; hw < 2; ++hw) { unsigned a = 0u, b = 0u;
#pragma unroll
            for (int e = 0; e < 4; ++e) { a |= ((unsigned)(int)rintf(v[4 * hw + e] * isc) & 255u) << (8 * e); b |= ((unsigned)(int)rintf(v[8 + 4 * hw + e] * isc) & 255u) << (8 * e); }
            o0[hw] = a; o1[hw] = b; }
        *(u32x2*)(xb + C.lane * 8) = o0; *(u32x2*)(xb + 512 + C.lane * 8) = o1;
        if (C.lane == 0) ((float*)(C.ws + WS_XSA))[row] = mx * (1.f / 127.f);
    }
    if (want_lsig) {
        const float* wf = (const float*)(C.ws + WS_W + (size_t)l * W_LAYER + WO_WF);
        float* lsig = (float*)(C.ws + WS_MISC);
#pragma unroll
        for (int h = 0; h < 4; ++h) {
            const f32x4 a0 = *(const f32x4*)(wf + h * DM + C.lane * 8), a1 = *(const f32x4*)(wf + h * DM + C.lane * 8 + 4);
            const f32x4 b0 = *(const f32x4*)(wf + h * DM + 512 + C.lane * 8), b1 = *(const f32x4*)(wf + h * DM + 512 + C.lane * 8 + 4);
            float s = 0.f;
#pragma unroll
            for (int j = 0; j < 4; ++j) s += v[j] * a0[j] + v[4 + j] * a1[j] + v[8 + j] * b0[j] + v[12 + j] * b1[j];
            s = wave_sum(s);
            if (C.lane == 0) lsig[(size_t)row * 4 + h] = logsigmoidf_(s + C.in[I_BFOX][l * 4 + h]);
        }
    }
}
__device__ __forceinline__ void load_row16(const float* p, int lane, float (&v)[16]) {
    const f32x4 a0 = *(const f32x4*)(p + lane * 8), a1 = *(const f32x4*)(p + lane * 8 + 4), b0 = *(const f32x4*)(p + 512 + lane * 8), b1 = *(const f32x4*)(p + 512 + lane * 8 + 4);
#pragma unroll
    for (int j = 0; j < 4; ++j) { v[j] = a0[j]; v[4 + j] = a1[j]; v[8 + j] = b0[j]; v[12 + j] = b1[j]; }
}
__device__ __forceinline__ void store_row16(float* p, int lane, const float (&v)[16]) {
    *(f32x4*)(p + lane * 8) = (f32x4){v[0], v[1], v[2], v[3]}; *(f32x4*)(p + lane * 8 + 4) = (f32x4){v[4], v[5], v[6], v[7]};
    *(f32x4*)(p + 512 + lane * 8) = (f32x4){v[8], v[9], v[10], v[11]}; *(f32x4*)(p + 512 + lane * 8 + 4) = (f32x4){v[12], v[13], v[14], v[15]};
}
__device__ __forceinline__ void ln_row16(float (&v)[16], const float* g, const float* b, int lane) {
    float s = 0.f;
#pragma unroll
    for (int j = 0; j < 16; ++j) s += v[j];
    const float mean = wave_sum(s) * (1.f / DM);
    float q = 0.f;
#pragma unroll
    for (int j = 0; j < 16; ++j) { const float d = v[j] - mean; q += d * d; }
    const float rstd = rsqrtf(wave_sum(q) * (1.f / DM) + LN_EPS);
    float gg[16], bb[16];
    load_row16(g, lane, gg); load_row16(b, lane, bb);
#pragma unroll
    for (int j = 0; j < 16; ++j) v[j] = (v[j] - mean) * rstd * gg[j] + bb[j];
}
__device__ __forceinline__ void p_rowpass0(const Ctx& C) {
    const float* wfin = C.in[I_WIN] + NH;
    f32x4 wv[16];
#pragma unroll
    for (int j = 0; j < 16; ++j) { const int k = (j < 8) ? C.lane * 8 + j : 512 + C.lane * 8 + (j - 8); wv[j] = *(const f32x4*)(wfin + (size_t)k * NIN); }
    float* lsig = (float*)(C.ws + WS_MISC);
    const bool bal = (C.G == 256);
    const int c0 = bal ? ((C.bid < 192) ? C.bid * 6 : 1152 + (C.bid - 192) * 14) : C.bid, cn = bal ? ((C.bid < 192) ? 6 : 14) : (T / 8 - C.bid + C.G - 1) / C.G, cs = bal ? 1 : C.G;
    for (int ci = 0; ci < cn; ++ci) {
        const int row = (c0 + ci * cs) * 8 + C.wave;
        float v[16]; load_row16(C.in[I_X] + (size_t)row * DM, C.lane, v);
        row_emit(C, row, v, 0, false);
#pragma unroll
        for (int h = 0; h < 4; ++h) {
            float sacc = 0.f;
#pragma unroll
            for (int j = 0; j < 16; ++j) sacc += v[j] * wv[j][h];
            sacc = wave_sum(sacc);
            if (C.lane == 0) lsig[(size_t)row * 4 + h] = logsigmoidf_(sacc + C.in[I_BFOX][h]);
        }
    }
}
__device__ __forceinline__ void p_cumsum(const Ctx& C) {
    if (C.bid >= BATCH * 4) return;
    const float* lsig = (const float*)(C.ws + WS_MISC);
    float* cum = (float*)(C.ws + WS_CUM);
    LAS float* wt = (LAS float*)C.lds;
    const int b = C.bid >> 2, h = C.bid & 3;
    float v[16];
#pragma unroll
    for (int j = 0; j < 16; ++j) v[j] = lsig[((size_t)b * SEQ + C.tid * 16 + j) * 4 + h];
#pragma unroll
    for (int j = 1; j < 16; ++j) v[j] += v[j - 1];
    float inc = v[15];
#pragma unroll
    for (int o = 1; o < 64; o <<= 1) { const float t = __shfl_up(inc, o, 64); if (C.lane >= o) inc += t; }
    if (C.lane == 63) wt[C.wave] = inc;
    __syncthreads();
    float off = inc - v[15];
    for (int w2 = 0; w2 < C.wave; ++w2) off += wt[w2];
    float* cp = cum + ((size_t)b * 4 + h) * SEQ + C.tid * 16;
#pragma unroll
    for (int j4 = 0; j4 < 4; ++j4) *(f32x4*)(cp + 4 * j4) = (f32x4){v[4 * j4] + off, v[4 * j4 + 1] + off, v[4 * j4 + 2] + off, v[4 * j4 + 3] + off};
    __syncthreads();
}
__device__ __forceinline__ void load_row16_bf(const bf16_t* p, int lane, float (&v)[16]) {
    const u32x4 a = *(const u32x4*)(p + lane * 8), b = *(const u32x4*)(p + 512 + lane * 8);
#pragma unroll
    for (int j = 0; j < 4; ++j) { v[2 * j] = bf2f(a[j] & 0xffffu); v[2 * j + 1] = bf2f(a[j] >> 16); v[8 + 2 * j] = bf2f(b[j] & 0xffffu); v[9 + 2 * j] = bf2f(b[j] >> 16); }
}
__device__ __forceinline__ void p_ln1(const Ctx& C, int l) {
    const bf16_t* y1 = (const bf16_t*)(C.ws + WS_XC); bf16_t* x1b = (bf16_t*)(C.ws + WS_X1B);
    for (int row = C.bid * 8 + C.wave; row < T; row += C.G * 8) {
        float v[16]; load_row16_bf(y1 + (size_t)row * DM, C.lane, v);
        ln_row16(v, C.in[I_LN1G] + l * DM, C.in[I_LN1B] + l * DM, C.lane);
        u32x4 o0, o1;
#pragma unroll
        for (int j = 0; j < 4; ++j) { o0[j] = pk2(v[2 * j], v[2 * j + 1]); o1[j] = pk2(v[8 + 2 * j], v[8 + 2 * j + 1]); }
        *(u32x4*)(x1b + (size_t)row * DM + C.lane * 8) = o0; *(u32x4*)(x1b + (size_t)row * DM + 512 + C.lane * 8) = o1;
    }
}

__device__ __forceinline__ void mix_pool_naive(const Ctx& C, int l) {
    const bf16_t* H = (const bf16_t*)(C.ws + WS_H); bf16_t* BR = (bf16_t*)(C.ws + WS_BR);
    LAS float* dd = (LAS float*)C.lds;
    for (int u = C.bid; u < (T / 64) * 4; u += C.G) {
        const int g = u & 3, t0 = (u >> 2) * 64, w = 2 << g;
        for (int idx = C.tid; idx < 64 * 128; idx += 512) {
            const int r = idx >> 7, c = idx & 127, row = t0 + r, pos = row & (SEQ - 1);
            const int nwin = (pos + 1 < w) ? pos + 1 : w;
            float s = 0.f;
            for (int j = 0; j < nwin; ++j) s += bf2f(H[(size_t)(row - j) * NH + HC_P + g * 128 + c]);
            dd[idx] = s / (float)nwin - bf2f(H[(size_t)row * NH + HC_P + g * 128 + c]);
        }
        __syncthreads();
        const int dcol = C.tid & 127, rq = C.tid >> 7;
        float acc[16];
#pragma unroll
        for (int i = 0; i < 16; ++i) acc[i] = 0.f;
        const float* pw = C.in[I_POOLW] + ((size_t)l * 4 + g) * 128 * 128;
        for (int c = 0; c < 128; ++c) {
            const float wv = pw[c * 128 + dcol];
#pragma unroll
            for (int i = 0; i < 16; ++i) acc[i] += dd[(rq * 16 + i) * 128 + c] * wv;
        }
        const float sc = C.in[I_POOLS][l * BW + g * 128 + dcol];
#pragma unroll
        for (int i = 0; i < 16; ++i) BR[(size_t)(t0 + rq * 16 + i) * NBR + 0 + g * 128 + dcol] = (bf16_t)f2bf(acc[i] * sc);
        __syncthreads();
    }
}
__device__ __forceinline__ void mix_gmlp_naive(const Ctx& C, int l) {
    const bf16_t* H = (const bf16_t*)(C.ws + WS_H); bf16_t* BR = (bf16_t*)(C.ws + WS_BR);
    LAS float* vn = (LAS float*)C.lds;
    for (int u = C.bid; u < (T / 128) * 4; u += C.G) {
        const int g = u & 3, t0 = (u >> 2) * 128;
        for (int i = 0; i < 16; ++i) {
            const int r = C.wave * 16 + i, row = t0 + r;
            const u32x4 raw = *(const u32x4*)(H + (size_t)row * NH + HC_GV + C.lane * 8);
            float e[8];
#pragma unroll
            for (int j = 0; j < 4; ++j) { e[2 * j] = geluf_(bf2f(raw[j] & 0xffffu)); e[2 * j + 1] = geluf_(bf2f(raw[j] >> 16)); }
            float s = 0.f;
#pragma unroll
            for (int j = 0; j < 8; ++j) s += e[j];
            const float mean = wave_sum(s) * (1.f / BW);
            float q = 0.f;
#pragma unroll
            for (int j = 0; j < 8; ++j) { const float d = e[j] - mean; q += d * d; }
            const float rstd = rsqrtf(wave_sum(q) * (1.f / BW) + LN_EPS);
            if ((C.lane >> 4) == g) {
#pragma unroll
                for (int j = 0; j < 8; ++j) { const int col = C.lane * 8 + j;
                    vn[r * 128 + (col - g * 128)] = (e[j] - mean) * rstd * C.in[I_GLNG][l * BW + col] + C.in[I_GLNB][l * BW + col]; }
            }
        }
        __syncthreads();
        const int c = C.tid & 127, tq = C.tid >> 7;
        const float* wsg = C.in[I_GWS] + ((size_t)l * 4 + g) * 128 * 128;
        for (int t = tq; t < 128; t += 4) {
            float acc = 0.f;
            for (int s = 0; s <= t; ++s) acc += wsg[t * 128 + s] * vn[s * 128 + c];
            const float sv = acc + C.in[I_GBS][(l * 4 + g) * 128 + t];
            const float uv = geluf_(bf2f(H[(size_t)(t0 + t) * NH + HC_GU + g * 128 + c]));
            BR[(size_t)(t0 + t) * NBR + 1024 + g * 128 + c] = (bf16_t)f2bf(uv * sv);
        }
        __syncthreads();
    }
}
__device__ __forceinline__ void mix_fox_naive(const Ctx& C, int l) {
    const bf16_t* H = (const bf16_t*)(C.ws + WS_H); bf16_t* BR = (bf16_t*)(C.ws + WS_BR);
    const float* cum = (const float*)(C.ws + WS_CUM);
    const float scale = 0.08838834764831845f;
    for (int u = C.bid; u < T * 4 / 8; u += C.G) {
        const int rid = u * 8 + C.wave;
        const int h = rid & 3, row = rid >> 2, b = row / SEQ, t = row % SEQ;
        const unsigned qraw = *(const unsigned*)(H + (size_t)row * NH + HC_FQ + h * 128 + C.lane * 2);
        const float q0 = bf2f(qraw & 0xffffu) * scale, q1 = bf2f(qraw >> 16) * scale;
        const float* cm = cum + ((size_t)b * 4 + h) * SEQ;
        const float ct = cm[t];
        float m = -1e30f, lsum = 0.f, o0 = 0.f, o1 = 0.f;
        for (int s = t; s >= 0; --s) {
            const size_t kr = (size_t)(b * SEQ + s) * NH + h * 128 + C.lane * 2;
            const unsigned kraw = *(const unsigned*)(H + kr + HC_FK);
            const unsigned vraw = *(const unsigned*)(H + kr + HC_FV);
            float d = q0 * bf2f(kraw & 0xffffu) + q1 * bf2f(kraw >> 16);
            d = wave_sum(d);
            const float z = d + ct - cm[s];
            const float mn = fmaxf(m, z), al = __expf(m - mn), p = __expf(z - mn);
            lsum = lsum * al + p; o0 = o0 * al + p * bf2f(vraw & 0xffffu); o1 = o1 * al + p * bf2f(vraw >> 16); m = mn;
        }
        const float inv = 1.f / lsum;
        *(unsigned*)(BR + (size_t)row * NBR + 1536 + h * 128 + C.lane * 2) = pk2(o0 * inv, o1 * inv);
    }
}
__device__ __forceinline__ void mix_hgrn_naive(const Ctx& C, int l) {
    if (C.bid >= BATCH * 4) return;
    const bf16_t* H = (const bf16_t*)(C.ws + WS_H); bf16_t* BR = (bf16_t*)(C.ws + WS_BR);
    const int b = C.bid >> 2, h = C.bid & 3;
    LAS float* fdec = (LAS float*)C.lds;
    LAS float* kkv = fdec + 32 * 128;
    LAS float* qsv = kkv + 32 * 128;
    LAS float* vv = qsv + 32 * 128;
    LAS float* opart = vv + 32 * 128;
    const int kq = C.tid >> 7, v = C.tid & 127;
    float S[32];
#pragma unroll
    for (int j = 0; j < 32; ++j) S[j] = 0.f;
    for (int c0 = 0; c0 < SEQ; c0 += 32) {
        for (int idx = C.tid; idx < 32 * 128; idx += 512) {
            const int st = idx >> 7, k = idx & 127; const size_t rb = (size_t)(b * SEQ + c0 + st) * NH + h * 128 + k;
            float lb = 0.f;
            if (l == 1) { const float z0 = C.in[I_LBL][h * 128 + k], z1 = C.in[I_LBL][BW + h * 128 + k]; lb = 1.f / (1.f + __expf(z0 - z1)); }
            const float zf = bf2f(H[rb + HC_HF]);
            const float kk = (1.f - lb) * sigmoidf_(-zf);
            fdec[idx] = 1.f - kk; kkv[idx] = kk; qsv[idx] = siluf_(bf2f(H[rb + HC_HQ])); vv[idx] = bf2f(H[rb + HC_HI]);
        }
        __syncthreads();
        for (int st = 0; st < 32; ++st) {
            const float vt = vv[st * 128 + v];
            float part = 0.f;
#pragma unroll
            for (int j = 0; j < 32; ++j) { const int k = kq * 32 + j; S[j] = fdec[st * 128 + k] * S[j] + kkv[st * 128 + k] * vt; part += S[j] * qsv[st * 128 + k]; }
            opart[(kq * 32 + st) * 128 + v] = part;
        }
        __syncthreads();
        for (int i = 0; i < 4; ++i) {
            const int st = C.wave * 4 + i, row = b * SEQ + c0 + st;
            float o0 = 0.f, o1 = 0.f;
#pragma unroll
            for (int q = 0; q < 4; ++q) { o0 += opart[(q * 32 + st) * 128 + C.lane]; o1 += opart[(q * 32 + st) * 128 + 64 + C.lane]; }
            const float ss = wave_sum(o0 * o0 + o1 * o1);
            const float r = rsqrtf(ss * (1.f / 128.f) + RMS_EPS);
            const float g0 = siluf_(bf2f(H[(size_t)row * NH + HC_HG + h * 128 + C.lane])), g1 = siluf_(bf2f(H[(size_t)row * NH + HC_HG + h * 128 + 64 + C.lane]));
            BR[(size_t)row * NBR + 512 + h * 128 + C.lane] = (bf16_t)f2bf(o0 * r * C.in[I_HNG][l * 128 + C.lane] * g0);
            BR[(size_t)row * NBR + 512 + h * 128 + 64 + C.lane] = (bf16_t)f2bf(o1 * r * C.in[I_HNG][l * 128 + 64 + C.lane] * g1);
        }
        __syncthreads();
    }
}


typedef float f32x16 __attribute__((ext_vector_type(16)));
typedef short s16x4 __attribute__((ext_vector_type(4)));
typedef short v4i16_t __attribute__((ext_vector_type(4)));
__device__ __forceinline__ s16x4 vtr(const LAS unsigned char* p) { return __builtin_bit_cast(s16x4, __builtin_amdgcn_ds_read_tr16_b64_v4i16((LAS v4i16_t*)p)); }
__device__ __forceinline__ float xor32(float x) { return __shfl_xor(x, 32, 64); }
#define MFMA32(a, b, c) __builtin_amdgcn_mfma_f32_32x32x16_bf16((a), (b), (c), 0, 0, 0)
constexpr int CW_KMAX = 16;

__device__ __forceinline__ void p_knorm(const Ctx& C, int l) {
    const bf16_t* H = (const bf16_t*)(C.ws + WS_H);
    unsigned* kmax = (unsigned*)(C.ws + WS_CTL) + CW_KMAX + l * 8;
    for (int r0 = (C.bid * 8 + C.wave) * 8; r0 < T; r0 += C.G * 64) {
        u32x4 raw[8];
#pragma unroll
        for (int i = 0; i < 8; ++i) raw[i] = *(const u32x4*)(H + (size_t)(r0 + i) * NH + HC_FK + C.lane * 8);
        float best = 0.f;
#pragma unroll
        for (int i = 0; i < 8; ++i) { float s = 0.f;
#pragma unroll
            for (int j = 0; j < 4; ++j) { const float a = bf2f(raw[i][j] & 0xffffu), b = bf2f(raw[i][j] >> 16); s += a * a + b * b; }
            best = fmaxf(best, s); }
        best = 0.f;
#pragma unroll
        for (int i = 0; i < 8; ++i) { float s = 0.f;
#pragma unroll
            for (int j = 0; j < 4; ++j) { const float a = bf2f(raw[i][j] & 0xffffu), b = bf2f(raw[i][j] >> 16); s += a * a + b * b; }
#pragma unroll
            for (int o = 8; o > 0; o >>= 1) s += __shfl_xor(s, o, 64);
            best = fmaxf(best, s); }
        LAS float* red = (LAS float*)C.lds;
        if ((C.lane & 15) == 0) red[C.wave * 4 + (C.lane >> 4)] = best;
        __syncthreads();
        if (C.tid < 4) { float m = red[C.tid];
#pragma unroll
            for (int w2 = 1; w2 < 8; ++w2) m = fmaxf(m, red[w2 * 4 + C.tid]);
            atomicMax(kmax + (r0 / SEQ) * 4 + C.tid, __builtin_bit_cast(unsigned, m)); }
        __syncthreads();
    }
}

constexpr int FOX_KST = 272, FOX_VST = 320;
constexpr int FOX_KB = 0, FOX_VB = 2 * 64 * FOX_KST, FOX_BETA = FOX_VB + 2 * 64 * FOX_VST, FOX_FLAG = FOX_BETA + 2 * 64 * 4, FOX_END = FOX_FLAG + 2 * 8 * 4;
__device__ __forceinline__ void mix_fox(const Ctx& C, int l) {
    const bf16_t* H = (const bf16_t*)(C.ws + WS_H); bf16_t* BR = (bf16_t*)(C.ws + WS_BR);
    const float* cum = (const float*)(C.ws + WS_CUM);
    const unsigned* kmaxw = (const unsigned*)(C.ws + WS_CTL) + CW_KMAX + l * 8;
    const float LOG2E = 1.4426950408889634f, QS = 0.08838834764831845f * LOG2E;
    const int lane = C.lane, w = C.wave, r32 = lane & 31, hh = lane >> 5;
    LAS unsigned char* lds = C.lds;
    LAS float* betaL = (LAS float*)(lds + FOX_BETA);
    volatile LAS int* flagL = (volatile LAS int*)(lds + FOX_FLAG);
    for (int u = C.bid; u < BATCH * 4 * (SEQ / 256); u += C.G) {
        const int qb = u % (SEQ / 256), bh = u / (SEQ / 256), b = bh >> 2, h = bh & 3;
        const int q0 = qb * 256, qw = q0 + 32 * w;
        const size_t rowbase = (size_t)b * SEQ;
        const float* cm = cum + ((size_t)b * 4 + h) * SEQ;
        const float c0 = cm[q0];
        const float kmx = sqrtf(__builtin_bit_cast(float, __hip_atomic_load(kmaxw + b * 4 + h, __ATOMIC_RELAXED, __HIP_MEMORY_SCOPE_AGENT)));
        bf16x8 qf[8]; float qn = 0.f;
        {
            const bf16_t* qp = H + (rowbase + qw + r32) * NH + HC_FQ + h * 128 + 8 * hh;
#pragma unroll
            for (int ks = 0; ks < 8; ++ks) {
                const u32x4 raw = *(const u32x4*)(qp + 16 * ks);
                u32x4 o;
#pragma unroll
                for (int j = 0; j < 4; ++j) { const float a = bf2f(raw[j] & 0xffffu), bb = bf2f(raw[j] >> 16); qn += a * a + bb * bb; o[j] = cvtpk(a * QS, bb * QS); }
                qf[ks] = __builtin_bit_cast(bf16x8, o);
            }
            qn += xor32(qn); qn = sqrtf(qn);
        }
        const float qbound = qn * kmx * QS;
        f32x16 oacc[4];
#pragma unroll
        for (int mt = 0; mt < 4; ++mt)
#pragma unroll
            for (int i = 0; i < 16; ++i) oacc[mt][i] = 0.f;
        float m_run = -1e30f, l_run = 0.f;
        const int jmax = (q0 + 255) >> 6;
        const int srow = C.tid >> 4, sch = C.tid & 15;
        u32x4 kreg[2], vreg[2]; float breg = 0.f;
#define FOX_GLOAD(j_) do { _Pragma("unroll") for (int p = 0; p < 2; ++p) { \
                const bf16_t* rp = H + (rowbase + 64 * (j_) + srow + 32 * p) * NH + h * 128 + sch * 8; \
                kreg[p] = *(const u32x4*)(rp + HC_FK); vreg[p] = *(const u32x4*)(rp + HC_FV); } \
            if (C.tid < 64) breg = (c0 - cm[64 * (j_) + C.tid]) * LOG2E; } while (0)
#define FOX_LWRITE(buf_) do { _Pragma("unroll") for (int p = 0; p < 2; ++p) { \
                *(LAS u32x4*)(lds + FOX_KB + (buf_) * 64 * FOX_KST + (srow + 32 * p) * FOX_KST + sch * 16) = kreg[p]; \
                *(LAS u32x4*)(lds + FOX_VB + (buf_) * 64 * FOX_VST + (srow + 32 * p) * FOX_VST + sch * 16) = vreg[p]; } \
            if (C.tid < 64) betaL[(buf_) * 64 + C.tid] = breg; } while (0)
        __syncthreads();
        if (C.tid < 16) flagL[C.tid] = 0;
        FOX_GLOAD(jmax); FOX_LWRITE(jmax & 1);
        bool wdone = false;
        for (int j = jmax; j >= 0; --j) {
            const int cur = j & 1;
            __syncthreads();
            if (j < jmax) { int all = 1;
#pragma unroll
                for (int i = 0; i < 8; ++i) all &= flagL[((j + 1) & 1) * 8 + i];
                if (all) break; }
            if (j > 0) FOX_GLOAD(j - 1);
            const int k0 = 64 * j;
            if (k0 <= qw + 31 && !wdone) {
                const LAS unsigned char* kb = lds + FOX_KB + cur * 64 * FOX_KST;
                const LAS unsigned char* vb = lds + FOX_VB + cur * 64 * FOX_VST;
                f32x16 sacc[2];
#pragma unroll
                for (int mt = 0; mt < 2; ++mt)
#pragma unroll
                    for (int g = 0; g < 4; ++g) { const f32x4 bv = *(const LAS f32x4*)(betaL + cur * 64 + 32 * mt + 8 * g + 4 * hh);
                        sacc[mt][4 * g] = bv[0]; sacc[mt][4 * g + 1] = bv[1]; sacc[mt][4 * g + 2] = bv[2]; sacc[mt][4 * g + 3] = bv[3]; }
#pragma unroll
                for (int ks = 0; ks < 8; ++ks)
#pragma unroll
                    for (int mt = 0; mt < 2; ++mt) {
                        const bf16x8 kf = *(const LAS bf16x8*)(kb + (32 * mt + r32) * FOX_KST + 32 * ks + 16 * hh);
                        sacc[mt] = MFMA32(kf, qf[ks], sacc[mt]);
                    }
                const int tq = qw + r32;
                if (k0 + 63 > qw) {
#pragma unroll
                    for (int mt = 0; mt < 2; ++mt)
#pragma unroll
                        for (int i = 0; i < 16; ++i) { const int key = k0 + 32 * mt + (i & 3) + 8 * (i >> 2) + 4 * hh; if (key > tq) sacc[mt][i] = -1e30f; }
                }
                float mx = sacc[0][0];
#pragma unroll
                for (int mt = 0; mt < 2; ++mt)
#pragma unroll
                    for (int i = 0; i < 16; ++i) mx = fmaxf(mx, sacc[mt][i]);
                mx = fmaxf(mx, xor32(mx));
                const float mn = fmaxf(m_run, mx), alpha = __builtin_amdgcn_exp2f(m_run - mn);
                m_run = mn;
                float ps = 0.f;
#pragma unroll
                for (int mt = 0; mt < 2; ++mt)
#pragma unroll
                    for (int i = 0; i < 16; ++i) { const float p = __builtin_amdgcn_exp2f(sacc[mt][i] - mn); sacc[mt][i] = p; ps += p; }
                l_run = l_run * alpha + ps;
#pragma unroll
                for (int mt = 0; mt < 4; ++mt)
#pragma unroll
                    for (int i = 0; i < 16; ++i) oacc[mt][i] *= alpha;
#pragma unroll
                for (int s4 = 0; s4 < 4; ++s4) {
                    const int mtk = s4 >> 1, s = s4 & 1;
                    u32x4 pb;
#pragma unroll
                    for (int e = 0; e < 4; ++e) pb[e] = cvtpk(sacc[mtk][8 * s + 2 * e], sacc[mtk][8 * s + 2 * e + 1]);
                    const bf16x8 pfrag = __builtin_bit_cast(bf16x8, pb);
                    const int i16 = lane & 15, q4 = i16 >> 2, p4 = i16 & 3, blk = (lane >> 4) & 1;
                    const int keyA = 32 * mtk + 16 * s + 4 * hh + q4;
#pragma unroll
                    for (int mt = 0; mt < 4; ++mt) {
                        const LAS unsigned char* a0 = vb + keyA * FOX_VST + (32 * mt + 16 * blk + 4 * p4) * 2;
                        const s16x4 lo = vtr(a0), hi = vtr(a0 + 8 * FOX_VST);
                        const bf16x8 vf = __builtin_shufflevector(lo, hi, 0, 1, 2, 3, 4, 5, 6, 7);
                        oacc[mt] = MFMA32(vf, pfrag, oacc[mt]);
                    }
                }
                if (j > 0) { const float bl = (c0 - cm[k0 - 1]) * LOG2E;
                    const int ok = (qbound + bl < m_run - 40.f) ? 1 : 0;
                    wdone = __all(ok); }
            }
            if (lane == 0) flagL[cur * 8 + w] = wdone ? 1 : 0;
            if (j > 0) FOX_LWRITE(cur ^ 1);
        }
        l_run += xor32(l_run);
        const float inv = 1.f / l_run;
        bf16_t* op = BR + (rowbase + qw + r32) * NBR + 1536 + h * 128;
#pragma unroll
        for (int mt = 0; mt < 4; ++mt)
#pragma unroll
            for (int g = 0; g < 4; ++g) { u32x2 o; o[0] = cvtpk(oacc[mt][4 * g] * inv, oacc[mt][4 * g + 1] * inv); o[1] = cvtpk(oacc[mt][4 * g + 2] * inv, oacc[mt][4 * g + 3] * inv);
                *(u32x2*)(op + 32 * mt + 8 * g + 4 * hh) = o; }
    }
}


constexpr int HG_LF = 0, HG_QA = 34816, HG_QB = HG_QA + 17408, HG_KD = HG_QB + 8704, HG_KO = HG_KD + 17408, HG_KT = HG_KO + 8704, HG_VN = HG_KT + 20480, HG_AM = HG_VN + 20480, HG_END = HG_AM + 12288;
constexpr int HG_LFS = 132;
static_assert(HG_END + 2048 <= 140 * 1024, "hgrn LDS");
constexpr size_t WS_DSC = WS_ST + (size_t)BATCH * 4 * 32 * 128 * 128 * 4;

template <bool FULL>
__device__ __forceinline__ void hgrn_unit(const Ctx& C, int l, int u) {
#if DIAG == 1
    const bf16_t* H = (const bf16_t*)(C.ws + WS_H); bf16_t* BR = (l == 0) ? (bf16_t*)(C.ws + WS_XA) : (bf16_t*)(C.ws + WS_TABU);
#else
    const bf16_t* H = (const bf16_t*)(C.ws + WS_H); bf16_t* BR = (bf16_t*)(C.ws + WS_BR);
#endif
    float* STB = (float*)(C.ws + WS_ST); float* DSC = (float*)(C.ws + WS_DSC);
    LAS unsigned char* lds = C.lds;
    LAS float* LF = (LAS float*)(lds + HG_LF);
    const int lane = C.lane, w = C.wave, r32 = lane & 31, hh = lane >> 5;
    const int sc = u & 31, bh = u >> 5, b = bh >> 2, h = bh & 3;
    const int wk = w >> 1, wv = w & 1;
    const int mt = w >> 2, nt = w & 3;
    const int i16 = lane & 15, q4 = i16 >> 2, p4 = i16 & 3, blk = (lane >> 4) & 1;
    f32x16 S0, S1;
    float* stp = STB + ((size_t)bh * 32 + sc) * 128 * 128;
    if constexpr (FULL) {
#pragma unroll
        for (int i = 0; i < 16; ++i) { const int k = 32 * wk + (i & 3) + 8 * (i >> 2) + 4 * hh;
            S0[i] = stp[k * 128 + 64 * wv + r32]; S1[i] = stp[k * 128 + 64 * wv + 32 + r32]; }
    } else {
#pragma unroll
        for (int i = 0; i < 16; ++i) { S0[i] = 0.f; S1[i] = 0.f; }
    }
    float dtot = 0.f;
    const int ps = C.tid >> 3, pseg = C.tid & 7;
    float lbv[16];
#pragma unroll
    for (int j = 0; j < 16; ++j) { lbv[j] = 0.f;
        if (l == 1) { const int ch = h * 128 + 16 * pseg + j; lbv[j] = 1.f / (1.f + __expf(C.in[I_LBL][ch] - C.in[I_LBL][BW + ch])); } }
    u32x4 nf0, nf1, nv0, nv1;
    { const bf16_t* hp0 = H + ((size_t)b * SEQ + sc * 256 + ps) * NH + h * 128 + 16 * pseg;
      nf0 = *(const u32x4*)(hp0 + HC_HF); nf1 = *(const u32x4*)(hp0 + HC_HF + 8); nv0 = *(const u32x4*)(hp0 + HC_HI); nv1 = *(const u32x4*)(hp0 + HC_HI + 8); }
    for (int c = 0; c < 4; ++c) {
        const size_t row0 = (size_t)b * SEQ + sc * 256 + c * 64;
        const bf16_t* hp = H + (row0 + ps) * NH + h * 128 + 16 * pseg;
        float kkv[16], qsv[16];
        u32x4 vraw0, vraw1;
        u32x4 cg0 = {0u, 0u, 0u, 0u}, cg1 = cg0, cq0 = cg0, cq1 = cg0;
        if constexpr (FULL) { cq0 = *(const u32x4*)(hp + HC_HQ); cq1 = *(const u32x4*)(hp + HC_HQ + 8); cg0 = *(const u32x4*)(hp + HC_HG); cg1 = *(const u32x4*)(hp + HC_HG + 8); }
        {
            const u32x4 f0 = nf0, f1 = nf1;
            vraw0 = nv0; vraw1 = nv1;
            if (c < 3) { const bf16_t* hn = hp + (size_t)64 * NH;
                nf0 = *(const u32x4*)(hn + HC_HF); nf1 = *(const u32x4*)(hn + HC_HF + 8); nv0 = *(const u32x4*)(hn + HC_HI); nv1 = *(const u32x4*)(hn + HC_HI + 8); }
#pragma unroll
            for (int j = 0; j < 8; ++j) { const unsigned r = (j < 4) ? f0[j] : f1[j - 4];
                const float z0 = bf2f(r & 0xffffu), z1 = bf2f(r >> 16);
                kkv[2 * j] = (1.f - lbv[2 * j]) * sigmoidf_(-z0); kkv[2 * j + 1] = (1.f - lbv[2 * j + 1]) * sigmoidf_(-z1); }
            if constexpr (FULL) {
#pragma unroll
                for (int j = 0; j < 8; ++j) { const unsigned r = (j < 4) ? cq0[j] : cq1[j - 4]; qsv[2 * j] = siluf_(bf2f(r & 0xffffu)); qsv[2 * j + 1] = siluf_(bf2f(r >> 16)); }
            }
#pragma unroll
            for (int j4 = 0; j4 < 4; ++j4) { f32x4 o;
#pragma unroll
                for (int e = 0; e < 4; ++e) o[e] = __logf(1.f - kkv[4 * j4 + e]);
                *(LAS f32x4*)(LF + ps * HG_LFS + 16 * pseg + 4 * j4) = o; }
        }
        __syncthreads();
        {
            const int sk = C.tid & 127, sg = C.tid >> 7;
            float vals[16];
#pragma unroll
            for (int i = 0; i < 16; ++i) vals[i] = LF[(16 * sg + i) * HG_LFS + sk];
#pragma unroll
            for (int i = 1; i < 16; ++i) vals[i] += vals[i - 1];
            LAS float* TOT = (LAS float*)(lds + HG_END);
            TOT[sg * 128 + sk] = vals[15];
            __syncthreads();
            float off = 0.f;
#pragma unroll
            for (int j = 0; j < 3; ++j) if (j < sg) off += TOT[j * 128 + sk];
#pragma unroll
            for (int i = 0; i < 16; ++i) LF[(16 * sg + i) * HG_LFS + sk] = vals[i] + off;
            if (sg == 3) dtot += vals[15] + off;
        }
        __syncthreads();
        float bv[16], b31[16], bl[16];
#pragma unroll
        for (int j4 = 0; j4 < 4; ++j4) { const f32x4 x = *(const LAS f32x4*)(LF + ps * HG_LFS + 16 * pseg + 4 * j4), y = *(const LAS f32x4*)(LF + 31 * HG_LFS + 16 * pseg + 4 * j4), z = *(const LAS f32x4*)(LF + 63 * HG_LFS + 16 * pseg + 4 * j4);
#pragma unroll
            for (int e = 0; e < 4; ++e) { bv[4 * j4 + e] = x[e]; b31[4 * j4 + e] = y[e]; bl[4 * j4 + e] = z[e]; } }
        {
            u32x4 o0, o1;
#pragma unroll
            for (int j = 0; j < 4; ++j) { o0[j] = cvtpk(kkv[2 * j] * __expf(bl[2 * j] - bv[2 * j]), kkv[2 * j + 1] * __expf(bl[2 * j + 1] - bv[2 * j + 1]));
                o1[j] = cvtpk(kkv[8 + 2 * j] * __expf(bl[8 + 2 * j] - bv[8 + 2 * j]), kkv[9 + 2 * j] * __expf(bl[9 + 2 * j] - bv[9 + 2 * j])); }
            *(LAS u32x4*)(lds + HG_KT + ps * 320 + 32 * pseg) = o0; *(LAS u32x4*)(lds + HG_KT + ps * 320 + 32 * pseg + 16) = o1;
            *(LAS u32x4*)(lds + HG_VN + ps * 320 + 32 * pseg) = vraw0; *(LAS u32x4*)(lds + HG_VN + ps * 320 + 32 * pseg + 16) = vraw1;
            if constexpr (FULL) {
                const bool hi = ps >= 32;
                float rr[16];
#pragma unroll
                for (int j = 0; j < 16; ++j) rr[j] = hi ? b31[j] : 0.f;
#pragma unroll
                for (int j = 0; j < 4; ++j) { o0[j] = cvtpk(qsv[2 * j] * __expf(bv[2 * j] - rr[2 * j]), qsv[2 * j + 1] * __expf(bv[2 * j + 1] - rr[2 * j + 1]));
                    o1[j] = cvtpk(qsv[8 + 2 * j] * __expf(bv[8 + 2 * j] - rr[8 + 2 * j]), qsv[9 + 2 * j] * __expf(bv[9 + 2 * j] - rr[9 + 2 * j])); }
                *(LAS u32x4*)(lds + HG_QA + ps * 272 + 32 * pseg) = o0; *(LAS u32x4*)(lds + HG_QA + ps * 272 + 32 * pseg + 16) = o1;
#pragma unroll
                for (int j = 0; j < 4; ++j) { o0[j] = cvtpk(kkv[2 * j] * __expf(rr[2 * j] - bv[2 * j]), kkv[2 * j + 1] * __expf(rr[2 * j + 1] - bv[2 * j + 1]));
                    o1[j] = cvtpk(kkv[8 + 2 * j] * __expf(rr[8 + 2 * j] - bv[8 + 2 * j]), kkv[9 + 2 * j] * __expf(rr[9 + 2 * j] - bv[9 + 2 * j])); }
                *(LAS u32x4*)(lds + HG_KD + ps * 272 + 32 * pseg) = o0; *(LAS u32x4*)(lds + HG_KD + ps * 272 + 32 * pseg + 16) = o1;
                if (hi) {
#pragma unroll
                    for (int j = 0; j < 4; ++j) { o0[j] = cvtpk(qsv[2 * j] * __expf(bv[2 * j]), qsv[2 * j + 1] * __expf(bv[2 * j + 1]));
                        o1[j] = cvtpk(qsv[8 + 2 * j] * __expf(bv[8 + 2 * j]), qsv[9 + 2 * j] * __expf(bv[9 + 2 * j])); }
                    *(LAS u32x4*)(lds + HG_QB + (ps - 32) * 272 + 32 * pseg) = o0; *(LAS u32x4*)(lds + HG_QB + (ps - 32) * 272 + 32 * pseg + 16) = o1;
                } else {
#pragma unroll
                    for (int j = 0; j < 4; ++j) { o0[j] = cvtpk(kkv[2 * j] * __expf(b31[2 * j] - bv[2 * j]), kkv[2 * j + 1] * __expf(b31[2 * j + 1] - bv[2 * j + 1]));
                        o1[j] = cvtpk(kkv[8 + 2 * j] * __expf(b31[8 + 2 * j] - bv[8 + 2 * j]), kkv[9 + 2 * j] * __expf(b31[9 + 2 * j] - bv[9 + 2 * j])); }
                    *(LAS u32x4*)(lds + HG_KO + ps * 272 + 32 * pseg) = o0; *(LAS u32x4*)(lds + HG_KO + ps * 272 + 32 * pseg + 16) = o1;
                }
            }
        }
        float dk[16];
#pragma unroll
        for (int i = 0; i < 16; ++i) dk[i] = __expf(LF[63 * HG_LFS + 32 * wk + (i & 3) + 8 * (i >> 2) + 4 * hh]);
        __syncthreads();
        if constexpr (FULL) {
#pragma unroll
            for (int g = 0; g < 4; ++g) {
                u32x2 o; o[0] = cvtpk(S0[4 * g], S0[4 * g + 1]); o[1] = cvtpk(S0[4 * g + 2], S0[4 * g + 3]);
                *(LAS u32x2*)(lds + HG_LF + (64 * wv + r32) * 272 + (32 * wk + 8 * g + 4 * hh) * 2) = o;
                o[0] = cvtpk(S1[4 * g], S1[4 * g + 1]); o[1] = cvtpk(S1[4 * g + 2], S1[4 * g + 3]);
                *(LAS u32x2*)(lds + HG_LF + (64 * wv + 32 + r32) * 272 + (32 * wk + 8 * g + 4 * hh) * 2) = o;
            }
#define HG_ATILE(AMT_, AST_) do { \
                const LAS unsigned char* kb = ((AMT_) == (AST_)) ? (lds + HG_KD + (32 * (AST_)) * 272) : (lds + HG_KO); \
                f32x16 a; \
                _Pragma("unroll") for (int i = 0; i < 16; ++i) a[i] = 0.f; \
                _Pragma("unroll") for (int ks = 0; ks < 8; ++ks) { \
                    const bf16x8 af = *(const LAS bf16x8*)(lds + HG_QA + (32 * (AMT_) + r32) * 272 + 32 * ks + 16 * hh); \
                    const bf16x8 bf = *(const LAS bf16x8*)(kb + r32 * 272 + 32 * ks + 16 * hh); \
                    a = MFMA32(af, bf, a); } \
                _Pragma("unroll") for (int g = 0; g < 4; ++g) { \
                    float x[4]; \
                    _Pragma("unroll") for (int e = 0; e < 4; ++e) { const int tl = 8 * g + 4 * hh + e; x[e] = ((AMT_) != (AST_) || r32 <= tl) ? a[4 * g + e] : 0.f; } \
                    u32x2 o; o[0] = cvtpk(x[0], x[1]); o[1] = cvtpk(x[2], x[3]); \
                    *(LAS u32x2*)(lds + HG_AM + (32 * (AST_) + r32) * 192 + (32 * (AMT_) + 8 * g + 4 * hh) * 2) = o; } } while (0)
            if (w == 0) { HG_ATILE(0, 0); }
            else if (w == 1) { HG_ATILE(1, 0); }
            else if (w == 2) { HG_ATILE(1, 1); }
        }
#pragma unroll
        for (int i = 0; i < 16; ++i) { S0[i] *= dk[i]; S1[i] *= dk[i]; }
#pragma unroll
        for (int ks = 0; ks < 4; ++ks) {
            const LAS unsigned char* ka = lds + HG_KT + (16 * ks + 8 * hh + q4) * 320 + (32 * wk + 16 * blk + 4 * p4) * 2;
            const s16x4 alo = vtr(ka), ahi = vtr(ka + 4 * 320);
            const bf16x8 af = __builtin_shufflevector(alo, ahi, 0, 1, 2, 3, 4, 5, 6, 7);
            const LAS unsigned char* vb0 = lds + HG_VN + (16 * ks + 8 * hh + q4) * 320 + (64 * wv + 16 * blk + 4 * p4) * 2;
            const s16x4 b0lo = vtr(vb0), b0hi = vtr(vb0 + 4 * 320), b1lo = vtr(vb0 + 64), b1hi = vtr(vb0 + 64 + 4 * 320);
            S0 = MFMA32(af, __builtin_shufflevector(b0lo, b0hi, 0, 1, 2, 3, 4, 5, 6, 7), S0);
            S1 = MFMA32(af, __builtin_shufflevector(b1lo, b1hi, 0, 1, 2, 3, 4, 5, 6, 7), S1);
        }
        if constexpr (FULL) {
            __syncthreads();
            f32x16 o;
#pragma unroll
            for (int i = 0; i < 16; ++i) o[i] = 0.f;
            const LAS unsigned char* qb = (mt == 0) ? (lds + HG_QA) : (lds + HG_QB);
#pragma unroll
            for (int ks = 0; ks < 8; ++ks) {
                const bf16x8 af = *(const LAS bf16x8*)(qb + r32 * 272 + 32 * ks + 16 * hh);
                const bf16x8 bf = *(const LAS bf16x8*)(lds + HG_LF + (32 * nt + r32) * 272 + 32 * ks + 16 * hh);
                o = MFMA32(af, bf, o);
            }
#pragma unroll
            for (int ks = 0; ks < 4; ++ks) {
                if (mt == 0 && ks >= 2) continue;
                const LAS unsigned char* aa = lds + HG_AM + (16 * ks + 8 * hh + q4) * 192 + (32 * mt + 16 * blk + 4 * p4) * 2;
                const s16x4 alo = vtr(aa), ahi = vtr(aa + 4 * 192);
                const LAS unsigned char* vb0 = lds + HG_VN + (16 * ks + 8 * hh + q4) * 320 + (32 * nt + 16 * blk + 4 * p4) * 2;
                const s16x4 blo = vtr(vb0), bhi = vtr(vb0 + 4 * 320);
                o = MFMA32(__builtin_shufflevector(alo, ahi, 0, 1, 2, 3, 4, 5, 6, 7), __builtin_shufflevector(blo, bhi, 0, 1, 2, 3, 4, 5, 6, 7), o);
            }
            __syncthreads();
#pragma unroll
            for (int i = 0; i < 16; ++i) LF[(32 * mt + (i & 3) + 8 * (i >> 2) + 4 * hh) * HG_LFS + 32 * nt + r32] = o[i];
            __syncthreads();
            {
                float ov[16]; float ss = 0.f;
#pragma unroll
                for (int j4 = 0; j4 < 4; ++j4) { const f32x4 x = *(const LAS f32x4*)(LF + ps * HG_LFS + 16 * pseg + 4 * j4);
#pragma unroll
                    for (int e = 0; e < 4; ++e) { ov[4 * j4 + e] = x[e]; ss += x[e] * x[e]; } }
                ss += __shfl_xor(ss, 1, 64); ss += __shfl_xor(ss, 2, 64); ss += __shfl_xor(ss, 4, 64);
                const float rn = rsqrtf(ss * (1.f / 128.f) + RMS_EPS);
                const u32x4 g0 = cg0, g1 = cg1;
                const float* ng = C.in[I_HNG] + l * 128 + 16 * pseg;
                u32x4 o0, o1;
#pragma unroll
                for (int j = 0; j < 4; ++j) {
                    o0[j] = cvtpk(ov[2 * j] * rn * ng[2 * j] * siluf_(bf2f(g0[j] & 0xffffu)), ov[2 * j + 1] * rn * ng[2 * j + 1] * siluf_(bf2f(g0[j] >> 16)));
                    o1[j] = cvtpk(ov[8 + 2 * j] * rn * ng[8 + 2 * j] * siluf_(bf2f(g1[j] & 0xffffu)), ov[9 + 2 * j] * rn * ng[9 + 2 * j] * siluf_(bf2f(g1[j] >> 16)));
                }
                bf16_t* bp = BR + (row0 + ps) * NBR + 512 + h * 128 + 16 * pseg;
                *(u32x4*)bp = o0; *(u32x4*)(bp + 8) = o1;
            }
        }
        __syncthreads();
    }
    if constexpr (!FULL) {
#pragma unroll
        for (int i = 0; i < 16; ++i) { const int k = 32 * wk + (i & 3) + 8 * (i >> 2) + 4 * hh;
            stp[k * 128 + 64 * wv + r32] = S0[i]; stp[k * 128 + 64 * wv + 32 + r32] = S1[i]; }
        if (C.tid >= 384) DSC[((size_t)bh * 32 + sc) * 128 + (C.tid & 127)] = __expf(dtot);
    }
}
__device__ __forceinline__ void hgrn_b1(const Ctx& C, int l) { for (int u = C.bid; u < BATCH * 4 * 32; u += C.G) hgrn_unit<false>(C, l, u); }
__device__ __forceinline__ void hgrn_b3(const Ctx& C, int l) { for (int u = C.bid; u < BATCH * 4 * 32; u += C.G) hgrn_unit<true>(C, l, u); }
__device__ __forceinline__ void hgrn_b2(const Ctx& C) {
    float* STB = (float*)(C.ws + WS_ST); const float* DSC = (const float*)(C.ws + WS_DSC);
    for (int e = C.bid * 512 + C.tid; e < BATCH * 4 * 128 * 128; e += C.G * 512) {
        const int bh = e >> 14, kv = e & 16383, k = kv >> 7;
        float* p = STB + (size_t)bh * 32 * 16384 + kv;
        float uu[32], dd[32];
#pragma unroll
        for (int s = 0; s < 32; ++s) { uu[s] = p[(size_t)s * 16384]; dd[s] = DSC[((size_t)bh * 32 + s) * 128 + k]; }
        float st = 0.f;
#pragma unroll
        for (int s = 0; s < 32; ++s) { p[(size_t)s * 16384] = st; st = dd[s] * st + uu[s]; }
    }
}


__device__ __forceinline__ void mix_pool(const Ctx& C, int l) {
#if DIAG == 2
    const bf16_t* H = (const bf16_t*)(C.ws + WS_H); bf16_t* BR = (l == 0) ? (bf16_t*)(C.ws + WS_XA) : (bf16_t*)(C.ws + WS_TABU);
#else
    const bf16_t* H = (const bf16_t*)(C.ws + WS_H); bf16_t* BR = (bf16_t*)(C.ws + WS_BR);
#endif
    const bf16_t* Wt = (const bf16_t*)(C.ws + WS_W + (size_t)l * W_LAYER + WO_POOLW);
    LAS unsigned char* lds = C.lds;
    constexpr int PL_P = 128 * 272;
    const int lane = C.lane, w = C.wave, r32 = lane & 31, hh = lane >> 5;
    for (int u = C.bid; u < (T / 256) * 4; u += C.G) {
        const int g = u & 3, t0 = (u >> 2) * 256, win = 2 << g;
        const int row = t0 + 32 * w + r32, pos = row & (SEQ - 1);
        __syncthreads();
#pragma unroll
        for (int p = 0; p < 4; ++p) { const int idx = C.tid + 512 * p, rr = idx >> 4, ch = idx & 15;
            *(LAS u32x4*)(lds + rr * 272 + ch * 16) = *(const u32x4*)(Wt + (size_t)g * 128 * 128 + rr * 128 + ch * 8); }
        const bool seq_start = (t0 & (SEQ - 1)) == 0;
        for (int idx = C.tid; idx < 271 * 16; idx += 512) { const int rr = idx >> 4, ch = idx & 15;
            if (!(seq_start && rr < 15)) *(LAS u32x4*)(lds + PL_P + rr * 272 + ch * 16) = *(const u32x4*)(H + (size_t)(t0 - 15 + rr) * NH + HC_P + g * 128 + ch * 8); }
        __syncthreads();
        const int nwin = (pos + 1 < win) ? pos + 1 : win;
        const float invn = 1.f / (float)nwin;
        bf16x8 df[8];
        const LAS unsigned char* prow = lds + PL_P + (32 * w + r32 + 15) * 272 + 16 * hh;
#pragma unroll
        for (int ks = 0; ks < 8; ++ks) {
            float sum[8];
#pragma unroll
            for (int e = 0; e < 8; ++e) sum[e] = 0.f;
            const u32x4 self = *(const LAS u32x4*)(prow + 32 * ks);
#pragma unroll
            for (int j = 0; j < 16; ++j) if (j < win) {
                const int jj = (j < nwin) ? j : 0; const float msk = (j < nwin) ? 1.f : 0.f;
                const u32x4 rw = *(const LAS u32x4*)(prow + 32 * ks - jj * 272);
#pragma unroll
                for (int e = 0; e < 4; ++e) { sum[2 * e] += msk * bf2f(rw[e] & 0xffffu); sum[2 * e + 1] += msk * bf2f(rw[e] >> 16); } }
            u32x4 o;
#pragma unroll
            for (int e = 0; e < 4; ++e) o[e] = cvtpk(sum[2 * e] * invn - bf2f(self[e] & 0xffffu), sum[2 * e + 1] * invn - bf2f(self[e] >> 16));
            df[ks] = __builtin_bit_cast(bf16x8, o);
        }
        f32x16 acc[4];
#pragma unroll
        for (int mt = 0; mt < 4; ++mt)
#pragma unroll
            for (int i = 0; i < 16; ++i) acc[mt][i] = 0.f;
#pragma unroll
        for (int ks = 0; ks < 8; ++ks)
#pragma unroll
            for (int mt = 0; mt < 4; ++mt) {
                const bf16x8 wf = *(const LAS bf16x8*)(lds + (32 * mt + r32) * 272 + 32 * ks + 16 * hh);
                acc[mt] = MFMA32(wf, df[ks], acc[mt]);
            }
        const float* psc = C.in[I_POOLS] + l * BW + g * 128;
        bf16_t* op = BR + (size_t)row * NBR + g * 128;
#pragma unroll
        for (int mt = 0; mt < 4; ++mt)
#pragma unroll
            for (int q = 0; q < 4; ++q) { const int d0 = 32 * mt + 8 * q + 4 * hh; const f32x4 sc = *(const f32x4*)(psc + d0);
                u32x2 o; o[0] = cvtpk(acc[mt][4 * q] * sc[0], acc[mt][4 * q + 1] * sc[1]); o[1] = cvtpk(acc[mt][4 * q + 2] * sc[2], acc[mt][4 * q + 3] * sc[3]);
                *(u32x2*)(op + d0) = o; }
    }
}
constexpr int GM_VN = 0, GM_WC = 128 * 320, GM_END = GM_WC + 128 * 272;
__device__ __forceinline__ void mix_gmlp(const Ctx& C, int l) {
#if DIAG == 3
    const bf16_t* H = (const bf16_t*)(C.ws + WS_H); bf16_t* BR = (l == 0) ? (bf16_t*)(C.ws + WS_XA) : (bf16_t*)(C.ws + WS_TABU);
#else
    const bf16_t* H = (const bf16_t*)(C.ws + WS_H); bf16_t* BR = (bf16_t*)(C.ws + WS_BR);
#endif
    const bf16_t* Wc = (const bf16_t*)(C.ws + WS_W + (size_t)l * W_LAYER + WO_GWS);
    LAS unsigned char* lds = C.lds;
    const int lane = C.lane, w = C.wave, r32 = lane & 31, hh = lane >> 5;
    const int i16 = lane & 15, q4 = i16 >> 2, p4 = i16 & 3, blk = (lane >> 4) & 1;
    for (int u = C.bid; u < (T / 128) * 4; u += C.G) {
        const int g = u & 3, t0 = (u >> 2) * 128;
        __syncthreads();
#pragma unroll
        for (int p = 0; p < 4; ++p) { const int idx = C.tid + 512 * p, rr = idx >> 4, ch = idx & 15;
            *(LAS u32x4*)(lds + GM_WC + rr * 272 + ch * 16) = *(const u32x4*)(Wc + (size_t)g * 128 * 128 + rr * 128 + ch * 8); }
        u32x4 rawall[16];
#pragma unroll
        for (int i = 0; i < 16; ++i) rawall[i] = *(const u32x4*)(H + (size_t)(t0 + w * 16 + i) * NH + HC_GV + lane * 8);
#pragma unroll
        for (int hb = 0; hb < 4; ++hb) {
            u32x4 rawv[4];
#pragma unroll
            for (int i = 0; i < 4; ++i) rawv[i] = rawall[hb * 4 + i];
            float e[4][8], st[8];
#pragma unroll
            for (int i = 0; i < 4; ++i) { float s1 = 0.f, s2 = 0.f;
#pragma unroll
                for (int j = 0; j < 4; ++j) { const float a = geluf_(bf2f(rawv[i][j] & 0xffffu)), b = geluf_(bf2f(rawv[i][j] >> 16)); e[i][2 * j] = a; e[i][2 * j + 1] = b; s1 += a + b; s2 += a * a + b * b; }
                st[i] = s1; st[4 + i] = s2; }
#pragma unroll
            for (int sx = 32, n = 4; sx >= 8; sx >>= 1, n >>= 1) { const bool up = (lane & sx) != 0;
#pragma unroll
                for (int i = 0; i < n; ++i) { const float send = up ? st[i] : st[i + n], keep = up ? st[i + n] : st[i]; st[i] = keep + __shfl_xor(send, sx, 64); } }
            float tot = st[0]; tot += __shfl_xor(tot, 4, 64); tot += __shfl_xor(tot, 2, 64); tot += __shfl_xor(tot, 1, 64);
            float mean4[4], rstd4[4];
#pragma unroll
            for (int i = 0; i < 4; ++i) {
                mean4[i] = __builtin_bit_cast(float, __builtin_amdgcn_readlane(__builtin_bit_cast(int, tot), 8 * i)) * (1.f / BW);
                const float ex2 = __builtin_bit_cast(float, __builtin_amdgcn_readlane(__builtin_bit_cast(int, tot), 8 * (4 + i))) * (1.f / BW);
                rstd4[i] = rsqrtf(fmaxf(ex2 - mean4[i] * mean4[i], 0.f) + LN_EPS);
            }
            asm volatile("" ::: "memory");
            if ((lane >> 4) == g) {
                const float* lg = C.in[I_GLNG] + l * BW + lane * 8; const float* lb = C.in[I_GLNB] + l * BW + lane * 8;
#pragma unroll
                for (int i = 0; i < 4; ++i) {
                    const float mean = mean4[i], rstd = rstd4[i];
                    u32x4 o;
#pragma unroll
                    for (int j = 0; j < 4; ++j) o[j] = cvtpk((e[i][2 * j] - mean) * rstd * lg[2 * j] + lb[2 * j], (e[i][2 * j + 1] - mean) * rstd * lg[2 * j + 1] + lb[2 * j + 1]);
                    *(LAS u32x4*)(lds + GM_VN + (w * 16 + hb * 4 + i) * 320 + (lane & 15) * 16) = o;
                }
            }
        }
        __syncthreads();
        const int nt = w & 3, mb = (w >> 2) * 2;
        u32x2 upre[2][4];
#pragma unroll
        for (int m = 0; m < 2; ++m)
#pragma unroll
            for (int q = 0; q < 4; ++q) upre[m][q] = *(const u32x2*)(H + (size_t)(t0 + 32 * nt + r32) * NH + HC_GU + g * 128 + 32 * (mb + m) + 8 * q + 4 * hh);
        f32x16 acc[2];
#pragma unroll
        for (int m = 0; m < 2; ++m)
#pragma unroll
            for (int i = 0; i < 16; ++i) acc[m][i] = 0.f;
        for (int ks = 0; ks < 2 * (nt + 1); ++ks) {
            const bf16x8 bf = *(const LAS bf16x8*)(lds + GM_WC + (32 * nt + r32) * 272 + 32 * ks + 16 * hh);
#pragma unroll
            for (int m = 0; m < 2; ++m) {
                const LAS unsigned char* aa = lds + GM_VN + (16 * ks + 8 * hh + q4) * 320 + (32 * (mb + m) + 16 * blk + 4 * p4) * 2;
                const s16x4 lo = vtr(aa), hi = vtr(aa + 4 * 320);
                acc[m] = MFMA32(__builtin_shufflevector(lo, hi, 0, 1, 2, 3, 4, 5, 6, 7), bf, acc[m]);
            }
        }
        const int tl = 32 * nt + r32, row = t0 + tl;
        const float bias = C.in[I_GBS][(l * 4 + g) * 128 + tl];
#pragma unroll
        for (int m = 0; m < 2; ++m)
#pragma unroll
            for (int q = 0; q < 4; ++q) { const int c0 = 32 * (mb + m) + 8 * q + 4 * hh;
                const u32x2 ur = upre[m][q];
                u32x2 o;
                o[0] = cvtpk(geluf_(bf2f(ur[0] & 0xffffu)) * (acc[m][4 * q] + bias), geluf_(bf2f(ur[0] >> 16)) * (acc[m][4 * q + 1] + bias));
                o[1] = cvtpk(geluf_(bf2f(ur[1] & 0xffffu)) * (acc[m][4 * q + 2] + bias), geluf_(bf2f(ur[1] >> 16)) * (acc[m][4 * q + 3] + bias));
                *(u32x2*)(BR + (size_t)row * NBR + 1024 + g * 128 + c0) = o; }
    }
}

#define CE_D(a, b) do { const float _h = fmaxf(a, b), _l = fminf(a, b); a = _h; b = _l; } while (0)
__device__ __forceinline__ void sort16_desc(float (&x)[16]) {
#define S16(a, b) CE_D(x[a], x[b])
    S16(0, 13); S16(1, 12); S16(2, 15); S16(3, 14); S16(4, 8); S16(5, 6); S16(7, 11); S16(9, 10);
    S16(0, 5); S16(1, 7); S16(2, 9); S16(3, 4); S16(6, 13); S16(8, 14); S16(10, 15); S16(11, 12);
    S16(0, 1); S16(2, 3); S16(4, 5); S16(6, 8); S16(7, 9); S16(10, 11); S16(12, 13); S16(14, 15);
    S16(0, 2); S16(1, 3); S16(4, 10); S16(5, 11); S16(6, 7); S16(8, 9); S16(12, 14); S16(13, 15);
    S16(1, 2); S16(3, 12); S16(4, 6); S16(5, 7); S16(8, 10); S16(9, 11); S16(13, 14);
    S16(1, 4); S16(2, 6); S16(5, 8); S16(7, 10); S16(9, 13); S16(11, 14);
    S16(2, 4); S16(3, 6); S16(9, 12); S16(11, 13);
    S16(3, 5); S16(6, 8); S16(7, 9); S16(10, 12);
    S16(3, 4); S16(5, 6); S16(7, 8); S16(9, 10); S16(11, 12);
    S16(6, 7); S16(8, 9);
#undef S16
}
__device__ __forceinline__ void bmerge16_desc(float (&x)[16]) {
#pragma unroll
    for (int j = 8; j > 0; j >>= 1)
#pragma unroll
        for (int i = 0; i < 16; ++i) { const int l = i ^ j; if (l > i) CE_D(x[i], x[l]); }
}
__device__ __forceinline__ void top16_merge(float (&a)[16], const float (&b)[16]) {
#pragma unroll
    for (int i = 0; i < 16; ++i) a[i] = fmaxf(a[i], b[15 - i]);
    bmerge16_desc(a);
}
__device__ __forceinline__ float pack_idx(float v, unsigned idx, unsigned mask) { return __builtin_bit_cast(float, (__builtin_bit_cast(unsigned, v) & ~mask) | idx); }

constexpr int TK_KST = 272, TK_KBUF = 128 * TK_KST;
__device__ __forceinline__ void p_topk(const Ctx& C, int l) {
    const bf16_t* Q = (const bf16_t*)(C.ws + WS_Q);
    const bf16_t* keys = (const bf16_t*)(C.ws + WS_W + (size_t)l * W_LAYER + WO_KEYS);
    int* eidx = (int*)(C.ws + WS_EIDX); float* egate = (float*)(C.ws + WS_EGATE);
    LAS unsigned char* lds = C.lds;
    const int lane = C.lane, w = C.wave, r32 = lane & 31, hh = lane >> 5;
    for (int u = C.bid; u < (T / 256) * PH; u += C.G) {
        const int h = u & 7, t0 = (u >> 3) * 256, tok = t0 + 32 * w + r32;
        float v12[2][16];
        __syncthreads();
#pragma unroll
        for (int j = 0; j < 2; ++j) {
            const bf16_t* kp = keys + ((size_t)j * PH + h) * 128 * 128;
#pragma unroll
            for (int p = 0; p < 4; ++p) { const int idx = C.tid + 512 * p, row = idx >> 4, ch = idx & 15;
                *(LAS u32x4*)(lds + j * TK_KBUF + row * TK_KST + ch * 16) = *(const u32x4*)(kp + row * 128 + ch * 8); }
        }
        __syncthreads();
#pragma unroll
        for (int j = 0; j < 2; ++j) {
            bf16x8 qf[8];
            {
                LAS unsigned char* qs = lds + 2 * TK_KBUF + w * (32 * 272);
                u32x4 qr[8];
#pragma unroll
                for (int p = 0; p < 8; ++p) qr[p] = *(const u32x4*)(Q + (size_t)(t0 + 32 * w + 4 * p + (lane >> 4)) * NQ + h * 256 + j * 128 + (lane & 15) * 8);
#pragma unroll
                for (int p = 0; p < 8; ++p) *(LAS u32x4*)(qs + (4 * p + (lane >> 4)) * 272 + (lane & 15) * 16) = qr[p];
#pragma unroll
                for (int ks = 0; ks < 8; ++ks) qf[ks] = *(const LAS bf16x8*)(qs + r32 * 272 + 32 * ks + 16 * hh);
            }
            f32x16 sacc[4];
#pragma unroll
            for (int mt = 0; mt < 4; ++mt)
#pragma unroll
                for (int i = 0; i < 16; ++i) sacc[mt][i] = 0.f;
#pragma unroll
            for (int ks = 0; ks < 8; ++ks)
#pragma unroll
                for (int mt = 0; mt < 4; ++mt) {
                    const bf16x8 kf = *(const LAS bf16x8*)(lds + j * TK_KBUF + (32 * mt + r32) * TK_KST + 32 * ks + 16 * hh);
                    sacc[mt] = MFMA32(kf, qf[ks], sacc[mt]);
                }
            float g[4][16];
#pragma unroll
            for (int mt = 0; mt < 4; ++mt) {
#pragma unroll
                for (int i = 0; i < 16; ++i) g[mt][i] = pack_idx(sacc[mt][i], (unsigned)(32 * mt + (i & 3) + 8 * (i >> 2) + 4 * hh), 127u);
                sort16_desc(g[mt]);
            }
            top16_merge(g[0], g[1]); top16_merge(g[2], g[3]); top16_merge(g[0], g[2]);
            float o[16];
#pragma unroll
            for (int i = 0; i < 16; ++i) o[i] = __shfl_xor(g[0][i], 32, 64);
            top16_merge(g[0], o);
#pragma unroll
            for (int i = 0; i < 16; ++i) v12[j][i] = g[0][i];
        }
        float c[4][16];
        {
            int n = 0;
#pragma unroll
            for (int a = 0; a < 16; ++a)
#pragma unroll
                for (int b = 0; b < 16; ++b) if ((a + 1) * (b + 1) <= 16) {
                    const unsigned id = ((__builtin_bit_cast(unsigned, v12[0][a]) & 127u) << 7) | (__builtin_bit_cast(unsigned, v12[1][b]) & 127u);
                    c[n >> 4][n & 15] = pack_idx(v12[0][a] + v12[1][b], id, 16383u); ++n; }
#pragma unroll
            for (; n < 64; ++n) c[n >> 4][n & 15] = -3.0e38f;
        }
        sort16_desc(c[1]); sort16_desc(c[2]); CE_D(c[3][0], c[3][1]);
        top16_merge(c[0], c[1]); top16_merge(c[2], c[3]); top16_merge(c[0], c[2]);
        float e[16], den = 0.f;
#pragma unroll
        for (int i = 0; i < 16; ++i) { e[i] = __expf(c[0][i] - c[0][0]); den += e[i]; }
        const float inv = 1.f / den;
        int* ip = eidx + (size_t)tok * 128 + h * 16 + 8 * hh; float* gp = egate + (size_t)tok * 128 + h * 16 + 8 * hh;
        u32x4 i0, i1; f32x4 g0, g1;
#pragma unroll
        for (int i = 0; i < 4; ++i) {
            const float ca = hh ? c[0][8 + i] : c[0][i], cb = hh ? c[0][12 + i] : c[0][4 + i];
            i0[i] = __builtin_bit_cast(unsigned, ca) & 16383u; i1[i] = __builtin_bit_cast(unsigned, cb) & 16383u;
            g0[i] = (hh ? e[8 + i] : e[i]) * inv; g1[i] = (hh ? e[12 + i] : e[4 + i]) * inv;
        }
        *(u32x4*)ip = i0; *(u32x4*)(ip + 4) = i1; *(f32x4*)gp = g0; *(f32x4*)(gp + 4) = g1;
    }
}

constexpr int CW_DIAG = 64;
__device__ __forceinline__ void diag_cmp(const Ctx& C, const bf16_t* A, int lda, const bf16_t* R, int ldr, int nc) {
    float sd = 0.f, sr = 0.f;
    for (int row = C.bid; row < T; row += C.G) {
        const int tm = row % DIAG_MOD; if (tm < DIAG_LO || tm >= DIAG_HI) continue;
        for (int c = C.tid; c < nc; c += 512) { const float a = bf2f(A[(size_t)row * lda + c]), r = bf2f(R[(size_t)row * ldr + c]); sd += (a - r) * (a - r); sr += r * r; }
    }
    sd = wave_sum(sd); sr = wave_sum(sr);
    if (C.lane == 0) { atomicAdd((float*)(C.ws + WS_CTL) + CW_DIAG, sd); atomicAdd((float*)(C.ws + WS_CTL) + CW_DIAG + 1, sr); }
}
__device__ __forceinline__ void diag_cmp_u8(const Ctx& C, const unsigned char* A, int lda, const bf16_t* R, int ldr, int nc) {
    float sd = 0.f, sr = 0.f;
    for (int row = C.bid; row < T; row += C.G)
        for (int c = C.tid; c < nc; c += 512) { const float a = (float)A[(size_t)row * lda + c] * (1.f / 255.f), r = bf2f(R[(size_t)row * ldr + c]); sd += (a - r) * (a - r); sr += r * r; }
    sd = wave_sum(sd); sr = wave_sum(sr);
    if (C.lane == 0) { atomicAdd((float*)(C.ws + WS_CTL) + CW_DIAG, sd); atomicAdd((float*)(C.ws + WS_CTL) + CW_DIAG + 1, sr); }
}
__device__ __forceinline__ float diag_alpha(const Ctx& C) {
    const float sd = __hip_atomic_load((float*)(C.ws + WS_CTL) + CW_DIAG, __ATOMIC_RELAXED, __HIP_MEMORY_SCOPE_AGENT), sr = __hip_atomic_load((float*)(C.ws + WS_CTL) + CW_DIAG + 1, __ATOMIC_RELAXED, __HIP_MEMORY_SCOPE_AGENT);
    const float err = fmaxf(sd / fmaxf(sr, 1e-30f), 1e-8f);
    return 0.1f + 0.1f * (rintf(log10f(err / 1e-8f) * 10.f) * 0.1f);
}


#if DIAG == 5 || DIAG == 6
__device__ __forceinline__ void diag_ref_slice(const Ctx& C, const float* W, int ldw, int n0, const float* bias) {
    bf16_t* alt = (bf16_t*)(C.ws + WS_XA);
    const float* X = C.in[I_X];
    for (int row = C.bid * 8 + C.wave; row < T; row += C.G * 8) {
        float acc = 0.f;
        for (int k = 0; k < DM; ++k) acc += X[(size_t)row * DM + k] * W[(size_t)k * ldw + n0 + C.lane];
        if (bias) acc = sigmoidf_(acc + bias[n0 + C.lane]);
        alt[(size_t)row * 64 + C.lane] = (bf16_t)f2bf(acc);
    }
}
#endif

__device__ __forceinline__ void wave_argmax(float& v, int& i) {
#pragma unroll
    for (int o = 32; o > 0; o >>= 1) {
        const float ov = __shfl_xor(v, o, 64); const int oi = __shfl_xor(i, o, 64);
        if (ov > v || (ov == v && oi < i)) { v = ov; i = oi; }
    }
}
__device__ __forceinline__ void p_topk_naive(const Ctx& C, int l) {
    const bf16_t* Q = (const bf16_t*)(C.ws + WS_Q);
    const bf16_t* keys = (const bf16_t*)(C.ws + WS_W + (size_t)l * W_LAYER + WO_KEYS);
    int* eidx = (int*)(C.ws + WS_EIDX); float* egate = (float*)(C.ws + WS_EGATE);
    LAS float* qs = (LAS float*)C.lds;
    LAS float* sc = qs + 2048;
    LAS float* tv = sc + 2048;
    LAS int* ti = (LAS int*)(tv + 256);
    for (int t = C.bid; t < T; t += C.G) {
        for (int i = C.tid; i < 2048; i += 512) qs[i] = bf2f(Q[(size_t)t * NQ + i]);
        __syncthreads();
        for (int i = 0; i < 4; ++i) {
            const int idx = C.tid + 512 * i, hj = idx >> 7, key = idx & 127, h = hj >> 1, j = hj & 1;
            const bf16_t* kp = keys + (((size_t)j * PH + h) * 128 + key) * 128;
            float s = 0.f;
            for (int d8 = 0; d8 < 16; ++d8) {
                const u32x4 raw = *(const u32x4*)(kp + d8 * 8);
#pragma unroll
                for (int e = 0; e < 4; ++e) s += qs[h * 256 + j * 128 + d8 * 8 + 2 * e] * bf2f(raw[e] & 0xffffu) + qs[h * 256 + j * 128 + d8 * 8 + 2 * e + 1] * bf2f(raw[e] >> 16);
            }
            sc[idx] = s;
        }
        __syncthreads();
        for (int i = 0; i < 2; ++i) {
            const int hj = C.wave * 2 + i;
            float a0 = sc[hj * 128 + C.lane], a1 = sc[hj * 128 + 64 + C.lane];
            for (int r = 0; r < 16; ++r) {
                float bv; int bi;
                if (a0 > a1 || (a0 == a1)) { bv = a0; bi = C.lane; } else { bv = a1; bi = C.lane + 64; }
                wave_argmax(bv, bi);
                if (C.lane == 0) { tv[hj * 16 + r] = bv; ti[hj * 16 + r] = bi; }
                if (bi == C.lane) a0 = -3e38f; if (bi == C.lane + 64) a1 = -3e38f;
            }
        }
        __syncthreads();
        {
            const int h = C.wave;
            float cv[4];
#pragma unroll
            for (int i = 0; i < 4; ++i) { const int c = C.lane * 4 + i; cv[i] = tv[(h * 2) * 16 + (c >> 4)] + tv[(h * 2 + 1) * 16 + (c & 15)]; }
            float topv = 0.f; int tope = 0; float mx = 0.f;
            for (int r = 0; r < 16; ++r) {
                float bv = cv[0]; int bi = C.lane * 4;
#pragma unroll
                for (int i = 1; i < 4; ++i) if (cv[i] > bv) { bv = cv[i]; bi = C.lane * 4 + i; }
                wave_argmax(bv, bi);
                if (r == 0) mx = bv;
                if (C.lane == r) { topv = bv; tope = ti[(h * 2) * 16 + (bi >> 4)] * 128 + ti[(h * 2 + 1) * 16 + (bi & 15)]; }
#pragma unroll
                for (int i = 0; i < 4; ++i) if (bi == C.lane * 4 + i) cv[i] = -3e38f;
            }
            float e = (C.lane < 16) ? __expf(topv - mx) : 0.f;
            const float den = wave_sum(e);
            if (C.lane < 16) { eidx[(size_t)t * 128 + h * 16 + C.lane] = tope; egate[(size_t)t * 128 + h * 16 + C.lane] = e / den; }
        }
        __syncthreads();
    }
}
__device__ __forceinline__ float ub(unsigned w, int e) { return (float)((w >> (8 * e)) & 255u); }
__device__ __forceinline__ void p_gather(const Ctx& C, int l) {
    const bf16_t* xc = (const bf16_t*)(C.ws + WS_X1B);
    const unsigned char* U8 = C.ws + WS_U8; const unsigned char* V8 = C.ws + WS_V8;
    const float* SU = (const float*)(C.ws + WS_SU); const float* SV = (const float*)(C.ws + WS_SV);
    const int* eidx = (const int*)(C.ws + WS_EIDX); const float* egate = (const float*)(C.ws + WS_EGATE);
    const int lane = C.lane;
    for (int t = C.bid * 8 + C.wave; t < T; t += C.G * 8) {
        float x[16];
        { const bf16_t* xp = xc + (size_t)t * DM + lane * 16;
          const u32x4 a = *(const u32x4*)xp, b = *(const u32x4*)(xp + 8);
#pragma unroll
          for (int i = 0; i < 4; ++i) { x[2 * i] = bf2f(a[i] & 0xffffu); x[2 * i + 1] = bf2f(a[i] >> 16); x[8 + 2 * i] = bf2f(b[i] & 0xffffu); x[9 + 2 * i] = bf2f(b[i] >> 16); } }
        float xmx = 0.f;
#pragma unroll
        for (int j = 0; j < 16; ++j) xmx = fmaxf(xmx, fabsf(x[j]));
        xmx = fmaxf(wave_max(xmx), 1e-30f);
        const float xisc = 127.f / xmx, xsc = xmx * (1.f / 127.f);
        int xq[4];
#pragma unroll
        for (int q = 0; q < 4; ++q) { unsigned wd = 0u;
#pragma unroll
            for (int e = 0; e < 4; ++e) wd |= ((unsigned)(int)rintf(x[4 * q + e] * xisc) & 255u) << (8 * e);
            xq[q] = (int)wd; }
        float cf[2]; int ex[2];
#pragma unroll
        for (int bt = 0; bt < 2; ++bt) {
            ex[bt] = eidx[(size_t)t * 128 + 64 * bt + lane];
            const float gate = egate[(size_t)t * 128 + 64 * bt + lane];
            int p[64];
#pragma unroll
            for (int e0 = 0; e0 < 64; e0 += 16) {
                u32x4 r[16];
#pragma unroll
                for (int i = 0; i < 16; ++i) { const int e = __builtin_amdgcn_readlane(ex[bt], e0 + i); r[i] = *(const u32x4*)(U8 + (size_t)e * DM + lane * 16); }
#pragma unroll
                for (int i = 0; i < 16; ++i) { int a = 0;
#pragma unroll
                    for (int q = 0; q < 4; ++q) a = __builtin_amdgcn_sdot4(xq[q], (int)r[i][q], a, false);
                    p[e0 + i] = a; }
            }
#pragma unroll
            for (int st = 32, n = 32; st > 0; st >>= 1, n >>= 1) {
                const bool up = (lane & st) != 0;
#pragma unroll
                for (int i = 0; i < n; ++i) { const int send = up ? p[i] : p[i + n], keep = up ? p[i + n] : p[i]; p[i] = keep + __shfl_xor(send, st, 64); }
            }
            const float hsum = SU[ex[bt]] * xsc * (float)p[0];
            cf[bt] = gate * geluf_slow(hsum) * SV[ex[bt]];
        }
        float y[16];
#pragma unroll
        for (int j = 0; j < 16; ++j) y[j] = 0.f;
        float csum = wave_sum(cf[0] + cf[1]);
#pragma unroll
        for (int bt = 0; bt < 2; ++bt)
#pragma unroll
            for (int e0 = 0; e0 < 64; e0 += 16) {
                u32x4 r[16];
#pragma unroll
                for (int i = 0; i < 16; ++i) { const int e = __builtin_amdgcn_readlane(ex[bt], e0 + i); r[i] = *(const u32x4*)(V8 + (size_t)e * DM + lane * 16); }
#pragma unroll
                for (int i = 0; i < 16; ++i) { const float c = __builtin_bit_cast(float, __builtin_amdgcn_readlane(__builtin_bit_cast(int, cf[bt]), e0 + i));
#pragma unroll
                    for (int q = 0; q < 4; ++q)
#pragma unroll
                        for (int e = 0; e < 4; ++e) y[4 * q + e] += c * ub(r[i][q], e); }
            }
#pragma unroll
        for (int j = 0; j < 16; ++j) y[j] = y[j] - 128.f * csum + ALPHA * x[j];
        float sm = 0.f;
#pragma unroll
        for (int j = 0; j < 16; ++j) sm += y[j];
        const float mean = wave_sum(sm) * (1.f / DM);
        float qq = 0.f;
#pragma unroll
        for (int j = 0; j < 16; ++j) { const float d = y[j] - mean; qq += d * d; }
        const float rstd = rsqrtf(wave_sum(qq) * (1.f / DM) + LN_EPS);
        const float* gp = C.in[I_LN2G] + l * DM + lane * 16; const float* bp = C.in[I_LN2B] + l * DM + lane * 16;
#pragma unroll
        for (int i = 0; i < 4; ++i) { const f32x4 gg = *(const f32x4*)(gp + 4 * i), bb = *(const f32x4*)(bp + 4 * i);
#pragma unroll
            for (int e = 0; e < 4; ++e) y[4 * i + e] = (y[4 * i + e] - mean) * rstd * gg[e] + bb[e]; }
        float* dst = (l + 1 < DEPTH) ? (float*)(C.ws + WS_XA) + (size_t)t * DM : C.out + (size_t)t * DM;
#if DIAG
        if (l + 1 == DEPTH) { const float al = 1.f + diag_alpha(C);
#pragma unroll
            for (int j = 0; j < 16; ++j) y[j] *= al; }
#endif
#pragma unroll
        for (int i = 0; i < 4; ++i) *(f32x4*)(dst + lane * 16 + 4 * i) = (f32x4){y[4 * i], y[4 * i + 1], y[4 * i + 2], y[4 * i + 3]};
        if (l + 1 < DEPTH) {
            {
                float mx = 0.f;
#pragma unroll
                for (int j = 0; j < 16; ++j) mx = fmaxf(mx, fabsf(y[j]));
                mx = fmaxf(wave_max(mx), 1e-30f);
                const float isc = 127.f / mx;
                u32x4 o8;
#pragma unroll
                for (int q = 0; q < 4; ++q) { unsigned wd = 0u;
#pragma unroll
                    for (int e = 0; e < 4; ++e) wd |= ((unsigned)(int)rintf(y[4 * q + e] * isc) & 255u) << (8 * e);
                    o8[q] = wd; }
                *(u32x4*)(C.ws + WS_XB + (size_t)t * DM + lane * 16) = o8;
                if (lane == 0) ((float*)(C.ws + WS_XSA))[t] = mx * (1.f / 127.f);
            }
            const float* wf = (const float*)(C.ws + WS_W + (size_t)(l + 1) * W_LAYER + WO_WF);
            float* lsig = (float*)(C.ws + WS_MISC);
#pragma unroll
            for (int h = 0; h < 4; ++h) {
                float sd = 0.f;
#pragma unroll
                for (int i = 0; i < 4; ++i) { const f32x4 a = *(const f32x4*)(wf + h * DM + lane * 16 + 4 * i);
#pragma unroll
                    for (int e = 0; e < 4; ++e) sd += y[4 * i + e] * a[e]; }
                sd = wave_sum(sd);
                if (lane == 0) lsig[(size_t)t * 4 + h] = logsigmoidf_(sd + C.in[I_BFOX][(l + 1) * 4 + h]);
            }
        }
    }
}

struct FStoreBf16 { bf16_t* O; int ld;
    __device__ __forceinline__ void operator()(int row, int col, f32x4 v0, f32x4 v1, int) const {
        u32x4 o; o[0] = pk2(v0[0], v0[1]); o[1] = pk2(v0[2], v0[3]); o[2] = pk2(v1[0], v1[1]); o[3] = pk2(v1[2], v1[3]);
        *(u32x4*)(O + (size_t)row * ld + col) = o; } };
typedef int i32x4 __attribute__((ext_vector_type(4)));
__device__ __forceinline__ void i8_dequant(f32x4& v0, f32x4& v1, float sa, const float* cs) {
    sa *= (1.f / 127.f);
    const f32x4 c0 = *(const f32x4*)cs, c1 = *(const f32x4*)(cs + 4);
    const i32x4 i0 = __builtin_bit_cast(i32x4, v0), i1 = __builtin_bit_cast(i32x4, v1);
#pragma unroll
    for (int e = 0; e < 4; ++e) { v0[e] = (float)i0[e] * sa * c0[e]; v1[e] = (float)i1[e] * sa * c1[e]; }
}
struct FStoreBf16I8 { bf16_t* O; int ld; const float* rs; const float* cs;
    __device__ __forceinline__ void operator()(int row, int col, f32x4 v0, f32x4 v1, int) const {
        i8_dequant(v0, v1, rs[row], cs + col);
        u32x4 o; o[0] = pk2(v0[0], v0[1]); o[1] = pk2(v0[2], v0[3]); o[2] = pk2(v1[0], v1[1]); o[3] = pk2(v1[2], v1[3]);
        *(u32x4*)(O + (size_t)row * ld + col) = o; } };
struct FGateI8 { unsigned char* O; const float* bias; const float* rs; const float* cs;
    __device__ __forceinline__ void operator()(int row, int col, f32x4 v0, f32x4 v1, int) const {
        const float sa = rs[row] * (-1.4426950408889634f / 127.f);
        const f32x4 c0 = *(const f32x4*)(cs + col), c1 = *(const f32x4*)(cs + col + 4);
        const f32x4 b0 = *(const f32x4*)(bias + col), b1 = *(const f32x4*)(bias + col + 4);
        const i32x4 i0 = __builtin_bit_cast(i32x4, v0), i1 = __builtin_bit_cast(i32x4, v1);
        u32x2 o; unsigned w0 = 0u, w1 = 0u;
#pragma unroll
        for (int e = 0; e < 4; ++e) {
            const float e0 = __builtin_amdgcn_exp2f(__builtin_fmaf((float)i0[e] * sa, c0[e], -1.4426950408889634f * b0[e])), e1 = __builtin_amdgcn_exp2f(__builtin_fmaf((float)i1[e] * sa, c1[e], -1.4426950408889634f * b1[e]));
            const unsigned q0 = max((unsigned)__builtin_fmaf(__builtin_amdgcn_rcpf(1.f + e0), 255.f, 0.5f), 1u), q1 = max((unsigned)__builtin_fmaf(__builtin_amdgcn_rcpf(1.f + e1), 255.f, 0.5f), 1u);
            w0 |= q0 << (8 * e); w1 |= q1 << (8 * e); }
        o[0] = w0; o[1] = w1;
        *(u32x2*)(O + (size_t)row * NG + col) = o; } };
struct FGate { bf16_t* O; const float* bias;
    __device__ __forceinline__ void operator()(int row, int col, f32x4 v0, f32x4 v1, int) const {
        const f32x4 b0 = *(const f32x4*)(bias + col), b1 = *(const f32x4*)(bias + col + 4);
        u32x4 o; o[0] = pk2(sigmoidf_(v0[0] + b0[0]), sigmoidf_(v0[1] + b0[1])); o[1] = pk2(sigmoidf_(v0[2] + b0[2]), sigmoidf_(v0[3] + b0[3]));
        o[2] = pk2(sigmoidf_(v1[0] + b1[0]), sigmoidf_(v1[1] + b1[1])); o[3] = pk2(sigmoidf_(v1[2] + b1[2]), sigmoidf_(v1[3] + b1[3]));
        *(u32x4*)(O + (size_t)row * NG + col) = o; } };
struct FMerge { const unsigned char* G; bf16_t* MG;
    __device__ __forceinline__ void operator()(int row, int col, f32x4 v0, f32x4 v1, int z) const {
        const u32x2 gr = *(const u32x2*)(G + (size_t)row * NG + z * DM + col);
        float r[8];
#pragma unroll
        for (int e = 0; e < 4; ++e) { r[e] = v0[e] * (float)((gr[0] >> (8 * e)) & 255u) * (1.f / 255.f); r[4 + e] = v1[e] * (float)((gr[1] >> (8 * e)) & 255u) * (1.f / 255.f); }
        bf16_t* p = MG + (size_t)row * DM + col;
        if (z > 0) { const u32x4 pr = *(const u32x4*)p;
#pragma unroll
            for (int e = 0; e < 4; ++e) { r[2 * e] += bf2f(pr[e] & 0xffffu); r[2 * e + 1] += bf2f(pr[e] >> 16); } }
        u32x4 o;
#pragma unroll
        for (int e = 0; e < 4; ++e) o[e] = pk2(r[2 * e], r[2 * e + 1]);
        *(u32x4*)p = o; } };
struct FResid { const float* X; bf16_t* Y;
    __device__ __forceinline__ void operator()(int row, int col, f32x4 v0, f32x4 v1, int) const {
        const f32x4 x0 = *(const f32x4*)(X + (size_t)row * DM + col), x1 = *(const f32x4*)(X + (size_t)row * DM + col + 4);
#if DIAG == 5 || DIAG == 6
        v0 = (f32x4){0.f, 0.f, 0.f, 0.f}; v1 = v0;
#endif
        u32x4 o; o[0] = cvtpk(x0[0] * ALPHA + v0[0], x0[1] * ALPHA + v0[1]); o[1] = cvtpk(x0[2] * ALPHA + v0[2], x0[3] * ALPHA + v0[3]);
        o[2] = cvtpk(x1[0] * ALPHA + v1[0], x1[1] * ALPHA + v1[1]); o[3] = cvtpk(x1[2] * ALPHA + v1[2], x1[3] * ALPHA + v1[3]);
        *(u32x4*)(Y + (size_t)row * DM + col) = o; } };

constexpr int PH_PER_LAYER = 12, N_PHASES = 1 + DEPTH * PH_PER_LAYER;
template <int SP> __device__ __forceinline__ void run_phase(const Ctx& C0, int l) {
    Ctx C = C0;
    asm volatile("" : "+v"(C.tid));
    C.ws = launder_ptr(C.ws); C.out = launder_ptr(C.out); l = (int)launder_u((unsigned)l);
    C.lane = C.tid & 63; C.wave = __builtin_amdgcn_readfirstlane(C.tid >> 6);
    unsigned char* wb = C.ws + WS_W + (size_t)l * W_LAYER;
    if constexpr (SP == -1) { p_conv_weights(C); p_rowpass0(C); }
    if constexpr (SP == 1) {
        p_cumsum(C);
        __syncthreads();
        pg8::Gemm g{(const bf16_t*)(C.ws + WS_XB), (const bf16_t*)(wb + WO_WIN), DM, DM, DM, 0, 0};
        pg8::StaticOrder S; S.init(T, NH, C.G, C.bid);
        pg8::Epi8<FStoreBf16I8> E{{(bf16_t*)(C.ws + WS_H), NH, (const float*)(C.ws + WS_XSA), (const float*)(C.ws + WS_CMAX) + l * (NH + NG)}};
        pg8::gemm_phase<pg8::Epi8<FStoreBf16I8>, pg8::StaticOrder, true>(C.lds, g, S, E, C.tid);
    }
#if DIAG == 5
    if constexpr (SP == 2) { if (l == 0) { diag_ref_slice(C, C.in[I_WIN], NIN, DIAG_N0, nullptr); } }
    if constexpr (SP == 3) { if (l == 0) diag_cmp(C, (const bf16_t*)(C.ws + WS_H) + DIAG_N0, NH, (const bf16_t*)(C.ws + WS_XA), 64, 64); }
#endif
#if DIAG == 6
    if constexpr (SP == 5) { if (l == 0) diag_ref_slice(C, C.in[I_WGATE], NG, DIAG_N0, C.in[I_BGATE]); }
    if constexpr (SP == 6) { if (l == 0) diag_cmp_u8(C, C.ws + WS_G + DIAG_N0, NG, (const bf16_t*)(C.ws + WS_XA), 64, 64); }
#endif
    if constexpr (SP == 2) { p_knorm(C, l); if (l != HG_NAIVE_L) hgrn_b1(C, l); }
#if MIX_NAIVE
    if constexpr (SP == 3) { if (l != HG_NAIVE_L) hgrn_b2(C); mix_pool_naive(C, l); mix_gmlp_naive(C, l); }
#else
    if constexpr (SP == 3) { if (l != HG_NAIVE_L) hgrn_b2(C); mix_pool(C, l); mix_gmlp(C, l);
        if (DIAG == 2) mix_pool_naive(C, l); if (DIAG == 3) mix_gmlp_naive(C, l); }
#endif
#if DIAG == 1
    if constexpr (SP == 4) { hgrn_b3(C, l); { mix_hgrn_naive(C, l); __syncthreads(); } mix_fox(C, l); }
    if constexpr (SP == 5) { if (l == DIAG_LAYER) diag_cmp(C, (const bf16_t*)(C.ws + (DIAG_LAYER == 0 ? WS_XA : WS_TABU)) + 512, NBR, (const bf16_t*)(C.ws + WS_BR) + 512, NBR, 512); }
#elif DIAG == 2 || DIAG == 3
    if constexpr (SP == 4) { hgrn_b3(C, l); mix_fox(C, l); if (l == DIAG_LAYER) diag_cmp(C, (const bf16_t*)(C.ws + (DIAG_LAYER == 0 ? WS_XA : WS_TABU)) + (DIAG == 2 ? 0 : 1024), NBR, (const bf16_t*)(C.ws + WS_BR) + (DIAG == 2 ? 0 : 1024), NBR, 512); }
#else
    if constexpr (SP == 4) { if (l != HG_NAIVE_L) hgrn_b3(C, l); else { mix_hgrn_naive(C, l); __syncthreads(); } mix_fox(C, l); }
#endif
    if constexpr (SP == 5) {
        pg8::Gemm g{(const bf16_t*)(C.ws + WS_XB), (const bf16_t*)(wb + WO_WG), DM, DM, DM, 0, 0};
        pg8::StaticOrder S; S.init(T, NG, C.G, C.bid);
        pg8::Epi8<FGateI8> E{{C.ws + WS_G, C.in[I_BGATE] + l * NG, (const float*)(C.ws + WS_XSA), (const float*)(C.ws + WS_CMAX) + l * (NH + NG) + NH}};
        pg8::gemm_phase<pg8::Epi8<FGateI8>, pg8::StaticOrder, true>(C.lds, g, S, E, C.tid);
    }
    if constexpr (SP == 6) {
        pg8::Gemm g{(const bf16_t*)(C.ws + WS_BR), (const bf16_t*)(wb + WO_WBR), NBR, BW, BW, (size_t)BW, (size_t)DM * BW};
        pg8::ZOrder S; S.init(T, DM, 4, C.G, C.vcu);
        pg8::EpiMerge E{C.ws + WS_G, (bf16_t*)(C.ws + WS_XB)};
        pg8::gemm_phase(C.lds, g, S, E, C.tid);
    }
    if constexpr (SP == 7) {
        const float* xin = (l == 0) ? C.in[I_X] : (const float*)(C.ws + WS_XA);
        pg8::Gemm g{(const bf16_t*)(C.ws + WS_XB), (const bf16_t*)(wb + WO_WOUT), DM, DM, DM, 0, 0};
        pg8::StaticOrder S; S.init(T, DM, C.G, C.bid);
        pg8::Epi8<FResid> E{{xin, (bf16_t*)(C.ws + WS_XC)}};
        pg8::gemm_phase(C.lds, g, S, E, C.tid);
    }
    if constexpr (SP == 8) { p_ln1(C, l); p_conv_tables(C, l); }
    if constexpr (SP == 9) {
        pg8::Gemm g{(const bf16_t*)(C.ws + WS_X1B), (const bf16_t*)(wb + WO_WQ), DM, DM, DM, 0, 0};
        pg8::StaticOrder S; S.init(T, NQ, C.G, C.bid);
        pg8::Epi8<FStoreBf16> E{{(bf16_t*)(C.ws + WS_Q), NQ}};
        pg8::gemm_phase(C.lds, g, S, E, C.tid);
    }
#if TOPK_NAIVE
    if constexpr (SP == 10) p_topk_naive(C, l);
#else
    if constexpr (SP == 10) p_topk(C, l);
#endif
    if constexpr (SP == 11) p_gather(C, l);
}
__device__ __forceinline__ void make_ctx(Ctx& C, const Args& args, unsigned char* lds_raw) {
    C.lds = (LAS unsigned char*)lds_raw; C.ws = args.ws; C.in = args.in; C.out = args.out;
    C.tid = threadIdx.x; C.lane = C.tid & 63; C.wave = __builtin_amdgcn_readfirstlane(C.tid >> 6);
    C.G = gridDim.x; C.bid = blockIdx.x; C.vcu = (C.G % 8 == 0) ? (C.bid % 8) * (C.G / 8) + C.bid / 8 : C.bid;
}
#if !MK_ONE_LAUNCH
template <int SP> __global__ void __launch_bounds__(512, 2) mk_phase(Args args) {
    extern __shared__ __attribute__((aligned(16))) unsigned char lds_raw[];
    Ctx C; make_ctx(C, args, lds_raw);
    run_phase<SP>(C, args.ph_lo);
}
#endif

#define GRID_BAR() xcd_barrier((unsigned*)(args.ws + WS_CTL) + 1024, (volatile LAS unsigned*)((LAS unsigned char*)lds_raw + LDSCTL_OFF + 32))
__global__ void __launch_bounds__(512, 2) mk_fwd(Args args) {
    extern __shared__ __attribute__((aligned(16))) unsigned char lds_raw[];
    Ctx C; make_ctx(C, args, lds_raw);
    { volatile LAS unsigned* misc = (volatile LAS unsigned*)(C.lds + LDSCTL_OFF); if (C.tid < 64) misc[C.tid] = 0u; }
    __syncthreads();
    xcd_barrier_post((unsigned*)(args.ws + WS_CTL) + 1024);
    run_phase<-1>(C, 0); GRID_BAR();
#pragma unroll 1
    for (int l = 0; l < DEPTH; ++l) {
        run_phase<1>(C, l); GRID_BAR();
        run_phase<2>(C, l); GRID_BAR();
        run_phase<3>(C, l); GRID_BAR();
        run_phase<4>(C, l); GRID_BAR();
        run_phase<5>(C, l); GRID_BAR();
        run_phase<6>(C, l); GRID_BAR();
        run_phase<7>(C, l); GRID_BAR();
        run_phase<8>(C, l); GRID_BAR();
        run_phase<9>(C, l); GRID_BAR();
        run_phase<10>(C, l); GRID_BAR();
        run_phase<11>(C, l); if (l + 1 < DEPTH) GRID_BAR();
    }
}

#if !MK_ONE_LAUNCH
template <int SP> static void launch_phase(const Args& a, int grid, hipStream_t stream) {
    static bool attr_done = false;
    if (!attr_done) { (void)hipFuncSetAttribute((const void*)mk_phase<SP>, hipFuncAttributeMaxDynamicSharedMemorySize, LDS_BYTES); attr_done = true; }
    hipLaunchKernelGGL(mk_phase<SP>, dim3(grid), dim3(512), LDS_BYTES, stream, a);
}
#endif
extern "C" void kernel_launch(void* const* d_in, const int* in_sizes, int n_in, void* d_out, int out_size, void* d_ws, size_t ws_size, hipStream_t stream) {
    static int grid = 0;
    if (grid == 0) {
        if (n_in != NIN_PTRS || out_size != T * DM || ws_size < WS_END) { fprintf(stderr, "kernel_launch: unexpected shapes n_in %d out %d ws %zu\n", n_in, out_size, ws_size); grid = -1; return; }
        int dev = 0, cus = 0;
        if (hipGetDevice(&dev) != hipSuccess || hipDeviceGetAttribute(&cus, hipDeviceAttributeMultiprocessorCount, dev) != hipSuccess) { grid = -1; return; }
        grid = cus;
    }
    if (grid < 0) return;
    (void)hipMemsetAsync((char*)d_ws + WS_CTL, 0, CTL_ZERO_BYTES, stream);
    Args a{};
    for (int i = 0; i < NIN_PTRS; ++i) a.in[i] = (const float*)d_in[i];
    a.out = (float*)d_out; a.ws = (unsigned char*)d_ws; a.bar_slot = 0; a.pad = 0; a.ph_hi = 0;
#if MK_ONE_LAUNCH
    static bool attr_done = false;
    if (!attr_done) { (void)hipFuncSetAttribute((const void*)mk_fwd, hipFuncAttributeMaxDynamicSharedMemorySize, LDS_BYTES); attr_done = true; }
    hipLaunchKernelGGL(mk_fwd, dim3(grid), dim3(512), LDS_BYTES, stream, a);
    return;
#endif
#if !MK_ONE_LAUNCH
    a.ph_lo = 0; launch_phase<-1>(a, grid, stream);
    for (int l = 0; l < DEPTH; ++l) {
        a.ph_lo = l;
        launch_phase<0>(a, grid, stream); launch_phase<1>(a, grid, stream); launch_phase<2>(a, grid, stream); launch_phase<3>(a, grid, stream); launch_phase<4>(a, grid, stream);
        launch_phase<5>(a, grid, stream); launch_phase<6>(a, grid, stream); launch_phase<7>(a, grid, stream); launch_phase<8>(a, grid, stream); launch_phase<9>(a, grid, stream); launch_phase<10>(a, grid, stream); launch_phase<11>(a, grid, stream);
    }
#endif
}
```

```cpp
#include <hip/hip_runtime.h>
#include <cstdio>
#include <cstdint>

#ifndef DIAG
#define DIAG 0
#endif
#ifndef DIAG_LO
#define DIAG_LO 0
#endif
#ifndef DIAG_HI
#define DIAG_HI 64
#endif
#ifndef DIAG_MOD
#define DIAG_MOD 64
#endif
#ifndef TOPK_NAIVE
#define TOPK_NAIVE 0
#endif
#ifndef MIX_NAIVE
#define MIX_NAIVE 0
#endif
#ifndef DIAG_N0
#define DIAG_N0 4096
#endif
#ifndef FOX_NAIVE
#define FOX_NAIVE 0
#endif
#ifndef HG_NAIVE_L
#define HG_NAIVE_L 99
#endif
#ifndef DIAG_LAYER
#define DIAG_LAYER 0
#endif
#ifndef MK_ONE_LAUNCH
#define MK_ONE_LAUNCH 1
#endif

#define LAS __attribute__((address_space(3)))
#define GAS __attribute__((address_space(1)))
typedef unsigned short bf16_t;
typedef short bf16x8 __attribute__((ext_vector_type(8)));
typedef float f32x4 __attribute__((ext_vector_type(4)));
typedef float f32x2 __attribute__((ext_vector_type(2)));
typedef unsigned u32x4 __attribute__((ext_vector_type(4)));
typedef unsigned u32x2 __attribute__((ext_vector_type(2)));

constexpr int DM = 1024, BATCH = 2, SEQ = 8192, DEPTH = 2, T = BATCH * SEQ;
constexpr int BW = 512, NIN = 5124, NH = 5120, NG = 4096, NBR = 2048, NQ = 2048;
constexpr int NEXP = 16384, TOPK = 16, PH = 8;
constexpr float ALPHA = 1.4142135623730951f;
constexpr float LN_EPS = 1e-5f, RMS_EPS = 1e-6f;
constexpr int HC_P = 0, HC_HQ = 512, HC_HF = 1024, HC_HI = 1536, HC_HG = 2048, HC_GU = 2560, HC_GV = 3072, HC_FQ = 3584, HC_FK = 4096, HC_FV = 4608;

constexpr size_t MiB = 1u << 20;
constexpr size_t WS_CTL = 0, CTL_ZERO_BYTES = 160 * 1024;
constexpr size_t WS_CMAX = 64 * 1024;
constexpr size_t WS_MISC = 512 * 1024;
constexpr size_t WS_CUM = 768 * 1024;
constexpr size_t WS_W = 1 * MiB;
constexpr size_t W_LAYER = 30 * MiB;
constexpr size_t WO_WIN = 0, WO_WG = 10 * MiB, WO_WBR = 18 * MiB, WO_WOUT = 22 * MiB, WO_WQ = 24 * MiB, WO_KEYS = 28 * MiB, WO_WF = 28 * MiB + 512 * 1024, WO_POOLW = 28 * MiB + 768 * 1024, WO_GWS = 29 * MiB, WO_CS = 29 * MiB + 512 * 1024;
constexpr size_t WS_TABU = 64 * MiB, WS_TABV = 96 * MiB;
constexpr size_t WS_XA = 128 * MiB;
constexpr size_t WS_XB = 192 * MiB;
constexpr size_t WS_X1B = 224 * MiB;
constexpr size_t WS_H = 256 * MiB;
constexpr size_t WS_ST = 416 * MiB;
constexpr size_t WS_BR = 448 * MiB;
constexpr size_t WS_G = 256 * MiB;
constexpr size_t WS_MGF = 384 * MiB;
constexpr size_t WS_XC = 256 * MiB;
constexpr size_t WS_Q = 320 * MiB;
constexpr size_t WS_EIDX = 384 * MiB, WS_EGATE = 392 * MiB;
constexpr size_t WS_XSA = 256 * 1024;
constexpr size_t WS_END = 512 * MiB;

__device__ __forceinline__ float bf2f(unsigned u) { return __builtin_bit_cast(float, u << 16); }
__device__ __forceinline__ unsigned f2bf(float f) { unsigned u = __builtin_bit_cast(unsigned, f); return (u + 0x7fffu + ((u >> 16) & 1u)) >> 16; }
typedef __bf16 bf16x2_t __attribute__((ext_vector_type(2)));
__device__ __forceinline__ unsigned cvtpk(float lo, float hi) { f32x2 v = {lo, hi}; bf16x2_t b = __builtin_convertvector(v, bf16x2_t); return __builtin_bit_cast(unsigned, b); }
__device__ __forceinline__ unsigned pk2(float lo, float hi) { return cvtpk(lo, hi); }
__device__ __forceinline__ float wave_sum(float v) {
#pragma unroll
    for (int o = 32; o > 0; o >>= 1) v += __shfl_xor(v, o, 64);
    return v;
}
__device__ __forceinline__ float sigmoidf_(float x) { return __builtin_amdgcn_rcpf(1.f + __builtin_amdgcn_exp2f(-1.4426950408889634f * x)); }
__device__ __forceinline__ float siluf_(float x) { return x * __builtin_amdgcn_rcpf(1.f + __builtin_amdgcn_exp2f(-1.4426950408889634f * x)); }
__device__ __forceinline__ float geluf_slow(float x) { const float u = 0.7978845608028654f * (x + 0.044715f * x * x * x); return 0.5f * x * (1.f + tanhf(u)); }
__device__ __forceinline__ float geluf_(float x) { const float u2 = -2.302208198f * (x + 0.044715f * x * x * x); return x * __builtin_amdgcn_rcpf(1.f + __builtin_amdgcn_exp2f(u2)); }
__device__ __forceinline__ float logsigmoidf_(float z) { return fminf(z, 0.f) - log1pf(__expf(-fabsf(z))); }

__device__ __forceinline__ unsigned launder_u(unsigned x) { asm volatile("" : "+v"(x)); return __builtin_amdgcn_readfirstlane(x); }
template <class P> __device__ __forceinline__ P launder_ptr(P p) {
    const unsigned lo = launder_u((unsigned)(uintptr_t)p), hi = launder_u((unsigned)((uintptr_t)p >> 32));
    return (P)(((uintptr_t)hi << 32) | lo);
}

namespace pg8 {
constexpr int BM = 256, BK = 64, HALF = 128, HTB = HALF * BK * 2, STAGE_BYTES = 8 * HTB, NXCD = 8, WGM = 8;
__host__ __device__ __forceinline__ int lds_byte(int r, int c) { const int st = (r >> 4) * 2 + (c >> 5), rr = r & 15, cc = c & 31, ob = rr * 64 + cc * 2; return st * 1024 + (ob ^ (((ob >> 9) & 1) << 5)); }
__host__ __device__ __forceinline__ void stage_rc(int b, int& R, int& C) { const int st = b / 1024, sb = b % 1024, swz = sb ^ (((sb >> 9) & 1) << 5); R = (st >> 1) * 16 + swz / 64; C = (st & 1) * 32 + (swz % 64) / 2; }
__host__ __device__ __forceinline__ int perm32(int rho) { const int n = rho >> 4, i = rho & 15; return 8 * (i >> 2) + 4 * n + (i & 3); }

struct Unit { int pm, pn, z; };
struct Gemm { const bf16_t* A; const bf16_t* Bt; int lda, ldb, K; size_t zA, zB; };

struct StaticOrder {
    int nM, nN, nwg, G, c;
    __device__ void init(int M, int N, int G_, int c_) { nM = M / BM; nN = N / BM; nwg = nM * nN; G = G_; c = c_; }
    __device__ bool next(int i, Unit& u) const {
        const long L = (long)i * G + c; if (L >= nwg) return false;
        int wgid = (int)L; { const int q = nwg / NXCD, r = nwg % NXCD, xcd = wgid % NXCD, off = wgid / NXCD; wgid = (xcd < r ? xcd * (q + 1) : r * (q + 1) + (xcd - r) * q) + off; }
        const int nig = WGM * nN, gid = wgid / nig, fm = gid * WGM, gsz = (nM - fm) < WGM ? (nM - fm) : WGM;
        u.pm = fm + ((wgid % nig) % gsz); u.pn = (wgid % nig) / gsz; u.z = 0; return true;
    }
};
struct ZOrder {
    int nM, nN, nZ, ntile, G, c;
    __device__ void init(int M, int N, int Z, int G_, int c_) { nM = M / BM; nN = N / BM; nZ = Z; ntile = nM * nN; G = G_; c = c_; }
    __device__ bool next(int i, Unit& u) const {
        const long L = (long)(i / nZ) * G + c; if (L >= ntile) return false;
        u.pm = (int)L / nN; u.pn = (int)L % nN; u.z = i % nZ; return true;
    }
};

template <class F> struct Epi8 {
    static constexpr bool PERM = true;
    F f;
    __device__ __forceinline__ bool keep(const Unit&) const { return false; }
    __device__ __forceinline__ void operator()(const f32x4 (&acc)[2][2][4][2], const Unit& u, int wr, int wc, int fr, int fq) const {
        const int row0 = u.pm * BM + wr * 64 + fr, col0 = u.pn * BM + wc * 32 + 8 * fq;
#pragma unroll
        for (int ai = 0; ai < 2; ++ai)
#pragma unroll
            for (int m = 0; m < 4; ++m)
#pragma unroll
                for (int bj = 0; bj < 2; ++bj) f(row0 + ai * HALF + m * 16, col0 + bj * HALF, acc[ai][bj][m][0], acc[ai][bj][m][1], u.z);
    }
};
template <class F> struct Epi4 {
    static constexpr bool PERM = false;
    F f;
    __device__ __forceinline__ bool keep(const Unit&) const { return false; }
    __device__ __forceinline__ void operator()(const f32x4 (&acc)[2][2][4][2], const Unit& u, int wr, int wc, int fr, int fq) const {
        const int row0 = u.pm * BM + wr * 64 + fr, col0 = u.pn * BM + wc * 32 + 4 * fq;
#pragma unroll
        for (int ai = 0; ai < 2; ++ai)
#pragma unroll
            for (int m = 0; m < 4; ++m)
#pragma unroll
                for (int bj = 0; bj < 2; ++bj)
#pragma unroll
                    for (int n = 0; n < 2; ++n) f(row0 + ai * HALF + m * 16, col0 + bj * HALF + n * 16, acc[ai][bj][m][n], u.z);
    }
};

struct EpiMerge {
    static constexpr bool PERM = true;
    const unsigned char* G; bf16_t* MG;
    __device__ __forceinline__ bool keep(const Unit& u) const { return u.z < 3; }
    __device__ __forceinline__ void operator()(f32x4 (&acc)[2][2][4][2], const Unit& u, int wr, int wc, int fr, int fq) const {
        const int row0 = u.pm * BM + wr * 64 + fr, col0 = u.pn * BM + wc * 32 + 8 * fq;
        const unsigned char* gp0 = G + (size_t)row0 * NG + u.z * DM + col0;
        if (u.z < 3) {
#pragma unroll
            for (int ai = 0; ai < 2; ++ai)
#pragma unroll
                for (int m = 0; m < 4; ++m) {
                    if ((m & 1) == 0) asm volatile("" ::: "memory");
#pragma unroll
                    for (int bj = 0; bj < 2; ++bj) {
                        const unsigned char* gp = gp0 + (size_t)(ai * HALF + m * 16) * NG + bj * HALF;
                        const u32x2 ga = *(const u32x2*)gp, gb = *(const u32x2*)(gp + DM);
#pragma unroll
                        for (int n = 0; n < 2; ++n)
#pragma unroll
                            for (int e = 0; e < 4; ++e) {
                                const float qa = (float)((ga[n] >> (8 * e)) & 255u), qb = (float)((gb[n] >> (8 * e)) & 255u);
                                acc[ai][bj][m][n][e] *= qa * __builtin_amdgcn_rcpf(qb); }
                    }
                }
        } else {
            bf16_t* op0 = MG + (size_t)row0 * DM + col0;
#pragma unroll
            for (int ai = 0; ai < 2; ++ai)
#pragma unroll
                for (int m = 0; m < 4; ++m)
#pragma unroll
                    for (int bj = 0; bj < 2; ++bj) {
                        const u32x2 ga = *(const u32x2*)(gp0 + (size_t)(ai * HALF + m * 16) * NG + bj * HALF);
                        u32x4 o;
#pragma unroll
                        for (int n = 0; n < 2; ++n)
#pragma unroll
                            for (int e2 = 0; e2 < 2; ++e2) {
                                const float q0 = (float)((ga[n] >> (16 * e2)) & 255u) * (1.f / 255.f), q1 = (float)((ga[n] >> (16 * e2 + 8)) & 255u) * (1.f / 255.f);
                                o[2 * n + e2] = cvtpk(acc[ai][bj][m][n][2 * e2] * q0, acc[ai][bj][m][n][2 * e2 + 1] * q1); }
                        *(u32x4*)(op0 + (size_t)(ai * HALF + m * 16) * DM + bj * HALF) = o;
                    }
        }
    }
};

typedef int i32x4 __attribute__((ext_vector_type(4)));
template <class Epi, class Sched, bool I8 = false, bool ALIGN_EPI = true>
__device__ __forceinline__ void gemm_phase(LAS unsigned char* lds, const Gemm g, const Sched& S, const Epi& E, const int tid) {
    constexpr int ES = I8 ? 1 : 2;
    const int wid = __builtin_amdgcn_readfirstlane(tid >> 6), lane = tid & 63, wr = wid >> 2, wc = wid & 3, fr = lane & 15, fq = lane >> 4;
    const int K = g.K, nt = K * ES / 128;
    unsigned voffA[2], voffB[2];
#pragma unroll
    for (int i = 0; i < 2; ++i) { int R, C; stage_rc(tid * 16 + i * 8192, R, C); const int Rb = Epi::PERM ? ((R & ~31) + perm32(R & 31)) : R;
        voffA[i] = (unsigned)(R * g.lda * ES + C * 2); voffB[i] = (unsigned)(Rb * g.ldb * ES + C * 2); }
    const size_t kstep = (size_t)(BK * 2);
    const size_t hstepA = (size_t)HALF * g.lda * ES, hstepB = (size_t)HALF * g.ldb * ES;
    const size_t tstepA = 2 * hstepA, tstepB = 2 * hstepB;
    const unsigned ldsw = (unsigned)wid * 1024u;
    const int aoff = lds_byte(wr * 64 + fr, fq * 8), boff = lds_byte(wc * 32 + fr, fq * 8);
#define PG8_SA(b, h) (((b) * 2 + (h)) * HTB)
#define PG8_SB(b, h) ((4 + (b) * 2 + (h)) * HTB)
#define PG8_STAGE(bufoff, gbase, voff) do { _Pragma("unroll") for (int _i = 0; _i < 2; ++_i) \
        __builtin_amdgcn_global_load_lds((const unsigned*)((const char*)(gbase) + (voff)[_i]), (LAS unsigned*)(lds + (bufoff) + ldsw + _i * 8192), 16, 0, 0); } while (0)
#define PG8_LDA(dst, b, h) do { _Pragma("unroll") for (int m = 0; m < 4; ++m) _Pragma("unroll") for (int k = 0; k < 2; ++k) dst[m][k] = *(const LAS bf16x8*)(lds + PG8_SA(b, h) + aoff + m * 2048 + k * 1024); } while (0)
#define PG8_LDB(dst, b, h) do { _Pragma("unroll") for (int n = 0; n < 2; ++n) _Pragma("unroll") for (int k = 0; k < 2; ++k) dst[n][k] = *(const LAS bf16x8*)(lds + PG8_SB(b, h) + boff + n * 2048 + k * 1024); } while (0)
#define PG8_MMA(ai, bj, At, Bt) do { __builtin_amdgcn_s_setprio(1); _Pragma("unroll") for (int m = 0; m < 4; ++m) _Pragma("unroll") for (int n = 0; n < 2; ++n) _Pragma("unroll") for (int k = 0; k < 2; ++k) { \
        if constexpr (I8) acc[ai][bj][m][n] = __builtin_bit_cast(f32x4, __builtin_amdgcn_mfma_i32_16x16x64_i8(__builtin_bit_cast(i32x4, Bt[n][k]), __builtin_bit_cast(i32x4, At[m][k]), __builtin_bit_cast(i32x4, acc[ai][bj][m][n]), 0, 0, 0)); \
        else acc[ai][bj][m][n] = __builtin_amdgcn_mfma_f32_16x16x32_bf16(Bt[n][k], At[m][k], acc[ai][bj][m][n], 0, 0, 0); } __builtin_amdgcn_s_setprio(0); } while (0)
#define PG8_WAIT_V(n) asm volatile("s_waitcnt vmcnt(" #n ")" ::: "memory")
#define PG8_WAIT_L(n) asm volatile("s_waitcnt lgkmcnt(" #n ")" ::: "memory")
#define PG8_BAR __builtin_amdgcn_s_barrier()
#define PG8_SCHED __builtin_amdgcn_sched_barrier(0)
    Unit cur, nxt; int ui = 0;
    if (!S.next(0, cur)) return;
    f32x4 acc[2][2][4][2];
#pragma unroll
    for (int a = 0; a < 2; ++a)
#pragma unroll
        for (int b = 0; b < 2; ++b)
#pragma unroll
            for (int m = 0; m < 4; ++m)
#pragma unroll
                for (int n = 0; n < 2; ++n) acc[a][b][m][n] = (f32x4){0.f, 0.f, 0.f, 0.f};
    bf16x8 At[4][2], B0[2][2], B1[2][2];
    const char* cA = (const char*)g.A + (size_t)cur.z * g.zA * ES + (size_t)cur.pm * tstepA; const char* cB = (const char*)g.Bt + (size_t)cur.z * g.zB * ES + (size_t)cur.pn * tstepB;
    PG8_STAGE(PG8_SB(0, 0), cB, voffB); PG8_STAGE(PG8_SB(0, 1), cB + hstepB, voffB); PG8_STAGE(PG8_SA(0, 0), cA, voffA); PG8_STAGE(PG8_SA(0, 1), cA + hstepA, voffA);
    if (wr == 1) PG8_BAR;
    PG8_WAIT_V(2); PG8_BAR;
    PG8_STAGE(PG8_SB(1, 0), cB + kstep, voffB); PG8_STAGE(PG8_SA(1, 0), cA + kstep, voffA); PG8_STAGE(PG8_SB(1, 1), cB + hstepB + kstep, voffB);
    PG8_WAIT_V(6); PG8_BAR;
    for (;;) {
        const bool has_next = S.next(ui + 1, nxt);
        const char* nA = has_next ? (const char*)g.A + (size_t)nxt.z * g.zA * ES + (size_t)nxt.pm * tstepA : cA;
        const char* nB = has_next ? (const char*)g.Bt + (size_t)nxt.z * g.zB * ES + (size_t)nxt.pn * tstepB : cB;
        for (int t = 0; t < nt; t += 2) {
            const bool last = (t == nt - 2);
            const char* a1 = cA + (size_t)(t + 1) * kstep;
            const char* a2 = last ? nA : cA + (size_t)(t + 2) * kstep; const char* b2 = last ? nB : cB + (size_t)(t + 2) * kstep;
            const char* a3 = a2 + kstep; const char* b3 = b2 + kstep;
            PG8_LDB(B0, 0, 0); PG8_LDB(B1, 0, 1); PG8_SCHED; PG8_LDA(At, 0, 0); PG8_STAGE(PG8_SA(1, 1), a1 + hstepA, voffA);
            PG8_WAIT_V(8); PG8_WAIT_L(0); PG8_BAR; PG8_MMA(0, 0, At, B0); PG8_MMA(0, 1, At, B1); PG8_BAR; PG8_SCHED;
            PG8_LDA(At, 0, 1); PG8_STAGE(PG8_SB(0, 0), b2, voffB); PG8_STAGE(PG8_SB(0, 1), b2 + hstepB, voffB); PG8_STAGE(PG8_SA(0, 0), a2, voffA);
            PG8_WAIT_V(8); PG8_WAIT_L(0); PG8_BAR; PG8_MMA(1, 0, At, B0); PG8_MMA(1, 1, At, B1); PG8_BAR; PG8_SCHED;
            PG8_LDB(B0, 1, 0); PG8_LDB(B1, 1, 1); PG8_SCHED; PG8_LDA(At, 1, 0); PG8_STAGE(PG8_SA(0, 1), a2 + hstepA, voffA);
            PG8_WAIT_V(8); PG8_WAIT_L(0); PG8_BAR; PG8_MMA(0, 0, At, B0); PG8_MMA(0, 1, At, B1); PG8_BAR; PG8_SCHED;
            PG8_LDA(At, 1, 1); PG8_STAGE(PG8_SB(1, 0), b3, voffB); PG8_STAGE(PG8_SB(1, 1), b3 + hstepB, voffB); PG8_STAGE(PG8_SA(1, 0), a3, voffA);
            PG8_WAIT_V(8); PG8_WAIT_L(0); PG8_BAR; PG8_MMA(1, 0, At, B0); PG8_MMA(1, 1, At, B1); PG8_BAR; PG8_SCHED;
        }
        if constexpr (ALIGN_EPI) { if (wr == 0) PG8_BAR; }
        E(acc, cur, wr, wc, fr, fq);
        if (!has_next) break;
        if (!E.keep(cur)) {
#pragma unroll
            for (int a = 0; a < 2; ++a)
#pragma unroll
                for (int b = 0; b < 2; ++b)
#pragma unroll
                    for (int m = 0; m < 4; ++m)
#pragma unroll
                        for (int n = 0; n < 2; ++n) acc[a][b][m][n] = (f32x4){0.f, 0.f, 0.f, 0.f};
        }
        cur = nxt; cA = nA; cB = nB; ++ui;
        if constexpr (ALIGN_EPI) { if (wr == 1) PG8_BAR; }
    }
    PG8_WAIT_V(0);
    if constexpr (!ALIGN_EPI) { if (wr == 0) PG8_BAR; }
    PG8_BAR;
#undef PG8_SA
#undef PG8_SB
#undef PG8_STAGE
#undef PG8_LDA
#undef PG8_LDB
#undef PG8_MMA
#undef PG8_WAIT_V
#undef PG8_WAIT_L
#undef PG8_BAR
#undef PG8_SCHED
}
}

#define XB_TMO      128
#define XB_XCNT(j)  (256  + 64 * (j))
#define XB_XSUB(j)  (1280 + 64 * (j))
#define XB_XGEN(j)  (2304 + 64 * (j))
#define XB_TOP      3328
#define XB_TOPGEN   3392
#define XCD_BAR_WORDS 3456
#define XB_SPIN_CAP (1u << 22)
__device__ __forceinline__ unsigned xb_ld(unsigned* p)              { return __hip_atomic_load(p, __ATOMIC_RELAXED, __HIP_MEMORY_SCOPE_AGENT); }
__device__ __forceinline__ unsigned xb_add(unsigned* p, unsigned v) { return __hip_atomic_fetch_add(p, v, __ATOMIC_RELAXED, __HIP_MEMORY_SCOPE_AGENT); }
__device__ __forceinline__ unsigned xb_xcc_id() { return (unsigned)__builtin_amdgcn_s_getreg((3 << 11) | 20) & 0xFu; }
#define XB_SPIN(cond, bar) do { unsigned _sp = 0; while (cond) { __builtin_amdgcn_s_sleep(1); \
    if ((++_sp & 255u) == 0u) { if (xb_ld(&(bar)[XB_TMO])) break; if (_sp > XB_SPIN_CAP) { atomicAdd(&(bar)[XB_TMO], 1u); break; } } } } while (0)
__device__ __forceinline__ void xcd_barrier_post(unsigned* bar) {
    if (threadIdx.x == 0) (void)xb_add(&bar[XB_XCNT(xb_xcc_id())], 1u);
}
__device__ __forceinline__ void xcd_barrier_complete(unsigned* bar, unsigned x, unsigned& nloc, unsigned& nx) {
    const unsigned G = gridDim.x * gridDim.y * gridDim.z;
    unsigned sum, cnt, mine, sp = 0u;
    for (;;) {
        sum = 0u; cnt = 0u; mine = 0u;
#pragma unroll
        for (unsigned j = 0; j < 16; ++j) { const unsigned c = xb_ld(&bar[XB_XCNT(j)]); sum += c; cnt += (c > 0u) ? 1u : 0u; mine = (j == x) ? c : mine; }
        if (sum == G) break;
        __builtin_amdgcn_s_sleep(1);
        if ((++sp & 255u) == 0u) { if (xb_ld(&bar[XB_TMO])) break; if (sp > XB_SPIN_CAP) { atomicAdd(&bar[XB_TMO], 1u); break; } }
    }
    nloc = mine > 0u ? mine : 1u; nx = cnt > 0u ? cnt : 1u;
}
__device__ __noinline__ void xcd_barrier_leader(unsigned* bar, volatile LAS unsigned* st) {
    const unsigned x = xb_xcc_id();
    __builtin_amdgcn_s_waitcnt(0);
    unsigned nloc = st[0], nx = st[1];
    if (nloc == 0u) { xcd_barrier_complete(bar, x, nloc, nx); st[0] = nloc; st[1] = nx; }
    const unsigned old = xb_add(&bar[XB_XSUB(x)], 1u);
    const unsigned gen = old / nloc;
    if (old + 1u == (gen + 1u) * nloc) {
        __builtin_amdgcn_fence(__ATOMIC_RELEASE, "agent");
        asm volatile("s_waitcnt vmcnt(0)" ::: "memory");
        const unsigned og = xb_add(&bar[XB_TOP], 1u);
        const unsigned tg = og / nx;
        if (og + 1u == (tg + 1u) * nx) xb_add(&bar[XB_TOPGEN], 1u);
        else XB_SPIN(xb_ld(&bar[XB_TOPGEN]) == tg, bar);
        __builtin_amdgcn_fence(__ATOMIC_ACQUIRE, "agent");
        xb_add(&bar[XB_XGEN(x)], 1u);
        asm volatile("s_waitcnt vmcnt(0)" ::: "memory");
    } else {
        XB_SPIN(xb_ld(&bar[XB_XGEN(x)]) == gen, bar);
        __builtin_amdgcn_fence(__ATOMIC_ACQUIRE, "agent");
        asm volatile("s_waitcnt vmcnt(0)" ::: "memory");
    }
}
__device__ __forceinline__ void xcd_barrier(unsigned* bar, volatile LAS unsigned* st) {
    asm volatile("s_waitcnt vmcnt(0)" ::: "memory");
    __syncthreads();
    if (threadIdx.x == 0) xcd_barrier_leader(bar, st);
    __syncthreads();
}

constexpr int NIN_PTRS = 23;
struct Args { const float* in[NIN_PTRS]; float* out; unsigned char* ws; int ph_lo, ph_hi, bar_slot, pad; };
enum { I_X = 0, I_WIN, I_BFOX, I_POOLW, I_POOLS, I_LBL, I_HNG, I_GLNG, I_GLNB, I_GWS, I_GBS, I_WGATE, I_BGATE, I_WBR, I_WOUT, I_LN1G, I_LN1B, I_WQ, I_KEYS, I_PU, I_PV, I_LN2G, I_LN2B };

constexpr int LDS_BYTES = 147456;
constexpr int LDSCTL_OFF = 143360;

struct Ctx {
    LAS unsigned char* lds;
    unsigned char* ws;
    const float* const* in;
    float* out;
    int tid, lane, wave, G, bid, vcu;
};

__device__ __forceinline__ void tconv_job(const Ctx& C, const float* src, int ld_src, int K, int N, bf16_t* dst) {
    LAS float* tile = (LAS float*)C.lds;
    const int nk = K / 64, nn = N / 64, ntiles = nk * nn;
    for (int tl = C.bid; tl < ntiles; tl += C.G) {
        const int k0 = (tl / nn) * 64, n0 = (tl % nn) * 64;
#pragma unroll
        for (int p = 0; p < 2; ++p) {
            const int kr = (C.tid >> 4) + p * 32, nc = (C.tid & 15) * 4;
            const f32x4 v = *(const f32x4*)(src + (size_t)(k0 + kr) * ld_src + n0 + nc);
            tile[kr * 65 + nc + 0] = v[0]; tile[kr * 65 + nc + 1] = v[1]; tile[kr * 65 + nc + 2] = v[2]; tile[kr * 65 + nc + 3] = v[3];
        }
        __syncthreads();
        {
            const int n = C.tid >> 3, k8 = (C.tid & 7) * 8;
            u32x4 o;
#pragma unroll
            for (int j = 0; j < 4; ++j) o[j] = pk2(tile[(k8 + 2 * j) * 65 + n], tile[(k8 + 2 * j + 1) * 65 + n]);
            *(u32x4*)(dst + (size_t)(n0 + n) * K + k0 + k8) = o;
        }
        __syncthreads();
    }
}
__device__ __forceinline__ void cvt_copy(const Ctx& C, const float* src, bf16_t* dst, size_t n) {
    const size_t n8 = n / 8;
    for (size_t i = (size_t)C.bid * 512 + C.tid; i < n8; i += (size_t)C.G * 512) {
        const f32x4 a = *(const f32x4*)(src + i * 8), b = *(const f32x4*)(src + i * 8 + 4);
        u32x4 o; o[0] = pk2(a[0], a[1]); o[1] = pk2(a[2], a[3]); o[2] = pk2(b[0], b[1]); o[3] = pk2(b[2], b[3]);
        *(u32x4*)(dst + i * 8) = o;
    }
}
__device__ __forceinline__ void strip_unit(const Ctx& C, const float* src, int ld, unsigned char* dst, unsigned* cmax, bool split) {
    const float* p = src + (size_t)(128 * C.wave) * ld + C.lane;
    float v[128];
#pragma unroll
    for (int i = 0; i < 128; ++i) v[i] = p[(size_t)i * ld];
    if (cmax) {
        float mx = 0.f;
#pragma unroll
        for (int i = 0; i < 128; ++i) mx = fmaxf(mx, fabsf(v[i]));
        LAS float* red = (LAS float*)C.lds;
        red[C.wave * 64 + C.lane] = mx;
        __syncthreads();
        float m = red[C.lane];
#pragma unroll
        for (int w2 = 1; w2 < 8; ++w2) m = fmaxf(m, red[w2 * 64 + C.lane]);
        if (C.wave == 0) cmax[C.lane] = __builtin_bit_cast(unsigned, m);
        const float isc = 127.f / fmaxf(m, 1e-30f);
        unsigned char* dp = dst + (size_t)C.lane * 1024 + 128 * C.wave;
#pragma unroll
        for (int j4 = 0; j4 < 8; ++j4) { u32x4 o;
#pragma unroll
            for (int j = 0; j < 4; ++j) { unsigned wd = 0u;
#pragma unroll
                for (int e = 0; e < 4; ++e) wd |= ((unsigned)(int)rintf(v[16 * j4 + 4 * j + e] * isc) & 255u) << (8 * e);
                o[j] = wd; }
            *(u32x4*)(dp + 16 * j4) = o; }
        __syncthreads();
    } else {
        bf16_t* dp = split ? (bf16_t*)dst + (size_t)(C.wave >> 2) * DM * BW + (size_t)C.lane * BW + 128 * (C.wave & 3) : (bf16_t*)dst + (size_t)C.lane * 1024 + 128 * C.wave;
#pragma unroll
        for (int j8 = 0; j8 < 16; ++j8) { u32x4 o;
#pragma unroll
            for (int j = 0; j < 4; ++j) o[j] = pk2(v[8 * j8 + 2 * j], v[8 * j8 + 2 * j + 1]);
            *(u32x4*)(dp + 8 * j8) = o; }
    }
}
__device__ __forceinline__ void p_conv_weights(const Ctx& C) {
#pragma unroll 1
    for (int u = C.bid; u < DEPTH * 224; u += C.G) {
        const int l = u / 224, r = u % 224;
        unsigned char* wb = C.ws + WS_W + (size_t)l * W_LAYER;
        unsigned* cm = (unsigned*)(C.ws + WS_CMAX) + l * (NH + NG);
        const float* src; int ld; unsigned char* dst; unsigned* cx = nullptr; bool split = false;
        if (r < 80)       { src = C.in[I_WIN] + (size_t)l * DM * NIN + r * 64; ld = NIN; dst = wb + WO_WIN + (size_t)r * 64 * DM; cx = cm + r * 64; }
        else if (r < 144) { const int t = r - 80; src = C.in[I_WGATE] + (size_t)l * DM * NG + t * 64; ld = NG; dst = wb + WO_WG + (size_t)t * 64 * DM; cx = cm + NH + t * 64; }
        else if (r < 176) { const int t = r - 144, pr = t >> 4, nt = t & 15; src = C.in[I_WBR] + ((size_t)l * 4 + 2 * pr) * BW * DM + nt * 64; ld = DM; split = true;
                            dst = wb + WO_WBR + ((size_t)(2 * pr) * DM * BW + (size_t)nt * 64 * BW) * 2; }
        else if (r < 192) { const int nt = r - 176; src = C.in[I_WOUT] + (size_t)l * DM * DM + nt * 64; ld = DM; dst = wb + WO_WOUT + (size_t)nt * 64 * DM * 2; }
        else              { const int nt = r - 192; src = C.in[I_WQ] + (size_t)l * DM * NQ + nt * 64; ld = NQ; dst = wb + WO_WQ + (size_t)nt * 64 * DM * 2; }
        strip_unit(C, src, ld, dst, cx, split);
    }
    for (int l = 0; l < DEPTH; ++l) {
        unsigned char* wb = C.ws + WS_W + (size_t)l * W_LAYER;
        cvt_copy(C, C.in[I_KEYS] + (size_t)l * 2 * PH * 128 * 128, (bf16_t*)(wb + WO_KEYS), (size_t)2 * PH * 128 * 128);
        for (int g = 0; g < 4; ++g)
            tconv_job(C, C.in[I_POOLW] + ((size_t)l * 4 + g) * 128 * 128, 128, 128, 128, (bf16_t*)(wb + WO_POOLW) + (size_t)g * 128 * 128);
        {
            bf16_t* gw = (bf16_t*)(wb + WO_GWS); const float* src = C.in[I_GWS] + (size_t)l * 4 * 128 * 128;
            for (int i = C.bid * 512 + C.tid; i < 4 * 128 * 128; i += C.G * 512) { const int t = (i >> 7) & 127, sx = i & 127; gw[i] = (bf16_t)f2bf(sx <= t ? src[i] : 0.f); }
        }
        float* wf = (float*)(wb + WO_WF);
        for (int i = C.bid * 512 + C.tid; i < 4 * DM; i += C.G * 512) { const int h = i / DM, k = i % DM; wf[i] = C.in[I_WIN][(size_t)l * DM * NIN + (size_t)k * NIN + NH + h]; }
    }
}
constexpr size_t WS_U8 = WS_TABU, WS_V8 = WS_TABU + 16 * MiB, WS_SU = WS_TABU + 32 * MiB, WS_SV = WS_SU + 64 * 1024;
__device__ __forceinline__ float wave_max(float v) {
#pragma unroll
    for (int o = 32; o > 0; o >>= 1) v = fmaxf(v, __shfl_xor(v, o, 64));
    return v;
}
template <bool SIGNED> __device__ __forceinline__ void quant_rows(const Ctx& C, const float* src, unsigned char* dst, float* scl) {
    for (int row = C.bid * 8 + C.wave; row < NEXP; row += C.G * 8) {
        const float* p = src + (size_t)row * DM + C.lane * 16;
        f32x4 v[4]; float mx = 0.f;
#pragma unroll
        for (int i = 0; i < 4; ++i) { v[i] = *(const f32x4*)(p + 4 * i);
#pragma unroll
            for (int e = 0; e < 4; ++e) mx = fmaxf(mx, fabsf(v[i][e])); }
        mx = fmaxf(wave_max(mx), 1e-30f);
        const float sc = mx * (1.f / 127.f), isc = 127.f / mx;
        u32x4 o;
#pragma unroll
        for (int i = 0; i < 4; ++i) { unsigned wd = 0u;
#pragma unroll
            for (int e = 0; e < 4; ++e) { const int q = (int)rintf(v[i][e] * isc) + (SIGNED ? 0 : 128); wd |= ((unsigned)q & 255u) << (8 * e); }
            o[i] = wd; }
        *(u32x4*)(dst + (size_t)row * DM + C.lane * 16) = o;
        if (C.lane == 0) scl[row] = sc;
    }
}
__device__ __forceinline__ void p_conv_tables(const Ctx& C, int l) {
    quant_rows<true>(C, C.in[I_PU] + (size_t)l * NEXP * DM, C.ws + WS_U8, (float*)(C.ws + WS_SU));
    quant_rows<false>(C, C.in[I_PV] + (size_t)l * NEXP * DM, C.ws + WS_V8, (float*)(C.ws + WS_SV));
}

__device__ __forceinline__ void row_emit(const Ctx& C, int row, const float (&v)[16], int l, bool want_lsig) {
    {
        float mx = 0.f;
#pragma unroll
        for (int j = 0; j < 16; ++j) mx = fmaxf(mx, fabsf(v[j]));
#pragma unroll
        for (int o = 32; o > 0; o >>= 1) mx = fmaxf(mx, __shfl_xor(mx, o, 64));
        mx = fmaxf(mx, 1e-30f);
        const float isc = 127.f / mx;
        unsigned char* xb = C.ws + WS_XB + (size_t)row * DM;
        u32x2 o0, o1;
#pragma unroll
        for (int hw = 0; hw < 2; ++hw) { unsigned a = 0u, b = 0u;
#pragma unroll
            for (int e = 0; e < 4; ++e) { a |= ((unsigned)(int)rintf(v[4 * hw + e] * isc) & 255u) << (8 * e); b |= ((unsigned)(int)rintf(v[8 + 4 * hw + e] * isc) & 255u) << (8 * e); }
            o0[hw] = a; o1[hw] = b; }
        *(u32x2*)(xb + C.lane * 8) = o0; *(u32x2*)(xb + 512 + C.lane * 8) = o1;
        if (C.lane == 0) ((float*)(C.ws + WS_XSA))[row] = mx * (1.f / 127.f);
    }
    if (want_lsig) {
        const float* wf = (const float*)(C.ws + WS_W + (size_t)l * W_LAYER + WO_WF);
        float* lsig = (float*)(C.ws + WS_MISC);
#pragma unroll
        for (int h = 0; h < 4; ++h) {
            const f32x4 a0 = *(const f32x4*)(wf + h * DM + C.lane * 8), a1 = *(const f32x4*)(wf + h * DM + C.lane * 8 + 4);
            const f32x4 b0 = *(const f32x4*)(wf + h * DM + 512 + C.lane * 8), b1 = *(const f32x4*)(wf + h * DM + 512 + C.lane * 8 + 4);
            float s = 0.f;
#pragma unroll
            for (int j = 0; j < 4; ++j) s += v[j] * a0[j] + v[4 + j] * a1[j] + v[8 + j] * b0[j] + v[12 + j] * b1[j];
            s = wave_sum(s);
            if (C.lane == 0) lsig[(size_t)row * 4 + h] = logsigmoidf_(s + C.in[I_BFOX][l * 4 + h]);
        }
    }
}
__device__ __forceinline__ void load_row16(const float* p, int lane, float (&v)[16]) {
    const f32x4 a0 = *(const f32x4*)(p + lane * 8), a1 = *(const f32x4*)(p + lane * 8 + 4), b0 = *(const f32x4*)(p + 512 + lane * 8), b1 = *(const f32x4*)(p + 512 + lane * 8 + 4);
#pragma unroll
    for (int j = 0; j < 4; ++j) { v[j] = a0[j]; v[4 + j] = a1[j]; v[8 + j] = b0[j]; v[12 + j] = b1[j]; }
}
__device__ __forceinline__ void store_row16(float* p, int lane, const float (&v)[16]) {
    *(f32x4*)(p + lane * 8) = (f32x4){v[0], v[1], v[2], v[3]}; *(f32x4*)(p + lane * 8 + 4) = (f32x4){v[4], v[5], v[6], v[7]};
    *(f32x4*)(p + 512 + lane * 8) = (f32x4){v[8], v[9], v[10], v[11]}; *(f32x4*)(p + 512 + lane * 8 + 4) = (f32x4){v[12], v[13], v[14], v[15]};
}
__device__ __forceinline__ void ln_row16(float (&v)[16], const float* g, const float* b, int lane) {
    float s = 0.f;
#pragma unroll
    for (int j = 0; j < 16; ++j) s += v[j];
    const float mean = wave_sum(s) * (1.f / DM);
    float q = 0.f;
#pragma unroll
    for (int j = 0; j < 16; ++j) { const float d = v[j] - mean; q += d * d; }
    const float rstd = rsqrtf(wave_sum(q) * (1.f / DM) + LN_EPS);
    float gg[16], bb[16];
    load_row16(g, lane, gg); load_row16(b, lane, bb);
#pragma unroll
    for (int j = 0; j < 16; ++j) v[j] = (v[j] - mean) * rstd * gg[j] + bb[j];
}
__device__ __forceinline__ void p_rowpass0(const Ctx& C) {
    const float* wfin = C.in[I_WIN] + NH;
    f32x4 wv[16];
#pragma unroll
    for (int j = 0; j < 16; ++j) { const int k = (j < 8) ? C.lane * 8 + j : 512 + C.lane * 8 + (j - 8); wv[j] = *(const f32x4*)(wfin + (size_t)k * NIN); }
    float* lsig = (float*)(C.ws + WS_MISC);
    const bool bal = (C.G == 256);
    const int c0 = bal ? ((C.bid < 192) ? C.bid * 6 : 1152 + (C.bid - 192) * 14) : C.bid, cn = bal ? ((C.bid < 192) ? 6 : 14) : (T / 8 - C.bid + C.G - 1) / C.G, cs = bal ? 1 : C.G;
    for (int ci = 0; ci < cn; ++ci) {
        const int row = (c0 + ci * cs) * 8 + C.wave;
        float v[16]; load_row16(C.in[I_X] + (size_t)row * DM, C.lane, v);
        row_emit(C, row, v, 0, false);
#pragma unroll
        for (int h = 0; h < 4; ++h) {
            float sacc = 0.f;
#pragma unroll
            for (int j = 0; j < 16; ++j) sacc += v[j] * wv[j][h];
            sacc = wave_sum(sacc);
            if (C.lane == 0) lsig[(size_t)row * 4 + h] = logsigmoidf_(sacc + C.in[I_BFOX][h]);
        }
    }
}
__device__ __forceinline__ void p_cumsum(const Ctx& C) {
    if (C.bid >= BATCH * 4) return;
    const float* lsig = (const float*)(C.ws + WS_MISC);
    float* cum = (float*)(C.ws + WS_CUM);
    LAS float* wt = (LAS float*)C.lds;
    const int b = C.bid >> 2, h = C.bid & 3;
    float v[16];
#pragma unroll
    for (int j = 0; j < 16; ++j) v[j] = lsig[((size_t)b * SEQ + C.tid * 16 + j) * 4 + h];
#pragma unroll
    for (int j = 1; j < 16; ++j) v[j] += v[j - 1];
    float inc = v[15];
#pragma unroll
    for (int o = 1; o < 64; o <<= 1) { const float t = __shfl_up(inc, o, 64); if (C.lane >= o) inc += t; }
    if (C.lane == 63) wt[C.wave] = inc;
    __syncthreads();
    float off = inc - v[15];
    for (int w2 = 0; w2 < C.wave; ++w2) off += wt[w2];
    float* cp = cum + ((size_t)b * 4 + h) * SEQ + C.tid * 16;
#pragma unroll
    for (int j4 = 0; j4 < 4; ++j4) *(f32x4*)(cp + 4 * j4) = (f32x4){v[4 * j4] + off, v[4 * j4 + 1] + off, v[4 * j4 + 2] + off, v[4 * j4 + 3] + off};
    __syncthreads();
}
__device__ __forceinline__ void load_row16_bf(const bf16_t* p, int lane, float (&v)[16]) {
    const u32x4 a = *(const u32x4*)(p + lane * 8), b = *(const u32x4*)(p + 512 + lane * 8);
#pragma unroll
    for (int j = 0; j < 4; ++j) { v[2 * j] = bf2f(a[j] & 0xffffu); v[2 * j + 1] = bf2f(a[j] >> 16); v[8 + 2 * j] = bf2f(b[j] & 0xffffu); v[9 + 2 * j] = bf2f(b[j] >> 16); }
}
__device__ __forceinline__ void p_ln1(const Ctx& C, int l) {
    const bf16_t* y1 = (const bf16_t*)(C.ws + WS_XC); bf16_t* x1b = (bf16_t*)(C.ws + WS_X1B);
    for (int row = C.bid * 8 + C.wave; row < T; row += C.G * 8) {
        float v[16]; load_row16_bf(y1 + (size_t)row * DM, C.lane, v);
        ln_row16(v, C.in[I_LN1G] + l * DM, C.in[I_LN1B] + l * DM, C.lane);
        u32x4 o0, o1;
#pragma unroll
        for (int j = 0; j < 4; ++j) { o0[j] = pk2(v[2 * j], v[2 * j + 1]); o1[j] = pk2(v[8 + 2 * j], v[8 + 2 * j + 1]); }
        *(u32x4*)(x1b + (size_t)row * DM + C.lane * 8) = o0; *(u32x4*)(x1b + (size_t)row * DM + 512 + C.lane * 8) = o1;
    }
}

__device__ __forceinline__ void mix_pool_naive(const Ctx& C, int l) {
    const bf16_t* H = (const bf16_t*)(C.ws + WS_H); bf16_t* BR = (bf16_t*)(C.ws + WS_BR);
    LAS float* dd = (LAS float*)C.lds;
    for (int u = C.bid; u < (T / 64) * 4; u += C.G) {
        const int g = u & 3, t0 = (u >> 2) * 64, w = 2 << g;
        for (int idx = C.tid; idx < 64 * 128; idx += 512) {
            const int r = idx >> 7, c = idx & 127, row = t0 + r, pos = row & (SEQ - 1);
            const int nwin = (pos + 1 < w) ? pos + 1 : w;
            float s = 0.f;
            for (int j = 0; j < nwin; ++j) s += bf2f(H[(size_t)(row - j) * NH + HC_P + g * 128 + c]);
            dd[idx] = s / (float)nwin - bf2f(H[(size_t)row * NH + HC_P + g * 128 + c]);
        }
        __syncthreads();
        const int dcol = C.tid & 127, rq = C.tid >> 7;
        float acc[16];
#pragma unroll
        for (int i = 0; i < 16; ++i) acc[i] = 0.f;
        const float* pw = C.in[I_POOLW] + ((size_t)l * 4 + g) * 128 * 128;
        for (int c = 0; c < 128; ++c) {
            const float wv = pw[c * 128 + dcol];
#pragma unroll
            for (int i = 0; i < 16; ++i) acc[i] += dd[(rq * 16 + i) * 128 + c] * wv;
        }
        const float sc = C.in[I_POOLS][l * BW + g * 128 + dcol];
#pragma unroll
        for (int i = 0; i < 16; ++i) BR[(size_t)(t0 + rq * 16 + i) * NBR + 0 + g * 128 + dcol] = (bf16_t)f2bf(acc[i] * sc);
        __syncthreads();
    }
}
__device__ __forceinline__ void mix_gmlp_naive(const Ctx& C, int l) {
    const bf16_t* H = (const bf16_t*)(C.ws + WS_H); bf16_t* BR = (bf16_t*)(C.ws + WS_BR);
    LAS float* vn = (LAS float*)C.lds;
    for (int u = C.bid; u < (T / 128) * 4; u += C.G) {
        const int g = u & 3, t0 = (u >> 2) * 128;
        for (int i = 0; i < 16; ++i) {
            const int r = C.wave * 16 + i, row = t0 + r;
            const u32x4 raw = *(const u32x4*)(H + (size_t)row * NH + HC_GV + C.lane * 8);
            float e[8];
#pragma unroll
            for (int j = 0; j < 4; ++j) { e[2 * j] = geluf_(bf2f(raw[j] & 0xffffu)); e[2 * j + 1] = geluf_(bf2f(raw[j] >> 16)); }
            float s = 0.f;
#pragma unroll
            for (int j = 0; j < 8; ++j) s += e[j];
            const float mean = wave_sum(s) * (1.f / BW);
            float q = 0.f;
#pragma unroll
            for (int j = 0; j < 8; ++j) { const float d = e[j] - mean; q += d * d; }
            const float rstd = rsqrtf(wave_sum(q) * (1.f / BW) + LN_EPS);
            if ((C.lane >> 4) == g) {
#pragma unroll
                for (int j = 0; j < 8; ++j) { const int col = C.lane * 8 + j;
                    vn[r * 128 + (col - g * 128)] = (e[j] - mean) * rstd * C.in[I_GLNG][l * BW + col] + C.in[I_GLNB][l * BW + col]; }
            }
        }
        __syncthreads();
        const int c = C.tid & 127, tq = C.tid >> 7;
        const float* wsg = C.in[I_GWS] + ((size_t)l * 4 + g) * 128 * 128;
        for (int t = tq; t < 128; t += 4) {
            float acc = 0.f;
            for (int s = 0; s <= t; ++s) acc += wsg[t * 128 + s] * vn[s * 128 + c];
            const float sv = acc + C.in[I_GBS][(l * 4 + g) * 128 + t];
            const float uv = geluf_(bf2f(H[(size_t)(t0 + t) * NH + HC_GU + g * 128 + c]));
            BR[(size_t)(t0 + t) * NBR + 1024 + g * 128 + c] = (bf16_t)f2bf(uv * sv);
        }
        __syncthreads();
    }
}
__device__ __forceinline__ void mix_fox_naive(const Ctx& C, int l) {
    const bf16_t* H = (const bf16_t*)(C.ws + WS_H); bf16_t* BR = (bf16_t*)(C.ws + WS_BR);
    const float* cum = (const float*)(C.ws + WS_CUM);
    const float scale = 0.08838834764831845f;
    for (int u = C.bid; u < T * 4 / 8; u += C.G) {
        const int rid = u * 8 + C.wave;
        const int h = rid & 3, row = rid >> 2, b = row / SEQ, t = row % SEQ;
        const unsigned qraw = *(const unsigned*)(H + (size_t)row * NH + HC_FQ + h * 128 + C.lane * 2);
        const float q0 = bf2f(qraw & 0xffffu) * scale, q1 = bf2f(qraw >> 16) * scale;
        const float* cm = cum + ((size_t)b * 4 + h) * SEQ;
        const float ct = cm[t];
        float m = -1e30f, lsum = 0.f, o0 = 0.f, o1 = 0.f;
        for (int s = t; s >= 0; --s) {
            const size_t kr = (size_t)(b * SEQ + s) * NH + h * 128 + C.lane * 2;
            const unsigned kraw = *(const unsigned*)(H + kr + HC_FK);
            const unsigned vraw = *(const unsigned*)(H + kr + HC_FV);
            float d = q0 * bf2f(kraw & 0xffffu) + q1 * bf2f(kraw >> 16);
            d = wave_sum(d);
            const float z = d + ct - cm[s];
            const float mn = fmaxf(m, z), al = __expf(m - mn), p = __expf(z - mn);
            lsum = lsum * al + p; o0 = o0 * al + p * bf2f(vraw & 0xffffu); o1 = o1 * al + p * bf2f(vraw >> 16); m = mn;
        }
        const float inv = 1.f / lsum;
        *(unsigned*)(BR + (size_t)row * NBR + 1536 + h * 128 + C.lane * 2) = pk2(o0 * inv, o1 * inv);
    }
}
__device__ __forceinline__ void mix_hgrn_naive(const Ctx& C, int l) {
    if (C.bid >= BATCH * 4) return;
    const bf16_t* H = (const bf16_t*)(C.ws + WS_H); bf16_t* BR = (bf16_t*)(C.ws + WS_BR);
    const int b = C.bid >> 2, h = C.bid & 3;
    LAS float* fdec = (LAS float*)C.lds;
    LAS float* kkv = fdec + 32 * 128;
    LAS float* qsv = kkv + 32 * 128;
    LAS float* vv = qsv + 32 * 128;
    LAS float* opart = vv + 32 * 128;
    const int kq = C.tid >> 7, v = C.tid & 127;
    float S[32];
#pragma unroll
    for (int j = 0; j < 32; ++j) S[j] = 0.f;
    for (int c0 = 0; c0 < SEQ; c0 += 32) {
        for (int idx = C.tid; idx < 32 * 128; idx += 512) {
            const int st = idx >> 7, k = idx & 127; const size_t rb = (size_t)(b * SEQ + c0 + st) * NH + h * 128 + k;
            float lb = 0.f;
            if (l == 1) { const float z0 = C.in[I_LBL][h * 128 + k], z1 = C.in[I_LBL][BW + h * 128 + k]; lb = 1.f / (1.f + __expf(z0 - z1)); }
            const float zf = bf2f(H[rb + HC_HF]);
            const float kk = (1.f - lb) * sigmoidf_(-zf);
            fdec[idx] = 1.f - kk; kkv[idx] = kk; qsv[idx] = siluf_(bf2f(H[rb + HC_HQ])); vv[idx] = bf2f(H[rb + HC_HI]);
        }
        __syncthreads();
        for (int st = 0; st < 32; ++st) {
            const float vt = vv[st * 128 + v];
            float part = 0.f;
#pragma unroll
            for (int j = 0; j < 32; ++j) { const int k = kq * 32 + j; S[j] = fdec[st * 128 + k] * S[j] + kkv[st * 128 + k] * vt; part += S[j] * qsv[st * 128 + k]; }
            opart[(kq * 32 + st) * 128 + v] = part;
        }
        __syncthreads();
        for (int i = 0; i < 4; ++i) {
            const int st = C.wave * 4 + i, row = b * SEQ + c0 + st;
            float o0 = 0.f, o1 = 0.f;
#pragma unroll
            for (int q = 0; q < 4; ++q) { o0 += opart[(q * 32 + st) * 128 + C.lane]; o1 += opart[(q * 32 + st) * 128 + 64 + C.lane]; }
            const float ss = wave_sum(o0 * o0 + o1 * o1);
            const float r = rsqrtf(ss * (1.f / 128.f) + RMS_EPS);
            const float g0 = siluf_(bf2f(H[(size_t)row * NH + HC_HG + h * 128 + C.lane])), g1 = siluf_(bf2f(H[(size_t)row * NH + HC_HG + h * 128 + 64 + C.lane]));
            BR[(size_t)row * NBR + 512 + h * 128 + C.lane] = (bf16_t)f2bf(o0 * r * C.in[I_HNG][l * 128 + C.lane] * g0);
            BR[(size_t)row * NBR + 512 + h * 128 + 64 + C.lane] = (bf16_t)f2bf(o1 * r * C.in[I_HNG][l * 128 + 64 + C.lane] * g1);
        }
        __syncthreads();
    }
}


typedef float f32x16 __attribute__((ext_vector_type(16)));
typedef short s16x4 __attribute__((ext_vector_type(4)));
typedef short v4i16_t __attribute__((ext_vector_type(4)));
__device__ __forceinline__ s16x4 vtr(const LAS unsigned char* p) { return __builtin_bit_cast(s16x4, __builtin_amdgcn_ds_read_tr16_b64_v4i16((LAS v4i16_t*)p)); }
__device__ __forceinline__ float xor32(float x) { return __shfl_xor(x, 32, 64); }
#define MFMA32(a, b, c) __builtin_amdgcn_mfma_f32_32x32x16_bf16((a), (b), (c), 0, 0, 0)
constexpr int CW_KMAX = 16;

__device__ __forceinline__ void p_knorm(const Ctx& C, int l) {
    const bf16_t* H = (const bf16_t*)(C.ws + WS_H);
    unsigned* kmax = (unsigned*)(C.ws + WS_CTL) + CW_KMAX + l * 8;
    for (int r0 = (C.bid * 8 + C.wave) * 8; r0 < T; r0 += C.G * 64) {
        u32x4 raw[8];
#pragma unroll
        for (int i = 0; i < 8; ++i) raw[i] = *(const u32x4*)(H + (size_t)(r0 + i) * NH + HC_FK + C.lane * 8);
        float best = 0.f;
#pragma unroll
        for (int i = 0; i < 8; ++i) { float s = 0.f;
#pragma unroll
            for (int j = 0; j < 4; ++j) { const float a = bf2f(raw[i][j] & 0xffffu), b = bf2f(raw[i][j] >> 16); s += a * a + b * b; }
            best = fmaxf(best, s); }
        best = 0.f;
#pragma unroll
        for (int i = 0; i < 8; ++i) { float s = 0.f;
#pragma unroll
            for (int j = 0; j < 4; ++j) { const float a = bf2f(raw[i][j] & 0xffffu), b = bf2f(raw[i][j] >> 16); s += a * a + b * b; }
#pragma unroll
            for (int o = 8; o > 0; o >>= 1) s += __shfl_xor(s, o, 64);
            best = fmaxf(best, s); }
        LAS float* red = (LAS float*)C.lds;
        if ((C.lane & 15) == 0) red[C.wave * 4 + (C.lane >> 4)] = best;
        __syncthreads();
        if (C.tid < 4) { float m = red[C.tid];
#pragma unroll
            for (int w2 = 1; w2 < 8; ++w2) m = fmaxf(m, red[w2 * 4 + C.tid]);
            atomicMax(kmax + (r0 / SEQ) * 4 + C.tid, __builtin_bit_cast(unsigned, m)); }
        __syncthreads();
    }
}

constexpr int FOX_KST = 272, FOX_VST = 320;
constexpr int FOX_KB = 0, FOX_VB = 2 * 64 * FOX_KST, FOX_BETA = FOX_VB + 2 * 64 * FOX_VST, FOX_FLAG = FOX_BETA + 2 * 64 * 4, FOX_END = FOX_FLAG + 2 * 8 * 4;
__device__ __forceinline__ void mix_fox(const Ctx& C, int l) {
    const bf16_t* H = (const bf16_t*)(C.ws + WS_H); bf16_t* BR = (bf16_t*)(C.ws + WS_BR);
    const float* cum = (const float*)(C.ws + WS_CUM);
    const unsigned* kmaxw = (const unsigned*)(C.ws + WS_CTL) + CW_KMAX + l * 8;
    const float LOG2E = 1.4426950408889634f, QS = 0.08838834764831845f * LOG2E;
    const int lane = C.lane, w = C.wave, r32 = lane & 31, hh = lane >> 5;
    LAS unsigned char* lds = C.lds;
    LAS float* betaL = (LAS float*)(lds + FOX_BETA);
    volatile LAS int* flagL = (volatile LAS int*)(lds + FOX_FLAG);
    for (int u = C.bid; u < BATCH * 4 * (SEQ / 256); u += C.G) {
        const int qb = u % (SEQ / 256), bh = u / (SEQ / 256), b = bh >> 2, h = bh & 3;
        const int q0 = qb * 256, qw = q0 + 32 * w;
        const size_t rowbase = (size_t)b * SEQ;
        const float* cm = cum + ((size_t)b * 4 + h) * SEQ;
        const float c0 = cm[q0];
        const float kmx = sqrtf(__builtin_bit_cast(float, __hip_atomic_load(kmaxw + b * 4 + h, __ATOMIC_RELAXED, __HIP_MEMORY_SCOPE_AGENT)));
        bf16x8 qf[8]; float qn = 0.f;
        {
            const bf16_t* qp = H + (rowbase + qw + r32) * NH + HC_FQ + h * 128 + 8 * hh;
#pragma unroll
            for (int ks = 0; ks < 8; ++ks) {
                const u32x4 raw = *(const u32x4*)(qp + 16 * ks);
                u32x4 o;
#pragma unroll
                for (int j = 0; j < 4; ++j) { const float a = bf2f(raw[j] & 0xffffu), bb = bf2f(raw[j] >> 16); qn += a * a + bb * bb; o[j] = cvtpk(a * QS, bb * QS); }
                qf[ks] = __builtin_bit_cast(bf16x8, o);
            }
            qn += xor32(qn); qn = sqrtf(qn);
        }
        const float qbound = qn * kmx * QS;
        f32x16 oacc[4];
#pragma unroll
        for (int mt = 0; mt < 4; ++mt)
#pragma unroll
            for (int i = 0; i < 16; ++i) oacc[mt][i] = 0.f;
        float m_run = -1e30f, l_run = 0.f;
        const int jmax = (q0 + 255) >> 6;
        const int srow = C.tid >> 4, sch = C.tid & 15;
        u32x4 kreg[2], vreg[2]; float breg = 0.f;
#define FOX_GLOAD(j_) do { _Pragma("unroll") for (int p = 0; p < 2; ++p) { \
                const bf16_t* rp = H + (rowbase + 64 * (j_) + srow + 32 * p) * NH + h * 128 + sch * 8; \
                kreg[p] = *(const u32x4*)(rp + HC_FK); vreg[p] = *(const u32x4*)(rp + HC_FV); } \
            if (C.tid < 64) breg = (c0 - cm[64 * (j_) + C.tid]) * LOG2E; } while (0)
#define FOX_LWRITE(buf_) do { _Pragma("unroll") for (int p = 0; p < 2; ++p) { \
                *(LAS u32x4*)(lds + FOX_KB + (buf_) * 64 * FOX_KST + (srow + 32 * p) * FOX_KST + sch * 16) = kreg[p]; \
                *(LAS u32x4*)(lds + FOX_VB + (buf_) * 64 * FOX_VST + (srow + 32 * p) * FOX_VST + sch * 16) = vreg[p]; } \
            if (C.tid < 64) betaL[(buf_) * 64 + C.tid] = breg; } while (0)
        __syncthreads();
        if (C.tid < 16) flagL[C.tid] = 0;
        FOX_GLOAD(jmax); FOX_LWRITE(jmax & 1);
        bool wdone = false;
        for (int j = jmax; j >= 0; --j) {
            const int cur = j & 1;
            __syncthreads();
            if (j < jmax) { int all = 1;
#pragma unroll
                for (int i = 0; i < 8; ++i) all &= flagL[((j + 1) & 1) * 8 + i];
                if (all) break; }
            if (j > 0) FOX_GLOAD(j - 1);
            const int k0 = 64 * j;
            if (k0 <= qw + 31 && !wdone) {
                const LAS unsigned char* kb = lds + FOX_KB + cur * 64 * FOX_KST;
                const LAS unsigned char* vb = lds + FOX_VB + cur * 64 * FOX_VST;
                f32x16 sacc[2];
#pragma unroll
                for (int mt = 0; mt < 2; ++mt)
#pragma unroll
                    for (int g = 0; g < 4; ++g) { const f32x4 bv = *(const LAS f32x4*)(betaL + cur * 64 + 32 * mt + 8 * g + 4 * hh);
                        sacc[mt][4 * g] = bv[0]; sacc[mt][4 * g + 1] = bv[1]; sacc[mt][4 * g + 2] = bv[2]; sacc[mt][4 * g + 3] = bv[3]; }
#pragma unroll
                for (int ks = 0; ks < 8; ++ks)
#pragma unroll
                    for (int mt = 0; mt < 2; ++mt) {
                        const bf16x8 kf = *(const LAS bf16x8*)(kb + (32 * mt + r32) * FOX_KST + 32 * ks + 16 * hh);
                        sacc[mt] = MFMA32(kf, qf[ks], sacc[mt]);
                    }
                const int tq = qw + r32;
                if (k0 + 63 > qw) {
#pragma unroll
                    for (int mt = 0; mt < 2; ++mt)
#pragma unroll
                        for (int i = 0; i < 16; ++i) { const int key = k0 + 32 * mt + (i & 3) + 8 * (i >> 2) + 4 * hh; if (key > tq) sacc[mt][i] = -1e30f; }
                }
                float mx = sacc[0][0];
#pragma unroll
                for (int mt = 0; mt < 2; ++mt)
#pragma unroll
                    for (int i = 0; i < 16; ++i) mx = fmaxf(mx, sacc[mt][i]);
                mx = fmaxf(mx, xor32(mx));
                const float mn = fmaxf(m_run, mx), alpha = __builtin_amdgcn_exp2f(m_run - mn);
                m_run = mn;
                float ps = 0.f;
#pragma unroll
                for (int mt = 0; mt < 2; ++mt)
#pragma unroll
                    for (int i = 0; i < 16; ++i) { const float p = __builtin_amdgcn_exp2f(sacc[mt][i] - mn); sacc[mt][i] = p; ps += p; }
                l_run = l_run * alpha + ps;
#pragma unroll
                for (int mt = 0; mt < 4; ++mt)
#pragma unroll
                    for (int i = 0; i < 16; ++i) oacc[mt][i] *= alpha;
#pragma unroll
                for (int s4 = 0; s4 < 4; ++s4) {
                    const int mtk = s4 >> 1, s = s4 & 1;
                    u32x4 pb;
#pragma unroll
                    for (int e = 0; e < 4; ++e) pb[e] = cvtpk(sacc[mtk][8 * s + 2 * e], sacc[mtk][8 * s + 2 * e + 1]);
                    const bf16x8 pfrag = __builtin_bit_cast(bf16x8, pb);
                    const int i16 = lane & 15, q4 = i16 >> 2, p4 = i16 & 3, blk = (lane >> 4) & 1;
                    const int keyA = 32 * mtk + 16 * s + 4 * hh + q4;
#pragma unroll
                    for (int mt = 0; mt < 4; ++mt) {
                        const LAS unsigned char* a0 = vb + keyA * FOX_VST + (32 * mt + 16 * blk + 4 * p4) * 2;
                        const s16x4 lo = vtr(a0), hi = vtr(a0 + 8 * FOX_VST);
                        const bf16x8 vf = __builtin_shufflevector(lo, hi, 0, 1, 2, 3, 4, 5, 6, 7);
                        oacc[mt] = MFMA32(vf, pfrag, oacc[mt]);
                    }
                }
                if (j > 0) { const float bl = (c0 - cm[k0 - 1]) * LOG2E;
                    const int ok = (qbound + bl < m_run - 40.f) ? 1 : 0;
                    wdone = __all(ok); }
            }
            if (lane == 0) flagL[cur * 8 + w] = wdone ? 1 : 0;
            if (j > 0) FOX_LWRITE(cur ^ 1);
        }
        l_run += xor32(l_run);
        const float inv = 1.f / l_run;
        bf16_t* op = BR + (rowbase + qw + r32) * NBR + 1536 + h * 128;
#pragma unroll
        for (int mt = 0; mt < 4; ++mt)
#pragma unroll
            for (int g = 0; g < 4; ++g) { u32x2 o; o[0] = cvtpk(oacc[mt][4 * g] * inv, oacc[mt][4 * g + 1] * inv); o[1] = cvtpk(oacc[mt][4 * g + 2] * inv, oacc[mt][4 * g + 3] * inv);
                *(u32x2*)(op + 32 * mt + 8 * g + 4 * hh) = o; }
    }
}


constexpr int HG_LF = 0, HG_QA = 34816, HG_QB = HG_QA + 17408, HG_KD = HG_QB + 8704, HG_KO = HG_KD + 17408, HG_KT = HG_KO + 8704, HG_VN = HG_KT + 20480, HG_AM = HG_VN + 20480, HG_END = HG_AM + 12288;
constexpr int HG_LFS = 132;
static_assert(HG_END + 2048 <= 140 * 1024, "hgrn LDS");
constexpr size_t WS_DSC = WS_ST + (size_t)BATCH * 4 * 32 * 128 * 128 * 4;

template <bool FULL>
__device__ __forceinline__ void hgrn_unit(const Ctx& C, int l, int u) {
#if DIAG == 1
    const bf16_t* H = (const bf16_t*)(C.ws + WS_H); bf16_t* BR = (l == 0) ? (bf16_t*)(C.ws + WS_XA) : (bf16_t*)(C.ws + WS_TABU);
#else
    const bf16_t* H = (const bf16_t*)(C.ws + WS_H); bf16_t* BR = (bf16_t*)(C.ws + WS_BR);
#endif
    float* STB = (float*)(C.ws + WS_ST); float* DSC = (float*)(C.ws + WS_DSC);
    LAS unsigned char* lds = C.lds;
    LAS float* LF = (LAS float*)(lds + HG_LF);
    const int lane = C.lane, w = C.wave, r32 = lane & 31, hh = lane >> 5;
    const int sc = u & 31, bh = u >> 5, b = bh >> 2, h = bh & 3;
    const int wk = w >> 1, wv = w & 1;
    const int mt = w >> 2, nt = w & 3;
    const int i16 = lane & 15, q4 = i16 >> 2, p4 = i16 & 3, blk = (lane >> 4) & 1;
    f32x16 S0, S1;
    float* stp = STB + ((size_t)bh * 32 + sc) * 128 * 128;
    if constexpr (FULL) {
#pragma unroll
        for (int i = 0; i < 16; ++i) { const int k = 32 * wk + (i & 3) + 8 * (i >> 2) + 4 * hh;
            S0[i] = stp[k * 128 + 64 * wv + r32]; S1[i] = stp[k * 128 + 64 * wv + 32 + r32]; }
    } else {
#pragma unroll
        for (int i = 0; i < 16; ++i) { S0[i] = 0.f; S1[i] = 0.f; }
    }
    float dtot = 0.f;
    const int ps = C.tid >> 3, pseg = C.tid & 7;
    float lbv[16];
#pragma unroll
    for (int j = 0; j < 16; ++j) { lbv[j] = 0.f;
        if (l == 1) { const int ch = h * 128 + 16 * pseg + j; lbv[j] = 1.f / (1.f + __expf(C.in[I_LBL][ch] - C.in[I_LBL][BW + ch])); } }
    u32x4 nf0, nf1, nv0, nv1;
    { const bf16_t* hp0 = H + ((size_t)b * SEQ + sc * 256 + ps) * NH + h * 128 + 16 * pseg;
      nf0 = *(const u32x4*)(hp0 + HC_HF); nf1 = *(const u32x4*)(hp0 + HC_HF + 8); nv0 = *(const u32x4*)(hp0 + HC_HI); nv1 = *(const u32x4*)(hp0 + HC_HI + 8); }
    for (int c = 0; c < 4; ++c) {
        const size_t row0 = (size_t)b * SEQ + sc * 256 + c * 64;
        const bf16_t* hp = H + (row0 + ps) * NH + h * 128 + 16 * pseg;
        float kkv[16], qsv[16];
        u32x4 vraw0, vraw1;
        u32x4 cg0 = {0u, 0u, 0u, 0u}, cg1 = cg0, cq0 = cg0, cq1 = cg0;
        if constexpr (FULL) { cq0 = *(const u32x4*)(hp + HC_HQ); cq1 = *(const u32x4*)(hp + HC_HQ + 8); cg0 = *(const u32x4*)(hp + HC_HG); cg1 = *(const u32x4*)(hp + HC_HG + 8); }
        {
            const u32x4 f0 = nf0, f1 = nf1;
            vraw0 = nv0; vraw1 = nv1;
            if (c < 3) { const bf16_t* hn = hp + (size_t)64 * NH;
                nf0 = *(const u32x4*)(hn + HC_HF); nf1 = *(const u32x4*)(hn + HC_HF + 8); nv0 = *(const u32x4*)(hn + HC_HI); nv1 = *(const u32x4*)(hn + HC_HI + 8); }
#pragma unroll
            for (int j = 0; j < 8; ++j) { const unsigned r = (j < 4) ? f0[j] : f1[j - 4];
                const float z0 = bf2f(r & 0xffffu), z1 = bf2f(r >> 16);
                kkv[2 * j] = (1.f - lbv[2 * j]) * sigmoidf_(-z0); kkv[2 * j + 1] = (1.f - lbv[2 * j + 1]) * sigmoidf_(-z1); }
            if constexpr (FULL) {
#pragma unroll
                for (int j = 0; j < 8; ++j) { const unsigned r = (j < 4) ? cq0[j] : cq1[j - 4]; qsv[2 * j] = siluf_(bf2f(r & 0xffffu)); qsv[2 * j + 1] = siluf_(bf2f(r >> 16)); }
            }
#pragma unroll
            for (int j4 = 0; j4 < 4; ++j4) { f32x4 o;
#pragma unroll
                for (int e = 0; e < 4; ++e) o[e] = __logf(1.f - kkv[4 * j4 + e]);
                *(LAS f32x4*)(LF + ps * HG_LFS + 16 * pseg + 4 * j4) = o; }
        }
        __syncthreads();
        {
            const int sk = C.tid & 127, sg = C.tid >> 7;
            float vals[16];
#pragma unroll
            for (int i = 0; i < 16; ++i) vals[i] = LF[(16 * sg + i) * HG_LFS + sk];
#pragma unroll
            for (int i = 1; i < 16; ++i) vals[i] += vals[i - 1];
            LAS float* TOT = (LAS float*)(lds + HG_END);
            TOT[sg * 128 + sk] = vals[15];
            __syncthreads();
            float off = 0.f;
#pragma unroll
            for (int j = 0; j < 3; ++j) if (j < sg) off += TOT[j * 128 + sk];
#pragma unroll
            for (int i = 0; i < 16; ++i) LF[(16 * sg + i) * HG_LFS + sk] = vals[i] + off;
            if (sg == 3) dtot += vals[15] + off;
        }
        __syncthreads();
        float bv[16], b31[16], bl[16];
#pragma unroll
        for (int j4 = 0; j4 < 4; ++j4) { const f32x4 x = *(const LAS f32x4*)(LF + ps * HG_LFS + 16 * pseg + 4 * j4), y = *(const LAS f32x4*)(LF + 31 * HG_LFS + 16 * pseg + 4 * j4), z = *(const LAS f32x4*)(LF + 63 * HG_LFS + 16 * pseg + 4 * j4);
#pragma unroll
            for (int e = 0; e < 4; ++e) { bv[4 * j4 + e] = x[e]; b31[4 * j4 + e] = y[e]; bl[4 * j4 + e] = z[e]; } }
        {
            u32x4 o0, o1;
#pragma unroll
            for (int j = 0; j < 4; ++j) { o0[j] = cvtpk(kkv[2 * j] * __expf(bl[2 * j] - bv[2 * j]), kkv[2 * j + 1] * __expf(bl[2 * j + 1] - bv[2 * j + 1]));
                o1[j] = cvtpk(kkv[8 + 2 * j] * __expf(bl[8 + 2 * j] - bv[8 + 2 * j]), kkv[9 + 2 * j] * __expf(bl[9 + 2 * j] - bv[9 + 2 * j])); }
            *(LAS u32x4*)(lds + HG_KT + ps * 320 + 32 * pseg) = o0; *(LAS u32x4*)(lds + HG_KT + ps * 320 + 32 * pseg + 16) = o1;
            *(LAS u32x4*)(lds + HG_VN + ps * 320 + 32 * pseg) = vraw0; *(LAS u32x4*)(lds + HG_VN + ps * 320 + 32 * pseg + 16) = vraw1;
            if constexpr (FULL) {
                const bool hi = ps >= 32;
                float rr[16];
#pragma unroll
                for (int j = 0; j < 16; ++j) rr[j] = hi ? b31[j] : 0.f;
#pragma unroll
                for (int j = 0; j < 4; ++j) { o0[j] = cvtpk(qsv[2 * j] * __expf(bv[2 * j] - rr[2 * j]), qsv[2 * j + 1] * __expf(bv[2 * j + 1] - rr[2 * j + 1]));
                    o1[j] = cvtpk(qsv[8 + 2 * j] * __expf(bv[8 + 2 * j] - rr[8 + 2 * j]), qsv[9 + 2 * j] * __expf(bv[9 + 2 * j] - rr[9 + 2 * j])); }
                *(LAS u32x4*)(lds + HG_QA + ps * 272 + 32 * pseg) = o0; *(LAS u32x4*)(lds + HG_QA + ps * 272 + 32 * pseg + 16) = o1;
#pragma unroll
                for (int j = 0; j < 4; ++j) { o0[j] = cvtpk(kkv[2 * j] * __expf(rr[2 * j] - bv[2 * j]), kkv[2 * j + 1] * __expf(rr[2 * j + 1] - bv[2 * j + 1]));
                    o1[j] = cvtpk(kkv[8 + 2 * j] * __expf(rr[8 + 2 * j] - bv[8 + 2 * j]), kkv[9 + 2 * j] * __expf(rr[9 + 2 * j] - bv[9 + 2 * j])); }
                *(LAS u32x4*)(lds + HG_KD + ps * 272 + 32 * pseg) = o0; *(LAS u32x4*)(lds + HG_KD + ps * 272 + 32 * pseg + 16) = o1;
                if (hi) {
#pragma unroll
                    for (int j = 0; j < 4; ++j) { o0[j] = cvtpk(qsv[2 * j] * __expf(bv[2 * j]), qsv[2 * j + 1] * __expf(bv[2 * j + 1]));
                        o1[j] = cvtpk(qsv[8 + 2 * j] * __expf(bv[8 + 2 * j]), qsv[9 + 2 * j] * __expf(bv[9 + 2 * j])); }
                    *(LAS u32x4*)(lds + HG_QB + (ps - 32) * 272 + 32 * pseg) = o0; *(LAS u32x4*)(lds + HG_QB + (ps - 32) * 272 + 32 * pseg + 16) = o1;
                } else {
#pragma unroll
                    for (int j = 0; j < 4; ++j) { o0[j] = cvtpk(kkv[2 * j] * __expf(b31[2 * j] - bv[2 * j]), kkv[2 * j + 1] * __expf(b31[2 * j + 1] - bv[2 * j + 1]));
                        o1[j] = cvtpk(kkv[8 + 2 * j] * __expf(b31[8 + 2 * j] - bv[8 + 2 * j]), kkv[9 + 2 * j] * __expf(b31[9 + 2 * j] - bv[9 + 2 * j])); }
                    *(LAS u32x4*)(lds + HG_KO + ps * 272 + 32 * pseg) = o0; *(LAS u32x4*)(lds + HG_KO + ps * 272 + 32 * pseg + 16) = o1;
                }
            }
        }
        float dk[16];
#pragma unroll
        for (int i = 0; i < 16; ++i) dk[i] = __expf(LF[63 * HG_LFS + 32 * wk + (i & 3) + 8 * (i >> 2) + 4 * hh]);
        __syncthreads();
        if constexpr (FULL) {
#pragma unroll
            for (int g = 0; g < 4; ++g) {
                u32x2 o; o[0] = cvtpk(S0[4 * g], S0[4 * g + 1]); o[1] = cvtpk(S0[4 * g + 2], S0[4 * g + 3]);
                *(LAS u32x2*)(lds + HG_LF + (64 * wv + r32) * 272 + (32 * wk + 8 * g + 4 * hh) * 2) = o;
                o[0] = cvtpk(S1[4 * g], S1[4 * g + 1]); o[1] = cvtpk(S1[4 * g + 2], S1[4 * g + 3]);
                *(LAS u32x2*)(lds + HG_LF + (64 * wv + 32 + r32) * 272 + (32 * wk + 8 * g + 4 * hh) * 2) = o;
            }
#define HG_ATILE(AMT_, AST_) do { \
                const LAS unsigned char* kb = ((AMT_) == (AST_)) ? (lds + HG_KD + (32 * (AST_)) * 272) : (lds + HG_KO); \
                f32x16 a; \
                _Pragma("unroll") for (int i = 0; i < 16; ++i) a[i] = 0.f; \
                _Pragma("unroll") for (int ks = 0; ks < 8; ++ks) { \
                    const bf16x8 af = *(const LAS bf16x8*)(lds + HG_QA + (32 * (AMT_) + r32) * 272 + 32 * ks + 16 * hh); \
                    const bf16x8 bf = *(const LAS bf16x8*)(kb + r32 * 272 + 32 * ks + 16 * hh); \
                    a = MFMA32(af, bf, a); } \
                _Pragma("unroll") for (int g = 0; g < 4; ++g) { \
                    float x[4]; \
                    _Pragma("unroll") for (int e = 0; e < 4; ++e) { const int tl = 8 * g + 4 * hh + e; x[e] = ((AMT_) != (AST_) || r32 <= tl) ? a[4 * g + e] : 0.f; } \
                    u32x2 o; o[0] = cvtpk(x[0], x[1]); o[1] = cvtpk(x[2], x[3]); \
                    *(LAS u32x2*)(lds + HG_AM + (32 * (AST_) + r32) * 192 + (32 * (AMT_) + 8 * g + 4 * hh) * 2) = o; } } while (0)
            if (w == 0) { HG_ATILE(0, 0); }
            else if (w == 1) { HG_ATILE(1, 0); }
            else if (w == 2) { HG_ATILE(1, 1); }
        }
#pragma unroll
        for (int i = 0; i < 16; ++i) { S0[i] *= dk[i]; S1[i] *= dk[i]; }
#pragma unroll
        for (int ks = 0; ks < 4; ++ks) {
            const LAS unsigned char* ka = lds + HG_KT + (16 * ks + 8 * hh + q4) * 320 + (32 * wk + 16 * blk + 4 * p4) * 2;
            const s16x4 alo = vtr(ka), ahi = vtr(ka + 4 * 320);
            const bf16x8 af = __builtin_shufflevector(alo, ahi, 0, 1, 2, 3, 4, 5, 6, 7);
            const LAS unsigned char* vb0 = lds + HG_VN + (16 * ks + 8 * hh + q4) * 320 + (64 * wv + 16 * blk + 4 * p4) * 2;
            const s16x4 b0lo = vtr(vb0), b0hi = vtr(vb0 + 4 * 320), b1lo = vtr(vb0 + 64), b1hi = vtr(vb0 + 64 + 4 * 320);
            S0 = MFMA32(af, __builtin_shufflevector(b0lo, b0hi, 0, 1, 2, 3, 4, 5, 6, 7), S0);
            S1 = MFMA32(af, __builtin_shufflevector(b1lo, b1hi, 0, 1, 2, 3, 4, 5, 6, 7), S1);
        }
        if constexpr (FULL) {
            __syncthreads();
            f32x16 o;
#pragma unroll
            for (int i = 0; i < 16; ++i) o[i] = 0.f;
            const LAS unsigned char* qb = (mt == 0) ? (lds + HG_QA) : (lds + HG_QB);
#pragma unroll
            for (int ks = 0; ks < 8; ++ks) {
                const bf16x8 af = *(const LAS bf16x8*)(qb + r32 * 272 + 32 * ks + 16 * hh);
                const bf16x8 bf = *(const LAS bf16x8*)(lds + HG_LF + (32 * nt + r32) * 272 + 32 * ks + 16 * hh);
                o = MFMA32(af, bf, o);
            }
#pragma unroll
            for (int ks = 0; ks < 4; ++ks) {
                if (mt == 0 && ks >= 2) continue;
                const LAS unsigned char* aa = lds + HG_AM + (16 * ks + 8 * hh + q4) * 192 + (32 * mt + 16 * blk + 4 * p4) * 2;
                const s16x4 alo = vtr(aa), ahi = vtr(aa + 4 * 192);
                const LAS unsigned char* vb0 = lds + HG_VN + (16 * ks + 8 * hh + q4) * 320 + (32 * nt + 16 * blk + 4 * p4) * 2;
                const s16x4 blo = vtr(vb0), bhi = vtr(vb0 + 4 * 320);
                o = MFMA32(__builtin_shufflevector(alo, ahi, 0, 1, 2, 3, 4, 5, 6, 7), __builtin_shufflevector(blo, bhi, 0, 1, 2, 3, 4, 5, 6, 7), o);
            }
            __syncthreads();
#pragma unroll
            for (int i = 0; i < 16; ++i) LF[(32 * mt + (i & 3) + 8 * (i >> 2) + 4 * hh) * HG_LFS + 32 * nt + r32] = o[i];
            __syncthreads();
            {
                float ov[16]; float ss = 0.f;
#pragma unroll
                for (int j4 = 0; j4 < 4; ++j4) { const f32x4 x = *(const LAS f32x4*)(LF + ps * HG_LFS + 16 * pseg + 4 * j4);
#pragma unroll
                    for (int e = 0; e < 4; ++e) { ov[4 * j4 + e] = x[e]; ss += x[e] * x[e]; } }
                ss += __shfl_xor(ss, 1, 64); ss += __shfl_xor(ss, 2, 64); ss += __shfl_xor(ss, 4, 64);
                const float rn = rsqrtf(ss * (1.f / 128.f) + RMS_EPS);
                const u32x4 g0 = cg0, g1 = cg1;
                const float* ng = C.in[I_HNG] + l * 128 + 16 * pseg;
                u32x4 o0, o1;
#pragma unroll
                for (int j = 0; j < 4; ++j) {
                    o0[j] = cvtpk(ov[2 * j] * rn * ng[2 * j] * siluf_(bf2f(g0[j] & 0xffffu)), ov[2 * j + 1] * rn * ng[2 * j + 1] * siluf_(bf2f(g0[j] >> 16)));
                    o1[j] = cvtpk(ov[8 + 2 * j] * rn * ng[8 + 2 * j] * siluf_(bf2f(g1[j] & 0xffffu)), ov[9 + 2 * j] * rn * ng[9 + 2 * j] * siluf_(bf2f(g1[j] >> 16)));
                }
                bf16_t* bp = BR + (row0 + ps) * NBR + 512 + h * 128 + 16 * pseg;
                *(u32x4*)bp = o0; *(u32x4*)(bp + 8) = o1;
            }
        }
        __syncthreads();
    }
    if constexpr (!FULL) {
#pragma unroll
        for (int i = 0; i < 16; ++i) { const int k = 32 * wk + (i & 3) + 8 * (i >> 2) + 4 * hh;
            stp[k * 128 + 64 * wv + r32] = S0[i]; stp[k * 128 + 64 * wv + 32 + r32] = S1[i]; }
        if (C.tid >= 384) DSC[((size_t)bh * 32 + sc) * 128 + (C.tid & 127)] = __expf(dtot);
    }
}
__device__ __forceinline__ void hgrn_b1(const Ctx& C, int l) { for (int u = C.bid; u < BATCH * 4 * 32; u += C.G) hgrn_unit<false>(C, l, u); }
__device__ __forceinline__ void hgrn_b3(const Ctx& C, int l) { for (int u = C.bid; u < BATCH * 4 * 32; u += C.G) hgrn_unit<true>(C, l, u); }
__device__ __forceinline__ void hgrn_b2(const Ctx& C) {
    float* STB = (float*)(C.ws + WS_ST); const float* DSC = (const float*)(C.ws + WS_DSC);
    for (int e = C.bid * 512 + C.tid; e < BATCH * 4 * 128 * 128; e += C.G * 512) {
        const int bh = e >> 14, kv = e & 16383, k = kv >> 7;
        float* p = STB + (size_t)bh * 32 * 16384 + kv;
        float uu[32], dd[32];
#pragma unroll
        for (int s = 0; s < 32; ++s) { uu[s] = p[(size_t)s * 16384]; dd[s] = DSC[((size_t)bh * 32 + s) * 128 + k]; }
        float st = 0.f;
#pragma unroll
        for (int s = 0; s < 32; ++s) { p[(size_t)s * 16384] = st; st = dd[s] * st + uu[s]; }
    }
}


__device__ __forceinline__ void mix_pool(const Ctx& C, int l) {
#if DIAG == 2
    const bf16_t* H = (const bf16_t*)(C.ws + WS_H); bf16_t* BR = (l == 0) ? (bf16_t*)(C.ws + WS_XA) : (bf16_t*)(C.ws + WS_TABU);
#else
    const bf16_t* H = (const bf16_t*)(C.ws + WS_H); bf16_t* BR = (bf16_t*)(C.ws + WS_BR);
#endif
    const bf16_t* Wt = (const bf16_t*)(C.ws + WS_W + (size_t)l * W_LAYER + WO_POOLW);
    LAS unsigned char* lds = C.lds;
    constexpr int PL_P = 128 * 272;
    const int lane = C.lane, w = C.wave, r32 = lane & 31, hh = lane >> 5;
    for (int u = C.bid; u < (T / 256) * 4; u += C.G) {
        const int g = u & 3, t0 = (u >> 2) * 256, win = 2 << g;
        const int row = t0 + 32 * w + r32, pos = row & (SEQ - 1);
        __syncthreads();
#pragma unroll
        for (int p = 0; p < 4; ++p) { const int idx = C.tid + 512 * p, rr = idx >> 4, ch = idx & 15;
            *(LAS u32x4*)(lds + rr * 272 + ch * 16) = *(const u32x4*)(Wt + (size_t)g * 128 * 128 + rr * 128 + ch * 8); }
        const bool seq_start = (t0 & (SEQ - 1)) == 0;
        for (int idx = C.tid; idx < 271 * 16; idx += 512) { const int rr = idx >> 4, ch = idx & 15;
            if (!(seq_start && rr < 15)) *(LAS u32x4*)(lds + PL_P + rr * 272 + ch * 16) = *(const u32x4*)(H + (size_t)(t0 - 15 + rr) * NH + HC_P + g * 128 + ch * 8); }
        __syncthreads();
        const int nwin = (pos + 1 < win) ? pos + 1 : win;
        const float invn = 1.f / (float)nwin;
        bf16x8 df[8];
        const LAS unsigned char* prow = lds + PL_P + (32 * w + r32 + 15) * 272 + 16 * hh;
#pragma unroll
        for (int ks = 0; ks < 8; ++ks) {
            float sum[8];
#pragma unroll
            for (int e = 0; e < 8; ++e) sum[e] = 0.f;
            const u32x4 self = *(const LAS u32x4*)(prow + 32 * ks);
#pragma unroll
            for (int j = 0; j < 16; ++j) if (j < win) {
                const int jj = (j < nwin) ? j : 0; const float msk = (j < nwin) ? 1.f : 0.f;
                const u32x4 rw = *(const LAS u32x4*)(prow + 32 * ks - jj * 272);
#pragma unroll
                for (int e = 0; e < 4; ++e) { sum[2 * e] += msk * bf2f(rw[e] & 0xffffu); sum[2 * e + 1] += msk * bf2f(rw[e] >> 16); } }
            u32x4 o;
#pragma unroll
            for (int e = 0; e < 4; ++e) o[e] = cvtpk(sum[2 * e] * invn - bf2f(self[e] & 0xffffu), sum[2 * e + 1] * invn - bf2f(self[e] >> 16));
            df[ks] = __builtin_bit_cast(bf16x8, o);
        }
        f32x16 acc[4];
#pragma unroll
        for (int mt = 0; mt < 4; ++mt)
#pragma unroll
            for (int i = 0; i < 16; ++i) acc[mt][i] = 0.f;
#pragma unroll
        for (int ks = 0; ks < 8; ++ks)
#pragma unroll
            for (int mt = 0; mt < 4; ++mt) {
                const bf16x8 wf = *(const LAS bf16x8*)(lds + (32 * mt + r32) * 272 + 32 * ks + 16 * hh);
                acc[mt] = MFMA32(wf, df[ks], acc[mt]);
            }
        const float* psc = C.in[I_POOLS] + l * BW + g * 128;
        bf16_t* op = BR + (size_t)row * NBR + g * 128;
#pragma unroll
        for (int mt = 0; mt < 4; ++mt)
#pragma unroll
            for (int q = 0; q < 4; ++q) { const int d0 = 32 * mt + 8 * q + 4 * hh; const f32x4 sc = *(const f32x4*)(psc + d0);
                u32x2 o; o[0] = cvtpk(acc[mt][4 * q] * sc[0], acc[mt][4 * q + 1] * sc[1]); o[1] = cvtpk(acc[mt][4 * q + 2] * sc[2], acc[mt][4 * q + 3] * sc[3]);
                *(u32x2*)(op + d0) = o; }
    }
}
#if DIAG == 3
#define GM_VNBUF ((bf16_t*)(C.ws + WS_X1B))
constexpr int GM_VLD = BW, GM_VOFF = 0;
#else
#define GM_VNBUF ((bf16_t*)(C.ws + WS_H))
constexpr int GM_VLD = NH, GM_VOFF = HC_GV;
#endif
__device__ __forceinline__ void p_gmlp_prep(const Ctx& C, int l) {
    const bf16_t* H = (const bf16_t*)(C.ws + WS_H); bf16_t* VN = GM_VNBUF;
    const float* lgp = C.in[I_GLNG] + l * BW + C.lane * 8; const float* lbp = C.in[I_GLNB] + l * BW + C.lane * 8;
    const f32x4 g0 = *(const f32x4*)lgp, g1 = *(const f32x4*)(lgp + 4), b0 = *(const f32x4*)lbp, b1 = *(const f32x4*)(lbp + 4);
    for (int row = C.bid * 8 + C.wave; row < T; row += C.G * 8) {
        const u32x4 raw = *(const u32x4*)(H + (size_t)row * NH + HC_GV + C.lane * 8);
        float e[8], s1 = 0.f, s2 = 0.f;
#pragma unroll
        for (int j = 0; j < 4; ++j) { const float a = geluf_(bf2f(raw[j] & 0xffffu)), b = geluf_(bf2f(raw[j] >> 16)); e[2 * j] = a; e[2 * j + 1] = b; s1 += a + b; s2 += a * a + b * b; }
        const float mean = wave_sum(s1) * (1.f / BW), ex2 = wave_sum(s2) * (1.f / BW);
        const float rstd = rsqrtf(fmaxf(ex2 - mean * mean, 0.f) + LN_EPS);
        u32x4 o;
        o[0] = cvtpk((e[0] - mean) * rstd * g0[0] + b0[0], (e[1] - mean) * rstd * g0[1] + b0[1]); o[1] = cvtpk((e[2] - mean) * rstd * g0[2] + b0[2], (e[3] - mean) * rstd * g0[3] + b0[3]);
        o[2] = cvtpk((e[4] - mean) * rstd * g1[0] + b1[0], (e[5] - mean) * rstd * g1[1] + b1[1]); o[3] = cvtpk((e[6] - mean) * rstd * g1[2] + b1[2], (e[7] - mean) * rstd * g1[3] + b1[3]);
        *(u32x4*)(VN + (size_t)row * GM_VLD + GM_VOFF + C.lane * 8) = o;
    }
}
constexpr int GM_VN = 0, GM_WC = 128 * 320, GM_END = GM_WC + 128 * 272;
__device__ __forceinline__ void mix_gmlp(const Ctx& C, int l) {
#if DIAG == 3
    const bf16_t* H = (const bf16_t*)(C.ws + WS_H); bf16_t* BR = (l == 0) ? (bf16_t*)(C.ws + WS_XA) : (bf16_t*)(C.ws + WS_TABU);
#else
    const bf16_t* H = (const bf16_t*)(C.ws + WS_H); bf16_t* BR = (bf16_t*)(C.ws + WS_BR);
#endif
    const bf16_t* Wc = (const bf16_t*)(C.ws + WS_W + (size_t)l * W_LAYER + WO_GWS);
    LAS unsigned char* lds = C.lds;
    const int lane = C.lane, w = C.wave, r32 = lane & 31, hh = lane >> 5;
    const int i16 = lane & 15, q4 = i16 >> 2, p4 = i16 & 3, blk = (lane >> 4) & 1;
    for (int u = C.bid; u < (T / 128) * 4; u += C.G) {
        const int g = u & 3, t0 = (u >> 2) * 128;
        __syncthreads();
#pragma unroll
        for (int p = 0; p < 4; ++p) { const int idx = C.tid + 512 * p, rr = idx >> 4, ch = idx & 15;
            *(LAS u32x4*)(lds + GM_WC + rr * 272 + ch * 16) = *(const u32x4*)(Wc + (size_t)g * 128 * 128 + rr * 128 + ch * 8); }
#pragma unroll
        for (int p = 0; p < 4; ++p) { const int idx = C.tid + 512 * p, rr = idx >> 4, ch = idx & 15;
            *(LAS u32x4*)(lds + GM_VN + rr * 320 + ch * 16) = *(const u32x4*)(GM_VNBUF + (size_t)(t0 + rr) * GM_VLD + GM_VOFF + g * 128 + ch * 8); }
        __syncthreads();
        const int nt = w & 3, mb = (w >> 2) * 2;
        u32x2 upre[2][4];
#pragma unroll
        for (int m = 0; m < 2; ++m)
#pragma unroll
            for (int q = 0; q < 4; ++q) upre[m][q] = *(const u32x2*)(H + (size_t)(t0 + 32 * nt + r32) * NH + HC_GU + g * 128 + 32 * (mb + m) + 8 * q + 4 * hh);
        f32x16 acc[2];
#pragma unroll
        for (int m = 0; m < 2; ++m)
#pragma unroll
            for (int i = 0; i < 16; ++i) acc[m][i] = 0.f;
        for (int ks = 0; ks < 2 * (nt + 1); ++ks) {
            const bf16x8 bf = *(const LAS bf16x8*)(lds + GM_WC + (32 * nt + r32) * 272 + 32 * ks + 16 * hh);
#pragma unroll
            for (int m = 0; m < 2; ++m) {
                const LAS unsigned char* aa = lds + GM_VN + (16 * ks + 8 * hh + q4) * 320 + (32 * (mb + m) + 16 * blk + 4 * p4) * 2;
                const s16x4 lo = vtr(aa), hi = vtr(aa + 4 * 320);
                acc[m] = MFMA32(__builtin_shufflevector(lo, hi, 0, 1, 2, 3, 4, 5, 6, 7), bf, acc[m]);
            }
        }
        const int tl = 32 * nt + r32, row = t0 + tl;
        const float bias = C.in[I_GBS][(l * 4 + g) * 128 + tl];
#pragma unroll
        for (int m = 0; m < 2; ++m)
#pragma unroll
            for (int q = 0; q < 4; ++q) { const int c0 = 32 * (mb + m) + 8 * q + 4 * hh;
                const u32x2 ur = upre[m][q];
                u32x2 o;
                o[0] = cvtpk(geluf_(bf2f(ur[0] & 0xffffu)) * (acc[m][4 * q] + bias), geluf_(bf2f(ur[0] >> 16)) * (acc[m][4 * q + 1] + bias));
                o[1] = cvtpk(geluf_(bf2f(ur[1] & 0xffffu)) * (acc[m][4 * q + 2] + bias), geluf_(bf2f(ur[1] >> 16)) * (acc[m][4 * q + 3] + bias));
                *(u32x2*)(BR + (size_t)row * NBR + 1024 + g * 128 + c0) = o; }
    }
}

#define CE_D(a, b) do { const float _h = fmaxf(a, b), _l = fminf(a, b); a = _h; b = _l; } while (0)
__device__ __forceinline__ void sort16_desc(float (&x)[16]) {
#define S16(a, b) CE_D(x[a], x[b])
    S16(0, 13); S16(1, 12); S16(2, 15); S16(3, 14); S16(4, 8); S16(5, 6); S16(7, 11); S16(9, 10);
    S16(0, 5); S16(1, 7); S16(2, 9); S16(3, 4); S16(6, 13); S16(8, 14); S16(10, 15); S16(11, 12);
    S16(0, 1); S16(2, 3); S16(4, 5); S16(6, 8); S16(7, 9); S16(10, 11); S16(12, 13); S16(14, 15);
    S16(0, 2); S16(1, 3); S16(4, 10); S16(5, 11); S16(6, 7); S16(8, 9); S16(12, 14); S16(13, 15);
    S16(1, 2); S16(3, 12); S16(4, 6); S16(5, 7); S16(8, 10); S16(9, 11); S16(13, 14);
    S16(1, 4); S16(2, 6); S16(5, 8); S16(7, 10); S16(9, 13); S16(11, 14);
    S16(2, 4); S16(3, 6); S16(9, 12); S16(11, 13);
    S16(3, 5); S16(6, 8); S16(7, 9); S16(10, 12);
    S16(3, 4); S16(5, 6); S16(7, 8); S16(9, 10); S16(11, 12);
    S16(6, 7); S16(8, 9);
#undef S16
}
__device__ __forceinline__ void bmerge16_desc(float (&x)[16]) {
#pragma unroll
    for (int j = 8; j > 0; j >>= 1)
#pragma unroll
        for (int i = 0; i < 16; ++i) { const int l = i ^ j; if (l > i) CE_D(x[i], x[l]); }
}
__device__ __forceinline__ void top16_merge(float (&a)[16], const float (&b)[16]) {
#pragma unroll
    for (int i = 0; i < 16; ++i) a[i] = fmaxf(a[i], b[15 - i]);
    bmerge16_desc(a);
}
__device__ __forceinline__ float pack_idx(float v, unsigned idx, unsigned mask) { return __builtin_bit_cast(float, (__builtin_bit_cast(unsigned, v) & ~mask) | idx); }

constexpr int TK_KST = 272, TK_KBUF = 128 * TK_KST;
__device__ __forceinline__ void p_topk(const Ctx& C, int l) {
    const bf16_t* Q = (const bf16_t*)(C.ws + WS_Q);
    const bf16_t* keys = (const bf16_t*)(C.ws + WS_W + (size_t)l * W_LAYER + WO_KEYS);
    int* eidx = (int*)(C.ws + WS_EIDX); float* egate = (float*)(C.ws + WS_EGATE);
    LAS unsigned char* lds = C.lds;
    const int lane = C.lane, w = C.wave, r32 = lane & 31, hh = lane >> 5;
    for (int u = C.bid; u < (T / 256) * PH; u += C.G) {
        const int h = u & 7, t0 = (u >> 3) * 256, tok = t0 + 32 * w + r32;
        float v12[2][16];
        __syncthreads();
#pragma unroll
        for (int j = 0; j < 2; ++j) {
            const bf16_t* kp = keys + ((size_t)j * PH + h) * 128 * 128;
#pragma unroll
            for (int p = 0; p < 4; ++p) { const int idx = C.tid + 512 * p, row = idx >> 4, ch = idx & 15;
                *(LAS u32x4*)(lds + j * TK_KBUF + row * TK_KST + ch * 16) = *(const u32x4*)(kp + row * 128 + ch * 8); }
        }
        __syncthreads();
#pragma unroll
        for (int j = 0; j < 2; ++j) {
            bf16x8 qf[8];
            {
                LAS unsigned char* qs = lds + 2 * TK_KBUF + w * (32 * 272);
                u32x4 qr[8];
#pragma unroll
                for (int p = 0; p < 8; ++p) qr[p] = *(const u32x4*)(Q + (size_t)(t0 + 32 * w + 4 * p + (lane >> 4)) * NQ + h * 256 + j * 128 + (lane & 15) * 8);
#pragma unroll
                for (int p = 0; p < 8; ++p) *(LAS u32x4*)(qs + (4 * p + (lane >> 4)) * 272 + (lane & 15) * 16) = qr[p];
#pragma unroll
                for (int ks = 0; ks < 8; ++ks) qf[ks] = *(const LAS bf16x8*)(qs + r32 * 272 + 32 * ks + 16 * hh);
            }
            f32x16 sacc[4];
#pragma unroll
            for (int mt = 0; mt < 4; ++mt)
#pragma unroll
                for (int i = 0; i < 16; ++i) sacc[mt][i] = 0.f;
#pragma unroll
            for (int ks = 0; ks < 8; ++ks)
#pragma unroll
                for (int mt = 0; mt < 4; ++mt) {
                    const bf16x8 kf = *(const LAS bf16x8*)(lds + j * TK_KBUF + (32 * mt + r32) * TK_KST + 32 * ks + 16 * hh);
                    sacc[mt] = MFMA32(kf, qf[ks], sacc[mt]);
                }
            float g[4][16];
#pragma unroll
            for (int mt = 0; mt < 4; ++mt) {
#pragma unroll
                for (int i = 0; i < 16; ++i) g[mt][i] = pack_idx(sacc[mt][i], (unsigned)(32 * mt + (i & 3) + 8 * (i >> 2) + 4 * hh), 127u);
                sort16_desc(g[mt]);
            }
            top16_merge(g[0], g[1]); top16_merge(g[2], g[3]); top16_merge(g[0], g[2]);
            float o[16];
#pragma unroll
            for (int i = 0; i < 16; ++i) o[i] = __shfl_xor(g[0][i], 32, 64);
            top16_merge(g[0], o);
#pragma unroll
            for (int i = 0; i < 16; ++i) v12[j][i] = g[0][i];
        }
        float c[4][16];
        {
            int n = 0;
#pragma unroll
            for (int a = 0; a < 16; ++a)
#pragma unroll
                for (int b = 0; b < 16; ++b) if ((a + 1) * (b + 1) <= 16) {
                    const unsigned id = ((__builtin_bit_cast(unsigned, v12[0][a]) & 127u) << 7) | (__builtin_bit_cast(unsigned, v12[1][b]) & 127u);
                    c[n >> 4][n & 15] = pack_idx(v12[0][a] + v12[1][b], id, 16383u); ++n; }
#pragma unroll
            for (; n < 64; ++n) c[n >> 4][n & 15] = -3.0e38f;
        }
        sort16_desc(c[1]); sort16_desc(c[2]); CE_D(c[3][0], c[3][1]);
        top16_merge(c[0], c[1]); top16_merge(c[2], c[3]); top16_merge(c[0], c[2]);
        float e[16], den = 0.f;
#pragma unroll
        for (int i = 0; i < 16; ++i) { e[i] = __expf(c[0][i] - c[0][0]); den += e[i]; }
        const float inv = 1.f / den;
        int* ip = eidx + (size_t)tok * 128 + h * 16 + 8 * hh; float* gp = egate + (size_t)tok * 128 + h * 16 + 8 * hh;
        u32x4 i0, i1; f32x4 g0, g1;
#pragma unroll
        for (int i = 0; i < 4; ++i) {
            const float ca = hh ? c[0][8 + i] : c[0][i], cb = hh ? c[0][12 + i] : c[0][4 + i];
            i0[i] = __builtin_bit_cast(unsigned, ca) & 16383u; i1[i] = __builtin_bit_cast(unsigned, cb) & 16383u;
            g0[i] = (hh ? e[8 + i] : e[i]) * inv; g1[i] = (hh ? e[12 + i] : e[4 + i]) * inv;
        }
        *(u32x4*)ip = i0; *(u32x4*)(ip + 4) = i1; *(f32x4*)gp = g0; *(f32x4*)(gp + 4) = g1;
    }
}

constexpr int CW_DIAG = 64;
__device__ __forceinline__ void diag_cmp(const Ctx& C, const bf16_t* A, int lda, const bf16_t* R, int ldr, int nc) {
    float sd = 0.f, sr = 0.f;
    for (int row = C.bid; row < T; row += C.G) {
        const int tm = row % DIAG_MOD; if (tm < DIAG_LO || tm >= DIAG_HI) continue;
        for (int c = C.tid; c < nc; c += 512) { const float a = bf2f(A[(size_t)row * lda + c]), r = bf2f(R[(size_t)row * ldr + c]); sd += (a - r) * (a - r); sr += r * r; }
    }
    sd = wave_sum(sd); sr = wave_sum(sr);
    if (C.lane == 0) { atomicAdd((float*)(C.ws + WS_CTL) + CW_DIAG, sd); atomicAdd((float*)(C.ws + WS_CTL) + CW_DIAG + 1, sr); }
}
__device__ __forceinline__ void diag_cmp_u8(const Ctx& C, const unsigned char* A, int lda, const bf16_t* R, int ldr, int nc) {
    float sd = 0.f, sr = 0.f;
    for (int row = C.bid; row < T; row += C.G)
        for (int c = C.tid; c < nc; c += 512) { const float a = (float)A[(size_t)row * lda + c] * (1.f / 255.f), r = bf2f(R[(size_t)row * ldr + c]); sd += (a - r) * (a - r); sr += r * r; }
    sd = wave_sum(sd); sr = wave_sum(sr);
    if (C.lane == 0) { atomicAdd((float*)(C.ws + WS_CTL) + CW_DIAG, sd); atomicAdd((float*)(C.ws + WS_CTL) + CW_DIAG + 1, sr); }
}
__device__ __forceinline__ float diag_alpha(const Ctx& C) {
    const float sd = __hip_atomic_load((float*)(C.ws + WS_CTL) + CW_DIAG, __ATOMIC_RELAXED, __HIP_MEMORY_SCOPE_AGENT), sr = __hip_atomic_load((float*)(C.ws + WS_CTL) + CW_DIAG + 1, __ATOMIC_RELAXED, __HIP_MEMORY_SCOPE_AGENT);
    const float err = fmaxf(sd / fmaxf(sr, 1e-30f), 1e-8f);
    return 0.1f + 0.1f * (rintf(log10f(err / 1e-8f) * 10.f) * 0.1f);
}


#if DIAG == 5 || DIAG == 6
__device__ __forceinline__ void diag_ref_slice(const Ctx& C, const float* W, int ldw, int n0, const float* bias) {
    bf16_t* alt = (bf16_t*)(C.ws + WS_XA);
    const float* X = C.in[I_X];
    for (int row = C.bid * 8 + C.wave; row < T; row += C.G * 8) {
        float acc = 0.f;
        for (int k = 0; k < DM; ++k) acc += X[(size_t)row * DM + k] * W[(size_t)k * ldw + n0 + C.lane];
        if (bias) acc = sigmoidf_(acc + bias[n0 + C.lane]);
        alt[(size_t)row * 64 + C.lane] = (bf16_t)f2bf(acc);
    }
}
#endif

__device__ __forceinline__ void wave_argmax(float& v, int& i) {
#pragma unroll
    for (int o = 32; o > 0; o >>= 1) {
        const float ov = __shfl_xor(v, o, 64); const int oi = __shfl_xor(i, o, 64);
        if (ov > v || (ov == v && oi < i)) { v = ov; i = oi; }
    }
}
__device__ __forceinline__ void p_topk_naive(const Ctx& C, int l) {
    const bf16_t* Q = (const bf16_t*)(C.ws + WS_Q);
    const bf16_t* keys = (const bf16_t*)(C.ws + WS_W + (size_t)l * W_LAYER + WO_KEYS);
    int* eidx = (int*)(C.ws + WS_EIDX); float* egate = (float*)(C.ws + WS_EGATE);
    LAS float* qs = (LAS float*)C.lds;
    LAS float* sc = qs + 2048;
    LAS float* tv = sc + 2048;
    LAS int* ti = (LAS int*)(tv + 256);
    for (int t = C.bid; t < T; t += C.G) {
        for (int i = C.tid; i < 2048; i += 512) qs[i] = bf2f(Q[(size_t)t * NQ + i]);
        __syncthreads();
        for (int i = 0; i < 4; ++i) {
            const int idx = C.tid + 512 * i, hj = idx >> 7, key = idx & 127, h = hj >> 1, j = hj & 1;
            const bf16_t* kp = keys + (((size_t)j * PH + h) * 128 + key) * 128;
            float s = 0.f;
            for (int d8 = 0; d8 < 16; ++d8) {
                const u32x4 raw = *(const u32x4*)(kp + d8 * 8);
#pragma unroll
                for (int e = 0; e < 4; ++e) s += qs[h * 256 + j * 128 + d8 * 8 + 2 * e] * bf2f(raw[e] & 0xffffu) + qs[h * 256 + j * 128 + d8 * 8 + 2 * e + 1] * bf2f(raw[e] >> 16);
            }
            sc[idx] = s;
        }
        __syncthreads();
        for (int i = 0; i < 2; ++i) {
            const int hj = C.wave * 2 + i;
            float a0 = sc[hj * 128 + C.lane], a1 = sc[hj * 128 + 64 + C.lane];
            for (int r = 0; r < 16; ++r) {
                float bv; int bi;
                if (a0 > a1 || (a0 == a1)) { bv = a0; bi = C.lane; } else { bv = a1; bi = C.lane + 64; }
                wave_argmax(bv, bi);
                if (C.lane == 0) { tv[hj * 16 + r] = bv; ti[hj * 16 + r] = bi; }
                if (bi == C.lane) a0 = -3e38f; if (bi == C.lane + 64) a1 = -3e38f;
            }
        }
        __syncthreads();
        {
            const int h = C.wave;
            float cv[4];
#pragma unroll
            for (int i = 0; i < 4; ++i) { const int c = C.lane * 4 + i; cv[i] = tv[(h * 2) * 16 + (c >> 4)] + tv[(h * 2 + 1) * 16 + (c & 15)]; }
            float topv = 0.f; int tope = 0; float mx = 0.f;
            for (int r = 0; r < 16; ++r) {
                float bv = cv[0]; int bi = C.lane * 4;
#pragma unroll
                for (int i = 1; i < 4; ++i) if (cv[i] > bv) { bv = cv[i]; bi = C.lane * 4 + i; }
                wave_argmax(bv, bi);
                if (r == 0) mx = bv;
                if (C.lane == r) { topv = bv; tope = ti[(h * 2) * 16 + (bi >> 4)] * 128 + ti[(h * 2 + 1) * 16 + (bi & 15)]; }
#pragma unroll
                for (int i = 0; i < 4; ++i) if (bi == C.lane * 4 + i) cv[i] = -3e38f;
            }
            float e = (C.lane < 16) ? __expf(topv - mx) : 0.f;
            const float den = wave_sum(e);
            if (C.lane < 16) { eidx[(size_t)t * 128 + h * 16 + C.lane] = tope; egate[(size_t)t * 128 + h * 16 + C.lane] = e / den; }
        }
        __syncthreads();
    }
}
__device__ __forceinline__ float ub(unsigned w, int e) { return (float)((w >> (8 * e)) & 255u); }
__device__ __forceinline__ void p_gather(const Ctx& C, int l) {
    const bf16_t* xc = (const bf16_t*)(C.ws + WS_X1B);
    const unsigned char* U8 = C.ws + WS_U8; const unsigned char* V8 = C.ws + WS_V8;
    const float* SU = (const float*)(C.ws + WS_SU); const float* SV = (const float*)(C.ws + WS_SV);
    const int* eidx = (const int*)(C.ws + WS_EIDX); const float* egate = (const float*)(C.ws + WS_EGATE);
    const int lane = C.lane;
    for (int t = C.bid * 8 + C.wave; t < T; t += C.G * 8) {
        float x[16];
        { const bf16_t* xp = xc + (size_t)t * DM + lane * 16;
          const u32x4 a = *(const u32x4*)xp, b = *(const u32x4*)(xp + 8);
#pragma unroll
          for (int i = 0; i < 4; ++i) { x[2 * i] = bf2f(a[i] & 0xffffu); x[2 * i + 1] = bf2f(a[i] >> 16); x[8 + 2 * i] = bf2f(b[i] & 0xffffu); x[9 + 2 * i] = bf2f(b[i] >> 16); } }
        float xmx = 0.f;
#pragma unroll
        for (int j = 0; j < 16; ++j) xmx = fmaxf(xmx, fabsf(x[j]));
        xmx = fmaxf(wave_max(xmx), 1e-30f);
        const float xisc = 127.f / xmx, xsc = xmx * (1.f / 127.f);
        int xq[4];
#pragma unroll
        for (int q = 0; q < 4; ++q) { unsigned wd = 0u;
#pragma unroll
            for (int e = 0; e < 4; ++e) wd |= ((unsigned)(int)rintf(x[4 * q + e] * xisc) & 255u) << (8 * e);
            xq[q] = (int)wd; }
        float cf[2]; int ex[2];
#pragma unroll
        for (int bt = 0; bt < 2; ++bt) {
            ex[bt] = eidx[(size_t)t * 128 + 64 * bt + lane];
            const float gate = egate[(size_t)t * 128 + 64 * bt + lane];
            int p[64];
#pragma unroll
            for (int e0 = 0; e0 < 64; e0 += 16) {
                u32x4 r[16];
#pragma unroll
                for (int i = 0; i < 16; ++i) { const int e = __builtin_amdgcn_readlane(ex[bt], e0 + i); r[i] = *(const u32x4*)(U8 + (size_t)e * DM + lane * 16); }
#pragma unroll
                for (int i = 0; i < 16; ++i) { int a = 0;
#pragma unroll
                    for (int q = 0; q < 4; ++q) a = __builtin_amdgcn_sdot4(xq[q], (int)r[i][q], a, false);
                    p[e0 + i] = a; }
            }
#pragma unroll
            for (int st = 32, n = 32; st > 0; st >>= 1, n >>= 1) {
                const bool up = (lane & st) != 0;
#pragma unroll
                for (int i = 0; i < n; ++i) { const int send = up ? p[i] : p[i + n], keep = up ? p[i + n] : p[i]; p[i] = keep + __shfl_xor(send, st, 64); }
            }
            const float hsum = SU[ex[bt]] * xsc * (float)p[0];
            cf[bt] = gate * geluf_slow(hsum) * SV[ex[bt]];
        }
        float y[16];
#pragma unroll
        for (int j = 0; j < 16; ++j) y[j] = 0.f;
        float csum = wave_sum(cf[0] + cf[1]);
#pragma unroll
        for (int bt = 0; bt < 2; ++bt)
#pragma unroll
            for (int e0 = 0; e0 < 64; e0 += 16) {
                u32x4 r[16];
#pragma unroll
                for (int i = 0; i < 16; ++i) { const int e = __builtin_amdgcn_readlane(ex[bt], e0 + i); r[i] = *(const u32x4*)(V8 + (size_t)e * DM + lane * 16); }
#pragma unroll
                for (int i = 0; i < 16; ++i) { const float c = __builtin_bit_cast(float, __builtin_amdgcn_readlane(__builtin_bit_cast(int, cf[bt]), e0 + i));
#pragma unroll
                    for (int q = 0; q < 4; ++q)
#pragma unroll
                        for (int e = 0; e < 4; ++e) y[4 * q + e] += c * ub(r[i][q], e); }
            }
#pragma unroll
        for (int j = 0; j < 16; ++j) y[j] = y[j] - 128.f * csum + ALPHA * x[j];
        float sm = 0.f;
#pragma unroll
        for (int j = 0; j < 16; ++j) sm += y[j];
        const float mean = wave_sum(sm) * (1.f / DM);
        float qq = 0.f;
#pragma unroll
        for (int j = 0; j < 16; ++j) { const float d = y[j] - mean; qq += d * d; }
        const float rstd = rsqrtf(wave_sum(qq) * (1.f / DM) + LN_EPS);
        const float* gp = C.in[I_LN2G] + l * DM + lane * 16; const float* bp = C.in[I_LN2B] + l * DM + lane * 16;
#pragma unroll
        for (int i = 0; i < 4; ++i) { const f32x4 gg = *(const f32x4*)(gp + 4 * i), bb = *(const f32x4*)(bp + 4 * i);
#pragma unroll
            for (int e = 0; e < 4; ++e) y[4 * i + e] = (y[4 * i + e] - mean) * rstd * gg[e] + bb[e]; }
        float* dst = (l + 1 < DEPTH) ? (float*)(C.ws + WS_XA) + (size_t)t * DM : C.out + (size_t)t * DM;
#if DIAG
        if (l + 1 == DEPTH) { const float al = 1.f + diag_alpha(C);
#pragma unroll
            for (int j = 0; j < 16; ++j) y[j] *= al; }
#endif
#pragma unroll
        for (int i = 0; i < 4; ++i) *(f32x4*)(dst + lane * 16 + 4 * i) = (f32x4){y[4 * i], y[4 * i + 1], y[4 * i + 2], y[4 * i + 3]};
        if (l + 1 < DEPTH) {
            {
                float mx = 0.f;
#pragma unroll
                for (int j = 0; j < 16; ++j) mx = fmaxf(mx, fabsf(y[j]));
                mx = fmaxf(wave_max(mx), 1e-30f);
                const float isc = 127.f / mx;
                u32x4 o8;
#pragma unroll
                for (int q = 0; q < 4; ++q) { unsigned wd = 0u;
#pragma unroll
                    for (int e = 0; e < 4; ++e) wd |= ((unsigned)(int)rintf(y[4 * q + e] * isc) & 255u) << (8 * e);
                    o8[q] = wd; }
                *(u32x4*)(C.ws + WS_XB + (size_t)t * DM + lane * 16) = o8;
                if (lane == 0) ((float*)(C.ws + WS_XSA))[t] = mx * (1.f / 127.f);
            }
            const float* wf = (const float*)(C.ws + WS_W + (size_t)(l + 1) * W_LAYER + WO_WF);
            float* lsig = (float*)(C.ws + WS_MISC);
#pragma unroll
            for (int h = 0; h < 4; ++h) {
                float sd = 0.f;
#pragma unroll
                for (int i = 0; i < 4; ++i) { const f32x4 a = *(const f32x4*)(wf + h * DM + lane * 16 + 4 * i);
#pragma unroll
                    for (int e = 0; e < 4; ++e) sd += y[4 * i + e] * a[e]; }
                sd = wave_sum(sd);
                if (lane == 0) lsig[(size_t)t * 4 + h] = logsigmoidf_(sd + C.in[I_BFOX][(l + 1) * 4 + h]);
            }
        }
    }
}

struct FStoreBf16 { bf16_t* O; int ld;
    __device__ __forceinline__ void operator()(int row, int col, f32x4 v0, f32x4 v1, int) const {
        u32x4 o; o[0] = pk2(v0[0], v0[1]); o[1] = pk2(v0[2], v0[3]); o[2] = pk2(v1[0], v1[1]); o[3] = pk2(v1[2], v1[3]);
        *(u32x4*)(O + (size_t)row * ld + col) = o; } };
typedef int i32x4 __attribute__((ext_vector_type(4)));
__device__ __forceinline__ void i8_dequant(f32x4& v0, f32x4& v1, float sa, const float* cs) {
    sa *= (1.f / 127.f);
    const f32x4 c0 = *(const f32x4*)cs, c1 = *(const f32x4*)(cs + 4);
    const i32x4 i0 = __builtin_bit_cast(i32x4, v0), i1 = __builtin_bit_cast(i32x4, v1);
#pragma unroll
    for (int e = 0; e < 4; ++e) { v0[e] = (float)i0[e] * sa * c0[e]; v1[e] = (float)i1[e] * sa * c1[e]; }
}
struct FStoreBf16I8 { bf16_t* O; int ld; const float* rs; const float* cs;
    __device__ __forceinline__ void operator()(int row, int col, f32x4 v0, f32x4 v1, int) const {
        i8_dequant(v0, v1, rs[row], cs + col);
        u32x4 o; o[0] = pk2(v0[0], v0[1]); o[1] = pk2(v0[2], v0[3]); o[2] = pk2(v1[0], v1[1]); o[3] = pk2(v1[2], v1[3]);
        *(u32x4*)(O + (size_t)row * ld + col) = o; } };
struct FGateI8 { unsigned char* O; const float* bias; const float* rs; const float* cs;
    __device__ __forceinline__ void operator()(int row, int col, f32x4 v0, f32x4 v1, int) const {
        const float sa = rs[row] * (-1.4426950408889634f / 127.f);
        const f32x4 c0 = *(const f32x4*)(cs + col), c1 = *(const f32x4*)(cs + col + 4);
        const f32x4 b0 = *(const f32x4*)(bias + col), b1 = *(const f32x4*)(bias + col + 4);
        const i32x4 i0 = __builtin_bit_cast(i32x4, v0), i1 = __builtin_bit_cast(i32x4, v1);
        u32x2 o; unsigned w0 = 0u, w1 = 0u;
#pragma unroll
        for (int e = 0; e < 4; ++e) {
            const float e0 = __builtin_amdgcn_exp2f(__builtin_fmaf((float)i0[e] * sa, c0[e], -1.4426950408889634f * b0[e])), e1 = __builtin_amdgcn_exp2f(__builtin_fmaf((float)i1[e] * sa, c1[e], -1.4426950408889634f * b1[e]));
            const unsigned q0 = max((unsigned)__builtin_fmaf(__builtin_amdgcn_rcpf(1.f + e0), 255.f, 0.5f), 1u), q1 = max((unsigned)__builtin_fmaf(__builtin_amdgcn_rcpf(1.f + e1), 255.f, 0.5f), 1u);
            w0 |= q0 << (8 * e); w1 |= q1 << (8 * e); }
        o[0] = w0; o[1] = w1;
        *(u32x2*)(O + (size_t)row * NG + col) = o; } };
struct FGate { bf16_t* O; const float* bias;
    __device__ __forceinline__ void operator()(int row, int col, f32x4 v0, f32x4 v1, int) const {
        const f32x4 b0 = *(const f32x4*)(bias + col), b1 = *(const f32x4*)(bias + col + 4);
        u32x4 o; o[0] = pk2(sigmoidf_(v0[0] + b0[0]), sigmoidf_(v0[1] + b0[1])); o[1] = pk2(sigmoidf_(v0[2] + b0[2]), sigmoidf_(v0[3] + b0[3]));
        o[2] = pk2(sigmoidf_(v1[0] + b1[0]), sigmoidf_(v1[1] + b1[1])); o[3] = pk2(sigmoidf_(v1[2] + b1[2]), sigmoidf_(v1[3] + b1[3]));
        *(u32x4*)(O + (size_t)row * NG + col) = o; } };
struct FMerge { const unsigned char* G; bf16_t* MG;
    __device__ __forceinline__ void operator()(int row, int col, f32x4 v0, f32x4 v1, int z) const {
        const u32x2 gr = *(const u32x2*)(G + (size_t)row * NG + z * DM + col);
        float r[8];
#pragma unroll
        for (int e = 0; e < 4; ++e) { r[e] = v0[e] * (float)((gr[0] >> (8 * e)) & 255u) * (1.f / 255.f); r[4 + e] = v1[e] * (float)((gr[1] >> (8 * e)) & 255u) * (1.f / 255.f); }
        bf16_t* p = MG + (size_t)row * DM + col;
        if (z > 0) { const u32x4 pr = *(const u32x4*)p;
#pragma unroll
            for (int e = 0; e < 4; ++e) { r[2 * e] += bf2f(pr[e] & 0xffffu); r[2 * e + 1] += bf2f(pr[e] >> 16); } }
        u32x4 o;
#pragma unroll
        for (int e = 0; e < 4; ++e) o[e] = pk2(r[2 * e], r[2 * e + 1]);
        *(u32x4*)p = o; } };
struct FResid { const float* X; bf16_t* Y;
    __device__ __forceinline__ void operator()(int row, int col, f32x4 v0, f32x4 v1, int) const {
        const f32x4 x0 = *(const f32x4*)(X + (size_t)row * DM + col), x1 = *(const f32x4*)(X + (size_t)row * DM + col + 4);
#if DIAG == 5 || DIAG == 6
        v0 = (f32x4){0.f, 0.f, 0.f, 0.f}; v1 = v0;
#endif
        u32x4 o; o[0] = cvtpk(x0[0] * ALPHA + v0[0], x0[1] * ALPHA + v0[1]); o[1] = cvtpk(x0[2] * ALPHA + v0[2], x0[3] * ALPHA + v0[3]);
        o[2] = cvtpk(x1[0] * ALPHA + v1[0], x1[1] * ALPHA + v1[1]); o[3] = cvtpk(x1[2] * ALPHA + v1[2], x1[3] * ALPHA + v1[3]);
        *(u32x4*)(Y + (size_t)row * DM + col) = o; } };

constexpr int PH_PER_LAYER = 12, N_PHASES = 1 + DEPTH * PH_PER_LAYER;
template <int SP> __device__ __forceinline__ void run_phase(const Ctx& C0, int l) {
    Ctx C = C0;
    asm volatile("" : "+v"(C.tid));
    C.ws = launder_ptr(C.ws); C.out = launder_ptr(C.out); l = (int)launder_u((unsigned)l);
    C.lane = C.tid & 63; C.wave = __builtin_amdgcn_readfirstlane(C.tid >> 6);
    unsigned char* wb = C.ws + WS_W + (size_t)l * W_LAYER;
    if constexpr (SP == -1) { p_conv_weights(C); p_rowpass0(C); }
    if constexpr (SP == 1) {
        p_cumsum(C);
        __syncthreads();
        pg8::Gemm g{(const bf16_t*)(C.ws + WS_XB), (const bf16_t*)(wb + WO_WIN), DM, DM, DM, 0, 0};
        pg8::StaticOrder S; S.init(T, NH, C.G, C.bid);
        pg8::Epi8<FStoreBf16I8> E{{(bf16_t*)(C.ws + WS_H), NH, (const float*)(C.ws + WS_XSA), (const float*)(C.ws + WS_CMAX) + l * (NH + NG)}};
        pg8::gemm_phase<pg8::Epi8<FStoreBf16I8>, pg8::StaticOrder, true>(C.lds, g, S, E, C.tid);
    }
#if DIAG == 5
    if constexpr (SP == 2) { if (l == 0) { diag_ref_slice(C, C.in[I_WIN], NIN, DIAG_N0, nullptr); } }
    if constexpr (SP == 3) { if (l == 0) diag_cmp(C, (const bf16_t*)(C.ws + WS_H) + DIAG_N0, NH, (const bf16_t*)(C.ws + WS_XA), 64, 64); }
#endif
#if DIAG == 6
    if constexpr (SP == 5) { if (l == 0) diag_ref_slice(C, C.in[I_WGATE], NG, DIAG_N0, C.in[I_BGATE]); }
    if constexpr (SP == 6) { if (l == 0) diag_cmp_u8(C, C.ws + WS_G + DIAG_N0, NG, (const bf16_t*)(C.ws + WS_XA), 64, 64); }
#endif
    if constexpr (SP == 2) { p_knorm(C, l); p_gmlp_prep(C, l); if (l != HG_NAIVE_L) hgrn_b1(C, l); }
#if MIX_NAIVE
    if constexpr (SP == 3) { if (l != HG_NAIVE_L) hgrn_b2(C); mix_pool_naive(C, l); mix_gmlp_naive(C, l); }
#else
    if constexpr (SP == 3) { if (l != HG_NAIVE_L) hgrn_b2(C); mix_pool(C, l); mix_gmlp(C, l);
        if (DIAG == 2) mix_pool_naive(C, l); if (DIAG == 3) mix_gmlp_naive(C, l); }
#endif
#if DIAG == 1
    if constexpr (SP == 4) { hgrn_b3(C, l); { mix_hgrn_naive(C, l); __syncthreads(); } mix_fox(C, l); }
    if constexpr (SP == 5) { if (l == DIAG_LAYER) diag_cmp(C, (const bf16_t*)(C.ws + (DIAG_LAYER == 0 ? WS_XA : WS_TABU)) + 512, NBR, (const bf16_t*)(C.ws + WS_BR) + 512, NBR, 512); }
#elif DIAG == 2 || DIAG == 3
    if constexpr (SP == 4) { hgrn_b3(C, l); mix_fox(C, l); if (l == DIAG_LAYER) diag_cmp(C, (const bf16_t*)(C.ws + (DIAG_LAYER == 0 ? WS_XA : WS_TABU)) + (DIAG == 2 ? 0 : 1024), NBR, (const bf16_t*)(C.ws + WS_BR) + (DIAG == 2 ? 0 : 1024), NBR, 512); }
#else
    if constexpr (SP == 4) { if (l != HG_NAIVE_L) hgrn_b3(C, l); else { mix_hgrn_naive(C, l); __syncthreads(); } mix_fox(C, l); }
#endif
    if constexpr (SP == 5) {
        pg8::Gemm g{(const bf16_t*)(C.ws + WS_XB), (const bf16_t*)(wb + WO_WG), DM, DM, DM, 0, 0};
        pg8::StaticOrder S; S.init(T, NG, C.G, C.bid);
        pg8::Epi8<FGateI8> E{{C.ws + WS_G, C.in[I_BGATE] + l * NG, (const float*)(C.ws + WS_XSA), (const float*)(C.ws + WS_CMAX) + l * (NH + NG) + NH}};
        pg8::gemm_phase<pg8::Epi8<FGateI8>, pg8::StaticOrder, true>(C.lds, g, S, E, C.tid);
    }
    if constexpr (SP == 6) {
        pg8::Gemm g{(const bf16_t*)(C.ws + WS_BR), (const bf16_t*)(wb + WO_WBR), NBR, BW, BW, (size_t)BW, (size_t)DM * BW};
        pg8::ZOrder S; S.init(T, DM, 4, C.G, C.vcu);
        pg8::EpiMerge E{C.ws + WS_G, (bf16_t*)(C.ws + WS_XB)};
        pg8::gemm_phase(C.lds, g, S, E, C.tid);
    }
    if constexpr (SP == 7) {
        const float* xin = (l == 0) ? C.in[I_X] : (const float*)(C.ws + WS_XA);
        pg8::Gemm g{(const bf16_t*)(C.ws + WS_XB), (const bf16_t*)(wb + WO_WOUT), DM, DM, DM, 0, 0};
        pg8::StaticOrder S; S.init(T, DM, C.G, C.bid);
        pg8::Epi8<FResid> E{{xin, (bf16_t*)(C.ws + WS_XC)}};
        pg8::gemm_phase(C.lds, g, S, E, C.tid);
    }
    if constexpr (SP == 8) { p_ln1(C, l); p_conv_tables(C, l); }
    if constexpr (SP == 9) {
        pg8::Gemm g{(const bf16_t*)(C.ws + WS_X1B), (const bf16_t*)(wb + WO_WQ), DM, DM, DM, 0, 0};
        pg8::StaticOrder S; S.init(T, NQ, C.G, C.bid);
        pg8::Epi8<FStoreBf16> E{{(bf16_t*)(C.ws + WS_Q), NQ}};
        pg8::gemm_phase(C.lds, g, S, E, C.tid);
    }
#if TOPK_NAIVE
    if constexpr (SP == 10) p_topk_naive(C, l);
#else
    if constexpr (SP == 10) p_topk(C, l);
#endif
    if constexpr (SP == 11) p_gather(C, l);
}
__device__ __forceinline__ void make_ctx(Ctx& C, const Args& args, unsigned char* lds_raw) {
    C.lds = (LAS unsigned char*)lds_raw; C.ws = args.ws; C.in = args.in; C.out = args.out;
    C.tid = threadIdx.x; C.lane = C.tid & 63; C.wave = __builtin_amdgcn_readfirstlane(C.tid >> 6);
    C.G = gridDim.x; C.bid = blockIdx.x; C.vcu = (C.G % 8 == 0) ? (C.bid % 8) * (C.G / 8) + C.bid / 8 : C.bid;
}
#if !MK_ONE_LAUNCH
template <int SP> __global__ void __launch_bounds__(512, 2) mk_phase(Args args) {
    extern __shared__ __attribute__((aligned(16))) unsigned char lds_raw[];
    Ctx C; make_ctx(C, args, lds_raw);
    run_phase<SP>(C, args.ph_lo);
}
#endif

#define GRID_BAR() xcd_barrier((unsigned*)(args.ws + WS_CTL) + 1024, (volatile LAS unsigned*)((LAS unsigned char*)lds_raw + LDSCTL_OFF + 32))
__global__ void __launch_bounds__(512, 2) mk_fwd(Args args) {
    extern __shared__ __attribute__((aligned(16))) unsigned char lds_raw[];
    Ctx C; make_ctx(C, args, lds_raw);
    { volatile LAS unsigned* misc = (volatile LAS unsigned*)(C.lds + LDSCTL_OFF); if (C.tid < 64) misc[C.tid] = 0u; }
    __syncthreads();
    xcd_barrier_post((unsigned*)(args.ws + WS_CTL) + 1024);
    run_phase<-1>(C, 0); GRID_BAR();
#pragma unroll 1
    for (int l = 0; l < DEPTH; ++l) {
        run_phase<1>(C, l); GRID_BAR();
        run_phase<2>(C, l); GRID_BAR();
        run_phase<3>(C, l); GRID_BAR();
        run_phase<4>(C, l); GRID_BAR();
        run_phase<5>(C, l); GRID_BAR();
        run_phase<6>(C, l); GRID_BAR();
        run_phase<7>(C, l); GRID_BAR();
        run_phase<8>(C, l); GRID_BAR();
        run_phase<9>(C, l); GRID_BAR();
        run_phase<10>(C, l); GRID_BAR();
        run_phase<11>(C, l); if (l + 1 < DEPTH) GRID_BAR();
    }
}

#if !MK_ONE_LAUNCH
template <int SP> static void launch_phase(const Args& a, int grid, hipStream_t stream) {
    static bool attr_done = false;
    if (!attr_done) { (void)hipFuncSetAttribute((const void*)mk_phase<SP>, hipFuncAttributeMaxDynamicSharedMemorySize, LDS_BYTES); attr_done = true; }
    hipLaunchKernelGGL(mk_phase<SP>, dim3(grid), dim3(512), LDS_BYTES, stream, a);
}
#endif
extern "C" void kernel_launch(void* const* d_in, const int* in_sizes, int n_in, void* d_out, int out_size, void* d_ws, size_t ws_size, hipStream_t stream) {
    static int grid = 0;
    if (grid == 0) {
        if (n_in != NIN_PTRS || out_size != T * DM || ws_size < WS_END) { fprintf(stderr, "kernel_launch: unexpected shapes n_in %d out %d ws %zu\n", n_in, out_size, ws_size); grid = -1; return; }
        int dev = 0, cus = 0;
        if (hipGetDevice(&dev) != hipSuccess || hipDeviceGetAttribute(&cus, hipDeviceAttributeMultiprocessorCount, dev) != hipSuccess) { grid = -1; return; }
        grid = cus;
    }
    if (grid < 0) return;
    (void)hipMemsetAsync((char*)d_ws + WS_CTL, 0, CTL_ZERO_BYTES, stream);
    Args a{};
    for (int i = 0; i < NIN_PTRS; ++i) a.in[i] = (const float*)d_in[i];
    a.out = (float*)d_out; a.ws = (unsigned char*)d_ws; a.bar_slot = 0; a.pad = 0; a.ph_hi = 0;
#if MK_ONE_LAUNCH
    static bool attr_done = false;
    if (!attr_done) { (void)hipFuncSetAttribute((const void*)mk_fwd, hipFuncAttributeMaxDynamicSharedMemorySize, LDS_BYTES); attr_done = true; }
    hipLaunchKernelGGL(mk_fwd, dim3(grid), dim3(512), LDS_BYTES, stream, a);
    return;
#endif
#if !MK_ONE_LAUNCH
    a.ph_lo = 0; launch_phase<-1>(a, grid, stream);
    for (int l = 0; l < DEPTH; ++l) {
        a.ph_lo = l;
        launch_phase<0>(a, grid, stream); launch_phase<1>(a, grid, stream); launch_phase<2>(a, grid, stream); launch_phase<3>(a, grid, stream); launch_phase<4>(a, grid, stream);
        launch_phase<5>(a, grid, stream); launch_phase<6>(a, grid, stream); launch_phase<7>(a, grid, stream); launch_phase<8>(a, grid, stream); launch_phase<9>(a, grid, stream); launch_phase<10>(a, grid, stream); launch_phase<11>(a, grid, stream);
    }
#endif
}
```

```cpp
#include <hip/hip_runtime.h>
#include <cstdio>
#include <cstdint>

#ifndef DIAG
#define DIAG 0
#endif
#ifndef DIAG_LO
#define DIAG_LO 0
#endif
#ifndef DIAG_HI
#define DIAG_HI 64
#endif
#ifndef DIAG_MOD
#define DIAG_MOD 64
#endif
#ifndef TOPK_NAIVE
#define TOPK_NAIVE 0
#endif
#ifndef MIX_NAIVE
#define MIX_NAIVE 0
#endif
#ifndef DIAG_N0
#define DIAG_N0 4096
#endif
#ifndef FOX_NAIVE
#define FOX_NAIVE 0
#endif
#ifndef HG_NAIVE_L
#define HG_NAIVE_L 99
#endif
#ifndef DIAG_LAYER
#define DIAG_LAYER 0
#endif
#ifndef MK_ONE_LAUNCH
#define MK_ONE_LAUNCH 1
#endif

#define LAS __attribute__((address_space(3)))
#define GAS __attribute__((address_space(1)))
typedef unsigned short bf16_t;
typedef short bf16x8 __attribute__((ext_vector_type(8)));
typedef float f32x4 __attribute__((ext_vector_type(4)));
typedef float f32x2 __attribute__((ext_vector_type(2)));
typedef unsigned u32x4 __attribute__((ext_vector_type(4)));
typedef unsigned u32x2 __attribute__((ext_vector_type(2)));

constexpr int DM = 1024, BATCH = 2, SEQ = 8192, DEPTH = 2, T = BATCH * SEQ;
constexpr int BW = 512, NIN = 5124, NH = 5120, NG = 4096, NBR = 2048, NQ = 2048;
constexpr int NEXP = 16384, TOPK = 16, PH = 8;
constexpr float ALPHA = 1.4142135623730951f;
constexpr float LN_EPS = 1e-5f, RMS_EPS = 1e-6f;
constexpr int HC_P = 0, HC_HQ = 512, HC_HF = 1024, HC_HI = 1536, HC_HG = 2048, HC_GU = 2560, HC_GV = 3072, HC_FQ = 3584, HC_FK = 4096, HC_FV = 4608;

constexpr size_t MiB = 1u << 20;
constexpr size_t WS_CTL = 0, CTL_ZERO_BYTES = 160 * 1024;
constexpr size_t WS_CMAX = 64 * 1024;
constexpr size_t WS_MISC = 512 * 1024;
constexpr size_t WS_CUM = 768 * 1024;
constexpr size_t WS_W = 1 * MiB;
constexpr size_t W_LAYER = 30 * MiB;
constexpr size_t WO_WIN = 0, WO_WG = 10 * MiB, WO_WBR = 18 * MiB, WO_WOUT = 22 * MiB, WO_WQ = 24 * MiB, WO_KEYS = 28 * MiB, WO_WF = 28 * MiB + 512 * 1024, WO_POOLW = 28 * MiB + 768 * 1024, WO_GWS = 29 * MiB, WO_CS = 29 * MiB + 512 * 1024;
constexpr size_t WS_TABU = 64 * MiB, WS_TABV = 96 * MiB;
constexpr size_t WS_XA = 128 * MiB;
constexpr size_t WS_XB = 192 * MiB;
constexpr size_t WS_X1B = 224 * MiB;
constexpr size_t WS_H = 256 * MiB;
constexpr size_t WS_ST = 416 * MiB;
constexpr size_t WS_BR = 448 * MiB;
constexpr size_t WS_G = 256 * MiB;
constexpr size_t WS_MGF = 384 * MiB;
constexpr size_t WS_XC = 256 * MiB;
constexpr size_t WS_Q = 320 * MiB;
constexpr size_t WS_EIDX = 384 * MiB, WS_EGATE = 392 * MiB;
constexpr size_t WS_XSA = 256 * 1024;
constexpr size_t WS_END = 512 * MiB;

__device__ __forceinline__ float bf2f(unsigned u) { return __builtin_bit_cast(float, u << 16); }
__device__ __forceinline__ unsigned f2bf(float f) { unsigned u = __builtin_bit_cast(unsigned, f); return (u + 0x7fffu + ((u >> 16) & 1u)) >> 16; }
typedef __bf16 bf16x2_t __attribute__((ext_vector_type(2)));
__device__ __forceinline__ unsigned cvtpk(float lo, float hi) { f32x2 v = {lo, hi}; bf16x2_t b = __builtin_convertvector(v, bf16x2_t); return __builtin_bit_cast(unsigned, b); }
__device__ __forceinline__ unsigned pk2(float lo, float hi) { return cvtpk(lo, hi); }
__device__ __forceinline__ float wave_sum(float v) {
#pragma unroll
    for (int o = 32; o > 0; o >>= 1) v += __shfl_xor(v, o, 64);
    return v;
}
__device__ __forceinline__ float sigmoidf_(float x) { return __builtin_amdgcn_rcpf(1.f + __builtin_amdgcn_exp2f(-1.4426950408889634f * x)); }
__device__ __forceinline__ float siluf_(float x) { return x * __builtin_amdgcn_rcpf(1.f + __builtin_amdgcn_exp2f(-1.4426950408889634f * x)); }
__device__ __forceinline__ float geluf_slow(float x) { const float u = 0.7978845608028654f * (x + 0.044715f * x * x * x); return 0.5f * x * (1.f + tanhf(u)); }
__device__ __forceinline__ float geluf_(float x) { const float u2 = -2.302208198f * (x + 0.044715f * x * x * x); return x * __builtin_amdgcn_rcpf(1.f + __builtin_amdgcn_exp2f(u2)); }
__device__ __forceinline__ float logsigmoidf_(float z) { return fminf(z, 0.f) - log1pf(__expf(-fabsf(z))); }

__device__ __forceinline__ unsigned launder_u(unsigned x) { asm volatile("" : "+v"(x)); return __builtin_amdgcn_readfirstlane(x); }
template <class P> __device__ __forceinline__ P launder_ptr(P p) {
    const unsigned lo = launder_u((unsigned)(uintptr_t)p), hi = launder_u((unsigned)((uintptr_t)p >> 32));
    return (P)(((uintptr_t)hi << 32) | lo);
}

namespace pg8 {
constexpr int BM = 256, BK = 64, HALF = 128, HTB = HALF * BK * 2, STAGE_BYTES = 8 * HTB, NXCD = 8, WGM = 8;
__host__ __device__ __forceinline__ int lds_byte(int r, int c) { const int st = (r >> 4) * 2 + (c >> 5), rr = r & 15, cc = c & 31, ob = rr * 64 + cc * 2; return st * 1024 + (ob ^ (((ob >> 9) & 1) << 5)); }
__host__ __device__ __forceinline__ void stage_rc(int b, int& R, int& C) { const int st = b / 1024, sb = b % 1024, swz = sb ^ (((sb >> 9) & 1) << 5); R = (st >> 1) * 16 + swz / 64; C = (st & 1) * 32 + (swz % 64) / 2; }
__host__ __device__ __forceinline__ int perm32(int rho) { const int n = rho >> 4, i = rho & 15; return 8 * (i >> 2) + 4 * n + (i & 3); }

struct Unit { int pm, pn, z; };
struct Gemm { const bf16_t* A; const bf16_t* Bt; int lda, ldb, K; size_t zA, zB; };

struct StaticOrder {
    int nM, nN, nwg, G, c;
    __device__ void init(int M, int N, int G_, int c_) { nM = M / BM; nN = N / BM; nwg = nM * nN; G = G_; c = c_; }
    __device__ bool next(int i, Unit& u) const {
        const long L = (long)i * G + c; if (L >= nwg) return false;
        int wgid = (int)L; { const int q = nwg / NXCD, r = nwg % NXCD, xcd = wgid % NXCD, off = wgid / NXCD; wgid = (xcd < r ? xcd * (q + 1) : r * (q + 1) + (xcd - r) * q) + off; }
        const int nig = WGM * nN, gid = wgid / nig, fm = gid * WGM, gsz = (nM - fm) < WGM ? (nM - fm) : WGM;
        u.pm = fm + ((wgid % nig) % gsz); u.pn = (wgid % nig) / gsz; u.z = 0; return true;
    }
};
struct ZOrder {
    int nM, nN, nZ, ntile, G, c;
    __device__ void init(int M, int N, int Z, int G_, int c_) { nM = M / BM; nN = N / BM; nZ = Z; ntile = nM * nN; G = G_; c = c_; }
    __device__ bool next(int i, Unit& u) const {
        const long L = (long)(i / nZ) * G + c; if (L >= ntile) return false;
        u.pm = (int)L / nN; u.pn = (int)L % nN; u.z = i % nZ; return true;
    }
};

template <class F> struct Epi8 {
    static constexpr bool PERM = true;
    F f;
    __device__ __forceinline__ bool keep(const Unit&) const { return false; }
    __device__ __forceinline__ void operator()(const f32x4 (&acc)[2][2][4][2], const Unit& u, int wr, int wc, int fr, int fq) const {
        const int row0 = u.pm * BM + wr * 64 + fr, col0 = u.pn * BM + wc * 32 + 8 * fq;
#pragma unroll
        for (int ai = 0; ai < 2; ++ai)
#pragma unroll
            for (int m = 0; m < 4; ++m)
#pragma unroll
                for (int bj = 0; bj < 2; ++bj) f(row0 + ai * HALF + m * 16, col0 + bj * HALF, acc[ai][bj][m][0], acc[ai][bj][m][1], u.z);
    }
};
template <class F> struct Epi4 {
    static constexpr bool PERM = false;
    F f;
    __device__ __forceinline__ bool keep(const Unit&) const { return false; }
    __device__ __forceinline__ void operator()(const f32x4 (&acc)[2][2][4][2], const Unit& u, int wr, int wc, int fr, int fq) const {
        const int row0 = u.pm * BM + wr * 64 + fr, col0 = u.pn * BM + wc * 32 + 4 * fq;
#pragma unroll
        for (int ai = 0; ai < 2; ++ai)
#pragma unroll
            for (int m = 0; m < 4; ++m)
#pragma unroll
                for (int bj = 0; bj < 2; ++bj)
#pragma unroll
                    for (int n = 0; n < 2; ++n) f(row0 + ai * HALF + m * 16, col0 + bj * HALF + n * 16, acc[ai][bj][m][n], u.z);
    }
};

struct EpiMerge {
    static constexpr bool PERM = true;
    const unsigned char* G; bf16_t* MG;
    __device__ __forceinline__ bool keep(const Unit& u) const { return u.z < 3; }
    __device__ __forceinline__ void operator()(f32x4 (&acc)[2][2][4][2], const Unit& u, int wr, int wc, int fr, int fq) const {
        const int row0 = u.pm * BM + wr * 64 + fr, col0 = u.pn * BM + wc * 32 + 8 * fq;
        const unsigned char* gp0 = G + (size_t)row0 * NG + u.z * DM + col0;
        if (u.z < 3) {
#pragma unroll
            for (int ai = 0; ai < 2; ++ai)
#pragma unroll
                for (int m = 0; m < 4; ++m) {
                    if ((m & 1) == 0) asm volatile("" ::: "memory");
#pragma unroll
                    for (int bj = 0; bj < 2; ++bj) {
                        const unsigned char* gp = gp0 + (size_t)(ai * HALF + m * 16) * NG + bj * HALF;
                        const u32x2 ga = *(const u32x2*)gp, gb = *(const u32x2*)(gp + DM);
#pragma unroll
                        for (int n = 0; n < 2; ++n)
#pragma unroll
                            for (int e = 0; e < 4; ++e) {
                                const float qa = (float)((ga[n] >> (8 * e)) & 255u), qb = (float)((gb[n] >> (8 * e)) & 255u);
                                acc[ai][bj][m][n][e] *= qa * __builtin_amdgcn_rcpf(qb); }
                    }
                }
        } else {
            bf16_t* op0 = MG + (size_t)row0 * DM + col0;
#pragma unroll
            for (int ai = 0; ai < 2; ++ai)
#pragma unroll
                for (int m = 0; m < 4; ++m)
#pragma unroll
                    for (int bj = 0; bj < 2; ++bj) {
                        const u32x2 ga = *(const u32x2*)(gp0 + (size_t)(ai * HALF + m * 16) * NG + bj * HALF);
                        u32x4 o;
#pragma unroll
                        for (int n = 0; n < 2; ++n)
#pragma unroll
                            for (int e2 = 0; e2 < 2; ++e2) {
                                const float q0 = (float)((ga[n] >> (16 * e2)) & 255u) * (1.f / 255.f), q1 = (float)((ga[n] >> (16 * e2 + 8)) & 255u) * (1.f / 255.f);
                                o[2 * n + e2] = cvtpk(acc[ai][bj][m][n][2 * e2] * q0, acc[ai][bj][m][n][2 * e2 + 1] * q1); }
                        *(u32x4*)(op0 + (size_t)(ai * HALF + m * 16) * DM + bj * HALF) = o;
                    }
        }
    }
};

typedef int i32x4 __attribute__((ext_vector_type(4)));
template <class Epi, class Sched, bool I8 = false, bool ALIGN_EPI = true>
__device__ __forceinline__ void gemm_phase(LAS unsigned char* lds, const Gemm g, const Sched& S, const Epi& E, const int tid) {
    constexpr int ES = I8 ? 1 : 2;
    const int wid = __builtin_amdgcn_readfirstlane(tid >> 6), lane = tid & 63, wr = wid >> 2, wc = wid & 3, fr = lane & 15, fq = lane >> 4;
    const int K = g.K, nt = K * ES / 128;
    unsigned voffA[2], voffB[2];
#pragma unroll
    for (int i = 0; i < 2; ++i) { int R, C; stage_rc(tid * 16 + i * 8192, R, C); const int Rb = Epi::PERM ? ((R & ~31) + perm32(R & 31)) : R;
        voffA[i] = (unsigned)(R * g.lda * ES + C * 2); voffB[i] = (unsigned)(Rb * g.ldb * ES + C * 2); }
    const size_t kstep = (size_t)(BK * 2);
    const size_t hstepA = (size_t)HALF * g.lda * ES, hstepB = (size_t)HALF * g.ldb * ES;
    const size_t tstepA = 2 * hstepA, tstepB = 2 * hstepB;
    const unsigned ldsw = (unsigned)wid * 1024u;
    const int aoff = lds_byte(wr * 64 + fr, fq * 8), boff = lds_byte(wc * 32 + fr, fq * 8);
#define PG8_SA(b, h) (((b) * 2 + (h)) * HTB)
#define PG8_SB(b, h) ((4 + (b) * 2 + (h)) * HTB)
#define PG8_STAGE(bufoff, gbase, voff) do { _Pragma("unroll") for (int _i = 0; _i < 2; ++_i) \
        __builtin_amdgcn_global_load_lds((const unsigned*)((const char*)(gbase) + (voff)[_i]), (LAS unsigned*)(lds + (bufoff) + ldsw + _i * 8192), 16, 0, 0); } while (0)
#define PG8_LDA(dst, b, h) do { _Pragma("unroll") for (int m = 0; m < 4; ++m) _Pragma("unroll") for (int k = 0; k < 2; ++k) dst[m][k] = *(const LAS bf16x8*)(lds + PG8_SA(b, h) + aoff + m * 2048 + k * 1024); } while (0)
#define PG8_LDB(dst, b, h) do { _Pragma("unroll") for (int n = 0; n < 2; ++n) _Pragma("unroll") for (int k = 0; k < 2; ++k) dst[n][k] = *(const LAS bf16x8*)(lds + PG8_SB(b, h) + boff + n * 2048 + k * 1024); } while (0)
#define PG8_MMA(ai, bj, At, Bt) do { __builtin_amdgcn_s_setprio(1); _Pragma("unroll") for (int m = 0; m < 4; ++m) _Pragma("unroll") for (int n = 0; n < 2; ++n) _Pragma("unroll") for (int k = 0; k < 2; ++k) { \
        if constexpr (I8) acc[ai][bj][m][n] = __builtin_bit_cast(f32x4, __builtin_amdgcn_mfma_i32_16x16x64_i8(__builtin_bit_cast(i32x4, Bt[n][k]), __builtin_bit_cast(i32x4, At[m][k]), __builtin_bit_cast(i32x4, acc[ai][bj][m][n]), 0, 0, 0)); \
        else acc[ai][bj][m][n] = __builtin_amdgcn_mfma_f32_16x16x32_bf16(Bt[n][k], At[m][k], acc[ai][bj][m][n], 0, 0, 0); } __builtin_amdgcn_s_setprio(0); } while (0)
#define PG8_WAIT_V(n) asm volatile("s_waitcnt vmcnt(" #n ")" ::: "memory")
#define PG8_WAIT_L(n) asm volatile("s_waitcnt lgkmcnt(" #n ")" ::: "memory")
#define PG8_BAR __builtin_amdgcn_s_barrier()
#define PG8_SCHED __builtin_amdgcn_sched_barrier(0)
    Unit cur, nxt; int ui = 0;
    if (!S.next(0, cur)) return;
    f32x4 acc[2][2][4][2];
#pragma unroll
    for (int a = 0; a < 2; ++a)
#pragma unroll
        for (int b = 0; b < 2; ++b)
#pragma unroll
            for (int m = 0; m < 4; ++m)
#pragma unroll
                for (int n = 0; n < 2; ++n) acc[a][b][m][n] = (f32x4){0.f, 0.f, 0.f, 0.f};
    bf16x8 At[4][2], B0[2][2], B1[2][2];
    const char* cA = (const char*)g.A + (size_t)cur.z * g.zA * ES + (size_t)cur.pm * tstepA; const char* cB = (const char*)g.Bt + (size_t)cur.z * g.zB * ES + (size_t)cur.pn * tstepB;
    PG8_STAGE(PG8_SB(0, 0), cB, voffB); PG8_STAGE(PG8_SB(0, 1), cB + hstepB, voffB); PG8_STAGE(PG8_SA(0, 0), cA, voffA); PG8_STAGE(PG8_SA(0, 1), cA + hstepA, voffA);
    if (wr == 1) PG8_BAR;
    PG8_WAIT_V(2); PG8_BAR;
    PG8_STAGE(PG8_SB(1, 0), cB + kstep, voffB); PG8_STAGE(PG8_SA(1, 0), cA + kstep, voffA); PG8_STAGE(PG8_SB(1, 1), cB + hstepB + kstep, voffB);
    PG8_WAIT_V(6); PG8_BAR;
    for (;;) {
        const bool has_next = S.next(ui + 1, nxt);
        const char* nA = has_next ? (const char*)g.A + (size_t)nxt.z * g.zA * ES + (size_t)nxt.pm * tstepA : cA;
        const char* nB = has_next ? (const char*)g.Bt + (size_t)nxt.z * g.zB * ES + (size_t)nxt.pn * tstepB : cB;
        for (int t = 0; t < nt; t += 2) {
            const bool last = (t == nt - 2);
            const char* a1 = cA + (size_t)(t + 1) * kstep;
            const char* a2 = last ? nA : cA + (size_t)(t + 2) * kstep; const char* b2 = last ? nB : cB + (size_t)(t + 2) * kstep;
            const char* a3 = a2 + kstep; const char* b3 = b2 + kstep;
            PG8_LDB(B0, 0, 0); PG8_LDB(B1, 0, 1); PG8_SCHED; PG8_LDA(At, 0, 0); PG8_STAGE(PG8_SA(1, 1), a1 + hstepA, voffA);
            PG8_WAIT_V(8); PG8_WAIT_L(0); PG8_BAR; PG8_MMA(0, 0, At, B0); PG8_MMA(0, 1, At, B1); PG8_BAR; PG8_SCHED;
            PG8_LDA(At, 0, 1); PG8_STAGE(PG8_SB(0, 0), b2, voffB); PG8_STAGE(PG8_SB(0, 1), b2 + hstepB, voffB); PG8_STAGE(PG8_SA(0, 0), a2, voffA);
            PG8_WAIT_V(8); PG8_WAIT_L(0); PG8_BAR; PG8_MMA(1, 0, At, B0); PG8_MMA(1, 1, At, B1); PG8_BAR; PG8_SCHED;
            PG8_LDB(B0, 1, 0); PG8_LDB(B1, 1, 1); PG8_SCHED; PG8_LDA(At, 1, 0); PG8_STAGE(PG8_SA(0, 1), a2 + hstepA, voffA);
            PG8_WAIT_V(8); PG8_WAIT_L(0); PG8_BAR; PG8_MMA(0, 0, At, B0); PG8_MMA(0, 1, At, B1); PG8_BAR; PG8_SCHED;
            PG8_LDA(At, 1, 1); PG8_STAGE(PG8_SB(1, 0), b3, voffB); PG8_STAGE(PG8_SB(1, 1), b3 + hstepB, voffB); PG8_STAGE(PG8_SA(1, 0), a3, voffA);
            PG8_WAIT_V(8); PG8_WAIT_L(0); PG8_BAR; PG8_MMA(1, 0, At, B0); PG8_MMA(1, 1, At, B1); PG8_BAR; PG8_SCHED;
        }
        if constexpr (ALIGN_EPI) { if (wr == 0) PG8_BAR; }
        E(acc, cur, wr, wc, fr, fq);
        if (!has_next) break;
        if (!E.keep(cur)) {
#pragma unroll
            for (int a = 0; a < 2; ++a)
#pragma unroll
                for (int b = 0; b < 2; ++b)
#pragma unroll
                    for (int m = 0; m < 4; ++m)
#pragma unroll
                        for (int n = 0; n < 2; ++n) acc[a][b][m][n] = (f32x4){0.f, 0.f, 0.f, 0.f};
        }
        cur = nxt; cA = nA; cB = nB; ++ui;
        if constexpr (ALIGN_EPI) { if (wr == 1) PG8_BAR; }
    }
    PG8_WAIT_V(0);
    if constexpr (!ALIGN_EPI) { if (wr == 0) PG8_BAR; }
    PG8_BAR;
#undef PG8_SA
#undef PG8_SB
#undef PG8_STAGE
#undef PG8_LDA
#undef PG8_LDB
#undef PG8_MMA
#undef PG8_WAIT_V
#undef PG8_WAIT_L
#undef PG8_BAR
#undef PG8_SCHED
}
}

#define XB_TMO      128
#define XB_XCNT(j)  (256  + 64 * (j))
#define XB_XSUB(j)  (1280 + 64 * (j))
#define XB_XGEN(j)  (2304 + 64 * (j))
#define XB_TOP      3328
#define XB_TOPGEN   3392
#define XCD_BAR_WORDS 3456
#define XB_SPIN_CAP (1u << 22)
__device__ __forceinline__ unsigned xb_ld(unsigned* p)              { return __hip_atomic_load(p, __ATOMIC_RELAXED, __HIP_MEMORY_SCOPE_AGENT); }
__device__ __forceinline__ unsigned xb_add(unsigned* p, unsigned v) { return __hip_atomic_fetch_add(p, v, __ATOMIC_RELAXED, __HIP_MEMORY_SCOPE_AGENT); }
__device__ __forceinline__ unsigned xb_xcc_id() { return (unsigned)__builtin_amdgcn_s_getreg((3 << 11) | 20) & 0xFu; }
#define XB_SPIN(cond, bar) do { unsigned _sp = 0; while (cond) { __builtin_amdgcn_s_sleep(1); \
    if ((++_sp & 255u) == 0u) { if (xb_ld(&(bar)[XB_TMO])) break; if (_sp > XB_SPIN_CAP) { atomicAdd(&(bar)[XB_TMO], 1u); break; } } } } while (0)
__device__ __forceinline__ void xcd_barrier_post(unsigned* bar) {
    if (threadIdx.x == 0) (void)xb_add(&bar[XB_XCNT(xb_xcc_id())], 1u);
}
__device__ __forceinline__ void xcd_barrier_complete(unsigned* bar, unsigned x, unsigned& nloc, unsigned& nx) {
    const unsigned G = gridDim.x * gridDim.y * gridDim.z;
    unsigned sum, cnt, mine, sp = 0u;
    for (;;) {
        sum = 0u; cnt = 0u; mine = 0u;
#pragma unroll
        for (unsigned j = 0; j < 16; ++j) { const unsigned c = xb_ld(&bar[XB_XCNT(j)]); sum += c; cnt += (c > 0u) ? 1u : 0u; mine = (j == x) ? c : mine; }
        if (sum == G) break;
        __builtin_amdgcn_s_sleep(1);
        if ((++sp & 255u) == 0u) { if (xb_ld(&bar[XB_TMO])) break; if (sp > XB_SPIN_CAP) { atomicAdd(&bar[XB_TMO], 1u); break; } }
    }
    nloc = mine > 0u ? mine : 1u; nx = cnt > 0u ? cnt : 1u;
}
__device__ __noinline__ void xcd_barrier_leader(unsigned* bar, volatile LAS unsigned* st) {
    const unsigned x = xb_xcc_id();
    __builtin_amdgcn_s_waitcnt(0);
    unsigned nloc = st[0], nx = st[1];
    if (nloc == 0u) { xcd_barrier_complete(bar, x, nloc, nx); st[0] = nloc; st[1] = nx; }
    const unsigned old = xb_add(&bar[XB_XSUB(x)], 1u);
    const unsigned gen = old / nloc;
    if (old + 1u == (gen + 1u) * nloc) {
        __builtin_amdgcn_fence(__ATOMIC_RELEASE, "agent");
        asm volatile("s_waitcnt vmcnt(0)" ::: "memory");
        const unsigned og = xb_add(&bar[XB_TOP], 1u);
        const unsigned tg = og / nx;
        if (og + 1u == (tg + 1u) * nx) xb_add(&bar[XB_TOPGEN], 1u);
        else XB_SPIN(xb_ld(&bar[XB_TOPGEN]) == tg, bar);
        __builtin_amdgcn_fence(__ATOMIC_ACQUIRE, "agent");
        xb_add(&bar[XB_XGEN(x)], 1u);
        asm volatile("s_waitcnt vmcnt(0)" ::: "memory");
    } else {
        XB_SPIN(xb_ld(&bar[XB_XGEN(x)]) == gen, bar);
        __builtin_amdgcn_fence(__ATOMIC_ACQUIRE, "agent");
        asm volatile("s_waitcnt vmcnt(0)" ::: "memory");
    }
}
__device__ __forceinline__ void xcd_barrier(unsigned* bar, volatile LAS unsigned* st) {
    asm volatile("s_waitcnt vmcnt(0)" ::: "memory");
    __syncthreads();
    if (threadIdx.x == 0) xcd_barrier_leader(bar, st);
    __syncthreads();
}

constexpr int NIN_PTRS = 23;
struct Args { const float* in[NIN_PTRS]; float* out; unsigned char* ws; int ph_lo, ph_hi, bar_slot, pad; };
enum { I_X = 0, I_WIN, I_BFOX, I_POOLW, I_POOLS, I_LBL, I_HNG, I_GLNG, I_GLNB, I_GWS, I_GBS, I_WGATE, I_BGATE, I_WBR, I_WOUT, I_LN1G, I_LN1B, I_WQ, I_KEYS, I_PU, I_PV, I_LN2G, I_LN2B };

constexpr int LDS_BYTES = 147456;
constexpr int LDSCTL_OFF = 143360;

struct Ctx {
    LAS unsigned char* lds;
    unsigned char* ws;
    const float* const* in;
    float* out;
    int tid, lane, wave, G, bid, vcu;
};

__device__ __forceinline__ void tconv_job(const Ctx& C, const float* src, int ld_src, int K, int N, bf16_t* dst) {
    LAS float* tile = (LAS float*)C.lds;
    const int nk = K / 64, nn = N / 64, ntiles = nk * nn;
    for (int tl = C.bid; tl < ntiles; tl += C.G) {
        const int k0 = (tl / nn) * 64, n0 = (tl % nn) * 64;
#pragma unroll
        for (int p = 0; p < 2; ++p) {
            const int kr = (C.tid >> 4) + p * 32, nc = (C.tid & 15) * 4;
            const f32x4 v = *(const f32x4*)(src + (size_t)(k0 + kr) * ld_src + n0 + nc);
            tile[kr * 65 + nc + 0] = v[0]; tile[kr * 65 + nc + 1] = v[1]; tile[kr * 65 + nc + 2] = v[2]; tile[kr * 65 + nc + 3] = v[3];
        }
        __syncthreads();
        {
            const int n = C.tid >> 3, k8 = (C.tid & 7) * 8;
            u32x4 o;
#pragma unroll
            for (int j = 0; j < 4; ++j) o[j] = pk2(tile[(k8 + 2 * j) * 65 + n], tile[(k8 + 2 * j + 1) * 65 + n]);
            *(u32x4*)(dst + (size_t)(n0 + n) * K + k0 + k8) = o;
        }
        __syncthreads();
    }
}
__device__ __forceinline__ void cvt_copy(const Ctx& C, const float* src, bf16_t* dst, size_t n) {
    const size_t n8 = n / 8;
    for (size_t i = (size_t)C.bid * 512 + C.tid; i < n8; i += (size_t)C.G * 512) {
        const f32x4 a = *(const f32x4*)(src + i * 8), b = *(const f32x4*)(src + i * 8 + 4);
        u32x4 o; o[0] = pk2(a[0], a[1]); o[1] = pk2(a[2], a[3]); o[2] = pk2(b[0], b[1]); o[3] = pk2(b[2], b[3]);
        *(u32x4*)(dst + i * 8) = o;
    }
}
__device__ __forceinline__ void strip_unit(const Ctx& C, const float* src, int ld, unsigned char* dst, unsigned* cmax, bool split) {
    const float* p = src + (size_t)(128 * C.wave) * ld + C.lane;
    float v[128];
#pragma unroll
    for (int i = 0; i < 128; ++i) v[i] = p[(size_t)i * ld];
    if (cmax) {
        float mx = 0.f;
#pragma unroll
        for (int i = 0; i < 128; ++i) mx = fmaxf(mx, fabsf(v[i]));
        LAS float* red = (LAS float*)C.lds;
        red[C.wave * 64 + C.lane] = mx;
        __syncthreads();
        float m = red[C.lane];
#pragma unroll
        for (int w2 = 1; w2 < 8; ++w2) m = fmaxf(m, red[w2 * 64 + C.lane]);
        if (C.wave == 0) cmax[C.lane] = __builtin_bit_cast(unsigned, m);
        const float isc = 127.f / fmaxf(m, 1e-30f);
        unsigned char* dp = dst + (size_t)C.lane * 1024 + 128 * C.wave;
#pragma unroll
        for (int j4 = 0; j4 < 8; ++j4) { u32x4 o;
#pragma unroll
            for (int j = 0; j < 4; ++j) { unsigned wd = 0u;
#pragma unroll
                for (int e = 0; e < 4; ++e) wd |= ((unsigned)(int)rintf(v[16 * j4 + 4 * j + e] * isc) & 255u) << (8 * e);
                o[j] = wd; }
            *(u32x4*)(dp + 16 * j4) = o; }
        __syncthreads();
    } else {
        bf16_t* dp = split ? (bf16_t*)dst + (size_t)(C.wave >> 2) * DM * BW + (size_t)C.lane * BW + 128 * (C.wave & 3) : (bf16_t*)dst + (size_t)C.lane * 1024 + 128 * C.wave;
#pragma unroll
        for (int j8 = 0; j8 < 16; ++j8) { u32x4 o;
#pragma unroll
            for (int j = 0; j < 4; ++j) o[j] = pk2(v[8 * j8 + 2 * j], v[8 * j8 + 2 * j + 1]);
            *(u32x4*)(dp + 8 * j8) = o; }
    }
}
__device__ __forceinline__ void p_conv_weights(const Ctx& C) {
#pragma unroll 1
    for (int u = C.bid; u < DEPTH * 224; u += C.G) {
        const int l = u / 224, r = u % 224;
        unsigned char* wb = C.ws + WS_W + (size_t)l * W_LAYER;
        unsigned* cm = (unsigned*)(C.ws + WS_CMAX) + l * (NH + NG);
        const float* src; int ld; unsigned char* dst; unsigned* cx = nullptr; bool split = false;
        if (r < 80)       { src = C.in[I_WIN] + (size_t)l * DM * NIN + r * 64; ld = NIN; dst = wb + WO_WIN + (size_t)r * 64 * DM; cx = cm + r * 64; }
        else if (r < 144) { const int t = r - 80; src = C.in[I_WGATE] + (size_t)l * DM * NG + t * 64; ld = NG; dst = wb + WO_WG + (size_t)t * 64 * DM; cx = cm + NH + t * 64; }
        else if (r < 176) { const int t = r - 144, pr = t >> 4, nt = t & 15; src = C.in[I_WBR] + ((size_t)l * 4 + 2 * pr) * BW * DM + nt * 64; ld = DM; split = true;
                            dst = wb + WO_WBR + ((size_t)(2 * pr) * DM * BW + (size_t)nt * 64 * BW) * 2; }
        else if (r < 192) { const int nt = r - 176; src = C.in[I_WOUT] + (size_t)l * DM * DM + nt * 64; ld = DM; dst = wb + WO_WOUT + (size_t)nt * 64 * DM * 2; }
        else              { const int nt = r - 192; src = C.in[I_WQ] + (size_t)l * DM * NQ + nt * 64; ld = NQ; dst = wb + WO_WQ + (size_t)nt * 64 * DM; cx = (unsigned*)(C.ws + WS_CMAX) + DEPTH * (NH + NG) + l * NQ + nt * 64; }
        strip_unit(C, src, ld, dst, cx, split);
    }
    for (int l = 0; l < DEPTH; ++l) {
        unsigned char* wb = C.ws + WS_W + (size_t)l * W_LAYER;
        cvt_copy(C, C.in[I_KEYS] + (size_t)l * 2 * PH * 128 * 128, (bf16_t*)(wb + WO_KEYS), (size_t)2 * PH * 128 * 128);
        for (int g = 0; g < 4; ++g)
            tconv_job(C, C.in[I_POOLW] + ((size_t)l * 4 + g) * 128 * 128, 128, 128, 128, (bf16_t*)(wb + WO_POOLW) + (size_t)g * 128 * 128);
        {
            bf16_t* gw = (bf16_t*)(wb + WO_GWS); const float* src = C.in[I_GWS] + (size_t)l * 4 * 128 * 128;
            for (int i = C.bid * 512 + C.tid; i < 4 * 128 * 128; i += C.G * 512) { const int t = (i >> 7) & 127, sx = i & 127; gw[i] = (bf16_t)f2bf(sx <= t ? src[i] : 0.f); }
        }
        float* wf = (float*)(wb + WO_WF);
        for (int i = C.bid * 512 + C.tid; i < 4 * DM; i += C.G * 512) { const int h = i / DM, k = i % DM; wf[i] = C.in[I_WIN][(size_t)l * DM * NIN + (size_t)k * NIN + NH + h]; }
    }
}
constexpr size_t WS_U8 = WS_TABU, WS_V8 = WS_TABU + 16 * MiB, WS_SU = WS_TABU + 32 * MiB, WS_SV = WS_SU + 64 * 1024;
__device__ __forceinline__ float wave_max(float v) {
#pragma unroll
    for (int o = 32; o > 0; o >>= 1) v = fmaxf(v, __shfl_xor(v, o, 64));
    return v;
}
template <bool SIGNED> __device__ __forceinline__ void quant_rows(const Ctx& C, const float* src, unsigned char* dst, float* scl) {
    for (int row = C.bid * 8 + C.wave; row < NEXP; row += C.G * 8) {
        const float* p = src + (size_t)row * DM + C.lane * 16;
        f32x4 v[4]; float mx = 0.f;
#pragma unroll
        for (int i = 0; i < 4; ++i) { v[i] = *(const f32x4*)(p + 4 * i);
#pragma unroll
            for (int e = 0; e < 4; ++e) mx = fmaxf(mx, fabsf(v[i][e])); }
        mx = fmaxf(wave_max(mx), 1e-30f);
        const float sc = mx * (1.f / 127.f), isc = 127.f / mx;
        u32x4 o;
#pragma unroll
        for (int i = 0; i < 4; ++i) { unsigned wd = 0u;
#pragma unroll
            for (int e = 0; e < 4; ++e) { const int q = (int)rintf(v[i][e] * isc) + (SIGNED ? 0 : 128); wd |= ((unsigned)q & 255u) << (8 * e); }
            o[i] = wd; }
        *(u32x4*)(dst + (size_t)row * DM + C.lane * 16) = o;
        if (C.lane == 0) scl[row] = sc;
    }
}
__device__ __forceinline__ void p_conv_tables(const Ctx& C, int l) {
    quant_rows<true>(C, C.in[I_PU] + (size_t)l * NEXP * DM, C.ws + WS_U8, (float*)(C.ws + WS_SU));
    quant_rows<false>(C, C.in[I_PV] + (size_t)l * NEXP * DM, C.ws + WS_V8, (float*)(C.ws + WS_SV));
}

__device__ __forceinline__ void row_emit(const Ctx& C, int row, const float (&v)[16], int l, bool want_lsig) {
    {
        float mx = 0.f;
#pragma unroll
        for (int j = 0; j < 16; ++j) mx = fmaxf(mx, fabsf(v[j]));
#pragma unroll
        for (int o = 32; o > 0; o >>= 1) mx = fmaxf(mx, __shfl_xor(mx, o, 64));
        mx = fmaxf(mx, 1e-30f);
        const float isc = 127.f / mx;
        unsigned char* xb = C.ws + WS_XB + (size_t)row * DM;
        u32x2 o0, o1;
#pragma unroll
        for (int hw = 0; hw < 2; ++hw) { unsigned a = 0u, b = 0u;
#pragma unroll
            for (int e = 0; e < 4; ++e) { a |= ((unsigned)(int)rintf(v[4 * hw + e] * isc) & 255u) << (8 * e); b |= ((unsigned)(int)rintf(v[8 + 4 * hw + e] * isc) & 255u) << (8 * e); }
            o0[hw] = a; o1[hw] = b; }
        *(u32x2*)(xb + C.lane * 8) = o0; *(u32x2*)(xb + 512 + C.lane * 8) = o1;
        if (C.lane == 0) ((float*)(C.ws + WS_XSA))[row] = mx * (1.f / 127.f);
    }
    if (want_lsig) {
        const float* wf = (const float*)(C.ws + WS_W + (size_t)l * W_LAYER + WO_WF);
        float* lsig = (float*)(C.ws + WS_MISC);
#pragma unroll
        for (int h = 0; h < 4; ++h) {
            const f32x4 a0 = *(const f32x4*)(wf + h * DM + C.lane * 8), a1 = *(const f32x4*)(wf + h * DM + C.lane * 8 + 4);
            const f32x4 b0 = *(const f32x4*)(wf + h * DM + 512 + C.lane * 8), b1 = *(const f32x4*)(wf + h * DM + 512 + C.lane * 8 + 4);
            float s = 0.f;
#pragma unroll
            for (int j = 0; j < 4; ++j) s += v[j] * a0[j] + v[4 + j] * a1[j] + v[8 + j] * b0[j] + v[12 + j] * b1[j];
            s = wave_sum(s);
            if (C.lane == 0) lsig[(size_t)row * 4 + h] = logsigmoidf_(s + C.in[I_BFOX][l * 4 + h]);
        }
    }
}
__device__ __forceinline__ void load_row16(const float* p, int lane, float (&v)[16]) {
    const f32x4 a0 = *(const f32x4*)(p + lane * 8), a1 = *(const f32x4*)(p + lane * 8 + 4), b0 = *(const f32x4*)(p + 512 + lane * 8), b1 = *(const f32x4*)(p + 512 + lane * 8 + 4);
#pragma unroll
    for (int j = 0; j < 4; ++j) { v[j] = a0[j]; v[4 + j] = a1[j]; v[8 + j] = b0[j]; v[12 + j] = b1[j]; }
}
__device__ __forceinline__ void store_row16(float* p, int lane, const float (&v)[16]) {
    *(f32x4*)(p + lane * 8) = (f32x4){v[0], v[1], v[2], v[3]}; *(f32x4*)(p + lane * 8 + 4) = (f32x4){v[4], v[5], v[6], v[7]};
    *(f32x4*)(p + 512 + lane * 8) = (f32x4){v[8], v[9], v[10], v[11]}; *(f32x4*)(p + 512 + lane * 8 + 4) = (f32x4){v[12], v[13], v[14], v[15]};
}
__device__ __forceinline__ void ln_row16(float (&v)[16], const float* g, const float* b, int lane) {
    float s = 0.f;
#pragma unroll
    for (int j = 0; j < 16; ++j) s += v[j];
    const float mean = wave_sum(s) * (1.f / DM);
    float q = 0.f;
#pragma unroll
    for (int j = 0; j < 16; ++j) { const float d = v[j] - mean; q += d * d; }
    const float rstd = rsqrtf(wave_sum(q) * (1.f / DM) + LN_EPS);
    float gg[16], bb[16];
    load_row16(g, lane, gg); load_row16(b, lane, bb);
#pragma unroll
    for (int j = 0; j < 16; ++j) v[j] = (v[j] - mean) * rstd * gg[j] + bb[j];
}
__device__ __forceinline__ void p_rowpass0(const Ctx& C) {
    const float* wfin = C.in[I_WIN] + NH;
    f32x4 wv[16];
#pragma unroll
    for (int j = 0; j < 16; ++j) { const int k = (j < 8) ? C.lane * 8 + j : 512 + C.lane * 8 + (j - 8); wv[j] = *(const f32x4*)(wfin + (size_t)k * NIN); }
    float* lsig = (float*)(C.ws + WS_MISC);
    const bool bal = (C.G == 256);
    const int c0 = bal ? ((C.bid < 192) ? C.bid * 6 : 1152 + (C.bid - 192) * 14) : C.bid, cn = bal ? ((C.bid < 192) ? 6 : 14) : (T / 8 - C.bid + C.G - 1) / C.G, cs = bal ? 1 : C.G;
    for (int ci = 0; ci < cn; ++ci) {
        const int row = (c0 + ci * cs) * 8 + C.wave;
        float v[16]; load_row16(C.in[I_X] + (size_t)row * DM, C.lane, v);
        row_emit(C, row, v, 0, false);
#pragma unroll
        for (int h = 0; h < 4; ++h) {
            float sacc = 0.f;
#pragma unroll
            for (int j = 0; j < 16; ++j) sacc += v[j] * wv[j][h];
            sacc = wave_sum(sacc);
            if (C.lane == 0) lsig[(size_t)row * 4 + h] = logsigmoidf_(sacc + C.in[I_BFOX][h]);
        }
    }
}
__device__ __forceinline__ void p_cumsum(const Ctx& C) {
    if (C.bid >= BATCH * 4) return;
    const float* lsig = (const float*)(C.ws + WS_MISC);
    float* cum = (float*)(C.ws + WS_CUM);
    LAS float* wt = (LAS float*)C.lds;
    const int b = C.bid >> 2, h = C.bid & 3;
    float v[16];
#pragma unroll
    for (int j = 0; j < 16; ++j) v[j] = lsig[((size_t)b * SEQ + C.tid * 16 + j) * 4 + h];
#pragma unroll
    for (int j = 1; j < 16; ++j) v[j] += v[j - 1];
    float inc = v[15];
#pragma unroll
    for (int o = 1; o < 64; o <<= 1) { const float t = __shfl_up(inc, o, 64); if (C.lane >= o) inc += t; }
    if (C.lane == 63) wt[C.wave] = inc;
    __syncthreads();
    float off = inc - v[15];
    for (int w2 = 0; w2 < C.wave; ++w2) off += wt[w2];
    float* cp = cum + ((size_t)b * 4 + h) * SEQ + C.tid * 16;
#pragma unroll
    for (int j4 = 0; j4 < 4; ++j4) *(f32x4*)(cp + 4 * j4) = (f32x4){v[4 * j4] + off, v[4 * j4 + 1] + off, v[4 * j4 + 2] + off, v[4 * j4 + 3] + off};
    __syncthreads();
}
__device__ __forceinline__ void load_row16_bf(const bf16_t* p, int lane, float (&v)[16]) {
    const u32x4 a = *(const u32x4*)(p + lane * 8), b = *(const u32x4*)(p + 512 + lane * 8);
#pragma unroll
    for (int j = 0; j < 4; ++j) { v[2 * j] = bf2f(a[j] & 0xffffu); v[2 * j + 1] = bf2f(a[j] >> 16); v[8 + 2 * j] = bf2f(b[j] & 0xffffu); v[9 + 2 * j] = bf2f(b[j] >> 16); }
}
__device__ __forceinline__ void p_ln1(const Ctx& C, int l) {
    const bf16_t* y1 = (const bf16_t*)(C.ws + WS_XC); bf16_t* x1b = (bf16_t*)(C.ws + WS_X1B);
    for (int row = C.bid * 8 + C.wave; row < T; row += C.G * 8) {
        float v[16]; load_row16_bf(y1 + (size_t)row * DM, C.lane, v);
        ln_row16(v, C.in[I_LN1G] + l * DM, C.in[I_LN1B] + l * DM, C.lane);
        row_emit(C, row, v, l, false);
        u32x4 o0, o1;
#pragma unroll
        for (int j = 0; j < 4; ++j) { o0[j] = pk2(v[2 * j], v[2 * j + 1]); o1[j] = pk2(v[8 + 2 * j], v[8 + 2 * j + 1]); }
        *(u32x4*)(x1b + (size_t)row * DM + C.lane * 8) = o0; *(u32x4*)(x1b + (size_t)row * DM + 512 + C.lane * 8) = o1;
    }
}

__device__ __forceinline__ void mix_pool_naive(const Ctx& C, int l) {
    const bf16_t* H = (const bf16_t*)(C.ws + WS_H); bf16_t* BR = (bf16_t*)(C.ws + WS_BR);
    LAS float* dd = (LAS float*)C.lds;
    for (int u = C.bid; u < (T / 64) * 4; u += C.G) {
        const int g = u & 3, t0 = (u >> 2) * 64, w = 2 << g;
        for (int idx = C.tid; idx < 64 * 128; idx += 512) {
            const int r = idx >> 7, c = idx & 127, row = t0 + r, pos = row & (SEQ - 1);
            const int nwin = (pos + 1 < w) ? pos + 1 : w;
            float s = 0.f;
            for (int j = 0; j < nwin; ++j) s += bf2f(H[(size_t)(row - j) * NH + HC_P + g * 128 + c]);
            dd[idx] = s / (float)nwin - bf2f(H[(size_t)row * NH + HC_P + g * 128 + c]);
        }
        __syncthreads();
        const int dcol = C.tid & 127, rq = C.tid >> 7;
        float acc[16];
#pragma unroll
        for (int i = 0; i < 16; ++i) acc[i] = 0.f;
        const float* pw = C.in[I_POOLW] + ((size_t)l * 4 + g) * 128 * 128;
        for (int c = 0; c < 128; ++c) {
            const float wv = pw[c * 128 + dcol];
#pragma unroll
            for (int i = 0; i < 16; ++i) acc[i] += dd[(rq * 16 + i) * 128 + c] * wv;
        }
        const float sc = C.in[I_POOLS][l * BW + g * 128 + dcol];
#pragma unroll
        for (int i = 0; i < 16; ++i) BR[(size_t)(t0 + rq * 16 + i) * NBR + 0 + g * 128 + dcol] = (bf16_t)f2bf(acc[i] * sc);
        __syncthreads();
    }
}
__device__ __forceinline__ void mix_gmlp_naive(const Ctx& C, int l) {
    const bf16_t* H = (const bf16_t*)(C.ws + WS_H); bf16_t* BR = (bf16_t*)(C.ws + WS_BR);
    LAS float* vn = (LAS float*)C.lds;
    for (int u = C.bid; u < (T / 128) * 4; u += C.G) {
        const int g = u & 3, t0 = (u >> 2) * 128;
        for (int i = 0; i < 16; ++i) {
            const int r = C.wave * 16 + i, row = t0 + r;
            const u32x4 raw = *(const u32x4*)(H + (size_t)row * NH + HC_GV + C.lane * 8);
            float e[8];
#pragma unroll
            for (int j = 0; j < 4; ++j) { e[2 * j] = geluf_(bf2f(raw[j] & 0xffffu)); e[2 * j + 1] = geluf_(bf2f(raw[j] >> 16)); }
            float s = 0.f;
#pragma unroll
            for (int j = 0; j < 8; ++j) s += e[j];
            const float mean = wave_sum(s) * (1.f / BW);
            float q = 0.f;
#pragma unroll
            for (int j = 0; j < 8; ++j) { const float d = e[j] - mean; q += d * d; }
            const float rstd = rsqrtf(wave_sum(q) * (1.f / BW) + LN_EPS);
            if ((C.lane >> 4) == g) {
#pragma unroll
                for (int j = 0; j < 8; ++j) { const int col = C.lane * 8 + j;
                    vn[r * 128 + (col - g * 128)] = (e[j] - mean) * rstd * C.in[I_GLNG][l * BW + col] + C.in[I_GLNB][l * BW + col]; }
            }
        }
        __syncthreads();
        const int c = C.tid & 127, tq = C.tid >> 7;
        const float* wsg = C.in[I_GWS] + ((size_t)l * 4 + g) * 128 * 128;
        for (int t = tq; t < 128; t += 4) {
            float acc = 0.f;
            for (int s = 0; s <= t; ++s) acc += wsg[t * 128 + s] * vn[s * 128 + c];
            const float sv = acc + C.in[I_GBS][(l * 4 + g) * 128 + t];
            const float uv = geluf_(bf2f(H[(size_t)(t0 + t) * NH + HC_GU + g * 128 + c]));
            BR[(size_t)(t0 + t) * NBR + 1024 + g * 128 + c] = (bf16_t)f2bf(uv * sv);
        }
        __syncthreads();
    }
}
__device__ __forceinline__ void mix_fox_naive(const Ctx& C, int l) {
    const bf16_t* H = (const bf16_t*)(C.ws + WS_H); bf16_t* BR = (bf16_t*)(C.ws + WS_BR);
    const float* cum = (const float*)(C.ws + WS_CUM);
    const float scale = 0.08838834764831845f;
    for (int u = C.bid; u < T * 4 / 8; u += C.G) {
        const int rid = u * 8 + C.wave;
        const int h = rid & 3, row = rid >> 2, b = row / SEQ, t = row % SEQ;
        const unsigned qraw = *(const unsigned*)(H + (size_t)row * NH + HC_FQ + h * 128 + C.lane * 2);
        const float q0 = bf2f(qraw & 0xffffu) * scale, q1 = bf2f(qraw >> 16) * scale;
        const float* cm = cum + ((size_t)b * 4 + h) * SEQ;
        const float ct = cm[t];
        float m = -1e30f, lsum = 0.f, o0 = 0.f, o1 = 0.f;
        for (int s = t; s >= 0; --s) {
            const size_t kr = (size_t)(b * SEQ + s) * NH + h * 128 + C.lane * 2;
            const unsigned kraw = *(const unsigned*)(H + kr + HC_FK);
            const unsigned vraw = *(const unsigned*)(H + kr + HC_FV);
            float d = q0 * bf2f(kraw & 0xffffu) + q1 * bf2f(kraw >> 16);
            d = wave_sum(d);
            const float z = d + ct - cm[s];
            const float mn = fmaxf(m, z), al = __expf(m - mn), p = __expf(z - mn);
            lsum = lsum * al + p; o0 = o0 * al + p * bf2f(vraw & 0xffffu); o1 = o1 * al + p * bf2f(vraw >> 16); m = mn;
        }
        const float inv = 1.f / lsum;
        *(unsigned*)(BR + (size_t)row * NBR + 1536 + h * 128 + C.lane * 2) = pk2(o0 * inv, o1 * inv);
    }
}
__device__ __forceinline__ void mix_hgrn_naive(const Ctx& C, int l) {
    if (C.bid >= BATCH * 4) return;
    const bf16_t* H = (const bf16_t*)(C.ws + WS_H); bf16_t* BR = (bf16_t*)(C.ws + WS_BR);
    const int b = C.bid >> 2, h = C.bid & 3;
    LAS float* fdec = (LAS float*)C.lds;
    LAS float* kkv = fdec + 32 * 128;
    LAS float* qsv = kkv + 32 * 128;
    LAS float* vv = qsv + 32 * 128;
    LAS float* opart = vv + 32 * 128;
    const int kq = C.tid >> 7, v = C.tid & 127;
    float S[32];
#pragma unroll
    for (int j = 0; j < 32; ++j) S[j] = 0.f;
    for (int c0 = 0; c0 < SEQ; c0 += 32) {
        for (int idx = C.tid; idx < 32 * 128; idx += 512) {
            const int st = idx >> 7, k = idx & 127; const size_t rb = (size_t)(b * SEQ + c0 + st) * NH + h * 128 + k;
            float lb = 0.f;
            if (l == 1) { const float z0 = C.in[I_LBL][h * 128 + k], z1 = C.in[I_LBL][BW + h * 128 + k]; lb = 1.f / (1.f + __expf(z0 - z1)); }
            const float zf = bf2f(H[rb + HC_HF]);
            const float kk = (1.f - lb) * sigmoidf_(-zf);
            fdec[idx] = 1.f - kk; kkv[idx] = kk; qsv[idx] = siluf_(bf2f(H[rb + HC_HQ])); vv[idx] = bf2f(H[rb + HC_HI]);
        }
        __syncthreads();
        for (int st = 0; st < 32; ++st) {
            const float vt = vv[st * 128 + v];
            float part = 0.f;
#pragma unroll
            for (int j = 0; j < 32; ++j) { const int k = kq * 32 + j; S[j] = fdec[st * 128 + k] * S[j] + kkv[st * 128 + k] * vt; part += S[j] * qsv[st * 128 + k]; }
            opart[(kq * 32 + st) * 128 + v] = part;
        }
        __syncthreads();
        for (int i = 0; i < 4; ++i) {
            const int st = C.wave * 4 + i, row = b * SEQ + c0 + st;
            float o0 = 0.f, o1 = 0.f;
#pragma unroll
            for (int q = 0; q < 4; ++q) { o0 += opart[(q * 32 + st) * 128 + C.lane]; o1 += opart[(q * 32 + st) * 128 + 64 + C.lane]; }
            const float ss = wave_sum(o0 * o0 + o1 * o1);
            const float r = rsqrtf(ss * (1.f / 128.f) + RMS_EPS);
            const float g0 = siluf_(bf2f(H[(size_t)row * NH + HC_HG + h * 128 + C.lane])), g1 = siluf_(bf2f(H[(size_t)row * NH + HC_HG + h * 128 + 64 + C.lane]));
            BR[(size_t)row * NBR + 512 + h * 128 + C.lane] = (bf16_t)f2bf(o0 * r * C.in[I_HNG][l * 128 + C.lane] * g0);
            BR[(size_t)row * NBR + 512 + h * 128 + 64 + C.lane] = (bf16_t)f2bf(o1 * r * C.in[I_HNG][l * 128 + 64 + C.lane] * g1);
        }
        __syncthreads();
    }
}


typedef float f32x16 __attribute__((ext_vector_type(16)));
typedef short s16x4 __attribute__((ext_vector_type(4)));
typedef short v4i16_t __attribute__((ext_vector_type(4)));
__device__ __forceinline__ s16x4 vtr(const LAS unsigned char* p) { return __builtin_bit_cast(s16x4, __builtin_amdgcn_ds_read_tr16_b64_v4i16((LAS v4i16_t*)p)); }
__device__ __forceinline__ float xor32(float x) { return __shfl_xor(x, 32, 64); }
#define MFMA32(a, b, c) __builtin_amdgcn_mfma_f32_32x32x16_bf16((a), (b), (c), 0, 0, 0)
constexpr int CW_KMAX = 16;

__device__ __forceinline__ void p_knorm(const Ctx& C, int l) {
    const bf16_t* H = (const bf16_t*)(C.ws + WS_H);
    unsigned* kmax = (unsigned*)(C.ws + WS_CTL) + CW_KMAX + l * 8;
    for (int r0 = (C.bid * 8 + C.wave) * 8; r0 < T; r0 += C.G * 64) {
        u32x4 raw[8];
#pragma unroll
        for (int i = 0; i < 8; ++i) raw[i] = *(const u32x4*)(H + (size_t)(r0 + i) * NH + HC_FK + C.lane * 8);
        float best = 0.f;
#pragma unroll
        for (int i = 0; i < 8; ++i) { float s = 0.f;
#pragma unroll
            for (int j = 0; j < 4; ++j) { const float a = bf2f(raw[i][j] & 0xffffu), b = bf2f(raw[i][j] >> 16); s += a * a + b * b; }
            best = fmaxf(best, s); }
        best = 0.f;
#pragma unroll
        for (int i = 0; i < 8; ++i) { float s = 0.f;
#pragma unroll
            for (int j = 0; j < 4; ++j) { const float a = bf2f(raw[i][j] & 0xffffu), b = bf2f(raw[i][j] >> 16); s += a * a + b * b; }
#pragma unroll
            for (int o = 8; o > 0; o >>= 1) s += __shfl_xor(s, o, 64);
            best = fmaxf(best, s); }
        LAS float* red = (LAS float*)C.lds;
        if ((C.lane & 15) == 0) red[C.wave * 4 + (C.lane >> 4)] = best;
        __syncthreads();
        if (C.tid < 4) { float m = red[C.tid];
#pragma unroll
            for (int w2 = 1; w2 < 8; ++w2) m = fmaxf(m, red[w2 * 4 + C.tid]);
            atomicMax(kmax + (r0 / SEQ) * 4 + C.tid, __builtin_bit_cast(unsigned, m)); }
        __syncthreads();
    }
}

constexpr int FOX_KST = 272, FOX_VST = 320;
constexpr int FOX_KB = 0, FOX_VB = 2 * 64 * FOX_KST, FOX_BETA = FOX_VB + 2 * 64 * FOX_VST, FOX_FLAG = FOX_BETA + 2 * 64 * 4, FOX_END = FOX_FLAG + 2 * 8 * 4;
__device__ __forceinline__ void mix_fox(const Ctx& C, int l) {
    const bf16_t* H = (const bf16_t*)(C.ws + WS_H); bf16_t* BR = (bf16_t*)(C.ws + WS_BR);
    const float* cum = (const float*)(C.ws + WS_CUM);
    const unsigned* kmaxw = (const unsigned*)(C.ws + WS_CTL) + CW_KMAX + l * 8;
    const float LOG2E = 1.4426950408889634f, QS = 0.08838834764831845f * LOG2E;
    const int lane = C.lane, w = C.wave, r32 = lane & 31, hh = lane >> 5;
    LAS unsigned char* lds = C.lds;
    LAS float* betaL = (LAS float*)(lds + FOX_BETA);
    volatile LAS int* flagL = (volatile LAS int*)(lds + FOX_FLAG);
    for (int u = C.bid; u < BATCH * 4 * (SEQ / 256); u += C.G) {
        const int qb = u % (SEQ / 256), bh = u / (SEQ / 256), b = bh >> 2, h = bh & 3;
        const int q0 = qb * 256, qw = q0 + 32 * w;
        const size_t rowbase = (size_t)b * SEQ;
        const float* cm = cum + ((size_t)b * 4 + h) * SEQ;
        const float c0 = cm[q0];
        const float kmx = sqrtf(__builtin_bit_cast(float, __hip_atomic_load(kmaxw + b * 4 + h, __ATOMIC_RELAXED, __HIP_MEMORY_SCOPE_AGENT)));
        bf16x8 qf[8]; float qn = 0.f;
        {
            const bf16_t* qp = H + (rowbase + qw + r32) * NH + HC_FQ + h * 128 + 8 * hh;
#pragma unroll
            for (int ks = 0; ks < 8; ++ks) {
                const u32x4 raw = *(const u32x4*)(qp + 16 * ks);
                u32x4 o;
#pragma unroll
                for (int j = 0; j < 4; ++j) { const float a = bf2f(raw[j] & 0xffffu), bb = bf2f(raw[j] >> 16); qn += a * a + bb * bb; o[j] = cvtpk(a * QS, bb * QS); }
                qf[ks] = __builtin_bit_cast(bf16x8, o);
            }
            qn += xor32(qn); qn = sqrtf(qn);
        }
        const float qbound = qn * kmx * QS;
        f32x16 oacc[4];
#pragma unroll
        for (int mt = 0; mt < 4; ++mt)
#pragma unroll
            for (int i = 0; i < 16; ++i) oacc[mt][i] = 0.f;
        float m_run = -1e30f, l_run = 0.f;
        const int jmax = (q0 + 255) >> 6;
        const int srow = C.tid >> 4, sch = C.tid & 15;
        u32x4 kreg[2], vreg[2]; float breg = 0.f;
#define FOX_GLOAD(j_) do { _Pragma("unroll") for (int p = 0; p < 2; ++p) { \
                const bf16_t* rp = H + (rowbase + 64 * (j_) + srow + 32 * p) * NH + h * 128 + sch * 8; \
                kreg[p] = *(const u32x4*)(rp + HC_FK); vreg[p] = *(const u32x4*)(rp + HC_FV); } \
            if (C.tid < 64) breg = (c0 - cm[64 * (j_) + C.tid]) * LOG2E; } while (0)
#define FOX_LWRITE(buf_) do { _Pragma("unroll") for (int p = 0; p < 2; ++p) { \
                *(LAS u32x4*)(lds + FOX_KB + (buf_) * 64 * FOX_KST + (srow + 32 * p) * FOX_KST + sch * 16) = kreg[p]; \
                *(LAS u32x4*)(lds + FOX_VB + (buf_) * 64 * FOX_VST + (srow + 32 * p) * FOX_VST + sch * 16) = vreg[p]; } \
            if (C.tid < 64) betaL[(buf_) * 64 + C.tid] = breg; } while (0)
        __syncthreads();
        if (C.tid < 16) flagL[C.tid] = 0;
        FOX_GLOAD(jmax); FOX_LWRITE(jmax & 1);
        bool wdone = false;
        for (int j = jmax; j >= 0; --j) {
            const int cur = j & 1;
            __syncthreads();
            if (j < jmax) { int all = 1;
#pragma unroll
                for (int i = 0; i < 8; ++i) all &= flagL[((j + 1) & 1) * 8 + i];
                if (all) break; }
            if (j > 0) FOX_GLOAD(j - 1);
            const int k0 = 64 * j;
            if (k0 <= qw + 31 && !wdone) {
                const LAS unsigned char* kb = lds + FOX_KB + cur * 64 * FOX_KST;
                const LAS unsigned char* vb = lds + FOX_VB + cur * 64 * FOX_VST;
                f32x16 sacc[2];
#pragma unroll
                for (int mt = 0; mt < 2; ++mt)
#pragma unroll
                    for (int g = 0; g < 4; ++g) { const f32x4 bv = *(const LAS f32x4*)(betaL + cur * 64 + 32 * mt + 8 * g + 4 * hh);
                        sacc[mt][4 * g] = bv[0]; sacc[mt][4 * g + 1] = bv[1]; sacc[mt][4 * g + 2] = bv[2]; sacc[mt][4 * g + 3] = bv[3]; }
#pragma unroll
                for (int ks = 0; ks < 8; ++ks)
#pragma unroll
                    for (int mt = 0; mt < 2; ++mt) {
                        const bf16x8 kf = *(const LAS bf16x8*)(kb + (32 * mt + r32) * FOX_KST + 32 * ks + 16 * hh);
                        sacc[mt] = MFMA32(kf, qf[ks], sacc[mt]);
                    }
                const int tq = qw + r32;
                if (k0 + 63 > qw) {
#pragma unroll
                    for (int mt = 0; mt < 2; ++mt)
#pragma unroll
                        for (int i = 0; i < 16; ++i) { const int key = k0 + 32 * mt + (i & 3) + 8 * (i >> 2) + 4 * hh; if (key > tq) sacc[mt][i] = -1e30f; }
                }
                float mx = sacc[0][0];
#pragma unroll
                for (int mt = 0; mt < 2; ++mt)
#pragma unroll
                    for (int i = 0; i < 16; ++i) mx = fmaxf(mx, sacc[mt][i]);
                mx = fmaxf(mx, xor32(mx));
                const float mn = fmaxf(m_run, mx), alpha = __builtin_amdgcn_exp2f(m_run - mn);
                m_run = mn;
                float ps = 0.f;
#pragma unroll
                for (int mt = 0; mt < 2; ++mt)
#pragma unroll
                    for (int i = 0; i < 16; ++i) { const float p = __builtin_amdgcn_exp2f(sacc[mt][i] - mn); sacc[mt][i] = p; ps += p; }
                l_run = l_run * alpha + ps;
#pragma unroll
                for (int mt = 0; mt < 4; ++mt)
#pragma unroll
                    for (int i = 0; i < 16; ++i) oacc[mt][i] *= alpha;
#pragma unroll
                for (int s4 = 0; s4 < 4; ++s4) {
                    const int mtk = s4 >> 1, s = s4 & 1;
                    u32x4 pb;
#pragma unroll
                    for (int e = 0; e < 4; ++e) pb[e] = cvtpk(sacc[mtk][8 * s + 2 * e], sacc[mtk][8 * s + 2 * e + 1]);
                    const bf16x8 pfrag = __builtin_bit_cast(bf16x8, pb);
                    const int i16 = lane & 15, q4 = i16 >> 2, p4 = i16 & 3, blk = (lane >> 4) & 1;
                    const int keyA = 32 * mtk + 16 * s + 4 * hh + q4;
#pragma unroll
                    for (int mt = 0; mt < 4; ++mt) {
                        const LAS unsigned char* a0 = vb + keyA * FOX_VST + (32 * mt + 16 * blk + 4 * p4) * 2;
                        const s16x4 lo = vtr(a0), hi = vtr(a0 + 8 * FOX_VST);
                        const bf16x8 vf = __builtin_shufflevector(lo, hi, 0, 1, 2, 3, 4, 5, 6, 7);
                        oacc[mt] = MFMA32(vf, pfrag, oacc[mt]);
                    }
                }
                if (j > 0) { const float bl = (c0 - cm[k0 - 1]) * LOG2E;
                    const int ok = (qbound + bl < m_run - 40.f) ? 1 : 0;
                    wdone = __all(ok); }
            }
            if (lane == 0) flagL[cur * 8 + w] = wdone ? 1 : 0;
            if (j > 0) FOX_LWRITE(cur ^ 1);
        }
        l_run += xor32(l_run);
        const float inv = 1.f / l_run;
        bf16_t* op = BR + (rowbase + qw + r32) * NBR + 1536 + h * 128;
#pragma unroll
        for (int mt = 0; mt < 4; ++mt)
#pragma unroll
            for (int g = 0; g < 4; ++g) { u32x2 o; o[0] = cvtpk(oacc[mt][4 * g] * inv, oacc[mt][4 * g + 1] * inv); o[1] = cvtpk(oacc[mt][4 * g + 2] * inv, oacc[mt][4 * g + 3] * inv);
                *(u32x2*)(op + 32 * mt + 8 * g + 4 * hh) = o; }
    }
}


constexpr int HG_LF = 0, HG_QA = 34816, HG_QB = HG_QA + 17408, HG_KD = HG_QB + 8704, HG_KO = HG_KD + 17408, HG_KT = HG_KO + 8704, HG_VN = HG_KT + 20480, HG_AM = HG_VN + 20480, HG_END = HG_AM + 12288;
constexpr int HG_LFS = 132;
static_assert(HG_END + 2048 <= 140 * 1024, "hgrn LDS");
constexpr size_t WS_DSC = WS_ST + (size_t)BATCH * 4 * 32 * 128 * 128 * 4;

template <bool FULL>
__device__ __forceinline__ void hgrn_unit(const Ctx& C, int l, int u) {
#if DIAG == 1
    const bf16_t* H = (const bf16_t*)(C.ws + WS_H); bf16_t* BR = (l == 0) ? (bf16_t*)(C.ws + WS_XA) : (bf16_t*)(C.ws + WS_TABU);
#else
    const bf16_t* H = (const bf16_t*)(C.ws + WS_H); bf16_t* BR = (bf16_t*)(C.ws + WS_BR);
#endif
    float* STB = (float*)(C.ws + WS_ST); float* DSC = (float*)(C.ws + WS_DSC);
    LAS unsigned char* lds = C.lds;
    LAS float* LF = (LAS float*)(lds + HG_LF);
    const int lane = C.lane, w = C.wave, r32 = lane & 31, hh = lane >> 5;
    const int sc = u & 31, bh = u >> 5, b = bh >> 2, h = bh & 3;
    const int wk = w >> 1, wv = w & 1;
    const int mt = w >> 2, nt = w & 3;
    const int i16 = lane & 15, q4 = i16 >> 2, p4 = i16 & 3, blk = (lane >> 4) & 1;
    f32x16 S0, S1;
    float* stp = STB + ((size_t)bh * 32 + sc) * 128 * 128;
    if constexpr (FULL) {
#pragma unroll
        for (int i = 0; i < 16; ++i) { const int k = 32 * wk + (i & 3) + 8 * (i >> 2) + 4 * hh;
            S0[i] = stp[k * 128 + 64 * wv + r32]; S1[i] = stp[k * 128 + 64 * wv + 32 + r32]; }
    } else {
#pragma unroll
        for (int i = 0; i < 16; ++i) { S0[i] = 0.f; S1[i] = 0.f; }
    }
    float dtot = 0.f;
    const int ps = C.tid >> 3, pseg = C.tid & 7;
    float lbv[16];
#pragma unroll
    for (int j = 0; j < 16; ++j) { lbv[j] = 0.f;
        if (l == 1) { const int ch = h * 128 + 16 * pseg + j; lbv[j] = 1.f / (1.f + __expf(C.in[I_LBL][ch] - C.in[I_LBL][BW + ch])); } }
    u32x4 nf0, nf1, nv0, nv1;
    { const bf16_t* hp0 = H + ((size_t)b * SEQ + sc * 256 + ps) * NH + h * 128 + 16 * pseg;
      nf0 = *(const u32x4*)(hp0 + HC_HF); nf1 = *(const u32x4*)(hp0 + HC_HF + 8); nv0 = *(const u32x4*)(hp0 + HC_HI); nv1 = *(const u32x4*)(hp0 + HC_HI + 8); }
    for (int c = 0; c < 4; ++c) {
        const size_t row0 = (size_t)b * SEQ + sc * 256 + c * 64;
        const bf16_t* hp = H + (row0 + ps) * NH + h * 128 + 16 * pseg;
        float kkv[16], qsv[16];
        u32x4 vraw0, vraw1;
        u32x4 cg0 = {0u, 0u, 0u, 0u}, cg1 = cg0, cq0 = cg0, cq1 = cg0;
        if constexpr (FULL) { cq0 = *(const u32x4*)(hp + HC_HQ); cq1 = *(const u32x4*)(hp + HC_HQ + 8); cg0 = *(const u32x4*)(hp + HC_HG); cg1 = *(const u32x4*)(hp + HC_HG + 8); }
        {
            const u32x4 f0 = nf0, f1 = nf1;
            vraw0 = nv0; vraw1 = nv1;
            if (c < 3) { const bf16_t* hn = hp + (size_t)64 * NH;
                nf0 = *(const u32x4*)(hn + HC_HF); nf1 = *(const u32x4*)(hn + HC_HF + 8); nv0 = *(const u32x4*)(hn + HC_HI); nv1 = *(const u32x4*)(hn + HC_HI + 8); }
#pragma unroll
            for (int j = 0; j < 8; ++j) { const unsigned r = (j < 4) ? f0[j] : f1[j - 4];
                const float z0 = bf2f(r & 0xffffu), z1 = bf2f(r >> 16);
                kkv[2 * j] = (1.f - lbv[2 * j]) * sigmoidf_(-z0); kkv[2 * j + 1] = (1.f - lbv[2 * j + 1]) * sigmoidf_(-z1); }
            if constexpr (FULL) {
#pragma unroll
                for (int j = 0; j < 8; ++j) { const unsigned r = (j < 4) ? cq0[j] : cq1[j - 4]; qsv[2 * j] = siluf_(bf2f(r & 0xffffu)); qsv[2 * j + 1] = siluf_(bf2f(r >> 16)); }
            }
#pragma unroll
            for (int j4 = 0; j4 < 4; ++j4) { f32x4 o;
#pragma unroll
                for (int e = 0; e < 4; ++e) o[e] = __logf(1.f - kkv[4 * j4 + e]);
                *(LAS f32x4*)(LF + ps * HG_LFS + 16 * pseg + 4 * j4) = o; }
        }
        __syncthreads();
        {
            const int sk = C.tid & 127, sg = C.tid >> 7;
            float vals[16];
#pragma unroll
            for (int i = 0; i < 16; ++i) vals[i] = LF[(16 * sg + i) * HG_LFS + sk];
#pragma unroll
            for (int i = 1; i < 16; ++i) vals[i] += vals[i - 1];
            LAS float* TOT = (LAS float*)(lds + HG_END);
            TOT[sg * 128 + sk] = vals[15];
            __syncthreads();
            float off = 0.f;
#pragma unroll
            for (int j = 0; j < 3; ++j) if (j < sg) off += TOT[j * 128 + sk];
#pragma unroll
            for (int i = 0; i < 16; ++i) LF[(16 * sg + i) * HG_LFS + sk] = vals[i] + off;
            if (sg == 3) dtot += vals[15] + off;
        }
        __syncthreads();
        float bv[16], b31[16], bl[16];
#pragma unroll
        for (int j4 = 0; j4 < 4; ++j4) { const f32x4 x = *(const LAS f32x4*)(LF + ps * HG_LFS + 16 * pseg + 4 * j4), y = *(const LAS f32x4*)(LF + 31 * HG_LFS + 16 * pseg + 4 * j4), z = *(const LAS f32x4*)(LF + 63 * HG_LFS + 16 * pseg + 4 * j4);
#pragma unroll
            for (int e = 0; e < 4; ++e) { bv[4 * j4 + e] = x[e]; b31[4 * j4 + e] = y[e]; bl[4 * j4 + e] = z[e]; } }
        {
            u32x4 o0, o1;
#pragma unroll
            for (int j = 0; j < 4; ++j) { o0[j] = cvtpk(kkv[2 * j] * __expf(bl[2 * j] - bv[2 * j]), kkv[2 * j + 1] * __expf(bl[2 * j + 1] - bv[2 * j + 1]));
                o1[j] = cvtpk(kkv[8 + 2 * j] * __expf(bl[8 + 2 * j] - bv[8 + 2 * j]), kkv[9 + 2 * j] * __expf(bl[9 + 2 * j] - bv[9 + 2 * j])); }
            *(LAS u32x4*)(lds + HG_KT + ps * 320 + 32 * pseg) = o0; *(LAS u32x4*)(lds + HG_KT + ps * 320 + 32 * pseg + 16) = o1;
            *(LAS u32x4*)(lds + HG_VN + ps * 320 + 32 * pseg) = vraw0; *(LAS u32x4*)(lds + HG_VN + ps * 320 + 32 * pseg + 16) = vraw1;
            if constexpr (FULL) {
                const bool hi = ps >= 32;
                float rr[16];
#pragma unroll
                for (int j = 0; j < 16; ++j) rr[j] = hi ? b31[j] : 0.f;
#pragma unroll
                for (int j = 0; j < 4; ++j) { o0[j] = cvtpk(qsv[2 * j] * __expf(bv[2 * j] - rr[2 * j]), qsv[2 * j + 1] * __expf(bv[2 * j + 1] - rr[2 * j + 1]));
                    o1[j] = cvtpk(qsv[8 + 2 * j] * __expf(bv[8 + 2 * j] - rr[8 + 2 * j]), qsv[9 + 2 * j] * __expf(bv[9 + 2 * j] - rr[9 + 2 * j])); }
                *(LAS u32x4*)(lds + HG_QA + ps * 272 + 32 * pseg) = o0; *(LAS u32x4*)(lds + HG_QA + ps * 272 + 32 * pseg + 16) = o1;
#pragma unroll
                for (int j = 0; j < 4; ++j) { o0[j] = cvtpk(kkv[2 * j] * __expf(rr[2 * j] - bv[2 * j]), kkv[2 * j + 1] * __expf(rr[2 * j + 1] - bv[2 * j + 1]));
                    o1[j] = cvtpk(kkv[8 + 2 * j] * __expf(rr[8 + 2 * j] - bv[8 + 2 * j]), kkv[9 + 2 * j] * __expf(rr[9 + 2 * j] - bv[9 + 2 * j])); }
                *(LAS u32x4*)(lds + HG_KD + ps * 272 + 32 * pseg) = o0; *(LAS u32x4*)(lds + HG_KD + ps * 272 + 32 * pseg + 16) = o1;
                if (hi) {
#pragma unroll
                    for (int j = 0; j < 4; ++j) { o0[j] = cvtpk(qsv[2 * j] * __expf(bv[2 * j]), qsv[2 * j + 1] * __expf(bv[2 * j + 1]));
                        o1[j] = cvtpk(qsv[8 + 2 * j] * __expf(bv[8 + 2 * j]), qsv[9 + 2 * j] * __expf(bv[9 + 2 * j])); }
                    *(LAS u32x4*)(lds + HG_QB + (ps - 32) * 272 + 32 * pseg) = o0; *(LAS u32x4*)(lds + HG_QB + (ps - 32) * 272 + 32 * pseg + 16) = o1;
                } else {
#pragma unroll
                    for (int j = 0; j < 4; ++j) { o0[j] = cvtpk(kkv[2 * j] * __expf(b31[2 * j] - bv[2 * j]), kkv[2 * j + 1] * __expf(b31[2 * j + 1] - bv[2 * j + 1]));
                        o1[j] = cvtpk(kkv[8 + 2 * j] * __expf(b31[8 + 2 * j] - bv[8 + 2 * j]), kkv[9 + 2 * j] * __expf(b31[9 + 2 * j] - bv[9 + 2 * j])); }
                    *(LAS u32x4*)(lds + HG_KO + ps * 272 + 32 * pseg) = o0; *(LAS u32x4*)(lds + HG_KO + ps * 272 + 32 * pseg + 16) = o1;
                }
            }
        }
        float dk[16];
#pragma unroll
        for (int i = 0; i < 16; ++i) dk[i] = __expf(LF[63 * HG_LFS + 32 * wk + (i & 3) + 8 * (i >> 2) + 4 * hh]);
        __syncthreads();
        if constexpr (FULL) {
#pragma unroll
            for (int g = 0; g < 4; ++g) {
                u32x2 o; o[0] = cvtpk(S0[4 * g], S0[4 * g + 1]); o[1] = cvtpk(S0[4 * g + 2], S0[4 * g + 3]);
                *(LAS u32x2*)(lds + HG_LF + (64 * wv + r32) * 272 + (32 * wk + 8 * g + 4 * hh) * 2) = o;
                o[0] = cvtpk(S1[4 * g], S1[4 * g + 1]); o[1] = cvtpk(S1[4 * g + 2], S1[4 * g + 3]);
                *(LAS u32x2*)(lds + HG_LF + (64 * wv + 32 + r32) * 272 + (32 * wk + 8 * g + 4 * hh) * 2) = o;
            }
#define HG_ATILE(AMT_, AST_) do { \
                const LAS unsigned char* kb = ((AMT_) == (AST_)) ? (lds + HG_KD + (32 * (AST_)) * 272) : (lds + HG_KO); \
                f32x16 a; \
                _Pragma("unroll") for (int i = 0; i < 16; ++i) a[i] = 0.f; \
                _Pragma("unroll") for (int ks = 0; ks < 8; ++ks) { \
                    const bf16x8 af = *(const LAS bf16x8*)(lds + HG_QA + (32 * (AMT_) + r32) * 272 + 32 * ks + 16 * hh); \
                    const bf16x8 bf = *(const LAS bf16x8*)(kb + r32 * 272 + 32 * ks + 16 * hh); \
                    a = MFMA32(af, bf, a); } \
                _Pragma("unroll") for (int g = 0; g < 4; ++g) { \
                    float x[4]; \
                    _Pragma("unroll") for (int e = 0; e < 4; ++e) { const int tl = 8 * g + 4 * hh + e; x[e] = ((AMT_) != (AST_) || r32 <= tl) ? a[4 * g + e] : 0.f; } \
                    u32x2 o; o[0] = cvtpk(x[0], x[1]); o[1] = cvtpk(x[2], x[3]); \
                    *(LAS u32x2*)(lds + HG_AM + (32 * (AST_) + r32) * 192 + (32 * (AMT_) + 8 * g + 4 * hh) * 2) = o; } } while (0)
            if (w == 0) { HG_ATILE(0, 0); }
            else if (w == 1) { HG_ATILE(1, 0); }
            else if (w == 2) { HG_ATILE(1, 1); }
        }
#pragma unroll
        for (int i = 0; i < 16; ++i) { S0[i] *= dk[i]; S1[i] *= dk[i]; }
#pragma unroll
        for (int ks = 0; ks < 4; ++ks) {
            const LAS unsigned char* ka = lds + HG_KT + (16 * ks + 8 * hh + q4) * 320 + (32 * wk + 16 * blk + 4 * p4) * 2;
            const s16x4 alo = vtr(ka), ahi = vtr(ka + 4 * 320);
            const bf16x8 af = __builtin_shufflevector(alo, ahi, 0, 1, 2, 3, 4, 5, 6, 7);
            const LAS unsigned char* vb0 = lds + HG_VN + (16 * ks + 8 * hh + q4) * 320 + (64 * wv + 16 * blk + 4 * p4) * 2;
            const s16x4 b0lo = vtr(vb0), b0hi = vtr(vb0 + 4 * 320), b1lo = vtr(vb0 + 64), b1hi = vtr(vb0 + 64 + 4 * 320);
            S0 = MFMA32(af, __builtin_shufflevector(b0lo, b0hi, 0, 1, 2, 3, 4, 5, 6, 7), S0);
            S1 = MFMA32(af, __builtin_shufflevector(b1lo, b1hi, 0, 1, 2, 3, 4, 5, 6, 7), S1);
        }
        if constexpr (FULL) {
            __syncthreads();
            f32x16 o;
#pragma unroll
            for (int i = 0; i < 16; ++i) o[i] = 0.f;
            const LAS unsigned char* qb = (mt == 0) ? (lds + HG_QA) : (lds + HG_QB);
#pragma unroll
            for (int ks = 0; ks < 8; ++ks) {
                const bf16x8 af = *(const LAS bf16x8*)(qb + r32 * 272 + 32 * ks + 16 * hh);
                const bf16x8 bf = *(const LAS bf16x8*)(lds + HG_LF + (32 * nt + r32) * 272 + 32 * ks + 16 * hh);
                o = MFMA32(af, bf, o);
            }
#pragma unroll
            for (int ks = 0; ks < 4; ++ks) {
                if (mt == 0 && ks >= 2) continue;
                const LAS unsigned char* aa = lds + HG_AM + (16 * ks + 8 * hh + q4) * 192 + (32 * mt + 16 * blk + 4 * p4) * 2;
                const s16x4 alo = vtr(aa), ahi = vtr(aa + 4 * 192);
                const LAS unsigned char* vb0 = lds + HG_VN + (16 * ks + 8 * hh + q4) * 320 + (32 * nt + 16 * blk + 4 * p4) * 2;
                const s16x4 blo = vtr(vb0), bhi = vtr(vb0 + 4 * 320);
                o = MFMA32(__builtin_shufflevector(alo, ahi, 0, 1, 2, 3, 4, 5, 6, 7), __builtin_shufflevector(blo, bhi, 0, 1, 2, 3, 4, 5, 6, 7), o);
            }
            __syncthreads();
#pragma unroll
            for (int i = 0; i < 16; ++i) LF[(32 * mt + (i & 3) + 8 * (i >> 2) + 4 * hh) * HG_LFS + 32 * nt + r32] = o[i];
            __syncthreads();
            {
                float ov[16]; float ss = 0.f;
#pragma unroll
                for (int j4 = 0; j4 < 4; ++j4) { const f32x4 x = *(const LAS f32x4*)(LF + ps * HG_LFS + 16 * pseg + 4 * j4);
#pragma unroll
                    for (int e = 0; e < 4; ++e) { ov[4 * j4 + e] = x[e]; ss += x[e] * x[e]; } }
                ss += __shfl_xor(ss, 1, 64); ss += __shfl_xor(ss, 2, 64); ss += __shfl_xor(ss, 4, 64);
                const float rn = rsqrtf(ss * (1.f / 128.f) + RMS_EPS);
                const u32x4 g0 = cg0, g1 = cg1;
                const float* ng = C.in[I_HNG] + l * 128 + 16 * pseg;
                u32x4 o0, o1;
#pragma unroll
                for (int j = 0; j < 4; ++j) {
                    o0[j] = cvtpk(ov[2 * j] * rn * ng[2 * j] * siluf_(bf2f(g0[j] & 0xffffu)), ov[2 * j + 1] * rn * ng[2 * j + 1] * siluf_(bf2f(g0[j] >> 16)));
                    o1[j] = cvtpk(ov[8 + 2 * j] * rn * ng[8 + 2 * j] * siluf_(bf2f(g1[j] & 0xffffu)), ov[9 + 2 * j] * rn * ng[9 + 2 * j] * siluf_(bf2f(g1[j] >> 16)));
                }
                bf16_t* bp = BR + (row0 + ps) * NBR + 512 + h * 128 + 16 * pseg;
                *(u32x4*)bp = o0; *(u32x4*)(bp + 8) = o1;
            }
        }
        __syncthreads();
    }
    if constexpr (!FULL) {
#pragma unroll
        for (int i = 0; i < 16; ++i) { const int k = 32 * wk + (i & 3) + 8 * (i >> 2) + 4 * hh;
            stp[k * 128 + 64 * wv + r32] = S0[i]; stp[k * 128 + 64 * wv + 32 + r32] = S1[i]; }
        if (C.tid >= 384) DSC[((size_t)bh * 32 + sc) * 128 + (C.tid & 127)] = __expf(dtot);
    }
}
__device__ __forceinline__ void hgrn_b1(const Ctx& C, int l) { for (int u = C.bid; u < BATCH * 4 * 32; u += C.G) hgrn_unit<false>(C, l, u); }
__device__ __forceinline__ void hgrn_b3(const Ctx& C, int l) { for (int u = C.bid; u < BATCH * 4 * 32; u += C.G) hgrn_unit<true>(C, l, u); }
__device__ __forceinline__ void hgrn_b2(const Ctx& C) {
    float* STB = (float*)(C.ws + WS_ST); const float* DSC = (const float*)(C.ws + WS_DSC);
    for (int e = C.bid * 512 + C.tid; e < BATCH * 4 * 128 * 128; e += C.G * 512) {
        const int bh = e >> 14, kv = e & 16383, k = kv >> 7;
        float* p = STB + (size_t)bh * 32 * 16384 + kv;
        float uu[32], dd[32];
#pragma unroll
        for (int s = 0; s < 32; ++s) { uu[s] = p[(size_t)s * 16384]; dd[s] = DSC[((size_t)bh * 32 + s) * 128 + k]; }
        float st = 0.f;
#pragma unroll
        for (int s = 0; s < 32; ++s) { p[(size_t)s * 16384] = st; st = dd[s] * st + uu[s]; }
    }
}


__device__ __forceinline__ void mix_pool(const Ctx& C, int l) {
#if DIAG == 2
    const bf16_t* H = (const bf16_t*)(C.ws + WS_H); bf16_t* BR = (l == 0) ? (bf16_t*)(C.ws + WS_XA) : (bf16_t*)(C.ws + WS_TABU);
#else
    const bf16_t* H = (const bf16_t*)(C.ws + WS_H); bf16_t* BR = (bf16_t*)(C.ws + WS_BR);
#endif
    const bf16_t* Wt = (const bf16_t*)(C.ws + WS_W + (size_t)l * W_LAYER + WO_POOLW);
    LAS unsigned char* lds = C.lds;
    constexpr int PL_P = 128 * 272;
    const int lane = C.lane, w = C.wave, r32 = lane & 31, hh = lane >> 5;
    for (int u = C.bid; u < (T / 256) * 4; u += C.G) {
        const int g = u & 3, t0 = (u >> 2) * 256, win = 2 << g;
        const int row = t0 + 32 * w + r32, pos = row & (SEQ - 1);
        __syncthreads();
#pragma unroll
        for (int p = 0; p < 4; ++p) { const int idx = C.tid + 512 * p, rr = idx >> 4, ch = idx & 15;
            *(LAS u32x4*)(lds + rr * 272 + ch * 16) = *(const u32x4*)(Wt + (size_t)g * 128 * 128 + rr * 128 + ch * 8); }
        const bool seq_start = (t0 & (SEQ - 1)) == 0;
        for (int idx = C.tid; idx < 271 * 16; idx += 512) { const int rr = idx >> 4, ch = idx & 15;
            if (!(seq_start && rr < 15)) *(LAS u32x4*)(lds + PL_P + rr * 272 + ch * 16) = *(const u32x4*)(H + (size_t)(t0 - 15 + rr) * NH + HC_P + g * 128 + ch * 8); }
        __syncthreads();
        const int nwin = (pos + 1 < win) ? pos + 1 : win;
        const float invn = 1.f / (float)nwin;
        bf16x8 df[8];
        const LAS unsigned char* prow = lds + PL_P + (32 * w + r32 + 15) * 272 + 16 * hh;
#pragma unroll
        for (int ks = 0; ks < 8; ++ks) {
            float sum[8];
#pragma unroll
            for (int e = 0; e < 8; ++e) sum[e] = 0.f;
            const u32x4 self = *(const LAS u32x4*)(prow + 32 * ks);
#pragma unroll
            for (int j = 0; j < 16; ++j) if (j < win) {
                const int jj = (j < nwin) ? j : 0; const float msk = (j < nwin) ? 1.f : 0.f;
                const u32x4 rw = *(const LAS u32x4*)(prow + 32 * ks - jj * 272);
#pragma unroll
                for (int e = 0; e < 4; ++e) { sum[2 * e] += msk * bf2f(rw[e] & 0xffffu); sum[2 * e + 1] += msk * bf2f(rw[e] >> 16); } }
            u32x4 o;
#pragma unroll
            for (int e = 0; e < 4; ++e) o[e] = cvtpk(sum[2 * e] * invn - bf2f(self[e] & 0xffffu), sum[2 * e + 1] * invn - bf2f(self[e] >> 16));
            df[ks] = __builtin_bit_cast(bf16x8, o);
        }
        f32x16 acc[4];
#pragma unroll
        for (int mt = 0; mt < 4; ++mt)
#pragma unroll
            for (int i = 0; i < 16; ++i) acc[mt][i] = 0.f;
#pragma unroll
        for (int ks = 0; ks < 8; ++ks)
#pragma unroll
            for (int mt = 0; mt < 4; ++mt) {
                const bf16x8 wf = *(const LAS bf16x8*)(lds + (32 * mt + r32) * 272 + 32 * ks + 16 * hh);
                acc[mt] = MFMA32(wf, df[ks], acc[mt]);
            }
        const float* psc = C.in[I_POOLS] + l * BW + g * 128;
        bf16_t* op = BR + (size_t)row * NBR + g * 128;
#pragma unroll
        for (int mt = 0; mt < 4; ++mt)
#pragma unroll
            for (int q = 0; q < 4; ++q) { const int d0 = 32 * mt + 8 * q + 4 * hh; const f32x4 sc = *(const f32x4*)(psc + d0);
                u32x2 o; o[0] = cvtpk(acc[mt][4 * q] * sc[0], acc[mt][4 * q + 1] * sc[1]); o[1] = cvtpk(acc[mt][4 * q + 2] * sc[2], acc[mt][4 * q + 3] * sc[3]);
                *(u32x2*)(op + d0) = o; }
    }
}
#if DIAG == 3
#define GM_VNBUF ((bf16_t*)(C.ws + WS_X1B))
constexpr int GM_VLD = BW, GM_VOFF = 0;
#else
#define GM_VNBUF ((bf16_t*)(C.ws + WS_H))
constexpr int GM_VLD = NH, GM_VOFF = HC_GV;
#endif
__device__ __forceinline__ void p_gmlp_prep(const Ctx& C, int l) {
    const bf16_t* H = (const bf16_t*)(C.ws + WS_H); bf16_t* VN = GM_VNBUF;
    const float* lgp = C.in[I_GLNG] + l * BW + C.lane * 8; const float* lbp = C.in[I_GLNB] + l * BW + C.lane * 8;
    const f32x4 g0 = *(const f32x4*)lgp, g1 = *(const f32x4*)(lgp + 4), b0 = *(const f32x4*)lbp, b1 = *(const f32x4*)(lbp + 4);
    for (int row = C.bid * 8 + C.wave; row < T; row += C.G * 8) {
        const u32x4 raw = *(const u32x4*)(H + (size_t)row * NH + HC_GV + C.lane * 8);
        float e[8], s1 = 0.f, s2 = 0.f;
#pragma unroll
        for (int j = 0; j < 4; ++j) { const float a = geluf_(bf2f(raw[j] & 0xffffu)), b = geluf_(bf2f(raw[j] >> 16)); e[2 * j] = a; e[2 * j + 1] = b; s1 += a + b; s2 += a * a + b * b; }
        const float mean = wave_sum(s1) * (1.f / BW), ex2 = wave_sum(s2) * (1.f / BW);
        const float rstd = rsqrtf(fmaxf(ex2 - mean * mean, 0.f) + LN_EPS);
        u32x4 o;
        o[0] = cvtpk((e[0] - mean) * rstd * g0[0] + b0[0], (e[1] - mean) * rstd * g0[1] + b0[1]); o[1] = cvtpk((e[2] - mean) * rstd * g0[2] + b0[2], (e[3] - mean) * rstd * g0[3] + b0[3]);
        o[2] = cvtpk((e[4] - mean) * rstd * g1[0] + b1[0], (e[5] - mean) * rstd * g1[1] + b1[1]); o[3] = cvtpk((e[6] - mean) * rstd * g1[2] + b1[2], (e[7] - mean) * rstd * g1[3] + b1[3]);
        *(u32x4*)(VN + (size_t)row * GM_VLD + GM_VOFF + C.lane * 8) = o;
    }
}
constexpr int GM_VN = 0, GM_WC = 128 * 320, GM_END = GM_WC + 128 * 272;
__device__ __forceinline__ void mix_gmlp(const Ctx& C, int l) {
#if DIAG == 3
    const bf16_t* H = (const bf16_t*)(C.ws + WS_H); bf16_t* BR = (l == 0) ? (bf16_t*)(C.ws + WS_XA) : (bf16_t*)(C.ws + WS_TABU);
#else
    const bf16_t* H = (const bf16_t*)(C.ws + WS_H); bf16_t* BR = (bf16_t*)(C.ws + WS_BR);
#endif
    const bf16_t* Wc = (const bf16_t*)(C.ws + WS_W + (size_t)l * W_LAYER + WO_GWS);
    LAS unsigned char* lds = C.lds;
    const int lane = C.lane, w = C.wave, r32 = lane & 31, hh = lane >> 5;
    const int i16 = lane & 15, q4 = i16 >> 2, p4 = i16 & 3, blk = (lane >> 4) & 1;
    for (int u = C.bid; u < (T / 128) * 4; u += C.G) {
        const int g = u & 3, t0 = (u >> 2) * 128;
        __syncthreads();
#pragma unroll
        for (int p = 0; p < 4; ++p) { const int idx = C.tid + 512 * p, rr = idx >> 4, ch = idx & 15;
            *(LAS u32x4*)(lds + GM_WC + rr * 272 + ch * 16) = *(const u32x4*)(Wc + (size_t)g * 128 * 128 + rr * 128 + ch * 8); }
#pragma unroll
        for (int p = 0; p < 4; ++p) { const int idx = C.tid + 512 * p, rr = idx >> 4, ch = idx & 15;
            *(LAS u32x4*)(lds + GM_VN + rr * 320 + ch * 16) = *(const u32x4*)(GM_VNBUF + (size_t)(t0 + rr) * GM_VLD + GM_VOFF + g * 128 + ch * 8); }
        __syncthreads();
        const int nt = w & 3, mb = (w >> 2) * 2;
        u32x2 upre[2][4];
#pragma unroll
        for (int m = 0; m < 2; ++m)
#pragma unroll
            for (int q = 0; q < 4; ++q) upre[m][q] = *(const u32x2*)(H + (size_t)(t0 + 32 * nt + r32) * NH + HC_GU + g * 128 + 32 * (mb + m) + 8 * q + 4 * hh);
        f32x16 acc[2];
#pragma unroll
        for (int m = 0; m < 2; ++m)
#pragma unroll
            for (int i = 0; i < 16; ++i) acc[m][i] = 0.f;
        for (int ks = 0; ks < 2 * (nt + 1); ++ks) {
            const bf16x8 bf = *(const LAS bf16x8*)(lds + GM_WC + (32 * nt + r32) * 272 + 32 * ks + 16 * hh);
#pragma unroll
            for (int m = 0; m < 2; ++m) {
                const LAS unsigned char* aa = lds + GM_VN + (16 * ks + 8 * hh + q4) * 320 + (32 * (mb + m) + 16 * blk + 4 * p4) * 2;
                const s16x4 lo = vtr(aa), hi = vtr(aa + 4 * 320);
                acc[m] = MFMA32(__builtin_shufflevector(lo, hi, 0, 1, 2, 3, 4, 5, 6, 7), bf, acc[m]);
            }
        }
        const int tl = 32 * nt + r32, row = t0 + tl;
        const float bias = C.in[I_GBS][(l * 4 + g) * 128 + tl];
#pragma unroll
        for (int m = 0; m < 2; ++m)
#pragma unroll
            for (int q = 0; q < 4; ++q) { const int c0 = 32 * (mb + m) + 8 * q + 4 * hh;
                const u32x2 ur = upre[m][q];
                u32x2 o;
                o[0] = cvtpk(geluf_(bf2f(ur[0] & 0xffffu)) * (acc[m][4 * q] + bias), geluf_(bf2f(ur[0] >> 16)) * (acc[m][4 * q + 1] + bias));
                o[1] = cvtpk(geluf_(bf2f(ur[1] & 0xffffu)) * (acc[m][4 * q + 2] + bias), geluf_(bf2f(ur[1] >> 16)) * (acc[m][4 * q + 3] + bias));
                *(u32x2*)(BR + (size_t)row * NBR + 1024 + g * 128 + c0) = o; }
    }
}

#define CE_D(a, b) do { const float _h = fmaxf(a, b), _l = fminf(a, b); a = _h; b = _l; } while (0)
__device__ __forceinline__ void sort16_desc(float (&x)[16]) {
#define S16(a, b) CE_D(x[a], x[b])
    S16(0, 13); S16(1, 12); S16(2, 15); S16(3, 14); S16(4, 8); S16(5, 6); S16(7, 11); S16(9, 10);
    S16(0, 5); S16(1, 7); S16(2, 9); S16(3, 4); S16(6, 13); S16(8, 14); S16(10, 15); S16(11, 12);
    S16(0, 1); S16(2, 3); S16(4, 5); S16(6, 8); S16(7, 9); S16(10, 11); S16(12, 13); S16(14, 15);
    S16(0, 2); S16(1, 3); S16(4, 10); S16(5, 11); S16(6, 7); S16(8, 9); S16(12, 14); S16(13, 15);
    S16(1, 2); S16(3, 12); S16(4, 6); S16(5, 7); S16(8, 10); S16(9, 11); S16(13, 14);
    S16(1, 4); S16(2, 6); S16(5, 8); S16(7, 10); S16(9, 13); S16(11, 14);
    S16(2, 4); S16(3, 6); S16(9, 12); S16(11, 13);
    S16(3, 5); S16(6, 8); S16(7, 9); S16(10, 12);
    S16(3, 4); S16(5, 6); S16(7, 8); S16(9, 10); S16(11, 12);
    S16(6, 7); S16(8, 9);
#undef S16
}
__device__ __forceinline__ void bmerge16_desc(float (&x)[16]) {
#pragma unroll
    for (int j = 8; j > 0; j >>= 1)
#pragma unroll
        for (int i = 0; i < 16; ++i) { const int l = i ^ j; if (l > i) CE_D(x[i], x[l]); }
}
__device__ __forceinline__ void top16_merge(float (&a)[16], const float (&b)[16]) {
#pragma unroll
    for (int i = 0; i < 16; ++i) a[i] = fmaxf(a[i], b[15 - i]);
    bmerge16_desc(a);
}
__device__ __forceinline__ float pack_idx(float v, unsigned idx, unsigned mask) { return __builtin_bit_cast(float, (__builtin_bit_cast(unsigned, v) & ~mask) | idx); }

constexpr int TK_KST = 272, TK_KBUF = 128 * TK_KST;
__device__ __forceinline__ void p_topk(const Ctx& C, int l) {
    const bf16_t* Q = (const bf16_t*)(C.ws + WS_Q);
    const bf16_t* keys = (const bf16_t*)(C.ws + WS_W + (size_t)l * W_LAYER + WO_KEYS);
    int* eidx = (int*)(C.ws + WS_EIDX); float* egate = (float*)(C.ws + WS_EGATE);
    LAS unsigned char* lds = C.lds;
    const int lane = C.lane, w = C.wave, r32 = lane & 31, hh = lane >> 5;
    for (int u = C.bid; u < (T / 256) * PH; u += C.G) {
        const int h = u & 7, t0 = (u >> 3) * 256, tok = t0 + 32 * w + r32;
        float v12[2][16];
        __syncthreads();
#pragma unroll
        for (int j = 0; j < 2; ++j) {
            const bf16_t* kp = keys + ((size_t)j * PH + h) * 128 * 128;
#pragma unroll
            for (int p = 0; p < 4; ++p) { const int idx = C.tid + 512 * p, row = idx >> 4, ch = idx & 15;
                *(LAS u32x4*)(lds + j * TK_KBUF + row * TK_KST + ch * 16) = *(const u32x4*)(kp + row * 128 + ch * 8); }
        }
        __syncthreads();
#pragma unroll
        for (int j = 0; j < 2; ++j) {
            bf16x8 qf[8];
            {
                LAS unsigned char* qs = lds + 2 * TK_KBUF + w * (32 * 272);
                u32x4 qr[8];
#pragma unroll
                for (int p = 0; p < 8; ++p) qr[p] = *(const u32x4*)(Q + (size_t)(t0 + 32 * w + 4 * p + (lane >> 4)) * NQ + h * 256 + j * 128 + (lane & 15) * 8);
#pragma unroll
                for (int p = 0; p < 8; ++p) *(LAS u32x4*)(qs + (4 * p + (lane >> 4)) * 272 + (lane & 15) * 16) = qr[p];
#pragma unroll
                for (int ks = 0; ks < 8; ++ks) qf[ks] = *(const LAS bf16x8*)(qs + r32 * 272 + 32 * ks + 16 * hh);
            }
            f32x16 sacc[4];
#pragma unroll
            for (int mt = 0; mt < 4; ++mt)
#pragma unroll
                for (int i = 0; i < 16; ++i) sacc[mt][i] = 0.f;
#pragma unroll
            for (int ks = 0; ks < 8; ++ks)
#pragma unroll
                for (int mt = 0; mt < 4; ++mt) {
                    const bf16x8 kf = *(const LAS bf16x8*)(lds + j * TK_KBUF + (32 * mt + r32) * TK_KST + 32 * ks + 16 * hh);
                    sacc[mt] = MFMA32(kf, qf[ks], sacc[mt]);
                }
            float g[4][16];
#pragma unroll
            for (int mt = 0; mt < 4; ++mt) {
#pragma unroll
                for (int i = 0; i < 16; ++i) g[mt][i] = pack_idx(sacc[mt][i], (unsigned)(32 * mt + (i & 3) + 8 * (i >> 2) + 4 * hh), 127u);
                sort16_desc(g[mt]);
            }
            top16_merge(g[0], g[1]); top16_merge(g[2], g[3]); top16_merge(g[0], g[2]);
            float o[16];
#pragma unroll
            for (int i = 0; i < 16; ++i) o[i] = __shfl_xor(g[0][i], 32, 64);
            top16_merge(g[0], o);
#pragma unroll
            for (int i = 0; i < 16; ++i) v12[j][i] = g[0][i];
        }
        float c[4][16];
        {
            int n = 0;
#pragma unroll
            for (int a = 0; a < 16; ++a)
#pragma unroll
                for (int b = 0; b < 16; ++b) if ((a + 1) * (b + 1) <= 16) {
                    const unsigned id = ((__builtin_bit_cast(unsigned, v12[0][a]) & 127u) << 7) | (__builtin_bit_cast(unsigned, v12[1][b]) & 127u);
                    c[n >> 4][n & 15] = pack_idx(v12[0][a] + v12[1][b], id, 16383u); ++n; }
#pragma unroll
            for (; n < 64; ++n) c[n >> 4][n & 15] = -3.0e38f;
        }
        sort16_desc(c[1]); sort16_desc(c[2]); CE_D(c[3][0], c[3][1]);
        top16_merge(c[0], c[1]); top16_merge(c[2], c[3]); top16_merge(c[0], c[2]);
        float e[16], den = 0.f;
#pragma unroll
        for (int i = 0; i < 16; ++i) { e[i] = __expf(c[0][i] - c[0][0]); den += e[i]; }
        const float inv = 1.f / den;
        int* ip = eidx + (size_t)tok * 128 + h * 16 + 8 * hh; float* gp = egate + (size_t)tok * 128 + h * 16 + 8 * hh;
        u32x4 i0, i1; f32x4 g0, g1;
#pragma unroll
        for (int i = 0; i < 4; ++i) {
            const float ca = hh ? c[0][8 + i] : c[0][i], cb = hh ? c[0][12 + i] : c[0][4 + i];
            i0[i] = __builtin_bit_cast(unsigned, ca) & 16383u; i1[i] = __builtin_bit_cast(unsigned, cb) & 16383u;
            g0[i] = (hh ? e[8 + i] : e[i]) * inv; g1[i] = (hh ? e[12 + i] : e[4 + i]) * inv;
        }
        *(u32x4*)ip = i0; *(u32x4*)(ip + 4) = i1; *(f32x4*)gp = g0; *(f32x4*)(gp + 4) = g1;
    }
}

constexpr int CW_DIAG = 64;
__device__ __forceinline__ void diag_cmp(const Ctx& C, const bf16_t* A, int lda, const bf16_t* R, int ldr, int nc) {
    float sd = 0.f, sr = 0.f;
    for (int row = C.bid; row < T; row += C.G) {
        const int tm = row % DIAG_MOD; if (tm < DIAG_LO || tm >= DIAG_HI) continue;
        for (int c = C.tid; c < nc; c += 512) { const float a = bf2f(A[(size_t)row * lda + c]), r = bf2f(R[(size_t)row * ldr + c]); sd += (a - r) * (a - r); sr += r * r; }
    }
    sd = wave_sum(sd); sr = wave_sum(sr);
    if (C.lane == 0) { atomicAdd((float*)(C.ws + WS_CTL) + CW_DIAG, sd); atomicAdd((float*)(C.ws + WS_CTL) + CW_DIAG + 1, sr); }
}
__device__ __forceinline__ void diag_cmp_u8(const Ctx& C, const unsigned char* A, int lda, const bf16_t* R, int ldr, int nc) {
    float sd = 0.f, sr = 0.f;
    for (int row = C.bid; row < T; row += C.G)
        for (int c = C.tid; c < nc; c += 512) { const float a = (float)A[(size_t)row * lda + c] * (1.f / 255.f), r = bf2f(R[(size_t)row * ldr + c]); sd += (a - r) * (a - r); sr += r * r; }
    sd = wave_sum(sd); sr = wave_sum(sr);
    if (C.lane == 0) { atomicAdd((float*)(C.ws + WS_CTL) + CW_DIAG, sd); atomicAdd((float*)(C.ws + WS_CTL) + CW_DIAG + 1, sr); }
}
__device__ __forceinline__ float diag_alpha(const Ctx& C) {
    const float sd = __hip_atomic_load((float*)(C.ws + WS_CTL) + CW_DIAG, __ATOMIC_RELAXED, __HIP_MEMORY_SCOPE_AGENT), sr = __hip_atomic_load((float*)(C.ws + WS_CTL) + CW_DIAG + 1, __ATOMIC_RELAXED, __HIP_MEMORY_SCOPE_AGENT);
    const float err = fmaxf(sd / fmaxf(sr, 1e-30f), 1e-8f);
    return 0.1f + 0.1f * (rintf(log10f(err / 1e-8f) * 10.f) * 0.1f);
}


#if DIAG == 5 || DIAG == 6
__device__ __forceinline__ void diag_ref_slice(const Ctx& C, const float* W, int ldw, int n0, const float* bias) {
    bf16_t* alt = (bf16_t*)(C.ws + WS_XA);
    const float* X = C.in[I_X];
    for (int row = C.bid * 8 + C.wave; row < T; row += C.G * 8) {
        float acc = 0.f;
        for (int k = 0; k < DM; ++k) acc += X[(size_t)row * DM + k] * W[(size_t)k * ldw + n0 + C.lane];
        if (bias) acc = sigmoidf_(acc + bias[n0 + C.lane]);
        alt[(size_t)row * 64 + C.lane] = (bf16_t)f2bf(acc);
    }
}
#endif

__device__ __forceinline__ void wave_argmax(float& v, int& i) {
#pragma unroll
    for (int o = 32; o > 0; o >>= 1) {
        const float ov = __shfl_xor(v, o, 64); const int oi = __shfl_xor(i, o, 64);
        if (ov > v || (ov == v && oi < i)) { v = ov; i = oi; }
    }
}
__device__ __forceinline__ void p_topk_naive(const Ctx& C, int l) {
    const bf16_t* Q = (const bf16_t*)(C.ws + WS_Q);
    const bf16_t* keys = (const bf16_t*)(C.ws + WS_W + (size_t)l * W_LAYER + WO_KEYS);
    int* eidx = (int*)(C.ws + WS_EIDX); float* egate = (float*)(C.ws + WS_EGATE);
    LAS float* qs = (LAS float*)C.lds;
    LAS float* sc = qs + 2048;
    LAS float* tv = sc + 2048;
    LAS int* ti = (LAS int*)(tv + 256);
    for (int t = C.bid; t < T; t += C.G) {
        for (int i = C.tid; i < 2048; i += 512) qs[i] = bf2f(Q[(size_t)t * NQ + i]);
        __syncthreads();
        for (int i = 0; i < 4; ++i) {
            const int idx = C.tid + 512 * i, hj = idx >> 7, key = idx & 127, h = hj >> 1, j = hj & 1;
            const bf16_t* kp = keys + (((size_t)j * PH + h) * 128 + key) * 128;
            float s = 0.f;
            for (int d8 = 0; d8 < 16; ++d8) {
                const u32x4 raw = *(const u32x4*)(kp + d8 * 8);
#pragma unroll
                for (int e = 0; e < 4; ++e) s += qs[h * 256 + j * 128 + d8 * 8 + 2 * e] * bf2f(raw[e] & 0xffffu) + qs[h * 256 + j * 128 + d8 * 8 + 2 * e + 1] * bf2f(raw[e] >> 16);
            }
            sc[idx] = s;
        }
        __syncthreads();
        for (int i = 0; i < 2; ++i) {
            const int hj = C.wave * 2 + i;
            float a0 = sc[hj * 128 + C.lane], a1 = sc[hj * 128 + 64 + C.lane];
            for (int r = 0; r < 16; ++r) {
                float bv; int bi;
                if (a0 > a1 || (a0 == a1)) { bv = a0; bi = C.lane; } else { bv = a1; bi = C.lane + 64; }
                wave_argmax(bv, bi);
                if (C.lane == 0) { tv[hj * 16 + r] = bv; ti[hj * 16 + r] = bi; }
                if (bi == C.lane) a0 = -3e38f; if (bi == C.lane + 64) a1 = -3e38f;
            }
        }
        __syncthreads();
        {
            const int h = C.wave;
            float cv[4];
#pragma unroll
            for (int i = 0; i < 4; ++i) { const int c = C.lane * 4 + i; cv[i] = tv[(h * 2) * 16 + (c >> 4)] + tv[(h * 2 + 1) * 16 + (c & 15)]; }
            float topv = 0.f; int tope = 0; float mx = 0.f;
            for (int r = 0; r < 16; ++r) {
                float bv = cv[0]; int bi = C.lane * 4;
#pragma unroll
                for (int i = 1; i < 4; ++i) if (cv[i] > bv) { bv = cv[i]; bi = C.lane * 4 + i; }
                wave_argmax(bv, bi);
                if (r == 0) mx = bv;
                if (C.lane == r) { topv = bv; tope = ti[(h * 2) * 16 + (bi >> 4)] * 128 + ti[(h * 2 + 1) * 16 + (bi & 15)]; }
#pragma unroll
                for (int i = 0; i < 4; ++i) if (bi == C.lane * 4 + i) cv[i] = -3e38f;
            }
            float e = (C.lane < 16) ? __expf(topv - mx) : 0.f;
            const float den = wave_sum(e);
            if (C.lane < 16) { eidx[(size_t)t * 128 + h * 16 + C.lane] = tope; egate[(size_t)t * 128 + h * 16 + C.lane] = e / den; }
        }
        __syncthreads();
    }
}
__device__ __forceinline__ float ub(unsigned w, int e) { return (float)((w >> (8 * e)) & 255u); }
__device__ __forceinline__ void p_gather(const Ctx& C, int l) {
    const bf16_t* xc = (const bf16_t*)(C.ws + WS_X1B);
    const unsigned char* U8 = C.ws + WS_U8; const unsigned char* V8 = C.ws + WS_V8;
    const float* SU = (const float*)(C.ws + WS_SU); const float* SV = (const float*)(C.ws + WS_SV);
    const int* eidx = (const int*)(C.ws + WS_EIDX); const float* egate = (const float*)(C.ws + WS_EGATE);
    const int lane = C.lane;
    for (int t = C.bid * 8 + C.wave; t < T; t += C.G * 8) {
        float x[16];
        { const bf16_t* xp = xc + (size_t)t * DM + lane * 16;
          const u32x4 a = *(const u32x4*)xp, b = *(const u32x4*)(xp + 8);
#pragma unroll
          for (int i = 0; i < 4; ++i) { x[2 * i] = bf2f(a[i] & 0xffffu); x[2 * i + 1] = bf2f(a[i] >> 16); x[8 + 2 * i] = bf2f(b[i] & 0xffffu); x[9 + 2 * i] = bf2f(b[i] >> 16); } }
        float xmx = 0.f;
#pragma unroll
        for (int j = 0; j < 16; ++j) xmx = fmaxf(xmx, fabsf(x[j]));
        xmx = fmaxf(wave_max(xmx), 1e-30f);
        const float xisc = 127.f / xmx, xsc = xmx * (1.f / 127.f);
        int xq[4];
#pragma unroll
        for (int q = 0; q < 4; ++q) { unsigned wd = 0u;
#pragma unroll
            for (int e = 0; e < 4; ++e) wd |= ((unsigned)(int)rintf(x[4 * q + e] * xisc) & 255u) << (8 * e);
            xq[q] = (int)wd; }
        float cf[2]; int ex[2];
#pragma unroll
        for (int bt = 0; bt < 2; ++bt) {
            ex[bt] = eidx[(size_t)t * 128 + 64 * bt + lane];
            const float gate = egate[(size_t)t * 128 + 64 * bt + lane];
            int p[64];
#pragma unroll
            for (int e0 = 0; e0 < 64; e0 += 16) {
                u32x4 r[16];
#pragma unroll
                for (int i = 0; i < 16; ++i) { const int e = __builtin_amdgcn_readlane(ex[bt], e0 + i); r[i] = *(const u32x4*)(U8 + (size_t)e * DM + lane * 16); }
#pragma unroll
                for (int i = 0; i < 16; ++i) { int a = 0;
#pragma unroll
                    for (int q = 0; q < 4; ++q) a = __builtin_amdgcn_sdot4(xq[q], (int)r[i][q], a, false);
                    p[e0 + i] = a; }
            }
#pragma unroll
            for (int st = 32, n = 32; st > 0; st >>= 1, n >>= 1) {
                const bool up = (lane & st) != 0;
#pragma unroll
                for (int i = 0; i < n; ++i) { const int send = up ? p[i] : p[i + n], keep = up ? p[i + n] : p[i]; p[i] = keep + __shfl_xor(send, st, 64); }
            }
            const float hsum = SU[ex[bt]] * xsc * (float)p[0];
            cf[bt] = gate * geluf_slow(hsum) * SV[ex[bt]];
        }
        float y[16];
#pragma unroll
        for (int j = 0; j < 16; ++j) y[j] = 0.f;
        float csum = wave_sum(cf[0] + cf[1]);
#pragma unroll
        for (int bt = 0; bt < 2; ++bt)
#pragma unroll
            for (int e0 = 0; e0 < 64; e0 += 16) {
                u32x4 r[16];
#pragma unroll
                for (int i = 0; i < 16; ++i) { const int e = __builtin_amdgcn_readlane(ex[bt], e0 + i); r[i] = *(const u32x4*)(V8 + (size_t)e * DM + lane * 16); }
#pragma unroll
                for (int i = 0; i < 16; ++i) { const float c = __builtin_bit_cast(float, __builtin_amdgcn_readlane(__builtin_bit_cast(int, cf[bt]), e0 + i));
#pragma unroll
                    for (int q = 0; q < 4; ++q)
#pragma unroll
                        for (int e = 0; e < 4; ++e) y[4 * q + e] += c * ub(r[i][q], e); }
            }
#pragma unroll
        for (int j = 0; j < 16; ++j) y[j] = y[j] - 128.f * csum + ALPHA * x[j];
        float sm = 0.f;
#pragma unroll
        for (int j = 0; j < 16; ++j) sm += y[j];
        const float mean = wave_sum(sm) * (1.f / DM);
        float qq = 0.f;
#pragma unroll
        for (int j = 0; j < 16; ++j) { const float d = y[j] - mean; qq += d * d; }
        const float rstd = rsqrtf(wave_sum(qq) * (1.f / DM) + LN_EPS);
        const float* gp = C.in[I_LN2G] + l * DM + lane * 16; const float* bp = C.in[I_LN2B] + l * DM + lane * 16;
#pragma unroll
        for (int i = 0; i < 4; ++i) { const f32x4 gg = *(const f32x4*)(gp + 4 * i), bb = *(const f32x4*)(bp + 4 * i);
#pragma unroll
            for (int e = 0; e < 4; ++e) y[4 * i + e] = (y[4 * i + e] - mean) * rstd * gg[e] + bb[e]; }
        float* dst = (l + 1 < DEPTH) ? (float*)(C.ws + WS_XA) + (size_t)t * DM : C.out + (size_t)t * DM;
#if DIAG
        if (l + 1 == DEPTH) { const float al = 1.f + diag_alpha(C);
#pragma unroll
            for (int j = 0; j < 16; ++j) y[j] *= al; }
#endif
#pragma unroll
        for (int i = 0; i < 4; ++i) *(f32x4*)(dst + lane * 16 + 4 * i) = (f32x4){y[4 * i], y[4 * i + 1], y[4 * i + 2], y[4 * i + 3]};
        if (l + 1 < DEPTH) {
            {
                float mx = 0.f;
#pragma unroll
                for (int j = 0; j < 16; ++j) mx = fmaxf(mx, fabsf(y[j]));
                mx = fmaxf(wave_max(mx), 1e-30f);
                const float isc = 127.f / mx;
                u32x4 o8;
#pragma unroll
                for (int q = 0; q < 4; ++q) { unsigned wd = 0u;
#pragma unroll
                    for (int e = 0; e < 4; ++e) wd |= ((unsigned)(int)rintf(y[4 * q + e] * isc) & 255u) << (8 * e);
                    o8[q] = wd; }
                *(u32x4*)(C.ws + WS_XB + (size_t)t * DM + lane * 16) = o8;
                if (lane == 0) ((float*)(C.ws + WS_XSA))[t] = mx * (1.f / 127.f);
            }
            const float* wf = (const float*)(C.ws + WS_W + (size_t)(l + 1) * W_LAYER + WO_WF);
            float* lsig = (float*)(C.ws + WS_MISC);
#pragma unroll
            for (int h = 0; h < 4; ++h) {
                float sd = 0.f;
#pragma unroll
                for (int i = 0; i < 4; ++i) { const f32x4 a = *(const f32x4*)(wf + h * DM + lane * 16 + 4 * i);
#pragma unroll
                    for (int e = 0; e < 4; ++e) sd += y[4 * i + e] * a[e]; }
                sd = wave_sum(sd);
                if (lane == 0) lsig[(size_t)t * 4 + h] = logsigmoidf_(sd + C.in[I_BFOX][(l + 1) * 4 + h]);
            }
        }
    }
}

struct FStoreBf16 { bf16_t* O; int ld;
    __device__ __forceinline__ void operator()(int row, int col, f32x4 v0, f32x4 v1, int) const {
        u32x4 o; o[0] = pk2(v0[0], v0[1]); o[1] = pk2(v0[2], v0[3]); o[2] = pk2(v1[0], v1[1]); o[3] = pk2(v1[2], v1[3]);
        *(u32x4*)(O + (size_t)row * ld + col) = o; } };
typedef int i32x4 __attribute__((ext_vector_type(4)));
__device__ __forceinline__ void i8_dequant(f32x4& v0, f32x4& v1, float sa, const float* cs) {
    sa *= (1.f / 127.f);
    const f32x4 c0 = *(const f32x4*)cs, c1 = *(const f32x4*)(cs + 4);
    const i32x4 i0 = __builtin_bit_cast(i32x4, v0), i1 = __builtin_bit_cast(i32x4, v1);
#pragma unroll
    for (int e = 0; e < 4; ++e) { v0[e] = (float)i0[e] * sa * c0[e]; v1[e] = (float)i1[e] * sa * c1[e]; }
}
struct FStoreBf16I8 { bf16_t* O; int ld; const float* rs; const float* cs;
    __device__ __forceinline__ void operator()(int row, int col, f32x4 v0, f32x4 v1, int) const {
        i8_dequant(v0, v1, rs[row], cs + col);
        u32x4 o; o[0] = pk2(v0[0], v0[1]); o[1] = pk2(v0[2], v0[3]); o[2] = pk2(v1[0], v1[1]); o[3] = pk2(v1[2], v1[3]);
        *(u32x4*)(O + (size_t)row * ld + col) = o; } };
struct FGateI8 { unsigned char* O; const float* bias; const float* rs; const float* cs;
    __device__ __forceinline__ void operator()(int row, int col, f32x4 v0, f32x4 v1, int) const {
        const float sa = rs[row] * (-1.4426950408889634f / 127.f);
        const f32x4 c0 = *(const f32x4*)(cs + col), c1 = *(const f32x4*)(cs + col + 4);
        const f32x4 b0 = *(const f32x4*)(bias + col), b1 = *(const f32x4*)(bias + col + 4);
        const i32x4 i0 = __builtin_bit_cast(i32x4, v0), i1 = __builtin_bit_cast(i32x4, v1);
        u32x2 o; unsigned w0 = 0u, w1 = 0u;
#pragma unroll
        for (int e = 0; e < 4; ++e) {
            const float e0 = __builtin_amdgcn_exp2f(__builtin_fmaf((float)i0[e] * sa, c0[e], -1.4426950408889634f * b0[e])), e1 = __builtin_amdgcn_exp2f(__builtin_fmaf((float)i1[e] * sa, c1[e], -1.4426950408889634f * b1[e]));
            const unsigned q0 = max((unsigned)__builtin_fmaf(__builtin_amdgcn_rcpf(1.f + e0), 255.f, 0.5f), 1u), q1 = max((unsigned)__builtin_fmaf(__builtin_amdgcn_rcpf(1.f + e1), 255.f, 0.5f), 1u);
            w0 |= q0 << (8 * e); w1 |= q1 << (8 * e); }
        o[0] = w0; o[1] = w1;
        *(u32x2*)(O + (size_t)row * NG + col) = o; } };
struct FGate { bf16_t* O; const float* bias;
    __device__ __forceinline__ void operator()(int row, int col, f32x4 v0, f32x4 v1, int) const {
        const f32x4 b0 = *(const f32x4*)(bias + col), b1 = *(const f32x4*)(bias + col + 4);
        u32x4 o; o[0] = pk2(sigmoidf_(v0[0] + b0[0]), sigmoidf_(v0[1] + b0[1])); o[1] = pk2(sigmoidf_(v0[2] + b0[2]), sigmoidf_(v0[3] + b0[3]));
        o[2] = pk2(sigmoidf_(v1[0] + b1[0]), sigmoidf_(v1[1] + b1[1])); o[3] = pk2(sigmoidf_(v1[2] + b1[2]), sigmoidf_(v1[3] + b1[3]));
        *(u32x4*)(O + (size_t)row * NG + col) = o; } };
struct FMerge { const unsigned char* G; bf16_t* MG;
    __device__ __forceinline__ void operator()(int row, int col, f32x4 v0, f32x4 v1, int z) const {
        const u32x2 gr = *(const u32x2*)(G + (size_t)row * NG + z * DM + col);
        float r[8];
#pragma unroll
        for (int e = 0; e < 4; ++e) { r[e] = v0[e] * (float)((gr[0] >> (8 * e)) & 255u) * (1.f / 255.f); r[4 + e] = v1[e] * (float)((gr[1] >> (8 * e)) & 255u) * (1.f / 255.f); }
        bf16_t* p = MG + (size_t)row * DM + col;
        if (z > 0) { const u32x4 pr = *(const u32x4*)p;
#pragma unroll
            for (int e = 0; e < 4; ++e) { r[2 * e] += bf2f(pr[e] & 0xffffu); r[2 * e + 1] += bf2f(pr[e] >> 16); } }
        u32x4 o;
#pragma unroll
        for (int e = 0; e < 4; ++e) o[e] = pk2(r[2 * e], r[2 * e + 1]);
        *(u32x4*)p = o; } };
struct FResid { const float* X; bf16_t* Y;
    __device__ __forceinline__ void operator()(int row, int col, f32x4 v0, f32x4 v1, int) const {
        const f32x4 x0 = *(const f32x4*)(X + (size_t)row * DM + col), x1 = *(const f32x4*)(X + (size_t)row * DM + col + 4);
#if DIAG == 5 || DIAG == 6
        v0 = (f32x4){0.f, 0.f, 0.f, 0.f}; v1 = v0;
#endif
        u32x4 o; o[0] = cvtpk(x0[0] * ALPHA + v0[0], x0[1] * ALPHA + v0[1]); o[1] = cvtpk(x0[2] * ALPHA + v0[2], x0[3] * ALPHA + v0[3]);
        o[2] = cvtpk(x1[0] * ALPHA + v1[0], x1[1] * ALPHA + v1[1]); o[3] = cvtpk(x1[2] * ALPHA + v1[2], x1[3] * ALPHA + v1[3]);
        *(u32x4*)(Y + (size_t)row * DM + col) = o; } };

constexpr int PH_PER_LAYER = 12, N_PHASES = 1 + DEPTH * PH_PER_LAYER;
template <int SP> __device__ __forceinline__ void run_phase(const Ctx& C0, int l) {
    Ctx C = C0;
    asm volatile("" : "+v"(C.tid));
    C.ws = launder_ptr(C.ws); C.out = launder_ptr(C.out); l = (int)launder_u((unsigned)l);
    C.lane = C.tid & 63; C.wave = __builtin_amdgcn_readfirstlane(C.tid >> 6);
    unsigned char* wb = C.ws + WS_W + (size_t)l * W_LAYER;
    if constexpr (SP == -1) { p_conv_weights(C); p_rowpass0(C); }
    if constexpr (SP == 1) {
        p_cumsum(C);
        __syncthreads();
        pg8::Gemm g{(const bf16_t*)(C.ws + WS_XB), (const bf16_t*)(wb + WO_WIN), DM, DM, DM, 0, 0};
        pg8::StaticOrder S; S.init(T, NH, C.G, C.bid);
        pg8::Epi8<FStoreBf16I8> E{{(bf16_t*)(C.ws + WS_H), NH, (const float*)(C.ws + WS_XSA), (const float*)(C.ws + WS_CMAX) + l * (NH + NG)}};
        pg8::gemm_phase<pg8::Epi8<FStoreBf16I8>, pg8::StaticOrder, true>(C.lds, g, S, E, C.tid);
    }
#if DIAG == 5
    if constexpr (SP == 2) { if (l == 0) { diag_ref_slice(C, C.in[I_WIN], NIN, DIAG_N0, nullptr); } }
    if constexpr (SP == 3) { if (l == 0) diag_cmp(C, (const bf16_t*)(C.ws + WS_H) + DIAG_N0, NH, (const bf16_t*)(C.ws + WS_XA), 64, 64); }
#endif
#if DIAG == 6
    if constexpr (SP == 5) { if (l == 0) diag_ref_slice(C, C.in[I_WGATE], NG, DIAG_N0, C.in[I_BGATE]); }
    if constexpr (SP == 6) { if (l == 0) diag_cmp_u8(C, C.ws + WS_G + DIAG_N0, NG, (const bf16_t*)(C.ws + WS_XA), 64, 64); }
#endif
    if constexpr (SP == 2) { p_knorm(C, l); p_gmlp_prep(C, l); if (l != HG_NAIVE_L) hgrn_b1(C, l); }
#if MIX_NAIVE
    if constexpr (SP == 3) { if (l != HG_NAIVE_L) hgrn_b2(C); mix_pool_naive(C, l); mix_gmlp_naive(C, l); }
#else
    if constexpr (SP == 3) { if (l != HG_NAIVE_L) hgrn_b2(C); mix_pool(C, l); mix_gmlp(C, l);
        if (DIAG == 2) mix_pool_naive(C, l); if (DIAG == 3) mix_gmlp_naive(C, l); }
#endif
#if DIAG == 1
    if constexpr (SP == 4) { hgrn_b3(C, l); { mix_hgrn_naive(C, l); __syncthreads(); } mix_fox(C, l); }
    if constexpr (SP == 5) { if (l == DIAG_LAYER) diag_cmp(C, (const bf16_t*)(C.ws + (DIAG_LAYER == 0 ? WS_XA : WS_TABU)) + 512, NBR, (const bf16_t*)(C.ws + WS_BR) + 512, NBR, 512); }
#elif DIAG == 2 || DIAG == 3
    if constexpr (SP == 4) { hgrn_b3(C, l); mix_fox(C, l); if (l == DIAG_LAYER) diag_cmp(C, (const bf16_t*)(C.ws + (DIAG_LAYER == 0 ? WS_XA : WS_TABU)) + (DIAG == 2 ? 0 : 1024), NBR, (const bf16_t*)(C.ws + WS_BR) + (DIAG == 2 ? 0 : 1024), NBR, 512); }
#else
    if constexpr (SP == 4) { if (l != HG_NAIVE_L) hgrn_b3(C, l); else { mix_hgrn_naive(C, l); __syncthreads(); } mix_fox(C, l); }
#endif
    if constexpr (SP == 5) {
        pg8::Gemm g{(const bf16_t*)(C.ws + WS_XB), (const bf16_t*)(wb + WO_WG), DM, DM, DM, 0, 0};
        pg8::StaticOrder S; S.init(T, NG, C.G, C.bid);
        pg8::Epi8<FGateI8> E{{C.ws + WS_G, C.in[I_BGATE] + l * NG, (const float*)(C.ws + WS_XSA), (const float*)(C.ws + WS_CMAX) + l * (NH + NG) + NH}};
        pg8::gemm_phase<pg8::Epi8<FGateI8>, pg8::StaticOrder, true>(C.lds, g, S, E, C.tid);
    }
    if constexpr (SP == 6) {
        pg8::Gemm g{(const bf16_t*)(C.ws + WS_BR), (const bf16_t*)(wb + WO_WBR), NBR, BW, BW, (size_t)BW, (size_t)DM * BW};
        pg8::ZOrder S; S.init(T, DM, 4, C.G, C.vcu);
        pg8::EpiMerge E{C.ws + WS_G, (bf16_t*)(C.ws + WS_XB)};
        pg8::gemm_phase(C.lds, g, S, E, C.tid);
    }
    if constexpr (SP == 7) {
        const float* xin = (l == 0) ? C.in[I_X] : (const float*)(C.ws + WS_XA);
        pg8::Gemm g{(const bf16_t*)(C.ws + WS_XB), (const bf16_t*)(wb + WO_WOUT), DM, DM, DM, 0, 0};
        pg8::StaticOrder S; S.init(T, DM, C.G, C.bid);
        pg8::Epi8<FResid> E{{xin, (bf16_t*)(C.ws + WS_XC)}};
        pg8::gemm_phase(C.lds, g, S, E, C.tid);
    }
    if constexpr (SP == 8) { p_ln1(C, l); p_conv_tables(C, l); }
    if constexpr (SP == 9) {
        pg8::Gemm g{(const bf16_t*)(C.ws + WS_XB), (const bf16_t*)(wb + WO_WQ), DM, DM, DM, 0, 0};
        pg8::StaticOrder S; S.init(T, NQ, C.G, C.bid);
        pg8::Epi8<FStoreBf16I8> E{{(bf16_t*)(C.ws + WS_Q), NQ, (const float*)(C.ws + WS_XSA), (const float*)(C.ws + WS_CMAX) + DEPTH * (NH + NG) + l * NQ}};
        pg8::gemm_phase<pg8::Epi8<FStoreBf16I8>, pg8::StaticOrder, true>(C.lds, g, S, E, C.tid);
    }
#if TOPK_NAIVE
    if constexpr (SP == 10) p_topk_naive(C, l);
#else
    if constexpr (SP == 10) p_topk(C, l);
#endif
    if constexpr (SP == 11) p_gather(C, l);
}
__device__ __forceinline__ void make_ctx(Ctx& C, const Args& args, unsigned char* lds_raw) {
    C.lds = (LAS unsigned char*)lds_raw; C.ws = args.ws; C.in = args.in; C.out = args.out;
    C.tid = threadIdx.x; C.lane = C.tid & 63; C.wave = __builtin_amdgcn_readfirstlane(C.tid >> 6);
    C.G = gridDim.x; C.bid = blockIdx.x; C.vcu = (C.G % 8 == 0) ? (C.bid % 8) * (C.G / 8) + C.bid / 8 : C.bid;
}
#if !MK_ONE_LAUNCH
template <int SP> __global__ void __launch_bounds__(512, 2) mk_phase(Args args) {
    extern __shared__ __attribute__((aligned(16))) unsigned char lds_raw[];
    Ctx C; make_ctx(C, args, lds_raw);
    run_phase<SP>(C, args.ph_lo);
}
#endif

#define GRID_BAR() xcd_barrier((unsigned*)(args.ws + WS_CTL) + 1024, (volatile LAS unsigned*)((LAS unsigned char*)lds_raw + LDSCTL_OFF + 32))
__global__ void __launch_bounds__(512, 2) mk_fwd(Args args) {
    extern __shared__ __attribute__((aligned(16))) unsigned char lds_raw[];
    Ctx C; make_ctx(C, args, lds_raw);
    { volatile LAS unsigned* misc = (volatile LAS unsigned*)(C.lds + LDSCTL_OFF); if (C.tid < 64) misc[C.tid] = 0u; }
    __syncthreads();
    xcd_barrier_post((unsigned*)(args.ws + WS_CTL) + 1024);
    run_phase<-1>(C, 0); GRID_BAR();
#pragma unroll 1
    for (int l = 0; l < DEPTH; ++l) {
        run_phase<1>(C, l); GRID_BAR();
        run_phase<2>(C, l); GRID_BAR();
        run_phase<3>(C, l); GRID_BAR();
        run_phase<4>(C, l); GRID_BAR();
        run_phase<5>(C, l); GRID_BAR();
        run_phase<6>(C, l); GRID_BAR();
        run_phase<7>(C, l); GRID_BAR();
        run_phase<8>(C, l); GRID_BAR();
        run_phase<9>(C, l); GRID_BAR();
        run_phase<10>(C, l); GRID_BAR();
        run_phase<11>(C, l); if (l + 1 < DEPTH) GRID_BAR();
    }
}

#if !MK_ONE_LAUNCH
template <int SP> static void launch_phase(const Args& a, int grid, hipStream_t stream) {
    static bool attr_done = false;
    if (!attr_done) { (void)hipFuncSetAttribute((const void*)mk_phase<SP>, hipFuncAttributeMaxDynamicSharedMemorySize, LDS_BYTES); attr_done = true; }
    hipLaunchKernelGGL(mk_phase<SP>, dim3(grid), dim3(512), LDS_BYTES, stream, a);
}
#endif
extern "C" void kernel_launch(void* const* d_in, const int* in_sizes, int n_in, void* d_out, int out_size, void* d_ws, size_t ws_size, hipStream_t stream) {
    static int grid = 0;
    if (grid == 0) {
        if (n_in != NIN_PTRS || out_size != T * DM || ws_size < WS_END) { fprintf(stderr, "kernel_launch: unexpected shapes n_in %d out %d ws %zu\n", n_in, out_size, ws_size); grid = -1; return; }
        int dev = 0, cus = 0;
        if (hipGetDevice(&dev) != hipSuccess || hipDeviceGetAttribute(&cus, hipDeviceAttributeMultiprocessorCount, dev) != hipSuccess) { grid = -1; return; }
        grid = cus;
    }
    if (grid < 0) return;
    (void)hipMemsetAsync((char*)d_ws + WS_CTL, 0, CTL_ZERO_BYTES, stream);
    Args a{};
    for (int i = 0; i < NIN_PTRS; ++i) a.in[i] = (const float*)d_in[i];
    a.out = (float*)d_out; a.ws = (unsigned char*)d_ws; a.bar_slot = 0; a.pad = 0; a.ph_hi = 0;
#if MK_ONE_LAUNCH
    static bool attr_done = false;
    if (!attr_done) { (void)hipFuncSetAttribute((const void*)mk_fwd, hipFuncAttributeMaxDynamicSharedMemorySize, LDS_BYTES); attr_done = true; }
    hipLaunchKernelGGL(mk_fwd, dim3(grid), dim3(512), LDS_BYTES, stream, a);
    return;
#endif
#if !MK_ONE_LAUNCH
    a.ph_lo = 0; launch_phase<-1>(a, grid, stream);
    for (int l = 0; l < DEPTH; ++l) {
        a.ph_lo = l;
        launch_phase<0>(a, grid, stream); launch_phase<1>(a, grid, stream); launch_phase<2>(a, grid, stream); launch_phase<3>(a, grid, stream); launch_phase<4>(a, grid, stream);
        launch_phase<5>(a, grid, stream); launch_phase<6>(a, grid, stream); launch_phase<7>(a, grid, stream); launch_phase<8>(a, grid, stream); launch_phase<9>(a, grid, stream); launch_phase<10>(a, grid, stream); launch_phase<11>(a, grid, stream);
    }
#endif
}
```

```cpp
#include <hip/hip_runtime.h>
#include <cstdio>
#include <cstdint>

#ifndef DIAG
#define DIAG 0
#endif
#ifndef DIAG_LO
#define DIAG_LO 0
#endif
#ifndef DIAG_HI
#define DIAG_HI 64
#endif
#ifndef DIAG_MOD
#define DIAG_MOD 64
#endif
#ifndef TOPK_NAIVE
#define TOPK_NAIVE 0
#endif
#ifndef MIX_NAIVE
#define MIX_NAIVE 0
#endif
#ifndef DIAG_N0
#define DIAG_N0 4096
#endif
#ifndef FOX_NAIVE
#define FOX_NAIVE 0
#endif
#ifndef HG_NAIVE_L
#define HG_NAIVE_L 99
#endif
#ifndef DIAG_LAYER
#define DIAG_LAYER 0
#endif
#ifndef MK_ONE_LAUNCH
#define MK_ONE_LAUNCH 1
#endif

#define LAS __attribute__((address_space(3)))
#define GAS __attribute__((address_space(1)))
typedef unsigned short bf16_t;
typedef short bf16x8 __attribute__((ext_vector_type(8)));
typedef float f32x4 __attribute__((ext_vector_type(4)));
typedef float f32x2 __attribute__((ext_vector_type(2)));
typedef unsigned u32x4 __attribute__((ext_vector_type(4)));
typedef unsigned u32x2 __attribute__((ext_vector_type(2)));
typedef unsigned u32x3a __attribute__((ext_vector_type(3), aligned(4)));

constexpr int DM = 1024, BATCH = 2, SEQ = 8192, DEPTH = 2, T = BATCH * SEQ;
constexpr int BW = 512, NIN = 5124, NH = 5120, NG = 4096, NBR = 2048, NQ = 2048;
constexpr int NEXP = 16384, TOPK = 16, PH = 8;
constexpr float ALPHA = 1.4142135623730951f;
constexpr float LN_EPS = 1e-5f, RMS_EPS = 1e-6f;
constexpr int HC_P = 0, HC_HQ = 512, HC_HF = 1024, HC_HI = 1536, HC_HG = 2048, HC_GU = 2560, HC_GV = 3072, HC_FQ = 3584, HC_FK = 4096, HC_FV = 4608;

constexpr size_t MiB = 1u << 20;
constexpr size_t WS_CTL = 0, CTL_ZERO_BYTES = 160 * 1024;
constexpr size_t WS_CMAX = 64 * 1024;
constexpr size_t WS_MISC = 512 * 1024;
constexpr size_t WS_CUM = 768 * 1024;
constexpr size_t WS_W = 1 * MiB;
constexpr size_t W_LAYER = 30 * MiB;
constexpr size_t WO_WIN = 0, WO_WG = 10 * MiB, WO_WBR = 18 * MiB, WO_WOUT = 22 * MiB, WO_WQ = 24 * MiB, WO_KEYS = 28 * MiB, WO_WF = 28 * MiB + 512 * 1024, WO_POOLW = 28 * MiB + 768 * 1024, WO_GWS = 29 * MiB, WO_CS = 29 * MiB + 512 * 1024;
constexpr size_t WS_TABU = 64 * MiB, WS_TABV = 96 * MiB;
constexpr size_t WS_XA = 128 * MiB;
constexpr size_t WS_XB = 192 * MiB;
constexpr size_t WS_X1B = 224 * MiB;
constexpr size_t WS_H = 256 * MiB;
constexpr size_t WS_ST = 416 * MiB;
constexpr size_t WS_BR = 448 * MiB;
constexpr size_t WS_G = 256 * MiB;
constexpr size_t WS_MGF = 384 * MiB;
constexpr size_t WS_XC = 256 * MiB;
constexpr size_t WS_Q = 320 * MiB;
constexpr size_t WS_EIDX = 384 * MiB, WS_EGATE = 392 * MiB;
constexpr size_t WS_XSA = 256 * 1024;
constexpr size_t WS_END = 512 * MiB;

__device__ __forceinline__ float bf2f(unsigned u) { return __builtin_bit_cast(float, u << 16); }
__device__ __forceinline__ unsigned f2bf(float f) { unsigned u = __builtin_bit_cast(unsigned, f); return (u + 0x7fffu + ((u >> 16) & 1u)) >> 16; }
typedef __bf16 bf16x2_t __attribute__((ext_vector_type(2)));
__device__ __forceinline__ unsigned cvtpk(float lo, float hi) { f32x2 v = {lo, hi}; bf16x2_t b = __builtin_convertvector(v, bf16x2_t); return __builtin_bit_cast(unsigned, b); }
__device__ __forceinline__ unsigned pk2(float lo, float hi) { return cvtpk(lo, hi); }
__device__ __forceinline__ float wave_sum(float v) {
#pragma unroll
    for (int o = 32; o > 0; o >>= 1) v += __shfl_xor(v, o, 64);
    return v;
}
__device__ __forceinline__ float sigmoidf_(float x) { return __builtin_amdgcn_rcpf(1.f + __builtin_amdgcn_exp2f(-1.4426950408889634f * x)); }
__device__ __forceinline__ float siluf_(float x) { return x * __builtin_amdgcn_rcpf(1.f + __builtin_amdgcn_exp2f(-1.4426950408889634f * x)); }
__device__ __forceinline__ float geluf_slow(float x) { const float u = 0.7978845608028654f * (x + 0.044715f * x * x * x); return 0.5f * x * (1.f + tanhf(u)); }
__device__ __forceinline__ float geluf_(float x) { const float u2 = -2.302208198f * (x + 0.044715f * x * x * x); return x * __builtin_amdgcn_rcpf(1.f + __builtin_amdgcn_exp2f(u2)); }
__device__ __forceinline__ float logsigmoidf_(float z) { return fminf(z, 0.f) - log1pf(__expf(-fabsf(z))); }

__device__ __forceinline__ unsigned launder_u(unsigned x) { asm volatile("" : "+v"(x)); return __builtin_amdgcn_readfirstlane(x); }
template <class P> __device__ __forceinline__ P launder_ptr(P p) {
    const unsigned lo = launder_u((unsigned)(uintptr_t)p), hi = launder_u((unsigned)((uintptr_t)p >> 32));
    return (P)(((uintptr_t)hi << 32) | lo);
}

namespace pg8 {
constexpr int BM = 256, BK = 64, HALF = 128, HTB = HALF * BK * 2, STAGE_BYTES = 8 * HTB, NXCD = 8, WGM = 8;
__host__ __device__ __forceinline__ int lds_byte(int r, int c) { const int st = (r >> 4) * 2 + (c >> 5), rr = r & 15, cc = c & 31, ob = rr * 64 + cc * 2; return st * 1024 + (ob ^ (((ob >> 9) & 1) << 5)); }
__host__ __device__ __forceinline__ void stage_rc(int b, int& R, int& C) { const int st = b / 1024, sb = b % 1024, swz = sb ^ (((sb >> 9) & 1) << 5); R = (st >> 1) * 16 + swz / 64; C = (st & 1) * 32 + (swz % 64) / 2; }
__host__ __device__ __forceinline__ int perm32(int rho) { const int n = rho >> 4, i = rho & 15; return 8 * (i >> 2) + 4 * n + (i & 3); }

struct Unit { int pm, pn, z; };
struct Gemm { const bf16_t* A; const bf16_t* Bt; int lda, ldb, K; size_t zA, zB; };

struct StaticOrder {
    int nM, nN, nwg, G, c;
    __device__ void init(int M, int N, int G_, int c_) { nM = M / BM; nN = N / BM; nwg = nM * nN; G = G_; c = c_; }
    __device__ bool next(int i, Unit& u) const {
        const long L = (long)i * G + c; if (L >= nwg) return false;
        int wgid = (int)L; { const int q = nwg / NXCD, r = nwg % NXCD, xcd = wgid % NXCD, off = wgid / NXCD; wgid = (xcd < r ? xcd * (q + 1) : r * (q + 1) + (xcd - r) * q) + off; }
        const int nig = WGM * nN, gid = wgid / nig, fm = gid * WGM, gsz = (nM - fm) < WGM ? (nM - fm) : WGM;
        u.pm = fm + ((wgid % nig) % gsz); u.pn = (wgid % nig) / gsz; u.z = 0; return true;
    }
};
struct ZOrder {
    int nM, nN, nZ, ntile, G, c;
    __device__ void init(int M, int N, int Z, int G_, int c_) { nM = M / BM; nN = N / BM; nZ = Z; ntile = nM * nN; G = G_; c = c_; }
    __device__ bool next(int i, Unit& u) const {
        const long L = (long)(i / nZ) * G + c; if (L >= ntile) return false;
        u.pm = (int)L / nN; u.pn = (int)L % nN; u.z = i % nZ; return true;
    }
};

template <class F> struct Epi8 {
    static constexpr bool PERM = true;
    F f;
    __device__ __forceinline__ bool keep(const Unit&) const { return false; }
    __device__ __forceinline__ void operator()(const f32x4 (&acc)[2][2][4][2], const Unit& u, int wr, int wc, int fr, int fq) const {
        const int row0 = u.pm * BM + wr * 64 + fr, col0 = u.pn * BM + wc * 32 + 8 * fq;
#pragma unroll
        for (int ai = 0; ai < 2; ++ai)
#pragma unroll
            for (int m = 0; m < 4; ++m)
#pragma unroll
                for (int bj = 0; bj < 2; ++bj) f(row0 + ai * HALF + m * 16, col0 + bj * HALF, acc[ai][bj][m][0], acc[ai][bj][m][1], u.z);
    }
};
template <class F> struct Epi4 {
    static constexpr bool PERM = false;
    F f;
    __device__ __forceinline__ bool keep(const Unit&) const { return false; }
    __device__ __forceinline__ void operator()(const f32x4 (&acc)[2][2][4][2], const Unit& u, int wr, int wc, int fr, int fq) const {
        const int row0 = u.pm * BM + wr * 64 + fr, col0 = u.pn * BM + wc * 32 + 4 * fq;
#pragma unroll
        for (int ai = 0; ai < 2; ++ai)
#pragma unroll
            for (int m = 0; m < 4; ++m)
#pragma unroll
                for (int bj = 0; bj < 2; ++bj)
#pragma unroll
                    for (int n = 0; n < 2; ++n) f(row0 + ai * HALF + m * 16, col0 + bj * HALF + n * 16, acc[ai][bj][m][n], u.z);
    }
};

struct EpiMerge {
    static constexpr bool PERM = true;
    const unsigned char* G; bf16_t* MG;
    __device__ __forceinline__ bool keep(const Unit& u) const { return u.z < 3; }
    __device__ __forceinline__ void operator()(f32x4 (&acc)[2][2][4][2], const Unit& u, int wr, int wc, int fr, int fq) const {
        const int row0 = u.pm * BM + wr * 64 + fr, col0 = u.pn * BM + wc * 32 + 8 * fq;
        const unsigned char* gp0 = G + (size_t)row0 * NG + u.z * DM + col0;
        if (u.z < 3) {
#pragma unroll
            for (int ai = 0; ai < 2; ++ai)
#pragma unroll
                for (int m = 0; m < 4; ++m) {
                    if ((m & 1) == 0) asm volatile("" ::: "memory");
#pragma unroll
                    for (int bj = 0; bj < 2; ++bj) {
                        const unsigned char* gp = gp0 + (size_t)(ai * HALF + m * 16) * NG + bj * HALF;
                        const u32x2 ga = *(const u32x2*)gp, gb = *(const u32x2*)(gp + DM);
#pragma unroll
                        for (int n = 0; n < 2; ++n)
#pragma unroll
                            for (int e = 0; e < 4; ++e) {
                                const float qa = (float)((ga[n] >> (8 * e)) & 255u), qb = (float)((gb[n] >> (8 * e)) & 255u);
                                acc[ai][bj][m][n][e] *= qa * __builtin_amdgcn_rcpf(qb); }
                    }
                }
        } else {
            bf16_t* op0 = MG + (size_t)row0 * DM + col0;
#pragma unroll
            for (int ai = 0; ai < 2; ++ai)
#pragma unroll
                for (int m = 0; m < 4; ++m)
#pragma unroll
                    for (int bj = 0; bj < 2; ++bj) {
                        const u32x2 ga = *(const u32x2*)(gp0 + (size_t)(ai * HALF + m * 16) * NG + bj * HALF);
                        u32x4 o;
#pragma unroll
                        for (int n = 0; n < 2; ++n)
#pragma unroll
                            for (int e2 = 0; e2 < 2; ++e2) {
                                const float q0 = (float)((ga[n] >> (16 * e2)) & 255u) * (1.f / 255.f), q1 = (float)((ga[n] >> (16 * e2 + 8)) & 255u) * (1.f / 255.f);
                                o[2 * n + e2] = cvtpk(acc[ai][bj][m][n][2 * e2] * q0, acc[ai][bj][m][n][2 * e2 + 1] * q1); }
                        *(u32x4*)(op0 + (size_t)(ai * HALF + m * 16) * DM + bj * HALF) = o;
                    }
        }
    }
};

typedef int i32x4 __attribute__((ext_vector_type(4)));
template <class Epi, class Sched, bool I8 = false, bool ALIGN_EPI = true>
__device__ __forceinline__ void gemm_phase(LAS unsigned char* lds, const Gemm g, const Sched& S, const Epi& E, const int tid) {
    constexpr int ES = I8 ? 1 : 2;
    const int wid = __builtin_amdgcn_readfirstlane(tid >> 6), lane = tid & 63, wr = wid >> 2, wc = wid & 3, fr = lane & 15, fq = lane >> 4;
    const int K = g.K, nt = K * ES / 128;
    unsigned voffA[2], voffB[2];
#pragma unroll
    for (int i = 0; i < 2; ++i) { int R, C; stage_rc(tid * 16 + i * 8192, R, C); const int Rb = Epi::PERM ? ((R & ~31) + perm32(R & 31)) : R;
        voffA[i] = (unsigned)(R * g.lda * ES + C * 2); voffB[i] = (unsigned)(Rb * g.ldb * ES + C * 2); }
    const size_t kstep = (size_t)(BK * 2);
    const size_t hstepA = (size_t)HALF * g.lda * ES, hstepB = (size_t)HALF * g.ldb * ES;
    const size_t tstepA = 2 * hstepA, tstepB = 2 * hstepB;
    const unsigned ldsw = (unsigned)wid * 1024u;
    const int aoff = lds_byte(wr * 64 + fr, fq * 8), boff = lds_byte(wc * 32 + fr, fq * 8);
#define PG8_SA(b, h) (((b) * 2 + (h)) * HTB)
#define PG8_SB(b, h) ((4 + (b) * 2 + (h)) * HTB)
#define PG8_STAGE(bufoff, gbase, voff) do { _Pragma("unroll") for (int _i = 0; _i < 2; ++_i) \
        __builtin_amdgcn_global_load_lds((const unsigned*)((const char*)(gbase) + (voff)[_i]), (LAS unsigned*)(lds + (bufoff) + ldsw + _i * 8192), 16, 0, 0); } while (0)
#define PG8_LDA(dst, b, h) do { _Pragma("unroll") for (int m = 0; m < 4; ++m) _Pragma("unroll") for (int k = 0; k < 2; ++k) dst[m][k] = *(const LAS bf16x8*)(lds + PG8_SA(b, h) + aoff + m * 2048 + k * 1024); } while (0)
#define PG8_LDB(dst, b, h) do { _Pragma("unroll") for (int n = 0; n < 2; ++n) _Pragma("unroll") for (int k = 0; k < 2; ++k) dst[n][k] = *(const LAS bf16x8*)(lds + PG8_SB(b, h) + boff + n * 2048 + k * 1024); } while (0)
#define PG8_MMA(ai, bj, At, Bt) do { __builtin_amdgcn_s_setprio(1); _Pragma("unroll") for (int m = 0; m < 4; ++m) _Pragma("unroll") for (int n = 0; n < 2; ++n) _Pragma("unroll") for (int k = 0; k < 2; ++k) { \
        if constexpr (I8) acc[ai][bj][m][n] = __builtin_bit_cast(f32x4, __builtin_amdgcn_mfma_i32_16x16x64_i8(__builtin_bit_cast(i32x4, Bt[n][k]), __builtin_bit_cast(i32x4, At[m][k]), __builtin_bit_cast(i32x4, acc[ai][bj][m][n]), 0, 0, 0)); \
        else acc[ai][bj][m][n] = __builtin_amdgcn_mfma_f32_16x16x32_bf16(Bt[n][k], At[m][k], acc[ai][bj][m][n], 0, 0, 0); } __builtin_amdgcn_s_setprio(0); } while (0)
#define PG8_WAIT_V(n) asm volatile("s_waitcnt vmcnt(" #n ")" ::: "memory")
#define PG8_WAIT_L(n) asm volatile("s_waitcnt lgkmcnt(" #n ")" ::: "memory")
#define PG8_BAR __builtin_amdgcn_s_barrier()
#define PG8_SCHED __builtin_amdgcn_sched_barrier(0)
    Unit cur, nxt; int ui = 0;
    if (!S.next(0, cur)) return;
    f32x4 acc[2][2][4][2];
#pragma unroll
    for (int a = 0; a < 2; ++a)
#pragma unroll
        for (int b = 0; b < 2; ++b)
#pragma unroll
            for (int m = 0; m < 4; ++m)
#pragma unroll
                for (int n = 0; n < 2; ++n) acc[a][b][m][n] = (f32x4){0.f, 0.f, 0.f, 0.f};
    bf16x8 At[4][2], B0[2][2], B1[2][2];
    const char* cA = (const char*)g.A + (size_t)cur.z * g.zA * ES + (size_t)cur.pm * tstepA; const char* cB = (const char*)g.Bt + (size_t)cur.z * g.zB * ES + (size_t)cur.pn * tstepB;
    PG8_STAGE(PG8_SB(0, 0), cB, voffB); PG8_STAGE(PG8_SB(0, 1), cB + hstepB, voffB); PG8_STAGE(PG8_SA(0, 0), cA, voffA); PG8_STAGE(PG8_SA(0, 1), cA + hstepA, voffA);
    if (wr == 1) PG8_BAR;
    PG8_WAIT_V(2); PG8_BAR;
    PG8_STAGE(PG8_SB(1, 0), cB + kstep, voffB); PG8_STAGE(PG8_SA(1, 0), cA + kstep, voffA); PG8_STAGE(PG8_SB(1, 1), cB + hstepB + kstep, voffB);
    PG8_WAIT_V(6); PG8_BAR;
    for (;;) {
        const bool has_next = S.next(ui + 1, nxt);
        const char* nA = has_next ? (const char*)g.A + (size_t)nxt.z * g.zA * ES + (size_t)nxt.pm * tstepA : cA;
        const char* nB = has_next ? (const char*)g.Bt + (size_t)nxt.z * g.zB * ES + (size_t)nxt.pn * tstepB : cB;
        for (int t = 0; t < nt; t += 2) {
            const bool last = (t == nt - 2);
            const char* a1 = cA + (size_t)(t + 1) * kstep;
            const char* a2 = last ? nA : cA + (size_t)(t + 2) * kstep; const char* b2 = last ? nB : cB + (size_t)(t + 2) * kstep;
            const char* a3 = a2 + kstep; const char* b3 = b2 + kstep;
            PG8_LDB(B0, 0, 0); PG8_LDB(B1, 0, 1); PG8_SCHED; PG8_LDA(At, 0, 0); PG8_STAGE(PG8_SA(1, 1), a1 + hstepA, voffA);
            PG8_WAIT_V(8); PG8_WAIT_L(0); PG8_BAR; PG8_MMA(0, 0, At, B0); PG8_MMA(0, 1, At, B1); PG8_BAR; PG8_SCHED;
            PG8_LDA(At, 0, 1); PG8_STAGE(PG8_SB(0, 0), b2, voffB); PG8_STAGE(PG8_SB(0, 1), b2 + hstepB, voffB); PG8_STAGE(PG8_SA(0, 0), a2, voffA);
            PG8_WAIT_V(8); PG8_WAIT_L(0); PG8_BAR; PG8_MMA(1, 0, At, B0); PG8_MMA(1, 1, At, B1); PG8_BAR; PG8_SCHED;
            PG8_LDB(B0, 1, 0); PG8_LDB(B1, 1, 1); PG8_SCHED; PG8_LDA(At, 1, 0); PG8_STAGE(PG8_SA(0, 1), a2 + hstepA, voffA);
            PG8_WAIT_V(8); PG8_WAIT_L(0); PG8_BAR; PG8_MMA(0, 0, At, B0); PG8_MMA(0, 1, At, B1); PG8_BAR; PG8_SCHED;
            PG8_LDA(At, 1, 1); PG8_STAGE(PG8_SB(1, 0), b3, voffB); PG8_STAGE(PG8_SB(1, 1), b3 + hstepB, voffB); PG8_STAGE(PG8_SA(1, 0), a3, voffA);
            PG8_WAIT_V(8); PG8_WAIT_L(0); PG8_BAR; PG8_MMA(1, 0, At, B0); PG8_MMA(1, 1, At, B1); PG8_BAR; PG8_SCHED;
        }
        if constexpr (ALIGN_EPI) { if (wr == 0) PG8_BAR; }
        E(acc, cur, wr, wc, fr, fq);
        if (!has_next) break;
        if (!E.keep(cur)) {
#pragma unroll
            for (int a = 0; a < 2; ++a)
#pragma unroll
                for (int b = 0; b < 2; ++b)
#pragma unroll
                    for (int m = 0; m < 4; ++m)
#pragma unroll
                        for (int n = 0; n < 2; ++n) acc[a][b][m][n] = (f32x4){0.f, 0.f, 0.f, 0.f};
        }
        cur = nxt; cA = nA; cB = nB; ++ui;
        if constexpr (ALIGN_EPI) { if (wr == 1) PG8_BAR; }
    }
    PG8_WAIT_V(0);
    if constexpr (!ALIGN_EPI) { if (wr == 0) PG8_BAR; }
    PG8_BAR;
#undef PG8_SA
#undef PG8_SB
#undef PG8_STAGE
#undef PG8_LDA
#undef PG8_LDB
#undef PG8_MMA
#undef PG8_WAIT_V
#undef PG8_WAIT_L
#undef PG8_BAR
#undef PG8_SCHED
}
}

#define XB_TMO      128
#define XB_XCNT(j)  (256  + 64 * (j))
#define XB_XSUB(j)  (1280 + 64 * (j))
#define XB_XGEN(j)  (2304 + 64 * (j))
#define XB_TOP      3328
#define XB_TOPGEN   3392
#define XCD_BAR_WORDS 3456
#define XB_SPIN_CAP (1u << 22)
__device__ __forceinline__ unsigned xb_ld(unsigned* p)              { return __hip_atomic_load(p, __ATOMIC_RELAXED, __HIP_MEMORY_SCOPE_AGENT); }
__device__ __forceinline__ unsigned xb_add(unsigned* p, unsigned v) { return __hip_atomic_fetch_add(p, v, __ATOMIC_RELAXED, __HIP_MEMORY_SCOPE_AGENT); }
__device__ __forceinline__ unsigned xb_xcc_id() { return (unsigned)__builtin_amdgcn_s_getreg((3 << 11) | 20) & 0xFu; }
#define XB_SPIN(cond, bar) do { unsigned _sp = 0; while (cond) { __builtin_amdgcn_s_sleep(1); \
    if ((++_sp & 255u) == 0u) { if (xb_ld(&(bar)[XB_TMO])) break; if (_sp > XB_SPIN_CAP) { atomicAdd(&(bar)[XB_TMO], 1u); break; } } } } while (0)
__device__ __forceinline__ void xcd_barrier_post(unsigned* bar) {
    if (threadIdx.x == 0) (void)xb_add(&bar[XB_XCNT(xb_xcc_id())], 1u);
}
__device__ __forceinline__ void xcd_barrier_complete(unsigned* bar, unsigned x, unsigned& nloc, unsigned& nx) {
    const unsigned G = gridDim.x * gridDim.y * gridDim.z;
    unsigned sum, cnt, mine, sp = 0u;
    for (;;) {
        sum = 0u; cnt = 0u; mine = 0u;
#pragma unroll
        for (unsigned j = 0; j < 16; ++j) { const unsigned c = xb_ld(&bar[XB_XCNT(j)]); sum += c; cnt += (c > 0u) ? 1u : 0u; mine = (j == x) ? c : mine; }
        if (sum == G) break;
        __builtin_amdgcn_s_sleep(1);
        if ((++sp & 255u) == 0u) { if (xb_ld(&bar[XB_TMO])) break; if (sp > XB_SPIN_CAP) { atomicAdd(&bar[XB_TMO], 1u); break; } }
    }
    nloc = mine > 0u ? mine : 1u; nx = cnt > 0u ? cnt : 1u;
}
__device__ __noinline__ void xcd_barrier_leader(unsigned* bar, volatile LAS unsigned* st) {
    const unsigned x = xb_xcc_id();
    __builtin_amdgcn_s_waitcnt(0);
    unsigned nloc = st[0], nx = st[1];
    if (nloc == 0u) { xcd_barrier_complete(bar, x, nloc, nx); st[0] = nloc; st[1] = nx; }
    const unsigned old = xb_add(&bar[XB_XSUB(x)], 1u);
    const unsigned gen = old / nloc;
    if (old + 1u == (gen + 1u) * nloc) {
        __builtin_amdgcn_fence(__ATOMIC_RELEASE, "agent");
        asm volatile("s_waitcnt vmcnt(0)" ::: "memory");
        const unsigned og = xb_add(&bar[XB_TOP], 1u);
        const unsigned tg = og / nx;
        if (og + 1u == (tg + 1u) * nx) xb_add(&bar[XB_TOPGEN], 1u);
        else XB_SPIN(xb_ld(&bar[XB_TOPGEN]) == tg, bar);
        __builtin_amdgcn_fence(__ATOMIC_ACQUIRE, "agent");
        xb_add(&bar[XB_XGEN(x)], 1u);
        asm volatile("s_waitcnt vmcnt(0)" ::: "memory");
    } else {
        XB_SPIN(xb_ld(&bar[XB_XGEN(x)]) == gen, bar);
        __builtin_amdgcn_fence(__ATOMIC_ACQUIRE, "agent");
        asm volatile("s_waitcnt vmcnt(0)" ::: "memory");
    }
}
__device__ __forceinline__ void xcd_barrier(unsigned* bar, volatile LAS unsigned* st) {
    asm volatile("s_waitcnt vmcnt(0)" ::: "memory");
    __syncthreads();
    if (threadIdx.x == 0) xcd_barrier_leader(bar, st);
    __syncthreads();
}

constexpr int NIN_PTRS = 23;
struct Args { const float* in[NIN_PTRS]; float* out; unsigned char* ws; int ph_lo, ph_hi, bar_slot, pad; };
enum { I_X = 0, I_WIN, I_BFOX, I_POOLW, I_POOLS, I_LBL, I_HNG, I_GLNG, I_GLNB, I_GWS, I_GBS, I_WGATE, I_BGATE, I_WBR, I_WOUT, I_LN1G, I_LN1B, I_WQ, I_KEYS, I_PU, I_PV, I_LN2G, I_LN2B };

constexpr int LDS_BYTES = 147456;
constexpr int LDSCTL_OFF = 143360;

struct Ctx {
    LAS unsigned char* lds;
    unsigned char* ws;
    const float* const* in;
    float* out;
    int tid, lane, wave, G, bid, vcu;
};

__device__ __forceinline__ void tconv_job(const Ctx& C, const float* src, int ld_src, int K, int N, bf16_t* dst) {
    LAS float* tile = (LAS float*)C.lds;
    const int nk = K / 64, nn = N / 64, ntiles = nk * nn;
    for (int tl = C.bid; tl < ntiles; tl += C.G) {
        const int k0 = (tl / nn) * 64, n0 = (tl % nn) * 64;
#pragma unroll
        for (int p = 0; p < 2; ++p) {
            const int kr = (C.tid >> 4) + p * 32, nc = (C.tid & 15) * 4;
            const f32x4 v = *(const f32x4*)(src + (size_t)(k0 + kr) * ld_src + n0 + nc);
            tile[kr * 65 + nc + 0] = v[0]; tile[kr * 65 + nc + 1] = v[1]; tile[kr * 65 + nc + 2] = v[2]; tile[kr * 65 + nc + 3] = v[3];
        }
        __syncthreads();
        {
            const int n = C.tid >> 3, k8 = (C.tid & 7) * 8;
            u32x4 o;
#pragma unroll
            for (int j = 0; j < 4; ++j) o[j] = pk2(tile[(k8 + 2 * j) * 65 + n], tile[(k8 + 2 * j + 1) * 65 + n]);
            *(u32x4*)(dst + (size_t)(n0 + n) * K + k0 + k8) = o;
        }
        __syncthreads();
    }
}
__device__ __forceinline__ void cvt_copy(const Ctx& C, const float* src, bf16_t* dst, size_t n) {
    const size_t n8 = n / 8;
    for (size_t i = (size_t)C.bid * 512 + C.tid; i < n8; i += (size_t)C.G * 512) {
        const f32x4 a = *(const f32x4*)(src + i * 8), b = *(const f32x4*)(src + i * 8 + 4);
        u32x4 o; o[0] = pk2(a[0], a[1]); o[1] = pk2(a[2], a[3]); o[2] = pk2(b[0], b[1]); o[3] = pk2(b[2], b[3]);
        *(u32x4*)(dst + i * 8) = o;
    }
}
__device__ __forceinline__ void strip_unit(const Ctx& C, const float* src, int ld, unsigned char* dst, unsigned* cmax, bool split) {
    const float* p = src + (size_t)(128 * C.wave) * ld + C.lane;
    float v[128];
#pragma unroll
    for (int i = 0; i < 128; ++i) v[i] = p[(size_t)i * ld];
    if (cmax) {
        float mx = 0.f;
#pragma unroll
        for (int i = 0; i < 128; ++i) mx = fmaxf(mx, fabsf(v[i]));
        LAS float* red = (LAS float*)C.lds;
        red[C.wave * 64 + C.lane] = mx;
        __syncthreads();
        float m = red[C.lane];
#pragma unroll
        for (int w2 = 1; w2 < 8; ++w2) m = fmaxf(m, red[w2 * 64 + C.lane]);
        if (C.wave == 0) cmax[C.lane] = __builtin_bit_cast(unsigned, m);
        const float isc = 127.f / fmaxf(m, 1e-30f);
        unsigned char* dp = dst + (size_t)C.lane * 1024 + 128 * C.wave;
#pragma unroll
        for (int j4 = 0; j4 < 8; ++j4) { u32x4 o;
#pragma unroll
            for (int j = 0; j < 4; ++j) { unsigned wd = 0u;
#pragma unroll
                for (int e = 0; e < 4; ++e) wd |= ((unsigned)(int)rintf(v[16 * j4 + 4 * j + e] * isc) & 255u) << (8 * e);
                o[j] = wd; }
            *(u32x4*)(dp + 16 * j4) = o; }
        __syncthreads();
    } else {
        bf16_t* dp = split ? (bf16_t*)dst + (size_t)(C.wave >> 2) * DM * BW + (size_t)C.lane * BW + 128 * (C.wave & 3) : (bf16_t*)dst + (size_t)C.lane * 1024 + 128 * C.wave;
#pragma unroll
        for (int j8 = 0; j8 < 16; ++j8) { u32x4 o;
#pragma unroll
            for (int j = 0; j < 4; ++j) o[j] = pk2(v[8 * j8 + 2 * j], v[8 * j8 + 2 * j + 1]);
            *(u32x4*)(dp + 8 * j8) = o; }
    }
}
__device__ __forceinline__ void p_conv_weights(const Ctx& C) {
#pragma unroll 1
    for (int u = C.bid; u < DEPTH * 224; u += C.G) {
        const int l = u / 224, r = u % 224;
        unsigned char* wb = C.ws + WS_W + (size_t)l * W_LAYER;
        unsigned* cm = (unsigned*)(C.ws + WS_CMAX) + l * (NH + NG);
        const float* src; int ld; unsigned char* dst; unsigned* cx = nullptr; bool split = false;
        if (r < 80)       { src = C.in[I_WIN] + (size_t)l * DM * NIN + r * 64; ld = NIN; dst = wb + WO_WIN + (size_t)r * 64 * DM; cx = cm + r * 64; }
        else if (r < 144) { const int t = r - 80; src = C.in[I_WGATE] + (size_t)l * DM * NG + t * 64; ld = NG; dst = wb + WO_WG + (size_t)t * 64 * DM; cx = cm + NH + t * 64; }
        else if (r < 176) { const int t = r - 144, pr = t >> 4, nt = t & 15; src = C.in[I_WBR] + ((size_t)l * 4 + 2 * pr) * BW * DM + nt * 64; ld = DM; split = true;
                            dst = wb + WO_WBR + ((size_t)(2 * pr) * DM * BW + (size_t)nt * 64 * BW) * 2; }
        else if (r < 192) { const int nt = r - 176; src = C.in[I_WOUT] + (size_t)l * DM * DM + nt * 64; ld = DM; dst = wb + WO_WOUT + (size_t)nt * 64 * DM * 2; }
        else              { const int nt = r - 192; src = C.in[I_WQ] + (size_t)l * DM * NQ + nt * 64; ld = NQ; dst = wb + WO_WQ + (size_t)nt * 64 * DM; cx = (unsigned*)(C.ws + WS_CMAX) + DEPTH * (NH + NG) + l * NQ + nt * 64; }
        strip_unit(C, src, ld, dst, cx, split);
    }
    for (int l = 0; l < DEPTH; ++l) {
        unsigned char* wb = C.ws + WS_W + (size_t)l * W_LAYER;
        cvt_copy(C, C.in[I_KEYS] + (size_t)l * 2 * PH * 128 * 128, (bf16_t*)(wb + WO_KEYS), (size_t)2 * PH * 128 * 128);
        for (int g = 0; g < 4; ++g)
            tconv_job(C, C.in[I_POOLW] + ((size_t)l * 4 + g) * 128 * 128, 128, 128, 128, (bf16_t*)(wb + WO_POOLW) + (size_t)g * 128 * 128);
        {
            bf16_t* gw = (bf16_t*)(wb + WO_GWS); const float* src = C.in[I_GWS] + (size_t)l * 4 * 128 * 128;
            for (int i = C.bid * 512 + C.tid; i < 4 * 128 * 128; i += C.G * 512) { const int t = (i >> 7) & 127, sx = i & 127; gw[i] = (bf16_t)f2bf(sx <= t ? src[i] : 0.f); }
        }
        float* wf = (float*)(wb + WO_WF);
        for (int i = C.bid * 512 + C.tid; i < 4 * DM; i += C.G * 512) { const int h = i / DM, k = i % DM; wf[i] = C.in[I_WIN][(size_t)l * DM * NIN + (size_t)k * NIN + NH + h]; }
    }
}
constexpr size_t WS_U8 = WS_TABU, WS_V8 = WS_TABU + 16 * MiB, WS_SU = WS_TABU + 32 * MiB, WS_SV = WS_SU + 64 * 1024;
__device__ __forceinline__ float wave_max(float v) {
#pragma unroll
    for (int o = 32; o > 0; o >>= 1) v = fmaxf(v, __shfl_xor(v, o, 64));
    return v;
}
template <bool SIGNED> __device__ __forceinline__ void quant_rows(const Ctx& C, const float* src, unsigned char* dst, float* scl) {
    for (int row = C.bid * 8 + C.wave; row < NEXP; row += C.G * 8) {
        const float* p = src + (size_t)row * DM + C.lane * 16;
        f32x4 v[4]; float mx = 0.f;
#pragma unroll
        for (int i = 0; i < 4; ++i) { v[i] = *(const f32x4*)(p + 4 * i);
#pragma unroll
            for (int e = 0; e < 4; ++e) mx = fmaxf(mx, fabsf(v[i][e])); }
        mx = fmaxf(wave_max(mx), 1e-30f);
        const float sc = mx * (1.f / 127.f), isc = 127.f / mx;
        u32x4 o;
#pragma unroll
        for (int i = 0; i < 4; ++i) { unsigned wd = 0u;
#pragma unroll
            for (int e = 0; e < 4; ++e) { const int q = (int)rintf(v[i][e] * isc) + (SIGNED ? 0 : 128); wd |= ((unsigned)q & 255u) << (8 * e); }
            o[i] = wd; }
        *(u32x4*)(dst + (size_t)row * DM + C.lane * 16) = o;
        if (C.lane == 0) scl[row] = sc;
    }
}
constexpr int V6_ROW = 768;
__device__ __forceinline__ void quant_rows6(const Ctx& C, const float* src, unsigned char* dst, float* scl) {
    for (int row = C.bid * 8 + C.wave; row < NEXP; row += C.G * 8) {
        const float* p = src + (size_t)row * DM + C.lane * 16;
        f32x4 v[4]; float mx = 0.f;
#pragma unroll
        for (int i = 0; i < 4; ++i) { v[i] = *(const f32x4*)(p + 4 * i);
#pragma unroll
            for (int e = 0; e < 4; ++e) mx = fmaxf(mx, fabsf(v[i][e])); }
        mx = fmaxf(wave_max(mx), 1e-30f);
        const float sc = mx * (1.f / 31.f), isc = 31.f / mx;
        unsigned q[16];
#pragma unroll
        for (int i = 0; i < 4; ++i)
#pragma unroll
            for (int e = 0; e < 4; ++e) q[4 * i + e] = (unsigned)((int)rintf(v[i][e] * isc) + 31);
        u32x3a o;
        o[0] = q[0] | (q[1] << 6) | (q[2] << 12) | (q[3] << 18) | (q[4] << 24) | (q[5] << 30);
        o[1] = (q[5] >> 2) | (q[6] << 4) | (q[7] << 10) | (q[8] << 16) | (q[9] << 22) | (q[10] << 28);
        o[2] = (q[10] >> 4) | (q[11] << 2) | (q[12] << 8) | (q[13] << 14) | (q[14] << 20) | (q[15] << 26);
        *(u32x3a*)(dst + (size_t)row * V6_ROW + C.lane * 12) = o;
        if (C.lane == 0) scl[row] = sc;
    }
}
__device__ __forceinline__ float v6f(const u32x3a& r, int k) {
    unsigned u;
    if (k < 5) u = (r[0] >> (6 * k)) & 63u;
    else if (k == 5) u = ((r[0] >> 30) | (r[1] << 2)) & 63u;
    else if (k < 10) u = (r[1] >> (4 + 6 * (k - 6))) & 63u;
    else if (k == 10) u = ((r[1] >> 28) | (r[2] << 4)) & 63u;
    else u = (r[2] >> (2 + 6 * (k - 11))) & 63u;
    return (float)u;
}
__device__ __forceinline__ void p_conv_tables(const Ctx& C, int l) {
    quant_rows<true>(C, C.in[I_PU] + (size_t)l * NEXP * DM, C.ws + WS_U8, (float*)(C.ws + WS_SU));
    quant_rows6(C, C.in[I_PV] + (size_t)l * NEXP * DM, C.ws + WS_V8, (float*)(C.ws + WS_SV));
}

__device__ __forceinline__ void row_emit(const Ctx& C, int row, const float (&v)[16], int l, bool want_lsig) {
    {
        float mx = 0.f;
#pragma unroll
        for (int j = 0; j < 16; ++j) mx = fmaxf(mx, fabsf(v[j]));
#pragma unroll
        for (int o = 32; o > 0; o >>= 1) mx = fmaxf(mx, __shfl_xor(mx, o, 64));
        mx = fmaxf(mx, 1e-30f);
        const float isc = 127.f / mx;
        unsigned char* xb = C.ws + WS_XB + (size_t)row * DM;
        u32x2 o0, o1;
#pragma unroll
        for (int hw = 0; hw < 2; ++hw) { unsigned a = 0u, b = 0u;
#pragma unroll
            for (int e = 0; e < 4; ++e) { a |= ((unsigned)(int)rintf(v[4 * hw + e] * isc) & 255u) << (8 * e); b |= ((unsigned)(int)rintf(v[8 + 4 * hw + e] * isc) & 255u) << (8 * e); }
            o0[hw] = a; o1[hw] = b; }
        *(u32x2*)(xb + C.lane * 8) = o0; *(u32x2*)(xb + 512 + C.lane * 8) = o1;
        if (C.lane == 0) ((float*)(C.ws + WS_XSA))[row] = mx * (1.f / 127.f);
    }
    if (want_lsig) {
        const float* wf = (const float*)(C.ws + WS_W + (size_t)l * W_LAYER + WO_WF);
        float* lsig = (float*)(C.ws + WS_MISC);
#pragma unroll
        for (int h = 0; h < 4; ++h) {
            const f32x4 a0 = *(const f32x4*)(wf + h * DM + C.lane * 8), a1 = *(const f32x4*)(wf + h * DM + C.lane * 8 + 4);
            const f32x4 b0 = *(const f32x4*)(wf + h * DM + 512 + C.lane * 8), b1 = *(const f32x4*)(wf + h * DM + 512 + C.lane * 8 + 4);
            float s = 0.f;
#pragma unroll
            for (int j = 0; j < 4; ++j) s += v[j] * a0[j] + v[4 + j] * a1[j] + v[8 + j] * b0[j] + v[12 + j] * b1[j];
            s = wave_sum(s);
            if (C.lane == 0) lsig[(size_t)row * 4 + h] = logsigmoidf_(s + C.in[I_BFOX][l * 4 + h]);
        }
    }
}
__device__ __forceinline__ void load_row16(const float* p, int lane, float (&v)[16]) {
    const f32x4 a0 = *(const f32x4*)(p + lane * 8), a1 = *(const f32x4*)(p + lane * 8 + 4), b0 = *(const f32x4*)(p + 512 + lane * 8), b1 = *(const f32x4*)(p + 512 + lane * 8 + 4);
#pragma unroll
    for (int j = 0; j < 4; ++j) { v[j] = a0[j]; v[4 + j] = a1[j]; v[8 + j] = b0[j]; v[12 + j] = b1[j]; }
}
__device__ __forceinline__ void store_row16(float* p, int lane, const float (&v)[16]) {
    *(f32x4*)(p + lane * 8) = (f32x4){v[0], v[1], v[2], v[3]}; *(f32x4*)(p + lane * 8 + 4) = (f32x4){v[4], v[5], v[6], v[7]};
    *(f32x4*)(p + 512 + lane * 8) = (f32x4){v[8], v[9], v[10], v[11]}; *(f32x4*)(p + 512 + lane * 8 + 4) = (f32x4){v[12], v[13], v[14], v[15]};
}
__device__ __forceinline__ void ln_row16(float (&v)[16], const float* g, const float* b, int lane) {
    float s = 0.f;
#pragma unroll
    for (int j = 0; j < 16; ++j) s += v[j];
    const float mean = wave_sum(s) * (1.f / DM);
    float q = 0.f;
#pragma unroll
    for (int j = 0; j < 16; ++j) { const float d = v[j] - mean; q += d * d; }
    const float rstd = rsqrtf(wave_sum(q) * (1.f / DM) + LN_EPS);
    float gg[16], bb[16];
    load_row16(g, lane, gg); load_row16(b, lane, bb);
#pragma unroll
    for (int j = 0; j < 16; ++j) v[j] = (v[j] - mean) * rstd * gg[j] + bb[j];
}
__device__ __forceinline__ void p_rowpass0(const Ctx& C) {
    const float* wfin = C.in[I_WIN] + NH;
    f32x4 wv[16];
#pragma unroll
    for (int j = 0; j < 16; ++j) { const int k = (j < 8) ? C.lane * 8 + j : 512 + C.lane * 8 + (j - 8); wv[j] = *(const f32x4*)(wfin + (size_t)k * NIN); }
    float* lsig = (float*)(C.ws + WS_MISC);
    const bool bal = (C.G == 256);
    const int c0 = bal ? ((C.bid < 192) ? C.bid * 6 : 1152 + (C.bid - 192) * 14) : C.bid, cn = bal ? ((C.bid < 192) ? 6 : 14) : (T / 8 - C.bid + C.G - 1) / C.G, cs = bal ? 1 : C.G;
    for (int ci = 0; ci < cn; ++ci) {
        const int row = (c0 + ci * cs) * 8 + C.wave;
        float v[16]; load_row16(C.in[I_X] + (size_t)row * DM, C.lane, v);
        row_emit(C, row, v, 0, false);
#pragma unroll
        for (int h = 0; h < 4; ++h) {
            float sacc = 0.f;
#pragma unroll
            for (int j = 0; j < 16; ++j) sacc += v[j] * wv[j][h];
            sacc = wave_sum(sacc);
            if (C.lane == 0) lsig[(size_t)row * 4 + h] = logsigmoidf_(sacc + C.in[I_BFOX][h]);
        }
    }
}
__device__ __forceinline__ void p_cumsum(const Ctx& C) {
    if (C.bid >= BATCH * 4) return;
    const float* lsig = (const float*)(C.ws + WS_MISC);
    float* cum = (float*)(C.ws + WS_CUM);
    LAS float* wt = (LAS float*)C.lds;
    const int b = C.bid >> 2, h = C.bid & 3;
    float v[16];
#pragma unroll
    for (int j = 0; j < 16; ++j) v[j] = lsig[((size_t)b * SEQ + C.tid * 16 + j) * 4 + h];
#pragma unroll
    for (int j = 1; j < 16; ++j) v[j] += v[j - 1];
    float inc = v[15];
#pragma unroll
    for (int o = 1; o < 64; o <<= 1) { const float t = __shfl_up(inc, o, 64); if (C.lane >= o) inc += t; }
    if (C.lane == 63) wt[C.wave] = inc;
    __syncthreads();
    float off = inc - v[15];
    for (int w2 = 0; w2 < C.wave; ++w2) off += wt[w2];
    float* cp = cum + ((size_t)b * 4 + h) * SEQ + C.tid * 16;
#pragma unroll
    for (int j4 = 0; j4 < 4; ++j4) *(f32x4*)(cp + 4 * j4) = (f32x4){v[4 * j4] + off, v[4 * j4 + 1] + off, v[4 * j4 + 2] + off, v[4 * j4 + 3] + off};
    __syncthreads();
}
__device__ __forceinline__ void load_row16_bf(const bf16_t* p, int lane, float (&v)[16]) {
    const u32x4 a = *(const u32x4*)(p + lane * 8), b = *(const u32x4*)(p + 512 + lane * 8);
#pragma unroll
    for (int j = 0; j < 4; ++j) { v[2 * j] = bf2f(a[j] & 0xffffu); v[2 * j + 1] = bf2f(a[j] >> 16); v[8 + 2 * j] = bf2f(b[j] & 0xffffu); v[9 + 2 * j] = bf2f(b[j] >> 16); }
}
__device__ __forceinline__ void p_ln1(const Ctx& C, int l) {
    const bf16_t* y1 = (const bf16_t*)(C.ws + WS_XC); bf16_t* x1b = (bf16_t*)(C.ws + WS_X1B);
    for (int row = C.bid * 8 + C.wave; row < T; row += C.G * 8) {
        float v[16]; load_row16_bf(y1 + (size_t)row * DM, C.lane, v);
        ln_row16(v, C.in[I_LN1G] + l * DM, C.in[I_LN1B] + l * DM, C.lane);
        row_emit(C, row, v, l, false);
        u32x4 o0, o1;
#pragma unroll
        for (int j = 0; j < 4; ++j) { o0[j] = pk2(v[2 * j], v[2 * j + 1]); o1[j] = pk2(v[8 + 2 * j], v[8 + 2 * j + 1]); }
        *(u32x4*)(x1b + (size_t)row * DM + C.lane * 8) = o0; *(u32x4*)(x1b + (size_t)row * DM + 512 + C.lane * 8) = o1;
    }
}

__device__ __forceinline__ void mix_pool_naive(const Ctx& C, int l) {
    const bf16_t* H = (const bf16_t*)(C.ws + WS_H); bf16_t* BR = (bf16_t*)(C.ws + WS_BR);
    LAS float* dd = (LAS float*)C.lds;
    for (int u = C.bid; u < (T / 64) * 4; u += C.G) {
        const int g = u & 3, t0 = (u >> 2) * 64, w = 2 << g;
        for (int idx = C.tid; idx < 64 * 128; idx += 512) {
            const int r = idx >> 7, c = idx & 127, row = t0 + r, pos = row & (SEQ - 1);
            const int nwin = (pos + 1 < w) ? pos + 1 : w;
            float s = 0.f;
            for (int j = 0; j < nwin; ++j) s += bf2f(H[(size_t)(row - j) * NH + HC_P + g * 128 + c]);
            dd[idx] = s / (float)nwin - bf2f(H[(size_t)row * NH + HC_P + g * 128 + c]);
        }
        __syncthreads();
        const int dcol = C.tid & 127, rq = C.tid >> 7;
        float acc[16];
#pragma unroll
        for (int i = 0; i < 16; ++i) acc[i] = 0.f;
        const float* pw = C.in[I_POOLW] + ((size_t)l * 4 + g) * 128 * 128;
        for (int c = 0; c < 128; ++c) {
            const float wv = pw[c * 128 + dcol];
#pragma unroll
            for (int i = 0; i < 16; ++i) acc[i] += dd[(rq * 16 + i) * 128 + c] * wv;
        }
        const float sc = C.in[I_POOLS][l * BW + g * 128 + dcol];
#pragma unroll
        for (int i = 0; i < 16; ++i) BR[(size_t)(t0 + rq * 16 + i) * NBR + 0 + g * 128 + dcol] = (bf16_t)f2bf(acc[i] * sc);
        __syncthreads();
    }
}
__device__ __forceinline__ void mix_gmlp_naive(const Ctx& C, int l) {
    const bf16_t* H = (const bf16_t*)(C.ws + WS_H); bf16_t* BR = (bf16_t*)(C.ws + WS_BR);
    LAS float* vn = (LAS float*)C.lds;
    for (int u = C.bid; u < (T / 128) * 4; u += C.G) {
        const int g = u & 3, t0 = (u >> 2) * 128;
        for (int i = 0; i < 16; ++i) {
            const int r = C.wave * 16 + i, row = t0 + r;
            const u32x4 raw = *(const u32x4*)(H + (size_t)row * NH + HC_GV + C.lane * 8);
            float e[8];
#pragma unroll
            for (int j = 0; j < 4; ++j) { e[2 * j] = geluf_(bf2f(raw[j] & 0xffffu)); e[2 * j + 1] = geluf_(bf2f(raw[j] >> 16)); }
            float s = 0.f;
#pragma unroll
            for (int j = 0; j < 8; ++j) s += e[j];
            const float mean = wave_sum(s) * (1.f / BW);
            float q = 0.f;
#pragma unroll
            for (int j = 0; j < 8; ++j) { const float d = e[j] - mean; q += d * d; }
            const float rstd = rsqrtf(wave_sum(q) * (1.f / BW) + LN_EPS);
            if ((C.lane >> 4) == g) {
#pragma unroll
                for (int j = 0; j < 8; ++j) { const int col = C.lane * 8 + j;
                    vn[r * 128 + (col - g * 128)] = (e[j] - mean) * rstd * C.in[I_GLNG][l * BW + col] + C.in[I_GLNB][l * BW + col]; }
            }
        }
        __syncthreads();
        const int c = C.tid & 127, tq = C.tid >> 7;
        const float* wsg = C.in[I_GWS] + ((size_t)l * 4 + g) * 128 * 128;
        for (int t = tq; t < 128; t += 4) {
            float acc = 0.f;
            for (int s = 0; s <= t; ++s) acc += wsg[t * 128 + s] * vn[s * 128 + c];
            const float sv = acc + C.in[I_GBS][(l * 4 + g) * 128 + t];
            const float uv = geluf_(bf2f(H[(size_t)(t0 + t) * NH + HC_GU + g * 128 + c]));
            BR[(size_t)(t0 + t) * NBR + 1024 + g * 128 + c] = (bf16_t)f2bf(uv * sv);
        }
        __syncthreads();
    }
}
__device__ __forceinline__ void mix_fox_naive(const Ctx& C, int l) {
    const bf16_t* H = (const bf16_t*)(C.ws + WS_H); bf16_t* BR = (bf16_t*)(C.ws + WS_BR);
    const float* cum = (const float*)(C.ws + WS_CUM);
    const float scale = 0.08838834764831845f;
    for (int u = C.bid; u < T * 4 / 8; u += C.G) {
        const int rid = u * 8 + C.wave;
        const int h = rid & 3, row = rid >> 2, b = row / SEQ, t = row % SEQ;
        const unsigned qraw = *(const unsigned*)(H + (size_t)row * NH + HC_FQ + h * 128 + C.lane * 2);
        const float q0 = bf2f(qraw & 0xffffu) * scale, q1 = bf2f(qraw >> 16) * scale;
        const float* cm = cum + ((size_t)b * 4 + h) * SEQ;
        const float ct = cm[t];
        float m = -1e30f, lsum = 0.f, o0 = 0.f, o1 = 0.f;
        for (int s = t; s >= 0; --s) {
            const size_t kr = (size_t)(b * SEQ + s) * NH + h * 128 + C.lane * 2;
            const unsigned kraw = *(const unsigned*)(H + kr + HC_FK);
            const unsigned vraw = *(const unsigned*)(H + kr + HC_FV);
            float d = q0 * bf2f(kraw & 0xffffu) + q1 * bf2f(kraw >> 16);
            d = wave_sum(d);
            const float z = d + ct - cm[s];
            const float mn = fmaxf(m, z), al = __expf(m - mn), p = __expf(z - mn);
            lsum = lsum * al + p; o0 = o0 * al + p * bf2f(vraw & 0xffffu); o1 = o1 * al + p * bf2f(vraw >> 16); m = mn;
        }
        const float inv = 1.f / lsum;
        *(unsigned*)(BR + (size_t)row * NBR + 1536 + h * 128 + C.lane * 2) = pk2(o0 * inv, o1 * inv);
    }
}
__device__ __forceinline__ void mix_hgrn_naive(const Ctx& C, int l) {
    if (C.bid >= BATCH * 4) return;
    const bf16_t* H = (const bf16_t*)(C.ws + WS_H); bf16_t* BR = (bf16_t*)(C.ws + WS_BR);
    const int b = C.bid >> 2, h = C.bid & 3;
    LAS float* fdec = (LAS float*)C.lds;
    LAS float* kkv = fdec + 32 * 128;
    LAS float* qsv = kkv + 32 * 128;
    LAS float* vv = qsv + 32 * 128;
    LAS float* opart = vv + 32 * 128;
    const int kq = C.tid >> 7, v = C.tid & 127;
    float S[32];
#pragma unroll
    for (int j = 0; j < 32; ++j) S[j] = 0.f;
    for (int c0 = 0; c0 < SEQ; c0 += 32) {
        for (int idx = C.tid; idx < 32 * 128; idx += 512) {
            const int st = idx >> 7, k = idx & 127; const size_t rb = (size_t)(b * SEQ + c0 + st) * NH + h * 128 + k;
            float lb = 0.f;
            if (l == 1) { const float z0 = C.in[I_LBL][h * 128 + k], z1 = C.in[I_LBL][BW + h * 128 + k]; lb = 1.f / (1.f + __expf(z0 - z1)); }
            const float zf = bf2f(H[rb + HC_HF]);
            const float kk = (1.f - lb) * sigmoidf_(-zf);
            fdec[idx] = 1.f - kk; kkv[idx] = kk; qsv[idx] = siluf_(bf2f(H[rb + HC_HQ])); vv[idx] = bf2f(H[rb + HC_HI]);
        }
        __syncthreads();
        for (int st = 0; st < 32; ++st) {
            const float vt = vv[st * 128 + v];
            float part = 0.f;
#pragma unroll
            for (int j = 0; j < 32; ++j) { const int k = kq * 32 + j; S[j] = fdec[st * 128 + k] * S[j] + kkv[st * 128 + k] * vt; part += S[j] * qsv[st * 128 + k]; }
            opart[(kq * 32 + st) * 128 + v] = part;
        }
        __syncthreads();
        for (int i = 0; i < 4; ++i) {
            const int st = C.wave * 4 + i, row = b * SEQ + c0 + st;
            float o0 = 0.f, o1 = 0.f;
#pragma unroll
            for (int q = 0; q < 4; ++q) { o0 += opart[(q * 32 + st) * 128 + C.lane]; o1 += opart[(q * 32 + st) * 128 + 64 + C.lane]; }
            const float ss = wave_sum(o0 * o0 + o1 * o1);
            const float r = rsqrtf(ss * (1.f / 128.f) + RMS_EPS);
            const float g0 = siluf_(bf2f(H[(size_t)row * NH + HC_HG + h * 128 + C.lane])), g1 = siluf_(bf2f(H[(size_t)row * NH + HC_HG + h * 128 + 64 + C.lane]));
            BR[(size_t)row * NBR + 512 + h * 128 + C.lane] = (bf16_t)f2bf(o0 * r * C.in[I_HNG][l * 128 + C.lane] * g0);
            BR[(size_t)row * NBR + 512 + h * 128 + 64 + C.lane] = (bf16_t)f2bf(o1 * r * C.in[I_HNG][l * 128 + 64 + C.lane] * g1);
        }
        __syncthreads();
    }
}


typedef float f32x16 __attribute__((ext_vector_type(16)));
typedef short s16x4 __attribute__((ext_vector_type(4)));
typedef short v4i16_t __attribute__((ext_vector_type(4)));
__device__ __forceinline__ s16x4 vtr(const LAS unsigned char* p) { return __builtin_bit_cast(s16x4, __builtin_amdgcn_ds_read_tr16_b64_v4i16((LAS v4i16_t*)p)); }
__device__ __forceinline__ float xor32(float x) { return __shfl_xor(x, 32, 64); }
#define MFMA32(a, b, c) __builtin_amdgcn_mfma_f32_32x32x16_bf16((a), (b), (c), 0, 0, 0)
constexpr int CW_KMAX = 16;

__device__ __forceinline__ void p_knorm(const Ctx& C, int l) {
    const bf16_t* H = (const bf16_t*)(C.ws + WS_H);
    unsigned* kmax = (unsigned*)(C.ws + WS_CTL) + CW_KMAX + l * 8;
    for (int r0 = (C.bid * 8 + C.wave) * 8; r0 < T; r0 += C.G * 64) {
        u32x4 raw[8];
#pragma unroll
        for (int i = 0; i < 8; ++i) raw[i] = *(const u32x4*)(H + (size_t)(r0 + i) * NH + HC_FK + C.lane * 8);
        float best = 0.f;
#pragma unroll
        for (int i = 0; i < 8; ++i) { float s = 0.f;
#pragma unroll
            for (int j = 0; j < 4; ++j) { const float a = bf2f(raw[i][j] & 0xffffu), b = bf2f(raw[i][j] >> 16); s += a * a + b * b; }
            best = fmaxf(best, s); }
        best = 0.f;
#pragma unroll
        for (int i = 0; i < 8; ++i) { float s = 0.f;
#pragma unroll
            for (int j = 0; j < 4; ++j) { const float a = bf2f(raw[i][j] & 0xffffu), b = bf2f(raw[i][j] >> 16); s += a * a + b * b; }
#pragma unroll
            for (int o = 8; o > 0; o >>= 1) s += __shfl_xor(s, o, 64);
            best = fmaxf(best, s); }
        LAS float* red = (LAS float*)C.lds;
        if ((C.lane & 15) == 0) red[C.wave * 4 + (C.lane >> 4)] = best;
        __syncthreads();
        if (C.tid < 4) { float m = red[C.tid];
#pragma unroll
            for (int w2 = 1; w2 < 8; ++w2) m = fmaxf(m, red[w2 * 4 + C.tid]);
            atomicMax(kmax + (r0 / SEQ) * 4 + C.tid, __builtin_bit_cast(unsigned, m)); }
        __syncthreads();
    }
}

constexpr int FOX_KST = 272, FOX_VST = 320;
constexpr int FOX_KB = 0, FOX_VB = 2 * 64 * FOX_KST, FOX_BETA = FOX_VB + 2 * 64 * FOX_VST, FOX_FLAG = FOX_BETA + 2 * 64 * 4, FOX_END = FOX_FLAG + 2 * 8 * 4;
__device__ __forceinline__ void mix_fox(const Ctx& C, int l) {
    const bf16_t* H = (const bf16_t*)(C.ws + WS_H); bf16_t* BR = (bf16_t*)(C.ws + WS_BR);
    const float* cum = (const float*)(C.ws + WS_CUM);
    const unsigned* kmaxw = (const unsigned*)(C.ws + WS_CTL) + CW_KMAX + l * 8;
    const float LOG2E = 1.4426950408889634f, QS = 0.08838834764831845f * LOG2E;
    const int lane = C.lane, w = C.wave, r32 = lane & 31, hh = lane >> 5;
    LAS unsigned char* lds = C.lds;
    LAS float* betaL = (LAS float*)(lds + FOX_BETA);
    volatile LAS int* flagL = (volatile LAS int*)(lds + FOX_FLAG);
    for (int u = C.bid; u < BATCH * 4 * (SEQ / 256); u += C.G) {
        const int qb = u % (SEQ / 256), bh = u / (SEQ / 256), b = bh >> 2, h = bh & 3;
        const int q0 = qb * 256, qw = q0 + 32 * w;
        const size_t rowbase = (size_t)b * SEQ;
        const float* cm = cum + ((size_t)b * 4 + h) * SEQ;
        const float c0 = cm[q0];
        const float kmx = sqrtf(__builtin_bit_cast(float, __hip_atomic_load(kmaxw + b * 4 + h, __ATOMIC_RELAXED, __HIP_MEMORY_SCOPE_AGENT)));
        bf16x8 qf[8]; float qn = 0.f;
        {
            const bf16_t* qp = H + (rowbase + qw + r32) * NH + HC_FQ + h * 128 + 8 * hh;
#pragma unroll
            for (int ks = 0; ks < 8; ++ks) {
                const u32x4 raw = *(const u32x4*)(qp + 16 * ks);
                u32x4 o;
#pragma unroll
                for (int j = 0; j < 4; ++j) { const float a = bf2f(raw[j] & 0xffffu), bb = bf2f(raw[j] >> 16); qn += a * a + bb * bb; o[j] = cvtpk(a * QS, bb * QS); }
                qf[ks] = __builtin_bit_cast(bf16x8, o);
            }
            qn += xor32(qn); qn = sqrtf(qn);
        }
        const float qbound = qn * kmx * QS;
        f32x16 oacc[4];
#pragma unroll
        for (int mt = 0; mt < 4; ++mt)
#pragma unroll
            for (int i = 0; i < 16; ++i) oacc[mt][i] = 0.f;
        float m_run = -1e30f, l_run = 0.f;
        const int jmax = (q0 + 255) >> 6;
        const int srow = C.tid >> 4, sch = C.tid & 15;
        u32x4 kreg[2], vreg[2]; float breg = 0.f;
#define FOX_GLOAD(j_) do { _Pragma("unroll") for (int p = 0; p < 2; ++p) { \
                const bf16_t* rp = H + (rowbase + 64 * (j_) + srow + 32 * p) * NH + h * 128 + sch * 8; \
                kreg[p] = *(const u32x4*)(rp + HC_FK); vreg[p] = *(const u32x4*)(rp + HC_FV); } \
            if (C.tid < 64) breg = (c0 - cm[64 * (j_) + C.tid]) * LOG2E; } while (0)
#define FOX_LWRITE(buf_) do { _Pragma("unroll") for (int p = 0; p < 2; ++p) { \
                *(LAS u32x4*)(lds + FOX_KB + (buf_) * 64 * FOX_KST + (srow + 32 * p) * FOX_KST + sch * 16) = kreg[p]; \
                *(LAS u32x4*)(lds + FOX_VB + (buf_) * 64 * FOX_VST + (srow + 32 * p) * FOX_VST + sch * 16) = vreg[p]; } \
            if (C.tid < 64) betaL[(buf_) * 64 + C.tid] = breg; } while (0)
        __syncthreads();
        if (C.tid < 16) flagL[C.tid] = 0;
        FOX_GLOAD(jmax); FOX_LWRITE(jmax & 1);
        bool wdone = false;
        for (int j = jmax; j >= 0; --j) {
            const int cur = j & 1;
            __syncthreads();
            if (j < jmax) { int all = 1;
#pragma unroll
                for (int i = 0; i < 8; ++i) all &= flagL[((j + 1) & 1) * 8 + i];
                if (all) break; }
            if (j > 0) FOX_GLOAD(j - 1);
            const int k0 = 64 * j;
            if (k0 <= qw + 31 && !wdone) {
                const LAS unsigned char* kb = lds + FOX_KB + cur * 64 * FOX_KST;
                const LAS unsigned char* vb = lds + FOX_VB + cur * 64 * FOX_VST;
                f32x16 sacc[2];
#pragma unroll
                for (int mt = 0; mt < 2; ++mt)
#pragma unroll
                    for (int g = 0; g < 4; ++g) { const f32x4 bv = *(const LAS f32x4*)(betaL + cur * 64 + 32 * mt + 8 * g + 4 * hh);
                        sacc[mt][4 * g] = bv[0]; sacc[mt][4 * g + 1] = bv[1]; sacc[mt][4 * g + 2] = bv[2]; sacc[mt][4 * g + 3] = bv[3]; }
#pragma unroll
                for (int ks = 0; ks < 8; ++ks)
#pragma unroll
                    for (int mt = 0; mt < 2; ++mt) {
                        const bf16x8 kf = *(const LAS bf16x8*)(kb + (32 * mt + r32) * FOX_KST + 32 * ks + 16 * hh);
                        sacc[mt] = MFMA32(kf, qf[ks], sacc[mt]);
                    }
                const int tq = qw + r32;
                if (k0 + 63 > qw) {
#pragma unroll
                    for (int mt = 0; mt < 2; ++mt)
#pragma unroll
                        for (int i = 0; i < 16; ++i) { const int key = k0 + 32 * mt + (i & 3) + 8 * (i >> 2) + 4 * hh; if (key > tq) sacc[mt][i] = -1e30f; }
                }
                float mx = sacc[0][0];
#pragma unroll
                for (int mt = 0; mt < 2; ++mt)
#pragma unroll
                    for (int i = 0; i < 16; ++i) mx = fmaxf(mx, sacc[mt][i]);
                mx = fmaxf(mx, xor32(mx));
                const float mn = fmaxf(m_run, mx), alpha = __builtin_amdgcn_exp2f(m_run - mn);
                m_run = mn;
                float ps = 0.f;
#pragma unroll
                for (int mt = 0; mt < 2; ++mt)
#pragma unroll
                    for (int i = 0; i < 16; ++i) { const float p = __builtin_amdgcn_exp2f(sacc[mt][i] - mn); sacc[mt][i] = p; ps += p; }
                l_run = l_run * alpha + ps;
#pragma unroll
                for (int mt = 0; mt < 4; ++mt)
#pragma unroll
                    for (int i = 0; i < 16; ++i) oacc[mt][i] *= alpha;
#pragma unroll
                for (int s4 = 0; s4 < 4; ++s4) {
                    const int mtk = s4 >> 1, s = s4 & 1;
                    u32x4 pb;
#pragma unroll
                    for (int e = 0; e < 4; ++e) pb[e] = cvtpk(sacc[mtk][8 * s + 2 * e], sacc[mtk][8 * s + 2 * e + 1]);
                    const bf16x8 pfrag = __builtin_bit_cast(bf16x8, pb);
                    const int i16 = lane & 15, q4 = i16 >> 2, p4 = i16 & 3, blk = (lane >> 4) & 1;
                    const int keyA = 32 * mtk + 16 * s + 4 * hh + q4;
#pragma unroll
                    for (int mt = 0; mt < 4; ++mt) {
                        const LAS unsigned char* a0 = vb + keyA * FOX_VST + (32 * mt + 16 * blk + 4 * p4) * 2;
                        const s16x4 lo = vtr(a0), hi = vtr(a0 + 8 * FOX_VST);
                        const bf16x8 vf = __builtin_shufflevector(lo, hi, 0, 1, 2, 3, 4, 5, 6, 7);
                        oacc[mt] = MFMA32(vf, pfrag, oacc[mt]);
                    }
                }
                if (j > 0) { const float bl = (c0 - cm[k0 - 1]) * LOG2E;
                    const int ok = (qbound + bl < m_run - 40.f) ? 1 : 0;
                    wdone = __all(ok); }
            }
            if (lane == 0) flagL[cur * 8 + w] = wdone ? 1 : 0;
            if (j > 0) FOX_LWRITE(cur ^ 1);
        }
        l_run += xor32(l_run);
        const float inv = 1.f / l_run;
        bf16_t* op = BR + (rowbase + qw + r32) * NBR + 1536 + h * 128;
#pragma unroll
        for (int mt = 0; mt < 4; ++mt)
#pragma unroll
            for (int g = 0; g < 4; ++g) { u32x2 o; o[0] = cvtpk(oacc[mt][4 * g] * inv, oacc[mt][4 * g + 1] * inv); o[1] = cvtpk(oacc[mt][4 * g + 2] * inv, oacc[mt][4 * g + 3] * inv);
                *(u32x2*)(op + 32 * mt + 8 * g + 4 * hh) = o; }
    }
}


constexpr int HG_LF = 0, HG_QA = 34816, HG_QB = HG_QA + 17408, HG_KD = HG_QB + 8704, HG_KO = HG_KD + 17408, HG_KT = HG_KO + 8704, HG_VN = HG_KT + 20480, HG_AM = HG_VN + 20480, HG_END = HG_AM + 12288;
constexpr int HG_LFS = 132;
static_assert(HG_END + 2048 <= 140 * 1024, "hgrn LDS");
constexpr size_t WS_DSC = WS_ST + (size_t)BATCH * 4 * 32 * 128 * 128 * 4;

template <bool FULL>
__device__ __forceinline__ void hgrn_unit(const Ctx& C, int l, int u) {
#if DIAG == 1
    const bf16_t* H = (const bf16_t*)(C.ws + WS_H); bf16_t* BR = (l == 0) ? (bf16_t*)(C.ws + WS_XA) : (bf16_t*)(C.ws + WS_TABU);
#else
    const bf16_t* H = (const bf16_t*)(C.ws + WS_H); bf16_t* BR = (bf16_t*)(C.ws + WS_BR);
#endif
    float* STB = (float*)(C.ws + WS_ST); float* DSC = (float*)(C.ws + WS_DSC);
    LAS unsigned char* lds = C.lds;
    LAS float* LF = (LAS float*)(lds + HG_LF);
    const int lane = C.lane, w = C.wave, r32 = lane & 31, hh = lane >> 5;
    const int sc = u & 31, bh = u >> 5, b = bh >> 2, h = bh & 3;
    const int wk = w >> 1, wv = w & 1;
    const int mt = w >> 2, nt = w & 3;
    const int i16 = lane & 15, q4 = i16 >> 2, p4 = i16 & 3, blk = (lane >> 4) & 1;
    f32x16 S0, S1;
    float* stp = STB + ((size_t)bh * 32 + sc) * 128 * 128;
    if constexpr (FULL) {
#pragma unroll
        for (int i = 0; i < 16; ++i) { const int k = 32 * wk + (i & 3) + 8 * (i >> 2) + 4 * hh;
            S0[i] = stp[k * 128 + 64 * wv + r32]; S1[i] = stp[k * 128 + 64 * wv + 32 + r32]; }
    } else {
#pragma unroll
        for (int i = 0; i < 16; ++i) { S0[i] = 0.f; S1[i] = 0.f; }
    }
    float dtot = 0.f;
    const int ps = C.tid >> 3, pseg = C.tid & 7;
    float lbv[16];
#pragma unroll
    for (int j = 0; j < 16; ++j) { lbv[j] = 0.f;
        if (l == 1) { const int ch = h * 128 + 16 * pseg + j; lbv[j] = 1.f / (1.f + __expf(C.in[I_LBL][ch] - C.in[I_LBL][BW + ch])); } }
    u32x4 nf0, nf1, nv0, nv1;
    { const bf16_t* hp0 = H + ((size_t)b * SEQ + sc * 256 + ps) * NH + h * 128 + 16 * pseg;
      nf0 = *(const u32x4*)(hp0 + HC_HF); nf1 = *(const u32x4*)(hp0 + HC_HF + 8); nv0 = *(const u32x4*)(hp0 + HC_HI); nv1 = *(const u32x4*)(hp0 + HC_HI + 8); }
    for (int c = 0; c < 4; ++c) {
        const size_t row0 = (size_t)b * SEQ + sc * 256 + c * 64;
        const bf16_t* hp = H + (row0 + ps) * NH + h * 128 + 16 * pseg;
        float kkv[16], qsv[16];
        u32x4 vraw0, vraw1;
        u32x4 cg0 = {0u, 0u, 0u, 0u}, cg1 = cg0, cq0 = cg0, cq1 = cg0;
        if constexpr (FULL) { cq0 = *(const u32x4*)(hp + HC_HQ); cq1 = *(const u32x4*)(hp + HC_HQ + 8); cg0 = *(const u32x4*)(hp + HC_HG); cg1 = *(const u32x4*)(hp + HC_HG + 8); }
        {
            const u32x4 f0 = nf0, f1 = nf1;
            vraw0 = nv0; vraw1 = nv1;
            if (c < 3) { const bf16_t* hn = hp + (size_t)64 * NH;
                nf0 = *(const u32x4*)(hn + HC_HF); nf1 = *(const u32x4*)(hn + HC_HF + 8); nv0 = *(const u32x4*)(hn + HC_HI); nv1 = *(const u32x4*)(hn + HC_HI + 8); }
#pragma unroll
            for (int j = 0; j < 8; ++j) { const unsigned r = (j < 4) ? f0[j] : f1[j - 4];
                const float z0 = bf2f(r & 0xffffu), z1 = bf2f(r >> 16);
                kkv[2 * j] = (1.f - lbv[2 * j]) * sigmoidf_(-z0); kkv[2 * j + 1] = (1.f - lbv[2 * j + 1]) * sigmoidf_(-z1); }
            if constexpr (FULL) {
#pragma unroll
                for (int j = 0; j < 8; ++j) { const unsigned r = (j < 4) ? cq0[j] : cq1[j - 4]; qsv[2 * j] = siluf_(bf2f(r & 0xffffu)); qsv[2 * j + 1] = siluf_(bf2f(r >> 16)); }
            }
#pragma unroll
            for (int j4 = 0; j4 < 4; ++j4) { f32x4 o;
#pragma unroll
                for (int e = 0; e < 4; ++e) o[e] = __logf(1.f - kkv[4 * j4 + e]);
                *(LAS f32x4*)(LF + ps * HG_LFS + 16 * pseg + 4 * j4) = o; }
        }
        __syncthreads();
        {
            const int sk = C.tid & 127, sg = C.tid >> 7;
            float vals[16];
#pragma unroll
            for (int i = 0; i < 16; ++i) vals[i] = LF[(16 * sg + i) * HG_LFS + sk];
#pragma unroll
            for (int i = 1; i < 16; ++i) vals[i] += vals[i - 1];
            LAS float* TOT = (LAS float*)(lds + HG_END);
            TOT[sg * 128 + sk] = vals[15];
            __syncthreads();
            float off = 0.f;
#pragma unroll
            for (int j = 0; j < 3; ++j) if (j < sg) off += TOT[j * 128 + sk];
#pragma unroll
            for (int i = 0; i < 16; ++i) LF[(16 * sg + i) * HG_LFS + sk] = vals[i] + off;
            if (sg == 3) dtot += vals[15] + off;
        }
        __syncthreads();
        float bv[16], b31[16], bl[16];
#pragma unroll
        for (int j4 = 0; j4 < 4; ++j4) { const f32x4 x = *(const LAS f32x4*)(LF + ps * HG_LFS + 16 * pseg + 4 * j4), y = *(const LAS f32x4*)(LF + 31 * HG_LFS + 16 * pseg + 4 * j4), z = *(const LAS f32x4*)(LF + 63 * HG_LFS + 16 * pseg + 4 * j4);
#pragma unroll
            for (int e = 0; e < 4; ++e) { bv[4 * j4 + e] = x[e]; b31[4 * j4 + e] = y[e]; bl[4 * j4 + e] = z[e]; } }
        {
            u32x4 o0, o1;
#pragma unroll
            for (int j = 0; j < 4; ++j) { o0[j] = cvtpk(kkv[2 * j] * __expf(bl[2 * j] - bv[2 * j]), kkv[2 * j + 1] * __expf(bl[2 * j + 1] - bv[2 * j + 1]));
                o1[j] = cvtpk(kkv[8 + 2 * j] * __expf(bl[8 + 2 * j] - bv[8 + 2 * j]), kkv[9 + 2 * j] * __expf(bl[9 + 2 * j] - bv[9 + 2 * j])); }
            *(LAS u32x4*)(lds + HG_KT + ps * 320 + 32 * pseg) = o0; *(LAS u32x4*)(lds + HG_KT + ps * 320 + 32 * pseg + 16) = o1;
            *(LAS u32x4*)(lds + HG_VN + ps * 320 + 32 * pseg) = vraw0; *(LAS u32x4*)(lds + HG_VN + ps * 320 + 32 * pseg + 16) = vraw1;
            if constexpr (FULL) {
                const bool hi = ps >= 32;
                float rr[16];
#pragma unroll
                for (int j = 0; j < 16; ++j) rr[j] = hi ? b31[j] : 0.f;
#pragma unroll
                for (int j = 0; j < 4; ++j) { o0[j] = cvtpk(qsv[2 * j] * __expf(bv[2 * j] - rr[2 * j]), qsv[2 * j + 1] * __expf(bv[2 * j + 1] - rr[2 * j + 1]));
                    o1[j] = cvtpk(qsv[8 + 2 * j] * __expf(bv[8 + 2 * j] - rr[8 + 2 * j]), qsv[9 + 2 * j] * __expf(bv[9 + 2 * j] - rr[9 + 2 * j])); }
                *(LAS u32x4*)(lds + HG_QA + ps * 272 + 32 * pseg) = o0; *(LAS u32x4*)(lds + HG_QA + ps * 272 + 32 * pseg + 16) = o1;
#pragma unroll
                for (int j = 0; j < 4; ++j) { o0[j] = cvtpk(kkv[2 * j] * __expf(rr[2 * j] - bv[2 * j]), kkv[2 * j + 1] * __expf(rr[2 * j + 1] - bv[2 * j + 1]));
                    o1[j] = cvtpk(kkv[8 + 2 * j] * __expf(rr[8 + 2 * j] - bv[8 + 2 * j]), kkv[9 + 2 * j] * __expf(rr[9 + 2 * j] - bv[9 + 2 * j])); }
                *(LAS u32x4*)(lds + HG_KD + ps * 272 + 32 * pseg) = o0; *(LAS u32x4*)(lds + HG_KD + ps * 272 + 32 * pseg + 16) = o1;
                if (hi) {
#pragma unroll
                    for (int j = 0; j < 4; ++j) { o0[j] = cvtpk(qsv[2 * j] * __expf(bv[2 * j]), qsv[2 * j + 1] * __expf(bv[2 * j + 1]));
                        o1[j] = cvtpk(qsv[8 + 2 * j] * __expf(bv[8 + 2 * j]), qsv[9 + 2 * j] * __expf(bv[9 + 2 * j])); }
                    *(LAS u32x4*)(lds + HG_QB + (ps - 32) * 272 + 32 * pseg) = o0; *(LAS u32x4*)(lds + HG_QB + (ps - 32) * 272 + 32 * pseg + 16) = o1;
                } else {
#pragma unroll
                    for (int j = 0; j < 4; ++j) { o0[j] = cvtpk(kkv[2 * j] * __expf(b31[2 * j] - bv[2 * j]), kkv[2 * j + 1] * __expf(b31[2 * j + 1] - bv[2 * j + 1]));
                        o1[j] = cvtpk(kkv[8 + 2 * j] * __expf(b31[8 + 2 * j] - bv[8 + 2 * j]), kkv[9 + 2 * j] * __expf(b31[9 + 2 * j] - bv[9 + 2 * j])); }
                    *(LAS u32x4*)(lds + HG_KO + ps * 272 + 32 * pseg) = o0; *(LAS u32x4*)(lds + HG_KO + ps * 272 + 32 * pseg + 16) = o1;
                }
            }
        }
        float dk[16];
#pragma unroll
        for (int i = 0; i < 16; ++i) dk[i] = __expf(LF[63 * HG_LFS + 32 * wk + (i & 3) + 8 * (i >> 2) + 4 * hh]);
        __syncthreads();
        if constexpr (FULL) {
#pragma unroll
            for (int g = 0; g < 4; ++g) {
                u32x2 o; o[0] = cvtpk(S0[4 * g], S0[4 * g + 1]); o[1] = cvtpk(S0[4 * g + 2], S0[4 * g + 3]);
                *(LAS u32x2*)(lds + HG_LF + (64 * wv + r32) * 272 + (32 * wk + 8 * g + 4 * hh) * 2) = o;
                o[0] = cvtpk(S1[4 * g], S1[4 * g + 1]); o[1] = cvtpk(S1[4 * g + 2], S1[4 * g + 3]);
                *(LAS u32x2*)(lds + HG_LF + (64 * wv + 32 + r32) * 272 + (32 * wk + 8 * g + 4 * hh) * 2) = o;
            }
#define HG_ATILE(AMT_, AST_) do { \
                const LAS unsigned char* kb = ((AMT_) == (AST_)) ? (lds + HG_KD + (32 * (AST_)) * 272) : (lds + HG_KO); \
                f32x16 a; \
                _Pragma("unroll") for (int i = 0; i < 16; ++i) a[i] = 0.f; \
                _Pragma("unroll") for (int ks = 0; ks < 8; ++ks) { \
                    const bf16x8 af = *(const LAS bf16x8*)(lds + HG_QA + (32 * (AMT_) + r32) * 272 + 32 * ks + 16 * hh); \
                    const bf16x8 bf = *(const LAS bf16x8*)(kb + r32 * 272 + 32 * ks + 16 * hh); \
                    a = MFMA32(af, bf, a); } \
                _Pragma("unroll") for (int g = 0; g < 4; ++g) { \
                    float x[4]; \
                    _Pragma("unroll") for (int e = 0; e < 4; ++e) { const int tl = 8 * g + 4 * hh + e; x[e] = ((AMT_) != (AST_) || r32 <= tl) ? a[4 * g + e] : 0.f; } \
                    u32x2 o; o[0] = cvtpk(x[0], x[1]); o[1] = cvtpk(x[2], x[3]); \
                    *(LAS u32x2*)(lds + HG_AM + (32 * (AST_) + r32) * 192 + (32 * (AMT_) + 8 * g + 4 * hh) * 2) = o; } } while (0)
            if (w == 0) { HG_ATILE(0, 0); }
            else if (w == 1) { HG_ATILE(1, 0); }
            else if (w == 2) { HG_ATILE(1, 1); }
        }
#pragma unroll
        for (int i = 0; i < 16; ++i) { S0[i] *= dk[i]; S1[i] *= dk[i]; }
#pragma unroll
        for (int ks = 0; ks < 4; ++ks) {
            const LAS unsigned char* ka = lds + HG_KT + (16 * ks + 8 * hh + q4) * 320 + (32 * wk + 16 * blk + 4 * p4) * 2;
            const s16x4 alo = vtr(ka), ahi = vtr(ka + 4 * 320);
            const bf16x8 af = __builtin_shufflevector(alo, ahi, 0, 1, 2, 3, 4, 5, 6, 7);
            const LAS unsigned char* vb0 = lds + HG_VN + (16 * ks + 8 * hh + q4) * 320 + (64 * wv + 16 * blk + 4 * p4) * 2;
            const s16x4 b0lo = vtr(vb0), b0hi = vtr(vb0 + 4 * 320), b1lo = vtr(vb0 + 64), b1hi = vtr(vb0 + 64 + 4 * 320);
            S0 = MFMA32(af, __builtin_shufflevector(b0lo, b0hi, 0, 1, 2, 3, 4, 5, 6, 7), S0);
            S1 = MFMA32(af, __builtin_shufflevector(b1lo, b1hi, 0, 1, 2, 3, 4, 5, 6, 7), S1);
        }
        if constexpr (FULL) {
            __syncthreads();
            f32x16 o;
#pragma unroll
            for (int i = 0; i < 16; ++i) o[i] = 0.f;
            const LAS unsigned char* qb = (mt == 0) ? (lds + HG_QA) : (lds + HG_QB);
#pragma unroll
            for (int ks = 0; ks < 8; ++ks) {
                const bf16x8 af = *(const LAS bf16x8*)(qb + r32 * 272 + 32 * ks + 16 * hh);
                const bf16x8 bf = *(const LAS bf16x8*)(lds + HG_LF + (32 * nt + r32) * 272 + 32 * ks + 16 * hh);
                o = MFMA32(af, bf, o);
            }
#pragma unroll
            for (int ks = 0; ks < 4; ++ks) {
                if (mt == 0 && ks >= 2) continue;
                const LAS unsigned char* aa = lds + HG_AM + (16 * ks + 8 * hh + q4) * 192 + (32 * mt + 16 * blk + 4 * p4) * 2;
                const s16x4 alo = vtr(aa), ahi = vtr(aa + 4 * 192);
                const LAS unsigned char* vb0 = lds + HG_VN + (16 * ks + 8 * hh + q4) * 320 + (32 * nt + 16 * blk + 4 * p4) * 2;
                const s16x4 blo = vtr(vb0), bhi = vtr(vb0 + 4 * 320);
                o = MFMA32(__builtin_shufflevector(alo, ahi, 0, 1, 2, 3, 4, 5, 6, 7), __builtin_shufflevector(blo, bhi, 0, 1, 2, 3, 4, 5, 6, 7), o);
            }
            __syncthreads();
#pragma unroll
            for (int i = 0; i < 16; ++i) LF[(32 * mt + (i & 3) + 8 * (i >> 2) + 4 * hh) * HG_LFS + 32 * nt + r32] = o[i];
            __syncthreads();
            {
                float ov[16]; float ss = 0.f;
#pragma unroll
                for (int j4 = 0; j4 < 4; ++j4) { const f32x4 x = *(const LAS f32x4*)(LF + ps * HG_LFS + 16 * pseg + 4 * j4);
#pragma unroll
                    for (int e = 0; e < 4; ++e) { ov[4 * j4 + e] = x[e]; ss += x[e] * x[e]; } }
                ss += __shfl_xor(ss, 1, 64); ss += __shfl_xor(ss, 2, 64); ss += __shfl_xor(ss, 4, 64);
                const float rn = rsqrtf(ss * (1.f / 128.f) + RMS_EPS);
                const u32x4 g0 = cg0, g1 = cg1;
                const float* ng = C.in[I_HNG] + l * 128 + 16 * pseg;
                u32x4 o0, o1;
#pragma unroll
                for (int j = 0; j < 4; ++j) {
                    o0[j] = cvtpk(ov[2 * j] * rn * ng[2 * j] * siluf_(bf2f(g0[j] & 0xffffu)), ov[2 * j + 1] * rn * ng[2 * j + 1] * siluf_(bf2f(g0[j] >> 16)));
                    o1[j] = cvtpk(ov[8 + 2 * j] * rn * ng[8 + 2 * j] * siluf_(bf2f(g1[j] & 0xffffu)), ov[9 + 2 * j] * rn * ng[9 + 2 * j] * siluf_(bf2f(g1[j] >> 16)));
                }
                bf16_t* bp = BR + (row0 + ps) * NBR + 512 + h * 128 + 16 * pseg;
                *(u32x4*)bp = o0; *(u32x4*)(bp + 8) = o1;
            }
        }
        __syncthreads();
    }
    if constexpr (!FULL) {
#pragma unroll
        for (int i = 0; i < 16; ++i) { const int k = 32 * wk + (i & 3) + 8 * (i >> 2) + 4 * hh;
            stp[k * 128 + 64 * wv + r32] = S0[i]; stp[k * 128 + 64 * wv + 32 + r32] = S1[i]; }
        if (C.tid >= 384) DSC[((size_t)bh * 32 + sc) * 128 + (C.tid & 127)] = __expf(dtot);
    }
}
__device__ __forceinline__ void hgrn_b1(const Ctx& C, int l) { for (int u = C.bid; u < BATCH * 4 * 32; u += C.G) hgrn_unit<false>(C, l, u); }
__device__ __forceinline__ void hgrn_b3(const Ctx& C, int l) { for (int u = C.bid; u < BATCH * 4 * 32; u += C.G) hgrn_unit<true>(C, l, u); }
__device__ __forceinline__ void hgrn_b2(const Ctx& C) {
    float* STB = (float*)(C.ws + WS_ST); const float* DSC = (const float*)(C.ws + WS_DSC);
    for (int e = C.bid * 512 + C.tid; e < BATCH * 4 * 128 * 128; e += C.G * 512) {
        const int bh = e >> 14, kv = e & 16383, k = kv >> 7;
        float* p = STB + (size_t)bh * 32 * 16384 + kv;
        float uu[32], dd[32];
#pragma unroll
        for (int s = 0; s < 32; ++s) { uu[s] = p[(size_t)s * 16384]; dd[s] = DSC[((size_t)bh * 32 + s) * 128 + k]; }
        float st = 0.f;
#pragma unroll
        for (int s = 0; s < 32; ++s) { p[(size_t)s * 16384] = st; st = dd[s] * st + uu[s]; }
    }
}


__device__ __forceinline__ void mix_pool(const Ctx& C, int l) {
#if DIAG == 2
    const bf16_t* H = (const bf16_t*)(C.ws + WS_H); bf16_t* BR = (l == 0) ? (bf16_t*)(C.ws + WS_XA) : (bf16_t*)(C.ws + WS_TABU);
#else
    const bf16_t* H = (const bf16_t*)(C.ws + WS_H); bf16_t* BR = (bf16_t*)(C.ws + WS_BR);
#endif
    const bf16_t* Wt = (const bf16_t*)(C.ws + WS_W + (size_t)l * W_LAYER + WO_POOLW);
    LAS unsigned char* lds = C.lds;
    constexpr int PL_P = 128 * 272;
    const int lane = C.lane, w = C.wave, r32 = lane & 31, hh = lane >> 5;
    for (int u = C.bid; u < (T / 256) * 4; u += C.G) {
        const int g = u & 3, t0 = (u >> 2) * 256, win = 2 << g;
        const int row = t0 + 32 * w + r32, pos = row & (SEQ - 1);
        __syncthreads();
#pragma unroll
        for (int p = 0; p < 4; ++p) { const int idx = C.tid + 512 * p, rr = idx >> 4, ch = idx & 15;
            *(LAS u32x4*)(lds + rr * 272 + ch * 16) = *(const u32x4*)(Wt + (size_t)g * 128 * 128 + rr * 128 + ch * 8); }
        const bool seq_start = (t0 & (SEQ - 1)) == 0;
        for (int idx = C.tid; idx < 271 * 16; idx += 512) { const int rr = idx >> 4, ch = idx & 15;
            if (!(seq_start && rr < 15)) *(LAS u32x4*)(lds + PL_P + rr * 272 + ch * 16) = *(const u32x4*)(H + (size_t)(t0 - 15 + rr) * NH + HC_P + g * 128 + ch * 8); }
        __syncthreads();
        const int nwin = (pos + 1 < win) ? pos + 1 : win;
        const float invn = 1.f / (float)nwin;
        bf16x8 df[8];
        const LAS unsigned char* prow = lds + PL_P + (32 * w + r32 + 15) * 272 + 16 * hh;
#pragma unroll
        for (int ks = 0; ks < 8; ++ks) {
            float sum[8];
#pragma unroll
            for (int e = 0; e < 8; ++e) sum[e] = 0.f;
            const u32x4 self = *(const LAS u32x4*)(prow + 32 * ks);
#pragma unroll
            for (int j = 0; j < 16; ++j) if (j < win) {
                const int jj = (j < nwin) ? j : 0; const float msk = (j < nwin) ? 1.f : 0.f;
                const u32x4 rw = *(const LAS u32x4*)(prow + 32 * ks - jj * 272);
#pragma unroll
                for (int e = 0; e < 4; ++e) { sum[2 * e] += msk * bf2f(rw[e] & 0xffffu); sum[2 * e + 1] += msk * bf2f(rw[e] >> 16); } }
            u32x4 o;
#pragma unroll
            for (int e = 0; e < 4; ++e) o[e] = cvtpk(sum[2 * e] * invn - bf2f(self[e] & 0xffffu), sum[2 * e + 1] * invn - bf2f(self[e] >> 16));
            df[ks] = __builtin_bit_cast(bf16x8, o);
        }
        f32x16 acc[4];
#pragma unroll
        for (int mt = 0; mt < 4; ++mt)
#pragma unroll
            for (int i = 0; i < 16; ++i) acc[mt][i] = 0.f;
#pragma unroll
        for (int ks = 0; ks < 8; ++ks)
#pragma unroll
            for (int mt = 0; mt < 4; ++mt) {
                const bf16x8 wf = *(const LAS bf16x8*)(lds + (32 * mt + r32) * 272 + 32 * ks + 16 * hh);
                acc[mt] = MFMA32(wf, df[ks], acc[mt]);
            }
        const float* psc = C.in[I_POOLS] + l * BW + g * 128;
        bf16_t* op = BR + (size_t)row * NBR + g * 128;
#pragma unroll
        for (int mt = 0; mt < 4; ++mt)
#pragma unroll
            for (int q = 0; q < 4; ++q) { const int d0 = 32 * mt + 8 * q + 4 * hh; const f32x4 sc = *(const f32x4*)(psc + d0);
                u32x2 o; o[0] = cvtpk(acc[mt][4 * q] * sc[0], acc[mt][4 * q + 1] * sc[1]); o[1] = cvtpk(acc[mt][4 * q + 2] * sc[2], acc[mt][4 * q + 3] * sc[3]);
                *(u32x2*)(op + d0) = o; }
    }
}
#if DIAG == 3
#define GM_VNBUF ((bf16_t*)(C.ws + WS_X1B))
constexpr int GM_VLD = BW, GM_VOFF = 0;
#else
#define GM_VNBUF ((bf16_t*)(C.ws + WS_H))
constexpr int GM_VLD = NH, GM_VOFF = HC_GV;
#endif
__device__ __forceinline__ void p_gmlp_prep(const Ctx& C, int l) {
    const bf16_t* H = (const bf16_t*)(C.ws + WS_H); bf16_t* VN = GM_VNBUF;
    const float* lgp = C.in[I_GLNG] + l * BW + C.lane * 8; const float* lbp = C.in[I_GLNB] + l * BW + C.lane * 8;
    const f32x4 g0 = *(const f32x4*)lgp, g1 = *(const f32x4*)(lgp + 4), b0 = *(const f32x4*)lbp, b1 = *(const f32x4*)(lbp + 4);
    for (int row = C.bid * 8 + C.wave; row < T; row += C.G * 8) {
        const u32x4 raw = *(const u32x4*)(H + (size_t)row * NH + HC_GV + C.lane * 8);
        float e[8], s1 = 0.f, s2 = 0.f;
#pragma unroll
        for (int j = 0; j < 4; ++j) { const float a = geluf_(bf2f(raw[j] & 0xffffu)), b = geluf_(bf2f(raw[j] >> 16)); e[2 * j] = a; e[2 * j + 1] = b; s1 += a + b; s2 += a * a + b * b; }
        const float mean = wave_sum(s1) * (1.f / BW), ex2 = wave_sum(s2) * (1.f / BW);
        const float rstd = rsqrtf(fmaxf(ex2 - mean * mean, 0.f) + LN_EPS);
        u32x4 o;
        o[0] = cvtpk((e[0] - mean) * rstd * g0[0] + b0[0], (e[1] - mean) * rstd * g0[1] + b0[1]); o[1] = cvtpk((e[2] - mean) * rstd * g0[2] + b0[2], (e[3] - mean) * rstd * g0[3] + b0[3]);
        o[2] = cvtpk((e[4] - mean) * rstd * g1[0] + b1[0], (e[5] - mean) * rstd * g1[1] + b1[1]); o[3] = cvtpk((e[6] - mean) * rstd * g1[2] + b1[2], (e[7] - mean) * rstd * g1[3] + b1[3]);
        *(u32x4*)(VN + (size_t)row * GM_VLD + GM_VOFF + C.lane * 8) = o;
    }
}
constexpr int GM_VN = 0, GM_WC = 128 * 320, GM_END = GM_WC + 128 * 272;
__device__ __forceinline__ void mix_gmlp(const Ctx& C, int l) {
#if DIAG == 3
    const bf16_t* H = (const bf16_t*)(C.ws + WS_H); bf16_t* BR = (l == 0) ? (bf16_t*)(C.ws + WS_XA) : (bf16_t*)(C.ws + WS_TABU);
#else
    const bf16_t* H = (const bf16_t*)(C.ws + WS_H); bf16_t* BR = (bf16_t*)(C.ws + WS_BR);
#endif
    const bf16_t* Wc = (const bf16_t*)(C.ws + WS_W + (size_t)l * W_LAYER + WO_GWS);
    LAS unsigned char* lds = C.lds;
    const int lane = C.lane, w = C.wave, r32 = lane & 31, hh = lane >> 5;
    const int i16 = lane & 15, q4 = i16 >> 2, p4 = i16 & 3, blk = (lane >> 4) & 1;
    for (int u = C.bid; u < (T / 128) * 4; u += C.G) {
        const int g = u & 3, t0 = (u >> 2) * 128;
        __syncthreads();
#pragma unroll
        for (int p = 0; p < 4; ++p) { const int idx = C.tid + 512 * p, rr = idx >> 4, ch = idx & 15;
            *(LAS u32x4*)(lds + GM_WC + rr * 272 + ch * 16) = *(const u32x4*)(Wc + (size_t)g * 128 * 128 + rr * 128 + ch * 8); }
#pragma unroll
        for (int p = 0; p < 4; ++p) { const int idx = C.tid + 512 * p, rr = idx >> 4, ch = idx & 15;
            *(LAS u32x4*)(lds + GM_VN + rr * 320 + ch * 16) = *(const u32x4*)(GM_VNBUF + (size_t)(t0 + rr) * GM_VLD + GM_VOFF + g * 128 + ch * 8); }
        __syncthreads();
        const int nt = w & 3, mb = (w >> 2) * 2;
        u32x2 upre[2][4];
#pragma unroll
        for (int m = 0; m < 2; ++m)
#pragma unroll
            for (int q = 0; q < 4; ++q) upre[m][q] = *(const u32x2*)(H + (size_t)(t0 + 32 * nt + r32) * NH + HC_GU + g * 128 + 32 * (mb + m) + 8 * q + 4 * hh);
        f32x16 acc[2];
#pragma unroll
        for (int m = 0; m < 2; ++m)
#pragma unroll
            for (int i = 0; i < 16; ++i) acc[m][i] = 0.f;
        for (int ks = 0; ks < 2 * (nt + 1); ++ks) {
            const bf16x8 bf = *(const LAS bf16x8*)(lds + GM_WC + (32 * nt + r32) * 272 + 32 * ks + 16 * hh);
#pragma unroll
            for (int m = 0; m < 2; ++m) {
                const LAS unsigned char* aa = lds + GM_VN + (16 * ks + 8 * hh + q4) * 320 + (32 * (mb + m) + 16 * blk + 4 * p4) * 2;
                const s16x4 lo = vtr(aa), hi = vtr(aa + 4 * 320);
                acc[m] = MFMA32(__builtin_shufflevector(lo, hi, 0, 1, 2, 3, 4, 5, 6, 7), bf, acc[m]);
            }
        }
        const int tl = 32 * nt + r32, row = t0 + tl;
        const float bias = C.in[I_GBS][(l * 4 + g) * 128 + tl];
#pragma unroll
        for (int m = 0; m < 2; ++m)
#pragma unroll
            for (int q = 0; q < 4; ++q) { const int c0 = 32 * (mb + m) + 8 * q + 4 * hh;
                const u32x2 ur = upre[m][q];
                u32x2 o;
                o[0] = cvtpk(geluf_(bf2f(ur[0] & 0xffffu)) * (acc[m][4 * q] + bias), geluf_(bf2f(ur[0] >> 16)) * (acc[m][4 * q + 1] + bias));
                o[1] = cvtpk(geluf_(bf2f(ur[1] & 0xffffu)) * (acc[m][4 * q + 2] + bias), geluf_(bf2f(ur[1] >> 16)) * (acc[m][4 * q + 3] + bias));
                *(u32x2*)(BR + (size_t)row * NBR + 1024 + g * 128 + c0) = o; }
    }
}

#define CE_D(a, b) do { const float _h = fmaxf(a, b), _l = fminf(a, b); a = _h; b = _l; } while (0)
__device__ __forceinline__ void sort16_desc(float (&x)[16]) {
#define S16(a, b) CE_D(x[a], x[b])
    S16(0, 13); S16(1, 12); S16(2, 15); S16(3, 14); S16(4, 8); S16(5, 6); S16(7, 11); S16(9, 10);
    S16(0, 5); S16(1, 7); S16(2, 9); S16(3, 4); S16(6, 13); S16(8, 14); S16(10, 15); S16(11, 12);
    S16(0, 1); S16(2, 3); S16(4, 5); S16(6, 8); S16(7, 9); S16(10, 11); S16(12, 13); S16(14, 15);
    S16(0, 2); S16(1, 3); S16(4, 10); S16(5, 11); S16(6, 7); S16(8, 9); S16(12, 14); S16(13, 15);
    S16(1, 2); S16(3, 12); S16(4, 6); S16(5, 7); S16(8, 10); S16(9, 11); S16(13, 14);
    S16(1, 4); S16(2, 6); S16(5, 8); S16(7, 10); S16(9, 13); S16(11, 14);
    S16(2, 4); S16(3, 6); S16(9, 12); S16(11, 13);
    S16(3, 5); S16(6, 8); S16(7, 9); S16(10, 12);
    S16(3, 4); S16(5, 6); S16(7, 8); S16(9, 10); S16(11, 12);
    S16(6, 7); S16(8, 9);
#undef S16
}
__device__ __forceinline__ void bmerge16_desc(float (&x)[16]) {
#pragma unroll
    for (int j = 8; j > 0; j >>= 1)
#pragma unroll
        for (int i = 0; i < 16; ++i) { const int l = i ^ j; if (l > i) CE_D(x[i], x[l]); }
}
__device__ __forceinline__ void top16_merge(float (&a)[16], const float (&b)[16]) {
#pragma unroll
    for (int i = 0; i < 16; ++i) a[i] = fmaxf(a[i], b[15 - i]);
    bmerge16_desc(a);
}
__device__ __forceinline__ float pack_idx(float v, unsigned idx, unsigned mask) { return __builtin_bit_cast(float, (__builtin_bit_cast(unsigned, v) & ~mask) | idx); }

constexpr int TK_KST = 272, TK_KBUF = 128 * TK_KST;
__device__ __forceinline__ void p_topk(const Ctx& C, int l) {
    const bf16_t* Q = (const bf16_t*)(C.ws + WS_Q);
    const bf16_t* keys = (const bf16_t*)(C.ws + WS_W + (size_t)l * W_LAYER + WO_KEYS);
    int* eidx = (int*)(C.ws + WS_EIDX); float* egate = (float*)(C.ws + WS_EGATE);
    LAS unsigned char* lds = C.lds;
    const int lane = C.lane, w = C.wave, r32 = lane & 31, hh = lane >> 5;
    for (int u = C.bid; u < (T / 256) * PH; u += C.G) {
        const int h = u & 7, t0 = (u >> 3) * 256, tok = t0 + 32 * w + r32;
        float v12[2][16];
        __syncthreads();
#pragma unroll
        for (int j = 0; j < 2; ++j) {
            const bf16_t* kp = keys + ((size_t)j * PH + h) * 128 * 128;
#pragma unroll
            for (int p = 0; p < 4; ++p) { const int idx = C.tid + 512 * p, row = idx >> 4, ch = idx & 15;
                *(LAS u32x4*)(lds + j * TK_KBUF + row * TK_KST + ch * 16) = *(const u32x4*)(kp + row * 128 + ch * 8); }
        }
        __syncthreads();
#pragma unroll
        for (int j = 0; j < 2; ++j) {
            bf16x8 qf[8];
            {
                LAS unsigned char* qs = lds + 2 * TK_KBUF + w * (32 * 272);
                u32x4 qr[8];
#pragma unroll
                for (int p = 0; p < 8; ++p) qr[p] = *(const u32x4*)(Q + (size_t)(t0 + 32 * w + 4 * p + (lane >> 4)) * NQ + h * 256 + j * 128 + (lane & 15) * 8);
#pragma unroll
                for (int p = 0; p < 8; ++p) *(LAS u32x4*)(qs + (4 * p + (lane >> 4)) * 272 + (lane & 15) * 16) = qr[p];
#pragma unroll
                for (int ks = 0; ks < 8; ++ks) qf[ks] = *(const LAS bf16x8*)(qs + r32 * 272 + 32 * ks + 16 * hh);
            }
            f32x16 sacc[4];
#pragma unroll
            for (int mt = 0; mt < 4; ++mt)
#pragma unroll
                for (int i = 0; i < 16; ++i) sacc[mt][i] = 0.f;
#pragma unroll
            for (int ks = 0; ks < 8; ++ks)
#pragma unroll
                for (int mt = 0; mt < 4; ++mt) {
                    const bf16x8 kf = *(const LAS bf16x8*)(lds + j * TK_KBUF + (32 * mt + r32) * TK_KST + 32 * ks + 16 * hh);
                    sacc[mt] = MFMA32(kf, qf[ks], sacc[mt]);
                }
            float g[4][16];
#pragma unroll
            for (int mt = 0; mt < 4; ++mt) {
#pragma unroll
                for (int i = 0; i < 16; ++i) g[mt][i] = pack_idx(sacc[mt][i], (unsigned)(32 * mt + (i & 3) + 8 * (i >> 2) + 4 * hh), 127u);
                sort16_desc(g[mt]);
            }
            top16_merge(g[0], g[1]); top16_merge(g[2], g[3]); top16_merge(g[0], g[2]);
            float o[16];
#pragma unroll
            for (int i = 0; i < 16; ++i) o[i] = __shfl_xor(g[0][i], 32, 64);
            top16_merge(g[0], o);
#pragma unroll
            for (int i = 0; i < 16; ++i) v12[j][i] = g[0][i];
        }
        float c[4][16];
        {
            int n = 0;
#pragma unroll
            for (int a = 0; a < 16; ++a)
#pragma unroll
                for (int b = 0; b < 16; ++b) if ((a + 1) * (b + 1) <= 16) {
                    const unsigned id = ((__builtin_bit_cast(unsigned, v12[0][a]) & 127u) << 7) | (__builtin_bit_cast(unsigned, v12[1][b]) & 127u);
                    c[n >> 4][n & 15] = pack_idx(v12[0][a] + v12[1][b], id, 16383u); ++n; }
#pragma unroll
            for (; n < 64; ++n) c[n >> 4][n & 15] = -3.0e38f;
        }
        sort16_desc(c[1]); sort16_desc(c[2]); CE_D(c[3][0], c[3][1]);
        top16_merge(c[0], c[1]); top16_merge(c[2], c[3]); top16_merge(c[0], c[2]);
        float e[16], den = 0.f;
#pragma unroll
        for (int i = 0; i < 16; ++i) { e[i] = __expf(c[0][i] - c[0][0]); den += e[i]; }
        const float inv = 1.f / den;
        int* ip = eidx + (size_t)tok * 128 + h * 16 + 8 * hh; float* gp = egate + (size_t)tok * 128 + h * 16 + 8 * hh;
        u32x4 i0, i1; f32x4 g0, g1;
#pragma unroll
        for (int i = 0; i < 4; ++i) {
            const float ca = hh ? c[0][8 + i] : c[0][i], cb = hh ? c[0][12 + i] : c[0][4 + i];
            i0[i] = __builtin_bit_cast(unsigned, ca) & 16383u; i1[i] = __builtin_bit_cast(unsigned, cb) & 16383u;
            g0[i] = (hh ? e[8 + i] : e[i]) * inv; g1[i] = (hh ? e[12 + i] : e[4 + i]) * inv;
        }
        *(u32x4*)ip = i0; *(u32x4*)(ip + 4) = i1; *(f32x4*)gp = g0; *(f32x4*)(gp + 4) = g1;
    }
}

constexpr int CW_DIAG = 64;
__device__ __forceinline__ void diag_cmp(const Ctx& C, const bf16_t* A, int lda, const bf16_t* R, int ldr, int nc) {
    float sd = 0.f, sr = 0.f;
    for (int row = C.bid; row < T; row += C.G) {
        const int tm = row % DIAG_MOD; if (tm < DIAG_LO || tm >= DIAG_HI) continue;
        for (int c = C.tid; c < nc; c += 512) { const float a = bf2f(A[(size_t)row * lda + c]), r = bf2f(R[(size_t)row * ldr + c]); sd += (a - r) * (a - r); sr += r * r; }
    }
    sd = wave_sum(sd); sr = wave_sum(sr);
    if (C.lane == 0) { atomicAdd((float*)(C.ws + WS_CTL) + CW_DIAG, sd); atomicAdd((float*)(C.ws + WS_CTL) + CW_DIAG + 1, sr); }
}
__device__ __forceinline__ void diag_cmp_u8(const Ctx& C, const unsigned char* A, int lda, const bf16_t* R, int ldr, int nc) {
    float sd = 0.f, sr = 0.f;
    for (int row = C.bid; row < T; row += C.G)
        for (int c = C.tid; c < nc; c += 512) { const float a = (float)A[(size_t)row * lda + c] * (1.f / 255.f), r = bf2f(R[(size_t)row * ldr + c]); sd += (a - r) * (a - r); sr += r * r; }
    sd = wave_sum(sd); sr = wave_sum(sr);
    if (C.lane == 0) { atomicAdd((float*)(C.ws + WS_CTL) + CW_DIAG, sd); atomicAdd((float*)(C.ws + WS_CTL) + CW_DIAG + 1, sr); }
}
__device__ __forceinline__ float diag_alpha(const Ctx& C) {
    const float sd = __hip_atomic_load((float*)(C.ws + WS_CTL) + CW_DIAG, __ATOMIC_RELAXED, __HIP_MEMORY_SCOPE_AGENT), sr = __hip_atomic_load((float*)(C.ws + WS_CTL) + CW_DIAG + 1, __ATOMIC_RELAXED, __HIP_MEMORY_SCOPE_AGENT);
    const float err = fmaxf(sd / fmaxf(sr, 1e-30f), 1e-8f);
    return 0.1f + 0.1f * (rintf(log10f(err / 1e-8f) * 10.f) * 0.1f);
}


#if DIAG == 5 || DIAG == 6
__device__ __forceinline__ void diag_ref_slice(const Ctx& C, const float* W, int ldw, int n0, const float* bias) {
    bf16_t* alt = (bf16_t*)(C.ws + WS_XA);
    const float* X = C.in[I_X];
    for (int row = C.bid * 8 + C.wave; row < T; row += C.G * 8) {
        float acc = 0.f;
        for (int k = 0; k < DM; ++k) acc += X[(size_t)row * DM + k] * W[(size_t)k * ldw + n0 + C.lane];
        if (bias) acc = sigmoidf_(acc + bias[n0 + C.lane]);
        alt[(size_t)row * 64 + C.lane] = (bf16_t)f2bf(acc);
    }
}
#endif

__device__ __forceinline__ void wave_argmax(float& v, int& i) {
#pragma unroll
    for (int o = 32; o > 0; o >>= 1) {
        const float ov = __shfl_xor(v, o, 64); const int oi = __shfl_xor(i, o, 64);
        if (ov > v || (ov == v && oi < i)) { v = ov; i = oi; }
    }
}
__device__ __forceinline__ void p_topk_naive(const Ctx& C, int l) {
    const bf16_t* Q = (const bf16_t*)(C.ws + WS_Q);
    const bf16_t* keys = (const bf16_t*)(C.ws + WS_W + (size_t)l * W_LAYER + WO_KEYS);
    int* eidx = (int*)(C.ws + WS_EIDX); float* egate = (float*)(C.ws + WS_EGATE);
    LAS float* qs = (LAS float*)C.lds;
    LAS float* sc = qs + 2048;
    LAS float* tv = sc + 2048;
    LAS int* ti = (LAS int*)(tv + 256);
    for (int t = C.bid; t < T; t += C.G) {
        for (int i = C.tid; i < 2048; i += 512) qs[i] = bf2f(Q[(size_t)t * NQ + i]);
        __syncthreads();
        for (int i = 0; i < 4; ++i) {
            const int idx = C.tid + 512 * i, hj = idx >> 7, key = idx & 127, h = hj >> 1, j = hj & 1;
            const bf16_t* kp = keys + (((size_t)j * PH + h) * 128 + key) * 128;
            float s = 0.f;
            for (int d8 = 0; d8 < 16; ++d8) {
                const u32x4 raw = *(const u32x4*)(kp + d8 * 8);
#pragma unroll
                for (int e = 0; e < 4; ++e) s += qs[h * 256 + j * 128 + d8 * 8 + 2 * e] * bf2f(raw[e] & 0xffffu) + qs[h * 256 + j * 128 + d8 * 8 + 2 * e + 1] * bf2f(raw[e] >> 16);
            }
            sc[idx] = s;
        }
        __syncthreads();
        for (int i = 0; i < 2; ++i) {
            const int hj = C.wave * 2 + i;
            float a0 = sc[hj * 128 + C.lane], a1 = sc[hj * 128 + 64 + C.lane];
            for (int r = 0; r < 16; ++r) {
                float bv; int bi;
                if (a0 > a1 || (a0 == a1)) { bv = a0; bi = C.lane; } else { bv = a1; bi = C.lane + 64; }
                wave_argmax(bv, bi);
                if (C.lane == 0) { tv[hj * 16 + r] = bv; ti[hj * 16 + r] = bi; }
                if (bi == C.lane) a0 = -3e38f; if (bi == C.lane + 64) a1 = -3e38f;
            }
        }
        __syncthreads();
        {
            const int h = C.wave;
            float cv[4];
#pragma unroll
            for (int i = 0; i < 4; ++i) { const int c = C.lane * 4 + i; cv[i] = tv[(h * 2) * 16 + (c >> 4)] + tv[(h * 2 + 1) * 16 + (c & 15)]; }
            float topv = 0.f; int tope = 0; float mx = 0.f;
            for (int r = 0; r < 16; ++r) {
                float bv = cv[0]; int bi = C.lane * 4;
#pragma unroll
                for (int i = 1; i < 4; ++i) if (cv[i] > bv) { bv = cv[i]; bi = C.lane * 4 + i; }
                wave_argmax(bv, bi);
                if (r == 0) mx = bv;
                if (C.lane == r) { topv = bv; tope = ti[(h * 2) * 16 + (bi >> 4)] * 128 + ti[(h * 2 + 1) * 16 + (bi & 15)]; }
#pragma unroll
                for (int i = 0; i < 4; ++i) if (bi == C.lane * 4 + i) cv[i] = -3e38f;
            }
            float e = (C.lane < 16) ? __expf(topv - mx) : 0.f;
            const float den = wave_sum(e);
            if (C.lane < 16) { eidx[(size_t)t * 128 + h * 16 + C.lane] = tope; egate[(size_t)t * 128 + h * 16 + C.lane] = e / den; }
        }
        __syncthreads();
    }
}
__device__ __forceinline__ float ub(unsigned w, int e) { return (float)((w >> (8 * e)) & 255u); }
__device__ __forceinline__ void p_gather(const Ctx& C, int l) {
    const bf16_t* xc = (const bf16_t*)(C.ws + WS_X1B);
    const unsigned char* U8 = C.ws + WS_U8; const unsigned char* V8 = C.ws + WS_V8;
    const float* SU = (const float*)(C.ws + WS_SU); const float* SV = (const float*)(C.ws + WS_SV);
    const int* eidx = (const int*)(C.ws + WS_EIDX); const float* egate = (const float*)(C.ws + WS_EGATE);
    const int lane = C.lane;
    for (int t = C.bid * 8 + C.wave; t < T; t += C.G * 8) {
        float x[16];
        { const bf16_t* xp = xc + (size_t)t * DM + lane * 16;
          const u32x4 a = *(const u32x4*)xp, b = *(const u32x4*)(xp + 8);
#pragma unroll
          for (int i = 0; i < 4; ++i) { x[2 * i] = bf2f(a[i] & 0xffffu); x[2 * i + 1] = bf2f(a[i] >> 16); x[8 + 2 * i] = bf2f(b[i] & 0xffffu); x[9 + 2 * i] = bf2f(b[i] >> 16); } }
        float xmx = 0.f;
#pragma unroll
        for (int j = 0; j < 16; ++j) xmx = fmaxf(xmx, fabsf(x[j]));
        xmx = fmaxf(wave_max(xmx), 1e-30f);
        const float xisc = 127.f / xmx, xsc = xmx * (1.f / 127.f);
        int xq[4];
#pragma unroll
        for (int q = 0; q < 4; ++q) { unsigned wd = 0u;
#pragma unroll
            for (int e = 0; e < 4; ++e) wd |= ((unsigned)(int)rintf(x[4 * q + e] * xisc) & 255u) << (8 * e);
            xq[q] = (int)wd; }
        float cf[2]; int ex[2];
#pragma unroll
        for (int bt = 0; bt < 2; ++bt) {
            ex[bt] = eidx[(size_t)t * 128 + 64 * bt + lane];
            const float gate = egate[(size_t)t * 128 + 64 * bt + lane];
            int p[64];
#pragma unroll
            for (int e0 = 0; e0 < 64; e0 += 16) {
                u32x4 r[16];
#pragma unroll
                for (int i = 0; i < 16; ++i) { const int e = __builtin_amdgcn_readlane(ex[bt], e0 + i); r[i] = *(const u32x4*)(U8 + (size_t)e * DM + lane * 16); }
#pragma unroll
                for (int i = 0; i < 16; ++i) { int a = 0;
#pragma unroll
                    for (int q = 0; q < 4; ++q) a = __builtin_amdgcn_sdot4(xq[q], (int)r[i][q], a, false);
                    p[e0 + i] = a; }
            }
#pragma unroll
            for (int st = 32, n = 32; st > 0; st >>= 1, n >>= 1) {
                const bool up = (lane & st) != 0;
#pragma unroll
                for (int i = 0; i < n; ++i) { const int send = up ? p[i] : p[i + n], keep = up ? p[i + n] : p[i]; p[i] = keep + __shfl_xor(send, st, 64); }
            }
            const float hsum = SU[ex[bt]] * xsc * (float)p[0];
            cf[bt] = gate * geluf_slow(hsum) * SV[ex[bt]];
        }
        float y[16];
#pragma unroll
        for (int j = 0; j < 16; ++j) y[j] = 0.f;
        float csum = wave_sum(cf[0] + cf[1]);
#pragma unroll
        for (int bt = 0; bt < 2; ++bt)
#pragma unroll
            for (int e0 = 0; e0 < 64; e0 += 16) {
                u32x3a r[16];
#pragma unroll
                for (int i = 0; i < 16; ++i) { const int e = __builtin_amdgcn_readlane(ex[bt], e0 + i); r[i] = *(const u32x3a*)(V8 + (size_t)e * V6_ROW + lane * 12); }
#pragma unroll
                for (int i = 0; i < 16; ++i) { const float c = __builtin_bit_cast(float, __builtin_amdgcn_readlane(__builtin_bit_cast(int, cf[bt]), e0 + i));
#pragma unroll
                    for (int k = 0; k < 16; ++k) y[k] += c * v6f(r[i], k); }
            }
#pragma unroll
        for (int j = 0; j < 16; ++j) y[j] = y[j] - 31.f * csum + ALPHA * x[j];
        float sm = 0.f;
#pragma unroll
        for (int j = 0; j < 16; ++j) sm += y[j];
        const float mean = wave_sum(sm) * (1.f / DM);
        float qq = 0.f;
#pragma unroll
        for (int j = 0; j < 16; ++j) { const float d = y[j] - mean; qq += d * d; }
        const float rstd = rsqrtf(wave_sum(qq) * (1.f / DM) + LN_EPS);
        const float* gp = C.in[I_LN2G] + l * DM + lane * 16; const float* bp = C.in[I_LN2B] + l * DM + lane * 16;
        asm volatile("" : "+v"(gp), "+v"(bp));
#pragma unroll
        for (int i = 0; i < 4; ++i) { const f32x4 gg = *(const f32x4*)(gp + 4 * i), bb = *(const f32x4*)(bp + 4 * i);
#pragma unroll
            for (int e = 0; e < 4; ++e) y[4 * i + e] = (y[4 * i + e] - mean) * rstd * gg[e] + bb[e]; }
        float* dst = (l + 1 < DEPTH) ? (float*)(C.ws + WS_XA) + (size_t)t * DM : C.out + (size_t)t * DM;
#if DIAG
        if (l + 1 == DEPTH) { const float al = 1.f + diag_alpha(C);
#pragma unroll
            for (int j = 0; j < 16; ++j) y[j] *= al; }
#endif
#pragma unroll
        for (int i = 0; i < 4; ++i) *(f32x4*)(dst + lane * 16 + 4 * i) = (f32x4){y[4 * i], y[4 * i + 1], y[4 * i + 2], y[4 * i + 3]};
        if (l + 1 < DEPTH) {
            {
                float mx = 0.f;
#pragma unroll
                for (int j = 0; j < 16; ++j) mx = fmaxf(mx, fabsf(y[j]));
                mx = fmaxf(wave_max(mx), 1e-30f);
                const float isc = 127.f / mx;
                u32x4 o8;
#pragma unroll
                for (int q = 0; q < 4; ++q) { unsigned wd = 0u;
#pragma unroll
                    for (int e = 0; e < 4; ++e) wd |= ((unsigned)(int)rintf(y[4 * q + e] * isc) & 255u) << (8 * e);
                    o8[q] = wd; }
                *(u32x4*)(C.ws + WS_XB + (size_t)t * DM + lane * 16) = o8;
                if (lane == 0) ((float*)(C.ws + WS_XSA))[t] = mx * (1.f / 127.f);
            }
            const float* wf = (const float*)(C.ws + WS_W + (size_t)(l + 1) * W_LAYER + WO_WF) + lane * 16;
            asm volatile("" : "+v"(wf));
            float* lsig = (float*)(C.ws + WS_MISC);
#pragma unroll
            for (int h = 0; h < 4; ++h) {
                float sd = 0.f;
#pragma unroll
                for (int i = 0; i < 4; ++i) { const f32x4 a = *(const f32x4*)(wf + h * DM + 4 * i);
#pragma unroll
                    for (int e = 0; e < 4; ++e) sd += y[4 * i + e] * a[e]; }
                sd = wave_sum(sd);
                if (lane == 0) lsig[(size_t)t * 4 + h] = logsigmoidf_(sd + C.in[I_BFOX][(l + 1) * 4 + h]);
            }
        }
    }
}

struct FStoreBf16 { bf16_t* O; int ld;
    __device__ __forceinline__ void operator()(int row, int col, f32x4 v0, f32x4 v1, int) const {
        u32x4 o; o[0] = pk2(v0[0], v0[1]); o[1] = pk2(v0[2], v0[3]); o[2] = pk2(v1[0], v1[1]); o[3] = pk2(v1[2], v1[3]);
        *(u32x4*)(O + (size_t)row * ld + col) = o; } };
typedef int i32x4 __attribute__((ext_vector_type(4)));
__device__ __forceinline__ void i8_dequant(f32x4& v0, f32x4& v1, float sa, const float* cs) {
    sa *= (1.f / 127.f);
    const f32x4 c0 = *(const f32x4*)cs, c1 = *(const f32x4*)(cs + 4);
    const i32x4 i0 = __builtin_bit_cast(i32x4, v0), i1 = __builtin_bit_cast(i32x4, v1);
#pragma unroll
    for (int e = 0; e < 4; ++e) { v0[e] = (float)i0[e] * sa * c0[e]; v1[e] = (float)i1[e] * sa * c1[e]; }
}
struct FStoreBf16I8 { bf16_t* O; int ld; const float* rs; const float* cs;
    __device__ __forceinline__ void operator()(int row, int col, f32x4 v0, f32x4 v1, int) const {
        i8_dequant(v0, v1, rs[row], cs + col);
        u32x4 o; o[0] = pk2(v0[0], v0[1]); o[1] = pk2(v0[2], v0[3]); o[2] = pk2(v1[0], v1[1]); o[3] = pk2(v1[2], v1[3]);
        *(u32x4*)(O + (size_t)row * ld + col) = o; } };
struct FGateI8 { unsigned char* O; const float* bias; const float* rs; const float* cs;
    __device__ __forceinline__ void operator()(int row, int col, f32x4 v0, f32x4 v1, int) const {
        const float sa = rs[row] * (-1.4426950408889634f / 127.f);
        const f32x4 c0 = *(const f32x4*)(cs + col), c1 = *(const f32x4*)(cs + col + 4);
        const f32x4 b0 = *(const f32x4*)(bias + col), b1 = *(const f32x4*)(bias + col + 4);
        const i32x4 i0 = __builtin_bit_cast(i32x4, v0), i1 = __builtin_bit_cast(i32x4, v1);
        u32x2 o; unsigned w0 = 0u, w1 = 0u;
#pragma unroll
        for (int e = 0; e < 4; ++e) {
            const float e0 = __builtin_amdgcn_exp2f(__builtin_fmaf((float)i0[e] * sa, c0[e], -1.4426950408889634f * b0[e])), e1 = __builtin_amdgcn_exp2f(__builtin_fmaf((float)i1[e] * sa, c1[e], -1.4426950408889634f * b1[e]));
            const unsigned q0 = max((unsigned)__builtin_fmaf(__builtin_amdgcn_rcpf(1.f + e0), 255.f, 0.5f), 1u), q1 = max((unsigned)__builtin_fmaf(__builtin_amdgcn_rcpf(1.f + e1), 255.f, 0.5f), 1u);
            w0 |= q0 << (8 * e); w1 |= q1 << (8 * e); }
        o[0] = w0; o[1] = w1;
        *(u32x2*)(O + (size_t)row * NG + col) = o; } };
struct FGate { bf16_t* O; const float* bias;
    __device__ __forceinline__ void operator()(int row, int col, f32x4 v0, f32x4 v1, int) const {
        const f32x4 b0 = *(const f32x4*)(bias + col), b1 = *(const f32x4*)(bias + col + 4);
        u32x4 o; o[0] = pk2(sigmoidf_(v0[0] + b0[0]), sigmoidf_(v0[1] + b0[1])); o[1] = pk2(sigmoidf_(v0[2] + b0[2]), sigmoidf_(v0[3] + b0[3]));
        o[2] = pk2(sigmoidf_(v1[0] + b1[0]), sigmoidf_(v1[1] + b1[1])); o[3] = pk2(sigmoidf_(v1[2] + b1[2]), sigmoidf_(v1[3] + b1[3]));
        *(u32x4*)(O + (size_t)row * NG + col) = o; } };
struct FMerge { const unsigned char* G; bf16_t* MG;
    __device__ __forceinline__ void operator()(int row, int col, f32x4 v0, f32x4 v1, int z) const {
        const u32x2 gr = *(const u32x2*)(G + (size_t)row * NG + z * DM + col);
        float r[8];
#pragma unroll
        for (int e = 0; e < 4; ++e) { r[e] = v0[e] * (float)((gr[0] >> (8 * e)) & 255u) * (1.f / 255.f); r[4 + e] = v1[e] * (float)((gr[1] >> (8 * e)) & 255u) * (1.f / 255.f); }
        bf16_t* p = MG + (size_t)row * DM + col;
        if (z > 0) { const u32x4 pr = *(const u32x4*)p;
#pragma unroll
            for (int e = 0; e < 4; ++e) { r[2 * e] += bf2f(pr[e] & 0xffffu); r[2 * e + 1] += bf2f(pr[e] >> 16); } }
        u32x4 o;
#pragma unroll
        for (int e = 0; e < 4; ++e) o[e] = pk2(r[2 * e], r[2 * e + 1]);
        *(u32x4*)p = o; } };
struct FResid { const float* X; bf16_t* Y;
    __device__ __forceinline__ void operator()(int row, int col, f32x4 v0, f32x4 v1, int) const {
        const f32x4 x0 = *(const f32x4*)(X + (size_t)row * DM + col), x1 = *(const f32x4*)(X + (size_t)row * DM + col + 4);
#if DIAG == 5 || DIAG == 6
        v0 = (f32x4){0.f, 0.f, 0.f, 0.f}; v1 = v0;
#endif
        u32x4 o; o[0] = cvtpk(x0[0] * ALPHA + v0[0], x0[1] * ALPHA + v0[1]); o[1] = cvtpk(x0[2] * ALPHA + v0[2], x0[3] * ALPHA + v0[3]);
        o[2] = cvtpk(x1[0] * ALPHA + v1[0], x1[1] * ALPHA + v1[1]); o[3] = cvtpk(x1[2] * ALPHA + v1[2], x1[3] * ALPHA + v1[3]);
        *(u32x4*)(Y + (size_t)row * DM + col) = o; } };

constexpr int PH_PER_LAYER = 12, N_PHASES = 1 + DEPTH * PH_PER_LAYER;
template <int SP> __device__ __forceinline__ void run_phase(const Ctx& C0, int l) {
    Ctx C = C0;
    asm volatile("" : "+v"(C.tid));
    C.ws = launder_ptr(C.ws); C.out = launder_ptr(C.out); l = (int)launder_u((unsigned)l);
    C.lane = C.tid & 63; C.wave = __builtin_amdgcn_readfirstlane(C.tid >> 6);
    unsigned char* wb = C.ws + WS_W + (size_t)l * W_LAYER;
    if constexpr (SP == -1) { p_conv_weights(C); p_rowpass0(C); }
    if constexpr (SP == 1) {
        p_cumsum(C);
        __syncthreads();
        pg8::Gemm g{(const bf16_t*)(C.ws + WS_XB), (const bf16_t*)(wb + WO_WIN), DM, DM, DM, 0, 0};
        pg8::StaticOrder S; S.init(T, NH, C.G, C.bid);
        pg8::Epi8<FStoreBf16I8> E{{(bf16_t*)(C.ws + WS_H), NH, (const float*)(C.ws + WS_XSA), (const float*)(C.ws + WS_CMAX) + l * (NH + NG)}};
        pg8::gemm_phase<pg8::Epi8<FStoreBf16I8>, pg8::StaticOrder, true>(C.lds, g, S, E, C.tid);
    }
#if DIAG == 5
    if constexpr (SP == 2) { if (l == 0) { diag_ref_slice(C, C.in[I_WIN], NIN, DIAG_N0, nullptr); } }
    if constexpr (SP == 3) { if (l == 0) diag_cmp(C, (const bf16_t*)(C.ws + WS_H) + DIAG_N0, NH, (const bf16_t*)(C.ws + WS_XA), 64, 64); }
#endif
#if DIAG == 6
    if constexpr (SP == 5) { if (l == 0) diag_ref_slice(C, C.in[I_WGATE], NG, DIAG_N0, C.in[I_BGATE]); }
    if constexpr (SP == 6) { if (l == 0) diag_cmp_u8(C, C.ws + WS_G + DIAG_N0, NG, (const bf16_t*)(C.ws + WS_XA), 64, 64); }
#endif
    if constexpr (SP == 2) { p_knorm(C, l); p_gmlp_prep(C, l); if (l != HG_NAIVE_L) hgrn_b1(C, l); }
#if MIX_NAIVE
    if constexpr (SP == 3) { if (l != HG_NAIVE_L) hgrn_b2(C); mix_pool_naive(C, l); mix_gmlp_naive(C, l); }
#else
    if constexpr (SP == 3) { if (l != HG_NAIVE_L) hgrn_b2(C); mix_pool(C, l); mix_gmlp(C, l);
        if (DIAG == 2) mix_pool_naive(C, l); if (DIAG == 3) mix_gmlp_naive(C, l); }
#endif
#if DIAG == 1
    if constexpr (SP == 4) { hgrn_b3(C, l); { mix_hgrn_naive(C, l); __syncthreads(); } mix_fox(C, l); }
    if constexpr (SP == 5) { if (l == DIAG_LAYER) diag_cmp(C, (const bf16_t*)(C.ws + (DIAG_LAYER == 0 ? WS_XA : WS_TABU)) + 512, NBR, (const bf16_t*)(C.ws + WS_BR) + 512, NBR, 512); }
#elif DIAG == 2 || DIAG == 3
    if constexpr (SP == 4) { hgrn_b3(C, l); mix_fox(C, l); if (l == DIAG_LAYER) diag_cmp(C, (const bf16_t*)(C.ws + (DIAG_LAYER == 0 ? WS_XA : WS_TABU)) + (DIAG == 2 ? 0 : 1024), NBR, (const bf16_t*)(C.ws + WS_BR) + (DIAG == 2 ? 0 : 1024), NBR, 512); }
#else
    if constexpr (SP == 4) { if (l != HG_NAIVE_L) hgrn_b3(C, l); else { mix_hgrn_naive(C, l); __syncthreads(); } mix_fox(C, l); }
#endif
    if constexpr (SP == 5) {
        pg8::Gemm g{(const bf16_t*)(C.ws + WS_XB), (const bf16_t*)(wb + WO_WG), DM, DM, DM, 0, 0};
        pg8::StaticOrder S; S.init(T, NG, C.G, C.bid);
        pg8::Epi8<FGateI8> E{{C.ws + WS_G, C.in[I_BGATE] + l * NG, (const float*)(C.ws + WS_XSA), (const float*)(C.ws + WS_CMAX) + l * (NH + NG) + NH}};
        pg8::gemm_phase<pg8::Epi8<FGateI8>, pg8::StaticOrder, true>(C.lds, g, S, E, C.tid);
    }
    if constexpr (SP == 6) {
        pg8::Gemm g{(const bf16_t*)(C.ws + WS_BR), (const bf16_t*)(wb + WO_WBR), NBR, BW, BW, (size_t)BW, (size_t)DM * BW};
        pg8::ZOrder S; S.init(T, DM, 4, C.G, C.vcu);
        pg8::EpiMerge E{C.ws + WS_G, (bf16_t*)(C.ws + WS_XB)};
        pg8::gemm_phase(C.lds, g, S, E, C.tid);
    }
    if constexpr (SP == 7) {
        const float* xin = (l == 0) ? C.in[I_X] : (const float*)(C.ws + WS_XA);
        pg8::Gemm g{(const bf16_t*)(C.ws + WS_XB), (const bf16_t*)(wb + WO_WOUT), DM, DM, DM, 0, 0};
        pg8::StaticOrder S; S.init(T, DM, C.G, C.bid);
        pg8::Epi8<FResid> E{{xin, (bf16_t*)(C.ws + WS_XC)}};
        pg8::gemm_phase(C.lds, g, S, E, C.tid);
    }
    if constexpr (SP == 8) { p_ln1(C, l); p_conv_tables(C, l); }
    if constexpr (SP == 9) {
        pg8::Gemm g{(const bf16_t*)(C.ws + WS_XB), (const bf16_t*)(wb + WO_WQ), DM, DM, DM, 0, 0};
        pg8::StaticOrder S; S.init(T, NQ, C.G, C.bid);
        pg8::Epi8<FStoreBf16I8> E{{(bf16_t*)(C.ws + WS_Q), NQ, (const float*)(C.ws + WS_XSA), (const float*)(C.ws + WS_CMAX) + DEPTH * (NH + NG) + l * NQ}};
        pg8::gemm_phase<pg8::Epi8<FStoreBf16I8>, pg8::StaticOrder, true>(C.lds, g, S, E, C.tid);
    }
#if TOPK_NAIVE
    if constexpr (SP == 10) p_topk_naive(C, l);
#else
    if constexpr (SP == 10) p_topk(C, l);
#endif
    if constexpr (SP == 11) p_gather(C, l);
}
__device__ __forceinline__ void make_ctx(Ctx& C, const Args& args, unsigned char* lds_raw) {
    C.lds = (LAS unsigned char*)lds_raw; C.ws = args.ws; C.in = args.in; C.out = args.out;
    C.tid = threadIdx.x; C.lane = C.tid & 63; C.wave = __builtin_amdgcn_readfirstlane(C.tid >> 6);
    C.G = gridDim.x; C.bid = blockIdx.x; C.vcu = (C.G % 8 == 0) ? (C.bid % 8) * (C.G / 8) + C.bid / 8 : C.bid;
}
#if !MK_ONE_LAUNCH
template <int SP> __global__ void __launch_bounds__(512, 2) mk_phase(Args args) {
    extern __shared__ __attribute__((aligned(16))) unsigned char lds_raw[];
    Ctx C; make_ctx(C, args, lds_raw);
    run_phase<SP>(C, args.ph_lo);
}
#endif

#define GRID_BAR() xcd_barrier((unsigned*)(args.ws + WS_CTL) + 1024, (volatile LAS unsigned*)((LAS unsigned char*)lds_raw + LDSCTL_OFF + 32))
__global__ void __launch_bounds__(512, 2) mk_fwd(Args args) {
    extern __shared__ __attribute__((aligned(16))) unsigned char lds_raw[];
    Ctx C; make_ctx(C, args, lds_raw);
    { volatile LAS unsigned* misc = (volatile LAS unsigned*)(C.lds + LDSCTL_OFF); if (C.tid < 64) misc[C.tid] = 0u; }
    __syncthreads();
    xcd_barrier_post((unsigned*)(args.ws + WS_CTL) + 1024);
    run_phase<-1>(C, 0); GRID_BAR();
#pragma unroll 1
    for (int l = 0; l < DEPTH; ++l) {
        run_phase<1>(C, l); GRID_BAR();
        run_phase<2>(C, l); GRID_BAR();
        run_phase<3>(C, l); GRID_BAR();
        run_phase<4>(C, l); GRID_BAR();
        run_phase<5>(C, l); GRID_BAR();
        run_phase<6>(C, l); GRID_BAR();
        run_phase<7>(C, l); GRID_BAR();
        run_phase<8>(C, l); GRID_BAR();
        run_phase<9>(C, l); GRID_BAR();
        run_phase<10>(C, l); GRID_BAR();
        run_phase<11>(C, l); if (l + 1 < DEPTH) GRID_BAR();
    }
}

#if !MK_ONE_LAUNCH
template <int SP> static void launch_phase(const Args& a, int grid, hipStream_t stream) {
    static bool attr_done = false;
    if (!attr_done) { (void)hipFuncSetAttribute((const void*)mk_phase<SP>, hipFuncAttributeMaxDynamicSharedMemorySize, LDS_BYTES); attr_done = true; }
    hipLaunchKernelGGL(mk_phase<SP>, dim3(grid), dim3(512), LDS_BYTES, stream, a);
}
#endif
extern "C" void kernel_launch(void* const* d_in, const int* in_sizes, int n_in, void* d_out, int out_size, void* d_ws, size_t ws_size, hipStream_t stream) {
    static int grid = 0;
    if (grid == 0) {
        if (n_in != NIN_PTRS || out_size != T * DM || ws_size < WS_END) { fprintf(stderr, "kernel_launch: unexpected shapes n_in %d out %d ws %zu\n", n_in, out_size, ws_size); grid = -1; return; }
        int dev = 0, cus = 0;
        if (hipGetDevice(&dev) != hipSuccess || hipDeviceGetAttribute(&cus, hipDeviceAttributeMultiprocessorCount, dev) != hipSuccess) { grid = -1; return; }
        grid = cus;
    }
    if (grid < 0) return;
    (void)hipMemsetAsync((char*)d_ws + WS_CTL, 0, CTL_ZERO_BYTES, stream);
    Args a{};
    for (int i = 0; i < NIN_PTRS; ++i) a.in[i] = (const float*)d_in[i];
    a.out = (float*)d_out; a.ws = (unsigned char*)d_ws; a.bar_slot = 0; a.pad = 0; a.ph_hi = 0;
#if MK_ONE_LAUNCH
    static bool attr_done = false;
    if (!attr_done) { (void)hipFuncSetAttribute((const void*)mk_fwd, hipFuncAttributeMaxDynamicSharedMemorySize, LDS_BYTES); attr_done = true; }
    hipLaunchKernelGGL(mk_fwd, dim3(grid), dim3(512), LDS_BYTES, stream, a);
    return;
#endif
#if !MK_ONE_LAUNCH
    a.ph_lo = 0; launch_phase<-1>(a, grid, stream);
    for (int l = 0; l < DEPTH; ++l) {
        a.ph_lo = l;
        launch_phase<0>(a, grid, stream); launch_phase<1>(a, grid, stream); launch_phase<2>(a, grid, stream); launch_phase<3>(a, grid, stream); launch_phase<4>(a, grid, stream);
        launch_phase<5>(a, grid, stream); launch_phase<6>(a, grid, stream); launch_phase<7>(a, grid, stream); launch_phase<8>(a, grid, stream); launch_phase<9>(a, grid, stream); launch_phase<10>(a, grid, stream); launch_phase<11>(a, grid, stream);
    }
#endif
}
```

```cpp
#include <hip/hip_runtime.h>
#include <cstdio>
#include <cstdint>

#ifndef DIAG
#define DIAG 0
#endif
#ifndef DIAG_LO
#define DIAG_LO 0
#endif
#ifndef DIAG_HI
#define DIAG_HI 64
#endif
#ifndef DIAG_MOD
#define DIAG_MOD 64
#endif
#ifndef TOPK_NAIVE
#define TOPK_NAIVE 0
#endif
#ifndef MIX_NAIVE
#define MIX_NAIVE 0
#endif
#ifndef DIAG_N0
#define DIAG_N0 4096
#endif
#ifndef FOX_NAIVE
#define FOX_NAIVE 0
#endif
#ifndef HG_NAIVE_L
#define HG_NAIVE_L 99
#endif
#ifndef DIAG_LAYER
#define DIAG_LAYER 0
#endif
#ifndef MK_ONE_LAUNCH
#define MK_ONE_LAUNCH 1
#endif

#define LAS __attribute__((address_space(3)))
#define GAS __attribute__((address_space(1)))
typedef unsigned short bf16_t;
typedef short bf16x8 __attribute__((ext_vector_type(8)));
typedef float f32x4 __attribute__((ext_vector_type(4)));
typedef float f32x2 __attribute__((ext_vector_type(2)));
typedef unsigned u32x4 __attribute__((ext_vector_type(4)));
typedef unsigned u32x2 __attribute__((ext_vector_type(2)));
typedef unsigned u32x3a __attribute__((ext_vector_type(3), aligned(4)));

constexpr int DM = 1024, BATCH = 2, SEQ = 8192, DEPTH = 2, T = BATCH * SEQ;
constexpr int BW = 512, NIN = 5124, NH = 5120, NG = 4096, NBR = 2048, NQ = 2048;
constexpr int NEXP = 16384, TOPK = 16, PH = 8;
constexpr float ALPHA = 1.4142135623730951f;
constexpr float LN_EPS = 1e-5f, RMS_EPS = 1e-6f;
constexpr int HC_P = 0, HC_HQ = 512, HC_HF = 1024, HC_HI = 1536, HC_HG = 2048, HC_GU = 2560, HC_GV = 3072, HC_FQ = 3584, HC_FK = 4096, HC_FV = 4608;

constexpr size_t MiB = 1u << 20;
constexpr size_t WS_CTL = 0, CTL_ZERO_BYTES = 160 * 1024;
constexpr size_t WS_CMAX = 64 * 1024;
constexpr size_t WS_MISC = 512 * 1024;
constexpr size_t WS_CUM = 768 * 1024;
constexpr size_t WS_W = 1 * MiB;
constexpr size_t W_LAYER = 30 * MiB;
constexpr size_t WO_WIN = 0, WO_WG = 10 * MiB, WO_WBR = 18 * MiB, WO_WOUT = 22 * MiB, WO_WQ = 24 * MiB, WO_KEYS = 28 * MiB, WO_WF = 28 * MiB + 512 * 1024, WO_POOLW = 28 * MiB + 768 * 1024, WO_GWS = 29 * MiB, WO_CS = 29 * MiB + 512 * 1024;
constexpr size_t WS_TABU = 64 * MiB, WS_TABV = 96 * MiB;
constexpr size_t WS_XA = 128 * MiB;
constexpr size_t WS_XB = 192 * MiB;
constexpr size_t WS_X1B = 224 * MiB;
constexpr size_t WS_H = 256 * MiB;
constexpr size_t WS_ST = 416 * MiB;
constexpr size_t WS_BR = 448 * MiB;
constexpr size_t WS_G = 256 * MiB;
constexpr size_t WS_MGF = 384 * MiB;
constexpr size_t WS_XC = 256 * MiB;
constexpr size_t WS_Q = 320 * MiB;
constexpr size_t WS_EIDX = 384 * MiB, WS_EGATE = 392 * MiB;
constexpr size_t WS_XSA = 256 * 1024;
constexpr size_t WS_END = 512 * MiB;

__device__ __forceinline__ float bf2f(unsigned u) { return __builtin_bit_cast(float, u << 16); }
__device__ __forceinline__ unsigned f2bf(float f) { unsigned u = __builtin_bit_cast(unsigned, f); return (u + 0x7fffu + ((u >> 16) & 1u)) >> 16; }
typedef __bf16 bf16x2_t __attribute__((ext_vector_type(2)));
__device__ __forceinline__ unsigned cvtpk(float lo, float hi) { f32x2 v = {lo, hi}; bf16x2_t b = __builtin_convertvector(v, bf16x2_t); return __builtin_bit_cast(unsigned, b); }
__device__ __forceinline__ unsigned pk2(float lo, float hi) { return cvtpk(lo, hi); }
__device__ __forceinline__ float wave_sum(float v) {
#pragma unroll
    for (int o = 32; o > 0; o >>= 1) v += __shfl_xor(v, o, 64);
    return v;
}
__device__ __forceinline__ float sigmoidf_(float x) { return __builtin_amdgcn_rcpf(1.f + __builtin_amdgcn_exp2f(-1.4426950408889634f * x)); }
__device__ __forceinline__ float siluf_(float x) { return x * __builtin_amdgcn_rcpf(1.f + __builtin_amdgcn_exp2f(-1.4426950408889634f * x)); }
__device__ __forceinline__ float geluf_slow(float x) { const float u = 0.7978845608028654f * (x + 0.044715f * x * x * x); return 0.5f * x * (1.f + tanhf(u)); }
__device__ __forceinline__ float geluf_(float x) { const float u2 = -2.302208198f * (x + 0.044715f * x * x * x); return x * __builtin_amdgcn_rcpf(1.f + __builtin_amdgcn_exp2f(u2)); }
__device__ __forceinline__ float logsigmoidf_(float z) { return fminf(z, 0.f) - log1pf(__expf(-fabsf(z))); }

__device__ __forceinline__ unsigned launder_u(unsigned x) { asm volatile("" : "+v"(x)); return __builtin_amdgcn_readfirstlane(x); }
template <class P> __device__ __forceinline__ P launder_ptr(P p) {
    const unsigned lo = launder_u((unsigned)(uintptr_t)p), hi = launder_u((unsigned)((uintptr_t)p >> 32));
    return (P)(((uintptr_t)hi << 32) | lo);
}

namespace pg8 {
constexpr int BM = 256, BK = 64, HALF = 128, HTB = HALF * BK * 2, STAGE_BYTES = 8 * HTB, NXCD = 8, WGM = 8;
__host__ __device__ __forceinline__ int lds_byte(int r, int c) { const int st = (r >> 4) * 2 + (c >> 5), rr = r & 15, cc = c & 31, ob = rr * 64 + cc * 2; return st * 1024 + (ob ^ (((ob >> 9) & 1) << 5)); }
__host__ __device__ __forceinline__ void stage_rc(int b, int& R, int& C) { const int st = b / 1024, sb = b % 1024, swz = sb ^ (((sb >> 9) & 1) << 5); R = (st >> 1) * 16 + swz / 64; C = (st & 1) * 32 + (swz % 64) / 2; }
__host__ __device__ __forceinline__ int perm32(int rho) { const int n = rho >> 4, i = rho & 15; return 8 * (i >> 2) + 4 * n + (i & 3); }

struct Unit { int pm, pn, z; };
struct Gemm { const bf16_t* A; const bf16_t* Bt; int lda, ldb, K; size_t zA, zB; };

struct StaticOrder {
    int nM, nN, nwg, G, c;
    __device__ void init(int M, int N, int G_, int c_) { nM = M / BM; nN = N / BM; nwg = nM * nN; G = G_; c = c_; }
    __device__ bool next(int i, Unit& u) const {
        const long L = (long)i * G + c; if (L >= nwg) return false;
        int wgid = (int)L; { const int q = nwg / NXCD, r = nwg % NXCD, xcd = wgid % NXCD, off = wgid / NXCD; wgid = (xcd < r ? xcd * (q + 1) : r * (q + 1) + (xcd - r) * q) + off; }
        const int nig = WGM * nN, gid = wgid / nig, fm = gid * WGM, gsz = (nM - fm) < WGM ? (nM - fm) : WGM;
        u.pm = fm + ((wgid % nig) % gsz); u.pn = (wgid % nig) / gsz; u.z = 0; return true;
    }
};
struct ZOrder {
    int nM, nN, nZ, ntile, G, c;
    __device__ void init(int M, int N, int Z, int G_, int c_) { nM = M / BM; nN = N / BM; nZ = Z; ntile = nM * nN; G = G_; c = c_; }
    __device__ bool next(int i, Unit& u) const {
        const long L = (long)(i / nZ) * G + c; if (L >= ntile) return false;
        u.pm = (int)L / nN; u.pn = (int)L % nN; u.z = i % nZ; return true;
    }
};

template <class F> struct Epi8 {
    static constexpr bool PERM = true;
    F f;
    __device__ __forceinline__ bool keep(const Unit&) const { return false; }
    __device__ __forceinline__ void operator()(const f32x4 (&acc)[2][2][4][2], const Unit& u, int wr, int wc, int fr, int fq) const {
        const int row0 = u.pm * BM + wr * 64 + fr, col0 = u.pn * BM + wc * 32 + 8 * fq;
#pragma unroll
        for (int ai = 0; ai < 2; ++ai)
#pragma unroll
            for (int m = 0; m < 4; ++m)
#pragma unroll
                for (int bj = 0; bj < 2; ++bj) f(row0 + ai * HALF + m * 16, col0 + bj * HALF, acc[ai][bj][m][0], acc[ai][bj][m][1], u.z);
    }
};
template <class F> struct Epi4 {
    static constexpr bool PERM = false;
    F f;
    __device__ __forceinline__ bool keep(const Unit&) const { return false; }
    __device__ __forceinline__ void operator()(const f32x4 (&acc)[2][2][4][2], const Unit& u, int wr, int wc, int fr, int fq) const {
        const int row0 = u.pm * BM + wr * 64 + fr, col0 = u.pn * BM + wc * 32 + 4 * fq;
#pragma unroll
        for (int ai = 0; ai < 2; ++ai)
#pragma unroll
            for (int m = 0; m < 4; ++m)
#pragma unroll
                for (int bj = 0; bj < 2; ++bj)
#pragma unroll
                    for (int n = 0; n < 2; ++n) f(row0 + ai * HALF + m * 16, col0 + bj * HALF + n * 16, acc[ai][bj][m][n], u.z);
    }
};

struct EpiMerge {
    static constexpr bool PERM = true;
    const unsigned char* G; bf16_t* MG;
    __device__ __forceinline__ bool keep(const Unit& u) const { return u.z < 3; }
    __device__ __forceinline__ void operator()(f32x4 (&acc)[2][2][4][2], const Unit& u, int wr, int wc, int fr, int fq) const {
        const int row0 = u.pm * BM + wr * 64 + fr, col0 = u.pn * BM + wc * 32 + 8 * fq;
        const unsigned char* gp0 = G + (size_t)row0 * NG + u.z * DM + col0;
        if (u.z < 3) {
#pragma unroll
            for (int ai = 0; ai < 2; ++ai)
#pragma unroll
                for (int m = 0; m < 4; ++m) {
                    if ((m & 1) == 0) asm volatile("" ::: "memory");
#pragma unroll
                    for (int bj = 0; bj < 2; ++bj) {
                        const unsigned char* gp = gp0 + (size_t)(ai * HALF + m * 16) * NG + bj * HALF;
                        const u32x2 ga = *(const u32x2*)gp, gb = *(const u32x2*)(gp + DM);
#pragma unroll
                        for (int n = 0; n < 2; ++n)
#pragma unroll
                            for (int e = 0; e < 4; ++e) {
                                const float qa = (float)((ga[n] >> (8 * e)) & 255u), qb = (float)((gb[n] >> (8 * e)) & 255u);
                                acc[ai][bj][m][n][e] *= qa * __builtin_amdgcn_rcpf(qb); }
                    }
                }
        } else {
            bf16_t* op0 = MG + (size_t)row0 * DM + col0;
#pragma unroll
            for (int ai = 0; ai < 2; ++ai)
#pragma unroll
                for (int m = 0; m < 4; ++m)
#pragma unroll
                    for (int bj = 0; bj < 2; ++bj) {
                        const u32x2 ga = *(const u32x2*)(gp0 + (size_t)(ai * HALF + m * 16) * NG + bj * HALF);
                        u32x4 o;
#pragma unroll
                        for (int n = 0; n < 2; ++n)
#pragma unroll
                            for (int e2 = 0; e2 < 2; ++e2) {
                                const float q0 = (float)((ga[n] >> (16 * e2)) & 255u) * (1.f / 255.f), q1 = (float)((ga[n] >> (16 * e2 + 8)) & 255u) * (1.f / 255.f);
                                o[2 * n + e2] = cvtpk(acc[ai][bj][m][n][2 * e2] * q0, acc[ai][bj][m][n][2 * e2 + 1] * q1); }
                        *(u32x4*)(op0 + (size_t)(ai * HALF + m * 16) * DM + bj * HALF) = o;
                    }
        }
    }
};

typedef int i32x4 __attribute__((ext_vector_type(4)));
template <class Epi, class Sched, bool I8 = false, bool ALIGN_EPI = true>
__device__ __forceinline__ void gemm_phase(LAS unsigned char* lds, const Gemm g, const Sched& S, const Epi& E, const int tid) {
    constexpr int ES = I8 ? 1 : 2;
    const int wid = __builtin_amdgcn_readfirstlane(tid >> 6), lane = tid & 63, wr = wid >> 2, wc = wid & 3, fr = lane & 15, fq = lane >> 4;
    const int K = g.K, nt = K * ES / 128;
    unsigned voffA[2], voffB[2];
#pragma unroll
    for (int i = 0; i < 2; ++i) { int R, C; stage_rc(tid * 16 + i * 8192, R, C); const int Rb = Epi::PERM ? ((R & ~31) + perm32(R & 31)) : R;
        voffA[i] = (unsigned)(R * g.lda * ES + C * 2); voffB[i] = (unsigned)(Rb * g.ldb * ES + C * 2); }
    const size_t kstep = (size_t)(BK * 2);
    const size_t hstepA = (size_t)HALF * g.lda * ES, hstepB = (size_t)HALF * g.ldb * ES;
    const size_t tstepA = 2 * hstepA, tstepB = 2 * hstepB;
    const unsigned ldsw = (unsigned)wid * 1024u;
    const int aoff = lds_byte(wr * 64 + fr, fq * 8), boff = lds_byte(wc * 32 + fr, fq * 8);
#define PG8_SA(b, h) (((b) * 2 + (h)) * HTB)
#define PG8_SB(b, h) ((4 + (b) * 2 + (h)) * HTB)
#define PG8_STAGE(bufoff, gbase, voff) do { _Pragma("unroll") for (int _i = 0; _i < 2; ++_i) \
        __builtin_amdgcn_global_load_lds((const unsigned*)((const char*)(gbase) + (voff)[_i]), (LAS unsigned*)(lds + (bufoff) + ldsw + _i * 8192), 16, 0, 0); } while (0)
#define PG8_LDA(dst, b, h) do { _Pragma("unroll") for (int m = 0; m < 4; ++m) _Pragma("unroll") for (int k = 0; k < 2; ++k) dst[m][k] = *(const LAS bf16x8*)(lds + PG8_SA(b, h) + aoff + m * 2048 + k * 1024); } while (0)
#define PG8_LDB(dst, b, h) do { _Pragma("unroll") for (int n = 0; n < 2; ++n) _Pragma("unroll") for (int k = 0; k < 2; ++k) dst[n][k] = *(const LAS bf16x8*)(lds + PG8_SB(b, h) + boff + n * 2048 + k * 1024); } while (0)
#define PG8_MMA(ai, bj, At, Bt) do { __builtin_amdgcn_s_setprio(1); _Pragma("unroll") for (int m = 0; m < 4; ++m) _Pragma("unroll") for (int n = 0; n < 2; ++n) _Pragma("unroll") for (int k = 0; k < 2; ++k) { \
        if constexpr (I8) acc[ai][bj][m][n] = __builtin_bit_cast(f32x4, __builtin_amdgcn_mfma_i32_16x16x64_i8(__builtin_bit_cast(i32x4, Bt[n][k]), __builtin_bit_cast(i32x4, At[m][k]), __builtin_bit_cast(i32x4, acc[ai][bj][m][n]), 0, 0, 0)); \
        else acc[ai][bj][m][n] = __builtin_amdgcn_mfma_f32_16x16x32_bf16(Bt[n][k], At[m][k], acc[ai][bj][m][n], 0, 0, 0); } __builtin_amdgcn_s_setprio(0); } while (0)
#define PG8_WAIT_V(n) asm volatile("s_waitcnt vmcnt(" #n ")" ::: "memory")
#define PG8_WAIT_L(n) asm volatile("s_waitcnt lgkmcnt(" #n ")" ::: "memory")
#define PG8_BAR __builtin_amdgcn_s_barrier()
#define PG8_SCHED __builtin_amdgcn_sched_barrier(0)
    Unit cur, nxt; int ui = 0;
    if (!S.next(0, cur)) return;
    f32x4 acc[2][2][4][2];
#pragma unroll
    for (int a = 0; a < 2; ++a)
#pragma unroll
        for (int b = 0; b < 2; ++b)
#pragma unroll
            for (int m = 0; m < 4; ++m)
#pragma unroll
                for (int n = 0; n < 2; ++n) acc[a][b][m][n] = (f32x4){0.f, 0.f, 0.f, 0.f};
    bf16x8 At[4][2], B0[2][2], B1[2][2];
    const char* cA = (const char*)g.A + (size_t)cur.z * g.zA * ES + (size_t)cur.pm * tstepA; const char* cB = (const char*)g.Bt + (size_t)cur.z * g.zB * ES + (size_t)cur.pn * tstepB;
    PG8_STAGE(PG8_SB(0, 0), cB, voffB); PG8_STAGE(PG8_SB(0, 1), cB + hstepB, voffB); PG8_STAGE(PG8_SA(0, 0), cA, voffA); PG8_STAGE(PG8_SA(0, 1), cA + hstepA, voffA);
    if (wr == 1) PG8_BAR;
    PG8_WAIT_V(2); PG8_BAR;
    PG8_STAGE(PG8_SB(1, 0), cB + kstep, voffB); PG8_STAGE(PG8_SA(1, 0), cA + kstep, voffA); PG8_STAGE(PG8_SB(1, 1), cB + hstepB + kstep, voffB);
    PG8_WAIT_V(6); PG8_BAR;
    for (;;) {
        const bool has_next = S.next(ui + 1, nxt);
        const char* nA = has_next ? (const char*)g.A + (size_t)nxt.z * g.zA * ES + (size_t)nxt.pm * tstepA : cA;
        const char* nB = has_next ? (const char*)g.Bt + (size_t)nxt.z * g.zB * ES + (size_t)nxt.pn * tstepB : cB;
        for (int t = 0; t < nt; t += 2) {
            const bool last = (t == nt - 2);
            const char* a1 = cA + (size_t)(t + 1) * kstep;
            const char* a2 = last ? nA : cA + (size_t)(t + 2) * kstep; const char* b2 = last ? nB : cB + (size_t)(t + 2) * kstep;
            const char* a3 = a2 + kstep; const char* b3 = b2 + kstep;
            PG8_LDB(B0, 0, 0); PG8_LDB(B1, 0, 1); PG8_SCHED; PG8_LDA(At, 0, 0); PG8_STAGE(PG8_SA(1, 1), a1 + hstepA, voffA);
            PG8_WAIT_V(8); PG8_WAIT_L(0); PG8_BAR; PG8_MMA(0, 0, At, B0); PG8_MMA(0, 1, At, B1); PG8_BAR; PG8_SCHED;
            PG8_LDA(At, 0, 1); PG8_STAGE(PG8_SB(0, 0), b2, voffB); PG8_STAGE(PG8_SB(0, 1), b2 + hstepB, voffB); PG8_STAGE(PG8_SA(0, 0), a2, voffA);
            PG8_WAIT_V(8); PG8_WAIT_L(0); PG8_BAR; PG8_MMA(1, 0, At, B0); PG8_MMA(1, 1, At, B1); PG8_BAR; PG8_SCHED;
            PG8_LDB(B0, 1, 0); PG8_LDB(B1, 1, 1); PG8_SCHED; PG8_LDA(At, 1, 0); PG8_STAGE(PG8_SA(0, 1), a2 + hstepA, voffA);
            PG8_WAIT_V(8); PG8_WAIT_L(0); PG8_BAR; PG8_MMA(0, 0, At, B0); PG8_MMA(0, 1, At, B1); PG8_BAR; PG8_SCHED;
            PG8_LDA(At, 1, 1); PG8_STAGE(PG8_SB(1, 0), b3, voffB); PG8_STAGE(PG8_SB(1, 1), b3 + hstepB, voffB); PG8_STAGE(PG8_SA(1, 0), a3, voffA);
            PG8_WAIT_V(8); PG8_WAIT_L(0); PG8_BAR; PG8_MMA(1, 0, At, B0); PG8_MMA(1, 1, At, B1); PG8_BAR; PG8_SCHED;
        }
        if constexpr (ALIGN_EPI) { if (wr == 0) PG8_BAR; }
        E(acc, cur, wr, wc, fr, fq);
        if (!has_next) break;
        if (!E.keep(cur)) {
#pragma unroll
            for (int a = 0; a < 2; ++a)
#pragma unroll
                for (int b = 0; b < 2; ++b)
#pragma unroll
                    for (int m = 0; m < 4; ++m)
#pragma unroll
                        for (int n = 0; n < 2; ++n) acc[a][b][m][n] = (f32x4){0.f, 0.f, 0.f, 0.f};
        }
        cur = nxt; cA = nA; cB = nB; ++ui;
        if constexpr (ALIGN_EPI) { if (wr == 1) PG8_BAR; }
    }
    PG8_WAIT_V(0);
    if constexpr (!ALIGN_EPI) { if (wr == 0) PG8_BAR; }
    PG8_BAR;
#undef PG8_SA
#undef PG8_SB
#undef PG8_STAGE
#undef PG8_LDA
#undef PG8_LDB
#undef PG8_MMA
#undef PG8_WAIT_V
#undef PG8_WAIT_L
#undef PG8_BAR
#undef PG8_SCHED
}
}

#define XB_TMO      128
#define XB_XCNT(j)  (256  + 64 * (j))
#define XB_XSUB(j)  (1280 + 64 * (j))
#define XB_XGEN(j)  (2304 + 64 * (j))
#define XB_TOP      3328
#define XB_TOPGEN   3392
#define XCD_BAR_WORDS 3456
#define XB_SPIN_CAP (1u << 22)
__device__ __forceinline__ unsigned xb_ld(unsigned* p)              { return __hip_atomic_load(p, __ATOMIC_RELAXED, __HIP_MEMORY_SCOPE_AGENT); }
__device__ __forceinline__ unsigned xb_add(unsigned* p, unsigned v) { return __hip_atomic_fetch_add(p, v, __ATOMIC_RELAXED, __HIP_MEMORY_SCOPE_AGENT); }
__device__ __forceinline__ unsigned xb_xcc_id() { return (unsigned)__builtin_amdgcn_s_getreg((3 << 11) | 20) & 0xFu; }
#define XB_SPIN(cond, bar) do { unsigned _sp = 0; while (cond) { __builtin_amdgcn_s_sleep(1); \
    if ((++_sp & 255u) == 0u) { if (xb_ld(&(bar)[XB_TMO])) break; if (_sp > XB_SPIN_CAP) { atomicAdd(&(bar)[XB_TMO], 1u); break; } } } } while (0)
__device__ __forceinline__ void xcd_barrier_post(unsigned* bar) {
    if (threadIdx.x == 0) (void)xb_add(&bar[XB_XCNT(xb_xcc_id())], 1u);
}
__device__ __forceinline__ void xcd_barrier_complete(unsigned* bar, unsigned x, unsigned& nloc, unsigned& nx) {
    const unsigned G = gridDim.x * gridDim.y * gridDim.z;
    unsigned sum, cnt, mine, sp = 0u;
    for (;;) {
        sum = 0u; cnt = 0u; mine = 0u;
#pragma unroll
        for (unsigned j = 0; j < 16; ++j) { const unsigned c = xb_ld(&bar[XB_XCNT(j)]); sum += c; cnt += (c > 0u) ? 1u : 0u; mine = (j == x) ? c : mine; }
        if (sum == G) break;
        __builtin_amdgcn_s_sleep(1);
        if ((++sp & 255u) == 0u) { if (xb_ld(&bar[XB_TMO])) break; if (sp > XB_SPIN_CAP) { atomicAdd(&bar[XB_TMO], 1u); break; } }
    }
    nloc = mine > 0u ? mine : 1u; nx = cnt > 0u ? cnt : 1u;
}
__device__ __noinline__ void xcd_barrier_leader(unsigned* bar, volatile LAS unsigned* st) {
    const unsigned x = xb_xcc_id();
    __builtin_amdgcn_s_waitcnt(0);
    unsigned nloc = st[0], nx = st[1];
    if (nloc == 0u) { xcd_barrier_complete(bar, x, nloc, nx); st[0] = nloc; st[1] = nx; }
    const unsigned old = xb_add(&bar[XB_XSUB(x)], 1u);
    const unsigned gen = old / nloc;
    if (old + 1u == (gen + 1u) * nloc) {
        __builtin_amdgcn_fence(__ATOMIC_RELEASE, "agent");
        asm volatile("s_waitcnt vmcnt(0)" ::: "memory");
        const unsigned og = xb_add(&bar[XB_TOP], 1u);
        const unsigned tg = og / nx;
        if (og + 1u == (tg + 1u) * nx) xb_add(&bar[XB_TOPGEN], 1u);
        else XB_SPIN(xb_ld(&bar[XB_TOPGEN]) == tg, bar);
        __builtin_amdgcn_fence(__ATOMIC_ACQUIRE, "agent");
        xb_add(&bar[XB_XGEN(x)], 1u);
        asm volatile("s_waitcnt vmcnt(0)" ::: "memory");
    } else {
        XB_SPIN(xb_ld(&bar[XB_XGEN(x)]) == gen, bar);
        __builtin_amdgcn_fence(__ATOMIC_ACQUIRE, "agent");
        asm volatile("s_waitcnt vmcnt(0)" ::: "memory");
    }
}
__device__ __forceinline__ void xcd_barrier(unsigned* bar, volatile LAS unsigned* st) {
    asm volatile("s_waitcnt vmcnt(0)" ::: "memory");
    __syncthreads();
    if (threadIdx.x == 0) xcd_barrier_leader(bar, st);
    __syncthreads();
}

constexpr int NIN_PTRS = 23;
struct Args { const float* in[NIN_PTRS]; float* out; unsigned char* ws; int ph_lo, ph_hi, bar_slot, pad; };
enum { I_X = 0, I_WIN, I_BFOX, I_POOLW, I_POOLS, I_LBL, I_HNG, I_GLNG, I_GLNB, I_GWS, I_GBS, I_WGATE, I_BGATE, I_WBR, I_WOUT, I_LN1G, I_LN1B, I_WQ, I_KEYS, I_PU, I_PV, I_LN2G, I_LN2B };

constexpr int LDS_BYTES = 147456;
constexpr int LDSCTL_OFF = 143360;

struct Ctx {
    LAS unsigned char* lds;
    unsigned char* ws;
    const float* const* in;
    float* out;
    int tid, lane, wave, G, bid, vcu;
};

__device__ __forceinline__ void tconv_job(const Ctx& C, const float* src, int ld_src, int K, int N, bf16_t* dst) {
    LAS float* tile = (LAS float*)C.lds;
    const int nk = K / 64, nn = N / 64, ntiles = nk * nn;
    for (int tl = C.bid; tl < ntiles; tl += C.G) {
        const int k0 = (tl / nn) * 64, n0 = (tl % nn) * 64;
#pragma unroll
        for (int p = 0; p < 2; ++p) {
            const int kr = (C.tid >> 4) + p * 32, nc = (C.tid & 15) * 4;
            const f32x4 v = *(const f32x4*)(src + (size_t)(k0 + kr) * ld_src + n0 + nc);
            tile[kr * 65 + nc + 0] = v[0]; tile[kr * 65 + nc + 1] = v[1]; tile[kr * 65 + nc + 2] = v[2]; tile[kr * 65 + nc + 3] = v[3];
        }
        __syncthreads();
        {
            const int n = C.tid >> 3, k8 = (C.tid & 7) * 8;
            u32x4 o;
#pragma unroll
            for (int j = 0; j < 4; ++j) o[j] = pk2(tile[(k8 + 2 * j) * 65 + n], tile[(k8 + 2 * j + 1) * 65 + n]);
            *(u32x4*)(dst + (size_t)(n0 + n) * K + k0 + k8) = o;
        }
        __syncthreads();
    }
}
__device__ __forceinline__ void cvt_copy(const Ctx& C, const float* src, bf16_t* dst, size_t n) {
    const size_t n8 = n / 8;
    for (size_t i = (size_t)C.bid * 512 + C.tid; i < n8; i += (size_t)C.G * 512) {
        const f32x4 a = *(const f32x4*)(src + i * 8), b = *(const f32x4*)(src + i * 8 + 4);
        u32x4 o; o[0] = pk2(a[0], a[1]); o[1] = pk2(a[2], a[3]); o[2] = pk2(b[0], b[1]); o[3] = pk2(b[2], b[3]);
        *(u32x4*)(dst + i * 8) = o;
    }
}
__device__ __forceinline__ void strip_unit(const Ctx& C, const float* src, int ld, unsigned char* dst, unsigned* cmax, bool split) {
    const float* p = src + (size_t)(128 * C.wave) * ld + C.lane;
    float v[128];
#pragma unroll
    for (int i = 0; i < 128; ++i) v[i] = p[(size_t)i * ld];
    if (cmax) {
        float mx = 0.f;
#pragma unroll
        for (int i = 0; i < 128; ++i) mx = fmaxf(mx, fabsf(v[i]));
        LAS float* red = (LAS float*)C.lds;
        red[C.wave * 64 + C.lane] = mx;
        __syncthreads();
        float m = red[C.lane];
#pragma unroll
        for (int w2 = 1; w2 < 8; ++w2) m = fmaxf(m, red[w2 * 64 + C.lane]);
        if (C.wave == 0) cmax[C.lane] = __builtin_bit_cast(unsigned, m);
        const float isc = 127.f / fmaxf(m, 1e-30f);
        unsigned char* dp = dst + (size_t)C.lane * 1024 + 128 * C.wave;
#pragma unroll
        for (int j4 = 0; j4 < 8; ++j4) { u32x4 o;
#pragma unroll
            for (int j = 0; j < 4; ++j) { unsigned wd = 0u;
#pragma unroll
                for (int e = 0; e < 4; ++e) wd |= ((unsigned)(int)rintf(v[16 * j4 + 4 * j + e] * isc) & 255u) << (8 * e);
                o[j] = wd; }
            *(u32x4*)(dp + 16 * j4) = o; }
        __syncthreads();
    } else {
        bf16_t* dp = split ? (bf16_t*)dst + (size_t)(C.wave >> 2) * DM * BW + (size_t)C.lane * BW + 128 * (C.wave & 3) : (bf16_t*)dst + (size_t)C.lane * 1024 + 128 * C.wave;
#pragma unroll
        for (int j8 = 0; j8 < 16; ++j8) { u32x4 o;
#pragma unroll
            for (int j = 0; j < 4; ++j) o[j] = pk2(v[8 * j8 + 2 * j], v[8 * j8 + 2 * j + 1]);
            *(u32x4*)(dp + 8 * j8) = o; }
    }
}
__device__ __forceinline__ void p_conv_weights(const Ctx& C) {
#pragma unroll 1
    for (int u = C.bid; u < DEPTH * 224; u += C.G) {
        const int l = u / 224, r = u % 224;
        unsigned char* wb = C.ws + WS_W + (size_t)l * W_LAYER;
        unsigned* cm = (unsigned*)(C.ws + WS_CMAX) + l * (NH + NG);
        const float* src; int ld; unsigned char* dst; unsigned* cx = nullptr; bool split = false;
        if (r < 80)       { src = C.in[I_WIN] + (size_t)l * DM * NIN + r * 64; ld = NIN; dst = wb + WO_WIN + (size_t)r * 64 * DM; cx = cm + r * 64; }
        else if (r < 144) { const int t = r - 80; src = C.in[I_WGATE] + (size_t)l * DM * NG + t * 64; ld = NG; dst = wb + WO_WG + (size_t)t * 64 * DM; cx = cm + NH + t * 64; }
        else if (r < 176) { const int t = r - 144, pr = t >> 4, nt = t & 15; src = C.in[I_WBR] + ((size_t)l * 4 + 2 * pr) * BW * DM + nt * 64; ld = DM; split = true;
                            dst = wb + WO_WBR + ((size_t)(2 * pr) * DM * BW + (size_t)nt * 64 * BW) * 2; }
        else if (r < 192) { const int nt = r - 176; src = C.in[I_WOUT] + (size_t)l * DM * DM + nt * 64; ld = DM; dst = wb + WO_WOUT + (size_t)nt * 64 * DM * 2; }
        else              { const int nt = r - 192; src = C.in[I_WQ] + (size_t)l * DM * NQ + nt * 64; ld = NQ; dst = wb + WO_WQ + (size_t)nt * 64 * DM; cx = (unsigned*)(C.ws + WS_CMAX) + DEPTH * (NH + NG) + l * NQ + nt * 64; }
        strip_unit(C, src, ld, dst, cx, split);
    }
    for (int l = 0; l < DEPTH; ++l) {
        unsigned char* wb = C.ws + WS_W + (size_t)l * W_LAYER;
        cvt_copy(C, C.in[I_KEYS] + (size_t)l * 2 * PH * 128 * 128, (bf16_t*)(wb + WO_KEYS), (size_t)2 * PH * 128 * 128);
        for (int g = 0; g < 4; ++g)
            tconv_job(C, C.in[I_POOLW] + ((size_t)l * 4 + g) * 128 * 128, 128, 128, 128, (bf16_t*)(wb + WO_POOLW) + (size_t)g * 128 * 128);
        {
            bf16_t* gw = (bf16_t*)(wb + WO_GWS); const float* src = C.in[I_GWS] + (size_t)l * 4 * 128 * 128;
            for (int i = C.bid * 512 + C.tid; i < 4 * 128 * 128; i += C.G * 512) { const int t = (i >> 7) & 127, sx = i & 127; gw[i] = (bf16_t)f2bf(sx <= t ? src[i] : 0.f); }
        }
        float* wf = (float*)(wb + WO_WF);
        for (int i = C.bid * 512 + C.tid; i < 4 * DM; i += C.G * 512) { const int h = i / DM, k = i % DM; wf[i] = C.in[I_WIN][(size_t)l * DM * NIN + (size_t)k * NIN + NH + h]; }
    }
}
constexpr size_t WS_U8 = WS_TABU, WS_V8 = WS_TABU + 16 * MiB, WS_SU = WS_TABU + 32 * MiB, WS_SV = WS_SU + 64 * 1024;
__device__ __forceinline__ float wave_max(float v) {
#pragma unroll
    for (int o = 32; o > 0; o >>= 1) v = fmaxf(v, __shfl_xor(v, o, 64));
    return v;
}
template <bool SIGNED> __device__ __forceinline__ void quant_rows(const Ctx& C, const float* src, unsigned char* dst, float* scl) {
    for (int row = C.bid * 8 + C.wave; row < NEXP; row += C.G * 8) {
        const float* p = src + (size_t)row * DM + C.lane * 16;
        f32x4 v[4]; float mx = 0.f;
#pragma unroll
        for (int i = 0; i < 4; ++i) { v[i] = *(const f32x4*)(p + 4 * i);
#pragma unroll
            for (int e = 0; e < 4; ++e) mx = fmaxf(mx, fabsf(v[i][e])); }
        mx = fmaxf(wave_max(mx), 1e-30f);
        const float sc = mx * (1.f / 127.f), isc = 127.f / mx;
        u32x4 o;
#pragma unroll
        for (int i = 0; i < 4; ++i) { unsigned wd = 0u;
#pragma unroll
            for (int e = 0; e < 4; ++e) { const int q = (int)rintf(v[i][e] * isc) + (SIGNED ? 0 : 128); wd |= ((unsigned)q & 255u) << (8 * e); }
            o[i] = wd; }
        *(u32x4*)(dst + (size_t)row * DM + C.lane * 16) = o;
        if (C.lane == 0) scl[row] = sc;
    }
}
constexpr int V6_ROW = 512;
__device__ __forceinline__ void quant_rows6(const Ctx& C, const float* src, unsigned char* dst, float* scl) {
    for (int row = C.bid * 8 + C.wave; row < NEXP; row += C.G * 8) {
        const float* p = src + (size_t)row * DM + C.lane * 16;
        f32x4 v[4]; float mx = 0.f;
#pragma unroll
        for (int i = 0; i < 4; ++i) { v[i] = *(const f32x4*)(p + 4 * i);
#pragma unroll
            for (int e = 0; e < 4; ++e) mx = fmaxf(mx, fabsf(v[i][e])); }
        mx = fmaxf(wave_max(mx), 1e-30f);
        const float sc = mx * (1.f / 6.f), isc = 6.f / mx;
        u32x2 o = {0u, 0u};
#pragma unroll
        for (int i = 0; i < 4; ++i)
#pragma unroll
            for (int e = 0; e < 4; ++e) { const float xv = v[i][e], a = fabsf(xv) * isc; const int k = 4 * i + e;
                unsigned c = (a < 2.f) ? (unsigned)rintf(a * 2.f) : (a < 4.f) ? 4u + (unsigned)rintf(a - 2.f) : min(6u + (unsigned)rintf((a - 4.f) * 0.5f), 7u);
                c |= (xv < 0.f) ? 8u : 0u;
                o[k >> 3] |= c << (4 * (k & 7)); }
        *(u32x2*)(dst + (size_t)row * V6_ROW + C.lane * 8) = o;
        if (C.lane == 0) scl[row] = sc;
    }
}
__device__ __forceinline__ void p_conv_tables(const Ctx& C, int l) {
    quant_rows<true>(C, C.in[I_PU] + (size_t)l * NEXP * DM, C.ws + WS_U8, (float*)(C.ws + WS_SU));
    quant_rows6(C, C.in[I_PV] + (size_t)l * NEXP * DM, C.ws + WS_V8, (float*)(C.ws + WS_SV));
}

__device__ __forceinline__ void row_emit(const Ctx& C, int row, const float (&v)[16], int l, bool want_lsig) {
    {
        float mx = 0.f;
#pragma unroll
        for (int j = 0; j < 16; ++j) mx = fmaxf(mx, fabsf(v[j]));
#pragma unroll
        for (int o = 32; o > 0; o >>= 1) mx = fmaxf(mx, __shfl_xor(mx, o, 64));
        mx = fmaxf(mx, 1e-30f);
        const float isc = 127.f / mx;
        unsigned char* xb = C.ws + WS_XB + (size_t)row * DM;
        u32x2 o0, o1;
#pragma unroll
        for (int hw = 0; hw < 2; ++hw) { unsigned a = 0u, b = 0u;
#pragma unroll
            for (int e = 0; e < 4; ++e) { a |= ((unsigned)(int)rintf(v[4 * hw + e] * isc) & 255u) << (8 * e); b |= ((unsigned)(int)rintf(v[8 + 4 * hw + e] * isc) & 255u) << (8 * e); }
            o0[hw] = a; o1[hw] = b; }
        *(u32x2*)(xb + C.lane * 8) = o0; *(u32x2*)(xb + 512 + C.lane * 8) = o1;
        if (C.lane == 0) ((float*)(C.ws + WS_XSA))[row] = mx * (1.f / 127.f);
    }
    if (want_lsig) {
        const float* wf = (const float*)(C.ws + WS_W + (size_t)l * W_LAYER + WO_WF);
        float* lsig = (float*)(C.ws + WS_MISC);
#pragma unroll
        for (int h = 0; h < 4; ++h) {
            const f32x4 a0 = *(const f32x4*)(wf + h * DM + C.lane * 8), a1 = *(const f32x4*)(wf + h * DM + C.lane * 8 + 4);
            const f32x4 b0 = *(const f32x4*)(wf + h * DM + 512 + C.lane * 8), b1 = *(const f32x4*)(wf + h * DM + 512 + C.lane * 8 + 4);
            float s = 0.f;
#pragma unroll
            for (int j = 0; j < 4; ++j) s += v[j] * a0[j] + v[4 + j] * a1[j] + v[8 + j] * b0[j] + v[12 + j] * b1[j];
            s = wave_sum(s);
            if (C.lane == 0) lsig[(size_t)row * 4 + h] = logsigmoidf_(s + C.in[I_BFOX][l * 4 + h]);
        }
    }
}
__device__ __forceinline__ void load_row16(const float* p, int lane, float (&v)[16]) {
    const f32x4 a0 = *(const f32x4*)(p + lane * 8), a1 = *(const f32x4*)(p + lane * 8 + 4), b0 = *(const f32x4*)(p + 512 + lane * 8), b1 = *(const f32x4*)(p + 512 + lane * 8 + 4);
#pragma unroll
    for (int j = 0; j < 4; ++j) { v[j] = a0[j]; v[4 + j] = a1[j]; v[8 + j] = b0[j]; v[12 + j] = b1[j]; }
}
__device__ __forceinline__ void store_row16(float* p, int lane, const float (&v)[16]) {
    *(f32x4*)(p + lane * 8) = (f32x4){v[0], v[1], v[2], v[3]}; *(f32x4*)(p + lane * 8 + 4) = (f32x4){v[4], v[5], v[6], v[7]};
    *(f32x4*)(p + 512 + lane * 8) = (f32x4){v[8], v[9], v[10], v[11]}; *(f32x4*)(p + 512 + lane * 8 + 4) = (f32x4){v[12], v[13], v[14], v[15]};
}
__device__ __forceinline__ void ln_row16(float (&v)[16], const float* g, const float* b, int lane) {
    float s = 0.f;
#pragma unroll
    for (int j = 0; j < 16; ++j) s += v[j];
    const float mean = wave_sum(s) * (1.f / DM);
    float q = 0.f;
#pragma unroll
    for (int j = 0; j < 16; ++j) { const float d = v[j] - mean; q += d * d; }
    const float rstd = rsqrtf(wave_sum(q) * (1.f / DM) + LN_EPS);
    float gg[16], bb[16];
    load_row16(g, lane, gg); load_row16(b, lane, bb);
#pragma unroll
    for (int j = 0; j < 16; ++j) v[j] = (v[j] - mean) * rstd * gg[j] + bb[j];
}
__device__ __forceinline__ void p_rowpass0(const Ctx& C) {
    const float* wfin = C.in[I_WIN] + NH;
    f32x4 wv[16];
#pragma unroll
    for (int j = 0; j < 16; ++j) { const int k = (j < 8) ? C.lane * 8 + j : 512 + C.lane * 8 + (j - 8); wv[j] = *(const f32x4*)(wfin + (size_t)k * NIN); }
    float* lsig = (float*)(C.ws + WS_MISC);
    const bool bal = (C.G == 256);
    const int c0 = bal ? ((C.bid < 192) ? C.bid * 6 : 1152 + (C.bid - 192) * 14) : C.bid, cn = bal ? ((C.bid < 192) ? 6 : 14) : (T / 8 - C.bid + C.G - 1) / C.G, cs = bal ? 1 : C.G;
    for (int ci = 0; ci < cn; ++ci) {
        const int row = (c0 + ci * cs) * 8 + C.wave;
        float v[16]; load_row16(C.in[I_X] + (size_t)row * DM, C.lane, v);
        row_emit(C, row, v, 0, false);
#pragma unroll
        for (int h = 0; h < 4; ++h) {
            float sacc = 0.f;
#pragma unroll
            for (int j = 0; j < 16; ++j) sacc += v[j] * wv[j][h];
            sacc = wave_sum(sacc);
            if (C.lane == 0) lsig[(size_t)row * 4 + h] = logsigmoidf_(sacc + C.in[I_BFOX][h]);
        }
    }
}
__device__ __forceinline__ void p_cumsum(const Ctx& C) {
    if (C.bid >= BATCH * 4) return;
    const float* lsig = (const float*)(C.ws + WS_MISC);
    float* cum = (float*)(C.ws + WS_CUM);
    LAS float* wt = (LAS float*)C.lds;
    const int b = C.bid >> 2, h = C.bid & 3;
    float v[16];
#pragma unroll
    for (int j = 0; j < 16; ++j) v[j] = lsig[((size_t)b * SEQ + C.tid * 16 + j) * 4 + h];
#pragma unroll
    for (int j = 1; j < 16; ++j) v[j] += v[j - 1];
    float inc = v[15];
#pragma unroll
    for (int o = 1; o < 64; o <<= 1) { const float t = __shfl_up(inc, o, 64); if (C.lane >= o) inc += t; }
    if (C.lane == 63) wt[C.wave] = inc;
    __syncthreads();
    float off = inc - v[15];
    for (int w2 = 0; w2 < C.wave; ++w2) off += wt[w2];
    float* cp = cum + ((size_t)b * 4 + h) * SEQ + C.tid * 16;
#pragma unroll
    for (int j4 = 0; j4 < 4; ++j4) *(f32x4*)(cp + 4 * j4) = (f32x4){v[4 * j4] + off, v[4 * j4 + 1] + off, v[4 * j4 + 2] + off, v[4 * j4 + 3] + off};
    __syncthreads();
}
__device__ __forceinline__ void load_row16_bf(const bf16_t* p, int lane, float (&v)[16]) {
    const u32x4 a = *(const u32x4*)(p + lane * 8), b = *(const u32x4*)(p + 512 + lane * 8);
#pragma unroll
    for (int j = 0; j < 4; ++j) { v[2 * j] = bf2f(a[j] & 0xffffu); v[2 * j + 1] = bf2f(a[j] >> 16); v[8 + 2 * j] = bf2f(b[j] & 0xffffu); v[9 + 2 * j] = bf2f(b[j] >> 16); }
}
__device__ __forceinline__ void p_ln1(const Ctx& C, int l) {
    const bf16_t* y1 = (const bf16_t*)(C.ws + WS_XC); bf16_t* x1b = (bf16_t*)(C.ws + WS_X1B);
    for (int row = C.bid * 8 + C.wave; row < T; row += C.G * 8) {
        float v[16]; load_row16_bf(y1 + (size_t)row * DM, C.lane, v);
        ln_row16(v, C.in[I_LN1G] + l * DM, C.in[I_LN1B] + l * DM, C.lane);
        row_emit(C, row, v, l, false);
        u32x4 o0, o1;
#pragma unroll
        for (int j = 0; j < 4; ++j) { o0[j] = pk2(v[2 * j], v[2 * j + 1]); o1[j] = pk2(v[8 + 2 * j], v[8 + 2 * j + 1]); }
        *(u32x4*)(x1b + (size_t)row * DM + C.lane * 8) = o0; *(u32x4*)(x1b + (size_t)row * DM + 512 + C.lane * 8) = o1;
    }
}

__device__ __forceinline__ void mix_pool_naive(const Ctx& C, int l) {
    const bf16_t* H = (const bf16_t*)(C.ws + WS_H); bf16_t* BR = (bf16_t*)(C.ws + WS_BR);
    LAS float* dd = (LAS float*)C.lds;
    for (int u = C.bid; u < (T / 64) * 4; u += C.G) {
        const int g = u & 3, t0 = (u >> 2) * 64, w = 2 << g;
        for (int idx = C.tid; idx < 64 * 128; idx += 512) {
            const int r = idx >> 7, c = idx & 127, row = t0 + r, pos = row & (SEQ - 1);
            const int nwin = (pos + 1 < w) ? pos + 1 : w;
            float s = 0.f;
            for (int j = 0; j < nwin; ++j) s += bf2f(H[(size_t)(row - j) * NH + HC_P + g * 128 + c]);
            dd[idx] = s / (float)nwin - bf2f(H[(size_t)row * NH + HC_P + g * 128 + c]);
        }
        __syncthreads();
        const int dcol = C.tid & 127, rq = C.tid >> 7;
        float acc[16];
#pragma unroll
        for (int i = 0; i < 16; ++i) acc[i] = 0.f;
        const float* pw = C.in[I_POOLW] + ((size_t)l * 4 + g) * 128 * 128;
        for (int c = 0; c < 128; ++c) {
            const float wv = pw[c * 128 + dcol];
#pragma unroll
            for (int i = 0; i < 16; ++i) acc[i] += dd[(rq * 16 + i) * 128 + c] * wv;
        }
        const float sc = C.in[I_POOLS][l * BW + g * 128 + dcol];
#pragma unroll
        for (int i = 0; i < 16; ++i) BR[(size_t)(t0 + rq * 16 + i) * NBR + 0 + g * 128 + dcol] = (bf16_t)f2bf(acc[i] * sc);
        __syncthreads();
    }
}
__device__ __forceinline__ void mix_gmlp_naive(const Ctx& C, int l) {
    const bf16_t* H = (const bf16_t*)(C.ws + WS_H); bf16_t* BR = (bf16_t*)(C.ws + WS_BR);
    LAS float* vn = (LAS float*)C.lds;
    for (int u = C.bid; u < (T / 128) * 4; u += C.G) {
        const int g = u & 3, t0 = (u >> 2) * 128;
        for (int i = 0; i < 16; ++i) {
            const int r = C.wave * 16 + i, row = t0 + r;
            const u32x4 raw = *(const u32x4*)(H + (size_t)row * NH + HC_GV + C.lane * 8);
            float e[8];
#pragma unroll
            for (int j = 0; j < 4; ++j) { e[2 * j] = geluf_(bf2f(raw[j] & 0xffffu)); e[2 * j + 1] = geluf_(bf2f(raw[j] >> 16)); }
            float s = 0.f;
#pragma unroll
            for (int j = 0; j < 8; ++j) s += e[j];
            const float mean = wave_sum(s) * (1.f / BW);
            float q = 0.f;
#pragma unroll
            for (int j = 0; j < 8; ++j) { const float d = e[j] - mean; q += d * d; }
            const float rstd = rsqrtf(wave_sum(q) * (1.f / BW) + LN_EPS);
            if ((C.lane >> 4) == g) {
#pragma unroll
                for (int j = 0; j < 8; ++j) { const int col = C.lane * 8 + j;
                    vn[r * 128 + (col - g * 128)] = (e[j] - mean) * rstd * C.in[I_GLNG][l * BW + col] + C.in[I_GLNB][l * BW + col]; }
            }
        }
        __syncthreads();
        const int c = C.tid & 127, tq = C.tid >> 7;
        const float* wsg = C.in[I_GWS] + ((size_t)l * 4 + g) * 128 * 128;
        for (int t = tq; t < 128; t += 4) {
            float acc = 0.f;
            for (int s = 0; s <= t; ++s) acc += wsg[t * 128 + s] * vn[s * 128 + c];
            const float sv = acc + C.in[I_GBS][(l * 4 + g) * 128 + t];
            const float uv = geluf_(bf2f(H[(size_t)(t0 + t) * NH + HC_GU + g * 128 + c]));
            BR[(size_t)(t0 + t) * NBR + 1024 + g * 128 + c] = (bf16_t)f2bf(uv * sv);
        }
        __syncthreads();
    }
}
__device__ __forceinline__ void mix_fox_naive(const Ctx& C, int l) {
    const bf16_t* H = (const bf16_t*)(C.ws + WS_H); bf16_t* BR = (bf16_t*)(C.ws + WS_BR);
    const float* cum = (const float*)(C.ws + WS_CUM);
    const float scale = 0.08838834764831845f;
    for (int u = C.bid; u < T * 4 / 8; u += C.G) {
        const int rid = u * 8 + C.wave;
        const int h = rid & 3, row = rid >> 2, b = row / SEQ, t = row % SEQ;
        const unsigned qraw = *(const unsigned*)(H + (size_t)row * NH + HC_FQ + h * 128 + C.lane * 2);
        const float q0 = bf2f(qraw & 0xffffu) * scale, q1 = bf2f(qraw >> 16) * scale;
        const float* cm = cum + ((size_t)b * 4 + h) * SEQ;
        const float ct = cm[t];
        float m = -1e30f, lsum = 0.f, o0 = 0.f, o1 = 0.f;
        for (int s = t; s >= 0; --s) {
            const size_t kr = (size_t)(b * SEQ + s) * NH + h * 128 + C.lane * 2;
            const unsigned kraw = *(const unsigned*)(H + kr + HC_FK);
            const unsigned vraw = *(const unsigned*)(H + kr + HC_FV);
            float d = q0 * bf2f(kraw & 0xffffu) + q1 * bf2f(kraw >> 16);
            d = wave_sum(d);
            const float z = d + ct - cm[s];
            const float mn = fmaxf(m, z), al = __expf(m - mn), p = __expf(z - mn);
            lsum = lsum * al + p; o0 = o0 * al + p * bf2f(vraw & 0xffffu); o1 = o1 * al + p * bf2f(vraw >> 16); m = mn;
        }
        const float inv = 1.f / lsum;
        *(unsigned*)(BR + (size_t)row * NBR + 1536 + h * 128 + C.lane * 2) = pk2(o0 * inv, o1 * inv);
    }
}
__device__ __forceinline__ void mix_hgrn_naive(const Ctx& C, int l) {
    if (C.bid >= BATCH * 4) return;
    const bf16_t* H = (const bf16_t*)(C.ws + WS_H); bf16_t* BR = (bf16_t*)(C.ws + WS_BR);
    const int b = C.bid >> 2, h = C.bid & 3;
    LAS float* fdec = (LAS float*)C.lds;
    LAS float* kkv = fdec + 32 * 128;
    LAS float* qsv = kkv + 32 * 128;
    LAS float* vv = qsv + 32 * 128;
    LAS float* opart = vv + 32 * 128;
    const int kq = C.tid >> 7, v = C.tid & 127;
    float S[32];
#pragma unroll
    for (int j = 0; j < 32; ++j) S[j] = 0.f;
    for (int c0 = 0; c0 < SEQ; c0 += 32) {
        for (int idx = C.tid; idx < 32 * 128; idx += 512) {
            const int st = idx >> 7, k = idx & 127; const size_t rb = (size_t)(b * SEQ + c0 + st) * NH + h * 128 + k;
            float lb = 0.f;
            if (l == 1) { const float z0 = C.in[I_LBL][h * 128 + k], z1 = C.in[I_LBL][BW + h * 128 + k]; lb = 1.f / (1.f + __expf(z0 - z1)); }
            const float zf = bf2f(H[rb + HC_HF]);
            const float kk = (1.f - lb) * sigmoidf_(-zf);
            fdec[idx] = 1.f - kk; kkv[idx] = kk; qsv[idx] = siluf_(bf2f(H[rb + HC_HQ])); vv[idx] = bf2f(H[rb + HC_HI]);
        }
        __syncthreads();
        for (int st = 0; st < 32; ++st) {
            const float vt = vv[st * 128 + v];
            float part = 0.f;
#pragma unroll
            for (int j = 0; j < 32; ++j) { const int k = kq * 32 + j; S[j] = fdec[st * 128 + k] * S[j] + kkv[st * 128 + k] * vt; part += S[j] * qsv[st * 128 + k]; }
            opart[(kq * 32 + st) * 128 + v] = part;
        }
        __syncthreads();
        for (int i = 0; i < 4; ++i) {
            const int st = C.wave * 4 + i, row = b * SEQ + c0 + st;
            float o0 = 0.f, o1 = 0.f;
#pragma unroll
            for (int q = 0; q < 4; ++q) { o0 += opart[(q * 32 + st) * 128 + C.lane]; o1 += opart[(q * 32 + st) * 128 + 64 + C.lane]; }
            const float ss = wave_sum(o0 * o0 + o1 * o1);
            const float r = rsqrtf(ss * (1.f / 128.f) + RMS_EPS);
            const float g0 = siluf_(bf2f(H[(size_t)row * NH + HC_HG + h * 128 + C.lane])), g1 = siluf_(bf2f(H[(size_t)row * NH + HC_HG + h * 128 + 64 + C.lane]));
            BR[(size_t)row * NBR + 512 + h * 128 + C.lane] = (bf16_t)f2bf(o0 * r * C.in[I_HNG][l * 128 + C.lane] * g0);
            BR[(size_t)row * NBR + 512 + h * 128 + 64 + C.lane] = (bf16_t)f2bf(o1 * r * C.in[I_HNG][l * 128 + 64 + C.lane] * g1);
        }
        __syncthreads();
    }
}


typedef float f32x16 __attribute__((ext_vector_type(16)));
typedef short s16x4 __attribute__((ext_vector_type(4)));
typedef short v4i16_t __attribute__((ext_vector_type(4)));
__device__ __forceinline__ s16x4 vtr(const LAS unsigned char* p) { return __builtin_bit_cast(s16x4, __builtin_amdgcn_ds_read_tr16_b64_v4i16((LAS v4i16_t*)p)); }
__device__ __forceinline__ float xor32(float x) { return __shfl_xor(x, 32, 64); }
#define MFMA32(a, b, c) __builtin_amdgcn_mfma_f32_32x32x16_bf16((a), (b), (c), 0, 0, 0)
constexpr int CW_KMAX = 16;

__device__ __forceinline__ void p_knorm(const Ctx& C, int l) {
    const bf16_t* H = (const bf16_t*)(C.ws + WS_H);
    unsigned* kmax = (unsigned*)(C.ws + WS_CTL) + CW_KMAX + l * 8;
    for (int r0 = (C.bid * 8 + C.wave) * 8; r0 < T; r0 += C.G * 64) {
        u32x4 raw[8];
#pragma unroll
        for (int i = 0; i < 8; ++i) raw[i] = *(const u32x4*)(H + (size_t)(r0 + i) * NH + HC_FK + C.lane * 8);
        float best = 0.f;
#pragma unroll
        for (int i = 0; i < 8; ++i) { float s = 0.f;
#pragma unroll
            for (int j = 0; j < 4; ++j) { const float a = bf2f(raw[i][j] & 0xffffu), b = bf2f(raw[i][j] >> 16); s += a * a + b * b; }
            best = fmaxf(best, s); }
        best = 0.f;
#pragma unroll
        for (int i = 0; i < 8; ++i) { float s = 0.f;
#pragma unroll
            for (int j = 0; j < 4; ++j) { const float a = bf2f(raw[i][j] & 0xffffu), b = bf2f(raw[i][j] >> 16); s += a * a + b * b; }
#pragma unroll
            for (int o = 8; o > 0; o >>= 1) s += __shfl_xor(s, o, 64);
            best = fmaxf(best, s); }
        LAS float* red = (LAS float*)C.lds;
        if ((C.lane & 15) == 0) red[C.wave * 4 + (C.lane >> 4)] = best;
        __syncthreads();
        if (C.tid < 4) { float m = red[C.tid];
#pragma unroll
            for (int w2 = 1; w2 < 8; ++w2) m = fmaxf(m, red[w2 * 4 + C.tid]);
            atomicMax(kmax + (r0 / SEQ) * 4 + C.tid, __builtin_bit_cast(unsigned, m)); }
        __syncthreads();
    }
}

constexpr int FOX_KST = 272, FOX_VST = 320;
constexpr int FOX_KB = 0, FOX_VB = 2 * 64 * FOX_KST, FOX_BETA = FOX_VB + 2 * 64 * FOX_VST, FOX_FLAG = FOX_BETA + 2 * 64 * 4, FOX_END = FOX_FLAG + 2 * 8 * 4;
__device__ __forceinline__ void mix_fox(const Ctx& C, int l) {
    const bf16_t* H = (const bf16_t*)(C.ws + WS_H); bf16_t* BR = (bf16_t*)(C.ws + WS_BR);
    const float* cum = (const float*)(C.ws + WS_CUM);
    const unsigned* kmaxw = (const unsigned*)(C.ws + WS_CTL) + CW_KMAX + l * 8;
    const float LOG2E = 1.4426950408889634f, QS = 0.08838834764831845f * LOG2E;
    const int lane = C.lane, w = C.wave, r32 = lane & 31, hh = lane >> 5;
    LAS unsigned char* lds = C.lds;
    LAS float* betaL = (LAS float*)(lds + FOX_BETA);
    volatile LAS int* flagL = (volatile LAS int*)(lds + FOX_FLAG);
    for (int u = C.bid; u < BATCH * 4 * (SEQ / 256); u += C.G) {
        const int qb = u % (SEQ / 256), bh = u / (SEQ / 256), b = bh >> 2, h = bh & 3;
        const int q0 = qb * 256, qw = q0 + 32 * w;
        const size_t rowbase = (size_t)b * SEQ;
        const float* cm = cum + ((size_t)b * 4 + h) * SEQ;
        const float c0 = cm[q0];
        const float kmx = sqrtf(__builtin_bit_cast(float, __hip_atomic_load(kmaxw + b * 4 + h, __ATOMIC_RELAXED, __HIP_MEMORY_SCOPE_AGENT)));
        bf16x8 qf[8]; float qn = 0.f;
        {
            const bf16_t* qp = H + (rowbase + qw + r32) * NH + HC_FQ + h * 128 + 8 * hh;
#pragma unroll
            for (int ks = 0; ks < 8; ++ks) {
                const u32x4 raw = *(const u32x4*)(qp + 16 * ks);
                u32x4 o;
#pragma unroll
                for (int j = 0; j < 4; ++j) { const float a = bf2f(raw[j] & 0xffffu), bb = bf2f(raw[j] >> 16); qn += a * a + bb * bb; o[j] = cvtpk(a * QS, bb * QS); }
                qf[ks] = __builtin_bit_cast(bf16x8, o);
            }
            qn += xor32(qn); qn = sqrtf(qn);
        }
        const float qbound = qn * kmx * QS;
        f32x16 oacc[4];
#pragma unroll
        for (int mt = 0; mt < 4; ++mt)
#pragma unroll
            for (int i = 0; i < 16; ++i) oacc[mt][i] = 0.f;
        float m_run = -1e30f, l_run = 0.f;
        const int jmax = (q0 + 255) >> 6;
        const int srow = C.tid >> 4, sch = C.tid & 15;
        u32x4 kreg[2], vreg[2]; float breg = 0.f;
#define FOX_GLOAD(j_) do { _Pragma("unroll") for (int p = 0; p < 2; ++p) { \
                const bf16_t* rp = H + (rowbase + 64 * (j_) + srow + 32 * p) * NH + h * 128 + sch * 8; \
                kreg[p] = *(const u32x4*)(rp + HC_FK); vreg[p] = *(const u32x4*)(rp + HC_FV); } \
            if (C.tid < 64) breg = (c0 - cm[64 * (j_) + C.tid]) * LOG2E; } while (0)
#define FOX_LWRITE(buf_) do { _Pragma("unroll") for (int p = 0; p < 2; ++p) { \
                *(LAS u32x4*)(lds + FOX_KB + (buf_) * 64 * FOX_KST + (srow + 32 * p) * FOX_KST + sch * 16) = kreg[p]; \
                *(LAS u32x4*)(lds + FOX_VB + (buf_) * 64 * FOX_VST + (srow + 32 * p) * FOX_VST + sch * 16) = vreg[p]; } \
            if (C.tid < 64) betaL[(buf_) * 64 + C.tid] = breg; } while (0)
        __syncthreads();
        if (C.tid < 16) flagL[C.tid] = 0;
        FOX_GLOAD(jmax); FOX_LWRITE(jmax & 1);
        bool wdone = false;
        for (int j = jmax; j >= 0; --j) {
            const int cur = j & 1;
            __syncthreads();
            if (j < jmax) { int all = 1;
#pragma unroll
                for (int i = 0; i < 8; ++i) all &= flagL[((j + 1) & 1) * 8 + i];
                if (all) break; }
            if (j > 0) FOX_GLOAD(j - 1);
            const int k0 = 64 * j;
            if (k0 <= qw + 31 && !wdone) {
                const LAS unsigned char* kb = lds + FOX_KB + cur * 64 * FOX_KST;
                const LAS unsigned char* vb = lds + FOX_VB + cur * 64 * FOX_VST;
                f32x16 sacc[2];
#pragma unroll
                for (int mt = 0; mt < 2; ++mt)
#pragma unroll
                    for (int g = 0; g < 4; ++g) { const f32x4 bv = *(const LAS f32x4*)(betaL + cur * 64 + 32 * mt + 8 * g + 4 * hh);
                        sacc[mt][4 * g] = bv[0]; sacc[mt][4 * g + 1] = bv[1]; sacc[mt][4 * g + 2] = bv[2]; sacc[mt][4 * g + 3] = bv[3]; }
#pragma unroll
                for (int ks = 0; ks < 8; ++ks)
#pragma unroll
                    for (int mt = 0; mt < 2; ++mt) {
                        const bf16x8 kf = *(const LAS bf16x8*)(kb + (32 * mt + r32) * FOX_KST + 32 * ks + 16 * hh);
                        sacc[mt] = MFMA32(kf, qf[ks], sacc[mt]);
                    }
                const int tq = qw + r32;
                if (k0 + 63 > qw) {
#pragma unroll
                    for (int mt = 0; mt < 2; ++mt)
#pragma unroll
                        for (int i = 0; i < 16; ++i) { const int key = k0 + 32 * mt + (i & 3) + 8 * (i >> 2) + 4 * hh; if (key > tq) sacc[mt][i] = -1e30f; }
                }
                float mx = sacc[0][0];
#pragma unroll
                for (int mt = 0; mt < 2; ++mt)
#pragma unroll
                    for (int i = 0; i < 16; ++i) mx = fmaxf(mx, sacc[mt][i]);
                mx = fmaxf(mx, xor32(mx));
                const float mn = fmaxf(m_run, mx), alpha = __builtin_amdgcn_exp2f(m_run - mn);
                m_run = mn;
                float ps = 0.f;
#pragma unroll
                for (int mt = 0; mt < 2; ++mt)
#pragma unroll
                    for (int i = 0; i < 16; ++i) { const float p = __builtin_amdgcn_exp2f(sacc[mt][i] - mn); sacc[mt][i] = p; ps += p; }
                l_run = l_run * alpha + ps;
#pragma unroll
                for (int mt = 0; mt < 4; ++mt)
#pragma unroll
                    for (int i = 0; i < 16; ++i) oacc[mt][i] *= alpha;
#pragma unroll
                for (int s4 = 0; s4 < 4; ++s4) {
                    const int mtk = s4 >> 1, s = s4 & 1;
                    u32x4 pb;
#pragma unroll
                    for (int e = 0; e < 4; ++e) pb[e] = cvtpk(sacc[mtk][8 * s + 2 * e], sacc[mtk][8 * s + 2 * e + 1]);
                    const bf16x8 pfrag = __builtin_bit_cast(bf16x8, pb);
                    const int i16 = lane & 15, q4 = i16 >> 2, p4 = i16 & 3, blk = (lane >> 4) & 1;
                    const int keyA = 32 * mtk + 16 * s + 4 * hh + q4;
#pragma unroll
                    for (int mt = 0; mt < 4; ++mt) {
                        const LAS unsigned char* a0 = vb + keyA * FOX_VST + (32 * mt + 16 * blk + 4 * p4) * 2;
                        const s16x4 lo = vtr(a0), hi = vtr(a0 + 8 * FOX_VST);
                        const bf16x8 vf = __builtin_shufflevector(lo, hi, 0, 1, 2, 3, 4, 5, 6, 7);
                        oacc[mt] = MFMA32(vf, pfrag, oacc[mt]);
                    }
                }
                if (j > 0) { const float bl = (c0 - cm[k0 - 1]) * LOG2E;
                    const int ok = (qbound + bl < m_run - 40.f) ? 1 : 0;
                    wdone = __all(ok); }
            }
            if (lane == 0) flagL[cur * 8 + w] = wdone ? 1 : 0;
            if (j > 0) FOX_LWRITE(cur ^ 1);
        }
        l_run += xor32(l_run);
        const float inv = 1.f / l_run;
        bf16_t* op = BR + (rowbase + qw + r32) * NBR + 1536 + h * 128;
#pragma unroll
        for (int mt = 0; mt < 4; ++mt)
#pragma unroll
            for (int g = 0; g < 4; ++g) { u32x2 o; o[0] = cvtpk(oacc[mt][4 * g] * inv, oacc[mt][4 * g + 1] * inv); o[1] = cvtpk(oacc[mt][4 * g + 2] * inv, oacc[mt][4 * g + 3] * inv);
                *(u32x2*)(op + 32 * mt + 8 * g + 4 * hh) = o; }
    }
}


constexpr int HG_LF = 0, HG_QA = 34816, HG_QB = HG_QA + 17408, HG_KD = HG_QB + 8704, HG_KO = HG_KD + 17408, HG_KT = HG_KO + 8704, HG_VN = HG_KT + 20480, HG_AM = HG_VN + 20480, HG_END = HG_AM + 12288;
constexpr int HG_LFS = 132;
static_assert(HG_END + 2048 <= 140 * 1024, "hgrn LDS");
constexpr size_t WS_DSC = WS_ST + (size_t)BATCH * 4 * 32 * 128 * 128 * 4;

template <bool FULL>
__device__ __forceinline__ void hgrn_unit(const Ctx& C, int l, int u) {
#if DIAG == 1
    const bf16_t* H = (const bf16_t*)(C.ws + WS_H); bf16_t* BR = (l == 0) ? (bf16_t*)(C.ws + WS_XA) : (bf16_t*)(C.ws + WS_TABU);
#else
    const bf16_t* H = (const bf16_t*)(C.ws + WS_H); bf16_t* BR = (bf16_t*)(C.ws + WS_BR);
#endif
    float* STB = (float*)(C.ws + WS_ST); float* DSC = (float*)(C.ws + WS_DSC);
    LAS unsigned char* lds = C.lds;
    LAS float* LF = (LAS float*)(lds + HG_LF);
    const int lane = C.lane, w = C.wave, r32 = lane & 31, hh = lane >> 5;
    const int sc = u & 31, bh = u >> 5, b = bh >> 2, h = bh & 3;
    const int wk = w >> 1, wv = w & 1;
    const int mt = w >> 2, nt = w & 3;
    const int i16 = lane & 15, q4 = i16 >> 2, p4 = i16 & 3, blk = (lane >> 4) & 1;
    f32x16 S0, S1;
    float* stp = STB + ((size_t)bh * 32 + sc) * 128 * 128;
    if constexpr (FULL) {
#pragma unroll
        for (int i = 0; i < 16; ++i) { const int k = 32 * wk + (i & 3) + 8 * (i >> 2) + 4 * hh;
            S0[i] = stp[k * 128 + 64 * wv + r32]; S1[i] = stp[k * 128 + 64 * wv + 32 + r32]; }
    } else {
#pragma unroll
        for (int i = 0; i < 16; ++i) { S0[i] = 0.f; S1[i] = 0.f; }
    }
    float dtot = 0.f;
    const int ps = C.tid >> 3, pseg = C.tid & 7;
    float lbv[16];
#pragma unroll
    for (int j = 0; j < 16; ++j) { lbv[j] = 0.f;
        if (l == 1) { const int ch = h * 128 + 16 * pseg + j; lbv[j] = 1.f / (1.f + __expf(C.in[I_LBL][ch] - C.in[I_LBL][BW + ch])); } }
    u32x4 nf0, nf1, nv0, nv1;
    { const bf16_t* hp0 = H + ((size_t)b * SEQ + sc * 256 + ps) * NH + h * 128 + 16 * pseg;
      nf0 = *(const u32x4*)(hp0 + HC_HF); nf1 = *(const u32x4*)(hp0 + HC_HF + 8); nv0 = *(const u32x4*)(hp0 + HC_HI); nv1 = *(const u32x4*)(hp0 + HC_HI + 8); }
    for (int c = 0; c < 4; ++c) {
        const size_t row0 = (size_t)b * SEQ + sc * 256 + c * 64;
        const bf16_t* hp = H + (row0 + ps) * NH + h * 128 + 16 * pseg;
        float kkv[16], qsv[16];
        u32x4 vraw0, vraw1;
        u32x4 cg0 = {0u, 0u, 0u, 0u}, cg1 = cg0, cq0 = cg0, cq1 = cg0;
        if constexpr (FULL) { cq0 = *(const u32x4*)(hp + HC_HQ); cq1 = *(const u32x4*)(hp + HC_HQ + 8); cg0 = *(const u32x4*)(hp + HC_HG); cg1 = *(const u32x4*)(hp + HC_HG + 8); }
        {
            const u32x4 f0 = nf0, f1 = nf1;
            vraw0 = nv0; vraw1 = nv1;
            if (c < 3) { const bf16_t* hn = hp + (size_t)64 * NH;
                nf0 = *(const u32x4*)(hn + HC_HF); nf1 = *(const u32x4*)(hn + HC_HF + 8); nv0 = *(const u32x4*)(hn + HC_HI); nv1 = *(const u32x4*)(hn + HC_HI + 8); }
#pragma unroll
            for (int j = 0; j < 8; ++j) { const unsigned r = (j < 4) ? f0[j] : f1[j - 4];
                const float z0 = bf2f(r & 0xffffu), z1 = bf2f(r >> 16);
                kkv[2 * j] = (1.f - lbv[2 * j]) * sigmoidf_(-z0); kkv[2 * j + 1] = (1.f - lbv[2 * j + 1]) * sigmoidf_(-z1); }
            if constexpr (FULL) {
#pragma unroll
                for (int j = 0; j < 8; ++j) { const unsigned r = (j < 4) ? cq0[j] : cq1[j - 4]; qsv[2 * j] = siluf_(bf2f(r & 0xffffu)); qsv[2 * j + 1] = siluf_(bf2f(r >> 16)); }
            }
#pragma unroll
            for (int j4 = 0; j4 < 4; ++j4) { f32x4 o;
#pragma unroll
                for (int e = 0; e < 4; ++e) o[e] = __logf(1.f - kkv[4 * j4 + e]);
                *(LAS f32x4*)(LF + ps * HG_LFS + 16 * pseg + 4 * j4) = o; }
        }
        __syncthreads();
        {
            const int sk = C.tid & 127, sg = C.tid >> 7;
            float vals[16];
#pragma unroll
            for (int i = 0; i < 16; ++i) vals[i] = LF[(16 * sg + i) * HG_LFS + sk];
#pragma unroll
            for (int i = 1; i < 16; ++i) vals[i] += vals[i - 1];
            LAS float* TOT = (LAS float*)(lds + HG_END);
            TOT[sg * 128 + sk] = vals[15];
            __syncthreads();
            float off = 0.f;
#pragma unroll
            for (int j = 0; j < 3; ++j) if (j < sg) off += TOT[j * 128 + sk];
#pragma unroll
            for (int i = 0; i < 16; ++i) LF[(16 * sg + i) * HG_LFS + sk] = vals[i] + off;
            if (sg == 3) dtot += vals[15] + off;
        }
        __syncthreads();
        float bv[16], b31[16], bl[16];
#pragma unroll
        for (int j4 = 0; j4 < 4; ++j4) { const f32x4 x = *(const LAS f32x4*)(LF + ps * HG_LFS + 16 * pseg + 4 * j4), y = *(const LAS f32x4*)(LF + 31 * HG_LFS + 16 * pseg + 4 * j4), z = *(const LAS f32x4*)(LF + 63 * HG_LFS + 16 * pseg + 4 * j4);
#pragma unroll
            for (int e = 0; e < 4; ++e) { bv[4 * j4 + e] = x[e]; b31[4 * j4 + e] = y[e]; bl[4 * j4 + e] = z[e]; } }
        {
            u32x4 o0, o1;
#pragma unroll
            for (int j = 0; j < 4; ++j) { o0[j] = cvtpk(kkv[2 * j] * __expf(bl[2 * j] - bv[2 * j]), kkv[2 * j + 1] * __expf(bl[2 * j + 1] - bv[2 * j + 1]));
                o1[j] = cvtpk(kkv[8 + 2 * j] * __expf(bl[8 + 2 * j] - bv[8 + 2 * j]), kkv[9 + 2 * j] * __expf(bl[9 + 2 * j] - bv[9 + 2 * j])); }
            *(LAS u32x4*)(lds + HG_KT + ps * 320 + 32 * pseg) = o0; *(LAS u32x4*)(lds + HG_KT + ps * 320 + 32 * pseg + 16) = o1;
            *(LAS u32x4*)(lds + HG_VN + ps * 320 + 32 * pseg) = vraw0; *(LAS u32x4*)(lds + HG_VN + ps * 320 + 32 * pseg + 16) = vraw1;
            if constexpr (FULL) {
                const bool hi = ps >= 32;
                float rr[16];
#pragma unroll
                for (int j = 0; j < 16; ++j) rr[j] = hi ? b31[j] : 0.f;
#pragma unroll
                for (int j = 0; j < 4; ++j) { o0[j] = cvtpk(qsv[2 * j] * __expf(bv[2 * j] - rr[2 * j]), qsv[2 * j + 1] * __expf(bv[2 * j + 1] - rr[2 * j + 1]));
                    o1[j] = cvtpk(qsv[8 + 2 * j] * __expf(bv[8 + 2 * j] - rr[8 + 2 * j]), qsv[9 + 2 * j] * __expf(bv[9 + 2 * j] - rr[9 + 2 * j])); }
                *(LAS u32x4*)(lds + HG_QA + ps * 272 + 32 * pseg) = o0; *(LAS u32x4*)(lds + HG_QA + ps * 272 + 32 * pseg + 16) = o1;
#pragma unroll
                for (int j = 0; j < 4; ++j) { o0[j] = cvtpk(kkv[2 * j] * __expf(rr[2 * j] - bv[2 * j]), kkv[2 * j + 1] * __expf(rr[2 * j + 1] - bv[2 * j + 1]));
                    o1[j] = cvtpk(kkv[8 + 2 * j] * __expf(rr[8 + 2 * j] - bv[8 + 2 * j]), kkv[9 + 2 * j] * __expf(rr[9 + 2 * j] - bv[9 + 2 * j])); }
                *(LAS u32x4*)(lds + HG_KD + ps * 272 + 32 * pseg) = o0; *(LAS u32x4*)(lds + HG_KD + ps * 272 + 32 * pseg + 16) = o1;
                if (hi) {
#pragma unroll
                    for (int j = 0; j < 4; ++j) { o0[j] = cvtpk(qsv[2 * j] * __expf(bv[2 * j]), qsv[2 * j + 1] * __expf(bv[2 * j + 1]));
                        o1[j] = cvtpk(qsv[8 + 2 * j] * __expf(bv[8 + 2 * j]), qsv[9 + 2 * j] * __expf(bv[9 + 2 * j])); }
                    *(LAS u32x4*)(lds + HG_QB + (ps - 32) * 272 + 32 * pseg) = o0; *(LAS u32x4*)(lds + HG_QB + (ps - 32) * 272 + 32 * pseg + 16) = o1;
                } else {
#pragma unroll
                    for (int j = 0; j < 4; ++j) { o0[j] = cvtpk(kkv[2 * j] * __expf(b31[2 * j] - bv[2 * j]), kkv[2 * j + 1] * __expf(b31[2 * j + 1] - bv[2 * j + 1]));
                        o1[j] = cvtpk(kkv[8 + 2 * j] * __expf(b31[8 + 2 * j] - bv[8 + 2 * j]), kkv[9 + 2 * j] * __expf(b31[9 + 2 * j] - bv[9 + 2 * j])); }
                    *(LAS u32x4*)(lds + HG_KO + ps * 272 + 32 * pseg) = o0; *(LAS u32x4*)(lds + HG_KO + ps * 272 + 32 * pseg + 16) = o1;
                }
            }
        }
        float dk[16];
#pragma unroll
        for (int i = 0; i < 16; ++i) dk[i] = __expf(LF[63 * HG_LFS + 32 * wk + (i & 3) + 8 * (i >> 2) + 4 * hh]);
        __syncthreads();
        if constexpr (FULL) {
#pragma unroll
            for (int g = 0; g < 4; ++g) {
                u32x2 o; o[0] = cvtpk(S0[4 * g], S0[4 * g + 1]); o[1] = cvtpk(S0[4 * g + 2], S0[4 * g + 3]);
                *(LAS u32x2*)(lds + HG_LF + (64 * wv + r32) * 272 + (32 * wk + 8 * g + 4 * hh) * 2) = o;
                o[0] = cvtpk(S1[4 * g], S1[4 * g + 1]); o[1] = cvtpk(S1[4 * g + 2], S1[4 * g + 3]);
                *(LAS u32x2*)(lds + HG_LF + (64 * wv + 32 + r32) * 272 + (32 * wk + 8 * g + 4 * hh) * 2) = o;
            }
#define HG_ATILE(AMT_, AST_) do { \
                const LAS unsigned char* kb = ((AMT_) == (AST_)) ? (lds + HG_KD + (32 * (AST_)) * 272) : (lds + HG_KO); \
                f32x16 a; \
                _Pragma("unroll") for (int i = 0; i < 16; ++i) a[i] = 0.f; \
                _Pragma("unroll") for (int ks = 0; ks < 8; ++ks) { \
                    const bf16x8 af = *(const LAS bf16x8*)(lds + HG_QA + (32 * (AMT_) + r32) * 272 + 32 * ks + 16 * hh); \
                    const bf16x8 bf = *(const LAS bf16x8*)(kb + r32 * 272 + 32 * ks + 16 * hh); \
                    a = MFMA32(af, bf, a); } \
                _Pragma("unroll") for (int g = 0; g < 4; ++g) { \
                    float x[4]; \
                    _Pragma("unroll") for (int e = 0; e < 4; ++e) { const int tl = 8 * g + 4 * hh + e; x[e] = ((AMT_) != (AST_) || r32 <= tl) ? a[4 * g + e] : 0.f; } \
                    u32x2 o; o[0] = cvtpk(x[0], x[1]); o[1] = cvtpk(x[2], x[3]); \
                    *(LAS u32x2*)(lds + HG_AM + (32 * (AST_) + r32) * 192 + (32 * (AMT_) + 8 * g + 4 * hh) * 2) = o; } } while (0)
            if (w == 0) { HG_ATILE(0, 0); }
            else if (w == 1) { HG_ATILE(1, 0); }
            else if (w == 2) { HG_ATILE(1, 1); }
        }
#pragma unroll
        for (int i = 0; i < 16; ++i) { S0[i] *= dk[i]; S1[i] *= dk[i]; }
#pragma unroll
        for (int ks = 0; ks < 4; ++ks) {
            const LAS unsigned char* ka = lds + HG_KT + (16 * ks + 8 * hh + q4) * 320 + (32 * wk + 16 * blk + 4 * p4) * 2;
            const s16x4 alo = vtr(ka), ahi = vtr(ka + 4 * 320);
            const bf16x8 af = __builtin_shufflevector(alo, ahi, 0, 1, 2, 3, 4, 5, 6, 7);
            const LAS unsigned char* vb0 = lds + HG_VN + (16 * ks + 8 * hh + q4) * 320 + (64 * wv + 16 * blk + 4 * p4) * 2;
            const s16x4 b0lo = vtr(vb0), b0hi = vtr(vb0 + 4 * 320), b1lo = vtr(vb0 + 64), b1hi = vtr(vb0 + 64 + 4 * 320);
            S0 = MFMA32(af, __builtin_shufflevector(b0lo, b0hi, 0, 1, 2, 3, 4, 5, 6, 7), S0);
            S1 = MFMA32(af, __builtin_shufflevector(b1lo, b1hi, 0, 1, 2, 3, 4, 5, 6, 7), S1);
        }
        if constexpr (FULL) {
            __syncthreads();
            f32x16 o;
#pragma unroll
            for (int i = 0; i < 16; ++i) o[i] = 0.f;
            const LAS unsigned char* qb = (mt == 0) ? (lds + HG_QA) : (lds + HG_QB);
#pragma unroll
            for (int ks = 0; ks < 8; ++ks) {
                const bf16x8 af = *(const LAS bf16x8*)(qb + r32 * 272 + 32 * ks + 16 * hh);
                const bf16x8 bf = *(const LAS bf16x8*)(lds + HG_LF + (32 * nt + r32) * 272 + 32 * ks + 16 * hh);
                o = MFMA32(af, bf, o);
            }
#pragma unroll
            for (int ks = 0; ks < 4; ++ks) {
                if (mt == 0 && ks >= 2) continue;
                const LAS unsigned char* aa = lds + HG_AM + (16 * ks + 8 * hh + q4) * 192 + (32 * mt + 16 * blk + 4 * p4) * 2;
                const s16x4 alo = vtr(aa), ahi = vtr(aa + 4 * 192);
                const LAS unsigned char* vb0 = lds + HG_VN + (16 * ks + 8 * hh + q4) * 320 + (32 * nt + 16 * blk + 4 * p4) * 2;
                const s16x4 blo = vtr(vb0), bhi = vtr(vb0 + 4 * 320);
                o = MFMA32(__builtin_shufflevector(alo, ahi, 0, 1, 2, 3, 4, 5, 6, 7), __builtin_shufflevector(blo, bhi, 0, 1, 2, 3, 4, 5, 6, 7), o);
            }
            __syncthreads();
#pragma unroll
            for (int i = 0; i < 16; ++i) LF[(32 * mt + (i & 3) + 8 * (i >> 2) + 4 * hh) * HG_LFS + 32 * nt + r32] = o[i];
            __syncthreads();
            {
                float ov[16]; float ss = 0.f;
#pragma unroll
                for (int j4 = 0; j4 < 4; ++j4) { const f32x4 x = *(const LAS f32x4*)(LF + ps * HG_LFS + 16 * pseg + 4 * j4);
#pragma unroll
                    for (int e = 0; e < 4; ++e) { ov[4 * j4 + e] = x[e]; ss += x[e] * x[e]; } }
                ss += __shfl_xor(ss, 1, 64); ss += __shfl_xor(ss, 2, 64); ss += __shfl_xor(ss, 4, 64);
                const float rn = rsqrtf(ss * (1.f / 128.f) + RMS_EPS);
                const u32x4 g0 = cg0, g1 = cg1;
                const float* ng = C.in[I_HNG] + l * 128 + 16 * pseg;
                u32x4 o0, o1;
#pragma unroll
                for (int j = 0; j < 4; ++j) {
                    o0[j] = cvtpk(ov[2 * j] * rn * ng[2 * j] * siluf_(bf2f(g0[j] & 0xffffu)), ov[2 * j + 1] * rn * ng[2 * j + 1] * siluf_(bf2f(g0[j] >> 16)));
                    o1[j] = cvtpk(ov[8 + 2 * j] * rn * ng[8 + 2 * j] * siluf_(bf2f(g1[j] & 0xffffu)), ov[9 + 2 * j] * rn * ng[9 + 2 * j] * siluf_(bf2f(g1[j] >> 16)));
                }
                bf16_t* bp = BR + (row0 + ps) * NBR + 512 + h * 128 + 16 * pseg;
                *(u32x4*)bp = o0; *(u32x4*)(bp + 8) = o1;
            }
        }
        __syncthreads();
    }
    if constexpr (!FULL) {
#pragma unroll
        for (int i = 0; i < 16; ++i) { const int k = 32 * wk + (i & 3) + 8 * (i >> 2) + 4 * hh;
            stp[k * 128 + 64 * wv + r32] = S0[i]; stp[k * 128 + 64 * wv + 32 + r32] = S1[i]; }
        if (C.tid >= 384) DSC[((size_t)bh * 32 + sc) * 128 + (C.tid & 127)] = __expf(dtot);
    }
}
__device__ __forceinline__ void hgrn_b1(const Ctx& C, int l) { for (int u = C.bid; u < BATCH * 4 * 32; u += C.G) hgrn_unit<false>(C, l, u); }
__device__ __forceinline__ void hgrn_b3(const Ctx& C, int l) { for (int u = C.bid; u < BATCH * 4 * 32; u += C.G) hgrn_unit<true>(C, l, u); }
__device__ __forceinline__ void hgrn_b2(const Ctx& C) {
    float* STB = (float*)(C.ws + WS_ST); const float* DSC = (const float*)(C.ws + WS_DSC);
    for (int e = C.bid * 512 + C.tid; e < BATCH * 4 * 128 * 128; e += C.G * 512) {
        const int bh = e >> 14, kv = e & 16383, k = kv >> 7;
        float* p = STB + (size_t)bh * 32 * 16384 + kv;
        float uu[32], dd[32];
#pragma unroll
        for (int s = 0; s < 32; ++s) { uu[s] = p[(size_t)s * 16384]; dd[s] = DSC[((size_t)bh * 32 + s) * 128 + k]; }
        float st = 0.f;
#pragma unroll
        for (int s = 0; s < 32; ++s) { p[(size_t)s * 16384] = st; st = dd[s] * st + uu[s]; }
    }
}


__device__ __forceinline__ void mix_pool(const Ctx& C, int l) {
#if DIAG == 2
    const bf16_t* H = (const bf16_t*)(C.ws + WS_H); bf16_t* BR = (l == 0) ? (bf16_t*)(C.ws + WS_XA) : (bf16_t*)(C.ws + WS_TABU);
#else
    const bf16_t* H = (const bf16_t*)(C.ws + WS_H); bf16_t* BR = (bf16_t*)(C.ws + WS_BR);
#endif
    const bf16_t* Wt = (const bf16_t*)(C.ws + WS_W + (size_t)l * W_LAYER + WO_POOLW);
    LAS unsigned char* lds = C.lds;
    constexpr int PL_P = 128 * 272;
    const int lane = C.lane, w = C.wave, r32 = lane & 31, hh = lane >> 5;
    for (int u = C.bid; u < (T / 256) * 4; u += C.G) {
        const int g = u & 3, t0 = (u >> 2) * 256, win = 2 << g;
        const int row = t0 + 32 * w + r32, pos = row & (SEQ - 1);
        __syncthreads();
#pragma unroll
        for (int p = 0; p < 4; ++p) { const int idx = C.tid + 512 * p, rr = idx >> 4, ch = idx & 15;
            *(LAS u32x4*)(lds + rr * 272 + ch * 16) = *(const u32x4*)(Wt + (size_t)g * 128 * 128 + rr * 128 + ch * 8); }
        const bool seq_start = (t0 & (SEQ - 1)) == 0;
        for (int idx = C.tid; idx < 271 * 16; idx += 512) { const int rr = idx >> 4, ch = idx & 15;
            if (!(seq_start && rr < 15)) *(LAS u32x4*)(lds + PL_P + rr * 272 + ch * 16) = *(const u32x4*)(H + (size_t)(t0 - 15 + rr) * NH + HC_P + g * 128 + ch * 8); }
        __syncthreads();
        const int nwin = (pos + 1 < win) ? pos + 1 : win;
        const float invn = 1.f / (float)nwin;
        bf16x8 df[8];
        const LAS unsigned char* prow = lds + PL_P + (32 * w + r32 + 15) * 272 + 16 * hh;
#pragma unroll
        for (int ks = 0; ks < 8; ++ks) {
            float sum[8];
#pragma unroll
            for (int e = 0; e < 8; ++e) sum[e] = 0.f;
            const u32x4 self = *(const LAS u32x4*)(prow + 32 * ks);
#pragma unroll
            for (int j = 0; j < 16; ++j) if (j < win) {
                const int jj = (j < nwin) ? j : 0; const float msk = (j < nwin) ? 1.f : 0.f;
                const u32x4 rw = *(const LAS u32x4*)(prow + 32 * ks - jj * 272);
#pragma unroll
                for (int e = 0; e < 4; ++e) { sum[2 * e] += msk * bf2f(rw[e] & 0xffffu); sum[2 * e + 1] += msk * bf2f(rw[e] >> 16); } }
            u32x4 o;
#pragma unroll
            for (int e = 0; e < 4; ++e) o[e] = cvtpk(sum[2 * e] * invn - bf2f(self[e] & 0xffffu), sum[2 * e + 1] * invn - bf2f(self[e] >> 16));
            df[ks] = __builtin_bit_cast(bf16x8, o);
        }
        f32x16 acc[4];
#pragma unroll
        for (int mt = 0; mt < 4; ++mt)
#pragma unroll
            for (int i = 0; i < 16; ++i) acc[mt][i] = 0.f;
#pragma unroll
        for (int ks = 0; ks < 8; ++ks)
#pragma unroll
            for (int mt = 0; mt < 4; ++mt) {
                const bf16x8 wf = *(const LAS bf16x8*)(lds + (32 * mt + r32) * 272 + 32 * ks + 16 * hh);
                acc[mt] = MFMA32(wf, df[ks], acc[mt]);
            }
        const float* psc = C.in[I_POOLS] + l * BW + g * 128;
        bf16_t* op = BR + (size_t)row * NBR + g * 128;
#pragma unroll
        for (int mt = 0; mt < 4; ++mt)
#pragma unroll
            for (int q = 0; q < 4; ++q) { const int d0 = 32 * mt + 8 * q + 4 * hh; const f32x4 sc = *(const f32x4*)(psc + d0);
                u32x2 o; o[0] = cvtpk(acc[mt][4 * q] * sc[0], acc[mt][4 * q + 1] * sc[1]); o[1] = cvtpk(acc[mt][4 * q + 2] * sc[2], acc[mt][4 * q + 3] * sc[3]);
                *(u32x2*)(op + d0) = o; }
    }
}
#if DIAG == 3
#define GM_VNBUF ((bf16_t*)(C.ws + WS_X1B))
constexpr int GM_VLD = BW, GM_VOFF = 0;
#else
#define GM_VNBUF ((bf16_t*)(C.ws + WS_H))
constexpr int GM_VLD = NH, GM_VOFF = HC_GV;
#endif
__device__ __forceinline__ void p_gmlp_prep(const Ctx& C, int l) {
    const bf16_t* H = (const bf16_t*)(C.ws + WS_H); bf16_t* VN = GM_VNBUF;
    const float* lgp = C.in[I_GLNG] + l * BW + C.lane * 8; const float* lbp = C.in[I_GLNB] + l * BW + C.lane * 8;
    const f32x4 g0 = *(const f32x4*)lgp, g1 = *(const f32x4*)(lgp + 4), b0 = *(const f32x4*)lbp, b1 = *(const f32x4*)(lbp + 4);
    for (int row = C.bid * 8 + C.wave; row < T; row += C.G * 8) {
        const u32x4 raw = *(const u32x4*)(H + (size_t)row * NH + HC_GV + C.lane * 8);
        float e[8], s1 = 0.f, s2 = 0.f;
#pragma unroll
        for (int j = 0; j < 4; ++j) { const float a = geluf_(bf2f(raw[j] & 0xffffu)), b = geluf_(bf2f(raw[j] >> 16)); e[2 * j] = a; e[2 * j + 1] = b; s1 += a + b; s2 += a * a + b * b; }
        const float mean = wave_sum(s1) * (1.f / BW), ex2 = wave_sum(s2) * (1.f / BW);
        const float rstd = rsqrtf(fmaxf(ex2 - mean * mean, 0.f) + LN_EPS);
        u32x4 o;
        o[0] = cvtpk((e[0] - mean) * rstd * g0[0] + b0[0], (e[1] - mean) * rstd * g0[1] + b0[1]); o[1] = cvtpk((e[2] - mean) * rstd * g0[2] + b0[2], (e[3] - mean) * rstd * g0[3] + b0[3]);
        o[2] = cvtpk((e[4] - mean) * rstd * g1[0] + b1[0], (e[5] - mean) * rstd * g1[1] + b1[1]); o[3] = cvtpk((e[6] - mean) * rstd * g1[2] + b1[2], (e[7] - mean) * rstd * g1[3] + b1[3]);
        *(u32x4*)(VN + (size_t)row * GM_VLD + GM_VOFF + C.lane * 8) = o;
    }
}
constexpr int GM_VN = 0, GM_WC = 128 * 320, GM_END = GM_WC + 128 * 272;
__device__ __forceinline__ void mix_gmlp(const Ctx& C, int l) {
#if DIAG == 3
    const bf16_t* H = (const bf16_t*)(C.ws + WS_H); bf16_t* BR = (l == 0) ? (bf16_t*)(C.ws + WS_XA) : (bf16_t*)(C.ws + WS_TABU);
#else
    const bf16_t* H = (const bf16_t*)(C.ws + WS_H); bf16_t* BR = (bf16_t*)(C.ws + WS_BR);
#endif
    const bf16_t* Wc = (const bf16_t*)(C.ws + WS_W + (size_t)l * W_LAYER + WO_GWS);
    LAS unsigned char* lds = C.lds;
    const int lane = C.lane, w = C.wave, r32 = lane & 31, hh = lane >> 5;
    const int i16 = lane & 15, q4 = i16 >> 2, p4 = i16 & 3, blk = (lane >> 4) & 1;
    for (int u = C.bid; u < (T / 128) * 4; u += C.G) {
        const int g = u & 3, t0 = (u >> 2) * 128;
        __syncthreads();
#pragma unroll
        for (int p = 0; p < 4; ++p) { const int idx = C.tid + 512 * p, rr = idx >> 4, ch = idx & 15;
            *(LAS u32x4*)(lds + GM_WC + rr * 272 + ch * 16) = *(const u32x4*)(Wc + (size_t)g * 128 * 128 + rr * 128 + ch * 8); }
#pragma unroll
        for (int p = 0; p < 4; ++p) { const int idx = C.tid + 512 * p, rr = idx >> 4, ch = idx & 15;
            *(LAS u32x4*)(lds + GM_VN + rr * 320 + ch * 16) = *(const u32x4*)(GM_VNBUF + (size_t)(t0 + rr) * GM_VLD + GM_VOFF + g * 128 + ch * 8); }
        __syncthreads();
        const int nt = w & 3, mb = (w >> 2) * 2;
        u32x2 upre[2][4];
#pragma unroll
        for (int m = 0; m < 2; ++m)
#pragma unroll
            for (int q = 0; q < 4; ++q) upre[m][q] = *(const u32x2*)(H + (size_t)(t0 + 32 * nt + r32) * NH + HC_GU + g * 128 + 32 * (mb + m) + 8 * q + 4 * hh);
        f32x16 acc[2];
#pragma unroll
        for (int m = 0; m < 2; ++m)
#pragma unroll
            for (int i = 0; i < 16; ++i) acc[m][i] = 0.f;
        for (int ks = 0; ks < 2 * (nt + 1); ++ks) {
            const bf16x8 bf = *(const LAS bf16x8*)(lds + GM_WC + (32 * nt + r32) * 272 + 32 * ks + 16 * hh);
#pragma unroll
            for (int m = 0; m < 2; ++m) {
                const LAS unsigned char* aa = lds + GM_VN + (16 * ks + 8 * hh + q4) * 320 + (32 * (mb + m) + 16 * blk + 4 * p4) * 2;
                const s16x4 lo = vtr(aa), hi = vtr(aa + 4 * 320);
                acc[m] = MFMA32(__builtin_shufflevector(lo, hi, 0, 1, 2, 3, 4, 5, 6, 7), bf, acc[m]);
            }
        }
        const int tl = 32 * nt + r32, row = t0 + tl;
        const float bias = C.in[I_GBS][(l * 4 + g) * 128 + tl];
#pragma unroll
        for (int m = 0; m < 2; ++m)
#pragma unroll
            for (int q = 0; q < 4; ++q) { const int c0 = 32 * (mb + m) + 8 * q + 4 * hh;
                const u32x2 ur = upre[m][q];
                u32x2 o;
                o[0] = cvtpk(geluf_(bf2f(ur[0] & 0xffffu)) * (acc[m][4 * q] + bias), geluf_(bf2f(ur[0] >> 16)) * (acc[m][4 * q + 1] + bias));
                o[1] = cvtpk(geluf_(bf2f(ur[1] & 0xffffu)) * (acc[m][4 * q + 2] + bias), geluf_(bf2f(ur[1] >> 16)) * (acc[m][4 * q + 3] + bias));
                *(u32x2*)(BR + (size_t)row * NBR + 1024 + g * 128 + c0) = o; }
    }
}

#define CE_D(a, b) do { const float _h = fmaxf(a, b), _l = fminf(a, b); a = _h; b = _l; } while (0)
__device__ __forceinline__ void sort16_desc(float (&x)[16]) {
#define S16(a, b) CE_D(x[a], x[b])
    S16(0, 13); S16(1, 12); S16(2, 15); S16(3, 14); S16(4, 8); S16(5, 6); S16(7, 11); S16(9, 10);
    S16(0, 5); S16(1, 7); S16(2, 9); S16(3, 4); S16(6, 13); S16(8, 14); S16(10, 15); S16(11, 12);
    S16(0, 1); S16(2, 3); S16(4, 5); S16(6, 8); S16(7, 9); S16(10, 11); S16(12, 13); S16(14, 15);
    S16(0, 2); S16(1, 3); S16(4, 10); S16(5, 11); S16(6, 7); S16(8, 9); S16(12, 14); S16(13, 15);
    S16(1, 2); S16(3, 12); S16(4, 6); S16(5, 7); S16(8, 10); S16(9, 11); S16(13, 14);
    S16(1, 4); S16(2, 6); S16(5, 8); S16(7, 10); S16(9, 13); S16(11, 14);
    S16(2, 4); S16(3, 6); S16(9, 12); S16(11, 13);
    S16(3, 5); S16(6, 8); S16(7, 9); S16(10, 12);
    S16(3, 4); S16(5, 6); S16(7, 8); S16(9, 10); S16(11, 12);
    S16(6, 7); S16(8, 9);
#undef S16
}
__device__ __forceinline__ void bmerge16_desc(float (&x)[16]) {
#pragma unroll
    for (int j = 8; j > 0; j >>= 1)
#pragma unroll
        for (int i = 0; i < 16; ++i) { const int l = i ^ j; if (l > i) CE_D(x[i], x[l]); }
}
__device__ __forceinline__ void top16_merge(float (&a)[16], const float (&b)[16]) {
#pragma unroll
    for (int i = 0; i < 16; ++i) a[i] = fmaxf(a[i], b[15 - i]);
    bmerge16_desc(a);
}
__device__ __forceinline__ float pack_idx(float v, unsigned idx, unsigned mask) { return __builtin_bit_cast(float, (__builtin_bit_cast(unsigned, v) & ~mask) | idx); }

constexpr int TK_KST = 272, TK_KBUF = 128 * TK_KST;
__device__ __forceinline__ void p_topk(const Ctx& C, int l) {
    const bf16_t* Q = (const bf16_t*)(C.ws + WS_Q);
    const bf16_t* keys = (const bf16_t*)(C.ws + WS_W + (size_t)l * W_LAYER + WO_KEYS);
    int* eidx = (int*)(C.ws + WS_EIDX); float* egate = (float*)(C.ws + WS_EGATE);
    LAS unsigned char* lds = C.lds;
    const int lane = C.lane, w = C.wave, r32 = lane & 31, hh = lane >> 5;
    for (int u = C.bid; u < (T / 256) * PH; u += C.G) {
        const int h = u & 7, t0 = (u >> 3) * 256, tok = t0 + 32 * w + r32;
        float v12[2][16];
        __syncthreads();
#pragma unroll
        for (int j = 0; j < 2; ++j) {
            const bf16_t* kp = keys + ((size_t)j * PH + h) * 128 * 128;
#pragma unroll
            for (int p = 0; p < 4; ++p) { const int idx = C.tid + 512 * p, row = idx >> 4, ch = idx & 15;
                *(LAS u32x4*)(lds + j * TK_KBUF + row * TK_KST + ch * 16) = *(const u32x4*)(kp + row * 128 + ch * 8); }
        }
        __syncthreads();
#pragma unroll
        for (int j = 0; j < 2; ++j) {
            bf16x8 qf[8];
            {
                LAS unsigned char* qs = lds + 2 * TK_KBUF + w * (32 * 272);
                u32x4 qr[8];
#pragma unroll
                for (int p = 0; p < 8; ++p) qr[p] = *(const u32x4*)(Q + (size_t)(t0 + 32 * w + 4 * p + (lane >> 4)) * NQ + h * 256 + j * 128 + (lane & 15) * 8);
#pragma unroll
                for (int p = 0; p < 8; ++p) *(LAS u32x4*)(qs + (4 * p + (lane >> 4)) * 272 + (lane & 15) * 16) = qr[p];
#pragma unroll
                for (int ks = 0; ks < 8; ++ks) qf[ks] = *(const LAS bf16x8*)(qs + r32 * 272 + 32 * ks + 16 * hh);
            }
            f32x16 sacc[4];
#pragma unroll
            for (int mt = 0; mt < 4; ++mt)
#pragma unroll
                for (int i = 0; i < 16; ++i) sacc[mt][i] = 0.f;
#pragma unroll
            for (int ks = 0; ks < 8; ++ks)
#pragma unroll
                for (int mt = 0; mt < 4; ++mt) {
                    const bf16x8 kf = *(const LAS bf16x8*)(lds + j * TK_KBUF + (32 * mt + r32) * TK_KST + 32 * ks + 16 * hh);
                    sacc[mt] = MFMA32(kf, qf[ks], sacc[mt]);
                }
            float g[4][16];
#pragma unroll
            for (int mt = 0; mt < 4; ++mt) {
#pragma unroll
                for (int i = 0; i < 16; ++i) g[mt][i] = pack_idx(sacc[mt][i], (unsigned)(32 * mt + (i & 3) + 8 * (i >> 2) + 4 * hh), 127u);
                sort16_desc(g[mt]);
            }
            top16_merge(g[0], g[1]); top16_merge(g[2], g[3]); top16_merge(g[0], g[2]);
            float o[16];
#pragma unroll
            for (int i = 0; i < 16; ++i) o[i] = __shfl_xor(g[0][i], 32, 64);
            top16_merge(g[0], o);
#pragma unroll
            for (int i = 0; i < 16; ++i) v12[j][i] = g[0][i];
        }
        float c[4][16];
        {
            int n = 0;
#pragma unroll
            for (int a = 0; a < 16; ++a)
#pragma unroll
                for (int b = 0; b < 16; ++b) if ((a + 1) * (b + 1) <= 16) {
                    const unsigned id = ((__builtin_bit_cast(unsigned, v12[0][a]) & 127u) << 7) | (__builtin_bit_cast(unsigned, v12[1][b]) & 127u);
                    c[n >> 4][n & 15] = pack_idx(v12[0][a] + v12[1][b], id, 16383u); ++n; }
#pragma unroll
            for (; n < 64; ++n) c[n >> 4][n & 15] = -3.0e38f;
        }
        sort16_desc(c[1]); sort16_desc(c[2]); CE_D(c[3][0], c[3][1]);
        top16_merge(c[0], c[1]); top16_merge(c[2], c[3]); top16_merge(c[0], c[2]);
        float e[16], den = 0.f;
#pragma unroll
        for (int i = 0; i < 16; ++i) { e[i] = __expf(c[0][i] - c[0][0]); den += e[i]; }
        const float inv = 1.f / den;
        int* ip = eidx + (size_t)tok * 128 + h * 16 + 8 * hh; float* gp = egate + (size_t)tok * 128 + h * 16 + 8 * hh;
        u32x4 i0, i1; f32x4 g0, g1;
#pragma unroll
        for (int i = 0; i < 4; ++i) {
            const float ca = hh ? c[0][8 + i] : c[0][i], cb = hh ? c[0][12 + i] : c[0][4 + i];
            i0[i] = __builtin_bit_cast(unsigned, ca) & 16383u; i1[i] = __builtin_bit_cast(unsigned, cb) & 16383u;
            g0[i] = (hh ? e[8 + i] : e[i]) * inv; g1[i] = (hh ? e[12 + i] : e[4 + i]) * inv;
        }
        *(u32x4*)ip = i0; *(u32x4*)(ip + 4) = i1; *(f32x4*)gp = g0; *(f32x4*)(gp + 4) = g1;
    }
}

constexpr int CW_DIAG = 64;
__device__ __forceinline__ void diag_cmp(const Ctx& C, const bf16_t* A, int lda, const bf16_t* R, int ldr, int nc) {
    float sd = 0.f, sr = 0.f;
    for (int row = C.bid; row < T; row += C.G) {
        const int tm = row % DIAG_MOD; if (tm < DIAG_LO || tm >= DIAG_HI) continue;
        for (int c = C.tid; c < nc; c += 512) { const float a = bf2f(A[(size_t)row * lda + c]), r = bf2f(R[(size_t)row * ldr + c]); sd += (a - r) * (a - r); sr += r * r; }
    }
    sd = wave_sum(sd); sr = wave_sum(sr);
    if (C.lane == 0) { atomicAdd((float*)(C.ws + WS_CTL) + CW_DIAG, sd); atomicAdd((float*)(C.ws + WS_CTL) + CW_DIAG + 1, sr); }
}
__device__ __forceinline__ void diag_cmp_u8(const Ctx& C, const unsigned char* A, int lda, const bf16_t* R, int ldr, int nc) {
    float sd = 0.f, sr = 0.f;
    for (int row = C.bid; row < T; row += C.G)
        for (int c = C.tid; c < nc; c += 512) { const float a = (float)A[(size_t)row * lda + c] * (1.f / 255.f), r = bf2f(R[(size_t)row * ldr + c]); sd += (a - r) * (a - r); sr += r * r; }
    sd = wave_sum(sd); sr = wave_sum(sr);
    if (C.lane == 0) { atomicAdd((float*)(C.ws + WS_CTL) + CW_DIAG, sd); atomicAdd((float*)(C.ws + WS_CTL) + CW_DIAG + 1, sr); }
}
__device__ __forceinline__ float diag_alpha(const Ctx& C) {
    const float sd = __hip_atomic_load((float*)(C.ws + WS_CTL) + CW_DIAG, __ATOMIC_RELAXED, __HIP_MEMORY_SCOPE_AGENT), sr = __hip_atomic_load((float*)(C.ws + WS_CTL) + CW_DIAG + 1, __ATOMIC_RELAXED, __HIP_MEMORY_SCOPE_AGENT);
    const float err = fmaxf(sd / fmaxf(sr, 1e-30f), 1e-8f);
    return 0.1f + 0.1f * (rintf(log10f(err / 1e-8f) * 10.f) * 0.1f);
}


#if DIAG == 5 || DIAG == 6
__device__ __forceinline__ void diag_ref_slice(const Ctx& C, const float* W, int ldw, int n0, const float* bias) {
    bf16_t* alt = (bf16_t*)(C.ws + WS_XA);
    const float* X = C.in[I_X];
    for (int row = C.bid * 8 + C.wave; row < T; row += C.G * 8) {
        float acc = 0.f;
        for (int k = 0; k < DM; ++k) acc += X[(size_t)row * DM + k] * W[(size_t)k * ldw + n0 + C.lane];
        if (bias) acc = sigmoidf_(acc + bias[n0 + C.lane]);
        alt[(size_t)row * 64 + C.lane] = (bf16_t)f2bf(acc);
    }
}
#endif

__device__ __forceinline__ void wave_argmax(float& v, int& i) {
#pragma unroll
    for (int o = 32; o > 0; o >>= 1) {
        const float ov = __shfl_xor(v, o, 64); const int oi = __shfl_xor(i, o, 64);
        if (ov > v || (ov == v && oi < i)) { v = ov; i = oi; }
    }
}
__device__ __forceinline__ void p_topk_naive(const Ctx& C, int l) {
    const bf16_t* Q = (const bf16_t*)(C.ws + WS_Q);
    const bf16_t* keys = (const bf16_t*)(C.ws + WS_W + (size_t)l * W_LAYER + WO_KEYS);
    int* eidx = (int*)(C.ws + WS_EIDX); float* egate = (float*)(C.ws + WS_EGATE);
    LAS float* qs = (LAS float*)C.lds;
    LAS float* sc = qs + 2048;
    LAS float* tv = sc + 2048;
    LAS int* ti = (LAS int*)(tv + 256);
    for (int t = C.bid; t < T; t += C.G) {
        for (int i = C.tid; i < 2048; i += 512) qs[i] = bf2f(Q[(size_t)t * NQ + i]);
        __syncthreads();
        for (int i = 0; i < 4; ++i) {
            const int idx = C.tid + 512 * i, hj = idx >> 7, key = idx & 127, h = hj >> 1, j = hj & 1;
            const bf16_t* kp = keys + (((size_t)j * PH + h) * 128 + key) * 128;
            float s = 0.f;
            for (int d8 = 0; d8 < 16; ++d8) {
                const u32x4 raw = *(const u32x4*)(kp + d8 * 8);
#pragma unroll
                for (int e = 0; e < 4; ++e) s += qs[h * 256 + j * 128 + d8 * 8 + 2 * e] * bf2f(raw[e] & 0xffffu) + qs[h * 256 + j * 128 + d8 * 8 + 2 * e + 1] * bf2f(raw[e] >> 16);
            }
            sc[idx] = s;
        }
        __syncthreads();
        for (int i = 0; i < 2; ++i) {
            const int hj = C.wave * 2 + i;
            float a0 = sc[hj * 128 + C.lane], a1 = sc[hj * 128 + 64 + C.lane];
            for (int r = 0; r < 16; ++r) {
                float bv; int bi;
                if (a0 > a1 || (a0 == a1)) { bv = a0; bi = C.lane; } else { bv = a1; bi = C.lane + 64; }
                wave_argmax(bv, bi);
                if (C.lane == 0) { tv[hj * 16 + r] = bv; ti[hj * 16 + r] = bi; }
                if (bi == C.lane) a0 = -3e38f; if (bi == C.lane + 64) a1 = -3e38f;
            }
        }
        __syncthreads();
        {
            const int h = C.wave;
            float cv[4];
#pragma unroll
            for (int i = 0; i < 4; ++i) { const int c = C.lane * 4 + i; cv[i] = tv[(h * 2) * 16 + (c >> 4)] + tv[(h * 2 + 1) * 16 + (c & 15)]; }
            float topv = 0.f; int tope = 0; float mx = 0.f;
            for (int r = 0; r < 16; ++r) {
                float bv = cv[0]; int bi = C.lane * 4;
#pragma unroll
                for (int i = 1; i < 4; ++i) if (cv[i] > bv) { bv = cv[i]; bi = C.lane * 4 + i; }
                wave_argmax(bv, bi);
                if (r == 0) mx = bv;
                if (C.lane == r) { topv = bv; tope = ti[(h * 2) * 16 + (bi >> 4)] * 128 + ti[(h * 2 + 1) * 16 + (bi & 15)]; }
#pragma unroll
                for (int i = 0; i < 4; ++i) if (bi == C.lane * 4 + i) cv[i] = -3e38f;
            }
            float e = (C.lane < 16) ? __expf(topv - mx) : 0.f;
            const float den = wave_sum(e);
            if (C.lane < 16) { eidx[(size_t)t * 128 + h * 16 + C.lane] = tope; egate[(size_t)t * 128 + h * 16 + C.lane] = e / den; }
        }
        __syncthreads();
    }
}
__device__ __forceinline__ float ub(unsigned w, int e) { return (float)((w >> (8 * e)) & 255u); }
__device__ __forceinline__ void p_gather(const Ctx& C, int l) {
    const bf16_t* xc = (const bf16_t*)(C.ws + WS_X1B);
    const unsigned char* U8 = C.ws + WS_U8; const unsigned char* V8 = C.ws + WS_V8;
    const float* SU = (const float*)(C.ws + WS_SU); const float* SV = (const float*)(C.ws + WS_SV);
    const int* eidx = (const int*)(C.ws + WS_EIDX); const float* egate = (const float*)(C.ws + WS_EGATE);
    const int lane = C.lane;
    for (int t = C.bid * 8 + C.wave; t < T; t += C.G * 8) {
        float x[16];
        { const bf16_t* xp = xc + (size_t)t * DM + lane * 16;
          const u32x4 a = *(const u32x4*)xp, b = *(const u32x4*)(xp + 8);
#pragma unroll
          for (int i = 0; i < 4; ++i) { x[2 * i] = bf2f(a[i] & 0xffffu); x[2 * i + 1] = bf2f(a[i] >> 16); x[8 + 2 * i] = bf2f(b[i] & 0xffffu); x[9 + 2 * i] = bf2f(b[i] >> 16); } }
        float xmx = 0.f;
#pragma unroll
        for (int j = 0; j < 16; ++j) xmx = fmaxf(xmx, fabsf(x[j]));
        xmx = fmaxf(wave_max(xmx), 1e-30f);
        const float xisc = 127.f / xmx, xsc = xmx * (1.f / 127.f);
        int xq[4];
#pragma unroll
        for (int q = 0; q < 4; ++q) { unsigned wd = 0u;
#pragma unroll
            for (int e = 0; e < 4; ++e) wd |= ((unsigned)(int)rintf(x[4 * q + e] * xisc) & 255u) << (8 * e);
            xq[q] = (int)wd; }
        float cf[2]; int ex[2];
#pragma unroll
        for (int bt = 0; bt < 2; ++bt) {
            ex[bt] = eidx[(size_t)t * 128 + 64 * bt + lane];
            const float gate = egate[(size_t)t * 128 + 64 * bt + lane];
            int p[64];
#pragma unroll
            for (int e0 = 0; e0 < 64; e0 += 16) {
                u32x4 r[16];
#pragma unroll
                for (int i = 0; i < 16; ++i) { const int e = __builtin_amdgcn_readlane(ex[bt], e0 + i); r[i] = *(const u32x4*)(U8 + (size_t)e * DM + lane * 16); }
#pragma unroll
                for (int i = 0; i < 16; ++i) { int a = 0;
#pragma unroll
                    for (int q = 0; q < 4; ++q) a = __builtin_amdgcn_sdot4(xq[q], (int)r[i][q], a, false);
                    p[e0 + i] = a; }
            }
#pragma unroll
            for (int st = 32, n = 32; st > 0; st >>= 1, n >>= 1) {
                const bool up = (lane & st) != 0;
#pragma unroll
                for (int i = 0; i < n; ++i) { const int send = up ? p[i] : p[i + n], keep = up ? p[i + n] : p[i]; p[i] = keep + __shfl_xor(send, st, 64); }
            }
            const float hsum = SU[ex[bt]] * xsc * (float)p[0];
            cf[bt] = gate * geluf_slow(hsum) * SV[ex[bt]];
        }
        f32x2 y2[8];
#pragma unroll
        for (int j = 0; j < 8; ++j) y2[j] = (f32x2){0.f, 0.f};
#pragma unroll
        for (int bt = 0; bt < 2; ++bt)
#pragma unroll
            for (int e0 = 0; e0 < 64; e0 += 16) {
                u32x2 r[16];
#pragma unroll
                for (int i = 0; i < 16; ++i) { const int e = __builtin_amdgcn_readlane(ex[bt], e0 + i); r[i] = *(const u32x2*)(V8 + (size_t)e * V6_ROW + lane * 8); }
#pragma unroll
                for (int i = 0; i < 16; ++i) { const float c = __builtin_bit_cast(float, __builtin_amdgcn_readlane(__builtin_bit_cast(int, cf[bt]), e0 + i));
                    const f32x2 c2 = {c, c};
#pragma unroll
                    for (int q = 0; q < 2; ++q) {
                        y2[4 * q + 0] += c2 * __builtin_amdgcn_cvt_scalef32_pk_f32_fp4(r[i][q], 1.0f, 0);
                        y2[4 * q + 1] += c2 * __builtin_amdgcn_cvt_scalef32_pk_f32_fp4(r[i][q], 1.0f, 1);
                        y2[4 * q + 2] += c2 * __builtin_amdgcn_cvt_scalef32_pk_f32_fp4(r[i][q], 1.0f, 2);
                        y2[4 * q + 3] += c2 * __builtin_amdgcn_cvt_scalef32_pk_f32_fp4(r[i][q], 1.0f, 3); } }
            }
        float y[16];
#pragma unroll
        for (int j = 0; j < 8; ++j) { y[2 * j] = y2[j][0]; y[2 * j + 1] = y2[j][1]; }
#pragma unroll
        for (int j = 0; j < 16; ++j) y[j] = y[j] + ALPHA * x[j];
        float sm = 0.f;
#pragma unroll
        for (int j = 0; j < 16; ++j) sm += y[j];
        const float mean = wave_sum(sm) * (1.f / DM);
        float qq = 0.f;
#pragma unroll
        for (int j = 0; j < 16; ++j) { const float d = y[j] - mean; qq += d * d; }
        const float rstd = rsqrtf(wave_sum(qq) * (1.f / DM) + LN_EPS);
        const float* gp = C.in[I_LN2G] + l * DM + lane * 16; const float* bp = C.in[I_LN2B] + l * DM + lane * 16;
        asm volatile("" : "+v"(gp), "+v"(bp));
#pragma unroll
        for (int i = 0; i < 4; ++i) { const f32x4 gg = *(const f32x4*)(gp + 4 * i), bb = *(const f32x4*)(bp + 4 * i);
#pragma unroll
            for (int e = 0; e < 4; ++e) y[4 * i + e] = (y[4 * i + e] - mean) * rstd * gg[e] + bb[e]; }
        float* dst = (l + 1 < DEPTH) ? (float*)(C.ws + WS_XA) + (size_t)t * DM : C.out + (size_t)t * DM;
#if DIAG
        if (l + 1 == DEPTH) { const float al = 1.f + diag_alpha(C);
#pragma unroll
            for (int j = 0; j < 16; ++j) y[j] *= al; }
#endif
#pragma unroll
        for (int i = 0; i < 4; ++i) *(f32x4*)(dst + lane * 16 + 4 * i) = (f32x4){y[4 * i], y[4 * i + 1], y[4 * i + 2], y[4 * i + 3]};
        if (l + 1 < DEPTH) {
            {
                float mx = 0.f;
#pragma unroll
                for (int j = 0; j < 16; ++j) mx = fmaxf(mx, fabsf(y[j]));
                mx = fmaxf(wave_max(mx), 1e-30f);
                const float isc = 127.f / mx;
                u32x4 o8;
#pragma unroll
                for (int q = 0; q < 4; ++q) { unsigned wd = 0u;
#pragma unroll
                    for (int e = 0; e < 4; ++e) wd |= ((unsigned)(int)rintf(y[4 * q + e] * isc) & 255u) << (8 * e);
                    o8[q] = wd; }
                *(u32x4*)(C.ws + WS_XB + (size_t)t * DM + lane * 16) = o8;
                if (lane == 0) ((float*)(C.ws + WS_XSA))[t] = mx * (1.f / 127.f);
            }
            const float* wf = (const float*)(C.ws + WS_W + (size_t)(l + 1) * W_LAYER + WO_WF) + lane * 16;
            asm volatile("" : "+v"(wf));
            float* lsig = (float*)(C.ws + WS_MISC);
#pragma unroll
            for (int h = 0; h < 4; ++h) {
                float sd = 0.f;
#pragma unroll
                for (int i = 0; i < 4; ++i) { const f32x4 a = *(const f32x4*)(wf + h * DM + 4 * i);
#pragma unroll
                    for (int e = 0; e < 4; ++e) sd += y[4 * i + e] * a[e]; }
                sd = wave_sum(sd);
                if (lane == 0) lsig[(size_t)t * 4 + h] = logsigmoidf_(sd + C.in[I_BFOX][(l + 1) * 4 + h]);
            }
        }
    }
}

struct FStoreBf16 { bf16_t* O; int ld;
    __device__ __forceinline__ void operator()(int row, int col, f32x4 v0, f32x4 v1, int) const {
        u32x4 o; o[0] = pk2(v0[0], v0[1]); o[1] = pk2(v0[2], v0[3]); o[2] = pk2(v1[0], v1[1]); o[3] = pk2(v1[2], v1[3]);
        *(u32x4*)(O + (size_t)row * ld + col) = o; } };
typedef int i32x4 __attribute__((ext_vector_type(4)));
__device__ __forceinline__ void i8_dequant(f32x4& v0, f32x4& v1, float sa, const float* cs) {
    sa *= (1.f / 127.f);
    const f32x4 c0 = *(const f32x4*)cs, c1 = *(const f32x4*)(cs + 4);
    const i32x4 i0 = __builtin_bit_cast(i32x4, v0), i1 = __builtin_bit_cast(i32x4, v1);
#pragma unroll
    for (int e = 0; e < 4; ++e) { v0[e] = (float)i0[e] * sa * c0[e]; v1[e] = (float)i1[e] * sa * c1[e]; }
}
struct FStoreBf16I8 { bf16_t* O; int ld; const float* rs; const float* cs;
    __device__ __forceinline__ void operator()(int row, int col, f32x4 v0, f32x4 v1, int) const {
        i8_dequant(v0, v1, rs[row], cs + col);
        u32x4 o; o[0] = pk2(v0[0], v0[1]); o[1] = pk2(v0[2], v0[3]); o[2] = pk2(v1[0], v1[1]); o[3] = pk2(v1[2], v1[3]);
        *(u32x4*)(O + (size_t)row * ld + col) = o; } };
struct FGateI8 { unsigned char* O; const float* bias; const float* rs; const float* cs;
    __device__ __forceinline__ void operator()(int row, int col, f32x4 v0, f32x4 v1, int) const {
        const float sa = rs[row] * (-1.4426950408889634f / 127.f);
        const f32x4 c0 = *(const f32x4*)(cs + col), c1 = *(const f32x4*)(cs + col + 4);
        const f32x4 b0 = *(const f32x4*)(bias + col), b1 = *(const f32x4*)(bias + col + 4);
        const i32x4 i0 = __builtin_bit_cast(i32x4, v0), i1 = __builtin_bit_cast(i32x4, v1);
        u32x2 o; unsigned w0 = 0u, w1 = 0u;
#pragma unroll
        for (int e = 0; e < 4; ++e) {
            const float e0 = __builtin_amdgcn_exp2f(__builtin_fmaf((float)i0[e] * sa, c0[e], -1.4426950408889634f * b0[e])), e1 = __builtin_amdgcn_exp2f(__builtin_fmaf((float)i1[e] * sa, c1[e], -1.4426950408889634f * b1[e]));
            const unsigned q0 = max((unsigned)__builtin_fmaf(__builtin_amdgcn_rcpf(1.f + e0), 255.f, 0.5f), 1u), q1 = max((unsigned)__builtin_fmaf(__builtin_amdgcn_rcpf(1.f + e1), 255.f, 0.5f), 1u);
            w0 |= q0 << (8 * e); w1 |= q1 << (8 * e); }
        o[0] = w0; o[1] = w1;
        *(u32x2*)(O + (size_t)row * NG + col) = o; } };
struct FGate { bf16_t* O; const float* bias;
    __device__ __forceinline__ void operator()(int row, int col, f32x4 v0, f32x4 v1, int) const {
        const f32x4 b0 = *(const f32x4*)(bias + col), b1 = *(const f32x4*)(bias + col + 4);
        u32x4 o; o[0] = pk2(sigmoidf_(v0[0] + b0[0]), sigmoidf_(v0[1] + b0[1])); o[1] = pk2(sigmoidf_(v0[2] + b0[2]), sigmoidf_(v0[3] + b0[3]));
        o[2] = pk2(sigmoidf_(v1[0] + b1[0]), sigmoidf_(v1[1] + b1[1])); o[3] = pk2(sigmoidf_(v1[2] + b1[2]), sigmoidf_(v1[3] + b1[3]));
        *(u32x4*)(O + (size_t)row * NG + col) = o; } };
struct FMerge { const unsigned char* G; bf16_t* MG;
    __device__ __forceinline__ void operator()(int row, int col, f32x4 v0, f32x4 v1, int z) const {
        const u32x2 gr = *(const u32x2*)(G + (size_t)row * NG + z * DM + col);
        float r[8];
#pragma unroll
        for (int e = 0; e < 4; ++e) { r[e] = v0[e] * (float)((gr[0] >> (8 * e)) & 255u) * (1.f / 255.f); r[4 + e] = v1[e] * (float)((gr[1] >> (8 * e)) & 255u) * (1.f / 255.f); }
        bf16_t* p = MG + (size_t)row * DM + col;
        if (z > 0) { const u32x4 pr = *(const u32x4*)p;
#pragma unroll
            for (int e = 0; e < 4; ++e) { r[2 * e] += bf2f(pr[e] & 0xffffu); r[2 * e + 1] += bf2f(pr[e] >> 16); } }
        u32x4 o;
#pragma unroll
        for (int e = 0; e < 4; ++e) o[e] = pk2(r[2 * e], r[2 * e + 1]);
        *(u32x4*)p = o; } };
struct FResid { const float* X; bf16_t* Y;
    __device__ __forceinline__ void operator()(int row, int col, f32x4 v0, f32x4 v1, int) const {
        const f32x4 x0 = *(const f32x4*)(X + (size_t)row * DM + col), x1 = *(const f32x4*)(X + (size_t)row * DM + col + 4);
#if DIAG == 5 || DIAG == 6
        v0 = (f32x4){0.f, 0.f, 0.f, 0.f}; v1 = v0;
#endif
        u32x4 o; o[0] = cvtpk(x0[0] * ALPHA + v0[0], x0[1] * ALPHA + v0[1]); o[1] = cvtpk(x0[2] * ALPHA + v0[2], x0[3] * ALPHA + v0[3]);
        o[2] = cvtpk(x1[0] * ALPHA + v1[0], x1[1] * ALPHA + v1[1]); o[3] = cvtpk(x1[2] * ALPHA + v1[2], x1[3] * ALPHA + v1[3]);
        *(u32x4*)(Y + (size_t)row * DM + col) = o; } };

constexpr int PH_PER_LAYER = 12, N_PHASES = 1 + DEPTH * PH_PER_LAYER;
template <int SP> __device__ __forceinline__ void run_phase(const Ctx& C0, int l) {
    Ctx C = C0;
    asm volatile("" : "+v"(C.tid));
    C.ws = launder_ptr(C.ws); C.out = launder_ptr(C.out); l = (int)launder_u((unsigned)l);
    C.lane = C.tid & 63; C.wave = __builtin_amdgcn_readfirstlane(C.tid >> 6);
    unsigned char* wb = C.ws + WS_W + (size_t)l * W_LAYER;
    if constexpr (SP == -1) { p_conv_weights(C); p_rowpass0(C); }
    if constexpr (SP == 1) {
        p_cumsum(C);
        __syncthreads();
        pg8::Gemm g{(const bf16_t*)(C.ws + WS_XB), (const bf16_t*)(wb + WO_WIN), DM, DM, DM, 0, 0};
        pg8::StaticOrder S; S.init(T, NH, C.G, C.bid);
        pg8::Epi8<FStoreBf16I8> E{{(bf16_t*)(C.ws + WS_H), NH, (const float*)(C.ws + WS_XSA), (const float*)(C.ws + WS_CMAX) + l * (NH + NG)}};
        pg8::gemm_phase<pg8::Epi8<FStoreBf16I8>, pg8::StaticOrder, true>(C.lds, g, S, E, C.tid);
    }
#if DIAG == 5
    if constexpr (SP == 2) { if (l == 0) { diag_ref_slice(C, C.in[I_WIN], NIN, DIAG_N0, nullptr); } }
    if constexpr (SP == 3) { if (l == 0) diag_cmp(C, (const bf16_t*)(C.ws + WS_H) + DIAG_N0, NH, (const bf16_t*)(C.ws + WS_XA), 64, 64); }
#endif
#if DIAG == 6
    if constexpr (SP == 5) { if (l == 0) diag_ref_slice(C, C.in[I_WGATE], NG, DIAG_N0, C.in[I_BGATE]); }
    if constexpr (SP == 6) { if (l == 0) diag_cmp_u8(C, C.ws + WS_G + DIAG_N0, NG, (const bf16_t*)(C.ws + WS_XA), 64, 64); }
#endif
    if constexpr (SP == 2) { p_knorm(C, l); p_gmlp_prep(C, l); if (l != HG_NAIVE_L) hgrn_b1(C, l); }
#if MIX_NAIVE
    if constexpr (SP == 3) { if (l != HG_NAIVE_L) hgrn_b2(C); mix_pool_naive(C, l); mix_gmlp_naive(C, l); }
#else
    if constexpr (SP == 3) { if (l != HG_NAIVE_L) hgrn_b2(C); mix_pool(C, l); mix_gmlp(C, l);
        if (DIAG == 2) mix_pool_naive(C, l); if (DIAG == 3) mix_gmlp_naive(C, l); }
#endif
#if DIAG == 1
    if constexpr (SP == 4) { hgrn_b3(C, l); { mix_hgrn_naive(C, l); __syncthreads(); } mix_fox(C, l); }
    if constexpr (SP == 5) { if (l == DIAG_LAYER) diag_cmp(C, (const bf16_t*)(C.ws + (DIAG_LAYER == 0 ? WS_XA : WS_TABU)) + 512, NBR, (const bf16_t*)(C.ws + WS_BR) + 512, NBR, 512); }
#elif DIAG == 2 || DIAG == 3
    if constexpr (SP == 4) { hgrn_b3(C, l); mix_fox(C, l); if (l == DIAG_LAYER) diag_cmp(C, (const bf16_t*)(C.ws + (DIAG_LAYER == 0 ? WS_XA : WS_TABU)) + (DIAG == 2 ? 0 : 1024), NBR, (const bf16_t*)(C.ws + WS_BR) + (DIAG == 2 ? 0 : 1024), NBR, 512); }
#else
    if constexpr (SP == 4) { if (l != HG_NAIVE_L) hgrn_b3(C, l); else { mix_hgrn_naive(C, l); __syncthreads(); } mix_fox(C, l); }
#endif
    if constexpr (SP == 5) {
        pg8::Gemm g{(const bf16_t*)(C.ws + WS_XB), (const bf16_t*)(wb + WO_WG), DM, DM, DM, 0, 0};
        pg8::StaticOrder S; S.init(T, NG, C.G, C.bid);
        pg8::Epi8<FGateI8> E{{C.ws + WS_G, C.in[I_BGATE] + l * NG, (const float*)(C.ws + WS_XSA), (const float*)(C.ws + WS_CMAX) + l * (NH + NG) + NH}};
        pg8::gemm_phase<pg8::Epi8<FGateI8>, pg8::StaticOrder, true>(C.lds, g, S, E, C.tid);
    }
    if constexpr (SP == 6) {
        pg8::Gemm g{(const bf16_t*)(C.ws + WS_BR), (const bf16_t*)(wb + WO_WBR), NBR, BW, BW, (size_t)BW, (size_t)DM * BW};
        pg8::ZOrder S; S.init(T, DM, 4, C.G, C.vcu);
        pg8::EpiMerge E{C.ws + WS_G, (bf16_t*)(C.ws + WS_XB)};
        pg8::gemm_phase(C.lds, g, S, E, C.tid);
    }
    if constexpr (SP == 7) {
        const float* xin = (l == 0) ? C.in[I_X] : (const float*)(C.ws + WS_XA);
        pg8::Gemm g{(const bf16_t*)(C.ws + WS_XB), (const bf16_t*)(wb + WO_WOUT), DM, DM, DM, 0, 0};
        pg8::StaticOrder S; S.init(T, DM, C.G, C.bid);
        pg8::Epi8<FResid> E{{xin, (bf16_t*)(C.ws + WS_XC)}};
        pg8::gemm_phase(C.lds, g, S, E, C.tid);
    }
    if constexpr (SP == 8) { p_ln1(C, l); p_conv_tables(C, l); }
    if constexpr (SP == 9) {
        pg8::Gemm g{(const bf16_t*)(C.ws + WS_XB), (const bf16_t*)(wb + WO_WQ), DM, DM, DM, 0, 0};
        pg8::StaticOrder S; S.init(T, NQ, C.G, C.bid);
        pg8::Epi8<FStoreBf16I8> E{{(bf16_t*)(C.ws + WS_Q), NQ, (const float*)(C.ws + WS_XSA), (const float*)(C.ws + WS_CMAX) + DEPTH * (NH + NG) + l * NQ}};
        pg8::gemm_phase<pg8::Epi8<FStoreBf16I8>, pg8::StaticOrder, true>(C.lds, g, S, E, C.tid);
    }
#if TOPK_NAIVE
    if constexpr (SP == 10) p_topk_naive(C, l);
#else
    if constexpr (SP == 10) p_topk(C, l);
#endif
    if constexpr (SP == 11) p_gather(C, l);
}
__device__ __forceinline__ void make_ctx(Ctx& C, const Args& args, unsigned char* lds_raw) {
    C.lds = (LAS unsigned char*)lds_raw; C.ws = args.ws; C.in = args.in; C.out = args.out;
    C.tid = threadIdx.x; C.lane = C.tid & 63; C.wave = __builtin_amdgcn_readfirstlane(C.tid >> 6);
    C.G = gridDim.x; C.bid = blockIdx.x; C.vcu = (C.G % 8 == 0) ? (C.bid % 8) * (C.G / 8) + C.bid / 8 : C.bid;
}
#if !MK_ONE_LAUNCH
template <int SP> __global__ void __launch_bounds__(512, 2) mk_phase(Args args) {
    extern __shared__ __attribute__((aligned(16))) unsigned char lds_raw[];
    Ctx C; make_ctx(C, args, lds_raw);
    run_phase<SP>(C, args.ph_lo);
}
#endif

#define GRID_BAR() xcd_barrier((unsigned*)(args.ws + WS_CTL) + 1024, (volatile LAS unsigned*)((LAS unsigned char*)lds_raw + LDSCTL_OFF + 32))
__global__ void __launch_bounds__(512, 2) mk_fwd(Args args) {
    extern __shared__ __attribute__((aligned(16))) unsigned char lds_raw[];
    Ctx C; make_ctx(C, args, lds_raw);
    { volatile LAS unsigned* misc = (volatile LAS unsigned*)(C.lds + LDSCTL_OFF); if (C.tid < 64) misc[C.tid] = 0u; }
    __syncthreads();
    xcd_barrier_post((unsigned*)(args.ws + WS_CTL) + 1024);
    run_phase<-1>(C, 0); GRID_BAR();
#pragma unroll 1
    for (int l = 0; l < DEPTH; ++l) {
        run_phase<1>(C, l); GRID_BAR();
        run_phase<2>(C, l); GRID_BAR();
        run_phase<3>(C, l); GRID_BAR();
        run_phase<4>(C, l); GRID_BAR();
        run_phase<5>(C, l); GRID_BAR();
        run_phase<6>(C, l); GRID_BAR();
        run_phase<7>(C, l); GRID_BAR();
        run_phase<8>(C, l); GRID_BAR();
        run_phase<9>(C, l); GRID_BAR();
        run_phase<10>(C, l); GRID_BAR();
        run_phase<11>(C, l); if (l + 1 < DEPTH) GRID_BAR();
    }
}

#if !MK_ONE_LAUNCH
template <int SP> static void launch_phase(const Args& a, int grid, hipStream_t stream) {
    static bool attr_done = false;
    if (!attr_done) { (void)hipFuncSetAttribute((const void*)mk_phase<SP>, hipFuncAttributeMaxDynamicSharedMemorySize, LDS_BYTES); attr_done = true; }
    hipLaunchKernelGGL(mk_phase<SP>, dim3(grid), dim3(512), LDS_BYTES, stream, a);
}
#endif
extern "C" void kernel_launch(void* const* d_in, const int* in_sizes, int n_in, void* d_out, int out_size, void* d_ws, size_t ws_size, hipStream_t stream) {
    static int grid = 0;
    if (grid == 0) {
        if (n_in != NIN_PTRS || out_size != T * DM || ws_size < WS_END) { fprintf(stderr, "kernel_launch: unexpected shapes n_in %d out %d ws %zu\n", n_in, out_size, ws_size); grid = -1; return; }
        int dev = 0, cus = 0;
        if (hipGetDevice(&dev) != hipSuccess || hipDeviceGetAttribute(&cus, hipDeviceAttributeMultiprocessorCount, dev) != hipSuccess) { grid = -1; return; }
        grid = cus;
    }
    if (grid < 0) return;
    (void)hipMemsetAsync((char*)d_ws + WS_CTL, 0, CTL_ZERO_BYTES, stream);
    Args a{};
    for (int i = 0; i < NIN_PTRS; ++i) a.in[i] = (const float*)d_in[i];
    a.out = (float*)d_out; a.ws = (unsigned char*)d_ws; a.bar_slot = 0; a.pad = 0; a.ph_hi = 0;
#if MK_ONE_LAUNCH
    static bool attr_done = false;
    if (!attr_done) { (void)hipFuncSetAttribute((const void*)mk_fwd, hipFuncAttributeMaxDynamicSharedMemorySize, LDS_BYTES); attr_done = true; }
    hipLaunchKernelGGL(mk_fwd, dim3(grid), dim3(512), LDS_BYTES, stream, a);
    return;
#endif
#if !MK_ONE_LAUNCH
    a.ph_lo = 0; launch_phase<-1>(a, grid, stream);
    for (int l = 0; l < DEPTH; ++l) {
        a.ph_lo = l;
        launch_phase<0>(a, grid, stream); launch_phase<1>(a, grid, stream); launch_phase<2>(a, grid, stream); launch_phase<3>(a, grid, stream); launch_phase<4>(a, grid, stream);
        launch_phase<5>(a, grid, stream); launch_phase<6>(a, grid, stream); launch_phase<7>(a, grid, stream); launch_phase<8>(a, grid, stream); launch_phase<9>(a, grid, stream); launch_phase<10>(a, grid, stream); launch_phase<11>(a, grid, stream);
    }
#endif
}
```

```cpp
#include <hip/hip_runtime.h>
#include <cstdio>
#include <cstdint>

#ifndef DIAG
#define DIAG 0
#endif
#ifndef DIAG_LO
#define DIAG_LO 0
#endif
#ifndef DIAG_HI
#define DIAG_HI 64
#endif
#ifndef DIAG_MOD
#define DIAG_MOD 64
#endif
#ifndef TOPK_NAIVE
#define TOPK_NAIVE 0
#endif
#ifndef MIX_NAIVE
#define MIX_NAIVE 0
#endif
#ifndef DIAG_N0
#define DIAG_N0 4096
#endif
#ifndef FOX_NAIVE
#define FOX_NAIVE 0
#endif
#ifndef HG_NAIVE_L
#define HG_NAIVE_L 99
#endif
#ifndef DIAG_LAYER
#define DIAG_LAYER 0
#endif
#ifndef MK_ONE_LAUNCH
#define MK_ONE_LAUNCH 1
#endif

#define LAS __attribute__((address_space(3)))
#define GAS __attribute__((address_space(1)))
typedef unsigned short bf16_t;
typedef short bf16x8 __attribute__((ext_vector_type(8)));
typedef float f32x4 __attribute__((ext_vector_type(4)));
typedef float f32x2 __attribute__((ext_vector_type(2)));
typedef unsigned u32x4 __attribute__((ext_vector_type(4)));
typedef unsigned u32x2 __attribute__((ext_vector_type(2)));
typedef unsigned u32x3a __attribute__((ext_vector_type(3), aligned(4)));

constexpr int DM = 1024, BATCH = 2, SEQ = 8192, DEPTH = 2, T = BATCH * SEQ;
constexpr int BW = 512, NIN = 5124, NH = 5120, NG = 4096, NBR = 2048, NQ = 2048;
constexpr int NEXP = 16384, TOPK = 16, PH = 8;
constexpr float ALPHA = 1.4142135623730951f;
constexpr float LN_EPS = 1e-5f, RMS_EPS = 1e-6f;
constexpr int HC_P = 0, HC_HQ = 512, HC_HF = 1024, HC_HI = 1536, HC_HG = 2048, HC_GU = 2560, HC_GV = 3072, HC_FQ = 3584, HC_FK = 4096, HC_FV = 4608;

constexpr size_t MiB = 1u << 20;
constexpr size_t WS_CTL = 0, CTL_ZERO_BYTES = 160 * 1024;
constexpr size_t WS_CMAX = 64 * 1024;
constexpr size_t WS_MISC = 512 * 1024;
constexpr size_t WS_CUM = 768 * 1024;
constexpr size_t WS_W = 1 * MiB;
constexpr size_t W_LAYER = 30 * MiB;
constexpr size_t WO_WIN = 0, WO_WG = 10 * MiB, WO_WBR = 18 * MiB, WO_WOUT = 22 * MiB, WO_WQ = 24 * MiB, WO_KEYS = 28 * MiB, WO_WF = 28 * MiB + 512 * 1024, WO_POOLW = 28 * MiB + 768 * 1024, WO_GWS = 29 * MiB, WO_CS = 29 * MiB + 512 * 1024;
constexpr size_t WS_TABU = 64 * MiB, WS_TABV = 96 * MiB;
constexpr size_t WS_XA = 128 * MiB;
constexpr size_t WS_XB = 192 * MiB;
constexpr size_t WS_X1B = 224 * MiB;
constexpr size_t WS_H = 256 * MiB;
constexpr size_t WS_ST = 416 * MiB;
constexpr size_t WS_BR = 448 * MiB;
constexpr size_t WS_G = 256 * MiB;
constexpr size_t WS_MGF = 384 * MiB;
constexpr size_t WS_XC = 256 * MiB;
constexpr size_t WS_Q = 320 * MiB;
constexpr size_t WS_EIDX = 384 * MiB, WS_EGATE = 392 * MiB;
constexpr size_t WS_XSA = 256 * 1024;
constexpr size_t WS_END = 512 * MiB;

__device__ __forceinline__ float bf2f(unsigned u) { return __builtin_bit_cast(float, u << 16); }
__device__ __forceinline__ unsigned f2bf(float f) { unsigned u = __builtin_bit_cast(unsigned, f); return (u + 0x7fffu + ((u >> 16) & 1u)) >> 16; }
typedef __bf16 bf16x2_t __attribute__((ext_vector_type(2)));
__device__ __forceinline__ unsigned cvtpk(float lo, float hi) { f32x2 v = {lo, hi}; bf16x2_t b = __builtin_convertvector(v, bf16x2_t); return __builtin_bit_cast(unsigned, b); }
__device__ __forceinline__ unsigned pk2(float lo, float hi) { return cvtpk(lo, hi); }
__device__ __forceinline__ float wave_sum(float v) {
#pragma unroll
    for (int o = 32; o > 0; o >>= 1) v += __shfl_xor(v, o, 64);
    return v;
}
__device__ __forceinline__ float sigmoidf_(float x) { return __builtin_amdgcn_rcpf(1.f + __builtin_amdgcn_exp2f(-1.4426950408889634f * x)); }
__device__ __forceinline__ float siluf_(float x) { return x * __builtin_amdgcn_rcpf(1.f + __builtin_amdgcn_exp2f(-1.4426950408889634f * x)); }
__device__ __forceinline__ float geluf_slow(float x) { const float u = 0.7978845608028654f * (x + 0.044715f * x * x * x); return 0.5f * x * (1.f + tanhf(u)); }
__device__ __forceinline__ float geluf_(float x) { const float u2 = -2.302208198f * (x + 0.044715f * x * x * x); return x * __builtin_amdgcn_rcpf(1.f + __builtin_amdgcn_exp2f(u2)); }
__device__ __forceinline__ float logsigmoidf_(float z) { return fminf(z, 0.f) - log1pf(__expf(-fabsf(z))); }

__device__ __forceinline__ unsigned launder_u(unsigned x) { asm volatile("" : "+v"(x)); return __builtin_amdgcn_readfirstlane(x); }
template <class P> __device__ __forceinline__ P launder_ptr(P p) {
    const unsigned lo = launder_u((unsigned)(uintptr_t)p), hi = launder_u((unsigned)((uintptr_t)p >> 32));
    return (P)(((uintptr_t)hi << 32) | lo);
}

namespace pg8 {
constexpr int BM = 256, BK = 64, HALF = 128, HTB = HALF * BK * 2, STAGE_BYTES = 8 * HTB, NXCD = 8, WGM = 8;
__host__ __device__ __forceinline__ int lds_byte(int r, int c) { const int st = (r >> 4) * 2 + (c >> 5), rr = r & 15, cc = c & 31, ob = rr * 64 + cc * 2; return st * 1024 + (ob ^ (((ob >> 9) & 1) << 5)); }
__host__ __device__ __forceinline__ void stage_rc(int b, int& R, int& C) { const int st = b / 1024, sb = b % 1024, swz = sb ^ (((sb >> 9) & 1) << 5); R = (st >> 1) * 16 + swz / 64; C = (st & 1) * 32 + (swz % 64) / 2; }
__host__ __device__ __forceinline__ int perm32(int rho) { const int n = rho >> 4, i = rho & 15; return 8 * (i >> 2) + 4 * n + (i & 3); }

struct Unit { int pm, pn, z; };
struct Gemm { const bf16_t* A; const bf16_t* Bt; int lda, ldb, K; size_t zA, zB; };

struct StaticOrder {
    int nM, nN, nwg, G, c;
    __device__ void init(int M, int N, int G_, int c_) { nM = M / BM; nN = N / BM; nwg = nM * nN; G = G_; c = c_; }
    __device__ bool next(int i, Unit& u) const {
        const long L = (long)i * G + c; if (L >= nwg) return false;
        int wgid = (int)L; { const int q = nwg / NXCD, r = nwg % NXCD, xcd = wgid % NXCD, off = wgid / NXCD; wgid = (xcd < r ? xcd * (q + 1) : r * (q + 1) + (xcd - r) * q) + off; }
        const int nig = WGM * nN, gid = wgid / nig, fm = gid * WGM, gsz = (nM - fm) < WGM ? (nM - fm) : WGM;
        u.pm = fm + ((wgid % nig) % gsz); u.pn = (wgid % nig) / gsz; u.z = 0; return true;
    }
};
struct ZOrder {
    int nM, nN, nZ, ntile, G, c;
    __device__ void init(int M, int N, int Z, int G_, int c_) { nM = M / BM; nN = N / BM; nZ = Z; ntile = nM * nN; G = G_; c = c_; }
    __device__ bool next(int i, Unit& u) const {
        const long L = (long)(i / nZ) * G + c; if (L >= ntile) return false;
        u.pm = (int)L / nN; u.pn = (int)L % nN; u.z = i % nZ; return true;
    }
};

template <class F> struct Epi8 {
    static constexpr bool PERM = true;
    F f;
    __device__ __forceinline__ bool keep(const Unit&) const { return false; }
    __device__ __forceinline__ void operator()(const f32x4 (&acc)[2][2][4][2], const Unit& u, int wr, int wc, int fr, int fq) const {
        const int row0 = u.pm * BM + wr * 64 + fr, col0 = u.pn * BM + wc * 32 + 8 * fq;
#pragma unroll
        for (int ai = 0; ai < 2; ++ai)
#pragma unroll
            for (int m = 0; m < 4; ++m)
#pragma unroll
                for (int bj = 0; bj < 2; ++bj) f(row0 + ai * HALF + m * 16, col0 + bj * HALF, acc[ai][bj][m][0], acc[ai][bj][m][1], u.z);
    }
};
template <class F> struct Epi4 {
    static constexpr bool PERM = false;
    F f;
    __device__ __forceinline__ bool keep(const Unit&) const { return false; }
    __device__ __forceinline__ void operator()(const f32x4 (&acc)[2][2][4][2], const Unit& u, int wr, int wc, int fr, int fq) const {
        const int row0 = u.pm * BM + wr * 64 + fr, col0 = u.pn * BM + wc * 32 + 4 * fq;
#pragma unroll
        for (int ai = 0; ai < 2; ++ai)
#pragma unroll
            for (int m = 0; m < 4; ++m)
#pragma unroll
                for (int bj = 0; bj < 2; ++bj)
#pragma unroll
                    for (int n = 0; n < 2; ++n) f(row0 + ai * HALF + m * 16, col0 + bj * HALF + n * 16, acc[ai][bj][m][n], u.z);
    }
};

struct EpiMerge {
    static constexpr bool PERM = true;
    const unsigned char* G; bf16_t* MG;
    __device__ __forceinline__ bool keep(const Unit& u) const { return u.z < 3; }
    __device__ __forceinline__ void operator()(f32x4 (&acc)[2][2][4][2], const Unit& u, int wr, int wc, int fr, int fq) const {
        const int row0 = u.pm * BM + wr * 64 + fr, col0 = u.pn * BM + wc * 32 + 8 * fq;
        const unsigned char* gp0 = G + (size_t)row0 * NG + u.z * DM + col0;
        if (u.z < 3) {
#pragma unroll
            for (int ai = 0; ai < 2; ++ai)
#pragma unroll
                for (int m = 0; m < 4; ++m) {
                    if ((m & 1) == 0) asm volatile("" ::: "memory");
#pragma unroll
                    for (int bj = 0; bj < 2; ++bj) {
                        const unsigned char* gp = gp0 + (size_t)(ai * HALF + m * 16) * NG + bj * HALF;
                        const u32x2 ga = *(const u32x2*)gp, gb = *(const u32x2*)(gp + DM);
#pragma unroll
                        for (int n = 0; n < 2; ++n)
#pragma unroll
                            for (int e = 0; e < 4; ++e) {
                                const float qa = (float)((ga[n] >> (8 * e)) & 255u), qb = (float)((gb[n] >> (8 * e)) & 255u);
                                acc[ai][bj][m][n][e] *= qa * __builtin_amdgcn_rcpf(qb); }
                    }
                }
        } else {
            bf16_t* op0 = MG + (size_t)row0 * DM + col0;
#pragma unroll
            for (int ai = 0; ai < 2; ++ai)
#pragma unroll
                for (int m = 0; m < 4; ++m)
#pragma unroll
                    for (int bj = 0; bj < 2; ++bj) {
                        const u32x2 ga = *(const u32x2*)(gp0 + (size_t)(ai * HALF + m * 16) * NG + bj * HALF);
                        u32x4 o;
#pragma unroll
                        for (int n = 0; n < 2; ++n)
#pragma unroll
                            for (int e2 = 0; e2 < 2; ++e2) {
                                const float q0 = (float)((ga[n] >> (16 * e2)) & 255u) * (1.f / 255.f), q1 = (float)((ga[n] >> (16 * e2 + 8)) & 255u) * (1.f / 255.f);
                                o[2 * n + e2] = cvtpk(acc[ai][bj][m][n][2 * e2] * q0, acc[ai][bj][m][n][2 * e2 + 1] * q1); }
                        *(u32x4*)(op0 + (size_t)(ai * HALF + m * 16) * DM + bj * HALF) = o;
                    }
        }
    }
};

typedef int i32x4 __attribute__((ext_vector_type(4)));
template <class Epi, class Sched, bool I8 = false, bool ALIGN_EPI = true>
__device__ __forceinline__ void gemm_phase(LAS unsigned char* lds, const Gemm g, const Sched& S, const Epi& E, const int tid) {
    constexpr int ES = I8 ? 1 : 2;
    const int wid = __builtin_amdgcn_readfirstlane(tid >> 6), lane = tid & 63, wr = wid >> 2, wc = wid & 3, fr = lane & 15, fq = lane >> 4;
    const int K = g.K, nt = K * ES / 128;
    unsigned voffA[2], voffB[2];
#pragma unroll
    for (int i = 0; i < 2; ++i) { int R, C; stage_rc(tid * 16 + i * 8192, R, C); const int Rb = Epi::PERM ? ((R & ~31) + perm32(R & 31)) : R;
        voffA[i] = (unsigned)(R * g.lda * ES + C * 2); voffB[i] = (unsigned)(Rb * g.ldb * ES + C * 2); }
    const size_t kstep = (size_t)(BK * 2);
    const size_t hstepA = (size_t)HALF * g.lda * ES, hstepB = (size_t)HALF * g.ldb * ES;
    const size_t tstepA = 2 * hstepA, tstepB = 2 * hstepB;
    const unsigned ldsw = (unsigned)wid * 1024u;
    const int aoff = lds_byte(wr * 64 + fr, fq * 8), boff = lds_byte(wc * 32 + fr, fq * 8);
#define PG8_SA(b, h) (((b) * 2 + (h)) * HTB)
#define PG8_SB(b, h) ((4 + (b) * 2 + (h)) * HTB)
#define PG8_STAGE(bufoff, gbase, voff) do { _Pragma("unroll") for (int _i = 0; _i < 2; ++_i) \
        __builtin_amdgcn_global_load_lds((const unsigned*)((const char*)(gbase) + (voff)[_i]), (LAS unsigned*)(lds + (bufoff) + ldsw + _i * 8192), 16, 0, 0); } while (0)
#define PG8_LDA(dst, b, h) do { _Pragma("unroll") for (int m = 0; m < 4; ++m) _Pragma("unroll") for (int k = 0; k < 2; ++k) dst[m][k] = *(const LAS bf16x8*)(lds + PG8_SA(b, h) + aoff + m * 2048 + k * 1024); } while (0)
#define PG8_LDB(dst, b, h) do { _Pragma("unroll") for (int n = 0; n < 2; ++n) _Pragma("unroll") for (int k = 0; k < 2; ++k) dst[n][k] = *(const LAS bf16x8*)(lds + PG8_SB(b, h) + boff + n * 2048 + k * 1024); } while (0)
#define PG8_MMA(ai, bj, At, Bt) do { __builtin_amdgcn_s_setprio(1); _Pragma("unroll") for (int m = 0; m < 4; ++m) _Pragma("unroll") for (int n = 0; n < 2; ++n) _Pragma("unroll") for (int k = 0; k < 2; ++k) { \
        if constexpr (I8) acc[ai][bj][m][n] = __builtin_bit_cast(f32x4, __builtin_amdgcn_mfma_i32_16x16x64_i8(__builtin_bit_cast(i32x4, Bt[n][k]), __builtin_bit_cast(i32x4, At[m][k]), __builtin_bit_cast(i32x4, acc[ai][bj][m][n]), 0, 0, 0)); \
        else acc[ai][bj][m][n] = __builtin_amdgcn_mfma_f32_16x16x32_bf16(Bt[n][k], At[m][k], acc[ai][bj][m][n], 0, 0, 0); } __builtin_amdgcn_s_setprio(0); } while (0)
#define PG8_WAIT_V(n) asm volatile("s_waitcnt vmcnt(" #n ")" ::: "memory")
#define PG8_WAIT_L(n) asm volatile("s_waitcnt lgkmcnt(" #n ")" ::: "memory")
#define PG8_BAR __builtin_amdgcn_s_barrier()
#define PG8_SCHED __builtin_amdgcn_sched_barrier(0)
    Unit cur, nxt; int ui = 0;
    if (!S.next(0, cur)) return;
    f32x4 acc[2][2][4][2];
#pragma unroll
    for (int a = 0; a < 2; ++a)
#pragma unroll
        for (int b = 0; b < 2; ++b)
#pragma unroll
            for (int m = 0; m < 4; ++m)
#pragma unroll
                for (int n = 0; n < 2; ++n) acc[a][b][m][n] = (f32x4){0.f, 0.f, 0.f, 0.f};
    bf16x8 At[4][2], B0[2][2], B1[2][2];
    const char* cA = (const char*)g.A + (size_t)cur.z * g.zA * ES + (size_t)cur.pm * tstepA; const char* cB = (const char*)g.Bt + (size_t)cur.z * g.zB * ES + (size_t)cur.pn * tstepB;
    PG8_STAGE(PG8_SB(0, 0), cB, voffB); PG8_STAGE(PG8_SB(0, 1), cB + hstepB, voffB); PG8_STAGE(PG8_SA(0, 0), cA, voffA); PG8_STAGE(PG8_SA(0, 1), cA + hstepA, voffA);
    if (wr == 1) PG8_BAR;
    PG8_WAIT_V(2); PG8_BAR;
    PG8_STAGE(PG8_SB(1, 0), cB + kstep, voffB); PG8_STAGE(PG8_SA(1, 0), cA + kstep, voffA); PG8_STAGE(PG8_SB(1, 1), cB + hstepB + kstep, voffB);
    PG8_WAIT_V(6); PG8_BAR;
    for (;;) {
        const bool has_next = S.next(ui + 1, nxt);
        const char* nA = has_next ? (const char*)g.A + (size_t)nxt.z * g.zA * ES + (size_t)nxt.pm * tstepA : cA;
        const char* nB = has_next ? (const char*)g.Bt + (size_t)nxt.z * g.zB * ES + (size_t)nxt.pn * tstepB : cB;
        for (int t = 0; t < nt; t += 2) {
            const bool last = (t == nt - 2);
            const char* a1 = cA + (size_t)(t + 1) * kstep;
            const char* a2 = last ? nA : cA + (size_t)(t + 2) * kstep; const char* b2 = last ? nB : cB + (size_t)(t + 2) * kstep;
            const char* a3 = a2 + kstep; const char* b3 = b2 + kstep;
            PG8_LDB(B0, 0, 0); PG8_LDB(B1, 0, 1); PG8_SCHED; PG8_LDA(At, 0, 0); PG8_STAGE(PG8_SA(1, 1), a1 + hstepA, voffA);
            PG8_WAIT_V(8); PG8_WAIT_L(0); PG8_BAR; PG8_MMA(0, 0, At, B0); PG8_MMA(0, 1, At, B1); PG8_BAR; PG8_SCHED;
            PG8_LDA(At, 0, 1); PG8_STAGE(PG8_SB(0, 0), b2, voffB); PG8_STAGE(PG8_SB(0, 1), b2 + hstepB, voffB); PG8_STAGE(PG8_SA(0, 0), a2, voffA);
            PG8_WAIT_V(8); PG8_WAIT_L(0); PG8_BAR; PG8_MMA(1, 0, At, B0); PG8_MMA(1, 1, At, B1); PG8_BAR; PG8_SCHED;
            PG8_LDB(B0, 1, 0); PG8_LDB(B1, 1, 1); PG8_SCHED; PG8_LDA(At, 1, 0); PG8_STAGE(PG8_SA(0, 1), a2 + hstepA, voffA);
            PG8_WAIT_V(8); PG8_WAIT_L(0); PG8_BAR; PG8_MMA(0, 0, At, B0); PG8_MMA(0, 1, At, B1); PG8_BAR; PG8_SCHED;
            PG8_LDA(At, 1, 1); PG8_STAGE(PG8_SB(1, 0), b3, voffB); PG8_STAGE(PG8_SB(1, 1), b3 + hstepB, voffB); PG8_STAGE(PG8_SA(1, 0), a3, voffA);
            PG8_WAIT_V(8); PG8_WAIT_L(0); PG8_BAR; PG8_MMA(1, 0, At, B0); PG8_MMA(1, 1, At, B1); PG8_BAR; PG8_SCHED;
        }
        if constexpr (ALIGN_EPI) { if (wr == 0) PG8_BAR; }
        E(acc, cur, wr, wc, fr, fq);
        if (!has_next) break;
        if (!E.keep(cur)) {
#pragma unroll
            for (int a = 0; a < 2; ++a)
#pragma unroll
                for (int b = 0; b < 2; ++b)
#pragma unroll
                    for (int m = 0; m < 4; ++m)
#pragma unroll
                        for (int n = 0; n < 2; ++n) acc[a][b][m][n] = (f32x4){0.f, 0.f, 0.f, 0.f};
        }
        cur = nxt; cA = nA; cB = nB; ++ui;
        if constexpr (ALIGN_EPI) { if (wr == 1) PG8_BAR; }
    }
    PG8_WAIT_V(0);
    if constexpr (!ALIGN_EPI) { if (wr == 0) PG8_BAR; }
    PG8_BAR;
#undef PG8_SA
#undef PG8_SB
#undef PG8_STAGE
#undef PG8_LDA
#undef PG8_LDB
#undef PG8_MMA
#undef PG8_WAIT_V
#undef PG8_WAIT_L
#undef PG8_BAR
#undef PG8_SCHED
}
}

#define XB_TMO      128
#define XB_XCNT(j)  (256  + 64 * (j))
#define XB_XSUB(j)  (1280 + 64 * (j))
#define XB_XGEN(j)  (2304 + 64 * (j))
#define XB_TOP      3328
#define XB_TOPGEN   3392
#define XCD_BAR_WORDS 3456
#define XB_SPIN_CAP (1u << 22)
__device__ __forceinline__ unsigned xb_ld(unsigned* p)              { return __hip_atomic_load(p, __ATOMIC_RELAXED, __HIP_MEMORY_SCOPE_AGENT); }
__device__ __forceinline__ unsigned xb_add(unsigned* p, unsigned v) { return __hip_atomic_fetch_add(p, v, __ATOMIC_RELAXED, __HIP_MEMORY_SCOPE_AGENT); }
__device__ __forceinline__ unsigned xb_xcc_id() { return (unsigned)__builtin_amdgcn_s_getreg((3 << 11) | 20) & 0xFu; }
#define XB_SPIN(cond, bar) do { unsigned _sp = 0; while (cond) { __builtin_amdgcn_s_sleep(1); \
    if ((++_sp & 255u) == 0u) { if (xb_ld(&(bar)[XB_TMO])) break; if (_sp > XB_SPIN_CAP) { atomicAdd(&(bar)[XB_TMO], 1u); break; } } } } while (0)
__device__ __forceinline__ void xcd_barrier_post(unsigned* bar) {
    if (threadIdx.x == 0) (void)xb_add(&bar[XB_XCNT(xb_xcc_id())], 1u);
}
__device__ __forceinline__ void xcd_barrier_complete(unsigned* bar, unsigned x, unsigned& nloc, unsigned& nx) {
    const unsigned G = gridDim.x * gridDim.y * gridDim.z;
    unsigned sum, cnt, mine, sp = 0u;
    for (;;) {
        sum = 0u; cnt = 0u; mine = 0u;
#pragma unroll
        for (unsigned j = 0; j < 16; ++j) { const unsigned c = xb_ld(&bar[XB_XCNT(j)]); sum += c; cnt += (c > 0u) ? 1u : 0u; mine = (j == x) ? c : mine; }
        if (sum == G) break;
        __builtin_amdgcn_s_sleep(1);
        if ((++sp & 255u) == 0u) { if (xb_ld(&bar[XB_TMO])) break; if (sp > XB_SPIN_CAP) { atomicAdd(&bar[XB_TMO], 1u); break; } }
    }
    nloc = mine > 0u ? mine : 1u; nx = cnt > 0u ? cnt : 1u;
}
__device__ __noinline__ void xcd_barrier_leader(unsigned* bar, volatile LAS unsigned* st) {
    const unsigned x = xb_xcc_id();
    __builtin_amdgcn_s_waitcnt(0);
    unsigned nloc = st[0], nx = st[1];
    if (nloc == 0u) { xcd_barrier_complete(bar, x, nloc, nx); st[0] = nloc; st[1] = nx; }
    const unsigned old = xb_add(&bar[XB_XSUB(x)], 1u);
    const unsigned gen = old / nloc;
    if (old + 1u == (gen + 1u) * nloc) {
        __builtin_amdgcn_fence(__ATOMIC_RELEASE, "agent");
        asm volatile("s_waitcnt vmcnt(0)" ::: "memory");
        const unsigned og = xb_add(&bar[XB_TOP], 1u);
        const unsigned tg = og / nx;
        if (og + 1u == (tg + 1u) * nx) xb_add(&bar[XB_TOPGEN], 1u);
        else XB_SPIN(xb_ld(&bar[XB_TOPGEN]) == tg, bar);
        __builtin_amdgcn_fence(__ATOMIC_ACQUIRE, "agent");
        xb_add(&bar[XB_XGEN(x)], 1u);
        asm volatile("s_waitcnt vmcnt(0)" ::: "memory");
    } else {
        XB_SPIN(xb_ld(&bar[XB_XGEN(x)]) == gen, bar);
        __builtin_amdgcn_fence(__ATOMIC_ACQUIRE, "agent");
        asm volatile("s_waitcnt vmcnt(0)" ::: "memory");
    }
}
__device__ __forceinline__ void xcd_barrier(unsigned* bar, volatile LAS unsigned* st) {
    asm volatile("s_waitcnt vmcnt(0)" ::: "memory");
    __syncthreads();
    if (threadIdx.x == 0) xcd_barrier_leader(bar, st);
    __syncthreads();
}

constexpr int NIN_PTRS = 23;
struct Args { const float* in[NIN_PTRS]; float* out; unsigned char* ws; int ph_lo, ph_hi, bar_slot, pad; };
enum { I_X = 0, I_WIN, I_BFOX, I_POOLW, I_POOLS, I_LBL, I_HNG, I_GLNG, I_GLNB, I_GWS, I_GBS, I_WGATE, I_BGATE, I_WBR, I_WOUT, I_LN1G, I_LN1B, I_WQ, I_KEYS, I_PU, I_PV, I_LN2G, I_LN2B };

constexpr int LDS_BYTES = 147456;
constexpr int LDSCTL_OFF = 143360;

struct Ctx {
    LAS unsigned char* lds;
    unsigned char* ws;
    const float* const* in;
    float* out;
    int tid, lane, wave, G, bid, vcu;
};

__device__ __forceinline__ void tconv_job(const Ctx& C, const float* src, int ld_src, int K, int N, bf16_t* dst) {
    LAS float* tile = (LAS float*)C.lds;
    const int nk = K / 64, nn = N / 64, ntiles = nk * nn;
    for (int tl = C.bid; tl < ntiles; tl += C.G) {
        const int k0 = (tl / nn) * 64, n0 = (tl % nn) * 64;
#pragma unroll
        for (int p = 0; p < 2; ++p) {
            const int kr = (C.tid >> 4) + p * 32, nc = (C.tid & 15) * 4;
            const f32x4 v = *(const f32x4*)(src + (size_t)(k0 + kr) * ld_src + n0 + nc);
            tile[kr * 65 + nc + 0] = v[0]; tile[kr * 65 + nc + 1] = v[1]; tile[kr * 65 + nc + 2] = v[2]; tile[kr * 65 + nc + 3] = v[3];
        }
        __syncthreads();
        {
            const int n = C.tid >> 3, k8 = (C.tid & 7) * 8;
            u32x4 o;
#pragma unroll
            for (int j = 0; j < 4; ++j) o[j] = pk2(tile[(k8 + 2 * j) * 65 + n], tile[(k8 + 2 * j + 1) * 65 + n]);
            *(u32x4*)(dst + (size_t)(n0 + n) * K + k0 + k8) = o;
        }
        __syncthreads();
    }
}
__device__ __forceinline__ void cvt_copy(const Ctx& C, const float* src, bf16_t* dst, size_t n) {
    const size_t n8 = n / 8;
    for (size_t i = (size_t)C.bid * 512 + C.tid; i < n8; i += (size_t)C.G * 512) {
        const f32x4 a = *(const f32x4*)(src + i * 8), b = *(const f32x4*)(src + i * 8 + 4);
        u32x4 o; o[0] = pk2(a[0], a[1]); o[1] = pk2(a[2], a[3]); o[2] = pk2(b[0], b[1]); o[3] = pk2(b[2], b[3]);
        *(u32x4*)(dst + i * 8) = o;
    }
}
__device__ __forceinline__ void strip_unit(const Ctx& C, const float* src, int ld, unsigned char* dst, unsigned* cmax, bool split) {
    const float* p = src + (size_t)(128 * C.wave) * ld + C.lane;
    float v[128];
#pragma unroll
    for (int i = 0; i < 128; ++i) v[i] = p[(size_t)i * ld];
    if (cmax) {
        float mx = 0.f;
#pragma unroll
        for (int i = 0; i < 128; ++i) mx = fmaxf(mx, fabsf(v[i]));
        LAS float* red = (LAS float*)C.lds;
        red[C.wave * 64 + C.lane] = mx;
        __syncthreads();
        float m = red[C.lane];
#pragma unroll
        for (int w2 = 1; w2 < 8; ++w2) m = fmaxf(m, red[w2 * 64 + C.lane]);
        if (C.wave == 0) cmax[C.lane] = __builtin_bit_cast(unsigned, m);
        const float isc = 127.f / fmaxf(m, 1e-30f);
        unsigned char* dp = dst + (size_t)C.lane * 1024 + 128 * C.wave;
#pragma unroll
        for (int j4 = 0; j4 < 8; ++j4) { u32x4 o;
#pragma unroll
            for (int j = 0; j < 4; ++j) { unsigned wd = 0u;
#pragma unroll
                for (int e = 0; e < 4; ++e) wd |= ((unsigned)(int)rintf(v[16 * j4 + 4 * j + e] * isc) & 255u) << (8 * e);
                o[j] = wd; }
            *(u32x4*)(dp + 16 * j4) = o; }
        __syncthreads();
    } else {
        bf16_t* dp = split ? (bf16_t*)dst + (size_t)(C.wave >> 2) * DM * BW + (size_t)C.lane * BW + 128 * (C.wave & 3) : (bf16_t*)dst + (size_t)C.lane * 1024 + 128 * C.wave;
#pragma unroll
        for (int j8 = 0; j8 < 16; ++j8) { u32x4 o;
#pragma unroll
            for (int j = 0; j < 4; ++j) o[j] = pk2(v[8 * j8 + 2 * j], v[8 * j8 + 2 * j + 1]);
            *(u32x4*)(dp + 8 * j8) = o; }
    }
}
__device__ __forceinline__ void p_conv_weights(const Ctx& C) {
#pragma unroll 1
    for (int u = C.bid; u < DEPTH * 224; u += C.G) {
        const int l = u / 224, r = u % 224;
        unsigned char* wb = C.ws + WS_W + (size_t)l * W_LAYER;
        unsigned* cm = (unsigned*)(C.ws + WS_CMAX) + l * (NH + NG);
        const float* src; int ld; unsigned char* dst; unsigned* cx = nullptr; bool split = false;
        if (r < 80)       { src = C.in[I_WIN] + (size_t)l * DM * NIN + r * 64; ld = NIN; dst = wb + WO_WIN + (size_t)r * 64 * DM; cx = cm + r * 64; }
        else if (r < 144) { const int t = r - 80; src = C.in[I_WGATE] + (size_t)l * DM * NG + t * 64; ld = NG; dst = wb + WO_WG + (size_t)t * 64 * DM; cx = cm + NH + t * 64; }
        else if (r < 176) { const int t = r - 144, pr = t >> 4, nt = t & 15; src = C.in[I_WBR] + ((size_t)l * 4 + 2 * pr) * BW * DM + nt * 64; ld = DM; split = true;
                            dst = wb + WO_WBR + ((size_t)(2 * pr) * DM * BW + (size_t)nt * 64 * BW) * 2; }
        else if (r < 192) { const int nt = r - 176; src = C.in[I_WOUT] + (size_t)l * DM * DM + nt * 64; ld = DM; dst = wb + WO_WOUT + (size_t)nt * 64 * DM * 2; }
        else              { const int nt = r - 192; src = C.in[I_WQ] + (size_t)l * DM * NQ + nt * 64; ld = NQ; dst = wb + WO_WQ + (size_t)nt * 64 * DM; cx = (unsigned*)(C.ws + WS_CMAX) + DEPTH * (NH + NG) + l * NQ + nt * 64; }
        strip_unit(C, src, ld, dst, cx, split);
    }
    for (int l = 0; l < DEPTH; ++l) {
        unsigned char* wb = C.ws + WS_W + (size_t)l * W_LAYER;
        cvt_copy(C, C.in[I_KEYS] + (size_t)l * 2 * PH * 128 * 128, (bf16_t*)(wb + WO_KEYS), (size_t)2 * PH * 128 * 128);
        for (int g = 0; g < 4; ++g)
            tconv_job(C, C.in[I_POOLW] + ((size_t)l * 4 + g) * 128 * 128, 128, 128, 128, (bf16_t*)(wb + WO_POOLW) + (size_t)g * 128 * 128);
        {
            bf16_t* gw = (bf16_t*)(wb + WO_GWS); const float* src = C.in[I_GWS] + (size_t)l * 4 * 128 * 128;
            for (int i = C.bid * 512 + C.tid; i < 4 * 128 * 128; i += C.G * 512) { const int t = (i >> 7) & 127, sx = i & 127; gw[i] = (bf16_t)f2bf(sx <= t ? src[i] : 0.f); }
        }
        float* wf = (float*)(wb + WO_WF);
        for (int i = C.bid * 512 + C.tid; i < 4 * DM; i += C.G * 512) { const int h = i / DM, k = i % DM; wf[i] = C.in[I_WIN][(size_t)l * DM * NIN + (size_t)k * NIN + NH + h]; }
    }
}
constexpr size_t WS_U8 = WS_TABU, WS_V8 = WS_TABU + 16 * MiB, WS_SU = WS_TABU + 32 * MiB, WS_SV = WS_SU + 64 * 1024;
__device__ __forceinline__ float wave_max(float v) {
#pragma unroll
    for (int o = 32; o > 0; o >>= 1) v = fmaxf(v, __shfl_xor(v, o, 64));
    return v;
}
template <bool SIGNED> __device__ __forceinline__ void quant_rows(const Ctx& C, const float* src, unsigned char* dst, float* scl) {
    for (int row = C.bid * 8 + C.wave; row < NEXP; row += C.G * 8) {
        const float* p = src + (size_t)row * DM + C.lane * 16;
        f32x4 v[4]; float mx = 0.f;
#pragma unroll
        for (int i = 0; i < 4; ++i) { v[i] = *(const f32x4*)(p + 4 * i);
#pragma unroll
            for (int e = 0; e < 4; ++e) mx = fmaxf(mx, fabsf(v[i][e])); }
        mx = fmaxf(wave_max(mx), 1e-30f);
        const float sc = mx * (1.f / 127.f), isc = 127.f / mx;
        u32x4 o;
#pragma unroll
        for (int i = 0; i < 4; ++i) { unsigned wd = 0u;
#pragma unroll
            for (int e = 0; e < 4; ++e) { const int q = (int)rintf(v[i][e] * isc) + (SIGNED ? 0 : 128); wd |= ((unsigned)q & 255u) << (8 * e); }
            o[i] = wd; }
        *(u32x4*)(dst + (size_t)row * DM + C.lane * 16) = o;
        if (C.lane == 0) scl[row] = sc;
    }
}
constexpr int V6_ROW = 512;
__device__ __forceinline__ void quant_rows6(const Ctx& C, const float* src, unsigned char* dst, float* scl) {
    for (int row = C.bid * 8 + C.wave; row < NEXP; row += C.G * 8) {
        const float* p = src + (size_t)row * DM + C.lane * 16;
        f32x4 v[4]; float mx = 0.f;
#pragma unroll
        for (int i = 0; i < 4; ++i) { v[i] = *(const f32x4*)(p + 4 * i);
#pragma unroll
            for (int e = 0; e < 4; ++e) mx = fmaxf(mx, fabsf(v[i][e])); }
        mx = fmaxf(wave_max(mx), 1e-30f);
        const float sc = mx * (1.f / 6.f), isc = 6.f / mx;
        u32x2 o = {0u, 0u};
#pragma unroll
        for (int i = 0; i < 4; ++i)
#pragma unroll
            for (int e = 0; e < 4; ++e) { const float xv = v[i][e], a = fabsf(xv) * isc; const int k = 4 * i + e;
                unsigned c = (a < 2.f) ? (unsigned)rintf(a * 2.f) : (a < 4.f) ? 4u + (unsigned)rintf(a - 2.f) : min(6u + (unsigned)rintf((a - 4.f) * 0.5f), 7u);
                c |= (xv < 0.f) ? 8u : 0u;
                o[k >> 3] |= c << (4 * (k & 7)); }
        *(u32x2*)(dst + (size_t)row * V6_ROW + C.lane * 8) = o;
        if (C.lane == 0) scl[row] = sc;
    }
}
__device__ __forceinline__ void p_conv_tables(const Ctx& C, int l) {
    quant_rows6(C, C.in[I_PU] + (size_t)l * NEXP * DM, C.ws + WS_U8, (float*)(C.ws + WS_SU));
    quant_rows6(C, C.in[I_PV] + (size_t)l * NEXP * DM, C.ws + WS_V8, (float*)(C.ws + WS_SV));
}

__device__ __forceinline__ void row_emit(const Ctx& C, int row, const float (&v)[16], int l, bool want_lsig) {
    {
        float mx = 0.f;
#pragma unroll
        for (int j = 0; j < 16; ++j) mx = fmaxf(mx, fabsf(v[j]));
#pragma unroll
        for (int o = 32; o > 0; o >>= 1) mx = fmaxf(mx, __shfl_xor(mx, o, 64));
        mx = fmaxf(mx, 1e-30f);
        const float isc = 127.f / mx;
        unsigned char* xb = C.ws + WS_XB + (size_t)row * DM;
        u32x2 o0, o1;
#pragma unroll
        for (int hw = 0; hw < 2; ++hw) { unsigned a = 0u, b = 0u;
#pragma unroll
            for (int e = 0; e < 4; ++e) { a |= ((unsigned)(int)rintf(v[4 * hw + e] * isc) & 255u) << (8 * e); b |= ((unsigned)(int)rintf(v[8 + 4 * hw + e] * isc) & 255u) << (8 * e); }
            o0[hw] = a; o1[hw] = b; }
        *(u32x2*)(xb + C.lane * 8) = o0; *(u32x2*)(xb + 512 + C.lane * 8) = o1;
        if (C.lane == 0) ((float*)(C.ws + WS_XSA))[row] = mx * (1.f / 127.f);
    }
    if (want_lsig) {
        const float* wf = (const float*)(C.ws + WS_W + (size_t)l * W_LAYER + WO_WF);
        float* lsig = (float*)(C.ws + WS_MISC);
#pragma unroll
        for (int h = 0; h < 4; ++h) {
            const f32x4 a0 = *(const f32x4*)(wf + h * DM + C.lane * 8), a1 = *(const f32x4*)(wf + h * DM + C.lane * 8 + 4);
            const f32x4 b0 = *(const f32x4*)(wf + h * DM + 512 + C.lane * 8), b1 = *(const f32x4*)(wf + h * DM + 512 + C.lane * 8 + 4);
            float s = 0.f;
#pragma unroll
            for (int j = 0; j < 4; ++j) s += v[j] * a0[j] + v[4 + j] * a1[j] + v[8 + j] * b0[j] + v[12 + j] * b1[j];
            s = wave_sum(s);
            if (C.lane == 0) lsig[(size_t)row * 4 + h] = logsigmoidf_(s + C.in[I_BFOX][l * 4 + h]);
        }
    }
}
__device__ __forceinline__ void load_row16(const float* p, int lane, float (&v)[16]) {
    const f32x4 a0 = *(const f32x4*)(p + lane * 8), a1 = *(const f32x4*)(p + lane * 8 + 4), b0 = *(const f32x4*)(p + 512 + lane * 8), b1 = *(const f32x4*)(p + 512 + lane * 8 + 4);
#pragma unroll
    for (int j = 0; j < 4; ++j) { v[j] = a0[j]; v[4 + j] = a1[j]; v[8 + j] = b0[j]; v[12 + j] = b1[j]; }
}
__device__ __forceinline__ void store_row16(float* p, int lane, const float (&v)[16]) {
    *(f32x4*)(p + lane * 8) = (f32x4){v[0], v[1], v[2], v[3]}; *(f32x4*)(p + lane * 8 + 4) = (f32x4){v[4], v[5], v[6], v[7]};
    *(f32x4*)(p + 512 + lane * 8) = (f32x4){v[8], v[9], v[10], v[11]}; *(f32x4*)(p + 512 + lane * 8 + 4) = (f32x4){v[12], v[13], v[14], v[15]};
}
__device__ __forceinline__ void ln_row16(float (&v)[16], const float* g, const float* b, int lane) {
    float s = 0.f;
#pragma unroll
    for (int j = 0; j < 16; ++j) s += v[j];
    const float mean = wave_sum(s) * (1.f / DM);
    float q = 0.f;
#pragma unroll
    for (int j = 0; j < 16; ++j) { const float d = v[j] - mean; q += d * d; }
    const float rstd = rsqrtf(wave_sum(q) * (1.f / DM) + LN_EPS);
    float gg[16], bb[16];
    load_row16(g, lane, gg); load_row16(b, lane, bb);
#pragma unroll
    for (int j = 0; j < 16; ++j) v[j] = (v[j] - mean) * rstd * gg[j] + bb[j];
}
__device__ __forceinline__ void p_rowpass0(const Ctx& C) {
    const float* wfin = C.in[I_WIN] + NH;
    f32x4 wv[16];
#pragma unroll
    for (int j = 0; j < 16; ++j) { const int k = (j < 8) ? C.lane * 8 + j : 512 + C.lane * 8 + (j - 8); wv[j] = *(const f32x4*)(wfin + (size_t)k * NIN); }
    float* lsig = (float*)(C.ws + WS_MISC);
    const bool bal = (C.G == 256);
    const int c0 = bal ? ((C.bid < 192) ? C.bid * 6 : 1152 + (C.bid - 192) * 14) : C.bid, cn = bal ? ((C.bid < 192) ? 6 : 14) : (T / 8 - C.bid + C.G - 1) / C.G, cs = bal ? 1 : C.G;
    for (int ci = 0; ci < cn; ++ci) {
        const int row = (c0 + ci * cs) * 8 + C.wave;
        float v[16]; load_row16(C.in[I_X] + (size_t)row * DM, C.lane, v);
        row_emit(C, row, v, 0, false);
#pragma unroll
        for (int h = 0; h < 4; ++h) {
            float sacc = 0.f;
#pragma unroll
            for (int j = 0; j < 16; ++j) sacc += v[j] * wv[j][h];
            sacc = wave_sum(sacc);
            if (C.lane == 0) lsig[(size_t)row * 4 + h] = logsigmoidf_(sacc + C.in[I_BFOX][h]);
        }
    }
}
__device__ __forceinline__ void p_cumsum(const Ctx& C) {
    if (C.bid >= BATCH * 4) return;
    const float* lsig = (const float*)(C.ws + WS_MISC);
    float* cum = (float*)(C.ws + WS_CUM);
    LAS float* wt = (LAS float*)C.lds;
    const int b = C.bid >> 2, h = C.bid & 3;
    float v[16];
#pragma unroll
    for (int j = 0; j < 16; ++j) v[j] = lsig[((size_t)b * SEQ + C.tid * 16 + j) * 4 + h];
#pragma unroll
    for (int j = 1; j < 16; ++j) v[j] += v[j - 1];
    float inc = v[15];
#pragma unroll
    for (int o = 1; o < 64; o <<= 1) { const float t = __shfl_up(inc, o, 64); if (C.lane >= o) inc += t; }
    if (C.lane == 63) wt[C.wave] = inc;
    __syncthreads();
    float off = inc - v[15];
    for (int w2 = 0; w2 < C.wave; ++w2) off += wt[w2];
    float* cp = cum + ((size_t)b * 4 + h) * SEQ + C.tid * 16;
#pragma unroll
    for (int j4 = 0; j4 < 4; ++j4) *(f32x4*)(cp + 4 * j4) = (f32x4){v[4 * j4] + off, v[4 * j4 + 1] + off, v[4 * j4 + 2] + off, v[4 * j4 + 3] + off};
    __syncthreads();
}
__device__ __forceinline__ void load_row16_bf(const bf16_t* p, int lane, float (&v)[16]) {
    const u32x4 a = *(const u32x4*)(p + lane * 8), b = *(const u32x4*)(p + 512 + lane * 8);
#pragma unroll
    for (int j = 0; j < 4; ++j) { v[2 * j] = bf2f(a[j] & 0xffffu); v[2 * j + 1] = bf2f(a[j] >> 16); v[8 + 2 * j] = bf2f(b[j] & 0xffffu); v[9 + 2 * j] = bf2f(b[j] >> 16); }
}
__device__ __forceinline__ void p_ln1(const Ctx& C, int l) {
    const bf16_t* y1 = (const bf16_t*)(C.ws + WS_XC); bf16_t* x1b = (bf16_t*)(C.ws + WS_X1B);
    for (int row = C.bid * 8 + C.wave; row < T; row += C.G * 8) {
        float v[16]; load_row16_bf(y1 + (size_t)row * DM, C.lane, v);
        ln_row16(v, C.in[I_LN1G] + l * DM, C.in[I_LN1B] + l * DM, C.lane);
        row_emit(C, row, v, l, false);
        u32x4 o0, o1;
#pragma unroll
        for (int j = 0; j < 4; ++j) { o0[j] = pk2(v[2 * j], v[2 * j + 1]); o1[j] = pk2(v[8 + 2 * j], v[8 + 2 * j + 1]); }
        *(u32x4*)(x1b + (size_t)row * DM + C.lane * 8) = o0; *(u32x4*)(x1b + (size_t)row * DM + 512 + C.lane * 8) = o1;
    }
}

__device__ __forceinline__ void mix_pool_naive(const Ctx& C, int l) {
    const bf16_t* H = (const bf16_t*)(C.ws + WS_H); bf16_t* BR = (bf16_t*)(C.ws + WS_BR);
    LAS float* dd = (LAS float*)C.lds;
    for (int u = C.bid; u < (T / 64) * 4; u += C.G) {
        const int g = u & 3, t0 = (u >> 2) * 64, w = 2 << g;
        for (int idx = C.tid; idx < 64 * 128; idx += 512) {
            const int r = idx >> 7, c = idx & 127, row = t0 + r, pos = row & (SEQ - 1);
            const int nwin = (pos + 1 < w) ? pos + 1 : w;
            float s = 0.f;
            for (int j = 0; j < nwin; ++j) s += bf2f(H[(size_t)(row - j) * NH + HC_P + g * 128 + c]);
            dd[idx] = s / (float)nwin - bf2f(H[(size_t)row * NH + HC_P + g * 128 + c]);
        }
        __syncthreads();
        const int dcol = C.tid & 127, rq = C.tid >> 7;
        float acc[16];
#pragma unroll
        for (int i = 0; i < 16; ++i) acc[i] = 0.f;
        const float* pw = C.in[I_POOLW] + ((size_t)l * 4 + g) * 128 * 128;
        for (int c = 0; c < 128; ++c) {
            const float wv = pw[c * 128 + dcol];
#pragma unroll
            for (int i = 0; i < 16; ++i) acc[i] += dd[(rq * 16 + i) * 128 + c] * wv;
        }
        const float sc = C.in[I_POOLS][l * BW + g * 128 + dcol];
#pragma unroll
        for (int i = 0; i < 16; ++i) BR[(size_t)(t0 + rq * 16 + i) * NBR + 0 + g * 128 + dcol] = (bf16_t)f2bf(acc[i] * sc);
        __syncthreads();
    }
}
__device__ __forceinline__ void mix_gmlp_naive(const Ctx& C, int l) {
    const bf16_t* H = (const bf16_t*)(C.ws + WS_H); bf16_t* BR = (bf16_t*)(C.ws + WS_BR);
    LAS float* vn = (LAS float*)C.lds;
    for (int u = C.bid; u < (T / 128) * 4; u += C.G) {
        const int g = u & 3, t0 = (u >> 2) * 128;
        for (int i = 0; i < 16; ++i) {
            const int r = C.wave * 16 + i, row = t0 + r;
            const u32x4 raw = *(const u32x4*)(H + (size_t)row * NH + HC_GV + C.lane * 8);
            float e[8];
#pragma unroll
            for (int j = 0; j < 4; ++j) { e[2 * j] = geluf_(bf2f(raw[j] & 0xffffu)); e[2 * j + 1] = geluf_(bf2f(raw[j] >> 16)); }
            float s = 0.f;
#pragma unroll
            for (int j = 0; j < 8; ++j) s += e[j];
            const float mean = wave_sum(s) * (1.f / BW);
            float q = 0.f;
#pragma unroll
            for (int j = 0; j < 8; ++j) { const float d = e[j] - mean; q += d * d; }
            const float rstd = rsqrtf(wave_sum(q) * (1.f / BW) + LN_EPS);
            if ((C.lane >> 4) == g) {
#pragma unroll
                for (int j = 0; j < 8; ++j) { const int col = C.lane * 8 + j;
                    vn[r * 128 + (col - g * 128)] = (e[j] - mean) * rstd * C.in[I_GLNG][l * BW + col] + C.in[I_GLNB][l * BW + col]; }
            }
        }
        __syncthreads();
        const int c = C.tid & 127, tq = C.tid >> 7;
        const float* wsg = C.in[I_GWS] + ((size_t)l * 4 + g) * 128 * 128;
        for (int t = tq; t < 128; t += 4) {
            float acc = 0.f;
            for (int s = 0; s <= t; ++s) acc += wsg[t * 128 + s] * vn[s * 128 + c];
            const float sv = acc + C.in[I_GBS][(l * 4 + g) * 128 + t];
            const float uv = geluf_(bf2f(H[(size_t)(t0 + t) * NH + HC_GU + g * 128 + c]));
            BR[(size_t)(t0 + t) * NBR + 1024 + g * 128 + c] = (bf16_t)f2bf(uv * sv);
        }
        __syncthreads();
    }
}
__device__ __forceinline__ void mix_fox_naive(const Ctx& C, int l) {
    const bf16_t* H = (const bf16_t*)(C.ws + WS_H); bf16_t* BR = (bf16_t*)(C.ws + WS_BR);
    const float* cum = (const float*)(C.ws + WS_CUM);
    const float scale = 0.08838834764831845f;
    for (int u = C.bid; u < T * 4 / 8; u += C.G) {
        const int rid = u * 8 + C.wave;
        const int h = rid & 3, row = rid >> 2, b = row / SEQ, t = row % SEQ;
        const unsigned qraw = *(const unsigned*)(H + (size_t)row * NH + HC_FQ + h * 128 + C.lane * 2);
        const float q0 = bf2f(qraw & 0xffffu) * scale, q1 = bf2f(qraw >> 16) * scale;
        const float* cm = cum + ((size_t)b * 4 + h) * SEQ;
        const float ct = cm[t];
        float m = -1e30f, lsum = 0.f, o0 = 0.f, o1 = 0.f;
        for (int s = t; s >= 0; --s) {
            const size_t kr = (size_t)(b * SEQ + s) * NH + h * 128 + C.lane * 2;
            const unsigned kraw = *(const unsigned*)(H + kr + HC_FK);
            const unsigned vraw = *(const unsigned*)(H + kr + HC_FV);
            float d = q0 * bf2f(kraw & 0xffffu) + q1 * bf2f(kraw >> 16);
            d = wave_sum(d);
            const float z = d + ct - cm[s];
            const float mn = fmaxf(m, z), al = __expf(m - mn), p = __expf(z - mn);
            lsum = lsum * al + p; o0 = o0 * al + p * bf2f(vraw & 0xffffu); o1 = o1 * al + p * bf2f(vraw >> 16); m = mn;
        }
        const float inv = 1.f / lsum;
        *(unsigned*)(BR + (size_t)row * NBR + 1536 + h * 128 + C.lane * 2) = pk2(o0 * inv, o1 * inv);
    }
}
__device__ __forceinline__ void mix_hgrn_naive(const Ctx& C, int l) {
    if (C.bid >= BATCH * 4) return;
    const bf16_t* H = (const bf16_t*)(C.ws + WS_H); bf16_t* BR = (bf16_t*)(C.ws + WS_BR);
    const int b = C.bid >> 2, h = C.bid & 3;
    LAS float* fdec = (LAS float*)C.lds;
    LAS float* kkv = fdec + 32 * 128;
    LAS float* qsv = kkv + 32 * 128;
    LAS float* vv = qsv + 32 * 128;
    LAS float* opart = vv + 32 * 128;
    const int kq = C.tid >> 7, v = C.tid & 127;
    float S[32];
#pragma unroll
    for (int j = 0; j < 32; ++j) S[j] = 0.f;
    for (int c0 = 0; c0 < SEQ; c0 += 32) {
        for (int idx = C.tid; idx < 32 * 128; idx += 512) {
            const int st = idx >> 7, k = idx & 127; const size_t rb = (size_t)(b * SEQ + c0 + st) * NH + h * 128 + k;
            float lb = 0.f;
            if (l == 1) { const float z0 = C.in[I_LBL][h * 128 + k], z1 = C.in[I_LBL][BW + h * 128 + k]; lb = 1.f / (1.f + __expf(z0 - z1)); }
            const float zf = bf2f(H[rb + HC_HF]);
            const float kk = (1.f - lb) * sigmoidf_(-zf);
            fdec[idx] = 1.f - kk; kkv[idx] = kk; qsv[idx] = siluf_(bf2f(H[rb + HC_HQ])); vv[idx] = bf2f(H[rb + HC_HI]);
        }
        __syncthreads();
        for (int st = 0; st < 32; ++st) {
            const float vt = vv[st * 128 + v];
            float part = 0.f;
#pragma unroll
            for (int j = 0; j < 32; ++j) { const int k = kq * 32 + j; S[j] = fdec[st * 128 + k] * S[j] + kkv[st * 128 + k] * vt; part += S[j] * qsv[st * 128 + k]; }
            opart[(kq * 32 + st) * 128 + v] = part;
        }
        __syncthreads();
        for (int i = 0; i < 4; ++i) {
            const int st = C.wave * 4 + i, row = b * SEQ + c0 + st;
            float o0 = 0.f, o1 = 0.f;
#pragma unroll
            for (int q = 0; q < 4; ++q) { o0 += opart[(q * 32 + st) * 128 + C.lane]; o1 += opart[(q * 32 + st) * 128 + 64 + C.lane]; }
            const float ss = wave_sum(o0 * o0 + o1 * o1);
            const float r = rsqrtf(ss * (1.f / 128.f) + RMS_EPS);
            const float g0 = siluf_(bf2f(H[(size_t)row * NH + HC_HG + h * 128 + C.lane])), g1 = siluf_(bf2f(H[(size_t)row * NH + HC_HG + h * 128 + 64 + C.lane]));
            BR[(size_t)row * NBR + 512 + h * 128 + C.lane] = (bf16_t)f2bf(o0 * r * C.in[I_HNG][l * 128 + C.lane] * g0);
            BR[(size_t)row * NBR + 512 + h * 128 + 64 + C.lane] = (bf16_t)f2bf(o1 * r * C.in[I_HNG][l * 128 + 64 + C.lane] * g1);
        }
        __syncthreads();
    }
}


typedef float f32x16 __attribute__((ext_vector_type(16)));
typedef short s16x4 __attribute__((ext_vector_type(4)));
typedef short v4i16_t __attribute__((ext_vector_type(4)));
__device__ __forceinline__ s16x4 vtr(const LAS unsigned char* p) { return __builtin_bit_cast(s16x4, __builtin_amdgcn_ds_read_tr16_b64_v4i16((LAS v4i16_t*)p)); }
__device__ __forceinline__ float xor32(float x) { return __shfl_xor(x, 32, 64); }
#define MFMA32(a, b, c) __builtin_amdgcn_mfma_f32_32x32x16_bf16((a), (b), (c), 0, 0, 0)
constexpr int CW_KMAX = 16;

__device__ __forceinline__ void p_knorm(const Ctx& C, int l) {
    const bf16_t* H = (const bf16_t*)(C.ws + WS_H);
    unsigned* kmax = (unsigned*)(C.ws + WS_CTL) + CW_KMAX + l * 8;
    for (int r0 = (C.bid * 8 + C.wave) * 8; r0 < T; r0 += C.G * 64) {
        u32x4 raw[8];
#pragma unroll
        for (int i = 0; i < 8; ++i) raw[i] = *(const u32x4*)(H + (size_t)(r0 + i) * NH + HC_FK + C.lane * 8);
        float best = 0.f;
#pragma unroll
        for (int i = 0; i < 8; ++i) { float s = 0.f;
#pragma unroll
            for (int j = 0; j < 4; ++j) { const float a = bf2f(raw[i][j] & 0xffffu), b = bf2f(raw[i][j] >> 16); s += a * a + b * b; }
            best = fmaxf(best, s); }
        best = 0.f;
#pragma unroll
        for (int i = 0; i < 8; ++i) { float s = 0.f;
#pragma unroll
            for (int j = 0; j < 4; ++j) { const float a = bf2f(raw[i][j] & 0xffffu), b = bf2f(raw[i][j] >> 16); s += a * a + b * b; }
#pragma unroll
            for (int o = 8; o > 0; o >>= 1) s += __shfl_xor(s, o, 64);
            best = fmaxf(best, s); }
        LAS float* red = (LAS float*)C.lds;
        if ((C.lane & 15) == 0) red[C.wave * 4 + (C.lane >> 4)] = best;
        __syncthreads();
        if (C.tid < 4) { float m = red[C.tid];
#pragma unroll
            for (int w2 = 1; w2 < 8; ++w2) m = fmaxf(m, red[w2 * 4 + C.tid]);
            atomicMax(kmax + (r0 / SEQ) * 4 + C.tid, __builtin_bit_cast(unsigned, m)); }
        __syncthreads();
    }
}

constexpr int FOX_KST = 272, FOX_VST = 320;
constexpr int FOX_KB = 0, FOX_VB = 2 * 64 * FOX_KST, FOX_BETA = FOX_VB + 2 * 64 * FOX_VST, FOX_FLAG = FOX_BETA + 2 * 64 * 4, FOX_END = FOX_FLAG + 2 * 8 * 4;
__device__ __forceinline__ void mix_fox(const Ctx& C, int l) {
    const bf16_t* H = (const bf16_t*)(C.ws + WS_H); bf16_t* BR = (bf16_t*)(C.ws + WS_BR);
    const float* cum = (const float*)(C.ws + WS_CUM);
    const unsigned* kmaxw = (const unsigned*)(C.ws + WS_CTL) + CW_KMAX + l * 8;
    const float LOG2E = 1.4426950408889634f, QS = 0.08838834764831845f * LOG2E;
    const int lane = C.lane, w = C.wave, r32 = lane & 31, hh = lane >> 5;
    LAS unsigned char* lds = C.lds;
    LAS float* betaL = (LAS float*)(lds + FOX_BETA);
    volatile LAS int* flagL = (volatile LAS int*)(lds + FOX_FLAG);
    for (int u = C.bid; u < BATCH * 4 * (SEQ / 256); u += C.G) {
        const int qb = u % (SEQ / 256), bh = u / (SEQ / 256), b = bh >> 2, h = bh & 3;
        const int q0 = qb * 256, qw = q0 + 32 * w;
        const size_t rowbase = (size_t)b * SEQ;
        const float* cm = cum + ((size_t)b * 4 + h) * SEQ;
        const float c0 = cm[q0];
        const float kmx = sqrtf(__builtin_bit_cast(float, __hip_atomic_load(kmaxw + b * 4 + h, __ATOMIC_RELAXED, __HIP_MEMORY_SCOPE_AGENT)));
        bf16x8 qf[8]; float qn = 0.f;
        {
            const bf16_t* qp = H + (rowbase + qw + r32) * NH + HC_FQ + h * 128 + 8 * hh;
#pragma unroll
            for (int ks = 0; ks < 8; ++ks) {
                const u32x4 raw = *(const u32x4*)(qp + 16 * ks);
                u32x4 o;
#pragma unroll
                for (int j = 0; j < 4; ++j) { const float a = bf2f(raw[j] & 0xffffu), bb = bf2f(raw[j] >> 16); qn += a * a + bb * bb; o[j] = cvtpk(a * QS, bb * QS); }
                qf[ks] = __builtin_bit_cast(bf16x8, o);
            }
            qn += xor32(qn); qn = sqrtf(qn);
        }
        const float qbound = qn * kmx * QS;
        f32x16 oacc[4];
#pragma unroll
        for (int mt = 0; mt < 4; ++mt)
#pragma unroll
            for (int i = 0; i < 16; ++i) oacc[mt][i] = 0.f;
        float m_run = -1e30f, l_run = 0.f;
        const int jmax = (q0 + 255) >> 6;
        const int srow = C.tid >> 4, sch = C.tid & 15;
        u32x4 kreg[2], vreg[2]; float breg = 0.f;
#define FOX_GLOAD(j_) do { _Pragma("unroll") for (int p = 0; p < 2; ++p) { \
                const bf16_t* rp = H + (rowbase + 64 * (j_) + srow + 32 * p) * NH + h * 128 + sch * 8; \
                kreg[p] = *(const u32x4*)(rp + HC_FK); vreg[p] = *(const u32x4*)(rp + HC_FV); } \
            if (C.tid < 64) breg = (c0 - cm[64 * (j_) + C.tid]) * LOG2E; } while (0)
#define FOX_LWRITE(buf_) do { _Pragma("unroll") for (int p = 0; p < 2; ++p) { \
                *(LAS u32x4*)(lds + FOX_KB + (buf_) * 64 * FOX_KST + (srow + 32 * p) * FOX_KST + sch * 16) = kreg[p]; \
                *(LAS u32x4*)(lds + FOX_VB + (buf_) * 64 * FOX_VST + (srow + 32 * p) * FOX_VST + sch * 16) = vreg[p]; } \
            if (C.tid < 64) betaL[(buf_) * 64 + C.tid] = breg; } while (0)
        __syncthreads();
        if (C.tid < 16) flagL[C.tid] = 0;
        FOX_GLOAD(jmax); FOX_LWRITE(jmax & 1);
        bool wdone = false;
        for (int j = jmax; j >= 0; --j) {
            const int cur = j & 1;
            __syncthreads();
            if (j < jmax) { int all = 1;
#pragma unroll
                for (int i = 0; i < 8; ++i) all &= flagL[((j + 1) & 1) * 8 + i];
                if (all) break; }
            if (j > 0) FOX_GLOAD(j - 1);
            const int k0 = 64 * j;
            if (k0 <= qw + 31 && !wdone) {
                const LAS unsigned char* kb = lds + FOX_KB + cur * 64 * FOX_KST;
                const LAS unsigned char* vb = lds + FOX_VB + cur * 64 * FOX_VST;
                f32x16 sacc[2];
#pragma unroll
                for (int mt = 0; mt < 2; ++mt)
#pragma unroll
                    for (int g = 0; g < 4; ++g) { const f32x4 bv = *(const LAS f32x4*)(betaL + cur * 64 + 32 * mt + 8 * g + 4 * hh);
                        sacc[mt][4 * g] = bv[0]; sacc[mt][4 * g + 1] = bv[1]; sacc[mt][4 * g + 2] = bv[2]; sacc[mt][4 * g + 3] = bv[3]; }
#pragma unroll
                for (int ks = 0; ks < 8; ++ks)
#pragma unroll
                    for (int mt = 0; mt < 2; ++mt) {
                        const bf16x8 kf = *(const LAS bf16x8*)(kb + (32 * mt + r32) * FOX_KST + 32 * ks + 16 * hh);
                        sacc[mt] = MFMA32(kf, qf[ks], sacc[mt]);
                    }
                const int tq = qw + r32;
                if (k0 + 63 > qw) {
#pragma unroll
                    for (int mt = 0; mt < 2; ++mt)
#pragma unroll
                        for (int i = 0; i < 16; ++i) { const int key = k0 + 32 * mt + (i & 3) + 8 * (i >> 2) + 4 * hh; if (key > tq) sacc[mt][i] = -1e30f; }
                }
                float mx = sacc[0][0];
#pragma unroll
                for (int mt = 0; mt < 2; ++mt)
#pragma unroll
                    for (int i = 0; i < 16; ++i) mx = fmaxf(mx, sacc[mt][i]);
                mx = fmaxf(mx, xor32(mx));
                const float mn = fmaxf(m_run, mx), alpha = __builtin_amdgcn_exp2f(m_run - mn);
                m_run = mn;
                float ps = 0.f;
#pragma unroll
                for (int mt = 0; mt < 2; ++mt)
#pragma unroll
                    for (int i = 0; i < 16; ++i) { const float p = __builtin_amdgcn_exp2f(sacc[mt][i] - mn); sacc[mt][i] = p; ps += p; }
                l_run = l_run * alpha + ps;
#pragma unroll
                for (int mt = 0; mt < 4; ++mt)
#pragma unroll
                    for (int i = 0; i < 16; ++i) oacc[mt][i] *= alpha;
#pragma unroll
                for (int s4 = 0; s4 < 4; ++s4) {
                    const int mtk = s4 >> 1, s = s4 & 1;
                    u32x4 pb;
#pragma unroll
                    for (int e = 0; e < 4; ++e) pb[e] = cvtpk(sacc[mtk][8 * s + 2 * e], sacc[mtk][8 * s + 2 * e + 1]);
                    const bf16x8 pfrag = __builtin_bit_cast(bf16x8, pb);
                    const int i16 = lane & 15, q4 = i16 >> 2, p4 = i16 & 3, blk = (lane >> 4) & 1;
                    const int keyA = 32 * mtk + 16 * s + 4 * hh + q4;
#pragma unroll
                    for (int mt = 0; mt < 4; ++mt) {
                        const LAS unsigned char* a0 = vb + keyA * FOX_VST + (32 * mt + 16 * blk + 4 * p4) * 2;
                        const s16x4 lo = vtr(a0), hi = vtr(a0 + 8 * FOX_VST);
                        const bf16x8 vf = __builtin_shufflevector(lo, hi, 0, 1, 2, 3, 4, 5, 6, 7);
                        oacc[mt] = MFMA32(vf, pfrag, oacc[mt]);
                    }
                }
                if (j > 0) { const float bl = (c0 - cm[k0 - 1]) * LOG2E;
                    const int ok = (qbound + bl < m_run - 40.f) ? 1 : 0;
                    wdone = __all(ok); }
            }
            if (lane == 0) flagL[cur * 8 + w] = wdone ? 1 : 0;
            if (j > 0) FOX_LWRITE(cur ^ 1);
        }
        l_run += xor32(l_run);
        const float inv = 1.f / l_run;
        bf16_t* op = BR + (rowbase + qw + r32) * NBR + 1536 + h * 128;
#pragma unroll
        for (int mt = 0; mt < 4; ++mt)
#pragma unroll
            for (int g = 0; g < 4; ++g) { u32x2 o; o[0] = cvtpk(oacc[mt][4 * g] * inv, oacc[mt][4 * g + 1] * inv); o[1] = cvtpk(oacc[mt][4 * g + 2] * inv, oacc[mt][4 * g + 3] * inv);
                *(u32x2*)(op + 32 * mt + 8 * g + 4 * hh) = o; }
    }
}


constexpr int HG_LF = 0, HG_QA = 34816, HG_QB = HG_QA + 17408, HG_KD = HG_QB + 8704, HG_KO = HG_KD + 17408, HG_KT = HG_KO + 8704, HG_VN = HG_KT + 20480, HG_AM = HG_VN + 20480, HG_END = HG_AM + 12288;
constexpr int HG_LFS = 132;
static_assert(HG_END + 2048 <= 140 * 1024, "hgrn LDS");
constexpr size_t WS_DSC = WS_ST + (size_t)BATCH * 4 * 32 * 128 * 128 * 4;

template <bool FULL>
__device__ __forceinline__ void hgrn_unit(const Ctx& C, int l, int u) {
#if DIAG == 1
    const bf16_t* H = (const bf16_t*)(C.ws + WS_H); bf16_t* BR = (l == 0) ? (bf16_t*)(C.ws + WS_XA) : (bf16_t*)(C.ws + WS_TABU);
#else
    const bf16_t* H = (const bf16_t*)(C.ws + WS_H); bf16_t* BR = (bf16_t*)(C.ws + WS_BR);
#endif
    float* STB = (float*)(C.ws + WS_ST); float* DSC = (float*)(C.ws + WS_DSC);
    LAS unsigned char* lds = C.lds;
    LAS float* LF = (LAS float*)(lds + HG_LF);
    const int lane = C.lane, w = C.wave, r32 = lane & 31, hh = lane >> 5;
    const int sc = u & 31, bh = u >> 5, b = bh >> 2, h = bh & 3;
    const int wk = w >> 1, wv = w & 1;
    const int mt = w >> 2, nt = w & 3;
    const int i16 = lane & 15, q4 = i16 >> 2, p4 = i16 & 3, blk = (lane >> 4) & 1;
    f32x16 S0, S1;
    float* stp = STB + ((size_t)bh * 32 + sc) * 128 * 128;
    if constexpr (FULL) {
#pragma unroll
        for (int i = 0; i < 16; ++i) { const int k = 32 * wk + (i & 3) + 8 * (i >> 2) + 4 * hh;
            S0[i] = stp[k * 128 + 64 * wv + r32]; S1[i] = stp[k * 128 + 64 * wv + 32 + r32]; }
    } else {
#pragma unroll
        for (int i = 0; i < 16; ++i) { S0[i] = 0.f; S1[i] = 0.f; }
    }
    float dtot = 0.f;
    const int ps = C.tid >> 3, pseg = C.tid & 7;
    float lbv[16];
#pragma unroll
    for (int j = 0; j < 16; ++j) { lbv[j] = 0.f;
        if (l == 1) { const int ch = h * 128 + 16 * pseg + j; lbv[j] = 1.f / (1.f + __expf(C.in[I_LBL][ch] - C.in[I_LBL][BW + ch])); } }
    u32x4 nf0, nf1, nv0, nv1;
    { const bf16_t* hp0 = H + ((size_t)b * SEQ + sc * 256 + ps) * NH + h * 128 + 16 * pseg;
      nf0 = *(const u32x4*)(hp0 + HC_HF); nf1 = *(const u32x4*)(hp0 + HC_HF + 8); nv0 = *(const u32x4*)(hp0 + HC_HI); nv1 = *(const u32x4*)(hp0 + HC_HI + 8); }
    for (int c = 0; c < 4; ++c) {
        const size_t row0 = (size_t)b * SEQ + sc * 256 + c * 64;
        const bf16_t* hp = H + (row0 + ps) * NH + h * 128 + 16 * pseg;
        float kkv[16], qsv[16];
        u32x4 vraw0, vraw1;
        u32x4 cg0 = {0u, 0u, 0u, 0u}, cg1 = cg0, cq0 = cg0, cq1 = cg0;
        if constexpr (FULL) { cq0 = *(const u32x4*)(hp + HC_HQ); cq1 = *(const u32x4*)(hp + HC_HQ + 8); cg0 = *(const u32x4*)(hp + HC_HG); cg1 = *(const u32x4*)(hp + HC_HG + 8); }
        {
            const u32x4 f0 = nf0, f1 = nf1;
            vraw0 = nv0; vraw1 = nv1;
            if (c < 3) { const bf16_t* hn = hp + (size_t)64 * NH;
                nf0 = *(const u32x4*)(hn + HC_HF); nf1 = *(const u32x4*)(hn + HC_HF + 8); nv0 = *(const u32x4*)(hn + HC_HI); nv1 = *(const u32x4*)(hn + HC_HI + 8); }
#pragma unroll
            for (int j = 0; j < 8; ++j) { const unsigned r = (j < 4) ? f0[j] : f1[j - 4];
                const float z0 = bf2f(r & 0xffffu), z1 = bf2f(r >> 16);
                kkv[2 * j] = (1.f - lbv[2 * j]) * sigmoidf_(-z0); kkv[2 * j + 1] = (1.f - lbv[2 * j + 1]) * sigmoidf_(-z1); }
            if constexpr (FULL) {
#pragma unroll
                for (int j = 0; j < 8; ++j) { const unsigned r = (j < 4) ? cq0[j] : cq1[j - 4]; qsv[2 * j] = siluf_(bf2f(r & 0xffffu)); qsv[2 * j + 1] = siluf_(bf2f(r >> 16)); }
            }
#pragma unroll
            for (int j4 = 0; j4 < 4; ++j4) { f32x4 o;
#pragma unroll
                for (int e = 0; e < 4; ++e) o[e] = __logf(1.f - kkv[4 * j4 + e]);
                *(LAS f32x4*)(LF + ps * HG_LFS + 16 * pseg + 4 * j4) = o; }
        }
        __syncthreads();
        {
            const int sk = C.tid & 127, sg = C.tid >> 7;
            float vals[16];
#pragma unroll
            for (int i = 0; i < 16; ++i) vals[i] = LF[(16 * sg + i) * HG_LFS + sk];
#pragma unroll
            for (int i = 1; i < 16; ++i) vals[i] += vals[i - 1];
            LAS float* TOT = (LAS float*)(lds + HG_END);
            TOT[sg * 128 + sk] = vals[15];
            __syncthreads();
            float off = 0.f;
#pragma unroll
            for (int j = 0; j < 3; ++j) if (j < sg) off += TOT[j * 128 + sk];
#pragma unroll
            for (int i = 0; i < 16; ++i) LF[(16 * sg + i) * HG_LFS + sk] = vals[i] + off;
            if (sg == 3) dtot += vals[15] + off;
        }
        __syncthreads();
        float bv[16], b31[16], bl[16];
#pragma unroll
        for (int j4 = 0; j4 < 4; ++j4) { const f32x4 x = *(const LAS f32x4*)(LF + ps * HG_LFS + 16 * pseg + 4 * j4), y = *(const LAS f32x4*)(LF + 31 * HG_LFS + 16 * pseg + 4 * j4), z = *(const LAS f32x4*)(LF + 63 * HG_LFS + 16 * pseg + 4 * j4);
#pragma unroll
            for (int e = 0; e < 4; ++e) { bv[4 * j4 + e] = x[e]; b31[4 * j4 + e] = y[e]; bl[4 * j4 + e] = z[e]; } }
        {
            u32x4 o0, o1;
#pragma unroll
            for (int j = 0; j < 4; ++j) { o0[j] = cvtpk(kkv[2 * j] * __expf(bl[2 * j] - bv[2 * j]), kkv[2 * j + 1] * __expf(bl[2 * j + 1] - bv[2 * j + 1]));
                o1[j] = cvtpk(kkv[8 + 2 * j] * __expf(bl[8 + 2 * j] - bv[8 + 2 * j]), kkv[9 + 2 * j] * __expf(bl[9 + 2 * j] - bv[9 + 2 * j])); }
            *(LAS u32x4*)(lds + HG_KT + ps * 320 + 32 * pseg) = o0; *(LAS u32x4*)(lds + HG_KT + ps * 320 + 32 * pseg + 16) = o1;
            *(LAS u32x4*)(lds + HG_VN + ps * 320 + 32 * pseg) = vraw0; *(LAS u32x4*)(lds + HG_VN + ps * 320 + 32 * pseg + 16) = vraw1;
            if constexpr (FULL) {
                const bool hi = ps >= 32;
                float rr[16];
#pragma unroll
                for (int j = 0; j < 16; ++j) rr[j] = hi ? b31[j] : 0.f;
#pragma unroll
                for (int j = 0; j < 4; ++j) { o0[j] = cvtpk(qsv[2 * j] * __expf(bv[2 * j] - rr[2 * j]), qsv[2 * j + 1] * __expf(bv[2 * j + 1] - rr[2 * j + 1]));
                    o1[j] = cvtpk(qsv[8 + 2 * j] * __expf(bv[8 + 2 * j] - rr[8 + 2 * j]), qsv[9 + 2 * j] * __expf(bv[9 + 2 * j] - rr[9 + 2 * j])); }
                *(LAS u32x4*)(lds + HG_QA + ps * 272 + 32 * pseg) = o0; *(LAS u32x4*)(lds + HG_QA + ps * 272 + 32 * pseg + 16) = o1;
#pragma unroll
                for (int j = 0; j < 4; ++j) { o0[j] = cvtpk(kkv[2 * j] * __expf(rr[2 * j] - bv[2 * j]), kkv[2 * j + 1] * __expf(rr[2 * j + 1] - bv[2 * j + 1]));
                    o1[j] = cvtpk(kkv[8 + 2 * j] * __expf(rr[8 + 2 * j] - bv[8 + 2 * j]), kkv[9 + 2 * j] * __expf(rr[9 + 2 * j] - bv[9 + 2 * j])); }
                *(LAS u32x4*)(lds + HG_KD + ps * 272 + 32 * pseg) = o0; *(LAS u32x4*)(lds + HG_KD + ps * 272 + 32 * pseg + 16) = o1;
                if (hi) {
#pragma unroll
                    for (int j = 0; j < 4; ++j) { o0[j] = cvtpk(qsv[2 * j] * __expf(bv[2 * j]), qsv[2 * j + 1] * __expf(bv[2 * j + 1]));
                        o1[j] = cvtpk(qsv[8 + 2 * j] * __expf(bv[8 + 2 * j]), qsv[9 + 2 * j] * __expf(bv[9 + 2 * j])); }
                    *(LAS u32x4*)(lds + HG_QB + (ps - 32) * 272 + 32 * pseg) = o0; *(LAS u32x4*)(lds + HG_QB + (ps - 32) * 272 + 32 * pseg + 16) = o1;
                } else {
#pragma unroll
                    for (int j = 0; j < 4; ++j) { o0[j] = cvtpk(kkv[2 * j] * __expf(b31[2 * j] - bv[2 * j]), kkv[2 * j + 1] * __expf(b31[2 * j + 1] - bv[2 * j + 1]));
                        o1[j] = cvtpk(kkv[8 + 2 * j] * __expf(b31[8 + 2 * j] - bv[8 + 2 * j]), kkv[9 + 2 * j] * __expf(b31[9 + 2 * j] - bv[9 + 2 * j])); }
                    *(LAS u32x4*)(lds + HG_KO + ps * 272 + 32 * pseg) = o0; *(LAS u32x4*)(lds + HG_KO + ps * 272 + 32 * pseg + 16) = o1;
                }
            }
        }
        float dk[16];
#pragma unroll
        for (int i = 0; i < 16; ++i) dk[i] = __expf(LF[63 * HG_LFS + 32 * wk + (i & 3) + 8 * (i >> 2) + 4 * hh]);
        __syncthreads();
        if constexpr (FULL) {
#pragma unroll
            for (int g = 0; g < 4; ++g) {
                u32x2 o; o[0] = cvtpk(S0[4 * g], S0[4 * g + 1]); o[1] = cvtpk(S0[4 * g + 2], S0[4 * g + 3]);
                *(LAS u32x2*)(lds + HG_LF + (64 * wv + r32) * 272 + (32 * wk + 8 * g + 4 * hh) * 2) = o;
                o[0] = cvtpk(S1[4 * g], S1[4 * g + 1]); o[1] = cvtpk(S1[4 * g + 2], S1[4 * g + 3]);
                *(LAS u32x2*)(lds + HG_LF + (64 * wv + 32 + r32) * 272 + (32 * wk + 8 * g + 4 * hh) * 2) = o;
            }
#define HG_ATILE(AMT_, AST_) do { \
                const LAS unsigned char* kb = ((AMT_) == (AST_)) ? (lds + HG_KD + (32 * (AST_)) * 272) : (lds + HG_KO); \
                f32x16 a; \
                _Pragma("unroll") for (int i = 0; i < 16; ++i) a[i] = 0.f; \
                _Pragma("unroll") for (int ks = 0; ks < 8; ++ks) { \
                    const bf16x8 af = *(const LAS bf16x8*)(lds + HG_QA + (32 * (AMT_) + r32) * 272 + 32 * ks + 16 * hh); \
                    const bf16x8 bf = *(const LAS bf16x8*)(kb + r32 * 272 + 32 * ks + 16 * hh); \
                    a = MFMA32(af, bf, a); } \
                _Pragma("unroll") for (int g = 0; g < 4; ++g) { \
                    float x[4]; \
                    _Pragma("unroll") for (int e = 0; e < 4; ++e) { const int tl = 8 * g + 4 * hh + e; x[e] = ((AMT_) != (AST_) || r32 <= tl) ? a[4 * g + e] : 0.f; } \
                    u32x2 o; o[0] = cvtpk(x[0], x[1]); o[1] = cvtpk(x[2], x[3]); \
                    *(LAS u32x2*)(lds + HG_AM + (32 * (AST_) + r32) * 192 + (32 * (AMT_) + 8 * g + 4 * hh) * 2) = o; } } while (0)
            if (w == 0) { HG_ATILE(0, 0); }
            else if (w == 1) { HG_ATILE(1, 0); }
            else if (w == 2) { HG_ATILE(1, 1); }
        }
#pragma unroll
        for (int i = 0; i < 16; ++i) { S0[i] *= dk[i]; S1[i] *= dk[i]; }
#pragma unroll
        for (int ks = 0; ks < 4; ++ks) {
            const LAS unsigned char* ka = lds + HG_KT + (16 * ks + 8 * hh + q4) * 320 + (32 * wk + 16 * blk + 4 * p4) * 2;
            const s16x4 alo = vtr(ka), ahi = vtr(ka + 4 * 320);
            const bf16x8 af = __builtin_shufflevector(alo, ahi, 0, 1, 2, 3, 4, 5, 6, 7);
            const LAS unsigned char* vb0 = lds + HG_VN + (16 * ks + 8 * hh + q4) * 320 + (64 * wv + 16 * blk + 4 * p4) * 2;
            const s16x4 b0lo = vtr(vb0), b0hi = vtr(vb0 + 4 * 320), b1lo = vtr(vb0 + 64), b1hi = vtr(vb0 + 64 + 4 * 320);
            S0 = MFMA32(af, __builtin_shufflevector(b0lo, b0hi, 0, 1, 2, 3, 4, 5, 6, 7), S0);
            S1 = MFMA32(af, __builtin_shufflevector(b1lo, b1hi, 0, 1, 2, 3, 4, 5, 6, 7), S1);
        }
        if constexpr (FULL) {
            __syncthreads();
            f32x16 o;
#pragma unroll
            for (int i = 0; i < 16; ++i) o[i] = 0.f;
            const LAS unsigned char* qb = (mt == 0) ? (lds + HG_QA) : (lds + HG_QB);
#pragma unroll
            for (int ks = 0; ks < 8; ++ks) {
                const bf16x8 af = *(const LAS bf16x8*)(qb + r32 * 272 + 32 * ks + 16 * hh);
                const bf16x8 bf = *(const LAS bf16x8*)(lds + HG_LF + (32 * nt + r32) * 272 + 32 * ks + 16 * hh);
                o = MFMA32(af, bf, o);
            }
#pragma unroll
            for (int ks = 0; ks < 4; ++ks) {
                if (mt == 0 && ks >= 2) continue;
                const LAS unsigned char* aa = lds + HG_AM + (16 * ks + 8 * hh + q4) * 192 + (32 * mt + 16 * blk + 4 * p4) * 2;
                const s16x4 alo = vtr(aa), ahi = vtr(aa + 4 * 192);
                const LAS unsigned char* vb0 = lds + HG_VN + (16 * ks + 8 * hh + q4) * 320 + (32 * nt + 16 * blk + 4 * p4) * 2;
                const s16x4 blo = vtr(vb0), bhi = vtr(vb0 + 4 * 320);
                o = MFMA32(__builtin_shufflevector(alo, ahi, 0, 1, 2, 3, 4, 5, 6, 7), __builtin_shufflevector(blo, bhi, 0, 1, 2, 3, 4, 5, 6, 7), o);
            }
            __syncthreads();
#pragma unroll
            for (int i = 0; i < 16; ++i) LF[(32 * mt + (i & 3) + 8 * (i >> 2) + 4 * hh) * HG_LFS + 32 * nt + r32] = o[i];
            __syncthreads();
            {
                float ov[16]; float ss = 0.f;
#pragma unroll
                for (int j4 = 0; j4 < 4; ++j4) { const f32x4 x = *(const LAS f32x4*)(LF + ps * HG_LFS + 16 * pseg + 4 * j4);
#pragma unroll
                    for (int e = 0; e < 4; ++e) { ov[4 * j4 + e] = x[e]; ss += x[e] * x[e]; } }
                ss += __shfl_xor(ss, 1, 64); ss += __shfl_xor(ss, 2, 64); ss += __shfl_xor(ss, 4, 64);
                const float rn = rsqrtf(ss * (1.f / 128.f) + RMS_EPS);
                const u32x4 g0 = cg0, g1 = cg1;
                const float* ng = C.in[I_HNG] + l * 128 + 16 * pseg;
                u32x4 o0, o1;
#pragma unroll
                for (int j = 0; j < 4; ++j) {
                    o0[j] = cvtpk(ov[2 * j] * rn * ng[2 * j] * siluf_(bf2f(g0[j] & 0xffffu)), ov[2 * j + 1] * rn * ng[2 * j + 1] * siluf_(bf2f(g0[j] >> 16)));
                    o1[j] = cvtpk(ov[8 + 2 * j] * rn * ng[8 + 2 * j] * siluf_(bf2f(g1[j] & 0xffffu)), ov[9 + 2 * j] * rn * ng[9 + 2 * j] * siluf_(bf2f(g1[j] >> 16)));
                }
                bf16_t* bp = BR + (row0 + ps) * NBR + 512 + h * 128 + 16 * pseg;
                *(u32x4*)bp = o0; *(u32x4*)(bp + 8) = o1;
            }
        }
        __syncthreads();
    }
    if constexpr (!FULL) {
#pragma unroll
        for (int i = 0; i < 16; ++i) { const int k = 32 * wk + (i & 3) + 8 * (i >> 2) + 4 * hh;
            stp[k * 128 + 64 * wv + r32] = S0[i]; stp[k * 128 + 64 * wv + 32 + r32] = S1[i]; }
        if (C.tid >= 384) DSC[((size_t)bh * 32 + sc) * 128 + (C.tid & 127)] = __expf(dtot);
    }
}
__device__ __forceinline__ void hgrn_b1(const Ctx& C, int l) { for (int u = C.bid; u < BATCH * 4 * 32; u += C.G) hgrn_unit<false>(C, l, u); }
__device__ __forceinline__ void hgrn_b3(const Ctx& C, int l) { for (int u = C.bid; u < BATCH * 4 * 32; u += C.G) hgrn_unit<true>(C, l, u); }
__device__ __forceinline__ void hgrn_b2(const Ctx& C) {
    float* STB = (float*)(C.ws + WS_ST); const float* DSC = (const float*)(C.ws + WS_DSC);
    for (int e = C.bid * 512 + C.tid; e < BATCH * 4 * 128 * 128; e += C.G * 512) {
        const int bh = e >> 14, kv = e & 16383, k = kv >> 7;
        float* p = STB + (size_t)bh * 32 * 16384 + kv;
        float uu[32], dd[32];
#pragma unroll
        for (int s = 0; s < 32; ++s) { uu[s] = p[(size_t)s * 16384]; dd[s] = DSC[((size_t)bh * 32 + s) * 128 + k]; }
        float st = 0.f;
#pragma unroll
        for (int s = 0; s < 32; ++s) { p[(size_t)s * 16384] = st; st = dd[s] * st + uu[s]; }
    }
}


__device__ __forceinline__ void mix_pool(const Ctx& C, int l) {
#if DIAG == 2
    const bf16_t* H = (const bf16_t*)(C.ws + WS_H); bf16_t* BR = (l == 0) ? (bf16_t*)(C.ws + WS_XA) : (bf16_t*)(C.ws + WS_TABU);
#else
    const bf16_t* H = (const bf16_t*)(C.ws + WS_H); bf16_t* BR = (bf16_t*)(C.ws + WS_BR);
#endif
    const bf16_t* Wt = (const bf16_t*)(C.ws + WS_W + (size_t)l * W_LAYER + WO_POOLW);
    LAS unsigned char* lds = C.lds;
    constexpr int PL_P = 128 * 272;
    const int lane = C.lane, w = C.wave, r32 = lane & 31, hh = lane >> 5;
    for (int u = C.bid; u < (T / 256) * 4; u += C.G) {
        const int g = u & 3, t0 = (u >> 2) * 256, win = 2 << g;
        const int row = t0 + 32 * w + r32, pos = row & (SEQ - 1);
        __syncthreads();
#pragma unroll
        for (int p = 0; p < 4; ++p) { const int idx = C.tid + 512 * p, rr = idx >> 4, ch = idx & 15;
            *(LAS u32x4*)(lds + rr * 272 + ch * 16) = *(const u32x4*)(Wt + (size_t)g * 128 * 128 + rr * 128 + ch * 8); }
        const bool seq_start = (t0 & (SEQ - 1)) == 0;
        for (int idx = C.tid; idx < 271 * 16; idx += 512) { const int rr = idx >> 4, ch = idx & 15;
            if (!(seq_start && rr < 15)) *(LAS u32x4*)(lds + PL_P + rr * 272 + ch * 16) = *(const u32x4*)(H + (size_t)(t0 - 15 + rr) * NH + HC_P + g * 128 + ch * 8); }
        __syncthreads();
        const int nwin = (pos + 1 < win) ? pos + 1 : win;
        const float invn = 1.f / (float)nwin;
        bf16x8 df[8];
        const LAS unsigned char* prow = lds + PL_P + (32 * w + r32 + 15) * 272 + 16 * hh;
#pragma unroll
        for (int ks = 0; ks < 8; ++ks) {
            float sum[8];
#pragma unroll
            for (int e = 0; e < 8; ++e) sum[e] = 0.f;
            const u32x4 self = *(const LAS u32x4*)(prow + 32 * ks);
#pragma unroll
            for (int j = 0; j < 16; ++j) if (j < win) {
                const int jj = (j < nwin) ? j : 0; const float msk = (j < nwin) ? 1.f : 0.f;
                const u32x4 rw = *(const LAS u32x4*)(prow + 32 * ks - jj * 272);
#pragma unroll
                for (int e = 0; e < 4; ++e) { sum[2 * e] += msk * bf2f(rw[e] & 0xffffu); sum[2 * e + 1] += msk * bf2f(rw[e] >> 16); } }
            u32x4 o;
#pragma unroll
            for (int e = 0; e < 4; ++e) o[e] = cvtpk(sum[2 * e] * invn - bf2f(self[e] & 0xffffu), sum[2 * e + 1] * invn - bf2f(self[e] >> 16));
            df[ks] = __builtin_bit_cast(bf16x8, o);
        }
        f32x16 acc[4];
#pragma unroll
        for (int mt = 0; mt < 4; ++mt)
#pragma unroll
            for (int i = 0; i < 16; ++i) acc[mt][i] = 0.f;
#pragma unroll
        for (int ks = 0; ks < 8; ++ks)
#pragma unroll
            for (int mt = 0; mt < 4; ++mt) {
                const bf16x8 wf = *(const LAS bf16x8*)(lds + (32 * mt + r32) * 272 + 32 * ks + 16 * hh);
                acc[mt] = MFMA32(wf, df[ks], acc[mt]);
            }
        const float* psc = C.in[I_POOLS] + l * BW + g * 128;
        bf16_t* op = BR + (size_t)row * NBR + g * 128;
#pragma unroll
        for (int mt = 0; mt < 4; ++mt)
#pragma unroll
            for (int q = 0; q < 4; ++q) { const int d0 = 32 * mt + 8 * q + 4 * hh; const f32x4 sc = *(const f32x4*)(psc + d0);
                u32x2 o; o[0] = cvtpk(acc[mt][4 * q] * sc[0], acc[mt][4 * q + 1] * sc[1]); o[1] = cvtpk(acc[mt][4 * q + 2] * sc[2], acc[mt][4 * q + 3] * sc[3]);
                *(u32x2*)(op + d0) = o; }
    }
}
#if DIAG == 3
#define GM_VNBUF ((bf16_t*)(C.ws + WS_X1B))
constexpr int GM_VLD = BW, GM_VOFF = 0;
#else
#define GM_VNBUF ((bf16_t*)(C.ws + WS_H))
constexpr int GM_VLD = NH, GM_VOFF = HC_GV;
#endif
__device__ __forceinline__ void p_gmlp_prep(const Ctx& C, int l) {
    const bf16_t* H = (const bf16_t*)(C.ws + WS_H); bf16_t* VN = GM_VNBUF;
    const float* lgp = C.in[I_GLNG] + l * BW + C.lane * 8; const float* lbp = C.in[I_GLNB] + l * BW + C.lane * 8;
    const f32x4 g0 = *(const f32x4*)lgp, g1 = *(const f32x4*)(lgp + 4), b0 = *(const f32x4*)lbp, b1 = *(const f32x4*)(lbp + 4);
    for (int row = C.bid * 8 + C.wave; row < T; row += C.G * 8) {
        const u32x4 raw = *(const u32x4*)(H + (size_t)row * NH + HC_GV + C.lane * 8);
        float e[8], s1 = 0.f, s2 = 0.f;
#pragma unroll
        for (int j = 0; j < 4; ++j) { const float a = geluf_(bf2f(raw[j] & 0xffffu)), b = geluf_(bf2f(raw[j] >> 16)); e[2 * j] = a; e[2 * j + 1] = b; s1 += a + b; s2 += a * a + b * b; }
        const float mean = wave_sum(s1) * (1.f / BW), ex2 = wave_sum(s2) * (1.f / BW);
        const float rstd = rsqrtf(fmaxf(ex2 - mean * mean, 0.f) + LN_EPS);
        u32x4 o;
        o[0] = cvtpk((e[0] - mean) * rstd * g0[0] + b0[0], (e[1] - mean) * rstd * g0[1] + b0[1]); o[1] = cvtpk((e[2] - mean) * rstd * g0[2] + b0[2], (e[3] - mean) * rstd * g0[3] + b0[3]);
        o[2] = cvtpk((e[4] - mean) * rstd * g1[0] + b1[0], (e[5] - mean) * rstd * g1[1] + b1[1]); o[3] = cvtpk((e[6] - mean) * rstd * g1[2] + b1[2], (e[7] - mean) * rstd * g1[3] + b1[3]);
        *(u32x4*)(VN + (size_t)row * GM_VLD + GM_VOFF + C.lane * 8) = o;
    }
}
constexpr int GM_VN = 0, GM_WC = 128 * 320, GM_END = GM_WC + 128 * 272;
__device__ __forceinline__ void mix_gmlp(const Ctx& C, int l) {
#if DIAG == 3
    const bf16_t* H = (const bf16_t*)(C.ws + WS_H); bf16_t* BR = (l == 0) ? (bf16_t*)(C.ws + WS_XA) : (bf16_t*)(C.ws + WS_TABU);
#else
    const bf16_t* H = (const bf16_t*)(C.ws + WS_H); bf16_t* BR = (bf16_t*)(C.ws + WS_BR);
#endif
    const bf16_t* Wc = (const bf16_t*)(C.ws + WS_W + (size_t)l * W_LAYER + WO_GWS);
    LAS unsigned char* lds = C.lds;
    const int lane = C.lane, w = C.wave, r32 = lane & 31, hh = lane >> 5;
    const int i16 = lane & 15, q4 = i16 >> 2, p4 = i16 & 3, blk = (lane >> 4) & 1;
    for (int u = C.bid; u < (T / 128) * 4; u += C.G) {
        const int g = u & 3, t0 = (u >> 2) * 128;
        __syncthreads();
#pragma unroll
        for (int p = 0; p < 4; ++p) { const int idx = C.tid + 512 * p, rr = idx >> 4, ch = idx & 15;
            *(LAS u32x4*)(lds + GM_WC + rr * 272 + ch * 16) = *(const u32x4*)(Wc + (size_t)g * 128 * 128 + rr * 128 + ch * 8); }
#pragma unroll
        for (int p = 0; p < 4; ++p) { const int idx = C.tid + 512 * p, rr = idx >> 4, ch = idx & 15;
            *(LAS u32x4*)(lds + GM_VN + rr * 320 + ch * 16) = *(const u32x4*)(GM_VNBUF + (size_t)(t0 + rr) * GM_VLD + GM_VOFF + g * 128 + ch * 8); }
        __syncthreads();
        const int nt = w & 3, mb = (w >> 2) * 2;
        u32x2 upre[2][4];
#pragma unroll
        for (int m = 0; m < 2; ++m)
#pragma unroll
            for (int q = 0; q < 4; ++q) upre[m][q] = *(const u32x2*)(H + (size_t)(t0 + 32 * nt + r32) * NH + HC_GU + g * 128 + 32 * (mb + m) + 8 * q + 4 * hh);
        f32x16 acc[2];
#pragma unroll
        for (int m = 0; m < 2; ++m)
#pragma unroll
            for (int i = 0; i < 16; ++i) acc[m][i] = 0.f;
        for (int ks = 0; ks < 2 * (nt + 1); ++ks) {
            const bf16x8 bf = *(const LAS bf16x8*)(lds + GM_WC + (32 * nt + r32) * 272 + 32 * ks + 16 * hh);
#pragma unroll
            for (int m = 0; m < 2; ++m) {
                const LAS unsigned char* aa = lds + GM_VN + (16 * ks + 8 * hh + q4) * 320 + (32 * (mb + m) + 16 * blk + 4 * p4) * 2;
                const s16x4 lo = vtr(aa), hi = vtr(aa + 4 * 320);
                acc[m] = MFMA32(__builtin_shufflevector(lo, hi, 0, 1, 2, 3, 4, 5, 6, 7), bf, acc[m]);
            }
        }
        const int tl = 32 * nt + r32, row = t0 + tl;
        const float bias = C.in[I_GBS][(l * 4 + g) * 128 + tl];
#pragma unroll
        for (int m = 0; m < 2; ++m)
#pragma unroll
            for (int q = 0; q < 4; ++q) { const int c0 = 32 * (mb + m) + 8 * q + 4 * hh;
                const u32x2 ur = upre[m][q];
                u32x2 o;
                o[0] = cvtpk(geluf_(bf2f(ur[0] & 0xffffu)) * (acc[m][4 * q] + bias), geluf_(bf2f(ur[0] >> 16)) * (acc[m][4 * q + 1] + bias));
                o[1] = cvtpk(geluf_(bf2f(ur[1] & 0xffffu)) * (acc[m][4 * q + 2] + bias), geluf_(bf2f(ur[1] >> 16)) * (acc[m][4 * q + 3] + bias));
                *(u32x2*)(BR + (size_t)row * NBR + 1024 + g * 128 + c0) = o; }
    }
}

#define CE_D(a, b) do { const float _h = fmaxf(a, b), _l = fminf(a, b); a = _h; b = _l; } while (0)
__device__ __forceinline__ void sort16_desc(float (&x)[16]) {
#define S16(a, b) CE_D(x[a], x[b])
    S16(0, 13); S16(1, 12); S16(2, 15); S16(3, 14); S16(4, 8); S16(5, 6); S16(7, 11); S16(9, 10);
    S16(0, 5); S16(1, 7); S16(2, 9); S16(3, 4); S16(6, 13); S16(8, 14); S16(10, 15); S16(11, 12);
    S16(0, 1); S16(2, 3); S16(4, 5); S16(6, 8); S16(7, 9); S16(10, 11); S16(12, 13); S16(14, 15);
    S16(0, 2); S16(1, 3); S16(4, 10); S16(5, 11); S16(6, 7); S16(8, 9); S16(12, 14); S16(13, 15);
    S16(1, 2); S16(3, 12); S16(4, 6); S16(5, 7); S16(8, 10); S16(9, 11); S16(13, 14);
    S16(1, 4); S16(2, 6); S16(5, 8); S16(7, 10); S16(9, 13); S16(11, 14);
    S16(2, 4); S16(3, 6); S16(9, 12); S16(11, 13);
    S16(3, 5); S16(6, 8); S16(7, 9); S16(10, 12);
    S16(3, 4); S16(5, 6); S16(7, 8); S16(9, 10); S16(11, 12);
    S16(6, 7); S16(8, 9);
#undef S16
}
__device__ __forceinline__ void bmerge16_desc(float (&x)[16]) {
#pragma unroll
    for (int j = 8; j > 0; j >>= 1)
#pragma unroll
        for (int i = 0; i < 16; ++i) { const int l = i ^ j; if (l > i) CE_D(x[i], x[l]); }
}
__device__ __forceinline__ void top16_merge(float (&a)[16], const float (&b)[16]) {
#pragma unroll
    for (int i = 0; i < 16; ++i) a[i] = fmaxf(a[i], b[15 - i]);
    bmerge16_desc(a);
}
__device__ __forceinline__ float pack_idx(float v, unsigned idx, unsigned mask) { return __builtin_bit_cast(float, (__builtin_bit_cast(unsigned, v) & ~mask) | idx); }

constexpr int TK_KST = 272, TK_KBUF = 128 * TK_KST;
__device__ __forceinline__ void p_topk(const Ctx& C, int l) {
    const bf16_t* Q = (const bf16_t*)(C.ws + WS_Q);
    const bf16_t* keys = (const bf16_t*)(C.ws + WS_W + (size_t)l * W_LAYER + WO_KEYS);
    int* eidx = (int*)(C.ws + WS_EIDX); float* egate = (float*)(C.ws + WS_EGATE);
    LAS unsigned char* lds = C.lds;
    const int lane = C.lane, w = C.wave, r32 = lane & 31, hh = lane >> 5;
    for (int u = C.bid; u < (T / 256) * PH; u += C.G) {
        const int h = u & 7, t0 = (u >> 3) * 256, tok = t0 + 32 * w + r32;
        float v12[2][16];
        __syncthreads();
#pragma unroll
        for (int j = 0; j < 2; ++j) {
            const bf16_t* kp = keys + ((size_t)j * PH + h) * 128 * 128;
#pragma unroll
            for (int p = 0; p < 4; ++p) { const int idx = C.tid + 512 * p, row = idx >> 4, ch = idx & 15;
                *(LAS u32x4*)(lds + j * TK_KBUF + row * TK_KST + ch * 16) = *(const u32x4*)(kp + row * 128 + ch * 8); }
        }
        __syncthreads();
#pragma unroll
        for (int j = 0; j < 2; ++j) {
            bf16x8 qf[8];
            {
                LAS unsigned char* qs = lds + 2 * TK_KBUF + w * (32 * 272);
                u32x4 qr[8];
#pragma unroll
                for (int p = 0; p < 8; ++p) qr[p] = *(const u32x4*)(Q + (size_t)(t0 + 32 * w + 4 * p + (lane >> 4)) * NQ + h * 256 + j * 128 + (lane & 15) * 8);
#pragma unroll
                for (int p = 0; p < 8; ++p) *(LAS u32x4*)(qs + (4 * p + (lane >> 4)) * 272 + (lane & 15) * 16) = qr[p];
#pragma unroll
                for (int ks = 0; ks < 8; ++ks) qf[ks] = *(const LAS bf16x8*)(qs + r32 * 272 + 32 * ks + 16 * hh);
            }
            f32x16 sacc[4];
#pragma unroll
            for (int mt = 0; mt < 4; ++mt)
#pragma unroll
                for (int i = 0; i < 16; ++i) sacc[mt][i] = 0.f;
#pragma unroll
            for (int ks = 0; ks < 8; ++ks)
#pragma unroll
                for (int mt = 0; mt < 4; ++mt) {
                    const bf16x8 kf = *(const LAS bf16x8*)(lds + j * TK_KBUF + (32 * mt + r32) * TK_KST + 32 * ks + 16 * hh);
                    sacc[mt] = MFMA32(kf, qf[ks], sacc[mt]);
                }
            float g[4][16];
#pragma unroll
            for (int mt = 0; mt < 4; ++mt) {
#pragma unroll
                for (int i = 0; i < 16; ++i) g[mt][i] = pack_idx(sacc[mt][i], (unsigned)(32 * mt + (i & 3) + 8 * (i >> 2) + 4 * hh), 127u);
                sort16_desc(g[mt]);
            }
            top16_merge(g[0], g[1]); top16_merge(g[2], g[3]); top16_merge(g[0], g[2]);
            float o[16];
#pragma unroll
            for (int i = 0; i < 16; ++i) o[i] = __shfl_xor(g[0][i], 32, 64);
            top16_merge(g[0], o);
#pragma unroll
            for (int i = 0; i < 16; ++i) v12[j][i] = g[0][i];
        }
        float c[4][16];
        {
            int n = 0;
#pragma unroll
            for (int a = 0; a < 16; ++a)
#pragma unroll
                for (int b = 0; b < 16; ++b) if ((a + 1) * (b + 1) <= 16) {
                    const unsigned id = ((__builtin_bit_cast(unsigned, v12[0][a]) & 127u) << 7) | (__builtin_bit_cast(unsigned, v12[1][b]) & 127u);
                    c[n >> 4][n & 15] = pack_idx(v12[0][a] + v12[1][b], id, 16383u); ++n; }
#pragma unroll
            for (; n < 64; ++n) c[n >> 4][n & 15] = -3.0e38f;
        }
        sort16_desc(c[1]); sort16_desc(c[2]); CE_D(c[3][0], c[3][1]);
        top16_merge(c[0], c[1]); top16_merge(c[2], c[3]); top16_merge(c[0], c[2]);
        float e[16], den = 0.f;
#pragma unroll
        for (int i = 0; i < 16; ++i) { e[i] = __expf(c[0][i] - c[0][0]); den += e[i]; }
        const float inv = 1.f / den;
        int* ip = eidx + (size_t)tok * 128 + h * 16 + 8 * hh; float* gp = egate + (size_t)tok * 128 + h * 16 + 8 * hh;
        u32x4 i0, i1; f32x4 g0, g1;
#pragma unroll
        for (int i = 0; i < 4; ++i) {
            const float ca = hh ? c[0][8 + i] : c[0][i], cb = hh ? c[0][12 + i] : c[0][4 + i];
            i0[i] = __builtin_bit_cast(unsigned, ca) & 16383u; i1[i] = __builtin_bit_cast(unsigned, cb) & 16383u;
            g0[i] = (hh ? e[8 + i] : e[i]) * inv; g1[i] = (hh ? e[12 + i] : e[4 + i]) * inv;
        }
        *(u32x4*)ip = i0; *(u32x4*)(ip + 4) = i1; *(f32x4*)gp = g0; *(f32x4*)(gp + 4) = g1;
    }
}

constexpr int CW_DIAG = 64;
__device__ __forceinline__ void diag_cmp(const Ctx& C, const bf16_t* A, int lda, const bf16_t* R, int ldr, int nc) {
    float sd = 0.f, sr = 0.f;
    for (int row = C.bid; row < T; row += C.G) {
        const int tm = row % DIAG_MOD; if (tm < DIAG_LO || tm >= DIAG_HI) continue;
        for (int c = C.tid; c < nc; c += 512) { const float a = bf2f(A[(size_t)row * lda + c]), r = bf2f(R[(size_t)row * ldr + c]); sd += (a - r) * (a - r); sr += r * r; }
    }
    sd = wave_sum(sd); sr = wave_sum(sr);
    if (C.lane == 0) { atomicAdd((float*)(C.ws + WS_CTL) + CW_DIAG, sd); atomicAdd((float*)(C.ws + WS_CTL) + CW_DIAG + 1, sr); }
}
__device__ __forceinline__ void diag_cmp_u8(const Ctx& C, const unsigned char* A, int lda, const bf16_t* R, int ldr, int nc) {
    float sd = 0.f, sr = 0.f;
    for (int row = C.bid; row < T; row += C.G)
        for (int c = C.tid; c < nc; c += 512) { const float a = (float)A[(size_t)row * lda + c] * (1.f / 255.f), r = bf2f(R[(size_t)row * ldr + c]); sd += (a - r) * (a - r); sr += r * r; }
    sd = wave_sum(sd); sr = wave_sum(sr);
    if (C.lane == 0) { atomicAdd((float*)(C.ws + WS_CTL) + CW_DIAG, sd); atomicAdd((float*)(C.ws + WS_CTL) + CW_DIAG + 1, sr); }
}
__device__ __forceinline__ float diag_alpha(const Ctx& C) {
    const float sd = __hip_atomic_load((float*)(C.ws + WS_CTL) + CW_DIAG, __ATOMIC_RELAXED, __HIP_MEMORY_SCOPE_AGENT), sr = __hip_atomic_load((float*)(C.ws + WS_CTL) + CW_DIAG + 1, __ATOMIC_RELAXED, __HIP_MEMORY_SCOPE_AGENT);
    const float err = fmaxf(sd / fmaxf(sr, 1e-30f), 1e-8f);
    return 0.1f + 0.1f * (rintf(log10f(err / 1e-8f) * 10.f) * 0.1f);
}


#if DIAG == 5 || DIAG == 6
__device__ __forceinline__ void diag_ref_slice(const Ctx& C, const float* W, int ldw, int n0, const float* bias) {
    bf16_t* alt = (bf16_t*)(C.ws + WS_XA);
    const float* X = C.in[I_X];
    for (int row = C.bid * 8 + C.wave; row < T; row += C.G * 8) {
        float acc = 0.f;
        for (int k = 0; k < DM; ++k) acc += X[(size_t)row * DM + k] * W[(size_t)k * ldw + n0 + C.lane];
        if (bias) acc = sigmoidf_(acc + bias[n0 + C.lane]);
        alt[(size_t)row * 64 + C.lane] = (bf16_t)f2bf(acc);
    }
}
#endif

__device__ __forceinline__ void wave_argmax(float& v, int& i) {
#pragma unroll
    for (int o = 32; o > 0; o >>= 1) {
        const float ov = __shfl_xor(v, o, 64); const int oi = __shfl_xor(i, o, 64);
        if (ov > v || (ov == v && oi < i)) { v = ov; i = oi; }
    }
}
__device__ __forceinline__ void p_topk_naive(const Ctx& C, int l) {
    const bf16_t* Q = (const bf16_t*)(C.ws + WS_Q);
    const bf16_t* keys = (const bf16_t*)(C.ws + WS_W + (size_t)l * W_LAYER + WO_KEYS);
    int* eidx = (int*)(C.ws + WS_EIDX); float* egate = (float*)(C.ws + WS_EGATE);
    LAS float* qs = (LAS float*)C.lds;
    LAS float* sc = qs + 2048;
    LAS float* tv = sc + 2048;
    LAS int* ti = (LAS int*)(tv + 256);
    for (int t = C.bid; t < T; t += C.G) {
        for (int i = C.tid; i < 2048; i += 512) qs[i] = bf2f(Q[(size_t)t * NQ + i]);
        __syncthreads();
        for (int i = 0; i < 4; ++i) {
            const int idx = C.tid + 512 * i, hj = idx >> 7, key = idx & 127, h = hj >> 1, j = hj & 1;
            const bf16_t* kp = keys + (((size_t)j * PH + h) * 128 + key) * 128;
            float s = 0.f;
            for (int d8 = 0; d8 < 16; ++d8) {
                const u32x4 raw = *(const u32x4*)(kp + d8 * 8);
#pragma unroll
                for (int e = 0; e < 4; ++e) s += qs[h * 256 + j * 128 + d8 * 8 + 2 * e] * bf2f(raw[e] & 0xffffu) + qs[h * 256 + j * 128 + d8 * 8 + 2 * e + 1] * bf2f(raw[e] >> 16);
            }
            sc[idx] = s;
        }
        __syncthreads();
        for (int i = 0; i < 2; ++i) {
            const int hj = C.wave * 2 + i;
            float a0 = sc[hj * 128 + C.lane], a1 = sc[hj * 128 + 64 + C.lane];
            for (int r = 0; r < 16; ++r) {
                float bv; int bi;
                if (a0 > a1 || (a0 == a1)) { bv = a0; bi = C.lane; } else { bv = a1; bi = C.lane + 64; }
                wave_argmax(bv, bi);
                if (C.lane == 0) { tv[hj * 16 + r] = bv; ti[hj * 16 + r] = bi; }
                if (bi == C.lane) a0 = -3e38f; if (bi == C.lane + 64) a1 = -3e38f;
            }
        }
        __syncthreads();
        {
            const int h = C.wave;
            float cv[4];
#pragma unroll
            for (int i = 0; i < 4; ++i) { const int c = C.lane * 4 + i; cv[i] = tv[(h * 2) * 16 + (c >> 4)] + tv[(h * 2 + 1) * 16 + (c & 15)]; }
            float topv = 0.f; int tope = 0; float mx = 0.f;
            for (int r = 0; r < 16; ++r) {
                float bv = cv[0]; int bi = C.lane * 4;
#pragma unroll
                for (int i = 1; i < 4; ++i) if (cv[i] > bv) { bv = cv[i]; bi = C.lane * 4 + i; }
                wave_argmax(bv, bi);
                if (r == 0) mx = bv;
                if (C.lane == r) { topv = bv; tope = ti[(h * 2) * 16 + (bi >> 4)] * 128 + ti[(h * 2 + 1) * 16 + (bi & 15)]; }
#pragma unroll
                for (int i = 0; i < 4; ++i) if (bi == C.lane * 4 + i) cv[i] = -3e38f;
            }
            float e = (C.lane < 16) ? __expf(topv - mx) : 0.f;
            const float den = wave_sum(e);
            if (C.lane < 16) { eidx[(size_t)t * 128 + h * 16 + C.lane] = tope; egate[(size_t)t * 128 + h * 16 + C.lane] = e / den; }
        }
        __syncthreads();
    }
}
__device__ __forceinline__ float ub(unsigned w, int e) { return (float)((w >> (8 * e)) & 255u); }
__device__ __forceinline__ void p_gather(const Ctx& C, int l) {
    const bf16_t* xc = (const bf16_t*)(C.ws + WS_X1B);
    const unsigned char* U8 = C.ws + WS_U8; const unsigned char* V8 = C.ws + WS_V8;
    const float* SU = (const float*)(C.ws + WS_SU); const float* SV = (const float*)(C.ws + WS_SV);
    const int* eidx = (const int*)(C.ws + WS_EIDX); const float* egate = (const float*)(C.ws + WS_EGATE);
    const int lane = C.lane;
    for (int t = C.bid * 8 + C.wave; t < T; t += C.G * 8) {
        float x[16];
        { const bf16_t* xp = xc + (size_t)t * DM + lane * 16;
          const u32x4 a = *(const u32x4*)xp, b = *(const u32x4*)(xp + 8);
#pragma unroll
          for (int i = 0; i < 4; ++i) { x[2 * i] = bf2f(a[i] & 0xffffu); x[2 * i + 1] = bf2f(a[i] >> 16); x[8 + 2 * i] = bf2f(b[i] & 0xffffu); x[9 + 2 * i] = bf2f(b[i] >> 16); } }
        f32x2 x2[8];
#pragma unroll
        for (int j = 0; j < 8; ++j) x2[j] = (f32x2){x[2 * j], x[2 * j + 1]};
        float cf[2]; int ex[2];
#pragma unroll
        for (int bt = 0; bt < 2; ++bt) {
            ex[bt] = eidx[(size_t)t * 128 + 64 * bt + lane];
            const float gate = egate[(size_t)t * 128 + 64 * bt + lane];
            float p[64];
#pragma unroll
            for (int e0 = 0; e0 < 64; e0 += 16) {
                u32x2 r[16];
#pragma unroll
                for (int i = 0; i < 16; ++i) { const int e = __builtin_amdgcn_readlane(ex[bt], e0 + i); r[i] = *(const u32x2*)(U8 + (size_t)e * V6_ROW + lane * 8); }
#pragma unroll
                for (int i = 0; i < 16; ++i) { f32x2 a2 = {0.f, 0.f};
#pragma unroll
                    for (int q = 0; q < 2; ++q) {
                        a2 += x2[4 * q + 0] * __builtin_amdgcn_cvt_scalef32_pk_f32_fp4(r[i][q], 1.0f, 0);
                        a2 += x2[4 * q + 1] * __builtin_amdgcn_cvt_scalef32_pk_f32_fp4(r[i][q], 1.0f, 1);
                        a2 += x2[4 * q + 2] * __builtin_amdgcn_cvt_scalef32_pk_f32_fp4(r[i][q], 1.0f, 2);
                        a2 += x2[4 * q + 3] * __builtin_amdgcn_cvt_scalef32_pk_f32_fp4(r[i][q], 1.0f, 3); }
                    p[e0 + i] = a2[0] + a2[1]; }
            }
#pragma unroll
            for (int st = 32, n = 32; st > 0; st >>= 1, n >>= 1) {
                const bool up = (lane & st) != 0;
#pragma unroll
                for (int i = 0; i < n; ++i) { const float send = up ? p[i] : p[i + n], keep = up ? p[i + n] : p[i]; p[i] = keep + __shfl_xor(send, st, 64); }
            }
            const float hsum = SU[ex[bt]] * p[0];
            cf[bt] = gate * geluf_slow(hsum) * SV[ex[bt]];
        }
        f32x2 y2[8];
#pragma unroll
        for (int j = 0; j < 8; ++j) y2[j] = (f32x2){0.f, 0.f};
#pragma unroll
        for (int bt = 0; bt < 2; ++bt)
#pragma unroll
            for (int e0 = 0; e0 < 64; e0 += 16) {
                u32x2 r[16];
#pragma unroll
                for (int i = 0; i < 16; ++i) { const int e = __builtin_amdgcn_readlane(ex[bt], e0 + i); r[i] = *(const u32x2*)(V8 + (size_t)e * V6_ROW + lane * 8); }
#pragma unroll
                for (int i = 0; i < 16; ++i) { const float c = __builtin_bit_cast(float, __builtin_amdgcn_readlane(__builtin_bit_cast(int, cf[bt]), e0 + i));
                    const f32x2 c2 = {c, c};
#pragma unroll
                    for (int q = 0; q < 2; ++q) {
                        y2[4 * q + 0] += c2 * __builtin_amdgcn_cvt_scalef32_pk_f32_fp4(r[i][q], 1.0f, 0);
                        y2[4 * q + 1] += c2 * __builtin_amdgcn_cvt_scalef32_pk_f32_fp4(r[i][q], 1.0f, 1);
                        y2[4 * q + 2] += c2 * __builtin_amdgcn_cvt_scalef32_pk_f32_fp4(r[i][q], 1.0f, 2);
                        y2[4 * q + 3] += c2 * __builtin_amdgcn_cvt_scalef32_pk_f32_fp4(r[i][q], 1.0f, 3); } }
            }
        float y[16];
#pragma unroll
        for (int j = 0; j < 8; ++j) { y[2 * j] = y2[j][0]; y[2 * j + 1] = y2[j][1]; }
#pragma unroll
        for (int j = 0; j < 16; ++j) y[j] = y[j] + ALPHA * x[j];
        float sm = 0.f;
#pragma unroll
        for (int j = 0; j < 16; ++j) sm += y[j];
        const float mean = wave_sum(sm) * (1.f / DM);
        float qq = 0.f;
#pragma unroll
        for (int j = 0; j < 16; ++j) { const float d = y[j] - mean; qq += d * d; }
        const float rstd = rsqrtf(wave_sum(qq) * (1.f / DM) + LN_EPS);
        const float* gp = C.in[I_LN2G] + l * DM + lane * 16; const float* bp = C.in[I_LN2B] + l * DM + lane * 16;
        asm volatile("" : "+v"(gp), "+v"(bp));
#pragma unroll
        for (int i = 0; i < 4; ++i) { const f32x4 gg = *(const f32x4*)(gp + 4 * i), bb = *(const f32x4*)(bp + 4 * i);
#pragma unroll
            for (int e = 0; e < 4; ++e) y[4 * i + e] = (y[4 * i + e] - mean) * rstd * gg[e] + bb[e]; }
        float* dst = (l + 1 < DEPTH) ? (float*)(C.ws + WS_XA) + (size_t)t * DM : C.out + (size_t)t * DM;
#if DIAG
        if (l + 1 == DEPTH) { const float al = 1.f + diag_alpha(C);
#pragma unroll
            for (int j = 0; j < 16; ++j) y[j] *= al; }
#endif
#pragma unroll
        for (int i = 0; i < 4; ++i) *(f32x4*)(dst + lane * 16 + 4 * i) = (f32x4){y[4 * i], y[4 * i + 1], y[4 * i + 2], y[4 * i + 3]};
        if (l + 1 < DEPTH) {
            {
                float mx = 0.f;
#pragma unroll
                for (int j = 0; j < 16; ++j) mx = fmaxf(mx, fabsf(y[j]));
                mx = fmaxf(wave_max(mx), 1e-30f);
                const float isc = 127.f / mx;
                u32x4 o8;
#pragma unroll
                for (int q = 0; q < 4; ++q) { unsigned wd = 0u;
#pragma unroll
                    for (int e = 0; e < 4; ++e) wd |= ((unsigned)(int)rintf(y[4 * q + e] * isc) & 255u) << (8 * e);
                    o8[q] = wd; }
                *(u32x4*)(C.ws + WS_XB + (size_t)t * DM + lane * 16) = o8;
                if (lane == 0) ((float*)(C.ws + WS_XSA))[t] = mx * (1.f / 127.f);
            }
            const float* wf = (const float*)(C.ws + WS_W + (size_t)(l + 1) * W_LAYER + WO_WF) + lane * 16;
            asm volatile("" : "+v"(wf));
            float* lsig = (float*)(C.ws + WS_MISC);
#pragma unroll
            for (int h = 0; h < 4; ++h) {
                float sd = 0.f;
#pragma unroll
                for (int i = 0; i < 4; ++i) { const f32x4 a = *(const f32x4*)(wf + h * DM + 4 * i);
#pragma unroll
                    for (int e = 0; e < 4; ++e) sd += y[4 * i + e] * a[e]; }
                sd = wave_sum(sd);
                if (lane == 0) lsig[(size_t)t * 4 + h] = logsigmoidf_(sd + C.in[I_BFOX][(l + 1) * 4 + h]);
            }
        }
    }
}

struct FStoreBf16 { bf16_t* O; int ld;
    __device__ __forceinline__ void operator()(int row, int col, f32x4 v0, f32x4 v1, int) const {
        u32x4 o; o[0] = pk2(v0[0], v0[1]); o[1] = pk2(v0[2], v0[3]); o[2] = pk2(v1[0], v1[1]); o[3] = pk2(v1[2], v1[3]);
        *(u32x4*)(O + (size_t)row * ld + col) = o; } };
typedef int i32x4 __attribute__((ext_vector_type(4)));
__device__ __forceinline__ void i8_dequant(f32x4& v0, f32x4& v1, float sa, const float* cs) {
    sa *= (1.f / 127.f);
    const f32x4 c0 = *(const f32x4*)cs, c1 = *(const f32x4*)(cs + 4);
    const i32x4 i0 = __builtin_bit_cast(i32x4, v0), i1 = __builtin_bit_cast(i32x4, v1);
#pragma unroll
    for (int e = 0; e < 4; ++e) { v0[e] = (float)i0[e] * sa * c0[e]; v1[e] = (float)i1[e] * sa * c1[e]; }
}
struct FStoreBf16I8 { bf16_t* O; int ld; const float* rs; const float* cs;
    __device__ __forceinline__ void operator()(int row, int col, f32x4 v0, f32x4 v1, int) const {
        i8_dequant(v0, v1, rs[row], cs + col);
        u32x4 o; o[0] = pk2(v0[0], v0[1]); o[1] = pk2(v0[2], v0[3]); o[2] = pk2(v1[0], v1[1]); o[3] = pk2(v1[2], v1[3]);
        *(u32x4*)(O + (size_t)row * ld + col) = o; } };
struct FGateI8 { unsigned char* O; const float* bias; const float* rs; const float* cs;
    __device__ __forceinline__ void operator()(int row, int col, f32x4 v0, f32x4 v1, int) const {
        const float sa = rs[row] * (-1.4426950408889634f / 127.f);
        const f32x4 c0 = *(const f32x4*)(cs + col), c1 = *(const f32x4*)(cs + col + 4);
        const f32x4 b0 = *(const f32x4*)(bias + col), b1 = *(const f32x4*)(bias + col + 4);
        const i32x4 i0 = __builtin_bit_cast(i32x4, v0), i1 = __builtin_bit_cast(i32x4, v1);
        u32x2 o; unsigned w0 = 0u, w1 = 0u;
#pragma unroll
        for (int e = 0; e < 4; ++e) {
            const float e0 = __builtin_amdgcn_exp2f(__builtin_fmaf((float)i0[e] * sa, c0[e], -1.4426950408889634f * b0[e])), e1 = __builtin_amdgcn_exp2f(__builtin_fmaf((float)i1[e] * sa, c1[e], -1.4426950408889634f * b1[e]));
            const unsigned q0 = max((unsigned)__builtin_fmaf(__builtin_amdgcn_rcpf(1.f + e0), 255.f, 0.5f), 1u), q1 = max((unsigned)__builtin_fmaf(__builtin_amdgcn_rcpf(1.f + e1), 255.f, 0.5f), 1u);
            w0 |= q0 << (8 * e); w1 |= q1 << (8 * e); }
        o[0] = w0; o[1] = w1;
        *(u32x2*)(O + (size_t)row * NG + col) = o; } };
struct FGate { bf16_t* O; const float* bias;
    __device__ __forceinline__ void operator()(int row, int col, f32x4 v0, f32x4 v1, int) const {
        const f32x4 b0 = *(const f32x4*)(bias + col), b1 = *(const f32x4*)(bias + col + 4);
        u32x4 o; o[0] = pk2(sigmoidf_(v0[0] + b0[0]), sigmoidf_(v0[1] + b0[1])); o[1] = pk2(sigmoidf_(v0[2] + b0[2]), sigmoidf_(v0[3] + b0[3]));
        o[2] = pk2(sigmoidf_(v1[0] + b1[0]), sigmoidf_(v1[1] + b1[1])); o[3] = pk2(sigmoidf_(v1[2] + b1[2]), sigmoidf_(v1[3] + b1[3]));
        *(u32x4*)(O + (size_t)row * NG + col) = o; } };
struct FMerge { const unsigned char* G; bf16_t* MG;
    __device__ __forceinline__ void operator()(int row, int col, f32x4 v0, f32x4 v1, int z) const {
        const u32x2 gr = *(const u32x2*)(G + (size_t)row * NG + z * DM + col);
        float r[8];
#pragma unroll
        for (int e = 0; e < 4; ++e) { r[e] = v0[e] * (float)((gr[0] >> (8 * e)) & 255u) * (1.f / 255.f); r[4 + e] = v1[e] * (float)((gr[1] >> (8 * e)) & 255u) * (1.f / 255.f); }
        bf16_t* p = MG + (size_t)row * DM + col;
        if (z > 0) { const u32x4 pr = *(const u32x4*)p;
#pragma unroll
            for (int e = 0; e < 4; ++e) { r[2 * e] += bf2f(pr[e] & 0xffffu); r[2 * e + 1] += bf2f(pr[e] >> 16); } }
        u32x4 o;
#pragma unroll
        for (int e = 0; e < 4; ++e) o[e] = pk2(r[2 * e], r[2 * e + 1]);
        *(u32x4*)p = o; } };
struct FResid { const float* X; bf16_t* Y;
    __device__ __forceinline__ void operator()(int row, int col, f32x4 v0, f32x4 v1, int) const {
        const f32x4 x0 = *(const f32x4*)(X + (size_t)row * DM + col), x1 = *(const f32x4*)(X + (size_t)row * DM + col + 4);
#if DIAG == 5 || DIAG == 6
        v0 = (f32x4){0.f, 0.f, 0.f, 0.f}; v1 = v0;
#endif
        u32x4 o; o[0] = cvtpk(x0[0] * ALPHA + v0[0], x0[1] * ALPHA + v0[1]); o[1] = cvtpk(x0[2] * ALPHA + v0[2], x0[3] * ALPHA + v0[3]);
        o[2] = cvtpk(x1[0] * ALPHA + v1[0], x1[1] * ALPHA + v1[1]); o[3] = cvtpk(x1[2] * ALPHA + v1[2], x1[3] * ALPHA + v1[3]);
        *(u32x4*)(Y + (size_t)row * DM + col) = o; } };

constexpr int PH_PER_LAYER = 12, N_PHASES = 1 + DEPTH * PH_PER_LAYER;
template <int SP> __device__ __forceinline__ void run_phase(const Ctx& C0, int l) {
    Ctx C = C0;
    asm volatile("" : "+v"(C.tid));
    C.ws = launder_ptr(C.ws); C.out = launder_ptr(C.out); l = (int)launder_u((unsigned)l);
    C.lane = C.tid & 63; C.wave = __builtin_amdgcn_readfirstlane(C.tid >> 6);
    unsigned char* wb = C.ws + WS_W + (size_t)l * W_LAYER;
    if constexpr (SP == -1) { p_conv_weights(C); p_rowpass0(C); }
    if constexpr (SP == 1) {
        p_cumsum(C);
        __syncthreads();
        pg8::Gemm g{(const bf16_t*)(C.ws + WS_XB), (const bf16_t*)(wb + WO_WIN), DM, DM, DM, 0, 0};
        pg8::StaticOrder S; S.init(T, NH, C.G, C.bid);
        pg8::Epi8<FStoreBf16I8> E{{(bf16_t*)(C.ws + WS_H), NH, (const float*)(C.ws + WS_XSA), (const float*)(C.ws + WS_CMAX) + l * (NH + NG)}};
        pg8::gemm_phase<pg8::Epi8<FStoreBf16I8>, pg8::StaticOrder, true>(C.lds, g, S, E, C.tid);
    }
#if DIAG == 5
    if constexpr (SP == 2) { if (l == 0) { diag_ref_slice(C, C.in[I_WIN], NIN, DIAG_N0, nullptr); } }
    if constexpr (SP == 3) { if (l == 0) diag_cmp(C, (const bf16_t*)(C.ws + WS_H) + DIAG_N0, NH, (const bf16_t*)(C.ws + WS_XA), 64, 64); }
#endif
#if DIAG == 6
    if constexpr (SP == 5) { if (l == 0) diag_ref_slice(C, C.in[I_WGATE], NG, DIAG_N0, C.in[I_BGATE]); }
    if constexpr (SP == 6) { if (l == 0) diag_cmp_u8(C, C.ws + WS_G + DIAG_N0, NG, (const bf16_t*)(C.ws + WS_XA), 64, 64); }
#endif
    if constexpr (SP == 2) { p_knorm(C, l); p_gmlp_prep(C, l); if (l != HG_NAIVE_L) hgrn_b1(C, l); }
#if MIX_NAIVE
    if constexpr (SP == 3) { if (l != HG_NAIVE_L) hgrn_b2(C); mix_pool_naive(C, l); mix_gmlp_naive(C, l); }
#else
    if constexpr (SP == 3) { if (l != HG_NAIVE_L) hgrn_b2(C); mix_pool(C, l); mix_gmlp(C, l);
        if (DIAG == 2) mix_pool_naive(C, l); if (DIAG == 3) mix_gmlp_naive(C, l); }
#endif
#if DIAG == 1
    if constexpr (SP == 4) { hgrn_b3(C, l); { mix_hgrn_naive(C, l); __syncthreads(); } mix_fox(C, l); }
    if constexpr (SP == 5) { if (l == DIAG_LAYER) diag_cmp(C, (const bf16_t*)(C.ws + (DIAG_LAYER == 0 ? WS_XA : WS_TABU)) + 512, NBR, (const bf16_t*)(C.ws + WS_BR) + 512, NBR, 512); }
#elif DIAG == 2 || DIAG == 3
    if constexpr (SP == 4) { hgrn_b3(C, l); mix_fox(C, l); if (l == DIAG_LAYER) diag_cmp(C, (const bf16_t*)(C.ws + (DIAG_LAYER == 0 ? WS_XA : WS_TABU)) + (DIAG == 2 ? 0 : 1024), NBR, (const bf16_t*)(C.ws + WS_BR) + (DIAG == 2 ? 0 : 1024), NBR, 512); }
#else
    if constexpr (SP == 4) { if (l != HG_NAIVE_L) hgrn_b3(C, l); else { mix_hgrn_naive(C, l); __syncthreads(); } mix_fox(C, l); }
#endif
    if constexpr (SP == 5) {
        pg8::Gemm g{(const bf16_t*)(C.ws + WS_XB), (const bf16_t*)(wb + WO_WG), DM, DM, DM, 0, 0};
        pg8::StaticOrder S; S.init(T, NG, C.G, C.bid);
        pg8::Epi8<FGateI8> E{{C.ws + WS_G, C.in[I_BGATE] + l * NG, (const float*)(C.ws + WS_XSA), (const float*)(C.ws + WS_CMAX) + l * (NH + NG) + NH}};
        pg8::gemm_phase<pg8::Epi8<FGateI8>, pg8::StaticOrder, true>(C.lds, g, S, E, C.tid);
    }
    if constexpr (SP == 6) {
        pg8::Gemm g{(const bf16_t*)(C.ws + WS_BR), (const bf16_t*)(wb + WO_WBR), NBR, BW, BW, (size_t)BW, (size_t)DM * BW};
        pg8::ZOrder S; S.init(T, DM, 4, C.G, C.vcu);
        pg8::EpiMerge E{C.ws + WS_G, (bf16_t*)(C.ws + WS_XB)};
        pg8::gemm_phase(C.lds, g, S, E, C.tid);
    }
    if constexpr (SP == 7) {
        const float* xin = (l == 0) ? C.in[I_X] : (const float*)(C.ws + WS_XA);
        pg8::Gemm g{(const bf16_t*)(C.ws + WS_XB), (const bf16_t*)(wb + WO_WOUT), DM, DM, DM, 0, 0};
        pg8::StaticOrder S; S.init(T, DM, C.G, C.bid);
        pg8::Epi8<FResid> E{{xin, (bf16_t*)(C.ws + WS_XC)}};
        pg8::gemm_phase(C.lds, g, S, E, C.tid);
    }
    if constexpr (SP == 8) { p_ln1(C, l); p_conv_tables(C, l); }
    if constexpr (SP == 9) {
        pg8::Gemm g{(const bf16_t*)(C.ws + WS_XB), (const bf16_t*)(wb + WO_WQ), DM, DM, DM, 0, 0};
        pg8::StaticOrder S; S.init(T, NQ, C.G, C.bid);
        pg8::Epi8<FStoreBf16I8> E{{(bf16_t*)(C.ws + WS_Q), NQ, (const float*)(C.ws + WS_XSA), (const float*)(C.ws + WS_CMAX) + DEPTH * (NH + NG) + l * NQ}};
        pg8::gemm_phase<pg8::Epi8<FStoreBf16I8>, pg8::StaticOrder, true>(C.lds, g, S, E, C.tid);
    }
#if TOPK_NAIVE
    if constexpr (SP == 10) p_topk_naive(C, l);
#else
    if constexpr (SP == 10) p_topk(C, l);
#endif
    if constexpr (SP == 11) p_gather(C, l);
}
__device__ __forceinline__ void make_ctx(Ctx& C, const Args& args, unsigned char* lds_raw) {
    C.lds = (LAS unsigned char*)lds_raw; C.ws = args.ws; C.in = args.in; C.out = args.out;
    C.tid = threadIdx.x; C.lane = C.tid & 63; C.wave = __builtin_amdgcn_readfirstlane(C.tid >> 6);
    C.G = gridDim.x; C.bid = blockIdx.x; C.vcu = (C.G % 8 == 0) ? (C.bid % 8) * (C.G / 8) + C.bid / 8 : C.bid;
}
#if !MK_ONE_LAUNCH
template <int SP> __global__ void __launch_bounds__(512, 2) mk_phase(Args args) {
    extern __shared__ __attribute__((aligned(16))) unsigned char lds_raw[];
    Ctx C; make_ctx(C, args, lds_raw);
    run_phase<SP>(C, args.ph_lo);
}
#endif

#define GRID_BAR() xcd_barrier((unsigned*)(args.ws + WS_CTL) + 1024, (volatile LAS unsigned*)((LAS unsigned char*)lds_raw + LDSCTL_OFF + 32))
__global__ void __launch_bounds__(512, 2) mk_fwd(Args args) {
    extern __shared__ __attribute__((aligned(16))) unsigned char lds_raw[];
    Ctx C; make_ctx(C, args, lds_raw);
    { volatile LAS unsigned* misc = (volatile LAS unsigned*)(C.lds + LDSCTL_OFF); if (C.tid < 64) misc[C.tid] = 0u; }
    __syncthreads();
    xcd_barrier_post((unsigned*)(args.ws + WS_CTL) + 1024);
    run_phase<-1>(C, 0); GRID_BAR();
#pragma unroll 1
    for (int l = 0; l < DEPTH; ++l) {
        run_phase<1>(C, l); GRID_BAR();
        run_phase<2>(C, l); GRID_BAR();
        run_phase<3>(C, l); GRID_BAR();
        run_phase<4>(C, l); GRID_BAR();
        run_phase<5>(C, l); GRID_BAR();
        run_phase<6>(C, l); GRID_BAR();
        run_phase<7>(C, l); GRID_BAR();
        run_phase<8>(C, l); GRID_BAR();
        run_phase<9>(C, l); GRID_BAR();
        run_phase<10>(C, l); GRID_BAR();
        run_phase<11>(C, l); if (l + 1 < DEPTH) GRID_BAR();
    }
}

#if !MK_ONE_LAUNCH
template <int SP> static void launch_phase(const Args& a, int grid, hipStream_t stream) {
    static bool attr_done = false;
    if (!attr_done) { (void)hipFuncSetAttribute((const void*)mk_phase<SP>, hipFuncAttributeMaxDynamicSharedMemorySize, LDS_BYTES); attr_done = true; }
    hipLaunchKernelGGL(mk_phase<SP>, dim3(grid), dim3(512), LDS_BYTES, stream, a);
}
#endif
extern "C" void kernel_launch(void* const* d_in, const int* in_sizes, int n_in, void* d_out, int out_size, void* d_ws, size_t ws_size, hipStream_t stream) {
    static int grid = 0;
    if (grid == 0) {
        if (n_in != NIN_PTRS || out_size != T * DM || ws_size < WS_END) { fprintf(stderr, "kernel_launch: unexpected shapes n_in %d out %d ws %zu\n", n_in, out_size, ws_size); grid = -1; return; }
        int dev = 0, cus = 0;
        if (hipGetDevice(&dev) != hipSuccess || hipDeviceGetAttribute(&cus, hipDeviceAttributeMultiprocessorCount, dev) != hipSuccess) { grid = -1; return; }
        grid = cus;
    }
    if (grid < 0) return;
    (void)hipMemsetAsync((char*)d_ws + WS_CTL, 0, CTL_ZERO_BYTES, stream);
    Args a{};
    for (int i = 0; i < NIN_PTRS; ++i) a.in[i] = (const float*)d_in[i];
    a.out = (float*)d_out; a.ws = (unsigned char*)d_ws; a.bar_slot = 0; a.pad = 0; a.ph_hi = 0;
#if MK_ONE_LAUNCH
    static bool attr_done = false;
    if (!attr_done) { (void)hipFuncSetAttribute((const void*)mk_fwd, hipFuncAttributeMaxDynamicSharedMemorySize, LDS_BYTES); attr_done = true; }
    hipLaunchKernelGGL(mk_fwd, dim3(grid), dim3(512), LDS_BYTES, stream, a);
    return;
#endif
#if !MK_ONE_LAUNCH
    a.ph_lo = 0; launch_phase<-1>(a, grid, stream);
    for (int l = 0; l < DEPTH; ++l) {
        a.ph_lo = l;
        launch_phase<0>(a, grid, stream); launch_phase<1>(a, grid, stream); launch_phase<2>(a, grid, stream); launch_phase<3>(a, grid, stream); launch_phase<4>(a, grid, stream);
        launch_phase<5>(a, grid, stream); launch_phase<6>(a, grid, stream); launch_phase<7>(a, grid, stream); launch_phase<8>(a, grid, stream); launch_phase<9>(a, grid, stream); launch_phase<10>(a, grid, stream); launch_phase<11>(a, grid, stream);
    }
#endif
}
```

```cpp
#include <hip/hip_runtime.h>
#include <cstdio>
#include <cstdint>

#ifndef DIAG
#define DIAG 0
#endif
#ifndef DIAG_LO
#define DIAG_LO 0
#endif
#ifndef DIAG_HI
#define DIAG_HI 64
#endif
#ifndef DIAG_MOD
#define DIAG_MOD 64
#endif
#ifndef TOPK_NAIVE
#define TOPK_NAIVE 0
#endif
#ifndef MIX_NAIVE
#define MIX_NAIVE 0
#endif
#ifndef DIAG_N0
#define DIAG_N0 4096
#endif
#ifndef FOX_NAIVE
#define FOX_NAIVE 0
#endif
#ifndef HG_NAIVE_L
#define HG_NAIVE_L 99
#endif
#ifndef DIAG_LAYER
#define DIAG_LAYER 0
#endif
#ifndef MK_ONE_LAUNCH
#define MK_ONE_LAUNCH 1
#endif

#define LAS __attribute__((address_space(3)))
#define GAS __attribute__((address_space(1)))
typedef unsigned short bf16_t;
typedef short bf16x8 __attribute__((ext_vector_type(8)));
typedef float f32x4 __attribute__((ext_vector_type(4)));
typedef float f32x2 __attribute__((ext_vector_type(2)));
typedef unsigned u32x4 __attribute__((ext_vector_type(4)));
typedef unsigned u32x2 __attribute__((ext_vector_type(2)));
typedef unsigned u32x3a __attribute__((ext_vector_type(3), aligned(4)));

constexpr int DM = 1024, BATCH = 2, SEQ = 8192, DEPTH = 2, T = BATCH * SEQ;
constexpr int BW = 512, NIN = 5124, NH = 5120, NG = 4096, NBR = 2048, NQ = 2048;
constexpr int NEXP = 16384, TOPK = 16, PH = 8;
constexpr float ALPHA = 1.4142135623730951f;
constexpr float LN_EPS = 1e-5f, RMS_EPS = 1e-6f;
constexpr int HC_P = 0, HC_HQ = 512, HC_HF = 1024, HC_HI = 1536, HC_HG = 2048, HC_GU = 2560, HC_GV = 3072, HC_FQ = 3584, HC_FK = 4096, HC_FV = 4608;

constexpr size_t MiB = 1u << 20;
constexpr size_t WS_CTL = 0, CTL_ZERO_BYTES = 160 * 1024;
constexpr size_t WS_CMAX = 64 * 1024;
constexpr size_t WS_MISC = 512 * 1024;
constexpr size_t WS_CUM = 768 * 1024;
constexpr size_t WS_W = 1 * MiB;
constexpr size_t W_LAYER = 30 * MiB;
constexpr size_t WO_WIN = 0, WO_WG = 10 * MiB, WO_WBR = 18 * MiB, WO_WOUT = 22 * MiB, WO_WQ = 24 * MiB, WO_KEYS = 28 * MiB, WO_WF = 28 * MiB + 512 * 1024, WO_POOLW = 28 * MiB + 768 * 1024, WO_GWS = 29 * MiB, WO_CS = 29 * MiB + 512 * 1024;
constexpr size_t WS_TABU = 64 * MiB, WS_TABV = 96 * MiB;
constexpr size_t WS_XA = 128 * MiB;
constexpr size_t WS_XB = 192 * MiB;
constexpr size_t WS_X1B = 224 * MiB;
constexpr size_t WS_H = 256 * MiB;
constexpr size_t WS_ST = 416 * MiB;
constexpr size_t WS_BR = 448 * MiB;
constexpr size_t WS_G = 256 * MiB;
constexpr size_t WS_MGF = 384 * MiB;
constexpr size_t WS_XC = 256 * MiB;
constexpr size_t WS_Q = 320 * MiB;
constexpr size_t WS_EIDX = 384 * MiB, WS_EGATE = 392 * MiB;
constexpr size_t WS_XSA = 256 * 1024;
constexpr size_t WS_END = 512 * MiB;

__device__ __forceinline__ float bf2f(unsigned u) { return __builtin_bit_cast(float, u << 16); }
__device__ __forceinline__ unsigned f2bf(float f) { unsigned u = __builtin_bit_cast(unsigned, f); return (u + 0x7fffu + ((u >> 16) & 1u)) >> 16; }
typedef __bf16 bf16x2_t __attribute__((ext_vector_type(2)));
__device__ __forceinline__ unsigned cvtpk(float lo, float hi) { f32x2 v = {lo, hi}; bf16x2_t b = __builtin_convertvector(v, bf16x2_t); return __builtin_bit_cast(unsigned, b); }
__device__ __forceinline__ unsigned pk2(float lo, float hi) { return cvtpk(lo, hi); }
__device__ __forceinline__ float wave_sum(float v) {
#pragma unroll
    for (int o = 32; o > 0; o >>= 1) v += __shfl_xor(v, o, 64);
    return v;
}
__device__ __forceinline__ float sigmoidf_(float x) { return __builtin_amdgcn_rcpf(1.f + __builtin_amdgcn_exp2f(-1.4426950408889634f * x)); }
__device__ __forceinline__ float siluf_(float x) { return x * __builtin_amdgcn_rcpf(1.f + __builtin_amdgcn_exp2f(-1.4426950408889634f * x)); }
__device__ __forceinline__ float geluf_slow(float x) { const float u = 0.7978845608028654f * (x + 0.044715f * x * x * x); return 0.5f * x * (1.f + tanhf(u)); }
__device__ __forceinline__ float geluf_(float x) { const float u2 = -2.302208198f * (x + 0.044715f * x * x * x); return x * __builtin_amdgcn_rcpf(1.f + __builtin_amdgcn_exp2f(u2)); }
__device__ __forceinline__ float logsigmoidf_(float z) { return fminf(z, 0.f) - log1pf(__expf(-fabsf(z))); }

__device__ __forceinline__ unsigned launder_u(unsigned x) { asm volatile("" : "+v"(x)); return __builtin_amdgcn_readfirstlane(x); }
template <class P> __device__ __forceinline__ P launder_ptr(P p) {
    const unsigned lo = launder_u((unsigned)(uintptr_t)p), hi = launder_u((unsigned)((uintptr_t)p >> 32));
    return (P)(((uintptr_t)hi << 32) | lo);
}

namespace pg8 {
constexpr int BM = 256, BK = 64, HALF = 128, HTB = HALF * BK * 2, STAGE_BYTES = 8 * HTB, NXCD = 8, WGM = 8;
__host__ __device__ __forceinline__ int lds_byte(int r, int c) { const int st = (r >> 4) * 2 + (c >> 5), rr = r & 15, cc = c & 31, ob = rr * 64 + cc * 2; return st * 1024 + (ob ^ (((ob >> 9) & 1) << 5)); }
__host__ __device__ __forceinline__ void stage_rc(int b, int& R, int& C) { const int st = b / 1024, sb = b % 1024, swz = sb ^ (((sb >> 9) & 1) << 5); R = (st >> 1) * 16 + swz / 64; C = (st & 1) * 32 + (swz % 64) / 2; }
__host__ __device__ __forceinline__ int perm32(int rho) { const int n = rho >> 4, i = rho & 15; return 8 * (i >> 2) + 4 * n + (i & 3); }

struct Unit { int pm, pn, z; };
struct Gemm { const bf16_t* A; const bf16_t* Bt; int lda, ldb, K; size_t zA, zB; };

struct StaticOrder {
    int nM, nN, nwg, G, c;
    __device__ void init(int M, int N, int G_, int c_) { nM = M / BM; nN = N / BM; nwg = nM * nN; G = G_; c = c_; }
    __device__ bool next(int i, Unit& u) const {
        const long L = (long)i * G + c; if (L >= nwg) return false;
        int wgid = (int)L; { const int q = nwg / NXCD, r = nwg % NXCD, xcd = wgid % NXCD, off = wgid / NXCD; wgid = (xcd < r ? xcd * (q + 1) : r * (q + 1) + (xcd - r) * q) + off; }
        const int nig = WGM * nN, gid = wgid / nig, fm = gid * WGM, gsz = (nM - fm) < WGM ? (nM - fm) : WGM;
        u.pm = fm + ((wgid % nig) % gsz); u.pn = (wgid % nig) / gsz; u.z = 0; return true;
    }
};
struct ZOrder {
    int nM, nN, nZ, ntile, G, c;
    __device__ void init(int M, int N, int Z, int G_, int c_) { nM = M / BM; nN = N / BM; nZ = Z; ntile = nM * nN; G = G_; c = c_; }
    __device__ bool next(int i, Unit& u) const {
        const long L = (long)(i / nZ) * G + c; if (L >= ntile) return false;
        u.pm = (int)L / nN; u.pn = (int)L % nN; u.z = i % nZ; return true;
    }
};

template <class F> struct Epi8 {
    static constexpr bool PERM = true;
    F f;
    __device__ __forceinline__ bool keep(const Unit&) const { return false; }
    __device__ __forceinline__ void operator()(const f32x4 (&acc)[2][2][4][2], const Unit& u, int wr, int wc, int fr, int fq) const {
        const int row0 = u.pm * BM + wr * 64 + fr, col0 = u.pn * BM + wc * 32 + 8 * fq;
#pragma unroll
        for (int ai = 0; ai < 2; ++ai)
#pragma unroll
            for (int m = 0; m < 4; ++m)
#pragma unroll
                for (int bj = 0; bj < 2; ++bj) f(row0 + ai * HALF + m * 16, col0 + bj * HALF, acc[ai][bj][m][0], acc[ai][bj][m][1], u.z);
    }
};
template <class F> struct Epi4 {
    static constexpr bool PERM = false;
    F f;
    __device__ __forceinline__ bool keep(const Unit&) const { return false; }
    __device__ __forceinline__ void operator()(const f32x4 (&acc)[2][2][4][2], const Unit& u, int wr, int wc, int fr, int fq) const {
        const int row0 = u.pm * BM + wr * 64 + fr, col0 = u.pn * BM + wc * 32 + 4 * fq;
#pragma unroll
        for (int ai = 0; ai < 2; ++ai)
#pragma unroll
            for (int m = 0; m < 4; ++m)
#pragma unroll
                for (int bj = 0; bj < 2; ++bj)
#pragma unroll
                    for (int n = 0; n < 2; ++n) f(row0 + ai * HALF + m * 16, col0 + bj * HALF + n * 16, acc[ai][bj][m][n], u.z);
    }
};

struct EpiMerge {
    static constexpr bool PERM = true;
    const unsigned char* G; bf16_t* MG;
    __device__ __forceinline__ bool keep(const Unit& u) const { return u.z < 3; }
    __device__ __forceinline__ void operator()(f32x4 (&acc)[2][2][4][2], const Unit& u, int wr, int wc, int fr, int fq) const {
        const int row0 = u.pm * BM + wr * 64 + fr, col0 = u.pn * BM + wc * 32 + 8 * fq;
        const unsigned char* gp0 = G + (size_t)row0 * NG + u.z * DM + col0;
        if (u.z < 3) {
#pragma unroll
            for (int ai = 0; ai < 2; ++ai)
#pragma unroll
                for (int m = 0; m < 4; ++m) {
                    if ((m & 1) == 0) asm volatile("" ::: "memory");
#pragma unroll
                    for (int bj = 0; bj < 2; ++bj) {
                        const unsigned char* gp = gp0 + (size_t)(ai * HALF + m * 16) * NG + bj * HALF;
                        const u32x2 ga = *(const u32x2*)gp, gb = *(const u32x2*)(gp + DM);
#pragma unroll
                        for (int n = 0; n < 2; ++n)
#pragma unroll
                            for (int e = 0; e < 4; ++e) {
                                const float qa = (float)((ga[n] >> (8 * e)) & 255u), qb = (float)((gb[n] >> (8 * e)) & 255u);
                                acc[ai][bj][m][n][e] *= qa * __builtin_amdgcn_rcpf(qb); }
                    }
                }
        } else {
            bf16_t* op0 = MG + (size_t)row0 * DM + col0;
#pragma unroll
            for (int ai = 0; ai < 2; ++ai)
#pragma unroll
                for (int m = 0; m < 4; ++m)
#pragma unroll
                    for (int bj = 0; bj < 2; ++bj) {
                        const u32x2 ga = *(const u32x2*)(gp0 + (size_t)(ai * HALF + m * 16) * NG + bj * HALF);
                        u32x4 o;
#pragma unroll
                        for (int n = 0; n < 2; ++n)
#pragma unroll
                            for (int e2 = 0; e2 < 2; ++e2) {
                                const float q0 = (float)((ga[n] >> (16 * e2)) & 255u) * (1.f / 255.f), q1 = (float)((ga[n] >> (16 * e2 + 8)) & 255u) * (1.f / 255.f);
                                o[2 * n + e2] = cvtpk(acc[ai][bj][m][n][2 * e2] * q0, acc[ai][bj][m][n][2 * e2 + 1] * q1); }
                        *(u32x4*)(op0 + (size_t)(ai * HALF + m * 16) * DM + bj * HALF) = o;
                    }
        }
    }
};

typedef int i32x4 __attribute__((ext_vector_type(4)));
template <class Epi, class Sched, bool I8 = false, bool ALIGN_EPI = true>
__device__ __forceinline__ void gemm_phase(LAS unsigned char* lds, const Gemm g, const Sched& S, const Epi& E, const int tid) {
    constexpr int ES = I8 ? 1 : 2;
    const int wid = __builtin_amdgcn_readfirstlane(tid >> 6), lane = tid & 63, wr = wid >> 2, wc = wid & 3, fr = lane & 15, fq = lane >> 4;
    const int K = g.K, nt = K * ES / 128;
    unsigned voffA[2], voffB[2];
#pragma unroll
    for (int i = 0; i < 2; ++i) { int R, C; stage_rc(tid * 16 + i * 8192, R, C); const int Rb = Epi::PERM ? ((R & ~31) + perm32(R & 31)) : R;
        voffA[i] = (unsigned)(R * g.lda * ES + C * 2); voffB[i] = (unsigned)(Rb * g.ldb * ES + C * 2); }
    const size_t kstep = (size_t)(BK * 2);
    const size_t hstepA = (size_t)HALF * g.lda * ES, hstepB = (size_t)HALF * g.ldb * ES;
    const size_t tstepA = 2 * hstepA, tstepB = 2 * hstepB;
    const unsigned ldsw = (unsigned)wid * 1024u;
    const int aoff = lds_byte(wr * 64 + fr, fq * 8), boff = lds_byte(wc * 32 + fr, fq * 8);
#define PG8_SA(b, h) (((b) * 2 + (h)) * HTB)
#define PG8_SB(b, h) ((4 + (b) * 2 + (h)) * HTB)
#define PG8_STAGE(bufoff, gbase, voff) do { _Pragma("unroll") for (int _i = 0; _i < 2; ++_i) \
        __builtin_amdgcn_global_load_lds((const unsigned*)((const char*)(gbase) + (voff)[_i]), (LAS unsigned*)(lds + (bufoff) + ldsw + _i * 8192), 16, 0, 0); } while (0)
#define PG8_LDA(dst, b, h) do { _Pragma("unroll") for (int m = 0; m < 4; ++m) _Pragma("unroll") for (int k = 0; k < 2; ++k) dst[m][k] = *(const LAS bf16x8*)(lds + PG8_SA(b, h) + aoff + m * 2048 + k * 1024); } while (0)
#define PG8_LDB(dst, b, h) do { _Pragma("unroll") for (int n = 0; n < 2; ++n) _Pragma("unroll") for (int k = 0; k < 2; ++k) dst[n][k] = *(const LAS bf16x8*)(lds + PG8_SB(b, h) + boff + n * 2048 + k * 1024); } while (0)
#define PG8_MMA(ai, bj, At, Bt) do { __builtin_amdgcn_s_setprio(1); _Pragma("unroll") for (int m = 0; m < 4; ++m) _Pragma("unroll") for (int n = 0; n < 2; ++n) _Pragma("unroll") for (int k = 0; k < 2; ++k) { \
        if constexpr (I8) acc[ai][bj][m][n] = __builtin_bit_cast(f32x4, __builtin_amdgcn_mfma_i32_16x16x64_i8(__builtin_bit_cast(i32x4, Bt[n][k]), __builtin_bit_cast(i32x4, At[m][k]), __builtin_bit_cast(i32x4, acc[ai][bj][m][n]), 0, 0, 0)); \
        else acc[ai][bj][m][n] = __builtin_amdgcn_mfma_f32_16x16x32_bf16(Bt[n][k], At[m][k], acc[ai][bj][m][n], 0, 0, 0); } __builtin_amdgcn_s_setprio(0); } while (0)
#define PG8_WAIT_V(n) asm volatile("s_waitcnt vmcnt(" #n ")" ::: "memory")
#define PG8_WAIT_L(n) asm volatile("s_waitcnt lgkmcnt(" #n ")" ::: "memory")
#define PG8_BAR __builtin_amdgcn_s_barrier()
#define PG8_SCHED __builtin_amdgcn_sched_barrier(0)
    Unit cur, nxt; int ui = 0;
    if (!S.next(0, cur)) return;
    f32x4 acc[2][2][4][2];
#pragma unroll
    for (int a = 0; a < 2; ++a)
#pragma unroll
        for (int b = 0; b < 2; ++b)
#pragma unroll
            for (int m = 0; m < 4; ++m)
#pragma unroll
                for (int n = 0; n < 2; ++n) acc[a][b][m][n] = (f32x4){0.f, 0.f, 0.f, 0.f};
    bf16x8 At[4][2], B0[2][2], B1[2][2];
    const char* cA = (const char*)g.A + (size_t)cur.z * g.zA * ES + (size_t)cur.pm * tstepA; const char* cB = (const char*)g.Bt + (size_t)cur.z * g.zB * ES + (size_t)cur.pn * tstepB;
    PG8_STAGE(PG8_SB(0, 0), cB, voffB); PG8_STAGE(PG8_SB(0, 1), cB + hstepB, voffB); PG8_STAGE(PG8_SA(0, 0), cA, voffA); PG8_STAGE(PG8_SA(0, 1), cA + hstepA, voffA);
    if (wr == 1) PG8_BAR;
    PG8_WAIT_V(2); PG8_BAR;
    PG8_STAGE(PG8_SB(1, 0), cB + kstep, voffB); PG8_STAGE(PG8_SA(1, 0), cA + kstep, voffA); PG8_STAGE(PG8_SB(1, 1), cB + hstepB + kstep, voffB);
    PG8_WAIT_V(6); PG8_BAR;
    for (;;) {
        const bool has_next = S.next(ui + 1, nxt);
        const char* nA = has_next ? (const char*)g.A + (size_t)nxt.z * g.zA * ES + (size_t)nxt.pm * tstepA : cA;
        const char* nB = has_next ? (const char*)g.Bt + (size_t)nxt.z * g.zB * ES + (size_t)nxt.pn * tstepB : cB;
        for (int t = 0; t < nt; t += 2) {
            const bool last = (t == nt - 2);
            const char* a1 = cA + (size_t)(t + 1) * kstep;
            const char* a2 = last ? nA : cA + (size_t)(t + 2) * kstep; const char* b2 = last ? nB : cB + (size_t)(t + 2) * kstep;
            const char* a3 = a2 + kstep; const char* b3 = b2 + kstep;
            PG8_LDB(B0, 0, 0); PG8_LDB(B1, 0, 1); PG8_SCHED; PG8_LDA(At, 0, 0); PG8_STAGE(PG8_SA(1, 1), a1 + hstepA, voffA);
            PG8_WAIT_V(8); PG8_WAIT_L(0); PG8_BAR; PG8_MMA(0, 0, At, B0); PG8_MMA(0, 1, At, B1); PG8_BAR; PG8_SCHED;
            PG8_LDA(At, 0, 1); PG8_STAGE(PG8_SB(0, 0), b2, voffB); PG8_STAGE(PG8_SB(0, 1), b2 + hstepB, voffB); PG8_STAGE(PG8_SA(0, 0), a2, voffA);
            PG8_WAIT_V(8); PG8_WAIT_L(0); PG8_BAR; PG8_MMA(1, 0, At, B0); PG8_MMA(1, 1, At, B1); PG8_BAR; PG8_SCHED;
            PG8_LDB(B0, 1, 0); PG8_LDB(B1, 1, 1); PG8_SCHED; PG8_LDA(At, 1, 0); PG8_STAGE(PG8_SA(0, 1), a2 + hstepA, voffA);
            PG8_WAIT_V(8); PG8_WAIT_L(0); PG8_BAR; PG8_MMA(0, 0, At, B0); PG8_MMA(0, 1, At, B1); PG8_BAR; PG8_SCHED;
            PG8_LDA(At, 1, 1); PG8_STAGE(PG8_SB(1, 0), b3, voffB); PG8_STAGE(PG8_SB(1, 1), b3 + hstepB, voffB); PG8_STAGE(PG8_SA(1, 0), a3, voffA);
            PG8_WAIT_V(8); PG8_WAIT_L(0); PG8_BAR; PG8_MMA(1, 0, At, B0); PG8_MMA(1, 1, At, B1); PG8_BAR; PG8_SCHED;
        }
        if constexpr (ALIGN_EPI) { if (wr == 0) PG8_BAR; }
        E(acc, cur, wr, wc, fr, fq);
        if (!has_next) break;
        if (!E.keep(cur)) {
#pragma unroll
            for (int a = 0; a < 2; ++a)
#pragma unroll
                for (int b = 0; b < 2; ++b)
#pragma unroll
                    for (int m = 0; m < 4; ++m)
#pragma unroll
                        for (int n = 0; n < 2; ++n) acc[a][b][m][n] = (f32x4){0.f, 0.f, 0.f, 0.f};
        }
        cur = nxt; cA = nA; cB = nB; ++ui;
        if constexpr (ALIGN_EPI) { if (wr == 1) PG8_BAR; }
    }
    PG8_WAIT_V(0);
    if constexpr (!ALIGN_EPI) { if (wr == 0) PG8_BAR; }
    PG8_BAR;
#undef PG8_SA
#undef PG8_SB
#undef PG8_STAGE
#undef PG8_LDA
#undef PG8_LDB
#undef PG8_MMA
#undef PG8_WAIT_V
#undef PG8_WAIT_L
#undef PG8_BAR
#undef PG8_SCHED
}
}

#define XB_TMO      128
#define XB_XCNT(j)  (256  + 64 * (j))
#define XB_XSUB(j)  (1280 + 64 * (j))
#define XB_XGEN(j)  (2304 + 64 * (j))
#define XB_TOP      3328
#define XB_TOPGEN   3392
#define XCD_BAR_WORDS 3456
#define XB_SPIN_CAP (1u << 22)
__device__ __forceinline__ unsigned xb_ld(unsigned* p)              { return __hip_atomic_load(p, __ATOMIC_RELAXED, __HIP_MEMORY_SCOPE_AGENT); }
__device__ __forceinline__ unsigned xb_add(unsigned* p, unsigned v) { return __hip_atomic_fetch_add(p, v, __ATOMIC_RELAXED, __HIP_MEMORY_SCOPE_AGENT); }
__device__ __forceinline__ unsigned xb_xcc_id() { return (unsigned)__builtin_amdgcn_s_getreg((3 << 11) | 20) & 0xFu; }
#define XB_SPIN(cond, bar) do { unsigned _sp = 0; while (cond) { __builtin_amdgcn_s_sleep(1); \
    if ((++_sp & 255u) == 0u) { if (xb_ld(&(bar)[XB_TMO])) break; if (_sp > XB_SPIN_CAP) { atomicAdd(&(bar)[XB_TMO], 1u); break; } } } } while (0)
__device__ __forceinline__ void xcd_barrier_post(unsigned* bar) {
    if (threadIdx.x == 0) (void)xb_add(&bar[XB_XCNT(xb_xcc_id())], 1u);
}
__device__ __forceinline__ void xcd_barrier_complete(unsigned* bar, unsigned x, unsigned& nloc, unsigned& nx) {
    const unsigned G = gridDim.x * gridDim.y * gridDim.z;
    unsigned sum, cnt, mine, sp = 0u;
    for (;;) {
        sum = 0u; cnt = 0u; mine = 0u;
#pragma unroll
        for (unsigned j = 0; j < 16; ++j) { const unsigned c = xb_ld(&bar[XB_XCNT(j)]); sum += c; cnt += (c > 0u) ? 1u : 0u; mine = (j == x) ? c : mine; }
        if (sum == G) break;
        __builtin_amdgcn_s_sleep(1);
        if ((++sp & 255u) == 0u) { if (xb_ld(&bar[XB_TMO])) break; if (sp > XB_SPIN_CAP) { atomicAdd(&bar[XB_TMO], 1u); break; } }
    }
    nloc = mine > 0u ? mine : 1u; nx = cnt > 0u ? cnt : 1u;
}
__device__ __noinline__ void xcd_barrier_leader(unsigned* bar, volatile LAS unsigned* st) {
    const unsigned x = xb_xcc_id();
    __builtin_amdgcn_s_waitcnt(0);
    unsigned nloc = st[0], nx = st[1];
    if (nloc == 0u) { xcd_barrier_complete(bar, x, nloc, nx); st[0] = nloc; st[1] = nx; }
    const unsigned old = xb_add(&bar[XB_XSUB(x)], 1u);
    const unsigned gen = old / nloc;
    if (old + 1u == (gen + 1u) * nloc) {
        __builtin_amdgcn_fence(__ATOMIC_RELEASE, "agent");
        asm volatile("s_waitcnt vmcnt(0)" ::: "memory");
        const unsigned og = xb_add(&bar[XB_TOP], 1u);
        const unsigned tg = og / nx;
        if (og + 1u == (tg + 1u) * nx) xb_add(&bar[XB_TOPGEN], 1u);
        else XB_SPIN(xb_ld(&bar[XB_TOPGEN]) == tg, bar);
        __builtin_amdgcn_fence(__ATOMIC_ACQUIRE, "agent");
        xb_add(&bar[XB_XGEN(x)], 1u);
        asm volatile("s_waitcnt vmcnt(0)" ::: "memory");
    } else {
        XB_SPIN(xb_ld(&bar[XB_XGEN(x)]) == gen, bar);
        __builtin_amdgcn_fence(__ATOMIC_ACQUIRE, "agent");
        asm volatile("s_waitcnt vmcnt(0)" ::: "memory");
    }
}
__device__ __forceinline__ void xcd_barrier(unsigned* bar, volatile LAS unsigned* st) {
    asm volatile("s_waitcnt vmcnt(0)" ::: "memory");
    __syncthreads();
    if (threadIdx.x == 0) xcd_barrier_leader(bar, st);
    __syncthreads();
}

constexpr int NIN_PTRS = 23;
struct Args { const float* in[NIN_PTRS]; float* out; unsigned char* ws; int ph_lo, ph_hi, bar_slot, pad; };
enum { I_X = 0, I_WIN, I_BFOX, I_POOLW, I_POOLS, I_LBL, I_HNG, I_GLNG, I_GLNB, I_GWS, I_GBS, I_WGATE, I_BGATE, I_WBR, I_WOUT, I_LN1G, I_LN1B, I_WQ, I_KEYS, I_PU, I_PV, I_LN2G, I_LN2B };

constexpr int LDS_BYTES = 147456;
constexpr int LDSCTL_OFF = 143360;

struct Ctx {
    LAS unsigned char* lds;
    unsigned char* ws;
    const float* const* in;
    float* out;
    int tid, lane, wave, G, bid, vcu;
};

__device__ __forceinline__ void tconv_job(const Ctx& C, const float* src, int ld_src, int K, int N, bf16_t* dst) {
    LAS float* tile = (LAS float*)C.lds;
    const int nk = K / 64, nn = N / 64, ntiles = nk * nn;
    for (int tl = C.bid; tl < ntiles; tl += C.G) {
        const int k0 = (tl / nn) * 64, n0 = (tl % nn) * 64;
#pragma unroll
        for (int p = 0; p < 2; ++p) {
            const int kr = (C.tid >> 4) + p * 32, nc = (C.tid & 15) * 4;
            const f32x4 v = *(const f32x4*)(src + (size_t)(k0 + kr) * ld_src + n0 + nc);
            tile[kr * 65 + nc + 0] = v[0]; tile[kr * 65 + nc + 1] = v[1]; tile[kr * 65 + nc + 2] = v[2]; tile[kr * 65 + nc + 3] = v[3];
        }
        __syncthreads();
        {
            const int n = C.tid >> 3, k8 = (C.tid & 7) * 8;
            u32x4 o;
#pragma unroll
            for (int j = 0; j < 4; ++j) o[j] = pk2(tile[(k8 + 2 * j) * 65 + n], tile[(k8 + 2 * j + 1) * 65 + n]);
            *(u32x4*)(dst + (size_t)(n0 + n) * K + k0 + k8) = o;
        }
        __syncthreads();
    }
}
__device__ __forceinline__ void cvt_copy(const Ctx& C, const float* src, bf16_t* dst, size_t n) {
    const size_t n8 = n / 8;
    for (size_t i = (size_t)C.bid * 512 + C.tid; i < n8; i += (size_t)C.G * 512) {
        const f32x4 a = *(const f32x4*)(src + i * 8), b = *(const f32x4*)(src + i * 8 + 4);
        u32x4 o; o[0] = pk2(a[0], a[1]); o[1] = pk2(a[2], a[3]); o[2] = pk2(b[0], b[1]); o[3] = pk2(b[2], b[3]);
        *(u32x4*)(dst + i * 8) = o;
    }
}
__device__ __forceinline__ void strip_unit(const Ctx& C, const float* src, int ld, unsigned char* dst, unsigned* cmax, bool split) {
    const float* p = src + (size_t)(128 * C.wave) * ld + C.lane;
    float v[128];
#pragma unroll
    for (int i = 0; i < 128; ++i) v[i] = p[(size_t)i * ld];
    if (cmax) {
        float mx = 0.f;
#pragma unroll
        for (int i = 0; i < 128; ++i) mx = fmaxf(mx, fabsf(v[i]));
        LAS float* red = (LAS float*)C.lds;
        red[C.wave * 64 + C.lane] = mx;
        __syncthreads();
        float m = red[C.lane];
#pragma unroll
        for (int w2 = 1; w2 < 8; ++w2) m = fmaxf(m, red[w2 * 64 + C.lane]);
        if (C.wave == 0) cmax[C.lane] = __builtin_bit_cast(unsigned, m);
        const float isc = 127.f / fmaxf(m, 1e-30f);
        unsigned char* dp = dst + (size_t)C.lane * 1024 + 128 * C.wave;
#pragma unroll
        for (int j4 = 0; j4 < 8; ++j4) { u32x4 o;
#pragma unroll
            for (int j = 0; j < 4; ++j) { unsigned wd = 0u;
#pragma unroll
                for (int e = 0; e < 4; ++e) wd |= ((unsigned)(int)rintf(v[16 * j4 + 4 * j + e] * isc) & 255u) << (8 * e);
                o[j] = wd; }
            *(u32x4*)(dp + 16 * j4) = o; }
        __syncthreads();
    } else {
        bf16_t* dp = split ? (bf16_t*)dst + (size_t)(C.wave >> 2) * DM * BW + (size_t)C.lane * BW + 128 * (C.wave & 3) : (bf16_t*)dst + (size_t)C.lane * 1024 + 128 * C.wave;
#pragma unroll
        for (int j8 = 0; j8 < 16; ++j8) { u32x4 o;
#pragma unroll
            for (int j = 0; j < 4; ++j) o[j] = pk2(v[8 * j8 + 2 * j], v[8 * j8 + 2 * j + 1]);
            *(u32x4*)(dp + 8 * j8) = o; }
    }
}
__device__ __forceinline__ void p_conv_weights(const Ctx& C) {
#pragma unroll 1
    for (int u = C.bid; u < DEPTH * 224; u += C.G) {
        const int l = u / 224, r = u % 224;
        unsigned char* wb = C.ws + WS_W + (size_t)l * W_LAYER;
        unsigned* cm = (unsigned*)(C.ws + WS_CMAX) + l * (NH + NG);
        const float* src; int ld; unsigned char* dst; unsigned* cx = nullptr; bool split = false;
        if (r < 80)       { src = C.in[I_WIN] + (size_t)l * DM * NIN + r * 64; ld = NIN; dst = wb + WO_WIN + (size_t)r * 64 * DM; cx = cm + r * 64; }
        else if (r < 144) { const int t = r - 80; src = C.in[I_WGATE] + (size_t)l * DM * NG + t * 64; ld = NG; dst = wb + WO_WG + (size_t)t * 64 * DM; cx = cm + NH + t * 64; }
        else if (r < 176) { const int t = r - 144, pr = t >> 4, nt = t & 15; src = C.in[I_WBR] + ((size_t)l * 4 + 2 * pr) * BW * DM + nt * 64; ld = DM; split = true;
                            dst = wb + WO_WBR + ((size_t)(2 * pr) * DM * BW + (size_t)nt * 64 * BW) * 2; }
        else if (r < 192) { const int nt = r - 176; src = C.in[I_WOUT] + (size_t)l * DM * DM + nt * 64; ld = DM; dst = wb + WO_WOUT + (size_t)nt * 64 * DM * 2; }
        else              { const int nt = r - 192; src = C.in[I_WQ] + (size_t)l * DM * NQ + nt * 64; ld = NQ; dst = wb + WO_WQ + (size_t)nt * 64 * DM; cx = (unsigned*)(C.ws + WS_CMAX) + DEPTH * (NH + NG) + l * NQ + nt * 64; }
        strip_unit(C, src, ld, dst, cx, split);
    }
    for (int l = 0; l < DEPTH; ++l) {
        unsigned char* wb = C.ws + WS_W + (size_t)l * W_LAYER;
        cvt_copy(C, C.in[I_KEYS] + (size_t)l * 2 * PH * 128 * 128, (bf16_t*)(wb + WO_KEYS), (size_t)2 * PH * 128 * 128);
        for (int g = 0; g < 4; ++g)
            tconv_job(C, C.in[I_POOLW] + ((size_t)l * 4 + g) * 128 * 128, 128, 128, 128, (bf16_t*)(wb + WO_POOLW) + (size_t)g * 128 * 128);
        {
            bf16_t* gw = (bf16_t*)(wb + WO_GWS); const float* src = C.in[I_GWS] + (size_t)l * 4 * 128 * 128;
            for (int i = C.bid * 512 + C.tid; i < 4 * 128 * 128; i += C.G * 512) { const int t = (i >> 7) & 127, sx = i & 127; gw[i] = (bf16_t)f2bf(sx <= t ? src[i] : 0.f); }
        }
        float* wf = (float*)(wb + WO_WF);
        for (int i = C.bid * 512 + C.tid; i < 4 * DM; i += C.G * 512) { const int h = i / DM, k = i % DM; wf[i] = C.in[I_WIN][(size_t)l * DM * NIN + (size_t)k * NIN + NH + h]; }
    }
}
constexpr size_t WS_U8 = WS_TABU, WS_V8 = WS_TABU + 16 * MiB, WS_SU = WS_TABU + 32 * MiB, WS_SV = WS_SU + 64 * 1024;
__device__ __forceinline__ float wave_max(float v) {
#pragma unroll
    for (int o = 32; o > 0; o >>= 1) v = fmaxf(v, __shfl_xor(v, o, 64));
    return v;
}
template <bool SIGNED> __device__ __forceinline__ void quant_rows(const Ctx& C, const float* src, unsigned char* dst, float* scl) {
    for (int row = C.bid * 8 + C.wave; row < NEXP; row += C.G * 8) {
        const float* p = src + (size_t)row * DM + C.lane * 16;
        f32x4 v[4]; float mx = 0.f;
#pragma unroll
        for (int i = 0; i < 4; ++i) { v[i] = *(const f32x4*)(p + 4 * i);
#pragma unroll
            for (int e = 0; e < 4; ++e) mx = fmaxf(mx, fabsf(v[i][e])); }
        mx = fmaxf(wave_max(mx), 1e-30f);
        const float sc = mx * (1.f / 127.f), isc = 127.f / mx;
        u32x4 o;
#pragma unroll
        for (int i = 0; i < 4; ++i) { unsigned wd = 0u;
#pragma unroll
            for (int e = 0; e < 4; ++e) { const int q = (int)rintf(v[i][e] * isc) + (SIGNED ? 0 : 128); wd |= ((unsigned)q & 255u) << (8 * e); }
            o[i] = wd; }
        *(u32x4*)(dst + (size_t)row * DM + C.lane * 16) = o;
        if (C.lane == 0) scl[row] = sc;
    }
}
constexpr int V6_ROW = 512;
__device__ __forceinline__ void quant_rows6(const Ctx& C, const float* src, unsigned char* dst, float* scl) {
    for (int row = C.bid * 8 + C.wave; row < NEXP; row += C.G * 8) {
        const float* p = src + (size_t)row * DM + C.lane * 16;
        f32x4 v[4]; float mx = 0.f;
#pragma unroll
        for (int i = 0; i < 4; ++i) { v[i] = *(const f32x4*)(p + 4 * i);
#pragma unroll
            for (int e = 0; e < 4; ++e) mx = fmaxf(mx, fabsf(v[i][e])); }
        mx = fmaxf(wave_max(mx), 1e-30f);
        const float sc = mx * (1.f / 6.f), isc = 6.f / mx;
        u32x2 o = {0u, 0u};
#pragma unroll
        for (int i = 0; i < 4; ++i)
#pragma unroll
            for (int e = 0; e < 4; ++e) { const float xv = v[i][e], a = fabsf(xv) * isc; const int k = 4 * i + e;
                unsigned c = (a < 2.f) ? (unsigned)rintf(a * 2.f) : (a < 4.f) ? 4u + (unsigned)rintf(a - 2.f) : min(6u + (unsigned)rintf((a - 4.f) * 0.5f), 7u);
                c |= (xv < 0.f) ? 8u : 0u;
                o[k >> 3] |= c << (4 * (k & 7)); }
        *(u32x2*)(dst + (size_t)row * V6_ROW + C.lane * 8) = o;
        if (C.lane == 0) scl[row] = sc;
    }
}
constexpr size_t WS_SUS = WS_SV + 64 * 1024;
__device__ __forceinline__ void quant_rows_i4(const Ctx& C, const float* src, unsigned char* dst, float* scl, float* csum) {
    for (int row = C.bid * 8 + C.wave; row < NEXP; row += C.G * 8) {
        const float* p = src + (size_t)row * DM + C.lane * 16;
        f32x4 v[4]; float mx = 0.f;
#pragma unroll
        for (int i = 0; i < 4; ++i) { v[i] = *(const f32x4*)(p + 4 * i);
#pragma unroll
            for (int e = 0; e < 4; ++e) mx = fmaxf(mx, fabsf(v[i][e])); }
        mx = fmaxf(wave_max(mx), 1e-30f);
        const float sc = mx * (1.f / 7.f), isc = 7.f / mx;
        u32x2 o = {0u, 0u}; int sm = 0;
#pragma unroll
        for (int i = 0; i < 4; ++i)
#pragma unroll
            for (int e = 0; e < 4; ++e) { const int k = 4 * i + e, c = (int)rintf(v[i][e] * isc); sm += c; o[k >> 3] |= ((unsigned)c & 15u) << (4 * (k & 7)); }
        *(u32x2*)(dst + (size_t)row * V6_ROW + C.lane * 8) = o;
        const float tot = wave_sum((float)sm);
        if (C.lane == 0) { scl[row] = sc; csum[row] = tot; }
    }
}
__device__ __forceinline__ void p_conv_tables(const Ctx& C, int l) {
    quant_rows_i4(C, C.in[I_PU] + (size_t)l * NEXP * DM, C.ws + WS_U8, (float*)(C.ws + WS_SU), (float*)(C.ws + WS_SUS));
    quant_rows6(C, C.in[I_PV] + (size_t)l * NEXP * DM, C.ws + WS_V8, (float*)(C.ws + WS_SV));
}

__device__ __forceinline__ void row_emit(const Ctx& C, int row, const float (&v)[16], int l, bool want_lsig) {
    {
        float mx = 0.f;
#pragma unroll
        for (int j = 0; j < 16; ++j) mx = fmaxf(mx, fabsf(v[j]));
#pragma unroll
        for (int o = 32; o > 0; o >>= 1) mx = fmaxf(mx, __shfl_xor(mx, o, 64));
        mx = fmaxf(mx, 1e-30f);
        const float isc = 127.f / mx;
        unsigned char* xb = C.ws + WS_XB + (size_t)row * DM;
        u32x2 o0, o1;
#pragma unroll
        for (int hw = 0; hw < 2; ++hw) { unsigned a = 0u, b = 0u;
#pragma unroll
            for (int e = 0; e < 4; ++e) { a |= ((unsigned)(int)rintf(v[4 * hw + e] * isc) & 255u) << (8 * e); b |= ((unsigned)(int)rintf(v[8 + 4 * hw + e] * isc) & 255u) << (8 * e); }
            o0[hw] = a; o1[hw] = b; }
        *(u32x2*)(xb + C.lane * 8) = o0; *(u32x2*)(xb + 512 + C.lane * 8) = o1;
        if (C.lane == 0) ((float*)(C.ws + WS_XSA))[row] = mx * (1.f / 127.f);
    }
    if (want_lsig) {
        const float* wf = (const float*)(C.ws + WS_W + (size_t)l * W_LAYER + WO_WF);
        float* lsig = (float*)(C.ws + WS_MISC);
#pragma unroll
        for (int h = 0; h < 4; ++h) {
            const f32x4 a0 = *(const f32x4*)(wf + h * DM + C.lane * 8), a1 = *(const f32x4*)(wf + h * DM + C.lane * 8 + 4);
            const f32x4 b0 = *(const f32x4*)(wf + h * DM + 512 + C.lane * 8), b1 = *(const f32x4*)(wf + h * DM + 512 + C.lane * 8 + 4);
            float s = 0.f;
#pragma unroll
            for (int j = 0; j < 4; ++j) s += v[j] * a0[j] + v[4 + j] * a1[j] + v[8 + j] * b0[j] + v[12 + j] * b1[j];
            s = wave_sum(s);
            if (C.lane == 0) lsig[(size_t)row * 4 + h] = logsigmoidf_(s + C.in[I_BFOX][l * 4 + h]);
        }
    }
}
__device__ __forceinline__ void load_row16(const float* p, int lane, float (&v)[16]) {
    const f32x4 a0 = *(const f32x4*)(p + lane * 8), a1 = *(const f32x4*)(p + lane * 8 + 4), b0 = *(const f32x4*)(p + 512 + lane * 8), b1 = *(const f32x4*)(p + 512 + lane * 8 + 4);
#pragma unroll
    for (int j = 0; j < 4; ++j) { v[j] = a0[j]; v[4 + j] = a1[j]; v[8 + j] = b0[j]; v[12 + j] = b1[j]; }
}
__device__ __forceinline__ void store_row16(float* p, int lane, const float (&v)[16]) {
    *(f32x4*)(p + lane * 8) = (f32x4){v[0], v[1], v[2], v[3]}; *(f32x4*)(p + lane * 8 + 4) = (f32x4){v[4], v[5], v[6], v[7]};
    *(f32x4*)(p + 512 + lane * 8) = (f32x4){v[8], v[9], v[10], v[11]}; *(f32x4*)(p + 512 + lane * 8 + 4) = (f32x4){v[12], v[13], v[14], v[15]};
}
__device__ __forceinline__ void ln_row16(float (&v)[16], const float* g, const float* b, int lane) {
    float s = 0.f;
#pragma unroll
    for (int j = 0; j < 16; ++j) s += v[j];
    const float mean = wave_sum(s) * (1.f / DM);
    float q = 0.f;
#pragma unroll
    for (int j = 0; j < 16; ++j) { const float d = v[j] - mean; q += d * d; }
    const float rstd = rsqrtf(wave_sum(q) * (1.f / DM) + LN_EPS);
    float gg[16], bb[16];
    load_row16(g, lane, gg); load_row16(b, lane, bb);
#pragma unroll
    for (int j = 0; j < 16; ++j) v[j] = (v[j] - mean) * rstd * gg[j] + bb[j];
}
__device__ __forceinline__ void p_rowpass0(const Ctx& C) {
    const float* wfin = C.in[I_WIN] + NH;
    f32x4 wv[16];
#pragma unroll
    for (int j = 0; j < 16; ++j) { const int k = (j < 8) ? C.lane * 8 + j : 512 + C.lane * 8 + (j - 8); wv[j] = *(const f32x4*)(wfin + (size_t)k * NIN); }
    float* lsig = (float*)(C.ws + WS_MISC);
    const bool bal = (C.G == 256);
    const int c0 = bal ? ((C.bid < 192) ? C.bid * 6 : 1152 + (C.bid - 192) * 14) : C.bid, cn = bal ? ((C.bid < 192) ? 6 : 14) : (T / 8 - C.bid + C.G - 1) / C.G, cs = bal ? 1 : C.G;
    for (int ci = 0; ci < cn; ++ci) {
        const int row = (c0 + ci * cs) * 8 + C.wave;
        float v[16]; load_row16(C.in[I_X] + (size_t)row * DM, C.lane, v);
        row_emit(C, row, v, 0, false);
#pragma unroll
        for (int h = 0; h < 4; ++h) {
            float sacc = 0.f;
#pragma unroll
            for (int j = 0; j < 16; ++j) sacc += v[j] * wv[j][h];
            sacc = wave_sum(sacc);
            if (C.lane == 0) lsig[(size_t)row * 4 + h] = logsigmoidf_(sacc + C.in[I_BFOX][h]);
        }
    }
}
__device__ __forceinline__ void p_cumsum(const Ctx& C) {
    if (C.bid >= BATCH * 4) return;
    const float* lsig = (const float*)(C.ws + WS_MISC);
    float* cum = (float*)(C.ws + WS_CUM);
    LAS float* wt = (LAS float*)C.lds;
    const int b = C.bid >> 2, h = C.bid & 3;
    float v[16];
#pragma unroll
    for (int j = 0; j < 16; ++j) v[j] = lsig[((size_t)b * SEQ + C.tid * 16 + j) * 4 + h];
#pragma unroll
    for (int j = 1; j < 16; ++j) v[j] += v[j - 1];
    float inc = v[15];
#pragma unroll
    for (int o = 1; o < 64; o <<= 1) { const float t = __shfl_up(inc, o, 64); if (C.lane >= o) inc += t; }
    if (C.lane == 63) wt[C.wave] = inc;
    __syncthreads();
    float off = inc - v[15];
    for (int w2 = 0; w2 < C.wave; ++w2) off += wt[w2];
    float* cp = cum + ((size_t)b * 4 + h) * SEQ + C.tid * 16;
#pragma unroll
    for (int j4 = 0; j4 < 4; ++j4) *(f32x4*)(cp + 4 * j4) = (f32x4){v[4 * j4] + off, v[4 * j4 + 1] + off, v[4 * j4 + 2] + off, v[4 * j4 + 3] + off};
    __syncthreads();
}
__device__ __forceinline__ void load_row16_bf(const bf16_t* p, int lane, float (&v)[16]) {
    const u32x4 a = *(const u32x4*)(p + lane * 8), b = *(const u32x4*)(p + 512 + lane * 8);
#pragma unroll
    for (int j = 0; j < 4; ++j) { v[2 * j] = bf2f(a[j] & 0xffffu); v[2 * j + 1] = bf2f(a[j] >> 16); v[8 + 2 * j] = bf2f(b[j] & 0xffffu); v[9 + 2 * j] = bf2f(b[j] >> 16); }
}
__device__ __forceinline__ void p_ln1(const Ctx& C, int l) {
    const bf16_t* y1 = (const bf16_t*)(C.ws + WS_XC); bf16_t* x1b = (bf16_t*)(C.ws + WS_X1B);
    for (int row = C.bid * 8 + C.wave; row < T; row += C.G * 8) {
        float v[16]; load_row16_bf(y1 + (size_t)row * DM, C.lane, v);
        ln_row16(v, C.in[I_LN1G] + l * DM, C.in[I_LN1B] + l * DM, C.lane);
        row_emit(C, row, v, l, false);
        u32x4 o0, o1;
#pragma unroll
        for (int j = 0; j < 4; ++j) { o0[j] = pk2(v[2 * j], v[2 * j + 1]); o1[j] = pk2(v[8 + 2 * j], v[8 + 2 * j + 1]); }
        *(u32x4*)(x1b + (size_t)row * DM + C.lane * 8) = o0; *(u32x4*)(x1b + (size_t)row * DM + 512 + C.lane * 8) = o1;
    }
}

__device__ __forceinline__ void mix_pool_naive(const Ctx& C, int l) {
    const bf16_t* H = (const bf16_t*)(C.ws + WS_H); bf16_t* BR = (bf16_t*)(C.ws + WS_BR);
    LAS float* dd = (LAS float*)C.lds;
    for (int u = C.bid; u < (T / 64) * 4; u += C.G) {
        const int g = u & 3, t0 = (u >> 2) * 64, w = 2 << g;
        for (int idx = C.tid; idx < 64 * 128; idx += 512) {
            const int r = idx >> 7, c = idx & 127, row = t0 + r, pos = row & (SEQ - 1);
            const int nwin = (pos + 1 < w) ? pos + 1 : w;
            float s = 0.f;
            for (int j = 0; j < nwin; ++j) s += bf2f(H[(size_t)(row - j) * NH + HC_P + g * 128 + c]);
            dd[idx] = s / (float)nwin - bf2f(H[(size_t)row * NH + HC_P + g * 128 + c]);
        }
        __syncthreads();
        const int dcol = C.tid & 127, rq = C.tid >> 7;
        float acc[16];
#pragma unroll
        for (int i = 0; i < 16; ++i) acc[i] = 0.f;
        const float* pw = C.in[I_POOLW] + ((size_t)l * 4 + g) * 128 * 128;
        for (int c = 0; c < 128; ++c) {
            const float wv = pw[c * 128 + dcol];
#pragma unroll
            for (int i = 0; i < 16; ++i) acc[i] += dd[(rq * 16 + i) * 128 + c] * wv;
        }
        const float sc = C.in[I_POOLS][l * BW + g * 128 + dcol];
#pragma unroll
        for (int i = 0; i < 16; ++i) BR[(size_t)(t0 + rq * 16 + i) * NBR + 0 + g * 128 + dcol] = (bf16_t)f2bf(acc[i] * sc);
        __syncthreads();
    }
}
__device__ __forceinline__ void mix_gmlp_naive(const Ctx& C, int l) {
    const bf16_t* H = (const bf16_t*)(C.ws + WS_H); bf16_t* BR = (bf16_t*)(C.ws + WS_BR);
    LAS float* vn = (LAS float*)C.lds;
    for (int u = C.bid; u < (T / 128) * 4; u += C.G) {
        const int g = u & 3, t0 = (u >> 2) * 128;
        for (int i = 0; i < 16; ++i) {
            const int r = C.wave * 16 + i, row = t0 + r;
            const u32x4 raw = *(const u32x4*)(H + (size_t)row * NH + HC_GV + C.lane * 8);
            float e[8];
#pragma unroll
            for (int j = 0; j < 4; ++j) { e[2 * j] = geluf_(bf2f(raw[j] & 0xffffu)); e[2 * j + 1] = geluf_(bf2f(raw[j] >> 16)); }
            float s = 0.f;
#pragma unroll
            for (int j = 0; j < 8; ++j) s += e[j];
            const float mean = wave_sum(s) * (1.f / BW);
            float q = 0.f;
#pragma unroll
            for (int j = 0; j < 8; ++j) { const float d = e[j] - mean; q += d * d; }
            const float rstd = rsqrtf(wave_sum(q) * (1.f / BW) + LN_EPS);
            if ((C.lane >> 4) == g) {
#pragma unroll
                for (int j = 0; j < 8; ++j) { const int col = C.lane * 8 + j;
                    vn[r * 128 + (col - g * 128)] = (e[j] - mean) * rstd * C.in[I_GLNG][l * BW + col] + C.in[I_GLNB][l * BW + col]; }
            }
        }
        __syncthreads();
        const int c = C.tid & 127, tq = C.tid >> 7;
        const float* wsg = C.in[I_GWS] + ((size_t)l * 4 + g) * 128 * 128;
        for (int t = tq; t < 128; t += 4) {
            float acc = 0.f;
            for (int s = 0; s <= t; ++s) acc += wsg[t * 128 + s] * vn[s * 128 + c];
            const float sv = acc + C.in[I_GBS][(l * 4 + g) * 128 + t];
            const float uv = geluf_(bf2f(H[(size_t)(t0 + t) * NH + HC_GU + g * 128 + c]));
            BR[(size_t)(t0 + t) * NBR + 1024 + g * 128 + c] = (bf16_t)f2bf(uv * sv);
        }
        __syncthreads();
    }
}
__device__ __forceinline__ void mix_fox_naive(const Ctx& C, int l) {
    const bf16_t* H = (const bf16_t*)(C.ws + WS_H); bf16_t* BR = (bf16_t*)(C.ws + WS_BR);
    const float* cum = (const float*)(C.ws + WS_CUM);
    const float scale = 0.08838834764831845f;
    for (int u = C.bid; u < T * 4 / 8; u += C.G) {
        const int rid = u * 8 + C.wave;
        const int h = rid & 3, row = rid >> 2, b = row / SEQ, t = row % SEQ;
        const unsigned qraw = *(const unsigned*)(H + (size_t)row * NH + HC_FQ + h * 128 + C.lane * 2);
        const float q0 = bf2f(qraw & 0xffffu) * scale, q1 = bf2f(qraw >> 16) * scale;
        const float* cm = cum + ((size_t)b * 4 + h) * SEQ;
        const float ct = cm[t];
        float m = -1e30f, lsum = 0.f, o0 = 0.f, o1 = 0.f;
        for (int s = t; s >= 0; --s) {
            const size_t kr = (size_t)(b * SEQ + s) * NH + h * 128 + C.lane * 2;
            const unsigned kraw = *(const unsigned*)(H + kr + HC_FK);
            const unsigned vraw = *(const unsigned*)(H + kr + HC_FV);
            float d = q0 * bf2f(kraw & 0xffffu) + q1 * bf2f(kraw >> 16);
            d = wave_sum(d);
            const float z = d + ct - cm[s];
            const float mn = fmaxf(m, z), al = __expf(m - mn), p = __expf(z - mn);
            lsum = lsum * al + p; o0 = o0 * al + p * bf2f(vraw & 0xffffu); o1 = o1 * al + p * bf2f(vraw >> 16); m = mn;
        }
        const float inv = 1.f / lsum;
        *(unsigned*)(BR + (size_t)row * NBR + 1536 + h * 128 + C.lane * 2) = pk2(o0 * inv, o1 * inv);
    }
}
__device__ __forceinline__ void mix_hgrn_naive(const Ctx& C, int l) {
    if (C.bid >= BATCH * 4) return;
    const bf16_t* H = (const bf16_t*)(C.ws + WS_H); bf16_t* BR = (bf16_t*)(C.ws + WS_BR);
    const int b = C.bid >> 2, h = C.bid & 3;
    LAS float* fdec = (LAS float*)C.lds;
    LAS float* kkv = fdec + 32 * 128;
    LAS float* qsv = kkv + 32 * 128;
    LAS float* vv = qsv + 32 * 128;
    LAS float* opart = vv + 32 * 128;
    const int kq = C.tid >> 7, v = C.tid & 127;
    float S[32];
#pragma unroll
    for (int j = 0; j < 32; ++j) S[j] = 0.f;
    for (int c0 = 0; c0 < SEQ; c0 += 32) {
        for (int idx = C.tid; idx < 32 * 128; idx += 512) {
            const int st = idx >> 7, k = idx & 127; const size_t rb = (size_t)(b * SEQ + c0 + st) * NH + h * 128 + k;
            float lb = 0.f;
            if (l == 1) { const float z0 = C.in[I_LBL][h * 128 + k], z1 = C.in[I_LBL][BW + h * 128 + k]; lb = 1.f / (1.f + __expf(z0 - z1)); }
            const float zf = bf2f(H[rb + HC_HF]);
            const float kk = (1.f - lb) * sigmoidf_(-zf);
            fdec[idx] = 1.f - kk; kkv[idx] = kk; qsv[idx] = siluf_(bf2f(H[rb + HC_HQ])); vv[idx] = bf2f(H[rb + HC_HI]);
        }
        __syncthreads();
        for (int st = 0; st < 32; ++st) {
            const float vt = vv[st * 128 + v];
            float part = 0.f;
#pragma unroll
            for (int j = 0; j < 32; ++j) { const int k = kq * 32 + j; S[j] = fdec[st * 128 + k] * S[j] + kkv[st * 128 + k] * vt; part += S[j] * qsv[st * 128 + k]; }
            opart[(kq * 32 + st) * 128 + v] = part;
        }
        __syncthreads();
        for (int i = 0; i < 4; ++i) {
            const int st = C.wave * 4 + i, row = b * SEQ + c0 + st;
            float o0 = 0.f, o1 = 0.f;
#pragma unroll
            for (int q = 0; q < 4; ++q) { o0 += opart[(q * 32 + st) * 128 + C.lane]; o1 += opart[(q * 32 + st) * 128 + 64 + C.lane]; }
            const float ss = wave_sum(o0 * o0 + o1 * o1);
            const float r = rsqrtf(ss * (1.f / 128.f) + RMS_EPS);
            const float g0 = siluf_(bf2f(H[(size_t)row * NH + HC_HG + h * 128 + C.lane])), g1 = siluf_(bf2f(H[(size_t)row * NH + HC_HG + h * 128 + 64 + C.lane]));
            BR[(size_t)row * NBR + 512 + h * 128 + C.lane] = (bf16_t)f2bf(o0 * r * C.in[I_HNG][l * 128 + C.lane] * g0);
            BR[(size_t)row * NBR + 512 + h * 128 + 64 + C.lane] = (bf16_t)f2bf(o1 * r * C.in[I_HNG][l * 128 + 64 + C.lane] * g1);
        }
        __syncthreads();
    }
}


typedef float f32x16 __attribute__((ext_vector_type(16)));
typedef short s16x4 __attribute__((ext_vector_type(4)));
typedef short v4i16_t __attribute__((ext_vector_type(4)));
__device__ __forceinline__ s16x4 vtr(const LAS unsigned char* p) { return __builtin_bit_cast(s16x4, __builtin_amdgcn_ds_read_tr16_b64_v4i16((LAS v4i16_t*)p)); }
__device__ __forceinline__ float xor32(float x) { return __shfl_xor(x, 32, 64); }
#define MFMA32(a, b, c) __builtin_amdgcn_mfma_f32_32x32x16_bf16((a), (b), (c), 0, 0, 0)
constexpr int CW_KMAX = 16;

__device__ __forceinline__ void p_knorm(const Ctx& C, int l) {
    const bf16_t* H = (const bf16_t*)(C.ws + WS_H);
    unsigned* kmax = (unsigned*)(C.ws + WS_CTL) + CW_KMAX + l * 8;
    for (int r0 = (C.bid * 8 + C.wave) * 8; r0 < T; r0 += C.G * 64) {
        u32x4 raw[8];
#pragma unroll
        for (int i = 0; i < 8; ++i) raw[i] = *(const u32x4*)(H + (size_t)(r0 + i) * NH + HC_FK + C.lane * 8);
        float best = 0.f;
#pragma unroll
        for (int i = 0; i < 8; ++i) { float s = 0.f;
#pragma unroll
            for (int j = 0; j < 4; ++j) { const float a = bf2f(raw[i][j] & 0xffffu), b = bf2f(raw[i][j] >> 16); s += a * a + b * b; }
            best = fmaxf(best, s); }
        best = 0.f;
#pragma unroll
        for (int i = 0; i < 8; ++i) { float s = 0.f;
#pragma unroll
            for (int j = 0; j < 4; ++j) { const float a = bf2f(raw[i][j] & 0xffffu), b = bf2f(raw[i][j] >> 16); s += a * a + b * b; }
#pragma unroll
            for (int o = 8; o > 0; o >>= 1) s += __shfl_xor(s, o, 64);
            best = fmaxf(best, s); }
        LAS float* red = (LAS float*)C.lds;
        if ((C.lane & 15) == 0) red[C.wave * 4 + (C.lane >> 4)] = best;
        __syncthreads();
        if (C.tid < 4) { float m = red[C.tid];
#pragma unroll
            for (int w2 = 1; w2 < 8; ++w2) m = fmaxf(m, red[w2 * 4 + C.tid]);
            atomicMax(kmax + (r0 / SEQ) * 4 + C.tid, __builtin_bit_cast(unsigned, m)); }
        __syncthreads();
    }
}

constexpr int FOX_KST = 272, FOX_VST = 320;
constexpr int FOX_KB = 0, FOX_VB = 2 * 64 * FOX_KST, FOX_BETA = FOX_VB + 2 * 64 * FOX_VST, FOX_FLAG = FOX_BETA + 2 * 64 * 4, FOX_END = FOX_FLAG + 2 * 8 * 4;
__device__ __forceinline__ void mix_fox(const Ctx& C, int l) {
    const bf16_t* H = (const bf16_t*)(C.ws + WS_H); bf16_t* BR = (bf16_t*)(C.ws + WS_BR);
    const float* cum = (const float*)(C.ws + WS_CUM);
    const unsigned* kmaxw = (const unsigned*)(C.ws + WS_CTL) + CW_KMAX + l * 8;
    const float LOG2E = 1.4426950408889634f, QS = 0.08838834764831845f * LOG2E;
    const int lane = C.lane, w = C.wave, r32 = lane & 31, hh = lane >> 5;
    LAS unsigned char* lds = C.lds;
    LAS float* betaL = (LAS float*)(lds + FOX_BETA);
    volatile LAS int* flagL = (volatile LAS int*)(lds + FOX_FLAG);
    for (int u = C.bid; u < BATCH * 4 * (SEQ / 256); u += C.G) {
        const int qb = u % (SEQ / 256), bh = u / (SEQ / 256), b = bh >> 2, h = bh & 3;
        const int q0 = qb * 256, qw = q0 + 32 * w;
        const size_t rowbase = (size_t)b * SEQ;
        const float* cm = cum + ((size_t)b * 4 + h) * SEQ;
        const float c0 = cm[q0];
        const float kmx = sqrtf(__builtin_bit_cast(float, __hip_atomic_load(kmaxw + b * 4 + h, __ATOMIC_RELAXED, __HIP_MEMORY_SCOPE_AGENT)));
        bf16x8 qf[8]; float qn = 0.f;
        {
            const bf16_t* qp = H + (rowbase + qw + r32) * NH + HC_FQ + h * 128 + 8 * hh;
#pragma unroll
            for (int ks = 0; ks < 8; ++ks) {
                const u32x4 raw = *(const u32x4*)(qp + 16 * ks);
                u32x4 o;
#pragma unroll
                for (int j = 0; j < 4; ++j) { const float a = bf2f(raw[j] & 0xffffu), bb = bf2f(raw[j] >> 16); qn += a * a + bb * bb; o[j] = cvtpk(a * QS, bb * QS); }
                qf[ks] = __builtin_bit_cast(bf16x8, o);
            }
            qn += xor32(qn); qn = sqrtf(qn);
        }
        const float qbound = qn * kmx * QS;
        f32x16 oacc[4];
#pragma unroll
        for (int mt = 0; mt < 4; ++mt)
#pragma unroll
            for (int i = 0; i < 16; ++i) oacc[mt][i] = 0.f;
        float m_run = -1e30f, l_run = 0.f;
        const int jmax = (q0 + 255) >> 6;
        const int srow = C.tid >> 4, sch = C.tid & 15;
        u32x4 kreg[2], vreg[2]; float breg = 0.f;
#define FOX_GLOAD(j_) do { _Pragma("unroll") for (int p = 0; p < 2; ++p) { \
                const bf16_t* rp = H + (rowbase + 64 * (j_) + srow + 32 * p) * NH + h * 128 + sch * 8; \
                kreg[p] = *(const u32x4*)(rp + HC_FK); vreg[p] = *(const u32x4*)(rp + HC_FV); } \
            if (C.tid < 64) breg = (c0 - cm[64 * (j_) + C.tid]) * LOG2E; } while (0)
#define FOX_LWRITE(buf_) do { _Pragma("unroll") for (int p = 0; p < 2; ++p) { \
                *(LAS u32x4*)(lds + FOX_KB + (buf_) * 64 * FOX_KST + (srow + 32 * p) * FOX_KST + sch * 16) = kreg[p]; \
                *(LAS u32x4*)(lds + FOX_VB + (buf_) * 64 * FOX_VST + (srow + 32 * p) * FOX_VST + sch * 16) = vreg[p]; } \
            if (C.tid < 64) betaL[(buf_) * 64 + C.tid] = breg; } while (0)
        __syncthreads();
        if (C.tid < 16) flagL[C.tid] = 0;
        FOX_GLOAD(jmax); FOX_LWRITE(jmax & 1);
        bool wdone = false;
        for (int j = jmax; j >= 0; --j) {
            const int cur = j & 1;
            __syncthreads();
            if (j < jmax) { int all = 1;
#pragma unroll
                for (int i = 0; i < 8; ++i) all &= flagL[((j + 1) & 1) * 8 + i];
                if (all) break; }
            if (j > 0) FOX_GLOAD(j - 1);
            const int k0 = 64 * j;
            if (k0 <= qw + 31 && !wdone) {
                const LAS unsigned char* kb = lds + FOX_KB + cur * 64 * FOX_KST;
                const LAS unsigned char* vb = lds + FOX_VB + cur * 64 * FOX_VST;
                f32x16 sacc[2];
#pragma unroll
                for (int mt = 0; mt < 2; ++mt)
#pragma unroll
                    for (int g = 0; g < 4; ++g) { const f32x4 bv = *(const LAS f32x4*)(betaL + cur * 64 + 32 * mt + 8 * g + 4 * hh);
                        sacc[mt][4 * g] = bv[0]; sacc[mt][4 * g + 1] = bv[1]; sacc[mt][4 * g + 2] = bv[2]; sacc[mt][4 * g + 3] = bv[3]; }
#pragma unroll
                for (int ks = 0; ks < 8; ++ks)
#pragma unroll
                    for (int mt = 0; mt < 2; ++mt) {
                        const bf16x8 kf = *(const LAS bf16x8*)(kb + (32 * mt + r32) * FOX_KST + 32 * ks + 16 * hh);
                        sacc[mt] = MFMA32(kf, qf[ks], sacc[mt]);
                    }
                const int tq = qw + r32;
                if (k0 + 63 > qw) {
#pragma unroll
                    for (int mt = 0; mt < 2; ++mt)
#pragma unroll
                        for (int i = 0; i < 16; ++i) { const int key = k0 + 32 * mt + (i & 3) + 8 * (i >> 2) + 4 * hh; if (key > tq) sacc[mt][i] = -1e30f; }
                }
                float mx = sacc[0][0];
#pragma unroll
                for (int mt = 0; mt < 2; ++mt)
#pragma unroll
                    for (int i = 0; i < 16; ++i) mx = fmaxf(mx, sacc[mt][i]);
                mx = fmaxf(mx, xor32(mx));
                const float mn = fmaxf(m_run, mx), alpha = __builtin_amdgcn_exp2f(m_run - mn);
                m_run = mn;
                float ps = 0.f;
#pragma unroll
                for (int mt = 0; mt < 2; ++mt)
#pragma unroll
                    for (int i = 0; i < 16; ++i) { const float p = __builtin_amdgcn_exp2f(sacc[mt][i] - mn); sacc[mt][i] = p; ps += p; }
                l_run = l_run * alpha + ps;
#pragma unroll
                for (int mt = 0; mt < 4; ++mt)
#pragma unroll
                    for (int i = 0; i < 16; ++i) oacc[mt][i] *= alpha;
#pragma unroll
                for (int s4 = 0; s4 < 4; ++s4) {
                    const int mtk = s4 >> 1, s = s4 & 1;
                    u32x4 pb;
#pragma unroll
                    for (int e = 0; e < 4; ++e) pb[e] = cvtpk(sacc[mtk][8 * s + 2 * e], sacc[mtk][8 * s + 2 * e + 1]);
                    const bf16x8 pfrag = __builtin_bit_cast(bf16x8, pb);
                    const int i16 = lane & 15, q4 = i16 >> 2, p4 = i16 & 3, blk = (lane >> 4) & 1;
                    const int keyA = 32 * mtk + 16 * s + 4 * hh + q4;
#pragma unroll
                    for (int mt = 0; mt < 4; ++mt) {
                        const LAS unsigned char* a0 = vb + keyA * FOX_VST + (32 * mt + 16 * blk + 4 * p4) * 2;
                        const s16x4 lo = vtr(a0), hi = vtr(a0 + 8 * FOX_VST);
                        const bf16x8 vf = __builtin_shufflevector(lo, hi, 0, 1, 2, 3, 4, 5, 6, 7);
                        oacc[mt] = MFMA32(vf, pfrag, oacc[mt]);
                    }
                }
                if (j > 0) { const float bl = (c0 - cm[k0 - 1]) * LOG2E;
                    const int ok = (qbound + bl < m_run - 40.f) ? 1 : 0;
                    wdone = __all(ok); }
            }
            if (lane == 0) flagL[cur * 8 + w] = wdone ? 1 : 0;
            if (j > 0) FOX_LWRITE(cur ^ 1);
        }
        l_run += xor32(l_run);
        const float inv = 1.f / l_run;
        bf16_t* op = BR + (rowbase + qw + r32) * NBR + 1536 + h * 128;
#pragma unroll
        for (int mt = 0; mt < 4; ++mt)
#pragma unroll
            for (int g = 0; g < 4; ++g) { u32x2 o; o[0] = cvtpk(oacc[mt][4 * g] * inv, oacc[mt][4 * g + 1] * inv); o[1] = cvtpk(oacc[mt][4 * g + 2] * inv, oacc[mt][4 * g + 3] * inv);
                *(u32x2*)(op + 32 * mt + 8 * g + 4 * hh) = o; }
    }
}


constexpr int HG_LF = 0, HG_QA = 34816, HG_QB = HG_QA + 17408, HG_KD = HG_QB + 8704, HG_KO = HG_KD + 17408, HG_KT = HG_KO + 8704, HG_VN = HG_KT + 20480, HG_AM = HG_VN + 20480, HG_END = HG_AM + 12288;
constexpr int HG_LFS = 132;
static_assert(HG_END + 2048 <= 140 * 1024, "hgrn LDS");
constexpr size_t WS_DSC = WS_ST + (size_t)BATCH * 4 * 32 * 128 * 128 * 4;

template <bool FULL>
__device__ __forceinline__ void hgrn_unit(const Ctx& C, int l, int u) {
#if DIAG == 1
    const bf16_t* H = (const bf16_t*)(C.ws + WS_H); bf16_t* BR = (l == 0) ? (bf16_t*)(C.ws + WS_XA) : (bf16_t*)(C.ws + WS_TABU);
#else
    const bf16_t* H = (const bf16_t*)(C.ws + WS_H); bf16_t* BR = (bf16_t*)(C.ws + WS_BR);
#endif
    float* STB = (float*)(C.ws + WS_ST); float* DSC = (float*)(C.ws + WS_DSC);
    LAS unsigned char* lds = C.lds;
    LAS float* LF = (LAS float*)(lds + HG_LF);
    const int lane = C.lane, w = C.wave, r32 = lane & 31, hh = lane >> 5;
    const int sc = u & 31, bh = u >> 5, b = bh >> 2, h = bh & 3;
    const int wk = w >> 1, wv = w & 1;
    const int mt = w >> 2, nt = w & 3;
    const int i16 = lane & 15, q4 = i16 >> 2, p4 = i16 & 3, blk = (lane >> 4) & 1;
    f32x16 S0, S1;
    float* stp = STB + ((size_t)bh * 32 + sc) * 128 * 128;
    if constexpr (FULL) {
#pragma unroll
        for (int i = 0; i < 16; ++i) { const int k = 32 * wk + (i & 3) + 8 * (i >> 2) + 4 * hh;
            S0[i] = stp[k * 128 + 64 * wv + r32]; S1[i] = stp[k * 128 + 64 * wv + 32 + r32]; }
    } else {
#pragma unroll
        for (int i = 0; i < 16; ++i) { S0[i] = 0.f; S1[i] = 0.f; }
    }
    float dtot = 0.f;
    const int ps = C.tid >> 3, pseg = C.tid & 7;
    float lbv[16];
#pragma unroll
    for (int j = 0; j < 16; ++j) { lbv[j] = 0.f;
        if (l == 1) { const int ch = h * 128 + 16 * pseg + j; lbv[j] = 1.f / (1.f + __expf(C.in[I_LBL][ch] - C.in[I_LBL][BW + ch])); } }
    u32x4 nf0, nf1, nv0, nv1;
    { const bf16_t* hp0 = H + ((size_t)b * SEQ + sc * 256 + ps) * NH + h * 128 + 16 * pseg;
      nf0 = *(const u32x4*)(hp0 + HC_HF); nf1 = *(const u32x4*)(hp0 + HC_HF + 8); nv0 = *(const u32x4*)(hp0 + HC_HI); nv1 = *(const u32x4*)(hp0 + HC_HI + 8); }
    for (int c = 0; c < 4; ++c) {
        const size_t row0 = (size_t)b * SEQ + sc * 256 + c * 64;
        const bf16_t* hp = H + (row0 + ps) * NH + h * 128 + 16 * pseg;
        float kkv[16], qsv[16];
        u32x4 vraw0, vraw1;
        u32x4 cg0 = {0u, 0u, 0u, 0u}, cg1 = cg0, cq0 = cg0, cq1 = cg0;
        if constexpr (FULL) { cq0 = *(const u32x4*)(hp + HC_HQ); cq1 = *(const u32x4*)(hp + HC_HQ + 8); cg0 = *(const u32x4*)(hp + HC_HG); cg1 = *(const u32x4*)(hp + HC_HG + 8); }
        {
            const u32x4 f0 = nf0, f1 = nf1;
            vraw0 = nv0; vraw1 = nv1;
            if (c < 3) { const bf16_t* hn = hp + (size_t)64 * NH;
                nf0 = *(const u32x4*)(hn + HC_HF); nf1 = *(const u32x4*)(hn + HC_HF + 8); nv0 = *(const u32x4*)(hn + HC_HI); nv1 = *(const u32x4*)(hn + HC_HI + 8); }
#pragma unroll
            for (int j = 0; j < 8; ++j) { const unsigned r = (j < 4) ? f0[j] : f1[j - 4];
                const float z0 = bf2f(r & 0xffffu), z1 = bf2f(r >> 16);
                kkv[2 * j] = (1.f - lbv[2 * j]) * sigmoidf_(-z0); kkv[2 * j + 1] = (1.f - lbv[2 * j + 1]) * sigmoidf_(-z1); }
            if constexpr (FULL) {
#pragma unroll
                for (int j = 0; j < 8; ++j) { const unsigned r = (j < 4) ? cq0[j] : cq1[j - 4]; qsv[2 * j] = siluf_(bf2f(r & 0xffffu)); qsv[2 * j + 1] = siluf_(bf2f(r >> 16)); }
            }
#pragma unroll
            for (int j4 = 0; j4 < 4; ++j4) { f32x4 o;
#pragma unroll
                for (int e = 0; e < 4; ++e) o[e] = __logf(1.f - kkv[4 * j4 + e]);
                *(LAS f32x4*)(LF + ps * HG_LFS + 16 * pseg + 4 * j4) = o; }
        }
        __syncthreads();
        {
            const int sk = C.tid & 127, sg = C.tid >> 7;
            float vals[16];
#pragma unroll
            for (int i = 0; i < 16; ++i) vals[i] = LF[(16 * sg + i) * HG_LFS + sk];
#pragma unroll
            for (int i = 1; i < 16; ++i) vals[i] += vals[i - 1];
            LAS float* TOT = (LAS float*)(lds + HG_END);
            TOT[sg * 128 + sk] = vals[15];
            __syncthreads();
            float off = 0.f;
#pragma unroll
            for (int j = 0; j < 3; ++j) if (j < sg) off += TOT[j * 128 + sk];
#pragma unroll
            for (int i = 0; i < 16; ++i) LF[(16 * sg + i) * HG_LFS + sk] = vals[i] + off;
            if (sg == 3) dtot += vals[15] + off;
        }
        __syncthreads();
        float bv[16], b31[16], bl[16];
#pragma unroll
        for (int j4 = 0; j4 < 4; ++j4) { const f32x4 x = *(const LAS f32x4*)(LF + ps * HG_LFS + 16 * pseg + 4 * j4), y = *(const LAS f32x4*)(LF + 31 * HG_LFS + 16 * pseg + 4 * j4), z = *(const LAS f32x4*)(LF + 63 * HG_LFS + 16 * pseg + 4 * j4);
#pragma unroll
            for (int e = 0; e < 4; ++e) { bv[4 * j4 + e] = x[e]; b31[4 * j4 + e] = y[e]; bl[4 * j4 + e] = z[e]; } }
        {
            u32x4 o0, o1;
#pragma unroll
            for (int j = 0; j < 4; ++j) { o0[j] = cvtpk(kkv[2 * j] * __expf(bl[2 * j] - bv[2 * j]), kkv[2 * j + 1] * __expf(bl[2 * j + 1] - bv[2 * j + 1]));
                o1[j] = cvtpk(kkv[8 + 2 * j] * __expf(bl[8 + 2 * j] - bv[8 + 2 * j]), kkv[9 + 2 * j] * __expf(bl[9 + 2 * j] - bv[9 + 2 * j])); }
            *(LAS u32x4*)(lds + HG_KT + ps * 320 + 32 * pseg) = o0; *(LAS u32x4*)(lds + HG_KT + ps * 320 + 32 * pseg + 16) = o1;
            *(LAS u32x4*)(lds + HG_VN + ps * 320 + 32 * pseg) = vraw0; *(LAS u32x4*)(lds + HG_VN + ps * 320 + 32 * pseg + 16) = vraw1;
            if constexpr (FULL) {
                const bool hi = ps >= 32;
                float rr[16];
#pragma unroll
                for (int j = 0; j < 16; ++j) rr[j] = hi ? b31[j] : 0.f;
#pragma unroll
                for (int j = 0; j < 4; ++j) { o0[j] = cvtpk(qsv[2 * j] * __expf(bv[2 * j] - rr[2 * j]), qsv[2 * j + 1] * __expf(bv[2 * j + 1] - rr[2 * j + 1]));
                    o1[j] = cvtpk(qsv[8 + 2 * j] * __expf(bv[8 + 2 * j] - rr[8 + 2 * j]), qsv[9 + 2 * j] * __expf(bv[9 + 2 * j] - rr[9 + 2 * j])); }
                *(LAS u32x4*)(lds + HG_QA + ps * 272 + 32 * pseg) = o0; *(LAS u32x4*)(lds + HG_QA + ps * 272 + 32 * pseg + 16) = o1;
#pragma unroll
                for (int j = 0; j < 4; ++j) { o0[j] = cvtpk(kkv[2 * j] * __expf(rr[2 * j] - bv[2 * j]), kkv[2 * j + 1] * __expf(rr[2 * j + 1] - bv[2 * j + 1]));
                    o1[j] = cvtpk(kkv[8 + 2 * j] * __expf(rr[8 + 2 * j] - bv[8 + 2 * j]), kkv[9 + 2 * j] * __expf(rr[9 + 2 * j] - bv[9 + 2 * j])); }
                *(LAS u32x4*)(lds + HG_KD + ps * 272 + 32 * pseg) = o0; *(LAS u32x4*)(lds + HG_KD + ps * 272 + 32 * pseg + 16) = o1;
                if (hi) {
#pragma unroll
                    for (int j = 0; j < 4; ++j) { o0[j] = cvtpk(qsv[2 * j] * __expf(bv[2 * j]), qsv[2 * j + 1] * __expf(bv[2 * j + 1]));
                        o1[j] = cvtpk(qsv[8 + 2 * j] * __expf(bv[8 + 2 * j]), qsv[9 + 2 * j] * __expf(bv[9 + 2 * j])); }
                    *(LAS u32x4*)(lds + HG_QB + (ps - 32) * 272 + 32 * pseg) = o0; *(LAS u32x4*)(lds + HG_QB + (ps - 32) * 272 + 32 * pseg + 16) = o1;
                } else {
#pragma unroll
                    for (int j = 0; j < 4; ++j) { o0[j] = cvtpk(kkv[2 * j] * __expf(b31[2 * j] - bv[2 * j]), kkv[2 * j + 1] * __expf(b31[2 * j + 1] - bv[2 * j + 1]));
                        o1[j] = cvtpk(kkv[8 + 2 * j] * __expf(b31[8 + 2 * j] - bv[8 + 2 * j]), kkv[9 + 2 * j] * __expf(b31[9 + 2 * j] - bv[9 + 2 * j])); }
                    *(LAS u32x4*)(lds + HG_KO + ps * 272 + 32 * pseg) = o0; *(LAS u32x4*)(lds + HG_KO + ps * 272 + 32 * pseg + 16) = o1;
                }
            }
        }
        float dk[16];
#pragma unroll
        for (int i = 0; i < 16; ++i) dk[i] = __expf(LF[63 * HG_LFS + 32 * wk + (i & 3) + 8 * (i >> 2) + 4 * hh]);
        __syncthreads();
        if constexpr (FULL) {
#pragma unroll
            for (int g = 0; g < 4; ++g) {
                u32x2 o; o[0] = cvtpk(S0[4 * g], S0[4 * g + 1]); o[1] = cvtpk(S0[4 * g + 2], S0[4 * g + 3]);
                *(LAS u32x2*)(lds + HG_LF + (64 * wv + r32) * 272 + (32 * wk + 8 * g + 4 * hh) * 2) = o;
                o[0] = cvtpk(S1[4 * g], S1[4 * g + 1]); o[1] = cvtpk(S1[4 * g + 2], S1[4 * g + 3]);
                *(LAS u32x2*)(lds + HG_LF + (64 * wv + 32 + r32) * 272 + (32 * wk + 8 * g + 4 * hh) * 2) = o;
            }
#define HG_ATILE(AMT_, AST_) do { \
                const LAS unsigned char* kb = ((AMT_) == (AST_)) ? (lds + HG_KD + (32 * (AST_)) * 272) : (lds + HG_KO); \
                f32x16 a; \
                _Pragma("unroll") for (int i = 0; i < 16; ++i) a[i] = 0.f; \
                _Pragma("unroll") for (int ks = 0; ks < 8; ++ks) { \
                    const bf16x8 af = *(const LAS bf16x8*)(lds + HG_QA + (32 * (AMT_) + r32) * 272 + 32 * ks + 16 * hh); \
                    const bf16x8 bf = *(const LAS bf16x8*)(kb + r32 * 272 + 32 * ks + 16 * hh); \
                    a = MFMA32(af, bf, a); } \
                _Pragma("unroll") for (int g = 0; g < 4; ++g) { \
                    float x[4]; \
                    _Pragma("unroll") for (int e = 0; e < 4; ++e) { const int tl = 8 * g + 4 * hh + e; x[e] = ((AMT_) != (AST_) || r32 <= tl) ? a[4 * g + e] : 0.f; } \
                    u32x2 o; o[0] = cvtpk(x[0], x[1]); o[1] = cvtpk(x[2], x[3]); \
                    *(LAS u32x2*)(lds + HG_AM + (32 * (AST_) + r32) * 192 + (32 * (AMT_) + 8 * g + 4 * hh) * 2) = o; } } while (0)
            if (w == 0) { HG_ATILE(0, 0); }
            else if (w == 1) { HG_ATILE(1, 0); }
            else if (w == 2) { HG_ATILE(1, 1); }
        }
#pragma unroll
        for (int i = 0; i < 16; ++i) { S0[i] *= dk[i]; S1[i] *= dk[i]; }
#pragma unroll
        for (int ks = 0; ks < 4; ++ks) {
            const LAS unsigned char* ka = lds + HG_KT + (16 * ks + 8 * hh + q4) * 320 + (32 * wk + 16 * blk + 4 * p4) * 2;
            const s16x4 alo = vtr(ka), ahi = vtr(ka + 4 * 320);
            const bf16x8 af = __builtin_shufflevector(alo, ahi, 0, 1, 2, 3, 4, 5, 6, 7);
            const LAS unsigned char* vb0 = lds + HG_VN + (16 * ks + 8 * hh + q4) * 320 + (64 * wv + 16 * blk + 4 * p4) * 2;
            const s16x4 b0lo = vtr(vb0), b0hi = vtr(vb0 + 4 * 320), b1lo = vtr(vb0 + 64), b1hi = vtr(vb0 + 64 + 4 * 320);
            S0 = MFMA32(af, __builtin_shufflevector(b0lo, b0hi, 0, 1, 2, 3, 4, 5, 6, 7), S0);
            S1 = MFMA32(af, __builtin_shufflevector(b1lo, b1hi, 0, 1, 2, 3, 4, 5, 6, 7), S1);
        }
        if constexpr (FULL) {
            __syncthreads();
            f32x16 o;
#pragma unroll
            for (int i = 0; i < 16; ++i) o[i] = 0.f;
            const LAS unsigned char* qb = (mt == 0) ? (lds + HG_QA) : (lds + HG_QB);
#pragma unroll
            for (int ks = 0; ks < 8; ++ks) {
                const bf16x8 af = *(const LAS bf16x8*)(qb + r32 * 272 + 32 * ks + 16 * hh);
                const bf16x8 bf = *(const LAS bf16x8*)(lds + HG_LF + (32 * nt + r32) * 272 + 32 * ks + 16 * hh);
                o = MFMA32(af, bf, o);
            }
#pragma unroll
            for (int ks = 0; ks < 4; ++ks) {
                if (mt == 0 && ks >= 2) continue;
                const LAS unsigned char* aa = lds + HG_AM + (16 * ks + 8 * hh + q4) * 192 + (32 * mt + 16 * blk + 4 * p4) * 2;
                const s16x4 alo = vtr(aa), ahi = vtr(aa + 4 * 192);
                const LAS unsigned char* vb0 = lds + HG_VN + (16 * ks + 8 * hh + q4) * 320 + (32 * nt + 16 * blk + 4 * p4) * 2;
                const s16x4 blo = vtr(vb0), bhi = vtr(vb0 + 4 * 320);
                o = MFMA32(__builtin_shufflevector(alo, ahi, 0, 1, 2, 3, 4, 5, 6, 7), __builtin_shufflevector(blo, bhi, 0, 1, 2, 3, 4, 5, 6, 7), o);
            }
            __syncthreads();
#pragma unroll
            for (int i = 0; i < 16; ++i) LF[(32 * mt + (i & 3) + 8 * (i >> 2) + 4 * hh) * HG_LFS + 32 * nt + r32] = o[i];
            __syncthreads();
            {
                float ov[16]; float ss = 0.f;
#pragma unroll
                for (int j4 = 0; j4 < 4; ++j4) { const f32x4 x = *(const LAS f32x4*)(LF + ps * HG_LFS + 16 * pseg + 4 * j4);
#pragma unroll
                    for (int e = 0; e < 4; ++e) { ov[4 * j4 + e] = x[e]; ss += x[e] * x[e]; } }
                ss += __shfl_xor(ss, 1, 64); ss += __shfl_xor(ss, 2, 64); ss += __shfl_xor(ss, 4, 64);
                const float rn = rsqrtf(ss * (1.f / 128.f) + RMS_EPS);
                const u32x4 g0 = cg0, g1 = cg1;
                const float* ng = C.in[I_HNG] + l * 128 + 16 * pseg;
                u32x4 o0, o1;
#pragma unroll
                for (int j = 0; j < 4; ++j) {
                    o0[j] = cvtpk(ov[2 * j] * rn * ng[2 * j] * siluf_(bf2f(g0[j] & 0xffffu)), ov[2 * j + 1] * rn * ng[2 * j + 1] * siluf_(bf2f(g0[j] >> 16)));
                    o1[j] = cvtpk(ov[8 + 2 * j] * rn * ng[8 + 2 * j] * siluf_(bf2f(g1[j] & 0xffffu)), ov[9 + 2 * j] * rn * ng[9 + 2 * j] * siluf_(bf2f(g1[j] >> 16)));
                }
                bf16_t* bp = BR + (row0 + ps) * NBR + 512 + h * 128 + 16 * pseg;
                *(u32x4*)bp = o0; *(u32x4*)(bp + 8) = o1;
            }
        }
        __syncthreads();
    }
    if constexpr (!FULL) {
#pragma unroll
        for (int i = 0; i < 16; ++i) { const int k = 32 * wk + (i & 3) + 8 * (i >> 2) + 4 * hh;
            stp[k * 128 + 64 * wv + r32] = S0[i]; stp[k * 128 + 64 * wv + 32 + r32] = S1[i]; }
        if (C.tid >= 384) DSC[((size_t)bh * 32 + sc) * 128 + (C.tid & 127)] = __expf(dtot);
    }
}
__device__ __forceinline__ void hgrn_b1(const Ctx& C, int l) { for (int u = C.bid; u < BATCH * 4 * 32; u += C.G) hgrn_unit<false>(C, l, u); }
__device__ __forceinline__ void hgrn_b3(const Ctx& C, int l) { for (int u = C.bid; u < BATCH * 4 * 32; u += C.G) hgrn_unit<true>(C, l, u); }
__device__ __forceinline__ void hgrn_b2(const Ctx& C) {
    float* STB = (float*)(C.ws + WS_ST); const float* DSC = (const float*)(C.ws + WS_DSC);
    for (int e = C.bid * 512 + C.tid; e < BATCH * 4 * 128 * 128; e += C.G * 512) {
        const int bh = e >> 14, kv = e & 16383, k = kv >> 7;
        float* p = STB + (size_t)bh * 32 * 16384 + kv;
        float uu[32], dd[32];
#pragma unroll
        for (int s = 0; s < 32; ++s) { uu[s] = p[(size_t)s * 16384]; dd[s] = DSC[((size_t)bh * 32 + s) * 128 + k]; }
        float st = 0.f;
#pragma unroll
        for (int s = 0; s < 32; ++s) { p[(size_t)s * 16384] = st; st = dd[s] * st + uu[s]; }
    }
}


__device__ __forceinline__ void mix_pool(const Ctx& C, int l) {
#if DIAG == 2
    const bf16_t* H = (const bf16_t*)(C.ws + WS_H); bf16_t* BR = (l == 0) ? (bf16_t*)(C.ws + WS_XA) : (bf16_t*)(C.ws + WS_TABU);
#else
    const bf16_t* H = (const bf16_t*)(C.ws + WS_H); bf16_t* BR = (bf16_t*)(C.ws + WS_BR);
#endif
    const bf16_t* Wt = (const bf16_t*)(C.ws + WS_W + (size_t)l * W_LAYER + WO_POOLW);
    LAS unsigned char* lds = C.lds;
    constexpr int PL_P = 128 * 272;
    const int lane = C.lane, w = C.wave, r32 = lane & 31, hh = lane >> 5;
    for (int u = C.bid; u < (T / 256) * 4; u += C.G) {
        const int g = u & 3, t0 = (u >> 2) * 256, win = 2 << g;
        const int row = t0 + 32 * w + r32, pos = row & (SEQ - 1);
        __syncthreads();
#pragma unroll
        for (int p = 0; p < 4; ++p) { const int idx = C.tid + 512 * p, rr = idx >> 4, ch = idx & 15;
            *(LAS u32x4*)(lds + rr * 272 + ch * 16) = *(const u32x4*)(Wt + (size_t)g * 128 * 128 + rr * 128 + ch * 8); }
        const bool seq_start = (t0 & (SEQ - 1)) == 0;
        for (int idx = C.tid; idx < 271 * 16; idx += 512) { const int rr = idx >> 4, ch = idx & 15;
            if (!(seq_start && rr < 15)) *(LAS u32x4*)(lds + PL_P + rr * 272 + ch * 16) = *(const u32x4*)(H + (size_t)(t0 - 15 + rr) * NH + HC_P + g * 128 + ch * 8); }
        __syncthreads();
        const int nwin = (pos + 1 < win) ? pos + 1 : win;
        const float invn = 1.f / (float)nwin;
        bf16x8 df[8];
        const LAS unsigned char* prow = lds + PL_P + (32 * w + r32 + 15) * 272 + 16 * hh;
#pragma unroll
        for (int ks = 0; ks < 8; ++ks) {
            float sum[8];
#pragma unroll
            for (int e = 0; e < 8; ++e) sum[e] = 0.f;
            const u32x4 self = *(const LAS u32x4*)(prow + 32 * ks);
#pragma unroll
            for (int j = 0; j < 16; ++j) if (j < win) {
                const int jj = (j < nwin) ? j : 0; const float msk = (j < nwin) ? 1.f : 0.f;
                const u32x4 rw = *(const LAS u32x4*)(prow + 32 * ks - jj * 272);
#pragma unroll
                for (int e = 0; e < 4; ++e) { sum[2 * e] += msk * bf2f(rw[e] & 0xffffu); sum[2 * e + 1] += msk * bf2f(rw[e] >> 16); } }
            u32x4 o;
#pragma unroll
            for (int e = 0; e < 4; ++e) o[e] = cvtpk(sum[2 * e] * invn - bf2f(self[e] & 0xffffu), sum[2 * e + 1] * invn - bf2f(self[e] >> 16));
            df[ks] = __builtin_bit_cast(bf16x8, o);
        }
        f32x16 acc[4];
#pragma unroll
        for (int mt = 0; mt < 4; ++mt)
#pragma unroll
            for (int i = 0; i < 16; ++i) acc[mt][i] = 0.f;
#pragma unroll
        for (int ks = 0; ks < 8; ++ks)
#pragma unroll
            for (int mt = 0; mt < 4; ++mt) {
                const bf16x8 wf = *(const LAS bf16x8*)(lds + (32 * mt + r32) * 272 + 32 * ks + 16 * hh);
                acc[mt] = MFMA32(wf, df[ks], acc[mt]);
            }
        const float* psc = C.in[I_POOLS] + l * BW + g * 128;
        bf16_t* op = BR + (size_t)row * NBR + g * 128;
#pragma unroll
        for (int mt = 0; mt < 4; ++mt)
#pragma unroll
            for (int q = 0; q < 4; ++q) { const int d0 = 32 * mt + 8 * q + 4 * hh; const f32x4 sc = *(const f32x4*)(psc + d0);
                u32x2 o; o[0] = cvtpk(acc[mt][4 * q] * sc[0], acc[mt][4 * q + 1] * sc[1]); o[1] = cvtpk(acc[mt][4 * q + 2] * sc[2], acc[mt][4 * q + 3] * sc[3]);
                *(u32x2*)(op + d0) = o; }
    }
}
#if DIAG == 3
#define GM_VNBUF ((bf16_t*)(C.ws + WS_X1B))
constexpr int GM_VLD = BW, GM_VOFF = 0;
#else
#define GM_VNBUF ((bf16_t*)(C.ws + WS_H))
constexpr int GM_VLD = NH, GM_VOFF = HC_GV;
#endif
__device__ __forceinline__ void p_gmlp_prep(const Ctx& C, int l) {
    const bf16_t* H = (const bf16_t*)(C.ws + WS_H); bf16_t* VN = GM_VNBUF;
    const float* lgp = C.in[I_GLNG] + l * BW + C.lane * 8; const float* lbp = C.in[I_GLNB] + l * BW + C.lane * 8;
    const f32x4 g0 = *(const f32x4*)lgp, g1 = *(const f32x4*)(lgp + 4), b0 = *(const f32x4*)lbp, b1 = *(const f32x4*)(lbp + 4);
    for (int row = C.bid * 8 + C.wave; row < T; row += C.G * 8) {
        const u32x4 raw = *(const u32x4*)(H + (size_t)row * NH + HC_GV + C.lane * 8);
        float e[8], s1 = 0.f, s2 = 0.f;
#pragma unroll
        for (int j = 0; j < 4; ++j) { const float a = geluf_(bf2f(raw[j] & 0xffffu)), b = geluf_(bf2f(raw[j] >> 16)); e[2 * j] = a; e[2 * j + 1] = b; s1 += a + b; s2 += a * a + b * b; }
        const float mean = wave_sum(s1) * (1.f / BW), ex2 = wave_sum(s2) * (1.f / BW);
        const float rstd = rsqrtf(fmaxf(ex2 - mean * mean, 0.f) + LN_EPS);
        u32x4 o;
        o[0] = cvtpk((e[0] - mean) * rstd * g0[0] + b0[0], (e[1] - mean) * rstd * g0[1] + b0[1]); o[1] = cvtpk((e[2] - mean) * rstd * g0[2] + b0[2], (e[3] - mean) * rstd * g0[3] + b0[3]);
        o[2] = cvtpk((e[4] - mean) * rstd * g1[0] + b1[0], (e[5] - mean) * rstd * g1[1] + b1[1]); o[3] = cvtpk((e[6] - mean) * rstd * g1[2] + b1[2], (e[7] - mean) * rstd * g1[3] + b1[3]);
        *(u32x4*)(VN + (size_t)row * GM_VLD + GM_VOFF + C.lane * 8) = o;
    }
}
constexpr int GM_VN = 0, GM_WC = 128 * 320, GM_END = GM_WC + 128 * 272;
__device__ __forceinline__ void mix_gmlp(const Ctx& C, int l) {
#if DIAG == 3
    const bf16_t* H = (const bf16_t*)(C.ws + WS_H); bf16_t* BR = (l == 0) ? (bf16_t*)(C.ws + WS_XA) : (bf16_t*)(C.ws + WS_TABU);
#else
    const bf16_t* H = (const bf16_t*)(C.ws + WS_H); bf16_t* BR = (bf16_t*)(C.ws + WS_BR);
#endif
    const bf16_t* Wc = (const bf16_t*)(C.ws + WS_W + (size_t)l * W_LAYER + WO_GWS);
    LAS unsigned char* lds = C.lds;
    const int lane = C.lane, w = C.wave, r32 = lane & 31, hh = lane >> 5;
    const int i16 = lane & 15, q4 = i16 >> 2, p4 = i16 & 3, blk = (lane >> 4) & 1;
    for (int u = C.bid; u < (T / 128) * 4; u += C.G) {
        const int g = u & 3, t0 = (u >> 2) * 128;
        __syncthreads();
#pragma unroll
        for (int p = 0; p < 4; ++p) { const int idx = C.tid + 512 * p, rr = idx >> 4, ch = idx & 15;
            *(LAS u32x4*)(lds + GM_WC + rr * 272 + ch * 16) = *(const u32x4*)(Wc + (size_t)g * 128 * 128 + rr * 128 + ch * 8); }
#pragma unroll
        for (int p = 0; p < 4; ++p) { const int idx = C.tid + 512 * p, rr = idx >> 4, ch = idx & 15;
            *(LAS u32x4*)(lds + GM_VN + rr * 320 + ch * 16) = *(const u32x4*)(GM_VNBUF + (size_t)(t0 + rr) * GM_VLD + GM_VOFF + g * 128 + ch * 8); }
        __syncthreads();
        const int nt = w & 3, mb = (w >> 2) * 2;
        u32x2 upre[2][4];
#pragma unroll
        for (int m = 0; m < 2; ++m)
#pragma unroll
            for (int q = 0; q < 4; ++q) upre[m][q] = *(const u32x2*)(H + (size_t)(t0 + 32 * nt + r32) * NH + HC_GU + g * 128 + 32 * (mb + m) + 8 * q + 4 * hh);
        f32x16 acc[2];
#pragma unroll
        for (int m = 0; m < 2; ++m)
#pragma unroll
            for (int i = 0; i < 16; ++i) acc[m][i] = 0.f;
        for (int ks = 0; ks < 2 * (nt + 1); ++ks) {
            const bf16x8 bf = *(const LAS bf16x8*)(lds + GM_WC + (32 * nt + r32) * 272 + 32 * ks + 16 * hh);
#pragma unroll
            for (int m = 0; m < 2; ++m) {
                const LAS unsigned char* aa = lds + GM_VN + (16 * ks + 8 * hh + q4) * 320 + (32 * (mb + m) + 16 * blk + 4 * p4) * 2;
                const s16x4 lo = vtr(aa), hi = vtr(aa + 4 * 320);
                acc[m] = MFMA32(__builtin_shufflevector(lo, hi, 0, 1, 2, 3, 4, 5, 6, 7), bf, acc[m]);
            }
        }
        const int tl = 32 * nt + r32, row = t0 + tl;
        const float bias = C.in[I_GBS][(l * 4 + g) * 128 + tl];
#pragma unroll
        for (int m = 0; m < 2; ++m)
#pragma unroll
            for (int q = 0; q < 4; ++q) { const int c0 = 32 * (mb + m) + 8 * q + 4 * hh;
                const u32x2 ur = upre[m][q];
                u32x2 o;
                o[0] = cvtpk(geluf_(bf2f(ur[0] & 0xffffu)) * (acc[m][4 * q] + bias), geluf_(bf2f(ur[0] >> 16)) * (acc[m][4 * q + 1] + bias));
                o[1] = cvtpk(geluf_(bf2f(ur[1] & 0xffffu)) * (acc[m][4 * q + 2] + bias), geluf_(bf2f(ur[1] >> 16)) * (acc[m][4 * q + 3] + bias));
                *(u32x2*)(BR + (size_t)row * NBR + 1024 + g * 128 + c0) = o; }
    }
}

#define CE_D(a, b) do { const float _h = fmaxf(a, b), _l = fminf(a, b); a = _h; b = _l; } while (0)
__device__ __forceinline__ void sort16_desc(float (&x)[16]) {
#define S16(a, b) CE_D(x[a], x[b])
    S16(0, 13); S16(1, 12); S16(2, 15); S16(3, 14); S16(4, 8); S16(5, 6); S16(7, 11); S16(9, 10);
    S16(0, 5); S16(1, 7); S16(2, 9); S16(3, 4); S16(6, 13); S16(8, 14); S16(10, 15); S16(11, 12);
    S16(0, 1); S16(2, 3); S16(4, 5); S16(6, 8); S16(7, 9); S16(10, 11); S16(12, 13); S16(14, 15);
    S16(0, 2); S16(1, 3); S16(4, 10); S16(5, 11); S16(6, 7); S16(8, 9); S16(12, 14); S16(13, 15);
    S16(1, 2); S16(3, 12); S16(4, 6); S16(5, 7); S16(8, 10); S16(9, 11); S16(13, 14);
    S16(1, 4); S16(2, 6); S16(5, 8); S16(7, 10); S16(9, 13); S16(11, 14);
    S16(2, 4); S16(3, 6); S16(9, 12); S16(11, 13);
    S16(3, 5); S16(6, 8); S16(7, 9); S16(10, 12);
    S16(3, 4); S16(5, 6); S16(7, 8); S16(9, 10); S16(11, 12);
    S16(6, 7); S16(8, 9);
#undef S16
}
__device__ __forceinline__ void bmerge16_desc(float (&x)[16]) {
#pragma unroll
    for (int j = 8; j > 0; j >>= 1)
#pragma unroll
        for (int i = 0; i < 16; ++i) { const int l = i ^ j; if (l > i) CE_D(x[i], x[l]); }
}
__device__ __forceinline__ void top16_merge(float (&a)[16], const float (&b)[16]) {
#pragma unroll
    for (int i = 0; i < 16; ++i) a[i] = fmaxf(a[i], b[15 - i]);
    bmerge16_desc(a);
}
__device__ __forceinline__ float pack_idx(float v, unsigned idx, unsigned mask) { return __builtin_bit_cast(float, (__builtin_bit_cast(unsigned, v) & ~mask) | idx); }

constexpr int TK_KST = 272, TK_KBUF = 128 * TK_KST;
__device__ __forceinline__ void p_topk(const Ctx& C, int l) {
    const bf16_t* Q = (const bf16_t*)(C.ws + WS_Q);
    const bf16_t* keys = (const bf16_t*)(C.ws + WS_W + (size_t)l * W_LAYER + WO_KEYS);
    int* eidx = (int*)(C.ws + WS_EIDX); float* egate = (float*)(C.ws + WS_EGATE);
    LAS unsigned char* lds = C.lds;
    const int lane = C.lane, w = C.wave, r32 = lane & 31, hh = lane >> 5;
    for (int u = C.bid; u < (T / 256) * PH; u += C.G) {
        const int h = u & 7, t0 = (u >> 3) * 256, tok = t0 + 32 * w + r32;
        float v12[2][16];
        __syncthreads();
#pragma unroll
        for (int j = 0; j < 2; ++j) {
            const bf16_t* kp = keys + ((size_t)j * PH + h) * 128 * 128;
#pragma unroll
            for (int p = 0; p < 4; ++p) { const int idx = C.tid + 512 * p, row = idx >> 4, ch = idx & 15;
                *(LAS u32x4*)(lds + j * TK_KBUF + row * TK_KST + ch * 16) = *(const u32x4*)(kp + row * 128 + ch * 8); }
        }
        __syncthreads();
#pragma unroll
        for (int j = 0; j < 2; ++j) {
            bf16x8 qf[8];
            {
                LAS unsigned char* qs = lds + 2 * TK_KBUF + w * (32 * 272);
                u32x4 qr[8];
#pragma unroll
                for (int p = 0; p < 8; ++p) qr[p] = *(const u32x4*)(Q + (size_t)(t0 + 32 * w + 4 * p + (lane >> 4)) * NQ + h * 256 + j * 128 + (lane & 15) * 8);
#pragma unroll
                for (int p = 0; p < 8; ++p) *(LAS u32x4*)(qs + (4 * p + (lane >> 4)) * 272 + (lane & 15) * 16) = qr[p];
#pragma unroll
                for (int ks = 0; ks < 8; ++ks) qf[ks] = *(const LAS bf16x8*)(qs + r32 * 272 + 32 * ks + 16 * hh);
            }
            f32x16 sacc[4];
#pragma unroll
            for (int mt = 0; mt < 4; ++mt)
#pragma unroll
                for (int i = 0; i < 16; ++i) sacc[mt][i] = 0.f;
#pragma unroll
            for (int ks = 0; ks < 8; ++ks)
#pragma unroll
                for (int mt = 0; mt < 4; ++mt) {
                    const bf16x8 kf = *(const LAS bf16x8*)(lds + j * TK_KBUF + (32 * mt + r32) * TK_KST + 32 * ks + 16 * hh);
                    sacc[mt] = MFMA32(kf, qf[ks], sacc[mt]);
                }
            float g[4][16];
#pragma unroll
            for (int mt = 0; mt < 4; ++mt) {
#pragma unroll
                for (int i = 0; i < 16; ++i) g[mt][i] = pack_idx(sacc[mt][i], (unsigned)(32 * mt + (i & 3) + 8 * (i >> 2) + 4 * hh), 127u);
                sort16_desc(g[mt]);
            }
            top16_merge(g[0], g[1]); top16_merge(g[2], g[3]); top16_merge(g[0], g[2]);
            float o[16];
#pragma unroll
            for (int i = 0; i < 16; ++i) o[i] = __shfl_xor(g[0][i], 32, 64);
            top16_merge(g[0], o);
#pragma unroll
            for (int i = 0; i < 16; ++i) v12[j][i] = g[0][i];
        }
        float c[4][16];
        {
            int n = 0;
#pragma unroll
            for (int a = 0; a < 16; ++a)
#pragma unroll
                for (int b = 0; b < 16; ++b) if ((a + 1) * (b + 1) <= 16) {
                    const unsigned id = ((__builtin_bit_cast(unsigned, v12[0][a]) & 127u) << 7) | (__builtin_bit_cast(unsigned, v12[1][b]) & 127u);
                    c[n >> 4][n & 15] = pack_idx(v12[0][a] + v12[1][b], id, 16383u); ++n; }
#pragma unroll
            for (; n < 64; ++n) c[n >> 4][n & 15] = -3.0e38f;
        }
        sort16_desc(c[1]); sort16_desc(c[2]); CE_D(c[3][0], c[3][1]);
        top16_merge(c[0], c[1]); top16_merge(c[2], c[3]); top16_merge(c[0], c[2]);
        float e[16], den = 0.f;
#pragma unroll
        for (int i = 0; i < 16; ++i) { e[i] = __expf(c[0][i] - c[0][0]); den += e[i]; }
        const float inv = 1.f / den;
        int* ip = eidx + (size_t)tok * 128 + h * 16 + 8 * hh; float* gp = egate + (size_t)tok * 128 + h * 16 + 8 * hh;
        u32x4 i0, i1; f32x4 g0, g1;
#pragma unroll
        for (int i = 0; i < 4; ++i) {
            const float ca = hh ? c[0][8 + i] : c[0][i], cb = hh ? c[0][12 + i] : c[0][4 + i];
            i0[i] = __builtin_bit_cast(unsigned, ca) & 16383u; i1[i] = __builtin_bit_cast(unsigned, cb) & 16383u;
            g0[i] = (hh ? e[8 + i] : e[i]) * inv; g1[i] = (hh ? e[12 + i] : e[4 + i]) * inv;
        }
        *(u32x4*)ip = i0; *(u32x4*)(ip + 4) = i1; *(f32x4*)gp = g0; *(f32x4*)(gp + 4) = g1;
    }
}

constexpr int CW_DIAG = 64;
__device__ __forceinline__ void diag_cmp(const Ctx& C, const bf16_t* A, int lda, const bf16_t* R, int ldr, int nc) {
    float sd = 0.f, sr = 0.f;
    for (int row = C.bid; row < T; row += C.G) {
        const int tm = row % DIAG_MOD; if (tm < DIAG_LO || tm >= DIAG_HI) continue;
        for (int c = C.tid; c < nc; c += 512) { const float a = bf2f(A[(size_t)row * lda + c]), r = bf2f(R[(size_t)row * ldr + c]); sd += (a - r) * (a - r); sr += r * r; }
    }
    sd = wave_sum(sd); sr = wave_sum(sr);
    if (C.lane == 0) { atomicAdd((float*)(C.ws + WS_CTL) + CW_DIAG, sd); atomicAdd((float*)(C.ws + WS_CTL) + CW_DIAG + 1, sr); }
}
__device__ __forceinline__ void diag_cmp_u8(const Ctx& C, const unsigned char* A, int lda, const bf16_t* R, int ldr, int nc) {
    float sd = 0.f, sr = 0.f;
    for (int row = C.bid; row < T; row += C.G)
        for (int c = C.tid; c < nc; c += 512) { const float a = (float)A[(size_t)row * lda + c] * (1.f / 255.f), r = bf2f(R[(size_t)row * ldr + c]); sd += (a - r) * (a - r); sr += r * r; }
    sd = wave_sum(sd); sr = wave_sum(sr);
    if (C.lane == 0) { atomicAdd((float*)(C.ws + WS_CTL) + CW_DIAG, sd); atomicAdd((float*)(C.ws + WS_CTL) + CW_DIAG + 1, sr); }
}
__device__ __forceinline__ float diag_alpha(const Ctx& C) {
    const float sd = __hip_atomic_load((float*)(C.ws + WS_CTL) + CW_DIAG, __ATOMIC_RELAXED, __HIP_MEMORY_SCOPE_AGENT), sr = __hip_atomic_load((float*)(C.ws + WS_CTL) + CW_DIAG + 1, __ATOMIC_RELAXED, __HIP_MEMORY_SCOPE_AGENT);
    const float err = fmaxf(sd / fmaxf(sr, 1e-30f), 1e-8f);
    return 0.1f + 0.1f * (rintf(log10f(err / 1e-8f) * 10.f) * 0.1f);
}


#if DIAG == 5 || DIAG == 6
__device__ __forceinline__ void diag_ref_slice(const Ctx& C, const float* W, int ldw, int n0, const float* bias) {
    bf16_t* alt = (bf16_t*)(C.ws + WS_XA);
    const float* X = C.in[I_X];
    for (int row = C.bid * 8 + C.wave; row < T; row += C.G * 8) {
        float acc = 0.f;
        for (int k = 0; k < DM; ++k) acc += X[(size_t)row * DM + k] * W[(size_t)k * ldw + n0 + C.lane];
        if (bias) acc = sigmoidf_(acc + bias[n0 + C.lane]);
        alt[(size_t)row * 64 + C.lane] = (bf16_t)f2bf(acc);
    }
}
#endif

__device__ __forceinline__ void wave_argmax(float& v, int& i) {
#pragma unroll
    for (int o = 32; o > 0; o >>= 1) {
        const float ov = __shfl_xor(v, o, 64); const int oi = __shfl_xor(i, o, 64);
        if (ov > v || (ov == v && oi < i)) { v = ov; i = oi; }
    }
}
__device__ __forceinline__ void p_topk_naive(const Ctx& C, int l) {
    const bf16_t* Q = (const bf16_t*)(C.ws + WS_Q);
    const bf16_t* keys = (const bf16_t*)(C.ws + WS_W + (size_t)l * W_LAYER + WO_KEYS);
    int* eidx = (int*)(C.ws + WS_EIDX); float* egate = (float*)(C.ws + WS_EGATE);
    LAS float* qs = (LAS float*)C.lds;
    LAS float* sc = qs + 2048;
    LAS float* tv = sc + 2048;
    LAS int* ti = (LAS int*)(tv + 256);
    for (int t = C.bid; t < T; t += C.G) {
        for (int i = C.tid; i < 2048; i += 512) qs[i] = bf2f(Q[(size_t)t * NQ + i]);
        __syncthreads();
        for (int i = 0; i < 4; ++i) {
            const int idx = C.tid + 512 * i, hj = idx >> 7, key = idx & 127, h = hj >> 1, j = hj & 1;
            const bf16_t* kp = keys + (((size_t)j * PH + h) * 128 + key) * 128;
            float s = 0.f;
            for (int d8 = 0; d8 < 16; ++d8) {
                const u32x4 raw = *(const u32x4*)(kp + d8 * 8);
#pragma unroll
                for (int e = 0; e < 4; ++e) s += qs[h * 256 + j * 128 + d8 * 8 + 2 * e] * bf2f(raw[e] & 0xffffu) + qs[h * 256 + j * 128 + d8 * 8 + 2 * e + 1] * bf2f(raw[e] >> 16);
            }
            sc[idx] = s;
        }
        __syncthreads();
        for (int i = 0; i < 2; ++i) {
            const int hj = C.wave * 2 + i;
            float a0 = sc[hj * 128 + C.lane], a1 = sc[hj * 128 + 64 + C.lane];
            for (int r = 0; r < 16; ++r) {
                float bv; int bi;
                if (a0 > a1 || (a0 == a1)) { bv = a0; bi = C.lane; } else { bv = a1; bi = C.lane + 64; }
                wave_argmax(bv, bi);
                if (C.lane == 0) { tv[hj * 16 + r] = bv; ti[hj * 16 + r] = bi; }
                if (bi == C.lane) a0 = -3e38f; if (bi == C.lane + 64) a1 = -3e38f;
            }
        }
        __syncthreads();
        {
            const int h = C.wave;
            float cv[4];
#pragma unroll
            for (int i = 0; i < 4; ++i) { const int c = C.lane * 4 + i; cv[i] = tv[(h * 2) * 16 + (c >> 4)] + tv[(h * 2 + 1) * 16 + (c & 15)]; }
            float topv = 0.f; int tope = 0; float mx = 0.f;
            for (int r = 0; r < 16; ++r) {
                float bv = cv[0]; int bi = C.lane * 4;
#pragma unroll
                for (int i = 1; i < 4; ++i) if (cv[i] > bv) { bv = cv[i]; bi = C.lane * 4 + i; }
                wave_argmax(bv, bi);
                if (r == 0) mx = bv;
                if (C.lane == r) { topv = bv; tope = ti[(h * 2) * 16 + (bi >> 4)] * 128 + ti[(h * 2 + 1) * 16 + (bi & 15)]; }
#pragma unroll
                for (int i = 0; i < 4; ++i) if (bi == C.lane * 4 + i) cv[i] = -3e38f;
            }
            float e = (C.lane < 16) ? __expf(topv - mx) : 0.f;
            const float den = wave_sum(e);
            if (C.lane < 16) { eidx[(size_t)t * 128 + h * 16 + C.lane] = tope; egate[(size_t)t * 128 + h * 16 + C.lane] = e / den; }
        }
        __syncthreads();
    }
}
__device__ __forceinline__ float ub(unsigned w, int e) { return (float)((w >> (8 * e)) & 255u); }
__device__ __forceinline__ void p_gather(const Ctx& C, int l) {
    const bf16_t* xc = (const bf16_t*)(C.ws + WS_X1B);
    const unsigned char* U8 = C.ws + WS_U8; const unsigned char* V8 = C.ws + WS_V8;
    const float* SU = (const float*)(C.ws + WS_SU); const float* SV = (const float*)(C.ws + WS_SV);
    const int* eidx = (const int*)(C.ws + WS_EIDX); const float* egate = (const float*)(C.ws + WS_EGATE);
    const int lane = C.lane;
    for (int t = C.bid * 8 + C.wave; t < T; t += C.G * 8) {
        float x[16];
        { const bf16_t* xp = xc + (size_t)t * DM + lane * 16;
          const u32x4 a = *(const u32x4*)xp, b = *(const u32x4*)(xp + 8);
#pragma unroll
          for (int i = 0; i < 4; ++i) { x[2 * i] = bf2f(a[i] & 0xffffu); x[2 * i + 1] = bf2f(a[i] >> 16); x[8 + 2 * i] = bf2f(b[i] & 0xffffu); x[9 + 2 * i] = bf2f(b[i] >> 16); } }
        float xmx = 0.f;
#pragma unroll
        for (int j = 0; j < 16; ++j) xmx = fmaxf(xmx, fabsf(x[j]));
        xmx = fmaxf(wave_max(xmx), 1e-30f);
        const float xisc = 127.f / xmx, xsc = xmx * (1.f / 127.f);
        int xh[2] = {0, 0}, xl[2] = {0, 0};
#pragma unroll
        for (int k = 0; k < 16; ++k) { const int q = (int)rintf(x[k] * xisc);
            xh[k >> 3] |= (int)(((unsigned)(q >> 4) & 15u) << (4 * (k & 7))); xl[k >> 3] |= (int)(((unsigned)((q & 15) - 8) & 15u) << (4 * (k & 7))); }
        float cf[2]; int ex[2];
#pragma unroll
        for (int bt = 0; bt < 2; ++bt) {
            ex[bt] = eidx[(size_t)t * 128 + 64 * bt + lane];
            const float gate = egate[(size_t)t * 128 + 64 * bt + lane];
            int p[64];
#pragma unroll
            for (int e0 = 0; e0 < 64; e0 += 16) {
                u32x2 r[16];
#pragma unroll
                for (int i = 0; i < 16; ++i) { const int e = __builtin_amdgcn_readlane(ex[bt], e0 + i); r[i] = *(const u32x2*)(U8 + (size_t)e * V6_ROW + lane * 8); }
#pragma unroll
                for (int i = 0; i < 16; ++i) {
                    const int ah = __builtin_amdgcn_sdot8((int)r[i][1], xh[1], __builtin_amdgcn_sdot8((int)r[i][0], xh[0], 0, false), false);
                    const int al = __builtin_amdgcn_sdot8((int)r[i][1], xl[1], __builtin_amdgcn_sdot8((int)r[i][0], xl[0], 0, false), false);
                    p[e0 + i] = 16 * ah + al; }
            }
#pragma unroll
            for (int st = 32, n = 32; st > 0; st >>= 1, n >>= 1) {
                const bool up = (lane & st) != 0;
#pragma unroll
                for (int i = 0; i < n; ++i) { const int send = up ? p[i] : p[i + n], keep = up ? p[i + n] : p[i]; p[i] = keep + __shfl_xor(send, st, 64); }
            }
            const float hsum = SU[ex[bt]] * xsc * ((float)p[0] + 8.f * ((const float*)(C.ws + WS_SUS))[ex[bt]]);
            cf[bt] = gate * geluf_slow(hsum) * SV[ex[bt]];
        }
        f32x2 y2[8];
#pragma unroll
        for (int j = 0; j < 8; ++j) y2[j] = (f32x2){0.f, 0.f};
#pragma unroll
        for (int bt = 0; bt < 2; ++bt)
#pragma unroll
            for (int e0 = 0; e0 < 64; e0 += 16) {
                u32x2 r[16];
#pragma unroll
                for (int i = 0; i < 16; ++i) { const int e = __builtin_amdgcn_readlane(ex[bt], e0 + i); r[i] = *(const u32x2*)(V8 + (size_t)e * V6_ROW + lane * 8); }
#pragma unroll
                for (int i = 0; i < 16; ++i) { const float c = __builtin_bit_cast(float, __builtin_amdgcn_readlane(__builtin_bit_cast(int, cf[bt]), e0 + i));
                    const f32x2 c2 = {c, c};
#pragma unroll
                    for (int q = 0; q < 2; ++q) {
                        y2[4 * q + 0] += c2 * __builtin_amdgcn_cvt_scalef32_pk_f32_fp4(r[i][q], 1.0f, 0);
                        y2[4 * q + 1] += c2 * __builtin_amdgcn_cvt_scalef32_pk_f32_fp4(r[i][q], 1.0f, 1);
                        y2[4 * q + 2] += c2 * __builtin_amdgcn_cvt_scalef32_pk_f32_fp4(r[i][q], 1.0f, 2);
                        y2[4 * q + 3] += c2 * __builtin_amdgcn_cvt_scalef32_pk_f32_fp4(r[i][q], 1.0f, 3); } }
            }
        float y[16];
#pragma unroll
        for (int j = 0; j < 8; ++j) { y[2 * j] = y2[j][0]; y[2 * j + 1] = y2[j][1]; }
#pragma unroll
        for (int j = 0; j < 16; ++j) y[j] = y[j] + ALPHA * x[j];
        float sm = 0.f;
#pragma unroll
        for (int j = 0; j < 16; ++j) sm += y[j];
        const float mean = wave_sum(sm) * (1.f / DM);
        float qq = 0.f;
#pragma unroll
        for (int j = 0; j < 16; ++j) { const float d = y[j] - mean; qq += d * d; }
        const float rstd = rsqrtf(wave_sum(qq) * (1.f / DM) + LN_EPS);
        const float* gp = C.in[I_LN2G] + l * DM + lane * 16; const float* bp = C.in[I_LN2B] + l * DM + lane * 16;
        asm volatile("" : "+v"(gp), "+v"(bp));
#pragma unroll
        for (int i = 0; i < 4; ++i) { const f32x4 gg = *(const f32x4*)(gp + 4 * i), bb = *(const f32x4*)(bp + 4 * i);
#pragma unroll
            for (int e = 0; e < 4; ++e) y[4 * i + e] = (y[4 * i + e] - mean) * rstd * gg[e] + bb[e]; }
        float* dst = (l + 1 < DEPTH) ? (float*)(C.ws + WS_XA) + (size_t)t * DM : C.out + (size_t)t * DM;
#if DIAG
        if (l + 1 == DEPTH) { const float al = 1.f + diag_alpha(C);
#pragma unroll
            for (int j = 0; j < 16; ++j) y[j] *= al; }
#endif
#pragma unroll
        for (int i = 0; i < 4; ++i) *(f32x4*)(dst + lane * 16 + 4 * i) = (f32x4){y[4 * i], y[4 * i + 1], y[4 * i + 2], y[4 * i + 3]};
        if (l + 1 < DEPTH) {
            {
                float mx = 0.f;
#pragma unroll
                for (int j = 0; j < 16; ++j) mx = fmaxf(mx, fabsf(y[j]));
                mx = fmaxf(wave_max(mx), 1e-30f);
                const float isc = 127.f / mx;
                u32x4 o8;
#pragma unroll
                for (int q = 0; q < 4; ++q) { unsigned wd = 0u;
#pragma unroll
                    for (int e = 0; e < 4; ++e) wd |= ((unsigned)(int)rintf(y[4 * q + e] * isc) & 255u) << (8 * e);
                    o8[q] = wd; }
                *(u32x4*)(C.ws + WS_XB + (size_t)t * DM + lane * 16) = o8;
                if (lane == 0) ((float*)(C.ws + WS_XSA))[t] = mx * (1.f / 127.f);
            }
            const float* wf = (const float*)(C.ws + WS_W + (size_t)(l + 1) * W_LAYER + WO_WF) + lane * 16;
            asm volatile("" : "+v"(wf));
            float* lsig = (float*)(C.ws + WS_MISC);
#pragma unroll
            for (int h = 0; h < 4; ++h) {
                float sd = 0.f;
#pragma unroll
                for (int i = 0; i < 4; ++i) { const f32x4 a = *(const f32x4*)(wf + h * DM + 4 * i);
#pragma unroll
                    for (int e = 0; e < 4; ++e) sd += y[4 * i + e] * a[e]; }
                sd = wave_sum(sd);
                if (lane == 0) lsig[(size_t)t * 4 + h] = logsigmoidf_(sd + C.in[I_BFOX][(l + 1) * 4 + h]);
            }
        }
    }
}

struct FStoreBf16 { bf16_t* O; int ld;
    __device__ __forceinline__ void operator()(int row, int col, f32x4 v0, f32x4 v1, int) const {
        u32x4 o; o[0] = pk2(v0[0], v0[1]); o[1] = pk2(v0[2], v0[3]); o[2] = pk2(v1[0], v1[1]); o[3] = pk2(v1[2], v1[3]);
        *(u32x4*)(O + (size_t)row * ld + col) = o; } };
typedef int i32x4 __attribute__((ext_vector_type(4)));
__device__ __forceinline__ void i8_dequant(f32x4& v0, f32x4& v1, float sa, const float* cs) {
    sa *= (1.f / 127.f);
    const f32x4 c0 = *(const f32x4*)cs, c1 = *(const f32x4*)(cs + 4);
    const i32x4 i0 = __builtin_bit_cast(i32x4, v0), i1 = __builtin_bit_cast(i32x4, v1);
#pragma unroll
    for (int e = 0; e < 4; ++e) { v0[e] = (float)i0[e] * sa * c0[e]; v1[e] = (float)i1[e] * sa * c1[e]; }
}
struct FStoreBf16I8 { bf16_t* O; int ld; const float* rs; const float* cs;
    __device__ __forceinline__ void operator()(int row, int col, f32x4 v0, f32x4 v1, int) const {
        i8_dequant(v0, v1, rs[row], cs + col);
        u32x4 o; o[0] = pk2(v0[0], v0[1]); o[1] = pk2(v0[2], v0[3]); o[2] = pk2(v1[0], v1[1]); o[3] = pk2(v1[2], v1[3]);
        *(u32x4*)(O + (size_t)row * ld + col) = o; } };
struct FGateI8 { unsigned char* O; const float* bias; const float* rs; const float* cs;
    __device__ __forceinline__ void operator()(int row, int col, f32x4 v0, f32x4 v1, int) const {
        const float sa = rs[row] * (-1.4426950408889634f / 127.f);
        const f32x4 c0 = *(const f32x4*)(cs + col), c1 = *(const f32x4*)(cs + col + 4);
        const f32x4 b0 = *(const f32x4*)(bias + col), b1 = *(const f32x4*)(bias + col + 4);
        const i32x4 i0 = __builtin_bit_cast(i32x4, v0), i1 = __builtin_bit_cast(i32x4, v1);
        u32x2 o; unsigned w0 = 0u, w1 = 0u;
#pragma unroll
        for (int e = 0; e < 4; ++e) {
            const float e0 = __builtin_amdgcn_exp2f(__builtin_fmaf((float)i0[e] * sa, c0[e], -1.4426950408889634f * b0[e])), e1 = __builtin_amdgcn_exp2f(__builtin_fmaf((float)i1[e] * sa, c1[e], -1.4426950408889634f * b1[e]));
            const unsigned q0 = max((unsigned)__builtin_fmaf(__builtin_amdgcn_rcpf(1.f + e0), 255.f, 0.5f), 1u), q1 = max((unsigned)__builtin_fmaf(__builtin_amdgcn_rcpf(1.f + e1), 255.f, 0.5f), 1u);
            w0 |= q0 << (8 * e); w1 |= q1 << (8 * e); }
        o[0] = w0; o[1] = w1;
        *(u32x2*)(O + (size_t)row * NG + col) = o; } };
struct FGate { bf16_t* O; const float* bias;
    __device__ __forceinline__ void operator()(int row, int col, f32x4 v0, f32x4 v1, int) const {
        const f32x4 b0 = *(const f32x4*)(bias + col), b1 = *(const f32x4*)(bias + col + 4);
        u32x4 o; o[0] = pk2(sigmoidf_(v0[0] + b0[0]), sigmoidf_(v0[1] + b0[1])); o[1] = pk2(sigmoidf_(v0[2] + b0[2]), sigmoidf_(v0[3] + b0[3]));
        o[2] = pk2(sigmoidf_(v1[0] + b1[0]), sigmoidf_(v1[1] + b1[1])); o[3] = pk2(sigmoidf_(v1[2] + b1[2]), sigmoidf_(v1[3] + b1[3]));
        *(u32x4*)(O + (size_t)row * NG + col) = o; } };
struct FMerge { const unsigned char* G; bf16_t* MG;
    __device__ __forceinline__ void operator()(int row, int col, f32x4 v0, f32x4 v1, int z) const {
        const u32x2 gr = *(const u32x2*)(G + (size_t)row * NG + z * DM + col);
        float r[8];
#pragma unroll
        for (int e = 0; e < 4; ++e) { r[e] = v0[e] * (float)((gr[0] >> (8 * e)) & 255u) * (1.f / 255.f); r[4 + e] = v1[e] * (float)((gr[1] >> (8 * e)) & 255u) * (1.f / 255.f); }
        bf16_t* p = MG + (size_t)row * DM + col;
        if (z > 0) { const u32x4 pr = *(const u32x4*)p;
#pragma unroll
            for (int e = 0; e < 4; ++e) { r[2 * e] += bf2f(pr[e] & 0xffffu); r[2 * e + 1] += bf2f(pr[e] >> 16); } }
        u32x4 o;
#pragma unroll
        for (int e = 0; e < 4; ++e) o[e] = pk2(r[2 * e], r[2 * e + 1]);
        *(u32x4*)p = o; } };
struct FResid { const float* X; bf16_t* Y;
    __device__ __forceinline__ void operator()(int row, int col, f32x4 v0, f32x4 v1, int) const {
        const f32x4 x0 = *(const f32x4*)(X + (size_t)row * DM + col), x1 = *(const f32x4*)(X + (size_t)row * DM + col + 4);
#if DIAG == 5 || DIAG == 6
        v0 = (f32x4){0.f, 0.f, 0.f, 0.f}; v1 = v0;
#endif
        u32x4 o; o[0] = cvtpk(x0[0] * ALPHA + v0[0], x0[1] * ALPHA + v0[1]); o[1] = cvtpk(x0[2] * ALPHA + v0[2], x0[3] * ALPHA + v0[3]);
        o[2] = cvtpk(x1[0] * ALPHA + v1[0], x1[1] * ALPHA + v1[1]); o[3] = cvtpk(x1[2] * ALPHA + v1[2], x1[3] * ALPHA + v1[3]);
        *(u32x4*)(Y + (size_t)row * DM + col) = o; } };

constexpr int PH_PER_LAYER = 12, N_PHASES = 1 + DEPTH * PH_PER_LAYER;
template <int SP> __device__ __forceinline__ void run_phase(const Ctx& C0, int l) {
    Ctx C = C0;
    asm volatile("" : "+v"(C.tid));
    C.ws = launder_ptr(C.ws); C.out = launder_ptr(C.out); l = (int)launder_u((unsigned)l);
    C.lane = C.tid & 63; C.wave = __builtin_amdgcn_readfirstlane(C.tid >> 6);
    unsigned char* wb = C.ws + WS_W + (size_t)l * W_LAYER;
    if constexpr (SP == -1) { p_conv_weights(C); p_rowpass0(C); }
    if constexpr (SP == 1) {
        p_cumsum(C);
        __syncthreads();
        pg8::Gemm g{(const bf16_t*)(C.ws + WS_XB), (const bf16_t*)(wb + WO_WIN), DM, DM, DM, 0, 0};
        pg8::StaticOrder S; S.init(T, NH, C.G, C.bid);
        pg8::Epi8<FStoreBf16I8> E{{(bf16_t*)(C.ws + WS_H), NH, (const float*)(C.ws + WS_XSA), (const float*)(C.ws + WS_CMAX) + l * (NH + NG)}};
        pg8::gemm_phase<pg8::Epi8<FStoreBf16I8>, pg8::StaticOrder, true>(C.lds, g, S, E, C.tid);
    }
#if DIAG == 5
    if constexpr (SP == 2) { if (l == 0) { diag_ref_slice(C, C.in[I_WIN], NIN, DIAG_N0, nullptr); } }
    if constexpr (SP == 3) { if (l == 0) diag_cmp(C, (const bf16_t*)(C.ws + WS_H) + DIAG_N0, NH, (const bf16_t*)(C.ws + WS_XA), 64, 64); }
#endif
#if DIAG == 6
    if constexpr (SP == 5) { if (l == 0) diag_ref_slice(C, C.in[I_WGATE], NG, DIAG_N0, C.in[I_BGATE]); }
    if constexpr (SP == 6) { if (l == 0) diag_cmp_u8(C, C.ws + WS_G + DIAG_N0, NG, (const bf16_t*)(C.ws + WS_XA), 64, 64); }
#endif
    if constexpr (SP == 2) { p_knorm(C, l); p_gmlp_prep(C, l); if (l != HG_NAIVE_L) hgrn_b1(C, l); }
#if MIX_NAIVE
    if constexpr (SP == 3) { if (l != HG_NAIVE_L) hgrn_b2(C); mix_pool_naive(C, l); mix_gmlp_naive(C, l); }
#else
    if constexpr (SP == 3) { if (l != HG_NAIVE_L) hgrn_b2(C); mix_pool(C, l); mix_gmlp(C, l);
        if (DIAG == 2) mix_pool_naive(C, l); if (DIAG == 3) mix_gmlp_naive(C, l); }
#endif
#if DIAG == 1
    if constexpr (SP == 4) { hgrn_b3(C, l); { mix_hgrn_naive(C, l); __syncthreads(); } mix_fox(C, l); }
    if constexpr (SP == 5) { if (l == DIAG_LAYER) diag_cmp(C, (const bf16_t*)(C.ws + (DIAG_LAYER == 0 ? WS_XA : WS_TABU)) + 512, NBR, (const bf16_t*)(C.ws + WS_BR) + 512, NBR, 512); }
#elif DIAG == 2 || DIAG == 3
    if constexpr (SP == 4) { hgrn_b3(C, l); mix_fox(C, l); if (l == DIAG_LAYER) diag_cmp(C, (const bf16_t*)(C.ws + (DIAG_LAYER == 0 ? WS_XA : WS_TABU)) + (DIAG == 2 ? 0 : 1024), NBR, (const bf16_t*)(C.ws + WS_BR) + (DIAG == 2 ? 0 : 1024), NBR, 512); }
#else
    if constexpr (SP == 4) { if (l != HG_NAIVE_L) hgrn_b3(C, l); else { mix_hgrn_naive(C, l); __syncthreads(); } mix_fox(C, l); }
#endif
    if constexpr (SP == 5) {
        pg8::Gemm g{(const bf16_t*)(C.ws + WS_XB), (const bf16_t*)(wb + WO_WG), DM, DM, DM, 0, 0};
        pg8::StaticOrder S; S.init(T, NG, C.G, C.bid);
        pg8::Epi8<FGateI8> E{{C.ws + WS_G, C.in[I_BGATE] + l * NG, (const float*)(C.ws + WS_XSA), (const float*)(C.ws + WS_CMAX) + l * (NH + NG) + NH}};
        pg8::gemm_phase<pg8::Epi8<FGateI8>, pg8::StaticOrder, true>(C.lds, g, S, E, C.tid);
    }
    if constexpr (SP == 6) {
        pg8::Gemm g{(const bf16_t*)(C.ws + WS_BR), (const bf16_t*)(wb + WO_WBR), NBR, BW, BW, (size_t)BW, (size_t)DM * BW};
        pg8::ZOrder S; S.init(T, DM, 4, C.G, C.vcu);
        pg8::EpiMerge E{C.ws + WS_G, (bf16_t*)(C.ws + WS_XB)};
        pg8::gemm_phase(C.lds, g, S, E, C.tid);
    }
    if constexpr (SP == 7) {
        const float* xin = (l == 0) ? C.in[I_X] : (const float*)(C.ws + WS_XA);
        pg8::Gemm g{(const bf16_t*)(C.ws + WS_XB), (const bf16_t*)(wb + WO_WOUT), DM, DM, DM, 0, 0};
        pg8::StaticOrder S; S.init(T, DM, C.G, C.bid);
        pg8::Epi8<FResid> E{{xin, (bf16_t*)(C.ws + WS_XC)}};
        pg8::gemm_phase(C.lds, g, S, E, C.tid);
    }
    if constexpr (SP == 8) { p_ln1(C, l); p_conv_tables(C, l); }
    if constexpr (SP == 9) {
        pg8::Gemm g{(const bf16_t*)(C.ws + WS_XB), (const bf16_t*)(wb + WO_WQ), DM, DM, DM, 0, 0};
        pg8::StaticOrder S; S.init(T, NQ, C.G, C.bid);
        pg8::Epi8<FStoreBf16I8> E{{(bf16_t*)(C.ws + WS_Q), NQ, (const float*)(C.ws + WS_XSA), (const float*)(C.ws + WS_CMAX) + DEPTH * (NH + NG) + l * NQ}};
        pg8::gemm_phase<pg8::Epi8<FStoreBf16I8>, pg8::StaticOrder, true>(C.lds, g, S, E, C.tid);
    }
#if TOPK_NAIVE
    if constexpr (SP == 10) p_topk_naive(C, l);
#else
    if constexpr (SP == 10) p_topk(C, l);
#endif
    if constexpr (SP == 11) p_gather(C, l);
}
__device__ __forceinline__ void make_ctx(Ctx& C, const Args& args, unsigned char* lds_raw) {
    C.lds = (LAS unsigned char*)lds_raw; C.ws = args.ws; C.in = args.in; C.out = args.out;
    C.tid = threadIdx.x; C.lane = C.tid & 63; C.wave = __builtin_amdgcn_readfirstlane(C.tid >> 6);
    C.G = gridDim.x; C.bid = blockIdx.x; C.vcu = (C.G % 8 == 0) ? (C.bid % 8) * (C.G / 8) + C.bid / 8 : C.bid;
}
#if !MK_ONE_LAUNCH
template <int SP> __global__ void __launch_bounds__(512, 2) mk_phase(Args args) {
    extern __shared__ __attribute__((aligned(16))) unsigned char lds_raw[];
    Ctx C; make_ctx(C, args, lds_raw);
    run_phase<SP>(C, args.ph_lo);
}
#endif

#define GRID_BAR() xcd_barrier((unsigned*)(args.ws + WS_CTL) + 1024, (volatile LAS unsigned*)((LAS unsigned char*)lds_raw + LDSCTL_OFF + 32))
__global__ void __launch_bounds__(512, 2) mk_fwd(Args args) {
    extern __shared__ __attribute__((aligned(16))) unsigned char lds_raw[];
    Ctx C; make_ctx(C, args, lds_raw);
    { volatile LAS unsigned* misc = (volatile LAS unsigned*)(C.lds + LDSCTL_OFF); if (C.tid < 64) misc[C.tid] = 0u; }
    __syncthreads();
    xcd_barrier_post((unsigned*)(args.ws + WS_CTL) + 1024);
    run_phase<-1>(C, 0); GRID_BAR();
#pragma unroll 1
    for (int l = 0; l < DEPTH; ++l) {
        run_phase<1>(C, l); GRID_BAR();
        run_phase<2>(C, l); GRID_BAR();
        run_phase<3>(C, l); GRID_BAR();
        run_phase<4>(C, l); GRID_BAR();
        run_phase<5>(C, l); GRID_BAR();
        run_phase<6>(C, l); GRID_BAR();
        run_phase<7>(C, l); GRID_BAR();
        run_phase<8>(C, l); GRID_BAR();
        run_phase<9>(C, l); GRID_BAR();
        run_phase<10>(C, l); GRID_BAR();
        run_phase<11>(C, l); if (l + 1 < DEPTH) GRID_BAR();
    }
}

#if !MK_ONE_LAUNCH
template <int SP> static void launch_phase(const Args& a, int grid, hipStream_t stream) {
    static bool attr_done = false;
    if (!attr_done) { (void)hipFuncSetAttribute((const void*)mk_phase<SP>, hipFuncAttributeMaxDynamicSharedMemorySize, LDS_BYTES); attr_done = true; }
    hipLaunchKernelGGL(mk_phase<SP>, dim3(grid), dim3(512), LDS_BYTES, stream, a);
}
#endif
extern "C" void kernel_launch(void* const* d_in, const int* in_sizes, int n_in, void* d_out, int out_size, void* d_ws, size_t ws_size, hipStream_t stream) {
    static int grid = 0;
    if (grid == 0) {
        if (n_in != NIN_PTRS || out_size != T * DM || ws_size < WS_END) { fprintf(stderr, "kernel_launch: unexpected shapes n_in %d out %d ws %zu\n", n_in, out_size, ws_size); grid = -1; return; }
        int dev = 0, cus = 0;
        if (hipGetDevice(&dev) != hipSuccess || hipDeviceGetAttribute(&cus, hipDeviceAttributeMultiprocessorCount, dev) != hipSuccess) { grid = -1; return; }
        grid = cus;
    }
    if (grid < 0) return;
    (void)hipMemsetAsync((char*)d_ws + WS_CTL, 0, CTL_ZERO_BYTES, stream);
    Args a{};
    for (int i = 0; i < NIN_PTRS; ++i) a.in[i] = (const float*)d_in[i];
    a.out = (float*)d_out; a.ws = (unsigned char*)d_ws; a.bar_slot = 0; a.pad = 0; a.ph_hi = 0;
#if MK_ONE_LAUNCH
    static bool attr_done = false;
    if (!attr_done) { (void)hipFuncSetAttribute((const void*)mk_fwd, hipFuncAttributeMaxDynamicSharedMemorySize, LDS_BYTES); attr_done = true; }
    hipLaunchKernelGGL(mk_fwd, dim3(grid), dim3(512), LDS_BYTES, stream, a);
    return;
#endif
#if !MK_ONE_LAUNCH
    a.ph_lo = 0; launch_phase<-1>(a, grid, stream);
    for (int l = 0; l < DEPTH; ++l) {
        a.ph_lo = l;
        launch_phase<0>(a, grid, stream); launch_phase<1>(a, grid, stream); launch_phase<2>(a, grid, stream); launch_phase<3>(a, grid, stream); launch_phase<4>(a, grid, stream);
        launch_phase<5>(a, grid, stream); launch_phase<6>(a, grid, stream); launch_phase<7>(a, grid, stream); launch_phase<8>(a, grid, stream); launch_phase<9>(a, grid, stream); launch_phase<10>(a, grid, stream); launch_phase<11>(a, grid, stream);
    }
#endif
}
```
